# Optimizing an MI355X kernel written in HIP

```python
import math
import jax, jax.numpy as jnp
from jax import lax
import numpy as np

D_MODEL = 1024
BATCH = 8
SEQ = 2048
DEPTH = 1

GRID_W = 64
CTX_LEN = 256
D_MIX = D_MODEL
N_DIRS = 2
S5_WIDTH = D_MIX // 2
S5_GROUP = 16
S5_GROUPS = S5_WIDTH // S5_GROUP
S5_STATE = 64
GDN_HEADS = 4
GDN_HEAD_DIM = (D_MIX - S5_WIDTH) // GDN_HEADS
GDN_WIDTH = GDN_HEADS * GDN_HEAD_DIM
GDN_CHUNK = 64
CONV_K = 3
PROJ_SPLITS = [S5_WIDTH, 3 * GDN_WIDTH, GDN_WIDTH, N_DIRS * GDN_HEADS, N_DIRS * GDN_HEADS]
PROJ_DIM = sum(PROJ_SPLITS)
PEER_HEADS = 8
PEER_N_KEYS = 128
PEER_N_EXPERTS = PEER_N_KEYS * PEER_N_KEYS
PEER_QUERY_DIM = 256
PEER_HALF = PEER_QUERY_DIM // 2
PEER_TOPK = 16
PEER_BLOCK = 128
EPS = 1e-6

kernel_name = "hymba_s5_gdn_peer_prefix_dit"


def rms_norm(x, g):
    xf = x.astype(jnp.float32)
    y = xf * lax.rsqrt(jnp.mean(xf * xf, axis=-1, keepdims=True) + EPS)
    return (y * g.astype(jnp.float32)).astype(x.dtype)


def l2_normalize(x):
    xf = x.astype(jnp.float32)
    return xf * lax.rsqrt(jnp.sum(xf * xf, axis=-1, keepdims=True) + EPS)


def adaln(cond, w_mod, b_mod):
    m = jax.nn.silu(cond) @ w_mod + b_mod
    return jnp.split(m[:, None, :], 6, axis=-1)


def modulate(h, shift, scale):
    return h * (1.0 + scale) + shift


def split_proj(p):
    idx = [int(i) for i in np.cumsum(PROJ_SPLITS)[:-1]]
    return jnp.split(p, idx, axis=-1)


def s5_discretize(lam_re, lam_im, log_dt, b_re, b_im):
    f32 = jnp.float32
    dt = jnp.exp(log_dt.astype(f32))[:, None]
    lr, li = lam_re.astype(f32), lam_im.astype(f32)
    mag = jnp.exp(lr * dt)
    lb_re, lb_im = mag * jnp.cos(li * dt), mag * jnp.sin(li * dt)
    den = lr * lr + li * li
    nr = lb_re - 1.0
    cr = (nr * lr + lb_im * li) / den
    ci = (lb_im * lr - nr * li) / den
    br, bi = b_re.astype(f32), b_im.astype(f32)
    bb_re = cr[..., None] * br - ci[..., None] * bi
    bb_im = cr[..., None] * bi + ci[..., None] * br
    return lb_re, lb_im, bb_re, bb_im


def _complex_affine_combine(e1, e2):
    a1r, a1i, b1r, b1i = e1
    a2r, a2i, b2r, b2i = e2
    return (a1r * a2r - a1i * a2i,
            a1r * a2i + a1i * a2r,
            a2r * b1r - a2i * b1i + b2r,
            a2r * b1i + a2i * b1r + b2i)


def s5_scan(u, lb_re, lb_im, bb_re, bb_im, h0_re, h0_im, reverse):
    if reverse:
        u = jnp.flip(u, axis=1)
    bu_re = jnp.einsum('blgc,gpc->blgp', u, bb_re)
    bu_im = jnp.einsum('blgc,gpc->blgp', u, bb_im)
    bu_re = bu_re.at[:, 0].add(lb_re * h0_re - lb_im * h0_im)
    bu_im = bu_im.at[:, 0].add(lb_re * h0_im + lb_im * h0_re)
    shape = (1, u.shape[1]) + lb_re.shape
    _, _, h_re, h_im = lax.associative_scan(
        _complex_affine_combine,
        (jnp.broadcast_to(lb_re, shape), jnp.broadcast_to(lb_im, shape), bu_re, bu_im), axis=1)
    fin_re, fin_im = h_re[:, -1], h_im[:, -1]
    if reverse:
        h_re, h_im = jnp.flip(h_re, axis=1), jnp.flip(h_im, axis=1)
    return h_re, h_im, fin_re, fin_im


def s5_readout(h_re, h_im, c_re, c_im):
    return (jnp.einsum('blgp,gcp->blgc', h_re, c_re.astype(jnp.float32))
            - jnp.einsum('blgp,gcp->blgc', h_im, c_im.astype(jnp.float32)))


def s5_mixer(u_x, u_c, lam_re, lam_im, log_dt, b_re, b_im, c_re, c_im, d_skip, w_glu, with_ctx):
    dtype = u_x.dtype

    def groups(u):
        return u.astype(jnp.float32).reshape(u.shape[0], u.shape[1], S5_GROUPS, S5_GROUP)

    ux, uc = groups(u_x), groups(u_c)
    d = d_skip.astype(jnp.float32).reshape(S5_GROUPS, S5_GROUP)
    zero = jnp.zeros((ux.shape[0], S5_GROUPS, S5_STATE), jnp.float32)
    y_x = ux * d
    y_c = uc * d if with_ctx else None
    for dr in range(N_DIRS):
        reverse = dr == 1
        lb_re, lb_im, bb_re, bb_im = s5_discretize(lam_re[dr], lam_im[dr], log_dt[dr], b_re[dr], b_im[dr])
        hc_re, hc_im, fc_re, fc_im = s5_scan(uc, lb_re, lb_im, bb_re, bb_im, zero, zero, reverse)
        hx_re, hx_im, _, _ = s5_scan(ux, lb_re, lb_im, bb_re, bb_im, fc_re, fc_im, reverse)
        y_x = y_x + s5_readout(hx_re, hx_im, c_re[dr], c_im[dr])
        if with_ctx:
            y_c = y_c + s5_readout(hc_re, hc_im, c_re[dr], c_im[dr])

    def glu(y):
        y = jax.nn.gelu(y.reshape(y.shape[0], y.shape[1], S5_WIDTH), approximate=False).astype(dtype)
        return y * jax.nn.sigmoid(y @ w_glu)

    return glu(y_x), (glu(y_c) if with_ctx else None)


def grid_short_conv(x, w, rows, cols):
    bn, length, ch = x.shape
    y = lax.conv_general_dilated(
        x.reshape(bn, rows, cols, ch), w.reshape(CONV_K, CONV_K, 1, ch).astype(x.dtype),
        window_strides=(1, 1), padding='SAME',
        dimension_numbers=('NHWC', 'HWIO', 'NHWC'), feature_group_count=ch)
    return y.reshape(bn, length, ch)


def gdn_prepare(qkv, a, b, rows, cols, conv_w, a_log, dt_bias):
    bn, length, _ = qkv.shape
    qkv = jax.nn.silu(grid_short_conv(qkv, conv_w, rows, cols))
    q, k, v = jnp.split(qkv, 3, axis=-1)

    def heads(t):
        return t.reshape(bn, length, GDN_HEADS, GDN_HEAD_DIM).transpose(0, 2, 1, 3)

    q = l2_normalize(heads(q)) * (GDN_HEAD_DIM ** -0.5)
    k = l2_normalize(heads(k))
    v = heads(v).astype(jnp.float32)
    a = a.astype(jnp.float32).reshape(bn, length, N_DIRS, GDN_HEADS)
    b = b.astype(jnp.float32).reshape(bn, length, N_DIRS, GDN_HEADS)
    g = -jnp.exp(a_log.astype(jnp.float32)) * jax.nn.softplus(a + dt_bias.astype(jnp.float32))
    beta = jax.nn.sigmoid(b)
    return q, k, v, g.transpose(2, 0, 3, 1), beta.transpose(2, 0, 3, 1)


def gated_delta_chunked(q, k, v, g, beta, s0):
    bn, nh, length, dk = q.shape
    dv = v.shape[-1]
    cs = GDN_CHUNK
    nc = length // cs
    q = q.reshape(bn, nh, nc, cs, dk)
    k = k.reshape(bn, nh, nc, cs, dk)
    v = v.reshape(bn, nh, nc, cs, dv)
    g = jnp.cumsum(g.reshape(bn, nh, nc, cs), axis=-1)
    beta = beta.reshape(bn, nh, nc, cs)
    incl = jnp.tril(jnp.ones((cs, cs), bool))
    strict = jnp.tril(jnp.ones((cs, cs), bool), -1)
    diff = g[..., :, None] - g[..., None, :]
    decay = jnp.where(incl, jnp.exp(jnp.where(incl, diff, 0.0)), 0.0)
    kb = k * beta[..., None]
    lmat = jnp.where(strict, jnp.einsum('bhncd,bhnsd->bhncs', kb, k) * decay, 0.0)
    eye = jnp.eye(cs, dtype=jnp.float32)
    tmat = lax.linalg.triangular_solve(eye + lmat, jnp.broadcast_to(eye, lmat.shape),
                                       left_side=True, lower=True, unit_diagonal=True)
    u = jnp.einsum('bhncs,bhnsd->bhncd', tmat, v * beta[..., None])
    w = jnp.einsum('bhncs,bhnsd->bhncd', tmat, kb * jnp.exp(g)[..., None])
    attn = jnp.where(incl, jnp.einsum('bhncd,bhnsd->bhncs', q, k) * decay, 0.0)
    q_dec = q * jnp.exp(g)[..., None]
    k_dec = k * jnp.exp(g[..., -1:] - g)[..., None]
    g_tot = jnp.exp(g[..., -1])
    xs = tuple(jnp.moveaxis(t, 2, 0) for t in (w, u, q_dec, attn, k_dec, g_tot))

    def step(s, inp):
        w_i, u_i, q_i, a_i, k_i, gt_i = inp
        v_new = u_i - jnp.einsum('bhck,bhkv->bhcv', w_i, s)
        o_i = jnp.einsum('bhck,bhkv->bhcv', q_i, s) + jnp.einsum('bhcs,bhsv->bhcv', a_i, v_new)
        s = s * gt_i[..., None, None] + jnp.einsum('bhck,bhcv->bhkv', k_i, v_new)
        return s, o_i

    s_fin, o = lax.scan(step, s0, xs)
    return jnp.moveaxis(o, 0, 2).reshape(bn, nh, length, dv), s_fin


def gdn_mixer(qkv_x, z_x, a_x, b_x, qkv_c, z_c, a_c, b_c, rows, conv_w, a_log, dt_bias, norm_g, with_ctx):
    qx, kx, vx, gx, bx = gdn_prepare(qkv_x, a_x, b_x, rows, GRID_W, conv_w, a_log, dt_bias)
    qc, kc, vc, gc, bc = gdn_prepare(qkv_c, a_c, b_c, 1, qkv_c.shape[1], conv_w, a_log, dt_bias)
    zero = jnp.zeros((qx.shape[0], GDN_HEADS, GDN_HEAD_DIM, GDN_HEAD_DIM), jnp.float32)
    o_x = jnp.zeros_like(vx)
    o_c = jnp.zeros_like(vc)
    for dr in range(N_DIRS):
        if dr == 1:
            flip = lambda t: jnp.flip(t, axis=2)
        else:
            flip = lambda t: t
        oc, sc = gated_delta_chunked(flip(qc), flip(kc), flip(vc), flip(gc[dr]), flip(bc[dr]), zero)
        ox, _ = gated_delta_chunked(flip(qx), flip(kx), flip(vx), flip(gx[dr]), flip(bx[dr]), sc)
        o_x = o_x + flip(ox)
        o_c = o_c + flip(oc)

    def out(o, z):
        bn, nh, length, dv = o.shape
        o = rms_norm(o.transpose(0, 2, 1, 3), norm_g)
        gate = jax.nn.silu(z.astype(jnp.float32)).reshape(bn, length, nh, dv)
        return (o * gate).reshape(bn, length, GDN_WIDTH).astype(z.dtype)

    return out(o_x, z_x), (out(o_c, z_c) if with_ctx else None)


def peer_ffn(h, w_q, sub_keys, expert_u, expert_v):
    bn, length, d = h.shape
    nt = bn * length
    t = h.reshape(nt, d)
    q = (t @ w_q).astype(jnp.float32).reshape(nt, PEER_HEADS, 2, PEER_HALF)
    s = jnp.einsum('thpk,hpnk->thpn', q, sub_keys.astype(jnp.float32))
    s1, i1 = lax.top_k(s[:, :, 0], PEER_TOPK)
    s2, i2 = lax.top_k(s[:, :, 1], PEER_TOPK)
    n_cand = PEER_TOPK * PEER_TOPK
    cand_s = (s1[..., :, None] + s2[..., None, :]).reshape(nt, PEER_HEADS, n_cand)
    cand_i = (i1[..., :, None] * PEER_N_KEYS + i2[..., None, :]).reshape(nt, PEER_HEADS, n_cand)
    top_s, pos = lax.top_k(cand_s, PEER_TOPK)
    idx = jnp.take_along_axis(cand_i, pos, axis=-1)
    gate = jax.nn.softmax(top_s, axis=-1).astype(h.dtype)
    kk = PEER_HEADS * PEER_TOPK
    nb = nt // PEER_BLOCK

    def block(args):
        tb, ib, gb = args
        act = jax.nn.gelu(jnp.einsum('tkd,td->tk', expert_u[ib], tb), approximate=False) * gb
        return jnp.einsum('tk,tkd->td', act, expert_v[ib])

    out = lax.map(block, (t.reshape(nb, PEER_BLOCK, d), idx.reshape(nb, PEER_BLOCK, kk),
                          gate.reshape(nb, PEER_BLOCK, kk)))
    return out.reshape(bn, length, d)


def setup_inputs(seed: int = 0) -> dict:
    key = jax.random.key(seed)
    ks = list(jax.random.split(key, 32))
    f32 = jnp.float32
    D = D_MODEL

    def nrm(k, shape, scale):
        return jax.random.normal(k, shape, f32) * scale

    def gain(k, shape):
        return 1.0 + 0.02 * jax.random.normal(k, shape, f32)

    n_idx = jnp.arange(S5_STATE, dtype=f32)
    s5_shape = (DEPTH, N_DIRS, S5_GROUPS, S5_STATE)
    dt_g = jnp.exp(jax.random.uniform(ks[20], (DEPTH, N_DIRS, GDN_HEADS), f32,
                                      minval=math.log(1e-3), maxval=math.log(1e-1)))
    return {
        "x": jax.random.normal(ks[0], (BATCH, SEQ, D), f32),
        "c": jax.random.normal(ks[1], (BATCH, D), f32),
        "ctx": jax.random.normal(ks[2], (BATCH, CTX_LEN, D), f32),
        "c_ctx": jax.random.normal(ks[3], (D,), f32),
        "w_mod": nrm(ks[4], (DEPTH, D, 6 * D), 0.5 * D ** -0.5),
        "b_mod": nrm(ks[5], (DEPTH, 6 * D), 0.01),
        "g_pre_mix": gain(ks[6], (DEPTH, D)),
        "g_post_mix": gain(ks[7], (DEPTH, D)),
        "g_pre_ffn": gain(ks[8], (DEPTH, D)),
        "g_post_ffn": gain(ks[9], (DEPTH, D)),
        "w_in": nrm(ks[10], (DEPTH, D, PROJ_DIM), D ** -0.5),
        "w_out": nrm(ks[11], (DEPTH, D_MIX, D), D_MIX ** -0.5),
        "s5_lam_re": -0.5 + nrm(ks[12], s5_shape, 0.01),
        "s5_lam_im": math.pi * n_idx + nrm(ks[13], s5_shape, 0.01),
        "s5_log_dt": jax.random.uniform(ks[14], (DEPTH, N_DIRS, S5_GROUPS), f32,
                                        minval=math.log(1e-3), maxval=math.log(1e-1)),
        "s5_b_re": nrm(ks[15], s5_shape + (S5_GROUP,), (2 * S5_GROUP) ** -0.5),
        "s5_b_im": nrm(ks[16], s5_shape + (S5_GROUP,), (2 * S5_GROUP) ** -0.5),
        "s5_c_re": nrm(ks[17], (DEPTH, N_DIRS, S5_GROUPS, S5_GROUP, S5_STATE), (2 * S5_STATE) ** -0.5),
        "s5_c_im": nrm(ks[18], (DEPTH, N_DIRS, S5_GROUPS, S5_GROUP, S5_STATE), (2 * S5_STATE) ** -0.5),
        "s5_d": nrm(ks[19], (DEPTH, S5_WIDTH), 1.0),
        "s5_w_glu": nrm(ks[21], (DEPTH, S5_WIDTH, S5_WIDTH), S5_WIDTH ** -0.5),
        "gdn_conv": nrm(ks[22], (DEPTH, CONV_K, CONV_K, 3 * GDN_WIDTH), 1.0 / CONV_K),
        "gdn_a_log": jnp.log(jax.random.uniform(ks[23], (DEPTH, N_DIRS, GDN_HEADS), f32, minval=1.0, maxval=16.0)),
        "gdn_dt_bias": dt_g + jnp.log(-jnp.expm1(-dt_g)),
        "gdn_norm": gain(ks[24], (DEPTH, GDN_HEAD_DIM)),
        "peer_w_q": nrm(ks[25], (DEPTH, D, PEER_HEADS * PEER_QUERY_DIM), D ** -0.5),
        "peer_keys": nrm(ks[26], (DEPTH, PEER_HEADS, 2, PEER_N_KEYS, PEER_HALF), PEER_HALF ** -0.5),
        "peer_u": nrm(ks[27], (DEPTH, PEER_N_EXPERTS, D), D ** -0.5),
        "peer_v": nrm(ks[28], (DEPTH, PEER_N_EXPERTS, D), PEER_HEADS ** -0.5),
    }


def reference(x, c, ctx, c_ctx, w_mod, b_mod, g_pre_mix, g_post_mix, g_pre_ffn, g_post_ffn,
              w_in, w_out, s5_lam_re, s5_lam_im, s5_log_dt, s5_b_re, s5_b_im, s5_c_re, s5_c_im,
              s5_d, s5_w_glu, gdn_conv, gdn_a_log, gdn_dt_bias, gdn_norm,
              peer_w_q, peer_keys, peer_u, peer_v):
    rows = x.shape[1] // GRID_W
    xc = ctx
    for layer in range(DEPTH):
        with_ctx = layer < DEPTH - 1
        mx = adaln(c, w_mod[layer], b_mod[layer])
        mc = adaln(c_ctx[None], w_mod[layer], b_mod[layer])

        hx = modulate(rms_norm(x, g_pre_mix[layer]), mx[0], mx[1])
        hc = modulate(rms_norm(xc, g_pre_mix[layer]), mc[0], mc[1])
        ux, qkvx, zx, ax, bx = split_proj(hx @ w_in[layer])
        uc, qkvc, zc, ac, bc = split_proj(hc @ w_in[layer])
        s5x, s5c = s5_mixer(ux, uc, s5_lam_re[layer], s5_lam_im[layer], s5_log_dt[layer],
                            s5_b_re[layer], s5_b_im[layer], s5_c_re[layer], s5_c_im[layer],
                            s5_d[layer], s5_w_glu[layer], with_ctx)
        gdx, gdc = gdn_mixer(qkvx, zx, ax, bx, qkvc, zc, ac, bc, rows, gdn_conv[layer],
                             gdn_a_log[layer], gdn_dt_bias[layer], gdn_norm[layer], with_ctx)
        x = x + mx[2] * rms_norm(jnp.concatenate([s5x, gdx], axis=-1) @ w_out[layer], g_post_mix[layer])
        if with_ctx:
            xc = xc + mc[2] * rms_norm(jnp.concatenate([s5c, gdc], axis=-1) @ w_out[layer], g_post_mix[layer])

        hx = modulate(rms_norm(x, g_pre_ffn[layer]), mx[3], mx[4])
        x = x + mx[5] * rms_norm(peer_ffn(hx, peer_w_q[layer], peer_keys[layer], peer_u[layer], peer_v[layer]),
                                 g_post_ffn[layer])
        if with_ctx:
            hc = modulate(rms_norm(xc, g_pre_ffn[layer]), mc[3], mc[4])
            xc = xc + mc[5] * rms_norm(peer_ffn(hc, peer_w_q[layer], peer_keys[layer], peer_u[layer], peer_v[layer]),
                                       g_post_ffn[layer])
    return x
```

```cpp
#include <hip/hip_runtime.h>
#include <hip/hip_cooperative_groups.h>
#include <cstdio>
#include <cstdint>
namespace cg = cooperative_groups;
namespace pg8 {
#define PG8_LAS __attribute__((address_space(3)))
typedef unsigned short bf16_t;
typedef short bf16x8 __attribute__((ext_vector_type(8)));
typedef float f32x4 __attribute__((ext_vector_type(4)));
typedef unsigned u32x4 __attribute__((ext_vector_type(4)));
constexpr int BM = 256, BK = 64, HALF = 128, HTB = HALF * BK * 2  , STAGE_BYTES = 8 * HTB, NXCD = 8, WGM = 8;

__host__ __device__ __forceinline__ int lds_byte(int r, int c) { const int st = (r >> 4) * 2 + (c >> 5), rr = r & 15, cc = c & 31, ob = rr * 64 + cc * 2; return st * 1024 + (ob ^ (((ob >> 9) & 1) << 5)); }
__host__ __device__ __forceinline__ void stage_rc(int b, int& R, int& C) { const int st = b / 1024, sb = b % 1024, swz = sb ^ (((sb >> 9) & 1) << 5); R = (st >> 1) * 16 + swz / 64; C = (st & 1) * 32 + (swz % 64) / 2; }
__host__ __device__ __forceinline__ int perm32(int rho) { const int n = rho >> 4, i = rho & 15; return 8 * (i >> 2) + 4 * n + (i & 3); }

struct Unit { int pm, pn; };
struct Gemm { const bf16_t* A; const bf16_t* Bt; int lda, ldb, K; };

struct StaticOrder {
    int nM, nN, nwg, G, c;
    __host__ __device__ void init(int M, int N, int G_, int c_) { nM = M / BM; nN = N / BM; nwg = nM * nN; G = G_; c = c_; }
    __host__ __device__ bool next(int i, Unit& u) const {
        const long L = (long)i * G + c; if (L >= nwg) return false;
        int wgid = (int)L; { const int q = nwg / NXCD, r = nwg % NXCD, xcd = wgid % NXCD, off = wgid / NXCD; wgid = (xcd < r ? xcd * (q + 1) : r * (q + 1) + (xcd - r) * q) + off; }
        const int nig = WGM * nN, gid = wgid / nig, fm = gid * WGM, gsz = (nM - fm) < WGM ? (nM - fm) : WGM;
        u.pm = fm + ((wgid % nig) % gsz); u.pn = (wgid % nig) / gsz; return true;
    }
    __device__ __forceinline__ void a_ready(const Unit&) const {}
    __device__ __forceinline__ void done(const Unit&) const {}
};

__device__ __forceinline__ unsigned cvt_pk_bf16(float lo, float hi) { unsigned r; asm volatile("v_cvt_pk_bf16_f32 %0, %1, %2" : "=v"(r) : "v"(lo), "v"(hi)); return r; }
typedef float f32x2 __attribute__((ext_vector_type(2)));
__device__ __forceinline__ f32x2 gelu_pk(f32x2 v) {
    const f32x2 av = __builtin_elementwise_abs(v), d = av * 0.2316418882f + 1.0f;
    f32x2 t; t.x = __builtin_amdgcn_rcpf(d.x); t.y = __builtin_amdgcn_rcpf(d.y);
    f32x2 q = t * 0.5307027145f + (-0.7265760135f); q = q * t + 0.7107068705f; q = q * t + (-0.142248368f); q = q * t + 0.127414796f; q = q * t;
    const f32x2 s = (v * v) * (-0.72134752044f);
    f32x2 e; e.x = __builtin_amdgcn_exp2f(s.x); e.y = __builtin_amdgcn_exp2f(s.y);
    const f32x2 m = v * (q * e), r = v - m;
    f32x2 o; o.x = v.x < 0.f ? m.x : r.x; o.y = v.y < 0.f ? m.y : r.y; return o;
}

template <int ACT  > struct EpiBf16 {
    static constexpr bool PERM = true, AFTER_DRAIN = false; static_assert(ACT == 0 || ACT == 1, "EpiBf16: ACT is 0 (none) or 1 (gelu_pk)");
    bf16_t* O; int ldc; const float* bias; int split_cols; size_t split_stride; float scale0;
    __device__ __forceinline__ void operator()(const f32x4 (&acc)[2][2][4][2], const Unit& u, int wr, int wc, int fr, int fq) const {
        const int row0 = u.pm * BM + wr * 64 + fr; int colt = u.pn * BM; bf16_t* base = O;
        float sc = 1.f; if (split_cols) { const int t = colt / split_cols; base += (size_t)t * split_stride; colt -= t * split_cols; if (t == 0) sc = scale0; }
        const int col0 = colt + wc * 32 + 8 * fq, bcol0 = u.pn * BM + wc * 32 + 8 * fq;
        f32x4 bv[2][2];
#pragma unroll
        for (int bj = 0; bj < 2; ++bj)
#pragma unroll
            for (int n = 0; n < 2; ++n) bv[bj][n] = bias ? *(const f32x4*)(bias + bcol0 + bj * HALF + 4 * n) : (f32x4){0.f, 0.f, 0.f, 0.f};
#pragma unroll
        for (int ai = 0; ai < 2; ++ai)
#pragma unroll
            for (int m = 0; m < 4; ++m) { bf16_t* rowp = base + (size_t)(row0 + ai * HALF + m * 16) * ldc + col0;
#pragma unroll
                for (int bj = 0; bj < 2; ++bj) { f32x4 v0 = acc[ai][bj][m][0] + bv[bj][0], v1 = acc[ai][bj][m][1] + bv[bj][1];
                    if (ACT == 1) { f32x2 a = gelu_pk((f32x2){v0[0], v0[1]}), b = gelu_pk((f32x2){v0[2], v0[3]}), c = gelu_pk((f32x2){v1[0], v1[1]}), d = gelu_pk((f32x2){v1[2], v1[3]});
                        v0 = (f32x4){a.x, a.y, b.x, b.y}; v1 = (f32x4){c.x, c.y, d.x, d.y}; }
                    v0 = v0 * sc; v1 = v1 * sc; u32x4 w; w.x = cvt_pk_bf16(v0[0], v0[1]); w.y = cvt_pk_bf16(v0[2], v0[3]); w.z = cvt_pk_bf16(v1[0], v1[1]); w.w = cvt_pk_bf16(v1[2], v1[3]);
                    *(u32x4*)(rowp + bj * HALF) = w; } }
    }
};

template <class Epi, class Sched, bool ALIGN_EPI = false, bool SP2 = false>
__device__ __forceinline__ void gemm_phase(PG8_LAS unsigned char* lds, const Gemm g, const Sched& S, const Epi& E) {
    const int tid = threadIdx.x, wid = __builtin_amdgcn_readfirstlane(tid >> 6), lane = tid & 63, wr = wid >> 2, wc = wid & 3, fr = lane & 15, fq = lane >> 4;
    const int K = g.K, nt = K / BK;
    unsigned voffA[2], voffB[2];
#pragma unroll
    for (int i = 0; i < 2; ++i) { int R, C; stage_rc(tid * 16 + i * 8192, R, C); const int Rb = Epi::PERM ? ((R & ~31) + perm32(R & 31)) : R;
        voffA[i] = (unsigned)(R * g.lda + C) * 2u; voffB[i] = (unsigned)(Rb * g.ldb + C) * 2u; }
    const size_t kstep = (size_t)(BK * 2);
    const size_t hstepA = (size_t)HALF * g.lda * 2, hstepB = (size_t)HALF * g.ldb * 2;
    const size_t tstepA = 2 * hstepA, tstepB = 2 * hstepB;
    const unsigned ldsw = (unsigned)wid * 1024u;
    const int aoff = lds_byte(wr * 64 + fr, fq * 8), boff = lds_byte(wc * 32 + fr, fq * 8);
#define PG8_SA(b, h) (((b) * 2 + (h)) * HTB)
#define PG8_SB(b, h) ((4 + (b) * 2 + (h)) * HTB)
#define PG8_STAGE(bufoff, gbase, voff) do { _Pragma("unroll") for (int _i = 0; _i < 2; ++_i) \
        __builtin_amdgcn_global_load_lds((const unsigned*)((const char*)(gbase) + (voff)[_i]), (PG8_LAS unsigned*)(lds + (bufoff) + ldsw + _i * 8192), 16, 0, 0); } while (0)
#define PG8_LDA(dst, b, h) do { _Pragma("unroll") for (int m = 0; m < 4; ++m) _Pragma("unroll") for (int k = 0; k < 2; ++k) dst[m][k] = *(const PG8_LAS bf16x8*)(lds + PG8_SA(b, h) + aoff + m * 2048 + k * 1024); } while (0)
#define PG8_LDB(dst, b, h) do { _Pragma("unroll") for (int n = 0; n < 2; ++n) _Pragma("unroll") for (int k = 0; k < 2; ++k) dst[n][k] = *(const PG8_LAS bf16x8*)(lds + PG8_SB(b, h) + boff + n * 2048 + k * 1024); } while (0)
#define PG8_MMA(ai, bj, At, Bt) do { __builtin_amdgcn_s_setprio(1); _Pragma("unroll") for (int m = 0; m < 4; ++m) _Pragma("unroll") for (int n = 0; n < 2; ++n) _Pragma("unroll") for (int k = 0; k < 2; ++k) \
        acc[ai][bj][m][n] = __builtin_amdgcn_mfma_f32_16x16x32_bf16(Bt[n][k], At[m][k], acc[ai][bj][m][n], 0, 0, 0); __builtin_amdgcn_s_setprio(0); } while (0)
#define PG8_WAIT_V(n) asm volatile("s_waitcnt vmcnt(" #n ")" ::: "memory")
#define PG8_WAIT_L(n) asm volatile("s_waitcnt lgkmcnt(" #n ")" ::: "memory")
#define PG8_BAR __builtin_amdgcn_s_barrier()
#define PG8_SCHED __builtin_amdgcn_sched_barrier(0)
    Unit cur, nxt; int ui = 0;
    if (!S.next(0, cur)) return;
    f32x4 acc[2][2][4][2];
#pragma unroll
    for (int a = 0; a < 2; ++a)
#pragma unroll
        for (int b = 0; b < 2; ++b)
#pragma unroll
            for (int m = 0; m < 4; ++m)
#pragma unroll
                for (int n = 0; n < 2; ++n) acc[a][b][m][n] = (f32x4){0.f, 0.f, 0.f, 0.f};
    bf16x8 At[4][2], B0[2][2], B1[2][2];
    const char* cA = (const char*)g.A + (size_t)cur.pm * tstepA; const char* cB = (const char*)g.Bt + (size_t)cur.pn * tstepB;
    S.a_ready(cur);
    if constexpr (SP2) {
        PG8_STAGE(PG8_SB(0, 0), cB, voffB); PG8_STAGE(PG8_SB(0, 1), cB + hstepB, voffB); PG8_STAGE(PG8_SA(0, 0), cA, voffA); PG8_STAGE(PG8_SA(0, 1), cA + hstepA, voffA);
        if (wr == 1) PG8_BAR;
        PG8_WAIT_V(2); PG8_BAR;
        PG8_STAGE(PG8_SB(1, 0), cB + kstep, voffB); PG8_STAGE(PG8_SA(1, 0), cA + kstep, voffA); PG8_STAGE(PG8_SB(1, 1), cB + hstepB + kstep, voffB);
        PG8_WAIT_V(6); PG8_BAR;
    } else {
        PG8_STAGE(PG8_SB(0, 0), cB, voffB); PG8_STAGE(PG8_SA(0, 0), cA, voffA); PG8_STAGE(PG8_SB(0, 1), cB + hstepB, voffB); PG8_STAGE(PG8_SA(0, 1), cA + hstepA, voffA);
        if (wr == 1) PG8_BAR;
        PG8_WAIT_V(4); PG8_BAR;
        PG8_STAGE(PG8_SB(1, 0), cB + kstep, voffB); PG8_STAGE(PG8_SA(1, 0), cA + kstep, voffA); PG8_STAGE(PG8_SB(1, 1), cB + hstepB + kstep, voffB);
        PG8_WAIT_V(6); PG8_BAR;
    }
    for (;;) {
        const bool has_next = S.next(ui + 1, nxt);
        const char* nA = has_next ? (const char*)g.A + (size_t)nxt.pm * tstepA : cA; const char* nB = has_next ? (const char*)g.Bt + (size_t)nxt.pn * tstepB : cB;
        for (int t = 0; t < nt; t += 2) {
            const bool last = (t == nt - 2);
            const char* a1 = cA + (size_t)(t + 1) * kstep;
            const char* a2 = last ? nA : cA + (size_t)(t + 2) * kstep; const char* b2 = last ? nB : cB + (size_t)(t + 2) * kstep;
            const char* a3 = a2 + kstep; const char* b3 = b2 + kstep;
            if (last && has_next) S.a_ready(nxt);
            if constexpr (SP2) {
            PG8_LDB(B0, 0, 0); PG8_LDB(B1, 0, 1); PG8_SCHED; PG8_LDA(At, 0, 0); PG8_STAGE(PG8_SA(1, 1), a1 + hstepA, voffA);
            PG8_WAIT_V(8); PG8_WAIT_L(0); PG8_BAR; PG8_MMA(0, 0, At, B0); PG8_MMA(0, 1, At, B1); PG8_BAR; PG8_SCHED;
            PG8_LDA(At, 0, 1); PG8_STAGE(PG8_SB(0, 0), b2, voffB); PG8_STAGE(PG8_SB(0, 1), b2 + hstepB, voffB); PG8_STAGE(PG8_SA(0, 0), a2, voffA);
            PG8_WAIT_V(8); PG8_WAIT_L(0); PG8_BAR; PG8_MMA(1, 0, At, B0); PG8_MMA(1, 1, At, B1); PG8_BAR; PG8_SCHED;
            PG8_LDB(B0, 1, 0); PG8_LDB(B1, 1, 1); PG8_SCHED; PG8_LDA(At, 1, 0); PG8_STAGE(PG8_SA(0, 1), a2 + hstepA, voffA);
            PG8_WAIT_V(8); PG8_WAIT_L(0); PG8_BAR; PG8_MMA(0, 0, At, B0); PG8_MMA(0, 1, At, B1); PG8_BAR; PG8_SCHED;
            PG8_LDA(At, 1, 1); PG8_STAGE(PG8_SB(1, 0), b3, voffB); PG8_STAGE(PG8_SB(1, 1), b3 + hstepB, voffB); PG8_STAGE(PG8_SA(1, 0), a3, voffA);
            PG8_WAIT_V(8); PG8_WAIT_L(0); PG8_BAR; PG8_MMA(1, 0, At, B0); PG8_MMA(1, 1, At, B1); PG8_BAR; PG8_SCHED;
            } else {
            PG8_LDB(B0, 0, 0); PG8_SCHED; PG8_LDA(At, 0, 0); PG8_STAGE(PG8_SA(1, 1), a1 + hstepA, voffA);
            PG8_WAIT_L(8); PG8_BAR; PG8_WAIT_L(0); PG8_MMA(0, 0, At, B0); PG8_BAR; PG8_SCHED;
            PG8_LDB(B1, 0, 1); PG8_STAGE(PG8_SB(0, 0), b2, voffB);
            PG8_BAR; PG8_WAIT_L(0); PG8_MMA(0, 1, At, B1); PG8_BAR;
            PG8_LDA(At, 0, 1); PG8_STAGE(PG8_SA(0, 0), a2, voffA);
            PG8_BAR; PG8_WAIT_L(0); PG8_MMA(1, 0, At, B0); PG8_BAR; PG8_SCHED;
            PG8_STAGE(PG8_SB(0, 1), b2 + hstepB, voffB);
            PG8_WAIT_V(6); PG8_BAR; PG8_MMA(1, 1, At, B1); PG8_BAR;
            PG8_LDB(B0, 1, 0); PG8_SCHED; PG8_LDA(At, 1, 0); PG8_STAGE(PG8_SA(0, 1), a2 + hstepA, voffA);
            PG8_WAIT_L(8); PG8_BAR; PG8_WAIT_L(0); PG8_MMA(0, 0, At, B0); PG8_BAR; PG8_SCHED;
            PG8_LDB(B1, 1, 1); PG8_STAGE(PG8_SB(1, 0), b3, voffB);
            PG8_BAR; PG8_WAIT_L(0); PG8_MMA(0, 1, At, B1); PG8_BAR;
            PG8_LDA(At, 1, 1); PG8_STAGE(PG8_SA(1, 0), a3, voffA);
            PG8_BAR; PG8_WAIT_L(0); PG8_MMA(1, 0, At, B0); PG8_BAR; PG8_SCHED;
            PG8_STAGE(PG8_SB(1, 1), b3 + hstepB, voffB);
            PG8_WAIT_V(6); PG8_BAR; PG8_MMA(1, 1, At, B1); PG8_BAR;
            }
        }
        if constexpr (ALIGN_EPI) { if (wr == 0) PG8_BAR; }
        if constexpr (!Epi::AFTER_DRAIN) { E(acc, cur, wr, wc, fr, fq); S.done(cur); }
        if (!has_next) break;
#pragma unroll
        for (int a = 0; a < 2; ++a)
#pragma unroll
            for (int b = 0; b < 2; ++b)
#pragma unroll
                for (int m = 0; m < 4; ++m)
#pragma unroll
                    for (int n = 0; n < 2; ++n) acc[a][b][m][n] = (f32x4){0.f, 0.f, 0.f, 0.f};
        cur = nxt; cA = nA; cB = nB; ++ui;
        if constexpr (ALIGN_EPI) { if (wr == 1) PG8_BAR; }
    }
    PG8_WAIT_V(0);
    if constexpr (!ALIGN_EPI) { if (wr == 0) PG8_BAR; }
    PG8_BAR;
    if constexpr (Epi::AFTER_DRAIN) { E.fused(acc, cur, wr, wc, fr, fq, lds, wid, lane); S.done(cur); }
#undef PG8_SA
#undef PG8_SB
#undef PG8_STAGE
#undef PG8_LDA
#undef PG8_LDB
#undef PG8_MMA
#undef PG8_WAIT_V
#undef PG8_WAIT_L
#undef PG8_BAR
#undef PG8_SCHED
}
}

#ifndef MK_ONE_LAUNCH
#define MK_ONE_LAUNCH 0
#endif
#define LAS __attribute__((address_space(3)))
typedef unsigned short bf16;
typedef unsigned v4u __attribute__((ext_vector_type(4)));
typedef unsigned v2u __attribute__((ext_vector_type(2)));
typedef float f32x4 __attribute__((ext_vector_type(4)));
typedef float f32x2 __attribute__((ext_vector_type(2)));

constexpr int D = 1024, NB = 8, SEQ = 2048, LC = 256, ML = NB * SEQ  , MC = NB * LC  , MT = ML + MC  ;
constexpr int PROJ = 2576, NPROJ = 2560;
constexpr int NEXP = 16384, TOPK = 16, KK = 128;
constexpr float EPS = 1e-6f;
constexpr int NTHREADS = 512, NWAVES = 8;
constexpr int LDS_BYTES = 147456;
constexpr int NPHASES = 12;

constexpr size_t MiB = 1u << 20;
constexpr size_t WS_CTL = 0;
constexpr size_t WS_MOD = 1 * MiB;
constexpr size_t WS_WIN = 2 * MiB;
constexpr size_t WS_WOUT = 8 * MiB;
constexpr size_t WS_WGLU = 10 * MiB;
constexpr size_t WS_WQ = 11 * MiB;
constexpr size_t WS_GB = 15 * MiB;
constexpr size_t WS_IDX = 17 * MiB;
constexpr size_t WS_GATE = 26 * MiB;
constexpr size_t WS_HX = 35 * MiB;
constexpr size_t WS_U = 72 * MiB;
constexpr size_t WS_YRAW = 35 * MiB;
constexpr size_t WS_Z = 100 * MiB;
constexpr size_t WS_QKVPRE = 116 * MiB;
constexpr size_t WS_OG = 116 * MiB;
constexpr size_t WS_HX2 = 116 * MiB;
constexpr size_t WS_QKV = 170 * MiB;
constexpr size_t WS_CAT = 170 * MiB;
constexpr size_t WS_YG = 202 * MiB;
constexpr size_t WS_QP = 170 * MiB;
constexpr size_t WS_YS5 = 224 * MiB;
constexpr size_t WS_END = 256 * MiB;
static_assert(WS_YRAW + (size_t)ML * D * 4 <= WS_Z && WS_Z + (size_t)ML * 512 * 2 <= WS_QKVPRE && WS_QKVPRE + (size_t)MT * 1536 * 2 <= WS_QKV && WS_QKV + (size_t)MT * 1536 * 2 <= WS_YS5, "ws map");
static_assert(WS_QP + (size_t)ML * 2048 * 2 <= WS_END && WS_YS5 + (size_t)2 * ML * 512 * 2 <= WS_END && WS_YG + (size_t)ML * 512 * 2 <= WS_YS5 && WS_U + (size_t)MT * 512 * 2 <= WS_Z, "ws map 2");
static_assert(WS_GATE + (size_t)ML * 128 * 4 <= WS_HX && WS_IDX + (size_t)ML * 128 * 4 <= WS_GATE && WS_HX + (size_t)MT * D * 2 <= WS_U, "ws map 3");

__device__ __forceinline__ unsigned f2bf(float f) { unsigned u = __builtin_bit_cast(unsigned, f); return (u + 0x7fffu + ((u >> 16) & 1u)) >> 16; }
__device__ __forceinline__ unsigned pk2(float lo, float hi) { return f2bf(lo) | (f2bf(hi) << 16); }
__device__ __forceinline__ float bflo(unsigned w) { return __builtin_bit_cast(float, w << 16); }
__device__ __forceinline__ float bfhi(unsigned w) { return __builtin_bit_cast(float, w & 0xffff0000u); }
__device__ __forceinline__ float bf1(bf16 h) { return __builtin_bit_cast(float, (unsigned)h << 16); }
__device__ __forceinline__ float wave_sum(float v) {
#pragma unroll
    for (int o = 1; o < 64; o <<= 1) v += __shfl_xor(v, o);
    return v;
}
__device__ __forceinline__ float wave_max(float v) {
#pragma unroll
    for (int o = 1; o < 64; o <<= 1) v = fmaxf(v, __shfl_xor(v, o));
    return v;
}
__device__ __forceinline__ float sigmoidf_(float x) { return 1.f / (1.f + __expf(-x)); }
__device__ __forceinline__ float siluf_(float x) { return x / (1.f + __expf(-x)); }
__device__ __forceinline__ float gelu_erf(float x) { return 0.5f * x * (1.f + erff(x * 0.70710678118654752f)); }
__device__ __forceinline__ void sincos_d(double a, float& s, float& c) {
    const double k = rint(a * 0.63661977236758134308);
    const double r = fma(-k, 1.57079632679489661923, a) - k * 6.123233995736766e-17;
    const double r2 = r * r;
    double sp = -2.5052108385441720e-08; sp = sp * r2 + 2.7557319223985893e-06; sp = sp * r2 - 1.9841269841269841e-04; sp = sp * r2 + 8.3333333333333332e-03; sp = sp * r2 - 1.6666666666666666e-01;
    const double sn = r + r * r2 * sp;
    double cp = 2.0876756987868099e-09; cp = cp * r2 - 2.7557319223985888e-07; cp = cp * r2 + 2.4801587301587302e-05; cp = cp * r2 - 1.3888888888888889e-03; cp = cp * r2 + 4.1666666666666664e-02; cp = cp * r2 - 0.5;
    const double cs = 1.0 + r2 * cp;
    const int q = ((int)k) & 3;
    const double ss = (q == 0) ? sn : (q == 1) ? cs : (q == 2) ? -sn : -cs;
    const double cc = (q == 0) ? cs : (q == 1) ? -sn : (q == 2) ? -cs : sn;
    s = (float)ss; c = (float)cc;
}

struct Args { const float* in[29]; float* out; unsigned char* ws; int ph_lo, ph_hi; };
static_assert(sizeof(Args) == 29 * 8 + 8 + 8 + 8, "Args has no padding");
enum { I_X = 0, I_C, I_CTX, I_CCTX, I_WMOD, I_BMOD, I_GPREMIX, I_GPOSTMIX, I_GPREFFN, I_GPOSTFFN, I_WIN, I_WOUT, I_LAMRE, I_LAMIM, I_LOGDT, I_BRE, I_BIM, I_CRE, I_CIM, I_S5D, I_WGLU,
       I_CONV, I_ALOG, I_DTBIAS, I_GDNNORM, I_WQ, I_KEYS, I_PU, I_PV };

__device__ __forceinline__ const float* in_row(const Args& a, int row) { return row < ML ? a.in[I_X] + (size_t)row * D : a.in[I_CTX] + (size_t)(row - ML) * D; }
__device__ __forceinline__ int mod_row(int row) { return row < ML ? (row >> 11) : 8; }

namespace pg8 {
struct EpiInProj {
    static constexpr bool PERM = true, AFTER_DRAIN = false;
    bf16_t* U; bf16_t* QKV; bf16_t* Z;
    __device__ __forceinline__ void operator()(const f32x4 (&acc)[2][2][4][2], const Unit& u, int wr, int wc, int fr, int fq) const {
        bf16_t* base; int ld, colt; bool lat_only = false;
        if (u.pn < 2) { base = U; ld = 512; colt = u.pn * BM; }
        else if (u.pn < 8) { base = QKV; ld = 1536; colt = (u.pn - 2) * BM; }
        else { base = Z; ld = 512; colt = (u.pn - 8) * BM; lat_only = true; }
        const int row0 = u.pm * BM + wr * 64 + fr, col0 = colt + wc * 32 + 8 * fq;
#pragma unroll
        for (int ai = 0; ai < 2; ++ai)
#pragma unroll
            for (int m = 0; m < 4; ++m) { const int row = row0 + ai * HALF + m * 16; bf16_t* rowp = base + (size_t)row * ld + col0;
                if (lat_only && row >= 16384) continue;
#pragma unroll
                for (int bj = 0; bj < 2; ++bj) { const f32x4 v0 = acc[ai][bj][m][0], v1 = acc[ai][bj][m][1];
                    u32x4 w; w.x = cvt_pk_bf16(v0[0], v0[1]); w.y = cvt_pk_bf16(v0[2], v0[3]); w.z = cvt_pk_bf16(v1[0], v1[1]); w.w = cvt_pk_bf16(v1[2], v1[3]);
                    *(u32x4*)(rowp + bj * HALF) = w; } }
    }
};
struct EpiGlu {
    static constexpr bool PERM = true, AFTER_DRAIN = false;
    const bf16_t* YG; bf16_t* CAT;
    __device__ __forceinline__ void operator()(const f32x4 (&acc)[2][2][4][2], const Unit& u, int wr, int wc, int fr, int fq) const {
        const int row0 = u.pm * BM + wr * 64 + fr, col0 = u.pn * BM + wc * 32 + 8 * fq;
#pragma unroll
        for (int ai = 0; ai < 2; ++ai)
#pragma unroll
            for (int m = 0; m < 4; ++m) { const int row = row0 + ai * HALF + m * 16;
#pragma unroll
                for (int bj = 0; bj < 2; ++bj) { const f32x4 v0 = acc[ai][bj][m][0], v1 = acc[ai][bj][m][1];
                    const u32x4 y = *(const u32x4*)(YG + (size_t)row * 512 + col0 + bj * HALF);
                    float o[8]; const float a[8] = {v0[0], v0[1], v0[2], v0[3], v1[0], v1[1], v1[2], v1[3]};
                    const unsigned yw[4] = {y.x, y.y, y.z, y.w};
#pragma unroll
                    for (int e = 0; e < 8; ++e) { const float yv = __builtin_bit_cast(float, (e & 1) ? (yw[e >> 1] & 0xffff0000u) : (yw[e >> 1] << 16)); o[e] = yv / (1.f + __expf(-a[e])); }
                    u32x4 w; w.x = cvt_pk_bf16(o[0], o[1]); w.y = cvt_pk_bf16(o[2], o[3]); w.z = cvt_pk_bf16(o[4], o[5]); w.w = cvt_pk_bf16(o[6], o[7]);
                    *(u32x4*)(CAT + (size_t)row * 1024 + col0 + bj * HALF) = w; } }
    }
};
struct EpiF32 {
    static constexpr bool PERM = false, AFTER_DRAIN = false;
    float* C; int ldc;
    __device__ __forceinline__ void operator()(const f32x4 (&acc)[2][2][4][2], const Unit& u, int wr, int wc, int fr, int fq) const {
        const int row0 = u.pm * BM + wr * 64 + fr, col0 = u.pn * BM + wc * 32 + 4 * fq;
#pragma unroll
        for (int ai = 0; ai < 2; ++ai)
#pragma unroll
            for (int m = 0; m < 4; ++m) { float* rowp = C + (size_t)(row0 + ai * HALF + m * 16) * ldc + col0;
#pragma unroll
                for (int bj = 0; bj < 2; ++bj)
#pragma unroll
                    for (int n = 0; n < 2; ++n) *(f32x4*)(rowp + bj * HALF + n * 16) = acc[ai][bj][m][n]; }
    }
};
}

struct Ctx { const Args* a; unsigned char* ws; unsigned char* lds; int tid, lane, wave, bid, G, gw, NGW, gwv; };

__device__ __forceinline__ void p0_transpose_item(const float* W, int ldw, int nblk, int K, bf16* WT, float* scr, int item, int lane) {
    const int kb = item / nblk, nb = item % nblk, k0 = 64 * kb, n0 = 32 * nb;
#pragma unroll 8
    for (int i = 0; i < 32; ++i) { const int kk = 2 * i + (lane >> 5); scr[kk * 33 + (lane & 31)] = W[(size_t)(k0 + kk) * ldw + n0 + (lane & 31)]; }
    __builtin_amdgcn_fence(__ATOMIC_RELEASE, "wavefront"); __builtin_amdgcn_wave_barrier(); __builtin_amdgcn_fence(__ATOMIC_ACQUIRE, "wavefront");
    const int c = lane & 7;
#pragma unroll
    for (int j = 0; j < 4; ++j) { const int n = (lane >> 3) + 8 * j; const float* s = scr + (8 * c) * 33 + n;
        v4u o; o.x = pk2(s[0 * 33], s[1 * 33]); o.y = pk2(s[2 * 33], s[3 * 33]); o.z = pk2(s[4 * 33], s[5 * 33]); o.w = pk2(s[6 * 33], s[7 * 33]);
        *(v4u*)(WT + (size_t)(n0 + n) * K + k0 + 8 * c) = o; }
    __builtin_amdgcn_fence(__ATOMIC_RELEASE, "wavefront"); __builtin_amdgcn_wave_barrier(); __builtin_amdgcn_fence(__ATOMIC_ACQUIRE, "wavefront");
}
__device__ __forceinline__ void phase_prep(const Ctx& c) {
    const Args& a = *c.a;
    float* scr = (float*)(c.lds + c.wave * 16384);
    constexpr int I_IN = 16 * 80, I_OUT = 16 * 32, I_GLU = 8 * 16, I_Q = 16 * 64;
    for (int it = c.gw; it < I_IN + I_OUT + I_GLU + I_Q; it += c.NGW) {
        int r = it;
        if (r < I_IN) { p0_transpose_item(a.in[I_WIN], PROJ, 80, 1024, (bf16*)(c.ws + WS_WIN), scr, r, c.lane); continue; } r -= I_IN;
        if (r < I_OUT) { p0_transpose_item(a.in[I_WOUT], 1024, 32, 1024, (bf16*)(c.ws + WS_WOUT), scr, r, c.lane); continue; } r -= I_OUT;
        if (r < I_GLU) { p0_transpose_item(a.in[I_WGLU], 512, 16, 512, (bf16*)(c.ws + WS_WGLU), scr, r, c.lane); continue; } r -= I_GLU;
        p0_transpose_item(a.in[I_WQ], 2048, 64, 1024, (bf16*)(c.ws + WS_WQ), scr, r, c.lane);
    }
    __syncthreads();
    float* sc = (float*)c.lds;
    float* red = (float*)(c.lds + 9 * 1024 * 4);
    float* MOD = (float*)(c.ws + WS_MOD);
    bool have = false;
    for (int item = c.bid; item < 96; item += c.G) {
        if (!have) { for (int i = c.tid; i < 9 * 1024; i += NTHREADS) { const int r = i >> 10, k = i & 1023; const float v = r < 8 ? a.in[I_C][r * 1024 + k] : a.in[I_CCTX][k]; sc[i] = siluf_(v); } have = true; __syncthreads(); }
        const int n0 = item * 64;
        float acc[9];
#pragma unroll
        for (int r = 0; r < 9; ++r) acc[r] = 0.f;
        const float* wp = a.in[I_WMOD] + (size_t)(c.wave * 128) * 6144 + n0 + c.lane;
#pragma unroll 4
        for (int k = 0; k < 128; ++k) { const float w = wp[(size_t)k * 6144];
#pragma unroll
            for (int r = 0; r < 9; ++r) acc[r] = fmaf(sc[r * 1024 + c.wave * 128 + k], w, acc[r]); }
#pragma unroll
        for (int r = 0; r < 9; ++r) red[(c.wave * 9 + r) * 64 + c.lane] = acc[r];
        __syncthreads();
        for (int i = c.tid; i < 576; i += NTHREADS) { const int r = i >> 6, l = i & 63; float s = a.in[I_BMOD][n0 + l];
#pragma unroll
            for (int w = 0; w < 8; ++w) s += red[(w * 9 + r) * 64 + l];
            MOD[r * 6144 + n0 + l] = s; }
        __syncthreads();
    }
}

__device__ __forceinline__ void phase_norm1(const Ctx& c) {
    const Args& a = *c.a;
    float* wabT = (float*)c.lds;
    for (int i = c.tid; i < 1024 * 16; i += NTHREADS) { const int k = i >> 4, j = i & 15; wabT[j * 1028 + k] = a.in[I_WIN][(size_t)k * PROJ + NPROJ + j]; }
    __syncthreads();
    const float* MOD = (const float*)(c.ws + WS_MOD);
    bf16* HX = (bf16*)(c.ws + WS_HX); float* GB = (float*)(c.ws + WS_GB);
    const float* gpre = a.in[I_GPREMIX];
    for (int row = c.gw; row < MT; row += c.NGW) {
        const f32x4* xr = (const f32x4*)in_row(a, row) + c.lane;
        const float* mr = MOD + mod_row(row) * 6144;
        f32x4 v[4]; float ss = 0.f;
#pragma unroll
        for (int j = 0; j < 4; ++j) { v[j] = xr[64 * j]; ss += (v[j].x * v[j].x + v[j].y * v[j].y) + (v[j].z * v[j].z + v[j].w * v[j].w); }
        const float r = rsqrtf(wave_sum(ss) * (1.f / D) + EPS);
#pragma unroll
        for (int j = 0; j < 4; ++j) { const int col = 4 * c.lane + 256 * j;
            const f32x4 g4 = *(const f32x4*)(gpre + col), sh = *(const f32x4*)(mr + col), scl = *(const f32x4*)(mr + 1024 + col);
            v[j] = (v[j] * r) * g4 * (scl + 1.f) + sh;
            v2u o; o.x = pk2(v[j].x, v[j].y); o.y = pk2(v[j].z, v[j].w);
            *(v2u*)(HX + (size_t)row * D + col) = o; }
        float mine = 0.f;
#pragma unroll 1
        for (int j = 0; j < 16; ++j) { float s = 0.f;
#pragma unroll
            for (int jj = 0; jj < 4; ++jj) { const f32x4 w = *(const f32x4*)(wabT + j * 1028 + 4 * c.lane + 256 * jj); s += (v[jj].x * w.x + v[jj].y * w.y) + (v[jj].z * w.z + v[jj].w * w.w); }
            s = wave_sum(s); mine = (c.lane == j) ? s : mine; }
        if (c.lane < 8) { const float t = mine + a.in[I_DTBIAS][c.lane]; const float sp = t > 20.f ? t : log1pf(expf(t)); GB[(size_t)row * 16 + c.lane] = -expf(a.in[I_ALOG][c.lane]) * sp; }
        else if (c.lane < 16) GB[(size_t)row * 16 + c.lane] = 1.f / (1.f + expf(-mine));
    }
}

__device__ __forceinline__ void phase_conv(const Ctx& c) {
    const Args& a = *c.a;
    const bf16* PRE = (const bf16*)(c.ws + WS_QKVPRE); bf16* OUT = (bf16*)(c.ws + WS_QKV);
    const float* cw = a.in[I_CONV];
    for (int row = c.gw; row < MT; row += c.NGW) {
        int nb_row[9]; bool ok[9];
        if (row < ML) { const int t = row & 2047, gr = t >> 6, gc = t & 63;
#pragma unroll
            for (int dy = -1; dy <= 1; ++dy)
#pragma unroll
                for (int dx = -1; dx <= 1; ++dx) { const int i = (dy + 1) * 3 + dx + 1; ok[i] = (gr + dy >= 0) && (gr + dy < 32) && (gc + dx >= 0) && (gc + dx < 64); nb_row[i] = row + dy * 64 + dx; } }
        else { const int t = (row - ML) & 255;
#pragma unroll
            for (int i = 0; i < 9; ++i) { ok[i] = false; nb_row[i] = row; }
#pragma unroll
            for (int dx = -1; dx <= 1; ++dx) { ok[4 + dx] = (t + dx >= 0) && (t + dx < 256); nb_row[4 + dx] = row + dx; } }
#pragma unroll 2
        for (int seg = 0; seg < 12; ++seg) { const int ch = seg * 128 + 2 * c.lane; float o0 = 0.f, o1 = 0.f;
#pragma unroll
            for (int i = 0; i < 9; ++i) if (ok[i]) { const unsigned w = *(const unsigned*)(PRE + (size_t)nb_row[i] * 1536 + ch); const f32x2 k2 = *(const f32x2*)(cw + i * 1536 + ch);
                o0 = fmaf(bflo(w), k2.x, o0); o1 = fmaf(bfhi(w), k2.y, o1); }
            o0 = siluf_(o0); o1 = siluf_(o1);
            if (seg < 8) { const float ssq = wave_sum(o0 * o0 + o1 * o1); const float sc = rsqrtf(ssq + EPS) * (seg < 4 ? 0.08838834764831845f : 1.f); o0 *= sc; o1 *= sc; }
            *(unsigned*)(OUT + (size_t)row * 1536 + ch) = pk2(o0, o1); }
    }
}

__device__ __forceinline__ int scan_row(int b, int dir, int step) {
    if (step < LC) { const int t = dir ? LC - 1 - step : step; return ML + b * LC + t; }
    const int t = step - LC; return b * SEQ + (dir ? SEQ - 1 - t : t);
}
__device__ __forceinline__ void s5_direct_task(const Ctx& c, int task, float* wl  ) {
    const Args& a = *c.a;
    const int dir = task & 1, g = (task >> 1) & 31, b = task >> 6, p = c.lane, dg = dir * 32 + g;
    const float dt = expf(a.in[I_LOGDT][dg]);
    const float lr = a.in[I_LAMRE][dg * 64 + p], li = a.in[I_LAMIM][dg * 64 + p];
    const float mag = expf(lr * dt); float sn, cs; sincos_d((double)li * (double)dt, sn, cs);
    const float lbr = mag * cs, lbi = mag * sn, den = lr * lr + li * li, nr = lbr - 1.f;
    const float cr = (nr * lr + lbi * li) / den, ci = (lbi * lr - nr * li) / den;
    float bbr[16], bbi[16], cre[16], cim[16];
#pragma unroll
    for (int ch = 0; ch < 16; ++ch) { const float br = a.in[I_BRE][(size_t)(dg * 64 + p) * 16 + ch], bi = a.in[I_BIM][(size_t)(dg * 64 + p) * 16 + ch];
        bbr[ch] = cr * br - ci * bi; bbi[ch] = cr * bi + ci * br;
        cre[ch] = a.in[I_CRE][(size_t)(dg * 16 + ch) * 64 + p]; cim[ch] = a.in[I_CIM][(size_t)(dg * 16 + ch) * 64 + p]; }
    const bf16* U = (const bf16*)(c.ws + WS_U); bf16* YS = (bf16*)(c.ws + WS_YS5) + (size_t)dir * ML * 512;
    float hre = 0.f, him = 0.f;
    v4u n0 = *(const v4u*)(U + (size_t)scan_row(b, dir, 0) * 512 + g * 16), n1 = *(const v4u*)(U + (size_t)scan_row(b, dir, 0) * 512 + g * 16 + 8);
    for (int step = 0; step < LC + SEQ; ++step) {
        const int row = scan_row(b, dir, step);
        const v4u u0 = n0, u1 = n1;
        if (step + 1 < LC + SEQ) { const bf16* np = U + (size_t)scan_row(b, dir, step + 1) * 512 + g * 16; n0 = *(const v4u*)np; n1 = *(const v4u*)(np + 8); }
        const unsigned uw[8] = {u0.x, u0.y, u0.z, u0.w, u1.x, u1.y, u1.z, u1.w};
        float bur = 0.f, bui = 0.f;
#pragma unroll
        for (int ch = 0; ch < 16; ++ch) { const float uv = (ch & 1) ? bfhi(uw[ch >> 1]) : bflo(uw[ch >> 1]); bur = fmaf(bbr[ch], uv, bur); bui = fmaf(bbi[ch], uv, bui); }
        const float nre = lbr * hre - lbi * him + bur, nim = lbr * him + lbi * hre + bui; hre = nre; him = nim;
        if (step >= LC) {
#pragma unroll
            for (int ch = 0; ch < 16; ++ch) wl[ch * 65 + p] = cre[ch] * hre - cim[ch] * him;
            __builtin_amdgcn_fence(__ATOMIC_RELEASE, "wavefront"); __builtin_amdgcn_wave_barrier(); __builtin_amdgcn_fence(__ATOMIC_ACQUIRE, "wavefront");
            const int ch = c.lane >> 2, part = c.lane & 3; float s = 0.f;
#pragma unroll
            for (int i = 0; i < 16; ++i) s += wl[ch * 65 + part * 16 + i];
            s += __shfl_xor(s, 1); s += __shfl_xor(s, 2);
            if (part == 0) YS[(size_t)row * 512 + g * 16 + ch] = (bf16)f2bf(s);
            __builtin_amdgcn_fence(__ATOMIC_RELEASE, "wavefront"); __builtin_amdgcn_wave_barrier(); __builtin_amdgcn_fence(__ATOMIC_ACQUIRE, "wavefront");
        }
    }
}
__device__ __forceinline__ void gdn_direct_task(const Ctx& c, int task, float* wl  ) {
    const int dvq = task & 3, dir = (task >> 2) & 1, h = (task >> 3) & 3, b = task >> 5, half = c.lane >> 5, dv = dvq * 32 + (c.lane & 31);
    const bf16* QKV = (const bf16*)(c.ws + WS_QKV); const float* GB = (const float*)(c.ws + WS_GB);
    bf16* OG = (bf16*)(c.ws + WS_OG) + (size_t)dir * ML * 512;
    float S[64];
#pragma unroll
    for (int i = 0; i < 64; ++i) S[i] = 0.f;
    float* kf = wl; float* qf = wl + 128;
    unsigned nq, nk; bf16 nv; float ng, nbt;
    { const int row = scan_row(b, dir, 0); const bf16* rp = QKV + (size_t)row * 1536 + h * 128; nq = *(const unsigned*)(rp + 2 * c.lane); nk = *(const unsigned*)(rp + 512 + 2 * c.lane); nv = rp[1024 + dv];
      ng = GB[(size_t)row * 16 + dir * 4 + h]; nbt = GB[(size_t)row * 16 + 8 + dir * 4 + h]; }
    for (int step = 0; step < LC + SEQ; ++step) {
        const int row = scan_row(b, dir, step);
        const unsigned qw = nq, kw = nk; const float v = bf1(nv), eg = __expf(ng), beta = nbt;
        if (step + 1 < LC + SEQ) { const int r2 = scan_row(b, dir, step + 1); const bf16* rp = QKV + (size_t)r2 * 1536 + h * 128; nq = *(const unsigned*)(rp + 2 * c.lane); nk = *(const unsigned*)(rp + 512 + 2 * c.lane); nv = rp[1024 + dv];
            ng = GB[(size_t)r2 * 16 + dir * 4 + h]; nbt = GB[(size_t)r2 * 16 + 8 + dir * 4 + h]; }
        *(f32x2*)(kf + 2 * c.lane) = (f32x2){bflo(kw), bfhi(kw)}; *(f32x2*)(qf + 2 * c.lane) = (f32x2){bflo(qw), bfhi(qw)};
        __builtin_amdgcn_fence(__ATOMIC_RELEASE, "wavefront"); __builtin_amdgcn_wave_barrier(); __builtin_amdgcn_fence(__ATOMIC_ACQUIRE, "wavefront");
        const float* kh = kf + 64 * half; const float* qh = qf + 64 * half;
        float ks = 0.f;
#pragma unroll
        for (int i = 0; i < 16; ++i) { const f32x4 k4 = *(const f32x4*)(kh + 4 * i);
            ks = fmaf(S[4 * i], k4.x, ks); ks = fmaf(S[4 * i + 1], k4.y, ks); ks = fmaf(S[4 * i + 2], k4.z, ks); ks = fmaf(S[4 * i + 3], k4.w, ks); }
        ks += __shfl_xor(ks, 32);
        const float vn = beta * (v - eg * ks);
        float o = 0.f;
#pragma unroll
        for (int i = 0; i < 16; ++i) { const f32x4 k4 = *(const f32x4*)(kh + 4 * i), q4 = *(const f32x4*)(qh + 4 * i);
            S[4 * i] = fmaf(S[4 * i], eg, k4.x * vn); S[4 * i + 1] = fmaf(S[4 * i + 1], eg, k4.y * vn); S[4 * i + 2] = fmaf(S[4 * i + 2], eg, k4.z * vn); S[4 * i + 3] = fmaf(S[4 * i + 3], eg, k4.w * vn);
            o = fmaf(S[4 * i], q4.x, o); o = fmaf(S[4 * i + 1], q4.y, o); o = fmaf(S[4 * i + 2], q4.z, o); o = fmaf(S[4 * i + 3], q4.w, o); }
        o += __shfl_xor(o, 32);
        if (step >= LC && half == 0) OG[(size_t)row * 512 + h * 128 + dv] = (bf16)f2bf(o);
        __builtin_amdgcn_fence(__ATOMIC_RELEASE, "wavefront"); __builtin_amdgcn_wave_barrier(); __builtin_amdgcn_fence(__ATOMIC_ACQUIRE, "wavefront");
    }
}
__device__ __forceinline__ void phase_scan_direct(const Ctx& c) {
    float* wl = (float*)(c.lds + c.wave * 8192);
    for (int t = c.gwv; t < 512 + 256; t += c.NGW) { if (t < 512) s5_direct_task(c, t, wl); else gdn_direct_task(c, t - 512, wl); }
}

__device__ __forceinline__ void phase_combine(const Ctx& c) {
    const Args& a = *c.a;
    const bf16* OG0 = (const bf16*)(c.ws + WS_OG); const bf16* OG1 = OG0 + (size_t)ML * 512; const bf16* Z = (const bf16*)(c.ws + WS_Z);
    const bf16* YS0 = (const bf16*)(c.ws + WS_YS5); const bf16* YS1 = YS0 + (size_t)ML * 512; const bf16* U = (const bf16*)(c.ws + WS_U);
    bf16* CAT = (bf16*)(c.ws + WS_CAT); bf16* YG = (bf16*)(c.ws + WS_YG);
    for (int row = c.gw; row < ML; row += c.NGW) {
#pragma unroll
        for (int h = 0; h < 4; ++h) { const int ch = h * 128 + 2 * c.lane;
            const unsigned w0 = *(const unsigned*)(OG0 + (size_t)row * 512 + ch), w1 = *(const unsigned*)(OG1 + (size_t)row * 512 + ch), zw = *(const unsigned*)(Z + (size_t)row * 512 + ch);
            const float o0 = bflo(w0) + bflo(w1), o1 = bfhi(w0) + bfhi(w1);
            const float r = rsqrtf(wave_sum(o0 * o0 + o1 * o1) * (1.f / 128.f) + EPS);
            const f32x2 ng = *(const f32x2*)(a.in[I_GDNNORM] + 2 * c.lane);
            *(unsigned*)(CAT + (size_t)row * 1024 + 512 + ch) = pk2(o0 * r * ng.x * siluf_(bflo(zw)), o1 * r * ng.y * siluf_(bfhi(zw))); }
        { const int ch = 8 * c.lane;
            const v4u uu = *(const v4u*)(U + (size_t)row * 512 + ch), y0 = *(const v4u*)(YS0 + (size_t)row * 512 + ch), y1 = *(const v4u*)(YS1 + (size_t)row * 512 + ch);
            const f32x4 d0 = *(const f32x4*)(a.in[I_S5D] + ch), d1 = *(const f32x4*)(a.in[I_S5D] + ch + 4);
            const unsigned uw[4] = {uu.x, uu.y, uu.z, uu.w}, a0[4] = {y0.x, y0.y, y0.z, y0.w}, a1[4] = {y1.x, y1.y, y1.z, y1.w}; const float dd[8] = {d0.x, d0.y, d0.z, d0.w, d1.x, d1.y, d1.z, d1.w};
            float o[8];
#pragma unroll
            for (int e = 0; e < 8; ++e) { const float uv = (e & 1) ? bfhi(uw[e >> 1]) : bflo(uw[e >> 1]); const float ya = (e & 1) ? bfhi(a0[e >> 1]) : bflo(a0[e >> 1]); const float yb = (e & 1) ? bfhi(a1[e >> 1]) : bflo(a1[e >> 1]);
                o[e] = gelu_erf(uv * dd[e] + ya + yb); }
            v4u w; w.x = pk2(o[0], o[1]); w.y = pk2(o[2], o[3]); w.z = pk2(o[4], o[5]); w.w = pk2(o[6], o[7]);
            *(v4u*)(YG + (size_t)row * 512 + ch) = w; }
    }
}

__device__ __forceinline__ void phase_rows2(const Ctx& c) {
    const Args& a = *c.a;
    const float* MOD = (const float*)(c.ws + WS_MOD); const float* YRAW = (const float*)(c.ws + WS_YRAW); bf16* HX2 = (bf16*)(c.ws + WS_HX2);
    for (int row = c.gw; row < ML; row += c.NGW) {
        const float* mr = MOD + (row >> 11) * 6144;
        f32x4 y[4], x[4]; float ss = 0.f;
#pragma unroll
        for (int j = 0; j < 4; ++j) { y[j] = *((const f32x4*)(YRAW + (size_t)row * D) + c.lane + 64 * j); x[j] = *((const f32x4*)(a.in[I_X] + (size_t)row * D) + c.lane + 64 * j);
            ss += (y[j].x * y[j].x + y[j].y * y[j].y) + (y[j].z * y[j].z + y[j].w * y[j].w); }
        const float r = rsqrtf(wave_sum(ss) * (1.f / D) + EPS); float s2 = 0.f;
#pragma unroll
        for (int j = 0; j < 4; ++j) { const int col = 4 * c.lane + 256 * j;
            const f32x4 g4 = *(const f32x4*)(a.in[I_GPOSTMIX] + col), gt = *(const f32x4*)(mr + 2048 + col);
            x[j] = x[j] + gt * ((y[j] * r) * g4);
            *(f32x4*)(a.out + (size_t)row * D + col) = x[j];
            s2 += (x[j].x * x[j].x + x[j].y * x[j].y) + (x[j].z * x[j].z + x[j].w * x[j].w); }
        const float r2 = rsqrtf(wave_sum(s2) * (1.f / D) + EPS);
#pragma unroll
        for (int j = 0; j < 4; ++j) { const int col = 4 * c.lane + 256 * j;
            const f32x4 g4 = *(const f32x4*)(a.in[I_GPREFFN] + col), sh = *(const f32x4*)(mr + 3072 + col), scl = *(const f32x4*)(mr + 4096 + col);
            const f32x4 hv = (x[j] * r2) * g4 * (scl + 1.f) + sh;
            v2u o; o.x = pk2(hv.x, hv.y); o.y = pk2(hv.z, hv.w);
            *(v2u*)(HX2 + (size_t)row * D + col) = o; }
    }
}

constexpr int KROW = 136;
__device__ __forceinline__ void phase_topk(const Ctx& c) {
    const Args& a = *c.a;
    bf16* kl = (bf16*)c.lds;
    unsigned char* wbase = c.lds + 2 * 128 * KROW * 2 + c.wave * 1024;
    bf16* qs = (bf16*)wbase;
    float* s1 = (float*)(wbase + 512); int* i1 = (int*)(wbase + 576); float* s2 = (float*)(wbase + 640); int* i2 = (int*)(wbase + 704);
    const bf16* QP = (const bf16*)(c.ws + WS_QP); int* IDX = (int*)(c.ws + WS_IDX); float* GATE = (float*)(c.ws + WS_GATE);
    for (int item = c.bid; item < 8 * 32; item += c.G) {
        const int h = item & 7, tr = item >> 3;
        __syncthreads();
        for (int i = c.tid; i < 2 * 128 * 64; i += NTHREADS) { const int k2 = i & 63, n = (i >> 6) & 127, p = i >> 13; const f32x2 kv = *(const f32x2*)(a.in[I_KEYS] + ((size_t)((h * 2 + p) * 128 + n)) * 128 + 2 * k2);
            *(unsigned*)(kl + (p * 128 + n) * KROW + 2 * k2) = pk2(kv.x, kv.y); }
        __syncthreads();
        for (int tt = c.wave; tt < 512; tt += NWAVES) {
            const int tok = tr * 512 + tt;
            *(v2u*)(qs + 4 * c.lane) = *(const v2u*)(QP + (size_t)tok * 2048 + h * 256 + 4 * c.lane);
            __builtin_amdgcn_fence(__ATOMIC_RELEASE, "wavefront"); __builtin_amdgcn_wave_barrier(); __builtin_amdgcn_fence(__ATOMIC_ACQUIRE, "wavefront");
            float sc[2][2];
#pragma unroll
            for (int p = 0; p < 2; ++p) { float sa = 0.f, sb = 0.f;
#pragma unroll
                for (int kk = 0; kk < 16; ++kk) { const v4u q8 = *(const v4u*)(qs + p * 128 + kk * 8), ka = *(const v4u*)(kl + (p * 128 + c.lane) * KROW + kk * 8), kb = *(const v4u*)(kl + (p * 128 + c.lane + 64) * KROW + kk * 8);
                    const unsigned qw[4] = {q8.x, q8.y, q8.z, q8.w}, aw[4] = {ka.x, ka.y, ka.z, ka.w}, bw[4] = {kb.x, kb.y, kb.z, kb.w};
#pragma unroll
                    for (int e = 0; e < 4; ++e) { sa = fmaf(bflo(qw[e]), bflo(aw[e]), sa); sa = fmaf(bfhi(qw[e]), bfhi(aw[e]), sa); sb = fmaf(bflo(qw[e]), bflo(bw[e]), sb); sb = fmaf(bfhi(qw[e]), bfhi(bw[e]), sb); } }
                sc[p][0] = sa; sc[p][1] = sb; }
#pragma unroll
            for (int p = 0; p < 2; ++p) { float va = sc[p][0], vb = sc[p][1]; float* so = p ? s2 : s1; int* io = p ? i2 : i1;
                for (int r = 0; r < 16; ++r) { const float m = fmaxf(va, vb), wm = wave_max(m); const unsigned long long bal = __ballot(m == wm); const int wl = __ffsll((long long)bal) - 1;
                    if (c.lane == wl) { const bool fa = (va == wm); so[r] = wm; io[r] = fa ? c.lane : c.lane + 64; if (fa) va = -INFINITY; else vb = -INFINITY; } } }
            __builtin_amdgcn_fence(__ATOMIC_RELEASE, "wavefront"); __builtin_amdgcn_wave_barrier(); __builtin_amdgcn_fence(__ATOMIC_ACQUIRE, "wavefront");
            const int ci = c.lane >> 2, cj = 4 * (c.lane & 3);
            float cv[4]; const float base = s1[ci];
#pragma unroll
            for (int e = 0; e < 4; ++e) cv[e] = base + s2[cj + e];
            float my_s = 0.f; int my_i = 0;
            for (int r = 0; r < 16; ++r) { const float m = fmaxf(fmaxf(cv[0], cv[1]), fmaxf(cv[2], cv[3])), wm = wave_max(m); const unsigned long long bal = __ballot(m == wm); const int wl = __ffsll((long long)bal) - 1;
                int sel = -1;
                if (c.lane == wl) { sel = (cv[0] == wm) ? 0 : (cv[1] == wm) ? 1 : (cv[2] == wm) ? 2 : 3;
#pragma unroll
                    for (int e = 0; e < 4; ++e) if (e == sel) cv[e] = -INFINITY; }
                const int selw = __shfl(sel, wl); const int eidx = i1[wl >> 2] * 128 + i2[4 * (wl & 3) + selw];
                if (c.lane == r) { my_s = wm; my_i = eidx; } }
            const float mx = __shfl(my_s, 0); const float ex = c.lane < 16 ? __expf(my_s - mx) : 0.f; const float den = wave_sum(ex);
            if (c.lane < 16) { IDX[(size_t)tok * 128 + h * 16 + c.lane] = my_i; GATE[(size_t)tok * 128 + h * 16 + c.lane] = ex / den; }
            __builtin_amdgcn_fence(__ATOMIC_RELEASE, "wavefront"); __builtin_amdgcn_wave_barrier(); __builtin_amdgcn_fence(__ATOMIC_ACQUIRE, "wavefront");
        }
    }
}

__device__ __forceinline__ void phase_experts(const Ctx& c) {
    const Args& a = *c.a;
    const float* MOD = (const float*)(c.ws + WS_MOD); const bf16* HX2 = (const bf16*)(c.ws + WS_HX2); const int* IDX = (const int*)(c.ws + WS_IDX); const float* GATE = (const float*)(c.ws + WS_GATE);
    float* acts = (float*)c.lds; int* eid = (int*)(c.lds + 512); float* red = (float*)(c.lds + 1024);
    for (int tok = c.bid; tok < ML; tok += c.G) {
        float hv[16];
#pragma unroll
        for (int j = 0; j < 4; ++j) { const v2u w = *(const v2u*)(HX2 + (size_t)tok * D + 4 * c.lane + 256 * j); hv[4 * j] = bflo(w.x); hv[4 * j + 1] = bfhi(w.x); hv[4 * j + 2] = bflo(w.y); hv[4 * j + 3] = bfhi(w.y); }
#pragma unroll 4
        for (int i = 0; i < 16; ++i) { const int k = c.wave * 16 + i; const int e = IDX[(size_t)tok * 128 + k];
            const f32x4* ur = (const f32x4*)(a.in[I_PU] + (size_t)e * D) + c.lane; float s = 0.f;
#pragma unroll
            for (int j = 0; j < 4; ++j) { const f32x4 u4 = ur[64 * j]; s += (u4.x * hv[4 * j] + u4.y * hv[4 * j + 1]) + (u4.z * hv[4 * j + 2] + u4.w * hv[4 * j + 3]); }
            s = wave_sum(s);
            if (c.lane == 0) { acts[k] = gelu_erf(s) * GATE[(size_t)tok * 128 + k]; eid[k] = e; } }
        __syncthreads();
        f32x2 acc = (f32x2){0.f, 0.f};
#pragma unroll 8
        for (int k = 0; k < 128; ++k) { const f32x2 v2 = *(const f32x2*)(a.in[I_PV] + (size_t)eid[k] * D + 2 * c.tid); const float ak = acts[k]; acc.x = fmaf(ak, v2.x, acc.x); acc.y = fmaf(ak, v2.y, acc.y); }
        const float ws = wave_sum(acc.x * acc.x + acc.y * acc.y);
        if (c.lane == 0) red[c.wave] = ws;
        __syncthreads();
        float tot = 0.f;
#pragma unroll
        for (int w = 0; w < 8; ++w) tot += red[w];
        const float r = rsqrtf(tot * (1.f / D) + EPS);
        const int col = 2 * c.tid; const float* mr = MOD + (tok >> 11) * 6144 + 5120;
        const f32x2 x1 = *(const f32x2*)(a.out + (size_t)tok * D + col), g2 = *(const f32x2*)(a.in[I_GPOSTFFN] + col), gt = *(const f32x2*)(mr + col);
        *(f32x2*)(a.out + (size_t)tok * D + col) = (f32x2){x1.x + gt.x * (acc.x * r * g2.x), x1.y + gt.y * (acc.y * r * g2.y)};
        __syncthreads();
    }
}

__global__ void __launch_bounds__(NTHREADS, 2) mk_fwd(Args args) {
    extern __shared__ __attribute__((aligned(16))) unsigned char lds[];
    Ctx c; c.a = &args; c.ws = args.ws; c.lds = lds;
    c.tid = threadIdx.x; c.lane = c.tid & 63; c.wave = __builtin_amdgcn_readfirstlane(c.tid >> 6); c.bid = blockIdx.x; c.G = gridDim.x;
    c.gw = c.bid * NWAVES + c.wave; c.NGW = c.G * NWAVES; c.gwv = c.wave * c.G + c.bid;
    const int lo = args.ph_lo, hi = args.ph_hi;
    PG8_LAS unsigned char* ring = (PG8_LAS unsigned char*)lds;
#ifndef MK_PH_MASK
#define MK_PH_MASK 0xfff
#endif
#define IN(k) (((MK_PH_MASK >> (k)) & 1) && lo <= (k) && (k) < hi)
#if MK_ONE_LAUNCH
    cg::grid_group grid = cg::this_grid();
#define SEAM(k) do { if (IN(k) && IN((k) + 1)) grid.sync(); } while (0)
#else
#define SEAM(k) do { } while (0)
#endif
    if (IN(0)) { phase_prep(c); } SEAM(0);
    if (IN(1)) { phase_norm1(c); } SEAM(1);
    if (IN(2)) { pg8::Gemm g{(const pg8::bf16_t*)(c.ws + WS_HX), (const pg8::bf16_t*)(c.ws + WS_WIN), 1024, 1024, 1024}; pg8::StaticOrder S; S.init(MT, NPROJ, c.G, c.bid);
        pg8::EpiInProj E{(pg8::bf16_t*)(c.ws + WS_U), (pg8::bf16_t*)(c.ws + WS_QKVPRE), (pg8::bf16_t*)(c.ws + WS_Z)};
        pg8::gemm_phase<pg8::EpiInProj, pg8::StaticOrder, true, true>(ring, g, S, E); } SEAM(2);
    if (IN(3)) { phase_conv(c); } SEAM(3);
    if (IN(4)) { phase_scan_direct(c); } SEAM(4);
    if (IN(5)) { phase_combine(c); } SEAM(5);
    if (IN(6)) { pg8::Gemm g{(const pg8::bf16_t*)(c.ws + WS_YG), (const pg8::bf16_t*)(c.ws + WS_WGLU), 512, 512, 512}; pg8::StaticOrder S; S.init(ML, 512, c.G, c.bid);
        pg8::EpiGlu E{(const pg8::bf16_t*)(c.ws + WS_YG), (pg8::bf16_t*)(c.ws + WS_CAT)};
        pg8::gemm_phase<pg8::EpiGlu, pg8::StaticOrder, true, true>(ring, g, S, E); } SEAM(6);
    if (IN(7)) { pg8::Gemm g{(const pg8::bf16_t*)(c.ws + WS_CAT), (const pg8::bf16_t*)(c.ws + WS_WOUT), 1024, 1024, 1024}; pg8::StaticOrder S; S.init(ML, 1024, c.G, c.bid);
        pg8::EpiF32 E{(float*)(c.ws + WS_YRAW), 1024};
        pg8::gemm_phase<pg8::EpiF32, pg8::StaticOrder, true, true>(ring, g, S, E); } SEAM(7);
    if (IN(8)) { phase_rows2(c); } SEAM(8);
    if (IN(9)) { pg8::Gemm g{(const pg8::bf16_t*)(c.ws + WS_HX2), (const pg8::bf16_t*)(c.ws + WS_WQ), 1024, 1024, 1024}; pg8::StaticOrder S; S.init(ML, 2048, c.G, c.bid);
        pg8::EpiBf16<0> E{(pg8::bf16_t*)(c.ws + WS_QP), 2048, nullptr, 0, 0, 1.f};
        pg8::gemm_phase<pg8::EpiBf16<0>, pg8::StaticOrder, true, true>(ring, g, S, E); } SEAM(9);
    if (IN(10)) { phase_topk(c); } SEAM(10);
    if (IN(11)) { phase_experts(c); }
#undef IN
#undef SEAM
}

extern "C" void kernel_launch(void* const* d_in, const int* in_sizes, int n_in, void* d_out, int out_size, void* d_ws, size_t ws_size, hipStream_t stream) {
    static int grid = 0;
    if (grid == 0) {
        if (n_in != 29 || out_size != ML * D || ws_size < WS_END) { fprintf(stderr, "kernel_launch: unexpected shapes (n_in %d out %d ws %zu)\n", n_in, out_size, ws_size); grid = -1; return; }
        int dev = 0, cus = 0, per_cu = 0;
        hipGetDevice(&dev); hipDeviceGetAttribute(&cus, hipDeviceAttributeMultiprocessorCount, dev);
        if (hipFuncSetAttribute((const void*)mk_fwd, hipFuncAttributeMaxDynamicSharedMemorySize, LDS_BYTES) != hipSuccess) { fprintf(stderr, "kernel_launch: hipFuncSetAttribute failed\n"); grid = -1; return; }
        hipOccupancyMaxActiveBlocksPerMultiprocessor(&per_cu, (const void*)mk_fwd, NTHREADS, LDS_BYTES);
        (void)hipGetLastError();
        if (per_cu < 1) per_cu = 1;
        grid = cus * 1;
        fprintf(stderr, "kernel_launch: cus %d per_cu %d grid %d\n", cus, per_cu, grid);
    }
    if (grid < 0) return;
    Args a{};
    for (int i = 0; i < 29; ++i) a.in[i] = (const float*)d_in[i];
    a.out = (float*)d_out; a.ws = (unsigned char*)d_ws;
#if MK_ONE_LAUNCH
    a.ph_lo = 0; a.ph_hi = NPHASES;
    void* kargs[] = {&a};
    hipError_t e = hipLaunchCooperativeKernel((const void*)mk_fwd, dim3(grid), dim3(NTHREADS), kargs, LDS_BYTES, stream);
    if (e != hipSuccess) fprintf(stderr, "kernel_launch: cooperative launch failed: %s\n", hipGetErrorString(e));
#else
    for (int ph = 0; ph < NPHASES; ++ph) { a.ph_lo = ph; a.ph_hi = ph + 1; hipLaunchKernelGGL(mk_fwd, dim3(grid), dim3(NTHREADS), LDS_BYTES, stream, a); }
#endif
}
```

```cpp
#include <hip/hip_runtime.h>
#include <hip/hip_cooperative_groups.h>
#include <cstdio>
#include <cstdint>
namespace cg = cooperative_groups;
namespace pg8 {
#define PG8_LAS __attribute__((address_space(3)))
typedef unsigned short bf16_t;
typedef short bf16x8 __attribute__((ext_vector_type(8)));
typedef float f32x4 __attribute__((ext_vector_type(4)));
typedef unsigned u32x4 __attribute__((ext_vector_type(4)));
constexpr int BM = 256, BK = 64, HALF = 128, HTB = HALF * BK * 2  , STAGE_BYTES = 8 * HTB, NXCD = 8, WGM = 8;

__host__ __device__ __forceinline__ int lds_byte(int r, int c) { const int st = (r >> 4) * 2 + (c >> 5), rr = r & 15, cc = c & 31, ob = rr * 64 + cc * 2; return st * 1024 + (ob ^ (((ob >> 9) & 1) << 5)); }
__host__ __device__ __forceinline__ void stage_rc(int b, int& R, int& C) { const int st = b / 1024, sb = b % 1024, swz = sb ^ (((sb >> 9) & 1) << 5); R = (st >> 1) * 16 + swz / 64; C = (st & 1) * 32 + (swz % 64) / 2; }
__host__ __device__ __forceinline__ int perm32(int rho) { const int n = rho >> 4, i = rho & 15; return 8 * (i >> 2) + 4 * n + (i & 3); }

struct Unit { int pm, pn; };
struct Gemm { const bf16_t* A; const bf16_t* Bt; int lda, ldb, K; };

struct StaticOrder {
    int nM, nN, nwg, G, c;
    __host__ __device__ void init(int M, int N, int G_, int c_) { nM = M / BM; nN = N / BM; nwg = nM * nN; G = G_; c = c_; }
    __host__ __device__ bool next(int i, Unit& u) const {
        const long L = (long)i * G + c; if (L >= nwg) return false;
        int wgid = (int)L; { const int q = nwg / NXCD, r = nwg % NXCD, xcd = wgid % NXCD, off = wgid / NXCD; wgid = (xcd < r ? xcd * (q + 1) : r * (q + 1) + (xcd - r) * q) + off; }
        const int nig = WGM * nN, gid = wgid / nig, fm = gid * WGM, gsz = (nM - fm) < WGM ? (nM - fm) : WGM;
        u.pm = fm + ((wgid % nig) % gsz); u.pn = (wgid % nig) / gsz; return true;
    }
    __device__ __forceinline__ void a_ready(const Unit&) const {}
    __device__ __forceinline__ void done(const Unit&) const {}
};

__device__ __forceinline__ unsigned cvt_pk_bf16(float lo, float hi) { unsigned r; asm volatile("v_cvt_pk_bf16_f32 %0, %1, %2" : "=v"(r) : "v"(lo), "v"(hi)); return r; }
typedef float f32x2 __attribute__((ext_vector_type(2)));
__device__ __forceinline__ f32x2 gelu_pk(f32x2 v) {
    const f32x2 av = __builtin_elementwise_abs(v), d = av * 0.2316418882f + 1.0f;
    f32x2 t; t.x = __builtin_amdgcn_rcpf(d.x); t.y = __builtin_amdgcn_rcpf(d.y);
    f32x2 q = t * 0.5307027145f + (-0.7265760135f); q = q * t + 0.7107068705f; q = q * t + (-0.142248368f); q = q * t + 0.127414796f; q = q * t;
    const f32x2 s = (v * v) * (-0.72134752044f);
    f32x2 e; e.x = __builtin_amdgcn_exp2f(s.x); e.y = __builtin_amdgcn_exp2f(s.y);
    const f32x2 m = v * (q * e), r = v - m;
    f32x2 o; o.x = v.x < 0.f ? m.x : r.x; o.y = v.y < 0.f ? m.y : r.y; return o;
}

template <int ACT  > struct EpiBf16 {
    static constexpr bool PERM = true, AFTER_DRAIN = false; static_assert(ACT == 0 || ACT == 1, "EpiBf16: ACT is 0 (none) or 1 (gelu_pk)");
    bf16_t* O; int ldc; const float* bias; int split_cols; size_t split_stride; float scale0;
    __device__ __forceinline__ void operator()(const f32x4 (&acc)[2][2][4][2], const Unit& u, int wr, int wc, int fr, int fq) const {
        const int row0 = u.pm * BM + wr * 64 + fr; int colt = u.pn * BM; bf16_t* base = O;
        float sc = 1.f; if (split_cols) { const int t = colt / split_cols; base += (size_t)t * split_stride; colt -= t * split_cols; if (t == 0) sc = scale0; }
        const int col0 = colt + wc * 32 + 8 * fq, bcol0 = u.pn * BM + wc * 32 + 8 * fq;
        f32x4 bv[2][2];
#pragma unroll
        for (int bj = 0; bj < 2; ++bj)
#pragma unroll
            for (int n = 0; n < 2; ++n) bv[bj][n] = bias ? *(const f32x4*)(bias + bcol0 + bj * HALF + 4 * n) : (f32x4){0.f, 0.f, 0.f, 0.f};
#pragma unroll
        for (int ai = 0; ai < 2; ++ai)
#pragma unroll
            for (int m = 0; m < 4; ++m) { bf16_t* rowp = base + (size_t)(row0 + ai * HALF + m * 16) * ldc + col0;
#pragma unroll
                for (int bj = 0; bj < 2; ++bj) { f32x4 v0 = acc[ai][bj][m][0] + bv[bj][0], v1 = acc[ai][bj][m][1] + bv[bj][1];
                    if (ACT == 1) { f32x2 a = gelu_pk((f32x2){v0[0], v0[1]}), b = gelu_pk((f32x2){v0[2], v0[3]}), c = gelu_pk((f32x2){v1[0], v1[1]}), d = gelu_pk((f32x2){v1[2], v1[3]});
                        v0 = (f32x4){a.x, a.y, b.x, b.y}; v1 = (f32x4){c.x, c.y, d.x, d.y}; }
                    v0 = v0 * sc; v1 = v1 * sc; u32x4 w; w.x = cvt_pk_bf16(v0[0], v0[1]); w.y = cvt_pk_bf16(v0[2], v0[3]); w.z = cvt_pk_bf16(v1[0], v1[1]); w.w = cvt_pk_bf16(v1[2], v1[3]);
                    *(u32x4*)(rowp + bj * HALF) = w; } }
    }
};

template <class Epi, class Sched, bool ALIGN_EPI = false, bool SP2 = false>
__device__ __forceinline__ void gemm_phase(PG8_LAS unsigned char* lds, const Gemm g, const Sched& S, const Epi& E) {
    const int tid = threadIdx.x, wid = __builtin_amdgcn_readfirstlane(tid >> 6), lane = tid & 63, wr = wid >> 2, wc = wid & 3, fr = lane & 15, fq = lane >> 4;
    const int K = g.K, nt = K / BK;
    unsigned voffA[2], voffB[2];
#pragma unroll
    for (int i = 0; i < 2; ++i) { int R, C; stage_rc(tid * 16 + i * 8192, R, C); const int Rb = Epi::PERM ? ((R & ~31) + perm32(R & 31)) : R;
        voffA[i] = (unsigned)(R * g.lda + C) * 2u; voffB[i] = (unsigned)(Rb * g.ldb + C) * 2u; }
    const size_t kstep = (size_t)(BK * 2);
    const size_t hstepA = (size_t)HALF * g.lda * 2, hstepB = (size_t)HALF * g.ldb * 2;
    const size_t tstepA = 2 * hstepA, tstepB = 2 * hstepB;
    const unsigned ldsw = (unsigned)wid * 1024u;
    const int aoff = lds_byte(wr * 64 + fr, fq * 8), boff = lds_byte(wc * 32 + fr, fq * 8);
#define PG8_SA(b, h) (((b) * 2 + (h)) * HTB)
#define PG8_SB(b, h) ((4 + (b) * 2 + (h)) * HTB)
#define PG8_STAGE(bufoff, gbase, voff) do { _Pragma("unroll") for (int _i = 0; _i < 2; ++_i) \
        __builtin_amdgcn_global_load_lds((const unsigned*)((const char*)(gbase) + (voff)[_i]), (PG8_LAS unsigned*)(lds + (bufoff) + ldsw + _i * 8192), 16, 0, 0); } while (0)
#define PG8_LDA(dst, b, h) do { _Pragma("unroll") for (int m = 0; m < 4; ++m) _Pragma("unroll") for (int k = 0; k < 2; ++k) dst[m][k] = *(const PG8_LAS bf16x8*)(lds + PG8_SA(b, h) + aoff + m * 2048 + k * 1024); } while (0)
#define PG8_LDB(dst, b, h) do { _Pragma("unroll") for (int n = 0; n < 2; ++n) _Pragma("unroll") for (int k = 0; k < 2; ++k) dst[n][k] = *(const PG8_LAS bf16x8*)(lds + PG8_SB(b, h) + boff + n * 2048 + k * 1024); } while (0)
#define PG8_MMA(ai, bj, At, Bt) do { __builtin_amdgcn_s_setprio(1); _Pragma("unroll") for (int m = 0; m < 4; ++m) _Pragma("unroll") for (int n = 0; n < 2; ++n) _Pragma("unroll") for (int k = 0; k < 2; ++k) \
        acc[ai][bj][m][n] = __builtin_amdgcn_mfma_f32_16x16x32_bf16(Bt[n][k], At[m][k], acc[ai][bj][m][n], 0, 0, 0); __builtin_amdgcn_s_setprio(0); } while (0)
#define PG8_WAIT_V(n) asm volatile("s_waitcnt vmcnt(" #n ")" ::: "memory")
#define PG8_WAIT_L(n) asm volatile("s_waitcnt lgkmcnt(" #n ")" ::: "memory")
#define PG8_BAR __builtin_amdgcn_s_barrier()
#define PG8_SCHED __builtin_amdgcn_sched_barrier(0)
    Unit cur, nxt; int ui = 0;
    if (!S.next(0, cur)) return;
    f32x4 acc[2][2][4][2];
#pragma unroll
    for (int a = 0; a < 2; ++a)
#pragma unroll
        for (int b = 0; b < 2; ++b)
#pragma unroll
            for (int m = 0; m < 4; ++m)
#pragma unroll
                for (int n = 0; n < 2; ++n) acc[a][b][m][n] = (f32x4){0.f, 0.f, 0.f, 0.f};
    bf16x8 At[4][2], B0[2][2], B1[2][2];
    const char* cA = (const char*)g.A + (size_t)cur.pm * tstepA; const char* cB = (const char*)g.Bt + (size_t)cur.pn * tstepB;
    S.a_ready(cur);
    if constexpr (SP2) {
        PG8_STAGE(PG8_SB(0, 0), cB, voffB); PG8_STAGE(PG8_SB(0, 1), cB + hstepB, voffB); PG8_STAGE(PG8_SA(0, 0), cA, voffA); PG8_STAGE(PG8_SA(0, 1), cA + hstepA, voffA);
        if (wr == 1) PG8_BAR;
        PG8_WAIT_V(2); PG8_BAR;
        PG8_STAGE(PG8_SB(1, 0), cB + kstep, voffB); PG8_STAGE(PG8_SA(1, 0), cA + kstep, voffA); PG8_STAGE(PG8_SB(1, 1), cB + hstepB + kstep, voffB);
        PG8_WAIT_V(6); PG8_BAR;
    } else {
        PG8_STAGE(PG8_SB(0, 0), cB, voffB); PG8_STAGE(PG8_SA(0, 0), cA, voffA); PG8_STAGE(PG8_SB(0, 1), cB + hstepB, voffB); PG8_STAGE(PG8_SA(0, 1), cA + hstepA, voffA);
        if (wr == 1) PG8_BAR;
        PG8_WAIT_V(4); PG8_BAR;
        PG8_STAGE(PG8_SB(1, 0), cB + kstep, voffB); PG8_STAGE(PG8_SA(1, 0), cA + kstep, voffA); PG8_STAGE(PG8_SB(1, 1), cB + hstepB + kstep, voffB);
        PG8_WAIT_V(6); PG8_BAR;
    }
    for (;;) {
        const bool has_next = S.next(ui + 1, nxt);
        const char* nA = has_next ? (const char*)g.A + (size_t)nxt.pm * tstepA : cA; const char* nB = has_next ? (const char*)g.Bt + (size_t)nxt.pn * tstepB : cB;
        for (int t = 0; t < nt; t += 2) {
            const bool last = (t == nt - 2);
            const char* a1 = cA + (size_t)(t + 1) * kstep;
            const char* a2 = last ? nA : cA + (size_t)(t + 2) * kstep; const char* b2 = last ? nB : cB + (size_t)(t + 2) * kstep;
            const char* a3 = a2 + kstep; const char* b3 = b2 + kstep;
            if (last && has_next) S.a_ready(nxt);
            if constexpr (SP2) {
            PG8_LDB(B0, 0, 0); PG8_LDB(B1, 0, 1); PG8_SCHED; PG8_LDA(At, 0, 0); PG8_STAGE(PG8_SA(1, 1), a1 + hstepA, voffA);
            PG8_WAIT_V(8); PG8_WAIT_L(0); PG8_BAR; PG8_MMA(0, 0, At, B0); PG8_MMA(0, 1, At, B1); PG8_BAR; PG8_SCHED;
            PG8_LDA(At, 0, 1); PG8_STAGE(PG8_SB(0, 0), b2, voffB); PG8_STAGE(PG8_SB(0, 1), b2 + hstepB, voffB); PG8_STAGE(PG8_SA(0, 0), a2, voffA);
            PG8_WAIT_V(8); PG8_WAIT_L(0); PG8_BAR; PG8_MMA(1, 0, At, B0); PG8_MMA(1, 1, At, B1); PG8_BAR; PG8_SCHED;
            PG8_LDB(B0, 1, 0); PG8_LDB(B1, 1, 1); PG8_SCHED; PG8_LDA(At, 1, 0); PG8_STAGE(PG8_SA(0, 1), a2 + hstepA, voffA);
            PG8_WAIT_V(8); PG8_WAIT_L(0); PG8_BAR; PG8_MMA(0, 0, At, B0); PG8_MMA(0, 1, At, B1); PG8_BAR; PG8_SCHED;
            PG8_LDA(At, 1, 1); PG8_STAGE(PG8_SB(1, 0), b3, voffB); PG8_STAGE(PG8_SB(1, 1), b3 + hstepB, voffB); PG8_STAGE(PG8_SA(1, 0), a3, voffA);
            PG8_WAIT_V(8); PG8_WAIT_L(0); PG8_BAR; PG8_MMA(1, 0, At, B0); PG8_MMA(1, 1, At, B1); PG8_BAR; PG8_SCHED;
            } else {
            PG8_LDB(B0, 0, 0); PG8_SCHED; PG8_LDA(At, 0, 0); PG8_STAGE(PG8_SA(1, 1), a1 + hstepA, voffA);
            PG8_WAIT_L(8); PG8_BAR; PG8_WAIT_L(0); PG8_MMA(0, 0, At, B0); PG8_BAR; PG8_SCHED;
            PG8_LDB(B1, 0, 1); PG8_STAGE(PG8_SB(0, 0), b2, voffB);
            PG8_BAR; PG8_WAIT_L(0); PG8_MMA(0, 1, At, B1); PG8_BAR;
            PG8_LDA(At, 0, 1); PG8_STAGE(PG8_SA(0, 0), a2, voffA);
            PG8_BAR; PG8_WAIT_L(0); PG8_MMA(1, 0, At, B0); PG8_BAR; PG8_SCHED;
            PG8_STAGE(PG8_SB(0, 1), b2 + hstepB, voffB);
            PG8_WAIT_V(6); PG8_BAR; PG8_MMA(1, 1, At, B1); PG8_BAR;
            PG8_LDB(B0, 1, 0); PG8_SCHED; PG8_LDA(At, 1, 0); PG8_STAGE(PG8_SA(0, 1), a2 + hstepA, voffA);
            PG8_WAIT_L(8); PG8_BAR; PG8_WAIT_L(0); PG8_MMA(0, 0, At, B0); PG8_BAR; PG8_SCHED;
            PG8_LDB(B1, 1, 1); PG8_STAGE(PG8_SB(1, 0), b3, voffB);
            PG8_BAR; PG8_WAIT_L(0); PG8_MMA(0, 1, At, B1); PG8_BAR;
            PG8_LDA(At, 1, 1); PG8_STAGE(PG8_SA(1, 0), a3, voffA);
            PG8_BAR; PG8_WAIT_L(0); PG8_MMA(1, 0, At, B0); PG8_BAR; PG8_SCHED;
            PG8_STAGE(PG8_SB(1, 1), b3 + hstepB, voffB);
            PG8_WAIT_V(6); PG8_BAR; PG8_MMA(1, 1, At, B1); PG8_BAR;
            }
        }
        if constexpr (ALIGN_EPI) { if (wr == 0) PG8_BAR; }
        if constexpr (!Epi::AFTER_DRAIN) { E(acc, cur, wr, wc, fr, fq); S.done(cur); }
        if (!has_next) break;
#pragma unroll
        for (int a = 0; a < 2; ++a)
#pragma unroll
            for (int b = 0; b < 2; ++b)
#pragma unroll
                for (int m = 0; m < 4; ++m)
#pragma unroll
                    for (int n = 0; n < 2; ++n) acc[a][b][m][n] = (f32x4){0.f, 0.f, 0.f, 0.f};
        cur = nxt; cA = nA; cB = nB; ++ui;
        if constexpr (ALIGN_EPI) { if (wr == 1) PG8_BAR; }
    }
    PG8_WAIT_V(0);
    if constexpr (!ALIGN_EPI) { if (wr == 0) PG8_BAR; }
    PG8_BAR;
    if constexpr (Epi::AFTER_DRAIN) { E.fused(acc, cur, wr, wc, fr, fq, lds, wid, lane); S.done(cur); }
#undef PG8_SA
#undef PG8_SB
#undef PG8_STAGE
#undef PG8_LDA
#undef PG8_LDB
#undef PG8_MMA
#undef PG8_WAIT_V
#undef PG8_WAIT_L
#undef PG8_BAR
#undef PG8_SCHED
}
}

#ifndef MK_ONE_LAUNCH
#define MK_ONE_LAUNCH 1
#endif
#define LAS __attribute__((address_space(3)))
typedef unsigned short bf16;
typedef unsigned v4u __attribute__((ext_vector_type(4)));
typedef unsigned v2u __attribute__((ext_vector_type(2)));
typedef float f32x4 __attribute__((ext_vector_type(4)));
typedef float f32x2 __attribute__((ext_vector_type(2)));

constexpr int D = 1024, NB = 8, SEQ = 2048, LC = 256, ML = NB * SEQ  , MC = NB * LC  , MT = ML + MC  ;
constexpr int PROJ = 2576, NPROJ = 2560;
constexpr int NEXP = 16384, TOPK = 16, KK = 128;
constexpr float EPS = 1e-6f;
constexpr int NTHREADS = 512, NWAVES = 8;
constexpr int LDS_BYTES = 147456;
constexpr int NPHASES = 12;

constexpr size_t MiB = 1u << 20;
constexpr size_t WS_CTL = 0;
constexpr size_t WS_MOD = 1 * MiB;
constexpr size_t WS_WIN = 2 * MiB;
constexpr size_t WS_WOUT = 8 * MiB;
constexpr size_t WS_WGLU = 10 * MiB;
constexpr size_t WS_WQ = 11 * MiB;
constexpr size_t WS_GB = 15 * MiB;
constexpr size_t WS_IDX = 17 * MiB;
constexpr size_t WS_GATE = 26 * MiB;
constexpr size_t WS_HX = 35 * MiB;
constexpr size_t WS_U = 72 * MiB;
constexpr size_t WS_YRAW = 35 * MiB;
constexpr size_t WS_Z = 100 * MiB;
constexpr size_t WS_QKVPRE = 116 * MiB;
constexpr size_t WS_OG = 116 * MiB;
constexpr size_t WS_HX2 = 116 * MiB;
constexpr size_t WS_QKV = 170 * MiB;
constexpr size_t WS_CAT = 170 * MiB;
constexpr size_t WS_YG = 202 * MiB;
constexpr size_t WS_QP = 170 * MiB;
constexpr size_t WS_YS5 = 224 * MiB;
constexpr size_t WS_END = 256 * MiB;
static_assert(WS_YRAW + (size_t)ML * D * 4 <= WS_Z && WS_Z + (size_t)ML * 512 * 2 <= WS_QKVPRE && WS_QKVPRE + (size_t)MT * 1536 * 2 <= WS_QKV && WS_QKV + (size_t)MT * 1536 * 2 <= WS_YS5, "ws map");
static_assert(WS_QP + (size_t)ML * 2048 * 2 <= WS_END && WS_YS5 + (size_t)2 * ML * 512 * 2 <= WS_END && WS_YG + (size_t)ML * 512 * 2 <= WS_YS5 && WS_U + (size_t)MT * 512 * 2 <= WS_Z, "ws map 2");
static_assert(WS_GATE + (size_t)ML * 128 * 4 <= WS_HX && WS_IDX + (size_t)ML * 128 * 4 <= WS_GATE && WS_HX + (size_t)MT * D * 2 <= WS_U, "ws map 3");

__device__ __forceinline__ unsigned f2bf(float f) { unsigned u = __builtin_bit_cast(unsigned, f); return (u + 0x7fffu + ((u >> 16) & 1u)) >> 16; }
__device__ __forceinline__ unsigned pk2(float lo, float hi) { return f2bf(lo) | (f2bf(hi) << 16); }
__device__ __forceinline__ float bflo(unsigned w) { return __builtin_bit_cast(float, w << 16); }
__device__ __forceinline__ float bfhi(unsigned w) { return __builtin_bit_cast(float, w & 0xffff0000u); }
__device__ __forceinline__ float bf1(bf16 h) { return __builtin_bit_cast(float, (unsigned)h << 16); }
__device__ __forceinline__ float wave_sum(float v) {
#pragma unroll
    for (int o = 1; o < 64; o <<= 1) v += __shfl_xor(v, o);
    return v;
}
__device__ __forceinline__ float wave_max(float v) {
#pragma unroll
    for (int o = 1; o < 64; o <<= 1) v = fmaxf(v, __shfl_xor(v, o));
    return v;
}
__device__ __forceinline__ float sigmoidf_(float x) { return 1.f / (1.f + __expf(-x)); }
__device__ __forceinline__ float siluf_(float x) { return x / (1.f + __expf(-x)); }
__device__ __forceinline__ float gelu_erf(float x) { return 0.5f * x * (1.f + erff(x * 0.70710678118654752f)); }
__device__ __forceinline__ void sincos_d(double a, float& s, float& c) {
    const double k = rint(a * 0.63661977236758134308);
    const double r = fma(-k, 1.57079632679489661923, a) - k * 6.123233995736766e-17;
    const double r2 = r * r;
    double sp = -2.5052108385441720e-08; sp = sp * r2 + 2.7557319223985893e-06; sp = sp * r2 - 1.9841269841269841e-04; sp = sp * r2 + 8.3333333333333332e-03; sp = sp * r2 - 1.6666666666666666e-01;
    const double sn = r + r * r2 * sp;
    double cp = 2.0876756987868099e-09; cp = cp * r2 - 2.7557319223985888e-07; cp = cp * r2 + 2.4801587301587302e-05; cp = cp * r2 - 1.3888888888888889e-03; cp = cp * r2 + 4.1666666666666664e-02; cp = cp * r2 - 0.5;
    const double cs = 1.0 + r2 * cp;
    const int q = ((int)k) & 3;
    const double ss = (q == 0) ? sn : (q == 1) ? cs : (q == 2) ? -sn : -cs;
    const double cc = (q == 0) ? cs : (q == 1) ? -sn : (q == 2) ? -cs : sn;
    s = (float)ss; c = (float)cc;
}

struct Args { const float* in[29]; float* out; unsigned char* ws; int ph_lo, ph_hi; };
static_assert(sizeof(Args) == 29 * 8 + 8 + 8 + 8, "Args has no padding");
enum { I_X = 0, I_C, I_CTX, I_CCTX, I_WMOD, I_BMOD, I_GPREMIX, I_GPOSTMIX, I_GPREFFN, I_GPOSTFFN, I_WIN, I_WOUT, I_LAMRE, I_LAMIM, I_LOGDT, I_BRE, I_BIM, I_CRE, I_CIM, I_S5D, I_WGLU,
       I_CONV, I_ALOG, I_DTBIAS, I_GDNNORM, I_WQ, I_KEYS, I_PU, I_PV };

__device__ __forceinline__ const float* in_row(const Args& a, int row) { return row < ML ? a.in[I_X] + (size_t)row * D : a.in[I_CTX] + (size_t)(row - ML) * D; }
__device__ __forceinline__ int mod_row(int row) { return row < ML ? (row >> 11) : 8; }

namespace pg8 {
struct EpiInProj {
    static constexpr bool PERM = true, AFTER_DRAIN = false;
    bf16_t* U; bf16_t* QKV; bf16_t* Z;
    __device__ __forceinline__ void operator()(const f32x4 (&acc)[2][2][4][2], const Unit& u, int wr, int wc, int fr, int fq) const {
        bf16_t* base; int ld, colt; bool lat_only = false;
        if (u.pn < 2) { base = U; ld = 512; colt = u.pn * BM; }
        else if (u.pn < 8) { base = QKV; ld = 1536; colt = (u.pn - 2) * BM; }
        else { base = Z; ld = 512; colt = (u.pn - 8) * BM; lat_only = true; }
        const int row0 = u.pm * BM + wr * 64 + fr, col0 = colt + wc * 32 + 8 * fq;
#pragma unroll
        for (int ai = 0; ai < 2; ++ai)
#pragma unroll
            for (int m = 0; m < 4; ++m) { const int row = row0 + ai * HALF + m * 16; bf16_t* rowp = base + (size_t)row * ld + col0;
                if (lat_only && row >= 16384) continue;
#pragma unroll
                for (int bj = 0; bj < 2; ++bj) { const f32x4 v0 = acc[ai][bj][m][0], v1 = acc[ai][bj][m][1];
                    u32x4 w; w.x = cvt_pk_bf16(v0[0], v0[1]); w.y = cvt_pk_bf16(v0[2], v0[3]); w.z = cvt_pk_bf16(v1[0], v1[1]); w.w = cvt_pk_bf16(v1[2], v1[3]);
                    *(u32x4*)(rowp + bj * HALF) = w; } }
    }
};
struct EpiGlu {
    static constexpr bool PERM = true, AFTER_DRAIN = false;
    const bf16_t* YG; bf16_t* CAT;
    __device__ __forceinline__ void operator()(const f32x4 (&acc)[2][2][4][2], const Unit& u, int wr, int wc, int fr, int fq) const {
        const int row0 = u.pm * BM + wr * 64 + fr, col0 = u.pn * BM + wc * 32 + 8 * fq;
#pragma unroll
        for (int ai = 0; ai < 2; ++ai)
#pragma unroll
            for (int m = 0; m < 4; ++m) { const int row = row0 + ai * HALF + m * 16;
#pragma unroll
                for (int bj = 0; bj < 2; ++bj) { const f32x4 v0 = acc[ai][bj][m][0], v1 = acc[ai][bj][m][1];
                    const u32x4 y = *(const u32x4*)(YG + (size_t)row * 512 + col0 + bj * HALF);
                    float o[8]; const float a[8] = {v0[0], v0[1], v0[2], v0[3], v1[0], v1[1], v1[2], v1[3]};
                    const unsigned yw[4] = {y.x, y.y, y.z, y.w};
#pragma unroll
                    for (int e = 0; e < 8; ++e) { const float yv = __builtin_bit_cast(float, (e & 1) ? (yw[e >> 1] & 0xffff0000u) : (yw[e >> 1] << 16)); o[e] = yv / (1.f + __expf(-a[e])); }
                    u32x4 w; w.x = cvt_pk_bf16(o[0], o[1]); w.y = cvt_pk_bf16(o[2], o[3]); w.z = cvt_pk_bf16(o[4], o[5]); w.w = cvt_pk_bf16(o[6], o[7]);
                    *(u32x4*)(CAT + (size_t)row * 1024 + col0 + bj * HALF) = w; } }
    }
};
struct EpiF32 {
    static constexpr bool PERM = false, AFTER_DRAIN = false;
    float* C; int ldc;
    __device__ __forceinline__ void operator()(const f32x4 (&acc)[2][2][4][2], const Unit& u, int wr, int wc, int fr, int fq) const {
        const int row0 = u.pm * BM + wr * 64 + fr, col0 = u.pn * BM + wc * 32 + 4 * fq;
#pragma unroll
        for (int ai = 0; ai < 2; ++ai)
#pragma unroll
            for (int m = 0; m < 4; ++m) { float* rowp = C + (size_t)(row0 + ai * HALF + m * 16) * ldc + col0;
#pragma unroll
                for (int bj = 0; bj < 2; ++bj)
#pragma unroll
                    for (int n = 0; n < 2; ++n) *(f32x4*)(rowp + bj * HALF + n * 16) = acc[ai][bj][m][n]; }
    }
};
}

struct Ctx { const Args* a; unsigned char* ws; unsigned char* lds; int tid, lane, wave, bid, G, gw, NGW, gwv; };

__device__ __forceinline__ void p0_transpose_item(const float* W, int ldw, int nblk, int K, bf16* WT, float* scr, int item, int lane) {
    const int kb = item / nblk, nb = item % nblk, k0 = 64 * kb, n0 = 32 * nb;
#pragma unroll 8
    for (int i = 0; i < 32; ++i) { const int kk = 2 * i + (lane >> 5); scr[kk * 33 + (lane & 31)] = W[(size_t)(k0 + kk) * ldw + n0 + (lane & 31)]; }
    __builtin_amdgcn_fence(__ATOMIC_RELEASE, "wavefront"); __builtin_amdgcn_wave_barrier(); __builtin_amdgcn_fence(__ATOMIC_ACQUIRE, "wavefront");
    const int c = lane & 7;
#pragma unroll
    for (int j = 0; j < 4; ++j) { const int n = (lane >> 3) + 8 * j; const float* s = scr + (8 * c) * 33 + n;
        v4u o; o.x = pk2(s[0 * 33], s[1 * 33]); o.y = pk2(s[2 * 33], s[3 * 33]); o.z = pk2(s[4 * 33], s[5 * 33]); o.w = pk2(s[6 * 33], s[7 * 33]);
        *(v4u*)(WT + (size_t)(n0 + n) * K + k0 + 8 * c) = o; }
    __builtin_amdgcn_fence(__ATOMIC_RELEASE, "wavefront"); __builtin_amdgcn_wave_barrier(); __builtin_amdgcn_fence(__ATOMIC_ACQUIRE, "wavefront");
}
__device__ __forceinline__ void phase_prep(const Ctx& c) {
    const Args& a = *c.a;
    float* scr = (float*)(c.lds + c.wave * 16384);
    constexpr int I_IN = 16 * 80, I_OUT = 16 * 32, I_GLU = 8 * 16, I_Q = 16 * 64;
    for (int it = c.gw; it < I_IN + I_OUT + I_GLU + I_Q; it += c.NGW) {
        int r = it;
        if (r < I_IN) { p0_transpose_item(a.in[I_WIN], PROJ, 80, 1024, (bf16*)(c.ws + WS_WIN), scr, r, c.lane); continue; } r -= I_IN;
        if (r < I_OUT) { p0_transpose_item(a.in[I_WOUT], 1024, 32, 1024, (bf16*)(c.ws + WS_WOUT), scr, r, c.lane); continue; } r -= I_OUT;
        if (r < I_GLU) { p0_transpose_item(a.in[I_WGLU], 512, 16, 512, (bf16*)(c.ws + WS_WGLU), scr, r, c.lane); continue; } r -= I_GLU;
        p0_transpose_item(a.in[I_WQ], 2048, 64, 1024, (bf16*)(c.ws + WS_WQ), scr, r, c.lane);
    }
    __syncthreads();
    float* sc = (float*)c.lds;
    float* red = (float*)(c.lds + 9 * 1024 * 4);
    float* MOD = (float*)(c.ws + WS_MOD);
    bool have = false;
    for (int item = c.bid; item < 96; item += c.G) {
        if (!have) { for (int i = c.tid; i < 9 * 1024; i += NTHREADS) { const int r = i >> 10, k = i & 1023; const float v = r < 8 ? a.in[I_C][r * 1024 + k] : a.in[I_CCTX][k]; sc[i] = siluf_(v); } have = true; __syncthreads(); }
        const int n0 = item * 64;
        float acc[9];
#pragma unroll
        for (int r = 0; r < 9; ++r) acc[r] = 0.f;
        const float* wp = a.in[I_WMOD] + (size_t)(c.wave * 128) * 6144 + n0 + c.lane;
#pragma unroll 4
        for (int k = 0; k < 128; ++k) { const float w = wp[(size_t)k * 6144];
#pragma unroll
            for (int r = 0; r < 9; ++r) acc[r] = fmaf(sc[r * 1024 + c.wave * 128 + k], w, acc[r]); }
#pragma unroll
        for (int r = 0; r < 9; ++r) red[(c.wave * 9 + r) * 64 + c.lane] = acc[r];
        __syncthreads();
        for (int i = c.tid; i < 576; i += NTHREADS) { const int r = i >> 6, l = i & 63; float s = a.in[I_BMOD][n0 + l];
#pragma unroll
            for (int w = 0; w < 8; ++w) s += red[(w * 9 + r) * 64 + l];
            MOD[r * 6144 + n0 + l] = s; }
        __syncthreads();
    }
}

__device__ __forceinline__ void phase_norm1(const Ctx& c) {
    const Args& a = *c.a;
    float* wabT = (float*)c.lds;
    for (int i = c.tid; i < 1024 * 16; i += NTHREADS) { const int k = i >> 4, j = i & 15; wabT[j * 1028 + k] = a.in[I_WIN][(size_t)k * PROJ + NPROJ + j]; }
    __syncthreads();
    const float* MOD = (const float*)(c.ws + WS_MOD);
    bf16* HX = (bf16*)(c.ws + WS_HX); float* GB = (float*)(c.ws + WS_GB);
    const float* gpre = a.in[I_GPREMIX];
    for (int row = c.gw; row < MT; row += c.NGW) {
        const f32x4* xr = (const f32x4*)in_row(a, row) + c.lane;
        const float* mr = MOD + mod_row(row) * 6144;
        f32x4 v[4]; float ss = 0.f;
#pragma unroll
        for (int j = 0; j < 4; ++j) { v[j] = xr[64 * j]; ss += (v[j].x * v[j].x + v[j].y * v[j].y) + (v[j].z * v[j].z + v[j].w * v[j].w); }
        const float r = rsqrtf(wave_sum(ss) * (1.f / D) + EPS);
#pragma unroll
        for (int j = 0; j < 4; ++j) { const int col = 4 * c.lane + 256 * j;
            const f32x4 g4 = *(const f32x4*)(gpre + col), sh = *(const f32x4*)(mr + col), scl = *(const f32x4*)(mr + 1024 + col);
            v[j] = (v[j] * r) * g4 * (scl + 1.f) + sh;
            v2u o; o.x = pk2(v[j].x, v[j].y); o.y = pk2(v[j].z, v[j].w);
            *(v2u*)(HX + (size_t)row * D + col) = o; }
        float mine = 0.f;
#pragma unroll 1
        for (int j = 0; j < 16; ++j) { float s = 0.f;
#pragma unroll
            for (int jj = 0; jj < 4; ++jj) { const f32x4 w = *(const f32x4*)(wabT + j * 1028 + 4 * c.lane + 256 * jj); s += (v[jj].x * w.x + v[jj].y * w.y) + (v[jj].z * w.z + v[jj].w * w.w); }
            s = wave_sum(s); mine = (c.lane == j) ? s : mine; }
        if (c.lane < 8) { const float t = mine + a.in[I_DTBIAS][c.lane]; const float sp = t > 20.f ? t : log1pf(expf(t)); GB[(size_t)row * 16 + c.lane] = -expf(a.in[I_ALOG][c.lane]) * sp; }
        else if (c.lane < 16) GB[(size_t)row * 16 + c.lane] = 1.f / (1.f + expf(-mine));
    }
}

__device__ __forceinline__ void phase_conv(const Ctx& c) {
    const Args& a = *c.a;
    const bf16* PRE = (const bf16*)(c.ws + WS_QKVPRE); bf16* OUT = (bf16*)(c.ws + WS_QKV);
    const float* cw = a.in[I_CONV];
    for (int row = c.gw; row < MT; row += c.NGW) {
        int nb_row[9]; bool ok[9];
        if (row < ML) { const int t = row & 2047, gr = t >> 6, gc = t & 63;
#pragma unroll
            for (int dy = -1; dy <= 1; ++dy)
#pragma unroll
                for (int dx = -1; dx <= 1; ++dx) { const int i = (dy + 1) * 3 + dx + 1; ok[i] = (gr + dy >= 0) && (gr + dy < 32) && (gc + dx >= 0) && (gc + dx < 64); nb_row[i] = row + dy * 64 + dx; } }
        else { const int t = (row - ML) & 255;
#pragma unroll
            for (int i = 0; i < 9; ++i) { ok[i] = false; nb_row[i] = row; }
#pragma unroll
            for (int dx = -1; dx <= 1; ++dx) { ok[4 + dx] = (t + dx >= 0) && (t + dx < 256); nb_row[4 + dx] = row + dx; } }
#pragma unroll 2
        for (int seg = 0; seg < 12; ++seg) { const int ch = seg * 128 + 2 * c.lane; float o0 = 0.f, o1 = 0.f;
#pragma unroll
            for (int i = 0; i < 9; ++i) if (ok[i]) { const unsigned w = *(const unsigned*)(PRE + (size_t)nb_row[i] * 1536 + ch); const f32x2 k2 = *(const f32x2*)(cw + i * 1536 + ch);
                o0 = fmaf(bflo(w), k2.x, o0); o1 = fmaf(bfhi(w), k2.y, o1); }
            o0 = siluf_(o0); o1 = siluf_(o1);
            if (seg < 8) { const float ssq = wave_sum(o0 * o0 + o1 * o1); const float sc = rsqrtf(ssq + EPS) * (seg < 4 ? 0.08838834764831845f : 1.f); o0 *= sc; o1 *= sc; }
            *(unsigned*)(OUT + (size_t)row * 1536 + ch) = pk2(o0, o1); }
    }
}

__device__ __forceinline__ int scan_row(int b, int dir, int step) {
    if (step < LC) { const int t = dir ? LC - 1 - step : step; return ML + b * LC + t; }
    const int t = step - LC; return b * SEQ + (dir ? SEQ - 1 - t : t);
}
__device__ __forceinline__ void s5_direct_task(const Ctx& c, int task, float* wl  ) {
    const Args& a = *c.a;
    const int dir = task & 1, g = (task >> 1) & 31, b = task >> 6, p = c.lane, dg = dir * 32 + g;
    const float dt = expf(a.in[I_LOGDT][dg]);
    const float lr = a.in[I_LAMRE][dg * 64 + p], li = a.in[I_LAMIM][dg * 64 + p];
    const float mag = expf(lr * dt); float sn, cs; sincos_d((double)li * (double)dt, sn, cs);
    const float lbr = mag * cs, lbi = mag * sn, den = lr * lr + li * li, nr = lbr - 1.f;
    const float cr = (nr * lr + lbi * li) / den, ci = (lbi * lr - nr * li) / den;
    float bbr[16], bbi[16], cre[16], cim[16];
#pragma unroll
    for (int ch = 0; ch < 16; ++ch) { const float br = a.in[I_BRE][(size_t)(dg * 64 + p) * 16 + ch], bi = a.in[I_BIM][(size_t)(dg * 64 + p) * 16 + ch];
        bbr[ch] = cr * br - ci * bi; bbi[ch] = cr * bi + ci * br;
        cre[ch] = a.in[I_CRE][(size_t)(dg * 16 + ch) * 64 + p]; cim[ch] = a.in[I_CIM][(size_t)(dg * 16 + ch) * 64 + p]; }
    const bf16* U = (const bf16*)(c.ws + WS_U); bf16* YS = (bf16*)(c.ws + WS_YS5) + (size_t)dir * ML * 512;
    float hre = 0.f, him = 0.f;
    v4u n0 = *(const v4u*)(U + (size_t)scan_row(b, dir, 0) * 512 + g * 16), n1 = *(const v4u*)(U + (size_t)scan_row(b, dir, 0) * 512 + g * 16 + 8);
    for (int step = 0; step < LC + SEQ; ++step) {
        const int row = scan_row(b, dir, step);
        const v4u u0 = n0, u1 = n1;
        if (step + 1 < LC + SEQ) { const bf16* np = U + (size_t)scan_row(b, dir, step + 1) * 512 + g * 16; n0 = *(const v4u*)np; n1 = *(const v4u*)(np + 8); }
        const unsigned uw[8] = {u0.x, u0.y, u0.z, u0.w, u1.x, u1.y, u1.z, u1.w};
        float bur = 0.f, bui = 0.f;
#pragma unroll
        for (int ch = 0; ch < 16; ++ch) { const float uv = (ch & 1) ? bfhi(uw[ch >> 1]) : bflo(uw[ch >> 1]); bur = fmaf(bbr[ch], uv, bur); bui = fmaf(bbi[ch], uv, bui); }
        const float nre = lbr * hre - lbi * him + bur, nim = lbr * him + lbi * hre + bui; hre = nre; him = nim;
        if (step >= LC) {
#pragma unroll
            for (int ch = 0; ch < 16; ++ch) wl[ch * 65 + p] = cre[ch] * hre - cim[ch] * him;
            __builtin_amdgcn_fence(__ATOMIC_RELEASE, "wavefront"); __builtin_amdgcn_wave_barrier(); __builtin_amdgcn_fence(__ATOMIC_ACQUIRE, "wavefront");
            const int ch = c.lane >> 2, part = c.lane & 3; float s = 0.f;
#pragma unroll
            for (int i = 0; i < 16; ++i) s += wl[ch * 65 + part * 16 + i];
            s += __shfl_xor(s, 1); s += __shfl_xor(s, 2);
            if (part == 0) YS[(size_t)row * 512 + g * 16 + ch] = (bf16)f2bf(s);
            __builtin_amdgcn_fence(__ATOMIC_RELEASE, "wavefront"); __builtin_amdgcn_wave_barrier(); __builtin_amdgcn_fence(__ATOMIC_ACQUIRE, "wavefront");
        }
    }
}
__device__ __forceinline__ void gdn_direct_task(const Ctx& c, int task, float* wl  ) {
    const int dvq = task & 3, dir = (task >> 2) & 1, h = (task >> 3) & 3, b = task >> 5, half = c.lane >> 5, dv = dvq * 32 + (c.lane & 31);
    const bf16* QKV = (const bf16*)(c.ws + WS_QKV); const float* GB = (const float*)(c.ws + WS_GB);
    bf16* OG = (bf16*)(c.ws + WS_OG) + (size_t)dir * ML * 512;
    float S[64];
#pragma unroll
    for (int i = 0; i < 64; ++i) S[i] = 0.f;
    float* kf = wl; float* qf = wl + 128;
    unsigned nq, nk; bf16 nv; float ng, nbt;
    { const int row = scan_row(b, dir, 0); const bf16* rp = QKV + (size_t)row * 1536 + h * 128; nq = *(const unsigned*)(rp + 2 * c.lane); nk = *(const unsigned*)(rp + 512 + 2 * c.lane); nv = rp[1024 + dv];
      ng = GB[(size_t)row * 16 + dir * 4 + h]; nbt = GB[(size_t)row * 16 + 8 + dir * 4 + h]; }
    for (int step = 0; step < LC + SEQ; ++step) {
        const int row = scan_row(b, dir, step);
        const unsigned qw = nq, kw = nk; const float v = bf1(nv), eg = __expf(ng), beta = nbt;
        if (step + 1 < LC + SEQ) { const int r2 = scan_row(b, dir, step + 1); const bf16* rp = QKV + (size_t)r2 * 1536 + h * 128; nq = *(const unsigned*)(rp + 2 * c.lane); nk = *(const unsigned*)(rp + 512 + 2 * c.lane); nv = rp[1024 + dv];
            ng = GB[(size_t)r2 * 16 + dir * 4 + h]; nbt = GB[(size_t)r2 * 16 + 8 + dir * 4 + h]; }
        *(f32x2*)(kf + 2 * c.lane) = (f32x2){bflo(kw), bfhi(kw)}; *(f32x2*)(qf + 2 * c.lane) = (f32x2){bflo(qw), bfhi(qw)};
        __builtin_amdgcn_fence(__ATOMIC_RELEASE, "wavefront"); __builtin_amdgcn_wave_barrier(); __builtin_amdgcn_fence(__ATOMIC_ACQUIRE, "wavefront");
        const float* kh = kf + 64 * half; const float* qh = qf + 64 * half;
        float ks = 0.f;
#pragma unroll
        for (int i = 0; i < 16; ++i) { const f32x4 k4 = *(const f32x4*)(kh + 4 * i);
            ks = fmaf(S[4 * i], k4.x, ks); ks = fmaf(S[4 * i + 1], k4.y, ks); ks = fmaf(S[4 * i + 2], k4.z, ks); ks = fmaf(S[4 * i + 3], k4.w, ks); }
        ks += __shfl_xor(ks, 32);
        const float vn = beta * (v - eg * ks);
        float o = 0.f;
#pragma unroll
        for (int i = 0; i < 16; ++i) { const f32x4 k4 = *(const f32x4*)(kh + 4 * i), q4 = *(const f32x4*)(qh + 4 * i);
            S[4 * i] = fmaf(S[4 * i], eg, k4.x * vn); S[4 * i + 1] = fmaf(S[4 * i + 1], eg, k4.y * vn); S[4 * i + 2] = fmaf(S[4 * i + 2], eg, k4.z * vn); S[4 * i + 3] = fmaf(S[4 * i + 3], eg, k4.w * vn);
            o = fmaf(S[4 * i], q4.x, o); o = fmaf(S[4 * i + 1], q4.y, o); o = fmaf(S[4 * i + 2], q4.z, o); o = fmaf(S[4 * i + 3], q4.w, o); }
        o += __shfl_xor(o, 32);
        if (step >= LC && half == 0) OG[(size_t)row * 512 + h * 128 + dv] = (bf16)f2bf(o);
        __builtin_amdgcn_fence(__ATOMIC_RELEASE, "wavefront"); __builtin_amdgcn_wave_barrier(); __builtin_amdgcn_fence(__ATOMIC_ACQUIRE, "wavefront");
    }
}
__device__ __forceinline__ void phase_scan_direct(const Ctx& c) {
    float* wl = (float*)(c.lds + c.wave * 8192);
    for (int t = c.gwv; t < 512 + 256; t += c.NGW) { if (t < 512) s5_direct_task(c, t, wl); else gdn_direct_task(c, t - 512, wl); }
}

__device__ __forceinline__ void phase_combine(const Ctx& c) {
    const Args& a = *c.a;
    const bf16* OG0 = (const bf16*)(c.ws + WS_OG); const bf16* OG1 = OG0 + (size_t)ML * 512; const bf16* Z = (const bf16*)(c.ws + WS_Z);
    const bf16* YS0 = (const bf16*)(c.ws + WS_YS5); const bf16* YS1 = YS0 + (size_t)ML * 512; const bf16* U = (const bf16*)(c.ws + WS_U);
    bf16* CAT = (bf16*)(c.ws + WS_CAT); bf16* YG = (bf16*)(c.ws + WS_YG);
    for (int row = c.gw; row < ML; row += c.NGW) {
#pragma unroll
        for (int h = 0; h < 4; ++h) { const int ch = h * 128 + 2 * c.lane;
            const unsigned w0 = *(const unsigned*)(OG0 + (size_t)row * 512 + ch), w1 = *(const unsigned*)(OG1 + (size_t)row * 512 + ch), zw = *(const unsigned*)(Z + (size_t)row * 512 + ch);
            const float o0 = bflo(w0) + bflo(w1), o1 = bfhi(w0) + bfhi(w1);
            const float r = rsqrtf(wave_sum(o0 * o0 + o1 * o1) * (1.f / 128.f) + EPS);
            const f32x2 ng = *(const f32x2*)(a.in[I_GDNNORM] + 2 * c.lane);
            *(unsigned*)(CAT + (size_t)row * 1024 + 512 + ch) = pk2(o0 * r * ng.x * siluf_(bflo(zw)), o1 * r * ng.y * siluf_(bfhi(zw))); }
        { const int ch = 8 * c.lane;
            const v4u uu = *(const v4u*)(U + (size_t)row * 512 + ch), y0 = *(const v4u*)(YS0 + (size_t)row * 512 + ch), y1 = *(const v4u*)(YS1 + (size_t)row * 512 + ch);
            const f32x4 d0 = *(const f32x4*)(a.in[I_S5D] + ch), d1 = *(const f32x4*)(a.in[I_S5D] + ch + 4);
            const unsigned uw[4] = {uu.x, uu.y, uu.z, uu.w}, a0[4] = {y0.x, y0.y, y0.z, y0.w}, a1[4] = {y1.x, y1.y, y1.z, y1.w}; const float dd[8] = {d0.x, d0.y, d0.z, d0.w, d1.x, d1.y, d1.z, d1.w};
            float o[8];
#pragma unroll
            for (int e = 0; e < 8; ++e) { const float uv = (e & 1) ? bfhi(uw[e >> 1]) : bflo(uw[e >> 1]); const float ya = (e & 1) ? bfhi(a0[e >> 1]) : bflo(a0[e >> 1]); const float yb = (e & 1) ? bfhi(a1[e >> 1]) : bflo(a1[e >> 1]);
                o[e] = gelu_erf(uv * dd[e] + ya + yb); }
            v4u w; w.x = pk2(o[0], o[1]); w.y = pk2(o[2], o[3]); w.z = pk2(o[4], o[5]); w.w = pk2(o[6], o[7]);
            *(v4u*)(YG + (size_t)row * 512 + ch) = w; }
    }
}

__device__ __forceinline__ void phase_rows2(const Ctx& c) {
    const Args& a = *c.a;
    const float* MOD = (const float*)(c.ws + WS_MOD); const float* YRAW = (const float*)(c.ws + WS_YRAW); bf16* HX2 = (bf16*)(c.ws + WS_HX2);
    for (int row = c.gw; row < ML; row += c.NGW) {
        const float* mr = MOD + (row >> 11) * 6144;
        f32x4 y[4], x[4]; float ss = 0.f;
#pragma unroll
        for (int j = 0; j < 4; ++j) { y[j] = *((const f32x4*)(YRAW + (size_t)row * D) + c.lane + 64 * j); x[j] = *((const f32x4*)(a.in[I_X] + (size_t)row * D) + c.lane + 64 * j);
            ss += (y[j].x * y[j].x + y[j].y * y[j].y) + (y[j].z * y[j].z + y[j].w * y[j].w); }
        const float r = rsqrtf(wave_sum(ss) * (1.f / D) + EPS); float s2 = 0.f;
#pragma unroll
        for (int j = 0; j < 4; ++j) { const int col = 4 * c.lane + 256 * j;
            const f32x4 g4 = *(const f32x4*)(a.in[I_GPOSTMIX] + col), gt = *(const f32x4*)(mr + 2048 + col);
            x[j] = x[j] + gt * ((y[j] * r) * g4);
            *(f32x4*)(a.out + (size_t)row * D + col) = x[j];
            s2 += (x[j].x * x[j].x + x[j].y * x[j].y) + (x[j].z * x[j].z + x[j].w * x[j].w); }
        const float r2 = rsqrtf(wave_sum(s2) * (1.f / D) + EPS);
#pragma unroll
        for (int j = 0; j < 4; ++j) { const int col = 4 * c.lane + 256 * j;
            const f32x4 g4 = *(const f32x4*)(a.in[I_GPREFFN] + col), sh = *(const f32x4*)(mr + 3072 + col), scl = *(const f32x4*)(mr + 4096 + col);
            const f32x4 hv = (x[j] * r2) * g4 * (scl + 1.f) + sh;
            v2u o; o.x = pk2(hv.x, hv.y); o.y = pk2(hv.z, hv.w);
            *(v2u*)(HX2 + (size_t)row * D + col) = o; }
    }
}

constexpr int KROW = 136;
__device__ __forceinline__ void phase_topk(const Ctx& c) {
    const Args& a = *c.a;
    bf16* kl = (bf16*)c.lds;
    unsigned char* wbase = c.lds + 2 * 128 * KROW * 2 + c.wave * 1024;
    bf16* qs = (bf16*)wbase;
    float* s1 = (float*)(wbase + 512); int* i1 = (int*)(wbase + 576); float* s2 = (float*)(wbase + 640); int* i2 = (int*)(wbase + 704);
    const bf16* QP = (const bf16*)(c.ws + WS_QP); int* IDX = (int*)(c.ws + WS_IDX); float* GATE = (float*)(c.ws + WS_GATE);
    for (int item = c.bid; item < 8 * 32; item += c.G) {
        const int h = item & 7, tr = item >> 3;
        __syncthreads();
        for (int i = c.tid; i < 2 * 128 * 64; i += NTHREADS) { const int k2 = i & 63, n = (i >> 6) & 127, p = i >> 13; const f32x2 kv = *(const f32x2*)(a.in[I_KEYS] + ((size_t)((h * 2 + p) * 128 + n)) * 128 + 2 * k2);
            *(unsigned*)(kl + (p * 128 + n) * KROW + 2 * k2) = pk2(kv.x, kv.y); }
        __syncthreads();
        for (int tt = c.wave; tt < 512; tt += NWAVES) {
            const int tok = tr * 512 + tt;
            *(v2u*)(qs + 4 * c.lane) = *(const v2u*)(QP + (size_t)tok * 2048 + h * 256 + 4 * c.lane);
            __builtin_amdgcn_fence(__ATOMIC_RELEASE, "wavefront"); __builtin_amdgcn_wave_barrier(); __builtin_amdgcn_fence(__ATOMIC_ACQUIRE, "wavefront");
            float sc[2][2];
#pragma unroll
            for (int p = 0; p < 2; ++p) { float sa = 0.f, sb = 0.f;
#pragma unroll
                for (int kk = 0; kk < 16; ++kk) { const v4u q8 = *(const v4u*)(qs + p * 128 + kk * 8), ka = *(const v4u*)(kl + (p * 128 + c.lane) * KROW + kk * 8), kb = *(const v4u*)(kl + (p * 128 + c.lane + 64) * KROW + kk * 8);
                    const unsigned qw[4] = {q8.x, q8.y, q8.z, q8.w}, aw[4] = {ka.x, ka.y, ka.z, ka.w}, bw[4] = {kb.x, kb.y, kb.z, kb.w};
#pragma unroll
                    for (int e = 0; e < 4; ++e) { sa = fmaf(bflo(qw[e]), bflo(aw[e]), sa); sa = fmaf(bfhi(qw[e]), bfhi(aw[e]), sa); sb = fmaf(bflo(qw[e]), bflo(bw[e]), sb); sb = fmaf(bfhi(qw[e]), bfhi(bw[e]), sb); } }
                sc[p][0] = sa; sc[p][1] = sb; }
#pragma unroll
            for (int p = 0; p < 2; ++p) { float va = sc[p][0], vb = sc[p][1]; float* so = p ? s2 : s1; int* io = p ? i2 : i1;
                for (int r = 0; r < 16; ++r) { const float m = fmaxf(va, vb), wm = wave_max(m); const unsigned long long bal = __ballot(m == wm); const int wl = __ffsll((long long)bal) - 1;
                    if (c.lane == wl) { const bool fa = (va == wm); so[r] = wm; io[r] = fa ? c.lane : c.lane + 64; if (fa) va = -INFINITY; else vb = -INFINITY; } } }
            __builtin_amdgcn_fence(__ATOMIC_RELEASE, "wavefront"); __builtin_amdgcn_wave_barrier(); __builtin_amdgcn_fence(__ATOMIC_ACQUIRE, "wavefront");
            const int ci = c.lane >> 2, cj = 4 * (c.lane & 3);
            float cv[4]; const float base = s1[ci];
#pragma unroll
            for (int e = 0; e < 4; ++e) cv[e] = base + s2[cj + e];
            float my_s = 0.f; int my_i = 0;
            for (int r = 0; r < 16; ++r) { const float m = fmaxf(fmaxf(cv[0], cv[1]), fmaxf(cv[2], cv[3])), wm = wave_max(m); const unsigned long long bal = __ballot(m == wm); const int wl = __ffsll((long long)bal) - 1;
                int sel = -1;
                if (c.lane == wl) { sel = (cv[0] == wm) ? 0 : (cv[1] == wm) ? 1 : (cv[2] == wm) ? 2 : 3;
#pragma unroll
                    for (int e = 0; e < 4; ++e) if (e == sel) cv[e] = -INFINITY; }
                const int selw = __shfl(sel, wl); const int eidx = i1[wl >> 2] * 128 + i2[4 * (wl & 3) + selw];
                if (c.lane == r) { my_s = wm; my_i = eidx; } }
            const float mx = __shfl(my_s, 0); const float ex = c.lane < 16 ? __expf(my_s - mx) : 0.f; const float den = wave_sum(ex);
            if (c.lane < 16) { IDX[(size_t)tok * 128 + h * 16 + c.lane] = my_i; GATE[(size_t)tok * 128 + h * 16 + c.lane] = ex / den; }
            __builtin_amdgcn_fence(__ATOMIC_RELEASE, "wavefront"); __builtin_amdgcn_wave_barrier(); __builtin_amdgcn_fence(__ATOMIC_ACQUIRE, "wavefront");
        }
    }
}

__device__ __forceinline__ void phase_experts(const Ctx& c) {
    const Args& a = *c.a;
    const float* MOD = (const float*)(c.ws + WS_MOD); const bf16* HX2 = (const bf16*)(c.ws + WS_HX2); const int* IDX = (const int*)(c.ws + WS_IDX); const float* GATE = (const float*)(c.ws + WS_GATE);
    float* acts = (float*)c.lds; int* eid = (int*)(c.lds + 512); float* red = (float*)(c.lds + 1024);
    for (int tok = c.bid; tok < ML; tok += c.G) {
        float hv[16];
#pragma unroll
        for (int j = 0; j < 4; ++j) { const v2u w = *(const v2u*)(HX2 + (size_t)tok * D + 4 * c.lane + 256 * j); hv[4 * j] = bflo(w.x); hv[4 * j + 1] = bfhi(w.x); hv[4 * j + 2] = bflo(w.y); hv[4 * j + 3] = bfhi(w.y); }
#pragma unroll 4
        for (int i = 0; i < 16; ++i) { const int k = c.wave * 16 + i; const int e = IDX[(size_t)tok * 128 + k];
            const f32x4* ur = (const f32x4*)(a.in[I_PU] + (size_t)e * D) + c.lane; float s = 0.f;
#pragma unroll
            for (int j = 0; j < 4; ++j) { const f32x4 u4 = ur[64 * j]; s += (u4.x * hv[4 * j] + u4.y * hv[4 * j + 1]) + (u4.z * hv[4 * j + 2] + u4.w * hv[4 * j + 3]); }
            s = wave_sum(s);
            if (c.lane == 0) { acts[k] = gelu_erf(s) * GATE[(size_t)tok * 128 + k]; eid[k] = e; } }
        __syncthreads();
        f32x2 acc = (f32x2){0.f, 0.f};
#pragma unroll 8
        for (int k = 0; k < 128; ++k) { const f32x2 v2 = *(const f32x2*)(a.in[I_PV] + (size_t)eid[k] * D + 2 * c.tid); const float ak = acts[k]; acc.x = fmaf(ak, v2.x, acc.x); acc.y = fmaf(ak, v2.y, acc.y); }
        const float ws = wave_sum(acc.x * acc.x + acc.y * acc.y);
        if (c.lane == 0) red[c.wave] = ws;
        __syncthreads();
        float tot = 0.f;
#pragma unroll
        for (int w = 0; w < 8; ++w) tot += red[w];
        const float r = rsqrtf(tot * (1.f / D) + EPS);
        const int col = 2 * c.tid; const float* mr = MOD + (tok >> 11) * 6144 + 5120;
        const f32x2 x1 = *(const f32x2*)(a.out + (size_t)tok * D + col), g2 = *(const f32x2*)(a.in[I_GPOSTFFN] + col), gt = *(const f32x2*)(mr + col);
        *(f32x2*)(a.out + (size_t)tok * D + col) = (f32x2){x1.x + gt.x * (acc.x * r * g2.x), x1.y + gt.y * (acc.y * r * g2.y)};
        __syncthreads();
    }
}

__global__ void __launch_bounds__(NTHREADS, 2) mk_fwd(Args args) {
    extern __shared__ __attribute__((aligned(16))) unsigned char lds[];
    Ctx c; c.a = &args; c.ws = args.ws; c.lds = lds;
    c.tid = threadIdx.x; c.lane = c.tid & 63; c.wave = __builtin_amdgcn_readfirstlane(c.tid >> 6); c.bid = blockIdx.x; c.G = gridDim.x;
    c.gw = c.bid * NWAVES + c.wave; c.NGW = c.G * NWAVES; c.gwv = c.wave * c.G + c.bid;
    const int lo = args.ph_lo, hi = args.ph_hi;
    PG8_LAS unsigned char* ring = (PG8_LAS unsigned char*)lds;
#ifndef MK_PH_MASK
#define MK_PH_MASK 0xfff
#endif
#define IN(k) (((MK_PH_MASK >> (k)) & 1) && lo <= (k) && (k) < hi)
#if MK_ONE_LAUNCH
    cg::grid_group grid = cg::this_grid();
#define SEAM(k) do { if (IN(k) && IN((k) + 1)) grid.sync(); } while (0)
#else
#define SEAM(k) do { } while (0)
#endif
    if (IN(0)) { phase_prep(c); } SEAM(0);
    if (IN(1)) { phase_norm1(c); } SEAM(1);
    if (IN(2)) { pg8::Gemm g{(const pg8::bf16_t*)(c.ws + WS_HX), (const pg8::bf16_t*)(c.ws + WS_WIN), 1024, 1024, 1024}; pg8::StaticOrder S; S.init(MT, NPROJ, c.G, c.bid);
        pg8::EpiInProj E{(pg8::bf16_t*)(c.ws + WS_U), (pg8::bf16_t*)(c.ws + WS_QKVPRE), (pg8::bf16_t*)(c.ws + WS_Z)};
        pg8::gemm_phase<pg8::EpiInProj, pg8::StaticOrder, true, true>(ring, g, S, E); } SEAM(2);
    if (IN(3)) { phase_conv(c); } SEAM(3);
    if (IN(4)) { phase_scan_direct(c); } SEAM(4);
    if (IN(5)) { phase_combine(c); } SEAM(5);
    if (IN(6)) { pg8::Gemm g{(const pg8::bf16_t*)(c.ws + WS_YG), (const pg8::bf16_t*)(c.ws + WS_WGLU), 512, 512, 512}; pg8::StaticOrder S; S.init(ML, 512, c.G, c.bid);
        pg8::EpiGlu E{(const pg8::bf16_t*)(c.ws + WS_YG), (pg8::bf16_t*)(c.ws + WS_CAT)};
        pg8::gemm_phase<pg8::EpiGlu, pg8::StaticOrder, true, true>(ring, g, S, E); } SEAM(6);
    if (IN(7)) { pg8::Gemm g{(const pg8::bf16_t*)(c.ws + WS_CAT), (const pg8::bf16_t*)(c.ws + WS_WOUT), 1024, 1024, 1024}; pg8::StaticOrder S; S.init(ML, 1024, c.G, c.bid);
        pg8::EpiF32 E{(float*)(c.ws + WS_YRAW), 1024};
        pg8::gemm_phase<pg8::EpiF32, pg8::StaticOrder, true, true>(ring, g, S, E); } SEAM(7);
    if (IN(8)) { phase_rows2(c); } SEAM(8);
    if (IN(9)) { pg8::Gemm g{(const pg8::bf16_t*)(c.ws + WS_HX2), (const pg8::bf16_t*)(c.ws + WS_WQ), 1024, 1024, 1024}; pg8::StaticOrder S; S.init(ML, 2048, c.G, c.bid);
        pg8::EpiBf16<0> E{(pg8::bf16_t*)(c.ws + WS_QP), 2048, nullptr, 0, 0, 1.f};
        pg8::gemm_phase<pg8::EpiBf16<0>, pg8::StaticOrder, true, true>(ring, g, S, E); } SEAM(9);
    if (IN(10)) { phase_topk(c); } SEAM(10);
    if (IN(11)) { phase_experts(c); }
#undef IN
#undef SEAM
}

extern "C" void kernel_launch(void* const* d_in, const int* in_sizes, int n_in, void* d_out, int out_size, void* d_ws, size_t ws_size, hipStream_t stream) {
    static int grid = 0;
    if (grid == 0) {
        if (n_in != 29 || out_size != ML * D || ws_size < WS_END) { fprintf(stderr, "kernel_launch: unexpected shapes (n_in %d out %d ws %zu)\n", n_in, out_size, ws_size); grid = -1; return; }
        int dev = 0, cus = 0, per_cu = 0;
        hipGetDevice(&dev); hipDeviceGetAttribute(&cus, hipDeviceAttributeMultiprocessorCount, dev);
        if (hipFuncSetAttribute((const void*)mk_fwd, hipFuncAttributeMaxDynamicSharedMemorySize, LDS_BYTES) != hipSuccess) { fprintf(stderr, "kernel_launch: hipFuncSetAttribute failed\n"); grid = -1; return; }
        hipOccupancyMaxActiveBlocksPerMultiprocessor(&per_cu, (const void*)mk_fwd, NTHREADS, LDS_BYTES);
        (void)hipGetLastError();
        if (per_cu < 1) per_cu = 1;
        grid = cus * 1;
        fprintf(stderr, "kernel_launch: cus %d per_cu %d grid %d\n", cus, per_cu, grid);
    }
    if (grid < 0) return;
    Args a{};
    for (int i = 0; i < 29; ++i) a.in[i] = (const float*)d_in[i];
    a.out = (float*)d_out; a.ws = (unsigned char*)d_ws;
#if MK_ONE_LAUNCH
    a.ph_lo = 0; a.ph_hi = NPHASES;
    void* kargs[] = {&a};
    hipError_t e = hipLaunchCooperativeKernel((const void*)mk_fwd, dim3(grid), dim3(NTHREADS), kargs, LDS_BYTES, stream);
    if (e != hipSuccess) fprintf(stderr, "kernel_launch: cooperative launch failed: %s\n", hipGetErrorString(e));
#else
    for (int ph = 0; ph < NPHASES; ++ph) { a.ph_lo = ph; a.ph_hi = ph + 1; hipLaunchKernelGGL(mk_fwd, dim3(grid), dim3(NTHREADS), LDS_BYTES, stream, a); }
#endif
}
```

```cpp
#include <hip/hip_runtime.h>
#include <hip/hip_cooperative_groups.h>
#include <cstdio>
#include <cstdint>
namespace cg = cooperative_groups;
namespace pg8 {
#define PG8_LAS __attribute__((address_space(3)))
typedef unsigned short bf16_t;
typedef short bf16x8 __attribute__((ext_vector_type(8)));
typedef float f32x4 __attribute__((ext_vector_type(4)));
typedef unsigned u32x4 __attribute__((ext_vector_type(4)));
constexpr int BM = 256, BK = 64, HALF = 128, HTB = HALF * BK * 2  , STAGE_BYTES = 8 * HTB, NXCD = 8, WGM = 8;

__host__ __device__ __forceinline__ int lds_byte(int r, int c) { const int st = (r >> 4) * 2 + (c >> 5), rr = r & 15, cc = c & 31, ob = rr * 64 + cc * 2; return st * 1024 + (ob ^ (((ob >> 9) & 1) << 5)); }
__host__ __device__ __forceinline__ void stage_rc(int b, int& R, int& C) { const int st = b / 1024, sb = b % 1024, swz = sb ^ (((sb >> 9) & 1) << 5); R = (st >> 1) * 16 + swz / 64; C = (st & 1) * 32 + (swz % 64) / 2; }
__host__ __device__ __forceinline__ int perm32(int rho) { const int n = rho >> 4, i = rho & 15; return 8 * (i >> 2) + 4 * n + (i & 3); }

struct Unit { int pm, pn; };
struct Gemm { const bf16_t* A; const bf16_t* Bt; int lda, ldb, K; };

struct StaticOrder {
    int nM, nN, nwg, G, c;
    __host__ __device__ void init(int M, int N, int G_, int c_) { nM = M / BM; nN = N / BM; nwg = nM * nN; G = G_; c = c_; }
    __host__ __device__ bool next(int i, Unit& u) const {
        const long L = (long)i * G + c; if (L >= nwg) return false;
        int wgid = (int)L; { const int q = nwg / NXCD, r = nwg % NXCD, xcd = wgid % NXCD, off = wgid / NXCD; wgid = (xcd < r ? xcd * (q + 1) : r * (q + 1) + (xcd - r) * q) + off; }
        const int nig = WGM * nN, gid = wgid / nig, fm = gid * WGM, gsz = (nM - fm) < WGM ? (nM - fm) : WGM;
        u.pm = fm + ((wgid % nig) % gsz); u.pn = (wgid % nig) / gsz; return true;
    }
    __device__ __forceinline__ void a_ready(const Unit&) const {}
    __device__ __forceinline__ void done(const Unit&) const {}
};

__device__ __forceinline__ unsigned cvt_pk_bf16(float lo, float hi) { unsigned r; asm volatile("v_cvt_pk_bf16_f32 %0, %1, %2" : "=v"(r) : "v"(lo), "v"(hi)); return r; }
typedef float f32x2 __attribute__((ext_vector_type(2)));
__device__ __forceinline__ f32x2 gelu_pk(f32x2 v) {
    const f32x2 av = __builtin_elementwise_abs(v), d = av * 0.2316418882f + 1.0f;
    f32x2 t; t.x = __builtin_amdgcn_rcpf(d.x); t.y = __builtin_amdgcn_rcpf(d.y);
    f32x2 q = t * 0.5307027145f + (-0.7265760135f); q = q * t + 0.7107068705f; q = q * t + (-0.142248368f); q = q * t + 0.127414796f; q = q * t;
    const f32x2 s = (v * v) * (-0.72134752044f);
    f32x2 e; e.x = __builtin_amdgcn_exp2f(s.x); e.y = __builtin_amdgcn_exp2f(s.y);
    const f32x2 m = v * (q * e), r = v - m;
    f32x2 o; o.x = v.x < 0.f ? m.x : r.x; o.y = v.y < 0.f ? m.y : r.y; return o;
}

template <int ACT  > struct EpiBf16 {
    static constexpr bool PERM = true, AFTER_DRAIN = false; static_assert(ACT == 0 || ACT == 1, "EpiBf16: ACT is 0 (none) or 1 (gelu_pk)");
    bf16_t* O; int ldc; const float* bias; int split_cols; size_t split_stride; float scale0;
    __device__ __forceinline__ void operator()(const f32x4 (&acc)[2][2][4][2], const Unit& u, int wr, int wc, int fr, int fq) const {
        const int row0 = u.pm * BM + wr * 64 + fr; int colt = u.pn * BM; bf16_t* base = O;
        float sc = 1.f; if (split_cols) { const int t = colt / split_cols; base += (size_t)t * split_stride; colt -= t * split_cols; if (t == 0) sc = scale0; }
        const int col0 = colt + wc * 32 + 8 * fq, bcol0 = u.pn * BM + wc * 32 + 8 * fq;
        f32x4 bv[2][2];
#pragma unroll
        for (int bj = 0; bj < 2; ++bj)
#pragma unroll
            for (int n = 0; n < 2; ++n) bv[bj][n] = bias ? *(const f32x4*)(bias + bcol0 + bj * HALF + 4 * n) : (f32x4){0.f, 0.f, 0.f, 0.f};
#pragma unroll
        for (int ai = 0; ai < 2; ++ai)
#pragma unroll
            for (int m = 0; m < 4; ++m) { bf16_t* rowp = base + (size_t)(row0 + ai * HALF + m * 16) * ldc + col0;
#pragma unroll
                for (int bj = 0; bj < 2; ++bj) { f32x4 v0 = acc[ai][bj][m][0] + bv[bj][0], v1 = acc[ai][bj][m][1] + bv[bj][1];
                    if (ACT == 1) { f32x2 a = gelu_pk((f32x2){v0[0], v0[1]}), b = gelu_pk((f32x2){v0[2], v0[3]}), c = gelu_pk((f32x2){v1[0], v1[1]}), d = gelu_pk((f32x2){v1[2], v1[3]});
                        v0 = (f32x4){a.x, a.y, b.x, b.y}; v1 = (f32x4){c.x, c.y, d.x, d.y}; }
                    v0 = v0 * sc; v1 = v1 * sc; u32x4 w; w.x = cvt_pk_bf16(v0[0], v0[1]); w.y = cvt_pk_bf16(v0[2], v0[3]); w.z = cvt_pk_bf16(v1[0], v1[1]); w.w = cvt_pk_bf16(v1[2], v1[3]);
                    *(u32x4*)(rowp + bj * HALF) = w; } }
    }
};

template <class Epi, class Sched, bool ALIGN_EPI = false, bool SP2 = false>
__device__ __forceinline__ void gemm_phase(PG8_LAS unsigned char* lds, const Gemm g, const Sched& S, const Epi& E) {
    const int tid = threadIdx.x, wid = __builtin_amdgcn_readfirstlane(tid >> 6), lane = tid & 63, wr = wid >> 2, wc = wid & 3, fr = lane & 15, fq = lane >> 4;
    const int K = g.K, nt = K / BK;
    unsigned voffA[2], voffB[2];
#pragma unroll
    for (int i = 0; i < 2; ++i) { int R, C; stage_rc(tid * 16 + i * 8192, R, C); const int Rb = Epi::PERM ? ((R & ~31) + perm32(R & 31)) : R;
        voffA[i] = (unsigned)(R * g.lda + C) * 2u; voffB[i] = (unsigned)(Rb * g.ldb + C) * 2u; }
    const size_t kstep = (size_t)(BK * 2);
    const size_t hstepA = (size_t)HALF * g.lda * 2, hstepB = (size_t)HALF * g.ldb * 2;
    const size_t tstepA = 2 * hstepA, tstepB = 2 * hstepB;
    const unsigned ldsw = (unsigned)wid * 1024u;
    const int aoff = lds_byte(wr * 64 + fr, fq * 8), boff = lds_byte(wc * 32 + fr, fq * 8);
#define PG8_SA(b, h) (((b) * 2 + (h)) * HTB)
#define PG8_SB(b, h) ((4 + (b) * 2 + (h)) * HTB)
#define PG8_STAGE(bufoff, gbase, voff) do { _Pragma("unroll") for (int _i = 0; _i < 2; ++_i) \
        __builtin_amdgcn_global_load_lds((const unsigned*)((const char*)(gbase) + (voff)[_i]), (PG8_LAS unsigned*)(lds + (bufoff) + ldsw + _i * 8192), 16, 0, 0); } while (0)
#define PG8_LDA(dst, b, h) do { _Pragma("unroll") for (int m = 0; m < 4; ++m) _Pragma("unroll") for (int k = 0; k < 2; ++k) dst[m][k] = *(const PG8_LAS bf16x8*)(lds + PG8_SA(b, h) + aoff + m * 2048 + k * 1024); } while (0)
#define PG8_LDB(dst, b, h) do { _Pragma("unroll") for (int n = 0; n < 2; ++n) _Pragma("unroll") for (int k = 0; k < 2; ++k) dst[n][k] = *(const PG8_LAS bf16x8*)(lds + PG8_SB(b, h) + boff + n * 2048 + k * 1024); } while (0)
#define PG8_MMA(ai, bj, At, Bt) do { __builtin_amdgcn_s_setprio(1); _Pragma("unroll") for (int m = 0; m < 4; ++m) _Pragma("unroll") for (int n = 0; n < 2; ++n) _Pragma("unroll") for (int k = 0; k < 2; ++k) \
        acc[ai][bj][m][n] = __builtin_amdgcn_mfma_f32_16x16x32_bf16(Bt[n][k], At[m][k], acc[ai][bj][m][n], 0, 0, 0); __builtin_amdgcn_s_setprio(0); } while (0)
#define PG8_WAIT_V(n) asm volatile("s_waitcnt vmcnt(" #n ")" ::: "memory")
#define PG8_WAIT_L(n) asm volatile("s_waitcnt lgkmcnt(" #n ")" ::: "memory")
#define PG8_BAR __builtin_amdgcn_s_barrier()
#define PG8_SCHED __builtin_amdgcn_sched_barrier(0)
    Unit cur, nxt; int ui = 0;
    if (!S.next(0, cur)) return;
    f32x4 acc[2][2][4][2];
#pragma unroll
    for (int a = 0; a < 2; ++a)
#pragma unroll
        for (int b = 0; b < 2; ++b)
#pragma unroll
            for (int m = 0; m < 4; ++m)
#pragma unroll
                for (int n = 0; n < 2; ++n) acc[a][b][m][n] = (f32x4){0.f, 0.f, 0.f, 0.f};
    bf16x8 At[4][2], B0[2][2], B1[2][2];
    const char* cA = (const char*)g.A + (size_t)cur.pm * tstepA; const char* cB = (const char*)g.Bt + (size_t)cur.pn * tstepB;
    S.a_ready(cur);
    if constexpr (SP2) {
        PG8_STAGE(PG8_SB(0, 0), cB, voffB); PG8_STAGE(PG8_SB(0, 1), cB + hstepB, voffB); PG8_STAGE(PG8_SA(0, 0), cA, voffA); PG8_STAGE(PG8_SA(0, 1), cA + hstepA, voffA);
        if (wr == 1) PG8_BAR;
        PG8_WAIT_V(2); PG8_BAR;
        PG8_STAGE(PG8_SB(1, 0), cB + kstep, voffB); PG8_STAGE(PG8_SA(1, 0), cA + kstep, voffA); PG8_STAGE(PG8_SB(1, 1), cB + hstepB + kstep, voffB);
        PG8_WAIT_V(6); PG8_BAR;
    } else {
        PG8_STAGE(PG8_SB(0, 0), cB, voffB); PG8_STAGE(PG8_SA(0, 0), cA, voffA); PG8_STAGE(PG8_SB(0, 1), cB + hstepB, voffB); PG8_STAGE(PG8_SA(0, 1), cA + hstepA, voffA);
        if (wr == 1) PG8_BAR;
        PG8_WAIT_V(4); PG8_BAR;
        PG8_STAGE(PG8_SB(1, 0), cB + kstep, voffB); PG8_STAGE(PG8_SA(1, 0), cA + kstep, voffA); PG8_STAGE(PG8_SB(1, 1), cB + hstepB + kstep, voffB);
        PG8_WAIT_V(6); PG8_BAR;
    }
    for (;;) {
        const bool has_next = S.next(ui + 1, nxt);
        const char* nA = has_next ? (const char*)g.A + (size_t)nxt.pm * tstepA : cA; const char* nB = has_next ? (const char*)g.Bt + (size_t)nxt.pn * tstepB : cB;
        for (int t = 0; t < nt; t += 2) {
            const bool last = (t == nt - 2);
            const char* a1 = cA + (size_t)(t + 1) * kstep;
            const char* a2 = last ? nA : cA + (size_t)(t + 2) * kstep; const char* b2 = last ? nB : cB + (size_t)(t + 2) * kstep;
            const char* a3 = a2 + kstep; const char* b3 = b2 + kstep;
            if (last && has_next) S.a_ready(nxt);
            if constexpr (SP2) {
            PG8_LDB(B0, 0, 0); PG8_LDB(B1, 0, 1); PG8_SCHED; PG8_LDA(At, 0, 0); PG8_STAGE(PG8_SA(1, 1), a1 + hstepA, voffA);
            PG8_WAIT_V(8); PG8_WAIT_L(0); PG8_BAR; PG8_MMA(0, 0, At, B0); PG8_MMA(0, 1, At, B1); PG8_BAR; PG8_SCHED;
            PG8_LDA(At, 0, 1); PG8_STAGE(PG8_SB(0, 0), b2, voffB); PG8_STAGE(PG8_SB(0, 1), b2 + hstepB, voffB); PG8_STAGE(PG8_SA(0, 0), a2, voffA);
            PG8_WAIT_V(8); PG8_WAIT_L(0); PG8_BAR; PG8_MMA(1, 0, At, B0); PG8_MMA(1, 1, At, B1); PG8_BAR; PG8_SCHED;
            PG8_LDB(B0, 1, 0); PG8_LDB(B1, 1, 1); PG8_SCHED; PG8_LDA(At, 1, 0); PG8_STAGE(PG8_SA(0, 1), a2 + hstepA, voffA);
            PG8_WAIT_V(8); PG8_WAIT_L(0); PG8_BAR; PG8_MMA(0, 0, At, B0); PG8_MMA(0, 1, At, B1); PG8_BAR; PG8_SCHED;
            PG8_LDA(At, 1, 1); PG8_STAGE(PG8_SB(1, 0), b3, voffB); PG8_STAGE(PG8_SB(1, 1), b3 + hstepB, voffB); PG8_STAGE(PG8_SA(1, 0), a3, voffA);
            PG8_WAIT_V(8); PG8_WAIT_L(0); PG8_BAR; PG8_MMA(1, 0, At, B0); PG8_MMA(1, 1, At, B1); PG8_BAR; PG8_SCHED;
            } else {
            PG8_LDB(B0, 0, 0); PG8_SCHED; PG8_LDA(At, 0, 0); PG8_STAGE(PG8_SA(1, 1), a1 + hstepA, voffA);
            PG8_WAIT_L(8); PG8_BAR; PG8_WAIT_L(0); PG8_MMA(0, 0, At, B0); PG8_BAR; PG8_SCHED;
            PG8_LDB(B1, 0, 1); PG8_STAGE(PG8_SB(0, 0), b2, voffB);
            PG8_BAR; PG8_WAIT_L(0); PG8_MMA(0, 1, At, B1); PG8_BAR;
            PG8_LDA(At, 0, 1); PG8_STAGE(PG8_SA(0, 0), a2, voffA);
            PG8_BAR; PG8_WAIT_L(0); PG8_MMA(1, 0, At, B0); PG8_BAR; PG8_SCHED;
            PG8_STAGE(PG8_SB(0, 1), b2 + hstepB, voffB);
            PG8_WAIT_V(6); PG8_BAR; PG8_MMA(1, 1, At, B1); PG8_BAR;
            PG8_LDB(B0, 1, 0); PG8_SCHED; PG8_LDA(At, 1, 0); PG8_STAGE(PG8_SA(0, 1), a2 + hstepA, voffA);
            PG8_WAIT_L(8); PG8_BAR; PG8_WAIT_L(0); PG8_MMA(0, 0, At, B0); PG8_BAR; PG8_SCHED;
            PG8_LDB(B1, 1, 1); PG8_STAGE(PG8_SB(1, 0), b3, voffB);
            PG8_BAR; PG8_WAIT_L(0); PG8_MMA(0, 1, At, B1); PG8_BAR;
            PG8_LDA(At, 1, 1); PG8_STAGE(PG8_SA(1, 0), a3, voffA);
            PG8_BAR; PG8_WAIT_L(0); PG8_MMA(1, 0, At, B0); PG8_BAR; PG8_SCHED;
            PG8_STAGE(PG8_SB(1, 1), b3 + hstepB, voffB);
            PG8_WAIT_V(6); PG8_BAR; PG8_MMA(1, 1, At, B1); PG8_BAR;
            }
        }
        if constexpr (ALIGN_EPI) { if (wr == 0) PG8_BAR; }
        if constexpr (!Epi::AFTER_DRAIN) { E(acc, cur, wr, wc, fr, fq); S.done(cur); }
        if (!has_next) break;
#pragma unroll
        for (int a = 0; a < 2; ++a)
#pragma unroll
            for (int b = 0; b < 2; ++b)
#pragma unroll
                for (int m = 0; m < 4; ++m)
#pragma unroll
                    for (int n = 0; n < 2; ++n) acc[a][b][m][n] = (f32x4){0.f, 0.f, 0.f, 0.f};
        cur = nxt; cA = nA; cB = nB; ++ui;
        if constexpr (ALIGN_EPI) { if (wr == 1) PG8_BAR; }
    }
    PG8_WAIT_V(0);
    if constexpr (!ALIGN_EPI) { if (wr == 0) PG8_BAR; }
    PG8_BAR;
    if constexpr (Epi::AFTER_DRAIN) { E.fused(acc, cur, wr, wc, fr, fq, lds, wid, lane); S.done(cur); }
#undef PG8_SA
#undef PG8_SB
#undef PG8_STAGE
#undef PG8_LDA
#undef PG8_LDB
#undef PG8_MMA
#undef PG8_WAIT_V
#undef PG8_WAIT_L
#undef PG8_BAR
#undef PG8_SCHED
}
}

#ifndef MK_EXP_OLD
#define MK_EXP_OLD 0
#endif
#ifndef MK_ONE_LAUNCH
#define MK_ONE_LAUNCH 1
#endif
#define LAS __attribute__((address_space(3)))
typedef unsigned short bf16;
typedef unsigned v4u __attribute__((ext_vector_type(4)));
typedef unsigned v2u __attribute__((ext_vector_type(2)));
typedef float f32x4 __attribute__((ext_vector_type(4)));
typedef float f32x2 __attribute__((ext_vector_type(2)));

constexpr int D = 1024, NB = 8, SEQ = 2048, LC = 256, ML = NB * SEQ  , MC = NB * LC  , MT = ML + MC  ;
constexpr int PROJ = 2576, NPROJ = 2560;
constexpr int NEXP = 16384, TOPK = 16, KK = 128;
constexpr float EPS = 1e-6f;
constexpr int NTHREADS = 512, NWAVES = 8;
constexpr int LDS_BYTES = 147456;
constexpr int NPHASES = 14;

constexpr size_t MiB = 1u << 20;
constexpr size_t WS_CTL = 0;
constexpr size_t CTL_ZERO_BYTES = 65536;
constexpr int CW_BAR = 0;
constexpr int CW_E1 = 4096, CW_E2 = 4096 + 8 * 64;
constexpr size_t WS_MOD = 1 * MiB;
constexpr size_t WS_WIN = 2 * MiB;
constexpr size_t WS_WOUT = 8 * MiB;
constexpr size_t WS_WGLU = 10 * MiB;
constexpr size_t WS_WQ = 11 * MiB;
constexpr size_t WS_GB = 15 * MiB;
constexpr size_t WS_IDX = 17 * MiB;
constexpr size_t WS_GATE = 26 * MiB;
constexpr size_t WS_HX = 35 * MiB;
constexpr size_t WS_U = 72 * MiB;
constexpr size_t WS_YRAW = 35 * MiB;
constexpr size_t WS_Z = 100 * MiB;
constexpr size_t WS_QKVPRE = 116 * MiB;
constexpr size_t WS_OG = 116 * MiB;
constexpr size_t WS_HX2 = 116 * MiB;
constexpr size_t WS_QKV = 170 * MiB;
constexpr size_t WS_CAT = 170 * MiB;
constexpr size_t WS_YG = 202 * MiB;
constexpr size_t WS_QP = 35 * MiB;
constexpr size_t WS_Y = 35 * MiB;
constexpr size_t WS_ACT = 100 * MiB;
constexpr size_t WS_SSQP = 108 * MiB;
constexpr size_t WS_USC = 109 * MiB;
constexpr size_t WS_VSC = 110 * MiB;
constexpr size_t WS_U8 = 224 * MiB;
constexpr size_t WS_V8 = 240 * MiB;
constexpr size_t WS_YS5 = 224 * MiB;
constexpr size_t WS_END = 256 * MiB;
static_assert(WS_YRAW + (size_t)ML * D * 4 <= WS_Z && WS_Z + (size_t)ML * 512 * 2 <= WS_QKVPRE && WS_QKVPRE + (size_t)MT * 1536 * 2 <= WS_QKV && WS_QKV + (size_t)MT * 1536 * 2 <= WS_YS5, "ws map");
static_assert(WS_QP + (size_t)ML * 2048 * 2 <= WS_Z && WS_YS5 + (size_t)2 * ML * 512 * 2 <= WS_END && WS_YG + (size_t)ML * 512 * 2 <= WS_YS5 && WS_U + (size_t)MT * 512 * 2 <= WS_Z, "ws map 2");
static_assert(WS_GATE + (size_t)ML * 128 * 4 <= WS_HX && WS_IDX + (size_t)ML * 128 * 4 <= WS_GATE && WS_HX + (size_t)MT * D * 2 <= WS_U, "ws map 3");

__device__ __forceinline__ unsigned f2bf(float f) { unsigned u = __builtin_bit_cast(unsigned, f); return (u + 0x7fffu + ((u >> 16) & 1u)) >> 16; }
__device__ __forceinline__ unsigned pk2(float lo, float hi) { return f2bf(lo) | (f2bf(hi) << 16); }
__device__ __forceinline__ float bflo(unsigned w) { return __builtin_bit_cast(float, w << 16); }
__device__ __forceinline__ float bfhi(unsigned w) { return __builtin_bit_cast(float, w & 0xffff0000u); }
__device__ __forceinline__ float bf1(bf16 h) { return __builtin_bit_cast(float, (unsigned)h << 16); }
__device__ __forceinline__ float wave_sum(float v) {
#pragma unroll
    for (int o = 1; o < 64; o <<= 1) v += __shfl_xor(v, o);
    return v;
}
__device__ __forceinline__ float wave_max(float v) {
#pragma unroll
    for (int o = 1; o < 64; o <<= 1) v = fmaxf(v, __shfl_xor(v, o));
    return v;
}
__device__ __forceinline__ float sigmoidf_(float x) { return 1.f / (1.f + __expf(-x)); }
__device__ __forceinline__ float siluf_(float x) { return x / (1.f + __expf(-x)); }
__device__ __forceinline__ float gelu_erf(float x) { return 0.5f * x * (1.f + erff(x * 0.70710678118654752f)); }
__device__ __forceinline__ void sincos_d(double a, float& s, float& c) {
    const double k = rint(a * 0.63661977236758134308);
    const double r = fma(-k, 1.57079632679489661923, a) - k * 6.123233995736766e-17;
    const double r2 = r * r;
    double sp = -2.5052108385441720e-08; sp = sp * r2 + 2.7557319223985893e-06; sp = sp * r2 - 1.9841269841269841e-04; sp = sp * r2 + 8.3333333333333332e-03; sp = sp * r2 - 1.6666666666666666e-01;
    const double sn = r + r * r2 * sp;
    double cp = 2.0876756987868099e-09; cp = cp * r2 - 2.7557319223985888e-07; cp = cp * r2 + 2.4801587301587302e-05; cp = cp * r2 - 1.3888888888888889e-03; cp = cp * r2 + 4.1666666666666664e-02; cp = cp * r2 - 0.5;
    const double cs = 1.0 + r2 * cp;
    const int q = ((int)k) & 3;
    const double ss = (q == 0) ? sn : (q == 1) ? cs : (q == 2) ? -sn : -cs;
    const double cc = (q == 0) ? cs : (q == 1) ? -sn : (q == 2) ? -cs : sn;
    s = (float)ss; c = (float)cc;
}

struct Args { const float* in[29]; float* out; unsigned char* ws; int ph_lo, ph_hi; };
static_assert(sizeof(Args) == 29 * 8 + 8 + 8 + 8, "Args has no padding");
enum { I_X = 0, I_C, I_CTX, I_CCTX, I_WMOD, I_BMOD, I_GPREMIX, I_GPOSTMIX, I_GPREFFN, I_GPOSTFFN, I_WIN, I_WOUT, I_LAMRE, I_LAMIM, I_LOGDT, I_BRE, I_BIM, I_CRE, I_CIM, I_S5D, I_WGLU,
       I_CONV, I_ALOG, I_DTBIAS, I_GDNNORM, I_WQ, I_KEYS, I_PU, I_PV };

__device__ __forceinline__ const float* in_row(const Args& a, int row) { return row < ML ? a.in[I_X] + (size_t)row * D : a.in[I_CTX] + (size_t)(row - ML) * D; }
__device__ __forceinline__ int mod_row(int row) { return row < ML ? (row >> 11) : 8; }

template <int CTRL> __device__ __forceinline__ float dppf(float v) { return __builtin_bit_cast(float, __builtin_amdgcn_update_dpp(0, __builtin_bit_cast(int, v), CTRL, 0xf, 0xf, true)); }
__device__ __forceinline__ float row_sum16(float v) { v += dppf<0xB1>(v); v += dppf<0x4E>(v); v += dppf<0x141>(v); v += dppf<0x140>(v); return v; }
__device__ __forceinline__ float row_max16(float v) { v = fmaxf(v, dppf<0xB1>(v)); v = fmaxf(v, dppf<0x4E>(v)); v = fmaxf(v, dppf<0x141>(v)); v = fmaxf(v, dppf<0x140>(v)); return v; }
__device__ __forceinline__ float wsum(float v) { v = row_sum16(v); return
    __builtin_bit_cast(float, __builtin_amdgcn_readlane(__builtin_bit_cast(int, v), 0)) + __builtin_bit_cast(float, __builtin_amdgcn_readlane(__builtin_bit_cast(int, v), 16)) +
    __builtin_bit_cast(float, __builtin_amdgcn_readlane(__builtin_bit_cast(int, v), 32)) + __builtin_bit_cast(float, __builtin_amdgcn_readlane(__builtin_bit_cast(int, v), 48)); }
__device__ __forceinline__ float wmax(float v) { v = row_max16(v); return fmaxf(fmaxf(__builtin_bit_cast(float, __builtin_amdgcn_readlane(__builtin_bit_cast(int, v), 0)), __builtin_bit_cast(float, __builtin_amdgcn_readlane(__builtin_bit_cast(int, v), 16))),
    fmaxf(__builtin_bit_cast(float, __builtin_amdgcn_readlane(__builtin_bit_cast(int, v), 32)), __builtin_bit_cast(float, __builtin_amdgcn_readlane(__builtin_bit_cast(int, v), 48)))); }
__device__ __forceinline__ int lane_rank(unsigned long long m) { return __builtin_amdgcn_mbcnt_hi((unsigned)(m >> 32), __builtin_amdgcn_mbcnt_lo((unsigned)m, 0)); }
__device__ __forceinline__ unsigned fkey(float f) { const unsigned u = __builtin_bit_cast(unsigned, f); return u ^ ((unsigned)((int)u >> 31) | 0x80000000u); }
#define WAVE_LDS_SYNC() do { __builtin_amdgcn_fence(__ATOMIC_RELEASE, "wavefront"); __builtin_amdgcn_wave_barrier(); __builtin_amdgcn_fence(__ATOMIC_ACQUIRE, "wavefront"); } while (0)
template <int N> __device__ __forceinline__ unsigned kth_key(const unsigned (&k)[N], int K) {
    unsigned T = 0;
    for (int bit = 31; bit >= 0; --bit) { const unsigned cand = T | (1u << bit); int cnt = 0;
#pragma unroll
        for (int n = 0; n < N; ++n) cnt += __popcll(__ballot(k[n] >= cand));
        if (cnt >= K) T = cand;
        if (cnt == K) break; }
    return T;
}

namespace pg8 {
struct EpiInProj {
    static constexpr bool PERM = true, AFTER_DRAIN = false;
    bf16_t* U; bf16_t* QKV; bf16_t* Z;
    __device__ __forceinline__ void operator()(const f32x4 (&acc)[2][2][4][2], const Unit& u, int wr, int wc, int fr, int fq) const {
        bf16_t* base; int ld, colt; bool lat_only = false;
        if (u.pn < 2) { base = U; ld = 512; colt = u.pn * BM; }
        else if (u.pn < 8) { base = QKV; ld = 1536; colt = (u.pn - 2) * BM; }
        else { base = Z; ld = 512; colt = (u.pn - 8) * BM; lat_only = true; }
        const int row0 = u.pm * BM + wr * 64 + fr, col0 = colt + wc * 32 + 8 * fq;
#pragma unroll
        for (int ai = 0; ai < 2; ++ai)
#pragma unroll
            for (int m = 0; m < 4; ++m) { const int row = row0 + ai * HALF + m * 16; bf16_t* rowp = base + (size_t)row * ld + col0;
                if (lat_only && row >= 16384) continue;
#pragma unroll
                for (int bj = 0; bj < 2; ++bj) { const f32x4 v0 = acc[ai][bj][m][0], v1 = acc[ai][bj][m][1];
                    u32x4 w; w.x = cvt_pk_bf16(v0[0], v0[1]); w.y = cvt_pk_bf16(v0[2], v0[3]); w.z = cvt_pk_bf16(v1[0], v1[1]); w.w = cvt_pk_bf16(v1[2], v1[3]);
                    *(u32x4*)(rowp + bj * HALF) = w; } }
    }
};
struct EpiGlu {
    static constexpr bool PERM = true, AFTER_DRAIN = false;
    const bf16_t* YG; bf16_t* CAT;
    __device__ __forceinline__ void operator()(const f32x4 (&acc)[2][2][4][2], const Unit& u, int wr, int wc, int fr, int fq) const {
        const int row0 = u.pm * BM + wr * 64 + fr, col0 = u.pn * BM + wc * 32 + 8 * fq;
#pragma unroll
        for (int ai = 0; ai < 2; ++ai)
#pragma unroll
            for (int m = 0; m < 4; ++m) { const int row = row0 + ai * HALF + m * 16;
#pragma unroll
                for (int bj = 0; bj < 2; ++bj) { const f32x4 v0 = acc[ai][bj][m][0], v1 = acc[ai][bj][m][1];
                    const u32x4 y = *(const u32x4*)(YG + (size_t)row * 512 + col0 + bj * HALF);
                    float o[8]; const float a[8] = {v0[0], v0[1], v0[2], v0[3], v1[0], v1[1], v1[2], v1[3]};
                    const unsigned yw[4] = {y.x, y.y, y.z, y.w};
#pragma unroll
                    for (int e = 0; e < 8; ++e) { const float yv = __builtin_bit_cast(float, (e & 1) ? (yw[e >> 1] & 0xffff0000u) : (yw[e >> 1] << 16)); o[e] = yv / (1.f + __expf(-a[e])); }
                    u32x4 w; w.x = cvt_pk_bf16(o[0], o[1]); w.y = cvt_pk_bf16(o[2], o[3]); w.z = cvt_pk_bf16(o[4], o[5]); w.w = cvt_pk_bf16(o[6], o[7]);
                    *(u32x4*)(CAT + (size_t)row * 1024 + col0 + bj * HALF) = w; } }
    }
};
struct EpiF32 {
    static constexpr bool PERM = false, AFTER_DRAIN = false;
    float* C; int ldc;
    __device__ __forceinline__ void operator()(const f32x4 (&acc)[2][2][4][2], const Unit& u, int wr, int wc, int fr, int fq) const {
        const int row0 = u.pm * BM + wr * 64 + fr, col0 = u.pn * BM + wc * 32 + 4 * fq;
#pragma unroll
        for (int ai = 0; ai < 2; ++ai)
#pragma unroll
            for (int m = 0; m < 4; ++m) { float* rowp = C + (size_t)(row0 + ai * HALF + m * 16) * ldc + col0;
#pragma unroll
                for (int bj = 0; bj < 2; ++bj)
#pragma unroll
                    for (int n = 0; n < 2; ++n) *(f32x4*)(rowp + bj * HALF + n * 16) = acc[ai][bj][m][n]; }
    }
};
}

struct Ctx { const Args* a; unsigned char* ws; unsigned char* lds; int tid, lane, wave, bid, G, gw, NGW, gwv; };

__device__ __forceinline__ void p0_transpose_item(const float* W, int ldw, int nblk, int K, bf16* WT, float* scr, int item, int lane) {
    const int kb = item / nblk, nb = item % nblk, k0 = 64 * kb, n0 = 32 * nb;
#pragma unroll 8
    for (int i = 0; i < 32; ++i) { const int kk = 2 * i + (lane >> 5); scr[kk * 33 + (lane & 31)] = W[(size_t)(k0 + kk) * ldw + n0 + (lane & 31)]; }
    __builtin_amdgcn_fence(__ATOMIC_RELEASE, "wavefront"); __builtin_amdgcn_wave_barrier(); __builtin_amdgcn_fence(__ATOMIC_ACQUIRE, "wavefront");
    const int c = lane & 7;
#pragma unroll
    for (int j = 0; j < 4; ++j) { const int n = (lane >> 3) + 8 * j; const float* s = scr + (8 * c) * 33 + n;
        v4u o; o.x = pk2(s[0 * 33], s[1 * 33]); o.y = pk2(s[2 * 33], s[3 * 33]); o.z = pk2(s[4 * 33], s[5 * 33]); o.w = pk2(s[6 * 33], s[7 * 33]);
        *(v4u*)(WT + (size_t)(n0 + n) * K + k0 + 8 * c) = o; }
    __builtin_amdgcn_fence(__ATOMIC_RELEASE, "wavefront"); __builtin_amdgcn_wave_barrier(); __builtin_amdgcn_fence(__ATOMIC_ACQUIRE, "wavefront");
}
__device__ __forceinline__ void phase_prep(const Ctx& c) {
    const Args& a = *c.a;
    float* scr = (float*)(c.lds + c.wave * 16384);
    constexpr int I_IN = 16 * 80, I_OUT = 16 * 32, I_GLU = 8 * 16, I_Q = 16 * 64;
    for (int it = c.gw; it < I_IN + I_OUT + I_GLU + I_Q; it += c.NGW) {
        int r = it;
        if (r < I_IN) { p0_transpose_item(a.in[I_WIN], PROJ, 80, 1024, (bf16*)(c.ws + WS_WIN), scr, r, c.lane); continue; } r -= I_IN;
        if (r < I_OUT) { p0_transpose_item(a.in[I_WOUT], 1024, 32, 1024, (bf16*)(c.ws + WS_WOUT), scr, r, c.lane); continue; } r -= I_OUT;
        if (r < I_GLU) { p0_transpose_item(a.in[I_WGLU], 512, 16, 512, (bf16*)(c.ws + WS_WGLU), scr, r, c.lane); continue; } r -= I_GLU;
        p0_transpose_item(a.in[I_WQ], 2048, 64, 1024, (bf16*)(c.ws + WS_WQ), scr, r, c.lane);
    }
    __syncthreads();
    float* sc = (float*)c.lds;
    float* red = (float*)(c.lds + 9 * 1024 * 4);
    float* MOD = (float*)(c.ws + WS_MOD);
    bool have = false;
    for (int item = c.bid; item < 96; item += c.G) {
        if (!have) { for (int i = c.tid; i < 9 * 1024; i += NTHREADS) { const int r = i >> 10, k = i & 1023; const float v = r < 8 ? a.in[I_C][r * 1024 + k] : a.in[I_CCTX][k]; sc[i] = siluf_(v); } have = true; __syncthreads(); }
        const int n0 = item * 64;
        float acc[9];
#pragma unroll
        for (int r = 0; r < 9; ++r) acc[r] = 0.f;
        const float* wp = a.in[I_WMOD] + (size_t)(c.wave * 128) * 6144 + n0 + c.lane;
#pragma unroll 4
        for (int k = 0; k < 128; ++k) { const float w = wp[(size_t)k * 6144];
#pragma unroll
            for (int r = 0; r < 9; ++r) acc[r] = fmaf(sc[r * 1024 + c.wave * 128 + k], w, acc[r]); }
#pragma unroll
        for (int r = 0; r < 9; ++r) red[(c.wave * 9 + r) * 64 + c.lane] = acc[r];
        __syncthreads();
        for (int i = c.tid; i < 576; i += NTHREADS) { const int r = i >> 6, l = i & 63; float s = a.in[I_BMOD][n0 + l];
#pragma unroll
            for (int w = 0; w < 8; ++w) s += red[(w * 9 + r) * 64 + l];
            MOD[r * 6144 + n0 + l] = s; }
        __syncthreads();
    }
}

__device__ __forceinline__ void phase_norm1(const Ctx& c) {
    const Args& a = *c.a;
    float* wabT = (float*)c.lds;
    for (int i = c.tid; i < 1024 * 16; i += NTHREADS) { const int k = i >> 4, j = i & 15; wabT[j * 1028 + k] = a.in[I_WIN][(size_t)k * PROJ + NPROJ + j]; }
    __syncthreads();
    const float* MOD = (const float*)(c.ws + WS_MOD);
    bf16* HX = (bf16*)(c.ws + WS_HX); float* GB = (float*)(c.ws + WS_GB);
    const float* gpre = a.in[I_GPREMIX];
    for (int row = c.gw; row < MT; row += c.NGW) {
        const f32x4* xr = (const f32x4*)in_row(a, row) + c.lane;
        const float* mr = MOD + mod_row(row) * 6144;
        f32x4 v[4]; float ss = 0.f;
#pragma unroll
        for (int j = 0; j < 4; ++j) { v[j] = xr[64 * j]; ss += (v[j].x * v[j].x + v[j].y * v[j].y) + (v[j].z * v[j].z + v[j].w * v[j].w); }
        const float r = rsqrtf(wave_sum(ss) * (1.f / D) + EPS);
#pragma unroll
        for (int j = 0; j < 4; ++j) { const int col = 4 * c.lane + 256 * j;
            const f32x4 g4 = *(const f32x4*)(gpre + col), sh = *(const f32x4*)(mr + col), scl = *(const f32x4*)(mr + 1024 + col);
            v[j] = (v[j] * r) * g4 * (scl + 1.f) + sh;
            v2u o; o.x = pk2(v[j].x, v[j].y); o.y = pk2(v[j].z, v[j].w);
            *(v2u*)(HX + (size_t)row * D + col) = o; }
        float mine = 0.f;
#pragma unroll 1
        for (int j = 0; j < 16; ++j) { float s = 0.f;
#pragma unroll
            for (int jj = 0; jj < 4; ++jj) { const f32x4 w = *(const f32x4*)(wabT + j * 1028 + 4 * c.lane + 256 * jj); s += (v[jj].x * w.x + v[jj].y * w.y) + (v[jj].z * w.z + v[jj].w * w.w); }
            s = wave_sum(s); mine = (c.lane == j) ? s : mine; }
        if (c.lane < 8) { const float t = mine + a.in[I_DTBIAS][c.lane]; const float sp = t > 20.f ? t : log1pf(expf(t)); GB[(size_t)row * 16 + c.lane] = -expf(a.in[I_ALOG][c.lane]) * sp; }
        else if (c.lane < 16) GB[(size_t)row * 16 + c.lane] = 1.f / (1.f + expf(-mine));
    }
}

__device__ __forceinline__ void phase_conv(const Ctx& c) {
    const Args& a = *c.a;
    const bf16* PRE = (const bf16*)(c.ws + WS_QKVPRE); bf16* OUT = (bf16*)(c.ws + WS_QKV);
    const float* cw = a.in[I_CONV];
    for (int row = c.gw; row < MT; row += c.NGW) {
        int nb_row[9]; bool ok[9];
        if (row < ML) { const int t = row & 2047, gr = t >> 6, gc = t & 63;
#pragma unroll
            for (int dy = -1; dy <= 1; ++dy)
#pragma unroll
                for (int dx = -1; dx <= 1; ++dx) { const int i = (dy + 1) * 3 + dx + 1; ok[i] = (gr + dy >= 0) && (gr + dy < 32) && (gc + dx >= 0) && (gc + dx < 64); nb_row[i] = row + dy * 64 + dx; } }
        else { const int t = (row - ML) & 255;
#pragma unroll
            for (int i = 0; i < 9; ++i) { ok[i] = false; nb_row[i] = row; }
#pragma unroll
            for (int dx = -1; dx <= 1; ++dx) { ok[4 + dx] = (t + dx >= 0) && (t + dx < 256); nb_row[4 + dx] = row + dx; } }
#pragma unroll 2
        for (int seg = 0; seg < 12; ++seg) { const int ch = seg * 128 + 2 * c.lane; float o0 = 0.f, o1 = 0.f;
#pragma unroll
            for (int i = 0; i < 9; ++i) if (ok[i]) { const unsigned w = *(const unsigned*)(PRE + (size_t)nb_row[i] * 1536 + ch); const f32x2 k2 = *(const f32x2*)(cw + i * 1536 + ch);
                o0 = fmaf(bflo(w), k2.x, o0); o1 = fmaf(bfhi(w), k2.y, o1); }
            o0 = siluf_(o0); o1 = siluf_(o1);
            if (seg < 8) { const float ssq = wave_sum(o0 * o0 + o1 * o1); const float sc = rsqrtf(ssq + EPS) * (seg < 4 ? 0.08838834764831845f : 1.f); o0 *= sc; o1 *= sc; }
            *(unsigned*)(OUT + (size_t)row * 1536 + ch) = pk2(o0, o1); }
    }
}

__device__ __forceinline__ int scan_row(int b, int dir, int step) {
    if (step < LC) { const int t = dir ? LC - 1 - step : step; return ML + b * LC + t; }
    const int t = step - LC; return b * SEQ + (dir ? SEQ - 1 - t : t);
}
__device__ __forceinline__ void s5_direct_task(const Ctx& c, int task, float* wl  ) {
    const Args& a = *c.a;
    const int dir = task & 1, g = (task >> 1) & 31, b = task >> 6, p = c.lane, dg = dir * 32 + g;
    const float dt = expf(a.in[I_LOGDT][dg]);
    const float lr = a.in[I_LAMRE][dg * 64 + p], li = a.in[I_LAMIM][dg * 64 + p];
    const float mag = expf(lr * dt); float sn, cs; sincos_d((double)li * (double)dt, sn, cs);
    const float lbr = mag * cs, lbi = mag * sn, den = lr * lr + li * li, nr = lbr - 1.f;
    const float cr = (nr * lr + lbi * li) / den, ci = (lbi * lr - nr * li) / den;
    float bbr[16], bbi[16], cre[16], cim[16];
#pragma unroll
    for (int ch = 0; ch < 16; ++ch) { const float br = a.in[I_BRE][(size_t)(dg * 64 + p) * 16 + ch], bi = a.in[I_BIM][(size_t)(dg * 64 + p) * 16 + ch];
        bbr[ch] = cr * br - ci * bi; bbi[ch] = cr * bi + ci * br;
        cre[ch] = a.in[I_CRE][(size_t)(dg * 16 + ch) * 64 + p]; cim[ch] = a.in[I_CIM][(size_t)(dg * 16 + ch) * 64 + p]; }
    const bf16* U = (const bf16*)(c.ws + WS_U); bf16* YS = (bf16*)(c.ws + WS_YS5) + (size_t)dir * ML * 512;
    float hre = 0.f, him = 0.f;
    v4u n0 = *(const v4u*)(U + (size_t)scan_row(b, dir, 0) * 512 + g * 16), n1 = *(const v4u*)(U + (size_t)scan_row(b, dir, 0) * 512 + g * 16 + 8);
    for (int step = 0; step < LC + SEQ; ++step) {
        const int row = scan_row(b, dir, step);
        const v4u u0 = n0, u1 = n1;
        if (step + 1 < LC + SEQ) { const bf16* np = U + (size_t)scan_row(b, dir, step + 1) * 512 + g * 16; n0 = *(const v4u*)np; n1 = *(const v4u*)(np + 8); }
        const unsigned uw[8] = {u0.x, u0.y, u0.z, u0.w, u1.x, u1.y, u1.z, u1.w};
        float bur = 0.f, bui = 0.f;
#pragma unroll
        for (int ch = 0; ch < 16; ++ch) { const float uv = (ch & 1) ? bfhi(uw[ch >> 1]) : bflo(uw[ch >> 1]); bur = fmaf(bbr[ch], uv, bur); bui = fmaf(bbi[ch], uv, bui); }
        const float nre = lbr * hre - lbi * him + bur, nim = lbr * him + lbi * hre + bui; hre = nre; him = nim;
        if (step >= LC) {
#pragma unroll
            for (int ch = 0; ch < 16; ++ch) wl[ch * 65 + p] = cre[ch] * hre - cim[ch] * him;
            __builtin_amdgcn_fence(__ATOMIC_RELEASE, "wavefront"); __builtin_amdgcn_wave_barrier(); __builtin_amdgcn_fence(__ATOMIC_ACQUIRE, "wavefront");
            const int ch = c.lane >> 2, part = c.lane & 3; float s = 0.f;
#pragma unroll
            for (int i = 0; i < 16; ++i) s += wl[ch * 65 + part * 16 + i];
            s += __shfl_xor(s, 1); s += __shfl_xor(s, 2);
            if (part == 0) YS[(size_t)row * 512 + g * 16 + ch] = (bf16)f2bf(s);
            __builtin_amdgcn_fence(__ATOMIC_RELEASE, "wavefront"); __builtin_amdgcn_wave_barrier(); __builtin_amdgcn_fence(__ATOMIC_ACQUIRE, "wavefront");
        }
    }
}
__device__ __forceinline__ void gdn_direct_task(const Ctx& c, int task, float* wl  ) {
    const int dvq = task & 3, dir = (task >> 2) & 1, h = (task >> 3) & 3, b = task >> 5, half = c.lane >> 5, dv = dvq * 32 + (c.lane & 31);
    const bf16* QKV = (const bf16*)(c.ws + WS_QKV); const float* GB = (const float*)(c.ws + WS_GB);
    bf16* OG = (bf16*)(c.ws + WS_OG) + (size_t)dir * ML * 512;
    float S[64];
#pragma unroll
    for (int i = 0; i < 64; ++i) S[i] = 0.f;
    float* kf = wl; float* qf = wl + 128;
    unsigned nq, nk; bf16 nv; float ng, nbt;
    { const int row = scan_row(b, dir, 0); const bf16* rp = QKV + (size_t)row * 1536 + h * 128; nq = *(const unsigned*)(rp + 2 * c.lane); nk = *(const unsigned*)(rp + 512 + 2 * c.lane); nv = rp[1024 + dv];
      ng = GB[(size_t)row * 16 + dir * 4 + h]; nbt = GB[(size_t)row * 16 + 8 + dir * 4 + h]; }
    for (int step = 0; step < LC + SEQ; ++step) {
        const int row = scan_row(b, dir, step);
        const unsigned qw = nq, kw = nk; const float v = bf1(nv), eg = __expf(ng), beta = nbt;
        if (step + 1 < LC + SEQ) { const int r2 = scan_row(b, dir, step + 1); const bf16* rp = QKV + (size_t)r2 * 1536 + h * 128; nq = *(const unsigned*)(rp + 2 * c.lane); nk = *(const unsigned*)(rp + 512 + 2 * c.lane); nv = rp[1024 + dv];
            ng = GB[(size_t)r2 * 16 + dir * 4 + h]; nbt = GB[(size_t)r2 * 16 + 8 + dir * 4 + h]; }
        *(f32x2*)(kf + 2 * c.lane) = (f32x2){bflo(kw), bfhi(kw)}; *(f32x2*)(qf + 2 * c.lane) = (f32x2){bflo(qw), bfhi(qw)};
        __builtin_amdgcn_fence(__ATOMIC_RELEASE, "wavefront"); __builtin_amdgcn_wave_barrier(); __builtin_amdgcn_fence(__ATOMIC_ACQUIRE, "wavefront");
        const float* kh = kf + 64 * half; const float* qh = qf + 64 * half;
        float ks = 0.f;
#pragma unroll
        for (int i = 0; i < 16; ++i) { const f32x4 k4 = *(const f32x4*)(kh + 4 * i);
            ks = fmaf(S[4 * i], k4.x, ks); ks = fmaf(S[4 * i + 1], k4.y, ks); ks = fmaf(S[4 * i + 2], k4.z, ks); ks = fmaf(S[4 * i + 3], k4.w, ks); }
        ks += __shfl_xor(ks, 32);
        const float vn = beta * (v - eg * ks);
        float o = 0.f;
#pragma unroll
        for (int i = 0; i < 16; ++i) { const f32x4 k4 = *(const f32x4*)(kh + 4 * i), q4 = *(const f32x4*)(qh + 4 * i);
            S[4 * i] = fmaf(S[4 * i], eg, k4.x * vn); S[4 * i + 1] = fmaf(S[4 * i + 1], eg, k4.y * vn); S[4 * i + 2] = fmaf(S[4 * i + 2], eg, k4.z * vn); S[4 * i + 3] = fmaf(S[4 * i + 3], eg, k4.w * vn);
            o = fmaf(S[4 * i], q4.x, o); o = fmaf(S[4 * i + 1], q4.y, o); o = fmaf(S[4 * i + 2], q4.z, o); o = fmaf(S[4 * i + 3], q4.w, o); }
        o += __shfl_xor(o, 32);
        if (step >= LC && half == 0) OG[(size_t)row * 512 + h * 128 + dv] = (bf16)f2bf(o);
        __builtin_amdgcn_fence(__ATOMIC_RELEASE, "wavefront"); __builtin_amdgcn_wave_barrier(); __builtin_amdgcn_fence(__ATOMIC_ACQUIRE, "wavefront");
    }
}
__device__ __forceinline__ void phase_scan_direct(const Ctx& c) {
    float* wl = (float*)(c.lds + c.wave * 8192);
    for (int t = c.gwv; t < 512 + 256; t += c.NGW) { if (t < 512) s5_direct_task(c, t, wl); else gdn_direct_task(c, t - 512, wl); }
}

__device__ __forceinline__ void phase_combine(const Ctx& c) {
    const Args& a = *c.a;
    const bf16* OG0 = (const bf16*)(c.ws + WS_OG); const bf16* OG1 = OG0 + (size_t)ML * 512; const bf16* Z = (const bf16*)(c.ws + WS_Z);
    const bf16* YS0 = (const bf16*)(c.ws + WS_YS5); const bf16* YS1 = YS0 + (size_t)ML * 512; const bf16* U = (const bf16*)(c.ws + WS_U);
    bf16* CAT = (bf16*)(c.ws + WS_CAT); bf16* YG = (bf16*)(c.ws + WS_YG);
    for (int row = c.gw; row < ML; row += c.NGW) {
#pragma unroll
        for (int h = 0; h < 4; ++h) { const int ch = h * 128 + 2 * c.lane;
            const unsigned w0 = *(const unsigned*)(OG0 + (size_t)row * 512 + ch), w1 = *(const unsigned*)(OG1 + (size_t)row * 512 + ch), zw = *(const unsigned*)(Z + (size_t)row * 512 + ch);
            const float o0 = bflo(w0) + bflo(w1), o1 = bfhi(w0) + bfhi(w1);
            const float r = rsqrtf(wave_sum(o0 * o0 + o1 * o1) * (1.f / 128.f) + EPS);
            const f32x2 ng = *(const f32x2*)(a.in[I_GDNNORM] + 2 * c.lane);
            *(unsigned*)(CAT + (size_t)row * 1024 + 512 + ch) = pk2(o0 * r * ng.x * siluf_(bflo(zw)), o1 * r * ng.y * siluf_(bfhi(zw))); }
        { const int ch = 8 * c.lane;
            const v4u uu = *(const v4u*)(U + (size_t)row * 512 + ch), y0 = *(const v4u*)(YS0 + (size_t)row * 512 + ch), y1 = *(const v4u*)(YS1 + (size_t)row * 512 + ch);
            const f32x4 d0 = *(const f32x4*)(a.in[I_S5D] + ch), d1 = *(const f32x4*)(a.in[I_S5D] + ch + 4);
            const unsigned uw[4] = {uu.x, uu.y, uu.z, uu.w}, a0[4] = {y0.x, y0.y, y0.z, y0.w}, a1[4] = {y1.x, y1.y, y1.z, y1.w}; const float dd[8] = {d0.x, d0.y, d0.z, d0.w, d1.x, d1.y, d1.z, d1.w};
            float o[8];
#pragma unroll
            for (int e = 0; e < 8; ++e) { const float uv = (e & 1) ? bfhi(uw[e >> 1]) : bflo(uw[e >> 1]); const float ya = (e & 1) ? bfhi(a0[e >> 1]) : bflo(a0[e >> 1]); const float yb = (e & 1) ? bfhi(a1[e >> 1]) : bflo(a1[e >> 1]);
                o[e] = gelu_erf(uv * dd[e] + ya + yb); }
            v4u w; w.x = pk2(o[0], o[1]); w.y = pk2(o[2], o[3]); w.z = pk2(o[4], o[5]); w.w = pk2(o[6], o[7]);
            *(v4u*)(YG + (size_t)row * 512 + ch) = w; }
    }
}

__device__ __forceinline__ void phase_rows2(const Ctx& c) {
    const Args& a = *c.a;
    const float* MOD = (const float*)(c.ws + WS_MOD); const float* YRAW = (const float*)(c.ws + WS_YRAW); bf16* HX2 = (bf16*)(c.ws + WS_HX2);
    for (int row = c.gw; row < ML; row += c.NGW) {
        const float* mr = MOD + (row >> 11) * 6144;
        f32x4 y[4], x[4]; float ss = 0.f;
#pragma unroll
        for (int j = 0; j < 4; ++j) { y[j] = *((const f32x4*)(YRAW + (size_t)row * D) + c.lane + 64 * j); x[j] = *((const f32x4*)(a.in[I_X] + (size_t)row * D) + c.lane + 64 * j);
            ss += (y[j].x * y[j].x + y[j].y * y[j].y) + (y[j].z * y[j].z + y[j].w * y[j].w); }
        const float r = rsqrtf(wave_sum(ss) * (1.f / D) + EPS); float s2 = 0.f;
#pragma unroll
        for (int j = 0; j < 4; ++j) { const int col = 4 * c.lane + 256 * j;
            const f32x4 g4 = *(const f32x4*)(a.in[I_GPOSTMIX] + col), gt = *(const f32x4*)(mr + 2048 + col);
            x[j] = x[j] + gt * ((y[j] * r) * g4);
            *(f32x4*)(a.out + (size_t)row * D + col) = x[j];
            s2 += (x[j].x * x[j].x + x[j].y * x[j].y) + (x[j].z * x[j].z + x[j].w * x[j].w); }
        const float r2 = rsqrtf(wave_sum(s2) * (1.f / D) + EPS);
#pragma unroll
        for (int j = 0; j < 4; ++j) { const int col = 4 * c.lane + 256 * j;
            const f32x4 g4 = *(const f32x4*)(a.in[I_GPREFFN] + col), sh = *(const f32x4*)(mr + 3072 + col), scl = *(const f32x4*)(mr + 4096 + col);
            const f32x4 hv = (x[j] * r2) * g4 * (scl + 1.f) + sh;
            v2u o; o.x = pk2(hv.x, hv.y); o.y = pk2(hv.z, hv.w);
            *(v2u*)(HX2 + (size_t)row * D + col) = o; }
    }
}


constexpr int KROW = 136;
__device__ __forceinline__ void phase_topk(const Ctx& c) {
    const Args& a = *c.a;
    bf16* kl = (bf16*)c.lds;
    unsigned char* wbase = c.lds + 2 * 128 * KROW * 2 + c.wave * 1024;
    bf16* qs = (bf16*)wbase;
    float* s1 = (float*)(wbase + 512); int* i1 = (int*)(wbase + 576); float* s2 = (float*)(wbase + 640); int* i2 = (int*)(wbase + 704); float* fs = (float*)(wbase + 768); int* fi = (int*)(wbase + 832);
    const bf16* QP = (const bf16*)(c.ws + WS_QP); int* IDX = (int*)(c.ws + WS_IDX); float* GATE = (float*)(c.ws + WS_GATE);
    for (int item = c.bid; item < 8 * 32; item += c.G) {
        const int h = item & 7, tr = item >> 3;
        __syncthreads();
        for (int i = c.tid; i < 2 * 128 * 64; i += NTHREADS) { const int k2 = i & 63, n = (i >> 6) & 127, p = i >> 13; const f32x2 kv = *(const f32x2*)(a.in[I_KEYS] + ((size_t)((h * 2 + p) * 128 + n)) * 128 + 2 * k2);
            *(unsigned*)(kl + (p * 128 + n) * KROW + 2 * k2) = pk2(kv.x, kv.y); }
        __syncthreads();
        for (int tt = c.wave; tt < 512; tt += NWAVES) {
            const int tok = tr * 512 + tt;
            *(v2u*)(qs + 4 * c.lane) = *(const v2u*)(QP + (size_t)tok * 2048 + h * 256 + 4 * c.lane);
            WAVE_LDS_SYNC();
            float sc[2][2];
#pragma unroll
            for (int p = 0; p < 2; ++p) { float sa0 = 0.f, sa1 = 0.f, sb0 = 0.f, sb1 = 0.f;
#pragma unroll 4
                for (int kk = 0; kk < 16; ++kk) { const v4u q8 = *(const v4u*)(qs + p * 128 + kk * 8), ka = *(const v4u*)(kl + (p * 128 + c.lane) * KROW + kk * 8), kb = *(const v4u*)(kl + (p * 128 + c.lane + 64) * KROW + kk * 8);
                    const unsigned qw[4] = {q8.x, q8.y, q8.z, q8.w}, aw[4] = {ka.x, ka.y, ka.z, ka.w}, bw[4] = {kb.x, kb.y, kb.z, kb.w};
#pragma unroll
                    for (int e = 0; e < 4; ++e) { sa0 = fmaf(bflo(qw[e]), bflo(aw[e]), sa0); sa1 = fmaf(bfhi(qw[e]), bfhi(aw[e]), sa1); sb0 = fmaf(bflo(qw[e]), bflo(bw[e]), sb0); sb1 = fmaf(bfhi(qw[e]), bfhi(bw[e]), sb1); } }
                sc[p][0] = sa0 + sa1; sc[p][1] = sb0 + sb1; }
#pragma unroll
            for (int p = 0; p < 2; ++p) { float* so = p ? s2 : s1; int* io = p ? i2 : i1;
                const unsigned ky[2] = {fkey(sc[p][0]), fkey(sc[p][1])};
                const unsigned T = kth_key<2>(ky, 16);
                int cgt = 0;
#pragma unroll
                for (int n = 0; n < 2; ++n) cgt += __popcll(__ballot(ky[n] > T));
                const int need = 16 - cgt; int base = 0, eqb = 0;
#pragma unroll
                for (int n = 0; n < 2; ++n) { const bool eq = ky[n] == T; const unsigned long long em = __ballot(eq); const bool sel = (ky[n] > T) || (eq && (eqb + lane_rank(em)) < need);
                    const unsigned long long sm = __ballot(sel); if (sel) { const int pos = base + lane_rank(sm); so[pos] = sc[p][n]; io[pos] = c.lane + 64 * n; }
                    base += __popcll(sm); eqb += __popcll(em); } }
            WAVE_LDS_SYNC();
            { const int ci = c.lane >> 2, cj = 4 * (c.lane & 3);
              float cv[4]; unsigned ky[4]; const float b1 = s1[ci];
#pragma unroll
              for (int e = 0; e < 4; ++e) { cv[e] = b1 + s2[cj + e]; ky[e] = fkey(cv[e]); }
              const unsigned T = kth_key<4>(ky, 16);
              int cgt = 0;
#pragma unroll
              for (int e = 0; e < 4; ++e) cgt += __popcll(__ballot(ky[e] > T));
              const int need = 16 - cgt; int base = 0, eqb = 0; const int e1 = i1[ci] * 128;
#pragma unroll
              for (int e = 0; e < 4; ++e) { const bool eq = ky[e] == T; const unsigned long long em = __ballot(eq); const bool sel = (ky[e] > T) || (eq && (eqb + lane_rank(em)) < need);
                  const unsigned long long sm = __ballot(sel); if (sel) { const int pos = base + lane_rank(sm); fs[pos] = cv[e]; fi[pos] = e1 + i2[cj + e]; }
                  base += __popcll(sm); eqb += __popcll(em); } }
            WAVE_LDS_SYNC();
            { const float v = fs[c.lane & 15]; const float mx = row_max16(v); const float ex = __expf(v - mx); const float den = row_sum16(ex);
              if (c.lane < 16) { IDX[(size_t)tok * 128 + h * 16 + c.lane] = fi[c.lane]; GATE[(size_t)tok * 128 + h * 16 + c.lane] = ex / den; } }
            WAVE_LDS_SYNC();
        }
    }
}

__device__ __forceinline__ void phase_fp8_tables(const Ctx& c) {
    const Args& a = *c.a;
    for (int r = c.gw; r < 2 * NEXP; r += c.NGW) {
        const bool isv = r >= NEXP; const int e = isv ? r - NEXP : r;
        const f32x4* src = (const f32x4*)((isv ? a.in[I_PV] : a.in[I_PU]) + (size_t)e * D) + 4 * c.lane;
        f32x4 v[4]; float m = 0.f;
#pragma unroll
        for (int j = 0; j < 4; ++j) { v[j] = src[j]; m = fmaxf(m, fmaxf(fmaxf(fabsf(v[j].x), fabsf(v[j].y)), fmaxf(fabsf(v[j].z), fabsf(v[j].w)))); }
        m = wmax(m); const float inv = m > 0.f ? 256.f / m : 0.f;
        v4u o; unsigned ow[4];
#pragma unroll
        for (int j = 0; j < 4; ++j) { int w = __builtin_amdgcn_cvt_pk_fp8_f32(v[j].x * inv, v[j].y * inv, 0, false); w = __builtin_amdgcn_cvt_pk_fp8_f32(v[j].z * inv, v[j].w * inv, w, true); ow[j] = (unsigned)w; }
        o.x = ow[0]; o.y = ow[1]; o.z = ow[2]; o.w = ow[3];
        *(v4u*)(c.ws + (isv ? WS_V8 : WS_U8) + (size_t)e * D + 16 * c.lane) = o;
        if (c.lane == 0) ((float*)(c.ws + (isv ? WS_VSC : WS_USC)))[e] = m * (1.f / 256.f);
    }
}
__device__ __forceinline__ void fp8x16_to_f32(const v4u& r, float (&f)[16]) {
    const unsigned w[4] = {r.x, r.y, r.z, r.w};
#pragma unroll
    for (int j = 0; j < 4; ++j) { const f32x2 lo = __builtin_amdgcn_cvt_pk_f32_fp8((int)w[j], false), hi = __builtin_amdgcn_cvt_pk_f32_fp8((int)w[j], true); f[4 * j] = lo.x; f[4 * j + 1] = lo.y; f[4 * j + 2] = hi.x; f[4 * j + 3] = hi.y; }
}
__device__ __forceinline__ unsigned xcc_id() { return (unsigned)__builtin_amdgcn_s_getreg((3 << 11) | 20) & 7u; }

__device__ __forceinline__ void phase_exp1(const Ctx& c) {
    const bf16* HX2 = (const bf16*)(c.ws + WS_HX2); const int* IDX = (const int*)(c.ws + WS_IDX); const float* GATE = (const float*)(c.ws + WS_GATE);
    const unsigned char* U8 = c.ws + WS_U8; const float* USC = (const float*)(c.ws + WS_USC); const float* VSC = (const float*)(c.ws + WS_VSC); float* ACT = (float*)(c.ws + WS_ACT);
    unsigned* cnt = (unsigned*)(c.ws + WS_CTL) + CW_E1;
    int* lk = (int*)(c.lds + c.wave * 1024); int* le = lk + 128;
    const int xcc = (int)xcc_id();
    constexpr int CH = 8;
    for (int bo = 0; bo < 8; ++bo) { const int x = (xcc + bo) & 7;
        for (;;) { unsigned t0 = 0; if (c.lane == 0) t0 = __hip_atomic_fetch_add(cnt + 64 * x, (unsigned)CH, __ATOMIC_RELAXED, __HIP_MEMORY_SCOPE_AGENT);
            t0 = (unsigned)__builtin_amdgcn_readfirstlane((int)t0); if (t0 >= (unsigned)ML) break;
            for (int t = (int)t0; t < (int)t0 + CH; ++t) {
                float hv[16];
                { const v4u h0 = *(const v4u*)(HX2 + (size_t)t * D + 16 * c.lane), h1 = *(const v4u*)(HX2 + (size_t)t * D + 16 * c.lane + 8); const unsigned hw[8] = {h0.x, h0.y, h0.z, h0.w, h1.x, h1.y, h1.z, h1.w};
#pragma unroll
                  for (int j = 0; j < 8; ++j) { hv[2 * j] = bflo(hw[j]); hv[2 * j + 1] = bfhi(hw[j]); } }
                const int eA = IDX[(size_t)t * 128 + c.lane], eB = IDX[(size_t)t * 128 + 64 + c.lane];
                const bool sA = (eA >> 11) == x, sB = (eB >> 11) == x; const unsigned long long mA = __ballot(sA), mB = __ballot(sB); const int nA = __popcll(mA), n = nA + __popcll(mB);
                if (sA) { const int pos = lane_rank(mA); lk[pos] = c.lane; le[pos] = eA; }
                if (sB) { const int pos = nA + lane_rank(mB); lk[pos] = c.lane + 64; le[pos] = eB; }
                WAVE_LDS_SYNC();
                for (int j0 = 0; j0 < n; j0 += 16) {
                    float p[16];
#pragma unroll
                    for (int jj = 0; jj < 16; ++jj) { const int j = j0 + jj; const int e = le[j < n ? j : 0];
                        const v4u row = *(const v4u*)(U8 + (size_t)e * D + 16 * c.lane); float f[16]; fp8x16_to_f32(row, f); float s0 = 0.f, s1 = 0.f;
#pragma unroll
                        for (int q = 0; q < 8; ++q) { s0 = fmaf(f[2 * q], hv[2 * q], s0); s1 = fmaf(f[2 * q + 1], hv[2 * q + 1], s1); }
                        p[jj] = s0 + s1; }
                    const bool b5 = c.lane & 32, b4 = c.lane & 16, b3 = c.lane & 8, b2 = c.lane & 4;
                    float q8[8], q4[4], q2[2];
#pragma unroll
                    for (int i = 0; i < 8; ++i) { const float keep = b5 ? p[i + 8] : p[i], send = b5 ? p[i] : p[i + 8]; q8[i] = keep + __shfl_xor(send, 32); }
#pragma unroll
                    for (int i = 0; i < 4; ++i) { const float keep = b4 ? q8[i + 4] : q8[i], send = b4 ? q8[i] : q8[i + 4]; q4[i] = keep + __shfl_xor(send, 16); }
#pragma unroll
                    for (int i = 0; i < 2; ++i) { const float keep = b3 ? q4[i + 2] : q4[i], send = b3 ? q4[i] : q4[i + 2]; q2[i] = keep + dppf<0x140>(send); }
                    float s; { const float keep = b2 ? q2[1] : q2[0], send = b2 ? q2[0] : q2[1]; s = keep + dppf<0x141>(send); }
                    s += dppf<0xB1>(s); s += dppf<0x4E>(s);
                    const int j = j0 + (b5 ? 8 : 0) + (b4 ? 4 : 0) + (b3 ? 2 : 0) + (b2 ? 1 : 0);
                    if (j < n && (c.lane & 3) == 0) { const int e = le[j], k = lk[j]; ACT[(size_t)t * 128 + k] = gelu_erf(s * USC[e]) * GATE[(size_t)t * 128 + k] * VSC[e]; }
                }
                WAVE_LDS_SYNC();
            } } }
}
__device__ __forceinline__ void phase_exp2(const Ctx& c) {
    const int* IDX = (const int*)(c.ws + WS_IDX); const float* ACT = (const float*)(c.ws + WS_ACT); const unsigned char* V8 = c.ws + WS_V8;
    float* Y = (float*)(c.ws + WS_Y); float* SSQP = (float*)(c.ws + WS_SSQP);
    unsigned* cnt = (unsigned*)(c.ws + WS_CTL) + CW_E2;
    const int xcc = (int)xcc_id(), sub = c.lane & 7, grp = c.lane >> 3;
    const bool b5 = c.lane & 32, b4 = c.lane & 16, b3 = c.lane & 8;
    constexpr int CH = 8;
    int bo = 0, t = 0, tend = 0;
    for (;;) {
        if (t >= tend) {
            unsigned t0 = 0; if (c.lane == 0) t0 = __hip_atomic_fetch_add(cnt + 64 * ((xcc + bo) & 7), (unsigned)CH, __ATOMIC_RELAXED, __HIP_MEMORY_SCOPE_AGENT);
            t0 = (unsigned)__builtin_amdgcn_readfirstlane((int)t0);
            if (t0 >= (unsigned)ML) { if (++bo >= 8) break; continue; }
            t = (int)t0; tend = t + CH;
        }
        const int x = (xcc + bo) & 7;
        float acc[16];
#pragma unroll
        for (int q = 0; q < 16; ++q) acc[q] = 0.f;
#pragma unroll 4
        for (int i = 0; i < 16; ++i) { const int k = 8 * i + grp; const int e = IDX[(size_t)t * 128 + k]; const float av = ACT[(size_t)t * 128 + k];
            const v4u row = *(const v4u*)(V8 + (size_t)e * D + x * 128 + 16 * sub); float f[16]; fp8x16_to_f32(row, f);
#pragma unroll
            for (int q = 0; q < 16; ++q) acc[q] = fmaf(av, f[q], acc[q]); }
        float q8[8], q4[4], q2[2];
#pragma unroll
        for (int i = 0; i < 8; ++i) { const float keep = b5 ? acc[i + 8] : acc[i], send = b5 ? acc[i] : acc[i + 8]; q8[i] = keep + __shfl_xor(send, 32); }
#pragma unroll
        for (int i = 0; i < 4; ++i) { const float keep = b4 ? q8[i + 4] : q8[i], send = b4 ? q8[i] : q8[i + 4]; q4[i] = keep + __shfl_xor(send, 16); }
#pragma unroll
        for (int i = 0; i < 2; ++i) { const float keep = b3 ? q4[i + 2] : q4[i], send = b3 ? q4[i] : q4[i + 2]; q2[i] = keep + __shfl_xor(send, 8); }
        const int col = x * 128 + 16 * sub + (b5 ? 8 : 0) + (b4 ? 4 : 0) + (b3 ? 2 : 0);
        *(f32x2*)(Y + (size_t)t * D + col) = (f32x2){q2[0], q2[1]};
        const float ss = wsum(q2[0] * q2[0] + q2[1] * q2[1]);
        SSQP[(size_t)x * ML + t] = ss;
        ++t;
    }
}
__device__ __forceinline__ void phase_exp3(const Ctx& c) {
    const Args& a = *c.a;
    const float* MOD = (const float*)(c.ws + WS_MOD); const float* Y = (const float*)(c.ws + WS_Y); const float* SSQP = (const float*)(c.ws + WS_SSQP);
    for (int row = c.gw; row < ML; row += c.NGW) {
        float ss = 0.f;
#pragma unroll
        for (int x = 0; x < 8; ++x) ss += SSQP[(size_t)x * ML + row];
        const float r = rsqrtf(ss * (1.f / D) + EPS); const float* mr = MOD + (row >> 11) * 6144 + 5120;
#pragma unroll
        for (int j = 0; j < 4; ++j) { const int col = 4 * c.lane + 256 * j;
            const f32x4 y = *(const f32x4*)(Y + (size_t)row * D + col), x1 = *(const f32x4*)(a.out + (size_t)row * D + col), g4 = *(const f32x4*)(a.in[I_GPOSTFFN] + col), gt = *(const f32x4*)(mr + col);
            *(f32x4*)(a.out + (size_t)row * D + col) = x1 + gt * ((y * r) * g4); }
    }
}

__device__ __forceinline__ void phase_experts(const Ctx& c) {
    const Args& a = *c.a;
    const float* MOD = (const float*)(c.ws + WS_MOD); const bf16* HX2 = (const bf16*)(c.ws + WS_HX2); const int* IDX = (const int*)(c.ws + WS_IDX); const float* GATE = (const float*)(c.ws + WS_GATE);
    float* acts = (float*)c.lds; int* eid = (int*)(c.lds + 512); float* red = (float*)(c.lds + 1024);
    for (int tok = c.bid; tok < ML; tok += c.G) {
        float hv[16];
#pragma unroll
        for (int j = 0; j < 4; ++j) { const v2u w = *(const v2u*)(HX2 + (size_t)tok * D + 4 * c.lane + 256 * j); hv[4 * j] = bflo(w.x); hv[4 * j + 1] = bfhi(w.x); hv[4 * j + 2] = bflo(w.y); hv[4 * j + 3] = bfhi(w.y); }
#pragma unroll 4
        for (int i = 0; i < 16; ++i) { const int k = c.wave * 16 + i; const int e = IDX[(size_t)tok * 128 + k];
            const f32x4* ur = (const f32x4*)(a.in[I_PU] + (size_t)e * D) + c.lane; float s = 0.f;
#pragma unroll
            for (int j = 0; j < 4; ++j) { const f32x4 u4 = ur[64 * j]; s += (u4.x * hv[4 * j] + u4.y * hv[4 * j + 1]) + (u4.z * hv[4 * j + 2] + u4.w * hv[4 * j + 3]); }
            s = wave_sum(s);
            if (c.lane == 0) { acts[k] = gelu_erf(s) * GATE[(size_t)tok * 128 + k]; eid[k] = e; } }
        __syncthreads();
        f32x2 acc = (f32x2){0.f, 0.f};
#pragma unroll 8
        for (int k = 0; k < 128; ++k) { const f32x2 v2 = *(const f32x2*)(a.in[I_PV] + (size_t)eid[k] * D + 2 * c.tid); const float ak = acts[k]; acc.x = fmaf(ak, v2.x, acc.x); acc.y = fmaf(ak, v2.y, acc.y); }
        const float ws = wave_sum(acc.x * acc.x + acc.y * acc.y);
        if (c.lane == 0) red[c.wave] = ws;
        __syncthreads();
        float tot = 0.f;
#pragma unroll
        for (int w = 0; w < 8; ++w) tot += red[w];
        const float r = rsqrtf(tot * (1.f / D) + EPS);
        const int col = 2 * c.tid; const float* mr = MOD + (tok >> 11) * 6144 + 5120;
        const f32x2 x1 = *(const f32x2*)(a.out + (size_t)tok * D + col), g2 = *(const f32x2*)(a.in[I_GPOSTFFN] + col), gt = *(const f32x2*)(mr + col);
        *(f32x2*)(a.out + (size_t)tok * D + col) = (f32x2){x1.x + gt.x * (acc.x * r * g2.x), x1.y + gt.y * (acc.y * r * g2.y)};
        __syncthreads();
    }
}


#define XB_TMO      128
#define XB_XCNT(j)  (256  + 64 * (j))
#define XB_XSUB(j)  (1280 + 64 * (j))
#define XB_XGEN(j)  (2304 + 64 * (j))
#define XB_TOP      3328
#define XB_TOPGEN   3392
#define XCD_BAR_WORDS 3456
#define XB_SPIN_CAP (1u << 20)
__device__ __forceinline__ unsigned xb_ld(unsigned* p)              { return __hip_atomic_load(p, __ATOMIC_RELAXED, __HIP_MEMORY_SCOPE_AGENT); }
__device__ __forceinline__ unsigned xb_add(unsigned* p, unsigned v) { return __hip_atomic_fetch_add(p, v, __ATOMIC_RELAXED, __HIP_MEMORY_SCOPE_AGENT); }
__device__ __forceinline__ unsigned xb_xcc_id() { return (unsigned)__builtin_amdgcn_s_getreg((3 << 11) | 20) & 0xFu; }
#define XB_SPIN(cond, bar) do { unsigned _sp = 0; while (cond) { __builtin_amdgcn_s_sleep(1); \
    if ((++_sp & 255u) == 0u) { if (xb_ld(&(bar)[XB_TMO])) break; if (_sp > XB_SPIN_CAP) { atomicAdd(&(bar)[XB_TMO], 1u); break; } } } } while (0)
struct XcdBarrier { unsigned* bar; unsigned x; volatile LAS unsigned* st; };
__device__ __forceinline__ XcdBarrier xcd_barrier_post(unsigned* bar, volatile LAS unsigned* st) {
    XcdBarrier b; b.bar = bar; b.x = xb_xcc_id(); b.st = st;
    if (threadIdx.x == 0) (void)xb_add(&bar[XB_XCNT(b.x)], 1u);
    return b;
}
__device__ __forceinline__ void xcd_barrier_complete(unsigned* bar, unsigned x, unsigned& nloc, unsigned& nx) {
    const unsigned G = gridDim.x * gridDim.y * gridDim.z;
    unsigned sum, cnt, mine, sp = 0u;
    for (;;) {
        sum = 0u; cnt = 0u; mine = 0u;
#pragma unroll
        for (unsigned j = 0; j < 16; ++j) { const unsigned c = xb_ld(&bar[XB_XCNT(j)]); sum += c; cnt += (c > 0u) ? 1u : 0u; mine = (j == x) ? c : mine; }
        if (sum == G) break;
        __builtin_amdgcn_s_sleep(1);
        if ((++sp & 255u) == 0u) { if (xb_ld(&bar[XB_TMO])) break; if (sp > XB_SPIN_CAP) { atomicAdd(&bar[XB_TMO], 1u); break; } }
    }
    nloc = mine > 0u ? mine : 1u; nx = cnt > 0u ? cnt : 1u;
}
__device__ __forceinline__ void xcd_barrier(const XcdBarrier& b) {
    asm volatile("s_waitcnt vmcnt(0)" ::: "memory");
    __syncthreads();
    if (threadIdx.x == 0) {
        unsigned* bar = b.bar;
        __builtin_amdgcn_s_waitcnt(0);
        unsigned nloc = b.st[0], nx = b.st[1];
        if (nloc == 0u) { xcd_barrier_complete(bar, b.x, nloc, nx); b.st[0] = nloc; b.st[1] = nx; }
        const unsigned old = xb_add(&bar[XB_XSUB(b.x)], 1u);
        const unsigned gen = old / nloc;
        if (old + 1u == (gen + 1u) * nloc) {
            __builtin_amdgcn_fence(__ATOMIC_RELEASE, "agent");
            asm volatile("s_waitcnt vmcnt(0)" ::: "memory");
            const unsigned og = xb_add(&bar[XB_TOP], 1u);
            const unsigned tg = og / nx;
            if (og + 1u == (tg + 1u) * nx) xb_add(&bar[XB_TOPGEN], 1u);
            else XB_SPIN(xb_ld(&bar[XB_TOPGEN]) == tg, bar);
            __builtin_amdgcn_fence(__ATOMIC_ACQUIRE, "agent");
            xb_add(&bar[XB_XGEN(b.x)], 1u);
            asm volatile("s_waitcnt vmcnt(0)" ::: "memory");
        } else {
            XB_SPIN(xb_ld(&bar[XB_XGEN(b.x)]) == gen, bar);
            __builtin_amdgcn_fence(__ATOMIC_ACQUIRE, "agent");
            asm volatile("s_waitcnt vmcnt(0)" ::: "memory");
        }
    }
    __syncthreads();
}

constexpr int LDS_MISC = LDS_BYTES - 64;
__global__ void __launch_bounds__(NTHREADS, 2) mk_fwd(Args args) {
    extern __shared__ __attribute__((aligned(16))) unsigned char lds[];
    Ctx c; c.a = &args; c.ws = args.ws; c.lds = lds;
    c.tid = threadIdx.x; c.lane = c.tid & 63; c.wave = __builtin_amdgcn_readfirstlane(c.tid >> 6); c.bid = blockIdx.x; c.G = gridDim.x;
    c.gw = c.bid * NWAVES + c.wave; c.NGW = c.G * NWAVES; c.gwv = c.wave * c.G + c.bid;
    const int lo = args.ph_lo, hi = args.ph_hi;
    PG8_LAS unsigned char* ring = (PG8_LAS unsigned char*)lds;
#ifndef MK_PH_MASK
#define MK_PH_MASK 0xffff
#endif
#define IN(k) (((MK_PH_MASK >> (k)) & 1) && lo <= (k) && (k) < hi)
#if MK_ONE_LAUNCH
    cg::grid_group grid = cg::this_grid();
    if (lo < 0) grid.sync();
    volatile LAS unsigned* st = (volatile LAS unsigned*)((LAS unsigned char*)lds + LDS_MISC);
    if (c.tid < 2) st[c.tid] = 0u;
    __syncthreads();
    const XcdBarrier bar = xcd_barrier_post((unsigned*)(c.ws + WS_CTL) + CW_BAR, st);
#define SEAM(k) do { if (IN(k) && IN((k) + 1) && !((k) >= 11 && MK_EXP_OLD)) xcd_barrier(bar); } while (0)
#else
#define SEAM(k) do { } while (0)
#endif
    if (IN(0)) { phase_prep(c); } SEAM(0);
    if (IN(1)) { phase_norm1(c); } SEAM(1);
    if (IN(2)) { pg8::Gemm g{(const pg8::bf16_t*)(c.ws + WS_HX), (const pg8::bf16_t*)(c.ws + WS_WIN), 1024, 1024, 1024}; pg8::StaticOrder S; S.init(MT, NPROJ, c.G, c.bid);
        pg8::EpiInProj E{(pg8::bf16_t*)(c.ws + WS_U), (pg8::bf16_t*)(c.ws + WS_QKVPRE), (pg8::bf16_t*)(c.ws + WS_Z)};
        pg8::gemm_phase<pg8::EpiInProj, pg8::StaticOrder, true, true>(ring, g, S, E); } SEAM(2);
    if (IN(3)) { phase_conv(c); } SEAM(3);
    if (IN(4)) { phase_scan_direct(c); } SEAM(4);
    if (IN(5)) { phase_combine(c); } SEAM(5);
    if (IN(6)) { pg8::Gemm g{(const pg8::bf16_t*)(c.ws + WS_YG), (const pg8::bf16_t*)(c.ws + WS_WGLU), 512, 512, 512}; pg8::StaticOrder S; S.init(ML, 512, c.G, c.bid);
        pg8::EpiGlu E{(const pg8::bf16_t*)(c.ws + WS_YG), (pg8::bf16_t*)(c.ws + WS_CAT)};
        pg8::gemm_phase<pg8::EpiGlu, pg8::StaticOrder, true, true>(ring, g, S, E); } SEAM(6);
    if (IN(7)) { pg8::Gemm g{(const pg8::bf16_t*)(c.ws + WS_CAT), (const pg8::bf16_t*)(c.ws + WS_WOUT), 1024, 1024, 1024}; pg8::StaticOrder S; S.init(ML, 1024, c.G, c.bid);
        pg8::EpiF32 E{(float*)(c.ws + WS_YRAW), 1024};
        pg8::gemm_phase<pg8::EpiF32, pg8::StaticOrder, true, true>(ring, g, S, E); } SEAM(7);
    if (IN(8)) { phase_rows2(c); phase_fp8_tables(c); } SEAM(8);
    if (IN(9)) { pg8::Gemm g{(const pg8::bf16_t*)(c.ws + WS_HX2), (const pg8::bf16_t*)(c.ws + WS_WQ), 1024, 1024, 1024}; pg8::StaticOrder S; S.init(ML, 2048, c.G, c.bid);
        pg8::EpiBf16<0> E{(pg8::bf16_t*)(c.ws + WS_QP), 2048, nullptr, 0, 0, 1.f};
        pg8::gemm_phase<pg8::EpiBf16<0>, pg8::StaticOrder, true, true>(ring, g, S, E); } SEAM(9);
    if (IN(10)) { phase_topk(c); } SEAM(10);
#if MK_EXP_OLD
    if (IN(11)) { phase_experts(c); }
#else
    if (IN(11)) { phase_exp1(c); } SEAM(11);
    if (IN(12)) { phase_exp2(c); } SEAM(12);
    if (IN(13)) { phase_exp3(c); }
#endif
#undef IN
#undef SEAM
}

extern "C" void kernel_launch(void* const* d_in, const int* in_sizes, int n_in, void* d_out, int out_size, void* d_ws, size_t ws_size, hipStream_t stream) {
    static int grid = 0;
    if (grid == 0) {
        if (n_in != 29 || out_size != ML * D || ws_size < WS_END) { fprintf(stderr, "kernel_launch: unexpected shapes (n_in %d out %d ws %zu)\n", n_in, out_size, ws_size); grid = -1; return; }
        int dev = 0, cus = 0, per_cu = 0;
        (void)hipGetDevice(&dev); (void)hipDeviceGetAttribute(&cus, hipDeviceAttributeMultiprocessorCount, dev);
        if (hipFuncSetAttribute((const void*)mk_fwd, hipFuncAttributeMaxDynamicSharedMemorySize, LDS_BYTES) != hipSuccess) { fprintf(stderr, "kernel_launch: hipFuncSetAttribute failed\n"); grid = -1; return; }
        (void)hipOccupancyMaxActiveBlocksPerMultiprocessor(&per_cu, (const void*)mk_fwd, NTHREADS, LDS_BYTES);
        (void)hipGetLastError();
        grid = cus;
        fprintf(stderr, "kernel_launch: cus %d per_cu %d grid %d\n", cus, per_cu, grid);
    }
    if (grid < 0) return;
    Args a{};
    for (int i = 0; i < 29; ++i) a.in[i] = (const float*)d_in[i];
    a.out = (float*)d_out; a.ws = (unsigned char*)d_ws;
    (void)hipMemsetAsync((char*)d_ws + WS_CTL, 0, CTL_ZERO_BYTES, stream);
#if MK_ONE_LAUNCH
    a.ph_lo = 0; a.ph_hi = NPHASES;
    void* kargs[] = {&a};
    hipError_t e = hipLaunchCooperativeKernel((const void*)mk_fwd, dim3(grid), dim3(NTHREADS), kargs, LDS_BYTES, stream);
    if (e != hipSuccess) fprintf(stderr, "kernel_launch: cooperative launch failed: %s\n", hipGetErrorString(e));
#else
    for (int ph = 0; ph < NPHASES; ++ph) { a.ph_lo = ph; a.ph_hi = ph + 1; hipLaunchKernelGGL(mk_fwd, dim3(grid), dim3(NTHREADS), LDS_BYTES, stream, a); }
#endif
}
```

```cpp
#include <hip/hip_runtime.h>
#include <hip/hip_cooperative_groups.h>
#include <cstdio>
#include <cstdint>
namespace cg = cooperative_groups;
namespace pg8 {
#define PG8_LAS __attribute__((address_space(3)))
typedef unsigned short bf16_t;
typedef short bf16x8 __attribute__((ext_vector_type(8)));
typedef float f32x4 __attribute__((ext_vector_type(4)));
typedef unsigned u32x4 __attribute__((ext_vector_type(4)));
constexpr int BM = 256, BK = 64, HALF = 128, HTB = HALF * BK * 2  , STAGE_BYTES = 8 * HTB, NXCD = 8, WGM = 8;

__host__ __device__ __forceinline__ int lds_byte(int r, int c) { const int st = (r >> 4) * 2 + (c >> 5), rr = r & 15, cc = c & 31, ob = rr * 64 + cc * 2; return st * 1024 + (ob ^ (((ob >> 9) & 1) << 5)); }
__host__ __device__ __forceinline__ void stage_rc(int b, int& R, int& C) { const int st = b / 1024, sb = b % 1024, swz = sb ^ (((sb >> 9) & 1) << 5); R = (st >> 1) * 16 + swz / 64; C = (st & 1) * 32 + (swz % 64) / 2; }
__host__ __device__ __forceinline__ int perm32(int rho) { const int n = rho >> 4, i = rho & 15; return 8 * (i >> 2) + 4 * n + (i & 3); }

struct Unit { int pm, pn; };
struct Gemm { const bf16_t* A; const bf16_t* Bt; int lda, ldb, K; };

struct StaticOrder {
    int nM, nN, nwg, G, c;
    __host__ __device__ void init(int M, int N, int G_, int c_) { nM = M / BM; nN = N / BM; nwg = nM * nN; G = G_; c = c_; }
    __host__ __device__ bool next(int i, Unit& u) const {
        const long L = (long)i * G + c; if (L >= nwg) return false;
        int wgid = (int)L; { const int q = nwg / NXCD, r = nwg % NXCD, xcd = wgid % NXCD, off = wgid / NXCD; wgid = (xcd < r ? xcd * (q + 1) : r * (q + 1) + (xcd - r) * q) + off; }
        const int nig = WGM * nN, gid = wgid / nig, fm = gid * WGM, gsz = (nM - fm) < WGM ? (nM - fm) : WGM;
        u.pm = fm + ((wgid % nig) % gsz); u.pn = (wgid % nig) / gsz; return true;
    }
    __device__ __forceinline__ void a_ready(const Unit&) const {}
    __device__ __forceinline__ void done(const Unit&) const {}
};

__device__ __forceinline__ unsigned cvt_pk_bf16(float lo, float hi) { unsigned r; asm volatile("v_cvt_pk_bf16_f32 %0, %1, %2" : "=v"(r) : "v"(lo), "v"(hi)); return r; }
typedef float f32x2 __attribute__((ext_vector_type(2)));
__device__ __forceinline__ f32x2 gelu_pk(f32x2 v) {
    const f32x2 av = __builtin_elementwise_abs(v), d = av * 0.2316418882f + 1.0f;
    f32x2 t; t.x = __builtin_amdgcn_rcpf(d.x); t.y = __builtin_amdgcn_rcpf(d.y);
    f32x2 q = t * 0.5307027145f + (-0.7265760135f); q = q * t + 0.7107068705f; q = q * t + (-0.142248368f); q = q * t + 0.127414796f; q = q * t;
    const f32x2 s = (v * v) * (-0.72134752044f);
    f32x2 e; e.x = __builtin_amdgcn_exp2f(s.x); e.y = __builtin_amdgcn_exp2f(s.y);
    const f32x2 m = v * (q * e), r = v - m;
    f32x2 o; o.x = v.x < 0.f ? m.x : r.x; o.y = v.y < 0.f ? m.y : r.y; return o;
}

template <int ACT  > struct EpiBf16 {
    static constexpr bool PERM = true, AFTER_DRAIN = false; static_assert(ACT == 0 || ACT == 1, "EpiBf16: ACT is 0 (none) or 1 (gelu_pk)");
    bf16_t* O; int ldc; const float* bias; int split_cols; size_t split_stride; float scale0;
    __device__ __forceinline__ void operator()(const f32x4 (&acc)[2][2][4][2], const Unit& u, int wr, int wc, int fr, int fq) const {
        const int row0 = u.pm * BM + wr * 64 + fr; int colt = u.pn * BM; bf16_t* base = O;
        float sc = 1.f; if (split_cols) { const int t = colt / split_cols; base += (size_t)t * split_stride; colt -= t * split_cols; if (t == 0) sc = scale0; }
        const int col0 = colt + wc * 32 + 8 * fq, bcol0 = u.pn * BM + wc * 32 + 8 * fq;
        f32x4 bv[2][2];
#pragma unroll
        for (int bj = 0; bj < 2; ++bj)
#pragma unroll
            for (int n = 0; n < 2; ++n) bv[bj][n] = bias ? *(const f32x4*)(bias + bcol0 + bj * HALF + 4 * n) : (f32x4){0.f, 0.f, 0.f, 0.f};
#pragma unroll
        for (int ai = 0; ai < 2; ++ai)
#pragma unroll
            for (int m = 0; m < 4; ++m) { bf16_t* rowp = base + (size_t)(row0 + ai * HALF + m * 16) * ldc + col0;
#pragma unroll
                for (int bj = 0; bj < 2; ++bj) { f32x4 v0 = acc[ai][bj][m][0] + bv[bj][0], v1 = acc[ai][bj][m][1] + bv[bj][1];
                    if (ACT == 1) { f32x2 a = gelu_pk((f32x2){v0[0], v0[1]}), b = gelu_pk((f32x2){v0[2], v0[3]}), c = gelu_pk((f32x2){v1[0], v1[1]}), d = gelu_pk((f32x2){v1[2], v1[3]});
                        v0 = (f32x4){a.x, a.y, b.x, b.y}; v1 = (f32x4){c.x, c.y, d.x, d.y}; }
                    v0 = v0 * sc; v1 = v1 * sc; u32x4 w; w.x = cvt_pk_bf16(v0[0], v0[1]); w.y = cvt_pk_bf16(v0[2], v0[3]); w.z = cvt_pk_bf16(v1[0], v1[1]); w.w = cvt_pk_bf16(v1[2], v1[3]);
                    *(u32x4*)(rowp + bj * HALF) = w; } }
    }
};

template <class Epi, class Sched, bool ALIGN_EPI = false, bool SP2 = false>
__device__ __forceinline__ void gemm_phase(PG8_LAS unsigned char* lds, const Gemm g, const Sched& S, const Epi& E) {
    const int tid = threadIdx.x, wid = __builtin_amdgcn_readfirstlane(tid >> 6), lane = tid & 63, wr = wid >> 2, wc = wid & 3, fr = lane & 15, fq = lane >> 4;
    const int K = g.K, nt = K / BK;
    unsigned voffA[2], voffB[2];
#pragma unroll
    for (int i = 0; i < 2; ++i) { int R, C; stage_rc(tid * 16 + i * 8192, R, C); const int Rb = Epi::PERM ? ((R & ~31) + perm32(R & 31)) : R;
        voffA[i] = (unsigned)(R * g.lda + C) * 2u; voffB[i] = (unsigned)(Rb * g.ldb + C) * 2u; }
    const size_t kstep = (size_t)(BK * 2);
    const size_t hstepA = (size_t)HALF * g.lda * 2, hstepB = (size_t)HALF * g.ldb * 2;
    const size_t tstepA = 2 * hstepA, tstepB = 2 * hstepB;
    const unsigned ldsw = (unsigned)wid * 1024u;
    const int aoff = lds_byte(wr * 64 + fr, fq * 8), boff = lds_byte(wc * 32 + fr, fq * 8);
#define PG8_SA(b, h) (((b) * 2 + (h)) * HTB)
#define PG8_SB(b, h) ((4 + (b) * 2 + (h)) * HTB)
#define PG8_STAGE(bufoff, gbase, voff) do { _Pragma("unroll") for (int _i = 0; _i < 2; ++_i) \
        __builtin_amdgcn_global_load_lds((const unsigned*)((const char*)(gbase) + (voff)[_i]), (PG8_LAS unsigned*)(lds + (bufoff) + ldsw + _i * 8192), 16, 0, 0); } while (0)
#define PG8_LDA(dst, b, h) do { _Pragma("unroll") for (int m = 0; m < 4; ++m) _Pragma("unroll") for (int k = 0; k < 2; ++k) dst[m][k] = *(const PG8_LAS bf16x8*)(lds + PG8_SA(b, h) + aoff + m * 2048 + k * 1024); } while (0)
#define PG8_LDB(dst, b, h) do { _Pragma("unroll") for (int n = 0; n < 2; ++n) _Pragma("unroll") for (int k = 0; k < 2; ++k) dst[n][k] = *(const PG8_LAS bf16x8*)(lds + PG8_SB(b, h) + boff + n * 2048 + k * 1024); } while (0)
#define PG8_MMA(ai, bj, At, Bt) do { __builtin_amdgcn_s_setprio(1); _Pragma("unroll") for (int m = 0; m < 4; ++m) _Pragma("unroll") for (int n = 0; n < 2; ++n) _Pragma("unroll") for (int k = 0; k < 2; ++k) \
        acc[ai][bj][m][n] = __builtin_amdgcn_mfma_f32_16x16x32_bf16(Bt[n][k], At[m][k], acc[ai][bj][m][n], 0, 0, 0); __builtin_amdgcn_s_setprio(0); } while (0)
#define PG8_WAIT_V(n) asm volatile("s_waitcnt vmcnt(" #n ")" ::: "memory")
#define PG8_WAIT_L(n) asm volatile("s_waitcnt lgkmcnt(" #n ")" ::: "memory")
#define PG8_BAR __builtin_amdgcn_s_barrier()
#define PG8_SCHED __builtin_amdgcn_sched_barrier(0)
    Unit cur, nxt; int ui = 0;
    if (!S.next(0, cur)) return;
    f32x4 acc[2][2][4][2];
#pragma unroll
    for (int a = 0; a < 2; ++a)
#pragma unroll
        for (int b = 0; b < 2; ++b)
#pragma unroll
            for (int m = 0; m < 4; ++m)
#pragma unroll
                for (int n = 0; n < 2; ++n) acc[a][b][m][n] = (f32x4){0.f, 0.f, 0.f, 0.f};
    bf16x8 At[4][2], B0[2][2], B1[2][2];
    const char* cA = (const char*)g.A + (size_t)cur.pm * tstepA; const char* cB = (const char*)g.Bt + (size_t)cur.pn * tstepB;
    S.a_ready(cur);
    if constexpr (SP2) {
        PG8_STAGE(PG8_SB(0, 0), cB, voffB); PG8_STAGE(PG8_SB(0, 1), cB + hstepB, voffB); PG8_STAGE(PG8_SA(0, 0), cA, voffA); PG8_STAGE(PG8_SA(0, 1), cA + hstepA, voffA);
        if (wr == 1) PG8_BAR;
        PG8_WAIT_V(2); PG8_BAR;
        PG8_STAGE(PG8_SB(1, 0), cB + kstep, voffB); PG8_STAGE(PG8_SA(1, 0), cA + kstep, voffA); PG8_STAGE(PG8_SB(1, 1), cB + hstepB + kstep, voffB);
        PG8_WAIT_V(6); PG8_BAR;
    } else {
        PG8_STAGE(PG8_SB(0, 0), cB, voffB); PG8_STAGE(PG8_SA(0, 0), cA, voffA); PG8_STAGE(PG8_SB(0, 1), cB + hstepB, voffB); PG8_STAGE(PG8_SA(0, 1), cA + hstepA, voffA);
        if (wr == 1) PG8_BAR;
        PG8_WAIT_V(4); PG8_BAR;
        PG8_STAGE(PG8_SB(1, 0), cB + kstep, voffB); PG8_STAGE(PG8_SA(1, 0), cA + kstep, voffA); PG8_STAGE(PG8_SB(1, 1), cB + hstepB + kstep, voffB);
        PG8_WAIT_V(6); PG8_BAR;
    }
    for (;;) {
        const bool has_next = S.next(ui + 1, nxt);
        const char* nA = has_next ? (const char*)g.A + (size_t)nxt.pm * tstepA : cA; const char* nB = has_next ? (const char*)g.Bt + (size_t)nxt.pn * tstepB : cB;
        for (int t = 0; t < nt; t += 2) {
            const bool last = (t == nt - 2);
            const char* a1 = cA + (size_t)(t + 1) * kstep;
            const char* a2 = last ? nA : cA + (size_t)(t + 2) * kstep; const char* b2 = last ? nB : cB + (size_t)(t + 2) * kstep;
            const char* a3 = a2 + kstep; const char* b3 = b2 + kstep;
            if (last && has_next) S.a_ready(nxt);
            if constexpr (SP2) {
            PG8_LDB(B0, 0, 0); PG8_LDB(B1, 0, 1); PG8_SCHED; PG8_LDA(At, 0, 0); PG8_STAGE(PG8_SA(1, 1), a1 + hstepA, voffA);
            PG8_WAIT_V(8); PG8_WAIT_L(0); PG8_BAR; PG8_MMA(0, 0, At, B0); PG8_MMA(0, 1, At, B1); PG8_BAR; PG8_SCHED;
            PG8_LDA(At, 0, 1); PG8_STAGE(PG8_SB(0, 0), b2, voffB); PG8_STAGE(PG8_SB(0, 1), b2 + hstepB, voffB); PG8_STAGE(PG8_SA(0, 0), a2, voffA);
            PG8_WAIT_V(8); PG8_WAIT_L(0); PG8_BAR; PG8_MMA(1, 0, At, B0); PG8_MMA(1, 1, At, B1); PG8_BAR; PG8_SCHED;
            PG8_LDB(B0, 1, 0); PG8_LDB(B1, 1, 1); PG8_SCHED; PG8_LDA(At, 1, 0); PG8_STAGE(PG8_SA(0, 1), a2 + hstepA, voffA);
            PG8_WAIT_V(8); PG8_WAIT_L(0); PG8_BAR; PG8_MMA(0, 0, At, B0); PG8_MMA(0, 1, At, B1); PG8_BAR; PG8_SCHED;
            PG8_LDA(At, 1, 1); PG8_STAGE(PG8_SB(1, 0), b3, voffB); PG8_STAGE(PG8_SB(1, 1), b3 + hstepB, voffB); PG8_STAGE(PG8_SA(1, 0), a3, voffA);
            PG8_WAIT_V(8); PG8_WAIT_L(0); PG8_BAR; PG8_MMA(1, 0, At, B0); PG8_MMA(1, 1, At, B1); PG8_BAR; PG8_SCHED;
            } else {
            PG8_LDB(B0, 0, 0); PG8_SCHED; PG8_LDA(At, 0, 0); PG8_STAGE(PG8_SA(1, 1), a1 + hstepA, voffA);
            PG8_WAIT_L(8); PG8_BAR; PG8_WAIT_L(0); PG8_MMA(0, 0, At, B0); PG8_BAR; PG8_SCHED;
            PG8_LDB(B1, 0, 1); PG8_STAGE(PG8_SB(0, 0), b2, voffB);
            PG8_BAR; PG8_WAIT_L(0); PG8_MMA(0, 1, At, B1); PG8_BAR;
            PG8_LDA(At, 0, 1); PG8_STAGE(PG8_SA(0, 0), a2, voffA);
            PG8_BAR; PG8_WAIT_L(0); PG8_MMA(1, 0, At, B0); PG8_BAR; PG8_SCHED;
            PG8_STAGE(PG8_SB(0, 1), b2 + hstepB, voffB);
            PG8_WAIT_V(6); PG8_BAR; PG8_MMA(1, 1, At, B1); PG8_BAR;
            PG8_LDB(B0, 1, 0); PG8_SCHED; PG8_LDA(At, 1, 0); PG8_STAGE(PG8_SA(0, 1), a2 + hstepA, voffA);
            PG8_WAIT_L(8); PG8_BAR; PG8_WAIT_L(0); PG8_MMA(0, 0, At, B0); PG8_BAR; PG8_SCHED;
            PG8_LDB(B1, 1, 1); PG8_STAGE(PG8_SB(1, 0), b3, voffB);
            PG8_BAR; PG8_WAIT_L(0); PG8_MMA(0, 1, At, B1); PG8_BAR;
            PG8_LDA(At, 1, 1); PG8_STAGE(PG8_SA(1, 0), a3, voffA);
            PG8_BAR; PG8_WAIT_L(0); PG8_MMA(1, 0, At, B0); PG8_BAR; PG8_SCHED;
            PG8_STAGE(PG8_SB(1, 1), b3 + hstepB, voffB);
            PG8_WAIT_V(6); PG8_BAR; PG8_MMA(1, 1, At, B1); PG8_BAR;
            }
        }
        if constexpr (ALIGN_EPI) { if (wr == 0) PG8_BAR; }
        if constexpr (!Epi::AFTER_DRAIN) { E(acc, cur, wr, wc, fr, fq); S.done(cur); }
        if (!has_next) break;
#pragma unroll
        for (int a = 0; a < 2; ++a)
#pragma unroll
            for (int b = 0; b < 2; ++b)
#pragma unroll
                for (int m = 0; m < 4; ++m)
#pragma unroll
                    for (int n = 0; n < 2; ++n) acc[a][b][m][n] = (f32x4){0.f, 0.f, 0.f, 0.f};
        cur = nxt; cA = nA; cB = nB; ++ui;
        if constexpr (ALIGN_EPI) { if (wr == 1) PG8_BAR; }
    }
    PG8_WAIT_V(0);
    if constexpr (!ALIGN_EPI) { if (wr == 0) PG8_BAR; }
    PG8_BAR;
    if constexpr (Epi::AFTER_DRAIN) { E.fused(acc, cur, wr, wc, fr, fq, lds, wid, lane); S.done(cur); }
#undef PG8_SA
#undef PG8_SB
#undef PG8_STAGE
#undef PG8_LDA
#undef PG8_LDB
#undef PG8_MMA
#undef PG8_WAIT_V
#undef PG8_WAIT_L
#undef PG8_BAR
#undef PG8_SCHED
}
}

#ifndef MK_EXP_OLD
#define MK_EXP_OLD 0
#endif
#ifndef MK_ONE_LAUNCH
#define MK_ONE_LAUNCH 1
#endif
#define LAS __attribute__((address_space(3)))
typedef unsigned short bf16;
typedef unsigned v4u __attribute__((ext_vector_type(4)));
typedef unsigned v2u __attribute__((ext_vector_type(2)));
typedef float f32x4 __attribute__((ext_vector_type(4)));
typedef float f32x2 __attribute__((ext_vector_type(2)));

constexpr int D = 1024, NB = 8, SEQ = 2048, LC = 256, ML = NB * SEQ  , MC = NB * LC  , MT = ML + MC  ;
constexpr int PROJ = 2576, NPROJ = 2560;
constexpr int NEXP = 16384, TOPK = 16, KK = 128;
constexpr float EPS = 1e-6f;
constexpr int NTHREADS = 512, NWAVES = 8;
constexpr int LDS_BYTES = 147456;
constexpr int NPHASES = 15;

constexpr size_t MiB = 1u << 20;
constexpr size_t WS_CTL = 0;
constexpr size_t CTL_ZERO_BYTES = 65536;
constexpr int CW_BAR = 0;
constexpr int CW_E1 = 4096, CW_E2 = 4096 + 8 * 64;
constexpr size_t WS_MOD = 1 * MiB;
constexpr size_t WS_WIN = 2 * MiB;
constexpr size_t WS_WOUT = 8 * MiB;
constexpr size_t WS_WGLU = 10 * MiB;
constexpr size_t WS_WQ = 11 * MiB;
constexpr size_t WS_GB = 15 * MiB;
constexpr size_t WS_IDX = 17 * MiB;
constexpr size_t WS_GATE = 26 * MiB;
constexpr size_t WS_HX = 35 * MiB;
constexpr size_t WS_U = 72 * MiB;
constexpr size_t WS_YRAW = 35 * MiB;
constexpr size_t WS_Z = 100 * MiB;
constexpr size_t WS_QKVPRE = 116 * MiB;
constexpr size_t WS_OG = 116 * MiB;
constexpr size_t WS_HX2 = 116 * MiB;
constexpr size_t WS_QKV = 170 * MiB;
constexpr size_t WS_CAT = 170 * MiB;
constexpr size_t WS_YG = 202 * MiB;
constexpr size_t WS_QP = 35 * MiB;
constexpr size_t WS_Y = 35 * MiB;
constexpr size_t WS_ACT = 100 * MiB;
constexpr size_t WS_SSQP = 108 * MiB;
constexpr size_t WS_USC = 109 * MiB;
constexpr size_t WS_VSC = 110 * MiB;
constexpr size_t WS_U8 = 224 * MiB;
constexpr size_t WS_V8 = 240 * MiB;
constexpr size_t WS_YS5 = 224 * MiB;
constexpr size_t WS_FRA = 17 * MiB;
constexpr size_t WS_FRK = 36 * MiB;
constexpr size_t WS_FRTAB = 92 * MiB;
constexpr size_t WS_FRT = 148 * MiB;
constexpr size_t WS_END = 256 * MiB;
static_assert(WS_YRAW + (size_t)ML * D * 4 <= WS_Z && WS_Z + (size_t)ML * 512 * 2 <= WS_QKVPRE && WS_QKVPRE + (size_t)MT * 1536 * 2 <= WS_QKV && WS_QKV + (size_t)MT * 1536 * 2 <= WS_YS5, "ws map");
static_assert(WS_QP + (size_t)ML * 2048 * 2 <= WS_Z && WS_YS5 + (size_t)2 * ML * 512 * 2 <= WS_END && WS_YG + (size_t)ML * 512 * 2 <= WS_YS5 && WS_U + (size_t)MT * 512 * 2 <= WS_Z, "ws map 2");
static_assert(WS_GATE + (size_t)ML * 128 * 4 <= WS_HX && WS_IDX + (size_t)ML * 128 * 4 <= WS_GATE && WS_HX + (size_t)MT * D * 2 <= WS_U, "ws map 3");

__device__ __forceinline__ unsigned f2bf(float f) { unsigned u = __builtin_bit_cast(unsigned, f); return (u + 0x7fffu + ((u >> 16) & 1u)) >> 16; }
__device__ __forceinline__ unsigned pk2(float lo, float hi) { return f2bf(lo) | (f2bf(hi) << 16); }
__device__ __forceinline__ float bflo(unsigned w) { return __builtin_bit_cast(float, w << 16); }
__device__ __forceinline__ float bfhi(unsigned w) { return __builtin_bit_cast(float, w & 0xffff0000u); }
__device__ __forceinline__ float bf1(bf16 h) { return __builtin_bit_cast(float, (unsigned)h << 16); }
__device__ __forceinline__ float wave_sum(float v) {
#pragma unroll
    for (int o = 1; o < 64; o <<= 1) v += __shfl_xor(v, o);
    return v;
}
__device__ __forceinline__ float wave_max(float v) {
#pragma unroll
    for (int o = 1; o < 64; o <<= 1) v = fmaxf(v, __shfl_xor(v, o));
    return v;
}
__device__ __forceinline__ float sigmoidf_(float x) { return 1.f / (1.f + __expf(-x)); }
__device__ __forceinline__ float siluf_(float x) { return x / (1.f + __expf(-x)); }
__device__ __forceinline__ float gelu_erf(float x) { return 0.5f * x * (1.f + erff(x * 0.70710678118654752f)); }
__device__ __forceinline__ void sincos_d(double a, float& s, float& c) {
    const double k = rint(a * 0.63661977236758134308);
    const double r = fma(-k, 1.57079632679489661923, a) - k * 6.123233995736766e-17;
    const double r2 = r * r;
    double sp = -2.5052108385441720e-08; sp = sp * r2 + 2.7557319223985893e-06; sp = sp * r2 - 1.9841269841269841e-04; sp = sp * r2 + 8.3333333333333332e-03; sp = sp * r2 - 1.6666666666666666e-01;
    const double sn = r + r * r2 * sp;
    double cp = 2.0876756987868099e-09; cp = cp * r2 - 2.7557319223985888e-07; cp = cp * r2 + 2.4801587301587302e-05; cp = cp * r2 - 1.3888888888888889e-03; cp = cp * r2 + 4.1666666666666664e-02; cp = cp * r2 - 0.5;
    const double cs = 1.0 + r2 * cp;
    const int q = ((int)k) & 3;
    const double ss = (q == 0) ? sn : (q == 1) ? cs : (q == 2) ? -sn : -cs;
    const double cc = (q == 0) ? cs : (q == 1) ? -sn : (q == 2) ? -cs : sn;
    s = (float)ss; c = (float)cc;
}

struct Args { const float* in[29]; float* out; unsigned char* ws; int ph_lo, ph_hi; };
static_assert(sizeof(Args) == 29 * 8 + 8 + 8 + 8, "Args has no padding");
enum { I_X = 0, I_C, I_CTX, I_CCTX, I_WMOD, I_BMOD, I_GPREMIX, I_GPOSTMIX, I_GPREFFN, I_GPOSTFFN, I_WIN, I_WOUT, I_LAMRE, I_LAMIM, I_LOGDT, I_BRE, I_BIM, I_CRE, I_CIM, I_S5D, I_WGLU,
       I_CONV, I_ALOG, I_DTBIAS, I_GDNNORM, I_WQ, I_KEYS, I_PU, I_PV };

__device__ __forceinline__ const float* in_row(const Args& a, int row) { return row < ML ? a.in[I_X] + (size_t)row * D : a.in[I_CTX] + (size_t)(row - ML) * D; }
__device__ __forceinline__ int mod_row(int row) { return row < ML ? (row >> 11) : 8; }

template <int CTRL> __device__ __forceinline__ float dppf(float v) { return __builtin_bit_cast(float, __builtin_amdgcn_update_dpp(0, __builtin_bit_cast(int, v), CTRL, 0xf, 0xf, true)); }
__device__ __forceinline__ float row_sum16(float v) { v += dppf<0xB1>(v); v += dppf<0x4E>(v); v += dppf<0x141>(v); v += dppf<0x140>(v); return v; }
__device__ __forceinline__ float row_max16(float v) { v = fmaxf(v, dppf<0xB1>(v)); v = fmaxf(v, dppf<0x4E>(v)); v = fmaxf(v, dppf<0x141>(v)); v = fmaxf(v, dppf<0x140>(v)); return v; }
__device__ __forceinline__ float wsum(float v) { v = row_sum16(v); return
    __builtin_bit_cast(float, __builtin_amdgcn_readlane(__builtin_bit_cast(int, v), 0)) + __builtin_bit_cast(float, __builtin_amdgcn_readlane(__builtin_bit_cast(int, v), 16)) +
    __builtin_bit_cast(float, __builtin_amdgcn_readlane(__builtin_bit_cast(int, v), 32)) + __builtin_bit_cast(float, __builtin_amdgcn_readlane(__builtin_bit_cast(int, v), 48)); }
__device__ __forceinline__ float wmax(float v) { v = row_max16(v); return fmaxf(fmaxf(__builtin_bit_cast(float, __builtin_amdgcn_readlane(__builtin_bit_cast(int, v), 0)), __builtin_bit_cast(float, __builtin_amdgcn_readlane(__builtin_bit_cast(int, v), 16))),
    fmaxf(__builtin_bit_cast(float, __builtin_amdgcn_readlane(__builtin_bit_cast(int, v), 32)), __builtin_bit_cast(float, __builtin_amdgcn_readlane(__builtin_bit_cast(int, v), 48)))); }
__device__ __forceinline__ int lane_rank(unsigned long long m) { return __builtin_amdgcn_mbcnt_hi((unsigned)(m >> 32), __builtin_amdgcn_mbcnt_lo((unsigned)m, 0)); }
__device__ __forceinline__ unsigned fkey(float f) { const unsigned u = __builtin_bit_cast(unsigned, f); return u ^ ((unsigned)((int)u >> 31) | 0x80000000u); }
#define WAVE_LDS_SYNC() do { __builtin_amdgcn_fence(__ATOMIC_RELEASE, "wavefront"); __builtin_amdgcn_wave_barrier(); __builtin_amdgcn_fence(__ATOMIC_ACQUIRE, "wavefront"); } while (0)
template <int N> __device__ __forceinline__ unsigned kth_key(const unsigned (&k)[N], int K) {
    unsigned T = 0;
    for (int bit = 31; bit >= 0; --bit) { const unsigned cand = T | (1u << bit); int cnt = 0;
#pragma unroll
        for (int n = 0; n < N; ++n) cnt += __popcll(__ballot(k[n] >= cand));
        if (cnt >= K) T = cand;
        if (cnt == K) break; }
    return T;
}

namespace pg8 {
struct EpiInProj {
    static constexpr bool PERM = true, AFTER_DRAIN = false;
    bf16_t* U; bf16_t* QKV; bf16_t* Z;
    __device__ __forceinline__ void operator()(const f32x4 (&acc)[2][2][4][2], const Unit& u, int wr, int wc, int fr, int fq) const {
        bf16_t* base; int ld, colt; bool lat_only = false;
        if (u.pn < 2) { base = U; ld = 512; colt = u.pn * BM; }
        else if (u.pn < 8) { base = QKV; ld = 1536; colt = (u.pn - 2) * BM; }
        else { base = Z; ld = 512; colt = (u.pn - 8) * BM; lat_only = true; }
        const int row0 = u.pm * BM + wr * 64 + fr, col0 = colt + wc * 32 + 8 * fq;
#pragma unroll
        for (int ai = 0; ai < 2; ++ai)
#pragma unroll
            for (int m = 0; m < 4; ++m) { const int row = row0 + ai * HALF + m * 16; bf16_t* rowp = base + (size_t)row * ld + col0;
                if (lat_only && row >= 16384) continue;
#pragma unroll
                for (int bj = 0; bj < 2; ++bj) { const f32x4 v0 = acc[ai][bj][m][0], v1 = acc[ai][bj][m][1];
                    u32x4 w; w.x = cvt_pk_bf16(v0[0], v0[1]); w.y = cvt_pk_bf16(v0[2], v0[3]); w.z = cvt_pk_bf16(v1[0], v1[1]); w.w = cvt_pk_bf16(v1[2], v1[3]);
                    *(u32x4*)(rowp + bj * HALF) = w; } }
    }
};
struct EpiGlu {
    static constexpr bool PERM = true, AFTER_DRAIN = false;
    const bf16_t* YG; bf16_t* CAT;
    __device__ __forceinline__ void operator()(const f32x4 (&acc)[2][2][4][2], const Unit& u, int wr, int wc, int fr, int fq) const {
        const int row0 = u.pm * BM + wr * 64 + fr, col0 = u.pn * BM + wc * 32 + 8 * fq;
#pragma unroll
        for (int ai = 0; ai < 2; ++ai)
#pragma unroll
            for (int m = 0; m < 4; ++m) { const int row = row0 + ai * HALF + m * 16;
#pragma unroll
                for (int bj = 0; bj < 2; ++bj) { const f32x4 v0 = acc[ai][bj][m][0], v1 = acc[ai][bj][m][1];
                    const u32x4 y = *(const u32x4*)(YG + (size_t)row * 512 + col0 + bj * HALF);
                    float o[8]; const float a[8] = {v0[0], v0[1], v0[2], v0[3], v1[0], v1[1], v1[2], v1[3]};
                    const unsigned yw[4] = {y.x, y.y, y.z, y.w};
#pragma unroll
                    for (int e = 0; e < 8; ++e) { const float yv = __builtin_bit_cast(float, (e & 1) ? (yw[e >> 1] & 0xffff0000u) : (yw[e >> 1] << 16)); o[e] = yv / (1.f + __expf(-a[e])); }
                    u32x4 w; w.x = cvt_pk_bf16(o[0], o[1]); w.y = cvt_pk_bf16(o[2], o[3]); w.z = cvt_pk_bf16(o[4], o[5]); w.w = cvt_pk_bf16(o[6], o[7]);
                    *(u32x4*)(CAT + (size_t)row * 1024 + col0 + bj * HALF) = w; } }
    }
};
struct EpiF32 {
    static constexpr bool PERM = false, AFTER_DRAIN = false;
    float* C; int ldc;
    __device__ __forceinline__ void operator()(const f32x4 (&acc)[2][2][4][2], const Unit& u, int wr, int wc, int fr, int fq) const {
        const int row0 = u.pm * BM + wr * 64 + fr, col0 = u.pn * BM + wc * 32 + 4 * fq;
#pragma unroll
        for (int ai = 0; ai < 2; ++ai)
#pragma unroll
            for (int m = 0; m < 4; ++m) { float* rowp = C + (size_t)(row0 + ai * HALF + m * 16) * ldc + col0;
#pragma unroll
                for (int bj = 0; bj < 2; ++bj)
#pragma unroll
                    for (int n = 0; n < 2; ++n) *(f32x4*)(rowp + bj * HALF + n * 16) = acc[ai][bj][m][n]; }
    }
};
}

struct Ctx { const Args* a; unsigned char* ws; unsigned char* lds; int tid, lane, wave, bid, G, gw, NGW, gwv; };

__device__ __forceinline__ void p0_transpose_item(const float* W, int ldw, int nblk, int K, bf16* WT, float* scr, int item, int lane) {
    const int kb = item / nblk, nb = item % nblk, k0 = 64 * kb, n0 = 32 * nb;
#pragma unroll 8
    for (int i = 0; i < 32; ++i) { const int kk = 2 * i + (lane >> 5); scr[kk * 33 + (lane & 31)] = W[(size_t)(k0 + kk) * ldw + n0 + (lane & 31)]; }
    __builtin_amdgcn_fence(__ATOMIC_RELEASE, "wavefront"); __builtin_amdgcn_wave_barrier(); __builtin_amdgcn_fence(__ATOMIC_ACQUIRE, "wavefront");
    const int c = lane & 7;
#pragma unroll
    for (int j = 0; j < 4; ++j) { const int n = (lane >> 3) + 8 * j; const float* s = scr + (8 * c) * 33 + n;
        v4u o; o.x = pk2(s[0 * 33], s[1 * 33]); o.y = pk2(s[2 * 33], s[3 * 33]); o.z = pk2(s[4 * 33], s[5 * 33]); o.w = pk2(s[6 * 33], s[7 * 33]);
        *(v4u*)(WT + (size_t)(n0 + n) * K + k0 + 8 * c) = o; }
    __builtin_amdgcn_fence(__ATOMIC_RELEASE, "wavefront"); __builtin_amdgcn_wave_barrier(); __builtin_amdgcn_fence(__ATOMIC_ACQUIRE, "wavefront");
}
__device__ __forceinline__ void phase_prep(const Ctx& c) {
    const Args& a = *c.a;
    float* scr = (float*)(c.lds + c.wave * 16384);
    constexpr int I_IN = 16 * 80, I_OUT = 16 * 32, I_GLU = 8 * 16, I_Q = 16 * 64;
    for (int it = c.gw; it < I_IN + I_OUT + I_GLU + I_Q; it += c.NGW) {
        int r = it;
        if (r < I_IN) { p0_transpose_item(a.in[I_WIN], PROJ, 80, 1024, (bf16*)(c.ws + WS_WIN), scr, r, c.lane); continue; } r -= I_IN;
        if (r < I_OUT) { p0_transpose_item(a.in[I_WOUT], 1024, 32, 1024, (bf16*)(c.ws + WS_WOUT), scr, r, c.lane); continue; } r -= I_OUT;
        if (r < I_GLU) { p0_transpose_item(a.in[I_WGLU], 512, 16, 512, (bf16*)(c.ws + WS_WGLU), scr, r, c.lane); continue; } r -= I_GLU;
        p0_transpose_item(a.in[I_WQ], 2048, 64, 1024, (bf16*)(c.ws + WS_WQ), scr, r, c.lane);
    }
    __syncthreads();
    float* sc = (float*)c.lds;
    float* red = (float*)(c.lds + 9 * 1024 * 4);
    float* MOD = (float*)(c.ws + WS_MOD);
    bool have = false;
    for (int item = c.bid; item < 96; item += c.G) {
        if (!have) { for (int i = c.tid; i < 9 * 1024; i += NTHREADS) { const int r = i >> 10, k = i & 1023; const float v = r < 8 ? a.in[I_C][r * 1024 + k] : a.in[I_CCTX][k]; sc[i] = siluf_(v); } have = true; __syncthreads(); }
        const int n0 = item * 64;
        float acc[9];
#pragma unroll
        for (int r = 0; r < 9; ++r) acc[r] = 0.f;
        const float* wp = a.in[I_WMOD] + (size_t)(c.wave * 128) * 6144 + n0 + c.lane;
#pragma unroll 4
        for (int k = 0; k < 128; ++k) { const float w = wp[(size_t)k * 6144];
#pragma unroll
            for (int r = 0; r < 9; ++r) acc[r] = fmaf(sc[r * 1024 + c.wave * 128 + k], w, acc[r]); }
#pragma unroll
        for (int r = 0; r < 9; ++r) red[(c.wave * 9 + r) * 64 + c.lane] = acc[r];
        __syncthreads();
        for (int i = c.tid; i < 576; i += NTHREADS) { const int r = i >> 6, l = i & 63; float s = a.in[I_BMOD][n0 + l];
#pragma unroll
            for (int w = 0; w < 8; ++w) s += red[(w * 9 + r) * 64 + l];
            MOD[r * 6144 + n0 + l] = s; }
        __syncthreads();
    }
}

__device__ __forceinline__ void phase_norm1(const Ctx& c) {
    const Args& a = *c.a;
    float* wabT = (float*)c.lds;
    for (int i = c.tid; i < 1024 * 16; i += NTHREADS) { const int k = i >> 4, j = i & 15; wabT[j * 1028 + k] = a.in[I_WIN][(size_t)k * PROJ + NPROJ + j]; }
    __syncthreads();
    const float* MOD = (const float*)(c.ws + WS_MOD);
    bf16* HX = (bf16*)(c.ws + WS_HX); float* GB = (float*)(c.ws + WS_GB);
    const float* gpre = a.in[I_GPREMIX];
    for (int row = c.gw; row < MT; row += c.NGW) {
        const f32x4* xr = (const f32x4*)in_row(a, row) + c.lane;
        const float* mr = MOD + mod_row(row) * 6144;
        f32x4 v[4]; float ss = 0.f;
#pragma unroll
        for (int j = 0; j < 4; ++j) { v[j] = xr[64 * j]; ss += (v[j].x * v[j].x + v[j].y * v[j].y) + (v[j].z * v[j].z + v[j].w * v[j].w); }
        const float r = rsqrtf(wave_sum(ss) * (1.f / D) + EPS);
#pragma unroll
        for (int j = 0; j < 4; ++j) { const int col = 4 * c.lane + 256 * j;
            const f32x4 g4 = *(const f32x4*)(gpre + col), sh = *(const f32x4*)(mr + col), scl = *(const f32x4*)(mr + 1024 + col);
            v[j] = (v[j] * r) * g4 * (scl + 1.f) + sh;
            v2u o; o.x = pk2(v[j].x, v[j].y); o.y = pk2(v[j].z, v[j].w);
            *(v2u*)(HX + (size_t)row * D + col) = o; }
        float mine = 0.f;
#pragma unroll 1
        for (int j = 0; j < 16; ++j) { float s = 0.f;
#pragma unroll
            for (int jj = 0; jj < 4; ++jj) { const f32x4 w = *(const f32x4*)(wabT + j * 1028 + 4 * c.lane + 256 * jj); s += (v[jj].x * w.x + v[jj].y * w.y) + (v[jj].z * w.z + v[jj].w * w.w); }
            s = wave_sum(s); mine = (c.lane == j) ? s : mine; }
        if (c.lane < 8) { const float t = mine + a.in[I_DTBIAS][c.lane]; const float sp = t > 20.f ? t : log1pf(expf(t)); GB[(size_t)row * 16 + c.lane] = -expf(a.in[I_ALOG][c.lane]) * sp; }
        else if (c.lane < 16) GB[(size_t)row * 16 + c.lane] = 1.f / (1.f + expf(-mine));
    }
}

__device__ __forceinline__ void phase_conv(const Ctx& c) {
    const Args& a = *c.a;
    const bf16* PRE = (const bf16*)(c.ws + WS_QKVPRE); bf16* OUT = (bf16*)(c.ws + WS_QKV);
    const float* cw = a.in[I_CONV];
    for (int row = c.gw; row < MT; row += c.NGW) {
        int nb_row[9]; bool ok[9];
        if (row < ML) { const int t = row & 2047, gr = t >> 6, gc = t & 63;
#pragma unroll
            for (int dy = -1; dy <= 1; ++dy)
#pragma unroll
                for (int dx = -1; dx <= 1; ++dx) { const int i = (dy + 1) * 3 + dx + 1; ok[i] = (gr + dy >= 0) && (gr + dy < 32) && (gc + dx >= 0) && (gc + dx < 64); nb_row[i] = row + dy * 64 + dx; } }
        else { const int t = (row - ML) & 255;
#pragma unroll
            for (int i = 0; i < 9; ++i) { ok[i] = false; nb_row[i] = row; }
#pragma unroll
            for (int dx = -1; dx <= 1; ++dx) { ok[4 + dx] = (t + dx >= 0) && (t + dx < 256); nb_row[4 + dx] = row + dx; } }
#pragma unroll 2
        for (int seg = 0; seg < 12; ++seg) { const int ch = seg * 128 + 2 * c.lane; float o0 = 0.f, o1 = 0.f;
#pragma unroll
            for (int i = 0; i < 9; ++i) if (ok[i]) { const unsigned w = *(const unsigned*)(PRE + (size_t)nb_row[i] * 1536 + ch); const f32x2 k2 = *(const f32x2*)(cw + i * 1536 + ch);
                o0 = fmaf(bflo(w), k2.x, o0); o1 = fmaf(bfhi(w), k2.y, o1); }
            o0 = siluf_(o0); o1 = siluf_(o1);
            if (seg < 8) { const float ssq = wave_sum(o0 * o0 + o1 * o1); const float sc = rsqrtf(ssq + EPS) * (seg < 4 ? 0.08838834764831845f : 1.f); o0 *= sc; o1 *= sc; }
            *(unsigned*)(OUT + (size_t)row * 1536 + ch) = pk2(o0, o1); }
    }
}

__device__ __forceinline__ int scan_row(int b, int dir, int step) {
    if (step < LC) { const int t = dir ? LC - 1 - step : step; return ML + b * LC + t; }
    const int t = step - LC; return b * SEQ + (dir ? SEQ - 1 - t : t);
}
__device__ __forceinline__ void s5_direct_task(const Ctx& c, int task, float* wl  ) {
    const Args& a = *c.a;
    const int dir = task & 1, g = (task >> 1) & 31, b = task >> 6, p = c.lane, dg = dir * 32 + g;
    const float dt = expf(a.in[I_LOGDT][dg]);
    const float lr = a.in[I_LAMRE][dg * 64 + p], li = a.in[I_LAMIM][dg * 64 + p];
    const float mag = expf(lr * dt); float sn, cs; sincos_d((double)li * (double)dt, sn, cs);
    const float lbr = mag * cs, lbi = mag * sn, den = lr * lr + li * li, nr = lbr - 1.f;
    const float cr = (nr * lr + lbi * li) / den, ci = (lbi * lr - nr * li) / den;
    float bbr[16], bbi[16], cre[16], cim[16];
#pragma unroll
    for (int ch = 0; ch < 16; ++ch) { const float br = a.in[I_BRE][(size_t)(dg * 64 + p) * 16 + ch], bi = a.in[I_BIM][(size_t)(dg * 64 + p) * 16 + ch];
        bbr[ch] = cr * br - ci * bi; bbi[ch] = cr * bi + ci * br;
        cre[ch] = a.in[I_CRE][(size_t)(dg * 16 + ch) * 64 + p]; cim[ch] = a.in[I_CIM][(size_t)(dg * 16 + ch) * 64 + p]; }
    const bf16* U = (const bf16*)(c.ws + WS_U); bf16* YS = (bf16*)(c.ws + WS_YS5) + (size_t)dir * ML * 512;
    float hre = 0.f, him = 0.f;
    v4u n0 = *(const v4u*)(U + (size_t)scan_row(b, dir, 0) * 512 + g * 16), n1 = *(const v4u*)(U + (size_t)scan_row(b, dir, 0) * 512 + g * 16 + 8);
    for (int step = 0; step < LC + SEQ; ++step) {
        const int row = scan_row(b, dir, step);
        const v4u u0 = n0, u1 = n1;
        if (step + 1 < LC + SEQ) { const bf16* np = U + (size_t)scan_row(b, dir, step + 1) * 512 + g * 16; n0 = *(const v4u*)np; n1 = *(const v4u*)(np + 8); }
        const unsigned uw[8] = {u0.x, u0.y, u0.z, u0.w, u1.x, u1.y, u1.z, u1.w};
        float bur = 0.f, bui = 0.f;
#pragma unroll
        for (int ch = 0; ch < 16; ++ch) { const float uv = (ch & 1) ? bfhi(uw[ch >> 1]) : bflo(uw[ch >> 1]); bur = fmaf(bbr[ch], uv, bur); bui = fmaf(bbi[ch], uv, bui); }
        const float nre = lbr * hre - lbi * him + bur, nim = lbr * him + lbi * hre + bui; hre = nre; him = nim;
        if (step >= LC) {
#pragma unroll
            for (int ch = 0; ch < 16; ++ch) wl[ch * 65 + p] = cre[ch] * hre - cim[ch] * him;
            __builtin_amdgcn_fence(__ATOMIC_RELEASE, "wavefront"); __builtin_amdgcn_wave_barrier(); __builtin_amdgcn_fence(__ATOMIC_ACQUIRE, "wavefront");
            const int ch = c.lane >> 2, part = c.lane & 3; float s = 0.f;
#pragma unroll
            for (int i = 0; i < 16; ++i) s += wl[ch * 65 + part * 16 + i];
            s += __shfl_xor(s, 1); s += __shfl_xor(s, 2);
            if (part == 0) YS[(size_t)row * 512 + g * 16 + ch] = (bf16)f2bf(s);
            __builtin_amdgcn_fence(__ATOMIC_RELEASE, "wavefront"); __builtin_amdgcn_wave_barrier(); __builtin_amdgcn_fence(__ATOMIC_ACQUIRE, "wavefront");
        }
    }
}
__device__ __forceinline__ void gdn_direct_task(const Ctx& c, int task, float* wl  ) {
    const int dvq = task & 3, dir = (task >> 2) & 1, h = (task >> 3) & 3, b = task >> 5, half = c.lane >> 5, dv = dvq * 32 + (c.lane & 31);
    const bf16* QKV = (const bf16*)(c.ws + WS_QKV); const float* GB = (const float*)(c.ws + WS_GB);
    bf16* OG = (bf16*)(c.ws + WS_OG) + (size_t)dir * ML * 512;
    float S[64];
#pragma unroll
    for (int i = 0; i < 64; ++i) S[i] = 0.f;
    float* kf = wl; float* qf = wl + 128;
    unsigned nq, nk; bf16 nv; float ng, nbt;
    { const int row = scan_row(b, dir, 0); const bf16* rp = QKV + (size_t)row * 1536 + h * 128; nq = *(const unsigned*)(rp + 2 * c.lane); nk = *(const unsigned*)(rp + 512 + 2 * c.lane); nv = rp[1024 + dv];
      ng = GB[(size_t)row * 16 + dir * 4 + h]; nbt = GB[(size_t)row * 16 + 8 + dir * 4 + h]; }
    for (int step = 0; step < LC + SEQ; ++step) {
        const int row = scan_row(b, dir, step);
        const unsigned qw = nq, kw = nk; const float v = bf1(nv), eg = __expf(ng), beta = nbt;
        if (step + 1 < LC + SEQ) { const int r2 = scan_row(b, dir, step + 1); const bf16* rp = QKV + (size_t)r2 * 1536 + h * 128; nq = *(const unsigned*)(rp + 2 * c.lane); nk = *(const unsigned*)(rp + 512 + 2 * c.lane); nv = rp[1024 + dv];
            ng = GB[(size_t)r2 * 16 + dir * 4 + h]; nbt = GB[(size_t)r2 * 16 + 8 + dir * 4 + h]; }
        *(f32x2*)(kf + 2 * c.lane) = (f32x2){bflo(kw), bfhi(kw)}; *(f32x2*)(qf + 2 * c.lane) = (f32x2){bflo(qw), bfhi(qw)};
        __builtin_amdgcn_fence(__ATOMIC_RELEASE, "wavefront"); __builtin_amdgcn_wave_barrier(); __builtin_amdgcn_fence(__ATOMIC_ACQUIRE, "wavefront");
        const float* kh = kf + 64 * half; const float* qh = qf + 64 * half;
        float ks = 0.f;
#pragma unroll
        for (int i = 0; i < 16; ++i) { const f32x4 k4 = *(const f32x4*)(kh + 4 * i);
            ks = fmaf(S[4 * i], k4.x, ks); ks = fmaf(S[4 * i + 1], k4.y, ks); ks = fmaf(S[4 * i + 2], k4.z, ks); ks = fmaf(S[4 * i + 3], k4.w, ks); }
        ks += __shfl_xor(ks, 32);
        const float vn = beta * (v - eg * ks);
        float o = 0.f;
#pragma unroll
        for (int i = 0; i < 16; ++i) { const f32x4 k4 = *(const f32x4*)(kh + 4 * i), q4 = *(const f32x4*)(qh + 4 * i);
            S[4 * i] = fmaf(S[4 * i], eg, k4.x * vn); S[4 * i + 1] = fmaf(S[4 * i + 1], eg, k4.y * vn); S[4 * i + 2] = fmaf(S[4 * i + 2], eg, k4.z * vn); S[4 * i + 3] = fmaf(S[4 * i + 3], eg, k4.w * vn);
            o = fmaf(S[4 * i], q4.x, o); o = fmaf(S[4 * i + 1], q4.y, o); o = fmaf(S[4 * i + 2], q4.z, o); o = fmaf(S[4 * i + 3], q4.w, o); }
        o += __shfl_xor(o, 32);
        if (step >= LC && half == 0) OG[(size_t)row * 512 + h * 128 + dv] = (bf16)f2bf(o);
        __builtin_amdgcn_fence(__ATOMIC_RELEASE, "wavefront"); __builtin_amdgcn_wave_barrier(); __builtin_amdgcn_fence(__ATOMIC_ACQUIRE, "wavefront");
    }
}
__device__ __forceinline__ void phase_scan_direct(const Ctx& c) {
    float* wl = (float*)(c.lds + c.wave * 8192);
    if (c.bid >= 64) for (int t = (c.bid - 64) + (c.G - 64) * c.wave; t < 512; t += (c.G - 64) * NWAVES) s5_direct_task(c, t, wl);
}

__device__ __forceinline__ void phase_combine(const Ctx& c) {
    const Args& a = *c.a;
    const bf16* OG0 = (const bf16*)(c.ws + WS_OG); const bf16* OG1 = OG0 + (size_t)ML * 512; const bf16* Z = (const bf16*)(c.ws + WS_Z);
    const bf16* YS0 = (const bf16*)(c.ws + WS_YS5); const bf16* YS1 = YS0 + (size_t)ML * 512; const bf16* U = (const bf16*)(c.ws + WS_U);
    bf16* CAT = (bf16*)(c.ws + WS_CAT); bf16* YG = (bf16*)(c.ws + WS_YG);
    for (int row = c.gw; row < ML; row += c.NGW) {
#pragma unroll
        for (int h = 0; h < 4; ++h) { const int ch = h * 128 + 2 * c.lane;
            const unsigned w0 = *(const unsigned*)(OG0 + (size_t)row * 512 + ch), w1 = *(const unsigned*)(OG1 + (size_t)row * 512 + ch), zw = *(const unsigned*)(Z + (size_t)row * 512 + ch);
            const float o0 = bflo(w0) + bflo(w1), o1 = bfhi(w0) + bfhi(w1);
            const float r = rsqrtf(wave_sum(o0 * o0 + o1 * o1) * (1.f / 128.f) + EPS);
            const f32x2 ng = *(const f32x2*)(a.in[I_GDNNORM] + 2 * c.lane);
            *(unsigned*)(CAT + (size_t)row * 1024 + 512 + ch) = pk2(o0 * r * ng.x * siluf_(bflo(zw)), o1 * r * ng.y * siluf_(bfhi(zw))); }
        { const int ch = 8 * c.lane;
            const v4u uu = *(const v4u*)(U + (size_t)row * 512 + ch), y0 = *(const v4u*)(YS0 + (size_t)row * 512 + ch), y1 = *(const v4u*)(YS1 + (size_t)row * 512 + ch);
            const f32x4 d0 = *(const f32x4*)(a.in[I_S5D] + ch), d1 = *(const f32x4*)(a.in[I_S5D] + ch + 4);
            const unsigned uw[4] = {uu.x, uu.y, uu.z, uu.w}, a0[4] = {y0.x, y0.y, y0.z, y0.w}, a1[4] = {y1.x, y1.y, y1.z, y1.w}; const float dd[8] = {d0.x, d0.y, d0.z, d0.w, d1.x, d1.y, d1.z, d1.w};
            float o[8];
#pragma unroll
            for (int e = 0; e < 8; ++e) { const float uv = (e & 1) ? bfhi(uw[e >> 1]) : bflo(uw[e >> 1]); const float ya = (e & 1) ? bfhi(a0[e >> 1]) : bflo(a0[e >> 1]); const float yb = (e & 1) ? bfhi(a1[e >> 1]) : bflo(a1[e >> 1]);
                o[e] = gelu_erf(uv * dd[e] + ya + yb); }
            v4u w; w.x = pk2(o[0], o[1]); w.y = pk2(o[2], o[3]); w.z = pk2(o[4], o[5]); w.w = pk2(o[6], o[7]);
            *(v4u*)(YG + (size_t)row * 512 + ch) = w; }
    }
}

__device__ __forceinline__ void phase_rows2(const Ctx& c) {
    const Args& a = *c.a;
    const float* MOD = (const float*)(c.ws + WS_MOD); const float* YRAW = (const float*)(c.ws + WS_YRAW); bf16* HX2 = (bf16*)(c.ws + WS_HX2);
    for (int row = c.gw; row < ML; row += c.NGW) {
        const float* mr = MOD + (row >> 11) * 6144;
        f32x4 y[4], x[4]; float ss = 0.f;
#pragma unroll
        for (int j = 0; j < 4; ++j) { y[j] = *((const f32x4*)(YRAW + (size_t)row * D) + c.lane + 64 * j); x[j] = *((const f32x4*)(a.in[I_X] + (size_t)row * D) + c.lane + 64 * j);
            ss += (y[j].x * y[j].x + y[j].y * y[j].y) + (y[j].z * y[j].z + y[j].w * y[j].w); }
        const float r = rsqrtf(wave_sum(ss) * (1.f / D) + EPS); float s2 = 0.f;
#pragma unroll
        for (int j = 0; j < 4; ++j) { const int col = 4 * c.lane + 256 * j;
            const f32x4 g4 = *(const f32x4*)(a.in[I_GPOSTMIX] + col), gt = *(const f32x4*)(mr + 2048 + col);
            x[j] = x[j] + gt * ((y[j] * r) * g4);
            *(f32x4*)(a.out + (size_t)row * D + col) = x[j];
            s2 += (x[j].x * x[j].x + x[j].y * x[j].y) + (x[j].z * x[j].z + x[j].w * x[j].w); }
        const float r2 = rsqrtf(wave_sum(s2) * (1.f / D) + EPS);
#pragma unroll
        for (int j = 0; j < 4; ++j) { const int col = 4 * c.lane + 256 * j;
            const f32x4 g4 = *(const f32x4*)(a.in[I_GPREFFN] + col), sh = *(const f32x4*)(mr + 3072 + col), scl = *(const f32x4*)(mr + 4096 + col);
            const f32x4 hv = (x[j] * r2) * g4 * (scl + 1.f) + sh;
            v2u o; o.x = pk2(hv.x, hv.y); o.y = pk2(hv.z, hv.w);
            *(v2u*)(HX2 + (size_t)row * D + col) = o; }
    }
}


constexpr int KROW = 136;
__device__ __forceinline__ void phase_topk(const Ctx& c) {
    const Args& a = *c.a;
    bf16* kl = (bf16*)c.lds;
    unsigned char* wbase = c.lds + 2 * 128 * KROW * 2 + c.wave * 1024;
    bf16* qs = (bf16*)wbase;
    float* s1 = (float*)(wbase + 512); int* i1 = (int*)(wbase + 576); float* s2 = (float*)(wbase + 640); int* i2 = (int*)(wbase + 704); float* fs = (float*)(wbase + 768); int* fi = (int*)(wbase + 832);
    const bf16* QP = (const bf16*)(c.ws + WS_QP); int* IDX = (int*)(c.ws + WS_IDX); float* GATE = (float*)(c.ws + WS_GATE);
    for (int item = c.bid; item < 8 * 32; item += c.G) {
        const int h = item & 7, tr = item >> 3;
        __syncthreads();
        for (int i = c.tid; i < 2 * 128 * 64; i += NTHREADS) { const int k2 = i & 63, n = (i >> 6) & 127, p = i >> 13; const f32x2 kv = *(const f32x2*)(a.in[I_KEYS] + ((size_t)((h * 2 + p) * 128 + n)) * 128 + 2 * k2);
            *(unsigned*)(kl + (p * 128 + n) * KROW + 2 * k2) = pk2(kv.x, kv.y); }
        __syncthreads();
        for (int tt = c.wave; tt < 512; tt += NWAVES) {
            const int tok = tr * 512 + tt;
            *(v2u*)(qs + 4 * c.lane) = *(const v2u*)(QP + (size_t)tok * 2048 + h * 256 + 4 * c.lane);
            WAVE_LDS_SYNC();
            float sc[2][2];
#pragma unroll
            for (int p = 0; p < 2; ++p) { float sa0 = 0.f, sa1 = 0.f, sb0 = 0.f, sb1 = 0.f;
#pragma unroll 4
                for (int kk = 0; kk < 16; ++kk) { const v4u q8 = *(const v4u*)(qs + p * 128 + kk * 8), ka = *(const v4u*)(kl + (p * 128 + c.lane) * KROW + kk * 8), kb = *(const v4u*)(kl + (p * 128 + c.lane + 64) * KROW + kk * 8);
                    const unsigned qw[4] = {q8.x, q8.y, q8.z, q8.w}, aw[4] = {ka.x, ka.y, ka.z, ka.w}, bw[4] = {kb.x, kb.y, kb.z, kb.w};
#pragma unroll
                    for (int e = 0; e < 4; ++e) { sa0 = fmaf(bflo(qw[e]), bflo(aw[e]), sa0); sa1 = fmaf(bfhi(qw[e]), bfhi(aw[e]), sa1); sb0 = fmaf(bflo(qw[e]), bflo(bw[e]), sb0); sb1 = fmaf(bfhi(qw[e]), bfhi(bw[e]), sb1); } }
                sc[p][0] = sa0 + sa1; sc[p][1] = sb0 + sb1; }
#pragma unroll
            for (int p = 0; p < 2; ++p) { float* so = p ? s2 : s1; int* io = p ? i2 : i1;
                const unsigned ky[2] = {fkey(sc[p][0]), fkey(sc[p][1])};
                const unsigned T = kth_key<2>(ky, 16);
                int cgt = 0;
#pragma unroll
                for (int n = 0; n < 2; ++n) cgt += __popcll(__ballot(ky[n] > T));
                const int need = 16 - cgt; int base = 0, eqb = 0;
#pragma unroll
                for (int n = 0; n < 2; ++n) { const bool eq = ky[n] == T; const unsigned long long em = __ballot(eq); const bool sel = (ky[n] > T) || (eq && (eqb + lane_rank(em)) < need);
                    const unsigned long long sm = __ballot(sel); if (sel) { const int pos = base + lane_rank(sm); so[pos] = sc[p][n]; io[pos] = c.lane + 64 * n; }
                    base += __popcll(sm); eqb += __popcll(em); } }
            WAVE_LDS_SYNC();
            { const int ci = c.lane >> 2, cj = 4 * (c.lane & 3);
              float cv[4]; unsigned ky[4]; const float b1 = s1[ci];
#pragma unroll
              for (int e = 0; e < 4; ++e) { cv[e] = b1 + s2[cj + e]; ky[e] = fkey(cv[e]); }
              const unsigned T = kth_key<4>(ky, 16);
              int cgt = 0;
#pragma unroll
              for (int e = 0; e < 4; ++e) cgt += __popcll(__ballot(ky[e] > T));
              const int need = 16 - cgt; int base = 0, eqb = 0; const int e1 = i1[ci] * 128;
#pragma unroll
              for (int e = 0; e < 4; ++e) { const bool eq = ky[e] == T; const unsigned long long em = __ballot(eq); const bool sel = (ky[e] > T) || (eq && (eqb + lane_rank(em)) < need);
                  const unsigned long long sm = __ballot(sel); if (sel) { const int pos = base + lane_rank(sm); fs[pos] = cv[e]; fi[pos] = e1 + i2[cj + e]; }
                  base += __popcll(sm); eqb += __popcll(em); } }
            WAVE_LDS_SYNC();
            { const float v = fs[c.lane & 15]; const float mx = row_max16(v); const float ex = __expf(v - mx); const float den = row_sum16(ex);
              if (c.lane < 16) { IDX[(size_t)tok * 128 + h * 16 + c.lane] = fi[c.lane]; GATE[(size_t)tok * 128 + h * 16 + c.lane] = ex / den; } }
            WAVE_LDS_SYNC();
        }
    }
}

__device__ __forceinline__ void phase_fp8_tables(const Ctx& c) {
    const Args& a = *c.a;
    for (int r = c.gw; r < 2 * NEXP; r += c.NGW) {
        const bool isv = r >= NEXP; const int e = isv ? r - NEXP : r;
        const f32x4* src = (const f32x4*)((isv ? a.in[I_PV] : a.in[I_PU]) + (size_t)e * D) + 4 * c.lane;
        f32x4 v[4]; float m = 0.f;
#pragma unroll
        for (int j = 0; j < 4; ++j) { v[j] = src[j]; m = fmaxf(m, fmaxf(fmaxf(fabsf(v[j].x), fabsf(v[j].y)), fmaxf(fabsf(v[j].z), fabsf(v[j].w)))); }
        m = wmax(m); const float inv = m > 0.f ? 256.f / m : 0.f;
        v4u o; unsigned ow[4];
#pragma unroll
        for (int j = 0; j < 4; ++j) { int w = __builtin_amdgcn_cvt_pk_fp8_f32(v[j].x * inv, v[j].y * inv, 0, false); w = __builtin_amdgcn_cvt_pk_fp8_f32(v[j].z * inv, v[j].w * inv, w, true); ow[j] = (unsigned)w; }
        o.x = ow[0]; o.y = ow[1]; o.z = ow[2]; o.w = ow[3];
        *(v4u*)(c.ws + (isv ? WS_V8 : WS_U8) + (size_t)e * D + 16 * c.lane) = o;
        if (c.lane == 0) ((float*)(c.ws + (isv ? WS_VSC : WS_USC)))[e] = m * (1.f / 256.f);
    }
}
__device__ __forceinline__ void fp8x16_to_f32(const v4u& r, float (&f)[16]) {
    const unsigned w[4] = {r.x, r.y, r.z, r.w};
#pragma unroll
    for (int j = 0; j < 4; ++j) { const f32x2 lo = __builtin_amdgcn_cvt_pk_f32_fp8((int)w[j], false), hi = __builtin_amdgcn_cvt_pk_f32_fp8((int)w[j], true); f[4 * j] = lo.x; f[4 * j + 1] = lo.y; f[4 * j + 2] = hi.x; f[4 * j + 3] = hi.y; }
}
__device__ __forceinline__ unsigned xcc_id() { return (unsigned)__builtin_amdgcn_s_getreg((3 << 11) | 20) & 7u; }

__device__ __forceinline__ void phase_exp1(const Ctx& c) {
    const bf16* HX2 = (const bf16*)(c.ws + WS_HX2); const int* IDX = (const int*)(c.ws + WS_IDX); const float* GATE = (const float*)(c.ws + WS_GATE);
    const unsigned char* U8 = c.ws + WS_U8; const float* USC = (const float*)(c.ws + WS_USC); const float* VSC = (const float*)(c.ws + WS_VSC); float* ACT = (float*)(c.ws + WS_ACT);
    unsigned* cnt = (unsigned*)(c.ws + WS_CTL) + CW_E1;
    int* lk = (int*)(c.lds + c.wave * 1024); int* le = lk + 128;
    const int xcc = (int)xcc_id();
    constexpr int CH = 8;
    for (int bo = 0; bo < 8; ++bo) { const int x = (xcc + bo) & 7;
        for (;;) { unsigned t0 = 0; if (c.lane == 0) t0 = __hip_atomic_fetch_add(cnt + 64 * x, (unsigned)CH, __ATOMIC_RELAXED, __HIP_MEMORY_SCOPE_AGENT);
            t0 = (unsigned)__builtin_amdgcn_readfirstlane((int)t0); if (t0 >= (unsigned)ML) break;
            for (int t = (int)t0; t < (int)t0 + CH; ++t) {
                float hv[16];
                { const v4u h0 = *(const v4u*)(HX2 + (size_t)t * D + 16 * c.lane), h1 = *(const v4u*)(HX2 + (size_t)t * D + 16 * c.lane + 8); const unsigned hw[8] = {h0.x, h0.y, h0.z, h0.w, h1.x, h1.y, h1.z, h1.w};
#pragma unroll
                  for (int j = 0; j < 8; ++j) { hv[2 * j] = bflo(hw[j]); hv[2 * j + 1] = bfhi(hw[j]); } }
                const int eA = IDX[(size_t)t * 128 + c.lane], eB = IDX[(size_t)t * 128 + 64 + c.lane];
                const bool sA = (eA >> 11) == x, sB = (eB >> 11) == x; const unsigned long long mA = __ballot(sA), mB = __ballot(sB); const int nA = __popcll(mA), n = nA + __popcll(mB);
                if (sA) { const int pos = lane_rank(mA); lk[pos] = c.lane; le[pos] = eA; }
                if (sB) { const int pos = nA + lane_rank(mB); lk[pos] = c.lane + 64; le[pos] = eB; }
                WAVE_LDS_SYNC();
                for (int j0 = 0; j0 < n; j0 += 16) {
                    float p[16];
#pragma unroll
                    for (int jj = 0; jj < 16; ++jj) { const int j = j0 + jj; const int e = le[j < n ? j : 0];
                        const v4u row = *(const v4u*)(U8 + (size_t)e * D + 16 * c.lane); float f[16]; fp8x16_to_f32(row, f); float s0 = 0.f, s1 = 0.f;
#pragma unroll
                        for (int q = 0; q < 8; ++q) { s0 = fmaf(f[2 * q], hv[2 * q], s0); s1 = fmaf(f[2 * q + 1], hv[2 * q + 1], s1); }
                        p[jj] = s0 + s1; }
                    const bool b5 = c.lane & 32, b4 = c.lane & 16, b3 = c.lane & 8, b2 = c.lane & 4;
                    float q8[8], q4[4], q2[2];
#pragma unroll
                    for (int i = 0; i < 8; ++i) { const float keep = b5 ? p[i + 8] : p[i], send = b5 ? p[i] : p[i + 8]; q8[i] = keep + __shfl_xor(send, 32); }
#pragma unroll
                    for (int i = 0; i < 4; ++i) { const float keep = b4 ? q8[i + 4] : q8[i], send = b4 ? q8[i] : q8[i + 4]; q4[i] = keep + __shfl_xor(send, 16); }
#pragma unroll
                    for (int i = 0; i < 2; ++i) { const float keep = b3 ? q4[i + 2] : q4[i], send = b3 ? q4[i] : q4[i + 2]; q2[i] = keep + dppf<0x140>(send); }
                    float s; { const float keep = b2 ? q2[1] : q2[0], send = b2 ? q2[0] : q2[1]; s = keep + dppf<0x141>(send); }
                    s += dppf<0xB1>(s); s += dppf<0x4E>(s);
                    const int j = j0 + (b5 ? 8 : 0) + (b4 ? 4 : 0) + (b3 ? 2 : 0) + (b2 ? 1 : 0);
                    if (j < n && (c.lane & 3) == 0) { const int e = le[j], k = lk[j]; ACT[(size_t)t * 128 + k] = gelu_erf(s * USC[e]) * GATE[(size_t)t * 128 + k] * VSC[e]; }
                }
                WAVE_LDS_SYNC();
            } } }
}
__device__ __forceinline__ void phase_exp2(const Ctx& c) {
    const int* IDX = (const int*)(c.ws + WS_IDX); const float* ACT = (const float*)(c.ws + WS_ACT); const unsigned char* V8 = c.ws + WS_V8;
    float* Y = (float*)(c.ws + WS_Y); float* SSQP = (float*)(c.ws + WS_SSQP);
    unsigned* cnt = (unsigned*)(c.ws + WS_CTL) + CW_E2;
    const int xcc = (int)xcc_id(), sub = c.lane & 7, grp = c.lane >> 3;
    const bool b5 = c.lane & 32, b4 = c.lane & 16, b3 = c.lane & 8;
    constexpr int CH = 8;
    int bo = 0, t = 0, tend = 0;
    for (;;) {
        if (t >= tend) {
            unsigned t0 = 0; if (c.lane == 0) t0 = __hip_atomic_fetch_add(cnt + 64 * ((xcc + bo) & 7), (unsigned)CH, __ATOMIC_RELAXED, __HIP_MEMORY_SCOPE_AGENT);
            t0 = (unsigned)__builtin_amdgcn_readfirstlane((int)t0);
            if (t0 >= (unsigned)ML) { if (++bo >= 8) break; continue; }
            t = (int)t0; tend = t + CH;
        }
        const int x = (xcc + bo) & 7;
        float acc[16];
#pragma unroll
        for (int q = 0; q < 16; ++q) acc[q] = 0.f;
#pragma unroll 4
        for (int i = 0; i < 16; ++i) { const int k = 8 * i + grp; const int e = IDX[(size_t)t * 128 + k]; const float av = ACT[(size_t)t * 128 + k];
            const v4u row = *(const v4u*)(V8 + (size_t)e * D + x * 128 + 16 * sub); float f[16]; fp8x16_to_f32(row, f);
#pragma unroll
            for (int q = 0; q < 16; ++q) acc[q] = fmaf(av, f[q], acc[q]); }
        float q8[8], q4[4], q2[2];
#pragma unroll
        for (int i = 0; i < 8; ++i) { const float keep = b5 ? acc[i + 8] : acc[i], send = b5 ? acc[i] : acc[i + 8]; q8[i] = keep + __shfl_xor(send, 32); }
#pragma unroll
        for (int i = 0; i < 4; ++i) { const float keep = b4 ? q8[i + 4] : q8[i], send = b4 ? q8[i] : q8[i + 4]; q4[i] = keep + __shfl_xor(send, 16); }
#pragma unroll
        for (int i = 0; i < 2; ++i) { const float keep = b3 ? q4[i + 2] : q4[i], send = b3 ? q4[i] : q4[i + 2]; q2[i] = keep + __shfl_xor(send, 8); }
        const int col = x * 128 + 16 * sub + (b5 ? 8 : 0) + (b4 ? 4 : 0) + (b3 ? 2 : 0);
        *(f32x2*)(Y + (size_t)t * D + col) = (f32x2){q2[0], q2[1]};
        const float ss = wsum(q2[0] * q2[0] + q2[1] * q2[1]);
        SSQP[(size_t)x * ML + t] = ss;
        ++t;
    }
}
__device__ __forceinline__ void phase_exp3(const Ctx& c) {
    const Args& a = *c.a;
    const float* MOD = (const float*)(c.ws + WS_MOD); const float* Y = (const float*)(c.ws + WS_Y); const float* SSQP = (const float*)(c.ws + WS_SSQP);
    for (int row = c.gw; row < ML; row += c.NGW) {
        float ss = 0.f;
#pragma unroll
        for (int x = 0; x < 8; ++x) ss += SSQP[(size_t)x * ML + row];
        const float r = rsqrtf(ss * (1.f / D) + EPS); const float* mr = MOD + (row >> 11) * 6144 + 5120;
#pragma unroll
        for (int j = 0; j < 4; ++j) { const int col = 4 * c.lane + 256 * j;
            const f32x4 y = *(const f32x4*)(Y + (size_t)row * D + col), x1 = *(const f32x4*)(a.out + (size_t)row * D + col), g4 = *(const f32x4*)(a.in[I_GPOSTFFN] + col), gt = *(const f32x4*)(mr + col);
            *(f32x4*)(a.out + (size_t)row * D + col) = x1 + gt * ((y * r) * g4); }
    }
}

__device__ __forceinline__ void phase_experts(const Ctx& c) {
    const Args& a = *c.a;
    const float* MOD = (const float*)(c.ws + WS_MOD); const bf16* HX2 = (const bf16*)(c.ws + WS_HX2); const int* IDX = (const int*)(c.ws + WS_IDX); const float* GATE = (const float*)(c.ws + WS_GATE);
    float* acts = (float*)c.lds; int* eid = (int*)(c.lds + 512); float* red = (float*)(c.lds + 1024);
    for (int tok = c.bid; tok < ML; tok += c.G) {
        float hv[16];
#pragma unroll
        for (int j = 0; j < 4; ++j) { const v2u w = *(const v2u*)(HX2 + (size_t)tok * D + 4 * c.lane + 256 * j); hv[4 * j] = bflo(w.x); hv[4 * j + 1] = bfhi(w.x); hv[4 * j + 2] = bflo(w.y); hv[4 * j + 3] = bfhi(w.y); }
#pragma unroll 4
        for (int i = 0; i < 16; ++i) { const int k = c.wave * 16 + i; const int e = IDX[(size_t)tok * 128 + k];
            const f32x4* ur = (const f32x4*)(a.in[I_PU] + (size_t)e * D) + c.lane; float s = 0.f;
#pragma unroll
            for (int j = 0; j < 4; ++j) { const f32x4 u4 = ur[64 * j]; s += (u4.x * hv[4 * j] + u4.y * hv[4 * j + 1]) + (u4.z * hv[4 * j + 2] + u4.w * hv[4 * j + 3]); }
            s = wave_sum(s);
            if (c.lane == 0) { acts[k] = gelu_erf(s) * GATE[(size_t)tok * 128 + k]; eid[k] = e; } }
        __syncthreads();
        f32x2 acc = (f32x2){0.f, 0.f};
#pragma unroll 8
        for (int k = 0; k < 128; ++k) { const f32x2 v2 = *(const f32x2*)(a.in[I_PV] + (size_t)eid[k] * D + 2 * c.tid); const float ak = acts[k]; acc.x = fmaf(ak, v2.x, acc.x); acc.y = fmaf(ak, v2.y, acc.y); }
        const float ws = wave_sum(acc.x * acc.x + acc.y * acc.y);
        if (c.lane == 0) red[c.wave] = ws;
        __syncthreads();
        float tot = 0.f;
#pragma unroll
        for (int w = 0; w < 8; ++w) tot += red[w];
        const float r = rsqrtf(tot * (1.f / D) + EPS);
        const int col = 2 * c.tid; const float* mr = MOD + (tok >> 11) * 6144 + 5120;
        const f32x2 x1 = *(const f32x2*)(a.out + (size_t)tok * D + col), g2 = *(const f32x2*)(a.in[I_GPOSTFFN] + col), gt = *(const f32x2*)(mr + col);
        *(f32x2*)(a.out + (size_t)tok * D + col) = (f32x2){x1.x + gt.x * (acc.x * r * g2.x), x1.y + gt.y * (acc.y * r * g2.y)};
        __syncthreads();
    }
}


typedef short bf16x8 __attribute__((ext_vector_type(8)));
typedef float f32x16 __attribute__((ext_vector_type(16)));
#define MFMA32(a, b, c) __builtin_amdgcn_mfma_f32_32x32x16_bf16((a), (b), (c), 0, 0, 0)
constexpr int GDN_NCH = 36, GDN_ITEMS = NB * 4 * 2 * GDN_NCH;
constexpr size_t FR_T_BYTES = 8192, FR_ATT_BYTES = 8192, FR_KD_BYTES = 16384, FR_TAB_BYTES = 1024;
__device__ __forceinline__ int crow16(int i, int hh) { return (i & 3) + 8 * (i >> 2) + 4 * hh; }
__device__ __forceinline__ bf16x8 pack_step(const f32x16& x, int s) {
    v4u w; w.x = pk2(x[8 * s + 0], x[8 * s + 1]); w.y = pk2(x[8 * s + 2], x[8 * s + 3]); w.z = pk2(x[8 * s + 4], x[8 * s + 5]); w.w = pk2(x[8 * s + 6], x[8 * s + 7]);
    return __builtin_bit_cast(bf16x8, w);
}
constexpr int GP_KR = 0, GP_QR = 17408, GP_KT = 34816, GP_LM = 53248, GP_TB = 70656, GP_TAB = 79872;
__device__ __forceinline__ void gdn_prep_item(const Ctx& c, int item) {
    const int n = item % GDN_NCH, bhd = item / GDN_NCH, dir = bhd & 1, h = (bhd >> 1) & 3, b = bhd >> 3;
    const bf16* QKV = (const bf16*)(c.ws + WS_QKV); const float* GB = (const float*)(c.ws + WS_GB);
    bf16* Kr = (bf16*)(c.lds + GP_KR); bf16* Qr = (bf16*)(c.lds + GP_QR); bf16* Kt = (bf16*)(c.lds + GP_KT); float* Lm = (float*)(c.lds + GP_LM); bf16* Tb = (bf16*)(c.lds + GP_TB); float* tab = (float*)(c.lds + GP_TAB);
    unsigned char* frT = c.ws + WS_FRT + (size_t)item * FR_T_BYTES; unsigned char* frA = c.ws + WS_FRA + (size_t)item * FR_ATT_BYTES; unsigned char* frK = c.ws + WS_FRK + (size_t)item * FR_KD_BYTES; float* frTab = (float*)(c.ws + WS_FRTAB + (size_t)item * FR_TAB_BYTES);
    const int r = c.lane & 31, hh = c.lane >> 5;
    if (c.wave == 0) { const int row = scan_row(b, dir, n * 64 + c.lane); float g = GB[(size_t)row * 16 + dir * 4 + h]; const float beta = GB[(size_t)row * 16 + 8 + dir * 4 + h];
#pragma unroll
        for (int o = 1; o < 64; o <<= 1) { const float t = __shfl_up(g, o); if (c.lane >= o) g += t; }
        const float gl = __shfl(g, 63);
        tab[c.lane] = g; tab[64 + c.lane] = beta; tab[128 + c.lane] = __expf(g); tab[192 + c.lane] = __expf(gl - g); }
    { const int s = c.tid >> 3, seg = c.tid & 7; const int row = scan_row(b, dir, n * 64 + s); const bf16* rp = QKV + (size_t)row * 1536 + h * 128 + seg * 16;
      const v4u q0 = *(const v4u*)rp, q1 = *(const v4u*)(rp + 8), k0 = *(const v4u*)(rp + 512), k1 = *(const v4u*)(rp + 520);
      *(v4u*)(Qr + s * 136 + seg * 16) = q0; *(v4u*)(Qr + s * 136 + seg * 16 + 8) = q1; *(v4u*)(Kr + s * 136 + seg * 16) = k0; *(v4u*)(Kr + s * 136 + seg * 16 + 8) = k1;
      const unsigned kw[8] = {k0.x, k0.y, k0.z, k0.w, k1.x, k1.y, k1.z, k1.w};
#pragma unroll
      for (int e = 0; e < 8; ++e) { Kt[(seg * 16 + 2 * e) * 72 + s] = (bf16)(kw[e] & 0xffffu); Kt[(seg * 16 + 2 * e + 1) * 72 + s] = (bf16)(kw[e] >> 16); } }
    __syncthreads();
    if (c.wave < 3) { const int ct = c.wave ? 1 : 0, st = c.wave == 2 ? 1 : 0;
        f32x16 acc;
#pragma unroll
        for (int i = 0; i < 16; ++i) acc[i] = 0.f;
#pragma unroll
        for (int kk = 0; kk < 8; ++kk) { const bf16x8 a = *(const bf16x8*)(Kr + (ct * 32 + r) * 136 + kk * 16 + hh * 8), bb = *(const bf16x8*)(Kr + (st * 32 + r) * 136 + kk * 16 + hh * 8); acc = MFMA32(a, bb, acc); }
        const int s = st * 32 + r; const float gcs = tab[s];
#pragma unroll
        for (int i = 0; i < 16; ++i) { const int cc = ct * 32 + crow16(i, hh); Lm[cc * 68 + s] = (s < cc) ? tab[64 + cc] * acc[i] * __expf(tab[cc] - gcs) : 0.f; }
    } else if (c.wave < 6) { const int w = c.wave - 3, st = w == 2 ? 1 : 0, ct = w ? 1 : 0;
        f32x16 acc;
#pragma unroll
        for (int i = 0; i < 16; ++i) acc[i] = 0.f;
#pragma unroll
        for (int kk = 0; kk < 8; ++kk) { const bf16x8 a = *(const bf16x8*)(Kr + (st * 32 + r) * 136 + kk * 16 + hh * 8), bb = *(const bf16x8*)(Qr + (ct * 32 + r) * 136 + kk * 16 + hh * 8); acc = MFMA32(a, bb, acc); }
        const int cc = ct * 32 + r; const float gcc = tab[cc];
#pragma unroll
        for (int i = 0; i < 16; ++i) { const int s = st * 32 + crow16(i, hh); acc[i] = (s <= cc) ? acc[i] * __expf(gcc - tab[s]) : 0.f; }
        *(bf16x8*)(frA + ((size_t)((ct * 4 + 2 * st) * 64 + c.lane)) * 16) = pack_step(acc, 0);
        *(bf16x8*)(frA + ((size_t)((ct * 4 + 2 * st + 1) * 64 + c.lane)) * 16) = pack_step(acc, 1);
    } else { const int w = c.wave - 6;
#pragma unroll
        for (int f = 0; f < 8; ++f) { const int fi = w * 8 + f, dkt = fi >> 2, cb = fi & 3; const bf16* kp = Kt + (dkt * 32 + r) * 72 + 16 * cb + 4 * hh;
            const v2u lo = *(const v2u*)kp, hi = *(const v2u*)(kp + 8); const f32x4 e0 = *(const f32x4*)(tab + 192 + 16 * cb + 4 * hh), e1 = *(const f32x4*)(tab + 192 + 16 * cb + 8 + 4 * hh);
            v4u o; o.x = pk2(bflo(lo.x) * e0.x, bfhi(lo.x) * e0.y); o.y = pk2(bflo(lo.y) * e0.z, bfhi(lo.y) * e0.w); o.z = pk2(bflo(hi.x) * e1.x, bfhi(hi.x) * e1.y); o.w = pk2(bflo(hi.y) * e1.z, bfhi(hi.y) * e1.w);
            *(v4u*)(frK + ((size_t)(fi * 64 + c.lane)) * 16) = o; }
        if (w == 0) { const v4u z = (v4u){0u, 0u, 0u, 0u}; *(v4u*)(frA + ((size_t)((0 * 4 + 2) * 64 + c.lane)) * 16) = z; *(v4u*)(frA + ((size_t)((0 * 4 + 3) * 64 + c.lane)) * 16) = z; }
        else { *(f32x4*)(frTab + 4 * c.lane) = *(const f32x4*)(tab + 4 * c.lane); }
    }
    __syncthreads();
    if (c.wave == 0) { float Tr[64];
#pragma unroll
        for (int i = 0; i < 64; ++i) { float a0 = (c.lane == i) ? 1.f : 0.f, a1 = 0.f;
#pragma unroll
            for (int s4 = 0; s4 < (i + 3) / 4; ++s4) { const f32x4 l4 = *(const f32x4*)(Lm + i * 68 + 4 * s4);
                if (4 * s4 + 0 < i) a0 = fmaf(-l4.x, Tr[4 * s4 + 0], a0); if (4 * s4 + 1 < i) a1 = fmaf(-l4.y, Tr[4 * s4 + 1], a1); if (4 * s4 + 2 < i) a0 = fmaf(-l4.z, Tr[4 * s4 + 2], a0); if (4 * s4 + 3 < i) a1 = fmaf(-l4.w, Tr[4 * s4 + 3], a1); }
            Tr[i] = a0 + a1; Tb[i * 72 + c.lane] = (bf16)f2bf(Tr[i]); } }
    __syncthreads();
    { const int ct = c.wave >> 2, sb = c.wave & 3; const bf16* tp = Tb + (ct * 32 + r) * 72 + 16 * sb + 4 * hh; const v2u lo = *(const v2u*)tp, hi = *(const v2u*)(tp + 8);
      *(v4u*)(frT + ((size_t)((ct * 4 + sb) * 64 + c.lane)) * 16) = (v4u){lo.x, lo.y, hi.x, hi.y}; }
    __syncthreads();
}
__device__ __forceinline__ void phase_gdn_prep(const Ctx& c) { for (int item = c.bid; item < GDN_ITEMS; item += c.G) gdn_prep_item(c, item); }

constexpr int GR_K = 0, GR_Q = 16384, GR_T = 32768, GR_A = 40960, GR_KD = 49152, GR_TAB = 65536, GR_BUF = 66560;
__device__ __forceinline__ void gdn_rec_stage(const Ctx& c, int bhd, int n, int buf) {
    const int dir = bhd & 1, h = (bhd >> 1) & 3, b = bhd >> 3, lw = c.wave - 4; const int item = bhd * GDN_NCH + n;
    LAS unsigned char* base = (LAS unsigned char*)c.lds + buf * GR_BUF;
    const unsigned char* QKVb = c.ws + WS_QKV;
#pragma unroll
    for (int q = 0; q < 4; ++q) { const int qi = lw + 4 * q;
        const int s = 4 * qi + (c.lane >> 4), ps = c.lane & 15, p = ps ^ (s & 15); const size_t rowb = (size_t)scan_row(b, dir, n * 64 + s) * 3072 + (size_t)h * 256 + p * 16;
        __builtin_amdgcn_global_load_lds((const unsigned*)(QKVb + rowb + 1024), (LAS unsigned*)(base + GR_K + qi * 1024), 16, 0, 0);
        __builtin_amdgcn_global_load_lds((const unsigned*)(QKVb + rowb), (LAS unsigned*)(base + GR_Q + qi * 1024), 16, 0, 0); }
    const unsigned char* frT = c.ws + WS_FRT + (size_t)item * FR_T_BYTES; const unsigned char* frA = c.ws + WS_FRA + (size_t)item * FR_ATT_BYTES; const unsigned char* frK = c.ws + WS_FRK + (size_t)item * FR_KD_BYTES;
#pragma unroll
    for (int q = 0; q < 2; ++q) { const int qi = lw + 4 * q;
        __builtin_amdgcn_global_load_lds((const unsigned*)(frT + qi * 1024 + c.lane * 16), (LAS unsigned*)(base + GR_T + qi * 1024), 16, 0, 0);
        __builtin_amdgcn_global_load_lds((const unsigned*)(frA + qi * 1024 + c.lane * 16), (LAS unsigned*)(base + GR_A + qi * 1024), 16, 0, 0); }
#pragma unroll
    for (int q = 0; q < 4; ++q) { const int qi = lw + 4 * q;
        __builtin_amdgcn_global_load_lds((const unsigned*)(frK + qi * 1024 + c.lane * 16), (LAS unsigned*)(base + GR_KD + qi * 1024), 16, 0, 0); }
    if (lw == 0) __builtin_amdgcn_global_load_lds((const unsigned*)(c.ws + WS_FRTAB + (size_t)item * FR_TAB_BYTES + c.lane * 16), (LAS unsigned*)(base + GR_TAB), 16, 0, 0);
}
__device__ __forceinline__ bf16x8 gr_rowfrag(const unsigned char* tile, int row, int kb, int hh) {
    const unsigned char* rp = tile + row * 256; const int sw = row & 15;
    const v2u lo = *(const v2u*)(rp + (((2 * kb) ^ sw) * 16) + 8 * hh), hi = *(const v2u*)(rp + (((2 * kb + 1) ^ sw) * 16) + 8 * hh);
    return __builtin_bit_cast(bf16x8, (v4u){lo.x, lo.y, hi.x, hi.y});
}
__device__ __forceinline__ void gdn_rec_block(const Ctx& c, int bhd) {
    const int dir = bhd & 1, h = (bhd >> 1) & 3, b = bhd >> 3, r = c.lane & 31, hh = c.lane >> 5, dvt = c.wave;
    const bf16* QKV = (const bf16*)(c.ws + WS_QKV); bf16* OG = (bf16*)(c.ws + WS_OG) + (size_t)dir * ML * 512;
    f32x16 S[4];
#pragma unroll
    for (int t = 0; t < 4; ++t)
#pragma unroll
        for (int i = 0; i < 16; ++i) S[t][i] = 0.f;
    if (c.wave >= 4) gdn_rec_stage(c, bhd, 0, 0);
    asm volatile("s_waitcnt vmcnt(0)" ::: "memory"); __syncthreads();
    for (int n = 0; n < GDN_NCH; ++n) {
        const int buf = n & 1;
        if (c.wave >= 4) { if (n + 1 < GDN_NCH) gdn_rec_stage(c, bhd, n + 1, buf ^ 1); }
        else {
            const unsigned char* base = c.lds + buf * GR_BUF; const float* tab = (const float*)(base + GR_TAB);
            const int row0 = scan_row(b, dir, n * 64), sgn = dir ? -1 : 1;
            const bf16* vcol = QKV + (size_t)row0 * 1536 + 1024 + h * 128 + dvt * 32 + r + (ptrdiff_t)(sgn * 4 * hh) * 1536;
            bf16* ocol = OG + (size_t)row0 * 512 + h * 128 + dvt * 32 + r + (ptrdiff_t)(sgn * 4 * hh) * 512;
            const ptrdiff_t vst = (ptrdiff_t)sgn * 1536, ost = (ptrdiff_t)sgn * 512;
            bf16x8 Sf[4][2];
#pragma unroll
            for (int t = 0; t < 4; ++t) { Sf[t][0] = pack_step(S[t], 0); Sf[t][1] = pack_step(S[t], 1); }
            bf16x8 Rf[2][2];
#pragma unroll
            for (int st = 0; st < 2; ++st) { f32x16 acc; bf16 vraw[16];
#pragma unroll
                for (int i = 0; i < 16; ++i) { acc[i] = 0.f; vraw[i] = vcol[vst * (st * 32 + (i & 3) + 8 * (i >> 2))]; }
#pragma unroll
                for (int kb = 0; kb < 8; ++kb) acc = MFMA32(gr_rowfrag(base + GR_K, st * 32 + r, kb, hh), Sf[kb >> 1][kb & 1], acc);
#pragma unroll
                for (int i = 0; i < 16; ++i) { const int s = st * 32 + crow16(i, hh); acc[i] = tab[64 + s] * (bf1(vraw[i]) - tab[128 + s] * acc[i]); }
                Rf[st][0] = pack_step(acc, 0); Rf[st][1] = pack_step(acc, 1); asm volatile("" ::: "memory"); }
            bf16x8 Vf[2][2];
#pragma unroll
            for (int ct = 0; ct < 2; ++ct) { f32x16 acc;
#pragma unroll
                for (int i = 0; i < 16; ++i) acc[i] = 0.f;
#pragma unroll
                for (int sb = 0; sb < 4; ++sb) if (sb < 2 * ct + 2) acc = MFMA32(*(const bf16x8*)(base + GR_T + ((ct * 4 + sb) * 64 + c.lane) * 16), Rf[sb >> 1][sb & 1], acc);
                Vf[ct][0] = pack_step(acc, 0); Vf[ct][1] = pack_step(acc, 1); }
            asm volatile("" ::: "memory");
#pragma unroll
            for (int ct = 0; ct < 2; ++ct) { f32x16 acc;
#pragma unroll
                for (int i = 0; i < 16; ++i) acc[i] = 0.f;
#pragma unroll
                for (int kb = 0; kb < 8; ++kb) acc = MFMA32(gr_rowfrag(base + GR_Q, ct * 32 + r, kb, hh), Sf[kb >> 1][kb & 1], acc);
#pragma unroll
                for (int i = 0; i < 16; ++i) acc[i] *= tab[128 + ct * 32 + crow16(i, hh)];
#pragma unroll
                for (int cb = 0; cb < 4; ++cb) if (cb < 2 * ct + 2) acc = MFMA32(*(const bf16x8*)(base + GR_A + ((ct * 4 + cb) * 64 + c.lane) * 16), Vf[cb >> 1][cb & 1], acc);
                if (n >= 4) {
#pragma unroll
                    for (int i = 0; i < 16; ++i) ocol[ost * (ct * 32 + (i & 3) + 8 * (i >> 2))] = (bf16)f2bf(acc[i]); }
                asm volatile("" ::: "memory"); }
            const float gtot = tab[128 + 63];
#pragma unroll
            for (int t = 0; t < 4; ++t) {
#pragma unroll
                for (int i = 0; i < 16; ++i) S[t][i] *= gtot;
#pragma unroll
                for (int cb = 0; cb < 4; ++cb) S[t] = MFMA32(*(const bf16x8*)(base + GR_KD + ((t * 4 + cb) * 64 + c.lane) * 16), Vf[cb >> 1][cb & 1], S[t]); }
        }
        asm volatile("s_waitcnt vmcnt(0)" ::: "memory"); __syncthreads();
    }
}
__device__ __forceinline__ void phase_gdn_rec(const Ctx& c) { for (int bhd = c.bid; bhd < 64; bhd += c.G) gdn_rec_block(c, bhd); }

#define XB_TMO      128
#define XB_XCNT(j)  (256  + 64 * (j))
#define XB_XSUB(j)  (1280 + 64 * (j))
#define XB_XGEN(j)  (2304 + 64 * (j))
#define XB_TOP      3328
#define XB_TOPGEN   3392
#define XCD_BAR_WORDS 3456
#define XB_SPIN_CAP (1u << 20)
__device__ __forceinline__ unsigned xb_ld(unsigned* p)              { return __hip_atomic_load(p, __ATOMIC_RELAXED, __HIP_MEMORY_SCOPE_AGENT); }
__device__ __forceinline__ unsigned xb_add(unsigned* p, unsigned v) { return __hip_atomic_fetch_add(p, v, __ATOMIC_RELAXED, __HIP_MEMORY_SCOPE_AGENT); }
__device__ __forceinline__ unsigned xb_xcc_id() { return (unsigned)__builtin_amdgcn_s_getreg((3 << 11) | 20) & 0xFu; }
#define XB_SPIN(cond, bar) do { unsigned _sp = 0; while (cond) { __builtin_amdgcn_s_sleep(1); \
    if ((++_sp & 255u) == 0u) { if (xb_ld(&(bar)[XB_TMO])) break; if (_sp > XB_SPIN_CAP) { atomicAdd(&(bar)[XB_TMO], 1u); break; } } } } while (0)
struct XcdBarrier { unsigned* bar; unsigned x; volatile LAS unsigned* st; };
__device__ __forceinline__ XcdBarrier xcd_barrier_post(unsigned* bar, volatile LAS unsigned* st) {
    XcdBarrier b; b.bar = bar; b.x = xb_xcc_id(); b.st = st;
    if (threadIdx.x == 0) (void)xb_add(&bar[XB_XCNT(b.x)], 1u);
    return b;
}
__device__ __forceinline__ void xcd_barrier_complete(unsigned* bar, unsigned x, unsigned& nloc, unsigned& nx) {
    const unsigned G = gridDim.x * gridDim.y * gridDim.z;
    unsigned sum, cnt, mine, sp = 0u;
    for (;;) {
        sum = 0u; cnt = 0u; mine = 0u;
#pragma unroll
        for (unsigned j = 0; j < 16; ++j) { const unsigned c = xb_ld(&bar[XB_XCNT(j)]); sum += c; cnt += (c > 0u) ? 1u : 0u; mine = (j == x) ? c : mine; }
        if (sum == G) break;
        __builtin_amdgcn_s_sleep(1);
        if ((++sp & 255u) == 0u) { if (xb_ld(&bar[XB_TMO])) break; if (sp > XB_SPIN_CAP) { atomicAdd(&bar[XB_TMO], 1u); break; } }
    }
    nloc = mine > 0u ? mine : 1u; nx = cnt > 0u ? cnt : 1u;
}
__device__ __forceinline__ void xcd_barrier(const XcdBarrier& b) {
    asm volatile("s_waitcnt vmcnt(0)" ::: "memory");
    __syncthreads();
    if (threadIdx.x == 0) {
        unsigned* bar = b.bar;
        __builtin_amdgcn_s_waitcnt(0);
        unsigned nloc = b.st[0], nx = b.st[1];
        if (nloc == 0u) { xcd_barrier_complete(bar, b.x, nloc, nx); b.st[0] = nloc; b.st[1] = nx; }
        const unsigned old = xb_add(&bar[XB_XSUB(b.x)], 1u);
        const unsigned gen = old / nloc;
        if (old + 1u == (gen + 1u) * nloc) {
            __builtin_amdgcn_fence(__ATOMIC_RELEASE, "agent");
            asm volatile("s_waitcnt vmcnt(0)" ::: "memory");
            const unsigned og = xb_add(&bar[XB_TOP], 1u);
            const unsigned tg = og / nx;
            if (og + 1u == (tg + 1u) * nx) xb_add(&bar[XB_TOPGEN], 1u);
            else XB_SPIN(xb_ld(&bar[XB_TOPGEN]) == tg, bar);
            __builtin_amdgcn_fence(__ATOMIC_ACQUIRE, "agent");
            xb_add(&bar[XB_XGEN(b.x)], 1u);
            asm volatile("s_waitcnt vmcnt(0)" ::: "memory");
        } else {
            XB_SPIN(xb_ld(&bar[XB_XGEN(b.x)]) == gen, bar);
            __builtin_amdgcn_fence(__ATOMIC_ACQUIRE, "agent");
            asm volatile("s_waitcnt vmcnt(0)" ::: "memory");
        }
    }
    __syncthreads();
}

constexpr int LDS_MISC = LDS_BYTES - 64;
__global__ void __launch_bounds__(NTHREADS, 2) mk_fwd(Args args) {
    extern __shared__ __attribute__((aligned(16))) unsigned char lds[];
    Ctx c; c.a = &args; c.ws = args.ws; c.lds = lds;
    c.tid = threadIdx.x; c.lane = c.tid & 63; c.wave = __builtin_amdgcn_readfirstlane(c.tid >> 6); c.bid = blockIdx.x; c.G = gridDim.x;
    c.gw = c.bid * NWAVES + c.wave; c.NGW = c.G * NWAVES; c.gwv = c.wave * c.G + c.bid;
    const int lo = args.ph_lo, hi = args.ph_hi;
    PG8_LAS unsigned char* ring = (PG8_LAS unsigned char*)lds;
#ifndef MK_PH_MASK
#define MK_PH_MASK 0xffff
#endif
#define IN(k) (((MK_PH_MASK >> (k)) & 1) && lo <= (k) && (k) < hi)
#if MK_ONE_LAUNCH
    cg::grid_group grid = cg::this_grid();
    if (lo < 0) grid.sync();
    volatile LAS unsigned* st = (volatile LAS unsigned*)((LAS unsigned char*)lds + LDS_MISC);
    if (c.tid < 2) st[c.tid] = 0u;
    __syncthreads();
    const XcdBarrier bar = xcd_barrier_post((unsigned*)(c.ws + WS_CTL) + CW_BAR, st);
#define SEAM(k) do { if (IN(k) && IN((k) + 1)) xcd_barrier(bar); } while (0)
#else
#define SEAM(k) do { } while (0)
#endif
    if (IN(0)) { phase_prep(c); } SEAM(0);
    if (IN(1)) { phase_norm1(c); } SEAM(1);
    if (IN(2)) { pg8::Gemm g{(const pg8::bf16_t*)(c.ws + WS_HX), (const pg8::bf16_t*)(c.ws + WS_WIN), 1024, 1024, 1024}; pg8::StaticOrder S; S.init(MT, NPROJ, c.G, c.bid);
        pg8::EpiInProj E{(pg8::bf16_t*)(c.ws + WS_U), (pg8::bf16_t*)(c.ws + WS_QKVPRE), (pg8::bf16_t*)(c.ws + WS_Z)};
        pg8::gemm_phase<pg8::EpiInProj, pg8::StaticOrder, true, true>(ring, g, S, E); } SEAM(2);
    if (IN(3)) { phase_conv(c); } SEAM(3);
    if (IN(4)) { phase_gdn_prep(c); } SEAM(4);
    if (IN(5)) { phase_gdn_rec(c); phase_scan_direct(c); } SEAM(5);
    if (IN(6)) { phase_combine(c); } SEAM(6);
    if (IN(7)) { pg8::Gemm g{(const pg8::bf16_t*)(c.ws + WS_YG), (const pg8::bf16_t*)(c.ws + WS_WGLU), 512, 512, 512}; pg8::StaticOrder S; S.init(ML, 512, c.G, c.bid);
        pg8::EpiGlu E{(const pg8::bf16_t*)(c.ws + WS_YG), (pg8::bf16_t*)(c.ws + WS_CAT)};
        pg8::gemm_phase<pg8::EpiGlu, pg8::StaticOrder, true, true>(ring, g, S, E); } SEAM(7);
    if (IN(8)) { pg8::Gemm g{(const pg8::bf16_t*)(c.ws + WS_CAT), (const pg8::bf16_t*)(c.ws + WS_WOUT), 1024, 1024, 1024}; pg8::StaticOrder S; S.init(ML, 1024, c.G, c.bid);
        pg8::EpiF32 E{(float*)(c.ws + WS_YRAW), 1024};
        pg8::gemm_phase<pg8::EpiF32, pg8::StaticOrder, true, true>(ring, g, S, E); } SEAM(8);
    if (IN(9)) { phase_rows2(c); phase_fp8_tables(c); } SEAM(9);
    if (IN(10)) { pg8::Gemm g{(const pg8::bf16_t*)(c.ws + WS_HX2), (const pg8::bf16_t*)(c.ws + WS_WQ), 1024, 1024, 1024}; pg8::StaticOrder S; S.init(ML, 2048, c.G, c.bid);
        pg8::EpiBf16<0> E{(pg8::bf16_t*)(c.ws + WS_QP), 2048, nullptr, 0, 0, 1.f};
        pg8::gemm_phase<pg8::EpiBf16<0>, pg8::StaticOrder, true, true>(ring, g, S, E); } SEAM(10);
    if (IN(11)) { phase_topk(c); } SEAM(11);
    if (IN(12)) { phase_exp1(c); } SEAM(12);
    if (IN(13)) { phase_exp2(c); } SEAM(13);
    if (IN(14)) { phase_exp3(c); }
#undef IN
#undef SEAM
}

extern "C" void kernel_launch(void* const* d_in, const int* in_sizes, int n_in, void* d_out, int out_size, void* d_ws, size_t ws_size, hipStream_t stream) {
    static int grid = 0;
    if (grid == 0) {
        if (n_in != 29 || out_size != ML * D || ws_size < WS_END) { fprintf(stderr, "kernel_launch: unexpected shapes (n_in %d out %d ws %zu)\n", n_in, out_size, ws_size); grid = -1; return; }
        int dev = 0, cus = 0, per_cu = 0;
        (void)hipGetDevice(&dev); (void)hipDeviceGetAttribute(&cus, hipDeviceAttributeMultiprocessorCount, dev);
        if (hipFuncSetAttribute((const void*)mk_fwd, hipFuncAttributeMaxDynamicSharedMemorySize, LDS_BYTES) != hipSuccess) { fprintf(stderr, "kernel_launch: hipFuncSetAttribute failed\n"); grid = -1; return; }
        (void)hipOccupancyMaxActiveBlocksPerMultiprocessor(&per_cu, (const void*)mk_fwd, NTHREADS, LDS_BYTES);
        (void)hipGetLastError();
        grid = cus;
        fprintf(stderr, "kernel_launch: cus %d per_cu %d grid %d\n", cus, per_cu, grid);
    }
    if (grid < 0) return;
    Args a{};
    for (int i = 0; i < 29; ++i) a.in[i] = (const float*)d_in[i];
    a.out = (float*)d_out; a.ws = (unsigned char*)d_ws;
    (void)hipMemsetAsync((char*)d_ws + WS_CTL, 0, CTL_ZERO_BYTES, stream);
#if MK_ONE_LAUNCH
    a.ph_lo = 0; a.ph_hi = NPHASES;
    void* kargs[] = {&a};
    hipError_t e = hipLaunchCooperativeKernel((const void*)mk_fwd, dim3(grid), dim3(NTHREADS), kargs, LDS_BYTES, stream);
    if (e != hipSuccess) fprintf(stderr, "kernel_launch: cooperative launch failed: %s\n", hipGetErrorString(e));
#else
    for (int ph = 0; ph < NPHASES; ++ph) { a.ph_lo = ph; a.ph_hi = ph + 1; hipLaunchKernelGGL(mk_fwd, dim3(grid), dim3(NTHREADS), LDS_BYTES, stream, a); }
#endif
}
```

```cpp
#include <hip/hip_runtime.h>
#include <hip/hip_cooperative_groups.h>
#include <cstdio>
#include <cstdint>
namespace cg = cooperative_groups;
namespace pg8 {
#define PG8_LAS __attribute__((address_space(3)))
typedef unsigned short bf16_t;
typedef short bf16x8 __attribute__((ext_vector_type(8)));
typedef float f32x4 __attribute__((ext_vector_type(4)));
typedef unsigned u32x4 __attribute__((ext_vector_type(4)));
constexpr int BM = 256, BK = 64, HALF = 128, HTB = HALF * BK * 2  , STAGE_BYTES = 8 * HTB, NXCD = 8, WGM = 8;

__host__ __device__ __forceinline__ int lds_byte(int r, int c) { const int st = (r >> 4) * 2 + (c >> 5), rr = r & 15, cc = c & 31, ob = rr * 64 + cc * 2; return st * 1024 + (ob ^ (((ob >> 9) & 1) << 5)); }
__host__ __device__ __forceinline__ void stage_rc(int b, int& R, int& C) { const int st = b / 1024, sb = b % 1024, swz = sb ^ (((sb >> 9) & 1) << 5); R = (st >> 1) * 16 + swz / 64; C = (st & 1) * 32 + (swz % 64) / 2; }
__host__ __device__ __forceinline__ int perm32(int rho) { const int n = rho >> 4, i = rho & 15; return 8 * (i >> 2) + 4 * n + (i & 3); }

struct Unit { int pm, pn; };
struct Gemm { const bf16_t* A; const bf16_t* Bt; int lda, ldb, K; };

struct StaticOrder {
    int nM, nN, nwg, G, c;
    __host__ __device__ void init(int M, int N, int G_, int c_) { nM = M / BM; nN = N / BM; nwg = nM * nN; G = G_; c = c_; }
    __host__ __device__ bool next(int i, Unit& u) const {
        const long L = (long)i * G + c; if (L >= nwg) return false;
        int wgid = (int)L; { const int q = nwg / NXCD, r = nwg % NXCD, xcd = wgid % NXCD, off = wgid / NXCD; wgid = (xcd < r ? xcd * (q + 1) : r * (q + 1) + (xcd - r) * q) + off; }
        const int nig = WGM * nN, gid = wgid / nig, fm = gid * WGM, gsz = (nM - fm) < WGM ? (nM - fm) : WGM;
        u.pm = fm + ((wgid % nig) % gsz); u.pn = (wgid % nig) / gsz; return true;
    }
    __device__ __forceinline__ void a_ready(const Unit&) const {}
    __device__ __forceinline__ void done(const Unit&) const {}
};

__device__ __forceinline__ unsigned cvt_pk_bf16(float lo, float hi) { unsigned r; asm volatile("v_cvt_pk_bf16_f32 %0, %1, %2" : "=v"(r) : "v"(lo), "v"(hi)); return r; }
typedef float f32x2 __attribute__((ext_vector_type(2)));
__device__ __forceinline__ f32x2 gelu_pk(f32x2 v) {
    const f32x2 av = __builtin_elementwise_abs(v), d = av * 0.2316418882f + 1.0f;
    f32x2 t; t.x = __builtin_amdgcn_rcpf(d.x); t.y = __builtin_amdgcn_rcpf(d.y);
    f32x2 q = t * 0.5307027145f + (-0.7265760135f); q = q * t + 0.7107068705f; q = q * t + (-0.142248368f); q = q * t + 0.127414796f; q = q * t;
    const f32x2 s = (v * v) * (-0.72134752044f);
    f32x2 e; e.x = __builtin_amdgcn_exp2f(s.x); e.y = __builtin_amdgcn_exp2f(s.y);
    const f32x2 m = v * (q * e), r = v - m;
    f32x2 o; o.x = v.x < 0.f ? m.x : r.x; o.y = v.y < 0.f ? m.y : r.y; return o;
}

template <int ACT  > struct EpiBf16 {
    static constexpr bool PERM = true, AFTER_DRAIN = false; static_assert(ACT == 0 || ACT == 1, "EpiBf16: ACT is 0 (none) or 1 (gelu_pk)");
    bf16_t* O; int ldc; const float* bias; int split_cols; size_t split_stride; float scale0;
    __device__ __forceinline__ void operator()(const f32x4 (&acc)[2][2][4][2], const Unit& u, int wr, int wc, int fr, int fq) const {
        const int row0 = u.pm * BM + wr * 64 + fr; int colt = u.pn * BM; bf16_t* base = O;
        float sc = 1.f; if (split_cols) { const int t = colt / split_cols; base += (size_t)t * split_stride; colt -= t * split_cols; if (t == 0) sc = scale0; }
        const int col0 = colt + wc * 32 + 8 * fq, bcol0 = u.pn * BM + wc * 32 + 8 * fq;
        f32x4 bv[2][2];
#pragma unroll
        for (int bj = 0; bj < 2; ++bj)
#pragma unroll
            for (int n = 0; n < 2; ++n) bv[bj][n] = bias ? *(const f32x4*)(bias + bcol0 + bj * HALF + 4 * n) : (f32x4){0.f, 0.f, 0.f, 0.f};
#pragma unroll
        for (int ai = 0; ai < 2; ++ai)
#pragma unroll
            for (int m = 0; m < 4; ++m) { bf16_t* rowp = base + (size_t)(row0 + ai * HALF + m * 16) * ldc + col0;
#pragma unroll
                for (int bj = 0; bj < 2; ++bj) { f32x4 v0 = acc[ai][bj][m][0] + bv[bj][0], v1 = acc[ai][bj][m][1] + bv[bj][1];
                    if (ACT == 1) { f32x2 a = gelu_pk((f32x2){v0[0], v0[1]}), b = gelu_pk((f32x2){v0[2], v0[3]}), c = gelu_pk((f32x2){v1[0], v1[1]}), d = gelu_pk((f32x2){v1[2], v1[3]});
                        v0 = (f32x4){a.x, a.y, b.x, b.y}; v1 = (f32x4){c.x, c.y, d.x, d.y}; }
                    v0 = v0 * sc; v1 = v1 * sc; u32x4 w; w.x = cvt_pk_bf16(v0[0], v0[1]); w.y = cvt_pk_bf16(v0[2], v0[3]); w.z = cvt_pk_bf16(v1[0], v1[1]); w.w = cvt_pk_bf16(v1[2], v1[3]);
                    *(u32x4*)(rowp + bj * HALF) = w; } }
    }
};

template <class Epi, class Sched, bool ALIGN_EPI = false, bool SP2 = false>
__device__ __forceinline__ void gemm_phase(PG8_LAS unsigned char* lds, const Gemm g, const Sched& S, const Epi& E) {
    const int tid = threadIdx.x, wid = __builtin_amdgcn_readfirstlane(tid >> 6), lane = tid & 63, wr = wid >> 2, wc = wid & 3, fr = lane & 15, fq = lane >> 4;
    const int K = g.K, nt = K / BK;
    unsigned voffA[2], voffB[2];
#pragma unroll
    for (int i = 0; i < 2; ++i) { int R, C; stage_rc(tid * 16 + i * 8192, R, C); const int Rb = Epi::PERM ? ((R & ~31) + perm32(R & 31)) : R;
        voffA[i] = (unsigned)(R * g.lda + C) * 2u; voffB[i] = (unsigned)(Rb * g.ldb + C) * 2u; }
    const size_t kstep = (size_t)(BK * 2);
    const size_t hstepA = (size_t)HALF * g.lda * 2, hstepB = (size_t)HALF * g.ldb * 2;
    const size_t tstepA = 2 * hstepA, tstepB = 2 * hstepB;
    const unsigned ldsw = (unsigned)wid * 1024u;
    const int aoff = lds_byte(wr * 64 + fr, fq * 8), boff = lds_byte(wc * 32 + fr, fq * 8);
#define PG8_SA(b, h) (((b) * 2 + (h)) * HTB)
#define PG8_SB(b, h) ((4 + (b) * 2 + (h)) * HTB)
#define PG8_STAGE(bufoff, gbase, voff) do { _Pragma("unroll") for (int _i = 0; _i < 2; ++_i) \
        __builtin_amdgcn_global_load_lds((const unsigned*)((const char*)(gbase) + (voff)[_i]), (PG8_LAS unsigned*)(lds + (bufoff) + ldsw + _i * 8192), 16, 0, 0); } while (0)
#define PG8_LDA(dst, b, h) do { _Pragma("unroll") for (int m = 0; m < 4; ++m) _Pragma("unroll") for (int k = 0; k < 2; ++k) dst[m][k] = *(const PG8_LAS bf16x8*)(lds + PG8_SA(b, h) + aoff + m * 2048 + k * 1024); } while (0)
#define PG8_LDB(dst, b, h) do { _Pragma("unroll") for (int n = 0; n < 2; ++n) _Pragma("unroll") for (int k = 0; k < 2; ++k) dst[n][k] = *(const PG8_LAS bf16x8*)(lds + PG8_SB(b, h) + boff + n * 2048 + k * 1024); } while (0)
#define PG8_MMA(ai, bj, At, Bt) do { __builtin_amdgcn_s_setprio(1); _Pragma("unroll") for (int m = 0; m < 4; ++m) _Pragma("unroll") for (int n = 0; n < 2; ++n) _Pragma("unroll") for (int k = 0; k < 2; ++k) \
        acc[ai][bj][m][n] = __builtin_amdgcn_mfma_f32_16x16x32_bf16(Bt[n][k], At[m][k], acc[ai][bj][m][n], 0, 0, 0); __builtin_amdgcn_s_setprio(0); } while (0)
#define PG8_WAIT_V(n) asm volatile("s_waitcnt vmcnt(" #n ")" ::: "memory")
#define PG8_WAIT_L(n) asm volatile("s_waitcnt lgkmcnt(" #n ")" ::: "memory")
#define PG8_BAR __builtin_amdgcn_s_barrier()
#define PG8_SCHED __builtin_amdgcn_sched_barrier(0)
    Unit cur, nxt; int ui = 0;
    if (!S.next(0, cur)) return;
    f32x4 acc[2][2][4][2];
#pragma unroll
    for (int a = 0; a < 2; ++a)
#pragma unroll
        for (int b = 0; b < 2; ++b)
#pragma unroll
            for (int m = 0; m < 4; ++m)
#pragma unroll
                for (int n = 0; n < 2; ++n) acc[a][b][m][n] = (f32x4){0.f, 0.f, 0.f, 0.f};
    bf16x8 At[4][2], B0[2][2], B1[2][2];
    const char* cA = (const char*)g.A + (size_t)cur.pm * tstepA; const char* cB = (const char*)g.Bt + (size_t)cur.pn * tstepB;
    S.a_ready(cur);
    if constexpr (SP2) {
        PG8_STAGE(PG8_SB(0, 0), cB, voffB); PG8_STAGE(PG8_SB(0, 1), cB + hstepB, voffB); PG8_STAGE(PG8_SA(0, 0), cA, voffA); PG8_STAGE(PG8_SA(0, 1), cA + hstepA, voffA);
        if (wr == 1) PG8_BAR;
        PG8_WAIT_V(2); PG8_BAR;
        PG8_STAGE(PG8_SB(1, 0), cB + kstep, voffB); PG8_STAGE(PG8_SA(1, 0), cA + kstep, voffA); PG8_STAGE(PG8_SB(1, 1), cB + hstepB + kstep, voffB);
        PG8_WAIT_V(6); PG8_BAR;
    } else {
        PG8_STAGE(PG8_SB(0, 0), cB, voffB); PG8_STAGE(PG8_SA(0, 0), cA, voffA); PG8_STAGE(PG8_SB(0, 1), cB + hstepB, voffB); PG8_STAGE(PG8_SA(0, 1), cA + hstepA, voffA);
        if (wr == 1) PG8_BAR;
        PG8_WAIT_V(4); PG8_BAR;
        PG8_STAGE(PG8_SB(1, 0), cB + kstep, voffB); PG8_STAGE(PG8_SA(1, 0), cA + kstep, voffA); PG8_STAGE(PG8_SB(1, 1), cB + hstepB + kstep, voffB);
        PG8_WAIT_V(6); PG8_BAR;
    }
    for (;;) {
        const bool has_next = S.next(ui + 1, nxt);
        const char* nA = has_next ? (const char*)g.A + (size_t)nxt.pm * tstepA : cA; const char* nB = has_next ? (const char*)g.Bt + (size_t)nxt.pn * tstepB : cB;
        for (int t = 0; t < nt; t += 2) {
            const bool last = (t == nt - 2);
            const char* a1 = cA + (size_t)(t + 1) * kstep;
            const char* a2 = last ? nA : cA + (size_t)(t + 2) * kstep; const char* b2 = last ? nB : cB + (size_t)(t + 2) * kstep;
            const char* a3 = a2 + kstep; const char* b3 = b2 + kstep;
            if (last && has_next) S.a_ready(nxt);
            if constexpr (SP2) {
            PG8_LDB(B0, 0, 0); PG8_LDB(B1, 0, 1); PG8_SCHED; PG8_LDA(At, 0, 0); PG8_STAGE(PG8_SA(1, 1), a1 + hstepA, voffA);
            PG8_WAIT_V(8); PG8_WAIT_L(0); PG8_BAR; PG8_MMA(0, 0, At, B0); PG8_MMA(0, 1, At, B1); PG8_BAR; PG8_SCHED;
            PG8_LDA(At, 0, 1); PG8_STAGE(PG8_SB(0, 0), b2, voffB); PG8_STAGE(PG8_SB(0, 1), b2 + hstepB, voffB); PG8_STAGE(PG8_SA(0, 0), a2, voffA);
            PG8_WAIT_V(8); PG8_WAIT_L(0); PG8_BAR; PG8_MMA(1, 0, At, B0); PG8_MMA(1, 1, At, B1); PG8_BAR; PG8_SCHED;
            PG8_LDB(B0, 1, 0); PG8_LDB(B1, 1, 1); PG8_SCHED; PG8_LDA(At, 1, 0); PG8_STAGE(PG8_SA(0, 1), a2 + hstepA, voffA);
            PG8_WAIT_V(8); PG8_WAIT_L(0); PG8_BAR; PG8_MMA(0, 0, At, B0); PG8_MMA(0, 1, At, B1); PG8_BAR; PG8_SCHED;
            PG8_LDA(At, 1, 1); PG8_STAGE(PG8_SB(1, 0), b3, voffB); PG8_STAGE(PG8_SB(1, 1), b3 + hstepB, voffB); PG8_STAGE(PG8_SA(1, 0), a3, voffA);
            PG8_WAIT_V(8); PG8_WAIT_L(0); PG8_BAR; PG8_MMA(1, 0, At, B0); PG8_MMA(1, 1, At, B1); PG8_BAR; PG8_SCHED;
            } else {
            PG8_LDB(B0, 0, 0); PG8_SCHED; PG8_LDA(At, 0, 0); PG8_STAGE(PG8_SA(1, 1), a1 + hstepA, voffA);
            PG8_WAIT_L(8); PG8_BAR; PG8_WAIT_L(0); PG8_MMA(0, 0, At, B0); PG8_BAR; PG8_SCHED;
            PG8_LDB(B1, 0, 1); PG8_STAGE(PG8_SB(0, 0), b2, voffB);
            PG8_BAR; PG8_WAIT_L(0); PG8_MMA(0, 1, At, B1); PG8_BAR;
            PG8_LDA(At, 0, 1); PG8_STAGE(PG8_SA(0, 0), a2, voffA);
            PG8_BAR; PG8_WAIT_L(0); PG8_MMA(1, 0, At, B0); PG8_BAR; PG8_SCHED;
            PG8_STAGE(PG8_SB(0, 1), b2 + hstepB, voffB);
            PG8_WAIT_V(6); PG8_BAR; PG8_MMA(1, 1, At, B1); PG8_BAR;
            PG8_LDB(B0, 1, 0); PG8_SCHED; PG8_LDA(At, 1, 0); PG8_STAGE(PG8_SA(0, 1), a2 + hstepA, voffA);
            PG8_WAIT_L(8); PG8_BAR; PG8_WAIT_L(0); PG8_MMA(0, 0, At, B0); PG8_BAR; PG8_SCHED;
            PG8_LDB(B1, 1, 1); PG8_STAGE(PG8_SB(1, 0), b3, voffB);
            PG8_BAR; PG8_WAIT_L(0); PG8_MMA(0, 1, At, B1); PG8_BAR;
            PG8_LDA(At, 1, 1); PG8_STAGE(PG8_SA(1, 0), a3, voffA);
            PG8_BAR; PG8_WAIT_L(0); PG8_MMA(1, 0, At, B0); PG8_BAR; PG8_SCHED;
            PG8_STAGE(PG8_SB(1, 1), b3 + hstepB, voffB);
            PG8_WAIT_V(6); PG8_BAR; PG8_MMA(1, 1, At, B1); PG8_BAR;
            }
        }
        if constexpr (ALIGN_EPI) { if (wr == 0) PG8_BAR; }
        if constexpr (!Epi::AFTER_DRAIN) { E(acc, cur, wr, wc, fr, fq); S.done(cur); }
        if (!has_next) break;
#pragma unroll
        for (int a = 0; a < 2; ++a)
#pragma unroll
            for (int b = 0; b < 2; ++b)
#pragma unroll
                for (int m = 0; m < 4; ++m)
#pragma unroll
                    for (int n = 0; n < 2; ++n) acc[a][b][m][n] = (f32x4){0.f, 0.f, 0.f, 0.f};
        cur = nxt; cA = nA; cB = nB; ++ui;
        if constexpr (ALIGN_EPI) { if (wr == 1) PG8_BAR; }
    }
    PG8_WAIT_V(0);
    if constexpr (!ALIGN_EPI) { if (wr == 0) PG8_BAR; }
    PG8_BAR;
    if constexpr (Epi::AFTER_DRAIN) { E.fused(acc, cur, wr, wc, fr, fq, lds, wid, lane); S.done(cur); }
#undef PG8_SA
#undef PG8_SB
#undef PG8_STAGE
#undef PG8_LDA
#undef PG8_LDB
#undef PG8_MMA
#undef PG8_WAIT_V
#undef PG8_WAIT_L
#undef PG8_BAR
#undef PG8_SCHED
}
}

#ifndef MK_EXP_OLD
#define MK_EXP_OLD 0
#endif
#ifndef MK_ONE_LAUNCH
#define MK_ONE_LAUNCH 1
#endif
#define LAS __attribute__((address_space(3)))
typedef unsigned short bf16;
typedef unsigned v4u __attribute__((ext_vector_type(4)));
typedef unsigned v2u __attribute__((ext_vector_type(2)));
typedef float f32x4 __attribute__((ext_vector_type(4)));
typedef float f32x2 __attribute__((ext_vector_type(2)));

constexpr int D = 1024, NB = 8, SEQ = 2048, LC = 256, ML = NB * SEQ  , MC = NB * LC  , MT = ML + MC  ;
constexpr int PROJ = 2576, NPROJ = 2560;
constexpr int NEXP = 16384, TOPK = 16, KK = 128;
constexpr float EPS = 1e-6f;
constexpr int NTHREADS = 512, NWAVES = 8;
constexpr int LDS_BYTES = 147456;
constexpr int NPHASES = 15;

constexpr size_t MiB = 1u << 20;
constexpr size_t WS_CTL = 0;
constexpr size_t CTL_ZERO_BYTES = 65536;
constexpr int CW_BAR = 0;
constexpr int CW_E1 = 4096, CW_E2 = 4096 + 8 * 64;
constexpr size_t WS_MOD = 1 * MiB;
constexpr size_t WS_LP = 1 * MiB + 512 * 1024;
constexpr size_t WS_WIN = 2 * MiB;
constexpr size_t WS_WOUT = 8 * MiB;
constexpr size_t WS_WGLU = 10 * MiB;
constexpr size_t WS_WQ = 11 * MiB;
constexpr size_t WS_GB = 15 * MiB;
constexpr size_t WS_BB = 17 * MiB;
constexpr size_t WS_PM = 41 * MiB;
constexpr size_t WS_OG = 17 * MiB;
constexpr size_t WS_HX2 = 17 * MiB;
constexpr size_t WS_U5 = 49 * MiB;
constexpr size_t WS_CAT = 49 * MiB;
constexpr size_t WS_IDX = 49 * MiB;
constexpr size_t WS_GATE = 57 * MiB;
constexpr size_t WS_ACT = 65 * MiB;
constexpr size_t WS_SSQP = 73 * MiB;
constexpr size_t WS_Z = 85 * MiB;
constexpr size_t WS_YRAW = 85 * MiB;
constexpr size_t WS_QP = 85 * MiB;
constexpr size_t WS_Y = 85 * MiB;
constexpr size_t WS_HX = 101 * MiB;
constexpr size_t WS_SS = 101 * MiB;
constexpr size_t WS_YG = 101 * MiB;
constexpr size_t WS_FRT = 125 * MiB;
constexpr size_t WS_QKVPRE = 137 * MiB;
constexpr size_t WS_FRA = 143 * MiB;
constexpr size_t WS_FRK = 161 * MiB;
constexpr size_t WS_FRTAB = 197 * MiB;
constexpr size_t WS_QKV = 202 * MiB;
constexpr size_t WS_U8 = 202 * MiB;
constexpr size_t WS_V8 = 218 * MiB;
constexpr size_t WS_USC = 234 * MiB;
constexpr size_t WS_VSC = 234 * MiB + 512 * 1024;
constexpr size_t WS_END = 256 * MiB;
static_assert(WS_BB + (size_t)32 * 512 * 768 * 2 <= WS_PM && WS_PM + (size_t)32 * 256 * 512 * 2 <= WS_U5 && WS_U5 + (size_t)32 * 768 * 768 * 2 <= WS_Z && WS_Z + (size_t)ML * 512 * 2 <= WS_HX, "ws map a");
static_assert(WS_HX + (size_t)MT * D * 2 <= WS_QKVPRE && WS_SS + (size_t)32 * 768 * 256 * 4 <= WS_FRT && WS_QKVPRE + (size_t)MT * 1536 * 2 <= WS_QKV && WS_QKV + (size_t)MT * 1536 * 2 <= WS_END, "ws map b");
static_assert(WS_FRT + (size_t)2304 * 8192 <= WS_FRA && WS_FRA + (size_t)2304 * 8192 <= WS_FRK && WS_FRK + (size_t)2304 * 16384 <= WS_FRTAB && WS_FRTAB + (size_t)2304 * 1024 <= WS_QKV, "ws map c");
static_assert(WS_OG + (size_t)2 * ML * 512 * 2 <= WS_CAT && WS_CAT + (size_t)ML * D * 2 <= WS_Z && WS_YRAW + (size_t)ML * D * 4 <= WS_U8 && WS_SSQP + (size_t)8 * ML * 4 <= WS_Z && WS_YG + (size_t)ML * 512 * 2 <= WS_FRT, "ws map d");

__device__ __forceinline__ unsigned f2bf(float f) { unsigned u = __builtin_bit_cast(unsigned, f); return (u + 0x7fffu + ((u >> 16) & 1u)) >> 16; }
__device__ __forceinline__ unsigned pk2(float lo, float hi) { return f2bf(lo) | (f2bf(hi) << 16); }
__device__ __forceinline__ float bflo(unsigned w) { return __builtin_bit_cast(float, w << 16); }
__device__ __forceinline__ float bfhi(unsigned w) { return __builtin_bit_cast(float, w & 0xffff0000u); }
__device__ __forceinline__ float bf1(bf16 h) { return __builtin_bit_cast(float, (unsigned)h << 16); }
__device__ __forceinline__ float wave_sum(float v) {
#pragma unroll
    for (int o = 1; o < 64; o <<= 1) v += __shfl_xor(v, o);
    return v;
}
__device__ __forceinline__ float wave_max(float v) {
#pragma unroll
    for (int o = 1; o < 64; o <<= 1) v = fmaxf(v, __shfl_xor(v, o));
    return v;
}
__device__ __forceinline__ float sigmoidf_(float x) { return 1.f / (1.f + __expf(-x)); }
__device__ __forceinline__ float siluf_(float x) { return x / (1.f + __expf(-x)); }
__device__ __forceinline__ float gelu_erf(float x) { return 0.5f * x * (1.f + erff(x * 0.70710678118654752f)); }
__device__ __forceinline__ void sincos_d(double a, float& s, float& c) {
    const double k = rint(a * 0.63661977236758134308);
    const double r = fma(-k, 1.57079632679489661923, a) - k * 6.123233995736766e-17;
    const double r2 = r * r;
    double sp = -2.5052108385441720e-08; sp = sp * r2 + 2.7557319223985893e-06; sp = sp * r2 - 1.9841269841269841e-04; sp = sp * r2 + 8.3333333333333332e-03; sp = sp * r2 - 1.6666666666666666e-01;
    const double sn = r + r * r2 * sp;
    double cp = 2.0876756987868099e-09; cp = cp * r2 - 2.7557319223985888e-07; cp = cp * r2 + 2.4801587301587302e-05; cp = cp * r2 - 1.3888888888888889e-03; cp = cp * r2 + 4.1666666666666664e-02; cp = cp * r2 - 0.5;
    const double cs = 1.0 + r2 * cp;
    const int q = ((int)k) & 3;
    const double ss = (q == 0) ? sn : (q == 1) ? cs : (q == 2) ? -sn : -cs;
    const double cc = (q == 0) ? cs : (q == 1) ? -sn : (q == 2) ? -cs : sn;
    s = (float)ss; c = (float)cc;
}

struct Args { const float* in[29]; float* out; unsigned char* ws; int ph_lo, ph_hi; };
static_assert(sizeof(Args) == 29 * 8 + 8 + 8 + 8, "Args has no padding");
enum { I_X = 0, I_C, I_CTX, I_CCTX, I_WMOD, I_BMOD, I_GPREMIX, I_GPOSTMIX, I_GPREFFN, I_GPOSTFFN, I_WIN, I_WOUT, I_LAMRE, I_LAMIM, I_LOGDT, I_BRE, I_BIM, I_CRE, I_CIM, I_S5D, I_WGLU,
       I_CONV, I_ALOG, I_DTBIAS, I_GDNNORM, I_WQ, I_KEYS, I_PU, I_PV };

__device__ __forceinline__ const float* in_row(const Args& a, int row) { return row < ML ? a.in[I_X] + (size_t)row * D : a.in[I_CTX] + (size_t)(row - ML) * D; }
__device__ __forceinline__ int mod_row(int row) { return row < ML ? (row >> 11) : 8; }

template <int CTRL> __device__ __forceinline__ float dppf(float v) { return __builtin_bit_cast(float, __builtin_amdgcn_update_dpp(0, __builtin_bit_cast(int, v), CTRL, 0xf, 0xf, true)); }
__device__ __forceinline__ float row_sum16(float v) { v += dppf<0xB1>(v); v += dppf<0x4E>(v); v += dppf<0x141>(v); v += dppf<0x140>(v); return v; }
__device__ __forceinline__ float row_max16(float v) { v = fmaxf(v, dppf<0xB1>(v)); v = fmaxf(v, dppf<0x4E>(v)); v = fmaxf(v, dppf<0x141>(v)); v = fmaxf(v, dppf<0x140>(v)); return v; }
__device__ __forceinline__ float wsum(float v) { v = row_sum16(v); return
    __builtin_bit_cast(float, __builtin_amdgcn_readlane(__builtin_bit_cast(int, v), 0)) + __builtin_bit_cast(float, __builtin_amdgcn_readlane(__builtin_bit_cast(int, v), 16)) +
    __builtin_bit_cast(float, __builtin_amdgcn_readlane(__builtin_bit_cast(int, v), 32)) + __builtin_bit_cast(float, __builtin_amdgcn_readlane(__builtin_bit_cast(int, v), 48)); }
__device__ __forceinline__ float wmax(float v) { v = row_max16(v); return fmaxf(fmaxf(__builtin_bit_cast(float, __builtin_amdgcn_readlane(__builtin_bit_cast(int, v), 0)), __builtin_bit_cast(float, __builtin_amdgcn_readlane(__builtin_bit_cast(int, v), 16))),
    fmaxf(__builtin_bit_cast(float, __builtin_amdgcn_readlane(__builtin_bit_cast(int, v), 32)), __builtin_bit_cast(float, __builtin_amdgcn_readlane(__builtin_bit_cast(int, v), 48)))); }
__device__ __forceinline__ int lane_rank(unsigned long long m) { return __builtin_amdgcn_mbcnt_hi((unsigned)(m >> 32), __builtin_amdgcn_mbcnt_lo((unsigned)m, 0)); }
__device__ __forceinline__ unsigned fkey(float f) { const unsigned u = __builtin_bit_cast(unsigned, f); return u ^ ((unsigned)((int)u >> 31) | 0x80000000u); }
#define WAVE_LDS_SYNC() do { __builtin_amdgcn_fence(__ATOMIC_RELEASE, "wavefront"); __builtin_amdgcn_wave_barrier(); __builtin_amdgcn_fence(__ATOMIC_ACQUIRE, "wavefront"); } while (0)
template <int N> __device__ __forceinline__ unsigned kth_key(const unsigned (&k)[N], int K) {
    unsigned T = 0;
    for (int bit = 31; bit >= 0; --bit) { const unsigned cand = T | (1u << bit); int cnt = 0;
#pragma unroll
        for (int n = 0; n < N; ++n) cnt += __popcll(__ballot(k[n] >= cand));
        if (cnt >= K) T = cand;
        if (cnt == K) break; }
    return T;
}

namespace pg8 {
struct EpiInProj {
    static constexpr bool PERM = true, AFTER_DRAIN = false;
    bf16_t* U; bf16_t* QKV; bf16_t* Z;
    __device__ __forceinline__ void operator()(const f32x4 (&acc)[2][2][4][2], const Unit& u, int wr, int wc, int fr, int fq) const {
        bf16_t* base; int ld, colt; bool lat_only = false;
        const bool s5 = u.pn < 2;
        if (s5) { base = U; ld = 0; colt = u.pn * BM; }
        else if (u.pn < 8) { base = QKV; ld = 1536; colt = (u.pn - 2) * BM; }
        else { base = Z; ld = 512; colt = (u.pn - 8) * BM; lat_only = true; }
        const int row0 = u.pm * BM + wr * 64 + fr, col0 = colt + wc * 32 + 8 * fq;
#pragma unroll
        for (int ai = 0; ai < 2; ++ai)
#pragma unroll
            for (int m = 0; m < 4; ++m) { const int row = row0 + ai * HALF + m * 16; bf16_t* rowp = base + (size_t)row * ld + col0;
                if (lat_only && row >= 16384) continue;
                if (s5) { const int R = row < 16384 ? (row >> 5) : 512 + ((row - 16384) >> 5), ii = row & 31; rowp = base + (size_t)R * 768 + ii * 16 + (col0 & 15); }
#pragma unroll
                for (int bj = 0; bj < 2; ++bj) { const f32x4 v0 = acc[ai][bj][m][0], v1 = acc[ai][bj][m][1];
                    u32x4 w; w.x = cvt_pk_bf16(v0[0], v0[1]); w.y = cvt_pk_bf16(v0[2], v0[3]); w.z = cvt_pk_bf16(v1[0], v1[1]); w.w = cvt_pk_bf16(v1[2], v1[3]);
                    if (s5) *(u32x4*)(rowp + (size_t)((col0 + bj * HALF) >> 4) * (768 * 768)) = w; else *(u32x4*)(rowp + bj * HALF) = w; } }
    }
};
struct EpiGlu {
    static constexpr bool PERM = true, AFTER_DRAIN = false;
    const bf16_t* YG; bf16_t* CAT;
    __device__ __forceinline__ void operator()(const f32x4 (&acc)[2][2][4][2], const Unit& u, int wr, int wc, int fr, int fq) const {
        const int row0 = u.pm * BM + wr * 64 + fr, col0 = u.pn * BM + wc * 32 + 8 * fq;
#pragma unroll
        for (int ai = 0; ai < 2; ++ai)
#pragma unroll
            for (int m = 0; m < 4; ++m) { const int row = row0 + ai * HALF + m * 16;
#pragma unroll
                for (int bj = 0; bj < 2; ++bj) { const f32x4 v0 = acc[ai][bj][m][0], v1 = acc[ai][bj][m][1];
                    const u32x4 y = *(const u32x4*)(YG + (size_t)row * 512 + col0 + bj * HALF);
                    float o[8]; const float a[8] = {v0[0], v0[1], v0[2], v0[3], v1[0], v1[1], v1[2], v1[3]};
                    const unsigned yw[4] = {y.x, y.y, y.z, y.w};
#pragma unroll
                    for (int e = 0; e < 8; ++e) { const float yv = __builtin_bit_cast(float, (e & 1) ? (yw[e >> 1] & 0xffff0000u) : (yw[e >> 1] << 16)); o[e] = yv / (1.f + __expf(-a[e])); }
                    u32x4 w; w.x = cvt_pk_bf16(o[0], o[1]); w.y = cvt_pk_bf16(o[2], o[3]); w.z = cvt_pk_bf16(o[4], o[5]); w.w = cvt_pk_bf16(o[6], o[7]);
                    *(u32x4*)(CAT + (size_t)row * 1024 + col0 + bj * HALF) = w; } }
    }
};
struct EpiF32 {
    static constexpr bool PERM = false, AFTER_DRAIN = false;
    float* C; int ldc;
    __device__ __forceinline__ void operator()(const f32x4 (&acc)[2][2][4][2], const Unit& u, int wr, int wc, int fr, int fq) const {
        const int row0 = u.pm * BM + wr * 64 + fr, col0 = u.pn * BM + wc * 32 + 4 * fq;
#pragma unroll
        for (int ai = 0; ai < 2; ++ai)
#pragma unroll
            for (int m = 0; m < 4; ++m) { float* rowp = C + (size_t)(row0 + ai * HALF + m * 16) * ldc + col0;
#pragma unroll
                for (int bj = 0; bj < 2; ++bj)
#pragma unroll
                    for (int n = 0; n < 2; ++n) *(f32x4*)(rowp + bj * HALF + n * 16) = acc[ai][bj][m][n]; }
    }
};
struct EpiSS {
    static constexpr bool PERM = false, AFTER_DRAIN = false;
    float* C;
    __device__ __forceinline__ void operator()(const f32x4 (&acc)[2][2][4][2], const Unit& u, int wr, int wc, int fr, int fq) const {
        const int row0 = u.pm * BM + wr * 64 + fr, col0 = wc * 32 + 4 * fq;
#pragma unroll
        for (int ai = 0; ai < 2; ++ai)
#pragma unroll
            for (int m = 0; m < 4; ++m) { float* rowp = C + (size_t)(row0 + ai * HALF + m * 16) * 256 + col0;
#pragma unroll
                for (int bj = 0; bj < 2; ++bj)
#pragma unroll
                    for (int n = 0; n < 2; ++n) *(f32x4*)(rowp + bj * HALF + n * 16) = acc[ai][bj][m][n]; }
    }
};
struct SchedSS { int G, c; __device__ bool next(int i, Unit& u) const { const int L = i * G + c; if (L >= 96) return false; u.pm = L; u.pn = L / 3; return true; }
    __device__ __forceinline__ void a_ready(const Unit&) const {} __device__ __forceinline__ void done(const Unit&) const {} };
struct EpiS5Y {
    static constexpr bool PERM = true, AFTER_DRAIN = false;
    bf16_t* YG;
    __device__ __forceinline__ void operator()(const f32x4 (&acc)[2][2][4][2], const Unit& u, int wr, int wc, int fr, int fq) const {
        const int g = u.pn >> 1, R0 = (u.pm - 3 * g) * BM + wr * 64 + fr, n0 = (u.pn & 1) * BM + wc * 32 + 8 * fq;
#pragma unroll
        for (int ai = 0; ai < 2; ++ai)
#pragma unroll
            for (int m = 0; m < 4; ++m) { const int R = R0 + ai * HALF + m * 16;
#pragma unroll
                for (int bj = 0; bj < 2; ++bj) { const int n = n0 + bj * HALF; const f32x4 v0 = acc[ai][bj][m][0], v1 = acc[ai][bj][m][1];
                    const f32x2 a = gelu_pk((f32x2){v0[0], v0[1]}), b = gelu_pk((f32x2){v0[2], v0[3]}), c2 = gelu_pk((f32x2){v1[0], v1[1]}), d = gelu_pk((f32x2){v1[2], v1[3]});
                    u32x4 w; w.x = cvt_pk_bf16(a.x, a.y); w.y = cvt_pk_bf16(b.x, b.y); w.z = cvt_pk_bf16(c2.x, c2.y); w.w = cvt_pk_bf16(d.x, d.y);
                    *(u32x4*)(YG + (size_t)(R * 32 + (n >> 4)) * 512 + g * 16 + (n & 15)) = w; } }
    }
};
struct SchedS5Y { int G, c; __device__ bool next(int i, Unit& u) const { const int L = i * G + c; if (L >= 128) return false; const int g = L >> 2; u.pm = 3 * g + ((L >> 1) & 1); u.pn = 2 * g + (L & 1); return true; }
    __device__ __forceinline__ void a_ready(const Unit&) const {} __device__ __forceinline__ void done(const Unit&) const {} };
}

struct Ctx { const Args* a; unsigned char* ws; unsigned char* lds; int tid, lane, wave, bid, G, gw, NGW, gwv; };

__device__ __forceinline__ void p0_transpose_item(const float* W, int ldw, int nblk, int K, bf16* WT, float* scr, int item, int lane) {
    const int kb = item / nblk, nb = item % nblk, k0 = 64 * kb, n0 = 32 * nb;
#pragma unroll 8
    for (int i = 0; i < 32; ++i) { const int kk = 2 * i + (lane >> 5); scr[kk * 33 + (lane & 31)] = W[(size_t)(k0 + kk) * ldw + n0 + (lane & 31)]; }
    __builtin_amdgcn_fence(__ATOMIC_RELEASE, "wavefront"); __builtin_amdgcn_wave_barrier(); __builtin_amdgcn_fence(__ATOMIC_ACQUIRE, "wavefront");
    const int c = lane & 7;
#pragma unroll
    for (int j = 0; j < 4; ++j) { const int n = (lane >> 3) + 8 * j; const float* s = scr + (8 * c) * 33 + n;
        v4u o; o.x = pk2(s[0 * 33], s[1 * 33]); o.y = pk2(s[2 * 33], s[3 * 33]); o.z = pk2(s[4 * 33], s[5 * 33]); o.w = pk2(s[6 * 33], s[7 * 33]);
        *(v4u*)(WT + (size_t)(n0 + n) * K + k0 + 8 * c) = o; }
    __builtin_amdgcn_fence(__ATOMIC_RELEASE, "wavefront"); __builtin_amdgcn_wave_barrier(); __builtin_amdgcn_fence(__ATOMIC_ACQUIRE, "wavefront");
}
__device__ __forceinline__ void phase_prep(const Ctx& c) {
    const Args& a = *c.a;
    float* scr = (float*)(c.lds + c.wave * 16384);
    constexpr int I_IN = 16 * 80, I_OUT = 16 * 32, I_GLU = 8 * 16, I_Q = 16 * 64;
    for (int it = c.gw; it < I_IN + I_OUT + I_GLU + I_Q; it += c.NGW) {
        int r = it;
        if (r < I_IN) { p0_transpose_item(a.in[I_WIN], PROJ, 80, 1024, (bf16*)(c.ws + WS_WIN), scr, r, c.lane); continue; } r -= I_IN;
        if (r < I_OUT) { p0_transpose_item(a.in[I_WOUT], 1024, 32, 1024, (bf16*)(c.ws + WS_WOUT), scr, r, c.lane); continue; } r -= I_OUT;
        if (r < I_GLU) { p0_transpose_item(a.in[I_WGLU], 512, 16, 512, (bf16*)(c.ws + WS_WGLU), scr, r, c.lane); continue; } r -= I_GLU;
        p0_transpose_item(a.in[I_WQ], 2048, 64, 1024, (bf16*)(c.ws + WS_WQ), scr, r, c.lane);
    }
    __syncthreads();
    float* sc = (float*)c.lds;
    float* red = (float*)(c.lds + 9 * 1024 * 4);
    float* MOD = (float*)(c.ws + WS_MOD);
    bool have = false;
    for (int item = c.bid; item < 96; item += c.G) {
        if (!have) { for (int i = c.tid; i < 9 * 1024; i += NTHREADS) { const int r = i >> 10, k = i & 1023; const float v = r < 8 ? a.in[I_C][r * 1024 + k] : a.in[I_CCTX][k]; sc[i] = siluf_(v); } have = true; __syncthreads(); }
        const int n0 = item * 64;
        float acc[9];
#pragma unroll
        for (int r = 0; r < 9; ++r) acc[r] = 0.f;
        const float* wp = a.in[I_WMOD] + (size_t)(c.wave * 128) * 6144 + n0 + c.lane;
#pragma unroll 4
        for (int k = 0; k < 128; ++k) { const float w = wp[(size_t)k * 6144];
#pragma unroll
            for (int r = 0; r < 9; ++r) acc[r] = fmaf(sc[r * 1024 + c.wave * 128 + k], w, acc[r]); }
#pragma unroll
        for (int r = 0; r < 9; ++r) red[(c.wave * 9 + r) * 64 + c.lane] = acc[r];
        __syncthreads();
        for (int i = c.tid; i < 576; i += NTHREADS) { const int r = i >> 6, l = i & 63; float s = a.in[I_BMOD][n0 + l];
#pragma unroll
            for (int w = 0; w < 8; ++w) s += red[(w * 9 + r) * 64 + l];
            MOD[r * 6144 + n0 + l] = s; }
        __syncthreads();
    }
}
__device__ __forceinline__ void s5_build_group(const Ctx& c, int g);
__device__ __forceinline__ void phase_s5_build(const Ctx& c) { for (int g = c.G - 1 - c.bid; g < 32; g += c.G) if (g >= 0) s5_build_group(c, g); }

__device__ __forceinline__ void phase_norm1(const Ctx& c) {
    const Args& a = *c.a;
    float* wabT = (float*)c.lds;
    for (int i = c.tid; i < 1024 * 16; i += NTHREADS) { const int k = i >> 4, j = i & 15; wabT[j * 1028 + k] = a.in[I_WIN][(size_t)k * PROJ + NPROJ + j]; }
    __syncthreads();
    const float* MOD = (const float*)(c.ws + WS_MOD);
    bf16* HX = (bf16*)(c.ws + WS_HX); float* GB = (float*)(c.ws + WS_GB);
    const float* gpre = a.in[I_GPREMIX];
    for (int row = c.gw; row < MT; row += c.NGW) {
        const f32x4* xr = (const f32x4*)in_row(a, row) + c.lane;
        const float* mr = MOD + mod_row(row) * 6144;
        f32x4 v[4]; float ss = 0.f;
#pragma unroll
        for (int j = 0; j < 4; ++j) { v[j] = xr[64 * j]; ss += (v[j].x * v[j].x + v[j].y * v[j].y) + (v[j].z * v[j].z + v[j].w * v[j].w); }
        const float r = rsqrtf(wave_sum(ss) * (1.f / D) + EPS);
#pragma unroll
        for (int j = 0; j < 4; ++j) { const int col = 4 * c.lane + 256 * j;
            const f32x4 g4 = *(const f32x4*)(gpre + col), sh = *(const f32x4*)(mr + col), scl = *(const f32x4*)(mr + 1024 + col);
            v[j] = (v[j] * r) * g4 * (scl + 1.f) + sh;
            v2u o; o.x = pk2(v[j].x, v[j].y); o.y = pk2(v[j].z, v[j].w);
            *(v2u*)(HX + (size_t)row * D + col) = o; }
        float mine = 0.f;
#pragma unroll 1
        for (int j = 0; j < 16; ++j) { float s = 0.f;
#pragma unroll
            for (int jj = 0; jj < 4; ++jj) { const f32x4 w = *(const f32x4*)(wabT + j * 1028 + 4 * c.lane + 256 * jj); s += (v[jj].x * w.x + v[jj].y * w.y) + (v[jj].z * w.z + v[jj].w * w.w); }
            s = wave_sum(s); mine = (c.lane == j) ? s : mine; }
        if (c.lane < 8) { const float t = mine + a.in[I_DTBIAS][c.lane]; const float sp = t > 20.f ? t : log1pf(expf(t)); GB[(size_t)row * 16 + c.lane] = -expf(a.in[I_ALOG][c.lane]) * sp; }
        else if (c.lane < 16) GB[(size_t)row * 16 + c.lane] = 1.f / (1.f + expf(-mine));
    }
}

__device__ __forceinline__ void phase_conv(const Ctx& c) {
    const Args& a = *c.a;
    const bf16* PRE = (const bf16*)(c.ws + WS_QKVPRE); bf16* OUT = (bf16*)(c.ws + WS_QKV);
    const float* cw = a.in[I_CONV];
    for (int row = c.gw; row < MT; row += c.NGW) {
        int nb_row[9]; bool ok[9];
        if (row < ML) { const int t = row & 2047, gr = t >> 6, gc = t & 63;
#pragma unroll
            for (int dy = -1; dy <= 1; ++dy)
#pragma unroll
                for (int dx = -1; dx <= 1; ++dx) { const int i = (dy + 1) * 3 + dx + 1; ok[i] = (gr + dy >= 0) && (gr + dy < 32) && (gc + dx >= 0) && (gc + dx < 64); nb_row[i] = row + dy * 64 + dx; } }
        else { const int t = (row - ML) & 255;
#pragma unroll
            for (int i = 0; i < 9; ++i) { ok[i] = false; nb_row[i] = row; }
#pragma unroll
            for (int dx = -1; dx <= 1; ++dx) { ok[4 + dx] = (t + dx >= 0) && (t + dx < 256); nb_row[4 + dx] = row + dx; } }
#pragma unroll 2
        for (int seg = 0; seg < 12; ++seg) { const int ch = seg * 128 + 2 * c.lane; float o0 = 0.f, o1 = 0.f;
#pragma unroll
            for (int i = 0; i < 9; ++i) if (ok[i]) { const unsigned w = *(const unsigned*)(PRE + (size_t)nb_row[i] * 1536 + ch); const f32x2 k2 = *(const f32x2*)(cw + i * 1536 + ch);
                o0 = fmaf(bflo(w), k2.x, o0); o1 = fmaf(bfhi(w), k2.y, o1); }
            o0 = siluf_(o0); o1 = siluf_(o1);
            if (seg < 8) { const float ssq = wave_sum(o0 * o0 + o1 * o1); const float sc = rsqrtf(ssq + EPS) * (seg < 4 ? 0.08838834764831845f : 1.f); o0 *= sc; o1 *= sc; }
            *(unsigned*)(OUT + (size_t)row * 1536 + ch) = pk2(o0, o1); }
    }
}

__device__ __forceinline__ int scan_row(int b, int dir, int step) {
    if (step < LC) { const int t = dir ? LC - 1 - step : step; return ML + b * LC + t; }
    const int t = step - LC; return b * SEQ + (dir ? SEQ - 1 - t : t);
}
__device__ __forceinline__ void phase_combine(const Ctx& c) {
    const Args& a = *c.a;
    const bf16* OG0 = (const bf16*)(c.ws + WS_OG); const bf16* OG1 = OG0 + (size_t)ML * 512; const bf16* Z = (const bf16*)(c.ws + WS_Z);
    bf16* CAT = (bf16*)(c.ws + WS_CAT);
    for (int row = c.gw; row < ML; row += c.NGW) {
#pragma unroll
        for (int h = 0; h < 4; ++h) { const int ch = h * 128 + 2 * c.lane;
            const unsigned w0 = *(const unsigned*)(OG0 + (size_t)row * 512 + ch), w1 = *(const unsigned*)(OG1 + (size_t)row * 512 + ch), zw = *(const unsigned*)(Z + (size_t)row * 512 + ch);
            const float o0 = bflo(w0) + bflo(w1), o1 = bfhi(w0) + bfhi(w1);
            const float r = rsqrtf(wave_sum(o0 * o0 + o1 * o1) * (1.f / 128.f) + EPS);
            const f32x2 ng = *(const f32x2*)(a.in[I_GDNNORM] + 2 * c.lane);
            *(unsigned*)(CAT + (size_t)row * 1024 + 512 + ch) = pk2(o0 * r * ng.x * siluf_(bflo(zw)), o1 * r * ng.y * siluf_(bfhi(zw))); }
    }
}

__device__ __forceinline__ void phase_rows2(const Ctx& c) {
    const Args& a = *c.a;
    const float* MOD = (const float*)(c.ws + WS_MOD); const float* YRAW = (const float*)(c.ws + WS_YRAW); bf16* HX2 = (bf16*)(c.ws + WS_HX2);
    for (int row = c.gw; row < ML; row += c.NGW) {
        const float* mr = MOD + (row >> 11) * 6144;
        f32x4 y[4], x[4]; float ss = 0.f;
#pragma unroll
        for (int j = 0; j < 4; ++j) { y[j] = *((const f32x4*)(YRAW + (size_t)row * D) + c.lane + 64 * j); x[j] = *((const f32x4*)(a.in[I_X] + (size_t)row * D) + c.lane + 64 * j);
            ss += (y[j].x * y[j].x + y[j].y * y[j].y) + (y[j].z * y[j].z + y[j].w * y[j].w); }
        const float r = rsqrtf(wave_sum(ss) * (1.f / D) + EPS); float s2 = 0.f;
#pragma unroll
        for (int j = 0; j < 4; ++j) { const int col = 4 * c.lane + 256 * j;
            const f32x4 g4 = *(const f32x4*)(a.in[I_GPOSTMIX] + col), gt = *(const f32x4*)(mr + 2048 + col);
            x[j] = x[j] + gt * ((y[j] * r) * g4);
            *(f32x4*)(a.out + (size_t)row * D + col) = x[j];
            s2 += (x[j].x * x[j].x + x[j].y * x[j].y) + (x[j].z * x[j].z + x[j].w * x[j].w); }
        const float r2 = rsqrtf(wave_sum(s2) * (1.f / D) + EPS);
#pragma unroll
        for (int j = 0; j < 4; ++j) { const int col = 4 * c.lane + 256 * j;
            const f32x4 g4 = *(const f32x4*)(a.in[I_GPREFFN] + col), sh = *(const f32x4*)(mr + 3072 + col), scl = *(const f32x4*)(mr + 4096 + col);
            const f32x4 hv = (x[j] * r2) * g4 * (scl + 1.f) + sh;
            v2u o; o.x = pk2(hv.x, hv.y); o.y = pk2(hv.z, hv.w);
            *(v2u*)(HX2 + (size_t)row * D + col) = o; }
    }
}


constexpr int KROW = 136;
__device__ __forceinline__ void phase_topk(const Ctx& c) {
    const Args& a = *c.a;
    bf16* kl = (bf16*)c.lds;
    unsigned char* wbase = c.lds + 2 * 128 * KROW * 2 + c.wave * 1024;
    bf16* qs = (bf16*)wbase;
    float* s1 = (float*)(wbase + 512); int* i1 = (int*)(wbase + 576); float* s2 = (float*)(wbase + 640); int* i2 = (int*)(wbase + 704); float* fs = (float*)(wbase + 768); int* fi = (int*)(wbase + 832);
    const bf16* QP = (const bf16*)(c.ws + WS_QP); int* IDX = (int*)(c.ws + WS_IDX); float* GATE = (float*)(c.ws + WS_GATE);
    for (int item = c.bid; item < 8 * 32; item += c.G) {
        const int h = item & 7, tr = item >> 3;
        __syncthreads();
        for (int i = c.tid; i < 2 * 128 * 64; i += NTHREADS) { const int k2 = i & 63, n = (i >> 6) & 127, p = i >> 13; const f32x2 kv = *(const f32x2*)(a.in[I_KEYS] + ((size_t)((h * 2 + p) * 128 + n)) * 128 + 2 * k2);
            *(unsigned*)(kl + (p * 128 + n) * KROW + 2 * k2) = pk2(kv.x, kv.y); }
        __syncthreads();
        for (int tt = c.wave; tt < 512; tt += NWAVES) {
            const int tok = tr * 512 + tt;
            *(v2u*)(qs + 4 * c.lane) = *(const v2u*)(QP + (size_t)tok * 2048 + h * 256 + 4 * c.lane);
            WAVE_LDS_SYNC();
            float sc[2][2];
#pragma unroll
            for (int p = 0; p < 2; ++p) { float sa0 = 0.f, sa1 = 0.f, sb0 = 0.f, sb1 = 0.f;
#pragma unroll 4
                for (int kk = 0; kk < 16; ++kk) { const v4u q8 = *(const v4u*)(qs + p * 128 + kk * 8), ka = *(const v4u*)(kl + (p * 128 + c.lane) * KROW + kk * 8), kb = *(const v4u*)(kl + (p * 128 + c.lane + 64) * KROW + kk * 8);
                    const unsigned qw[4] = {q8.x, q8.y, q8.z, q8.w}, aw[4] = {ka.x, ka.y, ka.z, ka.w}, bw[4] = {kb.x, kb.y, kb.z, kb.w};
#pragma unroll
                    for (int e = 0; e < 4; ++e) { sa0 = fmaf(bflo(qw[e]), bflo(aw[e]), sa0); sa1 = fmaf(bfhi(qw[e]), bfhi(aw[e]), sa1); sb0 = fmaf(bflo(qw[e]), bflo(bw[e]), sb0); sb1 = fmaf(bfhi(qw[e]), bfhi(bw[e]), sb1); } }
                sc[p][0] = sa0 + sa1; sc[p][1] = sb0 + sb1; }
#pragma unroll
            for (int p = 0; p < 2; ++p) { float* so = p ? s2 : s1; int* io = p ? i2 : i1;
                const unsigned ky[2] = {fkey(sc[p][0]), fkey(sc[p][1])};
                const unsigned T = kth_key<2>(ky, 16);
                int cgt = 0;
#pragma unroll
                for (int n = 0; n < 2; ++n) cgt += __popcll(__ballot(ky[n] > T));
                const int need = 16 - cgt; int base = 0, eqb = 0;
#pragma unroll
                for (int n = 0; n < 2; ++n) { const bool eq = ky[n] == T; const unsigned long long em = __ballot(eq); const bool sel = (ky[n] > T) || (eq && (eqb + lane_rank(em)) < need);
                    const unsigned long long sm = __ballot(sel); if (sel) { const int pos = base + lane_rank(sm); so[pos] = sc[p][n]; io[pos] = c.lane + 64 * n; }
                    base += __popcll(sm); eqb += __popcll(em); } }
            WAVE_LDS_SYNC();
            { const int ci = c.lane >> 2, cj = 4 * (c.lane & 3);
              float cv[4]; unsigned ky[4]; const float b1 = s1[ci];
#pragma unroll
              for (int e = 0; e < 4; ++e) { cv[e] = b1 + s2[cj + e]; ky[e] = fkey(cv[e]); }
              const unsigned T = kth_key<4>(ky, 16);
              int cgt = 0;
#pragma unroll
              for (int e = 0; e < 4; ++e) cgt += __popcll(__ballot(ky[e] > T));
              const int need = 16 - cgt; int base = 0, eqb = 0; const int e1 = i1[ci] * 128;
#pragma unroll
              for (int e = 0; e < 4; ++e) { const bool eq = ky[e] == T; const unsigned long long em = __ballot(eq); const bool sel = (ky[e] > T) || (eq && (eqb + lane_rank(em)) < need);
                  const unsigned long long sm = __ballot(sel); if (sel) { const int pos = base + lane_rank(sm); fs[pos] = cv[e]; fi[pos] = e1 + i2[cj + e]; }
                  base += __popcll(sm); eqb += __popcll(em); } }
            WAVE_LDS_SYNC();
            { const float v = fs[c.lane & 15]; const float mx = row_max16(v); const float ex = __expf(v - mx); const float den = row_sum16(ex);
              if (c.lane < 16) { IDX[(size_t)tok * 128 + h * 16 + c.lane] = fi[c.lane]; GATE[(size_t)tok * 128 + h * 16 + c.lane] = ex / den; } }
            WAVE_LDS_SYNC();
        }
    }
}

__device__ __forceinline__ void phase_fp8_tables(const Ctx& c) {
    const Args& a = *c.a;
    for (int r = c.gw; r < 2 * NEXP; r += c.NGW) {
        const bool isv = r >= NEXP; const int e = isv ? r - NEXP : r;
        const f32x4* src = (const f32x4*)((isv ? a.in[I_PV] : a.in[I_PU]) + (size_t)e * D) + 4 * c.lane;
        f32x4 v[4]; float m = 0.f;
#pragma unroll
        for (int j = 0; j < 4; ++j) { v[j] = src[j]; m = fmaxf(m, fmaxf(fmaxf(fabsf(v[j].x), fabsf(v[j].y)), fmaxf(fabsf(v[j].z), fabsf(v[j].w)))); }
        m = wmax(m); const float inv = m > 0.f ? 256.f / m : 0.f;
        v4u o; unsigned ow[4];
#pragma unroll
        for (int j = 0; j < 4; ++j) { int w = __builtin_amdgcn_cvt_pk_fp8_f32(v[j].x * inv, v[j].y * inv, 0, false); w = __builtin_amdgcn_cvt_pk_fp8_f32(v[j].z * inv, v[j].w * inv, w, true); ow[j] = (unsigned)w; }
        o.x = ow[0]; o.y = ow[1]; o.z = ow[2]; o.w = ow[3];
        *(v4u*)(c.ws + (isv ? WS_V8 : WS_U8) + (size_t)e * D + 16 * c.lane) = o;
        if (c.lane == 0) ((float*)(c.ws + (isv ? WS_VSC : WS_USC)))[e] = m * (1.f / 256.f);
    }
}
__device__ __forceinline__ void fp8x16_to_f32(const v4u& r, float (&f)[16]) {
    const unsigned w[4] = {r.x, r.y, r.z, r.w};
#pragma unroll
    for (int j = 0; j < 4; ++j) { const f32x2 lo = __builtin_amdgcn_cvt_pk_f32_fp8((int)w[j], false), hi = __builtin_amdgcn_cvt_pk_f32_fp8((int)w[j], true); f[4 * j] = lo.x; f[4 * j + 1] = lo.y; f[4 * j + 2] = hi.x; f[4 * j + 3] = hi.y; }
}
__device__ __forceinline__ unsigned xcc_id() { return (unsigned)__builtin_amdgcn_s_getreg((3 << 11) | 20) & 7u; }

__device__ __forceinline__ void phase_exp1(const Ctx& c) {
    const bf16* HX2 = (const bf16*)(c.ws + WS_HX2); const int* IDX = (const int*)(c.ws + WS_IDX); const float* GATE = (const float*)(c.ws + WS_GATE);
    const unsigned char* U8 = c.ws + WS_U8; const float* USC = (const float*)(c.ws + WS_USC); const float* VSC = (const float*)(c.ws + WS_VSC); float* ACT = (float*)(c.ws + WS_ACT);
    unsigned* cnt = (unsigned*)(c.ws + WS_CTL) + CW_E1;
    int* lk = (int*)(c.lds + c.wave * 1024); int* le = lk + 128;
    const int xcc = (int)xcc_id();
    constexpr int CH = 8;
    for (int bo = 0; bo < 8; ++bo) { const int x = (xcc + bo) & 7;
        for (;;) { unsigned t0 = 0; if (c.lane == 0) t0 = __hip_atomic_fetch_add(cnt + 64 * x, (unsigned)CH, __ATOMIC_RELAXED, __HIP_MEMORY_SCOPE_AGENT);
            t0 = (unsigned)__builtin_amdgcn_readfirstlane((int)t0); if (t0 >= (unsigned)ML) break;
            for (int t = (int)t0; t < (int)t0 + CH; ++t) {
                float hv[16];
                { const v4u h0 = *(const v4u*)(HX2 + (size_t)t * D + 16 * c.lane), h1 = *(const v4u*)(HX2 + (size_t)t * D + 16 * c.lane + 8); const unsigned hw[8] = {h0.x, h0.y, h0.z, h0.w, h1.x, h1.y, h1.z, h1.w};
#pragma unroll
                  for (int j = 0; j < 8; ++j) { hv[2 * j] = bflo(hw[j]); hv[2 * j + 1] = bfhi(hw[j]); } }
                const int eA = IDX[(size_t)t * 128 + c.lane], eB = IDX[(size_t)t * 128 + 64 + c.lane];
                const bool sA = (eA >> 11) == x, sB = (eB >> 11) == x; const unsigned long long mA = __ballot(sA), mB = __ballot(sB); const int nA = __popcll(mA), n = nA + __popcll(mB);
                if (sA) { const int pos = lane_rank(mA); lk[pos] = c.lane; le[pos] = eA; }
                if (sB) { const int pos = nA + lane_rank(mB); lk[pos] = c.lane + 64; le[pos] = eB; }
                WAVE_LDS_SYNC();
                for (int j0 = 0; j0 < n; j0 += 16) {
                    float p[16];
#pragma unroll
                    for (int jj = 0; jj < 16; ++jj) { const int j = j0 + jj; const int e = le[j < n ? j : 0];
                        const v4u row = *(const v4u*)(U8 + (size_t)e * D + 16 * c.lane); float f[16]; fp8x16_to_f32(row, f); float s0 = 0.f, s1 = 0.f;
#pragma unroll
                        for (int q = 0; q < 8; ++q) { s0 = fmaf(f[2 * q], hv[2 * q], s0); s1 = fmaf(f[2 * q + 1], hv[2 * q + 1], s1); }
                        p[jj] = s0 + s1; }
                    const bool b5 = c.lane & 32, b4 = c.lane & 16, b3 = c.lane & 8, b2 = c.lane & 4;
                    float q8[8], q4[4], q2[2];
#pragma unroll
                    for (int i = 0; i < 8; ++i) { const float keep = b5 ? p[i + 8] : p[i], send = b5 ? p[i] : p[i + 8]; q8[i] = keep + __shfl_xor(send, 32); }
#pragma unroll
                    for (int i = 0; i < 4; ++i) { const float keep = b4 ? q8[i + 4] : q8[i], send = b4 ? q8[i] : q8[i + 4]; q4[i] = keep + __shfl_xor(send, 16); }
#pragma unroll
                    for (int i = 0; i < 2; ++i) { const float keep = b3 ? q4[i + 2] : q4[i], send = b3 ? q4[i] : q4[i + 2]; q2[i] = keep + dppf<0x140>(send); }
                    float s; { const float keep = b2 ? q2[1] : q2[0], send = b2 ? q2[0] : q2[1]; s = keep + dppf<0x141>(send); }
                    s += dppf<0xB1>(s); s += dppf<0x4E>(s);
                    const int j = j0 + (b5 ? 8 : 0) + (b4 ? 4 : 0) + (b3 ? 2 : 0) + (b2 ? 1 : 0);
                    if (j < n && (c.lane & 3) == 0) { const int e = le[j], k = lk[j]; ACT[(size_t)t * 128 + k] = gelu_erf(s * USC[e]) * GATE[(size_t)t * 128 + k] * VSC[e]; }
                }
                WAVE_LDS_SYNC();
            } } }
}
__device__ __forceinline__ void phase_exp2(const Ctx& c) {
    const int* IDX = (const int*)(c.ws + WS_IDX); const float* ACT = (const float*)(c.ws + WS_ACT); const unsigned char* V8 = c.ws + WS_V8;
    float* Y = (float*)(c.ws + WS_Y); float* SSQP = (float*)(c.ws + WS_SSQP);
    unsigned* cnt = (unsigned*)(c.ws + WS_CTL) + CW_E2;
    const int xcc = (int)xcc_id(), sub = c.lane & 7, grp = c.lane >> 3;
    const bool b5 = c.lane & 32, b4 = c.lane & 16, b3 = c.lane & 8;
    constexpr int CH = 8;
    int bo = 0, t = 0, tend = 0;
    for (;;) {
        if (t >= tend) {
            unsigned t0 = 0; if (c.lane == 0) t0 = __hip_atomic_fetch_add(cnt + 64 * ((xcc + bo) & 7), (unsigned)CH, __ATOMIC_RELAXED, __HIP_MEMORY_SCOPE_AGENT);
            t0 = (unsigned)__builtin_amdgcn_readfirstlane((int)t0);
            if (t0 >= (unsigned)ML) { if (++bo >= 8) break; continue; }
            t = (int)t0; tend = t + CH;
        }
        const int x = (xcc + bo) & 7;
        float acc[16];
#pragma unroll
        for (int q = 0; q < 16; ++q) acc[q] = 0.f;
#pragma unroll 4
        for (int i = 0; i < 16; ++i) { const int k = 8 * i + grp; const int e = IDX[(size_t)t * 128 + k]; const float av = ACT[(size_t)t * 128 + k];
            const v4u row = *(const v4u*)(V8 + (size_t)e * D + x * 128 + 16 * sub); float f[16]; fp8x16_to_f32(row, f);
#pragma unroll
            for (int q = 0; q < 16; ++q) acc[q] = fmaf(av, f[q], acc[q]); }
        float q8[8], q4[4], q2[2];
#pragma unroll
        for (int i = 0; i < 8; ++i) { const float keep = b5 ? acc[i + 8] : acc[i], send = b5 ? acc[i] : acc[i + 8]; q8[i] = keep + __shfl_xor(send, 32); }
#pragma unroll
        for (int i = 0; i < 4; ++i) { const float keep = b4 ? q8[i + 4] : q8[i], send = b4 ? q8[i] : q8[i + 4]; q4[i] = keep + __shfl_xor(send, 16); }
#pragma unroll
        for (int i = 0; i < 2; ++i) { const float keep = b3 ? q4[i + 2] : q4[i], send = b3 ? q4[i] : q4[i + 2]; q2[i] = keep + __shfl_xor(send, 8); }
        const int col = x * 128 + 16 * sub + (b5 ? 8 : 0) + (b4 ? 4 : 0) + (b3 ? 2 : 0);
        *(f32x2*)(Y + (size_t)t * D + col) = (f32x2){q2[0], q2[1]};
        const float ss = wsum(q2[0] * q2[0] + q2[1] * q2[1]);
        SSQP[(size_t)x * ML + t] = ss;
        ++t;
    }
}
__device__ __forceinline__ void phase_exp3(const Ctx& c) {
    const Args& a = *c.a;
    const float* MOD = (const float*)(c.ws + WS_MOD); const float* Y = (const float*)(c.ws + WS_Y); const float* SSQP = (const float*)(c.ws + WS_SSQP);
    for (int row = c.gw; row < ML; row += c.NGW) {
        float ss = 0.f;
#pragma unroll
        for (int x = 0; x < 8; ++x) ss += SSQP[(size_t)x * ML + row];
        const float r = rsqrtf(ss * (1.f / D) + EPS); const float* mr = MOD + (row >> 11) * 6144 + 5120;
#pragma unroll
        for (int j = 0; j < 4; ++j) { const int col = 4 * c.lane + 256 * j;
            const f32x4 y = *(const f32x4*)(Y + (size_t)row * D + col), x1 = *(const f32x4*)(a.out + (size_t)row * D + col), g4 = *(const f32x4*)(a.in[I_GPOSTFFN] + col), gt = *(const f32x4*)(mr + col);
            *(f32x4*)(a.out + (size_t)row * D + col) = x1 + gt * ((y * r) * g4); }
    }
}

__device__ __forceinline__ void phase_experts(const Ctx& c) {
    const Args& a = *c.a;
    const float* MOD = (const float*)(c.ws + WS_MOD); const bf16* HX2 = (const bf16*)(c.ws + WS_HX2); const int* IDX = (const int*)(c.ws + WS_IDX); const float* GATE = (const float*)(c.ws + WS_GATE);
    float* acts = (float*)c.lds; int* eid = (int*)(c.lds + 512); float* red = (float*)(c.lds + 1024);
    for (int tok = c.bid; tok < ML; tok += c.G) {
        float hv[16];
#pragma unroll
        for (int j = 0; j < 4; ++j) { const v2u w = *(const v2u*)(HX2 + (size_t)tok * D + 4 * c.lane + 256 * j); hv[4 * j] = bflo(w.x); hv[4 * j + 1] = bfhi(w.x); hv[4 * j + 2] = bflo(w.y); hv[4 * j + 3] = bfhi(w.y); }
#pragma unroll 4
        for (int i = 0; i < 16; ++i) { const int k = c.wave * 16 + i; const int e = IDX[(size_t)tok * 128 + k];
            const f32x4* ur = (const f32x4*)(a.in[I_PU] + (size_t)e * D) + c.lane; float s = 0.f;
#pragma unroll
            for (int j = 0; j < 4; ++j) { const f32x4 u4 = ur[64 * j]; s += (u4.x * hv[4 * j] + u4.y * hv[4 * j + 1]) + (u4.z * hv[4 * j + 2] + u4.w * hv[4 * j + 3]); }
            s = wave_sum(s);
            if (c.lane == 0) { acts[k] = gelu_erf(s) * GATE[(size_t)tok * 128 + k]; eid[k] = e; } }
        __syncthreads();
        f32x2 acc = (f32x2){0.f, 0.f};
#pragma unroll 8
        for (int k = 0; k < 128; ++k) { const f32x2 v2 = *(const f32x2*)(a.in[I_PV] + (size_t)eid[k] * D + 2 * c.tid); const float ak = acts[k]; acc.x = fmaf(ak, v2.x, acc.x); acc.y = fmaf(ak, v2.y, acc.y); }
        const float ws = wave_sum(acc.x * acc.x + acc.y * acc.y);
        if (c.lane == 0) red[c.wave] = ws;
        __syncthreads();
        float tot = 0.f;
#pragma unroll
        for (int w = 0; w < 8; ++w) tot += red[w];
        const float r = rsqrtf(tot * (1.f / D) + EPS);
        const int col = 2 * c.tid; const float* mr = MOD + (tok >> 11) * 6144 + 5120;
        const f32x2 x1 = *(const f32x2*)(a.out + (size_t)tok * D + col), g2 = *(const f32x2*)(a.in[I_GPOSTFFN] + col), gt = *(const f32x2*)(mr + col);
        *(f32x2*)(a.out + (size_t)tok * D + col) = (f32x2){x1.x + gt.x * (acc.x * r * g2.x), x1.y + gt.y * (acc.y * r * g2.y)};
        __syncthreads();
    }
}


constexpr int S5_LPOW = 0, S5_BBAR = 33792, S5_CC = 50176, S5_MM = 66560;
__device__ __forceinline__ void s5_build_group(const Ctx& c, int g) {
    const Args& a = *c.a;
    f32x2* LPOW = (f32x2*)(c.lds + S5_LPOW);
    f32x2* BBAR = (f32x2*)(c.lds + S5_BBAR);
    f32x2* CC = (f32x2*)(c.lds + S5_CC);
    float* MM = (float*)(c.lds + S5_MM);
    __syncthreads();
    if (c.tid < 128) { const int dir = c.tid >> 6, p = c.tid & 63, dg = dir * 32 + g;
        const float dt = expf(a.in[I_LOGDT][dg]), lr = a.in[I_LAMRE][dg * 64 + p], li = a.in[I_LAMIM][dg * 64 + p];
        const double ang = (double)li * (double)dt; const float lrdt = lr * dt;
        for (int e = 0; e <= 32; ++e) { float sn, cs; sincos_d(ang * (double)e, sn, cs); const float mg = expf(lrdt * (float)e); LPOW[(dir * 33 + e) * 64 + p] = (f32x2){mg * cs, mg * sn}; }
        float sn, cs; sincos_d(ang, sn, cs); const float mag = expf(lrdt), lbr = mag * cs, lbi = mag * sn, den = lr * lr + li * li, nr = lbr - 1.f;
        const float cr = (nr * lr + lbi * li) / den, ci = (lbi * lr - nr * li) / den;
        for (int ch = 0; ch < 16; ++ch) { const float br = a.in[I_BRE][(size_t)(dg * 64 + p) * 16 + ch], bi = a.in[I_BIM][(size_t)(dg * 64 + p) * 16 + ch]; BBAR[(dir * 64 + p) * 16 + ch] = (f32x2){cr * br - ci * bi, cr * bi + ci * br}; } }
    for (int i = c.tid; i < 2048; i += NTHREADS) { const int dir = i >> 10, ch = (i >> 6) & 15, p = i & 63, dg = dir * 32 + g; CC[i] = (f32x2){a.in[I_CRE][(size_t)(dg * 16 + ch) * 64 + p], a.in[I_CIM][(size_t)(dg * 16 + ch) * 64 + p]}; }
    __syncthreads();
    for (int task = c.tid; task < 1024; task += NTHREADS) { const int cpb = task & 3, cb = (task >> 2) & 3, lag = (task >> 4) & 31, dir = task >> 9;
        float acc[4][4];
#pragma unroll
        for (int i = 0; i < 4; ++i)
#pragma unroll
            for (int j = 0; j < 4; ++j) acc[i][j] = 0.f;
        for (int p = 0; p < 64; ++p) { const f32x2 l = LPOW[(dir * 33 + lag) * 64 + p]; f32x2 G[4], Cw[4];
#pragma unroll
            for (int j = 0; j < 4; ++j) { const f32x2 bb = BBAR[(dir * 64 + p) * 16 + 4 * cpb + j]; G[j] = (f32x2){l.x * bb.x - l.y * bb.y, l.x * bb.y + l.y * bb.x}; }
#pragma unroll
            for (int i = 0; i < 4; ++i) Cw[i] = CC[(dir * 16 + 4 * cb + i) * 64 + p];
#pragma unroll
            for (int i = 0; i < 4; ++i)
#pragma unroll
                for (int j = 0; j < 4; ++j) acc[i][j] += Cw[i].x * G[j].x - Cw[i].y * G[j].y; }
#pragma unroll
        for (int i = 0; i < 4; ++i)
#pragma unroll
            for (int j = 0; j < 4; ++j) MM[((dir * 32 + lag) * 16 + 4 * cb + i) * 16 + 4 * cpb + j] = acc[i][j]; }
    __syncthreads();
    if (c.tid < 128) { const int dir = c.tid >> 6, p = c.tid & 63; ((f32x2*)(c.ws + WS_LP))[(dir * 32 + g) * 64 + p] = LPOW[(dir * 33 + 32) * 64 + p]; }
    bf16* PMg = (bf16*)(c.ws + WS_PM) + (size_t)g * 256 * 512; bf16* BBg = (bf16*)(c.ws + WS_BB) + (size_t)g * 512 * 768;
    for (int task = c.tid; task < 256 * 32; task += NTHREADS) { const int ip = task & 31, n = task >> 5, dir = n >> 7, im = (n >> 6) & 1, p = n & 63, e = dir ? ip : 31 - ip;
        const f32x2 l = LPOW[(dir * 33 + e) * 64 + p]; float o[16];
#pragma unroll
        for (int ch = 0; ch < 16; ++ch) { const f32x2 bb = BBAR[(dir * 64 + p) * 16 + ch]; o[ch] = im ? (l.x * bb.y + l.y * bb.x) : (l.x * bb.x - l.y * bb.y); }
        v4u w0, w1; w0.x = pk2(o[0], o[1]); w0.y = pk2(o[2], o[3]); w0.z = pk2(o[4], o[5]); w0.w = pk2(o[6], o[7]); w1.x = pk2(o[8], o[9]); w1.y = pk2(o[10], o[11]); w1.z = pk2(o[12], o[13]); w1.w = pk2(o[14], o[15]);
        *(v4u*)(PMg + (size_t)n * 512 + ip * 16) = w0; *(v4u*)(PMg + (size_t)n * 512 + ip * 16 + 8) = w1; }
    for (int task = c.tid; task < 512 * 32; task += NTHREADS) { const int ip = task & 31, n = task >> 5, i = n >> 4, ch = n & 15; float o[16];
#pragma unroll
        for (int q = 0; q < 16; ++q) o[q] = 0.f;
        if (ip <= i) { const float* m0 = MM + ((0 * 32 + (i - ip)) * 16 + ch) * 16;
#pragma unroll
            for (int q = 0; q < 16; ++q) o[q] += m0[q]; }
        if (ip >= i) { const float* m1 = MM + ((1 * 32 + (ip - i)) * 16 + ch) * 16;
#pragma unroll
            for (int q = 0; q < 16; ++q) o[q] += m1[q]; }
        if (ip == i) { const float dsk = a.in[I_S5D][g * 16 + ch];
#pragma unroll
            for (int q = 0; q < 16; ++q) o[q] += (q == ch) ? dsk : 0.f; }
        v4u w0, w1; w0.x = pk2(o[0], o[1]); w0.y = pk2(o[2], o[3]); w0.z = pk2(o[4], o[5]); w0.w = pk2(o[6], o[7]); w1.x = pk2(o[8], o[9]); w1.y = pk2(o[10], o[11]); w1.z = pk2(o[12], o[13]); w1.w = pk2(o[14], o[15]);
        *(v4u*)(BBg + (size_t)n * 768 + ip * 16) = w0; *(v4u*)(BBg + (size_t)n * 768 + ip * 16 + 8) = w1; }
    for (int task = c.tid; task < 512 * 32; task += NTHREADS) { const int p8 = task & 7, part = (task >> 3) & 3, n = task >> 5, i = n >> 4, ch = n & 15, dir = part >> 1, im = part & 1, e = dir ? 32 - i : i + 1; float o[8];
#pragma unroll
        for (int q = 0; q < 8; ++q) { const int p = p8 * 8 + q; const f32x2 l = LPOW[(dir * 33 + e) * 64 + p], cc = CC[(dir * 16 + ch) * 64 + p]; o[q] = im ? -(cc.x * l.y + cc.y * l.x) : (cc.x * l.x - cc.y * l.y); }
        v4u w0; w0.x = pk2(o[0], o[1]); w0.y = pk2(o[2], o[3]); w0.z = pk2(o[4], o[5]); w0.w = pk2(o[6], o[7]);
        *(v4u*)(BBg + (size_t)n * 768 + 512 + part * 64 + p8 * 8) = w0; }
}
__device__ __forceinline__ void s5_state_scan(const Ctx& c, int task) {
    const int dir = task & 1, g = (task >> 1) & 31, b = task >> 6, p = c.lane;
    const f32x2 a = ((const f32x2*)(c.ws + WS_LP))[(dir * 32 + g) * 64 + p];
    const float* SS = (const float*)(c.ws + WS_SS) + (size_t)g * 768 * 256 + dir * 128 + p; bf16* U5 = (bf16*)(c.ws + WS_U5) + (size_t)g * 768 * 768 + 512 + dir * 128 + p;
    float er = 0.f, ei = 0.f;
#pragma unroll 8
    for (int step = 0; step < 72; ++step) {
        const int R = (step < 8) ? 512 + b * 8 + (dir ? 7 - step : step) : b * 64 + (dir ? 71 - step : step - 8);
        if (step >= 8) { U5[(size_t)R * 768] = (bf16)f2bf(er); U5[(size_t)R * 768 + 64] = (bf16)f2bf(ei); }
        const float sr = SS[(size_t)R * 256], si = SS[(size_t)R * 256 + 64];
        const float nr = sr + a.x * er - a.y * ei, ni = si + a.x * ei + a.y * er; er = nr; ei = ni;
    }
}

typedef short bf16x8 __attribute__((ext_vector_type(8)));
typedef float f32x16 __attribute__((ext_vector_type(16)));
#define MFMA32(a, b, c) __builtin_amdgcn_mfma_f32_32x32x16_bf16((a), (b), (c), 0, 0, 0)
constexpr int GDN_NCH = 36, GDN_ITEMS = NB * 4 * 2 * GDN_NCH;
constexpr size_t FR_T_BYTES = 8192, FR_ATT_BYTES = 8192, FR_KD_BYTES = 16384, FR_TAB_BYTES = 1024;
__device__ __forceinline__ int crow16(int i, int hh) { return (i & 3) + 8 * (i >> 2) + 4 * hh; }
__device__ __forceinline__ bf16x8 pack_step(const f32x16& x, int s) {
    v4u w; w.x = pk2(x[8 * s + 0], x[8 * s + 1]); w.y = pk2(x[8 * s + 2], x[8 * s + 3]); w.z = pk2(x[8 * s + 4], x[8 * s + 5]); w.w = pk2(x[8 * s + 6], x[8 * s + 7]);
    return __builtin_bit_cast(bf16x8, w);
}
constexpr int GP_KR = 0, GP_QR = 17408, GP_KT = 34816, GP_LM = 53248, GP_TB = 70656, GP_TAB = 79872;
__device__ __forceinline__ void gdn_prep_item(const Ctx& c, int item) {
    const int n = item % GDN_NCH, bhd = item / GDN_NCH, dir = bhd & 1, h = (bhd >> 1) & 3, b = bhd >> 3;
    const bf16* QKV = (const bf16*)(c.ws + WS_QKV); const float* GB = (const float*)(c.ws + WS_GB);
    bf16* Kr = (bf16*)(c.lds + GP_KR); bf16* Qr = (bf16*)(c.lds + GP_QR); bf16* Kt = (bf16*)(c.lds + GP_KT); float* Lm = (float*)(c.lds + GP_LM); bf16* Tb = (bf16*)(c.lds + GP_TB); float* tab = (float*)(c.lds + GP_TAB);
    unsigned char* frT = c.ws + WS_FRT + (size_t)item * FR_T_BYTES; unsigned char* frA = c.ws + WS_FRA + (size_t)item * FR_ATT_BYTES; unsigned char* frK = c.ws + WS_FRK + (size_t)item * FR_KD_BYTES; float* frTab = (float*)(c.ws + WS_FRTAB + (size_t)item * FR_TAB_BYTES);
    const int r = c.lane & 31, hh = c.lane >> 5;
    if (c.wave == 0) { const int row = scan_row(b, dir, n * 64 + c.lane); float g = GB[(size_t)row * 16 + dir * 4 + h]; const float beta = GB[(size_t)row * 16 + 8 + dir * 4 + h];
#pragma unroll
        for (int o = 1; o < 64; o <<= 1) { const float t = __shfl_up(g, o); if (c.lane >= o) g += t; }
        const float gl = __shfl(g, 63);
        tab[c.lane] = g; tab[64 + c.lane] = beta; tab[128 + c.lane] = __expf(g); tab[192 + c.lane] = __expf(gl - g); }
    { const int s = c.tid >> 3, seg = c.tid & 7; const int row = scan_row(b, dir, n * 64 + s); const bf16* rp = QKV + (size_t)row * 1536 + h * 128 + seg * 16;
      const v4u q0 = *(const v4u*)rp, q1 = *(const v4u*)(rp + 8), k0 = *(const v4u*)(rp + 512), k1 = *(const v4u*)(rp + 520);
      *(v4u*)(Qr + s * 136 + seg * 16) = q0; *(v4u*)(Qr + s * 136 + seg * 16 + 8) = q1; *(v4u*)(Kr + s * 136 + seg * 16) = k0; *(v4u*)(Kr + s * 136 + seg * 16 + 8) = k1;
      const unsigned kw[8] = {k0.x, k0.y, k0.z, k0.w, k1.x, k1.y, k1.z, k1.w};
#pragma unroll
      for (int e = 0; e < 8; ++e) { Kt[(seg * 16 + 2 * e) * 72 + s] = (bf16)(kw[e] & 0xffffu); Kt[(seg * 16 + 2 * e + 1) * 72 + s] = (bf16)(kw[e] >> 16); } }
    __syncthreads();
    if (c.wave < 3) { const int ct = c.wave ? 1 : 0, st = c.wave == 2 ? 1 : 0;
        f32x16 acc;
#pragma unroll
        for (int i = 0; i < 16; ++i) acc[i] = 0.f;
#pragma unroll
        for (int kk = 0; kk < 8; ++kk) { const bf16x8 a = *(const bf16x8*)(Kr + (ct * 32 + r) * 136 + kk * 16 + hh * 8), bb = *(const bf16x8*)(Kr + (st * 32 + r) * 136 + kk * 16 + hh * 8); acc = MFMA32(a, bb, acc); }
        const int s = st * 32 + r; const float gcs = tab[s];
#pragma unroll
        for (int i = 0; i < 16; ++i) { const int cc = ct * 32 + crow16(i, hh); Lm[cc * 68 + s] = (s < cc) ? tab[64 + cc] * acc[i] * __expf(tab[cc] - gcs) : 0.f; }
    } else if (c.wave < 6) { const int w = c.wave - 3, st = w == 2 ? 1 : 0, ct = w ? 1 : 0;
        f32x16 acc;
#pragma unroll
        for (int i = 0; i < 16; ++i) acc[i] = 0.f;
#pragma unroll
        for (int kk = 0; kk < 8; ++kk) { const bf16x8 a = *(const bf16x8*)(Kr + (st * 32 + r) * 136 + kk * 16 + hh * 8), bb = *(const bf16x8*)(Qr + (ct * 32 + r) * 136 + kk * 16 + hh * 8); acc = MFMA32(a, bb, acc); }
        const int cc = ct * 32 + r; const float gcc = tab[cc];
#pragma unroll
        for (int i = 0; i < 16; ++i) { const int s = st * 32 + crow16(i, hh); acc[i] = (s <= cc) ? acc[i] * __expf(gcc - tab[s]) : 0.f; }
        *(bf16x8*)(frA + ((size_t)((ct * 4 + 2 * st) * 64 + c.lane)) * 16) = pack_step(acc, 0);
        *(bf16x8*)(frA + ((size_t)((ct * 4 + 2 * st + 1) * 64 + c.lane)) * 16) = pack_step(acc, 1);
    } else { const int w = c.wave - 6;
#pragma unroll
        for (int f = 0; f < 8; ++f) { const int fi = w * 8 + f, dkt = fi >> 2, cb = fi & 3; const bf16* kp = Kt + (dkt * 32 + r) * 72 + 16 * cb + 4 * hh;
            const v2u lo = *(const v2u*)kp, hi = *(const v2u*)(kp + 8); const f32x4 e0 = *(const f32x4*)(tab + 192 + 16 * cb + 4 * hh), e1 = *(const f32x4*)(tab + 192 + 16 * cb + 8 + 4 * hh);
            v4u o; o.x = pk2(bflo(lo.x) * e0.x, bfhi(lo.x) * e0.y); o.y = pk2(bflo(lo.y) * e0.z, bfhi(lo.y) * e0.w); o.z = pk2(bflo(hi.x) * e1.x, bfhi(hi.x) * e1.y); o.w = pk2(bflo(hi.y) * e1.z, bfhi(hi.y) * e1.w);
            *(v4u*)(frK + ((size_t)(fi * 64 + c.lane)) * 16) = o; }
        if (w == 0) { const v4u z = (v4u){0u, 0u, 0u, 0u}; *(v4u*)(frA + ((size_t)((0 * 4 + 2) * 64 + c.lane)) * 16) = z; *(v4u*)(frA + ((size_t)((0 * 4 + 3) * 64 + c.lane)) * 16) = z; }
        else { *(f32x4*)(frTab + 4 * c.lane) = *(const f32x4*)(tab + 4 * c.lane); }
    }
    __syncthreads();
    if (c.wave == 0) { float Tr[64];
#pragma unroll
        for (int i = 0; i < 64; ++i) { float a0 = (c.lane == i) ? 1.f : 0.f, a1 = 0.f;
#pragma unroll
            for (int s4 = 0; s4 < (i + 3) / 4; ++s4) { const f32x4 l4 = *(const f32x4*)(Lm + i * 68 + 4 * s4);
                if (4 * s4 + 0 < i) a0 = fmaf(-l4.x, Tr[4 * s4 + 0], a0); if (4 * s4 + 1 < i) a1 = fmaf(-l4.y, Tr[4 * s4 + 1], a1); if (4 * s4 + 2 < i) a0 = fmaf(-l4.z, Tr[4 * s4 + 2], a0); if (4 * s4 + 3 < i) a1 = fmaf(-l4.w, Tr[4 * s4 + 3], a1); }
            Tr[i] = a0 + a1; Tb[i * 72 + c.lane] = (bf16)f2bf(Tr[i]); } }
    __syncthreads();
    { const int ct = c.wave >> 2, sb = c.wave & 3; const bf16* tp = Tb + (ct * 32 + r) * 72 + 16 * sb + 4 * hh; const v2u lo = *(const v2u*)tp, hi = *(const v2u*)(tp + 8);
      *(v4u*)(frT + ((size_t)((ct * 4 + sb) * 64 + c.lane)) * 16) = (v4u){lo.x, lo.y, hi.x, hi.y}; }
    __syncthreads();
}
__device__ __forceinline__ void phase_gdn_prep(const Ctx& c) { for (int item = c.bid; item < GDN_ITEMS; item += c.G) gdn_prep_item(c, item); }

constexpr int GR_K = 0, GR_Q = 16384, GR_T = 32768, GR_A = 40960, GR_KD = 49152, GR_TAB = 65536, GR_BUF = 66560;
__device__ __forceinline__ void gdn_rec_stage(const Ctx& c, int bhd, int n, int buf) {
    const int dir = bhd & 1, h = (bhd >> 1) & 3, b = bhd >> 3, lw = c.wave - 4; const int item = bhd * GDN_NCH + n;
    LAS unsigned char* base = (LAS unsigned char*)c.lds + buf * GR_BUF;
    const unsigned char* QKVb = c.ws + WS_QKV;
#pragma unroll
    for (int q = 0; q < 4; ++q) { const int qi = lw + 4 * q;
        const int s = 4 * qi + (c.lane >> 4), ps = c.lane & 15, p = ps ^ (s & 15); const size_t rowb = (size_t)scan_row(b, dir, n * 64 + s) * 3072 + (size_t)h * 256 + p * 16;
        __builtin_amdgcn_global_load_lds((const unsigned*)(QKVb + rowb + 1024), (LAS unsigned*)(base + GR_K + qi * 1024), 16, 0, 0);
        __builtin_amdgcn_global_load_lds((const unsigned*)(QKVb + rowb), (LAS unsigned*)(base + GR_Q + qi * 1024), 16, 0, 0); }
    const unsigned char* frT = c.ws + WS_FRT + (size_t)item * FR_T_BYTES; const unsigned char* frA = c.ws + WS_FRA + (size_t)item * FR_ATT_BYTES; const unsigned char* frK = c.ws + WS_FRK + (size_t)item * FR_KD_BYTES;
#pragma unroll
    for (int q = 0; q < 2; ++q) { const int qi = lw + 4 * q;
        __builtin_amdgcn_global_load_lds((const unsigned*)(frT + qi * 1024 + c.lane * 16), (LAS unsigned*)(base + GR_T + qi * 1024), 16, 0, 0);
        __builtin_amdgcn_global_load_lds((const unsigned*)(frA + qi * 1024 + c.lane * 16), (LAS unsigned*)(base + GR_A + qi * 1024), 16, 0, 0); }
#pragma unroll
    for (int q = 0; q < 4; ++q) { const int qi = lw + 4 * q;
        __builtin_amdgcn_global_load_lds((const unsigned*)(frK + qi * 1024 + c.lane * 16), (LAS unsigned*)(base + GR_KD + qi * 1024), 16, 0, 0); }
    if (lw == 0) __builtin_amdgcn_global_load_lds((const unsigned*)(c.ws + WS_FRTAB + (size_t)item * FR_TAB_BYTES + c.lane * 16), (LAS unsigned*)(base + GR_TAB), 16, 0, 0);
}
__device__ __forceinline__ bf16x8 gr_rowfrag(const unsigned char* tile, int row, int kb, int hh) {
    const unsigned char* rp = tile + row * 256; const int sw = row & 15;
    const v2u lo = *(const v2u*)(rp + (((2 * kb) ^ sw) * 16) + 8 * hh), hi = *(const v2u*)(rp + (((2 * kb + 1) ^ sw) * 16) + 8 * hh);
    return __builtin_bit_cast(bf16x8, (v4u){lo.x, lo.y, hi.x, hi.y});
}
__device__ __forceinline__ void gdn_rec_block(const Ctx& c, int bhd) {
    const int dir = bhd & 1, h = (bhd >> 1) & 3, b = bhd >> 3, r = c.lane & 31, hh = c.lane >> 5, dvt = c.wave;
    const bf16* QKV = (const bf16*)(c.ws + WS_QKV); bf16* OG = (bf16*)(c.ws + WS_OG) + (size_t)dir * ML * 512;
    f32x16 S[4];
#pragma unroll
    for (int t = 0; t < 4; ++t)
#pragma unroll
        for (int i = 0; i < 16; ++i) S[t][i] = 0.f;
    if (c.wave >= 4) gdn_rec_stage(c, bhd, 0, 0);
    asm volatile("s_waitcnt vmcnt(0)" ::: "memory"); __syncthreads();
    for (int n = 0; n < GDN_NCH; ++n) {
        const int buf = n & 1;
        if (c.wave >= 4) { if (n + 1 < GDN_NCH) gdn_rec_stage(c, bhd, n + 1, buf ^ 1); }
        else {
            const unsigned char* base = c.lds + buf * GR_BUF; const float* tab = (const float*)(base + GR_TAB);
            const int row0 = scan_row(b, dir, n * 64), sgn = dir ? -1 : 1;
            const bf16* vcol = QKV + (size_t)row0 * 1536 + 1024 + h * 128 + dvt * 32 + r + (ptrdiff_t)(sgn * 4 * hh) * 1536;
            bf16* ocol = OG + (size_t)row0 * 512 + h * 128 + dvt * 32 + r + (ptrdiff_t)(sgn * 4 * hh) * 512;
            const ptrdiff_t vst = (ptrdiff_t)sgn * 1536, ost = (ptrdiff_t)sgn * 512;
            bf16x8 Sf[4][2];
#pragma unroll
            for (int t = 0; t < 4; ++t) { Sf[t][0] = pack_step(S[t], 0); Sf[t][1] = pack_step(S[t], 1); }
            bf16x8 Rf[2][2];
#pragma unroll
            for (int st = 0; st < 2; ++st) { f32x16 acc; bf16 vraw[16];
#pragma unroll
                for (int i = 0; i < 16; ++i) { acc[i] = 0.f; vraw[i] = vcol[vst * (st * 32 + (i & 3) + 8 * (i >> 2))]; }
#pragma unroll
                for (int kb = 0; kb < 8; ++kb) acc = MFMA32(gr_rowfrag(base + GR_K, st * 32 + r, kb, hh), Sf[kb >> 1][kb & 1], acc);
#pragma unroll
                for (int i = 0; i < 16; ++i) { const int s = st * 32 + crow16(i, hh); acc[i] = tab[64 + s] * (bf1(vraw[i]) - tab[128 + s] * acc[i]); }
                Rf[st][0] = pack_step(acc, 0); Rf[st][1] = pack_step(acc, 1); asm volatile("" ::: "memory"); }
            bf16x8 Vf[2][2];
#pragma unroll
            for (int ct = 0; ct < 2; ++ct) { f32x16 acc;
#pragma unroll
                for (int i = 0; i < 16; ++i) acc[i] = 0.f;
#pragma unroll
                for (int sb = 0; sb < 4; ++sb) if (sb < 2 * ct + 2) acc = MFMA32(*(const bf16x8*)(base + GR_T + ((ct * 4 + sb) * 64 + c.lane) * 16), Rf[sb >> 1][sb & 1], acc);
                Vf[ct][0] = pack_step(acc, 0); Vf[ct][1] = pack_step(acc, 1); }
            asm volatile("" ::: "memory");
#pragma unroll
            for (int ct = 0; ct < 2; ++ct) { f32x16 acc;
#pragma unroll
                for (int i = 0; i < 16; ++i) acc[i] = 0.f;
#pragma unroll
                for (int kb = 0; kb < 8; ++kb) acc = MFMA32(gr_rowfrag(base + GR_Q, ct * 32 + r, kb, hh), Sf[kb >> 1][kb & 1], acc);
#pragma unroll
                for (int i = 0; i < 16; ++i) acc[i] *= tab[128 + ct * 32 + crow16(i, hh)];
#pragma unroll
                for (int cb = 0; cb < 4; ++cb) if (cb < 2 * ct + 2) acc = MFMA32(*(const bf16x8*)(base + GR_A + ((ct * 4 + cb) * 64 + c.lane) * 16), Vf[cb >> 1][cb & 1], acc);
                if (n >= 4) {
#pragma unroll
                    for (int i = 0; i < 16; ++i) ocol[ost * (ct * 32 + (i & 3) + 8 * (i >> 2))] = (bf16)f2bf(acc[i]); }
                asm volatile("" ::: "memory"); }
            const float gtot = tab[128 + 63];
#pragma unroll
            for (int t = 0; t < 4; ++t) {
#pragma unroll
                for (int i = 0; i < 16; ++i) S[t][i] *= gtot;
#pragma unroll
                for (int cb = 0; cb < 4; ++cb) S[t] = MFMA32(*(const bf16x8*)(base + GR_KD + ((t * 4 + cb) * 64 + c.lane) * 16), Vf[cb >> 1][cb & 1], S[t]); }
        }
        asm volatile("s_waitcnt vmcnt(0)" ::: "memory"); __syncthreads();
    }
}
__device__ __forceinline__ void phase_gdn_rec(const Ctx& c) { for (int bhd = c.bid; bhd < 64; bhd += 64) gdn_rec_block(c, bhd); }

#define XB_TMO      128
#define XB_XCNT(j)  (256  + 64 * (j))
#define XB_XSUB(j)  (1280 + 64 * (j))
#define XB_XGEN(j)  (2304 + 64 * (j))
#define XB_TOP      3328
#define XB_TOPGEN   3392
#define XCD_BAR_WORDS 3456
#define XB_SPIN_CAP (1u << 20)
__device__ __forceinline__ unsigned xb_ld(unsigned* p)              { return __hip_atomic_load(p, __ATOMIC_RELAXED, __HIP_MEMORY_SCOPE_AGENT); }
__device__ __forceinline__ unsigned xb_add(unsigned* p, unsigned v) { return __hip_atomic_fetch_add(p, v, __ATOMIC_RELAXED, __HIP_MEMORY_SCOPE_AGENT); }
__device__ __forceinline__ unsigned xb_xcc_id() { return (unsigned)__builtin_amdgcn_s_getreg((3 << 11) | 20) & 0xFu; }
#define XB_SPIN(cond, bar) do { unsigned _sp = 0; while (cond) { __builtin_amdgcn_s_sleep(1); \
    if ((++_sp & 255u) == 0u) { if (xb_ld(&(bar)[XB_TMO])) break; if (_sp > XB_SPIN_CAP) { atomicAdd(&(bar)[XB_TMO], 1u); break; } } } } while (0)
struct XcdBarrier { unsigned* bar; unsigned x; volatile LAS unsigned* st; };
__device__ __forceinline__ XcdBarrier xcd_barrier_post(unsigned* bar, volatile LAS unsigned* st) {
    XcdBarrier b; b.bar = bar; b.x = xb_xcc_id(); b.st = st;
    if (threadIdx.x == 0) (void)xb_add(&bar[XB_XCNT(b.x)], 1u);
    return b;
}
__device__ __forceinline__ void xcd_barrier_complete(unsigned* bar, unsigned x, unsigned& nloc, unsigned& nx) {
    const unsigned G = gridDim.x * gridDim.y * gridDim.z;
    unsigned sum, cnt, mine, sp = 0u;
    for (;;) {
        sum = 0u; cnt = 0u; mine = 0u;
#pragma unroll
        for (unsigned j = 0; j < 16; ++j) { const unsigned c = xb_ld(&bar[XB_XCNT(j)]); sum += c; cnt += (c > 0u) ? 1u : 0u; mine = (j == x) ? c : mine; }
        if (sum == G) break;
        __builtin_amdgcn_s_sleep(1);
        if ((++sp & 255u) == 0u) { if (xb_ld(&bar[XB_TMO])) break; if (sp > XB_SPIN_CAP) { atomicAdd(&bar[XB_TMO], 1u); break; } }
    }
    nloc = mine > 0u ? mine : 1u; nx = cnt > 0u ? cnt : 1u;
}
__device__ __forceinline__ void xcd_barrier(const XcdBarrier& b) {
    asm volatile("s_waitcnt vmcnt(0)" ::: "memory");
    __syncthreads();
    if (threadIdx.x == 0) {
        unsigned* bar = b.bar;
        __builtin_amdgcn_s_waitcnt(0);
        unsigned nloc = b.st[0], nx = b.st[1];
        if (nloc == 0u) { xcd_barrier_complete(bar, b.x, nloc, nx); b.st[0] = nloc; b.st[1] = nx; }
        const unsigned old = xb_add(&bar[XB_XSUB(b.x)], 1u);
        const unsigned gen = old / nloc;
        if (old + 1u == (gen + 1u) * nloc) {
            __builtin_amdgcn_fence(__ATOMIC_RELEASE, "agent");
            asm volatile("s_waitcnt vmcnt(0)" ::: "memory");
            const unsigned og = xb_add(&bar[XB_TOP], 1u);
            const unsigned tg = og / nx;
            if (og + 1u == (tg + 1u) * nx) xb_add(&bar[XB_TOPGEN], 1u);
            else XB_SPIN(xb_ld(&bar[XB_TOPGEN]) == tg, bar);
            __builtin_amdgcn_fence(__ATOMIC_ACQUIRE, "agent");
            xb_add(&bar[XB_XGEN(b.x)], 1u);
            asm volatile("s_waitcnt vmcnt(0)" ::: "memory");
        } else {
            XB_SPIN(xb_ld(&bar[XB_XGEN(b.x)]) == gen, bar);
            __builtin_amdgcn_fence(__ATOMIC_ACQUIRE, "agent");
            asm volatile("s_waitcnt vmcnt(0)" ::: "memory");
        }
    }
    __syncthreads();
}

constexpr int LDS_MISC = LDS_BYTES - 64;
__global__ void __launch_bounds__(NTHREADS, 2) mk_fwd(Args args) {
    extern __shared__ __attribute__((aligned(16))) unsigned char lds[];
    Ctx c; c.a = &args; c.ws = args.ws; c.lds = lds;
    c.tid = threadIdx.x; c.lane = c.tid & 63; c.wave = __builtin_amdgcn_readfirstlane(c.tid >> 6); c.bid = blockIdx.x; c.G = gridDim.x;
    c.gw = c.bid * NWAVES + c.wave; c.NGW = c.G * NWAVES; c.gwv = c.wave * c.G + c.bid;
    const int lo = args.ph_lo, hi = args.ph_hi;
    PG8_LAS unsigned char* ring = (PG8_LAS unsigned char*)lds;
#ifndef MK_PH_MASK
#define MK_PH_MASK 0xffff
#endif
#define IN(k) (((MK_PH_MASK >> (k)) & 1) && lo <= (k) && (k) < hi)
#if MK_ONE_LAUNCH
    cg::grid_group grid = cg::this_grid();
    if (lo < 0) grid.sync();
    volatile LAS unsigned* st = (volatile LAS unsigned*)((LAS unsigned char*)lds + LDS_MISC);
    if (c.tid < 2) st[c.tid] = 0u;
    __syncthreads();
    const XcdBarrier bar = xcd_barrier_post((unsigned*)(c.ws + WS_CTL) + CW_BAR, st);
#define SEAM(k) do { if (IN(k) && IN((k) + 1)) xcd_barrier(bar); } while (0)
#else
#define SEAM(k) do { } while (0)
#endif
    if (IN(0)) { phase_prep(c); phase_s5_build(c); } SEAM(0);
    if (IN(1)) { phase_norm1(c); } SEAM(1);
    if (IN(2)) { pg8::Gemm g{(const pg8::bf16_t*)(c.ws + WS_HX), (const pg8::bf16_t*)(c.ws + WS_WIN), 1024, 1024, 1024}; pg8::StaticOrder S; S.init(MT, NPROJ, c.G, c.bid);
        pg8::EpiInProj E{(pg8::bf16_t*)(c.ws + WS_U5), (pg8::bf16_t*)(c.ws + WS_QKVPRE), (pg8::bf16_t*)(c.ws + WS_Z)};
        pg8::gemm_phase<pg8::EpiInProj, pg8::StaticOrder, true, true>(ring, g, S, E); } SEAM(2);
    if (IN(3)) { { pg8::Gemm g{(const pg8::bf16_t*)(c.ws + WS_U5), (const pg8::bf16_t*)(c.ws + WS_PM), 768, 512, 512}; pg8::SchedSS S{c.G, c.bid}; pg8::EpiSS E{(float*)(c.ws + WS_SS)};
          pg8::gemm_phase<pg8::EpiSS, pg8::SchedSS, true, true>(ring, g, S, E); }
        __syncthreads(); phase_conv(c); } SEAM(3);
    if (IN(4)) { if (c.wave < 2) s5_state_scan(c, c.bid + c.G * c.wave < 512 ? c.bid + c.G * c.wave : 0); __syncthreads(); phase_gdn_prep(c); } SEAM(4);
    if (IN(5)) { pg8::Gemm g{(const pg8::bf16_t*)(c.ws + WS_U5), (const pg8::bf16_t*)(c.ws + WS_BB), 768, 768, 768}; pg8::SchedS5Y S{c.G, c.bid}; pg8::EpiS5Y E{(pg8::bf16_t*)(c.ws + WS_YG)};
        pg8::gemm_phase<pg8::EpiS5Y, pg8::SchedS5Y, true, true>(ring, g, S, E); } SEAM(5);
    if (IN(6)) { if (c.bid < 64) phase_gdn_rec(c);
        else { pg8::Gemm g{(const pg8::bf16_t*)(c.ws + WS_YG), (const pg8::bf16_t*)(c.ws + WS_WGLU), 512, 512, 512}; pg8::StaticOrder S; S.init(ML, 512, c.G - 64, c.bid - 64);
            pg8::EpiGlu E{(const pg8::bf16_t*)(c.ws + WS_YG), (pg8::bf16_t*)(c.ws + WS_CAT)};
            pg8::gemm_phase<pg8::EpiGlu, pg8::StaticOrder, true, true>(ring, g, S, E); } } SEAM(6);
    if (IN(7)) { phase_combine(c); } SEAM(7);
    if (IN(8)) { pg8::Gemm g{(const pg8::bf16_t*)(c.ws + WS_CAT), (const pg8::bf16_t*)(c.ws + WS_WOUT), 1024, 1024, 1024}; pg8::StaticOrder S; S.init(ML, 1024, c.G, c.bid);
        pg8::EpiF32 E{(float*)(c.ws + WS_YRAW), 1024};
        pg8::gemm_phase<pg8::EpiF32, pg8::StaticOrder, true, true>(ring, g, S, E); } SEAM(8);
    if (IN(9)) { phase_rows2(c); phase_fp8_tables(c); } SEAM(9);
    if (IN(10)) { pg8::Gemm g{(const pg8::bf16_t*)(c.ws + WS_HX2), (const pg8::bf16_t*)(c.ws + WS_WQ), 1024, 1024, 1024}; pg8::StaticOrder S; S.init(ML, 2048, c.G, c.bid);
        pg8::EpiBf16<0> E{(pg8::bf16_t*)(c.ws + WS_QP), 2048, nullptr, 0, 0, 1.f};
        pg8::gemm_phase<pg8::EpiBf16<0>, pg8::StaticOrder, true, true>(ring, g, S, E); } SEAM(10);
    if (IN(11)) { phase_topk(c); } SEAM(11);
    if (IN(12)) { phase_exp1(c); } SEAM(12);
    if (IN(13)) { phase_exp2(c); } SEAM(13);
    if (IN(14)) { phase_exp3(c); }
#undef IN
#undef SEAM
}

extern "C" void kernel_launch(void* const* d_in, const int* in_sizes, int n_in, void* d_out, int out_size, void* d_ws, size_t ws_size, hipStream_t stream) {
    static int grid = 0;
    if (grid == 0) {
        if (n_in != 29 || out_size != ML * D || ws_size < WS_END) { fprintf(stderr, "kernel_launch: unexpected shapes (n_in %d out %d ws %zu)\n", n_in, out_size, ws_size); grid = -1; return; }
        int dev = 0, cus = 0, per_cu = 0;
        (void)hipGetDevice(&dev); (void)hipDeviceGetAttribute(&cus, hipDeviceAttributeMultiprocessorCount, dev);
        if (hipFuncSetAttribute((const void*)mk_fwd, hipFuncAttributeMaxDynamicSharedMemorySize, LDS_BYTES) != hipSuccess) { fprintf(stderr, "kernel_launch: hipFuncSetAttribute failed\n"); grid = -1; return; }
        (void)hipOccupancyMaxActiveBlocksPerMultiprocessor(&per_cu, (const void*)mk_fwd, NTHREADS, LDS_BYTES);
        (void)hipGetLastError();
        grid = cus;
        fprintf(stderr, "kernel_launch: cus %d per_cu %d grid %d\n", cus, per_cu, grid);
    }
    if (grid < 0) return;
    Args a{};
    for (int i = 0; i < 29; ++i) a.in[i] = (const float*)d_in[i];
    a.out = (float*)d_out; a.ws = (unsigned char*)d_ws;
    (void)hipMemsetAsync((char*)d_ws + WS_CTL, 0, CTL_ZERO_BYTES, stream);
#if MK_ONE_LAUNCH
    a.ph_lo = 0; a.ph_hi = NPHASES;
    void* kargs[] = {&a};
    hipError_t e = hipLaunchCooperativeKernel((const void*)mk_fwd, dim3(grid), dim3(NTHREADS), kargs, LDS_BYTES, stream);
    if (e != hipSuccess) fprintf(stderr, "kernel_launch: cooperative launch failed: %s\n", hipGetErrorString(e));
#else
    for (int ph = 0; ph < NPHASES; ++ph) { a.ph_lo = ph; a.ph_hi = ph + 1; hipLaunchKernelGGL(mk_fwd, dim3(grid), dim3(NTHREADS), LDS_BYTES, stream, a); }
#endif
}
```

```cpp
#include <hip/hip_runtime.h>
#include <hip/hip_cooperative_groups.h>
#include <cstdio>
#include <cstdint>
namespace cg = cooperative_groups;
namespace pg8 {
#define PG8_LAS __attribute__((address_space(3)))
typedef unsigned short bf16_t;
typedef short bf16x8 __attribute__((ext_vector_type(8)));
typedef float f32x4 __attribute__((ext_vector_type(4)));
typedef unsigned u32x4 __attribute__((ext_vector_type(4)));
constexpr int BM = 256, BK = 64, HALF = 128, HTB = HALF * BK * 2  , STAGE_BYTES = 8 * HTB, NXCD = 8, WGM = 8;

__host__ __device__ __forceinline__ int lds_byte(int r, int c) { const int st = (r >> 4) * 2 + (c >> 5), rr = r & 15, cc = c & 31, ob = rr * 64 + cc * 2; return st * 1024 + (ob ^ (((ob >> 9) & 1) << 5)); }
__host__ __device__ __forceinline__ void stage_rc(int b, int& R, int& C) { const int st = b / 1024, sb = b % 1024, swz = sb ^ (((sb >> 9) & 1) << 5); R = (st >> 1) * 16 + swz / 64; C = (st & 1) * 32 + (swz % 64) / 2; }
__host__ __device__ __forceinline__ int perm32(int rho) { const int n = rho >> 4, i = rho & 15; return 8 * (i >> 2) + 4 * n + (i & 3); }

struct Unit { int pm, pn; };
struct Gemm { const bf16_t* A; const bf16_t* Bt; int lda, ldb, K; };

struct StaticOrder {
    int nM, nN, nwg, G, c;
    __host__ __device__ void init(int M, int N, int G_, int c_) { nM = M / BM; nN = N / BM; nwg = nM * nN; G = G_; c = c_; }
    __host__ __device__ bool next(int i, Unit& u) const {
        const long L = (long)i * G + c; if (L >= nwg) return false;
        int wgid = (int)L; { const int q = nwg / NXCD, r = nwg % NXCD, xcd = wgid % NXCD, off = wgid / NXCD; wgid = (xcd < r ? xcd * (q + 1) : r * (q + 1) + (xcd - r) * q) + off; }
        const int nig = WGM * nN, gid = wgid / nig, fm = gid * WGM, gsz = (nM - fm) < WGM ? (nM - fm) : WGM;
        u.pm = fm + ((wgid % nig) % gsz); u.pn = (wgid % nig) / gsz; return true;
    }
    __device__ __forceinline__ void a_ready(const Unit&) const {}
    __device__ __forceinline__ void done(const Unit&) const {}
};

__device__ __forceinline__ unsigned cvt_pk_bf16(float lo, float hi) { unsigned r; asm volatile("v_cvt_pk_bf16_f32 %0, %1, %2" : "=v"(r) : "v"(lo), "v"(hi)); return r; }
typedef float f32x2 __attribute__((ext_vector_type(2)));
__device__ __forceinline__ f32x2 gelu_pk(f32x2 v) {
    const f32x2 av = __builtin_elementwise_abs(v), d = av * 0.2316418882f + 1.0f;
    f32x2 t; t.x = __builtin_amdgcn_rcpf(d.x); t.y = __builtin_amdgcn_rcpf(d.y);
    f32x2 q = t * 0.5307027145f + (-0.7265760135f); q = q * t + 0.7107068705f; q = q * t + (-0.142248368f); q = q * t + 0.127414796f; q = q * t;
    const f32x2 s = (v * v) * (-0.72134752044f);
    f32x2 e; e.x = __builtin_amdgcn_exp2f(s.x); e.y = __builtin_amdgcn_exp2f(s.y);
    const f32x2 m = v * (q * e), r = v - m;
    f32x2 o; o.x = v.x < 0.f ? m.x : r.x; o.y = v.y < 0.f ? m.y : r.y; return o;
}

template <int ACT  > struct EpiBf16 {
    static constexpr bool PERM = true, AFTER_DRAIN = false; static_assert(ACT == 0 || ACT == 1, "EpiBf16: ACT is 0 (none) or 1 (gelu_pk)");
    bf16_t* O; int ldc; const float* bias; int split_cols; size_t split_stride; float scale0;
    __device__ __forceinline__ void operator()(const f32x4 (&acc)[2][2][4][2], const Unit& u, int wr, int wc, int fr, int fq) const {
        const int row0 = u.pm * BM + wr * 64 + fr; int colt = u.pn * BM; bf16_t* base = O;
        float sc = 1.f; if (split_cols) { const int t = colt / split_cols; base += (size_t)t * split_stride; colt -= t * split_cols; if (t == 0) sc = scale0; }
        const int col0 = colt + wc * 32 + 8 * fq, bcol0 = u.pn * BM + wc * 32 + 8 * fq;
        f32x4 bv[2][2];
#pragma unroll
        for (int bj = 0; bj < 2; ++bj)
#pragma unroll
            for (int n = 0; n < 2; ++n) bv[bj][n] = bias ? *(const f32x4*)(bias + bcol0 + bj * HALF + 4 * n) : (f32x4){0.f, 0.f, 0.f, 0.f};
#pragma unroll
        for (int ai = 0; ai < 2; ++ai)
#pragma unroll
            for (int m = 0; m < 4; ++m) { bf16_t* rowp = base + (size_t)(row0 + ai * HALF + m * 16) * ldc + col0;
#pragma unroll
                for (int bj = 0; bj < 2; ++bj) { f32x4 v0 = acc[ai][bj][m][0] + bv[bj][0], v1 = acc[ai][bj][m][1] + bv[bj][1];
                    if (ACT == 1) { f32x2 a = gelu_pk((f32x2){v0[0], v0[1]}), b = gelu_pk((f32x2){v0[2], v0[3]}), c = gelu_pk((f32x2){v1[0], v1[1]}), d = gelu_pk((f32x2){v1[2], v1[3]});
                        v0 = (f32x4){a.x, a.y, b.x, b.y}; v1 = (f32x4){c.x, c.y, d.x, d.y}; }
                    v0 = v0 * sc; v1 = v1 * sc; u32x4 w; w.x = cvt_pk_bf16(v0[0], v0[1]); w.y = cvt_pk_bf16(v0[2], v0[3]); w.z = cvt_pk_bf16(v1[0], v1[1]); w.w = cvt_pk_bf16(v1[2], v1[3]);
                    *(u32x4*)(rowp + bj * HALF) = w; } }
    }
};

template <class Epi, class Sched, bool ALIGN_EPI = false, bool SP2 = false>
__device__ __forceinline__ void gemm_phase(PG8_LAS unsigned char* lds, const Gemm g, const Sched& S, const Epi& E) {
    const int tid = threadIdx.x, wid = __builtin_amdgcn_readfirstlane(tid >> 6), lane = tid & 63, wr = wid >> 2, wc = wid & 3, fr = lane & 15, fq = lane >> 4;
    const int K = g.K, nt = K / BK;
    unsigned voffA[2], voffB[2];
#pragma unroll
    for (int i = 0; i < 2; ++i) { int R, C; stage_rc(tid * 16 + i * 8192, R, C); const int Rb = Epi::PERM ? ((R & ~31) + perm32(R & 31)) : R;
        voffA[i] = (unsigned)(R * g.lda + C) * 2u; voffB[i] = (unsigned)(Rb * g.ldb + C) * 2u; }
    const size_t kstep = (size_t)(BK * 2);
    const size_t hstepA = (size_t)HALF * g.lda * 2, hstepB = (size_t)HALF * g.ldb * 2;
    const size_t tstepA = 2 * hstepA, tstepB = 2 * hstepB;
    const unsigned ldsw = (unsigned)wid * 1024u;
    const int aoff = lds_byte(wr * 64 + fr, fq * 8), boff = lds_byte(wc * 32 + fr, fq * 8);
#define PG8_SA(b, h) (((b) * 2 + (h)) * HTB)
#define PG8_SB(b, h) ((4 + (b) * 2 + (h)) * HTB)
#define PG8_STAGE(bufoff, gbase, voff) do { _Pragma("unroll") for (int _i = 0; _i < 2; ++_i) \
        __builtin_amdgcn_global_load_lds((const unsigned*)((const char*)(gbase) + (voff)[_i]), (PG8_LAS unsigned*)(lds + (bufoff) + ldsw + _i * 8192), 16, 0, 0); } while (0)
#define PG8_LDA(dst, b, h) do { _Pragma("unroll") for (int m = 0; m < 4; ++m) _Pragma("unroll") for (int k = 0; k < 2; ++k) dst[m][k] = *(const PG8_LAS bf16x8*)(lds + PG8_SA(b, h) + aoff + m * 2048 + k * 1024); } while (0)
#define PG8_LDB(dst, b, h) do { _Pragma("unroll") for (int n = 0; n < 2; ++n) _Pragma("unroll") for (int k = 0; k < 2; ++k) dst[n][k] = *(const PG8_LAS bf16x8*)(lds + PG8_SB(b, h) + boff + n * 2048 + k * 1024); } while (0)
#define PG8_MMA(ai, bj, At, Bt) do { __builtin_amdgcn_s_setprio(1); _Pragma("unroll") for (int m = 0; m < 4; ++m) _Pragma("unroll") for (int n = 0; n < 2; ++n) _Pragma("unroll") for (int k = 0; k < 2; ++k) \
        acc[ai][bj][m][n] = __builtin_amdgcn_mfma_f32_16x16x32_bf16(Bt[n][k], At[m][k], acc[ai][bj][m][n], 0, 0, 0); __builtin_amdgcn_s_setprio(0); } while (0)
#define PG8_WAIT_V(n) asm volatile("s_waitcnt vmcnt(" #n ")" ::: "memory")
#define PG8_WAIT_L(n) asm volatile("s_waitcnt lgkmcnt(" #n ")" ::: "memory")
#define PG8_BAR __builtin_amdgcn_s_barrier()
#define PG8_SCHED __builtin_amdgcn_sched_barrier(0)
    Unit cur, nxt; int ui = 0;
    if (!S.next(0, cur)) return;
    f32x4 acc[2][2][4][2];
#pragma unroll
    for (int a = 0; a < 2; ++a)
#pragma unroll
        for (int b = 0; b < 2; ++b)
#pragma unroll
            for (int m = 0; m < 4; ++m)
#pragma unroll
                for (int n = 0; n < 2; ++n) acc[a][b][m][n] = (f32x4){0.f, 0.f, 0.f, 0.f};
    bf16x8 At[4][2], B0[2][2], B1[2][2];
    const char* cA = (const char*)g.A + (size_t)cur.pm * tstepA; const char* cB = (const char*)g.Bt + (size_t)cur.pn * tstepB;
    S.a_ready(cur);
    if constexpr (SP2) {
        PG8_STAGE(PG8_SB(0, 0), cB, voffB); PG8_STAGE(PG8_SB(0, 1), cB + hstepB, voffB); PG8_STAGE(PG8_SA(0, 0), cA, voffA); PG8_STAGE(PG8_SA(0, 1), cA + hstepA, voffA);
        if (wr == 1) PG8_BAR;
        PG8_WAIT_V(2); PG8_BAR;
        PG8_STAGE(PG8_SB(1, 0), cB + kstep, voffB); PG8_STAGE(PG8_SA(1, 0), cA + kstep, voffA); PG8_STAGE(PG8_SB(1, 1), cB + hstepB + kstep, voffB);
        PG8_WAIT_V(6); PG8_BAR;
    } else {
        PG8_STAGE(PG8_SB(0, 0), cB, voffB); PG8_STAGE(PG8_SA(0, 0), cA, voffA); PG8_STAGE(PG8_SB(0, 1), cB + hstepB, voffB); PG8_STAGE(PG8_SA(0, 1), cA + hstepA, voffA);
        if (wr == 1) PG8_BAR;
        PG8_WAIT_V(4); PG8_BAR;
        PG8_STAGE(PG8_SB(1, 0), cB + kstep, voffB); PG8_STAGE(PG8_SA(1, 0), cA + kstep, voffA); PG8_STAGE(PG8_SB(1, 1), cB + hstepB + kstep, voffB);
        PG8_WAIT_V(6); PG8_BAR;
    }
    for (;;) {
        const bool has_next = S.next(ui + 1, nxt);
        const char* nA = has_next ? (const char*)g.A + (size_t)nxt.pm * tstepA : cA; const char* nB = has_next ? (const char*)g.Bt + (size_t)nxt.pn * tstepB : cB;
        for (int t = 0; t < nt; t += 2) {
            const bool last = (t == nt - 2);
            const char* a1 = cA + (size_t)(t + 1) * kstep;
            const char* a2 = last ? nA : cA + (size_t)(t + 2) * kstep; const char* b2 = last ? nB : cB + (size_t)(t + 2) * kstep;
            const char* a3 = a2 + kstep; const char* b3 = b2 + kstep;
            if (last && has_next) S.a_ready(nxt);
            if constexpr (SP2) {
            PG8_LDB(B0, 0, 0); PG8_LDB(B1, 0, 1); PG8_SCHED; PG8_LDA(At, 0, 0); PG8_STAGE(PG8_SA(1, 1), a1 + hstepA, voffA);
            PG8_WAIT_V(8); PG8_WAIT_L(0); PG8_BAR; PG8_MMA(0, 0, At, B0); PG8_MMA(0, 1, At, B1); PG8_BAR; PG8_SCHED;
            PG8_LDA(At, 0, 1); PG8_STAGE(PG8_SB(0, 0), b2, voffB); PG8_STAGE(PG8_SB(0, 1), b2 + hstepB, voffB); PG8_STAGE(PG8_SA(0, 0), a2, voffA);
            PG8_WAIT_V(8); PG8_WAIT_L(0); PG8_BAR; PG8_MMA(1, 0, At, B0); PG8_MMA(1, 1, At, B1); PG8_BAR; PG8_SCHED;
            PG8_LDB(B0, 1, 0); PG8_LDB(B1, 1, 1); PG8_SCHED; PG8_LDA(At, 1, 0); PG8_STAGE(PG8_SA(0, 1), a2 + hstepA, voffA);
            PG8_WAIT_V(8); PG8_WAIT_L(0); PG8_BAR; PG8_MMA(0, 0, At, B0); PG8_MMA(0, 1, At, B1); PG8_BAR; PG8_SCHED;
            PG8_LDA(At, 1, 1); PG8_STAGE(PG8_SB(1, 0), b3, voffB); PG8_STAGE(PG8_SB(1, 1), b3 + hstepB, voffB); PG8_STAGE(PG8_SA(1, 0), a3, voffA);
            PG8_WAIT_V(8); PG8_WAIT_L(0); PG8_BAR; PG8_MMA(1, 0, At, B0); PG8_MMA(1, 1, At, B1); PG8_BAR; PG8_SCHED;
            } else {
            PG8_LDB(B0, 0, 0); PG8_SCHED; PG8_LDA(At, 0, 0); PG8_STAGE(PG8_SA(1, 1), a1 + hstepA, voffA);
            PG8_WAIT_L(8); PG8_BAR; PG8_WAIT_L(0); PG8_MMA(0, 0, At, B0); PG8_BAR; PG8_SCHED;
            PG8_LDB(B1, 0, 1); PG8_STAGE(PG8_SB(0, 0), b2, voffB);
            PG8_BAR; PG8_WAIT_L(0); PG8_MMA(0, 1, At, B1); PG8_BAR;
            PG8_LDA(At, 0, 1); PG8_STAGE(PG8_SA(0, 0), a2, voffA);
            PG8_BAR; PG8_WAIT_L(0); PG8_MMA(1, 0, At, B0); PG8_BAR; PG8_SCHED;
            PG8_STAGE(PG8_SB(0, 1), b2 + hstepB, voffB);
            PG8_WAIT_V(6); PG8_BAR; PG8_MMA(1, 1, At, B1); PG8_BAR;
            PG8_LDB(B0, 1, 0); PG8_SCHED; PG8_LDA(At, 1, 0); PG8_STAGE(PG8_SA(0, 1), a2 + hstepA, voffA);
            PG8_WAIT_L(8); PG8_BAR; PG8_WAIT_L(0); PG8_MMA(0, 0, At, B0); PG8_BAR; PG8_SCHED;
            PG8_LDB(B1, 1, 1); PG8_STAGE(PG8_SB(1, 0), b3, voffB);
            PG8_BAR; PG8_WAIT_L(0); PG8_MMA(0, 1, At, B1); PG8_BAR;
            PG8_LDA(At, 1, 1); PG8_STAGE(PG8_SA(1, 0), a3, voffA);
            PG8_BAR; PG8_WAIT_L(0); PG8_MMA(1, 0, At, B0); PG8_BAR; PG8_SCHED;
            PG8_STAGE(PG8_SB(1, 1), b3 + hstepB, voffB);
            PG8_WAIT_V(6); PG8_BAR; PG8_MMA(1, 1, At, B1); PG8_BAR;
            }
        }
        if constexpr (ALIGN_EPI) { if (wr == 0) PG8_BAR; }
        if constexpr (!Epi::AFTER_DRAIN) { E(acc, cur, wr, wc, fr, fq); S.done(cur); }
        if (!has_next) break;
#pragma unroll
        for (int a = 0; a < 2; ++a)
#pragma unroll
            for (int b = 0; b < 2; ++b)
#pragma unroll
                for (int m = 0; m < 4; ++m)
#pragma unroll
                    for (int n = 0; n < 2; ++n) acc[a][b][m][n] = (f32x4){0.f, 0.f, 0.f, 0.f};
        cur = nxt; cA = nA; cB = nB; ++ui;
        if constexpr (ALIGN_EPI) { if (wr == 1) PG8_BAR; }
    }
    PG8_WAIT_V(0);
    if constexpr (!ALIGN_EPI) { if (wr == 0) PG8_BAR; }
    PG8_BAR;
    if constexpr (Epi::AFTER_DRAIN) { E.fused(acc, cur, wr, wc, fr, fq, lds, wid, lane); S.done(cur); }
#undef PG8_SA
#undef PG8_SB
#undef PG8_STAGE
#undef PG8_LDA
#undef PG8_LDB
#undef PG8_MMA
#undef PG8_WAIT_V
#undef PG8_WAIT_L
#undef PG8_BAR
#undef PG8_SCHED
}
}

#ifndef MK_EXP_OLD
#define MK_EXP_OLD 0
#endif
#ifndef MK_ONE_LAUNCH
#define MK_ONE_LAUNCH 1
#endif
#define LAS __attribute__((address_space(3)))
typedef unsigned short bf16;
typedef unsigned v4u __attribute__((ext_vector_type(4)));
typedef unsigned v2u __attribute__((ext_vector_type(2)));
typedef float f32x4 __attribute__((ext_vector_type(4)));
typedef float f32x2 __attribute__((ext_vector_type(2)));

constexpr int D = 1024, NB = 8, SEQ = 2048, LC = 256, ML = NB * SEQ  , MC = NB * LC  , MT = ML + MC  ;
constexpr int PROJ = 2576, NPROJ = 2560;
constexpr int NEXP = 16384, TOPK = 16, KK = 128;
constexpr float EPS = 1e-6f;
constexpr int NTHREADS = 512, NWAVES = 8;
constexpr int LDS_BYTES = 147456;
constexpr int NPHASES = 15;

constexpr size_t MiB = 1u << 20;
constexpr size_t WS_CTL = 0;
constexpr size_t CTL_ZERO_BYTES = 65536;
constexpr int CW_BAR = 0;
constexpr int CW_E1 = 4096, CW_E2 = 4096 + 8 * 64;
constexpr size_t WS_MOD = 1 * MiB;
constexpr size_t WS_LP = 1 * MiB + 512 * 1024;
constexpr size_t WS_WIN = 2 * MiB;
constexpr size_t WS_WOUT = 8 * MiB;
constexpr size_t WS_WGLU = 10 * MiB;
constexpr size_t WS_WQ = 11 * MiB;
constexpr size_t WS_GB = 15 * MiB;
constexpr size_t WS_BB = 17 * MiB;
constexpr size_t WS_PM = 41 * MiB;
constexpr size_t WS_OG = 17 * MiB;
constexpr size_t WS_HX2 = 17 * MiB;
constexpr size_t WS_U5 = 49 * MiB;
constexpr size_t WS_CAT = 49 * MiB;
constexpr size_t WS_IDX = 49 * MiB;
constexpr size_t WS_GATE = 57 * MiB;
constexpr size_t WS_ACT = 65 * MiB;
constexpr size_t WS_SSQP = 73 * MiB;
constexpr size_t WS_Z = 85 * MiB;
constexpr size_t WS_YRAW = 85 * MiB;
constexpr size_t WS_QP = 85 * MiB;
constexpr size_t WS_Y = 85 * MiB;
constexpr size_t WS_HX = 101 * MiB;
constexpr size_t WS_SS = 101 * MiB;
constexpr size_t WS_YG = 101 * MiB;
constexpr size_t WS_FRT = 125 * MiB;
constexpr size_t WS_QKVPRE = 137 * MiB;
constexpr size_t WS_FRA = 143 * MiB;
constexpr size_t WS_FRK = 161 * MiB;
constexpr size_t WS_FRTAB = 197 * MiB;
constexpr size_t WS_QKV = 202 * MiB;
constexpr size_t WS_U8 = 202 * MiB;
constexpr size_t WS_V8 = 218 * MiB;
constexpr size_t WS_USC = 234 * MiB;
constexpr size_t WS_VSC = 234 * MiB + 512 * 1024;
constexpr size_t WS_END = 256 * MiB;
static_assert(WS_BB + (size_t)32 * 512 * 768 * 2 <= WS_PM && WS_PM + (size_t)32 * 256 * 512 * 2 <= WS_U5 && WS_U5 + (size_t)32 * 768 * 768 * 2 <= WS_Z && WS_Z + (size_t)ML * 512 * 2 <= WS_HX, "ws map a");
static_assert(WS_HX + (size_t)MT * D * 2 <= WS_QKVPRE && WS_SS + (size_t)32 * 768 * 256 * 4 <= WS_FRT && WS_QKVPRE + (size_t)MT * 1536 * 2 <= WS_QKV && WS_QKV + (size_t)MT * 1536 * 2 <= WS_END, "ws map b");
static_assert(WS_FRT + (size_t)2304 * 8192 <= WS_FRA && WS_FRA + (size_t)2304 * 8192 <= WS_FRK && WS_FRK + (size_t)2304 * 16384 <= WS_FRTAB && WS_FRTAB + (size_t)2304 * 1024 <= WS_QKV, "ws map c");
static_assert(WS_OG + (size_t)2 * ML * 512 * 2 <= WS_CAT && WS_CAT + (size_t)ML * D * 2 <= WS_Z && WS_YRAW + (size_t)ML * D * 4 <= WS_U8 && WS_SSQP + (size_t)8 * ML * 4 <= WS_Z && WS_YG + (size_t)ML * 512 * 2 <= WS_FRT, "ws map d");

__device__ __forceinline__ unsigned f2bf(float f) { unsigned u = __builtin_bit_cast(unsigned, f); return (u + 0x7fffu + ((u >> 16) & 1u)) >> 16; }
typedef __bf16 bf16x2_t __attribute__((ext_vector_type(2)));
__device__ __forceinline__ unsigned pk2(float lo, float hi) { const f32x2 v = {lo, hi}; return __builtin_bit_cast(unsigned, __builtin_convertvector(v, bf16x2_t)); }
__device__ __forceinline__ float bflo(unsigned w) { return __builtin_bit_cast(float, w << 16); }
__device__ __forceinline__ float bfhi(unsigned w) { return __builtin_bit_cast(float, w & 0xffff0000u); }
__device__ __forceinline__ float bf1(bf16 h) { return __builtin_bit_cast(float, (unsigned)h << 16); }
__device__ __forceinline__ float wave_sum(float v) {
#pragma unroll
    for (int o = 1; o < 64; o <<= 1) v += __shfl_xor(v, o);
    return v;
}
__device__ __forceinline__ float wave_max(float v) {
#pragma unroll
    for (int o = 1; o < 64; o <<= 1) v = fmaxf(v, __shfl_xor(v, o));
    return v;
}
__device__ __forceinline__ float sigmoidf_(float x) { return 1.f / (1.f + __expf(-x)); }
__device__ __forceinline__ float siluf_(float x) { return x / (1.f + __expf(-x)); }
__device__ __forceinline__ float gelu_erf(float x) { return 0.5f * x * (1.f + erff(x * 0.70710678118654752f)); }
__device__ __forceinline__ void sincos_d(double a, float& s, float& c) {
    const double k = rint(a * 0.63661977236758134308);
    const double r = fma(-k, 1.57079632679489661923, a) - k * 6.123233995736766e-17;
    const double r2 = r * r;
    double sp = -2.5052108385441720e-08; sp = sp * r2 + 2.7557319223985893e-06; sp = sp * r2 - 1.9841269841269841e-04; sp = sp * r2 + 8.3333333333333332e-03; sp = sp * r2 - 1.6666666666666666e-01;
    const double sn = r + r * r2 * sp;
    double cp = 2.0876756987868099e-09; cp = cp * r2 - 2.7557319223985888e-07; cp = cp * r2 + 2.4801587301587302e-05; cp = cp * r2 - 1.3888888888888889e-03; cp = cp * r2 + 4.1666666666666664e-02; cp = cp * r2 - 0.5;
    const double cs = 1.0 + r2 * cp;
    const int q = ((int)k) & 3;
    const double ss = (q == 0) ? sn : (q == 1) ? cs : (q == 2) ? -sn : -cs;
    const double cc = (q == 0) ? cs : (q == 1) ? -sn : (q == 2) ? -cs : sn;
    s = (float)ss; c = (float)cc;
}

struct Args { const float* in[29]; float* out; unsigned char* ws; int ph_lo, ph_hi; };
static_assert(sizeof(Args) == 29 * 8 + 8 + 8 + 8, "Args has no padding");
enum { I_X = 0, I_C, I_CTX, I_CCTX, I_WMOD, I_BMOD, I_GPREMIX, I_GPOSTMIX, I_GPREFFN, I_GPOSTFFN, I_WIN, I_WOUT, I_LAMRE, I_LAMIM, I_LOGDT, I_BRE, I_BIM, I_CRE, I_CIM, I_S5D, I_WGLU,
       I_CONV, I_ALOG, I_DTBIAS, I_GDNNORM, I_WQ, I_KEYS, I_PU, I_PV };

__device__ __forceinline__ const float* in_row(const Args& a, int row) { return row < ML ? a.in[I_X] + (size_t)row * D : a.in[I_CTX] + (size_t)(row - ML) * D; }
__device__ __forceinline__ int mod_row(int row) { return row < ML ? (row >> 11) : 8; }

template <int CTRL> __device__ __forceinline__ float dppf(float v) { return __builtin_bit_cast(float, __builtin_amdgcn_update_dpp(0, __builtin_bit_cast(int, v), CTRL, 0xf, 0xf, true)); }
__device__ __forceinline__ float row_sum16(float v) { v += dppf<0xB1>(v); v += dppf<0x4E>(v); v += dppf<0x141>(v); v += dppf<0x140>(v); return v; }
__device__ __forceinline__ float row_max16(float v) { v = fmaxf(v, dppf<0xB1>(v)); v = fmaxf(v, dppf<0x4E>(v)); v = fmaxf(v, dppf<0x141>(v)); v = fmaxf(v, dppf<0x140>(v)); return v; }
__device__ __forceinline__ float wsum(float v) { v = row_sum16(v); return
    __builtin_bit_cast(float, __builtin_amdgcn_readlane(__builtin_bit_cast(int, v), 0)) + __builtin_bit_cast(float, __builtin_amdgcn_readlane(__builtin_bit_cast(int, v), 16)) +
    __builtin_bit_cast(float, __builtin_amdgcn_readlane(__builtin_bit_cast(int, v), 32)) + __builtin_bit_cast(float, __builtin_amdgcn_readlane(__builtin_bit_cast(int, v), 48)); }
__device__ __forceinline__ float wmax(float v) { v = row_max16(v); return fmaxf(fmaxf(__builtin_bit_cast(float, __builtin_amdgcn_readlane(__builtin_bit_cast(int, v), 0)), __builtin_bit_cast(float, __builtin_amdgcn_readlane(__builtin_bit_cast(int, v), 16))),
    fmaxf(__builtin_bit_cast(float, __builtin_amdgcn_readlane(__builtin_bit_cast(int, v), 32)), __builtin_bit_cast(float, __builtin_amdgcn_readlane(__builtin_bit_cast(int, v), 48)))); }
__device__ __forceinline__ int lane_rank(unsigned long long m) { return __builtin_amdgcn_mbcnt_hi((unsigned)(m >> 32), __builtin_amdgcn_mbcnt_lo((unsigned)m, 0)); }
__device__ __forceinline__ unsigned fkey(float f) { const unsigned u = __builtin_bit_cast(unsigned, f); return u ^ ((unsigned)((int)u >> 31) | 0x80000000u); }
#define WAVE_LDS_SYNC() do { __builtin_amdgcn_fence(__ATOMIC_RELEASE, "wavefront"); __builtin_amdgcn_wave_barrier(); __builtin_amdgcn_fence(__ATOMIC_ACQUIRE, "wavefront"); } while (0)
template <int N> __device__ __forceinline__ unsigned kth_key(const unsigned (&k)[N], int K) {
    unsigned T = 0;
    for (int bit = 31; bit >= 0; --bit) { const unsigned cand = T | (1u << bit); int cnt = 0;
#pragma unroll
        for (int n = 0; n < N; ++n) cnt += __popcll(__ballot(k[n] >= cand));
        if (cnt >= K) T = cand;
        if (cnt == K) break; }
    return T;
}

namespace pg8 {
struct EpiInProj {
    static constexpr bool PERM = true, AFTER_DRAIN = false;
    bf16_t* U; bf16_t* QKV; bf16_t* Z;
    __device__ __forceinline__ void operator()(const f32x4 (&acc)[2][2][4][2], const Unit& u, int wr, int wc, int fr, int fq) const {
        bf16_t* base; int ld, colt; bool lat_only = false;
        const bool s5 = u.pn < 2;
        if (s5) { base = U; ld = 0; colt = u.pn * BM; }
        else if (u.pn < 8) { base = QKV; ld = 1536; colt = (u.pn - 2) * BM; }
        else { base = Z; ld = 512; colt = (u.pn - 8) * BM; lat_only = true; }
        const int row0 = u.pm * BM + wr * 64 + fr, col0 = colt + wc * 32 + 8 * fq;
#pragma unroll
        for (int ai = 0; ai < 2; ++ai)
#pragma unroll
            for (int m = 0; m < 4; ++m) { const int row = row0 + ai * HALF + m * 16; bf16_t* rowp = base + (size_t)row * ld + col0;
                if (lat_only && row >= 16384) continue;
                if (s5) { const int R = row < 16384 ? (row >> 5) : 512 + ((row - 16384) >> 5), ii = row & 31; rowp = base + (size_t)R * 768 + ii * 16 + (col0 & 15); }
#pragma unroll
                for (int bj = 0; bj < 2; ++bj) { const f32x4 v0 = acc[ai][bj][m][0], v1 = acc[ai][bj][m][1];
                    u32x4 w; w.x = cvt_pk_bf16(v0[0], v0[1]); w.y = cvt_pk_bf16(v0[2], v0[3]); w.z = cvt_pk_bf16(v1[0], v1[1]); w.w = cvt_pk_bf16(v1[2], v1[3]);
                    if (s5) *(u32x4*)(rowp + (size_t)((col0 + bj * HALF) >> 4) * (768 * 768)) = w; else *(u32x4*)(rowp + bj * HALF) = w; } }
    }
};
struct EpiGlu {
    static constexpr bool PERM = true, AFTER_DRAIN = false;
    const bf16_t* YG; bf16_t* CAT;
    __device__ __forceinline__ void operator()(const f32x4 (&acc)[2][2][4][2], const Unit& u, int wr, int wc, int fr, int fq) const {
        const int row0 = u.pm * BM + wr * 64 + fr, col0 = u.pn * BM + wc * 32 + 8 * fq;
#pragma unroll
        for (int ai = 0; ai < 2; ++ai)
#pragma unroll
            for (int m = 0; m < 4; ++m) { const int row = row0 + ai * HALF + m * 16;
#pragma unroll
                for (int bj = 0; bj < 2; ++bj) { const f32x4 v0 = acc[ai][bj][m][0], v1 = acc[ai][bj][m][1];
                    const u32x4 y = *(const u32x4*)(YG + (size_t)row * 512 + col0 + bj * HALF);
                    float o[8]; const float a[8] = {v0[0], v0[1], v0[2], v0[3], v1[0], v1[1], v1[2], v1[3]};
                    const unsigned yw[4] = {y.x, y.y, y.z, y.w};
#pragma unroll
                    for (int e = 0; e < 8; ++e) { const float yv = __builtin_bit_cast(float, (e & 1) ? (yw[e >> 1] & 0xffff0000u) : (yw[e >> 1] << 16)); o[e] = yv / (1.f + __expf(-a[e])); }
                    u32x4 w; w.x = cvt_pk_bf16(o[0], o[1]); w.y = cvt_pk_bf16(o[2], o[3]); w.z = cvt_pk_bf16(o[4], o[5]); w.w = cvt_pk_bf16(o[6], o[7]);
                    *(u32x4*)(CAT + (size_t)row * 1024 + col0 + bj * HALF) = w; } }
    }
};
struct EpiF32 {
    static constexpr bool PERM = false, AFTER_DRAIN = false;
    float* C; int ldc;
    __device__ __forceinline__ void operator()(const f32x4 (&acc)[2][2][4][2], const Unit& u, int wr, int wc, int fr, int fq) const {
        const int row0 = u.pm * BM + wr * 64 + fr, col0 = u.pn * BM + wc * 32 + 4 * fq;
#pragma unroll
        for (int ai = 0; ai < 2; ++ai)
#pragma unroll
            for (int m = 0; m < 4; ++m) { float* rowp = C + (size_t)(row0 + ai * HALF + m * 16) * ldc + col0;
#pragma unroll
                for (int bj = 0; bj < 2; ++bj)
#pragma unroll
                    for (int n = 0; n < 2; ++n) *(f32x4*)(rowp + bj * HALF + n * 16) = acc[ai][bj][m][n]; }
    }
};
struct EpiSS {
    static constexpr bool PERM = false, AFTER_DRAIN = false;
    float* C;
    __device__ __forceinline__ void operator()(const f32x4 (&acc)[2][2][4][2], const Unit& u, int wr, int wc, int fr, int fq) const {
        const int row0 = u.pm * BM + wr * 64 + fr, col0 = wc * 32 + 4 * fq;
#pragma unroll
        for (int ai = 0; ai < 2; ++ai)
#pragma unroll
            for (int m = 0; m < 4; ++m) { float* rowp = C + (size_t)(row0 + ai * HALF + m * 16) * 256 + col0;
#pragma unroll
                for (int bj = 0; bj < 2; ++bj)
#pragma unroll
                    for (int n = 0; n < 2; ++n) *(f32x4*)(rowp + bj * HALF + n * 16) = acc[ai][bj][m][n]; }
    }
};
struct SchedSS { int G, c; __device__ bool next(int i, Unit& u) const { const int L = i * G + c; if (L >= 96) return false; u.pm = L; u.pn = L / 3; return true; }
    __device__ __forceinline__ void a_ready(const Unit&) const {} __device__ __forceinline__ void done(const Unit&) const {} };
struct EpiS5Y {
    static constexpr bool PERM = true, AFTER_DRAIN = false;
    bf16_t* YG;
    __device__ __forceinline__ void operator()(const f32x4 (&acc)[2][2][4][2], const Unit& u, int wr, int wc, int fr, int fq) const {
        const int g = u.pn >> 1, R0 = (u.pm - 3 * g) * BM + wr * 64 + fr, n0 = (u.pn & 1) * BM + wc * 32 + 8 * fq;
#pragma unroll
        for (int ai = 0; ai < 2; ++ai)
#pragma unroll
            for (int m = 0; m < 4; ++m) { const int R = R0 + ai * HALF + m * 16;
#pragma unroll
                for (int bj = 0; bj < 2; ++bj) { const int n = n0 + bj * HALF; const f32x4 v0 = acc[ai][bj][m][0], v1 = acc[ai][bj][m][1];
                    const f32x2 a = gelu_pk((f32x2){v0[0], v0[1]}), b = gelu_pk((f32x2){v0[2], v0[3]}), c2 = gelu_pk((f32x2){v1[0], v1[1]}), d = gelu_pk((f32x2){v1[2], v1[3]});
                    u32x4 w; w.x = cvt_pk_bf16(a.x, a.y); w.y = cvt_pk_bf16(b.x, b.y); w.z = cvt_pk_bf16(c2.x, c2.y); w.w = cvt_pk_bf16(d.x, d.y);
                    *(u32x4*)(YG + (size_t)(R * 32 + (n >> 4)) * 512 + g * 16 + (n & 15)) = w; } }
    }
};
struct SchedS5Y { int G, c; __device__ bool next(int i, Unit& u) const { const int L = i * G + c; if (L >= 128) return false; const int g = L >> 2; u.pm = 3 * g + ((L >> 1) & 1); u.pn = 2 * g + (L & 1); return true; }
    __device__ __forceinline__ void a_ready(const Unit&) const {} __device__ __forceinline__ void done(const Unit&) const {} };
}

struct Ctx { const Args* a; unsigned char* ws; unsigned char* lds; int tid, lane, wave, bid, G, gw, NGW, gwv; };

__device__ __forceinline__ void p0_transpose_item(const float* W, int ldw, int nblk, int K, bf16* WT, float* scr, int item, int lane) {
    const int kb = item / nblk, nb = item % nblk, k0 = 64 * kb, n0 = 32 * nb;
#pragma unroll 8
    for (int i = 0; i < 32; ++i) { const int kk = 2 * i + (lane >> 5); scr[kk * 33 + (lane & 31)] = W[(size_t)(k0 + kk) * ldw + n0 + (lane & 31)]; }
    __builtin_amdgcn_fence(__ATOMIC_RELEASE, "wavefront"); __builtin_amdgcn_wave_barrier(); __builtin_amdgcn_fence(__ATOMIC_ACQUIRE, "wavefront");
    const int c = lane & 7;
#pragma unroll
    for (int j = 0; j < 4; ++j) { const int n = (lane >> 3) + 8 * j; const float* s = scr + (8 * c) * 33 + n;
        v4u o; o.x = pk2(s[0 * 33], s[1 * 33]); o.y = pk2(s[2 * 33], s[3 * 33]); o.z = pk2(s[4 * 33], s[5 * 33]); o.w = pk2(s[6 * 33], s[7 * 33]);
        *(v4u*)(WT + (size_t)(n0 + n) * K + k0 + 8 * c) = o; }
    __builtin_amdgcn_fence(__ATOMIC_RELEASE, "wavefront"); __builtin_amdgcn_wave_barrier(); __builtin_amdgcn_fence(__ATOMIC_ACQUIRE, "wavefront");
}
__device__ __forceinline__ void phase_prep(const Ctx& c) {
    const Args& a = *c.a;
    float* scr = (float*)(c.lds + c.wave * 16384);
    constexpr int I_IN = 16 * 80, I_OUT = 16 * 32, I_GLU = 8 * 16, I_Q = 16 * 64;
    for (int it = c.gw; it < I_IN + I_OUT + I_GLU + I_Q; it += c.NGW) {
        int r = it;
        if (r < I_IN) { p0_transpose_item(a.in[I_WIN], PROJ, 80, 1024, (bf16*)(c.ws + WS_WIN), scr, r, c.lane); continue; } r -= I_IN;
        if (r < I_OUT) { p0_transpose_item(a.in[I_WOUT], 1024, 32, 1024, (bf16*)(c.ws + WS_WOUT), scr, r, c.lane); continue; } r -= I_OUT;
        if (r < I_GLU) { p0_transpose_item(a.in[I_WGLU], 512, 16, 512, (bf16*)(c.ws + WS_WGLU), scr, r, c.lane); continue; } r -= I_GLU;
        p0_transpose_item(a.in[I_WQ], 2048, 64, 1024, (bf16*)(c.ws + WS_WQ), scr, r, c.lane);
    }
    __syncthreads();
    float* sc = (float*)c.lds;
    float* red = (float*)(c.lds + 9 * 1024 * 4);
    float* MOD = (float*)(c.ws + WS_MOD);
    bool have = false;
    for (int item = c.bid; item < 96; item += c.G) {
        if (!have) { for (int i = c.tid; i < 9 * 1024; i += NTHREADS) { const int r = i >> 10, k = i & 1023; const float v = r < 8 ? a.in[I_C][r * 1024 + k] : a.in[I_CCTX][k]; sc[i] = siluf_(v); } have = true; __syncthreads(); }
        const int n0 = item * 64;
        float acc[9];
#pragma unroll
        for (int r = 0; r < 9; ++r) acc[r] = 0.f;
        const float* wp = a.in[I_WMOD] + (size_t)(c.wave * 128) * 6144 + n0 + c.lane;
#pragma unroll 4
        for (int k = 0; k < 128; ++k) { const float w = wp[(size_t)k * 6144];
#pragma unroll
            for (int r = 0; r < 9; ++r) acc[r] = fmaf(sc[r * 1024 + c.wave * 128 + k], w, acc[r]); }
#pragma unroll
        for (int r = 0; r < 9; ++r) red[(c.wave * 9 + r) * 64 + c.lane] = acc[r];
        __syncthreads();
        for (int i = c.tid; i < 576; i += NTHREADS) { const int r = i >> 6, l = i & 63; float s = a.in[I_BMOD][n0 + l];
#pragma unroll
            for (int w = 0; w < 8; ++w) s += red[(w * 9 + r) * 64 + l];
            MOD[r * 6144 + n0 + l] = s; }
        __syncthreads();
    }
}
__device__ __forceinline__ void s5_build_group(const Ctx& c, int g, int part);
__device__ __forceinline__ void phase_s5_build(const Ctx& c) { for (int it = c.bid; it < 256; it += c.G) s5_build_group(c, it >> 3, it & 7); }

__device__ __forceinline__ void phase_norm1(const Ctx& c) {
    const Args& a = *c.a;
    float* wabT = (float*)c.lds;
    for (int i = c.tid; i < 1024 * 16; i += NTHREADS) { const int k = i >> 4, j = i & 15; wabT[j * 1028 + k] = a.in[I_WIN][(size_t)k * PROJ + NPROJ + j]; }
    __syncthreads();
    const float* MOD = (const float*)(c.ws + WS_MOD);
    bf16* HX = (bf16*)(c.ws + WS_HX); float* GB = (float*)(c.ws + WS_GB);
    const float* gpre = a.in[I_GPREMIX];
    for (int row = c.gw; row < MT; row += c.NGW) {
        const f32x4* xr = (const f32x4*)in_row(a, row) + c.lane;
        const float* mr = MOD + mod_row(row) * 6144;
        f32x4 v[4]; float ss = 0.f;
#pragma unroll
        for (int j = 0; j < 4; ++j) { v[j] = xr[64 * j]; ss += (v[j].x * v[j].x + v[j].y * v[j].y) + (v[j].z * v[j].z + v[j].w * v[j].w); }
        const float r = rsqrtf(wave_sum(ss) * (1.f / D) + EPS);
#pragma unroll
        for (int j = 0; j < 4; ++j) { const int col = 4 * c.lane + 256 * j;
            const f32x4 g4 = *(const f32x4*)(gpre + col), sh = *(const f32x4*)(mr + col), scl = *(const f32x4*)(mr + 1024 + col);
            v[j] = (v[j] * r) * g4 * (scl + 1.f) + sh;
            v2u o; o.x = pk2(v[j].x, v[j].y); o.y = pk2(v[j].z, v[j].w);
            *(v2u*)(HX + (size_t)row * D + col) = o; }
        float mine = 0.f;
#pragma unroll 1
        for (int j = 0; j < 16; ++j) { float s = 0.f;
#pragma unroll
            for (int jj = 0; jj < 4; ++jj) { const f32x4 w = *(const f32x4*)(wabT + j * 1028 + 4 * c.lane + 256 * jj); s += (v[jj].x * w.x + v[jj].y * w.y) + (v[jj].z * w.z + v[jj].w * w.w); }
            s = wave_sum(s); mine = (c.lane == j) ? s : mine; }
        if (c.lane < 8) { const float t = mine + a.in[I_DTBIAS][c.lane]; const float sp = t > 20.f ? t : log1pf(expf(t)); GB[(size_t)row * 16 + c.lane] = -expf(a.in[I_ALOG][c.lane]) * sp; }
        else if (c.lane < 16) GB[(size_t)row * 16 + c.lane] = 1.f / (1.f + expf(-mine));
    }
}

__device__ __forceinline__ void phase_conv(const Ctx& c) {
    const Args& a = *c.a;
    const bf16* PRE = (const bf16*)(c.ws + WS_QKVPRE); bf16* OUT = (bf16*)(c.ws + WS_QKV);
    const float* cw = a.in[I_CONV];
#pragma unroll 1
    for (int pass = 0; pass < 3; ++pass) { const int ch0 = pass * 512 + 8 * c.lane;
        f32x4 wt[9][2];
#pragma unroll
        for (int i = 0; i < 9; ++i) { wt[i][0] = *(const f32x4*)(cw + i * 1536 + ch0); wt[i][1] = *(const f32x4*)(cw + i * 1536 + ch0 + 4); }
#pragma unroll 1
        for (int row = c.gw; row < MT; row += c.NGW) {
            int nb_row[9]; bool ok[9];
            if (row < ML) { const int t = row & 2047, gr = t >> 6, gc = t & 63;
#pragma unroll
                for (int dy = -1; dy <= 1; ++dy)
#pragma unroll
                    for (int dx = -1; dx <= 1; ++dx) { const int i = (dy + 1) * 3 + dx + 1; ok[i] = (gr + dy >= 0) && (gr + dy < 32) && (gc + dx >= 0) && (gc + dx < 64); nb_row[i] = row + dy * 64 + dx; } }
            else { const int t = (row - ML) & 255;
#pragma unroll
                for (int i = 0; i < 9; ++i) { ok[i] = false; nb_row[i] = row; }
#pragma unroll
                for (int dx = -1; dx <= 1; ++dx) { ok[4 + dx] = (t + dx >= 0) && (t + dx < 256); nb_row[4 + dx] = row + dx; } }
            v4u in[9];
#pragma unroll
            for (int i = 0; i < 9; ++i) in[i] = ok[i] ? *(const v4u*)(PRE + (size_t)nb_row[i] * 1536 + ch0) : (v4u){0u, 0u, 0u, 0u};
            float o[8];
#pragma unroll
            for (int q = 0; q < 8; ++q) o[q] = 0.f;
#pragma unroll
            for (int i = 0; i < 9; ++i) { const unsigned w[4] = {in[i].x, in[i].y, in[i].z, in[i].w}; const float kk[8] = {wt[i][0].x, wt[i][0].y, wt[i][0].z, wt[i][0].w, wt[i][1].x, wt[i][1].y, wt[i][1].z, wt[i][1].w};
#pragma unroll
                for (int q = 0; q < 4; ++q) { o[2 * q] = fmaf(bflo(w[q]), kk[2 * q], o[2 * q]); o[2 * q + 1] = fmaf(bfhi(w[q]), kk[2 * q + 1], o[2 * q + 1]); } }
            float ssq = 0.f;
#pragma unroll
            for (int q = 0; q < 8; ++q) { o[q] = siluf_(o[q]); ssq = fmaf(o[q], o[q], ssq); }
            if (pass < 2) { const float sc = rsqrtf(row_sum16(ssq) + EPS) * (pass == 0 ? 0.08838834764831845f : 1.f);
#pragma unroll
                for (int q = 0; q < 8; ++q) o[q] *= sc; }
            v4u ov; ov.x = pk2(o[0], o[1]); ov.y = pk2(o[2], o[3]); ov.z = pk2(o[4], o[5]); ov.w = pk2(o[6], o[7]);
            *(v4u*)(OUT + (size_t)row * 1536 + ch0) = ov;
        }
    }
}

__device__ __forceinline__ int scan_row(int b, int dir, int step) {
    if (step < LC) { const int t = dir ? LC - 1 - step : step; return ML + b * LC + t; }
    const int t = step - LC; return b * SEQ + (dir ? SEQ - 1 - t : t);
}
__device__ __forceinline__ void phase_combine(const Ctx& c) {
    const Args& a = *c.a;
    const bf16* OG0 = (const bf16*)(c.ws + WS_OG); const bf16* OG1 = OG0 + (size_t)ML * 512; const bf16* Z = (const bf16*)(c.ws + WS_Z);
    bf16* CAT = (bf16*)(c.ws + WS_CAT);
    for (int row = c.gw; row < ML; row += c.NGW) {
#pragma unroll
        for (int h = 0; h < 4; ++h) { const int ch = h * 128 + 2 * c.lane;
            const unsigned w0 = *(const unsigned*)(OG0 + (size_t)row * 512 + ch), w1 = *(const unsigned*)(OG1 + (size_t)row * 512 + ch), zw = *(const unsigned*)(Z + (size_t)row * 512 + ch);
            const float o0 = bflo(w0) + bflo(w1), o1 = bfhi(w0) + bfhi(w1);
            const float r = rsqrtf(wave_sum(o0 * o0 + o1 * o1) * (1.f / 128.f) + EPS);
            const f32x2 ng = *(const f32x2*)(a.in[I_GDNNORM] + 2 * c.lane);
            *(unsigned*)(CAT + (size_t)row * 1024 + 512 + ch) = pk2(o0 * r * ng.x * siluf_(bflo(zw)), o1 * r * ng.y * siluf_(bfhi(zw))); }
    }
}

__device__ __forceinline__ void phase_rows2(const Ctx& c) {
    const Args& a = *c.a;
    const float* MOD = (const float*)(c.ws + WS_MOD); const float* YRAW = (const float*)(c.ws + WS_YRAW); bf16* HX2 = (bf16*)(c.ws + WS_HX2);
    for (int row = c.gw; row < ML; row += c.NGW) {
        const float* mr = MOD + (row >> 11) * 6144;
        f32x4 y[4], x[4]; float ss = 0.f;
#pragma unroll
        for (int j = 0; j < 4; ++j) { y[j] = *((const f32x4*)(YRAW + (size_t)row * D) + c.lane + 64 * j); x[j] = *((const f32x4*)(a.in[I_X] + (size_t)row * D) + c.lane + 64 * j);
            ss += (y[j].x * y[j].x + y[j].y * y[j].y) + (y[j].z * y[j].z + y[j].w * y[j].w); }
        const float r = rsqrtf(wave_sum(ss) * (1.f / D) + EPS); float s2 = 0.f;
#pragma unroll
        for (int j = 0; j < 4; ++j) { const int col = 4 * c.lane + 256 * j;
            const f32x4 g4 = *(const f32x4*)(a.in[I_GPOSTMIX] + col), gt = *(const f32x4*)(mr + 2048 + col);
            x[j] = x[j] + gt * ((y[j] * r) * g4);
            *(f32x4*)(a.out + (size_t)row * D + col) = x[j];
            s2 += (x[j].x * x[j].x + x[j].y * x[j].y) + (x[j].z * x[j].z + x[j].w * x[j].w); }
        const float r2 = rsqrtf(wave_sum(s2) * (1.f / D) + EPS);
#pragma unroll
        for (int j = 0; j < 4; ++j) { const int col = 4 * c.lane + 256 * j;
            const f32x4 g4 = *(const f32x4*)(a.in[I_GPREFFN] + col), sh = *(const f32x4*)(mr + 3072 + col), scl = *(const f32x4*)(mr + 4096 + col);
            const f32x4 hv = (x[j] * r2) * g4 * (scl + 1.f) + sh;
            v2u o; o.x = pk2(hv.x, hv.y); o.y = pk2(hv.z, hv.w);
            *(v2u*)(HX2 + (size_t)row * D + col) = o; }
    }
}


constexpr int KROW = 136;
__device__ __forceinline__ void phase_topk(const Ctx& c) {
    const Args& a = *c.a;
    bf16* kl = (bf16*)c.lds;
    unsigned char* wbase = c.lds + 2 * 128 * KROW * 2 + c.wave * 1024;
    bf16* qs = (bf16*)wbase;
    float* s1 = (float*)(wbase + 512); int* i1 = (int*)(wbase + 576); float* s2 = (float*)(wbase + 640); int* i2 = (int*)(wbase + 704); float* fs = (float*)(wbase + 768); int* fi = (int*)(wbase + 832);
    const bf16* QP = (const bf16*)(c.ws + WS_QP); int* IDX = (int*)(c.ws + WS_IDX); float* GATE = (float*)(c.ws + WS_GATE);
    for (int item = c.bid; item < 8 * 32; item += c.G) {
        const int h = item & 7, tr = item >> 3;
        __syncthreads();
        for (int i = c.tid; i < 2 * 128 * 64; i += NTHREADS) { const int k2 = i & 63, n = (i >> 6) & 127, p = i >> 13; const f32x2 kv = *(const f32x2*)(a.in[I_KEYS] + ((size_t)((h * 2 + p) * 128 + n)) * 128 + 2 * k2);
            *(unsigned*)(kl + (p * 128 + n) * KROW + 2 * k2) = pk2(kv.x, kv.y); }
        __syncthreads();
        for (int tt = c.wave; tt < 512; tt += NWAVES) {
            const int tok = tr * 512 + tt;
            *(v2u*)(qs + 4 * c.lane) = *(const v2u*)(QP + (size_t)tok * 2048 + h * 256 + 4 * c.lane);
            WAVE_LDS_SYNC();
            float sc[2][2];
#pragma unroll
            for (int p = 0; p < 2; ++p) { float sa0 = 0.f, sa1 = 0.f, sb0 = 0.f, sb1 = 0.f;
#pragma unroll 4
                for (int kk = 0; kk < 16; ++kk) { const v4u q8 = *(const v4u*)(qs + p * 128 + kk * 8), ka = *(const v4u*)(kl + (p * 128 + c.lane) * KROW + kk * 8), kb = *(const v4u*)(kl + (p * 128 + c.lane + 64) * KROW + kk * 8);
                    const unsigned qw[4] = {q8.x, q8.y, q8.z, q8.w}, aw[4] = {ka.x, ka.y, ka.z, ka.w}, bw[4] = {kb.x, kb.y, kb.z, kb.w};
#pragma unroll
                    for (int e = 0; e < 4; ++e) { sa0 = fmaf(bflo(qw[e]), bflo(aw[e]), sa0); sa1 = fmaf(bfhi(qw[e]), bfhi(aw[e]), sa1); sb0 = fmaf(bflo(qw[e]), bflo(bw[e]), sb0); sb1 = fmaf(bfhi(qw[e]), bfhi(bw[e]), sb1); } }
                sc[p][0] = sa0 + sa1; sc[p][1] = sb0 + sb1; }
#pragma unroll
            for (int p = 0; p < 2; ++p) { float* so = p ? s2 : s1; int* io = p ? i2 : i1;
                const unsigned ky[2] = {fkey(sc[p][0]), fkey(sc[p][1])};
                const unsigned T = kth_key<2>(ky, 16);
                int cgt = 0;
#pragma unroll
                for (int n = 0; n < 2; ++n) cgt += __popcll(__ballot(ky[n] > T));
                const int need = 16 - cgt; int base = 0, eqb = 0;
#pragma unroll
                for (int n = 0; n < 2; ++n) { const bool eq = ky[n] == T; const unsigned long long em = __ballot(eq); const bool sel = (ky[n] > T) || (eq && (eqb + lane_rank(em)) < need);
                    const unsigned long long sm = __ballot(sel); if (sel) { const int pos = base + lane_rank(sm); so[pos] = sc[p][n]; io[pos] = c.lane + 64 * n; }
                    base += __popcll(sm); eqb += __popcll(em); } }
            WAVE_LDS_SYNC();
            { const int ci = c.lane >> 2, cj = 4 * (c.lane & 3);
              float cv[4]; unsigned ky[4]; const float b1 = s1[ci];
#pragma unroll
              for (int e = 0; e < 4; ++e) { cv[e] = b1 + s2[cj + e]; ky[e] = fkey(cv[e]); }
              const unsigned T = kth_key<4>(ky, 16);
              int cgt = 0;
#pragma unroll
              for (int e = 0; e < 4; ++e) cgt += __popcll(__ballot(ky[e] > T));
              const int need = 16 - cgt; int base = 0, eqb = 0; const int e1 = i1[ci] * 128;
#pragma unroll
              for (int e = 0; e < 4; ++e) { const bool eq = ky[e] == T; const unsigned long long em = __ballot(eq); const bool sel = (ky[e] > T) || (eq && (eqb + lane_rank(em)) < need);
                  const unsigned long long sm = __ballot(sel); if (sel) { const int pos = base + lane_rank(sm); fs[pos] = cv[e]; fi[pos] = e1 + i2[cj + e]; }
                  base += __popcll(sm); eqb += __popcll(em); } }
            WAVE_LDS_SYNC();
            { const float v = fs[c.lane & 15]; const float mx = row_max16(v); const float ex = __expf(v - mx); const float den = row_sum16(ex);
              if (c.lane < 16) { IDX[(size_t)tok * 128 + h * 16 + c.lane] = fi[c.lane]; GATE[(size_t)tok * 128 + h * 16 + c.lane] = ex / den; } }
            WAVE_LDS_SYNC();
        }
    }
}

__device__ __forceinline__ void phase_fp8_tables(const Ctx& c) {
    const Args& a = *c.a;
    for (int r = c.gw; r < 2 * NEXP; r += c.NGW) {
        const bool isv = r >= NEXP; const int e = isv ? r - NEXP : r;
        const f32x4* src = (const f32x4*)((isv ? a.in[I_PV] : a.in[I_PU]) + (size_t)e * D) + 4 * c.lane;
        f32x4 v[4]; float m = 0.f;
#pragma unroll
        for (int j = 0; j < 4; ++j) { v[j] = src[j]; m = fmaxf(m, fmaxf(fmaxf(fabsf(v[j].x), fabsf(v[j].y)), fmaxf(fabsf(v[j].z), fabsf(v[j].w)))); }
        m = wmax(m); const float inv = m > 0.f ? 256.f / m : 0.f;
        v4u o; unsigned ow[4];
#pragma unroll
        for (int j = 0; j < 4; ++j) { int w = __builtin_amdgcn_cvt_pk_fp8_f32(v[j].x * inv, v[j].y * inv, 0, false); w = __builtin_amdgcn_cvt_pk_fp8_f32(v[j].z * inv, v[j].w * inv, w, true); ow[j] = (unsigned)w; }
        o.x = ow[0]; o.y = ow[1]; o.z = ow[2]; o.w = ow[3];
        *(v4u*)(c.ws + (isv ? WS_V8 : WS_U8) + (size_t)e * D + 16 * c.lane) = o;
        if (c.lane == 0) ((float*)(c.ws + (isv ? WS_VSC : WS_USC)))[e] = m * (1.f / 256.f);
    }
}
__device__ __forceinline__ void fp8x16_to_f32(const v4u& r, float (&f)[16]) {
    const unsigned w[4] = {r.x, r.y, r.z, r.w};
#pragma unroll
    for (int j = 0; j < 4; ++j) { const f32x2 lo = __builtin_amdgcn_cvt_pk_f32_fp8((int)w[j], false), hi = __builtin_amdgcn_cvt_pk_f32_fp8((int)w[j], true); f[4 * j] = lo.x; f[4 * j + 1] = lo.y; f[4 * j + 2] = hi.x; f[4 * j + 3] = hi.y; }
}
__device__ __forceinline__ unsigned xcc_id() { return (unsigned)__builtin_amdgcn_s_getreg((3 << 11) | 20) & 7u; }

__device__ __forceinline__ void phase_exp1(const Ctx& c) {
    const bf16* HX2 = (const bf16*)(c.ws + WS_HX2); const int* IDX = (const int*)(c.ws + WS_IDX); const float* GATE = (const float*)(c.ws + WS_GATE);
    const unsigned char* U8 = c.ws + WS_U8; const float* USC = (const float*)(c.ws + WS_USC); const float* VSC = (const float*)(c.ws + WS_VSC); float* ACT = (float*)(c.ws + WS_ACT);
    unsigned* cnt = (unsigned*)(c.ws + WS_CTL) + CW_E1;
    int* lk = (int*)(c.lds + c.wave * 1024); int* le = lk + 128;
    const int xcc = (int)xcc_id();
    constexpr int CH = 8;
    for (int bo = 0; bo < 8; ++bo) { const int x = (xcc + bo) & 7;
        for (;;) { unsigned t0 = 0; if (c.lane == 0) t0 = __hip_atomic_fetch_add(cnt + 64 * x, (unsigned)CH, __ATOMIC_RELAXED, __HIP_MEMORY_SCOPE_AGENT);
            t0 = (unsigned)__builtin_amdgcn_readfirstlane((int)t0); if (t0 >= (unsigned)ML) break;
            for (int t = (int)t0; t < (int)t0 + CH; ++t) {
                float hv[16];
                { const v4u h0 = *(const v4u*)(HX2 + (size_t)t * D + 16 * c.lane), h1 = *(const v4u*)(HX2 + (size_t)t * D + 16 * c.lane + 8); const unsigned hw[8] = {h0.x, h0.y, h0.z, h0.w, h1.x, h1.y, h1.z, h1.w};
#pragma unroll
                  for (int j = 0; j < 8; ++j) { hv[2 * j] = bflo(hw[j]); hv[2 * j + 1] = bfhi(hw[j]); } }
                const int eA = IDX[(size_t)t * 128 + c.lane], eB = IDX[(size_t)t * 128 + 64 + c.lane];
                const bool sA = (eA >> 11) == x, sB = (eB >> 11) == x; const unsigned long long mA = __ballot(sA), mB = __ballot(sB); const int nA = __popcll(mA), n = nA + __popcll(mB);
                if (sA) { const int pos = lane_rank(mA); lk[pos] = c.lane; le[pos] = eA; }
                if (sB) { const int pos = nA + lane_rank(mB); lk[pos] = c.lane + 64; le[pos] = eB; }
                WAVE_LDS_SYNC();
                for (int j0 = 0; j0 < n; j0 += 16) {
                    float p[16];
#pragma unroll
                    for (int jj = 0; jj < 16; ++jj) { const int j = j0 + jj; const int e = le[j < n ? j : 0];
                        const v4u row = *(const v4u*)(U8 + (size_t)e * D + 16 * c.lane); float f[16]; fp8x16_to_f32(row, f); float s0 = 0.f, s1 = 0.f;
#pragma unroll
                        for (int q = 0; q < 8; ++q) { s0 = fmaf(f[2 * q], hv[2 * q], s0); s1 = fmaf(f[2 * q + 1], hv[2 * q + 1], s1); }
                        p[jj] = s0 + s1; }
                    const bool b5 = c.lane & 32, b4 = c.lane & 16, b3 = c.lane & 8, b2 = c.lane & 4;
                    float q8[8], q4[4], q2[2];
#pragma unroll
                    for (int i = 0; i < 8; ++i) { const float keep = b5 ? p[i + 8] : p[i], send = b5 ? p[i] : p[i + 8]; q8[i] = keep + __shfl_xor(send, 32); }
#pragma unroll
                    for (int i = 0; i < 4; ++i) { const float keep = b4 ? q8[i + 4] : q8[i], send = b4 ? q8[i] : q8[i + 4]; q4[i] = keep + __shfl_xor(send, 16); }
#pragma unroll
                    for (int i = 0; i < 2; ++i) { const float keep = b3 ? q4[i + 2] : q4[i], send = b3 ? q4[i] : q4[i + 2]; q2[i] = keep + dppf<0x140>(send); }
                    float s; { const float keep = b2 ? q2[1] : q2[0], send = b2 ? q2[0] : q2[1]; s = keep + dppf<0x141>(send); }
                    s += dppf<0xB1>(s); s += dppf<0x4E>(s);
                    const int j = j0 + (b5 ? 8 : 0) + (b4 ? 4 : 0) + (b3 ? 2 : 0) + (b2 ? 1 : 0);
                    if (j < n && (c.lane & 3) == 0) { const int e = le[j], k = lk[j]; ACT[(size_t)t * 128 + k] = gelu_erf(s * USC[e]) * GATE[(size_t)t * 128 + k] * VSC[e]; }
                }
                WAVE_LDS_SYNC();
            } } }
}
__device__ __forceinline__ void phase_exp2(const Ctx& c) {
    const int* IDX = (const int*)(c.ws + WS_IDX); const float* ACT = (const float*)(c.ws + WS_ACT); const unsigned char* V8 = c.ws + WS_V8;
    float* Y = (float*)(c.ws + WS_Y); float* SSQP = (float*)(c.ws + WS_SSQP);
    unsigned* cnt = (unsigned*)(c.ws + WS_CTL) + CW_E2;
    const int xcc = (int)xcc_id(), sub = c.lane & 7, grp = c.lane >> 3;
    const bool b5 = c.lane & 32, b4 = c.lane & 16, b3 = c.lane & 8;
    constexpr int CH = 8;
    int bo = 0, t = 0, tend = 0;
    for (;;) {
        if (t >= tend) {
            unsigned t0 = 0; if (c.lane == 0) t0 = __hip_atomic_fetch_add(cnt + 64 * ((xcc + bo) & 7), (unsigned)CH, __ATOMIC_RELAXED, __HIP_MEMORY_SCOPE_AGENT);
            t0 = (unsigned)__builtin_amdgcn_readfirstlane((int)t0);
            if (t0 >= (unsigned)ML) { if (++bo >= 8) break; continue; }
            t = (int)t0; tend = t + CH;
        }
        const int x = (xcc + bo) & 7;
        float acc[16];
#pragma unroll
        for (int q = 0; q < 16; ++q) acc[q] = 0.f;
#pragma unroll 4
        for (int i = 0; i < 16; ++i) { const int k = 8 * i + grp; const int e = IDX[(size_t)t * 128 + k]; const float av = ACT[(size_t)t * 128 + k];
            const v4u row = *(const v4u*)(V8 + (size_t)e * D + x * 128 + 16 * sub); float f[16]; fp8x16_to_f32(row, f);
#pragma unroll
            for (int q = 0; q < 16; ++q) acc[q] = fmaf(av, f[q], acc[q]); }
        float q8[8], q4[4], q2[2];
#pragma unroll
        for (int i = 0; i < 8; ++i) { const float keep = b5 ? acc[i + 8] : acc[i], send = b5 ? acc[i] : acc[i + 8]; q8[i] = keep + __shfl_xor(send, 32); }
#pragma unroll
        for (int i = 0; i < 4; ++i) { const float keep = b4 ? q8[i + 4] : q8[i], send = b4 ? q8[i] : q8[i + 4]; q4[i] = keep + __shfl_xor(send, 16); }
#pragma unroll
        for (int i = 0; i < 2; ++i) { const float keep = b3 ? q4[i + 2] : q4[i], send = b3 ? q4[i] : q4[i + 2]; q2[i] = keep + __shfl_xor(send, 8); }
        const int col = x * 128 + 16 * sub + (b5 ? 8 : 0) + (b4 ? 4 : 0) + (b3 ? 2 : 0);
        *(f32x2*)(Y + (size_t)t * D + col) = (f32x2){q2[0], q2[1]};
        const float ss = wsum(q2[0] * q2[0] + q2[1] * q2[1]);
        SSQP[(size_t)x * ML + t] = ss;
        ++t;
    }
}
__device__ __forceinline__ void phase_exp3(const Ctx& c) {
    const Args& a = *c.a;
    const float* MOD = (const float*)(c.ws + WS_MOD); const float* Y = (const float*)(c.ws + WS_Y); const float* SSQP = (const float*)(c.ws + WS_SSQP);
    for (int row = c.gw; row < ML; row += c.NGW) {
        float ss = 0.f;
#pragma unroll
        for (int x = 0; x < 8; ++x) ss += SSQP[(size_t)x * ML + row];
        const float r = rsqrtf(ss * (1.f / D) + EPS); const float* mr = MOD + (row >> 11) * 6144 + 5120;
#pragma unroll
        for (int j = 0; j < 4; ++j) { const int col = 4 * c.lane + 256 * j;
            const f32x4 y = *(const f32x4*)(Y + (size_t)row * D + col), x1 = *(const f32x4*)(a.out + (size_t)row * D + col), g4 = *(const f32x4*)(a.in[I_GPOSTFFN] + col), gt = *(const f32x4*)(mr + col);
            *(f32x4*)(a.out + (size_t)row * D + col) = x1 + gt * ((y * r) * g4); }
    }
}

__device__ __forceinline__ void phase_experts(const Ctx& c) {
    const Args& a = *c.a;
    const float* MOD = (const float*)(c.ws + WS_MOD); const bf16* HX2 = (const bf16*)(c.ws + WS_HX2); const int* IDX = (const int*)(c.ws + WS_IDX); const float* GATE = (const float*)(c.ws + WS_GATE);
    float* acts = (float*)c.lds; int* eid = (int*)(c.lds + 512); float* red = (float*)(c.lds + 1024);
    for (int tok = c.bid; tok < ML; tok += c.G) {
        float hv[16];
#pragma unroll
        for (int j = 0; j < 4; ++j) { const v2u w = *(const v2u*)(HX2 + (size_t)tok * D + 4 * c.lane + 256 * j); hv[4 * j] = bflo(w.x); hv[4 * j + 1] = bfhi(w.x); hv[4 * j + 2] = bflo(w.y); hv[4 * j + 3] = bfhi(w.y); }
#pragma unroll 4
        for (int i = 0; i < 16; ++i) { const int k = c.wave * 16 + i; const int e = IDX[(size_t)tok * 128 + k];
            const f32x4* ur = (const f32x4*)(a.in[I_PU] + (size_t)e * D) + c.lane; float s = 0.f;
#pragma unroll
            for (int j = 0; j < 4; ++j) { const f32x4 u4 = ur[64 * j]; s += (u4.x * hv[4 * j] + u4.y * hv[4 * j + 1]) + (u4.z * hv[4 * j + 2] + u4.w * hv[4 * j + 3]); }
            s = wave_sum(s);
            if (c.lane == 0) { acts[k] = gelu_erf(s) * GATE[(size_t)tok * 128 + k]; eid[k] = e; } }
        __syncthreads();
        f32x2 acc = (f32x2){0.f, 0.f};
#pragma unroll 8
        for (int k = 0; k < 128; ++k) { const f32x2 v2 = *(const f32x2*)(a.in[I_PV] + (size_t)eid[k] * D + 2 * c.tid); const float ak = acts[k]; acc.x = fmaf(ak, v2.x, acc.x); acc.y = fmaf(ak, v2.y, acc.y); }
        const float ws = wave_sum(acc.x * acc.x + acc.y * acc.y);
        if (c.lane == 0) red[c.wave] = ws;
        __syncthreads();
        float tot = 0.f;
#pragma unroll
        for (int w = 0; w < 8; ++w) tot += red[w];
        const float r = rsqrtf(tot * (1.f / D) + EPS);
        const int col = 2 * c.tid; const float* mr = MOD + (tok >> 11) * 6144 + 5120;
        const f32x2 x1 = *(const f32x2*)(a.out + (size_t)tok * D + col), g2 = *(const f32x2*)(a.in[I_GPOSTFFN] + col), gt = *(const f32x2*)(mr + col);
        *(f32x2*)(a.out + (size_t)tok * D + col) = (f32x2){x1.x + gt.x * (acc.x * r * g2.x), x1.y + gt.y * (acc.y * r * g2.y)};
        __syncthreads();
    }
}


constexpr int S5_LPOW = 0, S5_BBAR = 33792, S5_CC = 50176, S5_MM = 66560;
__device__ __forceinline__ void s5_build_group(const Ctx& c, int g, int part) {
    const Args& a = *c.a;
    f32x2* LPOW = (f32x2*)(c.lds + S5_LPOW);
    f32x2* BBAR = (f32x2*)(c.lds + S5_BBAR);
    f32x2* CC = (f32x2*)(c.lds + S5_CC);
    float* MM = (float*)(c.lds + S5_MM);
    __syncthreads();
    if (c.tid < 128) { const int dir = c.tid >> 6, p = c.tid & 63, dg = dir * 32 + g;
        const float dt = expf(a.in[I_LOGDT][dg]), lr = a.in[I_LAMRE][dg * 64 + p], li = a.in[I_LAMIM][dg * 64 + p];
        const double ang = (double)li * (double)dt; const float lrdt = lr * dt;
        for (int e = 0; e <= 32; ++e) { float sn, cs; sincos_d(ang * (double)e, sn, cs); const float mg = expf(lrdt * (float)e); LPOW[(dir * 33 + e) * 64 + p] = (f32x2){mg * cs, mg * sn}; }
        float sn, cs; sincos_d(ang, sn, cs); const float mag = expf(lrdt), lbr = mag * cs, lbi = mag * sn, den = lr * lr + li * li, nr = lbr - 1.f;
        const float cr = (nr * lr + lbi * li) / den, ci = (lbi * lr - nr * li) / den;
        for (int ch = 0; ch < 16; ++ch) { const float br = a.in[I_BRE][(size_t)(dg * 64 + p) * 16 + ch], bi = a.in[I_BIM][(size_t)(dg * 64 + p) * 16 + ch]; BBAR[(dir * 64 + p) * 16 + ch] = (f32x2){cr * br - ci * bi, cr * bi + ci * br}; } }
    for (int i = c.tid; i < 2048; i += NTHREADS) { const int dir = i >> 10, ch = (i >> 6) & 15, p = i & 63, dg = dir * 32 + g; CC[i] = (f32x2){a.in[I_CRE][(size_t)(dg * 16 + ch) * 64 + p], a.in[I_CIM][(size_t)(dg * 16 + ch) * 64 + p]}; }
    __syncthreads();
    for (int task = c.tid; task < 1024; task += NTHREADS) { const int cpb = task & 3, cb = (task >> 2) & 3, lag = (task >> 4) & 31, dir = task >> 9;
        float acc[4][4];
#pragma unroll
        for (int i = 0; i < 4; ++i)
#pragma unroll
            for (int j = 0; j < 4; ++j) acc[i][j] = 0.f;
        for (int p = 0; p < 64; ++p) { const f32x2 l = LPOW[(dir * 33 + lag) * 64 + p]; f32x2 G[4], Cw[4];
#pragma unroll
            for (int j = 0; j < 4; ++j) { const f32x2 bb = BBAR[(dir * 64 + p) * 16 + 4 * cpb + j]; G[j] = (f32x2){l.x * bb.x - l.y * bb.y, l.x * bb.y + l.y * bb.x}; }
#pragma unroll
            for (int i = 0; i < 4; ++i) Cw[i] = CC[(dir * 16 + 4 * cb + i) * 64 + p];
#pragma unroll
            for (int i = 0; i < 4; ++i)
#pragma unroll
                for (int j = 0; j < 4; ++j) acc[i][j] += Cw[i].x * G[j].x - Cw[i].y * G[j].y; }
#pragma unroll
        for (int i = 0; i < 4; ++i)
#pragma unroll
            for (int j = 0; j < 4; ++j) MM[((dir * 32 + lag) * 16 + 4 * cb + i) * 16 + 4 * cpb + j] = acc[i][j]; }
    __syncthreads();
    if (c.tid < 128 && part == 0) { const int dir = c.tid >> 6, p = c.tid & 63; ((f32x2*)(c.ws + WS_LP))[(dir * 32 + g) * 64 + p] = LPOW[(dir * 33 + 32) * 64 + p]; }
    bf16* PMg = (bf16*)(c.ws + WS_PM) + (size_t)g * 256 * 512; bf16* BBg = (bf16*)(c.ws + WS_BB) + (size_t)g * 512 * 768;
    for (int task = part * 32 * 32 + c.tid; task < (part + 1) * 32 * 32; task += NTHREADS) { const int ip = task & 31, n = task >> 5, dir = n >> 7, im = (n >> 6) & 1, p = n & 63, e = dir ? ip : 31 - ip;
        const f32x2 l = LPOW[(dir * 33 + e) * 64 + p]; float o[16];
#pragma unroll
        for (int ch = 0; ch < 16; ++ch) { const f32x2 bb = BBAR[(dir * 64 + p) * 16 + ch]; o[ch] = im ? (l.x * bb.y + l.y * bb.x) : (l.x * bb.x - l.y * bb.y); }
        v4u w0, w1; w0.x = pk2(o[0], o[1]); w0.y = pk2(o[2], o[3]); w0.z = pk2(o[4], o[5]); w0.w = pk2(o[6], o[7]); w1.x = pk2(o[8], o[9]); w1.y = pk2(o[10], o[11]); w1.z = pk2(o[12], o[13]); w1.w = pk2(o[14], o[15]);
        *(v4u*)(PMg + (size_t)n * 512 + ip * 16) = w0; *(v4u*)(PMg + (size_t)n * 512 + ip * 16 + 8) = w1; }
    for (int task = part * 64 * 32 + c.tid; task < (part + 1) * 64 * 32; task += NTHREADS) { const int ip = task & 31, n = task >> 5, i = n >> 4, ch = n & 15; float o[16];
#pragma unroll
        for (int q = 0; q < 16; ++q) o[q] = 0.f;
        if (ip <= i) { const float* m0 = MM + ((0 * 32 + (i - ip)) * 16 + ch) * 16;
#pragma unroll
            for (int q = 0; q < 16; ++q) o[q] += m0[q]; }
        if (ip >= i) { const float* m1 = MM + ((1 * 32 + (ip - i)) * 16 + ch) * 16;
#pragma unroll
            for (int q = 0; q < 16; ++q) o[q] += m1[q]; }
        if (ip == i) { const float dsk = a.in[I_S5D][g * 16 + ch];
#pragma unroll
            for (int q = 0; q < 16; ++q) o[q] += (q == ch) ? dsk : 0.f; }
        v4u w0, w1; w0.x = pk2(o[0], o[1]); w0.y = pk2(o[2], o[3]); w0.z = pk2(o[4], o[5]); w0.w = pk2(o[6], o[7]); w1.x = pk2(o[8], o[9]); w1.y = pk2(o[10], o[11]); w1.z = pk2(o[12], o[13]); w1.w = pk2(o[14], o[15]);
        *(v4u*)(BBg + (size_t)n * 768 + ip * 16) = w0; *(v4u*)(BBg + (size_t)n * 768 + ip * 16 + 8) = w1; }
    for (int task = part * 64 * 32 + c.tid; task < (part + 1) * 64 * 32; task += NTHREADS) { const int p8 = task & 7, part = (task >> 3) & 3, n = task >> 5, i = n >> 4, ch = n & 15, dir = part >> 1, im = part & 1, e = dir ? 32 - i : i + 1; float o[8];
#pragma unroll
        for (int q = 0; q < 8; ++q) { const int p = p8 * 8 + q; const f32x2 l = LPOW[(dir * 33 + e) * 64 + p], cc = CC[(dir * 16 + ch) * 64 + p]; o[q] = im ? -(cc.x * l.y + cc.y * l.x) : (cc.x * l.x - cc.y * l.y); }
        v4u w0; w0.x = pk2(o[0], o[1]); w0.y = pk2(o[2], o[3]); w0.z = pk2(o[4], o[5]); w0.w = pk2(o[6], o[7]);
        *(v4u*)(BBg + (size_t)n * 768 + 512 + part * 64 + p8 * 8) = w0; }
}
__device__ __forceinline__ void s5_state_scan(const Ctx& c, int task) {
    const int dir = task & 1, g = (task >> 1) & 31, b = task >> 6, p = c.lane;
    const f32x2 a = ((const f32x2*)(c.ws + WS_LP))[(dir * 32 + g) * 64 + p];
    const float* SS = (const float*)(c.ws + WS_SS) + (size_t)g * 768 * 256 + dir * 128 + p; bf16* U5 = (bf16*)(c.ws + WS_U5) + (size_t)g * 768 * 768 + 512 + dir * 128 + p;
    float er = 0.f, ei = 0.f;
#pragma unroll 8
    for (int step = 0; step < 72; ++step) {
        const int R = (step < 8) ? 512 + b * 8 + (dir ? 7 - step : step) : b * 64 + (dir ? 71 - step : step - 8);
        if (step >= 8) { U5[(size_t)R * 768] = (bf16)f2bf(er); U5[(size_t)R * 768 + 64] = (bf16)f2bf(ei); }
        const float sr = SS[(size_t)R * 256], si = SS[(size_t)R * 256 + 64];
        const float nr = sr + a.x * er - a.y * ei, ni = si + a.x * ei + a.y * er; er = nr; ei = ni;
    }
}

typedef short bf16x8 __attribute__((ext_vector_type(8)));
typedef float f32x16 __attribute__((ext_vector_type(16)));
#define MFMA32(a, b, c) __builtin_amdgcn_mfma_f32_32x32x16_bf16((a), (b), (c), 0, 0, 0)
constexpr int GDN_NCH = 36, GDN_ITEMS = NB * 4 * 2 * GDN_NCH;
constexpr size_t FR_T_BYTES = 8192, FR_ATT_BYTES = 8192, FR_KD_BYTES = 16384, FR_TAB_BYTES = 1024;
__device__ __forceinline__ int crow16(int i, int hh) { return (i & 3) + 8 * (i >> 2) + 4 * hh; }
__device__ __forceinline__ bf16x8 pack_step(const f32x16& x, int s) {
    v4u w; w.x = pk2(x[8 * s + 0], x[8 * s + 1]); w.y = pk2(x[8 * s + 2], x[8 * s + 3]); w.z = pk2(x[8 * s + 4], x[8 * s + 5]); w.w = pk2(x[8 * s + 6], x[8 * s + 7]);
    return __builtin_bit_cast(bf16x8, w);
}
__device__ __forceinline__ unsigned pk2v(float lo, float hi) { asm volatile("" : "+v"(lo), "+v"(hi)); return pk2(lo, hi); }
__device__ __forceinline__ bf16x8 pack_step_v(const f32x16& x, int s) {
    v4u w; w.x = pk2v(x[8 * s + 0], x[8 * s + 1]); w.y = pk2v(x[8 * s + 2], x[8 * s + 3]); w.z = pk2v(x[8 * s + 4], x[8 * s + 5]); w.w = pk2v(x[8 * s + 6], x[8 * s + 7]);
    return __builtin_bit_cast(bf16x8, w);
}
constexpr int GP_KR = 0, GP_QR = 17408, GP_KT = 34816, GP_LM = 53248, GP_TB = 70656, GP_TAB = 79872;
__device__ __forceinline__ void gdn_prep_item(const Ctx& c, int item) {
    const int n = item % GDN_NCH, bhd = item / GDN_NCH, dir = bhd & 1, h = (bhd >> 1) & 3, b = bhd >> 3;
    const bf16* QKV = (const bf16*)(c.ws + WS_QKV); const float* GB = (const float*)(c.ws + WS_GB);
    bf16* Kr = (bf16*)(c.lds + GP_KR); bf16* Qr = (bf16*)(c.lds + GP_QR); bf16* Kt = (bf16*)(c.lds + GP_KT); float* Lm = (float*)(c.lds + GP_LM); bf16* Tb = (bf16*)(c.lds + GP_TB); float* tab = (float*)(c.lds + GP_TAB);
    unsigned char* frT = c.ws + WS_FRT + (size_t)item * FR_T_BYTES; unsigned char* frA = c.ws + WS_FRA + (size_t)item * FR_ATT_BYTES; unsigned char* frK = c.ws + WS_FRK + (size_t)item * FR_KD_BYTES; float* frTab = (float*)(c.ws + WS_FRTAB + (size_t)item * FR_TAB_BYTES);
    const int r = c.lane & 31, hh = c.lane >> 5;
    if (c.wave == 0) { const int row = scan_row(b, dir, n * 64 + c.lane); float g = GB[(size_t)row * 16 + dir * 4 + h]; const float beta = GB[(size_t)row * 16 + 8 + dir * 4 + h];
#pragma unroll
        for (int o = 1; o < 64; o <<= 1) { const float t = __shfl_up(g, o); if (c.lane >= o) g += t; }
        const float gl = __shfl(g, 63);
        tab[c.lane] = g; tab[64 + c.lane] = beta; tab[128 + c.lane] = __expf(g); tab[192 + c.lane] = __expf(gl - g); }
    { const int s = c.tid >> 3, seg = c.tid & 7; const int row = scan_row(b, dir, n * 64 + s); const bf16* rp = QKV + (size_t)row * 1536 + h * 128 + seg * 16;
      const v4u q0 = *(const v4u*)rp, q1 = *(const v4u*)(rp + 8), k0 = *(const v4u*)(rp + 512), k1 = *(const v4u*)(rp + 520);
      *(v4u*)(Qr + s * 136 + seg * 16) = q0; *(v4u*)(Qr + s * 136 + seg * 16 + 8) = q1; *(v4u*)(Kr + s * 136 + seg * 16) = k0; *(v4u*)(Kr + s * 136 + seg * 16 + 8) = k1;
      const unsigned kw[8] = {k0.x, k0.y, k0.z, k0.w, k1.x, k1.y, k1.z, k1.w};
#pragma unroll
      for (int e = 0; e < 8; ++e) { Kt[(seg * 16 + 2 * e) * 72 + s] = (bf16)(kw[e] & 0xffffu); Kt[(seg * 16 + 2 * e + 1) * 72 + s] = (bf16)(kw[e] >> 16); } }
    __syncthreads();
    if (c.wave < 3) { const int ct = c.wave ? 1 : 0, st = c.wave == 2 ? 1 : 0;
        f32x16 acc;
#pragma unroll
        for (int i = 0; i < 16; ++i) acc[i] = 0.f;
#pragma unroll
        for (int kk = 0; kk < 8; ++kk) { const bf16x8 a = *(const bf16x8*)(Kr + (ct * 32 + r) * 136 + kk * 16 + hh * 8), bb = *(const bf16x8*)(Kr + (st * 32 + r) * 136 + kk * 16 + hh * 8); acc = MFMA32(a, bb, acc); }
        const int s = st * 32 + r; const float gcs = tab[s];
#pragma unroll
        for (int i = 0; i < 16; ++i) { const int cc = ct * 32 + crow16(i, hh); Lm[cc * 68 + s] = (s < cc) ? tab[64 + cc] * acc[i] * __expf(tab[cc] - gcs) : 0.f; }
    } else if (c.wave < 6) { const int w = c.wave - 3, st = w == 2 ? 1 : 0, ct = w ? 1 : 0;
        f32x16 acc;
#pragma unroll
        for (int i = 0; i < 16; ++i) acc[i] = 0.f;
#pragma unroll
        for (int kk = 0; kk < 8; ++kk) { const bf16x8 a = *(const bf16x8*)(Kr + (st * 32 + r) * 136 + kk * 16 + hh * 8), bb = *(const bf16x8*)(Qr + (ct * 32 + r) * 136 + kk * 16 + hh * 8); acc = MFMA32(a, bb, acc); }
        const int cc = ct * 32 + r; const float gcc = tab[cc];
#pragma unroll
        for (int i = 0; i < 16; ++i) { const int s = st * 32 + crow16(i, hh); acc[i] = (s <= cc) ? acc[i] * __expf(gcc - tab[s]) : 0.f; }
        *(bf16x8*)(frA + ((size_t)((ct * 4 + 2 * st) * 64 + c.lane)) * 16) = pack_step(acc, 0);
        *(bf16x8*)(frA + ((size_t)((ct * 4 + 2 * st + 1) * 64 + c.lane)) * 16) = pack_step(acc, 1);
    } else { const int w = c.wave - 6;
#pragma unroll
        for (int f = 0; f < 8; ++f) { const int fi = w * 8 + f, dkt = fi >> 2, cb = fi & 3; const bf16* kp = Kt + (dkt * 32 + r) * 72 + 16 * cb + 4 * hh;
            const v2u lo = *(const v2u*)kp, hi = *(const v2u*)(kp + 8); const f32x4 e0 = *(const f32x4*)(tab + 192 + 16 * cb + 4 * hh), e1 = *(const f32x4*)(tab + 192 + 16 * cb + 8 + 4 * hh);
            v4u o; o.x = pk2(bflo(lo.x) * e0.x, bfhi(lo.x) * e0.y); o.y = pk2(bflo(lo.y) * e0.z, bfhi(lo.y) * e0.w); o.z = pk2(bflo(hi.x) * e1.x, bfhi(hi.x) * e1.y); o.w = pk2(bflo(hi.y) * e1.z, bfhi(hi.y) * e1.w);
            *(v4u*)(frK + ((size_t)(fi * 64 + c.lane)) * 16) = o; }
        if (w == 0) { const v4u z = (v4u){0u, 0u, 0u, 0u}; *(v4u*)(frA + ((size_t)((0 * 4 + 2) * 64 + c.lane)) * 16) = z; *(v4u*)(frA + ((size_t)((0 * 4 + 3) * 64 + c.lane)) * 16) = z; }
        else { *(f32x4*)(frTab + 4 * c.lane) = *(const f32x4*)(tab + 4 * c.lane); }
    }
    __syncthreads();
    if (c.wave == 0) { float Tr[64];
#pragma unroll
        for (int i = 0; i < 64; ++i) { float a0 = (c.lane == i) ? 1.f : 0.f, a1 = 0.f;
#pragma unroll
            for (int s4 = 0; s4 < (i + 3) / 4; ++s4) { const f32x4 l4 = *(const f32x4*)(Lm + i * 68 + 4 * s4);
                if (4 * s4 + 0 < i) a0 = fmaf(-l4.x, Tr[4 * s4 + 0], a0); if (4 * s4 + 1 < i) a1 = fmaf(-l4.y, Tr[4 * s4 + 1], a1); if (4 * s4 + 2 < i) a0 = fmaf(-l4.z, Tr[4 * s4 + 2], a0); if (4 * s4 + 3 < i) a1 = fmaf(-l4.w, Tr[4 * s4 + 3], a1); }
            Tr[i] = a0 + a1; Tb[i * 72 + c.lane] = (bf16)f2bf(Tr[i]); } }
    __syncthreads();
    { const int ct = c.wave >> 2, sb = c.wave & 3; const bf16* tp = Tb + (ct * 32 + r) * 72 + 16 * sb + 4 * hh; const v2u lo = *(const v2u*)tp, hi = *(const v2u*)(tp + 8);
      *(v4u*)(frT + ((size_t)((ct * 4 + sb) * 64 + c.lane)) * 16) = (v4u){lo.x, lo.y, hi.x, hi.y}; }
    __syncthreads();
}
__device__ __forceinline__ void phase_gdn_prep(const Ctx& c) { for (int item = c.bid; item < GDN_ITEMS; item += c.G) gdn_prep_item(c, item); }

constexpr int GR_K = 0, GR_Q = 16384, GR_T = 32768, GR_A = 40960, GR_KD = 49152, GR_TAB = 65536, GR_BUF = 66560;
__device__ __forceinline__ void gdn_rec_stage(const Ctx& c, int bhd, int n, int buf) {
    const int dir = bhd & 1, h = (bhd >> 1) & 3, b = bhd >> 3, lw = c.wave - 4; const int item = bhd * GDN_NCH + n;
    LAS unsigned char* base = (LAS unsigned char*)c.lds + buf * GR_BUF;
    const unsigned char* QKVb = c.ws + WS_QKV;
#pragma unroll
    for (int q = 0; q < 4; ++q) { const int qi = lw + 4 * q;
        const int s = 4 * qi + (c.lane >> 4), ps = c.lane & 15, p = ps ^ (s & 15); const size_t rowb = (size_t)scan_row(b, dir, n * 64 + s) * 3072 + (size_t)h * 256 + p * 16;
        __builtin_amdgcn_global_load_lds((const unsigned*)(QKVb + rowb + 1024), (LAS unsigned*)(base + GR_K + qi * 1024), 16, 0, 0);
        __builtin_amdgcn_global_load_lds((const unsigned*)(QKVb + rowb), (LAS unsigned*)(base + GR_Q + qi * 1024), 16, 0, 0); }
    const unsigned char* frT = c.ws + WS_FRT + (size_t)item * FR_T_BYTES; const unsigned char* frA = c.ws + WS_FRA + (size_t)item * FR_ATT_BYTES; const unsigned char* frK = c.ws + WS_FRK + (size_t)item * FR_KD_BYTES;
#pragma unroll
    for (int q = 0; q < 2; ++q) { const int qi = lw + 4 * q;
        __builtin_amdgcn_global_load_lds((const unsigned*)(frT + qi * 1024 + c.lane * 16), (LAS unsigned*)(base + GR_T + qi * 1024), 16, 0, 0);
        __builtin_amdgcn_global_load_lds((const unsigned*)(frA + qi * 1024 + c.lane * 16), (LAS unsigned*)(base + GR_A + qi * 1024), 16, 0, 0); }
#pragma unroll
    for (int q = 0; q < 4; ++q) { const int qi = lw + 4 * q;
        __builtin_amdgcn_global_load_lds((const unsigned*)(frK + qi * 1024 + c.lane * 16), (LAS unsigned*)(base + GR_KD + qi * 1024), 16, 0, 0); }
    if (lw == 0) __builtin_amdgcn_global_load_lds((const unsigned*)(c.ws + WS_FRTAB + (size_t)item * FR_TAB_BYTES + c.lane * 16), (LAS unsigned*)(base + GR_TAB), 16, 0, 0);
}
__device__ __forceinline__ bf16x8 gr_rowfrag(const unsigned char* tile, int row, int kb, int hh) {
    const unsigned char* rp = tile + row * 256; const int sw = row & 15;
    const v2u lo = *(const v2u*)(rp + (((2 * kb) ^ sw) * 16) + 8 * hh), hi = *(const v2u*)(rp + (((2 * kb + 1) ^ sw) * 16) + 8 * hh);
    return __builtin_bit_cast(bf16x8, (v4u){lo.x, lo.y, hi.x, hi.y});
}
__device__ __forceinline__ void gdn_rec_block(const Ctx& c, int bhd) {
    const int dir = bhd & 1, h = (bhd >> 1) & 3, b = bhd >> 3, r = c.lane & 31, hh = c.lane >> 5, dvt = c.wave;
    const bf16* QKV = (const bf16*)(c.ws + WS_QKV); bf16* OG = (bf16*)(c.ws + WS_OG) + (size_t)dir * ML * 512;
    f32x16 S[4];
#pragma unroll
    for (int t = 0; t < 4; ++t)
#pragma unroll
        for (int i = 0; i < 16; ++i) S[t][i] = 0.f;
    if (c.wave >= 4) gdn_rec_stage(c, bhd, 0, 0);
    asm volatile("s_waitcnt vmcnt(0)" ::: "memory"); __syncthreads();
    for (int n = 0; n < GDN_NCH; ++n) {
        const int buf = n & 1;
        if (c.wave >= 4) { if (n + 1 < GDN_NCH) gdn_rec_stage(c, bhd, n + 1, buf ^ 1); }
        else {
            const unsigned char* base = c.lds + buf * GR_BUF; const float* tab = (const float*)(base + GR_TAB);
            const int row0 = scan_row(b, dir, n * 64), sgn = dir ? -1 : 1;
            const bf16* vcol = QKV + (size_t)row0 * 1536 + 1024 + h * 128 + dvt * 32 + r + (ptrdiff_t)(sgn * 4 * hh) * 1536;
            bf16* ocol = OG + (size_t)row0 * 512 + h * 128 + dvt * 32 + r + (ptrdiff_t)(sgn * 4 * hh) * 512;
            const ptrdiff_t vst = (ptrdiff_t)sgn * 1536, ost = (ptrdiff_t)sgn * 512;
            bf16 vraw[2][16];
#pragma unroll
            for (int st = 0; st < 2; ++st)
#pragma unroll
                for (int i = 0; i < 16; ++i) vraw[st][i] = vcol[vst * (st * 32 + (i & 3) + 8 * (i >> 2))];
            bf16x8 Rf[2][2];
#pragma unroll
            for (int st = 0; st < 2; ++st) { f32x16 acc;
#pragma unroll
                for (int i = 0; i < 16; ++i) acc[i] = 0.f;
#pragma unroll
                for (int kb = 0; kb < 8; ++kb) acc = MFMA32(gr_rowfrag(base + GR_K, st * 32 + r, kb, hh), pack_step_v(S[kb >> 1], kb & 1), acc);
#pragma unroll
                for (int i = 0; i < 16; ++i) { const int s = st * 32 + crow16(i, hh); acc[i] = tab[64 + s] * (bf1(vraw[st][i]) - tab[128 + s] * acc[i]); }
                Rf[st][0] = pack_step(acc, 0); Rf[st][1] = pack_step(acc, 1); asm volatile("" ::: "memory"); }
            bf16x8 Vf[2][2];
#pragma unroll
            for (int ct = 0; ct < 2; ++ct) { f32x16 acc;
#pragma unroll
                for (int i = 0; i < 16; ++i) acc[i] = 0.f;
#pragma unroll
                for (int sb = 0; sb < 4; ++sb) if (sb < 2 * ct + 2) acc = MFMA32(*(const bf16x8*)(base + GR_T + ((ct * 4 + sb) * 64 + c.lane) * 16), Rf[sb >> 1][sb & 1], acc);
                Vf[ct][0] = pack_step(acc, 0); Vf[ct][1] = pack_step(acc, 1); }
            asm volatile("" ::: "memory");
#pragma unroll
            for (int ct = 0; ct < 2; ++ct) { f32x16 acc;
#pragma unroll
                for (int i = 0; i < 16; ++i) acc[i] = 0.f;
#pragma unroll
                for (int kb = 0; kb < 8; ++kb) acc = MFMA32(gr_rowfrag(base + GR_Q, ct * 32 + r, kb, hh), pack_step_v(S[kb >> 1], kb & 1), acc);
#pragma unroll
                for (int i = 0; i < 16; ++i) acc[i] *= tab[128 + ct * 32 + crow16(i, hh)];
#pragma unroll
                for (int cb = 0; cb < 4; ++cb) if (cb < 2 * ct + 2) acc = MFMA32(*(const bf16x8*)(base + GR_A + ((ct * 4 + cb) * 64 + c.lane) * 16), Vf[cb >> 1][cb & 1], acc);
                if (n >= 4) {
#pragma unroll
                    for (int i = 0; i < 16; ++i) ocol[ost * (ct * 32 + (i & 3) + 8 * (i >> 2))] = (bf16)f2bf(acc[i]); }
                asm volatile("" ::: "memory"); }
            const float gtot = tab[128 + 63];
#pragma unroll
            for (int t = 0; t < 4; ++t) {
#pragma unroll
                for (int i = 0; i < 16; ++i) S[t][i] *= gtot;
#pragma unroll
                for (int cb = 0; cb < 4; ++cb) S[t] = MFMA32(*(const bf16x8*)(base + GR_KD + ((t * 4 + cb) * 64 + c.lane) * 16), Vf[cb >> 1][cb & 1], S[t]); }
        }
        if (c.wave >= 4) asm volatile("s_waitcnt vmcnt(0)" ::: "memory"); else asm volatile("s_waitcnt lgkmcnt(0)" ::: "memory");
        __builtin_amdgcn_s_barrier(); asm volatile("" ::: "memory");
    }
    asm volatile("s_waitcnt vmcnt(0)" ::: "memory"); __syncthreads();
}
__device__ __forceinline__ void phase_gdn_rec(const Ctx& c) { for (int bhd = c.bid; bhd < 64; bhd += 64) gdn_rec_block(c, bhd); }

#define XB_TMO      128
#define XB_XCNT(j)  (256  + 64 * (j))
#define XB_XSUB(j)  (1280 + 64 * (j))
#define XB_XGEN(j)  (2304 + 64 * (j))
#define XB_TOP      3328
#define XB_TOPGEN   3392
#define XCD_BAR_WORDS 3456
#define XB_SPIN_CAP (1u << 20)
__device__ __forceinline__ unsigned xb_ld(unsigned* p)              { return __hip_atomic_load(p, __ATOMIC_RELAXED, __HIP_MEMORY_SCOPE_AGENT); }
__device__ __forceinline__ unsigned xb_add(unsigned* p, unsigned v) { return __hip_atomic_fetch_add(p, v, __ATOMIC_RELAXED, __HIP_MEMORY_SCOPE_AGENT); }
__device__ __forceinline__ unsigned xb_xcc_id() { return (unsigned)__builtin_amdgcn_s_getreg((3 << 11) | 20) & 0xFu; }
#define XB_SPIN(cond, bar) do { unsigned _sp = 0; while (cond) { __builtin_amdgcn_s_sleep(1); \
    if ((++_sp & 255u) == 0u) { if (xb_ld(&(bar)[XB_TMO])) break; if (_sp > XB_SPIN_CAP) { atomicAdd(&(bar)[XB_TMO], 1u); break; } } } } while (0)
struct XcdBarrier { unsigned* bar; unsigned x; volatile LAS unsigned* st; };
__device__ __forceinline__ XcdBarrier xcd_barrier_post(unsigned* bar, volatile LAS unsigned* st) {
    XcdBarrier b; b.bar = bar; b.x = xb_xcc_id(); b.st = st;
    if (threadIdx.x == 0) (void)xb_add(&bar[XB_XCNT(b.x)], 1u);
    return b;
}
__device__ __forceinline__ void xcd_barrier_complete(unsigned* bar, unsigned x, unsigned& nloc, unsigned& nx) {
    const unsigned G = gridDim.x * gridDim.y * gridDim.z;
    unsigned sum, cnt, mine, sp = 0u;
    for (;;) {
        sum = 0u; cnt = 0u; mine = 0u;
#pragma unroll
        for (unsigned j = 0; j < 16; ++j) { const unsigned c = xb_ld(&bar[XB_XCNT(j)]); sum += c; cnt += (c > 0u) ? 1u : 0u; mine = (j == x) ? c : mine; }
        if (sum == G) break;
        __builtin_amdgcn_s_sleep(1);
        if ((++sp & 255u) == 0u) { if (xb_ld(&bar[XB_TMO])) break; if (sp > XB_SPIN_CAP) { atomicAdd(&bar[XB_TMO], 1u); break; } }
    }
    nloc = mine > 0u ? mine : 1u; nx = cnt > 0u ? cnt : 1u;
}
__device__ __forceinline__ void xcd_barrier(const XcdBarrier& b) {
    asm volatile("s_waitcnt vmcnt(0)" ::: "memory");
    __syncthreads();
    if (threadIdx.x == 0) {
        unsigned* bar = b.bar;
        __builtin_amdgcn_s_waitcnt(0);
        unsigned nloc = b.st[0], nx = b.st[1];
        if (nloc == 0u) { xcd_barrier_complete(bar, b.x, nloc, nx); b.st[0] = nloc; b.st[1] = nx; }
        const unsigned old = xb_add(&bar[XB_XSUB(b.x)], 1u);
        const unsigned gen = old / nloc;
        if (old + 1u == (gen + 1u) * nloc) {
            __builtin_amdgcn_fence(__ATOMIC_RELEASE, "agent");
            asm volatile("s_waitcnt vmcnt(0)" ::: "memory");
            const unsigned og = xb_add(&bar[XB_TOP], 1u);
            const unsigned tg = og / nx;
            if (og + 1u == (tg + 1u) * nx) xb_add(&bar[XB_TOPGEN], 1u);
            else XB_SPIN(xb_ld(&bar[XB_TOPGEN]) == tg, bar);
            __builtin_amdgcn_fence(__ATOMIC_ACQUIRE, "agent");
            xb_add(&bar[XB_XGEN(b.x)], 1u);
            asm volatile("s_waitcnt vmcnt(0)" ::: "memory");
        } else {
            XB_SPIN(xb_ld(&bar[XB_XGEN(b.x)]) == gen, bar);
            __builtin_amdgcn_fence(__ATOMIC_ACQUIRE, "agent");
            asm volatile("s_waitcnt vmcnt(0)" ::: "memory");
        }
    }
    __syncthreads();
}

constexpr int LDS_MISC = LDS_BYTES - 64;
__global__ void __launch_bounds__(NTHREADS, 2) mk_fwd(Args args) {
    extern __shared__ __attribute__((aligned(16))) unsigned char lds[];
    Ctx c; c.a = &args; c.ws = args.ws; c.lds = lds;
    c.tid = threadIdx.x; c.lane = c.tid & 63; c.wave = __builtin_amdgcn_readfirstlane(c.tid >> 6); c.bid = blockIdx.x; c.G = gridDim.x;
    c.gw = c.bid * NWAVES + c.wave; c.NGW = c.G * NWAVES; c.gwv = c.wave * c.G + c.bid;
    const int lo = args.ph_lo, hi = args.ph_hi;
    PG8_LAS unsigned char* ring = (PG8_LAS unsigned char*)lds;
#ifndef MK_PH_MASK
#define MK_PH_MASK 0xffff
#endif
#define IN(k) (((MK_PH_MASK >> (k)) & 1) && lo <= (k) && (k) < hi)
#if MK_ONE_LAUNCH
    cg::grid_group grid = cg::this_grid();
    if (lo < 0) grid.sync();
    volatile LAS unsigned* st = (volatile LAS unsigned*)((LAS unsigned char*)lds + LDS_MISC);
    if (c.tid < 2) st[c.tid] = 0u;
    __syncthreads();
    const XcdBarrier bar = xcd_barrier_post((unsigned*)(c.ws + WS_CTL) + CW_BAR, st);
#define SEAM(k) do { if (IN(k) && IN((k) + 1)) xcd_barrier(bar); } while (0)
#else
#define SEAM(k) do { } while (0)
#endif
    if (IN(0)) { phase_prep(c); phase_s5_build(c); } SEAM(0);
    if (IN(1)) { phase_norm1(c); } SEAM(1);
    if (IN(2)) { pg8::Gemm g{(const pg8::bf16_t*)(c.ws + WS_HX), (const pg8::bf16_t*)(c.ws + WS_WIN), 1024, 1024, 1024}; pg8::StaticOrder S; S.init(MT, NPROJ, c.G, c.bid);
        pg8::EpiInProj E{(pg8::bf16_t*)(c.ws + WS_U5), (pg8::bf16_t*)(c.ws + WS_QKVPRE), (pg8::bf16_t*)(c.ws + WS_Z)};
        pg8::gemm_phase<pg8::EpiInProj, pg8::StaticOrder, true, true>(ring, g, S, E); } SEAM(2);
    if (IN(3)) { { pg8::Gemm g{(const pg8::bf16_t*)(c.ws + WS_U5), (const pg8::bf16_t*)(c.ws + WS_PM), 768, 512, 512}; pg8::SchedSS S{c.G, c.bid}; pg8::EpiSS E{(float*)(c.ws + WS_SS)};
          pg8::gemm_phase<pg8::EpiSS, pg8::SchedSS, true, true>(ring, g, S, E); }
        __syncthreads(); phase_conv(c); } SEAM(3);
    if (IN(4)) { if (c.wave < 2) s5_state_scan(c, c.bid + c.G * c.wave < 512 ? c.bid + c.G * c.wave : 0); __syncthreads(); phase_gdn_prep(c); } SEAM(4);
    if (IN(5)) { pg8::Gemm g{(const pg8::bf16_t*)(c.ws + WS_U5), (const pg8::bf16_t*)(c.ws + WS_BB), 768, 768, 768}; pg8::SchedS5Y S{c.G, c.bid}; pg8::EpiS5Y E{(pg8::bf16_t*)(c.ws + WS_YG)};
        pg8::gemm_phase<pg8::EpiS5Y, pg8::SchedS5Y, true, true>(ring, g, S, E); } SEAM(5);
    if (IN(6)) { if (c.bid < 64) phase_gdn_rec(c);
        else { pg8::Gemm g{(const pg8::bf16_t*)(c.ws + WS_YG), (const pg8::bf16_t*)(c.ws + WS_WGLU), 512, 512, 512}; pg8::StaticOrder S; S.init(ML, 512, c.G - 64, c.bid - 64);
            pg8::EpiGlu E{(const pg8::bf16_t*)(c.ws + WS_YG), (pg8::bf16_t*)(c.ws + WS_CAT)};
            pg8::gemm_phase<pg8::EpiGlu, pg8::StaticOrder, true, true>(ring, g, S, E); } } SEAM(6);
    if (IN(7)) { phase_combine(c); } SEAM(7);
    if (IN(8)) { pg8::Gemm g{(const pg8::bf16_t*)(c.ws + WS_CAT), (const pg8::bf16_t*)(c.ws + WS_WOUT), 1024, 1024, 1024}; pg8::StaticOrder S; S.init(ML, 1024, c.G, c.bid);
        pg8::EpiF32 E{(float*)(c.ws + WS_YRAW), 1024};
        pg8::gemm_phase<pg8::EpiF32, pg8::StaticOrder, true, true>(ring, g, S, E); } SEAM(8);
    if (IN(9)) { phase_rows2(c); phase_fp8_tables(c); } SEAM(9);
    if (IN(10)) { pg8::Gemm g{(const pg8::bf16_t*)(c.ws + WS_HX2), (const pg8::bf16_t*)(c.ws + WS_WQ), 1024, 1024, 1024}; pg8::StaticOrder S; S.init(ML, 2048, c.G, c.bid);
        pg8::EpiBf16<0> E{(pg8::bf16_t*)(c.ws + WS_QP), 2048, nullptr, 0, 0, 1.f};
        pg8::gemm_phase<pg8::EpiBf16<0>, pg8::StaticOrder, true, true>(ring, g, S, E); } SEAM(10);
    if (IN(11)) { phase_topk(c); } SEAM(11);
    if (IN(12)) { phase_exp1(c); } SEAM(12);
    if (IN(13)) { phase_exp2(c); } SEAM(13);
    if (IN(14)) { phase_exp3(c); }
#undef IN
#undef SEAM
}

extern "C" void kernel_launch(void* const* d_in, const int* in_sizes, int n_in, void* d_out, int out_size, void* d_ws, size_t ws_size, hipStream_t stream) {
    static int grid = 0;
    if (grid == 0) {
        if (n_in != 29 || out_size != ML * D || ws_size < WS_END) { fprintf(stderr, "kernel_launch: unexpected shapes (n_in %d out %d ws %zu)\n", n_in, out_size, ws_size); grid = -1; return; }
        int dev = 0, cus = 0, per_cu = 0;
        (void)hipGetDevice(&dev); (void)hipDeviceGetAttribute(&cus, hipDeviceAttributeMultiprocessorCount, dev);
        if (hipFuncSetAttribute((const void*)mk_fwd, hipFuncAttributeMaxDynamicSharedMemorySize, LDS_BYTES) != hipSuccess) { fprintf(stderr, "kernel_launch: hipFuncSetAttribute failed\n"); grid = -1; return; }
        (void)hipOccupancyMaxActiveBlocksPerMultiprocessor(&per_cu, (const void*)mk_fwd, NTHREADS, LDS_BYTES);
        (void)hipGetLastError();
        grid = cus;
        fprintf(stderr, "kernel_launch: cus %d per_cu %d grid %d\n", cus, per_cu, grid);
    }
    if (grid < 0) return;
    Args a{};
    for (int i = 0; i < 29; ++i) a.in[i] = (const float*)d_in[i];
    a.out = (float*)d_out; a.ws = (unsigned char*)d_ws;
    (void)hipMemsetAsync((char*)d_ws + WS_CTL, 0, CTL_ZERO_BYTES, stream);
#if MK_ONE_LAUNCH
    a.ph_lo = 0; a.ph_hi = NPHASES;
    void* kargs[] = {&a};
    hipError_t e = hipLaunchCooperativeKernel((const void*)mk_fwd, dim3(grid), dim3(NTHREADS), kargs, LDS_BYTES, stream);
    if (e != hipSuccess) fprintf(stderr, "kernel_launch: cooperative launch failed: %s\n", hipGetErrorString(e));
#else
    for (int ph = 0; ph < NPHASES; ++ph) { a.ph_lo = ph; a.ph_hi = ph + 1; hipLaunchKernelGGL(mk_fwd, dim3(grid), dim3(NTHREADS), LDS_BYTES, stream, a); }
#endif
}
```

```cpp
#include <hip/hip_runtime.h>
#include <hip/hip_cooperative_groups.h>
#include <cstdio>
#include <cstdint>
namespace cg = cooperative_groups;
namespace pg8 {
#define PG8_LAS __attribute__((address_space(3)))
typedef unsigned short bf16_t;
typedef short bf16x8 __attribute__((ext_vector_type(8)));
typedef float f32x4 __attribute__((ext_vector_type(4)));
typedef unsigned u32x4 __attribute__((ext_vector_type(4)));
constexpr int BM = 256, BK = 64, HALF = 128, HTB = HALF * BK * 2  , STAGE_BYTES = 8 * HTB, NXCD = 8, WGM = 8;

__host__ __device__ __forceinline__ int lds_byte(int r, int c) { const int st = (r >> 4) * 2 + (c >> 5), rr = r & 15, cc = c & 31, ob = rr * 64 + cc * 2; return st * 1024 + (ob ^ (((ob >> 9) & 1) << 5)); }
__host__ __device__ __forceinline__ void stage_rc(int b, int& R, int& C) { const int st = b / 1024, sb = b % 1024, swz = sb ^ (((sb >> 9) & 1) << 5); R = (st >> 1) * 16 + swz / 64; C = (st & 1) * 32 + (swz % 64) / 2; }
__host__ __device__ __forceinline__ int perm32(int rho) { const int n = rho >> 4, i = rho & 15; return 8 * (i >> 2) + 4 * n + (i & 3); }

struct Unit { int pm, pn; };
struct Gemm { const bf16_t* A; const bf16_t* Bt; int lda, ldb, K; };

struct StaticOrder {
    int nM, nN, nwg, G, c;
    __host__ __device__ void init(int M, int N, int G_, int c_) { nM = M / BM; nN = N / BM; nwg = nM * nN; G = G_; c = c_; }
    __host__ __device__ bool next(int i, Unit& u) const {
        const long L = (long)i * G + c; if (L >= nwg) return false;
        int wgid = (int)L; { const int q = nwg / NXCD, r = nwg % NXCD, xcd = wgid % NXCD, off = wgid / NXCD; wgid = (xcd < r ? xcd * (q + 1) : r * (q + 1) + (xcd - r) * q) + off; }
        const int nig = WGM * nN, gid = wgid / nig, fm = gid * WGM, gsz = (nM - fm) < WGM ? (nM - fm) : WGM;
        u.pm = fm + ((wgid % nig) % gsz); u.pn = (wgid % nig) / gsz; return true;
    }
    __device__ __forceinline__ void a_ready(const Unit&) const {}
    __device__ __forceinline__ void done(const Unit&) const {}
};

__device__ __forceinline__ unsigned cvt_pk_bf16(float lo, float hi) { unsigned r; asm volatile("v_cvt_pk_bf16_f32 %0, %1, %2" : "=v"(r) : "v"(lo), "v"(hi)); return r; }
typedef float f32x2 __attribute__((ext_vector_type(2)));
__device__ __forceinline__ f32x2 gelu_pk(f32x2 v) {
    const f32x2 av = __builtin_elementwise_abs(v), d = av * 0.2316418882f + 1.0f;
    f32x2 t; t.x = __builtin_amdgcn_rcpf(d.x); t.y = __builtin_amdgcn_rcpf(d.y);
    f32x2 q = t * 0.5307027145f + (-0.7265760135f); q = q * t + 0.7107068705f; q = q * t + (-0.142248368f); q = q * t + 0.127414796f; q = q * t;
    const f32x2 s = (v * v) * (-0.72134752044f);
    f32x2 e; e.x = __builtin_amdgcn_exp2f(s.x); e.y = __builtin_amdgcn_exp2f(s.y);
    const f32x2 m = v * (q * e), r = v - m;
    f32x2 o; o.x = v.x < 0.f ? m.x : r.x; o.y = v.y < 0.f ? m.y : r.y; return o;
}

template <int ACT  > struct EpiBf16 {
    static constexpr bool PERM = true, AFTER_DRAIN = false; static_assert(ACT == 0 || ACT == 1, "EpiBf16: ACT is 0 (none) or 1 (gelu_pk)");
    bf16_t* O; int ldc; const float* bias; int split_cols; size_t split_stride; float scale0;
    __device__ __forceinline__ void operator()(const f32x4 (&acc)[2][2][4][2], const Unit& u, int wr, int wc, int fr, int fq) const {
        const int row0 = u.pm * BM + wr * 64 + fr; int colt = u.pn * BM; bf16_t* base = O;
        float sc = 1.f; if (split_cols) { const int t = colt / split_cols; base += (size_t)t * split_stride; colt -= t * split_cols; if (t == 0) sc = scale0; }
        const int col0 = colt + wc * 32 + 8 * fq, bcol0 = u.pn * BM + wc * 32 + 8 * fq;
        f32x4 bv[2][2];
#pragma unroll
        for (int bj = 0; bj < 2; ++bj)
#pragma unroll
            for (int n = 0; n < 2; ++n) bv[bj][n] = bias ? *(const f32x4*)(bias + bcol0 + bj * HALF + 4 * n) : (f32x4){0.f, 0.f, 0.f, 0.f};
#pragma unroll
        for (int ai = 0; ai < 2; ++ai)
#pragma unroll
            for (int m = 0; m < 4; ++m) { bf16_t* rowp = base + (size_t)(row0 + ai * HALF + m * 16) * ldc + col0;
#pragma unroll
                for (int bj = 0; bj < 2; ++bj) { f32x4 v0 = acc[ai][bj][m][0] + bv[bj][0], v1 = acc[ai][bj][m][1] + bv[bj][1];
                    if (ACT == 1) { f32x2 a = gelu_pk((f32x2){v0[0], v0[1]}), b = gelu_pk((f32x2){v0[2], v0[3]}), c = gelu_pk((f32x2){v1[0], v1[1]}), d = gelu_pk((f32x2){v1[2], v1[3]});
                        v0 = (f32x4){a.x, a.y, b.x, b.y}; v1 = (f32x4){c.x, c.y, d.x, d.y}; }
                    v0 = v0 * sc; v1 = v1 * sc; u32x4 w; w.x = cvt_pk_bf16(v0[0], v0[1]); w.y = cvt_pk_bf16(v0[2], v0[3]); w.z = cvt_pk_bf16(v1[0], v1[1]); w.w = cvt_pk_bf16(v1[2], v1[3]);
                    *(u32x4*)(rowp + bj * HALF) = w; } }
    }
};

template <class Epi, class Sched, bool ALIGN_EPI = false, bool SP2 = false>
__device__ __forceinline__ void gemm_phase(PG8_LAS unsigned char* lds, const Gemm g, const Sched& S, const Epi& E) {
    const int tid = threadIdx.x, wid = __builtin_amdgcn_readfirstlane(tid >> 6), lane = tid & 63, wr = wid >> 2, wc = wid & 3, fr = lane & 15, fq = lane >> 4;
    const int K = g.K, nt = K / BK;
    unsigned voffA[2], voffB[2];
#pragma unroll
    for (int i = 0; i < 2; ++i) { int R, C; stage_rc(tid * 16 + i * 8192, R, C); const int Rb = Epi::PERM ? ((R & ~31) + perm32(R & 31)) : R;
        voffA[i] = (unsigned)(R * g.lda + C) * 2u; voffB[i] = (unsigned)(Rb * g.ldb + C) * 2u; }
    const size_t kstep = (size_t)(BK * 2);
    const size_t hstepA = (size_t)HALF * g.lda * 2, hstepB = (size_t)HALF * g.ldb * 2;
    const size_t tstepA = 2 * hstepA, tstepB = 2 * hstepB;
    const unsigned ldsw = (unsigned)wid * 1024u;
    const int aoff = lds_byte(wr * 64 + fr, fq * 8), boff = lds_byte(wc * 32 + fr, fq * 8);
#define PG8_SA(b, h) (((b) * 2 + (h)) * HTB)
#define PG8_SB(b, h) ((4 + (b) * 2 + (h)) * HTB)
#define PG8_STAGE(bufoff, gbase, voff) do { _Pragma("unroll") for (int _i = 0; _i < 2; ++_i) \
        __builtin_amdgcn_global_load_lds((const unsigned*)((const char*)(gbase) + (voff)[_i]), (PG8_LAS unsigned*)(lds + (bufoff) + ldsw + _i * 8192), 16, 0, 0); } while (0)
#define PG8_LDA(dst, b, h) do { _Pragma("unroll") for (int m = 0; m < 4; ++m) _Pragma("unroll") for (int k = 0; k < 2; ++k) dst[m][k] = *(const PG8_LAS bf16x8*)(lds + PG8_SA(b, h) + aoff + m * 2048 + k * 1024); } while (0)
#define PG8_LDB(dst, b, h) do { _Pragma("unroll") for (int n = 0; n < 2; ++n) _Pragma("unroll") for (int k = 0; k < 2; ++k) dst[n][k] = *(const PG8_LAS bf16x8*)(lds + PG8_SB(b, h) + boff + n * 2048 + k * 1024); } while (0)
#define PG8_MMA(ai, bj, At, Bt) do { __builtin_amdgcn_s_setprio(1); _Pragma("unroll") for (int m = 0; m < 4; ++m) _Pragma("unroll") for (int n = 0; n < 2; ++n) _Pragma("unroll") for (int k = 0; k < 2; ++k) \
        acc[ai][bj][m][n] = __builtin_amdgcn_mfma_f32_16x16x32_bf16(Bt[n][k], At[m][k], acc[ai][bj][m][n], 0, 0, 0); __builtin_amdgcn_s_setprio(0); } while (0)
#define PG8_WAIT_V(n) asm volatile("s_waitcnt vmcnt(" #n ")" ::: "memory")
#define PG8_WAIT_L(n) asm volatile("s_waitcnt lgkmcnt(" #n ")" ::: "memory")
#define PG8_BAR __builtin_amdgcn_s_barrier()
#define PG8_SCHED __builtin_amdgcn_sched_barrier(0)
    Unit cur, nxt; int ui = 0;
    if (!S.next(0, cur)) return;
    f32x4 acc[2][2][4][2];
#pragma unroll
    for (int a = 0; a < 2; ++a)
#pragma unroll
        for (int b = 0; b < 2; ++b)
#pragma unroll
            for (int m = 0; m < 4; ++m)
#pragma unroll
                for (int n = 0; n < 2; ++n) acc[a][b][m][n] = (f32x4){0.f, 0.f, 0.f, 0.f};
    bf16x8 At[4][2], B0[2][2], B1[2][2];
    const char* cA = (const char*)g.A + (size_t)cur.pm * tstepA; const char* cB = (const char*)g.Bt + (size_t)cur.pn * tstepB;
    S.a_ready(cur);
    if constexpr (SP2) {
        PG8_STAGE(PG8_SB(0, 0), cB, voffB); PG8_STAGE(PG8_SB(0, 1), cB + hstepB, voffB); PG8_STAGE(PG8_SA(0, 0), cA, voffA); PG8_STAGE(PG8_SA(0, 1), cA + hstepA, voffA);
        if (wr == 1) PG8_BAR;
        PG8_WAIT_V(2); PG8_BAR;
        PG8_STAGE(PG8_SB(1, 0), cB + kstep, voffB); PG8_STAGE(PG8_SA(1, 0), cA + kstep, voffA); PG8_STAGE(PG8_SB(1, 1), cB + hstepB + kstep, voffB);
        PG8_WAIT_V(6); PG8_BAR;
    } else {
        PG8_STAGE(PG8_SB(0, 0), cB, voffB); PG8_STAGE(PG8_SA(0, 0), cA, voffA); PG8_STAGE(PG8_SB(0, 1), cB + hstepB, voffB); PG8_STAGE(PG8_SA(0, 1), cA + hstepA, voffA);
        if (wr == 1) PG8_BAR;
        PG8_WAIT_V(4); PG8_BAR;
        PG8_STAGE(PG8_SB(1, 0), cB + kstep, voffB); PG8_STAGE(PG8_SA(1, 0), cA + kstep, voffA); PG8_STAGE(PG8_SB(1, 1), cB + hstepB + kstep, voffB);
        PG8_WAIT_V(6); PG8_BAR;
    }
    for (;;) {
        const bool has_next = S.next(ui + 1, nxt);
        const char* nA = has_next ? (const char*)g.A + (size_t)nxt.pm * tstepA : cA; const char* nB = has_next ? (const char*)g.Bt + (size_t)nxt.pn * tstepB : cB;
        for (int t = 0; t < nt; t += 2) {
            const bool last = (t == nt - 2);
            const char* a1 = cA + (size_t)(t + 1) * kstep;
            const char* a2 = last ? nA : cA + (size_t)(t + 2) * kstep; const char* b2 = last ? nB : cB + (size_t)(t + 2) * kstep;
            const char* a3 = a2 + kstep; const char* b3 = b2 + kstep;
            if (last && has_next) S.a_ready(nxt);
            if constexpr (SP2) {
            PG8_LDB(B0, 0, 0); PG8_LDB(B1, 0, 1); PG8_SCHED; PG8_LDA(At, 0, 0); PG8_STAGE(PG8_SA(1, 1), a1 + hstepA, voffA);
            PG8_WAIT_V(8); PG8_WAIT_L(0); PG8_BAR; PG8_MMA(0, 0, At, B0); PG8_MMA(0, 1, At, B1); PG8_BAR; PG8_SCHED;
            PG8_LDA(At, 0, 1); PG8_STAGE(PG8_SB(0, 0), b2, voffB); PG8_STAGE(PG8_SB(0, 1), b2 + hstepB, voffB); PG8_STAGE(PG8_SA(0, 0), a2, voffA);
            PG8_WAIT_V(8); PG8_WAIT_L(0); PG8_BAR; PG8_MMA(1, 0, At, B0); PG8_MMA(1, 1, At, B1); PG8_BAR; PG8_SCHED;
            PG8_LDB(B0, 1, 0); PG8_LDB(B1, 1, 1); PG8_SCHED; PG8_LDA(At, 1, 0); PG8_STAGE(PG8_SA(0, 1), a2 + hstepA, voffA);
            PG8_WAIT_V(8); PG8_WAIT_L(0); PG8_BAR; PG8_MMA(0, 0, At, B0); PG8_MMA(0, 1, At, B1); PG8_BAR; PG8_SCHED;
            PG8_LDA(At, 1, 1); PG8_STAGE(PG8_SB(1, 0), b3, voffB); PG8_STAGE(PG8_SB(1, 1), b3 + hstepB, voffB); PG8_STAGE(PG8_SA(1, 0), a3, voffA);
            PG8_WAIT_V(8); PG8_WAIT_L(0); PG8_BAR; PG8_MMA(1, 0, At, B0); PG8_MMA(1, 1, At, B1); PG8_BAR; PG8_SCHED;
            } else {
            PG8_LDB(B0, 0, 0); PG8_SCHED; PG8_LDA(At, 0, 0); PG8_STAGE(PG8_SA(1, 1), a1 + hstepA, voffA);
            PG8_WAIT_L(8); PG8_BAR; PG8_WAIT_L(0); PG8_MMA(0, 0, At, B0); PG8_BAR; PG8_SCHED;
            PG8_LDB(B1, 0, 1); PG8_STAGE(PG8_SB(0, 0), b2, voffB);
            PG8_BAR; PG8_WAIT_L(0); PG8_MMA(0, 1, At, B1); PG8_BAR;
            PG8_LDA(At, 0, 1); PG8_STAGE(PG8_SA(0, 0), a2, voffA);
            PG8_BAR; PG8_WAIT_L(0); PG8_MMA(1, 0, At, B0); PG8_BAR; PG8_SCHED;
            PG8_STAGE(PG8_SB(0, 1), b2 + hstepB, voffB);
            PG8_WAIT_V(6); PG8_BAR; PG8_MMA(1, 1, At, B1); PG8_BAR;
            PG8_LDB(B0, 1, 0); PG8_SCHED; PG8_LDA(At, 1, 0); PG8_STAGE(PG8_SA(0, 1), a2 + hstepA, voffA);
            PG8_WAIT_L(8); PG8_BAR; PG8_WAIT_L(0); PG8_MMA(0, 0, At, B0); PG8_BAR; PG8_SCHED;
            PG8_LDB(B1, 1, 1); PG8_STAGE(PG8_SB(1, 0), b3, voffB);
            PG8_BAR; PG8_WAIT_L(0); PG8_MMA(0, 1, At, B1); PG8_BAR;
            PG8_LDA(At, 1, 1); PG8_STAGE(PG8_SA(1, 0), a3, voffA);
            PG8_BAR; PG8_WAIT_L(0); PG8_MMA(1, 0, At, B0); PG8_BAR; PG8_SCHED;
            PG8_STAGE(PG8_SB(1, 1), b3 + hstepB, voffB);
            PG8_WAIT_V(6); PG8_BAR; PG8_MMA(1, 1, At, B1); PG8_BAR;
            }
        }
        if constexpr (ALIGN_EPI) { if (wr == 0) PG8_BAR; }
        if constexpr (!Epi::AFTER_DRAIN) { E(acc, cur, wr, wc, fr, fq); S.done(cur); }
        if (!has_next) break;
#pragma unroll
        for (int a = 0; a < 2; ++a)
#pragma unroll
            for (int b = 0; b < 2; ++b)
#pragma unroll
                for (int m = 0; m < 4; ++m)
#pragma unroll
                    for (int n = 0; n < 2; ++n) acc[a][b][m][n] = (f32x4){0.f, 0.f, 0.f, 0.f};
        cur = nxt; cA = nA; cB = nB; ++ui;
        if constexpr (ALIGN_EPI) { if (wr == 1) PG8_BAR; }
    }
    PG8_WAIT_V(0);
    if constexpr (!ALIGN_EPI) { if (wr == 0) PG8_BAR; }
    PG8_BAR;
    if constexpr (Epi::AFTER_DRAIN) { E.fused(acc, cur, wr, wc, fr, fq, lds, wid, lane); S.done(cur); }
#undef PG8_SA
#undef PG8_SB
#undef PG8_STAGE
#undef PG8_LDA
#undef PG8_LDB
#undef PG8_MMA
#undef PG8_WAIT_V
#undef PG8_WAIT_L
#undef PG8_BAR
#undef PG8_SCHED
}
}

#ifndef MK_EXP_OLD
#define MK_EXP_OLD 0
#endif
#ifndef MK_ONE_LAUNCH
#define MK_ONE_LAUNCH 1
#endif
#define LAS __attribute__((address_space(3)))
typedef unsigned short bf16;
typedef unsigned v4u __attribute__((ext_vector_type(4)));
typedef unsigned v2u __attribute__((ext_vector_type(2)));
typedef float f32x4 __attribute__((ext_vector_type(4)));
typedef float f32x2 __attribute__((ext_vector_type(2)));

constexpr int D = 1024, NB = 8, SEQ = 2048, LC = 256, ML = NB * SEQ  , MC = NB * LC  , MT = ML + MC  ;
constexpr int PROJ = 2576, NPROJ = 2560;
constexpr int NEXP = 16384, TOPK = 16, KK = 128;
constexpr float EPS = 1e-6f;
constexpr int NTHREADS = 512, NWAVES = 8;
constexpr int LDS_BYTES = 147456;
constexpr int NPHASES = 15;

constexpr size_t MiB = 1u << 20;
constexpr size_t WS_CTL = 0;
constexpr size_t CTL_ZERO_BYTES = 65536;
constexpr int CW_BAR = 0;
constexpr int CW_E1 = 4096, CW_E2 = 4096 + 8 * 64;
constexpr size_t WS_MOD = 1 * MiB;
constexpr size_t WS_LP = 1 * MiB + 512 * 1024;
constexpr size_t WS_WIN = 2 * MiB;
constexpr size_t WS_WOUT = 8 * MiB;
constexpr size_t WS_WGLU = 10 * MiB;
constexpr size_t WS_WQ = 11 * MiB;
constexpr size_t WS_GB = 15 * MiB;
constexpr size_t WS_BB = 17 * MiB;
constexpr size_t WS_PM = 41 * MiB;
constexpr size_t WS_OG = 17 * MiB;
constexpr size_t WS_HX2 = 17 * MiB;
constexpr size_t WS_U5 = 49 * MiB;
constexpr size_t WS_CAT = 49 * MiB;
constexpr size_t WS_IDX = 49 * MiB;
constexpr size_t WS_GATE = 57 * MiB;
constexpr size_t WS_ACT = 65 * MiB;
constexpr size_t WS_SSQP = 73 * MiB;
constexpr size_t WS_Z = 85 * MiB;
constexpr size_t WS_YRAW = 85 * MiB;
constexpr size_t WS_QP = 85 * MiB;
constexpr size_t WS_Y = 85 * MiB;
constexpr size_t WS_HX = 101 * MiB;
constexpr size_t WS_SS = 101 * MiB;
constexpr size_t WS_YG = 101 * MiB;
constexpr size_t WS_FRT = 125 * MiB;
constexpr size_t WS_QKVPRE = 137 * MiB;
constexpr size_t WS_FRA = 143 * MiB;
constexpr size_t WS_FRK = 161 * MiB;
constexpr size_t WS_FRTAB = 197 * MiB;
constexpr size_t WS_QKV = 202 * MiB;
constexpr size_t WS_U8 = 202 * MiB;
constexpr size_t WS_V8 = 218 * MiB;
constexpr size_t WS_USC = 234 * MiB;
constexpr size_t WS_VSC = 234 * MiB + 512 * 1024;
constexpr size_t WS_END = 256 * MiB;
static_assert(WS_BB + (size_t)32 * 512 * 768 * 2 <= WS_PM && WS_PM + (size_t)32 * 256 * 512 * 2 <= WS_U5 && WS_U5 + (size_t)32 * 768 * 768 * 2 <= WS_Z && WS_Z + (size_t)ML * 512 * 2 <= WS_HX, "ws map a");
static_assert(WS_HX + (size_t)MT * D * 2 <= WS_QKVPRE && WS_SS + (size_t)32 * 768 * 256 * 4 <= WS_FRT && WS_QKVPRE + (size_t)MT * 1536 * 2 <= WS_QKV && WS_QKV + (size_t)MT * 1536 * 2 <= WS_END, "ws map b");
static_assert(WS_FRT + (size_t)2304 * 8192 <= WS_FRA && WS_FRA + (size_t)2304 * 8192 <= WS_FRK && WS_FRK + (size_t)2304 * 16384 <= WS_FRTAB && WS_FRTAB + (size_t)2304 * 1024 <= WS_QKV, "ws map c");
static_assert(WS_OG + (size_t)2 * ML * 512 * 2 <= WS_CAT && WS_CAT + (size_t)ML * D * 2 <= WS_Z && WS_YRAW + (size_t)ML * D * 4 <= WS_U8 && WS_SSQP + (size_t)8 * ML * 4 <= WS_Z && WS_YG + (size_t)ML * 512 * 2 <= WS_FRT, "ws map d");

__device__ __forceinline__ unsigned f2bf(float f) { unsigned u = __builtin_bit_cast(unsigned, f); return (u + 0x7fffu + ((u >> 16) & 1u)) >> 16; }
typedef __bf16 bf16x2_t __attribute__((ext_vector_type(2)));
__device__ __forceinline__ unsigned pk2(float lo, float hi) { const f32x2 v = {lo, hi}; return __builtin_bit_cast(unsigned, __builtin_convertvector(v, bf16x2_t)); }
__device__ __forceinline__ float bflo(unsigned w) { return __builtin_bit_cast(float, w << 16); }
__device__ __forceinline__ float bfhi(unsigned w) { return __builtin_bit_cast(float, w & 0xffff0000u); }
__device__ __forceinline__ float bf1(bf16 h) { return __builtin_bit_cast(float, (unsigned)h << 16); }
__device__ __forceinline__ float wave_sum(float v) {
#pragma unroll
    for (int o = 1; o < 64; o <<= 1) v += __shfl_xor(v, o);
    return v;
}
__device__ __forceinline__ float wave_max(float v) {
#pragma unroll
    for (int o = 1; o < 64; o <<= 1) v = fmaxf(v, __shfl_xor(v, o));
    return v;
}
__device__ __forceinline__ float sigmoidf_(float x) { return 1.f / (1.f + __expf(-x)); }
__device__ __forceinline__ float siluf_(float x) { return x / (1.f + __expf(-x)); }
__device__ __forceinline__ float gelu_erf(float x) { return 0.5f * x * (1.f + erff(x * 0.70710678118654752f)); }
__device__ __forceinline__ void sincos_d(double a, float& s, float& c) {
    const double k = rint(a * 0.63661977236758134308);
    const double r = fma(-k, 1.57079632679489661923, a) - k * 6.123233995736766e-17;
    const double r2 = r * r;
    double sp = -2.5052108385441720e-08; sp = sp * r2 + 2.7557319223985893e-06; sp = sp * r2 - 1.9841269841269841e-04; sp = sp * r2 + 8.3333333333333332e-03; sp = sp * r2 - 1.6666666666666666e-01;
    const double sn = r + r * r2 * sp;
    double cp = 2.0876756987868099e-09; cp = cp * r2 - 2.7557319223985888e-07; cp = cp * r2 + 2.4801587301587302e-05; cp = cp * r2 - 1.3888888888888889e-03; cp = cp * r2 + 4.1666666666666664e-02; cp = cp * r2 - 0.5;
    const double cs = 1.0 + r2 * cp;
    const int q = ((int)k) & 3;
    const double ss = (q == 0) ? sn : (q == 1) ? cs : (q == 2) ? -sn : -cs;
    const double cc = (q == 0) ? cs : (q == 1) ? -sn : (q == 2) ? -cs : sn;
    s = (float)ss; c = (float)cc;
}

struct Args { const float* in[29]; float* out; unsigned char* ws; int ph_lo, ph_hi; };
static_assert(sizeof(Args) == 29 * 8 + 8 + 8 + 8, "Args has no padding");
enum { I_X = 0, I_C, I_CTX, I_CCTX, I_WMOD, I_BMOD, I_GPREMIX, I_GPOSTMIX, I_GPREFFN, I_GPOSTFFN, I_WIN, I_WOUT, I_LAMRE, I_LAMIM, I_LOGDT, I_BRE, I_BIM, I_CRE, I_CIM, I_S5D, I_WGLU,
       I_CONV, I_ALOG, I_DTBIAS, I_GDNNORM, I_WQ, I_KEYS, I_PU, I_PV };

__device__ __forceinline__ const float* in_row(const Args& a, int row) { return row < ML ? a.in[I_X] + (size_t)row * D : a.in[I_CTX] + (size_t)(row - ML) * D; }
__device__ __forceinline__ int mod_row(int row) { return row < ML ? (row >> 11) : 8; }

template <int CTRL> __device__ __forceinline__ float dppf(float v) { return __builtin_bit_cast(float, __builtin_amdgcn_update_dpp(0, __builtin_bit_cast(int, v), CTRL, 0xf, 0xf, true)); }
__device__ __forceinline__ float row_sum16(float v) { v += dppf<0xB1>(v); v += dppf<0x4E>(v); v += dppf<0x141>(v); v += dppf<0x140>(v); return v; }
__device__ __forceinline__ float row_max16(float v) { v = fmaxf(v, dppf<0xB1>(v)); v = fmaxf(v, dppf<0x4E>(v)); v = fmaxf(v, dppf<0x141>(v)); v = fmaxf(v, dppf<0x140>(v)); return v; }
__device__ __forceinline__ float wsum(float v) { v = row_sum16(v); return
    __builtin_bit_cast(float, __builtin_amdgcn_readlane(__builtin_bit_cast(int, v), 0)) + __builtin_bit_cast(float, __builtin_amdgcn_readlane(__builtin_bit_cast(int, v), 16)) +
    __builtin_bit_cast(float, __builtin_amdgcn_readlane(__builtin_bit_cast(int, v), 32)) + __builtin_bit_cast(float, __builtin_amdgcn_readlane(__builtin_bit_cast(int, v), 48)); }
__device__ __forceinline__ float wmax(float v) { v = row_max16(v); return fmaxf(fmaxf(__builtin_bit_cast(float, __builtin_amdgcn_readlane(__builtin_bit_cast(int, v), 0)), __builtin_bit_cast(float, __builtin_amdgcn_readlane(__builtin_bit_cast(int, v), 16))),
    fmaxf(__builtin_bit_cast(float, __builtin_amdgcn_readlane(__builtin_bit_cast(int, v), 32)), __builtin_bit_cast(float, __builtin_amdgcn_readlane(__builtin_bit_cast(int, v), 48)))); }
__device__ __forceinline__ int lane_rank(unsigned long long m) { return __builtin_amdgcn_mbcnt_hi((unsigned)(m >> 32), __builtin_amdgcn_mbcnt_lo((unsigned)m, 0)); }
__device__ __forceinline__ unsigned fkey(float f) { const unsigned u = __builtin_bit_cast(unsigned, f); return u ^ ((unsigned)((int)u >> 31) | 0x80000000u); }
#define WAVE_LDS_SYNC() do { __builtin_amdgcn_fence(__ATOMIC_RELEASE, "wavefront"); __builtin_amdgcn_wave_barrier(); __builtin_amdgcn_fence(__ATOMIC_ACQUIRE, "wavefront"); } while (0)
template <int N> __device__ __forceinline__ unsigned kth_key(const unsigned (&k)[N], int K) {
    unsigned T = 0;
    for (int bit = 31; bit >= 0; --bit) { const unsigned cand = T | (1u << bit); int cnt = 0;
#pragma unroll
        for (int n = 0; n < N; ++n) cnt += __popcll(__ballot(k[n] >= cand));
        if (cnt >= K) T = cand;
        if (cnt == K) break; }
    return T;
}

namespace pg8 {
struct EpiInProj {
    static constexpr bool PERM = true, AFTER_DRAIN = false;
    bf16_t* U; bf16_t* QKV; bf16_t* Z;
    __device__ __forceinline__ void operator()(const f32x4 (&acc)[2][2][4][2], const Unit& u, int wr, int wc, int fr, int fq) const {
        bf16_t* base; int ld, colt; bool lat_only = false;
        const bool s5 = u.pn < 2;
        if (s5) { base = U; ld = 0; colt = u.pn * BM; }
        else if (u.pn < 8) { base = QKV; ld = 1536; colt = (u.pn - 2) * BM; }
        else { base = Z; ld = 512; colt = (u.pn - 8) * BM; lat_only = true; }
        const int row0 = u.pm * BM + wr * 64 + fr, col0 = colt + wc * 32 + 8 * fq;
#pragma unroll
        for (int ai = 0; ai < 2; ++ai)
#pragma unroll
            for (int m = 0; m < 4; ++m) { const int row = row0 + ai * HALF + m * 16; bf16_t* rowp = base + (size_t)row * ld + col0;
                if (lat_only && row >= 16384) continue;
                if (s5) { const int R = row < 16384 ? (row >> 5) : 512 + ((row - 16384) >> 5), ii = row & 31; rowp = base + (size_t)R * 768 + ii * 16 + (col0 & 15); }
#pragma unroll
                for (int bj = 0; bj < 2; ++bj) { const f32x4 v0 = acc[ai][bj][m][0], v1 = acc[ai][bj][m][1];
                    u32x4 w; w.x = cvt_pk_bf16(v0[0], v0[1]); w.y = cvt_pk_bf16(v0[2], v0[3]); w.z = cvt_pk_bf16(v1[0], v1[1]); w.w = cvt_pk_bf16(v1[2], v1[3]);
                    if (s5) *(u32x4*)(rowp + (size_t)((col0 + bj * HALF) >> 4) * (768 * 768)) = w; else *(u32x4*)(rowp + bj * HALF) = w; } }
    }
};
struct EpiGlu {
    static constexpr bool PERM = true, AFTER_DRAIN = false;
    const bf16_t* YG; bf16_t* CAT;
    __device__ __forceinline__ void operator()(const f32x4 (&acc)[2][2][4][2], const Unit& u, int wr, int wc, int fr, int fq) const {
        const int row0 = u.pm * BM + wr * 64 + fr, col0 = u.pn * BM + wc * 32 + 8 * fq;
#pragma unroll
        for (int ai = 0; ai < 2; ++ai)
#pragma unroll
            for (int m = 0; m < 4; ++m) { const int row = row0 + ai * HALF + m * 16;
#pragma unroll
                for (int bj = 0; bj < 2; ++bj) { const f32x4 v0 = acc[ai][bj][m][0], v1 = acc[ai][bj][m][1];
                    const u32x4 y = *(const u32x4*)(YG + (size_t)row * 512 + col0 + bj * HALF);
                    float o[8]; const float a[8] = {v0[0], v0[1], v0[2], v0[3], v1[0], v1[1], v1[2], v1[3]};
                    const unsigned yw[4] = {y.x, y.y, y.z, y.w};
#pragma unroll
                    for (int e = 0; e < 8; ++e) { const float yv = __builtin_bit_cast(float, (e & 1) ? (yw[e >> 1] & 0xffff0000u) : (yw[e >> 1] << 16)); o[e] = yv / (1.f + __expf(-a[e])); }
                    u32x4 w; w.x = cvt_pk_bf16(o[0], o[1]); w.y = cvt_pk_bf16(o[2], o[3]); w.z = cvt_pk_bf16(o[4], o[5]); w.w = cvt_pk_bf16(o[6], o[7]);
                    *(u32x4*)(CAT + (size_t)row * 1024 + col0 + bj * HALF) = w; } }
    }
};
struct EpiF32 {
    static constexpr bool PERM = false, AFTER_DRAIN = false;
    float* C; int ldc;
    __device__ __forceinline__ void operator()(const f32x4 (&acc)[2][2][4][2], const Unit& u, int wr, int wc, int fr, int fq) const {
        const int row0 = u.pm * BM + wr * 64 + fr, col0 = u.pn * BM + wc * 32 + 4 * fq;
#pragma unroll
        for (int ai = 0; ai < 2; ++ai)
#pragma unroll
            for (int m = 0; m < 4; ++m) { float* rowp = C + (size_t)(row0 + ai * HALF + m * 16) * ldc + col0;
#pragma unroll
                for (int bj = 0; bj < 2; ++bj)
#pragma unroll
                    for (int n = 0; n < 2; ++n) *(f32x4*)(rowp + bj * HALF + n * 16) = acc[ai][bj][m][n]; }
    }
};
struct EpiSS {
    static constexpr bool PERM = false, AFTER_DRAIN = false;
    float* C;
    __device__ __forceinline__ void operator()(const f32x4 (&acc)[2][2][4][2], const Unit& u, int wr, int wc, int fr, int fq) const {
        const int row0 = u.pm * BM + wr * 64 + fr, col0 = wc * 32 + 4 * fq;
#pragma unroll
        for (int ai = 0; ai < 2; ++ai)
#pragma unroll
            for (int m = 0; m < 4; ++m) { float* rowp = C + (size_t)(row0 + ai * HALF + m * 16) * 256 + col0;
#pragma unroll
                for (int bj = 0; bj < 2; ++bj)
#pragma unroll
                    for (int n = 0; n < 2; ++n) *(f32x4*)(rowp + bj * HALF + n * 16) = acc[ai][bj][m][n]; }
    }
};
struct SchedSS { int G, c; __device__ bool next(int i, Unit& u) const { const int L = i * G + c; if (L >= 96) return false; u.pm = L; u.pn = L / 3; return true; }
    __device__ __forceinline__ void a_ready(const Unit&) const {} __device__ __forceinline__ void done(const Unit&) const {} };
struct EpiS5Y {
    static constexpr bool PERM = true, AFTER_DRAIN = false;
    bf16_t* YG;
    __device__ __forceinline__ void operator()(const f32x4 (&acc)[2][2][4][2], const Unit& u, int wr, int wc, int fr, int fq) const {
        const int g = u.pn >> 1, R0 = (u.pm - 3 * g) * BM + wr * 64 + fr, n0 = (u.pn & 1) * BM + wc * 32 + 8 * fq;
#pragma unroll
        for (int ai = 0; ai < 2; ++ai)
#pragma unroll
            for (int m = 0; m < 4; ++m) { const int R = R0 + ai * HALF + m * 16;
#pragma unroll
                for (int bj = 0; bj < 2; ++bj) { const int n = n0 + bj * HALF; const f32x4 v0 = acc[ai][bj][m][0], v1 = acc[ai][bj][m][1];
                    const f32x2 a = gelu_pk((f32x2){v0[0], v0[1]}), b = gelu_pk((f32x2){v0[2], v0[3]}), c2 = gelu_pk((f32x2){v1[0], v1[1]}), d = gelu_pk((f32x2){v1[2], v1[3]});
                    u32x4 w; w.x = cvt_pk_bf16(a.x, a.y); w.y = cvt_pk_bf16(b.x, b.y); w.z = cvt_pk_bf16(c2.x, c2.y); w.w = cvt_pk_bf16(d.x, d.y);
                    *(u32x4*)(YG + (size_t)(R * 32 + (n >> 4)) * 512 + g * 16 + (n & 15)) = w; } }
    }
};
struct SchedS5Y { int G, c; __device__ bool next(int i, Unit& u) const { const int L = i * G + c; if (L >= 128) return false; const int g = L >> 2; u.pm = 3 * g + ((L >> 1) & 1); u.pn = 2 * g + (L & 1); return true; }
    __device__ __forceinline__ void a_ready(const Unit&) const {} __device__ __forceinline__ void done(const Unit&) const {} };
}

struct Ctx { const Args* a; unsigned char* ws; unsigned char* lds; int tid, lane, wave, bid, G, gw, NGW, gwv; };

__device__ __forceinline__ void p0_transpose_item(const float* W, int ldw, int nblk, int K, bf16* WT, float* scr, int item, int lane) {
    const int kb = item / nblk, nb = item % nblk, k0 = 64 * kb, n0 = 32 * nb;
#pragma unroll 8
    for (int i = 0; i < 32; ++i) { const int kk = 2 * i + (lane >> 5); scr[kk * 33 + (lane & 31)] = W[(size_t)(k0 + kk) * ldw + n0 + (lane & 31)]; }
    __builtin_amdgcn_fence(__ATOMIC_RELEASE, "wavefront"); __builtin_amdgcn_wave_barrier(); __builtin_amdgcn_fence(__ATOMIC_ACQUIRE, "wavefront");
    const int c = lane & 7;
#pragma unroll
    for (int j = 0; j < 4; ++j) { const int n = (lane >> 3) + 8 * j; const float* s = scr + (8 * c) * 33 + n;
        v4u o; o.x = pk2(s[0 * 33], s[1 * 33]); o.y = pk2(s[2 * 33], s[3 * 33]); o.z = pk2(s[4 * 33], s[5 * 33]); o.w = pk2(s[6 * 33], s[7 * 33]);
        *(v4u*)(WT + (size_t)(n0 + n) * K + k0 + 8 * c) = o; }
    __builtin_amdgcn_fence(__ATOMIC_RELEASE, "wavefront"); __builtin_amdgcn_wave_barrier(); __builtin_amdgcn_fence(__ATOMIC_ACQUIRE, "wavefront");
}
__device__ __forceinline__ void phase_prep(const Ctx& c) {
    const Args& a = *c.a;
    float* scr = (float*)(c.lds + c.wave * 16384);
    constexpr int I_IN = 16 * 80, I_OUT = 16 * 32, I_GLU = 8 * 16, I_Q = 16 * 64;
    for (int it = c.gw; it < I_IN + I_OUT + I_GLU + I_Q; it += c.NGW) {
        int r = it;
        if (r < I_IN) { p0_transpose_item(a.in[I_WIN], PROJ, 80, 1024, (bf16*)(c.ws + WS_WIN), scr, r, c.lane); continue; } r -= I_IN;
        if (r < I_OUT) { p0_transpose_item(a.in[I_WOUT], 1024, 32, 1024, (bf16*)(c.ws + WS_WOUT), scr, r, c.lane); continue; } r -= I_OUT;
        if (r < I_GLU) { p0_transpose_item(a.in[I_WGLU], 512, 16, 512, (bf16*)(c.ws + WS_WGLU), scr, r, c.lane); continue; } r -= I_GLU;
        p0_transpose_item(a.in[I_WQ], 2048, 64, 1024, (bf16*)(c.ws + WS_WQ), scr, r, c.lane);
    }
    __syncthreads();
    float* sc = (float*)c.lds;
    float* red = (float*)(c.lds + 9 * 1024 * 4);
    float* MOD = (float*)(c.ws + WS_MOD);
    bool have = false;
    for (int item = c.bid; item < 96; item += c.G) {
        if (!have) { for (int i = c.tid; i < 9 * 1024; i += NTHREADS) { const int r = i >> 10, k = i & 1023; const float v = r < 8 ? a.in[I_C][r * 1024 + k] : a.in[I_CCTX][k]; sc[i] = siluf_(v); } have = true; __syncthreads(); }
        const int n0 = item * 64;
        float acc[9];
#pragma unroll
        for (int r = 0; r < 9; ++r) acc[r] = 0.f;
        const float* wp = a.in[I_WMOD] + (size_t)(c.wave * 128) * 6144 + n0 + c.lane;
#pragma unroll 4
        for (int k = 0; k < 128; ++k) { const float w = wp[(size_t)k * 6144];
#pragma unroll
            for (int r = 0; r < 9; ++r) acc[r] = fmaf(sc[r * 1024 + c.wave * 128 + k], w, acc[r]); }
#pragma unroll
        for (int r = 0; r < 9; ++r) red[(c.wave * 9 + r) * 64 + c.lane] = acc[r];
        __syncthreads();
        for (int i = c.tid; i < 576; i += NTHREADS) { const int r = i >> 6, l = i & 63; float s = a.in[I_BMOD][n0 + l];
#pragma unroll
            for (int w = 0; w < 8; ++w) s += red[(w * 9 + r) * 64 + l];
            MOD[r * 6144 + n0 + l] = s; }
        __syncthreads();
    }
}
__device__ __forceinline__ void s5_build_group(const Ctx& c, int g, int part);
__device__ __forceinline__ void phase_s5_build(const Ctx& c) { for (int it = c.bid; it < 256; it += c.G) s5_build_group(c, it >> 3, it & 7); }

__device__ __forceinline__ void phase_norm1(const Ctx& c) {
    const Args& a = *c.a;
    float* wabT = (float*)c.lds;
    for (int i = c.tid; i < 1024 * 16; i += NTHREADS) { const int k = i >> 4, j = i & 15; wabT[j * 1028 + k] = a.in[I_WIN][(size_t)k * PROJ + NPROJ + j]; }
    __syncthreads();
    const float* MOD = (const float*)(c.ws + WS_MOD);
    bf16* HX = (bf16*)(c.ws + WS_HX); float* GB = (float*)(c.ws + WS_GB);
    const float* gpre = a.in[I_GPREMIX];
    for (int row = c.gw; row < MT; row += c.NGW) {
        const f32x4* xr = (const f32x4*)in_row(a, row) + c.lane;
        const float* mr = MOD + mod_row(row) * 6144;
        f32x4 v[4]; float ss = 0.f;
#pragma unroll
        for (int j = 0; j < 4; ++j) { v[j] = xr[64 * j]; ss += (v[j].x * v[j].x + v[j].y * v[j].y) + (v[j].z * v[j].z + v[j].w * v[j].w); }
        const float r = rsqrtf(wave_sum(ss) * (1.f / D) + EPS);
#pragma unroll
        for (int j = 0; j < 4; ++j) { const int col = 4 * c.lane + 256 * j;
            const f32x4 g4 = *(const f32x4*)(gpre + col), sh = *(const f32x4*)(mr + col), scl = *(const f32x4*)(mr + 1024 + col);
            v[j] = (v[j] * r) * g4 * (scl + 1.f) + sh;
            v2u o; o.x = pk2(v[j].x, v[j].y); o.y = pk2(v[j].z, v[j].w);
            *(v2u*)(HX + (size_t)row * D + col) = o; }
        float mine = 0.f;
#pragma unroll 1
        for (int j = 0; j < 16; ++j) { float s = 0.f;
#pragma unroll
            for (int jj = 0; jj < 4; ++jj) { const f32x4 w = *(const f32x4*)(wabT + j * 1028 + 4 * c.lane + 256 * jj); s += (v[jj].x * w.x + v[jj].y * w.y) + (v[jj].z * w.z + v[jj].w * w.w); }
            s = wave_sum(s); mine = (c.lane == j) ? s : mine; }
        if (c.lane < 8) { const float t = mine + a.in[I_DTBIAS][c.lane]; const float sp = t > 20.f ? t : log1pf(expf(t)); GB[(size_t)row * 16 + c.lane] = -expf(a.in[I_ALOG][c.lane]) * sp; }
        else if (c.lane < 16) GB[(size_t)row * 16 + c.lane] = 1.f / (1.f + expf(-mine));
    }
}

__device__ __forceinline__ void phase_conv(const Ctx& c) {
    const Args& a = *c.a;
    const bf16* PRE = (const bf16*)(c.ws + WS_QKVPRE); bf16* OUT = (bf16*)(c.ws + WS_QKV);
    const float* cw = a.in[I_CONV];
#pragma unroll 1
    for (int pass = 0; pass < 3; ++pass) { const int ch0 = pass * 512 + 8 * c.lane;
        f32x4 wt[9][2];
#pragma unroll
        for (int i = 0; i < 9; ++i) { wt[i][0] = *(const f32x4*)(cw + i * 1536 + ch0); wt[i][1] = *(const f32x4*)(cw + i * 1536 + ch0 + 4); }
#pragma unroll 1
        for (int row = c.gw; row < MT; row += c.NGW) {
            int nb_row[9]; bool ok[9];
            if (row < ML) { const int t = row & 2047, gr = t >> 6, gc = t & 63;
#pragma unroll
                for (int dy = -1; dy <= 1; ++dy)
#pragma unroll
                    for (int dx = -1; dx <= 1; ++dx) { const int i = (dy + 1) * 3 + dx + 1; ok[i] = (gr + dy >= 0) && (gr + dy < 32) && (gc + dx >= 0) && (gc + dx < 64); nb_row[i] = row + dy * 64 + dx; } }
            else { const int t = (row - ML) & 255;
#pragma unroll
                for (int i = 0; i < 9; ++i) { ok[i] = false; nb_row[i] = row; }
#pragma unroll
                for (int dx = -1; dx <= 1; ++dx) { ok[4 + dx] = (t + dx >= 0) && (t + dx < 256); nb_row[4 + dx] = row + dx; } }
            v4u in[9];
#pragma unroll
            for (int i = 0; i < 9; ++i) in[i] = ok[i] ? *(const v4u*)(PRE + (size_t)nb_row[i] * 1536 + ch0) : (v4u){0u, 0u, 0u, 0u};
            float o[8];
#pragma unroll
            for (int q = 0; q < 8; ++q) o[q] = 0.f;
#pragma unroll
            for (int i = 0; i < 9; ++i) { const unsigned w[4] = {in[i].x, in[i].y, in[i].z, in[i].w}; const float kk[8] = {wt[i][0].x, wt[i][0].y, wt[i][0].z, wt[i][0].w, wt[i][1].x, wt[i][1].y, wt[i][1].z, wt[i][1].w};
#pragma unroll
                for (int q = 0; q < 4; ++q) { o[2 * q] = fmaf(bflo(w[q]), kk[2 * q], o[2 * q]); o[2 * q + 1] = fmaf(bfhi(w[q]), kk[2 * q + 1], o[2 * q + 1]); } }
            float ssq = 0.f;
#pragma unroll
            for (int q = 0; q < 8; ++q) { o[q] = siluf_(o[q]); ssq = fmaf(o[q], o[q], ssq); }
            if (pass < 2) { const float sc = rsqrtf(row_sum16(ssq) + EPS) * (pass == 0 ? 0.08838834764831845f : 1.f);
#pragma unroll
                for (int q = 0; q < 8; ++q) o[q] *= sc; }
            v4u ov; ov.x = pk2(o[0], o[1]); ov.y = pk2(o[2], o[3]); ov.z = pk2(o[4], o[5]); ov.w = pk2(o[6], o[7]);
            *(v4u*)(OUT + (size_t)row * 1536 + ch0) = ov;
        }
    }
}

__device__ __forceinline__ int scan_row(int b, int dir, int step) {
    if (step < LC) { const int t = dir ? LC - 1 - step : step; return ML + b * LC + t; }
    const int t = step - LC; return b * SEQ + (dir ? SEQ - 1 - t : t);
}
__device__ __forceinline__ void phase_combine(const Ctx& c) {
    const Args& a = *c.a;
    const bf16* OG0 = (const bf16*)(c.ws + WS_OG); const bf16* OG1 = OG0 + (size_t)ML * 512; const bf16* Z = (const bf16*)(c.ws + WS_Z);
    bf16* CAT = (bf16*)(c.ws + WS_CAT);
    for (int row = c.gw; row < ML; row += c.NGW) {
#pragma unroll
        for (int h = 0; h < 4; ++h) { const int ch = h * 128 + 2 * c.lane;
            const unsigned w0 = *(const unsigned*)(OG0 + (size_t)row * 512 + ch), w1 = *(const unsigned*)(OG1 + (size_t)row * 512 + ch), zw = *(const unsigned*)(Z + (size_t)row * 512 + ch);
            const float o0 = bflo(w0) + bflo(w1), o1 = bfhi(w0) + bfhi(w1);
            const float r = rsqrtf(wave_sum(o0 * o0 + o1 * o1) * (1.f / 128.f) + EPS);
            const f32x2 ng = *(const f32x2*)(a.in[I_GDNNORM] + 2 * c.lane);
            *(unsigned*)(CAT + (size_t)row * 1024 + 512 + ch) = pk2(o0 * r * ng.x * siluf_(bflo(zw)), o1 * r * ng.y * siluf_(bfhi(zw))); }
    }
}

__device__ __forceinline__ void phase_rows2(const Ctx& c) {
    const Args& a = *c.a;
    const float* MOD = (const float*)(c.ws + WS_MOD); const float* YRAW = (const float*)(c.ws + WS_YRAW); bf16* HX2 = (bf16*)(c.ws + WS_HX2);
    for (int row = c.gw; row < ML; row += c.NGW) {
        const float* mr = MOD + (row >> 11) * 6144;
        f32x4 y[4], x[4]; float ss = 0.f;
#pragma unroll
        for (int j = 0; j < 4; ++j) { y[j] = *((const f32x4*)(YRAW + (size_t)row * D) + c.lane + 64 * j); x[j] = *((const f32x4*)(a.in[I_X] + (size_t)row * D) + c.lane + 64 * j);
            ss += (y[j].x * y[j].x + y[j].y * y[j].y) + (y[j].z * y[j].z + y[j].w * y[j].w); }
        const float r = rsqrtf(wave_sum(ss) * (1.f / D) + EPS); float s2 = 0.f;
#pragma unroll
        for (int j = 0; j < 4; ++j) { const int col = 4 * c.lane + 256 * j;
            const f32x4 g4 = *(const f32x4*)(a.in[I_GPOSTMIX] + col), gt = *(const f32x4*)(mr + 2048 + col);
            x[j] = x[j] + gt * ((y[j] * r) * g4);
            *(f32x4*)(a.out + (size_t)row * D + col) = x[j];
            s2 += (x[j].x * x[j].x + x[j].y * x[j].y) + (x[j].z * x[j].z + x[j].w * x[j].w); }
        const float r2 = rsqrtf(wave_sum(s2) * (1.f / D) + EPS);
#pragma unroll
        for (int j = 0; j < 4; ++j) { const int col = 4 * c.lane + 256 * j;
            const f32x4 g4 = *(const f32x4*)(a.in[I_GPREFFN] + col), sh = *(const f32x4*)(mr + 3072 + col), scl = *(const f32x4*)(mr + 4096 + col);
            const f32x4 hv = (x[j] * r2) * g4 * (scl + 1.f) + sh;
            v2u o; o.x = pk2(hv.x, hv.y); o.y = pk2(hv.z, hv.w);
            *(v2u*)(HX2 + (size_t)row * D + col) = o; }
    }
}


constexpr int KROW = 136;
__device__ __forceinline__ void phase_topk(const Ctx& c) {
    const Args& a = *c.a;
    bf16* kl = (bf16*)c.lds;
    unsigned char* wbase = c.lds + 2 * 128 * KROW * 2 + c.wave * 1024;
    bf16* qs = (bf16*)wbase;
    float* s1 = (float*)(wbase + 512); int* i1 = (int*)(wbase + 576); float* s2 = (float*)(wbase + 640); int* i2 = (int*)(wbase + 704); float* fs = (float*)(wbase + 768); int* fi = (int*)(wbase + 832);
    const bf16* QP = (const bf16*)(c.ws + WS_QP); int* IDX = (int*)(c.ws + WS_IDX); float* GATE = (float*)(c.ws + WS_GATE);
    for (int item = c.bid; item < 8 * 32; item += c.G) {
        const int h = item & 7, tr = item >> 3;
        __syncthreads();
        for (int i = c.tid; i < 2 * 128 * 64; i += NTHREADS) { const int k2 = i & 63, n = (i >> 6) & 127, p = i >> 13; const f32x2 kv = *(const f32x2*)(a.in[I_KEYS] + ((size_t)((h * 2 + p) * 128 + n)) * 128 + 2 * k2);
            *(unsigned*)(kl + (p * 128 + n) * KROW + 2 * k2) = pk2(kv.x, kv.y); }
        __syncthreads();
        v2u qnext = *(const v2u*)(QP + (size_t)(tr * 512 + c.wave) * 2048 + h * 256 + 4 * c.lane);
        for (int tt = c.wave; tt < 512; tt += NWAVES) {
            const int tok = tr * 512 + tt;
            *(v2u*)(qs + 4 * c.lane) = qnext;
            if (tt + NWAVES < 512) qnext = *(const v2u*)(QP + (size_t)(tok + NWAVES) * 2048 + h * 256 + 4 * c.lane);
            WAVE_LDS_SYNC();
            float sc[2][2];
#pragma unroll
            for (int p = 0; p < 2; ++p) { float sa0 = 0.f, sa1 = 0.f, sb0 = 0.f, sb1 = 0.f;
#pragma unroll 4
                for (int kk = 0; kk < 16; ++kk) { const bf16x2_t* qp = (const bf16x2_t*)(qs + p * 128 + kk * 8); const bf16x2_t* ap = (const bf16x2_t*)(kl + (p * 128 + c.lane) * KROW + kk * 8); const bf16x2_t* bp = (const bf16x2_t*)(kl + (p * 128 + c.lane + 64) * KROW + kk * 8);
                    const bf16x2_t q0 = qp[0], q1 = qp[1], q2 = qp[2], q3 = qp[3], a0 = ap[0], a1 = ap[1], a2 = ap[2], a3 = ap[3], b0 = bp[0], b1 = bp[1], b2 = bp[2], b3 = bp[3];
                    sa0 = __builtin_amdgcn_fdot2_f32_bf16(q0, a0, sa0, false); sa1 = __builtin_amdgcn_fdot2_f32_bf16(q1, a1, sa1, false); sa0 = __builtin_amdgcn_fdot2_f32_bf16(q2, a2, sa0, false); sa1 = __builtin_amdgcn_fdot2_f32_bf16(q3, a3, sa1, false);
                    sb0 = __builtin_amdgcn_fdot2_f32_bf16(q0, b0, sb0, false); sb1 = __builtin_amdgcn_fdot2_f32_bf16(q1, b1, sb1, false); sb0 = __builtin_amdgcn_fdot2_f32_bf16(q2, b2, sb0, false); sb1 = __builtin_amdgcn_fdot2_f32_bf16(q3, b3, sb1, false); }
                sc[p][0] = sa0 + sa1; sc[p][1] = sb0 + sb1; }
#pragma unroll
            for (int p = 0; p < 2; ++p) { float* so = p ? s2 : s1; int* io = p ? i2 : i1;
                const unsigned ky[2] = {fkey(sc[p][0]), fkey(sc[p][1])};
                const unsigned T = kth_key<2>(ky, 16);
                int cgt = 0;
#pragma unroll
                for (int n = 0; n < 2; ++n) cgt += __popcll(__ballot(ky[n] > T));
                const int need = 16 - cgt; int base = 0, eqb = 0;
#pragma unroll
                for (int n = 0; n < 2; ++n) { const bool eq = ky[n] == T; const unsigned long long em = __ballot(eq); const bool sel = (ky[n] > T) || (eq && (eqb + lane_rank(em)) < need);
                    const unsigned long long sm = __ballot(sel); if (sel) { const int pos = base + lane_rank(sm); so[pos] = sc[p][n]; io[pos] = c.lane + 64 * n; }
                    base += __popcll(sm); eqb += __popcll(em); } }
            WAVE_LDS_SYNC();
            { const int ci = c.lane >> 2, cj = 4 * (c.lane & 3);
              float cv[4]; unsigned ky[4]; const float b1 = s1[ci];
#pragma unroll
              for (int e = 0; e < 4; ++e) { cv[e] = b1 + s2[cj + e]; ky[e] = fkey(cv[e]); }
              const unsigned T = kth_key<4>(ky, 16);
              int cgt = 0;
#pragma unroll
              for (int e = 0; e < 4; ++e) cgt += __popcll(__ballot(ky[e] > T));
              const int need = 16 - cgt; int base = 0, eqb = 0; const int e1 = i1[ci] * 128;
#pragma unroll
              for (int e = 0; e < 4; ++e) { const bool eq = ky[e] == T; const unsigned long long em = __ballot(eq); const bool sel = (ky[e] > T) || (eq && (eqb + lane_rank(em)) < need);
                  const unsigned long long sm = __ballot(sel); if (sel) { const int pos = base + lane_rank(sm); fs[pos] = cv[e]; fi[pos] = e1 + i2[cj + e]; }
                  base += __popcll(sm); eqb += __popcll(em); } }
            WAVE_LDS_SYNC();
            { const float v = fs[c.lane & 15]; const float mx = row_max16(v); const float ex = __expf(v - mx); const float den = row_sum16(ex);
              if (c.lane < 16) { IDX[(size_t)tok * 128 + h * 16 + c.lane] = fi[c.lane]; GATE[(size_t)tok * 128 + h * 16 + c.lane] = ex / den; } }
            WAVE_LDS_SYNC();
        }
    }
}

__device__ __forceinline__ void phase_fp8_tables(const Ctx& c) {
    const Args& a = *c.a;
    for (int r = c.gw; r < 2 * NEXP; r += c.NGW) {
        const bool isv = r >= NEXP; const int e = isv ? r - NEXP : r;
        const f32x4* src = (const f32x4*)((isv ? a.in[I_PV] : a.in[I_PU]) + (size_t)e * D) + 4 * c.lane;
        f32x4 v[4]; float m = 0.f;
#pragma unroll
        for (int j = 0; j < 4; ++j) { v[j] = src[j]; m = fmaxf(m, fmaxf(fmaxf(fabsf(v[j].x), fabsf(v[j].y)), fmaxf(fabsf(v[j].z), fabsf(v[j].w)))); }
        m = wmax(m); const float inv = m > 0.f ? 256.f / m : 0.f;
        v4u o; unsigned ow[4];
#pragma unroll
        for (int j = 0; j < 4; ++j) { int w = __builtin_amdgcn_cvt_pk_fp8_f32(v[j].x * inv, v[j].y * inv, 0, false); w = __builtin_amdgcn_cvt_pk_fp8_f32(v[j].z * inv, v[j].w * inv, w, true); ow[j] = (unsigned)w; }
        o.x = ow[0]; o.y = ow[1]; o.z = ow[2]; o.w = ow[3];
        *(v4u*)(c.ws + (isv ? WS_V8 : WS_U8) + (size_t)e * D + 16 * c.lane) = o;
        if (c.lane == 0) ((float*)(c.ws + (isv ? WS_VSC : WS_USC)))[e] = m * (1.f / 256.f);
    }
}
__device__ __forceinline__ void fp8x16_to_f32(const v4u& r, float (&f)[16]) {
    const unsigned w[4] = {r.x, r.y, r.z, r.w};
#pragma unroll
    for (int j = 0; j < 4; ++j) { const f32x2 lo = __builtin_amdgcn_cvt_pk_f32_fp8((int)w[j], false), hi = __builtin_amdgcn_cvt_pk_f32_fp8((int)w[j], true); f[4 * j] = lo.x; f[4 * j + 1] = lo.y; f[4 * j + 2] = hi.x; f[4 * j + 3] = hi.y; }
}
__device__ __forceinline__ unsigned xcc_id() { return (unsigned)__builtin_amdgcn_s_getreg((3 << 11) | 20) & 7u; }

__device__ __forceinline__ void phase_exp1(const Ctx& c) {
    const bf16* HX2 = (const bf16*)(c.ws + WS_HX2); const int* IDX = (const int*)(c.ws + WS_IDX); const float* GATE = (const float*)(c.ws + WS_GATE);
    const unsigned char* U8 = c.ws + WS_U8; const float* USC = (const float*)(c.ws + WS_USC); const float* VSC = (const float*)(c.ws + WS_VSC); float* ACT = (float*)(c.ws + WS_ACT);
    unsigned* cnt = (unsigned*)(c.ws + WS_CTL) + CW_E1;
    int* lk = (int*)(c.lds + c.wave * 1024); int* le = lk + 128;
    const int xcc = (int)xcc_id();
    const bool b5 = c.lane & 32, b4 = c.lane & 16, b3 = c.lane & 8, b2 = c.lane & 4;
    const int jl = (b5 ? 8 : 0) + (b4 ? 4 : 0) + (b3 ? 2 : 0) + (b2 ? 1 : 0);
    constexpr int CH = 8;
    int bo = 0, t = 0, tend = 0;
    v4u h0 = (v4u){0u, 0u, 0u, 0u}, h1 = h0; int eA = 0, eB = 0;
    for (;;) {
        if (t >= tend) {
            unsigned t0 = 0; if (c.lane == 0) t0 = __hip_atomic_fetch_add(cnt + 64 * ((xcc + bo) & 7), (unsigned)CH, __ATOMIC_RELAXED, __HIP_MEMORY_SCOPE_AGENT);
            t0 = (unsigned)__builtin_amdgcn_readfirstlane((int)t0);
            if (t0 >= (unsigned)ML) { if (++bo >= 8) break; continue; }
            t = (int)t0; tend = t + CH;
            h0 = *(const v4u*)(HX2 + (size_t)t * D + 16 * c.lane); h1 = *(const v4u*)(HX2 + (size_t)t * D + 16 * c.lane + 8); eA = IDX[(size_t)t * 128 + c.lane]; eB = IDX[(size_t)t * 128 + 64 + c.lane];
        }
        const int x = (xcc + bo) & 7;
        float hv[16];
        { const unsigned hw[8] = {h0.x, h0.y, h0.z, h0.w, h1.x, h1.y, h1.z, h1.w};
#pragma unroll
          for (int j = 0; j < 8; ++j) { hv[2 * j] = bflo(hw[j]); hv[2 * j + 1] = bfhi(hw[j]); } }
        const bool sA = (eA >> 11) == x, sB = (eB >> 11) == x; const unsigned long long mA = __ballot(sA), mB = __ballot(sB); const int nA = __popcll(mA), n = nA + __popcll(mB);
        if (sA) { const int pos = lane_rank(mA); lk[pos] = c.lane; le[pos] = eA; }
        if (sB) { const int pos = nA + lane_rank(mB); lk[pos] = c.lane + 64; le[pos] = eB; }
        if (t + 1 < tend) { h0 = *(const v4u*)(HX2 + (size_t)(t + 1) * D + 16 * c.lane); h1 = *(const v4u*)(HX2 + (size_t)(t + 1) * D + 16 * c.lane + 8); eA = IDX[(size_t)(t + 1) * 128 + c.lane]; eB = IDX[(size_t)(t + 1) * 128 + 64 + c.lane]; }
        WAVE_LDS_SYNC();
        for (int j0 = 0; j0 < n; j0 += 16) {
            const int jm = j0 + jl < n ? j0 + jl : 0; const int em = le[jm], km = lk[jm];
            const float usc = USC[em], vsc = VSC[em], gate = GATE[(size_t)t * 128 + km];
            float p[16];
#pragma unroll
            for (int jj = 0; jj < 16; ++jj) { const int j = j0 + jj; const int e = le[j < n ? j : 0];
                const v4u row = *(const v4u*)(U8 + (size_t)e * D + 16 * c.lane); float f[16]; fp8x16_to_f32(row, f); float s0 = 0.f, s1 = 0.f;
#pragma unroll
                for (int q = 0; q < 8; ++q) { s0 = fmaf(f[2 * q], hv[2 * q], s0); s1 = fmaf(f[2 * q + 1], hv[2 * q + 1], s1); }
                p[jj] = s0 + s1; }
            float q8[8], q4[4], q2[2];
#pragma unroll
            for (int i = 0; i < 8; ++i) { const float keep = b5 ? p[i + 8] : p[i], send = b5 ? p[i] : p[i + 8]; q8[i] = keep + __shfl_xor(send, 32); }
#pragma unroll
            for (int i = 0; i < 4; ++i) { const float keep = b4 ? q8[i + 4] : q8[i], send = b4 ? q8[i] : q8[i + 4]; q4[i] = keep + __shfl_xor(send, 16); }
#pragma unroll
            for (int i = 0; i < 2; ++i) { const float keep = b3 ? q4[i + 2] : q4[i], send = b3 ? q4[i] : q4[i + 2]; q2[i] = keep + dppf<0x140>(send); }
            float s; { const float keep = b2 ? q2[1] : q2[0], send = b2 ? q2[0] : q2[1]; s = keep + dppf<0x141>(send); }
            s += dppf<0xB1>(s); s += dppf<0x4E>(s);
            if (j0 + jl < n && (c.lane & 3) == 0) ACT[(size_t)t * 128 + km] = gelu_erf(s * usc) * gate * vsc;
        }
        WAVE_LDS_SYNC();
        ++t;
    }
}
__device__ __forceinline__ void phase_exp2(const Ctx& c) {
    const int* IDX = (const int*)(c.ws + WS_IDX); const float* ACT = (const float*)(c.ws + WS_ACT); const unsigned char* V8 = c.ws + WS_V8;
    float* Y = (float*)(c.ws + WS_Y); float* SSQP = (float*)(c.ws + WS_SSQP);
    unsigned* cnt = (unsigned*)(c.ws + WS_CTL) + CW_E2;
    int* li = (int*)(c.lds + c.wave * 1024); float* la = (float*)(li + 128);
    const int xcc = (int)xcc_id(), sub = c.lane & 7, grp = c.lane >> 3;
    const bool b5 = c.lane & 32, b4 = c.lane & 16, b3 = c.lane & 8;
    constexpr int CH = 8;
    int bo = 0, t = 0, tend = 0;
    int iA = 0, iB = 0; float aA = 0.f, aB = 0.f;
    for (;;) {
        if (t >= tend) {
            unsigned t0 = 0; if (c.lane == 0) t0 = __hip_atomic_fetch_add(cnt + 64 * ((xcc + bo) & 7), (unsigned)CH, __ATOMIC_RELAXED, __HIP_MEMORY_SCOPE_AGENT);
            t0 = (unsigned)__builtin_amdgcn_readfirstlane((int)t0);
            if (t0 >= (unsigned)ML) { if (++bo >= 8) break; continue; }
            t = (int)t0; tend = t + CH;
            iA = IDX[(size_t)t * 128 + c.lane]; iB = IDX[(size_t)t * 128 + 64 + c.lane]; aA = ACT[(size_t)t * 128 + c.lane]; aB = ACT[(size_t)t * 128 + 64 + c.lane];
        }
        const int x = (xcc + bo) & 7;
        li[c.lane] = iA; li[64 + c.lane] = iB; la[c.lane] = aA; la[64 + c.lane] = aB;
        if (t + 1 < tend) { iA = IDX[(size_t)(t + 1) * 128 + c.lane]; iB = IDX[(size_t)(t + 1) * 128 + 64 + c.lane]; aA = ACT[(size_t)(t + 1) * 128 + c.lane]; aB = ACT[(size_t)(t + 1) * 128 + 64 + c.lane]; }
        WAVE_LDS_SYNC();
        float acc[16];
#pragma unroll
        for (int q = 0; q < 16; ++q) acc[q] = 0.f;
#pragma unroll
        for (int hf = 0; hf < 2; ++hf) { v4u rows[8]; float av[8];
#pragma unroll
            for (int i = 0; i < 8; ++i) { const int k = 8 * (8 * hf + i) + grp; rows[i] = *(const v4u*)(V8 + (size_t)li[k] * D + x * 128 + 16 * sub); av[i] = la[k]; }
#pragma unroll
            for (int i = 0; i < 8; ++i) { float f[16]; fp8x16_to_f32(rows[i], f);
#pragma unroll
                for (int q = 0; q < 16; ++q) acc[q] = fmaf(av[i], f[q], acc[q]); } }
        float q8[8], q4[4], q2[2];
#pragma unroll
        for (int i = 0; i < 8; ++i) { const float keep = b5 ? acc[i + 8] : acc[i], send = b5 ? acc[i] : acc[i + 8]; q8[i] = keep + __shfl_xor(send, 32); }
#pragma unroll
        for (int i = 0; i < 4; ++i) { const float keep = b4 ? q8[i + 4] : q8[i], send = b4 ? q8[i] : q8[i + 4]; q4[i] = keep + __shfl_xor(send, 16); }
#pragma unroll
        for (int i = 0; i < 2; ++i) { const float keep = b3 ? q4[i + 2] : q4[i], send = b3 ? q4[i] : q4[i + 2]; q2[i] = keep + __shfl_xor(send, 8); }
        const int col = x * 128 + 16 * sub + (b5 ? 8 : 0) + (b4 ? 4 : 0) + (b3 ? 2 : 0);
        *(f32x2*)(Y + (size_t)t * D + col) = (f32x2){q2[0], q2[1]};
        const float ss = wsum(q2[0] * q2[0] + q2[1] * q2[1]);
        SSQP[(size_t)x * ML + t] = ss;
        WAVE_LDS_SYNC();
        ++t;
    }
}
__device__ __forceinline__ void phase_exp3(const Ctx& c) {
    const Args& a = *c.a;
    const float* MOD = (const float*)(c.ws + WS_MOD); const float* Y = (const float*)(c.ws + WS_Y); const float* SSQP = (const float*)(c.ws + WS_SSQP);
    for (int row = c.gw; row < ML; row += c.NGW) {
        float ss = 0.f;
#pragma unroll
        for (int x = 0; x < 8; ++x) ss += SSQP[(size_t)x * ML + row];
        const float r = rsqrtf(ss * (1.f / D) + EPS); const float* mr = MOD + (row >> 11) * 6144 + 5120;
#pragma unroll
        for (int j = 0; j < 4; ++j) { const int col = 4 * c.lane + 256 * j;
            const f32x4 y = *(const f32x4*)(Y + (size_t)row * D + col), x1 = *(const f32x4*)(a.out + (size_t)row * D + col), g4 = *(const f32x4*)(a.in[I_GPOSTFFN] + col), gt = *(const f32x4*)(mr + col);
            *(f32x4*)(a.out + (size_t)row * D + col) = x1 + gt * ((y * r) * g4); }
    }
}

__device__ __forceinline__ void phase_experts(const Ctx& c) {
    const Args& a = *c.a;
    const float* MOD = (const float*)(c.ws + WS_MOD); const bf16* HX2 = (const bf16*)(c.ws + WS_HX2); const int* IDX = (const int*)(c.ws + WS_IDX); const float* GATE = (const float*)(c.ws + WS_GATE);
    float* acts = (float*)c.lds; int* eid = (int*)(c.lds + 512); float* red = (float*)(c.lds + 1024);
    for (int tok = c.bid; tok < ML; tok += c.G) {
        float hv[16];
#pragma unroll
        for (int j = 0; j < 4; ++j) { const v2u w = *(const v2u*)(HX2 + (size_t)tok * D + 4 * c.lane + 256 * j); hv[4 * j] = bflo(w.x); hv[4 * j + 1] = bfhi(w.x); hv[4 * j + 2] = bflo(w.y); hv[4 * j + 3] = bfhi(w.y); }
#pragma unroll 4
        for (int i = 0; i < 16; ++i) { const int k = c.wave * 16 + i; const int e = IDX[(size_t)tok * 128 + k];
            const f32x4* ur = (const f32x4*)(a.in[I_PU] + (size_t)e * D) + c.lane; float s = 0.f;
#pragma unroll
            for (int j = 0; j < 4; ++j) { const f32x4 u4 = ur[64 * j]; s += (u4.x * hv[4 * j] + u4.y * hv[4 * j + 1]) + (u4.z * hv[4 * j + 2] + u4.w * hv[4 * j + 3]); }
            s = wave_sum(s);
            if (c.lane == 0) { acts[k] = gelu_erf(s) * GATE[(size_t)tok * 128 + k]; eid[k] = e; } }
        __syncthreads();
        f32x2 acc = (f32x2){0.f, 0.f};
#pragma unroll 8
        for (int k = 0; k < 128; ++k) { const f32x2 v2 = *(const f32x2*)(a.in[I_PV] + (size_t)eid[k] * D + 2 * c.tid); const float ak = acts[k]; acc.x = fmaf(ak, v2.x, acc.x); acc.y = fmaf(ak, v2.y, acc.y); }
        const float ws = wave_sum(acc.x * acc.x + acc.y * acc.y);
        if (c.lane == 0) red[c.wave] = ws;
        __syncthreads();
        float tot = 0.f;
#pragma unroll
        for (int w = 0; w < 8; ++w) tot += red[w];
        const float r = rsqrtf(tot * (1.f / D) + EPS);
        const int col = 2 * c.tid; const float* mr = MOD + (tok >> 11) * 6144 + 5120;
        const f32x2 x1 = *(const f32x2*)(a.out + (size_t)tok * D + col), g2 = *(const f32x2*)(a.in[I_GPOSTFFN] + col), gt = *(const f32x2*)(mr + col);
        *(f32x2*)(a.out + (size_t)tok * D + col) = (f32x2){x1.x + gt.x * (acc.x * r * g2.x), x1.y + gt.y * (acc.y * r * g2.y)};
        __syncthreads();
    }
}


constexpr int S5_LPOW = 0, S5_BBAR = 33792, S5_CC = 50176, S5_MM = 66560;
__device__ __forceinline__ void s5_build_group(const Ctx& c, int g, int part) {
    const Args& a = *c.a;
    f32x2* LPOW = (f32x2*)(c.lds + S5_LPOW);
    f32x2* BBAR = (f32x2*)(c.lds + S5_BBAR);
    f32x2* CC = (f32x2*)(c.lds + S5_CC);
    float* MM = (float*)(c.lds + S5_MM);
    __syncthreads();
    if (c.tid < 128) { const int dir = c.tid >> 6, p = c.tid & 63, dg = dir * 32 + g;
        const float dt = expf(a.in[I_LOGDT][dg]), lr = a.in[I_LAMRE][dg * 64 + p], li = a.in[I_LAMIM][dg * 64 + p];
        const double ang = (double)li * (double)dt; const float lrdt = lr * dt;
        for (int e = 0; e <= 32; ++e) { float sn, cs; sincos_d(ang * (double)e, sn, cs); const float mg = expf(lrdt * (float)e); LPOW[(dir * 33 + e) * 64 + p] = (f32x2){mg * cs, mg * sn}; }
        float sn, cs; sincos_d(ang, sn, cs); const float mag = expf(lrdt), lbr = mag * cs, lbi = mag * sn, den = lr * lr + li * li, nr = lbr - 1.f;
        const float cr = (nr * lr + lbi * li) / den, ci = (lbi * lr - nr * li) / den;
        for (int ch = 0; ch < 16; ++ch) { const float br = a.in[I_BRE][(size_t)(dg * 64 + p) * 16 + ch], bi = a.in[I_BIM][(size_t)(dg * 64 + p) * 16 + ch]; BBAR[(dir * 64 + p) * 16 + ch] = (f32x2){cr * br - ci * bi, cr * bi + ci * br}; } }
    for (int i = c.tid; i < 2048; i += NTHREADS) { const int dir = i >> 10, ch = (i >> 6) & 15, p = i & 63, dg = dir * 32 + g; CC[i] = (f32x2){a.in[I_CRE][(size_t)(dg * 16 + ch) * 64 + p], a.in[I_CIM][(size_t)(dg * 16 + ch) * 64 + p]}; }
    __syncthreads();
    for (int task = c.tid; task < 1024; task += NTHREADS) { const int cpb = task & 3, cb = (task >> 2) & 3, lag = (task >> 4) & 31, dir = task >> 9;
        float acc[4][4];
#pragma unroll
        for (int i = 0; i < 4; ++i)
#pragma unroll
            for (int j = 0; j < 4; ++j) acc[i][j] = 0.f;
        for (int p = 0; p < 64; ++p) { const f32x2 l = LPOW[(dir * 33 + lag) * 64 + p]; f32x2 G[4], Cw[4];
#pragma unroll
            for (int j = 0; j < 4; ++j) { const f32x2 bb = BBAR[(dir * 64 + p) * 16 + 4 * cpb + j]; G[j] = (f32x2){l.x * bb.x - l.y * bb.y, l.x * bb.y + l.y * bb.x}; }
#pragma unroll
            for (int i = 0; i < 4; ++i) Cw[i] = CC[(dir * 16 + 4 * cb + i) * 64 + p];
#pragma unroll
            for (int i = 0; i < 4; ++i)
#pragma unroll
                for (int j = 0; j < 4; ++j) acc[i][j] += Cw[i].x * G[j].x - Cw[i].y * G[j].y; }
#pragma unroll
        for (int i = 0; i < 4; ++i)
#pragma unroll
            for (int j = 0; j < 4; ++j) MM[((dir * 32 + lag) * 16 + 4 * cb + i) * 16 + 4 * cpb + j] = acc[i][j]; }
    __syncthreads();
    if (c.tid < 128 && part == 0) { const int dir = c.tid >> 6, p = c.tid & 63; ((f32x2*)(c.ws + WS_LP))[(dir * 32 + g) * 64 + p] = LPOW[(dir * 33 + 32) * 64 + p]; }
    bf16* PMg = (bf16*)(c.ws + WS_PM) + (size_t)g * 256 * 512; bf16* BBg = (bf16*)(c.ws + WS_BB) + (size_t)g * 512 * 768;
    for (int task = part * 32 * 32 + c.tid; task < (part + 1) * 32 * 32; task += NTHREADS) { const int ip = task & 31, n = task >> 5, dir = n >> 7, im = (n >> 6) & 1, p = n & 63, e = dir ? ip : 31 - ip;
        const f32x2 l = LPOW[(dir * 33 + e) * 64 + p]; float o[16];
#pragma unroll
        for (int ch = 0; ch < 16; ++ch) { const f32x2 bb = BBAR[(dir * 64 + p) * 16 + ch]; o[ch] = im ? (l.x * bb.y + l.y * bb.x) : (l.x * bb.x - l.y * bb.y); }
        v4u w0, w1; w0.x = pk2(o[0], o[1]); w0.y = pk2(o[2], o[3]); w0.z = pk2(o[4], o[5]); w0.w = pk2(o[6], o[7]); w1.x = pk2(o[8], o[9]); w1.y = pk2(o[10], o[11]); w1.z = pk2(o[12], o[13]); w1.w = pk2(o[14], o[15]);
        *(v4u*)(PMg + (size_t)n * 512 + ip * 16) = w0; *(v4u*)(PMg + (size_t)n * 512 + ip * 16 + 8) = w1; }
    for (int task = part * 64 * 32 + c.tid; task < (part + 1) * 64 * 32; task += NTHREADS) { const int ip = task & 31, n = task >> 5, i = n >> 4, ch = n & 15; float o[16];
#pragma unroll
        for (int q = 0; q < 16; ++q) o[q] = 0.f;
        if (ip <= i) { const float* m0 = MM + ((0 * 32 + (i - ip)) * 16 + ch) * 16;
#pragma unroll
            for (int q = 0; q < 16; ++q) o[q] += m0[q]; }
        if (ip >= i) { const float* m1 = MM + ((1 * 32 + (ip - i)) * 16 + ch) * 16;
#pragma unroll
            for (int q = 0; q < 16; ++q) o[q] += m1[q]; }
        if (ip == i) { const float dsk = a.in[I_S5D][g * 16 + ch];
#pragma unroll
            for (int q = 0; q < 16; ++q) o[q] += (q == ch) ? dsk : 0.f; }
        v4u w0, w1; w0.x = pk2(o[0], o[1]); w0.y = pk2(o[2], o[3]); w0.z = pk2(o[4], o[5]); w0.w = pk2(o[6], o[7]); w1.x = pk2(o[8], o[9]); w1.y = pk2(o[10], o[11]); w1.z = pk2(o[12], o[13]); w1.w = pk2(o[14], o[15]);
        *(v4u*)(BBg + (size_t)n * 768 + ip * 16) = w0; *(v4u*)(BBg + (size_t)n * 768 + ip * 16 + 8) = w1; }
    for (int task = part * 64 * 32 + c.tid; task < (part + 1) * 64 * 32; task += NTHREADS) { const int p8 = task & 7, part = (task >> 3) & 3, n = task >> 5, i = n >> 4, ch = n & 15, dir = part >> 1, im = part & 1, e = dir ? 32 - i : i + 1; float o[8];
#pragma unroll
        for (int q = 0; q < 8; ++q) { const int p = p8 * 8 + q; const f32x2 l = LPOW[(dir * 33 + e) * 64 + p], cc = CC[(dir * 16 + ch) * 64 + p]; o[q] = im ? -(cc.x * l.y + cc.y * l.x) : (cc.x * l.x - cc.y * l.y); }
        v4u w0; w0.x = pk2(o[0], o[1]); w0.y = pk2(o[2], o[3]); w0.z = pk2(o[4], o[5]); w0.w = pk2(o[6], o[7]);
        *(v4u*)(BBg + (size_t)n * 768 + 512 + part * 64 + p8 * 8) = w0; }
}
__device__ __forceinline__ void s5_state_scan(const Ctx& c, int task) {
    const int dir = task & 1, g = (task >> 1) & 31, b = task >> 6, p = c.lane;
    const f32x2 a = ((const f32x2*)(c.ws + WS_LP))[(dir * 32 + g) * 64 + p];
    const float* SS = (const float*)(c.ws + WS_SS) + (size_t)g * 768 * 256 + dir * 128 + p; bf16* U5 = (bf16*)(c.ws + WS_U5) + (size_t)g * 768 * 768 + 512 + dir * 128 + p;
    float er = 0.f, ei = 0.f;
#pragma unroll 8
    for (int step = 0; step < 72; ++step) {
        const int R = (step < 8) ? 512 + b * 8 + (dir ? 7 - step : step) : b * 64 + (dir ? 71 - step : step - 8);
        if (step >= 8) { U5[(size_t)R * 768] = (bf16)f2bf(er); U5[(size_t)R * 768 + 64] = (bf16)f2bf(ei); }
        const float sr = SS[(size_t)R * 256], si = SS[(size_t)R * 256 + 64];
        const float nr = sr + a.x * er - a.y * ei, ni = si + a.x * ei + a.y * er; er = nr; ei = ni;
    }
}

typedef short bf16x8 __attribute__((ext_vector_type(8)));
typedef float f32x16 __attribute__((ext_vector_type(16)));
#define MFMA32(a, b, c) __builtin_amdgcn_mfma_f32_32x32x16_bf16((a), (b), (c), 0, 0, 0)
constexpr int GDN_NCH = 36, GDN_ITEMS = NB * 4 * 2 * GDN_NCH;
constexpr size_t FR_T_BYTES = 8192, FR_ATT_BYTES = 8192, FR_KD_BYTES = 16384, FR_TAB_BYTES = 1024;
__device__ __forceinline__ int crow16(int i, int hh) { return (i & 3) + 8 * (i >> 2) + 4 * hh; }
__device__ __forceinline__ bf16x8 pack_step(const f32x16& x, int s) {
    v4u w; w.x = pk2(x[8 * s + 0], x[8 * s + 1]); w.y = pk2(x[8 * s + 2], x[8 * s + 3]); w.z = pk2(x[8 * s + 4], x[8 * s + 5]); w.w = pk2(x[8 * s + 6], x[8 * s + 7]);
    return __builtin_bit_cast(bf16x8, w);
}
__device__ __forceinline__ unsigned pk2v(float lo, float hi) { asm volatile("" : "+v"(lo), "+v"(hi)); return pk2(lo, hi); }
__device__ __forceinline__ bf16x8 pack_step_v(const f32x16& x, int s) {
    v4u w; w.x = pk2v(x[8 * s + 0], x[8 * s + 1]); w.y = pk2v(x[8 * s + 2], x[8 * s + 3]); w.z = pk2v(x[8 * s + 4], x[8 * s + 5]); w.w = pk2v(x[8 * s + 6], x[8 * s + 7]);
    return __builtin_bit_cast(bf16x8, w);
}
constexpr int GP_KR = 0, GP_QR = 17408, GP_KT = 34816, GP_LM = 53248, GP_TB = 70656, GP_TAB = 79872;
__device__ __forceinline__ void gdn_prep_item(const Ctx& c, int item) {
    const int n = item % GDN_NCH, bhd = item / GDN_NCH, dir = bhd & 1, h = (bhd >> 1) & 3, b = bhd >> 3;
    const bf16* QKV = (const bf16*)(c.ws + WS_QKV); const float* GB = (const float*)(c.ws + WS_GB);
    bf16* Kr = (bf16*)(c.lds + GP_KR); bf16* Qr = (bf16*)(c.lds + GP_QR); bf16* Kt = (bf16*)(c.lds + GP_KT); float* Lm = (float*)(c.lds + GP_LM); bf16* Tb = (bf16*)(c.lds + GP_TB); float* tab = (float*)(c.lds + GP_TAB);
    unsigned char* frT = c.ws + WS_FRT + (size_t)item * FR_T_BYTES; unsigned char* frA = c.ws + WS_FRA + (size_t)item * FR_ATT_BYTES; unsigned char* frK = c.ws + WS_FRK + (size_t)item * FR_KD_BYTES; float* frTab = (float*)(c.ws + WS_FRTAB + (size_t)item * FR_TAB_BYTES);
    const int r = c.lane & 31, hh = c.lane >> 5;
    if (c.wave == 0) { const int row = scan_row(b, dir, n * 64 + c.lane); float g = GB[(size_t)row * 16 + dir * 4 + h]; const float beta = GB[(size_t)row * 16 + 8 + dir * 4 + h];
#pragma unroll
        for (int o = 1; o < 64; o <<= 1) { const float t = __shfl_up(g, o); if (c.lane >= o) g += t; }
        const float gl = __shfl(g, 63);
        tab[c.lane] = g; tab[64 + c.lane] = beta; tab[128 + c.lane] = __expf(g); tab[192 + c.lane] = __expf(gl - g); }
    { const int s = c.tid >> 3, seg = c.tid & 7; const int row = scan_row(b, dir, n * 64 + s); const bf16* rp = QKV + (size_t)row * 1536 + h * 128 + seg * 16;
      const v4u q0 = *(const v4u*)rp, q1 = *(const v4u*)(rp + 8), k0 = *(const v4u*)(rp + 512), k1 = *(const v4u*)(rp + 520);
      *(v4u*)(Qr + s * 136 + seg * 16) = q0; *(v4u*)(Qr + s * 136 + seg * 16 + 8) = q1; *(v4u*)(Kr + s * 136 + seg * 16) = k0; *(v4u*)(Kr + s * 136 + seg * 16 + 8) = k1;
      const unsigned kw[8] = {k0.x, k0.y, k0.z, k0.w, k1.x, k1.y, k1.z, k1.w};
#pragma unroll
      for (int e = 0; e < 8; ++e) { Kt[(seg * 16 + 2 * e) * 72 + s] = (bf16)(kw[e] & 0xffffu); Kt[(seg * 16 + 2 * e + 1) * 72 + s] = (bf16)(kw[e] >> 16); } }
    __syncthreads();
    if (c.wave < 3) { const int ct = c.wave ? 1 : 0, st = c.wave == 2 ? 1 : 0;
        f32x16 acc;
#pragma unroll
        for (int i = 0; i < 16; ++i) acc[i] = 0.f;
#pragma unroll
        for (int kk = 0; kk < 8; ++kk) { const bf16x8 a = *(const bf16x8*)(Kr + (ct * 32 + r) * 136 + kk * 16 + hh * 8), bb = *(const bf16x8*)(Kr + (st * 32 + r) * 136 + kk * 16 + hh * 8); acc = MFMA32(a, bb, acc); }
        const int s = st * 32 + r; const float gcs = tab[s];
#pragma unroll
        for (int i = 0; i < 16; ++i) { const int cc = ct * 32 + crow16(i, hh); Lm[cc * 68 + s] = (s < cc) ? tab[64 + cc] * acc[i] * __expf(tab[cc] - gcs) : 0.f; }
    } else if (c.wave < 6) { const int w = c.wave - 3, st = w == 2 ? 1 : 0, ct = w ? 1 : 0;
        f32x16 acc;
#pragma unroll
        for (int i = 0; i < 16; ++i) acc[i] = 0.f;
#pragma unroll
        for (int kk = 0; kk < 8; ++kk) { const bf16x8 a = *(const bf16x8*)(Kr + (st * 32 + r) * 136 + kk * 16 + hh * 8), bb = *(const bf16x8*)(Qr + (ct * 32 + r) * 136 + kk * 16 + hh * 8); acc = MFMA32(a, bb, acc); }
        const int cc = ct * 32 + r; const float gcc = tab[cc];
#pragma unroll
        for (int i = 0; i < 16; ++i) { const int s = st * 32 + crow16(i, hh); acc[i] = (s <= cc) ? acc[i] * __expf(gcc - tab[s]) : 0.f; }
        *(bf16x8*)(frA + ((size_t)((ct * 4 + 2 * st) * 64 + c.lane)) * 16) = pack_step(acc, 0);
        *(bf16x8*)(frA + ((size_t)((ct * 4 + 2 * st + 1) * 64 + c.lane)) * 16) = pack_step(acc, 1);
    } else { const int w = c.wave - 6;
#pragma unroll
        for (int f = 0; f < 8; ++f) { const int fi = w * 8 + f, dkt = fi >> 2, cb = fi & 3; const bf16* kp = Kt + (dkt * 32 + r) * 72 + 16 * cb + 4 * hh;
            const v2u lo = *(const v2u*)kp, hi = *(const v2u*)(kp + 8); const f32x4 e0 = *(const f32x4*)(tab + 192 + 16 * cb + 4 * hh), e1 = *(const f32x4*)(tab + 192 + 16 * cb + 8 + 4 * hh);
            v4u o; o.x = pk2(bflo(lo.x) * e0.x, bfhi(lo.x) * e0.y); o.y = pk2(bflo(lo.y) * e0.z, bfhi(lo.y) * e0.w); o.z = pk2(bflo(hi.x) * e1.x, bfhi(hi.x) * e1.y); o.w = pk2(bflo(hi.y) * e1.z, bfhi(hi.y) * e1.w);
            *(v4u*)(frK + ((size_t)(fi * 64 + c.lane)) * 16) = o; }
        if (w == 0) { const v4u z = (v4u){0u, 0u, 0u, 0u}; *(v4u*)(frA + ((size_t)((0 * 4 + 2) * 64 + c.lane)) * 16) = z; *(v4u*)(frA + ((size_t)((0 * 4 + 3) * 64 + c.lane)) * 16) = z; }
        else { *(f32x4*)(frTab + 4 * c.lane) = *(const f32x4*)(tab + 4 * c.lane); }
    }
    __syncthreads();
    if (c.wave == 0) { float Tr[64];
#pragma unroll
        for (int i = 0; i < 64; ++i) { float a0 = (c.lane == i) ? 1.f : 0.f, a1 = 0.f;
#pragma unroll
            for (int s4 = 0; s4 < (i + 3) / 4; ++s4) { const f32x4 l4 = *(const f32x4*)(Lm + i * 68 + 4 * s4);
                if (4 * s4 + 0 < i) a0 = fmaf(-l4.x, Tr[4 * s4 + 0], a0); if (4 * s4 + 1 < i) a1 = fmaf(-l4.y, Tr[4 * s4 + 1], a1); if (4 * s4 + 2 < i) a0 = fmaf(-l4.z, Tr[4 * s4 + 2], a0); if (4 * s4 + 3 < i) a1 = fmaf(-l4.w, Tr[4 * s4 + 3], a1); }
            Tr[i] = a0 + a1; Tb[i * 72 + c.lane] = (bf16)f2bf(Tr[i]); } }
    __syncthreads();
    { const int ct = c.wave >> 2, sb = c.wave & 3; const bf16* tp = Tb + (ct * 32 + r) * 72 + 16 * sb + 4 * hh; const v2u lo = *(const v2u*)tp, hi = *(const v2u*)(tp + 8);
      *(v4u*)(frT + ((size_t)((ct * 4 + sb) * 64 + c.lane)) * 16) = (v4u){lo.x, lo.y, hi.x, hi.y}; }
    __syncthreads();
}
__device__ __forceinline__ void phase_gdn_prep(const Ctx& c) { for (int item = c.bid; item < GDN_ITEMS; item += c.G) gdn_prep_item(c, item); }

constexpr int GR_K = 0, GR_Q = 16384, GR_T = 32768, GR_A = 40960, GR_KD = 49152, GR_TAB = 65536, GR_BUF = 66560;
__device__ __forceinline__ void gdn_rec_stage(const Ctx& c, int bhd, int n, int buf) {
    const int dir = bhd & 1, h = (bhd >> 1) & 3, b = bhd >> 3, lw = c.wave - 4; const int item = bhd * GDN_NCH + n;
    LAS unsigned char* base = (LAS unsigned char*)c.lds + buf * GR_BUF;
    const unsigned char* QKVb = c.ws + WS_QKV;
#pragma unroll
    for (int q = 0; q < 4; ++q) { const int qi = lw + 4 * q;
        const int s = 4 * qi + (c.lane >> 4), ps = c.lane & 15, p = ps ^ (s & 15); const size_t rowb = (size_t)scan_row(b, dir, n * 64 + s) * 3072 + (size_t)h * 256 + p * 16;
        __builtin_amdgcn_global_load_lds((const unsigned*)(QKVb + rowb + 1024), (LAS unsigned*)(base + GR_K + qi * 1024), 16, 0, 0);
        __builtin_amdgcn_global_load_lds((const unsigned*)(QKVb + rowb), (LAS unsigned*)(base + GR_Q + qi * 1024), 16, 0, 0); }
    const unsigned char* frT = c.ws + WS_FRT + (size_t)item * FR_T_BYTES; const unsigned char* frA = c.ws + WS_FRA + (size_t)item * FR_ATT_BYTES; const unsigned char* frK = c.ws + WS_FRK + (size_t)item * FR_KD_BYTES;
#pragma unroll
    for (int q = 0; q < 2; ++q) { const int qi = lw + 4 * q;
        __builtin_amdgcn_global_load_lds((const unsigned*)(frT + qi * 1024 + c.lane * 16), (LAS unsigned*)(base + GR_T + qi * 1024), 16, 0, 0);
        __builtin_amdgcn_global_load_lds((const unsigned*)(frA + qi * 1024 + c.lane * 16), (LAS unsigned*)(base + GR_A + qi * 1024), 16, 0, 0); }
#pragma unroll
    for (int q = 0; q < 4; ++q) { const int qi = lw + 4 * q;
        __builtin_amdgcn_global_load_lds((const unsigned*)(frK + qi * 1024 + c.lane * 16), (LAS unsigned*)(base + GR_KD + qi * 1024), 16, 0, 0); }
    if (lw == 0) __builtin_amdgcn_global_load_lds((const unsigned*)(c.ws + WS_FRTAB + (size_t)item * FR_TAB_BYTES + c.lane * 16), (LAS unsigned*)(base + GR_TAB), 16, 0, 0);
}
__device__ __forceinline__ bf16x8 gr_rowfrag(const unsigned char* tile, int row, int kb, int hh) {
    const unsigned char* rp = tile + row * 256; const int sw = row & 15;
    const v2u lo = *(const v2u*)(rp + (((2 * kb) ^ sw) * 16) + 8 * hh), hi = *(const v2u*)(rp + (((2 * kb + 1) ^ sw) * 16) + 8 * hh);
    return __builtin_bit_cast(bf16x8, (v4u){lo.x, lo.y, hi.x, hi.y});
}
__device__ __forceinline__ void gdn_rec_block(const Ctx& c, int bhd) {
    const int dir = bhd & 1, h = (bhd >> 1) & 3, b = bhd >> 3, r = c.lane & 31, hh = c.lane >> 5, dvt = c.wave;
    const bf16* QKV = (const bf16*)(c.ws + WS_QKV); bf16* OG = (bf16*)(c.ws + WS_OG) + (size_t)dir * ML * 512;
    f32x16 S[4];
#pragma unroll
    for (int t = 0; t < 4; ++t)
#pragma unroll
        for (int i = 0; i < 16; ++i) S[t][i] = 0.f;
    if (c.wave >= 4) gdn_rec_stage(c, bhd, 0, 0);
    asm volatile("s_waitcnt vmcnt(0)" ::: "memory"); __syncthreads();
    for (int n = 0; n < GDN_NCH; ++n) {
        const int buf = n & 1;
        if (c.wave >= 4) { if (n + 1 < GDN_NCH) gdn_rec_stage(c, bhd, n + 1, buf ^ 1); }
        else {
            const unsigned char* base = c.lds + buf * GR_BUF; const float* tab = (const float*)(base + GR_TAB);
            const int row0 = scan_row(b, dir, n * 64), sgn = dir ? -1 : 1;
            const bf16* vcol = QKV + (size_t)row0 * 1536 + 1024 + h * 128 + dvt * 32 + r + (ptrdiff_t)(sgn * 4 * hh) * 1536;
            bf16* ocol = OG + (size_t)row0 * 512 + h * 128 + dvt * 32 + r + (ptrdiff_t)(sgn * 4 * hh) * 512;
            const ptrdiff_t vst = (ptrdiff_t)sgn * 1536, ost = (ptrdiff_t)sgn * 512;
            bf16 vraw[2][16];
#pragma unroll
            for (int st = 0; st < 2; ++st)
#pragma unroll
                for (int i = 0; i < 16; ++i) vraw[st][i] = vcol[vst * (st * 32 + (i & 3) + 8 * (i >> 2))];
            bf16x8 Rf[2][2];
#pragma unroll
            for (int st = 0; st < 2; ++st) { f32x16 acc;
#pragma unroll
                for (int i = 0; i < 16; ++i) acc[i] = 0.f;
#pragma unroll
                for (int kb = 0; kb < 8; ++kb) acc = MFMA32(gr_rowfrag(base + GR_K, st * 32 + r, kb, hh), pack_step_v(S[kb >> 1], kb & 1), acc);
#pragma unroll
                for (int i = 0; i < 16; ++i) { const int s = st * 32 + crow16(i, hh); acc[i] = tab[64 + s] * (bf1(vraw[st][i]) - tab[128 + s] * acc[i]); }
                Rf[st][0] = pack_step(acc, 0); Rf[st][1] = pack_step(acc, 1); asm volatile("" ::: "memory"); }
            bf16x8 Vf[2][2];
#pragma unroll
            for (int ct = 0; ct < 2; ++ct) { f32x16 acc;
#pragma unroll
                for (int i = 0; i < 16; ++i) acc[i] = 0.f;
#pragma unroll
                for (int sb = 0; sb < 4; ++sb) if (sb < 2 * ct + 2) acc = MFMA32(*(const bf16x8*)(base + GR_T + ((ct * 4 + sb) * 64 + c.lane) * 16), Rf[sb >> 1][sb & 1], acc);
                Vf[ct][0] = pack_step(acc, 0); Vf[ct][1] = pack_step(acc, 1); }
            asm volatile("" ::: "memory");
#pragma unroll
            for (int ct = 0; ct < 2; ++ct) { f32x16 acc;
#pragma unroll
                for (int i = 0; i < 16; ++i) acc[i] = 0.f;
#pragma unroll
                for (int kb = 0; kb < 8; ++kb) acc = MFMA32(gr_rowfrag(base + GR_Q, ct * 32 + r, kb, hh), pack_step_v(S[kb >> 1], kb & 1), acc);
#pragma unroll
                for (int i = 0; i < 16; ++i) acc[i] *= tab[128 + ct * 32 + crow16(i, hh)];
#pragma unroll
                for (int cb = 0; cb < 4; ++cb) if (cb < 2 * ct + 2) acc = MFMA32(*(const bf16x8*)(base + GR_A + ((ct * 4 + cb) * 64 + c.lane) * 16), Vf[cb >> 1][cb & 1], acc);
                if (n >= 4) {
#pragma unroll
                    for (int i = 0; i < 16; ++i) ocol[ost * (ct * 32 + (i & 3) + 8 * (i >> 2))] = (bf16)f2bf(acc[i]); }
                asm volatile("" ::: "memory"); }
            const float gtot = tab[128 + 63];
#pragma unroll
            for (int t = 0; t < 4; ++t) {
#pragma unroll
                for (int i = 0; i < 16; ++i) S[t][i] *= gtot;
#pragma unroll
                for (int cb = 0; cb < 4; ++cb) S[t] = MFMA32(*(const bf16x8*)(base + GR_KD + ((t * 4 + cb) * 64 + c.lane) * 16), Vf[cb >> 1][cb & 1], S[t]); }
        }
        if (c.wave >= 4) asm volatile("s_waitcnt vmcnt(0)" ::: "memory"); else asm volatile("s_waitcnt lgkmcnt(0)" ::: "memory");
        __builtin_amdgcn_s_barrier(); asm volatile("" ::: "memory");
    }
    asm volatile("s_waitcnt vmcnt(0)" ::: "memory"); __syncthreads();
}
__device__ __forceinline__ void phase_gdn_rec(const Ctx& c) { for (int bhd = c.bid; bhd < 64; bhd += 64) gdn_rec_block(c, bhd); }

#define XB_TMO      128
#define XB_XCNT(j)  (256  + 64 * (j))
#define XB_XSUB(j)  (1280 + 64 * (j))
#define XB_XGEN(j)  (2304 + 64 * (j))
#define XB_TOP      3328
#define XB_TOPGEN   3392
#define XCD_BAR_WORDS 3456
#define XB_SPIN_CAP (1u << 20)
__device__ __forceinline__ unsigned xb_ld(unsigned* p)              { return __hip_atomic_load(p, __ATOMIC_RELAXED, __HIP_MEMORY_SCOPE_AGENT); }
__device__ __forceinline__ unsigned xb_add(unsigned* p, unsigned v) { return __hip_atomic_fetch_add(p, v, __ATOMIC_RELAXED, __HIP_MEMORY_SCOPE_AGENT); }
__device__ __forceinline__ unsigned xb_xcc_id() { return (unsigned)__builtin_amdgcn_s_getreg((3 << 11) | 20) & 0xFu; }
#define XB_SPIN(cond, bar) do { unsigned _sp = 0; while (cond) { __builtin_amdgcn_s_sleep(1); \
    if ((++_sp & 255u) == 0u) { if (xb_ld(&(bar)[XB_TMO])) break; if (_sp > XB_SPIN_CAP) { atomicAdd(&(bar)[XB_TMO], 1u); break; } } } } while (0)
struct XcdBarrier { unsigned* bar; unsigned x; volatile LAS unsigned* st; };
__device__ __forceinline__ XcdBarrier xcd_barrier_post(unsigned* bar, volatile LAS unsigned* st) {
    XcdBarrier b; b.bar = bar; b.x = xb_xcc_id(); b.st = st;
    if (threadIdx.x == 0) (void)xb_add(&bar[XB_XCNT(b.x)], 1u);
    return b;
}
__device__ __forceinline__ void xcd_barrier_complete(unsigned* bar, unsigned x, unsigned& nloc, unsigned& nx) {
    const unsigned G = gridDim.x * gridDim.y * gridDim.z;
    unsigned sum, cnt, mine, sp = 0u;
    for (;;) {
        sum = 0u; cnt = 0u; mine = 0u;
#pragma unroll
        for (unsigned j = 0; j < 16; ++j) { const unsigned c = xb_ld(&bar[XB_XCNT(j)]); sum += c; cnt += (c > 0u) ? 1u : 0u; mine = (j == x) ? c : mine; }
        if (sum == G) break;
        __builtin_amdgcn_s_sleep(1);
        if ((++sp & 255u) == 0u) { if (xb_ld(&bar[XB_TMO])) break; if (sp > XB_SPIN_CAP) { atomicAdd(&bar[XB_TMO], 1u); break; } }
    }
    nloc = mine > 0u ? mine : 1u; nx = cnt > 0u ? cnt : 1u;
}
__device__ __forceinline__ void xcd_barrier(const XcdBarrier& b) {
    asm volatile("s_waitcnt vmcnt(0)" ::: "memory");
    __syncthreads();
    if (threadIdx.x == 0) {
        unsigned* bar = b.bar;
        __builtin_amdgcn_s_waitcnt(0);
        unsigned nloc = b.st[0], nx = b.st[1];
        if (nloc == 0u) { xcd_barrier_complete(bar, b.x, nloc, nx); b.st[0] = nloc; b.st[1] = nx; }
        const unsigned old = xb_add(&bar[XB_XSUB(b.x)], 1u);
        const unsigned gen = old / nloc;
        if (old + 1u == (gen + 1u) * nloc) {
            __builtin_amdgcn_fence(__ATOMIC_RELEASE, "agent");
            asm volatile("s_waitcnt vmcnt(0)" ::: "memory");
            const unsigned og = xb_add(&bar[XB_TOP], 1u);
            const unsigned tg = og / nx;
            if (og + 1u == (tg + 1u) * nx) xb_add(&bar[XB_TOPGEN], 1u);
            else XB_SPIN(xb_ld(&bar[XB_TOPGEN]) == tg, bar);
            __builtin_amdgcn_fence(__ATOMIC_ACQUIRE, "agent");
            xb_add(&bar[XB_XGEN(b.x)], 1u);
            asm volatile("s_waitcnt vmcnt(0)" ::: "memory");
        } else {
            XB_SPIN(xb_ld(&bar[XB_XGEN(b.x)]) == gen, bar);
            __builtin_amdgcn_fence(__ATOMIC_ACQUIRE, "agent");
            asm volatile("s_waitcnt vmcnt(0)" ::: "memory");
        }
    }
    __syncthreads();
}

constexpr int LDS_MISC = LDS_BYTES - 64;
__global__ void __launch_bounds__(NTHREADS, 2) mk_fwd(Args args) {
    extern __shared__ __attribute__((aligned(16))) unsigned char lds[];
    Ctx c; c.a = &args; c.ws = args.ws; c.lds = lds;
    c.tid = threadIdx.x; c.lane = c.tid & 63; c.wave = __builtin_amdgcn_readfirstlane(c.tid >> 6); c.bid = blockIdx.x; c.G = gridDim.x;
    c.gw = c.bid * NWAVES + c.wave; c.NGW = c.G * NWAVES; c.gwv = c.wave * c.G + c.bid;
    const int lo = args.ph_lo, hi = args.ph_hi;
    PG8_LAS unsigned char* ring = (PG8_LAS unsigned char*)lds;
#ifndef MK_PH_MASK
#define MK_PH_MASK 0xffff
#endif
#define IN(k) (((MK_PH_MASK >> (k)) & 1) && lo <= (k) && (k) < hi)
#if MK_ONE_LAUNCH
    cg::grid_group grid = cg::this_grid();
    if (lo < 0) grid.sync();
    volatile LAS unsigned* st = (volatile LAS unsigned*)((LAS unsigned char*)lds + LDS_MISC);
    if (c.tid < 2) st[c.tid] = 0u;
    __syncthreads();
    const XcdBarrier bar = xcd_barrier_post((unsigned*)(c.ws + WS_CTL) + CW_BAR, st);
#define SEAM(k) do { if (IN(k) && IN((k) + 1)) xcd_barrier(bar); } while (0)
#else
#define SEAM(k) do { } while (0)
#endif
    if (IN(0)) { phase_prep(c); phase_s5_build(c); } SEAM(0);
    if (IN(1)) { phase_norm1(c); } SEAM(1);
    if (IN(2)) { pg8::Gemm g{(const pg8::bf16_t*)(c.ws + WS_HX), (const pg8::bf16_t*)(c.ws + WS_WIN), 1024, 1024, 1024}; pg8::StaticOrder S; S.init(MT, NPROJ, c.G, c.bid);
        pg8::EpiInProj E{(pg8::bf16_t*)(c.ws + WS_U5), (pg8::bf16_t*)(c.ws + WS_QKVPRE), (pg8::bf16_t*)(c.ws + WS_Z)};
        pg8::gemm_phase<pg8::EpiInProj, pg8::StaticOrder, true, true>(ring, g, S, E); } SEAM(2);
    if (IN(3)) { { pg8::Gemm g{(const pg8::bf16_t*)(c.ws + WS_U5), (const pg8::bf16_t*)(c.ws + WS_PM), 768, 512, 512}; pg8::SchedSS S{c.G, c.bid}; pg8::EpiSS E{(float*)(c.ws + WS_SS)};
          pg8::gemm_phase<pg8::EpiSS, pg8::SchedSS, true, true>(ring, g, S, E); }
        __syncthreads(); phase_conv(c); } SEAM(3);
    if (IN(4)) { if (c.wave < 2) s5_state_scan(c, c.bid + c.G * c.wave < 512 ? c.bid + c.G * c.wave : 0); __syncthreads(); phase_gdn_prep(c); } SEAM(4);
    if (IN(5)) { pg8::Gemm g{(const pg8::bf16_t*)(c.ws + WS_U5), (const pg8::bf16_t*)(c.ws + WS_BB), 768, 768, 768}; pg8::SchedS5Y S{c.G, c.bid}; pg8::EpiS5Y E{(pg8::bf16_t*)(c.ws + WS_YG)};
        pg8::gemm_phase<pg8::EpiS5Y, pg8::SchedS5Y, true, true>(ring, g, S, E); } SEAM(5);
    if (IN(6)) { if (c.bid < 64) phase_gdn_rec(c);
        else { pg8::Gemm g{(const pg8::bf16_t*)(c.ws + WS_YG), (const pg8::bf16_t*)(c.ws + WS_WGLU), 512, 512, 512}; pg8::StaticOrder S; S.init(ML, 512, c.G - 64, c.bid - 64);
            pg8::EpiGlu E{(const pg8::bf16_t*)(c.ws + WS_YG), (pg8::bf16_t*)(c.ws + WS_CAT)};
            pg8::gemm_phase<pg8::EpiGlu, pg8::StaticOrder, true, true>(ring, g, S, E); } } SEAM(6);
    if (IN(7)) { phase_combine(c); } SEAM(7);
    if (IN(8)) { pg8::Gemm g{(const pg8::bf16_t*)(c.ws + WS_CAT), (const pg8::bf16_t*)(c.ws + WS_WOUT), 1024, 1024, 1024}; pg8::StaticOrder S; S.init(ML, 1024, c.G, c.bid);
        pg8::EpiF32 E{(float*)(c.ws + WS_YRAW), 1024};
        pg8::gemm_phase<pg8::EpiF32, pg8::StaticOrder, true, true>(ring, g, S, E); } SEAM(8);
    if (IN(9)) { phase_rows2(c); phase_fp8_tables(c); } SEAM(9);
    if (IN(10)) { pg8::Gemm g{(const pg8::bf16_t*)(c.ws + WS_HX2), (const pg8::bf16_t*)(c.ws + WS_WQ), 1024, 1024, 1024}; pg8::StaticOrder S; S.init(ML, 2048, c.G, c.bid);
        pg8::EpiBf16<0> E{(pg8::bf16_t*)(c.ws + WS_QP), 2048, nullptr, 0, 0, 1.f};
        pg8::gemm_phase<pg8::EpiBf16<0>, pg8::StaticOrder, true, true>(ring, g, S, E); } SEAM(10);
    if (IN(11)) { phase_topk(c); } SEAM(11);
    if (IN(12)) { phase_exp1(c); } SEAM(12);
    if (IN(13)) { phase_exp2(c); } SEAM(13);
    if (IN(14)) { phase_exp3(c); }
#undef IN
#undef SEAM
}

extern "C" void kernel_launch(void* const* d_in, const int* in_sizes, int n_in, void* d_out, int out_size, void* d_ws, size_t ws_size, hipStream_t stream) {
    static int grid = 0;
    if (grid == 0) {
        if (n_in != 29 || out_size != ML * D || ws_size < WS_END) { fprintf(stderr, "kernel_launch: unexpected shapes (n_in %d out %d ws %zu)\n", n_in, out_size, ws_size); grid = -1; return; }
        int dev = 0, cus = 0, per_cu = 0;
        (void)hipGetDevice(&dev); (void)hipDeviceGetAttribute(&cus, hipDeviceAttributeMultiprocessorCount, dev);
        if (hipFuncSetAttribute((const void*)mk_fwd, hipFuncAttributeMaxDynamicSharedMemorySize, LDS_BYTES) != hipSuccess) { fprintf(stderr, "kernel_launch: hipFuncSetAttribute failed\n"); grid = -1; return; }
        (void)hipOccupancyMaxActiveBlocksPerMultiprocessor(&per_cu, (const void*)mk_fwd, NTHREADS, LDS_BYTES);
        (void)hipGetLastError();
        grid = cus;
        fprintf(stderr, "kernel_launch: cus %d per_cu %d grid %d\n", cus, per_cu, grid);
    }
    if (grid < 0) return;
    Args a{};
    for (int i = 0; i < 29; ++i) a.in[i] = (const float*)d_in[i];
    a.out = (float*)d_out; a.ws = (unsigned char*)d_ws;
    (void)hipMemsetAsync((char*)d_ws + WS_CTL, 0, CTL_ZERO_BYTES, stream);
#if MK_ONE_LAUNCH
    a.ph_lo = 0; a.ph_hi = NPHASES;
    void* kargs[] = {&a};
    hipError_t e = hipLaunchCooperativeKernel((const void*)mk_fwd, dim3(grid), dim3(NTHREADS), kargs, LDS_BYTES, stream);
    if (e != hipSuccess) fprintf(stderr, "kernel_launch: cooperative launch failed: %s\n", hipGetErrorString(e));
#else
    for (int ph = 0; ph < NPHASES; ++ph) { a.ph_lo = ph; a.ph_hi = ph + 1; hipLaunchKernelGGL(mk_fwd, dim3(grid), dim3(NTHREADS), LDS_BYTES, stream, a); }
#endif
}
```

```cpp
#include <hip/hip_runtime.h>
#include <hip/hip_cooperative_groups.h>
#include <cstdio>
#include <cstdint>
namespace cg = cooperative_groups;
namespace pg8 {
#define PG8_LAS __attribute__((address_space(3)))
typedef unsigned short bf16_t;
typedef short bf16x8 __attribute__((ext_vector_type(8)));
typedef float f32x4 __attribute__((ext_vector_type(4)));
typedef unsigned u32x4 __attribute__((ext_vector_type(4)));
constexpr int BM = 256, BK = 64, HALF = 128, HTB = HALF * BK * 2  , STAGE_BYTES = 8 * HTB, NXCD = 8, WGM = 8;

__host__ __device__ __forceinline__ int lds_byte(int r, int c) { const int st = (r >> 4) * 2 + (c >> 5), rr = r & 15, cc = c & 31, ob = rr * 64 + cc * 2; return st * 1024 + (ob ^ (((ob >> 9) & 1) << 5)); }
__host__ __device__ __forceinline__ void stage_rc(int b, int& R, int& C) { const int st = b / 1024, sb = b % 1024, swz = sb ^ (((sb >> 9) & 1) << 5); R = (st >> 1) * 16 + swz / 64; C = (st & 1) * 32 + (swz % 64) / 2; }
__host__ __device__ __forceinline__ int perm32(int rho) { const int n = rho >> 4, i = rho & 15; return 8 * (i >> 2) + 4 * n + (i & 3); }

struct Unit { int pm, pn; };
struct Gemm { const bf16_t* A; const bf16_t* Bt; int lda, ldb, K; };

struct StaticOrder {
    int nM, nN, nwg, G, c;
    __host__ __device__ void init(int M, int N, int G_, int c_) { nM = M / BM; nN = N / BM; nwg = nM * nN; G = G_; c = c_; }
    __host__ __device__ bool next(int i, Unit& u) const {
        const long L = (long)i * G + c; if (L >= nwg) return false;
        int wgid = (int)L; { const int q = nwg / NXCD, r = nwg % NXCD, xcd = wgid % NXCD, off = wgid / NXCD; wgid = (xcd < r ? xcd * (q + 1) : r * (q + 1) + (xcd - r) * q) + off; }
        const int nig = WGM * nN, gid = wgid / nig, fm = gid * WGM, gsz = (nM - fm) < WGM ? (nM - fm) : WGM;
        u.pm = fm + ((wgid % nig) % gsz); u.pn = (wgid % nig) / gsz; return true;
    }
    __device__ __forceinline__ void a_ready(const Unit&) const {}
    __device__ __forceinline__ void done(const Unit&) const {}
};

__device__ __forceinline__ unsigned cvt_pk_bf16(float lo, float hi) { unsigned r; asm volatile("v_cvt_pk_bf16_f32 %0, %1, %2" : "=v"(r) : "v"(lo), "v"(hi)); return r; }
typedef float f32x2 __attribute__((ext_vector_type(2)));
__device__ __forceinline__ f32x2 gelu_pk(f32x2 v) {
    const f32x2 av = __builtin_elementwise_abs(v), d = av * 0.2316418882f + 1.0f;
    f32x2 t; t.x = __builtin_amdgcn_rcpf(d.x); t.y = __builtin_amdgcn_rcpf(d.y);
    f32x2 q = t * 0.5307027145f + (-0.7265760135f); q = q * t + 0.7107068705f; q = q * t + (-0.142248368f); q = q * t + 0.127414796f; q = q * t;
    const f32x2 s = (v * v) * (-0.72134752044f);
    f32x2 e; e.x = __builtin_amdgcn_exp2f(s.x); e.y = __builtin_amdgcn_exp2f(s.y);
    const f32x2 m = v * (q * e), r = v - m;
    f32x2 o; o.x = v.x < 0.f ? m.x : r.x; o.y = v.y < 0.f ? m.y : r.y; return o;
}

template <int ACT  > struct EpiBf16 {
    static constexpr bool PERM = true, AFTER_DRAIN = false; static_assert(ACT == 0 || ACT == 1, "EpiBf16: ACT is 0 (none) or 1 (gelu_pk)");
    bf16_t* O; int ldc; const float* bias; int split_cols; size_t split_stride; float scale0;
    __device__ __forceinline__ void operator()(const f32x4 (&acc)[2][2][4][2], const Unit& u, int wr, int wc, int fr, int fq) const {
        const int row0 = u.pm * BM + wr * 64 + fr; int colt = u.pn * BM; bf16_t* base = O;
        float sc = 1.f; if (split_cols) { const int t = colt / split_cols; base += (size_t)t * split_stride; colt -= t * split_cols; if (t == 0) sc = scale0; }
        const int col0 = colt + wc * 32 + 8 * fq, bcol0 = u.pn * BM + wc * 32 + 8 * fq;
        f32x4 bv[2][2];
#pragma unroll
        for (int bj = 0; bj < 2; ++bj)
#pragma unroll
            for (int n = 0; n < 2; ++n) bv[bj][n] = bias ? *(const f32x4*)(bias + bcol0 + bj * HALF + 4 * n) : (f32x4){0.f, 0.f, 0.f, 0.f};
#pragma unroll
        for (int ai = 0; ai < 2; ++ai)
#pragma unroll
            for (int m = 0; m < 4; ++m) { bf16_t* rowp = base + (size_t)(row0 + ai * HALF + m * 16) * ldc + col0;
#pragma unroll
                for (int bj = 0; bj < 2; ++bj) { f32x4 v0 = acc[ai][bj][m][0] + bv[bj][0], v1 = acc[ai][bj][m][1] + bv[bj][1];
                    if (ACT == 1) { f32x2 a = gelu_pk((f32x2){v0[0], v0[1]}), b = gelu_pk((f32x2){v0[2], v0[3]}), c = gelu_pk((f32x2){v1[0], v1[1]}), d = gelu_pk((f32x2){v1[2], v1[3]});
                        v0 = (f32x4){a.x, a.y, b.x, b.y}; v1 = (f32x4){c.x, c.y, d.x, d.y}; }
                    v0 = v0 * sc; v1 = v1 * sc; u32x4 w; w.x = cvt_pk_bf16(v0[0], v0[1]); w.y = cvt_pk_bf16(v0[2], v0[3]); w.z = cvt_pk_bf16(v1[0], v1[1]); w.w = cvt_pk_bf16(v1[2], v1[3]);
                    *(u32x4*)(rowp + bj * HALF) = w; } }
    }
};

template <class Epi, class Sched, bool ALIGN_EPI = false, bool SP2 = false>
__device__ __forceinline__ void gemm_phase(PG8_LAS unsigned char* lds, const Gemm g, const Sched& S, const Epi& E) {
    const int tid = threadIdx.x, wid = __builtin_amdgcn_readfirstlane(tid >> 6), lane = tid & 63, wr = wid >> 2, wc = wid & 3, fr = lane & 15, fq = lane >> 4;
    const int K = g.K, nt = K / BK;
    unsigned voffA[2], voffB[2];
#pragma unroll
    for (int i = 0; i < 2; ++i) { int R, C; stage_rc(tid * 16 + i * 8192, R, C); const int Rb = Epi::PERM ? ((R & ~31) + perm32(R & 31)) : R;
        voffA[i] = (unsigned)(R * g.lda + C) * 2u; voffB[i] = (unsigned)(Rb * g.ldb + C) * 2u; }
    const size_t kstep = (size_t)(BK * 2);
    const size_t hstepA = (size_t)HALF * g.lda * 2, hstepB = (size_t)HALF * g.ldb * 2;
    const size_t tstepA = 2 * hstepA, tstepB = 2 * hstepB;
    const unsigned ldsw = (unsigned)wid * 1024u;
    const int aoff = lds_byte(wr * 64 + fr, fq * 8), boff = lds_byte(wc * 32 + fr, fq * 8);
#define PG8_SA(b, h) (((b) * 2 + (h)) * HTB)
#define PG8_SB(b, h) ((4 + (b) * 2 + (h)) * HTB)
#define PG8_STAGE(bufoff, gbase, voff) do { _Pragma("unroll") for (int _i = 0; _i < 2; ++_i) \
        __builtin_amdgcn_global_load_lds((const unsigned*)((const char*)(gbase) + (voff)[_i]), (PG8_LAS unsigned*)(lds + (bufoff) + ldsw + _i * 8192), 16, 0, 0); } while (0)
#define PG8_LDA(dst, b, h) do { _Pragma("unroll") for (int m = 0; m < 4; ++m) _Pragma("unroll") for (int k = 0; k < 2; ++k) dst[m][k] = *(const PG8_LAS bf16x8*)(lds + PG8_SA(b, h) + aoff + m * 2048 + k * 1024); } while (0)
#define PG8_LDB(dst, b, h) do { _Pragma("unroll") for (int n = 0; n < 2; ++n) _Pragma("unroll") for (int k = 0; k < 2; ++k) dst[n][k] = *(const PG8_LAS bf16x8*)(lds + PG8_SB(b, h) + boff + n * 2048 + k * 1024); } while (0)
#define PG8_MMA(ai, bj, At, Bt) do { __builtin_amdgcn_s_setprio(1); _Pragma("unroll") for (int m = 0; m < 4; ++m) _Pragma("unroll") for (int n = 0; n < 2; ++n) _Pragma("unroll") for (int k = 0; k < 2; ++k) \
        acc[ai][bj][m][n] = __builtin_amdgcn_mfma_f32_16x16x32_bf16(Bt[n][k], At[m][k], acc[ai][bj][m][n], 0, 0, 0); __builtin_amdgcn_s_setprio(0); } while (0)
#define PG8_WAIT_V(n) asm volatile("s_waitcnt vmcnt(" #n ")" ::: "memory")
#define PG8_WAIT_L(n) asm volatile("s_waitcnt lgkmcnt(" #n ")" ::: "memory")
#define PG8_BAR __builtin_amdgcn_s_barrier()
#define PG8_SCHED __builtin_amdgcn_sched_barrier(0)
    Unit cur, nxt; int ui = 0;
    if (!S.next(0, cur)) return;
    f32x4 acc[2][2][4][2];
#pragma unroll
    for (int a = 0; a < 2; ++a)
#pragma unroll
        for (int b = 0; b < 2; ++b)
#pragma unroll
            for (int m = 0; m < 4; ++m)
#pragma unroll
                for (int n = 0; n < 2; ++n) acc[a][b][m][n] = (f32x4){0.f, 0.f, 0.f, 0.f};
    bf16x8 At[4][2], B0[2][2], B1[2][2];
    const char* cA = (const char*)g.A + (size_t)cur.pm * tstepA; const char* cB = (const char*)g.Bt + (size_t)cur.pn * tstepB;
    S.a_ready(cur);
    if constexpr (SP2) {
        PG8_STAGE(PG8_SB(0, 0), cB, voffB); PG8_STAGE(PG8_SB(0, 1), cB + hstepB, voffB); PG8_STAGE(PG8_SA(0, 0), cA, voffA); PG8_STAGE(PG8_SA(0, 1), cA + hstepA, voffA);
        if (wr == 1) PG8_BAR;
        PG8_WAIT_V(2); PG8_BAR;
        PG8_STAGE(PG8_SB(1, 0), cB + kstep, voffB); PG8_STAGE(PG8_SA(1, 0), cA + kstep, voffA); PG8_STAGE(PG8_SB(1, 1), cB + hstepB + kstep, voffB);
        PG8_WAIT_V(6); PG8_BAR;
    } else {
        PG8_STAGE(PG8_SB(0, 0), cB, voffB); PG8_STAGE(PG8_SA(0, 0), cA, voffA); PG8_STAGE(PG8_SB(0, 1), cB + hstepB, voffB); PG8_STAGE(PG8_SA(0, 1), cA + hstepA, voffA);
        if (wr == 1) PG8_BAR;
        PG8_WAIT_V(4); PG8_BAR;
        PG8_STAGE(PG8_SB(1, 0), cB + kstep, voffB); PG8_STAGE(PG8_SA(1, 0), cA + kstep, voffA); PG8_STAGE(PG8_SB(1, 1), cB + hstepB + kstep, voffB);
        PG8_WAIT_V(6); PG8_BAR;
    }
    for (;;) {
        const bool has_next = S.next(ui + 1, nxt);
        const char* nA = has_next ? (const char*)g.A + (size_t)nxt.pm * tstepA : cA; const char* nB = has_next ? (const char*)g.Bt + (size_t)nxt.pn * tstepB : cB;
        for (int t = 0; t < nt; t += 2) {
            const bool last = (t == nt - 2);
            const char* a1 = cA + (size_t)(t + 1) * kstep;
            const char* a2 = last ? nA : cA + (size_t)(t + 2) * kstep; const char* b2 = last ? nB : cB + (size_t)(t + 2) * kstep;
            const char* a3 = a2 + kstep; const char* b3 = b2 + kstep;
            if (last && has_next) S.a_ready(nxt);
            if constexpr (SP2) {
            PG8_LDB(B0, 0, 0); PG8_LDB(B1, 0, 1); PG8_SCHED; PG8_LDA(At, 0, 0); PG8_STAGE(PG8_SA(1, 1), a1 + hstepA, voffA);
            PG8_WAIT_V(8); PG8_WAIT_L(0); PG8_BAR; PG8_MMA(0, 0, At, B0); PG8_MMA(0, 1, At, B1); PG8_BAR; PG8_SCHED;
            PG8_LDA(At, 0, 1); PG8_STAGE(PG8_SB(0, 0), b2, voffB); PG8_STAGE(PG8_SB(0, 1), b2 + hstepB, voffB); PG8_STAGE(PG8_SA(0, 0), a2, voffA);
            PG8_WAIT_V(8); PG8_WAIT_L(0); PG8_BAR; PG8_MMA(1, 0, At, B0); PG8_MMA(1, 1, At, B1); PG8_BAR; PG8_SCHED;
            PG8_LDB(B0, 1, 0); PG8_LDB(B1, 1, 1); PG8_SCHED; PG8_LDA(At, 1, 0); PG8_STAGE(PG8_SA(0, 1), a2 + hstepA, voffA);
            PG8_WAIT_V(8); PG8_WAIT_L(0); PG8_BAR; PG8_MMA(0, 0, At, B0); PG8_MMA(0, 1, At, B1); PG8_BAR; PG8_SCHED;
            PG8_LDA(At, 1, 1); PG8_STAGE(PG8_SB(1, 0), b3, voffB); PG8_STAGE(PG8_SB(1, 1), b3 + hstepB, voffB); PG8_STAGE(PG8_SA(1, 0), a3, voffA);
            PG8_WAIT_V(8); PG8_WAIT_L(0); PG8_BAR; PG8_MMA(1, 0, At, B0); PG8_MMA(1, 1, At, B1); PG8_BAR; PG8_SCHED;
            } else {
            PG8_LDB(B0, 0, 0); PG8_SCHED; PG8_LDA(At, 0, 0); PG8_STAGE(PG8_SA(1, 1), a1 + hstepA, voffA);
            PG8_WAIT_L(8); PG8_BAR; PG8_WAIT_L(0); PG8_MMA(0, 0, At, B0); PG8_BAR; PG8_SCHED;
            PG8_LDB(B1, 0, 1); PG8_STAGE(PG8_SB(0, 0), b2, voffB);
            PG8_BAR; PG8_WAIT_L(0); PG8_MMA(0, 1, At, B1); PG8_BAR;
            PG8_LDA(At, 0, 1); PG8_STAGE(PG8_SA(0, 0), a2, voffA);
            PG8_BAR; PG8_WAIT_L(0); PG8_MMA(1, 0, At, B0); PG8_BAR; PG8_SCHED;
            PG8_STAGE(PG8_SB(0, 1), b2 + hstepB, voffB);
            PG8_WAIT_V(6); PG8_BAR; PG8_MMA(1, 1, At, B1); PG8_BAR;
            PG8_LDB(B0, 1, 0); PG8_SCHED; PG8_LDA(At, 1, 0); PG8_STAGE(PG8_SA(0, 1), a2 + hstepA, voffA);
            PG8_WAIT_L(8); PG8_BAR; PG8_WAIT_L(0); PG8_MMA(0, 0, At, B0); PG8_BAR; PG8_SCHED;
            PG8_LDB(B1, 1, 1); PG8_STAGE(PG8_SB(1, 0), b3, voffB);
            PG8_BAR; PG8_WAIT_L(0); PG8_MMA(0, 1, At, B1); PG8_BAR;
            PG8_LDA(At, 1, 1); PG8_STAGE(PG8_SA(1, 0), a3, voffA);
            PG8_BAR; PG8_WAIT_L(0); PG8_MMA(1, 0, At, B0); PG8_BAR; PG8_SCHED;
            PG8_STAGE(PG8_SB(1, 1), b3 + hstepB, voffB);
            PG8_WAIT_V(6); PG8_BAR; PG8_MMA(1, 1, At, B1); PG8_BAR;
            }
        }
        if constexpr (ALIGN_EPI) { if (wr == 0) PG8_BAR; }
        if constexpr (!Epi::AFTER_DRAIN) { E(acc, cur, wr, wc, fr, fq); S.done(cur); }
        if (!has_next) break;
#pragma unroll
        for (int a = 0; a < 2; ++a)
#pragma unroll
            for (int b = 0; b < 2; ++b)
#pragma unroll
                for (int m = 0; m < 4; ++m)
#pragma unroll
                    for (int n = 0; n < 2; ++n) acc[a][b][m][n] = (f32x4){0.f, 0.f, 0.f, 0.f};
        cur = nxt; cA = nA; cB = nB; ++ui;
        if constexpr (ALIGN_EPI) { if (wr == 1) PG8_BAR; }
    }
    PG8_WAIT_V(0);
    if constexpr (!ALIGN_EPI) { if (wr == 0) PG8_BAR; }
    PG8_BAR;
    if constexpr (Epi::AFTER_DRAIN) { E.fused(acc, cur, wr, wc, fr, fq, lds, wid, lane); S.done(cur); }
#undef PG8_SA
#undef PG8_SB
#undef PG8_STAGE
#undef PG8_LDA
#undef PG8_LDB
#undef PG8_MMA
#undef PG8_WAIT_V
#undef PG8_WAIT_L
#undef PG8_BAR
#undef PG8_SCHED
}
}

#ifndef MK_EXP_OLD
#define MK_EXP_OLD 0
#endif
#ifndef MK_ONE_LAUNCH
#define MK_ONE_LAUNCH 1
#endif
#define LAS __attribute__((address_space(3)))
typedef unsigned short bf16;
typedef unsigned v4u __attribute__((ext_vector_type(4)));
typedef unsigned v2u __attribute__((ext_vector_type(2)));
typedef float f32x4 __attribute__((ext_vector_type(4)));
typedef float f32x2 __attribute__((ext_vector_type(2)));

constexpr int D = 1024, NB = 8, SEQ = 2048, LC = 256, ML = NB * SEQ  , MC = NB * LC  , MT = ML + MC  ;
constexpr int PROJ = 2576, NPROJ = 2560;
constexpr int NEXP = 16384, TOPK = 16, KK = 128;
constexpr float EPS = 1e-6f;
constexpr int NTHREADS = 512, NWAVES = 8;
constexpr int LDS_BYTES = 147456;
constexpr int NPHASES = 15;

constexpr size_t MiB = 1u << 20;
constexpr size_t WS_CTL = 0;
constexpr size_t CTL_ZERO_BYTES = 65536;
constexpr int CW_BAR = 0;
constexpr int CW_E1 = 4096, CW_E2 = 4096 + 8 * 64;
constexpr size_t WS_MOD = 1 * MiB;
constexpr size_t WS_LP = 1 * MiB + 512 * 1024;
constexpr size_t WS_WIN = 2 * MiB;
constexpr size_t WS_WOUT = 8 * MiB;
constexpr size_t WS_WGLU = 10 * MiB;
constexpr size_t WS_WQ = 11 * MiB;
constexpr size_t WS_GB = 15 * MiB;
constexpr size_t WS_BB = 17 * MiB;
constexpr size_t WS_PM = 41 * MiB;
constexpr size_t WS_OG = 17 * MiB;
constexpr size_t WS_HX2 = 17 * MiB;
constexpr size_t WS_U5 = 49 * MiB;
constexpr size_t WS_CAT = 49 * MiB;
constexpr size_t WS_IDX = 49 * MiB;
constexpr size_t WS_GATE = 57 * MiB;
constexpr size_t WS_ACT = 65 * MiB;
constexpr size_t WS_SSQP = 73 * MiB;
constexpr size_t WS_Z = 85 * MiB;
constexpr size_t WS_YRAW = 85 * MiB;
constexpr size_t WS_QP = 85 * MiB;
constexpr size_t WS_Y = 85 * MiB;
constexpr size_t WS_HX = 101 * MiB;
constexpr size_t WS_SS = 101 * MiB;
constexpr size_t WS_YG = 101 * MiB;
constexpr size_t WS_FRT = 125 * MiB;
constexpr size_t WS_QKVPRE = 137 * MiB;
constexpr size_t WS_FRA = 143 * MiB;
constexpr size_t WS_FRK = 161 * MiB;
constexpr size_t WS_FRTAB = 197 * MiB;
constexpr size_t WS_QKV = 202 * MiB;
constexpr size_t WS_U8 = 202 * MiB;
constexpr size_t WS_V8 = 218 * MiB;
constexpr size_t WS_USC = 234 * MiB;
constexpr size_t WS_VSC = 234 * MiB + 512 * 1024;
constexpr size_t WS_HQ8 = 150 * MiB;
constexpr size_t WS_HS = 183 * MiB;
constexpr size_t WS_END = 256 * MiB;
static_assert(WS_BB + (size_t)32 * 512 * 768 * 2 <= WS_PM && WS_PM + (size_t)32 * 256 * 512 * 2 <= WS_U5 && WS_U5 + (size_t)32 * 768 * 768 * 2 <= WS_Z && WS_Z + (size_t)ML * 512 * 2 <= WS_HX, "ws map a");
static_assert(WS_HX + (size_t)MT * D * 2 <= WS_QKVPRE && WS_SS + (size_t)32 * 768 * 256 * 4 <= WS_FRT && WS_QKVPRE + (size_t)MT * 1536 * 2 <= WS_QKV && WS_QKV + (size_t)MT * 1536 * 2 <= WS_END, "ws map b");
static_assert(WS_FRT + (size_t)2304 * 8192 <= WS_FRA && WS_FRA + (size_t)2304 * 8192 <= WS_FRK && WS_FRK + (size_t)2304 * 16384 <= WS_FRTAB && WS_FRTAB + (size_t)2304 * 1024 <= WS_QKV, "ws map c");
static_assert(WS_OG + (size_t)2 * ML * 512 * 2 <= WS_CAT && WS_CAT + (size_t)ML * D * 2 <= WS_Z && WS_YRAW + (size_t)ML * D * 4 <= WS_U8 && WS_SSQP + (size_t)8 * ML * 4 <= WS_Z && WS_YG + (size_t)ML * 512 * 2 <= WS_FRT, "ws map d");

__device__ __forceinline__ unsigned f2bf(float f) { unsigned u = __builtin_bit_cast(unsigned, f); return (u + 0x7fffu + ((u >> 16) & 1u)) >> 16; }
typedef __bf16 bf16x2_t __attribute__((ext_vector_type(2)));
__device__ __forceinline__ unsigned pk2(float lo, float hi) { const f32x2 v = {lo, hi}; return __builtin_bit_cast(unsigned, __builtin_convertvector(v, bf16x2_t)); }
__device__ __forceinline__ float bflo(unsigned w) { return __builtin_bit_cast(float, w << 16); }
__device__ __forceinline__ float bfhi(unsigned w) { return __builtin_bit_cast(float, w & 0xffff0000u); }
__device__ __forceinline__ float bf1(bf16 h) { return __builtin_bit_cast(float, (unsigned)h << 16); }
__device__ __forceinline__ float wave_sum(float v) {
#pragma unroll
    for (int o = 1; o < 64; o <<= 1) v += __shfl_xor(v, o);
    return v;
}
__device__ __forceinline__ float wave_max(float v) {
#pragma unroll
    for (int o = 1; o < 64; o <<= 1) v = fmaxf(v, __shfl_xor(v, o));
    return v;
}
__device__ __forceinline__ float sigmoidf_(float x) { return 1.f / (1.f + __expf(-x)); }
__device__ __forceinline__ float siluf_(float x) { return x / (1.f + __expf(-x)); }
__device__ __forceinline__ float gelu_erf(float x) { return 0.5f * x * (1.f + erff(x * 0.70710678118654752f)); }
__device__ __forceinline__ void sincos_d(double a, float& s, float& c) {
    const double k = rint(a * 0.63661977236758134308);
    const double r = fma(-k, 1.57079632679489661923, a) - k * 6.123233995736766e-17;
    const double r2 = r * r;
    double sp = -2.5052108385441720e-08; sp = sp * r2 + 2.7557319223985893e-06; sp = sp * r2 - 1.9841269841269841e-04; sp = sp * r2 + 8.3333333333333332e-03; sp = sp * r2 - 1.6666666666666666e-01;
    const double sn = r + r * r2 * sp;
    double cp = 2.0876756987868099e-09; cp = cp * r2 - 2.7557319223985888e-07; cp = cp * r2 + 2.4801587301587302e-05; cp = cp * r2 - 1.3888888888888889e-03; cp = cp * r2 + 4.1666666666666664e-02; cp = cp * r2 - 0.5;
    const double cs = 1.0 + r2 * cp;
    const int q = ((int)k) & 3;
    const double ss = (q == 0) ? sn : (q == 1) ? cs : (q == 2) ? -sn : -cs;
    const double cc = (q == 0) ? cs : (q == 1) ? -sn : (q == 2) ? -cs : sn;
    s = (float)ss; c = (float)cc;
}

struct Args { const float* in[29]; float* out; unsigned char* ws; int ph_lo, ph_hi; };
static_assert(sizeof(Args) == 29 * 8 + 8 + 8 + 8, "Args has no padding");
enum { I_X = 0, I_C, I_CTX, I_CCTX, I_WMOD, I_BMOD, I_GPREMIX, I_GPOSTMIX, I_GPREFFN, I_GPOSTFFN, I_WIN, I_WOUT, I_LAMRE, I_LAMIM, I_LOGDT, I_BRE, I_BIM, I_CRE, I_CIM, I_S5D, I_WGLU,
       I_CONV, I_ALOG, I_DTBIAS, I_GDNNORM, I_WQ, I_KEYS, I_PU, I_PV };

__device__ __forceinline__ const float* in_row(const Args& a, int row) { return row < ML ? a.in[I_X] + (size_t)row * D : a.in[I_CTX] + (size_t)(row - ML) * D; }
__device__ __forceinline__ int mod_row(int row) { return row < ML ? (row >> 11) : 8; }

template <int CTRL> __device__ __forceinline__ float dppf(float v) { return __builtin_bit_cast(float, __builtin_amdgcn_update_dpp(0, __builtin_bit_cast(int, v), CTRL, 0xf, 0xf, true)); }
__device__ __forceinline__ float row_sum16(float v) { v += dppf<0xB1>(v); v += dppf<0x4E>(v); v += dppf<0x141>(v); v += dppf<0x140>(v); return v; }
__device__ __forceinline__ float row_max16(float v) { v = fmaxf(v, dppf<0xB1>(v)); v = fmaxf(v, dppf<0x4E>(v)); v = fmaxf(v, dppf<0x141>(v)); v = fmaxf(v, dppf<0x140>(v)); return v; }
__device__ __forceinline__ float wsum(float v) { v = row_sum16(v); return
    __builtin_bit_cast(float, __builtin_amdgcn_readlane(__builtin_bit_cast(int, v), 0)) + __builtin_bit_cast(float, __builtin_amdgcn_readlane(__builtin_bit_cast(int, v), 16)) +
    __builtin_bit_cast(float, __builtin_amdgcn_readlane(__builtin_bit_cast(int, v), 32)) + __builtin_bit_cast(float, __builtin_amdgcn_readlane(__builtin_bit_cast(int, v), 48)); }
__device__ __forceinline__ float wmax(float v) { v = row_max16(v); return fmaxf(fmaxf(__builtin_bit_cast(float, __builtin_amdgcn_readlane(__builtin_bit_cast(int, v), 0)), __builtin_bit_cast(float, __builtin_amdgcn_readlane(__builtin_bit_cast(int, v), 16))),
    fmaxf(__builtin_bit_cast(float, __builtin_amdgcn_readlane(__builtin_bit_cast(int, v), 32)), __builtin_bit_cast(float, __builtin_amdgcn_readlane(__builtin_bit_cast(int, v), 48)))); }
__device__ __forceinline__ int lane_rank(unsigned long long m) { return __builtin_amdgcn_mbcnt_hi((unsigned)(m >> 32), __builtin_amdgcn_mbcnt_lo((unsigned)m, 0)); }
__device__ __forceinline__ unsigned fkey(float f) { const unsigned u = __builtin_bit_cast(unsigned, f); return u ^ ((unsigned)((int)u >> 31) | 0x80000000u); }
#define WAVE_LDS_SYNC() do { __builtin_amdgcn_fence(__ATOMIC_RELEASE, "wavefront"); __builtin_amdgcn_wave_barrier(); __builtin_amdgcn_fence(__ATOMIC_ACQUIRE, "wavefront"); } while (0)
template <int N> __device__ __forceinline__ unsigned kth_key(const unsigned (&k)[N], int K) {
    unsigned T = 0;
    for (int bit = 31; bit >= 0; --bit) { const unsigned cand = T | (1u << bit); int cnt = 0;
#pragma unroll
        for (int n = 0; n < N; ++n) cnt += __popcll(__ballot(k[n] >= cand));
        if (cnt >= K) T = cand;
        if (cnt == K) break; }
    return T;
}

namespace pg8 {
struct EpiInProj {
    static constexpr bool PERM = true, AFTER_DRAIN = false;
    bf16_t* U; bf16_t* QKV; bf16_t* Z;
    __device__ __forceinline__ void operator()(const f32x4 (&acc)[2][2][4][2], const Unit& u, int wr, int wc, int fr, int fq) const {
        bf16_t* base; int ld, colt; bool lat_only = false;
        const bool s5 = u.pn < 2;
        if (s5) { base = U; ld = 0; colt = u.pn * BM; }
        else if (u.pn < 8) { base = QKV; ld = 1536; colt = (u.pn - 2) * BM; }
        else { base = Z; ld = 512; colt = (u.pn - 8) * BM; lat_only = true; }
        const int row0 = u.pm * BM + wr * 64 + fr, col0 = colt + wc * 32 + 8 * fq;
#pragma unroll
        for (int ai = 0; ai < 2; ++ai)
#pragma unroll
            for (int m = 0; m < 4; ++m) { const int row = row0 + ai * HALF + m * 16; bf16_t* rowp = base + (size_t)row * ld + col0;
                if (lat_only && row >= 16384) continue;
                if (s5) { const int R = row < 16384 ? (row >> 5) : 512 + ((row - 16384) >> 5), ii = row & 31; rowp = base + (size_t)R * 768 + ii * 16 + (col0 & 15); }
#pragma unroll
                for (int bj = 0; bj < 2; ++bj) { const f32x4 v0 = acc[ai][bj][m][0], v1 = acc[ai][bj][m][1];
                    u32x4 w; w.x = cvt_pk_bf16(v0[0], v0[1]); w.y = cvt_pk_bf16(v0[2], v0[3]); w.z = cvt_pk_bf16(v1[0], v1[1]); w.w = cvt_pk_bf16(v1[2], v1[3]);
                    if (s5) *(u32x4*)(rowp + (size_t)((col0 + bj * HALF) >> 4) * (768 * 768)) = w; else *(u32x4*)(rowp + bj * HALF) = w; } }
    }
};
struct EpiGlu {
    static constexpr bool PERM = true, AFTER_DRAIN = false;
    const bf16_t* YG; bf16_t* CAT;
    __device__ __forceinline__ void operator()(const f32x4 (&acc)[2][2][4][2], const Unit& u, int wr, int wc, int fr, int fq) const {
        const int row0 = u.pm * BM + wr * 64 + fr, col0 = u.pn * BM + wc * 32 + 8 * fq;
#pragma unroll
        for (int ai = 0; ai < 2; ++ai)
#pragma unroll
            for (int m = 0; m < 4; ++m) { const int row = row0 + ai * HALF + m * 16;
#pragma unroll
                for (int bj = 0; bj < 2; ++bj) { const f32x4 v0 = acc[ai][bj][m][0], v1 = acc[ai][bj][m][1];
                    const u32x4 y = *(const u32x4*)(YG + (size_t)row * 512 + col0 + bj * HALF);
                    float o[8]; const float a[8] = {v0[0], v0[1], v0[2], v0[3], v1[0], v1[1], v1[2], v1[3]};
                    const unsigned yw[4] = {y.x, y.y, y.z, y.w};
#pragma unroll
                    for (int e = 0; e < 8; ++e) { const float yv = __builtin_bit_cast(float, (e & 1) ? (yw[e >> 1] & 0xffff0000u) : (yw[e >> 1] << 16)); o[e] = yv / (1.f + __expf(-a[e])); }
                    u32x4 w; w.x = cvt_pk_bf16(o[0], o[1]); w.y = cvt_pk_bf16(o[2], o[3]); w.z = cvt_pk_bf16(o[4], o[5]); w.w = cvt_pk_bf16(o[6], o[7]);
                    *(u32x4*)(CAT + (size_t)row * 1024 + col0 + bj * HALF) = w; } }
    }
};
struct EpiF32 {
    static constexpr bool PERM = false, AFTER_DRAIN = false;
    float* C; int ldc;
    __device__ __forceinline__ void operator()(const f32x4 (&acc)[2][2][4][2], const Unit& u, int wr, int wc, int fr, int fq) const {
        const int row0 = u.pm * BM + wr * 64 + fr, col0 = u.pn * BM + wc * 32 + 4 * fq;
#pragma unroll
        for (int ai = 0; ai < 2; ++ai)
#pragma unroll
            for (int m = 0; m < 4; ++m) { float* rowp = C + (size_t)(row0 + ai * HALF + m * 16) * ldc + col0;
#pragma unroll
                for (int bj = 0; bj < 2; ++bj)
#pragma unroll
                    for (int n = 0; n < 2; ++n) *(f32x4*)(rowp + bj * HALF + n * 16) = acc[ai][bj][m][n]; }
    }
};
struct EpiSS {
    static constexpr bool PERM = false, AFTER_DRAIN = false;
    float* C;
    __device__ __forceinline__ void operator()(const f32x4 (&acc)[2][2][4][2], const Unit& u, int wr, int wc, int fr, int fq) const {
        const int row0 = u.pm * BM + wr * 64 + fr, col0 = wc * 32 + 4 * fq;
#pragma unroll
        for (int ai = 0; ai < 2; ++ai)
#pragma unroll
            for (int m = 0; m < 4; ++m) { float* rowp = C + (size_t)(row0 + ai * HALF + m * 16) * 256 + col0;
#pragma unroll
                for (int bj = 0; bj < 2; ++bj)
#pragma unroll
                    for (int n = 0; n < 2; ++n) *(f32x4*)(rowp + bj * HALF + n * 16) = acc[ai][bj][m][n]; }
    }
};
struct SchedSS { int G, c; __device__ bool next(int i, Unit& u) const { const int L = i * G + c; if (L >= 96) return false; u.pm = L; u.pn = L / 3; return true; }
    __device__ __forceinline__ void a_ready(const Unit&) const {} __device__ __forceinline__ void done(const Unit&) const {} };
struct EpiS5Y {
    static constexpr bool PERM = true, AFTER_DRAIN = false;
    bf16_t* YG;
    __device__ __forceinline__ void operator()(const f32x4 (&acc)[2][2][4][2], const Unit& u, int wr, int wc, int fr, int fq) const {
        const int g = u.pn >> 1, R0 = (u.pm - 3 * g) * BM + wr * 64 + fr, n0 = (u.pn & 1) * BM + wc * 32 + 8 * fq;
#pragma unroll
        for (int ai = 0; ai < 2; ++ai)
#pragma unroll
            for (int m = 0; m < 4; ++m) { const int R = R0 + ai * HALF + m * 16;
#pragma unroll
                for (int bj = 0; bj < 2; ++bj) { const int n = n0 + bj * HALF; const f32x4 v0 = acc[ai][bj][m][0], v1 = acc[ai][bj][m][1];
                    const f32x2 a = gelu_pk((f32x2){v0[0], v0[1]}), b = gelu_pk((f32x2){v0[2], v0[3]}), c2 = gelu_pk((f32x2){v1[0], v1[1]}), d = gelu_pk((f32x2){v1[2], v1[3]});
                    u32x4 w; w.x = cvt_pk_bf16(a.x, a.y); w.y = cvt_pk_bf16(b.x, b.y); w.z = cvt_pk_bf16(c2.x, c2.y); w.w = cvt_pk_bf16(d.x, d.y);
                    *(u32x4*)(YG + (size_t)(R * 32 + (n >> 4)) * 512 + g * 16 + (n & 15)) = w; } }
    }
};
struct SchedS5Y { int G, c; __device__ bool next(int i, Unit& u) const { const int L = i * G + c; if (L >= 128) return false; const int g = L >> 2; u.pm = 3 * g + ((L >> 1) & 1); u.pn = 2 * g + (L & 1); return true; }
    __device__ __forceinline__ void a_ready(const Unit&) const {} __device__ __forceinline__ void done(const Unit&) const {} };
}

struct Ctx { const Args* a; unsigned char* ws; unsigned char* lds; int tid, lane, wave, bid, G, gw, NGW, gwv; };

__device__ __forceinline__ void p0_transpose_item(const float* W, int ldw, int nblk, int K, bf16* WT, float* scr, int item, int lane) {
    const int kb = item / nblk, nb = item % nblk, k0 = 64 * kb, n0 = 32 * nb;
#pragma unroll 8
    for (int i = 0; i < 32; ++i) { const int kk = 2 * i + (lane >> 5); scr[kk * 33 + (lane & 31)] = W[(size_t)(k0 + kk) * ldw + n0 + (lane & 31)]; }
    __builtin_amdgcn_fence(__ATOMIC_RELEASE, "wavefront"); __builtin_amdgcn_wave_barrier(); __builtin_amdgcn_fence(__ATOMIC_ACQUIRE, "wavefront");
    const int c = lane & 7;
#pragma unroll
    for (int j = 0; j < 4; ++j) { const int n = (lane >> 3) + 8 * j; const float* s = scr + (8 * c) * 33 + n;
        v4u o; o.x = pk2(s[0 * 33], s[1 * 33]); o.y = pk2(s[2 * 33], s[3 * 33]); o.z = pk2(s[4 * 33], s[5 * 33]); o.w = pk2(s[6 * 33], s[7 * 33]);
        *(v4u*)(WT + (size_t)(n0 + n) * K + k0 + 8 * c) = o; }
    __builtin_amdgcn_fence(__ATOMIC_RELEASE, "wavefront"); __builtin_amdgcn_wave_barrier(); __builtin_amdgcn_fence(__ATOMIC_ACQUIRE, "wavefront");
}
__device__ __forceinline__ void phase_prep(const Ctx& c) {
    const Args& a = *c.a;
    float* scr = (float*)(c.lds + c.wave * 16384);
    constexpr int I_IN = 16 * 80, I_OUT = 16 * 32, I_GLU = 8 * 16, I_Q = 16 * 64;
    for (int it = c.gw; it < I_IN + I_OUT + I_GLU + I_Q; it += c.NGW) {
        int r = it;
        if (r < I_IN) { p0_transpose_item(a.in[I_WIN], PROJ, 80, 1024, (bf16*)(c.ws + WS_WIN), scr, r, c.lane); continue; } r -= I_IN;
        if (r < I_OUT) { p0_transpose_item(a.in[I_WOUT], 1024, 32, 1024, (bf16*)(c.ws + WS_WOUT), scr, r, c.lane); continue; } r -= I_OUT;
        if (r < I_GLU) { p0_transpose_item(a.in[I_WGLU], 512, 16, 512, (bf16*)(c.ws + WS_WGLU), scr, r, c.lane); continue; } r -= I_GLU;
        p0_transpose_item(a.in[I_WQ], 2048, 64, 1024, (bf16*)(c.ws + WS_WQ), scr, r, c.lane);
    }
    __syncthreads();
    float* sc = (float*)c.lds;
    float* red = (float*)(c.lds + 9 * 1024 * 4);
    float* MOD = (float*)(c.ws + WS_MOD);
    bool have = false;
    for (int item = c.bid; item < 96; item += c.G) {
        if (!have) { for (int i = c.tid; i < 9 * 1024; i += NTHREADS) { const int r = i >> 10, k = i & 1023; const float v = r < 8 ? a.in[I_C][r * 1024 + k] : a.in[I_CCTX][k]; sc[i] = siluf_(v); } have = true; __syncthreads(); }
        const int n0 = item * 64;
        float acc[9];
#pragma unroll
        for (int r = 0; r < 9; ++r) acc[r] = 0.f;
        const float* wp = a.in[I_WMOD] + (size_t)(c.wave * 128) * 6144 + n0 + c.lane;
#pragma unroll 4
        for (int k = 0; k < 128; ++k) { const float w = wp[(size_t)k * 6144];
#pragma unroll
            for (int r = 0; r < 9; ++r) acc[r] = fmaf(sc[r * 1024 + c.wave * 128 + k], w, acc[r]); }
#pragma unroll
        for (int r = 0; r < 9; ++r) red[(c.wave * 9 + r) * 64 + c.lane] = acc[r];
        __syncthreads();
        for (int i = c.tid; i < 576; i += NTHREADS) { const int r = i >> 6, l = i & 63; float s = a.in[I_BMOD][n0 + l];
#pragma unroll
            for (int w = 0; w < 8; ++w) s += red[(w * 9 + r) * 64 + l];
            MOD[r * 6144 + n0 + l] = s; }
        __syncthreads();
    }
}
__device__ __forceinline__ void s5_build_group(const Ctx& c, int g, int part);
__device__ __forceinline__ void phase_s5_build(const Ctx& c) { for (int it = c.bid; it < 256; it += c.G) s5_build_group(c, it >> 3, it & 7); }

__device__ __forceinline__ void phase_norm1(const Ctx& c) {
    const Args& a = *c.a;
    float* wabT = (float*)c.lds;
    for (int i = c.tid; i < 1024 * 16; i += NTHREADS) { const int k = i >> 4, j = i & 15; wabT[j * 1028 + k] = a.in[I_WIN][(size_t)k * PROJ + NPROJ + j]; }
    __syncthreads();
    const float* MOD = (const float*)(c.ws + WS_MOD);
    bf16* HX = (bf16*)(c.ws + WS_HX); float* GB = (float*)(c.ws + WS_GB);
    const float* gpre = a.in[I_GPREMIX];
    for (int row = c.gw; row < MT; row += c.NGW) {
        const f32x4* xr = (const f32x4*)in_row(a, row) + c.lane;
        const float* mr = MOD + mod_row(row) * 6144;
        f32x4 v[4]; float ss = 0.f;
#pragma unroll
        for (int j = 0; j < 4; ++j) { v[j] = xr[64 * j]; ss += (v[j].x * v[j].x + v[j].y * v[j].y) + (v[j].z * v[j].z + v[j].w * v[j].w); }
        const float r = rsqrtf(wsum(ss) * (1.f / D) + EPS);
#pragma unroll
        for (int j = 0; j < 4; ++j) { const int col = 4 * c.lane + 256 * j;
            const f32x4 g4 = *(const f32x4*)(gpre + col), sh = *(const f32x4*)(mr + col), scl = *(const f32x4*)(mr + 1024 + col);
            v[j] = (v[j] * r) * g4 * (scl + 1.f) + sh;
            v2u o; o.x = pk2(v[j].x, v[j].y); o.y = pk2(v[j].z, v[j].w);
            *(v2u*)(HX + (size_t)row * D + col) = o; }
        float pj[16];
#pragma unroll
        for (int j = 0; j < 16; ++j) { float s = 0.f;
#pragma unroll
            for (int jj = 0; jj < 4; ++jj) { const f32x4 w = *(const f32x4*)(wabT + j * 1028 + 4 * c.lane + 256 * jj); s += (v[jj].x * w.x + v[jj].y * w.y) + (v[jj].z * w.z + v[jj].w * w.w); }
            pj[j] = s; if ((j & 1) == 1) asm volatile("" ::: "memory"); }
        const bool b5 = c.lane & 32, b4 = c.lane & 16, b3 = c.lane & 8, b2 = c.lane & 4;
        float q8[8], q4[4], q2[2];
#pragma unroll
        for (int i = 0; i < 8; ++i) { const float keep = b5 ? pj[i + 8] : pj[i], send = b5 ? pj[i] : pj[i + 8]; q8[i] = keep + __shfl_xor(send, 32); }
#pragma unroll
        for (int i = 0; i < 4; ++i) { const float keep = b4 ? q8[i + 4] : q8[i], send = b4 ? q8[i] : q8[i + 4]; q4[i] = keep + __shfl_xor(send, 16); }
#pragma unroll
        for (int i = 0; i < 2; ++i) { const float keep = b3 ? q4[i + 2] : q4[i], send = b3 ? q4[i] : q4[i + 2]; q2[i] = keep + dppf<0x140>(send); }
        float mine; { const float keep = b2 ? q2[1] : q2[0], send = b2 ? q2[0] : q2[1]; mine = keep + dppf<0x141>(send); }
        mine += dppf<0xB1>(mine); mine += dppf<0x4E>(mine);
        const int jl = (b5 ? 8 : 0) + (b4 ? 4 : 0) + (b3 ? 2 : 0) + (b2 ? 1 : 0);
        if ((c.lane & 3) == 0) {
            if (jl < 8) { const float t = mine + a.in[I_DTBIAS][jl]; const float sp = t > 20.f ? t : log1pf(expf(t)); GB[(size_t)row * 16 + jl] = -expf(a.in[I_ALOG][jl]) * sp; }
            else GB[(size_t)row * 16 + jl] = 1.f / (1.f + expf(-mine)); }
    }
}

__device__ __forceinline__ void phase_conv(const Ctx& c) {
    const Args& a = *c.a;
    const bf16* PRE = (const bf16*)(c.ws + WS_QKVPRE); bf16* OUT = (bf16*)(c.ws + WS_QKV);
    const float* cw = a.in[I_CONV];
#pragma unroll 1
    for (int pass = 0; pass < 3; ++pass) { const int ch0 = pass * 512 + 8 * c.lane;
        f32x4 wt[9][2];
#pragma unroll
        for (int i = 0; i < 9; ++i) { wt[i][0] = *(const f32x4*)(cw + i * 1536 + ch0); wt[i][1] = *(const f32x4*)(cw + i * 1536 + ch0 + 4); }
#pragma unroll 1
        for (int row = c.gw; row < MT; row += c.NGW) {
            int nb_row[9]; bool ok[9];
            if (row < ML) { const int t = row & 2047, gr = t >> 6, gc = t & 63;
#pragma unroll
                for (int dy = -1; dy <= 1; ++dy)
#pragma unroll
                    for (int dx = -1; dx <= 1; ++dx) { const int i = (dy + 1) * 3 + dx + 1; ok[i] = (gr + dy >= 0) && (gr + dy < 32) && (gc + dx >= 0) && (gc + dx < 64); nb_row[i] = row + dy * 64 + dx; } }
            else { const int t = (row - ML) & 255;
#pragma unroll
                for (int i = 0; i < 9; ++i) { ok[i] = false; nb_row[i] = row; }
#pragma unroll
                for (int dx = -1; dx <= 1; ++dx) { ok[4 + dx] = (t + dx >= 0) && (t + dx < 256); nb_row[4 + dx] = row + dx; } }
            v4u in[9];
#pragma unroll
            for (int i = 0; i < 9; ++i) in[i] = ok[i] ? *(const v4u*)(PRE + (size_t)nb_row[i] * 1536 + ch0) : (v4u){0u, 0u, 0u, 0u};
            float o[8];
#pragma unroll
            for (int q = 0; q < 8; ++q) o[q] = 0.f;
#pragma unroll
            for (int i = 0; i < 9; ++i) { const unsigned w[4] = {in[i].x, in[i].y, in[i].z, in[i].w}; const float kk[8] = {wt[i][0].x, wt[i][0].y, wt[i][0].z, wt[i][0].w, wt[i][1].x, wt[i][1].y, wt[i][1].z, wt[i][1].w};
#pragma unroll
                for (int q = 0; q < 4; ++q) { o[2 * q] = fmaf(bflo(w[q]), kk[2 * q], o[2 * q]); o[2 * q + 1] = fmaf(bfhi(w[q]), kk[2 * q + 1], o[2 * q + 1]); } }
            float ssq = 0.f;
#pragma unroll
            for (int q = 0; q < 8; ++q) { o[q] = siluf_(o[q]); ssq = fmaf(o[q], o[q], ssq); }
            if (pass < 2) { const float sc = rsqrtf(row_sum16(ssq) + EPS) * (pass == 0 ? 0.08838834764831845f : 1.f);
#pragma unroll
                for (int q = 0; q < 8; ++q) o[q] *= sc; }
            v4u ov; ov.x = pk2(o[0], o[1]); ov.y = pk2(o[2], o[3]); ov.z = pk2(o[4], o[5]); ov.w = pk2(o[6], o[7]);
            *(v4u*)(OUT + (size_t)row * 1536 + ch0) = ov;
        }
    }
}

__device__ __forceinline__ int scan_row(int b, int dir, int step) {
    if (step < LC) { const int t = dir ? LC - 1 - step : step; return ML + b * LC + t; }
    const int t = step - LC; return b * SEQ + (dir ? SEQ - 1 - t : t);
}
__device__ __forceinline__ void phase_combine(const Ctx& c) {
    const Args& a = *c.a;
    const bf16* OG0 = (const bf16*)(c.ws + WS_OG); const bf16* OG1 = OG0 + (size_t)ML * 512; const bf16* Z = (const bf16*)(c.ws + WS_Z);
    bf16* CAT = (bf16*)(c.ws + WS_CAT);
    for (int row = c.gw; row < ML; row += c.NGW) {
#pragma unroll
        for (int h = 0; h < 4; ++h) { const int ch = h * 128 + 2 * c.lane;
            const unsigned w0 = *(const unsigned*)(OG0 + (size_t)row * 512 + ch), w1 = *(const unsigned*)(OG1 + (size_t)row * 512 + ch), zw = *(const unsigned*)(Z + (size_t)row * 512 + ch);
            const float o0 = bflo(w0) + bflo(w1), o1 = bfhi(w0) + bfhi(w1);
            const float r = rsqrtf(wave_sum(o0 * o0 + o1 * o1) * (1.f / 128.f) + EPS);
            const f32x2 ng = *(const f32x2*)(a.in[I_GDNNORM] + 2 * c.lane);
            *(unsigned*)(CAT + (size_t)row * 1024 + 512 + ch) = pk2(o0 * r * ng.x * siluf_(bflo(zw)), o1 * r * ng.y * siluf_(bfhi(zw))); }
    }
}

__device__ __forceinline__ void phase_rows2(const Ctx& c) {
    const Args& a = *c.a;
    const float* MOD = (const float*)(c.ws + WS_MOD); const float* YRAW = (const float*)(c.ws + WS_YRAW); bf16* HX2 = (bf16*)(c.ws + WS_HX2);
    for (int row = c.gw; row < ML; row += c.NGW) {
        const float* mr = MOD + (row >> 11) * 6144;
        f32x4 y[4], x[4]; float ss = 0.f;
#pragma unroll
        for (int j = 0; j < 4; ++j) { y[j] = *((const f32x4*)(YRAW + (size_t)row * D) + c.lane + 64 * j); x[j] = *((const f32x4*)(a.in[I_X] + (size_t)row * D) + c.lane + 64 * j);
            ss += (y[j].x * y[j].x + y[j].y * y[j].y) + (y[j].z * y[j].z + y[j].w * y[j].w); }
        const float r = rsqrtf(wave_sum(ss) * (1.f / D) + EPS); float s2 = 0.f;
#pragma unroll
        for (int j = 0; j < 4; ++j) { const int col = 4 * c.lane + 256 * j;
            const f32x4 g4 = *(const f32x4*)(a.in[I_GPOSTMIX] + col), gt = *(const f32x4*)(mr + 2048 + col);
            x[j] = x[j] + gt * ((y[j] * r) * g4);
            *(f32x4*)(a.out + (size_t)row * D + col) = x[j];
            s2 += (x[j].x * x[j].x + x[j].y * x[j].y) + (x[j].z * x[j].z + x[j].w * x[j].w); }
        const float r2 = rsqrtf(wave_sum(s2) * (1.f / D) + EPS);
#pragma unroll
        for (int j = 0; j < 4; ++j) { const int col = 4 * c.lane + 256 * j;
            const f32x4 g4 = *(const f32x4*)(a.in[I_GPREFFN] + col), sh = *(const f32x4*)(mr + 3072 + col), scl = *(const f32x4*)(mr + 4096 + col);
            const f32x4 hv = (x[j] * r2) * g4 * (scl + 1.f) + sh;
            v2u o; o.x = pk2(hv.x, hv.y); o.y = pk2(hv.z, hv.w);
            *(v2u*)(HX2 + (size_t)row * D + col) = o;
            x[j] = (f32x4){bflo(o.x), bfhi(o.x), bflo(o.y), bfhi(o.y)}; }
        { float mx = 0.f;
#pragma unroll
          for (int j = 0; j < 4; ++j) mx = fmaxf(mx, fmaxf(fmaxf(fabsf(x[j].x), fabsf(x[j].y)), fmaxf(fabsf(x[j].z), fabsf(x[j].w))));
          mx = wmax(mx); const float hs = mx > 0.f ? 256.f / mx : 1.f;
          unsigned char* hq = c.ws + WS_HQ8 + (size_t)row * 2048;
#pragma unroll
          for (int j = 0; j < 4; ++j) { const float a0 = x[j].x * hs, a1 = x[j].y * hs, a2 = x[j].z * hs, a3 = x[j].w * hs;
              int w = __builtin_amdgcn_cvt_pk_fp8_f32(a0, a1, 0, false); w = __builtin_amdgcn_cvt_pk_fp8_f32(a2, a3, w, true);
              const f32x2 b01 = __builtin_amdgcn_cvt_pk_f32_fp8(w, false), b23 = __builtin_amdgcn_cvt_pk_f32_fp8(w, true);
              int w2 = __builtin_amdgcn_cvt_pk_fp8_f32((a0 - b01.x) * 16.f, (a1 - b01.y) * 16.f, 0, false); w2 = __builtin_amdgcn_cvt_pk_fp8_f32((a2 - b23.x) * 16.f, (a3 - b23.y) * 16.f, w2, true);
              *(unsigned*)(hq + 4 * c.lane + 256 * j) = (unsigned)w; *(unsigned*)(hq + 1024 + 4 * c.lane + 256 * j) = (unsigned)w2; }
          if (c.lane == 0) ((float*)(c.ws + WS_HS))[row] = 1.f / hs; }
    }
}


constexpr int KROW = 136;
__device__ __forceinline__ void phase_topk(const Ctx& c) {
    const Args& a = *c.a;
    bf16* kl = (bf16*)c.lds;
    unsigned char* wbase = c.lds + 2 * 128 * KROW * 2 + c.wave * 1024;
    bf16* qs = (bf16*)wbase;
    float* s1 = (float*)(wbase + 512); int* i1 = (int*)(wbase + 576); float* s2 = (float*)(wbase + 640); int* i2 = (int*)(wbase + 704); float* fs = (float*)(wbase + 768); int* fi = (int*)(wbase + 832);
    const bf16* QP = (const bf16*)(c.ws + WS_QP); int* IDX = (int*)(c.ws + WS_IDX); float* GATE = (float*)(c.ws + WS_GATE);
    for (int item = c.bid; item < 8 * 32; item += c.G) {
        const int h = item & 7, tr = item >> 3;
        __syncthreads();
        for (int i = c.tid; i < 2 * 128 * 64; i += NTHREADS) { const int k2 = i & 63, n = (i >> 6) & 127, p = i >> 13; const f32x2 kv = *(const f32x2*)(a.in[I_KEYS] + ((size_t)((h * 2 + p) * 128 + n)) * 128 + 2 * k2);
            *(unsigned*)(kl + (p * 128 + n) * KROW + 2 * k2) = pk2(kv.x, kv.y); }
        __syncthreads();
        v2u qnext = *(const v2u*)(QP + (size_t)(tr * 512 + c.wave) * 2048 + h * 256 + 4 * c.lane);
        for (int tt = c.wave; tt < 512; tt += NWAVES) {
            const int tok = tr * 512 + tt;
            *(v2u*)(qs + 4 * c.lane) = qnext;
            if (tt + NWAVES < 512) qnext = *(const v2u*)(QP + (size_t)(tok + NWAVES) * 2048 + h * 256 + 4 * c.lane);
            WAVE_LDS_SYNC();
            float sc[2][2];
#pragma unroll
            for (int p = 0; p < 2; ++p) { float sa0 = 0.f, sa1 = 0.f, sb0 = 0.f, sb1 = 0.f;
#pragma unroll 4
                for (int kk = 0; kk < 16; ++kk) { const bf16x2_t* qp = (const bf16x2_t*)(qs + p * 128 + kk * 8); const bf16x2_t* ap = (const bf16x2_t*)(kl + (p * 128 + c.lane) * KROW + kk * 8); const bf16x2_t* bp = (const bf16x2_t*)(kl + (p * 128 + c.lane + 64) * KROW + kk * 8);
                    const bf16x2_t q0 = qp[0], q1 = qp[1], q2 = qp[2], q3 = qp[3], a0 = ap[0], a1 = ap[1], a2 = ap[2], a3 = ap[3], b0 = bp[0], b1 = bp[1], b2 = bp[2], b3 = bp[3];
                    sa0 = __builtin_amdgcn_fdot2_f32_bf16(q0, a0, sa0, false); sa1 = __builtin_amdgcn_fdot2_f32_bf16(q1, a1, sa1, false); sa0 = __builtin_amdgcn_fdot2_f32_bf16(q2, a2, sa0, false); sa1 = __builtin_amdgcn_fdot2_f32_bf16(q3, a3, sa1, false);
                    sb0 = __builtin_amdgcn_fdot2_f32_bf16(q0, b0, sb0, false); sb1 = __builtin_amdgcn_fdot2_f32_bf16(q1, b1, sb1, false); sb0 = __builtin_amdgcn_fdot2_f32_bf16(q2, b2, sb0, false); sb1 = __builtin_amdgcn_fdot2_f32_bf16(q3, b3, sb1, false); }
                sc[p][0] = sa0 + sa1; sc[p][1] = sb0 + sb1; }
#pragma unroll
            for (int p = 0; p < 2; ++p) { float* so = p ? s2 : s1; int* io = p ? i2 : i1;
                const unsigned ky[2] = {fkey(sc[p][0]), fkey(sc[p][1])};
                const unsigned T = kth_key<2>(ky, 16);
                int cgt = 0;
#pragma unroll
                for (int n = 0; n < 2; ++n) cgt += __popcll(__ballot(ky[n] > T));
                const int need = 16 - cgt; int base = 0, eqb = 0;
#pragma unroll
                for (int n = 0; n < 2; ++n) { const bool eq = ky[n] == T; const unsigned long long em = __ballot(eq); const bool sel = (ky[n] > T) || (eq && (eqb + lane_rank(em)) < need);
                    const unsigned long long sm = __ballot(sel); if (sel) { const int pos = base + lane_rank(sm); so[pos] = sc[p][n]; io[pos] = c.lane + 64 * n; }
                    base += __popcll(sm); eqb += __popcll(em); } }
            WAVE_LDS_SYNC();
            { const int ci = c.lane >> 2, cj = 4 * (c.lane & 3);
              float cv[4]; unsigned ky[4]; const float b1 = s1[ci];
#pragma unroll
              for (int e = 0; e < 4; ++e) { cv[e] = b1 + s2[cj + e]; ky[e] = fkey(cv[e]); }
              const unsigned T = kth_key<4>(ky, 16);
              int cgt = 0;
#pragma unroll
              for (int e = 0; e < 4; ++e) cgt += __popcll(__ballot(ky[e] > T));
              const int need = 16 - cgt; int base = 0, eqb = 0; const int e1 = i1[ci] * 128;
#pragma unroll
              for (int e = 0; e < 4; ++e) { const bool eq = ky[e] == T; const unsigned long long em = __ballot(eq); const bool sel = (ky[e] > T) || (eq && (eqb + lane_rank(em)) < need);
                  const unsigned long long sm = __ballot(sel); if (sel) { const int pos = base + lane_rank(sm); fs[pos] = cv[e]; fi[pos] = e1 + i2[cj + e]; }
                  base += __popcll(sm); eqb += __popcll(em); } }
            WAVE_LDS_SYNC();
            { const float v = fs[c.lane & 15]; const float mx = row_max16(v); const float ex = __expf(v - mx); const float den = row_sum16(ex);
              if (c.lane < 16) { IDX[(size_t)tok * 128 + h * 16 + c.lane] = fi[c.lane]; GATE[(size_t)tok * 128 + h * 16 + c.lane] = ex / den; } }
            WAVE_LDS_SYNC();
        }
    }
}

__device__ __forceinline__ void phase_fp8_tables(const Ctx& c) {
    const Args& a = *c.a;
    for (int r = c.gw; r < 2 * NEXP; r += c.NGW) {
        const bool isv = r >= NEXP; const int e = isv ? r - NEXP : r;
        const f32x4* src = (const f32x4*)((isv ? a.in[I_PV] : a.in[I_PU]) + (size_t)e * D) + 4 * c.lane;
        f32x4 v[4]; float m = 0.f;
#pragma unroll
        for (int j = 0; j < 4; ++j) { v[j] = src[j]; m = fmaxf(m, fmaxf(fmaxf(fabsf(v[j].x), fabsf(v[j].y)), fmaxf(fabsf(v[j].z), fabsf(v[j].w)))); }
        m = wmax(m); const float inv = m > 0.f ? 256.f / m : 0.f;
        v4u o; unsigned ow[4];
#pragma unroll
        for (int j = 0; j < 4; ++j) { int w = __builtin_amdgcn_cvt_pk_fp8_f32(v[j].x * inv, v[j].y * inv, 0, false); w = __builtin_amdgcn_cvt_pk_fp8_f32(v[j].z * inv, v[j].w * inv, w, true); ow[j] = (unsigned)w; }
        o.x = ow[0]; o.y = ow[1]; o.z = ow[2]; o.w = ow[3];
        *(v4u*)(c.ws + (isv ? WS_V8 : WS_U8) + (size_t)e * D + 16 * c.lane) = o;
        if (c.lane == 0) ((float*)(c.ws + (isv ? WS_VSC : WS_USC)))[e] = m * (1.f / 256.f);
    }
}
__device__ __forceinline__ void fp8x16_to_f32(const v4u& r, float (&f)[16]) {
    const unsigned w[4] = {r.x, r.y, r.z, r.w};
#pragma unroll
    for (int j = 0; j < 4; ++j) { const f32x2 lo = __builtin_amdgcn_cvt_pk_f32_fp8((int)w[j], false), hi = __builtin_amdgcn_cvt_pk_f32_fp8((int)w[j], true); f[4 * j] = lo.x; f[4 * j + 1] = lo.y; f[4 * j + 2] = hi.x; f[4 * j + 3] = hi.y; }
}
__device__ __forceinline__ unsigned xcc_id() { return (unsigned)__builtin_amdgcn_s_getreg((3 << 11) | 20) & 7u; }

typedef long l64x2 __attribute__((ext_vector_type(2)));
struct E1Grp { l64x2 rw[16]; int e; float usc, vsc, gate; };
__device__ __forceinline__ void phase_exp1(const Ctx& c) {
    typedef float f32x4m __attribute__((ext_vector_type(4)));
    const int* IDX = (const int*)(c.ws + WS_IDX); const float* GATE = (const float*)(c.ws + WS_GATE); const float* HS = (const float*)(c.ws + WS_HS);
    const unsigned char* U8 = c.ws + WS_U8; const float* USC = (const float*)(c.ws + WS_USC); const float* VSC = (const float*)(c.ws + WS_VSC); float* ACT = (float*)(c.ws + WS_ACT);
    constexpr int CH = 4, TS = 2080, HLS = 1040;
    unsigned char* wl = c.lds + c.wave * 12800; int* le = (int*)wl; unsigned char* hq = wl + 4096; float* res = (float*)(wl + 4096 + CH * TS);
    const int r16 = c.lane & 15, g4 = c.lane >> 4; const bool bcol = r16 < 2;
    for (int item = c.gw; item < ML / CH; item += c.NGW) {
        const int t0 = item * CH;
        { v4u im[CH][2]; v4u ei[2];
#pragma unroll
          for (int tau = 0; tau < CH; ++tau) { const unsigned char* ip = c.ws + WS_HQ8 + ((size_t)t0 + tau) * 2048 + 16 * c.lane; im[tau][0] = *(const v4u*)ip; im[tau][1] = *(const v4u*)(ip + 1024); }
          ei[0] = *(const v4u*)(IDX + (size_t)t0 * 128 + 4 * c.lane); ei[1] = *(const v4u*)(IDX + (size_t)t0 * 128 + 256 + 4 * c.lane);
#pragma unroll
          for (int tau = 0; tau < CH; ++tau) { *(v4u*)(hq + tau * TS + 16 * c.lane) = im[tau][0]; *(v4u*)(hq + tau * TS + HLS + 16 * c.lane) = im[tau][1]; }
          *(v4u*)(le + 4 * c.lane) = ei[0]; *(v4u*)(le + 256 + 4 * c.lane) = ei[1];
          if (c.lane < CH) res[16 + c.lane] = HS[(size_t)t0 + c.lane]; }
        WAVE_LDS_SYNC();
#define E1_LOAD(G, J0) do { { const int j = ((J0) < CH * 128 ? (J0) : 0) + r16; G.e = le[j]; G.usc = USC[G.e]; G.vsc = VSC[G.e]; G.gate = GATE[(size_t)t0 * 128 + j]; \
              const unsigned char* rowp = U8 + (size_t)G.e * D + 16 * g4; _Pragma("unroll") for (int jj = 0; jj < 16; ++jj) G.rw[jj] = *(const l64x2*)(rowp + 64 * jj); } } while (0)
#define E1_COMP(G, J0) do { const unsigned char* hb = hq + ((J0) >> 7) * TS + (r16 & 1) * HLS + 16 * g4; const float hinv = res[16 + ((J0) >> 7)]; \
            f32x4m acc = {0.f, 0.f, 0.f, 0.f}; _Pragma("unroll") for (int jj = 0; jj < 16; ++jj) { \
                const long bq0 = *(const long*)(hb + 64 * jj), bq1 = *(const long*)(hb + 64 * jj + 8); \
                acc = __builtin_amdgcn_mfma_f32_16x16x32_fp8_fp8(G.rw[jj].x, bcol ? bq0 : 0l, acc, 0, 0, 0); acc = __builtin_amdgcn_mfma_f32_16x16x32_fp8_fp8(G.rw[jj].y, bcol ? bq1 : 0l, acc, 0, 0, 0); } \
            _Pragma("unroll") for (int q = 0; q < 4; ++q) { const float lo = dppf<0xB1>(acc[q]); if (r16 == 0) res[4 * g4 + q] = (acc[q] + lo * 0.0625f) * hinv; } \
            WAVE_LDS_SYNC(); \
            if (c.lane < 16) ACT[(size_t)t0 * 128 + (J0) + c.lane] = gelu_erf(res[c.lane] * G.usc) * G.gate * G.vsc; \
            WAVE_LDS_SYNC(); } while (0)
        E1Grp ga, gb;
        E1_LOAD(ga, 0);
#pragma unroll 1
        for (int j0 = 0; j0 < CH * 128; j0 += 32) {
            E1_LOAD(gb, j0 + 16);
            __builtin_amdgcn_sched_barrier(0);
            E1_COMP(ga, j0);
            __builtin_amdgcn_sched_barrier(0);
            E1_LOAD(ga, j0 + 32);
            __builtin_amdgcn_sched_barrier(0);
            E1_COMP(gb, j0 + 16);
            __builtin_amdgcn_sched_barrier(0);
        }
#undef E1_LOAD
#undef E1_COMP
        WAVE_LDS_SYNC();
    }
}
__device__ __forceinline__ void phase_exp2(const Ctx& c) {
    const int* IDX = (const int*)(c.ws + WS_IDX); const float* ACT = (const float*)(c.ws + WS_ACT); const unsigned char* V8 = c.ws + WS_V8;
    float* Y = (float*)(c.ws + WS_Y); float* SSQP = (float*)(c.ws + WS_SSQP);
    unsigned* cnt = (unsigned*)(c.ws + WS_CTL) + CW_E2;
    int* li = (int*)(c.lds + c.wave * 1024); float* la = (float*)(li + 128);
    const int xcc = (int)xcc_id(), sub = c.lane & 7, grp = c.lane >> 3;
    const bool b5 = c.lane & 32, b4 = c.lane & 16, b3 = c.lane & 8;
    constexpr int CH = 8;
    int bo = 0, t = 0, tend = 0;
    int iA = 0, iB = 0; float aA = 0.f, aB = 0.f;
    for (;;) {
        if (t >= tend) {
            unsigned t0 = 0; if (c.lane == 0) t0 = __hip_atomic_fetch_add(cnt + 64 * ((xcc + bo) & 7), (unsigned)CH, __ATOMIC_RELAXED, __HIP_MEMORY_SCOPE_AGENT);
            t0 = (unsigned)__builtin_amdgcn_readfirstlane((int)t0);
            if (t0 >= (unsigned)ML) { if (++bo >= 8) break; continue; }
            t = (int)t0; tend = t + CH;
            iA = IDX[(size_t)t * 128 + c.lane]; iB = IDX[(size_t)t * 128 + 64 + c.lane]; aA = ACT[(size_t)t * 128 + c.lane]; aB = ACT[(size_t)t * 128 + 64 + c.lane];
        }
        const int x = (xcc + bo) & 7;
        li[c.lane] = iA; li[64 + c.lane] = iB; la[c.lane] = aA; la[64 + c.lane] = aB;
        if (t + 1 < tend) { iA = IDX[(size_t)(t + 1) * 128 + c.lane]; iB = IDX[(size_t)(t + 1) * 128 + 64 + c.lane]; aA = ACT[(size_t)(t + 1) * 128 + c.lane]; aB = ACT[(size_t)(t + 1) * 128 + 64 + c.lane]; }
        WAVE_LDS_SYNC();
        float acc[16];
#pragma unroll
        for (int q = 0; q < 16; ++q) acc[q] = 0.f;
#pragma unroll
        for (int hf = 0; hf < 2; ++hf) { v4u rows[8]; float av[8];
#pragma unroll
            for (int i = 0; i < 8; ++i) { const int k = 8 * (8 * hf + i) + grp; rows[i] = *(const v4u*)(V8 + (size_t)li[k] * D + x * 128 + 16 * sub); av[i] = la[k]; }
#pragma unroll
            for (int i = 0; i < 8; ++i) { float f[16]; fp8x16_to_f32(rows[i], f);
#pragma unroll
                for (int q = 0; q < 16; ++q) acc[q] = fmaf(av[i], f[q], acc[q]); } }
        float q8[8], q4[4], q2[2];
#pragma unroll
        for (int i = 0; i < 8; ++i) { const float keep = b5 ? acc[i + 8] : acc[i], send = b5 ? acc[i] : acc[i + 8]; q8[i] = keep + __shfl_xor(send, 32); }
#pragma unroll
        for (int i = 0; i < 4; ++i) { const float keep = b4 ? q8[i + 4] : q8[i], send = b4 ? q8[i] : q8[i + 4]; q4[i] = keep + __shfl_xor(send, 16); }
#pragma unroll
        for (int i = 0; i < 2; ++i) { const float keep = b3 ? q4[i + 2] : q4[i], send = b3 ? q4[i] : q4[i + 2]; q2[i] = keep + __shfl_xor(send, 8); }
        const int col = x * 128 + 16 * sub + (b5 ? 8 : 0) + (b4 ? 4 : 0) + (b3 ? 2 : 0);
        *(f32x2*)(Y + (size_t)t * D + col) = (f32x2){q2[0], q2[1]};
        const float ss = wsum(q2[0] * q2[0] + q2[1] * q2[1]);
        SSQP[(size_t)x * ML + t] = ss;
        WAVE_LDS_SYNC();
        ++t;
    }
}
__device__ __forceinline__ void phase_exp3(const Ctx& c) {
    const Args& a = *c.a;
    const float* MOD = (const float*)(c.ws + WS_MOD); const float* Y = (const float*)(c.ws + WS_Y); const float* SSQP = (const float*)(c.ws + WS_SSQP);
    for (int row = c.gw; row < ML; row += c.NGW) {
        float ss = 0.f;
#pragma unroll
        for (int x = 0; x < 8; ++x) ss += SSQP[(size_t)x * ML + row];
        const float r = rsqrtf(ss * (1.f / D) + EPS); const float* mr = MOD + (row >> 11) * 6144 + 5120;
#pragma unroll
        for (int j = 0; j < 4; ++j) { const int col = 4 * c.lane + 256 * j;
            const f32x4 y = *(const f32x4*)(Y + (size_t)row * D + col), x1 = *(const f32x4*)(a.out + (size_t)row * D + col), g4 = *(const f32x4*)(a.in[I_GPOSTFFN] + col), gt = *(const f32x4*)(mr + col);
            *(f32x4*)(a.out + (size_t)row * D + col) = x1 + gt * ((y * r) * g4); }
    }
}

__device__ __forceinline__ void phase_experts(const Ctx& c) {
    const Args& a = *c.a;
    const float* MOD = (const float*)(c.ws + WS_MOD); const bf16* HX2 = (const bf16*)(c.ws + WS_HX2); const int* IDX = (const int*)(c.ws + WS_IDX); const float* GATE = (const float*)(c.ws + WS_GATE);
    float* acts = (float*)c.lds; int* eid = (int*)(c.lds + 512); float* red = (float*)(c.lds + 1024);
    for (int tok = c.bid; tok < ML; tok += c.G) {
        float hv[16];
#pragma unroll
        for (int j = 0; j < 4; ++j) { const v2u w = *(const v2u*)(HX2 + (size_t)tok * D + 4 * c.lane + 256 * j); hv[4 * j] = bflo(w.x); hv[4 * j + 1] = bfhi(w.x); hv[4 * j + 2] = bflo(w.y); hv[4 * j + 3] = bfhi(w.y); }
#pragma unroll 4
        for (int i = 0; i < 16; ++i) { const int k = c.wave * 16 + i; const int e = IDX[(size_t)tok * 128 + k];
            const f32x4* ur = (const f32x4*)(a.in[I_PU] + (size_t)e * D) + c.lane; float s = 0.f;
#pragma unroll
            for (int j = 0; j < 4; ++j) { const f32x4 u4 = ur[64 * j]; s += (u4.x * hv[4 * j] + u4.y * hv[4 * j + 1]) + (u4.z * hv[4 * j + 2] + u4.w * hv[4 * j + 3]); }
            s = wave_sum(s);
            if (c.lane == 0) { acts[k] = gelu_erf(s) * GATE[(size_t)tok * 128 + k]; eid[k] = e; } }
        __syncthreads();
        f32x2 acc = (f32x2){0.f, 0.f};
#pragma unroll 8
        for (int k = 0; k < 128; ++k) { const f32x2 v2 = *(const f32x2*)(a.in[I_PV] + (size_t)eid[k] * D + 2 * c.tid); const float ak = acts[k]; acc.x = fmaf(ak, v2.x, acc.x); acc.y = fmaf(ak, v2.y, acc.y); }
        const float ws = wave_sum(acc.x * acc.x + acc.y * acc.y);
        if (c.lane == 0) red[c.wave] = ws;
        __syncthreads();
        float tot = 0.f;
#pragma unroll
        for (int w = 0; w < 8; ++w) tot += red[w];
        const float r = rsqrtf(tot * (1.f / D) + EPS);
        const int col = 2 * c.tid; const float* mr = MOD + (tok >> 11) * 6144 + 5120;
        const f32x2 x1 = *(const f32x2*)(a.out + (size_t)tok * D + col), g2 = *(const f32x2*)(a.in[I_GPOSTFFN] + col), gt = *(const f32x2*)(mr + col);
        *(f32x2*)(a.out + (size_t)tok * D + col) = (f32x2){x1.x + gt.x * (acc.x * r * g2.x), x1.y + gt.y * (acc.y * r * g2.y)};
        __syncthreads();
    }
}


constexpr int S5_LPOW = 0, S5_BBAR = 33792, S5_CC = 50176, S5_MM = 66560;
__device__ __forceinline__ void s5_build_group(const Ctx& c, int g, int part) {
    const Args& a = *c.a;
    f32x2* LPOW = (f32x2*)(c.lds + S5_LPOW);
    f32x2* BBAR = (f32x2*)(c.lds + S5_BBAR);
    f32x2* CC = (f32x2*)(c.lds + S5_CC);
    float* MM = (float*)(c.lds + S5_MM);
    __syncthreads();
    if (c.tid < 128) { const int dir = c.tid >> 6, p = c.tid & 63, dg = dir * 32 + g;
        const float dt = expf(a.in[I_LOGDT][dg]), lr = a.in[I_LAMRE][dg * 64 + p], li = a.in[I_LAMIM][dg * 64 + p];
        const double ang = (double)li * (double)dt; const float lrdt = lr * dt;
        for (int e = 0; e <= 32; ++e) { float sn, cs; sincos_d(ang * (double)e, sn, cs); const float mg = expf(lrdt * (float)e); LPOW[(dir * 33 + e) * 64 + p] = (f32x2){mg * cs, mg * sn}; }
        float sn, cs; sincos_d(ang, sn, cs); const float mag = expf(lrdt), lbr = mag * cs, lbi = mag * sn, den = lr * lr + li * li, nr = lbr - 1.f;
        const float cr = (nr * lr + lbi * li) / den, ci = (lbi * lr - nr * li) / den;
        for (int ch = 0; ch < 16; ++ch) { const float br = a.in[I_BRE][(size_t)(dg * 64 + p) * 16 + ch], bi = a.in[I_BIM][(size_t)(dg * 64 + p) * 16 + ch]; BBAR[(dir * 64 + p) * 16 + ch] = (f32x2){cr * br - ci * bi, cr * bi + ci * br}; } }
    for (int i = c.tid; i < 2048; i += NTHREADS) { const int dir = i >> 10, ch = (i >> 6) & 15, p = i & 63, dg = dir * 32 + g; CC[i] = (f32x2){a.in[I_CRE][(size_t)(dg * 16 + ch) * 64 + p], a.in[I_CIM][(size_t)(dg * 16 + ch) * 64 + p]}; }
    __syncthreads();
    for (int task = c.tid; task < 1024; task += NTHREADS) { const int cpb = task & 3, cb = (task >> 2) & 3, lag = (task >> 4) & 31, dir = task >> 9;
        float acc[4][4];
#pragma unroll
        for (int i = 0; i < 4; ++i)
#pragma unroll
            for (int j = 0; j < 4; ++j) acc[i][j] = 0.f;
        for (int p = 0; p < 64; ++p) { const f32x2 l = LPOW[(dir * 33 + lag) * 64 + p]; f32x2 G[4], Cw[4];
#pragma unroll
            for (int j = 0; j < 4; ++j) { const f32x2 bb = BBAR[(dir * 64 + p) * 16 + 4 * cpb + j]; G[j] = (f32x2){l.x * bb.x - l.y * bb.y, l.x * bb.y + l.y * bb.x}; }
#pragma unroll
            for (int i = 0; i < 4; ++i) Cw[i] = CC[(dir * 16 + 4 * cb + i) * 64 + p];
#pragma unroll
            for (int i = 0; i < 4; ++i)
#pragma unroll
                for (int j = 0; j < 4; ++j) acc[i][j] += Cw[i].x * G[j].x - Cw[i].y * G[j].y; }
#pragma unroll
        for (int i = 0; i < 4; ++i)
#pragma unroll
            for (int j = 0; j < 4; ++j) MM[((dir * 32 + lag) * 16 + 4 * cb + i) * 16 + 4 * cpb + j] = acc[i][j]; }
    __syncthreads();
    if (c.tid < 128 && part == 0) { const int dir = c.tid >> 6, p = c.tid & 63; ((f32x2*)(c.ws + WS_LP))[(dir * 32 + g) * 64 + p] = LPOW[(dir * 33 + 32) * 64 + p]; }
    bf16* PMg = (bf16*)(c.ws + WS_PM) + (size_t)g * 256 * 512; bf16* BBg = (bf16*)(c.ws + WS_BB) + (size_t)g * 512 * 768;
    for (int task = part * 32 * 32 + c.tid; task < (part + 1) * 32 * 32; task += NTHREADS) { const int ip = task & 31, n = task >> 5, dir = n >> 7, im = (n >> 6) & 1, p = n & 63, e = dir ? ip : 31 - ip;
        const f32x2 l = LPOW[(dir * 33 + e) * 64 + p]; float o[16];
#pragma unroll
        for (int ch = 0; ch < 16; ++ch) { const f32x2 bb = BBAR[(dir * 64 + p) * 16 + ch]; o[ch] = im ? (l.x * bb.y + l.y * bb.x) : (l.x * bb.x - l.y * bb.y); }
        v4u w0, w1; w0.x = pk2(o[0], o[1]); w0.y = pk2(o[2], o[3]); w0.z = pk2(o[4], o[5]); w0.w = pk2(o[6], o[7]); w1.x = pk2(o[8], o[9]); w1.y = pk2(o[10], o[11]); w1.z = pk2(o[12], o[13]); w1.w = pk2(o[14], o[15]);
        *(v4u*)(PMg + (size_t)n * 512 + ip * 16) = w0; *(v4u*)(PMg + (size_t)n * 512 + ip * 16 + 8) = w1; }
    for (int task = part * 64 * 32 + c.tid; task < (part + 1) * 64 * 32; task += NTHREADS) { const int ip = task & 31, n = task >> 5, i = n >> 4, ch = n & 15; float o[16];
#pragma unroll
        for (int q = 0; q < 16; ++q) o[q] = 0.f;
        if (ip <= i) { const float* m0 = MM + ((0 * 32 + (i - ip)) * 16 + ch) * 16;
#pragma unroll
            for (int q = 0; q < 16; ++q) o[q] += m0[q]; }
        if (ip >= i) { const float* m1 = MM + ((1 * 32 + (ip - i)) * 16 + ch) * 16;
#pragma unroll
            for (int q = 0; q < 16; ++q) o[q] += m1[q]; }
        if (ip == i) { const float dsk = a.in[I_S5D][g * 16 + ch];
#pragma unroll
            for (int q = 0; q < 16; ++q) o[q] += (q == ch) ? dsk : 0.f; }
        v4u w0, w1; w0.x = pk2(o[0], o[1]); w0.y = pk2(o[2], o[3]); w0.z = pk2(o[4], o[5]); w0.w = pk2(o[6], o[7]); w1.x = pk2(o[8], o[9]); w1.y = pk2(o[10], o[11]); w1.z = pk2(o[12], o[13]); w1.w = pk2(o[14], o[15]);
        *(v4u*)(BBg + (size_t)n * 768 + ip * 16) = w0; *(v4u*)(BBg + (size_t)n * 768 + ip * 16 + 8) = w1; }
    for (int task = part * 64 * 32 + c.tid; task < (part + 1) * 64 * 32; task += NTHREADS) { const int p8 = task & 7, part = (task >> 3) & 3, n = task >> 5, i = n >> 4, ch = n & 15, dir = part >> 1, im = part & 1, e = dir ? 32 - i : i + 1; float o[8];
#pragma unroll
        for (int q = 0; q < 8; ++q) { const int p = p8 * 8 + q; const f32x2 l = LPOW[(dir * 33 + e) * 64 + p], cc = CC[(dir * 16 + ch) * 64 + p]; o[q] = im ? -(cc.x * l.y + cc.y * l.x) : (cc.x * l.x - cc.y * l.y); }
        v4u w0; w0.x = pk2(o[0], o[1]); w0.y = pk2(o[2], o[3]); w0.z = pk2(o[4], o[5]); w0.w = pk2(o[6], o[7]);
        *(v4u*)(BBg + (size_t)n * 768 + 512 + part * 64 + p8 * 8) = w0; }
}
__device__ __forceinline__ void s5_state_scan(const Ctx& c, int task) {
    const int dir = task & 1, g = (task >> 1) & 31, b = task >> 6, p = c.lane;
    const f32x2 a = ((const f32x2*)(c.ws + WS_LP))[(dir * 32 + g) * 64 + p];
    const float* SS = (const float*)(c.ws + WS_SS) + (size_t)g * 768 * 256 + dir * 128 + p; bf16* U5 = (bf16*)(c.ws + WS_U5) + (size_t)g * 768 * 768 + 512 + dir * 128 + p;
    float er = 0.f, ei = 0.f;
#pragma unroll 8
    for (int step = 0; step < 72; ++step) {
        const int R = (step < 8) ? 512 + b * 8 + (dir ? 7 - step : step) : b * 64 + (dir ? 71 - step : step - 8);
        if (step >= 8) { U5[(size_t)R * 768] = (bf16)f2bf(er); U5[(size_t)R * 768 + 64] = (bf16)f2bf(ei); }
        const float sr = SS[(size_t)R * 256], si = SS[(size_t)R * 256 + 64];
        const float nr = sr + a.x * er - a.y * ei, ni = si + a.x * ei + a.y * er; er = nr; ei = ni;
    }
}

typedef short bf16x8 __attribute__((ext_vector_type(8)));
typedef float f32x16 __attribute__((ext_vector_type(16)));
#define MFMA32(a, b, c) __builtin_amdgcn_mfma_f32_32x32x16_bf16((a), (b), (c), 0, 0, 0)
constexpr int GDN_NCH = 36, GDN_ITEMS = NB * 4 * 2 * GDN_NCH;
constexpr size_t FR_T_BYTES = 8192, FR_ATT_BYTES = 8192, FR_KD_BYTES = 16384, FR_TAB_BYTES = 1024;
__device__ __forceinline__ int crow16(int i, int hh) { return (i & 3) + 8 * (i >> 2) + 4 * hh; }
__device__ __forceinline__ bf16x8 pack_step(const f32x16& x, int s) {
    v4u w; w.x = pk2(x[8 * s + 0], x[8 * s + 1]); w.y = pk2(x[8 * s + 2], x[8 * s + 3]); w.z = pk2(x[8 * s + 4], x[8 * s + 5]); w.w = pk2(x[8 * s + 6], x[8 * s + 7]);
    return __builtin_bit_cast(bf16x8, w);
}
__device__ __forceinline__ unsigned pk2v(float lo, float hi) { asm volatile("" : "+v"(lo), "+v"(hi)); return pk2(lo, hi); }
__device__ __forceinline__ bf16x8 pack_step_v(const f32x16& x, int s) {
    v4u w; w.x = pk2v(x[8 * s + 0], x[8 * s + 1]); w.y = pk2v(x[8 * s + 2], x[8 * s + 3]); w.z = pk2v(x[8 * s + 4], x[8 * s + 5]); w.w = pk2v(x[8 * s + 6], x[8 * s + 7]);
    return __builtin_bit_cast(bf16x8, w);
}
constexpr int GP_KR = 0, GP_QR = 17408, GP_KT = 34816, GP_LM = 53248, GP_TB = 70656, GP_TAB = 79872;
__device__ __forceinline__ void gdn_prep_item(const Ctx& c, int item) {
    const int n = item % GDN_NCH, bhd = item / GDN_NCH, dir = bhd & 1, h = (bhd >> 1) & 3, b = bhd >> 3;
    const bf16* QKV = (const bf16*)(c.ws + WS_QKV); const float* GB = (const float*)(c.ws + WS_GB);
    bf16* Kr = (bf16*)(c.lds + GP_KR); bf16* Qr = (bf16*)(c.lds + GP_QR); bf16* Kt = (bf16*)(c.lds + GP_KT); float* Lm = (float*)(c.lds + GP_LM); bf16* Tb = (bf16*)(c.lds + GP_TB); float* tab = (float*)(c.lds + GP_TAB);
    unsigned char* frT = c.ws + WS_FRT + (size_t)item * FR_T_BYTES; unsigned char* frA = c.ws + WS_FRA + (size_t)item * FR_ATT_BYTES; unsigned char* frK = c.ws + WS_FRK + (size_t)item * FR_KD_BYTES; float* frTab = (float*)(c.ws + WS_FRTAB + (size_t)item * FR_TAB_BYTES);
    const int r = c.lane & 31, hh = c.lane >> 5;
    if (c.wave == 0) { const int row = scan_row(b, dir, n * 64 + c.lane); float g = GB[(size_t)row * 16 + dir * 4 + h]; const float beta = GB[(size_t)row * 16 + 8 + dir * 4 + h];
#pragma unroll
        for (int o = 1; o < 64; o <<= 1) { const float t = __shfl_up(g, o); if (c.lane >= o) g += t; }
        const float gl = __shfl(g, 63);
        tab[c.lane] = g; tab[64 + c.lane] = beta; tab[128 + c.lane] = __expf(g); tab[192 + c.lane] = __expf(gl - g); }
    { const int s = c.tid >> 3, seg = c.tid & 7; const int row = scan_row(b, dir, n * 64 + s); const bf16* rp = QKV + (size_t)row * 1536 + h * 128 + seg * 16;
      const v4u q0 = *(const v4u*)rp, q1 = *(const v4u*)(rp + 8), k0 = *(const v4u*)(rp + 512), k1 = *(const v4u*)(rp + 520);
      *(v4u*)(Qr + s * 136 + seg * 16) = q0; *(v4u*)(Qr + s * 136 + seg * 16 + 8) = q1; *(v4u*)(Kr + s * 136 + seg * 16) = k0; *(v4u*)(Kr + s * 136 + seg * 16 + 8) = k1;
      const unsigned kw[8] = {k0.x, k0.y, k0.z, k0.w, k1.x, k1.y, k1.z, k1.w};
#pragma unroll
      for (int e = 0; e < 8; ++e) { Kt[(seg * 16 + 2 * e) * 72 + s] = (bf16)(kw[e] & 0xffffu); Kt[(seg * 16 + 2 * e + 1) * 72 + s] = (bf16)(kw[e] >> 16); } }
    __syncthreads();
    if (c.wave < 3) { const int ct = c.wave ? 1 : 0, st = c.wave == 2 ? 1 : 0;
        f32x16 acc;
#pragma unroll
        for (int i = 0; i < 16; ++i) acc[i] = 0.f;
#pragma unroll
        for (int kk = 0; kk < 8; ++kk) { const bf16x8 a = *(const bf16x8*)(Kr + (ct * 32 + r) * 136 + kk * 16 + hh * 8), bb = *(const bf16x8*)(Kr + (st * 32 + r) * 136 + kk * 16 + hh * 8); acc = MFMA32(a, bb, acc); }
        const int s = st * 32 + r; const float gcs = tab[s];
#pragma unroll
        for (int i = 0; i < 16; ++i) { const int cc = ct * 32 + crow16(i, hh); Lm[cc * 68 + s] = (s < cc) ? tab[64 + cc] * acc[i] * __expf(tab[cc] - gcs) : 0.f; }
    } else if (c.wave < 6) { const int w = c.wave - 3, st = w == 2 ? 1 : 0, ct = w ? 1 : 0;
        f32x16 acc;
#pragma unroll
        for (int i = 0; i < 16; ++i) acc[i] = 0.f;
#pragma unroll
        for (int kk = 0; kk < 8; ++kk) { const bf16x8 a = *(const bf16x8*)(Kr + (st * 32 + r) * 136 + kk * 16 + hh * 8), bb = *(const bf16x8*)(Qr + (ct * 32 + r) * 136 + kk * 16 + hh * 8); acc = MFMA32(a, bb, acc); }
        const int cc = ct * 32 + r; const float gcc = tab[cc];
#pragma unroll
        for (int i = 0; i < 16; ++i) { const int s = st * 32 + crow16(i, hh); acc[i] = (s <= cc) ? acc[i] * __expf(gcc - tab[s]) : 0.f; }
        *(bf16x8*)(frA + ((size_t)((ct * 4 + 2 * st) * 64 + c.lane)) * 16) = pack_step(acc, 0);
        *(bf16x8*)(frA + ((size_t)((ct * 4 + 2 * st + 1) * 64 + c.lane)) * 16) = pack_step(acc, 1);
    } else { const int w = c.wave - 6;
#pragma unroll
        for (int f = 0; f < 8; ++f) { const int fi = w * 8 + f, dkt = fi >> 2, cb = fi & 3; const bf16* kp = Kt + (dkt * 32 + r) * 72 + 16 * cb + 4 * hh;
            const v2u lo = *(const v2u*)kp, hi = *(const v2u*)(kp + 8); const f32x4 e0 = *(const f32x4*)(tab + 192 + 16 * cb + 4 * hh), e1 = *(const f32x4*)(tab + 192 + 16 * cb + 8 + 4 * hh);
            v4u o; o.x = pk2(bflo(lo.x) * e0.x, bfhi(lo.x) * e0.y); o.y = pk2(bflo(lo.y) * e0.z, bfhi(lo.y) * e0.w); o.z = pk2(bflo(hi.x) * e1.x, bfhi(hi.x) * e1.y); o.w = pk2(bflo(hi.y) * e1.z, bfhi(hi.y) * e1.w);
            *(v4u*)(frK + ((size_t)(fi * 64 + c.lane)) * 16) = o; }
        if (w == 0) { const v4u z = (v4u){0u, 0u, 0u, 0u}; *(v4u*)(frA + ((size_t)((0 * 4 + 2) * 64 + c.lane)) * 16) = z; *(v4u*)(frA + ((size_t)((0 * 4 + 3) * 64 + c.lane)) * 16) = z; }
        else { *(f32x4*)(frTab + 4 * c.lane) = *(const f32x4*)(tab + 4 * c.lane); }
    }
    __syncthreads();
    if (c.wave == 0) { float Tr[64];
#pragma unroll
        for (int i = 0; i < 64; ++i) { float a0 = (c.lane == i) ? 1.f : 0.f, a1 = 0.f;
#pragma unroll
            for (int s4 = 0; s4 < (i + 3) / 4; ++s4) { const f32x4 l4 = *(const f32x4*)(Lm + i * 68 + 4 * s4);
                if (4 * s4 + 0 < i) a0 = fmaf(-l4.x, Tr[4 * s4 + 0], a0); if (4 * s4 + 1 < i) a1 = fmaf(-l4.y, Tr[4 * s4 + 1], a1); if (4 * s4 + 2 < i) a0 = fmaf(-l4.z, Tr[4 * s4 + 2], a0); if (4 * s4 + 3 < i) a1 = fmaf(-l4.w, Tr[4 * s4 + 3], a1); }
            Tr[i] = a0 + a1; Tb[i * 72 + c.lane] = (bf16)f2bf(Tr[i]); } }
    __syncthreads();
    { const int ct = c.wave >> 2, sb = c.wave & 3; const bf16* tp = Tb + (ct * 32 + r) * 72 + 16 * sb + 4 * hh; const v2u lo = *(const v2u*)tp, hi = *(const v2u*)(tp + 8);
      *(v4u*)(frT + ((size_t)((ct * 4 + sb) * 64 + c.lane)) * 16) = (v4u){lo.x, lo.y, hi.x, hi.y}; }
    __syncthreads();
}
__device__ __forceinline__ void phase_gdn_prep(const Ctx& c) { for (int item = c.bid; item < GDN_ITEMS; item += c.G) gdn_prep_item(c, item); }

constexpr int GR_K = 0, GR_Q = 16384, GR_T = 32768, GR_A = 40960, GR_KD = 49152, GR_TAB = 65536, GR_BUF = 66560;
__device__ __forceinline__ void gdn_rec_stage(const Ctx& c, int bhd, int n, int buf) {
    const int dir = bhd & 1, h = (bhd >> 1) & 3, b = bhd >> 3, lw = c.wave - 4; const int item = bhd * GDN_NCH + n;
    LAS unsigned char* base = (LAS unsigned char*)c.lds + buf * GR_BUF;
    const unsigned char* QKVb = c.ws + WS_QKV;
#pragma unroll
    for (int q = 0; q < 4; ++q) { const int qi = lw + 4 * q;
        const int s = 4 * qi + (c.lane >> 4), ps = c.lane & 15, p = ps ^ (s & 15); const size_t rowb = (size_t)scan_row(b, dir, n * 64 + s) * 3072 + (size_t)h * 256 + p * 16;
        __builtin_amdgcn_global_load_lds((const unsigned*)(QKVb + rowb + 1024), (LAS unsigned*)(base + GR_K + qi * 1024), 16, 0, 0);
        __builtin_amdgcn_global_load_lds((const unsigned*)(QKVb + rowb), (LAS unsigned*)(base + GR_Q + qi * 1024), 16, 0, 0); }
    const unsigned char* frT = c.ws + WS_FRT + (size_t)item * FR_T_BYTES; const unsigned char* frA = c.ws + WS_FRA + (size_t)item * FR_ATT_BYTES; const unsigned char* frK = c.ws + WS_FRK + (size_t)item * FR_KD_BYTES;
#pragma unroll
    for (int q = 0; q < 2; ++q) { const int qi = lw + 4 * q;
        __builtin_amdgcn_global_load_lds((const unsigned*)(frT + qi * 1024 + c.lane * 16), (LAS unsigned*)(base + GR_T + qi * 1024), 16, 0, 0);
        __builtin_amdgcn_global_load_lds((const unsigned*)(frA + qi * 1024 + c.lane * 16), (LAS unsigned*)(base + GR_A + qi * 1024), 16, 0, 0); }
#pragma unroll
    for (int q = 0; q < 4; ++q) { const int qi = lw + 4 * q;
        __builtin_amdgcn_global_load_lds((const unsigned*)(frK + qi * 1024 + c.lane * 16), (LAS unsigned*)(base + GR_KD + qi * 1024), 16, 0, 0); }
    if (lw == 0) __builtin_amdgcn_global_load_lds((const unsigned*)(c.ws + WS_FRTAB + (size_t)item * FR_TAB_BYTES + c.lane * 16), (LAS unsigned*)(base + GR_TAB), 16, 0, 0);
}
__device__ __forceinline__ bf16x8 gr_rowfrag(const unsigned char* tile, int row, int kb, int hh) {
    const unsigned char* rp = tile + row * 256; const int sw = row & 15;
    const v2u lo = *(const v2u*)(rp + (((2 * kb) ^ sw) * 16) + 8 * hh), hi = *(const v2u*)(rp + (((2 * kb + 1) ^ sw) * 16) + 8 * hh);
    return __builtin_bit_cast(bf16x8, (v4u){lo.x, lo.y, hi.x, hi.y});
}
__device__ __forceinline__ void gdn_rec_block(const Ctx& c, int bhd) {
    const int dir = bhd & 1, h = (bhd >> 1) & 3, b = bhd >> 3, r = c.lane & 31, hh = c.lane >> 5, dvt = c.wave;
    const bf16* QKV = (const bf16*)(c.ws + WS_QKV); bf16* OG = (bf16*)(c.ws + WS_OG) + (size_t)dir * ML * 512;
    f32x16 S[4];
#pragma unroll
    for (int t = 0; t < 4; ++t)
#pragma unroll
        for (int i = 0; i < 16; ++i) S[t][i] = 0.f;
    if (c.wave >= 4) gdn_rec_stage(c, bhd, 0, 0);
    asm volatile("s_waitcnt vmcnt(0)" ::: "memory"); __syncthreads();
    for (int n = 0; n < GDN_NCH; ++n) {
        const int buf = n & 1;
        if (c.wave >= 4) { if (n + 1 < GDN_NCH) gdn_rec_stage(c, bhd, n + 1, buf ^ 1); }
        else {
            const unsigned char* base = c.lds + buf * GR_BUF; const float* tab = (const float*)(base + GR_TAB);
            const int row0 = scan_row(b, dir, n * 64), sgn = dir ? -1 : 1;
            const bf16* vcol = QKV + (size_t)row0 * 1536 + 1024 + h * 128 + dvt * 32 + r + (ptrdiff_t)(sgn * 4 * hh) * 1536;
            bf16* ocol = OG + (size_t)row0 * 512 + h * 128 + dvt * 32 + r + (ptrdiff_t)(sgn * 4 * hh) * 512;
            const ptrdiff_t vst = (ptrdiff_t)sgn * 1536, ost = (ptrdiff_t)sgn * 512;
            bf16 vraw[2][16];
#pragma unroll
            for (int st = 0; st < 2; ++st)
#pragma unroll
                for (int i = 0; i < 16; ++i) vraw[st][i] = vcol[vst * (st * 32 + (i & 3) + 8 * (i >> 2))];
            bf16x8 Rf[2][2];
#pragma unroll
            for (int st = 0; st < 2; ++st) { f32x16 acc;
#pragma unroll
                for (int i = 0; i < 16; ++i) acc[i] = 0.f;
#pragma unroll
                for (int kb = 0; kb < 8; ++kb) acc = MFMA32(gr_rowfrag(base + GR_K, st * 32 + r, kb, hh), pack_step_v(S[kb >> 1], kb & 1), acc);
#pragma unroll
                for (int i = 0; i < 16; ++i) { const int s = st * 32 + crow16(i, hh); acc[i] = tab[64 + s] * (bf1(vraw[st][i]) - tab[128 + s] * acc[i]); }
                Rf[st][0] = pack_step(acc, 0); Rf[st][1] = pack_step(acc, 1); asm volatile("" ::: "memory"); }
            bf16x8 Vf[2][2];
#pragma unroll
            for (int ct = 0; ct < 2; ++ct) { f32x16 acc;
#pragma unroll
                for (int i = 0; i < 16; ++i) acc[i] = 0.f;
#pragma unroll
                for (int sb = 0; sb < 4; ++sb) if (sb < 2 * ct + 2) acc = MFMA32(*(const bf16x8*)(base + GR_T + ((ct * 4 + sb) * 64 + c.lane) * 16), Rf[sb >> 1][sb & 1], acc);
                Vf[ct][0] = pack_step(acc, 0); Vf[ct][1] = pack_step(acc, 1); }
            asm volatile("" ::: "memory");
#pragma unroll
            for (int ct = 0; ct < 2; ++ct) { f32x16 acc;
#pragma unroll
                for (int i = 0; i < 16; ++i) acc[i] = 0.f;
#pragma unroll
                for (int kb = 0; kb < 8; ++kb) acc = MFMA32(gr_rowfrag(base + GR_Q, ct * 32 + r, kb, hh), pack_step_v(S[kb >> 1], kb & 1), acc);
#pragma unroll
                for (int i = 0; i < 16; ++i) acc[i] *= tab[128 + ct * 32 + crow16(i, hh)];
#pragma unroll
                for (int cb = 0; cb < 4; ++cb) if (cb < 2 * ct + 2) acc = MFMA32(*(const bf16x8*)(base + GR_A + ((ct * 4 + cb) * 64 + c.lane) * 16), Vf[cb >> 1][cb & 1], acc);
                if (n >= 4) {
#pragma unroll
                    for (int i = 0; i < 16; ++i) ocol[ost * (ct * 32 + (i & 3) + 8 * (i >> 2))] = (bf16)f2bf(acc[i]); }
                asm volatile("" ::: "memory"); }
            const float gtot = tab[128 + 63];
#pragma unroll
            for (int t = 0; t < 4; ++t) {
#pragma unroll
                for (int i = 0; i < 16; ++i) S[t][i] *= gtot;
#pragma unroll
                for (int cb = 0; cb < 4; ++cb) S[t] = MFMA32(*(const bf16x8*)(base + GR_KD + ((t * 4 + cb) * 64 + c.lane) * 16), Vf[cb >> 1][cb & 1], S[t]); }
        }
        if (c.wave >= 4) asm volatile("s_waitcnt vmcnt(0)" ::: "memory"); else asm volatile("s_waitcnt lgkmcnt(0)" ::: "memory");
        __builtin_amdgcn_s_barrier(); asm volatile("" ::: "memory");
    }
    asm volatile("s_waitcnt vmcnt(0)" ::: "memory"); __syncthreads();
}
__device__ __forceinline__ void phase_gdn_rec(const Ctx& c) { for (int bhd = c.bid; bhd < 64; bhd += 64) gdn_rec_block(c, bhd); }

#define XB_TMO      128
#define XB_XCNT(j)  (256  + 64 * (j))
#define XB_XSUB(j)  (1280 + 64 * (j))
#define XB_XGEN(j)  (2304 + 64 * (j))
#define XB_TOP      3328
#define XB_TOPGEN   3392
#define XCD_BAR_WORDS 3456
#define XB_SPIN_CAP (1u << 20)
__device__ __forceinline__ unsigned xb_ld(unsigned* p)              { return __hip_atomic_load(p, __ATOMIC_RELAXED, __HIP_MEMORY_SCOPE_AGENT); }
__device__ __forceinline__ unsigned xb_add(unsigned* p, unsigned v) { return __hip_atomic_fetch_add(p, v, __ATOMIC_RELAXED, __HIP_MEMORY_SCOPE_AGENT); }
__device__ __forceinline__ unsigned xb_xcc_id() { return (unsigned)__builtin_amdgcn_s_getreg((3 << 11) | 20) & 0xFu; }
#define XB_SPIN(cond, bar) do { unsigned _sp = 0; while (cond) { __builtin_amdgcn_s_sleep(1); \
    if ((++_sp & 255u) == 0u) { if (xb_ld(&(bar)[XB_TMO])) break; if (_sp > XB_SPIN_CAP) { atomicAdd(&(bar)[XB_TMO], 1u); break; } } } } while (0)
struct XcdBarrier { unsigned* bar; unsigned x; volatile LAS unsigned* st; };
__device__ __forceinline__ XcdBarrier xcd_barrier_post(unsigned* bar, volatile LAS unsigned* st) {
    XcdBarrier b; b.bar = bar; b.x = xb_xcc_id(); b.st = st;
    if (threadIdx.x == 0) (void)xb_add(&bar[XB_XCNT(b.x)], 1u);
    return b;
}
__device__ __forceinline__ void xcd_barrier_complete(unsigned* bar, unsigned x, unsigned& nloc, unsigned& nx) {
    const unsigned G = gridDim.x * gridDim.y * gridDim.z;
    unsigned sum, cnt, mine, sp = 0u;
    for (;;) {
        sum = 0u; cnt = 0u; mine = 0u;
#pragma unroll
        for (unsigned j = 0; j < 16; ++j) { const unsigned c = xb_ld(&bar[XB_XCNT(j)]); sum += c; cnt += (c > 0u) ? 1u : 0u; mine = (j == x) ? c : mine; }
        if (sum == G) break;
        __builtin_amdgcn_s_sleep(1);
        if ((++sp & 255u) == 0u) { if (xb_ld(&bar[XB_TMO])) break; if (sp > XB_SPIN_CAP) { atomicAdd(&bar[XB_TMO], 1u); break; } }
    }
    nloc = mine > 0u ? mine : 1u; nx = cnt > 0u ? cnt : 1u;
}
__device__ __forceinline__ void xcd_barrier(const XcdBarrier& b) {
    asm volatile("s_waitcnt vmcnt(0)" ::: "memory");
    __syncthreads();
    if (threadIdx.x == 0) {
        unsigned* bar = b.bar;
        __builtin_amdgcn_s_waitcnt(0);
        unsigned nloc = b.st[0], nx = b.st[1];
        if (nloc == 0u) { xcd_barrier_complete(bar, b.x, nloc, nx); b.st[0] = nloc; b.st[1] = nx; }
        const unsigned old = xb_add(&bar[XB_XSUB(b.x)], 1u);
        const unsigned gen = old / nloc;
        if (old + 1u == (gen + 1u) * nloc) {
            __builtin_amdgcn_fence(__ATOMIC_RELEASE, "agent");
            asm volatile("s_waitcnt vmcnt(0)" ::: "memory");
            const unsigned og = xb_add(&bar[XB_TOP], 1u);
            const unsigned tg = og / nx;
            if (og + 1u == (tg + 1u) * nx) xb_add(&bar[XB_TOPGEN], 1u);
            else XB_SPIN(xb_ld(&bar[XB_TOPGEN]) == tg, bar);
            __builtin_amdgcn_fence(__ATOMIC_ACQUIRE, "agent");
            xb_add(&bar[XB_XGEN(b.x)], 1u);
            asm volatile("s_waitcnt vmcnt(0)" ::: "memory");
        } else {
            XB_SPIN(xb_ld(&bar[XB_XGEN(b.x)]) == gen, bar);
            __builtin_amdgcn_fence(__ATOMIC_ACQUIRE, "agent");
            asm volatile("s_waitcnt vmcnt(0)" ::: "memory");
        }
    }
    __syncthreads();
}

constexpr int LDS_MISC = LDS_BYTES - 64;
__global__ void __launch_bounds__(NTHREADS, 2) mk_fwd(Args args) {
    extern __shared__ __attribute__((aligned(16))) unsigned char lds[];
    Ctx c; c.a = &args; c.ws = args.ws; c.lds = lds;
    c.tid = threadIdx.x; c.lane = c.tid & 63; c.wave = __builtin_amdgcn_readfirstlane(c.tid >> 6); c.bid = blockIdx.x; c.G = gridDim.x;
    c.gw = c.bid * NWAVES + c.wave; c.NGW = c.G * NWAVES; c.gwv = c.wave * c.G + c.bid;
    const int lo = args.ph_lo, hi = args.ph_hi;
    PG8_LAS unsigned char* ring = (PG8_LAS unsigned char*)lds;
#ifndef MK_PH_MASK
#define MK_PH_MASK 0xffff
#endif
#define IN(k) (((MK_PH_MASK >> (k)) & 1) && lo <= (k) && (k) < hi)
#if MK_ONE_LAUNCH
    cg::grid_group grid = cg::this_grid();
    if (lo < 0) grid.sync();
    volatile LAS unsigned* st = (volatile LAS unsigned*)((LAS unsigned char*)lds + LDS_MISC);
    if (c.tid < 2) st[c.tid] = 0u;
    __syncthreads();
    const XcdBarrier bar = xcd_barrier_post((unsigned*)(c.ws + WS_CTL) + CW_BAR, st);
#define SEAM(k) do { if (IN(k) && IN((k) + 1)) xcd_barrier(bar); } while (0)
#else
#define SEAM(k) do { } while (0)
#endif
    if (IN(0)) { phase_prep(c); phase_s5_build(c); } SEAM(0);
    if (IN(1)) { phase_norm1(c); } SEAM(1);
    if (IN(2)) { pg8::Gemm g{(const pg8::bf16_t*)(c.ws + WS_HX), (const pg8::bf16_t*)(c.ws + WS_WIN), 1024, 1024, 1024}; pg8::StaticOrder S; S.init(MT, NPROJ, c.G, c.bid);
        pg8::EpiInProj E{(pg8::bf16_t*)(c.ws + WS_U5), (pg8::bf16_t*)(c.ws + WS_QKVPRE), (pg8::bf16_t*)(c.ws + WS_Z)};
        pg8::gemm_phase<pg8::EpiInProj, pg8::StaticOrder, true, true>(ring, g, S, E); } SEAM(2);
    if (IN(3)) { { pg8::Gemm g{(const pg8::bf16_t*)(c.ws + WS_U5), (const pg8::bf16_t*)(c.ws + WS_PM), 768, 512, 512}; pg8::SchedSS S{c.G, c.bid}; pg8::EpiSS E{(float*)(c.ws + WS_SS)};
          pg8::gemm_phase<pg8::EpiSS, pg8::SchedSS, true, true>(ring, g, S, E); }
        __syncthreads(); phase_conv(c); } SEAM(3);
    if (IN(4)) { if (c.wave < 2) s5_state_scan(c, c.bid + c.G * c.wave < 512 ? c.bid + c.G * c.wave : 0); __syncthreads(); phase_gdn_prep(c); } SEAM(4);
    if (IN(5)) { pg8::Gemm g{(const pg8::bf16_t*)(c.ws + WS_U5), (const pg8::bf16_t*)(c.ws + WS_BB), 768, 768, 768}; pg8::SchedS5Y S{c.G, c.bid}; pg8::EpiS5Y E{(pg8::bf16_t*)(c.ws + WS_YG)};
        pg8::gemm_phase<pg8::EpiS5Y, pg8::SchedS5Y, true, true>(ring, g, S, E); } SEAM(5);
    if (IN(6)) { if (c.bid < 64) phase_gdn_rec(c);
        else { pg8::Gemm g{(const pg8::bf16_t*)(c.ws + WS_YG), (const pg8::bf16_t*)(c.ws + WS_WGLU), 512, 512, 512}; pg8::StaticOrder S; S.init(ML, 512, c.G - 64, c.bid - 64);
            pg8::EpiGlu E{(const pg8::bf16_t*)(c.ws + WS_YG), (pg8::bf16_t*)(c.ws + WS_CAT)};
            pg8::gemm_phase<pg8::EpiGlu, pg8::StaticOrder, true, true>(ring, g, S, E); } } SEAM(6);
    if (IN(7)) { phase_combine(c); } SEAM(7);
    if (IN(8)) { pg8::Gemm g{(const pg8::bf16_t*)(c.ws + WS_CAT), (const pg8::bf16_t*)(c.ws + WS_WOUT), 1024, 1024, 1024}; pg8::StaticOrder S; S.init(ML, 1024, c.G, c.bid);
        pg8::EpiF32 E{(float*)(c.ws + WS_YRAW), 1024};
        pg8::gemm_phase<pg8::EpiF32, pg8::StaticOrder, true, true>(ring, g, S, E); } SEAM(8);
    if (IN(9)) { phase_rows2(c); phase_fp8_tables(c); } SEAM(9);
    if (IN(10)) { pg8::Gemm g{(const pg8::bf16_t*)(c.ws + WS_HX2), (const pg8::bf16_t*)(c.ws + WS_WQ), 1024, 1024, 1024}; pg8::StaticOrder S; S.init(ML, 2048, c.G, c.bid);
        pg8::EpiBf16<0> E{(pg8::bf16_t*)(c.ws + WS_QP), 2048, nullptr, 0, 0, 1.f};
        pg8::gemm_phase<pg8::EpiBf16<0>, pg8::StaticOrder, true, true>(ring, g, S, E); } SEAM(10);
    if (IN(11)) { phase_topk(c); } SEAM(11);
    if (IN(12)) { phase_exp1(c); } SEAM(12);
    if (IN(13)) { phase_exp2(c); } SEAM(13);
    if (IN(14)) { phase_exp3(c); }
#undef IN
#undef SEAM
}

extern "C" void kernel_launch(void* const* d_in, const int* in_sizes, int n_in, void* d_out, int out_size, void* d_ws, size_t ws_size, hipStream_t stream) {
    static int grid = 0;
    if (grid == 0) {
        if (n_in != 29 || out_size != ML * D || ws_size < WS_END) { fprintf(stderr, "kernel_launch: unexpected shapes (n_in %d out %d ws %zu)\n", n_in, out_size, ws_size); grid = -1; return; }
        int dev = 0, cus = 0, per_cu = 0;
        (void)hipGetDevice(&dev); (void)hipDeviceGetAttribute(&cus, hipDeviceAttributeMultiprocessorCount, dev);
        if (hipFuncSetAttribute((const void*)mk_fwd, hipFuncAttributeMaxDynamicSharedMemorySize, LDS_BYTES) != hipSuccess) { fprintf(stderr, "kernel_launch: hipFuncSetAttribute failed\n"); grid = -1; return; }
        (void)hipOccupancyMaxActiveBlocksPerMultiprocessor(&per_cu, (const void*)mk_fwd, NTHREADS, LDS_BYTES);
        (void)hipGetLastError();
        grid = cus;
        fprintf(stderr, "kernel_launch: cus %d per_cu %d grid %d\n", cus, per_cu, grid);
    }
    if (grid < 0) return;
    Args a{};
    for (int i = 0; i < 29; ++i) a.in[i] = (const float*)d_in[i];
    a.out = (float*)d_out; a.ws = (unsigned char*)d_ws;
    (void)hipMemsetAsync((char*)d_ws + WS_CTL, 0, CTL_ZERO_BYTES, stream);
#if MK_ONE_LAUNCH
    a.ph_lo = 0; a.ph_hi = NPHASES;
    void* kargs[] = {&a};
    hipError_t e = hipLaunchCooperativeKernel((const void*)mk_fwd, dim3(grid), dim3(NTHREADS), kargs, LDS_BYTES, stream);
    if (e != hipSuccess) fprintf(stderr, "kernel_launch: cooperative launch failed: %s\n", hipGetErrorString(e));
#else
    for (int ph = 0; ph < NPHASES; ++ph) { a.ph_lo = ph; a.ph_hi = ph + 1; hipLaunchKernelGGL(mk_fwd, dim3(grid), dim3(NTHREADS), LDS_BYTES, stream, a); }
#endif
}
```

```cpp
#include <hip/hip_runtime.h>
#include <hip/hip_cooperative_groups.h>
#include <cstdio>
#include <cstdint>
namespace cg = cooperative_groups;
namespace pg8 {
#define PG8_LAS __attribute__((address_space(3)))
typedef unsigned short bf16_t;
typedef short bf16x8 __attribute__((ext_vector_type(8)));
typedef float f32x4 __attribute__((ext_vector_type(4)));
typedef unsigned u32x4 __attribute__((ext_vector_type(4)));
constexpr int BM = 256, BK = 64, HALF = 128, HTB = HALF * BK * 2  , STAGE_BYTES = 8 * HTB, NXCD = 8, WGM = 8;

__host__ __device__ __forceinline__ int lds_byte(int r, int c) { const int st = (r >> 4) * 2 + (c >> 5), rr = r & 15, cc = c & 31, ob = rr * 64 + cc * 2; return st * 1024 + (ob ^ (((ob >> 9) & 1) << 5)); }
__host__ __device__ __forceinline__ void stage_rc(int b, int& R, int& C) { const int st = b / 1024, sb = b % 1024, swz = sb ^ (((sb >> 9) & 1) << 5); R = (st >> 1) * 16 + swz / 64; C = (st & 1) * 32 + (swz % 64) / 2; }
__host__ __device__ __forceinline__ int perm32(int rho) { const int n = rho >> 4, i = rho & 15; return 8 * (i >> 2) + 4 * n + (i & 3); }

struct Unit { int pm, pn; };
struct Gemm { const bf16_t* A; const bf16_t* Bt; int lda, ldb, K; };

struct StaticOrder {
    int nM, nN, nwg, G, c;
    __host__ __device__ void init(int M, int N, int G_, int c_) { nM = M / BM; nN = N / BM; nwg = nM * nN; G = G_; c = c_; }
    __host__ __device__ bool next(int i, Unit& u) const {
        const long L = (long)i * G + c; if (L >= nwg) return false;
        int wgid = (int)L; { const int q = nwg / NXCD, r = nwg % NXCD, xcd = wgid % NXCD, off = wgid / NXCD; wgid = (xcd < r ? xcd * (q + 1) : r * (q + 1) + (xcd - r) * q) + off; }
        const int nig = WGM * nN, gid = wgid / nig, fm = gid * WGM, gsz = (nM - fm) < WGM ? (nM - fm) : WGM;
        u.pm = fm + ((wgid % nig) % gsz); u.pn = (wgid % nig) / gsz; return true;
    }
    __device__ __forceinline__ void a_ready(const Unit&) const {}
    __device__ __forceinline__ void done(const Unit&) const {}
};

__device__ __forceinline__ unsigned cvt_pk_bf16(float lo, float hi) { unsigned r; asm volatile("v_cvt_pk_bf16_f32 %0, %1, %2" : "=v"(r) : "v"(lo), "v"(hi)); return r; }
typedef float f32x2 __attribute__((ext_vector_type(2)));
__device__ __forceinline__ f32x2 gelu_pk(f32x2 v) {
    const f32x2 av = __builtin_elementwise_abs(v), d = av * 0.2316418882f + 1.0f;
    f32x2 t; t.x = __builtin_amdgcn_rcpf(d.x); t.y = __builtin_amdgcn_rcpf(d.y);
    f32x2 q = t * 0.5307027145f + (-0.7265760135f); q = q * t + 0.7107068705f; q = q * t + (-0.142248368f); q = q * t + 0.127414796f; q = q * t;
    const f32x2 s = (v * v) * (-0.72134752044f);
    f32x2 e; e.x = __builtin_amdgcn_exp2f(s.x); e.y = __builtin_amdgcn_exp2f(s.y);
    const f32x2 m = v * (q * e), r = v - m;
    f32x2 o; o.x = v.x < 0.f ? m.x : r.x; o.y = v.y < 0.f ? m.y : r.y; return o;
}

template <int ACT  > struct EpiBf16 {
    static constexpr bool PERM = true, AFTER_DRAIN = false; static_assert(ACT == 0 || ACT == 1, "EpiBf16: ACT is 0 (none) or 1 (gelu_pk)");
    bf16_t* O; int ldc; const float* bias; int split_cols; size_t split_stride; float scale0;
    __device__ __forceinline__ void operator()(const f32x4 (&acc)[2][2][4][2], const Unit& u, int wr, int wc, int fr, int fq) const {
        const int row0 = u.pm * BM + wr * 64 + fr; int colt = u.pn * BM; bf16_t* base = O;
        float sc = 1.f; if (split_cols) { const int t = colt / split_cols; base += (size_t)t * split_stride; colt -= t * split_cols; if (t == 0) sc = scale0; }
        const int col0 = colt + wc * 32 + 8 * fq, bcol0 = u.pn * BM + wc * 32 + 8 * fq;
        f32x4 bv[2][2];
#pragma unroll
        for (int bj = 0; bj < 2; ++bj)
#pragma unroll
            for (int n = 0; n < 2; ++n) bv[bj][n] = bias ? *(const f32x4*)(bias + bcol0 + bj * HALF + 4 * n) : (f32x4){0.f, 0.f, 0.f, 0.f};
#pragma unroll
        for (int ai = 0; ai < 2; ++ai)
#pragma unroll
            for (int m = 0; m < 4; ++m) { bf16_t* rowp = base + (size_t)(row0 + ai * HALF + m * 16) * ldc + col0;
#pragma unroll
                for (int bj = 0; bj < 2; ++bj) { f32x4 v0 = acc[ai][bj][m][0] + bv[bj][0], v1 = acc[ai][bj][m][1] + bv[bj][1];
                    if (ACT == 1) { f32x2 a = gelu_pk((f32x2){v0[0], v0[1]}), b = gelu_pk((f32x2){v0[2], v0[3]}), c = gelu_pk((f32x2){v1[0], v1[1]}), d = gelu_pk((f32x2){v1[2], v1[3]});
                        v0 = (f32x4){a.x, a.y, b.x, b.y}; v1 = (f32x4){c.x, c.y, d.x, d.y}; }
                    v0 = v0 * sc; v1 = v1 * sc; u32x4 w; w.x = cvt_pk_bf16(v0[0], v0[1]); w.y = cvt_pk_bf16(v0[2], v0[3]); w.z = cvt_pk_bf16(v1[0], v1[1]); w.w = cvt_pk_bf16(v1[2], v1[3]);
                    *(u32x4*)(rowp + bj * HALF) = w; } }
    }
};

template <class Epi, class Sched, bool ALIGN_EPI = false, bool SP2 = false>
__device__ __forceinline__ void gemm_phase(PG8_LAS unsigned char* lds, const Gemm g, const Sched& S, const Epi& E) {
    const int tid = threadIdx.x, wid = __builtin_amdgcn_readfirstlane(tid >> 6), lane = tid & 63, wr = wid >> 2, wc = wid & 3, fr = lane & 15, fq = lane >> 4;
    const int K = g.K, nt = K / BK;
    unsigned voffA[2], voffB[2];
#pragma unroll
    for (int i = 0; i < 2; ++i) { int R, C; stage_rc(tid * 16 + i * 8192, R, C); const int Rb = Epi::PERM ? ((R & ~31) + perm32(R & 31)) : R;
        voffA[i] = (unsigned)(R * g.lda + C) * 2u; voffB[i] = (unsigned)(Rb * g.ldb + C) * 2u; }
    const size_t kstep = (size_t)(BK * 2);
    const size_t hstepA = (size_t)HALF * g.lda * 2, hstepB = (size_t)HALF * g.ldb * 2;
    const size_t tstepA = 2 * hstepA, tstepB = 2 * hstepB;
    const unsigned ldsw = (unsigned)wid * 1024u;
    const int aoff = lds_byte(wr * 64 + fr, fq * 8), boff = lds_byte(wc * 32 + fr, fq * 8);
#define PG8_SA(b, h) (((b) * 2 + (h)) * HTB)
#define PG8_SB(b, h) ((4 + (b) * 2 + (h)) * HTB)
#define PG8_STAGE(bufoff, gbase, voff) do { _Pragma("unroll") for (int _i = 0; _i < 2; ++_i) \
        __builtin_amdgcn_global_load_lds((const unsigned*)((const char*)(gbase) + (voff)[_i]), (PG8_LAS unsigned*)(lds + (bufoff) + ldsw + _i * 8192), 16, 0, 0); } while (0)
#define PG8_LDA(dst, b, h) do { _Pragma("unroll") for (int m = 0; m < 4; ++m) _Pragma("unroll") for (int k = 0; k < 2; ++k) dst[m][k] = *(const PG8_LAS bf16x8*)(lds + PG8_SA(b, h) + aoff + m * 2048 + k * 1024); } while (0)
#define PG8_LDB(dst, b, h) do { _Pragma("unroll") for (int n = 0; n < 2; ++n) _Pragma("unroll") for (int k = 0; k < 2; ++k) dst[n][k] = *(const PG8_LAS bf16x8*)(lds + PG8_SB(b, h) + boff + n * 2048 + k * 1024); } while (0)
#define PG8_MMA(ai, bj, At, Bt) do { __builtin_amdgcn_s_setprio(1); _Pragma("unroll") for (int m = 0; m < 4; ++m) _Pragma("unroll") for (int n = 0; n < 2; ++n) _Pragma("unroll") for (int k = 0; k < 2; ++k) \
        acc[ai][bj][m][n] = __builtin_amdgcn_mfma_f32_16x16x32_bf16(Bt[n][k], At[m][k], acc[ai][bj][m][n], 0, 0, 0); __builtin_amdgcn_s_setprio(0); } while (0)
#define PG8_WAIT_V(n) asm volatile("s_waitcnt vmcnt(" #n ")" ::: "memory")
#define PG8_WAIT_L(n) asm volatile("s_waitcnt lgkmcnt(" #n ")" ::: "memory")
#define PG8_BAR __builtin_amdgcn_s_barrier()
#define PG8_SCHED __builtin_amdgcn_sched_barrier(0)
    Unit cur, nxt; int ui = 0;
    if (!S.next(0, cur)) return;
    f32x4 acc[2][2][4][2];
#pragma unroll
    for (int a = 0; a < 2; ++a)
#pragma unroll
        for (int b = 0; b < 2; ++b)
#pragma unroll
            for (int m = 0; m < 4; ++m)
#pragma unroll
                for (int n = 0; n < 2; ++n) acc[a][b][m][n] = (f32x4){0.f, 0.f, 0.f, 0.f};
    bf16x8 At[4][2], B0[2][2], B1[2][2];
    const char* cA = (const char*)g.A + (size_t)cur.pm * tstepA; const char* cB = (const char*)g.Bt + (size_t)cur.pn * tstepB;
    S.a_ready(cur);
    if constexpr (SP2) {
        PG8_STAGE(PG8_SB(0, 0), cB, voffB); PG8_STAGE(PG8_SB(0, 1), cB + hstepB, voffB); PG8_STAGE(PG8_SA(0, 0), cA, voffA); PG8_STAGE(PG8_SA(0, 1), cA + hstepA, voffA);
        if (wr == 1) PG8_BAR;
        PG8_WAIT_V(2); PG8_BAR;
        PG8_STAGE(PG8_SB(1, 0), cB + kstep, voffB); PG8_STAGE(PG8_SA(1, 0), cA + kstep, voffA); PG8_STAGE(PG8_SB(1, 1), cB + hstepB + kstep, voffB);
        PG8_WAIT_V(6); PG8_BAR;
    } else {
        PG8_STAGE(PG8_SB(0, 0), cB, voffB); PG8_STAGE(PG8_SA(0, 0), cA, voffA); PG8_STAGE(PG8_SB(0, 1), cB + hstepB, voffB); PG8_STAGE(PG8_SA(0, 1), cA + hstepA, voffA);
        if (wr == 1) PG8_BAR;
        PG8_WAIT_V(4); PG8_BAR;
        PG8_STAGE(PG8_SB(1, 0), cB + kstep, voffB); PG8_STAGE(PG8_SA(1, 0), cA + kstep, voffA); PG8_STAGE(PG8_SB(1, 1), cB + hstepB + kstep, voffB);
        PG8_WAIT_V(6); PG8_BAR;
    }
    for (;;) {
        const bool has_next = S.next(ui + 1, nxt);
        const char* nA = has_next ? (const char*)g.A + (size_t)nxt.pm * tstepA : cA; const char* nB = has_next ? (const char*)g.Bt + (size_t)nxt.pn * tstepB : cB;
        for (int t = 0; t < nt; t += 2) {
            const bool last = (t == nt - 2);
            const char* a1 = cA + (size_t)(t + 1) * kstep;
            const char* a2 = last ? nA : cA + (size_t)(t + 2) * kstep; const char* b2 = last ? nB : cB + (size_t)(t + 2) * kstep;
            const char* a3 = a2 + kstep; const char* b3 = b2 + kstep;
            if (last && has_next) S.a_ready(nxt);
            if constexpr (SP2) {
            PG8_LDB(B0, 0, 0); PG8_LDB(B1, 0, 1); PG8_SCHED; PG8_LDA(At, 0, 0); PG8_STAGE(PG8_SA(1, 1), a1 + hstepA, voffA);
            PG8_WAIT_V(8); PG8_WAIT_L(0); PG8_BAR; PG8_MMA(0, 0, At, B0); PG8_MMA(0, 1, At, B1); PG8_BAR; PG8_SCHED;
            PG8_LDA(At, 0, 1); PG8_STAGE(PG8_SB(0, 0), b2, voffB); PG8_STAGE(PG8_SB(0, 1), b2 + hstepB, voffB); PG8_STAGE(PG8_SA(0, 0), a2, voffA);
            PG8_WAIT_V(8); PG8_WAIT_L(0); PG8_BAR; PG8_MMA(1, 0, At, B0); PG8_MMA(1, 1, At, B1); PG8_BAR; PG8_SCHED;
            PG8_LDB(B0, 1, 0); PG8_LDB(B1, 1, 1); PG8_SCHED; PG8_LDA(At, 1, 0); PG8_STAGE(PG8_SA(0, 1), a2 + hstepA, voffA);
            PG8_WAIT_V(8); PG8_WAIT_L(0); PG8_BAR; PG8_MMA(0, 0, At, B0); PG8_MMA(0, 1, At, B1); PG8_BAR; PG8_SCHED;
            PG8_LDA(At, 1, 1); PG8_STAGE(PG8_SB(1, 0), b3, voffB); PG8_STAGE(PG8_SB(1, 1), b3 + hstepB, voffB); PG8_STAGE(PG8_SA(1, 0), a3, voffA);
            PG8_WAIT_V(8); PG8_WAIT_L(0); PG8_BAR; PG8_MMA(1, 0, At, B0); PG8_MMA(1, 1, At, B1); PG8_BAR; PG8_SCHED;
            } else {
            PG8_LDB(B0, 0, 0); PG8_SCHED; PG8_LDA(At, 0, 0); PG8_STAGE(PG8_SA(1, 1), a1 + hstepA, voffA);
            PG8_WAIT_L(8); PG8_BAR; PG8_WAIT_L(0); PG8_MMA(0, 0, At, B0); PG8_BAR; PG8_SCHED;
            PG8_LDB(B1, 0, 1); PG8_STAGE(PG8_SB(0, 0), b2, voffB);
            PG8_BAR; PG8_WAIT_L(0); PG8_MMA(0, 1, At, B1); PG8_BAR;
            PG8_LDA(At, 0, 1); PG8_STAGE(PG8_SA(0, 0), a2, voffA);
            PG8_BAR; PG8_WAIT_L(0); PG8_MMA(1, 0, At, B0); PG8_BAR; PG8_SCHED;
            PG8_STAGE(PG8_SB(0, 1), b2 + hstepB, voffB);
            PG8_WAIT_V(6); PG8_BAR; PG8_MMA(1, 1, At, B1); PG8_BAR;
            PG8_LDB(B0, 1, 0); PG8_SCHED; PG8_LDA(At, 1, 0); PG8_STAGE(PG8_SA(0, 1), a2 + hstepA, voffA);
            PG8_WAIT_L(8); PG8_BAR; PG8_WAIT_L(0); PG8_MMA(0, 0, At, B0); PG8_BAR; PG8_SCHED;
            PG8_LDB(B1, 1, 1); PG8_STAGE(PG8_SB(1, 0), b3, voffB);
            PG8_BAR; PG8_WAIT_L(0); PG8_MMA(0, 1, At, B1); PG8_BAR;
            PG8_LDA(At, 1, 1); PG8_STAGE(PG8_SA(1, 0), a3, voffA);
            PG8_BAR; PG8_WAIT_L(0); PG8_MMA(1, 0, At, B0); PG8_BAR; PG8_SCHED;
            PG8_STAGE(PG8_SB(1, 1), b3 + hstepB, voffB);
            PG8_WAIT_V(6); PG8_BAR; PG8_MMA(1, 1, At, B1); PG8_BAR;
            }
        }
        if constexpr (ALIGN_EPI) { if (wr == 0) PG8_BAR; }
        if constexpr (!Epi::AFTER_DRAIN) { E(acc, cur, wr, wc, fr, fq); S.done(cur); }
        if (!has_next) break;
#pragma unroll
        for (int a = 0; a < 2; ++a)
#pragma unroll
            for (int b = 0; b < 2; ++b)
#pragma unroll
                for (int m = 0; m < 4; ++m)
#pragma unroll
                    for (int n = 0; n < 2; ++n) acc[a][b][m][n] = (f32x4){0.f, 0.f, 0.f, 0.f};
        cur = nxt; cA = nA; cB = nB; ++ui;
        if constexpr (ALIGN_EPI) { if (wr == 1) PG8_BAR; }
    }
    PG8_WAIT_V(0);
    if constexpr (!ALIGN_EPI) { if (wr == 0) PG8_BAR; }
    PG8_BAR;
    if constexpr (Epi::AFTER_DRAIN) { E.fused(acc, cur, wr, wc, fr, fq, lds, wid, lane); S.done(cur); }
#undef PG8_SA
#undef PG8_SB
#undef PG8_STAGE
#undef PG8_LDA
#undef PG8_LDB
#undef PG8_MMA
#undef PG8_WAIT_V
#undef PG8_WAIT_L
#undef PG8_BAR
#undef PG8_SCHED
}
}

#ifndef MK_EXP_OLD
#define MK_EXP_OLD 0
#endif
#ifndef MK_ONE_LAUNCH
#define MK_ONE_LAUNCH 1
#endif
#define LAS __attribute__((address_space(3)))
typedef unsigned short bf16;
typedef unsigned v4u __attribute__((ext_vector_type(4)));
typedef unsigned v2u __attribute__((ext_vector_type(2)));
typedef float f32x4 __attribute__((ext_vector_type(4)));
typedef float f32x2 __attribute__((ext_vector_type(2)));
typedef short bf16x8 __attribute__((ext_vector_type(8)));
typedef float f32x16 __attribute__((ext_vector_type(16)));
#define MFMA32(a, b, c) __builtin_amdgcn_mfma_f32_32x32x16_bf16((a), (b), (c), 0, 0, 0)

constexpr int D = 1024, NB = 8, SEQ = 2048, LC = 256, ML = NB * SEQ  , MC = NB * LC  , MT = ML + MC  ;
constexpr int PROJ = 2576, NPROJ = 2560;
constexpr int NEXP = 16384, TOPK = 16, KK = 128;
constexpr float EPS = 1e-6f;
constexpr int NTHREADS = 512, NWAVES = 8;
constexpr int LDS_BYTES = 147456;
constexpr int NPHASES = 15;

constexpr size_t MiB = 1u << 20;
constexpr size_t WS_CTL = 0;
constexpr size_t CTL_ZERO_BYTES = 65536;
constexpr int CW_BAR = 0;
constexpr int CW_E1 = 4096, CW_E2 = 4096 + 8 * 64;
constexpr size_t WS_MOD = 1 * MiB;
constexpr size_t WS_LP = 1 * MiB + 512 * 1024;
constexpr size_t WS_WIN = 2 * MiB;
constexpr size_t WS_WOUT = 8 * MiB;
constexpr size_t WS_WGLU = 10 * MiB;
constexpr size_t WS_WQ = 11 * MiB;
constexpr size_t WS_GB = 15 * MiB;
constexpr size_t WS_BB = 17 * MiB;
constexpr size_t WS_PM = 41 * MiB;
constexpr size_t WS_OG = 17 * MiB;
constexpr size_t WS_HX2 = 17 * MiB;
constexpr size_t WS_U5 = 49 * MiB;
constexpr size_t WS_CAT = 49 * MiB;
constexpr size_t WS_IDX = 49 * MiB;
constexpr size_t WS_GATE = 57 * MiB;
constexpr size_t WS_ACT = 65 * MiB;
constexpr size_t WS_SSQP = 73 * MiB;
constexpr size_t WS_Z = 85 * MiB;
constexpr size_t WS_YRAW = 85 * MiB;
constexpr size_t WS_QP = 85 * MiB;
constexpr size_t WS_Y = 85 * MiB;
constexpr size_t WS_HX = 101 * MiB;
constexpr size_t WS_SS = 101 * MiB;
constexpr size_t WS_YG = 101 * MiB;
constexpr size_t WS_FRT = 125 * MiB;
constexpr size_t WS_QKVPRE = 137 * MiB;
constexpr size_t WS_FRA = 143 * MiB;
constexpr size_t WS_FRK = 161 * MiB;
constexpr size_t WS_FRTAB = 197 * MiB;
constexpr size_t WS_QKV = 202 * MiB;
constexpr size_t WS_U8 = 202 * MiB;
constexpr size_t WS_V8 = 218 * MiB;
constexpr size_t WS_USC = 234 * MiB;
constexpr size_t WS_VSC = 234 * MiB + 512 * 1024;
constexpr size_t WS_HQ8 = 150 * MiB;
constexpr size_t WS_HS = 183 * MiB;
constexpr size_t WS_END = 256 * MiB;
static_assert(WS_BB + (size_t)32 * 512 * 768 * 2 <= WS_PM && WS_PM + (size_t)32 * 256 * 512 * 2 <= WS_U5 && WS_U5 + (size_t)32 * 768 * 768 * 2 <= WS_Z && WS_Z + (size_t)ML * 512 * 2 <= WS_HX, "ws map a");
static_assert(WS_HX + (size_t)MT * D * 2 <= WS_QKVPRE && WS_SS + (size_t)32 * 768 * 256 * 4 <= WS_FRT && WS_QKVPRE + (size_t)MT * 1536 * 2 <= WS_QKV && WS_QKV + (size_t)MT * 1536 * 2 <= WS_END, "ws map b");
static_assert(WS_FRT + (size_t)2304 * 8192 <= WS_FRA && WS_FRA + (size_t)2304 * 8192 <= WS_FRK && WS_FRK + (size_t)2304 * 16384 <= WS_FRTAB && WS_FRTAB + (size_t)2304 * 1024 <= WS_QKV, "ws map c");
static_assert(WS_OG + (size_t)2 * ML * 512 * 2 <= WS_CAT && WS_CAT + (size_t)ML * D * 2 <= WS_Z && WS_YRAW + (size_t)ML * D * 4 <= WS_U8 && WS_SSQP + (size_t)8 * ML * 4 <= WS_Z && WS_YG + (size_t)ML * 512 * 2 <= WS_FRT, "ws map d");

__device__ __forceinline__ unsigned f2bf(float f) { unsigned u = __builtin_bit_cast(unsigned, f); return (u + 0x7fffu + ((u >> 16) & 1u)) >> 16; }
typedef __bf16 bf16x2_t __attribute__((ext_vector_type(2)));
__device__ __forceinline__ unsigned pk2(float lo, float hi) { const f32x2 v = {lo, hi}; return __builtin_bit_cast(unsigned, __builtin_convertvector(v, bf16x2_t)); }
__device__ __forceinline__ float bflo(unsigned w) { return __builtin_bit_cast(float, w << 16); }
__device__ __forceinline__ float bfhi(unsigned w) { return __builtin_bit_cast(float, w & 0xffff0000u); }
__device__ __forceinline__ float bf1(bf16 h) { return __builtin_bit_cast(float, (unsigned)h << 16); }
__device__ __forceinline__ float wave_sum(float v) {
#pragma unroll
    for (int o = 1; o < 64; o <<= 1) v += __shfl_xor(v, o);
    return v;
}
__device__ __forceinline__ float wave_max(float v) {
#pragma unroll
    for (int o = 1; o < 64; o <<= 1) v = fmaxf(v, __shfl_xor(v, o));
    return v;
}
__device__ __forceinline__ float sigmoidf_(float x) { return 1.f / (1.f + __expf(-x)); }
__device__ __forceinline__ float siluf_(float x) { return x / (1.f + __expf(-x)); }
__device__ __forceinline__ float gelu_erf(float x) { return 0.5f * x * (1.f + erff(x * 0.70710678118654752f)); }
__device__ __forceinline__ void sincos_d(double a, float& s, float& c) {
    const double k = rint(a * 0.63661977236758134308);
    const double r = fma(-k, 1.57079632679489661923, a) - k * 6.123233995736766e-17;
    const double r2 = r * r;
    double sp = -2.5052108385441720e-08; sp = sp * r2 + 2.7557319223985893e-06; sp = sp * r2 - 1.9841269841269841e-04; sp = sp * r2 + 8.3333333333333332e-03; sp = sp * r2 - 1.6666666666666666e-01;
    const double sn = r + r * r2 * sp;
    double cp = 2.0876756987868099e-09; cp = cp * r2 - 2.7557319223985888e-07; cp = cp * r2 + 2.4801587301587302e-05; cp = cp * r2 - 1.3888888888888889e-03; cp = cp * r2 + 4.1666666666666664e-02; cp = cp * r2 - 0.5;
    const double cs = 1.0 + r2 * cp;
    const int q = ((int)k) & 3;
    const double ss = (q == 0) ? sn : (q == 1) ? cs : (q == 2) ? -sn : -cs;
    const double cc = (q == 0) ? cs : (q == 1) ? -sn : (q == 2) ? -cs : sn;
    s = (float)ss; c = (float)cc;
}

struct Args { const float* in[29]; float* out; unsigned char* ws; int ph_lo, ph_hi; };
static_assert(sizeof(Args) == 29 * 8 + 8 + 8 + 8, "Args has no padding");
enum { I_X = 0, I_C, I_CTX, I_CCTX, I_WMOD, I_BMOD, I_GPREMIX, I_GPOSTMIX, I_GPREFFN, I_GPOSTFFN, I_WIN, I_WOUT, I_LAMRE, I_LAMIM, I_LOGDT, I_BRE, I_BIM, I_CRE, I_CIM, I_S5D, I_WGLU,
       I_CONV, I_ALOG, I_DTBIAS, I_GDNNORM, I_WQ, I_KEYS, I_PU, I_PV };

__device__ __forceinline__ const float* in_row(const Args& a, int row) { return row < ML ? a.in[I_X] + (size_t)row * D : a.in[I_CTX] + (size_t)(row - ML) * D; }
__device__ __forceinline__ int mod_row(int row) { return row < ML ? (row >> 11) : 8; }

template <int CTRL> __device__ __forceinline__ float dppf(float v) { return __builtin_bit_cast(float, __builtin_amdgcn_update_dpp(0, __builtin_bit_cast(int, v), CTRL, 0xf, 0xf, true)); }
__device__ __forceinline__ float row_sum16(float v) { v += dppf<0xB1>(v); v += dppf<0x4E>(v); v += dppf<0x141>(v); v += dppf<0x140>(v); return v; }
__device__ __forceinline__ float row_max16(float v) { v = fmaxf(v, dppf<0xB1>(v)); v = fmaxf(v, dppf<0x4E>(v)); v = fmaxf(v, dppf<0x141>(v)); v = fmaxf(v, dppf<0x140>(v)); return v; }
__device__ __forceinline__ float wsum(float v) { v = row_sum16(v); return
    __builtin_bit_cast(float, __builtin_amdgcn_readlane(__builtin_bit_cast(int, v), 0)) + __builtin_bit_cast(float, __builtin_amdgcn_readlane(__builtin_bit_cast(int, v), 16)) +
    __builtin_bit_cast(float, __builtin_amdgcn_readlane(__builtin_bit_cast(int, v), 32)) + __builtin_bit_cast(float, __builtin_amdgcn_readlane(__builtin_bit_cast(int, v), 48)); }
__device__ __forceinline__ float wmax(float v) { v = row_max16(v); return fmaxf(fmaxf(__builtin_bit_cast(float, __builtin_amdgcn_readlane(__builtin_bit_cast(int, v), 0)), __builtin_bit_cast(float, __builtin_amdgcn_readlane(__builtin_bit_cast(int, v), 16))),
    fmaxf(__builtin_bit_cast(float, __builtin_amdgcn_readlane(__builtin_bit_cast(int, v), 32)), __builtin_bit_cast(float, __builtin_amdgcn_readlane(__builtin_bit_cast(int, v), 48)))); }
__device__ __forceinline__ int lane_rank(unsigned long long m) { return __builtin_amdgcn_mbcnt_hi((unsigned)(m >> 32), __builtin_amdgcn_mbcnt_lo((unsigned)m, 0)); }
__device__ __forceinline__ unsigned fkey(float f) { const unsigned u = __builtin_bit_cast(unsigned, f); return u ^ ((unsigned)((int)u >> 31) | 0x80000000u); }
#define WAVE_LDS_SYNC() do { __builtin_amdgcn_fence(__ATOMIC_RELEASE, "wavefront"); __builtin_amdgcn_wave_barrier(); __builtin_amdgcn_fence(__ATOMIC_ACQUIRE, "wavefront"); } while (0)
template <int N> __device__ __forceinline__ unsigned kth_key(const unsigned (&k)[N], int K) {
    unsigned T = 0;
    for (int bit = 31; bit >= 0; --bit) { const unsigned cand = T | (1u << bit); int cnt = 0;
#pragma unroll
        for (int n = 0; n < N; ++n) cnt += __popcll(__ballot(k[n] >= cand));
        if (cnt >= K) T = cand;
        if (cnt == K) break; }
    return T;
}

namespace pg8 {
struct EpiInProj {
    static constexpr bool PERM = true, AFTER_DRAIN = false;
    bf16_t* U; bf16_t* QKV; bf16_t* Z;
    __device__ __forceinline__ void operator()(const f32x4 (&acc)[2][2][4][2], const Unit& u, int wr, int wc, int fr, int fq) const {
        bf16_t* base; int ld, colt; bool lat_only = false;
        const bool s5 = u.pn < 2;
        if (s5) { base = U; ld = 0; colt = u.pn * BM; }
        else if (u.pn < 8) { base = QKV; ld = 1536; colt = (u.pn - 2) * BM; }
        else { base = Z; ld = 512; colt = (u.pn - 8) * BM; lat_only = true; }
        const int row0 = u.pm * BM + wr * 64 + fr, col0 = colt + wc * 32 + 8 * fq;
#pragma unroll
        for (int ai = 0; ai < 2; ++ai)
#pragma unroll
            for (int m = 0; m < 4; ++m) { const int row = row0 + ai * HALF + m * 16; bf16_t* rowp = base + (size_t)row * ld + col0;
                if (lat_only && row >= 16384) continue;
                if (s5) { const int R = row < 16384 ? (row >> 5) : 512 + ((row - 16384) >> 5), ii = row & 31; rowp = base + (size_t)R * 768 + ii * 16 + (col0 & 15); }
#pragma unroll
                for (int bj = 0; bj < 2; ++bj) { const f32x4 v0 = acc[ai][bj][m][0], v1 = acc[ai][bj][m][1];
                    u32x4 w; w.x = cvt_pk_bf16(v0[0], v0[1]); w.y = cvt_pk_bf16(v0[2], v0[3]); w.z = cvt_pk_bf16(v1[0], v1[1]); w.w = cvt_pk_bf16(v1[2], v1[3]);
                    if (s5) *(u32x4*)(rowp + (size_t)((col0 + bj * HALF) >> 4) * (768 * 768)) = w; else *(u32x4*)(rowp + bj * HALF) = w; } }
    }
};
struct EpiGlu {
    static constexpr bool PERM = true, AFTER_DRAIN = false;
    const bf16_t* YG; bf16_t* CAT;
    __device__ __forceinline__ void operator()(const f32x4 (&acc)[2][2][4][2], const Unit& u, int wr, int wc, int fr, int fq) const {
        const int row0 = u.pm * BM + wr * 64 + fr, col0 = u.pn * BM + wc * 32 + 8 * fq;
#pragma unroll
        for (int ai = 0; ai < 2; ++ai)
#pragma unroll
            for (int m = 0; m < 4; ++m) { const int row = row0 + ai * HALF + m * 16;
#pragma unroll
                for (int bj = 0; bj < 2; ++bj) { const f32x4 v0 = acc[ai][bj][m][0], v1 = acc[ai][bj][m][1];
                    const u32x4 y = *(const u32x4*)(YG + (size_t)row * 512 + col0 + bj * HALF);
                    float o[8]; const float a[8] = {v0[0], v0[1], v0[2], v0[3], v1[0], v1[1], v1[2], v1[3]};
                    const unsigned yw[4] = {y.x, y.y, y.z, y.w};
#pragma unroll
                    for (int e = 0; e < 8; ++e) { const float yv = __builtin_bit_cast(float, (e & 1) ? (yw[e >> 1] & 0xffff0000u) : (yw[e >> 1] << 16)); o[e] = yv / (1.f + __expf(-a[e])); }
                    u32x4 w; w.x = cvt_pk_bf16(o[0], o[1]); w.y = cvt_pk_bf16(o[2], o[3]); w.z = cvt_pk_bf16(o[4], o[5]); w.w = cvt_pk_bf16(o[6], o[7]);
                    *(u32x4*)(CAT + (size_t)row * 1024 + col0 + bj * HALF) = w; } }
    }
};
struct EpiF32 {
    static constexpr bool PERM = false, AFTER_DRAIN = false;
    float* C; int ldc;
    __device__ __forceinline__ void operator()(const f32x4 (&acc)[2][2][4][2], const Unit& u, int wr, int wc, int fr, int fq) const {
        const int row0 = u.pm * BM + wr * 64 + fr, col0 = u.pn * BM + wc * 32 + 4 * fq;
#pragma unroll
        for (int ai = 0; ai < 2; ++ai)
#pragma unroll
            for (int m = 0; m < 4; ++m) { float* rowp = C + (size_t)(row0 + ai * HALF + m * 16) * ldc + col0;
#pragma unroll
                for (int bj = 0; bj < 2; ++bj)
#pragma unroll
                    for (int n = 0; n < 2; ++n) *(f32x4*)(rowp + bj * HALF + n * 16) = acc[ai][bj][m][n]; }
    }
};
struct EpiSS {
    static constexpr bool PERM = false, AFTER_DRAIN = false;
    float* C;
    __device__ __forceinline__ void operator()(const f32x4 (&acc)[2][2][4][2], const Unit& u, int wr, int wc, int fr, int fq) const {
        const int row0 = u.pm * BM + wr * 64 + fr, col0 = wc * 32 + 4 * fq;
#pragma unroll
        for (int ai = 0; ai < 2; ++ai)
#pragma unroll
            for (int m = 0; m < 4; ++m) { float* rowp = C + (size_t)(row0 + ai * HALF + m * 16) * 256 + col0;
#pragma unroll
                for (int bj = 0; bj < 2; ++bj)
#pragma unroll
                    for (int n = 0; n < 2; ++n) *(f32x4*)(rowp + bj * HALF + n * 16) = acc[ai][bj][m][n]; }
    }
};
struct SchedSS { int G, c; __device__ bool next(int i, Unit& u) const { const int L = i * G + c; if (L >= 96) return false; u.pm = L; u.pn = L / 3; return true; }
    __device__ __forceinline__ void a_ready(const Unit&) const {} __device__ __forceinline__ void done(const Unit&) const {} };
struct EpiS5Y {
    static constexpr bool PERM = true, AFTER_DRAIN = false;
    bf16_t* YG;
    __device__ __forceinline__ void operator()(const f32x4 (&acc)[2][2][4][2], const Unit& u, int wr, int wc, int fr, int fq) const {
        const int g = u.pn >> 1, R0 = (u.pm - 3 * g) * BM + wr * 64 + fr, n0 = (u.pn & 1) * BM + wc * 32 + 8 * fq;
#pragma unroll
        for (int ai = 0; ai < 2; ++ai)
#pragma unroll
            for (int m = 0; m < 4; ++m) { const int R = R0 + ai * HALF + m * 16;
#pragma unroll
                for (int bj = 0; bj < 2; ++bj) { const int n = n0 + bj * HALF; const f32x4 v0 = acc[ai][bj][m][0], v1 = acc[ai][bj][m][1];
                    const f32x2 a = gelu_pk((f32x2){v0[0], v0[1]}), b = gelu_pk((f32x2){v0[2], v0[3]}), c2 = gelu_pk((f32x2){v1[0], v1[1]}), d = gelu_pk((f32x2){v1[2], v1[3]});
                    u32x4 w; w.x = cvt_pk_bf16(a.x, a.y); w.y = cvt_pk_bf16(b.x, b.y); w.z = cvt_pk_bf16(c2.x, c2.y); w.w = cvt_pk_bf16(d.x, d.y);
                    *(u32x4*)(YG + (size_t)(R * 32 + (n >> 4)) * 512 + g * 16 + (n & 15)) = w; } }
    }
};
struct SchedS5Y { int G, c; __device__ bool next(int i, Unit& u) const { const int L = i * G + c; if (L >= 128) return false; const int g = L >> 2; u.pm = 3 * g + ((L >> 1) & 1); u.pn = 2 * g + (L & 1); return true; }
    __device__ __forceinline__ void a_ready(const Unit&) const {} __device__ __forceinline__ void done(const Unit&) const {} };
}

struct Ctx { const Args* a; unsigned char* ws; unsigned char* lds; int tid, lane, wave, bid, G, gw, NGW, gwv; };

__device__ __forceinline__ void p0_transpose_item(const float* W, int ldw, int nblk, int K, bf16* WT, float* scr, int item, int lane) {
    const int kb = item / nblk, nb = item % nblk, k0 = 64 * kb, n0 = 32 * nb;
#pragma unroll 8
    for (int i = 0; i < 32; ++i) { const int kk = 2 * i + (lane >> 5); scr[kk * 33 + (lane & 31)] = W[(size_t)(k0 + kk) * ldw + n0 + (lane & 31)]; }
    __builtin_amdgcn_fence(__ATOMIC_RELEASE, "wavefront"); __builtin_amdgcn_wave_barrier(); __builtin_amdgcn_fence(__ATOMIC_ACQUIRE, "wavefront");
    const int c = lane & 7;
#pragma unroll
    for (int j = 0; j < 4; ++j) { const int n = (lane >> 3) + 8 * j; const float* s = scr + (8 * c) * 33 + n;
        v4u o; o.x = pk2(s[0 * 33], s[1 * 33]); o.y = pk2(s[2 * 33], s[3 * 33]); o.z = pk2(s[4 * 33], s[5 * 33]); o.w = pk2(s[6 * 33], s[7 * 33]);
        *(v4u*)(WT + (size_t)(n0 + n) * K + k0 + 8 * c) = o; }
    __builtin_amdgcn_fence(__ATOMIC_RELEASE, "wavefront"); __builtin_amdgcn_wave_barrier(); __builtin_amdgcn_fence(__ATOMIC_ACQUIRE, "wavefront");
}
__device__ __forceinline__ void phase_prep(const Ctx& c) {
    const Args& a = *c.a;
    float* scr = (float*)(c.lds + c.wave * 16384);
    constexpr int I_IN = 16 * 80, I_OUT = 16 * 32, I_GLU = 8 * 16, I_Q = 16 * 64;
    for (int it = c.gw; it < I_IN + I_OUT + I_GLU + I_Q; it += c.NGW) {
        int r = it;
        if (r < I_IN) { p0_transpose_item(a.in[I_WIN], PROJ, 80, 1024, (bf16*)(c.ws + WS_WIN), scr, r, c.lane); continue; } r -= I_IN;
        if (r < I_OUT) { p0_transpose_item(a.in[I_WOUT], 1024, 32, 1024, (bf16*)(c.ws + WS_WOUT), scr, r, c.lane); continue; } r -= I_OUT;
        if (r < I_GLU) { p0_transpose_item(a.in[I_WGLU], 512, 16, 512, (bf16*)(c.ws + WS_WGLU), scr, r, c.lane); continue; } r -= I_GLU;
        p0_transpose_item(a.in[I_WQ], 2048, 64, 1024, (bf16*)(c.ws + WS_WQ), scr, r, c.lane);
    }
    __syncthreads();
    float* sc = (float*)c.lds;
    float* red = (float*)(c.lds + 9 * 1024 * 4);
    float* MOD = (float*)(c.ws + WS_MOD);
    bool have = false;
    for (int item = c.bid; item < 96; item += c.G) {
        if (!have) { for (int i = c.tid; i < 9 * 1024; i += NTHREADS) { const int r = i >> 10, k = i & 1023; const float v = r < 8 ? a.in[I_C][r * 1024 + k] : a.in[I_CCTX][k]; sc[i] = siluf_(v); } have = true; __syncthreads(); }
        const int n0 = item * 64;
        float acc[9];
#pragma unroll
        for (int r = 0; r < 9; ++r) acc[r] = 0.f;
        const float* wp = a.in[I_WMOD] + (size_t)(c.wave * 128) * 6144 + n0 + c.lane;
#pragma unroll 4
        for (int k = 0; k < 128; ++k) { const float w = wp[(size_t)k * 6144];
#pragma unroll
            for (int r = 0; r < 9; ++r) acc[r] = fmaf(sc[r * 1024 + c.wave * 128 + k], w, acc[r]); }
#pragma unroll
        for (int r = 0; r < 9; ++r) red[(c.wave * 9 + r) * 64 + c.lane] = acc[r];
        __syncthreads();
        for (int i = c.tid; i < 576; i += NTHREADS) { const int r = i >> 6, l = i & 63; float s = a.in[I_BMOD][n0 + l];
#pragma unroll
            for (int w = 0; w < 8; ++w) s += red[(w * 9 + r) * 64 + l];
            MOD[r * 6144 + n0 + l] = s; }
        __syncthreads();
    }
}
__device__ __forceinline__ void s5_build_group(const Ctx& c, int g, int part);
__device__ __forceinline__ void phase_s5_build(const Ctx& c) { for (int it = c.bid; it < 256; it += c.G) s5_build_group(c, it >> 3, it & 7); }

__device__ __forceinline__ void phase_norm1(const Ctx& c) {
    const Args& a = *c.a;
    float* wabT = (float*)c.lds;
    for (int i = c.tid; i < 1024 * 16; i += NTHREADS) { const int k = i >> 4, j = i & 15; wabT[j * 1028 + k] = a.in[I_WIN][(size_t)k * PROJ + NPROJ + j]; }
    __syncthreads();
    const float* MOD = (const float*)(c.ws + WS_MOD);
    bf16* HX = (bf16*)(c.ws + WS_HX); float* GB = (float*)(c.ws + WS_GB);
    const float* gpre = a.in[I_GPREMIX];
    for (int row = c.gw; row < MT; row += c.NGW) {
        const f32x4* xr = (const f32x4*)in_row(a, row) + c.lane;
        const float* mr = MOD + mod_row(row) * 6144;
        f32x4 v[4]; float ss = 0.f;
#pragma unroll
        for (int j = 0; j < 4; ++j) { v[j] = xr[64 * j]; ss += (v[j].x * v[j].x + v[j].y * v[j].y) + (v[j].z * v[j].z + v[j].w * v[j].w); }
        const float r = rsqrtf(wsum(ss) * (1.f / D) + EPS);
#pragma unroll
        for (int j = 0; j < 4; ++j) { const int col = 4 * c.lane + 256 * j;
            const f32x4 g4 = *(const f32x4*)(gpre + col), sh = *(const f32x4*)(mr + col), scl = *(const f32x4*)(mr + 1024 + col);
            v[j] = (v[j] * r) * g4 * (scl + 1.f) + sh;
            v2u o; o.x = pk2(v[j].x, v[j].y); o.y = pk2(v[j].z, v[j].w);
            *(v2u*)(HX + (size_t)row * D + col) = o; }
        float pj[16];
#pragma unroll
        for (int j = 0; j < 16; ++j) { float s = 0.f;
#pragma unroll
            for (int jj = 0; jj < 4; ++jj) { const f32x4 w = *(const f32x4*)(wabT + j * 1028 + 4 * c.lane + 256 * jj); s += (v[jj].x * w.x + v[jj].y * w.y) + (v[jj].z * w.z + v[jj].w * w.w); }
            pj[j] = s; if ((j & 1) == 1) asm volatile("" ::: "memory"); }
        const bool b5 = c.lane & 32, b4 = c.lane & 16, b3 = c.lane & 8, b2 = c.lane & 4;
        float q8[8], q4[4], q2[2];
#pragma unroll
        for (int i = 0; i < 8; ++i) { const float keep = b5 ? pj[i + 8] : pj[i], send = b5 ? pj[i] : pj[i + 8]; q8[i] = keep + __shfl_xor(send, 32); }
#pragma unroll
        for (int i = 0; i < 4; ++i) { const float keep = b4 ? q8[i + 4] : q8[i], send = b4 ? q8[i] : q8[i + 4]; q4[i] = keep + __shfl_xor(send, 16); }
#pragma unroll
        for (int i = 0; i < 2; ++i) { const float keep = b3 ? q4[i + 2] : q4[i], send = b3 ? q4[i] : q4[i + 2]; q2[i] = keep + dppf<0x140>(send); }
        float mine; { const float keep = b2 ? q2[1] : q2[0], send = b2 ? q2[0] : q2[1]; mine = keep + dppf<0x141>(send); }
        mine += dppf<0xB1>(mine); mine += dppf<0x4E>(mine);
        const int jl = (b5 ? 8 : 0) + (b4 ? 4 : 0) + (b3 ? 2 : 0) + (b2 ? 1 : 0);
        if ((c.lane & 3) == 0) {
            if (jl < 8) { const float t = mine + a.in[I_DTBIAS][jl]; const float sp = t > 20.f ? t : log1pf(expf(t)); GB[(size_t)row * 16 + jl] = -expf(a.in[I_ALOG][jl]) * sp; }
            else GB[(size_t)row * 16 + jl] = 1.f / (1.f + expf(-mine)); }
    }
}

__device__ __forceinline__ void phase_conv(const Ctx& c) {
    const Args& a = *c.a;
    const bf16* PRE = (const bf16*)(c.ws + WS_QKVPRE); bf16* OUT = (bf16*)(c.ws + WS_QKV);
    const float* cw = a.in[I_CONV];
#pragma unroll 1
    for (int pass = 0; pass < 3; ++pass) { const int ch0 = pass * 512 + 8 * c.lane;
        f32x4 wt[9][2];
#pragma unroll
        for (int i = 0; i < 9; ++i) { wt[i][0] = *(const f32x4*)(cw + i * 1536 + ch0); wt[i][1] = *(const f32x4*)(cw + i * 1536 + ch0 + 4); }
#pragma unroll 1
        for (int row = c.gw; row < MT; row += c.NGW) {
            int nb_row[9]; bool ok[9];
            if (row < ML) { const int t = row & 2047, gr = t >> 6, gc = t & 63;
#pragma unroll
                for (int dy = -1; dy <= 1; ++dy)
#pragma unroll
                    for (int dx = -1; dx <= 1; ++dx) { const int i = (dy + 1) * 3 + dx + 1; ok[i] = (gr + dy >= 0) && (gr + dy < 32) && (gc + dx >= 0) && (gc + dx < 64); nb_row[i] = row + dy * 64 + dx; } }
            else { const int t = (row - ML) & 255;
#pragma unroll
                for (int i = 0; i < 9; ++i) { ok[i] = false; nb_row[i] = row; }
#pragma unroll
                for (int dx = -1; dx <= 1; ++dx) { ok[4 + dx] = (t + dx >= 0) && (t + dx < 256); nb_row[4 + dx] = row + dx; } }
            v4u in[9];
#pragma unroll
            for (int i = 0; i < 9; ++i) in[i] = ok[i] ? *(const v4u*)(PRE + (size_t)nb_row[i] * 1536 + ch0) : (v4u){0u, 0u, 0u, 0u};
            float o[8];
#pragma unroll
            for (int q = 0; q < 8; ++q) o[q] = 0.f;
#pragma unroll
            for (int i = 0; i < 9; ++i) { const unsigned w[4] = {in[i].x, in[i].y, in[i].z, in[i].w}; const float kk[8] = {wt[i][0].x, wt[i][0].y, wt[i][0].z, wt[i][0].w, wt[i][1].x, wt[i][1].y, wt[i][1].z, wt[i][1].w};
#pragma unroll
                for (int q = 0; q < 4; ++q) { o[2 * q] = fmaf(bflo(w[q]), kk[2 * q], o[2 * q]); o[2 * q + 1] = fmaf(bfhi(w[q]), kk[2 * q + 1], o[2 * q + 1]); } }
            float ssq = 0.f;
#pragma unroll
            for (int q = 0; q < 8; ++q) { o[q] = siluf_(o[q]); ssq = fmaf(o[q], o[q], ssq); }
            if (pass < 2) { const float sc = rsqrtf(row_sum16(ssq) + EPS) * (pass == 0 ? 0.08838834764831845f : 1.f);
#pragma unroll
                for (int q = 0; q < 8; ++q) o[q] *= sc; }
            v4u ov; ov.x = pk2(o[0], o[1]); ov.y = pk2(o[2], o[3]); ov.z = pk2(o[4], o[5]); ov.w = pk2(o[6], o[7]);
            *(v4u*)(OUT + (size_t)row * 1536 + ch0) = ov;
        }
    }
}

__device__ __forceinline__ int scan_row(int b, int dir, int step) {
    if (step < LC) { const int t = dir ? LC - 1 - step : step; return ML + b * LC + t; }
    const int t = step - LC; return b * SEQ + (dir ? SEQ - 1 - t : t);
}
__device__ __forceinline__ void phase_combine(const Ctx& c) {
    const Args& a = *c.a;
    const bf16* OG0 = (const bf16*)(c.ws + WS_OG); const bf16* OG1 = OG0 + (size_t)ML * 512; const bf16* Z = (const bf16*)(c.ws + WS_Z);
    bf16* CAT = (bf16*)(c.ws + WS_CAT);
    for (int row = c.gw; row < ML; row += c.NGW) {
#pragma unroll
        for (int h = 0; h < 4; ++h) { const int ch = h * 128 + 2 * c.lane;
            const unsigned w0 = *(const unsigned*)(OG0 + (size_t)row * 512 + ch), w1 = *(const unsigned*)(OG1 + (size_t)row * 512 + ch), zw = *(const unsigned*)(Z + (size_t)row * 512 + ch);
            const float o0 = bflo(w0) + bflo(w1), o1 = bfhi(w0) + bfhi(w1);
            const float r = rsqrtf(wave_sum(o0 * o0 + o1 * o1) * (1.f / 128.f) + EPS);
            const f32x2 ng = *(const f32x2*)(a.in[I_GDNNORM] + 2 * c.lane);
            *(unsigned*)(CAT + (size_t)row * 1024 + 512 + ch) = pk2(o0 * r * ng.x * siluf_(bflo(zw)), o1 * r * ng.y * siluf_(bfhi(zw))); }
    }
}

__device__ __forceinline__ void phase_rows2(const Ctx& c) {
    const Args& a = *c.a;
    const float* MOD = (const float*)(c.ws + WS_MOD); const float* YRAW = (const float*)(c.ws + WS_YRAW); bf16* HX2 = (bf16*)(c.ws + WS_HX2);
    for (int row = c.gw; row < ML; row += c.NGW) {
        const float* mr = MOD + (row >> 11) * 6144;
        f32x4 y[4], x[4]; float ss = 0.f;
#pragma unroll
        for (int j = 0; j < 4; ++j) { y[j] = *((const f32x4*)(YRAW + (size_t)row * D) + c.lane + 64 * j); x[j] = *((const f32x4*)(a.in[I_X] + (size_t)row * D) + c.lane + 64 * j);
            ss += (y[j].x * y[j].x + y[j].y * y[j].y) + (y[j].z * y[j].z + y[j].w * y[j].w); }
        const float r = rsqrtf(wave_sum(ss) * (1.f / D) + EPS); float s2 = 0.f;
#pragma unroll
        for (int j = 0; j < 4; ++j) { const int col = 4 * c.lane + 256 * j;
            const f32x4 g4 = *(const f32x4*)(a.in[I_GPOSTMIX] + col), gt = *(const f32x4*)(mr + 2048 + col);
            x[j] = x[j] + gt * ((y[j] * r) * g4);
            *(f32x4*)(a.out + (size_t)row * D + col) = x[j];
            s2 += (x[j].x * x[j].x + x[j].y * x[j].y) + (x[j].z * x[j].z + x[j].w * x[j].w); }
        const float r2 = rsqrtf(wave_sum(s2) * (1.f / D) + EPS);
#pragma unroll
        for (int j = 0; j < 4; ++j) { const int col = 4 * c.lane + 256 * j;
            const f32x4 g4 = *(const f32x4*)(a.in[I_GPREFFN] + col), sh = *(const f32x4*)(mr + 3072 + col), scl = *(const f32x4*)(mr + 4096 + col);
            const f32x4 hv = (x[j] * r2) * g4 * (scl + 1.f) + sh;
            v2u o; o.x = pk2(hv.x, hv.y); o.y = pk2(hv.z, hv.w);
            *(v2u*)(HX2 + (size_t)row * D + col) = o;
            x[j] = (f32x4){bflo(o.x), bfhi(o.x), bflo(o.y), bfhi(o.y)}; }
        { float mx = 0.f;
#pragma unroll
          for (int j = 0; j < 4; ++j) mx = fmaxf(mx, fmaxf(fmaxf(fabsf(x[j].x), fabsf(x[j].y)), fmaxf(fabsf(x[j].z), fabsf(x[j].w))));
          mx = wmax(mx); const float hs = mx > 0.f ? 256.f / mx : 1.f;
          unsigned char* hq = c.ws + WS_HQ8 + (size_t)row * 2048;
#pragma unroll
          for (int j = 0; j < 4; ++j) { const float a0 = x[j].x * hs, a1 = x[j].y * hs, a2 = x[j].z * hs, a3 = x[j].w * hs;
              int w = __builtin_amdgcn_cvt_pk_fp8_f32(a0, a1, 0, false); w = __builtin_amdgcn_cvt_pk_fp8_f32(a2, a3, w, true);
              const f32x2 b01 = __builtin_amdgcn_cvt_pk_f32_fp8(w, false), b23 = __builtin_amdgcn_cvt_pk_f32_fp8(w, true);
              int w2 = __builtin_amdgcn_cvt_pk_fp8_f32((a0 - b01.x) * 16.f, (a1 - b01.y) * 16.f, 0, false); w2 = __builtin_amdgcn_cvt_pk_fp8_f32((a2 - b23.x) * 16.f, (a3 - b23.y) * 16.f, w2, true);
              *(unsigned*)(hq + 4 * c.lane + 256 * j) = (unsigned)w; *(unsigned*)(hq + 1024 + 4 * c.lane + 256 * j) = (unsigned)w2; }
          if (c.lane == 0) ((float*)(c.ws + WS_HS))[row] = 1.f / hs; }
    }
}


constexpr int KROW = 136;
__device__ __forceinline__ float unfkey(unsigned k) { const unsigned u = (k & 0x80000000u) ? (k ^ 0x80000000u) : ~k; return __builtin_bit_cast(float, u); }
__device__ __forceinline__ void ins16(unsigned (&L)[16], unsigned key) {
#pragma unroll
    for (int q = 0; q < 16; ++q) { const unsigned hi = L[q] > key ? L[q] : key, lo = L[q] > key ? key : L[q]; L[q] = hi; key = lo; }
}
__device__ __forceinline__ void merge16(unsigned (&L)[16]) {
    unsigned R[16];
#pragma unroll
    for (int q = 0; q < 16; ++q) R[q] = (unsigned)__shfl_xor((int)L[15 - q], 32);
#pragma unroll
    for (int q = 0; q < 16; ++q) L[q] = L[q] > R[q] ? L[q] : R[q];
#pragma unroll
    for (int j = 8; j >= 1; j >>= 1)
#pragma unroll
        for (int q = 0; q < 16; ++q) if ((q & j) == 0) { const unsigned hi = L[q] > L[q + j] ? L[q] : L[q + j], lo = L[q] > L[q + j] ? L[q + j] : L[q]; L[q] = hi; L[q + j] = lo; }
}
__device__ __forceinline__ void phase_topk(const Ctx& c) {
    const Args& a = *c.a;
    bf16* kl = (bf16*)c.lds;
    unsigned char* wtab = c.lds + 2 * 128 * KROW * 2 + c.wave * 1088;
    const bf16* QP = (const bf16*)(c.ws + WS_QP); int* IDX = (int*)(c.ws + WS_IDX); float* GATE = (float*)(c.ws + WS_GATE);
    const int r = c.lane & 31, hh = c.lane >> 5;
    { const unsigned char ptab[50] = {0, 1, 2, 3, 4, 5, 6, 7, 8, 9, 10, 11, 12, 13, 14, 15, 16, 17, 18, 19, 20, 21, 22, 23, 32, 33, 34, 35, 36, 48, 49, 50, 51, 64, 65, 66, 80, 81, 96, 97, 112, 113, 128, 144, 160, 176, 192, 208, 224, 240};
      if (c.lane < 50) wtab[1024 + c.lane] = ptab[c.lane < 50 ? c.lane : 0]; }
    for (int item = c.bid; item < 8 * 32; item += c.G) {
        const int h = item & 7, tr = item >> 3;
        __syncthreads();
        for (int i = c.tid; i < 2 * 128 * 64; i += NTHREADS) { const int k2 = i & 63, n = (i >> 6) & 127, p = i >> 13; const f32x2 kv = *(const f32x2*)(a.in[I_KEYS] + ((size_t)((h * 2 + p) * 128 + n)) * 128 + 2 * k2);
            *(unsigned*)(kl + (p * 128 + n) * KROW + 2 * k2) = pk2(kv.x, kv.y); }
        __syncthreads();
        for (int tile = c.wave; tile < 16; tile += NWAVES) {
            const int tok = tr * 512 + tile * 32 + r;
            unsigned LA[16], LB[16];
#pragma unroll
            for (int p = 0; p < 2; ++p) {
                bf16x8 qf[8];
#pragma unroll
                for (int kk = 0; kk < 8; ++kk) qf[kk] = *(const bf16x8*)(QP + (size_t)tok * 2048 + h * 256 + p * 128 + kk * 16 + hh * 8);
                f32x16 acc[4];
#pragma unroll
                for (int nt = 0; nt < 4; ++nt)
#pragma unroll
                    for (int i = 0; i < 16; ++i) acc[nt][i] = 0.f;
#pragma unroll
                for (int kk = 0; kk < 8; ++kk)
#pragma unroll
                    for (int nt = 0; nt < 4; ++nt) acc[nt] = MFMA32(*(const bf16x8*)(kl + (p * 128 + nt * 32 + r) * KROW + kk * 16 + hh * 8), qf[kk], acc[nt]);
                unsigned (&L)[16] = p ? LB : LA;
#pragma unroll
                for (int q = 0; q < 16; ++q) L[q] = 0u;
#pragma unroll
                for (int nt = 0; nt < 4; ++nt)
#pragma unroll
                    for (int i = 0; i < 16; ++i) { const int n = nt * 32 + (i & 3) + 8 * (i >> 2) + 4 * hh; ins16(L, (fkey(acc[nt][i]) & ~127u) | (unsigned)(127 - n)); }
                merge16(L);
            }
            unsigned char* tt = wtab + r * 32;
            if (hh == 0) {
#pragma unroll
                for (int q = 0; q < 16; ++q) tt[q] = (unsigned char)(127u - (LA[q] & 127u)); }
            else {
#pragma unroll
                for (int q = 0; q < 16; ++q) tt[16 + q] = (unsigned char)(127u - (LB[q] & 127u)); }
            float va[16], vb[16];
#pragma unroll
            for (int q = 0; q < 16; ++q) { va[q] = unfkey(LA[q] & ~127u); vb[q] = unfkey(LB[q] & ~127u); }
            unsigned LC[16];
#pragma unroll
            for (int q = 0; q < 16; ++q) LC[q] = 0u;
            { const float s0 = va[0] + vb[0], s1 = va[0] + vb[1]; ins16(LC, (fkey(hh ? s1 : s0) & ~63u) | (unsigned)(63 - (0 + hh))); }
            { const float s0 = va[0] + vb[2], s1 = va[0] + vb[3]; ins16(LC, (fkey(hh ? s1 : s0) & ~63u) | (unsigned)(63 - (2 + hh))); }
            { const float s0 = va[0] + vb[4], s1 = va[0] + vb[5]; ins16(LC, (fkey(hh ? s1 : s0) & ~63u) | (unsigned)(63 - (4 + hh))); }
            { const float s0 = va[0] + vb[6], s1 = va[0] + vb[7]; ins16(LC, (fkey(hh ? s1 : s0) & ~63u) | (unsigned)(63 - (6 + hh))); }
            { const float s0 = va[0] + vb[8], s1 = va[0] + vb[9]; ins16(LC, (fkey(hh ? s1 : s0) & ~63u) | (unsigned)(63 - (8 + hh))); }
            { const float s0 = va[0] + vb[10], s1 = va[0] + vb[11]; ins16(LC, (fkey(hh ? s1 : s0) & ~63u) | (unsigned)(63 - (10 + hh))); }
            { const float s0 = va[0] + vb[12], s1 = va[0] + vb[13]; ins16(LC, (fkey(hh ? s1 : s0) & ~63u) | (unsigned)(63 - (12 + hh))); }
            { const float s0 = va[0] + vb[14], s1 = va[0] + vb[15]; ins16(LC, (fkey(hh ? s1 : s0) & ~63u) | (unsigned)(63 - (14 + hh))); }
            { const float s0 = va[1] + vb[0], s1 = va[1] + vb[1]; ins16(LC, (fkey(hh ? s1 : s0) & ~63u) | (unsigned)(63 - (16 + hh))); }
            { const float s0 = va[1] + vb[2], s1 = va[1] + vb[3]; ins16(LC, (fkey(hh ? s1 : s0) & ~63u) | (unsigned)(63 - (18 + hh))); }
            { const float s0 = va[1] + vb[4], s1 = va[1] + vb[5]; ins16(LC, (fkey(hh ? s1 : s0) & ~63u) | (unsigned)(63 - (20 + hh))); }
            { const float s0 = va[1] + vb[6], s1 = va[1] + vb[7]; ins16(LC, (fkey(hh ? s1 : s0) & ~63u) | (unsigned)(63 - (22 + hh))); }
            { const float s0 = va[2] + vb[0], s1 = va[2] + vb[1]; ins16(LC, (fkey(hh ? s1 : s0) & ~63u) | (unsigned)(63 - (24 + hh))); }
            { const float s0 = va[2] + vb[2], s1 = va[2] + vb[3]; ins16(LC, (fkey(hh ? s1 : s0) & ~63u) | (unsigned)(63 - (26 + hh))); }
            { const float s0 = va[2] + vb[4], s1 = va[3] + vb[0]; ins16(LC, (fkey(hh ? s1 : s0) & ~63u) | (unsigned)(63 - (28 + hh))); }
            { const float s0 = va[3] + vb[1], s1 = va[3] + vb[2]; ins16(LC, (fkey(hh ? s1 : s0) & ~63u) | (unsigned)(63 - (30 + hh))); }
            { const float s0 = va[3] + vb[3], s1 = va[4] + vb[0]; ins16(LC, (fkey(hh ? s1 : s0) & ~63u) | (unsigned)(63 - (32 + hh))); }
            { const float s0 = va[4] + vb[1], s1 = va[4] + vb[2]; ins16(LC, (fkey(hh ? s1 : s0) & ~63u) | (unsigned)(63 - (34 + hh))); }
            { const float s0 = va[5] + vb[0], s1 = va[5] + vb[1]; ins16(LC, (fkey(hh ? s1 : s0) & ~63u) | (unsigned)(63 - (36 + hh))); }
            { const float s0 = va[6] + vb[0], s1 = va[6] + vb[1]; ins16(LC, (fkey(hh ? s1 : s0) & ~63u) | (unsigned)(63 - (38 + hh))); }
            { const float s0 = va[7] + vb[0], s1 = va[7] + vb[1]; ins16(LC, (fkey(hh ? s1 : s0) & ~63u) | (unsigned)(63 - (40 + hh))); }
            { const float s0 = va[8] + vb[0], s1 = va[9] + vb[0]; ins16(LC, (fkey(hh ? s1 : s0) & ~63u) | (unsigned)(63 - (42 + hh))); }
            { const float s0 = va[10] + vb[0], s1 = va[11] + vb[0]; ins16(LC, (fkey(hh ? s1 : s0) & ~63u) | (unsigned)(63 - (44 + hh))); }
            { const float s0 = va[12] + vb[0], s1 = va[13] + vb[0]; ins16(LC, (fkey(hh ? s1 : s0) & ~63u) | (unsigned)(63 - (46 + hh))); }
            { const float s0 = va[14] + vb[0], s1 = va[15] + vb[0]; ins16(LC, (fkey(hh ? s1 : s0) & ~63u) | (unsigned)(63 - (48 + hh))); }
            merge16(LC);
            WAVE_LDS_SYNC();
            float ev[16]; float den = 0.f; const float mx = unfkey(LC[0] & ~63u);
#pragma unroll
            for (int q = 0; q < 16; ++q) { ev[q] = __expf(unfkey(LC[q] & ~63u) - mx); den += ev[q]; }
            const float inv = 1.f / den;
            if (hh == 0) { int ex[16];
#pragma unroll
                for (int q = 0; q < 16; ++q) { const unsigned pc = wtab[1024 + (63u - (LC[q] & 63u))]; ex[q] = (int)tt[pc >> 4] * 128 + (int)tt[16 + (pc & 15u)]; }
#pragma unroll
                for (int q = 0; q < 4; ++q) *(v4u*)(IDX + (size_t)tok * 128 + h * 16 + 4 * q) = (v4u){(unsigned)ex[4 * q], (unsigned)ex[4 * q + 1], (unsigned)ex[4 * q + 2], (unsigned)ex[4 * q + 3]}; }
            else {
#pragma unroll
                for (int q = 0; q < 4; ++q) *(f32x4*)(GATE + (size_t)tok * 128 + h * 16 + 4 * q) = (f32x4){ev[4 * q] * inv, ev[4 * q + 1] * inv, ev[4 * q + 2] * inv, ev[4 * q + 3] * inv}; }
            WAVE_LDS_SYNC();
        }
    }
}

__device__ __forceinline__ void phase_fp8_tables(const Ctx& c) {
    const Args& a = *c.a;
    for (int r = c.gw; r < 2 * NEXP; r += c.NGW) {
        const bool isv = r >= NEXP; const int e = isv ? r - NEXP : r;
        const f32x4* src = (const f32x4*)((isv ? a.in[I_PV] : a.in[I_PU]) + (size_t)e * D) + 4 * c.lane;
        f32x4 v[4]; float m = 0.f;
#pragma unroll
        for (int j = 0; j < 4; ++j) { v[j] = src[j]; m = fmaxf(m, fmaxf(fmaxf(fabsf(v[j].x), fabsf(v[j].y)), fmaxf(fabsf(v[j].z), fabsf(v[j].w)))); }
        m = wmax(m); const float inv = m > 0.f ? 256.f / m : 0.f;
        v4u o; unsigned ow[4];
#pragma unroll
        for (int j = 0; j < 4; ++j) { int w = __builtin_amdgcn_cvt_pk_fp8_f32(v[j].x * inv, v[j].y * inv, 0, false); w = __builtin_amdgcn_cvt_pk_fp8_f32(v[j].z * inv, v[j].w * inv, w, true); ow[j] = (unsigned)w; }
        o.x = ow[0]; o.y = ow[1]; o.z = ow[2]; o.w = ow[3];
        *(v4u*)(c.ws + (isv ? WS_V8 : WS_U8) + (size_t)e * D + 16 * c.lane) = o;
        if (c.lane == 0) ((float*)(c.ws + (isv ? WS_VSC : WS_USC)))[e] = m * (1.f / 256.f);
    }
}
__device__ __forceinline__ void fp8x16_to_f32(const v4u& r, float (&f)[16]) {
    const unsigned w[4] = {r.x, r.y, r.z, r.w};
#pragma unroll
    for (int j = 0; j < 4; ++j) { const f32x2 lo = __builtin_amdgcn_cvt_pk_f32_fp8((int)w[j], false), hi = __builtin_amdgcn_cvt_pk_f32_fp8((int)w[j], true); f[4 * j] = lo.x; f[4 * j + 1] = lo.y; f[4 * j + 2] = hi.x; f[4 * j + 3] = hi.y; }
}
__device__ __forceinline__ unsigned xcc_id() { return (unsigned)__builtin_amdgcn_s_getreg((3 << 11) | 20) & 7u; }

typedef long l64x2 __attribute__((ext_vector_type(2)));
struct E1Grp { l64x2 rw[16]; int e; float usc, vsc, gate; };
__device__ __forceinline__ void phase_exp1(const Ctx& c) {
    typedef float f32x4m __attribute__((ext_vector_type(4)));
    const int* IDX = (const int*)(c.ws + WS_IDX); const float* GATE = (const float*)(c.ws + WS_GATE); const float* HS = (const float*)(c.ws + WS_HS);
    const unsigned char* U8 = c.ws + WS_U8; const float* USC = (const float*)(c.ws + WS_USC); const float* VSC = (const float*)(c.ws + WS_VSC); float* ACT = (float*)(c.ws + WS_ACT);
    constexpr int CH = 4, TS = 2080, HLS = 1040;
    unsigned char* wl = c.lds + c.wave * 12800; int* le = (int*)wl; unsigned char* hq = wl + 4096; float* res = (float*)(wl + 4096 + CH * TS);
    const int r16 = c.lane & 15, g4 = c.lane >> 4; const bool bcol = r16 < 2;
    for (int item = c.gw; item < ML / CH; item += c.NGW) {
        const int t0 = item * CH;
        { v4u im[CH][2]; v4u ei[2];
#pragma unroll
          for (int tau = 0; tau < CH; ++tau) { const unsigned char* ip = c.ws + WS_HQ8 + ((size_t)t0 + tau) * 2048 + 16 * c.lane; im[tau][0] = *(const v4u*)ip; im[tau][1] = *(const v4u*)(ip + 1024); }
          ei[0] = *(const v4u*)(IDX + (size_t)t0 * 128 + 4 * c.lane); ei[1] = *(const v4u*)(IDX + (size_t)t0 * 128 + 256 + 4 * c.lane);
#pragma unroll
          for (int tau = 0; tau < CH; ++tau) { *(v4u*)(hq + tau * TS + 16 * c.lane) = im[tau][0]; *(v4u*)(hq + tau * TS + HLS + 16 * c.lane) = im[tau][1]; }
          *(v4u*)(le + 4 * c.lane) = ei[0]; *(v4u*)(le + 256 + 4 * c.lane) = ei[1];
          if (c.lane < CH) res[16 + c.lane] = HS[(size_t)t0 + c.lane]; }
        WAVE_LDS_SYNC();
#define E1_LOAD(G, J0) do { { const int j = ((J0) < CH * 128 ? (J0) : 0) + r16; G.e = le[j]; G.usc = USC[G.e]; G.vsc = VSC[G.e]; G.gate = GATE[(size_t)t0 * 128 + j]; \
              const unsigned char* rowp = U8 + (size_t)G.e * D + 16 * g4; _Pragma("unroll") for (int jj = 0; jj < 16; ++jj) G.rw[jj] = *(const l64x2*)(rowp + 64 * jj); } } while (0)
#define E1_COMP(G, J0) do { const unsigned char* hb = hq + ((J0) >> 7) * TS + (r16 & 1) * HLS + 16 * g4; const float hinv = res[16 + ((J0) >> 7)]; \
            f32x4m acc = {0.f, 0.f, 0.f, 0.f}; _Pragma("unroll") for (int jj = 0; jj < 16; ++jj) { \
                const long bq0 = *(const long*)(hb + 64 * jj), bq1 = *(const long*)(hb + 64 * jj + 8); \
                acc = __builtin_amdgcn_mfma_f32_16x16x32_fp8_fp8(G.rw[jj].x, bcol ? bq0 : 0l, acc, 0, 0, 0); acc = __builtin_amdgcn_mfma_f32_16x16x32_fp8_fp8(G.rw[jj].y, bcol ? bq1 : 0l, acc, 0, 0, 0); } \
            _Pragma("unroll") for (int q = 0; q < 4; ++q) { const float lo = dppf<0xB1>(acc[q]); if (r16 == 0) res[4 * g4 + q] = (acc[q] + lo * 0.0625f) * hinv; } \
            WAVE_LDS_SYNC(); \
            if (c.lane < 16) ACT[(size_t)t0 * 128 + (J0) + c.lane] = gelu_erf(res[c.lane] * G.usc) * G.gate * G.vsc; \
            WAVE_LDS_SYNC(); } while (0)
        E1Grp ga, gb;
        E1_LOAD(ga, 0);
#pragma unroll 1
        for (int j0 = 0; j0 < CH * 128; j0 += 32) {
            E1_LOAD(gb, j0 + 16);
            __builtin_amdgcn_sched_barrier(0);
            E1_COMP(ga, j0);
            __builtin_amdgcn_sched_barrier(0);
            E1_LOAD(ga, j0 + 32);
            __builtin_amdgcn_sched_barrier(0);
            E1_COMP(gb, j0 + 16);
            __builtin_amdgcn_sched_barrier(0);
        }
#undef E1_LOAD
#undef E1_COMP
        WAVE_LDS_SYNC();
    }
}
__device__ __forceinline__ void phase_exp2(const Ctx& c) {
    const int* IDX = (const int*)(c.ws + WS_IDX); const float* ACT = (const float*)(c.ws + WS_ACT); const unsigned char* V8 = c.ws + WS_V8;
    float* Y = (float*)(c.ws + WS_Y); float* SSQP = (float*)(c.ws + WS_SSQP);
    unsigned* cnt = (unsigned*)(c.ws + WS_CTL) + CW_E2;
    int* li = (int*)(c.lds + c.wave * 1024); float* la = (float*)(li + 128);
    const int xcc = (int)xcc_id(), sub = c.lane & 7, grp = c.lane >> 3;
    const bool b5 = c.lane & 32, b4 = c.lane & 16, b3 = c.lane & 8;
    constexpr int CH = 8;
    int bo = 0, t = 0, tend = 0;
    int iA = 0, iB = 0; float aA = 0.f, aB = 0.f;
    for (;;) {
        if (t >= tend) {
            unsigned t0 = 0; if (c.lane == 0) t0 = __hip_atomic_fetch_add(cnt + 64 * ((xcc + bo) & 7), (unsigned)CH, __ATOMIC_RELAXED, __HIP_MEMORY_SCOPE_AGENT);
            t0 = (unsigned)__builtin_amdgcn_readfirstlane((int)t0);
            if (t0 >= (unsigned)ML) { if (++bo >= 8) break; continue; }
            t = (int)t0; tend = t + CH;
            iA = IDX[(size_t)t * 128 + c.lane]; iB = IDX[(size_t)t * 128 + 64 + c.lane]; aA = ACT[(size_t)t * 128 + c.lane]; aB = ACT[(size_t)t * 128 + 64 + c.lane];
        }
        const int x = (xcc + bo) & 7;
        li[c.lane] = iA; li[64 + c.lane] = iB; la[c.lane] = aA; la[64 + c.lane] = aB;
        if (t + 1 < tend) { iA = IDX[(size_t)(t + 1) * 128 + c.lane]; iB = IDX[(size_t)(t + 1) * 128 + 64 + c.lane]; aA = ACT[(size_t)(t + 1) * 128 + c.lane]; aB = ACT[(size_t)(t + 1) * 128 + 64 + c.lane]; }
        WAVE_LDS_SYNC();
        float acc[16];
#pragma unroll
        for (int q = 0; q < 16; ++q) acc[q] = 0.f;
#pragma unroll
        for (int hf = 0; hf < 2; ++hf) { v4u rows[8]; float av[8];
#pragma unroll
            for (int i = 0; i < 8; ++i) { const int k = 8 * (8 * hf + i) + grp; rows[i] = *(const v4u*)(V8 + (size_t)li[k] * D + x * 128 + 16 * sub); av[i] = la[k]; }
#pragma unroll
            for (int i = 0; i < 8; ++i) { float f[16]; fp8x16_to_f32(rows[i], f);
#pragma unroll
                for (int q = 0; q < 16; ++q) acc[q] = fmaf(av[i], f[q], acc[q]); } }
        float q8[8], q4[4], q2[2];
#pragma unroll
        for (int i = 0; i < 8; ++i) { const float keep = b5 ? acc[i + 8] : acc[i], send = b5 ? acc[i] : acc[i + 8]; q8[i] = keep + __shfl_xor(send, 32); }
#pragma unroll
        for (int i = 0; i < 4; ++i) { const float keep = b4 ? q8[i + 4] : q8[i], send = b4 ? q8[i] : q8[i + 4]; q4[i] = keep + __shfl_xor(send, 16); }
#pragma unroll
        for (int i = 0; i < 2; ++i) { const float keep = b3 ? q4[i + 2] : q4[i], send = b3 ? q4[i] : q4[i + 2]; q2[i] = keep + __shfl_xor(send, 8); }
        const int col = x * 128 + 16 * sub + (b5 ? 8 : 0) + (b4 ? 4 : 0) + (b3 ? 2 : 0);
        *(f32x2*)(Y + (size_t)t * D + col) = (f32x2){q2[0], q2[1]};
        const float ss = wsum(q2[0] * q2[0] + q2[1] * q2[1]);
        SSQP[(size_t)x * ML + t] = ss;
        WAVE_LDS_SYNC();
        ++t;
    }
}
__device__ __forceinline__ void phase_exp3(const Ctx& c) {
    const Args& a = *c.a;
    const float* MOD = (const float*)(c.ws + WS_MOD); const float* Y = (const float*)(c.ws + WS_Y); const float* SSQP = (const float*)(c.ws + WS_SSQP);
    for (int row = c.gw; row < ML; row += c.NGW) {
        float ss = 0.f;
#pragma unroll
        for (int x = 0; x < 8; ++x) ss += SSQP[(size_t)x * ML + row];
        const float r = rsqrtf(ss * (1.f / D) + EPS); const float* mr = MOD + (row >> 11) * 6144 + 5120;
#pragma unroll
        for (int j = 0; j < 4; ++j) { const int col = 4 * c.lane + 256 * j;
            const f32x4 y = *(const f32x4*)(Y + (size_t)row * D + col), x1 = *(const f32x4*)(a.out + (size_t)row * D + col), g4 = *(const f32x4*)(a.in[I_GPOSTFFN] + col), gt = *(const f32x4*)(mr + col);
            *(f32x4*)(a.out + (size_t)row * D + col) = x1 + gt * ((y * r) * g4); }
    }
}

__device__ __forceinline__ void phase_experts(const Ctx& c) {
    const Args& a = *c.a;
    const float* MOD = (const float*)(c.ws + WS_MOD); const bf16* HX2 = (const bf16*)(c.ws + WS_HX2); const int* IDX = (const int*)(c.ws + WS_IDX); const float* GATE = (const float*)(c.ws + WS_GATE);
    float* acts = (float*)c.lds; int* eid = (int*)(c.lds + 512); float* red = (float*)(c.lds + 1024);
    for (int tok = c.bid; tok < ML; tok += c.G) {
        float hv[16];
#pragma unroll
        for (int j = 0; j < 4; ++j) { const v2u w = *(const v2u*)(HX2 + (size_t)tok * D + 4 * c.lane + 256 * j); hv[4 * j] = bflo(w.x); hv[4 * j + 1] = bfhi(w.x); hv[4 * j + 2] = bflo(w.y); hv[4 * j + 3] = bfhi(w.y); }
#pragma unroll 4
        for (int i = 0; i < 16; ++i) { const int k = c.wave * 16 + i; const int e = IDX[(size_t)tok * 128 + k];
            const f32x4* ur = (const f32x4*)(a.in[I_PU] + (size_t)e * D) + c.lane; float s = 0.f;
#pragma unroll
            for (int j = 0; j < 4; ++j) { const f32x4 u4 = ur[64 * j]; s += (u4.x * hv[4 * j] + u4.y * hv[4 * j + 1]) + (u4.z * hv[4 * j + 2] + u4.w * hv[4 * j + 3]); }
            s = wave_sum(s);
            if (c.lane == 0) { acts[k] = gelu_erf(s) * GATE[(size_t)tok * 128 + k]; eid[k] = e; } }
        __syncthreads();
        f32x2 acc = (f32x2){0.f, 0.f};
#pragma unroll 8
        for (int k = 0; k < 128; ++k) { const f32x2 v2 = *(const f32x2*)(a.in[I_PV] + (size_t)eid[k] * D + 2 * c.tid); const float ak = acts[k]; acc.x = fmaf(ak, v2.x, acc.x); acc.y = fmaf(ak, v2.y, acc.y); }
        const float ws = wave_sum(acc.x * acc.x + acc.y * acc.y);
        if (c.lane == 0) red[c.wave] = ws;
        __syncthreads();
        float tot = 0.f;
#pragma unroll
        for (int w = 0; w < 8; ++w) tot += red[w];
        const float r = rsqrtf(tot * (1.f / D) + EPS);
        const int col = 2 * c.tid; const float* mr = MOD + (tok >> 11) * 6144 + 5120;
        const f32x2 x1 = *(const f32x2*)(a.out + (size_t)tok * D + col), g2 = *(const f32x2*)(a.in[I_GPOSTFFN] + col), gt = *(const f32x2*)(mr + col);
        *(f32x2*)(a.out + (size_t)tok * D + col) = (f32x2){x1.x + gt.x * (acc.x * r * g2.x), x1.y + gt.y * (acc.y * r * g2.y)};
        __syncthreads();
    }
}


constexpr int S5_LPOW = 0, S5_BBAR = 33792, S5_CC = 50176, S5_MM = 66560;
__device__ __forceinline__ void s5_build_group(const Ctx& c, int g, int part) {
    const Args& a = *c.a;
    f32x2* LPOW = (f32x2*)(c.lds + S5_LPOW);
    f32x2* BBAR = (f32x2*)(c.lds + S5_BBAR);
    f32x2* CC = (f32x2*)(c.lds + S5_CC);
    float* MM = (float*)(c.lds + S5_MM);
    __syncthreads();
    if (c.tid < 128) { const int dir = c.tid >> 6, p = c.tid & 63, dg = dir * 32 + g;
        const float dt = expf(a.in[I_LOGDT][dg]), lr = a.in[I_LAMRE][dg * 64 + p], li = a.in[I_LAMIM][dg * 64 + p];
        const double ang = (double)li * (double)dt; const float lrdt = lr * dt;
        for (int e = 0; e <= 32; ++e) { float sn, cs; sincos_d(ang * (double)e, sn, cs); const float mg = expf(lrdt * (float)e); LPOW[(dir * 33 + e) * 64 + p] = (f32x2){mg * cs, mg * sn}; }
        float sn, cs; sincos_d(ang, sn, cs); const float mag = expf(lrdt), lbr = mag * cs, lbi = mag * sn, den = lr * lr + li * li, nr = lbr - 1.f;
        const float cr = (nr * lr + lbi * li) / den, ci = (lbi * lr - nr * li) / den;
        for (int ch = 0; ch < 16; ++ch) { const float br = a.in[I_BRE][(size_t)(dg * 64 + p) * 16 + ch], bi = a.in[I_BIM][(size_t)(dg * 64 + p) * 16 + ch]; BBAR[(dir * 64 + p) * 16 + ch] = (f32x2){cr * br - ci * bi, cr * bi + ci * br}; } }
    for (int i = c.tid; i < 2048; i += NTHREADS) { const int dir = i >> 10, ch = (i >> 6) & 15, p = i & 63, dg = dir * 32 + g; CC[i] = (f32x2){a.in[I_CRE][(size_t)(dg * 16 + ch) * 64 + p], a.in[I_CIM][(size_t)(dg * 16 + ch) * 64 + p]}; }
    __syncthreads();
    for (int task = c.tid; task < 1024; task += NTHREADS) { const int cpb = task & 3, cb = (task >> 2) & 3, lag = (task >> 4) & 31, dir = task >> 9;
        float acc[4][4];
#pragma unroll
        for (int i = 0; i < 4; ++i)
#pragma unroll
            for (int j = 0; j < 4; ++j) acc[i][j] = 0.f;
        for (int p = 0; p < 64; ++p) { const f32x2 l = LPOW[(dir * 33 + lag) * 64 + p]; f32x2 G[4], Cw[4];
#pragma unroll
            for (int j = 0; j < 4; ++j) { const f32x2 bb = BBAR[(dir * 64 + p) * 16 + 4 * cpb + j]; G[j] = (f32x2){l.x * bb.x - l.y * bb.y, l.x * bb.y + l.y * bb.x}; }
#pragma unroll
            for (int i = 0; i < 4; ++i) Cw[i] = CC[(dir * 16 + 4 * cb + i) * 64 + p];
#pragma unroll
            for (int i = 0; i < 4; ++i)
#pragma unroll
                for (int j = 0; j < 4; ++j) acc[i][j] += Cw[i].x * G[j].x - Cw[i].y * G[j].y; }
#pragma unroll
        for (int i = 0; i < 4; ++i)
#pragma unroll
            for (int j = 0; j < 4; ++j) MM[((dir * 32 + lag) * 16 + 4 * cb + i) * 16 + 4 * cpb + j] = acc[i][j]; }
    __syncthreads();
    if (c.tid < 128 && part == 0) { const int dir = c.tid >> 6, p = c.tid & 63; ((f32x2*)(c.ws + WS_LP))[(dir * 32 + g) * 64 + p] = LPOW[(dir * 33 + 32) * 64 + p]; }
    bf16* PMg = (bf16*)(c.ws + WS_PM) + (size_t)g * 256 * 512; bf16* BBg = (bf16*)(c.ws + WS_BB) + (size_t)g * 512 * 768;
    for (int task = part * 32 * 32 + c.tid; task < (part + 1) * 32 * 32; task += NTHREADS) { const int ip = task & 31, n = task >> 5, dir = n >> 7, im = (n >> 6) & 1, p = n & 63, e = dir ? ip : 31 - ip;
        const f32x2 l = LPOW[(dir * 33 + e) * 64 + p]; float o[16];
#pragma unroll
        for (int ch = 0; ch < 16; ++ch) { const f32x2 bb = BBAR[(dir * 64 + p) * 16 + ch]; o[ch] = im ? (l.x * bb.y + l.y * bb.x) : (l.x * bb.x - l.y * bb.y); }
        v4u w0, w1; w0.x = pk2(o[0], o[1]); w0.y = pk2(o[2], o[3]); w0.z = pk2(o[4], o[5]); w0.w = pk2(o[6], o[7]); w1.x = pk2(o[8], o[9]); w1.y = pk2(o[10], o[11]); w1.z = pk2(o[12], o[13]); w1.w = pk2(o[14], o[15]);
        *(v4u*)(PMg + (size_t)n * 512 + ip * 16) = w0; *(v4u*)(PMg + (size_t)n * 512 + ip * 16 + 8) = w1; }
    for (int task = part * 64 * 32 + c.tid; task < (part + 1) * 64 * 32; task += NTHREADS) { const int ip = task & 31, n = task >> 5, i = n >> 4, ch = n & 15; float o[16];
#pragma unroll
        for (int q = 0; q < 16; ++q) o[q] = 0.f;
        if (ip <= i) { const float* m0 = MM + ((0 * 32 + (i - ip)) * 16 + ch) * 16;
#pragma unroll
            for (int q = 0; q < 16; ++q) o[q] += m0[q]; }
        if (ip >= i) { const float* m1 = MM + ((1 * 32 + (ip - i)) * 16 + ch) * 16;
#pragma unroll
            for (int q = 0; q < 16; ++q) o[q] += m1[q]; }
        if (ip == i) { const float dsk = a.in[I_S5D][g * 16 + ch];
#pragma unroll
            for (int q = 0; q < 16; ++q) o[q] += (q == ch) ? dsk : 0.f; }
        v4u w0, w1; w0.x = pk2(o[0], o[1]); w0.y = pk2(o[2], o[3]); w0.z = pk2(o[4], o[5]); w0.w = pk2(o[6], o[7]); w1.x = pk2(o[8], o[9]); w1.y = pk2(o[10], o[11]); w1.z = pk2(o[12], o[13]); w1.w = pk2(o[14], o[15]);
        *(v4u*)(BBg + (size_t)n * 768 + ip * 16) = w0; *(v4u*)(BBg + (size_t)n * 768 + ip * 16 + 8) = w1; }
    for (int task = part * 64 * 32 + c.tid; task < (part + 1) * 64 * 32; task += NTHREADS) { const int p8 = task & 7, part = (task >> 3) & 3, n = task >> 5, i = n >> 4, ch = n & 15, dir = part >> 1, im = part & 1, e = dir ? 32 - i : i + 1; float o[8];
#pragma unroll
        for (int q = 0; q < 8; ++q) { const int p = p8 * 8 + q; const f32x2 l = LPOW[(dir * 33 + e) * 64 + p], cc = CC[(dir * 16 + ch) * 64 + p]; o[q] = im ? -(cc.x * l.y + cc.y * l.x) : (cc.x * l.x - cc.y * l.y); }
        v4u w0; w0.x = pk2(o[0], o[1]); w0.y = pk2(o[2], o[3]); w0.z = pk2(o[4], o[5]); w0.w = pk2(o[6], o[7]);
        *(v4u*)(BBg + (size_t)n * 768 + 512 + part * 64 + p8 * 8) = w0; }
}
__device__ __forceinline__ void s5_state_scan(const Ctx& c, int task) {
    const int dir = task & 1, g = (task >> 1) & 31, b = task >> 6, p = c.lane;
    const f32x2 a = ((const f32x2*)(c.ws + WS_LP))[(dir * 32 + g) * 64 + p];
    const float* SS = (const float*)(c.ws + WS_SS) + (size_t)g * 768 * 256 + dir * 128 + p; bf16* U5 = (bf16*)(c.ws + WS_U5) + (size_t)g * 768 * 768 + 512 + dir * 128 + p;
    float er = 0.f, ei = 0.f;
#pragma unroll 8
    for (int step = 0; step < 72; ++step) {
        const int R = (step < 8) ? 512 + b * 8 + (dir ? 7 - step : step) : b * 64 + (dir ? 71 - step : step - 8);
        if (step >= 8) { U5[(size_t)R * 768] = (bf16)f2bf(er); U5[(size_t)R * 768 + 64] = (bf16)f2bf(ei); }
        const float sr = SS[(size_t)R * 256], si = SS[(size_t)R * 256 + 64];
        const float nr = sr + a.x * er - a.y * ei, ni = si + a.x * ei + a.y * er; er = nr; ei = ni;
    }
}

constexpr int GDN_NCH = 36, GDN_ITEMS = NB * 4 * 2 * GDN_NCH;
constexpr size_t FR_T_BYTES = 8192, FR_ATT_BYTES = 8192, FR_KD_BYTES = 16384, FR_TAB_BYTES = 1024;
__device__ __forceinline__ int crow16(int i, int hh) { return (i & 3) + 8 * (i >> 2) + 4 * hh; }
__device__ __forceinline__ bf16x8 pack_step(const f32x16& x, int s) {
    v4u w; w.x = pk2(x[8 * s + 0], x[8 * s + 1]); w.y = pk2(x[8 * s + 2], x[8 * s + 3]); w.z = pk2(x[8 * s + 4], x[8 * s + 5]); w.w = pk2(x[8 * s + 6], x[8 * s + 7]);
    return __builtin_bit_cast(bf16x8, w);
}
__device__ __forceinline__ unsigned pk2v(float lo, float hi) { asm volatile("" : "+v"(lo), "+v"(hi)); return pk2(lo, hi); }
__device__ __forceinline__ bf16x8 pack_step_v(const f32x16& x, int s) {
    v4u w; w.x = pk2v(x[8 * s + 0], x[8 * s + 1]); w.y = pk2v(x[8 * s + 2], x[8 * s + 3]); w.z = pk2v(x[8 * s + 4], x[8 * s + 5]); w.w = pk2v(x[8 * s + 6], x[8 * s + 7]);
    return __builtin_bit_cast(bf16x8, w);
}
constexpr int GP_KR = 0, GP_QR = 17408, GP_KT = 34816, GP_LM = 53248, GP_TB = 70656, GP_TAB = 79872;
__device__ __forceinline__ void gdn_prep_item(const Ctx& c, int item) {
    const int n = item % GDN_NCH, bhd = item / GDN_NCH, dir = bhd & 1, h = (bhd >> 1) & 3, b = bhd >> 3;
    const bf16* QKV = (const bf16*)(c.ws + WS_QKV); const float* GB = (const float*)(c.ws + WS_GB);
    bf16* Kr = (bf16*)(c.lds + GP_KR); bf16* Qr = (bf16*)(c.lds + GP_QR); bf16* Kt = (bf16*)(c.lds + GP_KT); float* Lm = (float*)(c.lds + GP_LM); bf16* Tb = (bf16*)(c.lds + GP_TB); float* tab = (float*)(c.lds + GP_TAB);
    unsigned char* frT = c.ws + WS_FRT + (size_t)item * FR_T_BYTES; unsigned char* frA = c.ws + WS_FRA + (size_t)item * FR_ATT_BYTES; unsigned char* frK = c.ws + WS_FRK + (size_t)item * FR_KD_BYTES; float* frTab = (float*)(c.ws + WS_FRTAB + (size_t)item * FR_TAB_BYTES);
    const int r = c.lane & 31, hh = c.lane >> 5;
    if (c.wave == 0) { const int row = scan_row(b, dir, n * 64 + c.lane); float g = GB[(size_t)row * 16 + dir * 4 + h]; const float beta = GB[(size_t)row * 16 + 8 + dir * 4 + h];
#pragma unroll
        for (int o = 1; o < 64; o <<= 1) { const float t = __shfl_up(g, o); if (c.lane >= o) g += t; }
        const float gl = __shfl(g, 63);
        tab[c.lane] = g; tab[64 + c.lane] = beta; tab[128 + c.lane] = __expf(g); tab[192 + c.lane] = __expf(gl - g); }
    { const int s = c.tid >> 3, seg = c.tid & 7; const int row = scan_row(b, dir, n * 64 + s); const bf16* rp = QKV + (size_t)row * 1536 + h * 128 + seg * 16;
      const v4u q0 = *(const v4u*)rp, q1 = *(const v4u*)(rp + 8), k0 = *(const v4u*)(rp + 512), k1 = *(const v4u*)(rp + 520);
      *(v4u*)(Qr + s * 136 + seg * 16) = q0; *(v4u*)(Qr + s * 136 + seg * 16 + 8) = q1; *(v4u*)(Kr + s * 136 + seg * 16) = k0; *(v4u*)(Kr + s * 136 + seg * 16 + 8) = k1;
      const unsigned kw[8] = {k0.x, k0.y, k0.z, k0.w, k1.x, k1.y, k1.z, k1.w};
#pragma unroll
      for (int e = 0; e < 8; ++e) { Kt[(seg * 16 + 2 * e) * 72 + s] = (bf16)(kw[e] & 0xffffu); Kt[(seg * 16 + 2 * e + 1) * 72 + s] = (bf16)(kw[e] >> 16); } }
    __syncthreads();
    if (c.wave < 3) { const int ct = c.wave ? 1 : 0, st = c.wave == 2 ? 1 : 0;
        f32x16 acc;
#pragma unroll
        for (int i = 0; i < 16; ++i) acc[i] = 0.f;
#pragma unroll
        for (int kk = 0; kk < 8; ++kk) { const bf16x8 a = *(const bf16x8*)(Kr + (ct * 32 + r) * 136 + kk * 16 + hh * 8), bb = *(const bf16x8*)(Kr + (st * 32 + r) * 136 + kk * 16 + hh * 8); acc = MFMA32(a, bb, acc); }
        const int s = st * 32 + r; const float gcs = tab[s];
#pragma unroll
        for (int i = 0; i < 16; ++i) { const int cc = ct * 32 + crow16(i, hh); Lm[cc * 68 + s] = (s < cc) ? tab[64 + cc] * acc[i] * __expf(tab[cc] - gcs) : 0.f; }
    } else if (c.wave < 6) { const int w = c.wave - 3, st = w == 2 ? 1 : 0, ct = w ? 1 : 0;
        f32x16 acc;
#pragma unroll
        for (int i = 0; i < 16; ++i) acc[i] = 0.f;
#pragma unroll
        for (int kk = 0; kk < 8; ++kk) { const bf16x8 a = *(const bf16x8*)(Kr + (st * 32 + r) * 136 + kk * 16 + hh * 8), bb = *(const bf16x8*)(Qr + (ct * 32 + r) * 136 + kk * 16 + hh * 8); acc = MFMA32(a, bb, acc); }
        const int cc = ct * 32 + r; const float gcc = tab[cc];
#pragma unroll
        for (int i = 0; i < 16; ++i) { const int s = st * 32 + crow16(i, hh); acc[i] = (s <= cc) ? acc[i] * __expf(gcc - tab[s]) : 0.f; }
        *(bf16x8*)(frA + ((size_t)((ct * 4 + 2 * st) * 64 + c.lane)) * 16) = pack_step(acc, 0);
        *(bf16x8*)(frA + ((size_t)((ct * 4 + 2 * st + 1) * 64 + c.lane)) * 16) = pack_step(acc, 1);
    } else { const int w = c.wave - 6;
#pragma unroll
        for (int f = 0; f < 8; ++f) { const int fi = w * 8 + f, dkt = fi >> 2, cb = fi & 3; const bf16* kp = Kt + (dkt * 32 + r) * 72 + 16 * cb + 4 * hh;
            const v2u lo = *(const v2u*)kp, hi = *(const v2u*)(kp + 8); const f32x4 e0 = *(const f32x4*)(tab + 192 + 16 * cb + 4 * hh), e1 = *(const f32x4*)(tab + 192 + 16 * cb + 8 + 4 * hh);
            v4u o; o.x = pk2(bflo(lo.x) * e0.x, bfhi(lo.x) * e0.y); o.y = pk2(bflo(lo.y) * e0.z, bfhi(lo.y) * e0.w); o.z = pk2(bflo(hi.x) * e1.x, bfhi(hi.x) * e1.y); o.w = pk2(bflo(hi.y) * e1.z, bfhi(hi.y) * e1.w);
            *(v4u*)(frK + ((size_t)(fi * 64 + c.lane)) * 16) = o; }
        if (w == 0) { const v4u z = (v4u){0u, 0u, 0u, 0u}; *(v4u*)(frA + ((size_t)((0 * 4 + 2) * 64 + c.lane)) * 16) = z; *(v4u*)(frA + ((size_t)((0 * 4 + 3) * 64 + c.lane)) * 16) = z; }
        else { *(f32x4*)(frTab + 4 * c.lane) = *(const f32x4*)(tab + 4 * c.lane); }
    }
    __syncthreads();
    if (c.wave == 0) { float Tr[64];
#pragma unroll
        for (int i = 0; i < 64; ++i) { float a0 = (c.lane == i) ? 1.f : 0.f, a1 = 0.f;
#pragma unroll
            for (int s4 = 0; s4 < (i + 3) / 4; ++s4) { const f32x4 l4 = *(const f32x4*)(Lm + i * 68 + 4 * s4);
                if (4 * s4 + 0 < i) a0 = fmaf(-l4.x, Tr[4 * s4 + 0], a0); if (4 * s4 + 1 < i) a1 = fmaf(-l4.y, Tr[4 * s4 + 1], a1); if (4 * s4 + 2 < i) a0 = fmaf(-l4.z, Tr[4 * s4 + 2], a0); if (4 * s4 + 3 < i) a1 = fmaf(-l4.w, Tr[4 * s4 + 3], a1); }
            Tr[i] = a0 + a1; Tb[i * 72 + c.lane] = (bf16)f2bf(Tr[i]); } }
    __syncthreads();
    { const int ct = c.wave >> 2, sb = c.wave & 3; const bf16* tp = Tb + (ct * 32 + r) * 72 + 16 * sb + 4 * hh; const v2u lo = *(const v2u*)tp, hi = *(const v2u*)(tp + 8);
      *(v4u*)(frT + ((size_t)((ct * 4 + sb) * 64 + c.lane)) * 16) = (v4u){lo.x, lo.y, hi.x, hi.y}; }
    __syncthreads();
}
__device__ __forceinline__ void phase_gdn_prep(const Ctx& c) { for (int item = c.bid; item < GDN_ITEMS; item += c.G) gdn_prep_item(c, item); }

constexpr int GR_K = 0, GR_Q = 16384, GR_T = 32768, GR_A = 40960, GR_KD = 49152, GR_TAB = 65536, GR_BUF = 66560;
__device__ __forceinline__ void gdn_rec_stage(const Ctx& c, int bhd, int n, int buf) {
    const int dir = bhd & 1, h = (bhd >> 1) & 3, b = bhd >> 3, lw = c.wave - 4; const int item = bhd * GDN_NCH + n;
    LAS unsigned char* base = (LAS unsigned char*)c.lds + buf * GR_BUF;
    const unsigned char* QKVb = c.ws + WS_QKV;
#pragma unroll
    for (int q = 0; q < 4; ++q) { const int qi = lw + 4 * q;
        const int s = 4 * qi + (c.lane >> 4), ps = c.lane & 15, p = ps ^ (s & 15); const size_t rowb = (size_t)scan_row(b, dir, n * 64 + s) * 3072 + (size_t)h * 256 + p * 16;
        __builtin_amdgcn_global_load_lds((const unsigned*)(QKVb + rowb + 1024), (LAS unsigned*)(base + GR_K + qi * 1024), 16, 0, 0);
        __builtin_amdgcn_global_load_lds((const unsigned*)(QKVb + rowb), (LAS unsigned*)(base + GR_Q + qi * 1024), 16, 0, 0); }
    const unsigned char* frT = c.ws + WS_FRT + (size_t)item * FR_T_BYTES; const unsigned char* frA = c.ws + WS_FRA + (size_t)item * FR_ATT_BYTES; const unsigned char* frK = c.ws + WS_FRK + (size_t)item * FR_KD_BYTES;
#pragma unroll
    for (int q = 0; q < 2; ++q) { const int qi = lw + 4 * q;
        __builtin_amdgcn_global_load_lds((const unsigned*)(frT + qi * 1024 + c.lane * 16), (LAS unsigned*)(base + GR_T + qi * 1024), 16, 0, 0);
        __builtin_amdgcn_global_load_lds((const unsigned*)(frA + qi * 1024 + c.lane * 16), (LAS unsigned*)(base + GR_A + qi * 1024), 16, 0, 0); }
#pragma unroll
    for (int q = 0; q < 4; ++q) { const int qi = lw + 4 * q;
        __builtin_amdgcn_global_load_lds((const unsigned*)(frK + qi * 1024 + c.lane * 16), (LAS unsigned*)(base + GR_KD + qi * 1024), 16, 0, 0); }
    if (lw == 0) __builtin_amdgcn_global_load_lds((const unsigned*)(c.ws + WS_FRTAB + (size_t)item * FR_TAB_BYTES + c.lane * 16), (LAS unsigned*)(base + GR_TAB), 16, 0, 0);
}
__device__ __forceinline__ bf16x8 gr_rowfrag(const unsigned char* tile, int row, int kb, int hh) {
    const unsigned char* rp = tile + row * 256; const int sw = row & 15;
    const v2u lo = *(const v2u*)(rp + (((2 * kb) ^ sw) * 16) + 8 * hh), hi = *(const v2u*)(rp + (((2 * kb + 1) ^ sw) * 16) + 8 * hh);
    return __builtin_bit_cast(bf16x8, (v4u){lo.x, lo.y, hi.x, hi.y});
}
__device__ __forceinline__ void gdn_rec_block(const Ctx& c, int bhd) {
    const int dir = bhd & 1, h = (bhd >> 1) & 3, b = bhd >> 3, r = c.lane & 31, hh = c.lane >> 5, dvt = c.wave;
    const bf16* QKV = (const bf16*)(c.ws + WS_QKV); bf16* OG = (bf16*)(c.ws + WS_OG) + (size_t)dir * ML * 512;
    f32x16 S[4];
#pragma unroll
    for (int t = 0; t < 4; ++t)
#pragma unroll
        for (int i = 0; i < 16; ++i) S[t][i] = 0.f;
    if (c.wave >= 4) gdn_rec_stage(c, bhd, 0, 0);
    asm volatile("s_waitcnt vmcnt(0)" ::: "memory"); __syncthreads();
    for (int n = 0; n < GDN_NCH; ++n) {
        const int buf = n & 1;
        if (c.wave >= 4) { if (n + 1 < GDN_NCH) gdn_rec_stage(c, bhd, n + 1, buf ^ 1); }
        else {
            const unsigned char* base = c.lds + buf * GR_BUF; const float* tab = (const float*)(base + GR_TAB);
            const int row0 = scan_row(b, dir, n * 64), sgn = dir ? -1 : 1;
            const bf16* vcol = QKV + (size_t)row0 * 1536 + 1024 + h * 128 + dvt * 32 + r + (ptrdiff_t)(sgn * 4 * hh) * 1536;
            bf16* ocol = OG + (size_t)row0 * 512 + h * 128 + dvt * 32 + r + (ptrdiff_t)(sgn * 4 * hh) * 512;
            const ptrdiff_t vst = (ptrdiff_t)sgn * 1536, ost = (ptrdiff_t)sgn * 512;
            bf16 vraw[2][16];
#pragma unroll
            for (int st = 0; st < 2; ++st)
#pragma unroll
                for (int i = 0; i < 16; ++i) vraw[st][i] = vcol[vst * (st * 32 + (i & 3) + 8 * (i >> 2))];
            bf16x8 Rf[2][2];
#pragma unroll
            for (int st = 0; st < 2; ++st) { f32x16 acc;
#pragma unroll
                for (int i = 0; i < 16; ++i) acc[i] = 0.f;
#pragma unroll
                for (int kb = 0; kb < 8; ++kb) acc = MFMA32(gr_rowfrag(base + GR_K, st * 32 + r, kb, hh), pack_step_v(S[kb >> 1], kb & 1), acc);
#pragma unroll
                for (int i = 0; i < 16; ++i) { const int s = st * 32 + crow16(i, hh); acc[i] = tab[64 + s] * (bf1(vraw[st][i]) - tab[128 + s] * acc[i]); }
                Rf[st][0] = pack_step(acc, 0); Rf[st][1] = pack_step(acc, 1); asm volatile("" ::: "memory"); }
            bf16x8 Vf[2][2];
#pragma unroll
            for (int ct = 0; ct < 2; ++ct) { f32x16 acc;
#pragma unroll
                for (int i = 0; i < 16; ++i) acc[i] = 0.f;
#pragma unroll
                for (int sb = 0; sb < 4; ++sb) if (sb < 2 * ct + 2) acc = MFMA32(*(const bf16x8*)(base + GR_T + ((ct * 4 + sb) * 64 + c.lane) * 16), Rf[sb >> 1][sb & 1], acc);
                Vf[ct][0] = pack_step(acc, 0); Vf[ct][1] = pack_step(acc, 1); }
            asm volatile("" ::: "memory");
#pragma unroll
            for (int ct = 0; ct < 2; ++ct) { f32x16 acc;
#pragma unroll
                for (int i = 0; i < 16; ++i) acc[i] = 0.f;
#pragma unroll
                for (int kb = 0; kb < 8; ++kb) acc = MFMA32(gr_rowfrag(base + GR_Q, ct * 32 + r, kb, hh), pack_step_v(S[kb >> 1], kb & 1), acc);
#pragma unroll
                for (int i = 0; i < 16; ++i) acc[i] *= tab[128 + ct * 32 + crow16(i, hh)];
#pragma unroll
                for (int cb = 0; cb < 4; ++cb) if (cb < 2 * ct + 2) acc = MFMA32(*(const bf16x8*)(base + GR_A + ((ct * 4 + cb) * 64 + c.lane) * 16), Vf[cb >> 1][cb & 1], acc);
                if (n >= 4) {
#pragma unroll
                    for (int i = 0; i < 16; ++i) ocol[ost * (ct * 32 + (i & 3) + 8 * (i >> 2))] = (bf16)f2bf(acc[i]); }
                asm volatile("" ::: "memory"); }
            const float gtot = tab[128 + 63];
#pragma unroll
            for (int t = 0; t < 4; ++t) {
#pragma unroll
                for (int i = 0; i < 16; ++i) S[t][i] *= gtot;
#pragma unroll
                for (int cb = 0; cb < 4; ++cb) S[t] = MFMA32(*(const bf16x8*)(base + GR_KD + ((t * 4 + cb) * 64 + c.lane) * 16), Vf[cb >> 1][cb & 1], S[t]); }
        }
        if (c.wave >= 4) asm volatile("s_waitcnt vmcnt(0)" ::: "memory"); else asm volatile("s_waitcnt lgkmcnt(0)" ::: "memory");
        __builtin_amdgcn_s_barrier(); asm volatile("" ::: "memory");
    }
    asm volatile("s_waitcnt vmcnt(0)" ::: "memory"); __syncthreads();
}
__device__ __forceinline__ void phase_gdn_rec(const Ctx& c) { for (int bhd = c.bid; bhd < 64; bhd += 64) gdn_rec_block(c, bhd); }

#define XB_TMO      128
#define XB_XCNT(j)  (256  + 64 * (j))
#define XB_XSUB(j)  (1280 + 64 * (j))
#define XB_XGEN(j)  (2304 + 64 * (j))
#define XB_TOP      3328
#define XB_TOPGEN   3392
#define XCD_BAR_WORDS 3456
#define XB_SPIN_CAP (1u << 20)
__device__ __forceinline__ unsigned xb_ld(unsigned* p)              { return __hip_atomic_load(p, __ATOMIC_RELAXED, __HIP_MEMORY_SCOPE_AGENT); }
__device__ __forceinline__ unsigned xb_add(unsigned* p, unsigned v) { return __hip_atomic_fetch_add(p, v, __ATOMIC_RELAXED, __HIP_MEMORY_SCOPE_AGENT); }
__device__ __forceinline__ unsigned xb_xcc_id() { return (unsigned)__builtin_amdgcn_s_getreg((3 << 11) | 20) & 0xFu; }
#define XB_SPIN(cond, bar) do { unsigned _sp = 0; while (cond) { __builtin_amdgcn_s_sleep(1); \
    if ((++_sp & 255u) == 0u) { if (xb_ld(&(bar)[XB_TMO])) break; if (_sp > XB_SPIN_CAP) { atomicAdd(&(bar)[XB_TMO], 1u); break; } } } } while (0)
struct XcdBarrier { unsigned* bar; unsigned x; volatile LAS unsigned* st; };
__device__ __forceinline__ XcdBarrier xcd_barrier_post(unsigned* bar, volatile LAS unsigned* st) {
    XcdBarrier b; b.bar = bar; b.x = xb_xcc_id(); b.st = st;
    if (threadIdx.x == 0) (void)xb_add(&bar[XB_XCNT(b.x)], 1u);
    return b;
}
__device__ __forceinline__ void xcd_barrier_complete(unsigned* bar, unsigned x, unsigned& nloc, unsigned& nx) {
    const unsigned G = gridDim.x * gridDim.y * gridDim.z;
    unsigned sum, cnt, mine, sp = 0u;
    for (;;) {
        sum = 0u; cnt = 0u; mine = 0u;
#pragma unroll
        for (unsigned j = 0; j < 16; ++j) { const unsigned c = xb_ld(&bar[XB_XCNT(j)]); sum += c; cnt += (c > 0u) ? 1u : 0u; mine = (j == x) ? c : mine; }
        if (sum == G) break;
        __builtin_amdgcn_s_sleep(1);
        if ((++sp & 255u) == 0u) { if (xb_ld(&bar[XB_TMO])) break; if (sp > XB_SPIN_CAP) { atomicAdd(&bar[XB_TMO], 1u); break; } }
    }
    nloc = mine > 0u ? mine : 1u; nx = cnt > 0u ? cnt : 1u;
}
__device__ __forceinline__ void xcd_barrier(const XcdBarrier& b) {
    asm volatile("s_waitcnt vmcnt(0)" ::: "memory");
    __syncthreads();
    if (threadIdx.x == 0) {
        unsigned* bar = b.bar;
        __builtin_amdgcn_s_waitcnt(0);
        unsigned nloc = b.st[0], nx = b.st[1];
        if (nloc == 0u) { xcd_barrier_complete(bar, b.x, nloc, nx); b.st[0] = nloc; b.st[1] = nx; }
        const unsigned old = xb_add(&bar[XB_XSUB(b.x)], 1u);
        const unsigned gen = old / nloc;
        if (old + 1u == (gen + 1u) * nloc) {
            __builtin_amdgcn_fence(__ATOMIC_RELEASE, "agent");
            asm volatile("s_waitcnt vmcnt(0)" ::: "memory");
            const unsigned og = xb_add(&bar[XB_TOP], 1u);
            const unsigned tg = og / nx;
            if (og + 1u == (tg + 1u) * nx) xb_add(&bar[XB_TOPGEN], 1u);
            else XB_SPIN(xb_ld(&bar[XB_TOPGEN]) == tg, bar);
            __builtin_amdgcn_fence(__ATOMIC_ACQUIRE, "agent");
            xb_add(&bar[XB_XGEN(b.x)], 1u);
            asm volatile("s_waitcnt vmcnt(0)" ::: "memory");
        } else {
            XB_SPIN(xb_ld(&bar[XB_XGEN(b.x)]) == gen, bar);
            __builtin_amdgcn_fence(__ATOMIC_ACQUIRE, "agent");
            asm volatile("s_waitcnt vmcnt(0)" ::: "memory");
        }
    }
    __syncthreads();
}

constexpr int LDS_MISC = LDS_BYTES - 64;
__global__ void __launch_bounds__(NTHREADS, 2) mk_fwd(Args args) {
    extern __shared__ __attribute__((aligned(16))) unsigned char lds[];
    Ctx c; c.a = &args; c.ws = args.ws; c.lds = lds;
    c.tid = threadIdx.x; c.lane = c.tid & 63; c.wave = __builtin_amdgcn_readfirstlane(c.tid >> 6); c.bid = blockIdx.x; c.G = gridDim.x;
    c.gw = c.bid * NWAVES + c.wave; c.NGW = c.G * NWAVES; c.gwv = c.wave * c.G + c.bid;
    const int lo = args.ph_lo, hi = args.ph_hi;
    PG8_LAS unsigned char* ring = (PG8_LAS unsigned char*)lds;
#ifndef MK_PH_MASK
#define MK_PH_MASK 0xffff
#endif
#define IN(k) (((MK_PH_MASK >> (k)) & 1) && lo <= (k) && (k) < hi)
#if MK_ONE_LAUNCH
    cg::grid_group grid = cg::this_grid();
    if (lo < 0) grid.sync();
    volatile LAS unsigned* st = (volatile LAS unsigned*)((LAS unsigned char*)lds + LDS_MISC);
    if (c.tid < 2) st[c.tid] = 0u;
    __syncthreads();
    const XcdBarrier bar = xcd_barrier_post((unsigned*)(c.ws + WS_CTL) + CW_BAR, st);
#define SEAM(k) do { if (IN(k) && IN((k) + 1)) xcd_barrier(bar); } while (0)
#else
#define SEAM(k) do { } while (0)
#endif
    if (IN(0)) { phase_prep(c); phase_s5_build(c); } SEAM(0);
    if (IN(1)) { phase_norm1(c); } SEAM(1);
    if (IN(2)) { pg8::Gemm g{(const pg8::bf16_t*)(c.ws + WS_HX), (const pg8::bf16_t*)(c.ws + WS_WIN), 1024, 1024, 1024}; pg8::StaticOrder S; S.init(MT, NPROJ, c.G, c.bid);
        pg8::EpiInProj E{(pg8::bf16_t*)(c.ws + WS_U5), (pg8::bf16_t*)(c.ws + WS_QKVPRE), (pg8::bf16_t*)(c.ws + WS_Z)};
        pg8::gemm_phase<pg8::EpiInProj, pg8::StaticOrder, true, true>(ring, g, S, E); } SEAM(2);
    if (IN(3)) { { pg8::Gemm g{(const pg8::bf16_t*)(c.ws + WS_U5), (const pg8::bf16_t*)(c.ws + WS_PM), 768, 512, 512}; pg8::SchedSS S{c.G, c.bid}; pg8::EpiSS E{(float*)(c.ws + WS_SS)};
          pg8::gemm_phase<pg8::EpiSS, pg8::SchedSS, true, true>(ring, g, S, E); }
        __syncthreads(); phase_conv(c); } SEAM(3);
    if (IN(4)) { if (c.wave < 2) s5_state_scan(c, c.bid + c.G * c.wave < 512 ? c.bid + c.G * c.wave : 0); __syncthreads(); phase_gdn_prep(c); } SEAM(4);
    if (IN(5)) { pg8::Gemm g{(const pg8::bf16_t*)(c.ws + WS_U5), (const pg8::bf16_t*)(c.ws + WS_BB), 768, 768, 768}; pg8::SchedS5Y S{c.G, c.bid}; pg8::EpiS5Y E{(pg8::bf16_t*)(c.ws + WS_YG)};
        pg8::gemm_phase<pg8::EpiS5Y, pg8::SchedS5Y, true, true>(ring, g, S, E); } SEAM(5);
    if (IN(6)) { if (c.bid < 64) phase_gdn_rec(c);
        else { pg8::Gemm g{(const pg8::bf16_t*)(c.ws + WS_YG), (const pg8::bf16_t*)(c.ws + WS_WGLU), 512, 512, 512}; pg8::StaticOrder S; S.init(ML, 512, c.G - 64, c.bid - 64);
            pg8::EpiGlu E{(const pg8::bf16_t*)(c.ws + WS_YG), (pg8::bf16_t*)(c.ws + WS_CAT)};
            pg8::gemm_phase<pg8::EpiGlu, pg8::StaticOrder, true, true>(ring, g, S, E); } } SEAM(6);
    if (IN(7)) { phase_combine(c); } SEAM(7);
    if (IN(8)) { pg8::Gemm g{(const pg8::bf16_t*)(c.ws + WS_CAT), (const pg8::bf16_t*)(c.ws + WS_WOUT), 1024, 1024, 1024}; pg8::StaticOrder S; S.init(ML, 1024, c.G, c.bid);
        pg8::EpiF32 E{(float*)(c.ws + WS_YRAW), 1024};
        pg8::gemm_phase<pg8::EpiF32, pg8::StaticOrder, true, true>(ring, g, S, E); } SEAM(8);
    if (IN(9)) { phase_rows2(c); phase_fp8_tables(c); } SEAM(9);
    if (IN(10)) { pg8::Gemm g{(const pg8::bf16_t*)(c.ws + WS_HX2), (const pg8::bf16_t*)(c.ws + WS_WQ), 1024, 1024, 1024}; pg8::StaticOrder S; S.init(ML, 2048, c.G, c.bid);
        pg8::EpiBf16<0> E{(pg8::bf16_t*)(c.ws + WS_QP), 2048, nullptr, 0, 0, 1.f};
        pg8::gemm_phase<pg8::EpiBf16<0>, pg8::StaticOrder, true, true>(ring, g, S, E); } SEAM(10);
    if (IN(11)) { phase_topk(c); } SEAM(11);
    if (IN(12)) { phase_exp1(c); } SEAM(12);
    if (IN(13)) { phase_exp2(c); } SEAM(13);
    if (IN(14)) { phase_exp3(c); }
#undef IN
#undef SEAM
}

extern "C" void kernel_launch(void* const* d_in, const int* in_sizes, int n_in, void* d_out, int out_size, void* d_ws, size_t ws_size, hipStream_t stream) {
    static int grid = 0;
    if (grid == 0) {
        if (n_in != 29 || out_size != ML * D || ws_size < WS_END) { fprintf(stderr, "kernel_launch: unexpected shapes (n_in %d out %d ws %zu)\n", n_in, out_size, ws_size); grid = -1; return; }
        int dev = 0, cus = 0, per_cu = 0;
        (void)hipGetDevice(&dev); (void)hipDeviceGetAttribute(&cus, hipDeviceAttributeMultiprocessorCount, dev);
        if (hipFuncSetAttribute((const void*)mk_fwd, hipFuncAttributeMaxDynamicSharedMemorySize, LDS_BYTES) != hipSuccess) { fprintf(stderr, "kernel_launch: hipFuncSetAttribute failed\n"); grid = -1; return; }
        (void)hipOccupancyMaxActiveBlocksPerMultiprocessor(&per_cu, (const void*)mk_fwd, NTHREADS, LDS_BYTES);
        (void)hipGetLastError();
        grid = cus;
        fprintf(stderr, "kernel_launch: cus %d per_cu %d grid %d\n", cus, per_cu, grid);
    }
    if (grid < 0) return;
    Args a{};
    for (int i = 0; i < 29; ++i) a.in[i] = (const float*)d_in[i];
    a.out = (float*)d_out; a.ws = (unsigned char*)d_ws;
    (void)hipMemsetAsync((char*)d_ws + WS_CTL, 0, CTL_ZERO_BYTES, stream);
#if MK_ONE_LAUNCH
    a.ph_lo = 0; a.ph_hi = NPHASES;
    void* kargs[] = {&a};
    hipError_t e = hipLaunchCooperativeKernel((const void*)mk_fwd, dim3(grid), dim3(NTHREADS), kargs, LDS_BYTES, stream);
    if (e != hipSuccess) fprintf(stderr, "kernel_launch: cooperative launch failed: %s\n", hipGetErrorString(e));
#else
    for (int ph = 0; ph < NPHASES; ++ph) { a.ph_lo = ph; a.ph_hi = ph + 1; hipLaunchKernelGGL(mk_fwd, dim3(grid), dim3(NTHREADS), LDS_BYTES, stream, a); }
#endif
}
```

```cpp
#include <hip/hip_runtime.h>
#include <hip/hip_cooperative_groups.h>
#include <cstdio>
#include <cstdint>
namespace cg = cooperative_groups;
namespace pg8 {
#define PG8_LAS __attribute__((address_space(3)))
typedef unsigned short bf16_t;
typedef short bf16x8 __attribute__((ext_vector_type(8)));
typedef float f32x4 __attribute__((ext_vector_type(4)));
typedef unsigned u32x4 __attribute__((ext_vector_type(4)));
constexpr int BM = 256, BK = 64, HALF = 128, HTB = HALF * BK * 2  , STAGE_BYTES = 8 * HTB, NXCD = 8, WGM = 8;

__host__ __device__ __forceinline__ int lds_byte(int r, int c) { const int st = (r >> 4) * 2 + (c >> 5), rr = r & 15, cc = c & 31, ob = rr * 64 + cc * 2; return st * 1024 + (ob ^ (((ob >> 9) & 1) << 5)); }
__host__ __device__ __forceinline__ void stage_rc(int b, int& R, int& C) { const int st = b / 1024, sb = b % 1024, swz = sb ^ (((sb >> 9) & 1) << 5); R = (st >> 1) * 16 + swz / 64; C = (st & 1) * 32 + (swz % 64) / 2; }
__host__ __device__ __forceinline__ int perm32(int rho) { const int n = rho >> 4, i = rho & 15; return 8 * (i >> 2) + 4 * n + (i & 3); }

struct Unit { int pm, pn; };
struct Gemm { const bf16_t* A; const bf16_t* Bt; int lda, ldb, K; };

struct StaticOrder {
    int nM, nN, nwg, G, c;
    __host__ __device__ void init(int M, int N, int G_, int c_) { nM = M / BM; nN = N / BM; nwg = nM * nN; G = G_; c = c_; }
    __host__ __device__ bool next(int i, Unit& u) const {
        const long L = (long)i * G + c; if (L >= nwg) return false;
        int wgid = (int)L; { const int q = nwg / NXCD, r = nwg % NXCD, xcd = wgid % NXCD, off = wgid / NXCD; wgid = (xcd < r ? xcd * (q + 1) : r * (q + 1) + (xcd - r) * q) + off; }
        const int nig = WGM * nN, gid = wgid / nig, fm = gid * WGM, gsz = (nM - fm) < WGM ? (nM - fm) : WGM;
        u.pm = fm + ((wgid % nig) % gsz); u.pn = (wgid % nig) / gsz; return true;
    }
    __device__ __forceinline__ void a_ready(const Unit&) const {}
    __device__ __forceinline__ void done(const Unit&) const {}
};

__device__ __forceinline__ unsigned cvt_pk_bf16(float lo, float hi) { unsigned r; asm volatile("v_cvt_pk_bf16_f32 %0, %1, %2" : "=v"(r) : "v"(lo), "v"(hi)); return r; }
typedef float f32x2 __attribute__((ext_vector_type(2)));
__device__ __forceinline__ f32x2 gelu_pk(f32x2 v) {
    const f32x2 av = __builtin_elementwise_abs(v), d = av * 0.2316418882f + 1.0f;
    f32x2 t; t.x = __builtin_amdgcn_rcpf(d.x); t.y = __builtin_amdgcn_rcpf(d.y);
    f32x2 q = t * 0.5307027145f + (-0.7265760135f); q = q * t + 0.7107068705f; q = q * t + (-0.142248368f); q = q * t + 0.127414796f; q = q * t;
    const f32x2 s = (v * v) * (-0.72134752044f);
    f32x2 e; e.x = __builtin_amdgcn_exp2f(s.x); e.y = __builtin_amdgcn_exp2f(s.y);
    const f32x2 m = v * (q * e), r = v - m;
    f32x2 o; o.x = v.x < 0.f ? m.x : r.x; o.y = v.y < 0.f ? m.y : r.y; return o;
}

template <int ACT  > struct EpiBf16 {
    static constexpr bool PERM = true, AFTER_DRAIN = false; static_assert(ACT == 0 || ACT == 1, "EpiBf16: ACT is 0 (none) or 1 (gelu_pk)");
    bf16_t* O; int ldc; const float* bias; int split_cols; size_t split_stride; float scale0;
    __device__ __forceinline__ void operator()(const f32x4 (&acc)[2][2][4][2], const Unit& u, int wr, int wc, int fr, int fq) const {
        const int row0 = u.pm * BM + wr * 64 + fr; int colt = u.pn * BM; bf16_t* base = O;
        float sc = 1.f; if (split_cols) { const int t = colt / split_cols; base += (size_t)t * split_stride; colt -= t * split_cols; if (t == 0) sc = scale0; }
        const int col0 = colt + wc * 32 + 8 * fq, bcol0 = u.pn * BM + wc * 32 + 8 * fq;
        f32x4 bv[2][2];
#pragma unroll
        for (int bj = 0; bj < 2; ++bj)
#pragma unroll
            for (int n = 0; n < 2; ++n) bv[bj][n] = bias ? *(const f32x4*)(bias + bcol0 + bj * HALF + 4 * n) : (f32x4){0.f, 0.f, 0.f, 0.f};
#pragma unroll
        for (int ai = 0; ai < 2; ++ai)
#pragma unroll
            for (int m = 0; m < 4; ++m) { bf16_t* rowp = base + (size_t)(row0 + ai * HALF + m * 16) * ldc + col0;
#pragma unroll
                for (int bj = 0; bj < 2; ++bj) { f32x4 v0 = acc[ai][bj][m][0] + bv[bj][0], v1 = acc[ai][bj][m][1] + bv[bj][1];
                    if (ACT == 1) { f32x2 a = gelu_pk((f32x2){v0[0], v0[1]}), b = gelu_pk((f32x2){v0[2], v0[3]}), c = gelu_pk((f32x2){v1[0], v1[1]}), d = gelu_pk((f32x2){v1[2], v1[3]});
                        v0 = (f32x4){a.x, a.y, b.x, b.y}; v1 = (f32x4){c.x, c.y, d.x, d.y}; }
                    v0 = v0 * sc; v1 = v1 * sc; u32x4 w; w.x = cvt_pk_bf16(v0[0], v0[1]); w.y = cvt_pk_bf16(v0[2], v0[3]); w.z = cvt_pk_bf16(v1[0], v1[1]); w.w = cvt_pk_bf16(v1[2], v1[3]);
                    *(u32x4*)(rowp + bj * HALF) = w; } }
    }
};

template <class Epi, class Sched, bool ALIGN_EPI = false, bool SP2 = false>
__device__ __forceinline__ void gemm_phase(PG8_LAS unsigned char* lds, const Gemm g, const Sched& S, const Epi& E) {
    const int tid = threadIdx.x, wid = __builtin_amdgcn_readfirstlane(tid >> 6), lane = tid & 63, wr = wid >> 2, wc = wid & 3, fr = lane & 15, fq = lane >> 4;
    const int K = g.K, nt = K / BK;
    unsigned voffA[2], voffB[2];
#pragma unroll
    for (int i = 0; i < 2; ++i) { int R, C; stage_rc(tid * 16 + i * 8192, R, C); const int Rb = Epi::PERM ? ((R & ~31) + perm32(R & 31)) : R;
        voffA[i] = (unsigned)(R * g.lda + C) * 2u; voffB[i] = (unsigned)(Rb * g.ldb + C) * 2u; }
    const size_t kstep = (size_t)(BK * 2);
    const size_t hstepA = (size_t)HALF * g.lda * 2, hstepB = (size_t)HALF * g.ldb * 2;
    const size_t tstepA = 2 * hstepA, tstepB = 2 * hstepB;
    const unsigned ldsw = (unsigned)wid * 1024u;
    const int aoff = lds_byte(wr * 64 + fr, fq * 8), boff = lds_byte(wc * 32 + fr, fq * 8);
#define PG8_SA(b, h) (((b) * 2 + (h)) * HTB)
#define PG8_SB(b, h) ((4 + (b) * 2 + (h)) * HTB)
#define PG8_STAGE(bufoff, gbase, voff) do { _Pragma("unroll") for (int _i = 0; _i < 2; ++_i) \
        __builtin_amdgcn_global_load_lds((const unsigned*)((const char*)(gbase) + (voff)[_i]), (PG8_LAS unsigned*)(lds + (bufoff) + ldsw + _i * 8192), 16, 0, 0); } while (0)
#define PG8_LDA(dst, b, h) do { _Pragma("unroll") for (int m = 0; m < 4; ++m) _Pragma("unroll") for (int k = 0; k < 2; ++k) dst[m][k] = *(const PG8_LAS bf16x8*)(lds + PG8_SA(b, h) + aoff + m * 2048 + k * 1024); } while (0)
#define PG8_LDB(dst, b, h) do { _Pragma("unroll") for (int n = 0; n < 2; ++n) _Pragma("unroll") for (int k = 0; k < 2; ++k) dst[n][k] = *(const PG8_LAS bf16x8*)(lds + PG8_SB(b, h) + boff + n * 2048 + k * 1024); } while (0)
#define PG8_MMA(ai, bj, At, Bt) do { __builtin_amdgcn_s_setprio(1); _Pragma("unroll") for (int m = 0; m < 4; ++m) _Pragma("unroll") for (int n = 0; n < 2; ++n) _Pragma("unroll") for (int k = 0; k < 2; ++k) \
        acc[ai][bj][m][n] = __builtin_amdgcn_mfma_f32_16x16x32_bf16(Bt[n][k], At[m][k], acc[ai][bj][m][n], 0, 0, 0); __builtin_amdgcn_s_setprio(0); } while (0)
#define PG8_WAIT_V(n) asm volatile("s_waitcnt vmcnt(" #n ")" ::: "memory")
#define PG8_WAIT_L(n) asm volatile("s_waitcnt lgkmcnt(" #n ")" ::: "memory")
#define PG8_BAR __builtin_amdgcn_s_barrier()
#define PG8_SCHED __builtin_amdgcn_sched_barrier(0)
    Unit cur, nxt; int ui = 0;
    if (!S.next(0, cur)) return;
    f32x4 acc[2][2][4][2];
#pragma unroll
    for (int a = 0; a < 2; ++a)
#pragma unroll
        for (int b = 0; b < 2; ++b)
#pragma unroll
            for (int m = 0; m < 4; ++m)
#pragma unroll
                for (int n = 0; n < 2; ++n) acc[a][b][m][n] = (f32x4){0.f, 0.f, 0.f, 0.f};
    bf16x8 At[4][2], B0[2][2], B1[2][2];
    const char* cA = (const char*)g.A + (size_t)cur.pm * tstepA; const char* cB = (const char*)g.Bt + (size_t)cur.pn * tstepB;
    S.a_ready(cur);
    if constexpr (SP2) {
        PG8_STAGE(PG8_SB(0, 0), cB, voffB); PG8_STAGE(PG8_SB(0, 1), cB + hstepB, voffB); PG8_STAGE(PG8_SA(0, 0), cA, voffA); PG8_STAGE(PG8_SA(0, 1), cA + hstepA, voffA);
        if (wr == 1) PG8_BAR;
        PG8_WAIT_V(2); PG8_BAR;
        PG8_STAGE(PG8_SB(1, 0), cB + kstep, voffB); PG8_STAGE(PG8_SA(1, 0), cA + kstep, voffA); PG8_STAGE(PG8_SB(1, 1), cB + hstepB + kstep, voffB);
        PG8_WAIT_V(6); PG8_BAR;
    } else {
        PG8_STAGE(PG8_SB(0, 0), cB, voffB); PG8_STAGE(PG8_SA(0, 0), cA, voffA); PG8_STAGE(PG8_SB(0, 1), cB + hstepB, voffB); PG8_STAGE(PG8_SA(0, 1), cA + hstepA, voffA);
        if (wr == 1) PG8_BAR;
        PG8_WAIT_V(4); PG8_BAR;
        PG8_STAGE(PG8_SB(1, 0), cB + kstep, voffB); PG8_STAGE(PG8_SA(1, 0), cA + kstep, voffA); PG8_STAGE(PG8_SB(1, 1), cB + hstepB + kstep, voffB);
        PG8_WAIT_V(6); PG8_BAR;
    }
    for (;;) {
        const bool has_next = S.next(ui + 1, nxt);
        const char* nA = has_next ? (const char*)g.A + (size_t)nxt.pm * tstepA : cA; const char* nB = has_next ? (const char*)g.Bt + (size_t)nxt.pn * tstepB : cB;
        for (int t = 0; t < nt; t += 2) {
            const bool last = (t == nt - 2);
            const char* a1 = cA + (size_t)(t + 1) * kstep;
            const char* a2 = last ? nA : cA + (size_t)(t + 2) * kstep; const char* b2 = last ? nB : cB + (size_t)(t + 2) * kstep;
            const char* a3 = a2 + kstep; const char* b3 = b2 + kstep;
            if (last && has_next) S.a_ready(nxt);
            if constexpr (SP2) {
            PG8_LDB(B0, 0, 0); PG8_LDB(B1, 0, 1); PG8_SCHED; PG8_LDA(At, 0, 0); PG8_STAGE(PG8_SA(1, 1), a1 + hstepA, voffA);
            PG8_WAIT_V(8); PG8_WAIT_L(0); PG8_BAR; PG8_MMA(0, 0, At, B0); PG8_MMA(0, 1, At, B1); PG8_BAR; PG8_SCHED;
            PG8_LDA(At, 0, 1); PG8_STAGE(PG8_SB(0, 0), b2, voffB); PG8_STAGE(PG8_SB(0, 1), b2 + hstepB, voffB); PG8_STAGE(PG8_SA(0, 0), a2, voffA);
            PG8_WAIT_V(8); PG8_WAIT_L(0); PG8_BAR; PG8_MMA(1, 0, At, B0); PG8_MMA(1, 1, At, B1); PG8_BAR; PG8_SCHED;
            PG8_LDB(B0, 1, 0); PG8_LDB(B1, 1, 1); PG8_SCHED; PG8_LDA(At, 1, 0); PG8_STAGE(PG8_SA(0, 1), a2 + hstepA, voffA);
            PG8_WAIT_V(8); PG8_WAIT_L(0); PG8_BAR; PG8_MMA(0, 0, At, B0); PG8_MMA(0, 1, At, B1); PG8_BAR; PG8_SCHED;
            PG8_LDA(At, 1, 1); PG8_STAGE(PG8_SB(1, 0), b3, voffB); PG8_STAGE(PG8_SB(1, 1), b3 + hstepB, voffB); PG8_STAGE(PG8_SA(1, 0), a3, voffA);
            PG8_WAIT_V(8); PG8_WAIT_L(0); PG8_BAR; PG8_MMA(1, 0, At, B0); PG8_MMA(1, 1, At, B1); PG8_BAR; PG8_SCHED;
            } else {
            PG8_LDB(B0, 0, 0); PG8_SCHED; PG8_LDA(At, 0, 0); PG8_STAGE(PG8_SA(1, 1), a1 + hstepA, voffA);
            PG8_WAIT_L(8); PG8_BAR; PG8_WAIT_L(0); PG8_MMA(0, 0, At, B0); PG8_BAR; PG8_SCHED;
            PG8_LDB(B1, 0, 1); PG8_STAGE(PG8_SB(0, 0), b2, voffB);
            PG8_BAR; PG8_WAIT_L(0); PG8_MMA(0, 1, At, B1); PG8_BAR;
            PG8_LDA(At, 0, 1); PG8_STAGE(PG8_SA(0, 0), a2, voffA);
            PG8_BAR; PG8_WAIT_L(0); PG8_MMA(1, 0, At, B0); PG8_BAR; PG8_SCHED;
            PG8_STAGE(PG8_SB(0, 1), b2 + hstepB, voffB);
            PG8_WAIT_V(6); PG8_BAR; PG8_MMA(1, 1, At, B1); PG8_BAR;
            PG8_LDB(B0, 1, 0); PG8_SCHED; PG8_LDA(At, 1, 0); PG8_STAGE(PG8_SA(0, 1), a2 + hstepA, voffA);
            PG8_WAIT_L(8); PG8_BAR; PG8_WAIT_L(0); PG8_MMA(0, 0, At, B0); PG8_BAR; PG8_SCHED;
            PG8_LDB(B1, 1, 1); PG8_STAGE(PG8_SB(1, 0), b3, voffB);
            PG8_BAR; PG8_WAIT_L(0); PG8_MMA(0, 1, At, B1); PG8_BAR;
            PG8_LDA(At, 1, 1); PG8_STAGE(PG8_SA(1, 0), a3, voffA);
            PG8_BAR; PG8_WAIT_L(0); PG8_MMA(1, 0, At, B0); PG8_BAR; PG8_SCHED;
            PG8_STAGE(PG8_SB(1, 1), b3 + hstepB, voffB);
            PG8_WAIT_V(6); PG8_BAR; PG8_MMA(1, 1, At, B1); PG8_BAR;
            }
        }
        if constexpr (ALIGN_EPI) { if (wr == 0) PG8_BAR; }
        if constexpr (!Epi::AFTER_DRAIN) { E(acc, cur, wr, wc, fr, fq); S.done(cur); }
        if (!has_next) break;
#pragma unroll
        for (int a = 0; a < 2; ++a)
#pragma unroll
            for (int b = 0; b < 2; ++b)
#pragma unroll
                for (int m = 0; m < 4; ++m)
#pragma unroll
                    for (int n = 0; n < 2; ++n) acc[a][b][m][n] = (f32x4){0.f, 0.f, 0.f, 0.f};
        cur = nxt; cA = nA; cB = nB; ++ui;
        if constexpr (ALIGN_EPI) { if (wr == 1) PG8_BAR; }
    }
    PG8_WAIT_V(0);
    if constexpr (!ALIGN_EPI) { if (wr == 0) PG8_BAR; }
    PG8_BAR;
    if constexpr (Epi::AFTER_DRAIN) { E.fused(acc, cur, wr, wc, fr, fq, lds, wid, lane); S.done(cur); }
#undef PG8_SA
#undef PG8_SB
#undef PG8_STAGE
#undef PG8_LDA
#undef PG8_LDB
#undef PG8_MMA
#undef PG8_WAIT_V
#undef PG8_WAIT_L
#undef PG8_BAR
#undef PG8_SCHED
}
}

#ifndef MK_EXP_OLD
#define MK_EXP_OLD 0
#endif
#ifndef MK_ONE_LAUNCH
#define MK_ONE_LAUNCH 1
#endif
#define LAS __attribute__((address_space(3)))
typedef unsigned short bf16;
typedef unsigned v4u __attribute__((ext_vector_type(4)));
typedef unsigned v2u __attribute__((ext_vector_type(2)));
typedef float f32x4 __attribute__((ext_vector_type(4)));
typedef float f32x2 __attribute__((ext_vector_type(2)));
typedef short bf16x8 __attribute__((ext_vector_type(8)));
typedef float f32x16 __attribute__((ext_vector_type(16)));
#define MFMA32(a, b, c) __builtin_amdgcn_mfma_f32_32x32x16_bf16((a), (b), (c), 0, 0, 0)

constexpr int D = 1024, NB = 8, SEQ = 2048, LC = 256, ML = NB * SEQ  , MC = NB * LC  , MT = ML + MC  ;
constexpr int PROJ = 2576, NPROJ = 2560;
constexpr int NEXP = 16384, TOPK = 16, KK = 128;
constexpr float EPS = 1e-6f;
constexpr int NTHREADS = 512, NWAVES = 8;
constexpr int LDS_BYTES = 147456;
constexpr int NPHASES = 15;

constexpr size_t MiB = 1u << 20;
constexpr size_t WS_CTL = 0;
constexpr size_t CTL_ZERO_BYTES = 65536;
constexpr int CW_BAR = 0;
constexpr int CW_E1 = 4096, CW_E2 = 4096 + 8 * 64;
constexpr size_t WS_MOD = 1 * MiB;
constexpr size_t WS_LP = 1 * MiB + 512 * 1024;
constexpr size_t WS_WIN = 2 * MiB;
constexpr size_t WS_WOUT = 8 * MiB;
constexpr size_t WS_WGLU = 10 * MiB;
constexpr size_t WS_WQ = 11 * MiB;
constexpr size_t WS_GB = 15 * MiB;
constexpr size_t WS_BB = 17 * MiB;
constexpr size_t WS_PM = 41 * MiB;
constexpr size_t WS_OG = 17 * MiB;
constexpr size_t WS_HX2 = 17 * MiB;
constexpr size_t WS_U5 = 49 * MiB;
constexpr size_t WS_CAT = 49 * MiB;
constexpr size_t WS_IDX = 49 * MiB;
constexpr size_t WS_GATE = 57 * MiB;
constexpr size_t WS_ACT = 65 * MiB;
constexpr size_t WS_SSQP = 73 * MiB;
constexpr size_t WS_Z = 85 * MiB;
constexpr size_t WS_YRAW = 85 * MiB;
constexpr size_t WS_QP = 85 * MiB;
constexpr size_t WS_Y = 85 * MiB;
constexpr size_t WS_HX = 101 * MiB;
constexpr size_t WS_SS = 101 * MiB;
constexpr size_t WS_YG = 101 * MiB;
constexpr size_t WS_FRT = 125 * MiB;
constexpr size_t WS_QKVPRE = 137 * MiB;
constexpr size_t WS_FRA = 143 * MiB;
constexpr size_t WS_FRK = 161 * MiB;
constexpr size_t WS_FRTAB = 197 * MiB;
constexpr size_t WS_QKV = 202 * MiB;
constexpr size_t WS_U8 = 202 * MiB;
constexpr size_t WS_V8 = 218 * MiB;
constexpr size_t WS_USC = 234 * MiB;
constexpr size_t WS_VSC = 234 * MiB + 512 * 1024;
constexpr size_t WS_HQ8 = 150 * MiB;
constexpr size_t WS_HS = 183 * MiB;
constexpr size_t WS_END = 256 * MiB;
static_assert(WS_BB + (size_t)32 * 512 * 768 * 2 <= WS_PM && WS_PM + (size_t)32 * 256 * 512 * 2 <= WS_U5 && WS_U5 + (size_t)32 * 768 * 768 * 2 <= WS_Z && WS_Z + (size_t)ML * 512 * 2 <= WS_HX, "ws map a");
static_assert(WS_HX + (size_t)MT * D * 2 <= WS_QKVPRE && WS_SS + (size_t)32 * 768 * 256 * 4 <= WS_FRT && WS_QKVPRE + (size_t)MT * 1536 * 2 <= WS_QKV && WS_QKV + (size_t)MT * 1536 * 2 <= WS_END, "ws map b");
static_assert(WS_FRT + (size_t)2304 * 8192 <= WS_FRA && WS_FRA + (size_t)2304 * 8192 <= WS_FRK && WS_FRK + (size_t)2304 * 16384 <= WS_FRTAB && WS_FRTAB + (size_t)2304 * 1024 <= WS_QKV, "ws map c");
static_assert(WS_OG + (size_t)2 * ML * 512 * 2 <= WS_CAT && WS_CAT + (size_t)ML * D * 2 <= WS_Z && WS_YRAW + (size_t)ML * D * 4 <= WS_U8 && WS_SSQP + (size_t)8 * ML * 4 <= WS_Z && WS_YG + (size_t)ML * 512 * 2 <= WS_FRT, "ws map d");

__device__ __forceinline__ unsigned f2bf(float f) { unsigned u = __builtin_bit_cast(unsigned, f); return (u + 0x7fffu + ((u >> 16) & 1u)) >> 16; }
typedef __bf16 bf16x2_t __attribute__((ext_vector_type(2)));
__device__ __forceinline__ unsigned pk2(float lo, float hi) { const f32x2 v = {lo, hi}; return __builtin_bit_cast(unsigned, __builtin_convertvector(v, bf16x2_t)); }
__device__ __forceinline__ float bflo(unsigned w) { return __builtin_bit_cast(float, w << 16); }
__device__ __forceinline__ float bfhi(unsigned w) { return __builtin_bit_cast(float, w & 0xffff0000u); }
__device__ __forceinline__ float bf1(bf16 h) { return __builtin_bit_cast(float, (unsigned)h << 16); }
__device__ __forceinline__ float wave_sum(float v) {
#pragma unroll
    for (int o = 1; o < 64; o <<= 1) v += __shfl_xor(v, o);
    return v;
}
__device__ __forceinline__ float wave_max(float v) {
#pragma unroll
    for (int o = 1; o < 64; o <<= 1) v = fmaxf(v, __shfl_xor(v, o));
    return v;
}
__device__ __forceinline__ float sigmoidf_(float x) { return 1.f / (1.f + __expf(-x)); }
__device__ __forceinline__ float siluf_(float x) { return x / (1.f + __expf(-x)); }
__device__ __forceinline__ float gelu_erf(float x) { return 0.5f * x * (1.f + erff(x * 0.70710678118654752f)); }
__device__ __forceinline__ void sincos_d(double a, float& s, float& c) {
    const double k = rint(a * 0.63661977236758134308);
    const double r = fma(-k, 1.57079632679489661923, a) - k * 6.123233995736766e-17;
    const double r2 = r * r;
    double sp = -2.5052108385441720e-08; sp = sp * r2 + 2.7557319223985893e-06; sp = sp * r2 - 1.9841269841269841e-04; sp = sp * r2 + 8.3333333333333332e-03; sp = sp * r2 - 1.6666666666666666e-01;
    const double sn = r + r * r2 * sp;
    double cp = 2.0876756987868099e-09; cp = cp * r2 - 2.7557319223985888e-07; cp = cp * r2 + 2.4801587301587302e-05; cp = cp * r2 - 1.3888888888888889e-03; cp = cp * r2 + 4.1666666666666664e-02; cp = cp * r2 - 0.5;
    const double cs = 1.0 + r2 * cp;
    const int q = ((int)k) & 3;
    const double ss = (q == 0) ? sn : (q == 1) ? cs : (q == 2) ? -sn : -cs;
    const double cc = (q == 0) ? cs : (q == 1) ? -sn : (q == 2) ? -cs : sn;
    s = (float)ss; c = (float)cc;
}

struct Args { const float* in[29]; float* out; unsigned char* ws; int ph_lo, ph_hi; };
static_assert(sizeof(Args) == 29 * 8 + 8 + 8 + 8, "Args has no padding");
enum { I_X = 0, I_C, I_CTX, I_CCTX, I_WMOD, I_BMOD, I_GPREMIX, I_GPOSTMIX, I_GPREFFN, I_GPOSTFFN, I_WIN, I_WOUT, I_LAMRE, I_LAMIM, I_LOGDT, I_BRE, I_BIM, I_CRE, I_CIM, I_S5D, I_WGLU,
       I_CONV, I_ALOG, I_DTBIAS, I_GDNNORM, I_WQ, I_KEYS, I_PU, I_PV };

__device__ __forceinline__ const float* in_row(const Args& a, int row) { return row < ML ? a.in[I_X] + (size_t)row * D : a.in[I_CTX] + (size_t)(row - ML) * D; }
__device__ __forceinline__ int mod_row(int row) { return row < ML ? (row >> 11) : 8; }

template <int CTRL> __device__ __forceinline__ float dppf(float v) { return __builtin_bit_cast(float, __builtin_amdgcn_update_dpp(0, __builtin_bit_cast(int, v), CTRL, 0xf, 0xf, true)); }
__device__ __forceinline__ float row_sum16(float v) { v += dppf<0xB1>(v); v += dppf<0x4E>(v); v += dppf<0x141>(v); v += dppf<0x140>(v); return v; }
__device__ __forceinline__ float row_max16(float v) { v = fmaxf(v, dppf<0xB1>(v)); v = fmaxf(v, dppf<0x4E>(v)); v = fmaxf(v, dppf<0x141>(v)); v = fmaxf(v, dppf<0x140>(v)); return v; }
__device__ __forceinline__ float wsum(float v) { v = row_sum16(v); return
    __builtin_bit_cast(float, __builtin_amdgcn_readlane(__builtin_bit_cast(int, v), 0)) + __builtin_bit_cast(float, __builtin_amdgcn_readlane(__builtin_bit_cast(int, v), 16)) +
    __builtin_bit_cast(float, __builtin_amdgcn_readlane(__builtin_bit_cast(int, v), 32)) + __builtin_bit_cast(float, __builtin_amdgcn_readlane(__builtin_bit_cast(int, v), 48)); }
__device__ __forceinline__ float wmax(float v) { v = row_max16(v); return fmaxf(fmaxf(__builtin_bit_cast(float, __builtin_amdgcn_readlane(__builtin_bit_cast(int, v), 0)), __builtin_bit_cast(float, __builtin_amdgcn_readlane(__builtin_bit_cast(int, v), 16))),
    fmaxf(__builtin_bit_cast(float, __builtin_amdgcn_readlane(__builtin_bit_cast(int, v), 32)), __builtin_bit_cast(float, __builtin_amdgcn_readlane(__builtin_bit_cast(int, v), 48)))); }
__device__ __forceinline__ int lane_rank(unsigned long long m) { return __builtin_amdgcn_mbcnt_hi((unsigned)(m >> 32), __builtin_amdgcn_mbcnt_lo((unsigned)m, 0)); }
__device__ __forceinline__ unsigned fkey(float f) { const unsigned u = __builtin_bit_cast(unsigned, f); return u ^ ((unsigned)((int)u >> 31) | 0x80000000u); }
#define WAVE_LDS_SYNC() do { __builtin_amdgcn_fence(__ATOMIC_RELEASE, "wavefront"); __builtin_amdgcn_wave_barrier(); __builtin_amdgcn_fence(__ATOMIC_ACQUIRE, "wavefront"); } while (0)
template <int N> __device__ __forceinline__ unsigned kth_key(const unsigned (&k)[N], int K) {
    unsigned T = 0;
    for (int bit = 31; bit >= 0; --bit) { const unsigned cand = T | (1u << bit); int cnt = 0;
#pragma unroll
        for (int n = 0; n < N; ++n) cnt += __popcll(__ballot(k[n] >= cand));
        if (cnt >= K) T = cand;
        if (cnt == K) break; }
    return T;
}

namespace pg8 {
struct EpiInProj {
    static constexpr bool PERM = true, AFTER_DRAIN = false;
    bf16_t* U; bf16_t* QKV; bf16_t* Z;
    __device__ __forceinline__ void operator()(const f32x4 (&acc)[2][2][4][2], const Unit& u, int wr, int wc, int fr, int fq) const {
        bf16_t* base; int ld, colt; bool lat_only = false;
        const bool s5 = u.pn < 2;
        if (s5) { base = U; ld = 0; colt = u.pn * BM; }
        else if (u.pn < 8) { base = QKV; ld = 1536; colt = (u.pn - 2) * BM; }
        else { base = Z; ld = 512; colt = (u.pn - 8) * BM; lat_only = true; }
        const int row0 = u.pm * BM + wr * 64 + fr, col0 = colt + wc * 32 + 8 * fq;
#pragma unroll
        for (int ai = 0; ai < 2; ++ai)
#pragma unroll
            for (int m = 0; m < 4; ++m) { const int row = row0 + ai * HALF + m * 16; bf16_t* rowp = base + (size_t)row * ld + col0;
                if (lat_only && row >= 16384) continue;
                if (s5) { const int R = row < 16384 ? (row >> 5) : 512 + ((row - 16384) >> 5), ii = row & 31; rowp = base + (size_t)R * 768 + ii * 16 + (col0 & 15); }
#pragma unroll
                for (int bj = 0; bj < 2; ++bj) { const f32x4 v0 = acc[ai][bj][m][0], v1 = acc[ai][bj][m][1];
                    u32x4 w; w.x = cvt_pk_bf16(v0[0], v0[1]); w.y = cvt_pk_bf16(v0[2], v0[3]); w.z = cvt_pk_bf16(v1[0], v1[1]); w.w = cvt_pk_bf16(v1[2], v1[3]);
                    if (s5) *(u32x4*)(rowp + (size_t)((col0 + bj * HALF) >> 4) * (768 * 768)) = w; else *(u32x4*)(rowp + bj * HALF) = w; } }
    }
};
struct EpiGlu {
    static constexpr bool PERM = true, AFTER_DRAIN = false;
    const bf16_t* YG; bf16_t* CAT;
    __device__ __forceinline__ void operator()(const f32x4 (&acc)[2][2][4][2], const Unit& u, int wr, int wc, int fr, int fq) const {
        const int row0 = u.pm * BM + wr * 64 + fr, col0 = u.pn * BM + wc * 32 + 8 * fq;
#pragma unroll
        for (int ai = 0; ai < 2; ++ai)
#pragma unroll
            for (int m = 0; m < 4; ++m) { const int row = row0 + ai * HALF + m * 16;
#pragma unroll
                for (int bj = 0; bj < 2; ++bj) { const f32x4 v0 = acc[ai][bj][m][0], v1 = acc[ai][bj][m][1];
                    const u32x4 y = *(const u32x4*)(YG + (size_t)row * 512 + col0 + bj * HALF);
                    float o[8]; const float a[8] = {v0[0], v0[1], v0[2], v0[3], v1[0], v1[1], v1[2], v1[3]};
                    const unsigned yw[4] = {y.x, y.y, y.z, y.w};
#pragma unroll
                    for (int e = 0; e < 8; ++e) { const float yv = __builtin_bit_cast(float, (e & 1) ? (yw[e >> 1] & 0xffff0000u) : (yw[e >> 1] << 16)); o[e] = yv / (1.f + __expf(-a[e])); }
                    u32x4 w; w.x = cvt_pk_bf16(o[0], o[1]); w.y = cvt_pk_bf16(o[2], o[3]); w.z = cvt_pk_bf16(o[4], o[5]); w.w = cvt_pk_bf16(o[6], o[7]);
                    *(u32x4*)(CAT + (size_t)row * 1024 + col0 + bj * HALF) = w; } }
    }
};
struct EpiF32 {
    static constexpr bool PERM = false, AFTER_DRAIN = false;
    float* C; int ldc;
    __device__ __forceinline__ void operator()(const f32x4 (&acc)[2][2][4][2], const Unit& u, int wr, int wc, int fr, int fq) const {
        const int row0 = u.pm * BM + wr * 64 + fr, col0 = u.pn * BM + wc * 32 + 4 * fq;
#pragma unroll
        for (int ai = 0; ai < 2; ++ai)
#pragma unroll
            for (int m = 0; m < 4; ++m) { float* rowp = C + (size_t)(row0 + ai * HALF + m * 16) * ldc + col0;
#pragma unroll
                for (int bj = 0; bj < 2; ++bj)
#pragma unroll
                    for (int n = 0; n < 2; ++n) *(f32x4*)(rowp + bj * HALF + n * 16) = acc[ai][bj][m][n]; }
    }
};
struct EpiSS {
    static constexpr bool PERM = false, AFTER_DRAIN = false;
    float* C;
    __device__ __forceinline__ void operator()(const f32x4 (&acc)[2][2][4][2], const Unit& u, int wr, int wc, int fr, int fq) const {
        const int row0 = u.pm * BM + wr * 64 + fr, col0 = wc * 32 + 4 * fq;
#pragma unroll
        for (int ai = 0; ai < 2; ++ai)
#pragma unroll
            for (int m = 0; m < 4; ++m) { float* rowp = C + (size_t)(row0 + ai * HALF + m * 16) * 256 + col0;
#pragma unroll
                for (int bj = 0; bj < 2; ++bj)
#pragma unroll
                    for (int n = 0; n < 2; ++n) *(f32x4*)(rowp + bj * HALF + n * 16) = acc[ai][bj][m][n]; }
    }
};
struct SchedSS { int G, c; __device__ bool next(int i, Unit& u) const { const int L = i * G + c; if (L >= 96) return false; u.pm = L; u.pn = L / 3; return true; }
    __device__ __forceinline__ void a_ready(const Unit&) const {} __device__ __forceinline__ void done(const Unit&) const {} };
struct EpiS5Y {
    static constexpr bool PERM = true, AFTER_DRAIN = false;
    bf16_t* YG;
    __device__ __forceinline__ void operator()(const f32x4 (&acc)[2][2][4][2], const Unit& u, int wr, int wc, int fr, int fq) const {
        const int g = u.pn >> 1, R0 = (u.pm - 3 * g) * BM + wr * 64 + fr, n0 = (u.pn & 1) * BM + wc * 32 + 8 * fq;
#pragma unroll
        for (int ai = 0; ai < 2; ++ai)
#pragma unroll
            for (int m = 0; m < 4; ++m) { const int R = R0 + ai * HALF + m * 16;
#pragma unroll
                for (int bj = 0; bj < 2; ++bj) { const int n = n0 + bj * HALF; const f32x4 v0 = acc[ai][bj][m][0], v1 = acc[ai][bj][m][1];
                    const f32x2 a = gelu_pk((f32x2){v0[0], v0[1]}), b = gelu_pk((f32x2){v0[2], v0[3]}), c2 = gelu_pk((f32x2){v1[0], v1[1]}), d = gelu_pk((f32x2){v1[2], v1[3]});
                    u32x4 w; w.x = cvt_pk_bf16(a.x, a.y); w.y = cvt_pk_bf16(b.x, b.y); w.z = cvt_pk_bf16(c2.x, c2.y); w.w = cvt_pk_bf16(d.x, d.y);
                    *(u32x4*)(YG + (size_t)(R * 32 + (n >> 4)) * 512 + g * 16 + (n & 15)) = w; } }
    }
};
struct SchedS5Y { int G, c; __device__ bool next(int i, Unit& u) const { const int L = i * G + c; if (L >= 128) return false; const int g = L >> 2; u.pm = 3 * g + ((L >> 1) & 1); u.pn = 2 * g + (L & 1); return true; }
    __device__ __forceinline__ void a_ready(const Unit&) const {} __device__ __forceinline__ void done(const Unit&) const {} };
}

struct Ctx { const Args* a; unsigned char* ws; unsigned char* lds; int tid, lane, wave, bid, G, gw, NGW, gwv; };

__device__ __forceinline__ void p0_transpose_item(const float* W, int ldw, int nblk, int K, bf16* WT, float* scr, int item, int lane) {
    const int kb = item / nblk, nb = item % nblk, k0 = 64 * kb, n0 = 32 * nb;
#pragma unroll 8
    for (int i = 0; i < 32; ++i) { const int kk = 2 * i + (lane >> 5); scr[kk * 33 + (lane & 31)] = W[(size_t)(k0 + kk) * ldw + n0 + (lane & 31)]; }
    __builtin_amdgcn_fence(__ATOMIC_RELEASE, "wavefront"); __builtin_amdgcn_wave_barrier(); __builtin_amdgcn_fence(__ATOMIC_ACQUIRE, "wavefront");
    const int c = lane & 7;
#pragma unroll
    for (int j = 0; j < 4; ++j) { const int n = (lane >> 3) + 8 * j; const float* s = scr + (8 * c) * 33 + n;
        v4u o; o.x = pk2(s[0 * 33], s[1 * 33]); o.y = pk2(s[2 * 33], s[3 * 33]); o.z = pk2(s[4 * 33], s[5 * 33]); o.w = pk2(s[6 * 33], s[7 * 33]);
        *(v4u*)(WT + (size_t)(n0 + n) * K + k0 + 8 * c) = o; }
    __builtin_amdgcn_fence(__ATOMIC_RELEASE, "wavefront"); __builtin_amdgcn_wave_barrier(); __builtin_amdgcn_fence(__ATOMIC_ACQUIRE, "wavefront");
}
__device__ __forceinline__ void phase_prep(const Ctx& c) {
    const Args& a = *c.a;
    float* scr = (float*)(c.lds + c.wave * 16384);
    constexpr int I_IN = 16 * 80, I_OUT = 16 * 32, I_GLU = 8 * 16, I_Q = 16 * 64;
    for (int it = c.gw; it < I_IN + I_OUT + I_GLU + I_Q; it += c.NGW) {
        int r = it;
        if (r < I_IN) { p0_transpose_item(a.in[I_WIN], PROJ, 80, 1024, (bf16*)(c.ws + WS_WIN), scr, r, c.lane); continue; } r -= I_IN;
        if (r < I_OUT) { p0_transpose_item(a.in[I_WOUT], 1024, 32, 1024, (bf16*)(c.ws + WS_WOUT), scr, r, c.lane); continue; } r -= I_OUT;
        if (r < I_GLU) { p0_transpose_item(a.in[I_WGLU], 512, 16, 512, (bf16*)(c.ws + WS_WGLU), scr, r, c.lane); continue; } r -= I_GLU;
        p0_transpose_item(a.in[I_WQ], 2048, 64, 1024, (bf16*)(c.ws + WS_WQ), scr, r, c.lane);
    }
    __syncthreads();
    float* sc = (float*)c.lds;
    float* red = (float*)(c.lds + 9 * 1024 * 4);
    float* MOD = (float*)(c.ws + WS_MOD);
    bool have = false;
    for (int item = c.bid; item < 96; item += c.G) {
        if (!have) { for (int i = c.tid; i < 9 * 1024; i += NTHREADS) { const int r = i >> 10, k = i & 1023; const float v = r < 8 ? a.in[I_C][r * 1024 + k] : a.in[I_CCTX][k]; sc[i] = siluf_(v); } have = true; __syncthreads(); }
        const int n0 = item * 64;
        float acc[9];
#pragma unroll
        for (int r = 0; r < 9; ++r) acc[r] = 0.f;
        const float* wp = a.in[I_WMOD] + (size_t)(c.wave * 128) * 6144 + n0 + c.lane;
#pragma unroll 4
        for (int k = 0; k < 128; ++k) { const float w = wp[(size_t)k * 6144];
#pragma unroll
            for (int r = 0; r < 9; ++r) acc[r] = fmaf(sc[r * 1024 + c.wave * 128 + k], w, acc[r]); }
#pragma unroll
        for (int r = 0; r < 9; ++r) red[(c.wave * 9 + r) * 64 + c.lane] = acc[r];
        __syncthreads();
        for (int i = c.tid; i < 576; i += NTHREADS) { const int r = i >> 6, l = i & 63; float s = a.in[I_BMOD][n0 + l];
#pragma unroll
            for (int w = 0; w < 8; ++w) s += red[(w * 9 + r) * 64 + l];
            MOD[r * 6144 + n0 + l] = s; }
        __syncthreads();
    }
}
__device__ __forceinline__ void s5_build_group(const Ctx& c, int g, int part);
__device__ __forceinline__ void phase_s5_build(const Ctx& c) { for (int it = c.bid; it < 256; it += c.G) s5_build_group(c, it >> 3, it & 7); }

__device__ __forceinline__ void phase_norm1(const Ctx& c) {
    const Args& a = *c.a;
    float* wabT = (float*)c.lds;
    for (int i = c.tid; i < 1024 * 16; i += NTHREADS) { const int k = i >> 4, j = i & 15; wabT[j * 1028 + k] = a.in[I_WIN][(size_t)k * PROJ + NPROJ + j]; }
    __syncthreads();
    const float* MOD = (const float*)(c.ws + WS_MOD);
    bf16* HX = (bf16*)(c.ws + WS_HX); float* GB = (float*)(c.ws + WS_GB);
    const float* gpre = a.in[I_GPREMIX];
    for (int row = c.gw; row < MT; row += c.NGW) {
        const f32x4* xr = (const f32x4*)in_row(a, row) + c.lane;
        const float* mr = MOD + mod_row(row) * 6144;
        f32x4 v[4]; float ss = 0.f;
#pragma unroll
        for (int j = 0; j < 4; ++j) { v[j] = xr[64 * j]; ss += (v[j].x * v[j].x + v[j].y * v[j].y) + (v[j].z * v[j].z + v[j].w * v[j].w); }
        const float r = rsqrtf(wsum(ss) * (1.f / D) + EPS);
#pragma unroll
        for (int j = 0; j < 4; ++j) { const int col = 4 * c.lane + 256 * j;
            const f32x4 g4 = *(const f32x4*)(gpre + col), sh = *(const f32x4*)(mr + col), scl = *(const f32x4*)(mr + 1024 + col);
            v[j] = (v[j] * r) * g4 * (scl + 1.f) + sh;
            v2u o; o.x = pk2(v[j].x, v[j].y); o.y = pk2(v[j].z, v[j].w);
            *(v2u*)(HX + (size_t)row * D + col) = o; }
        float pj[16];
#pragma unroll
        for (int j = 0; j < 16; ++j) { float s = 0.f;
#pragma unroll
            for (int jj = 0; jj < 4; ++jj) { const f32x4 w = *(const f32x4*)(wabT + j * 1028 + 4 * c.lane + 256 * jj); s += (v[jj].x * w.x + v[jj].y * w.y) + (v[jj].z * w.z + v[jj].w * w.w); }
            pj[j] = s; if ((j & 1) == 1) asm volatile("" ::: "memory"); }
        const bool b5 = c.lane & 32, b4 = c.lane & 16, b3 = c.lane & 8, b2 = c.lane & 4;
        float q8[8], q4[4], q2[2];
#pragma unroll
        for (int i = 0; i < 8; ++i) { const float keep = b5 ? pj[i + 8] : pj[i], send = b5 ? pj[i] : pj[i + 8]; q8[i] = keep + __shfl_xor(send, 32); }
#pragma unroll
        for (int i = 0; i < 4; ++i) { const float keep = b4 ? q8[i + 4] : q8[i], send = b4 ? q8[i] : q8[i + 4]; q4[i] = keep + __shfl_xor(send, 16); }
#pragma unroll
        for (int i = 0; i < 2; ++i) { const float keep = b3 ? q4[i + 2] : q4[i], send = b3 ? q4[i] : q4[i + 2]; q2[i] = keep + dppf<0x140>(send); }
        float mine; { const float keep = b2 ? q2[1] : q2[0], send = b2 ? q2[0] : q2[1]; mine = keep + dppf<0x141>(send); }
        mine += dppf<0xB1>(mine); mine += dppf<0x4E>(mine);
        const int jl = (b5 ? 8 : 0) + (b4 ? 4 : 0) + (b3 ? 2 : 0) + (b2 ? 1 : 0);
        if ((c.lane & 3) == 0) {
            if (jl < 8) { const float t = mine + a.in[I_DTBIAS][jl]; const float sp = t > 20.f ? t : log1pf(expf(t)); GB[(size_t)row * 16 + jl] = -expf(a.in[I_ALOG][jl]) * sp; }
            else GB[(size_t)row * 16 + jl] = 1.f / (1.f + expf(-mine)); }
    }
}

__device__ __forceinline__ void phase_conv(const Ctx& c) {
    const Args& a = *c.a;
    const bf16* PRE = (const bf16*)(c.ws + WS_QKVPRE); bf16* OUT = (bf16*)(c.ws + WS_QKV);
    const float* cw = a.in[I_CONV];
#pragma unroll 1
    for (int pass = 0; pass < 3; ++pass) { const int ch0 = pass * 512 + 8 * c.lane;
        f32x4 wt[9][2];
#pragma unroll
        for (int i = 0; i < 9; ++i) { wt[i][0] = *(const f32x4*)(cw + i * 1536 + ch0); wt[i][1] = *(const f32x4*)(cw + i * 1536 + ch0 + 4); }
#pragma unroll 1
        for (int row = c.gw; row < MT; row += c.NGW) {
            int nb_row[9]; bool ok[9];
            if (row < ML) { const int t = row & 2047, gr = t >> 6, gc = t & 63;
#pragma unroll
                for (int dy = -1; dy <= 1; ++dy)
#pragma unroll
                    for (int dx = -1; dx <= 1; ++dx) { const int i = (dy + 1) * 3 + dx + 1; ok[i] = (gr + dy >= 0) && (gr + dy < 32) && (gc + dx >= 0) && (gc + dx < 64); nb_row[i] = row + dy * 64 + dx; } }
            else { const int t = (row - ML) & 255;
#pragma unroll
                for (int i = 0; i < 9; ++i) { ok[i] = false; nb_row[i] = row; }
#pragma unroll
                for (int dx = -1; dx <= 1; ++dx) { ok[4 + dx] = (t + dx >= 0) && (t + dx < 256); nb_row[4 + dx] = row + dx; } }
            v4u in[9];
#pragma unroll
            for (int i = 0; i < 9; ++i) in[i] = ok[i] ? *(const v4u*)(PRE + (size_t)nb_row[i] * 1536 + ch0) : (v4u){0u, 0u, 0u, 0u};
            float o[8];
#pragma unroll
            for (int q = 0; q < 8; ++q) o[q] = 0.f;
#pragma unroll
            for (int i = 0; i < 9; ++i) { const unsigned w[4] = {in[i].x, in[i].y, in[i].z, in[i].w}; const float kk[8] = {wt[i][0].x, wt[i][0].y, wt[i][0].z, wt[i][0].w, wt[i][1].x, wt[i][1].y, wt[i][1].z, wt[i][1].w};
#pragma unroll
                for (int q = 0; q < 4; ++q) { o[2 * q] = fmaf(bflo(w[q]), kk[2 * q], o[2 * q]); o[2 * q + 1] = fmaf(bfhi(w[q]), kk[2 * q + 1], o[2 * q + 1]); } }
            float ssq = 0.f;
#pragma unroll
            for (int q = 0; q < 8; ++q) { o[q] = siluf_(o[q]); ssq = fmaf(o[q], o[q], ssq); }
            if (pass < 2) { const float sc = rsqrtf(row_sum16(ssq) + EPS) * (pass == 0 ? 0.08838834764831845f : 1.f);
#pragma unroll
                for (int q = 0; q < 8; ++q) o[q] *= sc; }
            v4u ov; ov.x = pk2(o[0], o[1]); ov.y = pk2(o[2], o[3]); ov.z = pk2(o[4], o[5]); ov.w = pk2(o[6], o[7]);
            *(v4u*)(OUT + (size_t)row * 1536 + ch0) = ov;
        }
    }
}

__device__ __forceinline__ int scan_row(int b, int dir, int step) {
    if (step < LC) { const int t = dir ? LC - 1 - step : step; return ML + b * LC + t; }
    const int t = step - LC; return b * SEQ + (dir ? SEQ - 1 - t : t);
}
__device__ __forceinline__ void phase_combine(const Ctx& c) {
    const Args& a = *c.a;
    const bf16* OG0 = (const bf16*)(c.ws + WS_OG); const bf16* OG1 = OG0 + (size_t)ML * 512; const bf16* Z = (const bf16*)(c.ws + WS_Z);
    bf16* CAT = (bf16*)(c.ws + WS_CAT);
    for (int row = c.gw; row < ML; row += c.NGW) {
#pragma unroll
        for (int h = 0; h < 4; ++h) { const int ch = h * 128 + 2 * c.lane;
            const unsigned w0 = *(const unsigned*)(OG0 + (size_t)row * 512 + ch), w1 = *(const unsigned*)(OG1 + (size_t)row * 512 + ch), zw = *(const unsigned*)(Z + (size_t)row * 512 + ch);
            const float o0 = bflo(w0) + bflo(w1), o1 = bfhi(w0) + bfhi(w1);
            const float r = rsqrtf(wave_sum(o0 * o0 + o1 * o1) * (1.f / 128.f) + EPS);
            const f32x2 ng = *(const f32x2*)(a.in[I_GDNNORM] + 2 * c.lane);
            *(unsigned*)(CAT + (size_t)row * 1024 + 512 + ch) = pk2(o0 * r * ng.x * siluf_(bflo(zw)), o1 * r * ng.y * siluf_(bfhi(zw))); }
    }
}

__device__ __forceinline__ void phase_rows2(const Ctx& c) {
    const Args& a = *c.a;
    const float* MOD = (const float*)(c.ws + WS_MOD); const float* YRAW = (const float*)(c.ws + WS_YRAW); bf16* HX2 = (bf16*)(c.ws + WS_HX2);
    for (int row = c.gw; row < ML; row += c.NGW) {
        const float* mr = MOD + (row >> 11) * 6144;
        f32x4 y[4], x[4]; float ss = 0.f;
#pragma unroll
        for (int j = 0; j < 4; ++j) { y[j] = *((const f32x4*)(YRAW + (size_t)row * D) + c.lane + 64 * j); x[j] = *((const f32x4*)(a.in[I_X] + (size_t)row * D) + c.lane + 64 * j);
            ss += (y[j].x * y[j].x + y[j].y * y[j].y) + (y[j].z * y[j].z + y[j].w * y[j].w); }
        const float r = rsqrtf(wave_sum(ss) * (1.f / D) + EPS); float s2 = 0.f;
#pragma unroll
        for (int j = 0; j < 4; ++j) { const int col = 4 * c.lane + 256 * j;
            const f32x4 g4 = *(const f32x4*)(a.in[I_GPOSTMIX] + col), gt = *(const f32x4*)(mr + 2048 + col);
            x[j] = x[j] + gt * ((y[j] * r) * g4);
            *(f32x4*)(a.out + (size_t)row * D + col) = x[j];
            s2 += (x[j].x * x[j].x + x[j].y * x[j].y) + (x[j].z * x[j].z + x[j].w * x[j].w); }
        const float r2 = rsqrtf(wave_sum(s2) * (1.f / D) + EPS);
#pragma unroll
        for (int j = 0; j < 4; ++j) { const int col = 4 * c.lane + 256 * j;
            const f32x4 g4 = *(const f32x4*)(a.in[I_GPREFFN] + col), sh = *(const f32x4*)(mr + 3072 + col), scl = *(const f32x4*)(mr + 4096 + col);
            const f32x4 hv = (x[j] * r2) * g4 * (scl + 1.f) + sh;
            v2u o; o.x = pk2(hv.x, hv.y); o.y = pk2(hv.z, hv.w);
            *(v2u*)(HX2 + (size_t)row * D + col) = o;
            x[j] = (f32x4){bflo(o.x), bfhi(o.x), bflo(o.y), bfhi(o.y)}; }
        { float mx = 0.f;
#pragma unroll
          for (int j = 0; j < 4; ++j) mx = fmaxf(mx, fmaxf(fmaxf(fabsf(x[j].x), fabsf(x[j].y)), fmaxf(fabsf(x[j].z), fabsf(x[j].w))));
          mx = wmax(mx); const float hs = mx > 0.f ? 256.f / mx : 1.f;
          unsigned char* hq = c.ws + WS_HQ8 + (size_t)row * 2048;
#pragma unroll
          for (int j = 0; j < 4; ++j) { const float a0 = x[j].x * hs, a1 = x[j].y * hs, a2 = x[j].z * hs, a3 = x[j].w * hs;
              int w = __builtin_amdgcn_cvt_pk_fp8_f32(a0, a1, 0, false); w = __builtin_amdgcn_cvt_pk_fp8_f32(a2, a3, w, true);
              const f32x2 b01 = __builtin_amdgcn_cvt_pk_f32_fp8(w, false), b23 = __builtin_amdgcn_cvt_pk_f32_fp8(w, true);
              int w2 = __builtin_amdgcn_cvt_pk_fp8_f32((a0 - b01.x) * 16.f, (a1 - b01.y) * 16.f, 0, false); w2 = __builtin_amdgcn_cvt_pk_fp8_f32((a2 - b23.x) * 16.f, (a3 - b23.y) * 16.f, w2, true);
              *(unsigned*)(hq + 4 * c.lane + 256 * j) = (unsigned)w; *(unsigned*)(hq + 1024 + 4 * c.lane + 256 * j) = (unsigned)w2; }
          if (c.lane == 0) ((float*)(c.ws + WS_HS))[row] = 1.f / hs; }
    }
}


constexpr int KROW = 136;
__device__ __forceinline__ float unfkey(unsigned k) { const unsigned u = (k & 0x80000000u) ? (k ^ 0x80000000u) : ~k; return __builtin_bit_cast(float, u); }
__device__ __forceinline__ void ins16(unsigned (&L)[16], unsigned key) {
#pragma unroll
    for (int q = 0; q < 16; ++q) { const unsigned hi = L[q] > key ? L[q] : key, lo = L[q] > key ? key : L[q]; L[q] = hi; key = lo; }
}
__device__ __forceinline__ void merge16(unsigned (&L)[16]) {
    unsigned R[16];
#pragma unroll
    for (int q = 0; q < 16; ++q) R[q] = (unsigned)__shfl_xor((int)L[15 - q], 32);
#pragma unroll
    for (int q = 0; q < 16; ++q) L[q] = L[q] > R[q] ? L[q] : R[q];
#pragma unroll
    for (int j = 8; j >= 1; j >>= 1)
#pragma unroll
        for (int q = 0; q < 16; ++q) if ((q & j) == 0) { const unsigned hi = L[q] > L[q + j] ? L[q] : L[q + j], lo = L[q] > L[q + j] ? L[q + j] : L[q]; L[q] = hi; L[q + j] = lo; }
}
__device__ __forceinline__ void phase_topk(const Ctx& c) {
    const Args& a = *c.a;
    bf16* kl = (bf16*)c.lds;
    unsigned char* wtab = c.lds + 2 * 128 * KROW * 2 + c.wave * 1088;
    const bf16* QP = (const bf16*)(c.ws + WS_QP); int* IDX = (int*)(c.ws + WS_IDX); float* GATE = (float*)(c.ws + WS_GATE);
    const int r = c.lane & 31, hh = c.lane >> 5;
    { const unsigned char ptab[50] = {0, 1, 2, 3, 4, 5, 6, 7, 8, 9, 10, 11, 12, 13, 14, 15, 16, 17, 18, 19, 20, 21, 22, 23, 32, 33, 34, 35, 36, 48, 49, 50, 51, 64, 65, 66, 80, 81, 96, 97, 112, 113, 128, 144, 160, 176, 192, 208, 224, 240};
      if (c.lane < 50) wtab[1024 + c.lane] = ptab[c.lane < 50 ? c.lane : 0]; }
    for (int item = c.bid; item < 8 * 32; item += c.G) {
        const int h = item & 7, tr = item >> 3;
        __syncthreads();
        for (int i = c.tid; i < 2 * 128 * 64; i += NTHREADS) { const int k2 = i & 63, n = (i >> 6) & 127, p = i >> 13; const f32x2 kv = *(const f32x2*)(a.in[I_KEYS] + ((size_t)((h * 2 + p) * 128 + n)) * 128 + 2 * k2);
            *(unsigned*)(kl + (p * 128 + n) * KROW + 2 * k2) = pk2(kv.x, kv.y); }
        __syncthreads();
        for (int tile = c.wave; tile < 16; tile += NWAVES) {
            const int tok = tr * 512 + tile * 32 + r;
            unsigned LA[16], LB[16];
#pragma unroll
            for (int p = 0; p < 2; ++p) {
                bf16x8 qf[8];
#pragma unroll
                for (int kk = 0; kk < 8; ++kk) qf[kk] = *(const bf16x8*)(QP + (size_t)tok * 2048 + h * 256 + p * 128 + kk * 16 + hh * 8);
                f32x16 acc[4];
#pragma unroll
                for (int nt = 0; nt < 4; ++nt)
#pragma unroll
                    for (int i = 0; i < 16; ++i) acc[nt][i] = 0.f;
#pragma unroll
                for (int kk = 0; kk < 8; ++kk)
#pragma unroll
                    for (int nt = 0; nt < 4; ++nt) acc[nt] = MFMA32(*(const bf16x8*)(kl + (p * 128 + nt * 32 + r) * KROW + kk * 16 + hh * 8), qf[kk], acc[nt]);
                unsigned (&L)[16] = p ? LB : LA;
#pragma unroll
                for (int q = 0; q < 16; ++q) L[q] = 0u;
#pragma unroll
                for (int nt = 0; nt < 4; ++nt)
#pragma unroll
                    for (int i = 0; i < 16; ++i) { const int n = nt * 32 + (i & 3) + 8 * (i >> 2) + 4 * hh; ins16(L, (fkey(acc[nt][i]) & ~127u) | (unsigned)(127 - n)); }
                merge16(L);
            }
            unsigned char* tt = wtab + r * 32;
            if (hh == 0) {
#pragma unroll
                for (int q = 0; q < 16; ++q) tt[q] = (unsigned char)(127u - (LA[q] & 127u)); }
            else {
#pragma unroll
                for (int q = 0; q < 16; ++q) tt[16 + q] = (unsigned char)(127u - (LB[q] & 127u)); }
            float va[16], vb[16];
#pragma unroll
            for (int q = 0; q < 16; ++q) { va[q] = unfkey(LA[q] & ~127u); vb[q] = unfkey(LB[q] & ~127u); }
            unsigned LC[16];
#pragma unroll
            for (int q = 0; q < 16; ++q) LC[q] = 0u;
            { const float s0 = va[0] + vb[0], s1 = va[0] + vb[1]; ins16(LC, (fkey(hh ? s1 : s0) & ~63u) | (unsigned)(63 - (0 + hh))); }
            { const float s0 = va[0] + vb[2], s1 = va[0] + vb[3]; ins16(LC, (fkey(hh ? s1 : s0) & ~63u) | (unsigned)(63 - (2 + hh))); }
            { const float s0 = va[0] + vb[4], s1 = va[0] + vb[5]; ins16(LC, (fkey(hh ? s1 : s0) & ~63u) | (unsigned)(63 - (4 + hh))); }
            { const float s0 = va[0] + vb[6], s1 = va[0] + vb[7]; ins16(LC, (fkey(hh ? s1 : s0) & ~63u) | (unsigned)(63 - (6 + hh))); }
            { const float s0 = va[0] + vb[8], s1 = va[0] + vb[9]; ins16(LC, (fkey(hh ? s1 : s0) & ~63u) | (unsigned)(63 - (8 + hh))); }
            { const float s0 = va[0] + vb[10], s1 = va[0] + vb[11]; ins16(LC, (fkey(hh ? s1 : s0) & ~63u) | (unsigned)(63 - (10 + hh))); }
            { const float s0 = va[0] + vb[12], s1 = va[0] + vb[13]; ins16(LC, (fkey(hh ? s1 : s0) & ~63u) | (unsigned)(63 - (12 + hh))); }
            { const float s0 = va[0] + vb[14], s1 = va[0] + vb[15]; ins16(LC, (fkey(hh ? s1 : s0) & ~63u) | (unsigned)(63 - (14 + hh))); }
            { const float s0 = va[1] + vb[0], s1 = va[1] + vb[1]; ins16(LC, (fkey(hh ? s1 : s0) & ~63u) | (unsigned)(63 - (16 + hh))); }
            { const float s0 = va[1] + vb[2], s1 = va[1] + vb[3]; ins16(LC, (fkey(hh ? s1 : s0) & ~63u) | (unsigned)(63 - (18 + hh))); }
            { const float s0 = va[1] + vb[4], s1 = va[1] + vb[5]; ins16(LC, (fkey(hh ? s1 : s0) & ~63u) | (unsigned)(63 - (20 + hh))); }
            { const float s0 = va[1] + vb[6], s1 = va[1] + vb[7]; ins16(LC, (fkey(hh ? s1 : s0) & ~63u) | (unsigned)(63 - (22 + hh))); }
            { const float s0 = va[2] + vb[0], s1 = va[2] + vb[1]; ins16(LC, (fkey(hh ? s1 : s0) & ~63u) | (unsigned)(63 - (24 + hh))); }
            { const float s0 = va[2] + vb[2], s1 = va[2] + vb[3]; ins16(LC, (fkey(hh ? s1 : s0) & ~63u) | (unsigned)(63 - (26 + hh))); }
            { const float s0 = va[2] + vb[4], s1 = va[3] + vb[0]; ins16(LC, (fkey(hh ? s1 : s0) & ~63u) | (unsigned)(63 - (28 + hh))); }
            { const float s0 = va[3] + vb[1], s1 = va[3] + vb[2]; ins16(LC, (fkey(hh ? s1 : s0) & ~63u) | (unsigned)(63 - (30 + hh))); }
            { const float s0 = va[3] + vb[3], s1 = va[4] + vb[0]; ins16(LC, (fkey(hh ? s1 : s0) & ~63u) | (unsigned)(63 - (32 + hh))); }
            { const float s0 = va[4] + vb[1], s1 = va[4] + vb[2]; ins16(LC, (fkey(hh ? s1 : s0) & ~63u) | (unsigned)(63 - (34 + hh))); }
            { const float s0 = va[5] + vb[0], s1 = va[5] + vb[1]; ins16(LC, (fkey(hh ? s1 : s0) & ~63u) | (unsigned)(63 - (36 + hh))); }
            { const float s0 = va[6] + vb[0], s1 = va[6] + vb[1]; ins16(LC, (fkey(hh ? s1 : s0) & ~63u) | (unsigned)(63 - (38 + hh))); }
            { const float s0 = va[7] + vb[0], s1 = va[7] + vb[1]; ins16(LC, (fkey(hh ? s1 : s0) & ~63u) | (unsigned)(63 - (40 + hh))); }
            { const float s0 = va[8] + vb[0], s1 = va[9] + vb[0]; ins16(LC, (fkey(hh ? s1 : s0) & ~63u) | (unsigned)(63 - (42 + hh))); }
            { const float s0 = va[10] + vb[0], s1 = va[11] + vb[0]; ins16(LC, (fkey(hh ? s1 : s0) & ~63u) | (unsigned)(63 - (44 + hh))); }
            { const float s0 = va[12] + vb[0], s1 = va[13] + vb[0]; ins16(LC, (fkey(hh ? s1 : s0) & ~63u) | (unsigned)(63 - (46 + hh))); }
            { const float s0 = va[14] + vb[0], s1 = va[15] + vb[0]; ins16(LC, (fkey(hh ? s1 : s0) & ~63u) | (unsigned)(63 - (48 + hh))); }
            merge16(LC);
            WAVE_LDS_SYNC();
            float ev[16]; float den = 0.f; const float mx = unfkey(LC[0] & ~63u);
#pragma unroll
            for (int q = 0; q < 16; ++q) { ev[q] = __expf(unfkey(LC[q] & ~63u) - mx); den += ev[q]; }
            const float inv = 1.f / den;
            if (hh == 0) { int ex[16];
#pragma unroll
                for (int q = 0; q < 16; ++q) { const unsigned pc = wtab[1024 + (63u - (LC[q] & 63u))]; ex[q] = (int)tt[pc >> 4] * 128 + (int)tt[16 + (pc & 15u)]; }
#pragma unroll
                for (int q = 0; q < 4; ++q) *(v4u*)(IDX + (size_t)tok * 128 + h * 16 + 4 * q) = (v4u){(unsigned)ex[4 * q], (unsigned)ex[4 * q + 1], (unsigned)ex[4 * q + 2], (unsigned)ex[4 * q + 3]}; }
            else {
#pragma unroll
                for (int q = 0; q < 4; ++q) *(f32x4*)(GATE + (size_t)tok * 128 + h * 16 + 4 * q) = (f32x4){ev[4 * q] * inv, ev[4 * q + 1] * inv, ev[4 * q + 2] * inv, ev[4 * q + 3] * inv}; }
            WAVE_LDS_SYNC();
        }
    }
}

__device__ __forceinline__ void phase_fp8_tables(const Ctx& c) {
    const Args& a = *c.a;
    for (int r = c.gw; r < 2 * NEXP; r += c.NGW) {
        const bool isv = r >= NEXP; const int e = isv ? r - NEXP : r;
        const f32x4* src = (const f32x4*)((isv ? a.in[I_PV] : a.in[I_PU]) + (size_t)e * D) + 4 * c.lane;
        f32x4 v[4]; float m = 0.f;
#pragma unroll
        for (int j = 0; j < 4; ++j) { v[j] = src[j]; m = fmaxf(m, fmaxf(fmaxf(fabsf(v[j].x), fabsf(v[j].y)), fmaxf(fabsf(v[j].z), fabsf(v[j].w)))); }
        m = wmax(m); const float inv = m > 0.f ? 256.f / m : 0.f;
        v4u o; unsigned ow[4];
#pragma unroll
        for (int j = 0; j < 4; ++j) { int w = __builtin_amdgcn_cvt_pk_fp8_f32(v[j].x * inv, v[j].y * inv, 0, false); w = __builtin_amdgcn_cvt_pk_fp8_f32(v[j].z * inv, v[j].w * inv, w, true); ow[j] = (unsigned)w; }
        o.x = ow[0]; o.y = ow[1]; o.z = ow[2]; o.w = ow[3];
        *(v4u*)(c.ws + (isv ? WS_V8 : WS_U8) + (size_t)e * D + 16 * c.lane) = o;
        if (c.lane == 0) ((float*)(c.ws + (isv ? WS_VSC : WS_USC)))[e] = m * (1.f / 256.f);
    }
}
__device__ __forceinline__ void fp8x16_to_f32(const v4u& r, float (&f)[16]) {
    const unsigned w[4] = {r.x, r.y, r.z, r.w};
#pragma unroll
    for (int j = 0; j < 4; ++j) { const f32x2 lo = __builtin_amdgcn_cvt_pk_f32_fp8((int)w[j], false), hi = __builtin_amdgcn_cvt_pk_f32_fp8((int)w[j], true); f[4 * j] = lo.x; f[4 * j + 1] = lo.y; f[4 * j + 2] = hi.x; f[4 * j + 3] = hi.y; }
}
__device__ __forceinline__ unsigned xcc_id() { return (unsigned)__builtin_amdgcn_s_getreg((3 << 11) | 20) & 7u; }

typedef long l64x2 __attribute__((ext_vector_type(2)));
struct E1Grp { l64x2 rw[16]; int e; float usc, vsc, gate; };
__device__ __forceinline__ void phase_exp1(const Ctx& c) {
    typedef float f32x4m __attribute__((ext_vector_type(4)));
    const int* IDX = (const int*)(c.ws + WS_IDX); const float* GATE = (const float*)(c.ws + WS_GATE); const float* HS = (const float*)(c.ws + WS_HS);
    const unsigned char* U8 = c.ws + WS_U8; const float* USC = (const float*)(c.ws + WS_USC); const float* VSC = (const float*)(c.ws + WS_VSC); float* ACT = (float*)(c.ws + WS_ACT);
    constexpr int CH = 4, TS = 2080, HLS = 1040;
    unsigned char* wl = c.lds + c.wave * 12800; int* le = (int*)wl; unsigned char* hq = wl + 4096; float* res = (float*)(wl + 4096 + CH * TS);
    const int r16 = c.lane & 15, g4 = c.lane >> 4; const bool bcol = r16 < 2;
    for (int item = c.gw; item < ML / CH; item += c.NGW) {
        const int t0 = item * CH;
        { v4u im[CH][2]; v4u ei[2];
#pragma unroll
          for (int tau = 0; tau < CH; ++tau) { const unsigned char* ip = c.ws + WS_HQ8 + ((size_t)t0 + tau) * 2048 + 16 * c.lane; im[tau][0] = *(const v4u*)ip; im[tau][1] = *(const v4u*)(ip + 1024); }
          ei[0] = *(const v4u*)(IDX + (size_t)t0 * 128 + 4 * c.lane); ei[1] = *(const v4u*)(IDX + (size_t)t0 * 128 + 256 + 4 * c.lane);
#pragma unroll
          for (int tau = 0; tau < CH; ++tau) { *(v4u*)(hq + tau * TS + 16 * c.lane) = im[tau][0]; *(v4u*)(hq + tau * TS + HLS + 16 * c.lane) = im[tau][1]; }
          *(v4u*)(le + 4 * c.lane) = ei[0]; *(v4u*)(le + 256 + 4 * c.lane) = ei[1];
          if (c.lane < CH) res[16 + c.lane] = HS[(size_t)t0 + c.lane]; }
        WAVE_LDS_SYNC();
#define E1_LOAD(G, J0) do { { const int j = ((J0) < CH * 128 ? (J0) : 0) + r16; G.e = le[j]; G.usc = USC[G.e]; G.vsc = VSC[G.e]; G.gate = GATE[(size_t)t0 * 128 + j]; \
              const unsigned char* rowp = U8 + (size_t)G.e * D + 16 * g4; _Pragma("unroll") for (int jj = 0; jj < 16; ++jj) G.rw[jj] = *(const l64x2*)(rowp + 64 * jj); } } while (0)
#define E1_COMP(G, J0) do { const unsigned char* hb = hq + ((J0) >> 7) * TS + (r16 & 1) * HLS + 16 * g4; const float hinv = res[16 + ((J0) >> 7)]; \
            f32x4m acc = {0.f, 0.f, 0.f, 0.f}; _Pragma("unroll") for (int jj = 0; jj < 16; ++jj) { \
                const long bq0 = *(const long*)(hb + 64 * jj), bq1 = *(const long*)(hb + 64 * jj + 8); \
                acc = __builtin_amdgcn_mfma_f32_16x16x32_fp8_fp8(G.rw[jj].x, bcol ? bq0 : 0l, acc, 0, 0, 0); acc = __builtin_amdgcn_mfma_f32_16x16x32_fp8_fp8(G.rw[jj].y, bcol ? bq1 : 0l, acc, 0, 0, 0); } \
            _Pragma("unroll") for (int q = 0; q < 4; ++q) { const float lo = dppf<0xB1>(acc[q]); if (r16 == 0) res[4 * g4 + q] = (acc[q] + lo * 0.0625f) * hinv; } \
            WAVE_LDS_SYNC(); \
            if (c.lane < 16) ACT[(size_t)t0 * 128 + (J0) + c.lane] = gelu_erf(res[c.lane] * G.usc) * G.gate * G.vsc; \
            WAVE_LDS_SYNC(); } while (0)
        E1Grp ga, gb;
        E1_LOAD(ga, 0);
#pragma unroll 1
        for (int j0 = 0; j0 < CH * 128; j0 += 32) {
            E1_LOAD(gb, j0 + 16);
            __builtin_amdgcn_sched_barrier(0);
            E1_COMP(ga, j0);
            __builtin_amdgcn_sched_barrier(0);
            E1_LOAD(ga, j0 + 32);
            __builtin_amdgcn_sched_barrier(0);
            E1_COMP(gb, j0 + 16);
            __builtin_amdgcn_sched_barrier(0);
        }
#undef E1_LOAD
#undef E1_COMP
        WAVE_LDS_SYNC();
    }
}
__device__ __forceinline__ void phase_exp2(const Ctx& c) {
    const int* IDX = (const int*)(c.ws + WS_IDX); const float* ACT = (const float*)(c.ws + WS_ACT); const unsigned char* V8 = c.ws + WS_V8;
    float* Y = (float*)(c.ws + WS_Y); float* SSQP = (float*)(c.ws + WS_SSQP);
    unsigned* cnt = (unsigned*)(c.ws + WS_CTL) + CW_E2;
    int* li = (int*)(c.lds + c.wave * 1024); float* la = (float*)(li + 128);
    const int xcc = (int)xcc_id(), sub = c.lane & 7, grp = c.lane >> 3;
    const bool b5 = c.lane & 32, b4 = c.lane & 16, b3 = c.lane & 8;
    constexpr int CH = 8;
    int bo = 0, t = 0, tend = 0;
    int iA = 0, iB = 0; float aA = 0.f, aB = 0.f;
    for (;;) {
        if (t >= tend) {
            unsigned t0 = 0; if (c.lane == 0) t0 = __hip_atomic_fetch_add(cnt + 64 * ((xcc + bo) & 7), (unsigned)CH, __ATOMIC_RELAXED, __HIP_MEMORY_SCOPE_AGENT);
            t0 = (unsigned)__builtin_amdgcn_readfirstlane((int)t0);
            if (t0 >= (unsigned)ML) { if (++bo >= 8) break; continue; }
            t = (int)t0; tend = t + CH;
            iA = IDX[(size_t)t * 128 + c.lane]; iB = IDX[(size_t)t * 128 + 64 + c.lane]; aA = ACT[(size_t)t * 128 + c.lane]; aB = ACT[(size_t)t * 128 + 64 + c.lane];
        }
        const int x = (xcc + bo) & 7;
        li[c.lane] = iA; li[64 + c.lane] = iB; la[c.lane] = aA; la[64 + c.lane] = aB;
        if (t + 1 < tend) { iA = IDX[(size_t)(t + 1) * 128 + c.lane]; iB = IDX[(size_t)(t + 1) * 128 + 64 + c.lane]; aA = ACT[(size_t)(t + 1) * 128 + c.lane]; aB = ACT[(size_t)(t + 1) * 128 + 64 + c.lane]; }
        WAVE_LDS_SYNC();
        float acc[16];
#pragma unroll
        for (int q = 0; q < 16; ++q) acc[q] = 0.f;
#pragma unroll
        for (int hf = 0; hf < 2; ++hf) { v4u rows[8]; float av[8];
#pragma unroll
            for (int i = 0; i < 8; ++i) { const int k = 8 * (8 * hf + i) + grp; rows[i] = *(const v4u*)(V8 + (size_t)li[k] * D + x * 128 + 16 * sub); av[i] = la[k]; }
#pragma unroll
            for (int i = 0; i < 8; ++i) { float f[16]; fp8x16_to_f32(rows[i], f);
#pragma unroll
                for (int q = 0; q < 16; ++q) acc[q] = fmaf(av[i], f[q], acc[q]); } }
        float q8[8], q4[4], q2[2];
#pragma unroll
        for (int i = 0; i < 8; ++i) { const float keep = b5 ? acc[i + 8] : acc[i], send = b5 ? acc[i] : acc[i + 8]; q8[i] = keep + __shfl_xor(send, 32); }
#pragma unroll
        for (int i = 0; i < 4; ++i) { const float keep = b4 ? q8[i + 4] : q8[i], send = b4 ? q8[i] : q8[i + 4]; q4[i] = keep + __shfl_xor(send, 16); }
#pragma unroll
        for (int i = 0; i < 2; ++i) { const float keep = b3 ? q4[i + 2] : q4[i], send = b3 ? q4[i] : q4[i + 2]; q2[i] = keep + __shfl_xor(send, 8); }
        const int col = x * 128 + 16 * sub + (b5 ? 8 : 0) + (b4 ? 4 : 0) + (b3 ? 2 : 0);
        *(f32x2*)(Y + (size_t)t * D + col) = (f32x2){q2[0], q2[1]};
        const float ss = wsum(q2[0] * q2[0] + q2[1] * q2[1]);
        SSQP[(size_t)x * ML + t] = ss;
        WAVE_LDS_SYNC();
        ++t;
    }
}
__device__ __forceinline__ void phase_exp3(const Ctx& c) {
    const Args& a = *c.a;
    const float* MOD = (const float*)(c.ws + WS_MOD); const float* Y = (const float*)(c.ws + WS_Y); const float* SSQP = (const float*)(c.ws + WS_SSQP);
    for (int row = c.gw; row < ML; row += c.NGW) {
        float ss = 0.f;
#pragma unroll
        for (int x = 0; x < 8; ++x) ss += SSQP[(size_t)x * ML + row];
        const float r = rsqrtf(ss * (1.f / D) + EPS); const float* mr = MOD + (row >> 11) * 6144 + 5120;
#pragma unroll
        for (int j = 0; j < 4; ++j) { const int col = 4 * c.lane + 256 * j;
            const f32x4 y = *(const f32x4*)(Y + (size_t)row * D + col), x1 = *(const f32x4*)(a.out + (size_t)row * D + col), g4 = *(const f32x4*)(a.in[I_GPOSTFFN] + col), gt = *(const f32x4*)(mr + col);
            *(f32x4*)(a.out + (size_t)row * D + col) = x1 + gt * ((y * r) * g4); }
    }
}

__device__ __forceinline__ void phase_experts(const Ctx& c) {
    const Args& a = *c.a;
    const float* MOD = (const float*)(c.ws + WS_MOD); const bf16* HX2 = (const bf16*)(c.ws + WS_HX2); const int* IDX = (const int*)(c.ws + WS_IDX); const float* GATE = (const float*)(c.ws + WS_GATE);
    float* acts = (float*)c.lds; int* eid = (int*)(c.lds + 512); float* red = (float*)(c.lds + 1024);
    for (int tok = c.bid; tok < ML; tok += c.G) {
        float hv[16];
#pragma unroll
        for (int j = 0; j < 4; ++j) { const v2u w = *(const v2u*)(HX2 + (size_t)tok * D + 4 * c.lane + 256 * j); hv[4 * j] = bflo(w.x); hv[4 * j + 1] = bfhi(w.x); hv[4 * j + 2] = bflo(w.y); hv[4 * j + 3] = bfhi(w.y); }
#pragma unroll 4
        for (int i = 0; i < 16; ++i) { const int k = c.wave * 16 + i; const int e = IDX[(size_t)tok * 128 + k];
            const f32x4* ur = (const f32x4*)(a.in[I_PU] + (size_t)e * D) + c.lane; float s = 0.f;
#pragma unroll
            for (int j = 0; j < 4; ++j) { const f32x4 u4 = ur[64 * j]; s += (u4.x * hv[4 * j] + u4.y * hv[4 * j + 1]) + (u4.z * hv[4 * j + 2] + u4.w * hv[4 * j + 3]); }
            s = wave_sum(s);
            if (c.lane == 0) { acts[k] = gelu_erf(s) * GATE[(size_t)tok * 128 + k]; eid[k] = e; } }
        __syncthreads();
        f32x2 acc = (f32x2){0.f, 0.f};
#pragma unroll 8
        for (int k = 0; k < 128; ++k) { const f32x2 v2 = *(const f32x2*)(a.in[I_PV] + (size_t)eid[k] * D + 2 * c.tid); const float ak = acts[k]; acc.x = fmaf(ak, v2.x, acc.x); acc.y = fmaf(ak, v2.y, acc.y); }
        const float ws = wave_sum(acc.x * acc.x + acc.y * acc.y);
        if (c.lane == 0) red[c.wave] = ws;
        __syncthreads();
        float tot = 0.f;
#pragma unroll
        for (int w = 0; w < 8; ++w) tot += red[w];
        const float r = rsqrtf(tot * (1.f / D) + EPS);
        const int col = 2 * c.tid; const float* mr = MOD + (tok >> 11) * 6144 + 5120;
        const f32x2 x1 = *(const f32x2*)(a.out + (size_t)tok * D + col), g2 = *(const f32x2*)(a.in[I_GPOSTFFN] + col), gt = *(const f32x2*)(mr + col);
        *(f32x2*)(a.out + (size_t)tok * D + col) = (f32x2){x1.x + gt.x * (acc.x * r * g2.x), x1.y + gt.y * (acc.y * r * g2.y)};
        __syncthreads();
    }
}


constexpr int S5_LPOW = 0, S5_BBAR = 33792, S5_CC = 50176, S5_MM = 66560;
__device__ __forceinline__ void s5_build_group(const Ctx& c, int g, int part) {
    const Args& a = *c.a;
    f32x2* LPOW = (f32x2*)(c.lds + S5_LPOW);
    f32x2* BBAR = (f32x2*)(c.lds + S5_BBAR);
    f32x2* CC = (f32x2*)(c.lds + S5_CC);
    float* MM = (float*)(c.lds + S5_MM);
    __syncthreads();
    if (c.tid < 128) { const int dir = c.tid >> 6, p = c.tid & 63, dg = dir * 32 + g;
        const float dt = expf(a.in[I_LOGDT][dg]), lr = a.in[I_LAMRE][dg * 64 + p], li = a.in[I_LAMIM][dg * 64 + p];
        const double ang = (double)li * (double)dt; const float lrdt = lr * dt;
        for (int e = 0; e <= 32; ++e) { float sn, cs; sincos_d(ang * (double)e, sn, cs); const float mg = expf(lrdt * (float)e); LPOW[(dir * 33 + e) * 64 + p] = (f32x2){mg * cs, mg * sn}; }
        float sn, cs; sincos_d(ang, sn, cs); const float mag = expf(lrdt), lbr = mag * cs, lbi = mag * sn, den = lr * lr + li * li, nr = lbr - 1.f;
        const float cr = (nr * lr + lbi * li) / den, ci = (lbi * lr - nr * li) / den;
        for (int ch = 0; ch < 16; ++ch) { const float br = a.in[I_BRE][(size_t)(dg * 64 + p) * 16 + ch], bi = a.in[I_BIM][(size_t)(dg * 64 + p) * 16 + ch]; BBAR[(dir * 64 + p) * 16 + ch] = (f32x2){cr * br - ci * bi, cr * bi + ci * br}; } }
    for (int i = c.tid; i < 2048; i += NTHREADS) { const int dir = i >> 10, ch = (i >> 6) & 15, p = i & 63, dg = dir * 32 + g; CC[i] = (f32x2){a.in[I_CRE][(size_t)(dg * 16 + ch) * 64 + p], a.in[I_CIM][(size_t)(dg * 16 + ch) * 64 + p]}; }
    __syncthreads();
    for (int task = c.tid; task < 1024; task += NTHREADS) { const int cpb = task & 3, cb = (task >> 2) & 3, lag = (task >> 4) & 31, dir = task >> 9;
        float acc[4][4];
#pragma unroll
        for (int i = 0; i < 4; ++i)
#pragma unroll
            for (int j = 0; j < 4; ++j) acc[i][j] = 0.f;
        for (int p = 0; p < 64; ++p) { const f32x2 l = LPOW[(dir * 33 + lag) * 64 + p]; f32x2 G[4], Cw[4];
#pragma unroll
            for (int j = 0; j < 4; ++j) { const f32x2 bb = BBAR[(dir * 64 + p) * 16 + 4 * cpb + j]; G[j] = (f32x2){l.x * bb.x - l.y * bb.y, l.x * bb.y + l.y * bb.x}; }
#pragma unroll
            for (int i = 0; i < 4; ++i) Cw[i] = CC[(dir * 16 + 4 * cb + i) * 64 + p];
#pragma unroll
            for (int i = 0; i < 4; ++i)
#pragma unroll
                for (int j = 0; j < 4; ++j) acc[i][j] += Cw[i].x * G[j].x - Cw[i].y * G[j].y; }
#pragma unroll
        for (int i = 0; i < 4; ++i)
#pragma unroll
            for (int j = 0; j < 4; ++j) MM[((dir * 32 + lag) * 16 + 4 * cb + i) * 16 + 4 * cpb + j] = acc[i][j]; }
    __syncthreads();
    if (c.tid < 128 && part == 0) { const int dir = c.tid >> 6, p = c.tid & 63; ((f32x2*)(c.ws + WS_LP))[(dir * 32 + g) * 64 + p] = LPOW[(dir * 33 + 32) * 64 + p]; }
    bf16* PMg = (bf16*)(c.ws + WS_PM) + (size_t)g * 256 * 512; bf16* BBg = (bf16*)(c.ws + WS_BB) + (size_t)g * 512 * 768;
    for (int task = part * 32 * 32 + c.tid; task < (part + 1) * 32 * 32; task += NTHREADS) { const int ip = task & 31, n = task >> 5, dir = n >> 7, im = (n >> 6) & 1, p = n & 63, e = dir ? ip : 31 - ip;
        const f32x2 l = LPOW[(dir * 33 + e) * 64 + p]; float o[16];
#pragma unroll
        for (int ch = 0; ch < 16; ++ch) { const f32x2 bb = BBAR[(dir * 64 + p) * 16 + ch]; o[ch] = im ? (l.x * bb.y + l.y * bb.x) : (l.x * bb.x - l.y * bb.y); }
        v4u w0, w1; w0.x = pk2(o[0], o[1]); w0.y = pk2(o[2], o[3]); w0.z = pk2(o[4], o[5]); w0.w = pk2(o[6], o[7]); w1.x = pk2(o[8], o[9]); w1.y = pk2(o[10], o[11]); w1.z = pk2(o[12], o[13]); w1.w = pk2(o[14], o[15]);
        *(v4u*)(PMg + (size_t)n * 512 + ip * 16) = w0; *(v4u*)(PMg + (size_t)n * 512 + ip * 16 + 8) = w1; }
    for (int task = part * 64 * 32 + c.tid; task < (part + 1) * 64 * 32; task += NTHREADS) { const int ip = task & 31, n = task >> 5, i = n >> 4, ch = n & 15; float o[16];
#pragma unroll
        for (int q = 0; q < 16; ++q) o[q] = 0.f;
        if (ip <= i) { const float* m0 = MM + ((0 * 32 + (i - ip)) * 16 + ch) * 16;
#pragma unroll
            for (int q = 0; q < 16; ++q) o[q] += m0[q]; }
        if (ip >= i) { const float* m1 = MM + ((1 * 32 + (ip - i)) * 16 + ch) * 16;
#pragma unroll
            for (int q = 0; q < 16; ++q) o[q] += m1[q]; }
        if (ip == i) { const float dsk = a.in[I_S5D][g * 16 + ch];
#pragma unroll
            for (int q = 0; q < 16; ++q) o[q] += (q == ch) ? dsk : 0.f; }
        v4u w0, w1; w0.x = pk2(o[0], o[1]); w0.y = pk2(o[2], o[3]); w0.z = pk2(o[4], o[5]); w0.w = pk2(o[6], o[7]); w1.x = pk2(o[8], o[9]); w1.y = pk2(o[10], o[11]); w1.z = pk2(o[12], o[13]); w1.w = pk2(o[14], o[15]);
        *(v4u*)(BBg + (size_t)n * 768 + ip * 16) = w0; *(v4u*)(BBg + (size_t)n * 768 + ip * 16 + 8) = w1; }
    for (int task = part * 64 * 32 + c.tid; task < (part + 1) * 64 * 32; task += NTHREADS) { const int p8 = task & 7, part = (task >> 3) & 3, n = task >> 5, i = n >> 4, ch = n & 15, dir = part >> 1, im = part & 1, e = dir ? 32 - i : i + 1; float o[8];
#pragma unroll
        for (int q = 0; q < 8; ++q) { const int p = p8 * 8 + q; const f32x2 l = LPOW[(dir * 33 + e) * 64 + p], cc = CC[(dir * 16 + ch) * 64 + p]; o[q] = im ? -(cc.x * l.y + cc.y * l.x) : (cc.x * l.x - cc.y * l.y); }
        v4u w0; w0.x = pk2(o[0], o[1]); w0.y = pk2(o[2], o[3]); w0.z = pk2(o[4], o[5]); w0.w = pk2(o[6], o[7]);
        *(v4u*)(BBg + (size_t)n * 768 + 512 + part * 64 + p8 * 8) = w0; }
}
__device__ __forceinline__ void s5_state_scan(const Ctx& c, int task) {
    const int dir = task & 1, g = (task >> 1) & 31, b = task >> 6, p = c.lane;
    const f32x2 a = ((const f32x2*)(c.ws + WS_LP))[(dir * 32 + g) * 64 + p];
    const float* SS = (const float*)(c.ws + WS_SS) + (size_t)g * 768 * 256 + dir * 128 + p; bf16* U5 = (bf16*)(c.ws + WS_U5) + (size_t)g * 768 * 768 + 512 + dir * 128 + p;
    float er = 0.f, ei = 0.f;
#pragma unroll 8
    for (int step = 0; step < 72; ++step) {
        const int R = (step < 8) ? 512 + b * 8 + (dir ? 7 - step : step) : b * 64 + (dir ? 71 - step : step - 8);
        if (step >= 8) { U5[(size_t)R * 768] = (bf16)f2bf(er); U5[(size_t)R * 768 + 64] = (bf16)f2bf(ei); }
        const float sr = SS[(size_t)R * 256], si = SS[(size_t)R * 256 + 64];
        const float nr = sr + a.x * er - a.y * ei, ni = si + a.x * ei + a.y * er; er = nr; ei = ni;
    }
}

constexpr int GDN_NCH = 36, GDN_ITEMS = NB * 4 * 2 * GDN_NCH;
constexpr size_t FR_T_BYTES = 8192, FR_ATT_BYTES = 8192, FR_KD_BYTES = 16384, FR_TAB_BYTES = 1024;
__device__ __forceinline__ int crow16(int i, int hh) { return (i & 3) + 8 * (i >> 2) + 4 * hh; }
__device__ __forceinline__ bf16x8 pack_step(const f32x16& x, int s) {
    v4u w; w.x = pk2(x[8 * s + 0], x[8 * s + 1]); w.y = pk2(x[8 * s + 2], x[8 * s + 3]); w.z = pk2(x[8 * s + 4], x[8 * s + 5]); w.w = pk2(x[8 * s + 6], x[8 * s + 7]);
    return __builtin_bit_cast(bf16x8, w);
}
__device__ __forceinline__ unsigned pk2v(float lo, float hi) { asm volatile("" : "+v"(lo), "+v"(hi)); return pk2(lo, hi); }
__device__ __forceinline__ bf16x8 pack_step_v(const f32x16& x, int s) {
    v4u w; w.x = pk2v(x[8 * s + 0], x[8 * s + 1]); w.y = pk2v(x[8 * s + 2], x[8 * s + 3]); w.z = pk2v(x[8 * s + 4], x[8 * s + 5]); w.w = pk2v(x[8 * s + 6], x[8 * s + 7]);
    return __builtin_bit_cast(bf16x8, w);
}
constexpr int GP_KR = 0, GP_QR = 17408, GP_KT = 34816, GP_TAB = 53248, GP_LP = 54272, GP_LPB = 8448 + 256;
__host__ __device__ constexpr int LOFF(int i) { return i < 1 ? 0 : 4 * (((i - 1) >> 2) + 1) * (2 * ((i - 1) >> 2) + ((i - 1) & 3)); }
static_assert(LOFF(1) == 0 && LOFF(2) == 4 && LOFF(5) == 16 && LOFF(6) == 24 && LOFF(64) == 2112, "packed lower-triangular row offsets");
__device__ __forceinline__ void gdn_prep_stage(const Ctx& c, int item, float* Lp) {
    const int n = item % GDN_NCH, bhd = item / GDN_NCH, dir = bhd & 1, h = (bhd >> 1) & 3, b = bhd >> 3;
    const bf16* QKV = (const bf16*)(c.ws + WS_QKV); const float* GB = (const float*)(c.ws + WS_GB);
    bf16* Kr = (bf16*)(c.lds + GP_KR); bf16* Qr = (bf16*)(c.lds + GP_QR); bf16* Kt = (bf16*)(c.lds + GP_KT); float* tab = (float*)(c.lds + GP_TAB);
    unsigned char* frA = c.ws + WS_FRA + (size_t)item * FR_ATT_BYTES; unsigned char* frK = c.ws + WS_FRK + (size_t)item * FR_KD_BYTES; float* frTab = (float*)(c.ws + WS_FRTAB + (size_t)item * FR_TAB_BYTES);
    const int r = c.lane & 31, hh = c.lane >> 5;
    if (c.wave == 0) { const int row = scan_row(b, dir, n * 64 + c.lane); float g = GB[(size_t)row * 16 + dir * 4 + h]; const float beta = GB[(size_t)row * 16 + 8 + dir * 4 + h];
#pragma unroll
        for (int o = 1; o < 64; o <<= 1) { const float t = __shfl_up(g, o); if (c.lane >= o) g += t; }
        const float gl = __shfl(g, 63);
        tab[c.lane] = g; tab[64 + c.lane] = beta; tab[128 + c.lane] = __expf(g); tab[192 + c.lane] = __expf(gl - g); }
    { const int s = c.tid >> 3, seg = c.tid & 7; const int row = scan_row(b, dir, n * 64 + s); const bf16* rp = QKV + (size_t)row * 1536 + h * 128 + seg * 16;
      const v4u q0 = *(const v4u*)rp, q1 = *(const v4u*)(rp + 8), k0 = *(const v4u*)(rp + 512), k1 = *(const v4u*)(rp + 520);
      *(v4u*)(Qr + s * 136 + seg * 16) = q0; *(v4u*)(Qr + s * 136 + seg * 16 + 8) = q1; *(v4u*)(Kr + s * 136 + seg * 16) = k0; *(v4u*)(Kr + s * 136 + seg * 16 + 8) = k1;
      const unsigned kw[8] = {k0.x, k0.y, k0.z, k0.w, k1.x, k1.y, k1.z, k1.w};
#pragma unroll
      for (int e = 0; e < 8; ++e) { Kt[(seg * 16 + 2 * e) * 72 + s] = (bf16)(kw[e] & 0xffffu); Kt[(seg * 16 + 2 * e + 1) * 72 + s] = (bf16)(kw[e] >> 16); } }
    __syncthreads();
    if (c.wave < 3) { const int ct = c.wave ? 1 : 0, st = c.wave == 2 ? 1 : 0;
        f32x16 acc;
#pragma unroll
        for (int i = 0; i < 16; ++i) acc[i] = 0.f;
#pragma unroll
        for (int kk = 0; kk < 8; ++kk) { const bf16x8 a = *(const bf16x8*)(Kr + (ct * 32 + r) * 136 + kk * 16 + hh * 8), bb = *(const bf16x8*)(Kr + (st * 32 + r) * 136 + kk * 16 + hh * 8); acc = MFMA32(a, bb, acc); }
        const int s = st * 32 + r; const float gcs = tab[s];
#pragma unroll
        for (int i = 0; i < 16; ++i) { const int cc = ct * 32 + crow16(i, hh); if (s < cc) Lp[LOFF(cc) + s] = tab[64 + cc] * acc[i] * __expf(tab[cc] - gcs); }
    } else if (c.wave < 6) { const int w = c.wave - 3, st = w == 2 ? 1 : 0, ct = w ? 1 : 0;
        f32x16 acc;
#pragma unroll
        for (int i = 0; i < 16; ++i) acc[i] = 0.f;
#pragma unroll
        for (int kk = 0; kk < 8; ++kk) { const bf16x8 a = *(const bf16x8*)(Kr + (st * 32 + r) * 136 + kk * 16 + hh * 8), bb = *(const bf16x8*)(Qr + (ct * 32 + r) * 136 + kk * 16 + hh * 8); acc = MFMA32(a, bb, acc); }
        const int cc = ct * 32 + r; const float gcc = tab[cc];
#pragma unroll
        for (int i = 0; i < 16; ++i) { const int s = st * 32 + crow16(i, hh); acc[i] = (s <= cc) ? acc[i] * __expf(gcc - tab[s]) : 0.f; }
        *(bf16x8*)(frA + ((size_t)((ct * 4 + 2 * st) * 64 + c.lane)) * 16) = pack_step(acc, 0);
        *(bf16x8*)(frA + ((size_t)((ct * 4 + 2 * st + 1) * 64 + c.lane)) * 16) = pack_step(acc, 1);
    } else { const int w = c.wave - 6;
#pragma unroll
        for (int f = 0; f < 8; ++f) { const int fi = w * 8 + f, dkt = fi >> 2, cb = fi & 3; const bf16* kp = Kt + (dkt * 32 + r) * 72 + 16 * cb + 4 * hh;
            const v2u lo = *(const v2u*)kp, hi = *(const v2u*)(kp + 8); const f32x4 e0 = *(const f32x4*)(tab + 192 + 16 * cb + 4 * hh), e1 = *(const f32x4*)(tab + 192 + 16 * cb + 8 + 4 * hh);
            v4u o; o.x = pk2(bflo(lo.x) * e0.x, bfhi(lo.x) * e0.y); o.y = pk2(bflo(lo.y) * e0.z, bfhi(lo.y) * e0.w); o.z = pk2(bflo(hi.x) * e1.x, bfhi(hi.x) * e1.y); o.w = pk2(bflo(hi.y) * e1.z, bfhi(hi.y) * e1.w);
            *(v4u*)(frK + ((size_t)(fi * 64 + c.lane)) * 16) = o; }
        if (w == 0) { const v4u z = (v4u){0u, 0u, 0u, 0u}; *(v4u*)(frA + ((size_t)((0 * 4 + 2) * 64 + c.lane)) * 16) = z; *(v4u*)(frA + ((size_t)((0 * 4 + 3) * 64 + c.lane)) * 16) = z; }
        else { *(f32x4*)(frTab + 4 * c.lane) = *(const f32x4*)(tab + 4 * c.lane); }
    }
    __syncthreads();
}
__device__ __forceinline__ void gdn_prep_solve(const Ctx& c, int item, float* Lp) {
    float Tr[64];
#pragma unroll
    for (int i = 0; i < 64; ++i) { int le_ = c.lane; asm volatile("" : "+v"(le_)); float a0 = (le_ == i) ? 1.f : 0.f, a1 = 0.f;
#pragma unroll
        for (int s4 = 0; s4 < (i + 3) / 4; ++s4) { const f32x4 l4 = *(const f32x4*)(Lp + LOFF(i) + 4 * s4);
            if (4 * s4 + 0 < i) a0 = fmaf(-l4.x, Tr[4 * s4 + 0], a0); if (4 * s4 + 1 < i) a1 = fmaf(-l4.y, Tr[4 * s4 + 1], a1); if (4 * s4 + 2 < i) a0 = fmaf(-l4.z, Tr[4 * s4 + 2], a0); if (4 * s4 + 3 < i) a1 = fmaf(-l4.w, Tr[4 * s4 + 3], a1); }
        Tr[i] = a0 + a1; { int lo_ = c.lane; asm volatile("" : "+v"(lo_)); Lp[(lo_ < i) ? LOFF(i) + lo_ : 2112 + lo_] = Tr[i]; } }
    WAVE_LDS_SYNC();
    unsigned char* frT = c.ws + WS_FRT + (size_t)item * FR_T_BYTES;
    const int r = c.lane & 31, hh = c.lane >> 5;
#pragma unroll
    for (int f = 0; f < 8; ++f) { const int ct = f >> 2, sb = f & 3, cc = ct * 32 + r; float v[8];
#pragma unroll
        for (int q = 0; q < 2; ++q) { const int s0 = 16 * sb + 8 * q + 4 * hh;
            f32x4 t4 = (f32x4){0.f, 0.f, 0.f, 0.f}; if (s0 < cc) t4 = *(const f32x4*)(Lp + LOFF(cc) + s0);
            v[4 * q + 0] = (s0 + 0 < cc) ? t4.x : (s0 + 0 == cc ? 1.f : 0.f); v[4 * q + 1] = (s0 + 1 < cc) ? t4.y : (s0 + 1 == cc ? 1.f : 0.f);
            v[4 * q + 2] = (s0 + 2 < cc) ? t4.z : (s0 + 2 == cc ? 1.f : 0.f); v[4 * q + 3] = (s0 + 3 < cc) ? t4.w : (s0 + 3 == cc ? 1.f : 0.f); }
        *(v4u*)(frT + ((size_t)(f * 64 + c.lane)) * 16) = (v4u){pk2(v[0], v[1]), pk2(v[2], v[3]), pk2(v[4], v[5]), pk2(v[6], v[7])}; }
}
__device__ __forceinline__ void phase_gdn_prep(const Ctx& c) {
    for (int base = c.bid; base < GDN_ITEMS; base += 8 * c.G) {
        int cnt = 0;
#pragma unroll 1
        for (int q = 0; q < 8; ++q) { const int item = base + q * c.G; if (item < GDN_ITEMS) { gdn_prep_stage(c, item, (float*)(c.lds + GP_LP + q * GP_LPB)); cnt = q + 1; } }
        if (c.wave < cnt) gdn_prep_solve(c, base + c.wave * c.G, (float*)(c.lds + GP_LP + c.wave * GP_LPB));
        __syncthreads();
    }
}

constexpr int GR_K = 0, GR_Q = 16384, GR_T = 32768, GR_A = 40960, GR_KD = 49152, GR_TAB = 65536, GR_BUF = 66560;
__device__ __forceinline__ void gdn_rec_stage(const Ctx& c, int bhd, int n, int buf) {
    const int dir = bhd & 1, h = (bhd >> 1) & 3, b = bhd >> 3, lw = c.wave - 4; const int item = bhd * GDN_NCH + n;
    LAS unsigned char* base = (LAS unsigned char*)c.lds + buf * GR_BUF;
    const unsigned char* QKVb = c.ws + WS_QKV;
#pragma unroll
    for (int q = 0; q < 4; ++q) { const int qi = lw + 4 * q;
        const int s = 4 * qi + (c.lane >> 4), ps = c.lane & 15, p = ps ^ (s & 15); const size_t rowb = (size_t)scan_row(b, dir, n * 64 + s) * 3072 + (size_t)h * 256 + p * 16;
        __builtin_amdgcn_global_load_lds((const unsigned*)(QKVb + rowb + 1024), (LAS unsigned*)(base + GR_K + qi * 1024), 16, 0, 0);
        __builtin_amdgcn_global_load_lds((const unsigned*)(QKVb + rowb), (LAS unsigned*)(base + GR_Q + qi * 1024), 16, 0, 0); }
    const unsigned char* frT = c.ws + WS_FRT + (size_t)item * FR_T_BYTES; const unsigned char* frA = c.ws + WS_FRA + (size_t)item * FR_ATT_BYTES; const unsigned char* frK = c.ws + WS_FRK + (size_t)item * FR_KD_BYTES;
#pragma unroll
    for (int q = 0; q < 2; ++q) { const int qi = lw + 4 * q;
        __builtin_amdgcn_global_load_lds((const unsigned*)(frT + qi * 1024 + c.lane * 16), (LAS unsigned*)(base + GR_T + qi * 1024), 16, 0, 0);
        __builtin_amdgcn_global_load_lds((const unsigned*)(frA + qi * 1024 + c.lane * 16), (LAS unsigned*)(base + GR_A + qi * 1024), 16, 0, 0); }
#pragma unroll
    for (int q = 0; q < 4; ++q) { const int qi = lw + 4 * q;
        __builtin_amdgcn_global_load_lds((const unsigned*)(frK + qi * 1024 + c.lane * 16), (LAS unsigned*)(base + GR_KD + qi * 1024), 16, 0, 0); }
    if (lw == 0) __builtin_amdgcn_global_load_lds((const unsigned*)(c.ws + WS_FRTAB + (size_t)item * FR_TAB_BYTES + c.lane * 16), (LAS unsigned*)(base + GR_TAB), 16, 0, 0);
}
__device__ __forceinline__ bf16x8 gr_rowfrag(const unsigned char* tile, int row, int kb, int hh) {
    const unsigned char* rp = tile + row * 256; const int sw = row & 15;
    const v2u lo = *(const v2u*)(rp + (((2 * kb) ^ sw) * 16) + 8 * hh), hi = *(const v2u*)(rp + (((2 * kb + 1) ^ sw) * 16) + 8 * hh);
    return __builtin_bit_cast(bf16x8, (v4u){lo.x, lo.y, hi.x, hi.y});
}
__device__ __forceinline__ void gdn_rec_block(const Ctx& c, int bhd) {
    const int dir = bhd & 1, h = (bhd >> 1) & 3, b = bhd >> 3, r = c.lane & 31, hh = c.lane >> 5, dvt = c.wave;
    const bf16* QKV = (const bf16*)(c.ws + WS_QKV); bf16* OG = (bf16*)(c.ws + WS_OG) + (size_t)dir * ML * 512;
    f32x16 S[4];
#pragma unroll
    for (int t = 0; t < 4; ++t)
#pragma unroll
        for (int i = 0; i < 16; ++i) S[t][i] = 0.f;
    if (c.wave >= 4) gdn_rec_stage(c, bhd, 0, 0);
    asm volatile("s_waitcnt vmcnt(0)" ::: "memory"); __syncthreads();
    for (int n = 0; n < GDN_NCH; ++n) {
        const int buf = n & 1;
        if (c.wave >= 4) { if (n + 1 < GDN_NCH) gdn_rec_stage(c, bhd, n + 1, buf ^ 1); }
        else {
            const unsigned char* base = c.lds + buf * GR_BUF; const float* tab = (const float*)(base + GR_TAB);
            const int row0 = scan_row(b, dir, n * 64), sgn = dir ? -1 : 1;
            const bf16* vcol = QKV + (size_t)row0 * 1536 + 1024 + h * 128 + dvt * 32 + r + (ptrdiff_t)(sgn * 4 * hh) * 1536;
            bf16* ocol = OG + (size_t)row0 * 512 + h * 128 + dvt * 32 + r + (ptrdiff_t)(sgn * 4 * hh) * 512;
            const ptrdiff_t vst = (ptrdiff_t)sgn * 1536, ost = (ptrdiff_t)sgn * 512;
            bf16 vraw[2][16];
#pragma unroll
            for (int st = 0; st < 2; ++st)
#pragma unroll
                for (int i = 0; i < 16; ++i) vraw[st][i] = vcol[vst * (st * 32 + (i & 3) + 8 * (i >> 2))];
            bf16x8 Rf[2][2];
#pragma unroll
            for (int st = 0; st < 2; ++st) { f32x16 acc;
#pragma unroll
                for (int i = 0; i < 16; ++i) acc[i] = 0.f;
#pragma unroll
                for (int kb = 0; kb < 8; ++kb) acc = MFMA32(gr_rowfrag(base + GR_K, st * 32 + r, kb, hh), pack_step_v(S[kb >> 1], kb & 1), acc);
#pragma unroll
                for (int i = 0; i < 16; ++i) { const int s = st * 32 + crow16(i, hh); acc[i] = tab[64 + s] * (bf1(vraw[st][i]) - tab[128 + s] * acc[i]); }
                Rf[st][0] = pack_step(acc, 0); Rf[st][1] = pack_step(acc, 1); asm volatile("" ::: "memory"); }
            bf16x8 Vf[2][2];
#pragma unroll
            for (int ct = 0; ct < 2; ++ct) { f32x16 acc;
#pragma unroll
                for (int i = 0; i < 16; ++i) acc[i] = 0.f;
#pragma unroll
                for (int sb = 0; sb < 4; ++sb) if (sb < 2 * ct + 2) acc = MFMA32(*(const bf16x8*)(base + GR_T + ((ct * 4 + sb) * 64 + c.lane) * 16), Rf[sb >> 1][sb & 1], acc);
                Vf[ct][0] = pack_step(acc, 0); Vf[ct][1] = pack_step(acc, 1); }
            asm volatile("" ::: "memory");
#pragma unroll
            for (int ct = 0; ct < 2; ++ct) { f32x16 acc;
#pragma unroll
                for (int i = 0; i < 16; ++i) acc[i] = 0.f;
#pragma unroll
                for (int kb = 0; kb < 8; ++kb) acc = MFMA32(gr_rowfrag(base + GR_Q, ct * 32 + r, kb, hh), pack_step_v(S[kb >> 1], kb & 1), acc);
#pragma unroll
                for (int i = 0; i < 16; ++i) acc[i] *= tab[128 + ct * 32 + crow16(i, hh)];
#pragma unroll
                for (int cb = 0; cb < 4; ++cb) if (cb < 2 * ct + 2) acc = MFMA32(*(const bf16x8*)(base + GR_A + ((ct * 4 + cb) * 64 + c.lane) * 16), Vf[cb >> 1][cb & 1], acc);
                if (n >= 4) {
#pragma unroll
                    for (int i = 0; i < 16; ++i) ocol[ost * (ct * 32 + (i & 3) + 8 * (i >> 2))] = (bf16)f2bf(acc[i]); }
                asm volatile("" ::: "memory"); }
            const float gtot = tab[128 + 63];
#pragma unroll
            for (int t = 0; t < 4; ++t) {
#pragma unroll
                for (int i = 0; i < 16; ++i) S[t][i] *= gtot;
#pragma unroll
                for (int cb = 0; cb < 4; ++cb) S[t] = MFMA32(*(const bf16x8*)(base + GR_KD + ((t * 4 + cb) * 64 + c.lane) * 16), Vf[cb >> 1][cb & 1], S[t]); }
        }
        if (c.wave >= 4) asm volatile("s_waitcnt vmcnt(0)" ::: "memory"); else asm volatile("s_waitcnt lgkmcnt(0)" ::: "memory");
        __builtin_amdgcn_s_barrier(); asm volatile("" ::: "memory");
    }
    asm volatile("s_waitcnt vmcnt(0)" ::: "memory"); __syncthreads();
}
__device__ __forceinline__ void phase_gdn_rec(const Ctx& c) { for (int bhd = c.bid; bhd < 64; bhd += 64) gdn_rec_block(c, bhd); }

#define XB_TMO      128
#define XB_XCNT(j)  (256  + 64 * (j))
#define XB_XSUB(j)  (1280 + 64 * (j))
#define XB_XGEN(j)  (2304 + 64 * (j))
#define XB_TOP      3328
#define XB_TOPGEN   3392
#define XCD_BAR_WORDS 3456
#define XB_SPIN_CAP (1u << 20)
__device__ __forceinline__ unsigned xb_ld(unsigned* p)              { return __hip_atomic_load(p, __ATOMIC_RELAXED, __HIP_MEMORY_SCOPE_AGENT); }
__device__ __forceinline__ unsigned xb_add(unsigned* p, unsigned v) { return __hip_atomic_fetch_add(p, v, __ATOMIC_RELAXED, __HIP_MEMORY_SCOPE_AGENT); }
__device__ __forceinline__ unsigned xb_xcc_id() { return (unsigned)__builtin_amdgcn_s_getreg((3 << 11) | 20) & 0xFu; }
#define XB_SPIN(cond, bar) do { unsigned _sp = 0; while (cond) { __builtin_amdgcn_s_sleep(1); \
    if ((++_sp & 255u) == 0u) { if (xb_ld(&(bar)[XB_TMO])) break; if (_sp > XB_SPIN_CAP) { atomicAdd(&(bar)[XB_TMO], 1u); break; } } } } while (0)
struct XcdBarrier { unsigned* bar; unsigned x; volatile LAS unsigned* st; };
__device__ __forceinline__ XcdBarrier xcd_barrier_post(unsigned* bar, volatile LAS unsigned* st) {
    XcdBarrier b; b.bar = bar; b.x = xb_xcc_id(); b.st = st;
    if (threadIdx.x == 0) (void)xb_add(&bar[XB_XCNT(b.x)], 1u);
    return b;
}
__device__ __forceinline__ void xcd_barrier_complete(unsigned* bar, unsigned x, unsigned& nloc, unsigned& nx) {
    const unsigned G = gridDim.x * gridDim.y * gridDim.z;
    unsigned sum, cnt, mine, sp = 0u;
    for (;;) {
        sum = 0u; cnt = 0u; mine = 0u;
#pragma unroll
        for (unsigned j = 0; j < 16; ++j) { const unsigned c = xb_ld(&bar[XB_XCNT(j)]); sum += c; cnt += (c > 0u) ? 1u : 0u; mine = (j == x) ? c : mine; }
        if (sum == G) break;
        __builtin_amdgcn_s_sleep(1);
        if ((++sp & 255u) == 0u) { if (xb_ld(&bar[XB_TMO])) break; if (sp > XB_SPIN_CAP) { atomicAdd(&bar[XB_TMO], 1u); break; } }
    }
    nloc = mine > 0u ? mine : 1u; nx = cnt > 0u ? cnt : 1u;
}
__device__ __forceinline__ void xcd_barrier(const XcdBarrier& b) {
    asm volatile("s_waitcnt vmcnt(0)" ::: "memory");
    __syncthreads();
    if (threadIdx.x == 0) {
        unsigned* bar = b.bar;
        __builtin_amdgcn_s_waitcnt(0);
        unsigned nloc = b.st[0], nx = b.st[1];
        if (nloc == 0u) { xcd_barrier_complete(bar, b.x, nloc, nx); b.st[0] = nloc; b.st[1] = nx; }
        const unsigned old = xb_add(&bar[XB_XSUB(b.x)], 1u);
        const unsigned gen = old / nloc;
        if (old + 1u == (gen + 1u) * nloc) {
            __builtin_amdgcn_fence(__ATOMIC_RELEASE, "agent");
            asm volatile("s_waitcnt vmcnt(0)" ::: "memory");
            const unsigned og = xb_add(&bar[XB_TOP], 1u);
            const unsigned tg = og / nx;
            if (og + 1u == (tg + 1u) * nx) xb_add(&bar[XB_TOPGEN], 1u);
            else XB_SPIN(xb_ld(&bar[XB_TOPGEN]) == tg, bar);
            __builtin_amdgcn_fence(__ATOMIC_ACQUIRE, "agent");
            xb_add(&bar[XB_XGEN(b.x)], 1u);
            asm volatile("s_waitcnt vmcnt(0)" ::: "memory");
        } else {
            XB_SPIN(xb_ld(&bar[XB_XGEN(b.x)]) == gen, bar);
            __builtin_amdgcn_fence(__ATOMIC_ACQUIRE, "agent");
            asm volatile("s_waitcnt vmcnt(0)" ::: "memory");
        }
    }
    __syncthreads();
}

constexpr int LDS_MISC = LDS_BYTES - 64;
__global__ void __launch_bounds__(NTHREADS, 2) mk_fwd(Args args) {
    extern __shared__ __attribute__((aligned(16))) unsigned char lds[];
    Ctx c; c.a = &args; c.ws = args.ws; c.lds = lds;
    c.tid = threadIdx.x; c.lane = c.tid & 63; c.wave = __builtin_amdgcn_readfirstlane(c.tid >> 6); c.bid = blockIdx.x; c.G = gridDim.x;
    c.gw = c.bid * NWAVES + c.wave; c.NGW = c.G * NWAVES; c.gwv = c.wave * c.G + c.bid;
    const int lo = args.ph_lo, hi = args.ph_hi;
    PG8_LAS unsigned char* ring = (PG8_LAS unsigned char*)lds;
#ifndef MK_PH_MASK
#define MK_PH_MASK 0xffff
#endif
#define IN(k) (((MK_PH_MASK >> (k)) & 1) && lo <= (k) && (k) < hi)
#if MK_ONE_LAUNCH
    cg::grid_group grid = cg::this_grid();
    if (lo < 0) grid.sync();
    volatile LAS unsigned* st = (volatile LAS unsigned*)((LAS unsigned char*)lds + LDS_MISC);
    if (c.tid < 2) st[c.tid] = 0u;
    __syncthreads();
    const XcdBarrier bar = xcd_barrier_post((unsigned*)(c.ws + WS_CTL) + CW_BAR, st);
#define SEAM(k) do { if (IN(k) && IN((k) + 1)) xcd_barrier(bar); } while (0)
#else
#define SEAM(k) do { } while (0)
#endif
    if (IN(0)) { phase_prep(c); phase_s5_build(c); } SEAM(0);
    if (IN(1)) { phase_norm1(c); } SEAM(1);
    if (IN(2)) { pg8::Gemm g{(const pg8::bf16_t*)(c.ws + WS_HX), (const pg8::bf16_t*)(c.ws + WS_WIN), 1024, 1024, 1024}; pg8::StaticOrder S; S.init(MT, NPROJ, c.G, c.bid);
        pg8::EpiInProj E{(pg8::bf16_t*)(c.ws + WS_U5), (pg8::bf16_t*)(c.ws + WS_QKVPRE), (pg8::bf16_t*)(c.ws + WS_Z)};
        pg8::gemm_phase<pg8::EpiInProj, pg8::StaticOrder, true, true>(ring, g, S, E); } SEAM(2);
    if (IN(3)) { { pg8::Gemm g{(const pg8::bf16_t*)(c.ws + WS_U5), (const pg8::bf16_t*)(c.ws + WS_PM), 768, 512, 512}; pg8::SchedSS S{c.G, c.bid}; pg8::EpiSS E{(float*)(c.ws + WS_SS)};
          pg8::gemm_phase<pg8::EpiSS, pg8::SchedSS, true, true>(ring, g, S, E); }
        __syncthreads(); phase_conv(c); } SEAM(3);
    if (IN(4)) { if (c.wave < 2) s5_state_scan(c, c.bid + c.G * c.wave < 512 ? c.bid + c.G * c.wave : 0); __syncthreads(); phase_gdn_prep(c); } SEAM(4);
    if (IN(5)) { pg8::Gemm g{(const pg8::bf16_t*)(c.ws + WS_U5), (const pg8::bf16_t*)(c.ws + WS_BB), 768, 768, 768}; pg8::SchedS5Y S{c.G, c.bid}; pg8::EpiS5Y E{(pg8::bf16_t*)(c.ws + WS_YG)};
        pg8::gemm_phase<pg8::EpiS5Y, pg8::SchedS5Y, true, true>(ring, g, S, E); } SEAM(5);
    if (IN(6)) { if (c.bid < 64) phase_gdn_rec(c);
        else { pg8::Gemm g{(const pg8::bf16_t*)(c.ws + WS_YG), (const pg8::bf16_t*)(c.ws + WS_WGLU), 512, 512, 512}; pg8::StaticOrder S; S.init(ML, 512, c.G - 64, c.bid - 64);
            pg8::EpiGlu E{(const pg8::bf16_t*)(c.ws + WS_YG), (pg8::bf16_t*)(c.ws + WS_CAT)};
            pg8::gemm_phase<pg8::EpiGlu, pg8::StaticOrder, true, true>(ring, g, S, E); } } SEAM(6);
    if (IN(7)) { phase_combine(c); } SEAM(7);
    if (IN(8)) { pg8::Gemm g{(const pg8::bf16_t*)(c.ws + WS_CAT), (const pg8::bf16_t*)(c.ws + WS_WOUT), 1024, 1024, 1024}; pg8::StaticOrder S; S.init(ML, 1024, c.G, c.bid);
        pg8::EpiF32 E{(float*)(c.ws + WS_YRAW), 1024};
        pg8::gemm_phase<pg8::EpiF32, pg8::StaticOrder, true, true>(ring, g, S, E); } SEAM(8);
    if (IN(9)) { phase_rows2(c); phase_fp8_tables(c); } SEAM(9);
    if (IN(10)) { pg8::Gemm g{(const pg8::bf16_t*)(c.ws + WS_HX2), (const pg8::bf16_t*)(c.ws + WS_WQ), 1024, 1024, 1024}; pg8::StaticOrder S; S.init(ML, 2048, c.G, c.bid);
        pg8::EpiBf16<0> E{(pg8::bf16_t*)(c.ws + WS_QP), 2048, nullptr, 0, 0, 1.f};
        pg8::gemm_phase<pg8::EpiBf16<0>, pg8::StaticOrder, true, true>(ring, g, S, E); } SEAM(10);
    if (IN(11)) { phase_topk(c); } SEAM(11);
    if (IN(12)) { phase_exp1(c); } SEAM(12);
    if (IN(13)) { phase_exp2(c); } SEAM(13);
    if (IN(14)) { phase_exp3(c); }
#undef IN
#undef SEAM
}

extern "C" void kernel_launch(void* const* d_in, const int* in_sizes, int n_in, void* d_out, int out_size, void* d_ws, size_t ws_size, hipStream_t stream) {
    static int grid = 0;
    if (grid == 0) {
        if (n_in != 29 || out_size != ML * D || ws_size < WS_END) { fprintf(stderr, "kernel_launch: unexpected shapes (n_in %d out %d ws %zu)\n", n_in, out_size, ws_size); grid = -1; return; }
        int dev = 0, cus = 0, per_cu = 0;
        (void)hipGetDevice(&dev); (void)hipDeviceGetAttribute(&cus, hipDeviceAttributeMultiprocessorCount, dev);
        if (hipFuncSetAttribute((const void*)mk_fwd, hipFuncAttributeMaxDynamicSharedMemorySize, LDS_BYTES) != hipSuccess) { fprintf(stderr, "kernel_launch: hipFuncSetAttribute failed\n"); grid = -1; return; }
        (void)hipOccupancyMaxActiveBlocksPerMultiprocessor(&per_cu, (const void*)mk_fwd, NTHREADS, LDS_BYTES);
        (void)hipGetLastError();
        grid = cus;
        fprintf(stderr, "kernel_launch: cus %d per_cu %d grid %d\n", cus, per_cu, grid);
    }
    if (grid < 0) return;
    Args a{};
    for (int i = 0; i < 29; ++i) a.in[i] = (const float*)d_in[i];
    a.out = (float*)d_out; a.ws = (unsigned char*)d_ws;
    (void)hipMemsetAsync((char*)d_ws + WS_CTL, 0, CTL_ZERO_BYTES, stream);
#if MK_ONE_LAUNCH
    a.ph_lo = 0; a.ph_hi = NPHASES;
    void* kargs[] = {&a};
    hipError_t e = hipLaunchCooperativeKernel((const void*)mk_fwd, dim3(grid), dim3(NTHREADS), kargs, LDS_BYTES, stream);
    if (e != hipSuccess) fprintf(stderr, "kernel_launch: cooperative launch failed: %s\n", hipGetErrorString(e));
#else
    for (int ph = 0; ph < NPHASES; ++ph) { a.ph_lo = ph; a.ph_hi = ph + 1; hipLaunchKernelGGL(mk_fwd, dim3(grid), dim3(NTHREADS), LDS_BYTES, stream, a); }
#endif
}
```

```cpp
#include <hip/hip_runtime.h>
#include <hip/hip_cooperative_groups.h>
#include <cstdio>
#include <cstdint>
namespace cg = cooperative_groups;
namespace pg8 {
#define PG8_LAS __attribute__((address_space(3)))
typedef unsigned short bf16_t;
typedef short bf16x8 __attribute__((ext_vector_type(8)));
typedef float f32x4 __attribute__((ext_vector_type(4)));
typedef unsigned u32x4 __attribute__((ext_vector_type(4)));
constexpr int BM = 256, BK = 64, HALF = 128, HTB = HALF * BK * 2  , STAGE_BYTES = 8 * HTB, NXCD = 8, WGM = 8;

__host__ __device__ __forceinline__ int lds_byte(int r, int c) { const int st = (r >> 4) * 2 + (c >> 5), rr = r & 15, cc = c & 31, ob = rr * 64 + cc * 2; return st * 1024 + (ob ^ (((ob >> 9) & 1) << 5)); }
__host__ __device__ __forceinline__ void stage_rc(int b, int& R, int& C) { const int st = b / 1024, sb = b % 1024, swz = sb ^ (((sb >> 9) & 1) << 5); R = (st >> 1) * 16 + swz / 64; C = (st & 1) * 32 + (swz % 64) / 2; }
__host__ __device__ __forceinline__ int perm32(int rho) { const int n = rho >> 4, i = rho & 15; return 8 * (i >> 2) + 4 * n + (i & 3); }

struct Unit { int pm, pn; };
struct Gemm { const bf16_t* A; const bf16_t* Bt; int lda, ldb, K; };

struct StaticOrder {
    int nM, nN, nwg, G, c;
    __host__ __device__ void init(int M, int N, int G_, int c_) { nM = M / BM; nN = N / BM; nwg = nM * nN; G = G_; c = c_; }
    __host__ __device__ bool next(int i, Unit& u) const {
        const long L = (long)i * G + c; if (L >= nwg) return false;
        int wgid = (int)L; { const int q = nwg / NXCD, r = nwg % NXCD, xcd = wgid % NXCD, off = wgid / NXCD; wgid = (xcd < r ? xcd * (q + 1) : r * (q + 1) + (xcd - r) * q) + off; }
        const int nig = WGM * nN, gid = wgid / nig, fm = gid * WGM, gsz = (nM - fm) < WGM ? (nM - fm) : WGM;
        u.pm = fm + ((wgid % nig) % gsz); u.pn = (wgid % nig) / gsz; return true;
    }
    __device__ __forceinline__ void a_ready(const Unit&) const {}
    __device__ __forceinline__ void done(const Unit&) const {}
};

__device__ __forceinline__ unsigned cvt_pk_bf16(float lo, float hi) { unsigned r; asm volatile("v_cvt_pk_bf16_f32 %0, %1, %2" : "=v"(r) : "v"(lo), "v"(hi)); return r; }
typedef float f32x2 __attribute__((ext_vector_type(2)));
__device__ __forceinline__ f32x2 gelu_pk(f32x2 v) {
    const f32x2 av = __builtin_elementwise_abs(v), d = av * 0.2316418882f + 1.0f;
    f32x2 t; t.x = __builtin_amdgcn_rcpf(d.x); t.y = __builtin_amdgcn_rcpf(d.y);
    f32x2 q = t * 0.5307027145f + (-0.7265760135f); q = q * t + 0.7107068705f; q = q * t + (-0.142248368f); q = q * t + 0.127414796f; q = q * t;
    const f32x2 s = (v * v) * (-0.72134752044f);
    f32x2 e; e.x = __builtin_amdgcn_exp2f(s.x); e.y = __builtin_amdgcn_exp2f(s.y);
    const f32x2 m = v * (q * e), r = v - m;
    f32x2 o; o.x = v.x < 0.f ? m.x : r.x; o.y = v.y < 0.f ? m.y : r.y; return o;
}

template <int ACT  > struct EpiBf16 {
    static constexpr bool PERM = true, AFTER_DRAIN = false; static_assert(ACT == 0 || ACT == 1, "EpiBf16: ACT is 0 (none) or 1 (gelu_pk)");
    bf16_t* O; int ldc; const float* bias; int split_cols; size_t split_stride; float scale0;
    __device__ __forceinline__ void operator()(const f32x4 (&acc)[2][2][4][2], const Unit& u, int wr, int wc, int fr, int fq) const {
        const int row0 = u.pm * BM + wr * 64 + fr; int colt = u.pn * BM; bf16_t* base = O;
        float sc = 1.f; if (split_cols) { const int t = colt / split_cols; base += (size_t)t * split_stride; colt -= t * split_cols; if (t == 0) sc = scale0; }
        const int col0 = colt + wc * 32 + 8 * fq, bcol0 = u.pn * BM + wc * 32 + 8 * fq;
        f32x4 bv[2][2];
#pragma unroll
        for (int bj = 0; bj < 2; ++bj)
#pragma unroll
            for (int n = 0; n < 2; ++n) bv[bj][n] = bias ? *(const f32x4*)(bias + bcol0 + bj * HALF + 4 * n) : (f32x4){0.f, 0.f, 0.f, 0.f};
#pragma unroll
        for (int ai = 0; ai < 2; ++ai)
#pragma unroll
            for (int m = 0; m < 4; ++m) { bf16_t* rowp = base + (size_t)(row0 + ai * HALF + m * 16) * ldc + col0;
#pragma unroll
                for (int bj = 0; bj < 2; ++bj) { f32x4 v0 = acc[ai][bj][m][0] + bv[bj][0], v1 = acc[ai][bj][m][1] + bv[bj][1];
                    if (ACT == 1) { f32x2 a = gelu_pk((f32x2){v0[0], v0[1]}), b = gelu_pk((f32x2){v0[2], v0[3]}), c = gelu_pk((f32x2){v1[0], v1[1]}), d = gelu_pk((f32x2){v1[2], v1[3]});
                        v0 = (f32x4){a.x, a.y, b.x, b.y}; v1 = (f32x4){c.x, c.y, d.x, d.y}; }
                    v0 = v0 * sc; v1 = v1 * sc; u32x4 w; w.x = cvt_pk_bf16(v0[0], v0[1]); w.y = cvt_pk_bf16(v0[2], v0[3]); w.z = cvt_pk_bf16(v1[0], v1[1]); w.w = cvt_pk_bf16(v1[2], v1[3]);
                    *(u32x4*)(rowp + bj * HALF) = w; } }
    }
};

template <class Epi, class Sched, bool ALIGN_EPI = false, bool SP2 = false>
__device__ __forceinline__ void gemm_phase(PG8_LAS unsigned char* lds, const Gemm g, const Sched& S, const Epi& E) {
    const int tid = threadIdx.x, wid = __builtin_amdgcn_readfirstlane(tid >> 6), lane = tid & 63, wr = wid >> 2, wc = wid & 3, fr = lane & 15, fq = lane >> 4;
    const int K = g.K, nt = K / BK;
    unsigned voffA[2], voffB[2];
#pragma unroll
    for (int i = 0; i < 2; ++i) { int R, C; stage_rc(tid * 16 + i * 8192, R, C); const int Rb = Epi::PERM ? ((R & ~31) + perm32(R & 31)) : R;
        voffA[i] = (unsigned)(R * g.lda + C) * 2u; voffB[i] = (unsigned)(Rb * g.ldb + C) * 2u; }
    const size_t kstep = (size_t)(BK * 2);
    const size_t hstepA = (size_t)HALF * g.lda * 2, hstepB = (size_t)HALF * g.ldb * 2;
    const size_t tstepA = 2 * hstepA, tstepB = 2 * hstepB;
    const unsigned ldsw = (unsigned)wid * 1024u;
    const int aoff = lds_byte(wr * 64 + fr, fq * 8), boff = lds_byte(wc * 32 + fr, fq * 8);
#define PG8_SA(b, h) (((b) * 2 + (h)) * HTB)
#define PG8_SB(b, h) ((4 + (b) * 2 + (h)) * HTB)
#define PG8_STAGE(bufoff, gbase, voff) do { _Pragma("unroll") for (int _i = 0; _i < 2; ++_i) \
        __builtin_amdgcn_global_load_lds((const unsigned*)((const char*)(gbase) + (voff)[_i]), (PG8_LAS unsigned*)(lds + (bufoff) + ldsw + _i * 8192), 16, 0, 0); } while (0)
#define PG8_LDA(dst, b, h) do { _Pragma("unroll") for (int m = 0; m < 4; ++m) _Pragma("unroll") for (int k = 0; k < 2; ++k) dst[m][k] = *(const PG8_LAS bf16x8*)(lds + PG8_SA(b, h) + aoff + m * 2048 + k * 1024); } while (0)
#define PG8_LDB(dst, b, h) do { _Pragma("unroll") for (int n = 0; n < 2; ++n) _Pragma("unroll") for (int k = 0; k < 2; ++k) dst[n][k] = *(const PG8_LAS bf16x8*)(lds + PG8_SB(b, h) + boff + n * 2048 + k * 1024); } while (0)
#define PG8_MMA(ai, bj, At, Bt) do { __builtin_amdgcn_s_setprio(1); _Pragma("unroll") for (int m = 0; m < 4; ++m) _Pragma("unroll") for (int n = 0; n < 2; ++n) _Pragma("unroll") for (int k = 0; k < 2; ++k) \
        acc[ai][bj][m][n] = __builtin_amdgcn_mfma_f32_16x16x32_bf16(Bt[n][k], At[m][k], acc[ai][bj][m][n], 0, 0, 0); __builtin_amdgcn_s_setprio(0); } while (0)
#define PG8_WAIT_V(n) asm volatile("s_waitcnt vmcnt(" #n ")" ::: "memory")
#define PG8_WAIT_L(n) asm volatile("s_waitcnt lgkmcnt(" #n ")" ::: "memory")
#define PG8_BAR __builtin_amdgcn_s_barrier()
#define PG8_SCHED __builtin_amdgcn_sched_barrier(0)
    Unit cur, nxt; int ui = 0;
    if (!S.next(0, cur)) return;
    f32x4 acc[2][2][4][2];
#pragma unroll
    for (int a = 0; a < 2; ++a)
#pragma unroll
        for (int b = 0; b < 2; ++b)
#pragma unroll
            for (int m = 0; m < 4; ++m)
#pragma unroll
                for (int n = 0; n < 2; ++n) acc[a][b][m][n] = (f32x4){0.f, 0.f, 0.f, 0.f};
    bf16x8 At[4][2], B0[2][2], B1[2][2];
    const char* cA = (const char*)g.A + (size_t)cur.pm * tstepA; const char* cB = (const char*)g.Bt + (size_t)cur.pn * tstepB;
    S.a_ready(cur);
    if constexpr (SP2) {
        PG8_STAGE(PG8_SB(0, 0), cB, voffB); PG8_STAGE(PG8_SB(0, 1), cB + hstepB, voffB); PG8_STAGE(PG8_SA(0, 0), cA, voffA); PG8_STAGE(PG8_SA(0, 1), cA + hstepA, voffA);
        if (wr == 1) PG8_BAR;
        PG8_WAIT_V(2); PG8_BAR;
        PG8_STAGE(PG8_SB(1, 0), cB + kstep, voffB); PG8_STAGE(PG8_SA(1, 0), cA + kstep, voffA); PG8_STAGE(PG8_SB(1, 1), cB + hstepB + kstep, voffB);
        PG8_WAIT_V(6); PG8_BAR;
    } else {
        PG8_STAGE(PG8_SB(0, 0), cB, voffB); PG8_STAGE(PG8_SA(0, 0), cA, voffA); PG8_STAGE(PG8_SB(0, 1), cB + hstepB, voffB); PG8_STAGE(PG8_SA(0, 1), cA + hstepA, voffA);
        if (wr == 1) PG8_BAR;
        PG8_WAIT_V(4); PG8_BAR;
        PG8_STAGE(PG8_SB(1, 0), cB + kstep, voffB); PG8_STAGE(PG8_SA(1, 0), cA + kstep, voffA); PG8_STAGE(PG8_SB(1, 1), cB + hstepB + kstep, voffB);
        PG8_WAIT_V(6); PG8_BAR;
    }
    for (;;) {
        const bool has_next = S.next(ui + 1, nxt);
        const char* nA = has_next ? (const char*)g.A + (size_t)nxt.pm * tstepA : cA; const char* nB = has_next ? (const char*)g.Bt + (size_t)nxt.pn * tstepB : cB;
        for (int t = 0; t < nt; t += 2) {
            const bool last = (t == nt - 2);
            const char* a1 = cA + (size_t)(t + 1) * kstep;
            const char* a2 = last ? nA : cA + (size_t)(t + 2) * kstep; const char* b2 = last ? nB : cB + (size_t)(t + 2) * kstep;
            const char* a3 = a2 + kstep; const char* b3 = b2 + kstep;
            if (last && has_next) S.a_ready(nxt);
            if constexpr (SP2) {
            PG8_LDB(B0, 0, 0); PG8_LDB(B1, 0, 1); PG8_SCHED; PG8_LDA(At, 0, 0); PG8_STAGE(PG8_SA(1, 1), a1 + hstepA, voffA);
            PG8_WAIT_V(8); PG8_WAIT_L(0); PG8_BAR; PG8_MMA(0, 0, At, B0); PG8_MMA(0, 1, At, B1); PG8_BAR; PG8_SCHED;
            PG8_LDA(At, 0, 1); PG8_STAGE(PG8_SB(0, 0), b2, voffB); PG8_STAGE(PG8_SB(0, 1), b2 + hstepB, voffB); PG8_STAGE(PG8_SA(0, 0), a2, voffA);
            PG8_WAIT_V(8); PG8_WAIT_L(0); PG8_BAR; PG8_MMA(1, 0, At, B0); PG8_MMA(1, 1, At, B1); PG8_BAR; PG8_SCHED;
            PG8_LDB(B0, 1, 0); PG8_LDB(B1, 1, 1); PG8_SCHED; PG8_LDA(At, 1, 0); PG8_STAGE(PG8_SA(0, 1), a2 + hstepA, voffA);
            PG8_WAIT_V(8); PG8_WAIT_L(0); PG8_BAR; PG8_MMA(0, 0, At, B0); PG8_MMA(0, 1, At, B1); PG8_BAR; PG8_SCHED;
            PG8_LDA(At, 1, 1); PG8_STAGE(PG8_SB(1, 0), b3, voffB); PG8_STAGE(PG8_SB(1, 1), b3 + hstepB, voffB); PG8_STAGE(PG8_SA(1, 0), a3, voffA);
            PG8_WAIT_V(8); PG8_WAIT_L(0); PG8_BAR; PG8_MMA(1, 0, At, B0); PG8_MMA(1, 1, At, B1); PG8_BAR; PG8_SCHED;
            } else {
            PG8_LDB(B0, 0, 0); PG8_SCHED; PG8_LDA(At, 0, 0); PG8_STAGE(PG8_SA(1, 1), a1 + hstepA, voffA);
            PG8_WAIT_L(8); PG8_BAR; PG8_WAIT_L(0); PG8_MMA(0, 0, At, B0); PG8_BAR; PG8_SCHED;
            PG8_LDB(B1, 0, 1); PG8_STAGE(PG8_SB(0, 0), b2, voffB);
            PG8_BAR; PG8_WAIT_L(0); PG8_MMA(0, 1, At, B1); PG8_BAR;
            PG8_LDA(At, 0, 1); PG8_STAGE(PG8_SA(0, 0), a2, voffA);
            PG8_BAR; PG8_WAIT_L(0); PG8_MMA(1, 0, At, B0); PG8_BAR; PG8_SCHED;
            PG8_STAGE(PG8_SB(0, 1), b2 + hstepB, voffB);
            PG8_WAIT_V(6); PG8_BAR; PG8_MMA(1, 1, At, B1); PG8_BAR;
            PG8_LDB(B0, 1, 0); PG8_SCHED; PG8_LDA(At, 1, 0); PG8_STAGE(PG8_SA(0, 1), a2 + hstepA, voffA);
            PG8_WAIT_L(8); PG8_BAR; PG8_WAIT_L(0); PG8_MMA(0, 0, At, B0); PG8_BAR; PG8_SCHED;
            PG8_LDB(B1, 1, 1); PG8_STAGE(PG8_SB(1, 0), b3, voffB);
            PG8_BAR; PG8_WAIT_L(0); PG8_MMA(0, 1, At, B1); PG8_BAR;
            PG8_LDA(At, 1, 1); PG8_STAGE(PG8_SA(1, 0), a3, voffA);
            PG8_BAR; PG8_WAIT_L(0); PG8_MMA(1, 0, At, B0); PG8_BAR; PG8_SCHED;
            PG8_STAGE(PG8_SB(1, 1), b3 + hstepB, voffB);
            PG8_WAIT_V(6); PG8_BAR; PG8_MMA(1, 1, At, B1); PG8_BAR;
            }
        }
        if constexpr (ALIGN_EPI) { if (wr == 0) PG8_BAR; }
        if constexpr (!Epi::AFTER_DRAIN) { E(acc, cur, wr, wc, fr, fq); S.done(cur); }
        if (!has_next) break;
#pragma unroll
        for (int a = 0; a < 2; ++a)
#pragma unroll
            for (int b = 0; b < 2; ++b)
#pragma unroll
                for (int m = 0; m < 4; ++m)
#pragma unroll
                    for (int n = 0; n < 2; ++n) acc[a][b][m][n] = (f32x4){0.f, 0.f, 0.f, 0.f};
        cur = nxt; cA = nA; cB = nB; ++ui;
        if constexpr (ALIGN_EPI) { if (wr == 1) PG8_BAR; }
    }
    PG8_WAIT_V(0);
    if constexpr (!ALIGN_EPI) { if (wr == 0) PG8_BAR; }
    PG8_BAR;
    if constexpr (Epi::AFTER_DRAIN) { E.fused(acc, cur, wr, wc, fr, fq, lds, wid, lane); S.done(cur); }
#undef PG8_SA
#undef PG8_SB
#undef PG8_STAGE
#undef PG8_LDA
#undef PG8_LDB
#undef PG8_MMA
#undef PG8_WAIT_V
#undef PG8_WAIT_L
#undef PG8_BAR
#undef PG8_SCHED
}
}

#ifndef MK_EXP_OLD
#define MK_EXP_OLD 0
#endif
#ifndef MK_ONE_LAUNCH
#define MK_ONE_LAUNCH 1
#endif
#define LAS __attribute__((address_space(3)))
typedef unsigned short bf16;
typedef unsigned v4u __attribute__((ext_vector_type(4)));
typedef unsigned v2u __attribute__((ext_vector_type(2)));
typedef float f32x4 __attribute__((ext_vector_type(4)));
typedef float f32x2 __attribute__((ext_vector_type(2)));
typedef short bf16x8 __attribute__((ext_vector_type(8)));
typedef float f32x16 __attribute__((ext_vector_type(16)));
#define MFMA32(a, b, c) __builtin_amdgcn_mfma_f32_32x32x16_bf16((a), (b), (c), 0, 0, 0)

constexpr int D = 1024, NB = 8, SEQ = 2048, LC = 256, ML = NB * SEQ  , MC = NB * LC  , MT = ML + MC  ;
constexpr int PROJ = 2576, NPROJ = 2560;
constexpr int NEXP = 16384, TOPK = 16, KK = 128;
constexpr float EPS = 1e-6f;
constexpr int NTHREADS = 512, NWAVES = 8;
constexpr int LDS_BYTES = 147456;
constexpr int NPHASES = 16;

constexpr size_t MiB = 1u << 20;
constexpr size_t WS_CTL = 0;
constexpr size_t CTL_ZERO_BYTES = 65536;
constexpr int CW_BAR = 0;
constexpr int CW_E1 = 4096, CW_E2 = 4096 + 8 * 64;
constexpr size_t WS_MOD = 1 * MiB;
constexpr size_t WS_LP = 1 * MiB + 512 * 1024;
constexpr size_t WS_WIN = 2 * MiB;
constexpr size_t WS_WOUT = 8 * MiB;
constexpr size_t WS_WGLU = 10 * MiB;
constexpr size_t WS_WQ = 11 * MiB;
constexpr size_t WS_GB = 15 * MiB;
constexpr size_t WS_BB = 17 * MiB;
constexpr size_t WS_PM = 41 * MiB;
constexpr size_t WS_OG = 17 * MiB;
constexpr size_t WS_HX2 = 17 * MiB;
constexpr size_t WS_U5 = 49 * MiB;
constexpr size_t WS_CAT = 49 * MiB;
constexpr size_t WS_IDX = 49 * MiB;
constexpr size_t WS_GATE = 57 * MiB;
constexpr size_t WS_ACT = 65 * MiB;
constexpr size_t WS_SSQP = 73 * MiB;
constexpr size_t WS_Z = 85 * MiB;
constexpr size_t WS_YRAW = 85 * MiB;
constexpr size_t WS_QP = 85 * MiB;
constexpr size_t WS_Y = 85 * MiB;
constexpr size_t WS_HX = 101 * MiB;
constexpr size_t WS_SS = 101 * MiB;
constexpr size_t WS_YG = 101 * MiB;
constexpr size_t WS_FRT = 125 * MiB;
constexpr size_t WS_QKVPRE = 137 * MiB;
constexpr size_t WS_FRA = 143 * MiB;
constexpr size_t WS_FRK = 161 * MiB;
constexpr size_t WS_FRTAB = 197 * MiB;
constexpr size_t WS_QKV = 202 * MiB;
constexpr size_t WS_U8 = 202 * MiB;
constexpr size_t WS_V8 = 218 * MiB;
constexpr size_t WS_USC = 234 * MiB;
constexpr size_t WS_VSC = 234 * MiB + 512 * 1024;
constexpr size_t WS_HQ8 = 150 * MiB;
constexpr size_t WS_HS = 183 * MiB;
constexpr size_t WS_PACT = 85 * MiB;
constexpr size_t WS_END = 256 * MiB;
static_assert(WS_BB + (size_t)32 * 512 * 768 * 2 <= WS_PM && WS_PM + (size_t)32 * 256 * 512 * 2 <= WS_U5 && WS_U5 + (size_t)32 * 768 * 768 * 2 <= WS_Z && WS_Z + (size_t)ML * 512 * 2 <= WS_HX, "ws map a");
static_assert(WS_HX + (size_t)MT * D * 2 <= WS_QKVPRE && WS_SS + (size_t)32 * 768 * 256 * 4 <= WS_FRT && WS_QKVPRE + (size_t)MT * 1536 * 2 <= WS_QKV && WS_QKV + (size_t)MT * 1536 * 2 <= WS_END, "ws map b");
static_assert(WS_FRT + (size_t)2304 * 8192 <= WS_FRA && WS_FRA + (size_t)2304 * 8192 <= WS_FRK && WS_FRK + (size_t)2304 * 16384 <= WS_FRTAB && WS_FRTAB + (size_t)2304 * 1024 <= WS_QKV, "ws map c");
static_assert(WS_OG + (size_t)2 * ML * 512 * 2 <= WS_CAT && WS_CAT + (size_t)ML * D * 2 <= WS_Z && WS_YRAW + (size_t)ML * D * 4 <= WS_U8 && WS_SSQP + (size_t)8 * ML * 4 <= WS_Z && WS_YG + (size_t)ML * 512 * 2 <= WS_FRT, "ws map d");

__device__ __forceinline__ unsigned f2bf(float f) { unsigned u = __builtin_bit_cast(unsigned, f); return (u + 0x7fffu + ((u >> 16) & 1u)) >> 16; }
typedef __bf16 bf16x2_t __attribute__((ext_vector_type(2)));
__device__ __forceinline__ unsigned pk2(float lo, float hi) { const f32x2 v = {lo, hi}; return __builtin_bit_cast(unsigned, __builtin_convertvector(v, bf16x2_t)); }
__device__ __forceinline__ float bflo(unsigned w) { return __builtin_bit_cast(float, w << 16); }
__device__ __forceinline__ float bfhi(unsigned w) { return __builtin_bit_cast(float, w & 0xffff0000u); }
__device__ __forceinline__ float bf1(bf16 h) { return __builtin_bit_cast(float, (unsigned)h << 16); }
__device__ __forceinline__ float wave_sum(float v) {
#pragma unroll
    for (int o = 1; o < 64; o <<= 1) v += __shfl_xor(v, o);
    return v;
}
__device__ __forceinline__ float wave_max(float v) {
#pragma unroll
    for (int o = 1; o < 64; o <<= 1) v = fmaxf(v, __shfl_xor(v, o));
    return v;
}
__device__ __forceinline__ float sigmoidf_(float x) { return 1.f / (1.f + __expf(-x)); }
__device__ __forceinline__ float siluf_(float x) { return x / (1.f + __expf(-x)); }
__device__ __forceinline__ float gelu_erf(float x) { return 0.5f * x * (1.f + erff(x * 0.70710678118654752f)); }
__device__ __forceinline__ void sincos_d(double a, float& s, float& c) {
    const double k = rint(a * 0.63661977236758134308);
    const double r = fma(-k, 1.57079632679489661923, a) - k * 6.123233995736766e-17;
    const double r2 = r * r;
    double sp = -2.5052108385441720e-08; sp = sp * r2 + 2.7557319223985893e-06; sp = sp * r2 - 1.9841269841269841e-04; sp = sp * r2 + 8.3333333333333332e-03; sp = sp * r2 - 1.6666666666666666e-01;
    const double sn = r + r * r2 * sp;
    double cp = 2.0876756987868099e-09; cp = cp * r2 - 2.7557319223985888e-07; cp = cp * r2 + 2.4801587301587302e-05; cp = cp * r2 - 1.3888888888888889e-03; cp = cp * r2 + 4.1666666666666664e-02; cp = cp * r2 - 0.5;
    const double cs = 1.0 + r2 * cp;
    const int q = ((int)k) & 3;
    const double ss = (q == 0) ? sn : (q == 1) ? cs : (q == 2) ? -sn : -cs;
    const double cc = (q == 0) ? cs : (q == 1) ? -sn : (q == 2) ? -cs : sn;
    s = (float)ss; c = (float)cc;
}

struct Args { const float* in[29]; float* out; unsigned char* ws; int ph_lo, ph_hi; };
static_assert(sizeof(Args) == 29 * 8 + 8 + 8 + 8, "Args has no padding");
enum { I_X = 0, I_C, I_CTX, I_CCTX, I_WMOD, I_BMOD, I_GPREMIX, I_GPOSTMIX, I_GPREFFN, I_GPOSTFFN, I_WIN, I_WOUT, I_LAMRE, I_LAMIM, I_LOGDT, I_BRE, I_BIM, I_CRE, I_CIM, I_S5D, I_WGLU,
       I_CONV, I_ALOG, I_DTBIAS, I_GDNNORM, I_WQ, I_KEYS, I_PU, I_PV };

__device__ __forceinline__ const float* in_row(const Args& a, int row) { return row < ML ? a.in[I_X] + (size_t)row * D : a.in[I_CTX] + (size_t)(row - ML) * D; }
__device__ __forceinline__ int mod_row(int row) { return row < ML ? (row >> 11) : 8; }

template <int CTRL> __device__ __forceinline__ float dppf(float v) { return __builtin_bit_cast(float, __builtin_amdgcn_update_dpp(0, __builtin_bit_cast(int, v), CTRL, 0xf, 0xf, true)); }
__device__ __forceinline__ float row_sum16(float v) { v += dppf<0xB1>(v); v += dppf<0x4E>(v); v += dppf<0x141>(v); v += dppf<0x140>(v); return v; }
__device__ __forceinline__ float row_max16(float v) { v = fmaxf(v, dppf<0xB1>(v)); v = fmaxf(v, dppf<0x4E>(v)); v = fmaxf(v, dppf<0x141>(v)); v = fmaxf(v, dppf<0x140>(v)); return v; }
__device__ __forceinline__ float wsum(float v) { v = row_sum16(v); return
    __builtin_bit_cast(float, __builtin_amdgcn_readlane(__builtin_bit_cast(int, v), 0)) + __builtin_bit_cast(float, __builtin_amdgcn_readlane(__builtin_bit_cast(int, v), 16)) +
    __builtin_bit_cast(float, __builtin_amdgcn_readlane(__builtin_bit_cast(int, v), 32)) + __builtin_bit_cast(float, __builtin_amdgcn_readlane(__builtin_bit_cast(int, v), 48)); }
__device__ __forceinline__ float wmax(float v) { v = row_max16(v); return fmaxf(fmaxf(__builtin_bit_cast(float, __builtin_amdgcn_readlane(__builtin_bit_cast(int, v), 0)), __builtin_bit_cast(float, __builtin_amdgcn_readlane(__builtin_bit_cast(int, v), 16))),
    fmaxf(__builtin_bit_cast(float, __builtin_amdgcn_readlane(__builtin_bit_cast(int, v), 32)), __builtin_bit_cast(float, __builtin_amdgcn_readlane(__builtin_bit_cast(int, v), 48)))); }
__device__ __forceinline__ int lane_rank(unsigned long long m) { return __builtin_amdgcn_mbcnt_hi((unsigned)(m >> 32), __builtin_amdgcn_mbcnt_lo((unsigned)m, 0)); }
__device__ __forceinline__ unsigned fkey(float f) { const unsigned u = __builtin_bit_cast(unsigned, f); return u ^ ((unsigned)((int)u >> 31) | 0x80000000u); }
#define WAVE_LDS_SYNC() do { __builtin_amdgcn_fence(__ATOMIC_RELEASE, "wavefront"); __builtin_amdgcn_wave_barrier(); __builtin_amdgcn_fence(__ATOMIC_ACQUIRE, "wavefront"); } while (0)
template <int N> __device__ __forceinline__ unsigned kth_key(const unsigned (&k)[N], int K) {
    unsigned T = 0;
    for (int bit = 31; bit >= 0; --bit) { const unsigned cand = T | (1u << bit); int cnt = 0;
#pragma unroll
        for (int n = 0; n < N; ++n) cnt += __popcll(__ballot(k[n] >= cand));
        if (cnt >= K) T = cand;
        if (cnt == K) break; }
    return T;
}

namespace pg8 {
struct EpiInProj {
    static constexpr bool PERM = true, AFTER_DRAIN = false;
    bf16_t* U; bf16_t* QKV; bf16_t* Z;
    __device__ __forceinline__ void operator()(const f32x4 (&acc)[2][2][4][2], const Unit& u, int wr, int wc, int fr, int fq) const {
        bf16_t* base; int ld, colt; bool lat_only = false;
        const bool s5 = u.pn < 2;
        if (s5) { base = U; ld = 0; colt = u.pn * BM; }
        else if (u.pn < 8) { base = QKV; ld = 1536; colt = (u.pn - 2) * BM; }
        else { base = Z; ld = 512; colt = (u.pn - 8) * BM; lat_only = true; }
        const int row0 = u.pm * BM + wr * 64 + fr, col0 = colt + wc * 32 + 8 * fq;
#pragma unroll
        for (int ai = 0; ai < 2; ++ai)
#pragma unroll
            for (int m = 0; m < 4; ++m) { const int row = row0 + ai * HALF + m * 16; bf16_t* rowp = base + (size_t)row * ld + col0;
                if (lat_only && row >= 16384) continue;
                if (s5) { const int R = row < 16384 ? (row >> 5) : 512 + ((row - 16384) >> 5), ii = row & 31; rowp = base + (size_t)R * 768 + ii * 16 + (col0 & 15); }
#pragma unroll
                for (int bj = 0; bj < 2; ++bj) { const f32x4 v0 = acc[ai][bj][m][0], v1 = acc[ai][bj][m][1];
                    u32x4 w; w.x = cvt_pk_bf16(v0[0], v0[1]); w.y = cvt_pk_bf16(v0[2], v0[3]); w.z = cvt_pk_bf16(v1[0], v1[1]); w.w = cvt_pk_bf16(v1[2], v1[3]);
                    if (s5) *(u32x4*)(rowp + (size_t)((col0 + bj * HALF) >> 4) * (768 * 768)) = w; else *(u32x4*)(rowp + bj * HALF) = w; } }
    }
};
struct EpiGlu {
    static constexpr bool PERM = true, AFTER_DRAIN = false;
    const bf16_t* YG; bf16_t* CAT;
    __device__ __forceinline__ void operator()(const f32x4 (&acc)[2][2][4][2], const Unit& u, int wr, int wc, int fr, int fq) const {
        const int row0 = u.pm * BM + wr * 64 + fr, col0 = u.pn * BM + wc * 32 + 8 * fq;
#pragma unroll
        for (int ai = 0; ai < 2; ++ai)
#pragma unroll
            for (int m = 0; m < 4; ++m) { const int row = row0 + ai * HALF + m * 16;
#pragma unroll
                for (int bj = 0; bj < 2; ++bj) { const f32x4 v0 = acc[ai][bj][m][0], v1 = acc[ai][bj][m][1];
                    const u32x4 y = *(const u32x4*)(YG + (size_t)row * 512 + col0 + bj * HALF);
                    float o[8]; const float a[8] = {v0[0], v0[1], v0[2], v0[3], v1[0], v1[1], v1[2], v1[3]};
                    const unsigned yw[4] = {y.x, y.y, y.z, y.w};
#pragma unroll
                    for (int e = 0; e < 8; ++e) { const float yv = __builtin_bit_cast(float, (e & 1) ? (yw[e >> 1] & 0xffff0000u) : (yw[e >> 1] << 16)); o[e] = yv / (1.f + __expf(-a[e])); }
                    u32x4 w; w.x = cvt_pk_bf16(o[0], o[1]); w.y = cvt_pk_bf16(o[2], o[3]); w.z = cvt_pk_bf16(o[4], o[5]); w.w = cvt_pk_bf16(o[6], o[7]);
                    *(u32x4*)(CAT + (size_t)row * 1024 + col0 + bj * HALF) = w; } }
    }
};
struct EpiF32 {
    static constexpr bool PERM = false, AFTER_DRAIN = false;
    float* C; int ldc;
    __device__ __forceinline__ void operator()(const f32x4 (&acc)[2][2][4][2], const Unit& u, int wr, int wc, int fr, int fq) const {
        const int row0 = u.pm * BM + wr * 64 + fr, col0 = u.pn * BM + wc * 32 + 4 * fq;
#pragma unroll
        for (int ai = 0; ai < 2; ++ai)
#pragma unroll
            for (int m = 0; m < 4; ++m) { float* rowp = C + (size_t)(row0 + ai * HALF + m * 16) * ldc + col0;
#pragma unroll
                for (int bj = 0; bj < 2; ++bj)
#pragma unroll
                    for (int n = 0; n < 2; ++n) *(f32x4*)(rowp + bj * HALF + n * 16) = acc[ai][bj][m][n]; }
    }
};
struct EpiSS {
    static constexpr bool PERM = false, AFTER_DRAIN = false;
    float* C;
    __device__ __forceinline__ void operator()(const f32x4 (&acc)[2][2][4][2], const Unit& u, int wr, int wc, int fr, int fq) const {
        const int row0 = u.pm * BM + wr * 64 + fr, col0 = wc * 32 + 4 * fq;
#pragma unroll
        for (int ai = 0; ai < 2; ++ai)
#pragma unroll
            for (int m = 0; m < 4; ++m) { float* rowp = C + (size_t)(row0 + ai * HALF + m * 16) * 256 + col0;
#pragma unroll
                for (int bj = 0; bj < 2; ++bj)
#pragma unroll
                    for (int n = 0; n < 2; ++n) *(f32x4*)(rowp + bj * HALF + n * 16) = acc[ai][bj][m][n]; }
    }
};
struct SchedSS { int G, c; __device__ bool next(int i, Unit& u) const { const int L = i * G + c; if (L >= 96) return false; u.pm = L; u.pn = L / 3; return true; }
    __device__ __forceinline__ void a_ready(const Unit&) const {} __device__ __forceinline__ void done(const Unit&) const {} };
struct EpiS5Y {
    static constexpr bool PERM = true, AFTER_DRAIN = false;
    bf16_t* YG;
    __device__ __forceinline__ void operator()(const f32x4 (&acc)[2][2][4][2], const Unit& u, int wr, int wc, int fr, int fq) const {
        const int g = u.pn >> 1, R0 = (u.pm - 3 * g) * BM + wr * 64 + fr, n0 = (u.pn & 1) * BM + wc * 32 + 8 * fq;
#pragma unroll
        for (int ai = 0; ai < 2; ++ai)
#pragma unroll
            for (int m = 0; m < 4; ++m) { const int R = R0 + ai * HALF + m * 16;
#pragma unroll
                for (int bj = 0; bj < 2; ++bj) { const int n = n0 + bj * HALF; const f32x4 v0 = acc[ai][bj][m][0], v1 = acc[ai][bj][m][1];
                    const f32x2 a = gelu_pk((f32x2){v0[0], v0[1]}), b = gelu_pk((f32x2){v0[2], v0[3]}), c2 = gelu_pk((f32x2){v1[0], v1[1]}), d = gelu_pk((f32x2){v1[2], v1[3]});
                    u32x4 w; w.x = cvt_pk_bf16(a.x, a.y); w.y = cvt_pk_bf16(b.x, b.y); w.z = cvt_pk_bf16(c2.x, c2.y); w.w = cvt_pk_bf16(d.x, d.y);
                    *(u32x4*)(YG + (size_t)(R * 32 + (n >> 4)) * 512 + g * 16 + (n & 15)) = w; } }
    }
};
struct SchedS5Y { int G, c; __device__ bool next(int i, Unit& u) const { const int L = i * G + c; if (L >= 128) return false; const int g = L >> 2; u.pm = 3 * g + ((L >> 1) & 1); u.pn = 2 * g + (L & 1); return true; }
    __device__ __forceinline__ void a_ready(const Unit&) const {} __device__ __forceinline__ void done(const Unit&) const {} };
}

struct Ctx { const Args* a; unsigned char* ws; unsigned char* lds; int tid, lane, wave, bid, G, gw, NGW, gwv; };

__device__ __forceinline__ void p0_transpose_item(const float* W, int ldw, int nblk, int K, bf16* WT, float* scr, int item, int lane) {
    const int kb = item / nblk, nb = item % nblk, k0 = 64 * kb, n0 = 32 * nb;
#pragma unroll 8
    for (int i = 0; i < 32; ++i) { const int kk = 2 * i + (lane >> 5); scr[kk * 33 + (lane & 31)] = W[(size_t)(k0 + kk) * ldw + n0 + (lane & 31)]; }
    __builtin_amdgcn_fence(__ATOMIC_RELEASE, "wavefront"); __builtin_amdgcn_wave_barrier(); __builtin_amdgcn_fence(__ATOMIC_ACQUIRE, "wavefront");
    const int c = lane & 7;
#pragma unroll
    for (int j = 0; j < 4; ++j) { const int n = (lane >> 3) + 8 * j; const float* s = scr + (8 * c) * 33 + n;
        v4u o; o.x = pk2(s[0 * 33], s[1 * 33]); o.y = pk2(s[2 * 33], s[3 * 33]); o.z = pk2(s[4 * 33], s[5 * 33]); o.w = pk2(s[6 * 33], s[7 * 33]);
        *(v4u*)(WT + (size_t)(n0 + n) * K + k0 + 8 * c) = o; }
    __builtin_amdgcn_fence(__ATOMIC_RELEASE, "wavefront"); __builtin_amdgcn_wave_barrier(); __builtin_amdgcn_fence(__ATOMIC_ACQUIRE, "wavefront");
}
__device__ __forceinline__ void phase_prep(const Ctx& c) {
    const Args& a = *c.a;
    float* scr = (float*)(c.lds + c.wave * 16384);
    constexpr int I_IN = 16 * 80, I_OUT = 16 * 32, I_GLU = 8 * 16, I_Q = 16 * 64;
    for (int it = c.gw; it < I_IN + I_OUT + I_GLU + I_Q; it += c.NGW) {
        int r = it;
        if (r < I_IN) { p0_transpose_item(a.in[I_WIN], PROJ, 80, 1024, (bf16*)(c.ws + WS_WIN), scr, r, c.lane); continue; } r -= I_IN;
        if (r < I_OUT) { p0_transpose_item(a.in[I_WOUT], 1024, 32, 1024, (bf16*)(c.ws + WS_WOUT), scr, r, c.lane); continue; } r -= I_OUT;
        if (r < I_GLU) { p0_transpose_item(a.in[I_WGLU], 512, 16, 512, (bf16*)(c.ws + WS_WGLU), scr, r, c.lane); continue; } r -= I_GLU;
        p0_transpose_item(a.in[I_WQ], 2048, 64, 1024, (bf16*)(c.ws + WS_WQ), scr, r, c.lane);
    }
    __syncthreads();
    float* sc = (float*)c.lds;
    float* red = (float*)(c.lds + 9 * 1024 * 4);
    float* MOD = (float*)(c.ws + WS_MOD);
    bool have = false;
    for (int item = c.bid; item < 96; item += c.G) {
        if (!have) { for (int i = c.tid; i < 9 * 1024; i += NTHREADS) { const int r = i >> 10, k = i & 1023; const float v = r < 8 ? a.in[I_C][r * 1024 + k] : a.in[I_CCTX][k]; sc[i] = siluf_(v); } have = true; __syncthreads(); }
        const int n0 = item * 64;
        float acc[9];
#pragma unroll
        for (int r = 0; r < 9; ++r) acc[r] = 0.f;
        const float* wp = a.in[I_WMOD] + (size_t)(c.wave * 128) * 6144 + n0 + c.lane;
#pragma unroll 16
        for (int k = 0; k < 128; ++k) { const float w = wp[(size_t)k * 6144];
#pragma unroll
            for (int r = 0; r < 9; ++r) acc[r] = fmaf(sc[r * 1024 + c.wave * 128 + k], w, acc[r]); }
#pragma unroll
        for (int r = 0; r < 9; ++r) red[(c.wave * 9 + r) * 64 + c.lane] = acc[r];
        __syncthreads();
        for (int i = c.tid; i < 576; i += NTHREADS) { const int r = i >> 6, l = i & 63; float s = a.in[I_BMOD][n0 + l];
#pragma unroll
            for (int w = 0; w < 8; ++w) s += red[(w * 9 + r) * 64 + l];
            MOD[r * 6144 + n0 + l] = s; }
        __syncthreads();
    }
}
__device__ __forceinline__ void s5_build_group(const Ctx& c, int g, int part);
__device__ __forceinline__ void phase_s5_build(const Ctx& c) { for (int it = c.bid; it < 256; it += c.G) s5_build_group(c, it >> 3, it & 7); }

__device__ __forceinline__ void phase_norm1(const Ctx& c) {
    const Args& a = *c.a;
    float* wabT = (float*)c.lds;
    for (int i = c.tid; i < 1024 * 16; i += NTHREADS) { const int k = i >> 4, j = i & 15; wabT[j * 1028 + k] = a.in[I_WIN][(size_t)k * PROJ + NPROJ + j]; }
    __syncthreads();
    const float* MOD = (const float*)(c.ws + WS_MOD);
    bf16* HX = (bf16*)(c.ws + WS_HX); float* GB = (float*)(c.ws + WS_GB);
    const float* gpre = a.in[I_GPREMIX];
    f32x4 nx[4];
    if (c.gw < MT) { const f32x4* xr = (const f32x4*)in_row(a, c.gw) + c.lane;
#pragma unroll
        for (int j = 0; j < 4; ++j) nx[j] = xr[64 * j]; }
    for (int row = c.gw; row < MT; row += c.NGW) {
        const float* mr = MOD + mod_row(row) * 6144;
        f32x4 v[4]; float ss = 0.f;
#pragma unroll
        for (int j = 0; j < 4; ++j) { v[j] = nx[j]; ss += (v[j].x * v[j].x + v[j].y * v[j].y) + (v[j].z * v[j].z + v[j].w * v[j].w); }
        if (row + c.NGW < MT) { const f32x4* xr = (const f32x4*)in_row(a, row + c.NGW) + c.lane;
#pragma unroll
            for (int j = 0; j < 4; ++j) nx[j] = xr[64 * j]; }
        const float r = rsqrtf(wsum(ss) * (1.f / D) + EPS);
#pragma unroll
        for (int j = 0; j < 4; ++j) { const int col = 4 * c.lane + 256 * j;
            const f32x4 g4 = *(const f32x4*)(gpre + col), sh = *(const f32x4*)(mr + col), scl = *(const f32x4*)(mr + 1024 + col);
            v[j] = (v[j] * r) * g4 * (scl + 1.f) + sh;
            v2u o; o.x = pk2(v[j].x, v[j].y); o.y = pk2(v[j].z, v[j].w);
            *(v2u*)(HX + (size_t)row * D + col) = o; }
        float pj[16];
#pragma unroll
        for (int j = 0; j < 16; ++j) { float s = 0.f;
#pragma unroll
            for (int jj = 0; jj < 4; ++jj) { const f32x4 w = *(const f32x4*)(wabT + j * 1028 + 4 * c.lane + 256 * jj); s += (v[jj].x * w.x + v[jj].y * w.y) + (v[jj].z * w.z + v[jj].w * w.w); }
            pj[j] = s; if ((j & 1) == 1) asm volatile("" ::: "memory"); }
        const bool b5 = c.lane & 32, b4 = c.lane & 16, b3 = c.lane & 8, b2 = c.lane & 4;
        float q8[8], q4[4], q2[2];
#pragma unroll
        for (int i = 0; i < 8; ++i) { const float keep = b5 ? pj[i + 8] : pj[i], send = b5 ? pj[i] : pj[i + 8]; q8[i] = keep + __shfl_xor(send, 32); }
#pragma unroll
        for (int i = 0; i < 4; ++i) { const float keep = b4 ? q8[i + 4] : q8[i], send = b4 ? q8[i] : q8[i + 4]; q4[i] = keep + __shfl_xor(send, 16); }
#pragma unroll
        for (int i = 0; i < 2; ++i) { const float keep = b3 ? q4[i + 2] : q4[i], send = b3 ? q4[i] : q4[i + 2]; q2[i] = keep + dppf<0x140>(send); }
        float mine; { const float keep = b2 ? q2[1] : q2[0], send = b2 ? q2[0] : q2[1]; mine = keep + dppf<0x141>(send); }
        mine += dppf<0xB1>(mine); mine += dppf<0x4E>(mine);
        const int jl = (b5 ? 8 : 0) + (b4 ? 4 : 0) + (b3 ? 2 : 0) + (b2 ? 1 : 0);
        if ((c.lane & 3) == 0) {
            if (jl < 8) { const float t = mine + a.in[I_DTBIAS][jl]; const float sp = t > 20.f ? t : log1pf(expf(t)); GB[(size_t)row * 16 + jl] = -expf(a.in[I_ALOG][jl]) * sp; }
            else GB[(size_t)row * 16 + jl] = 1.f / (1.f + expf(-mine)); }
    }
}

__device__ __forceinline__ void phase_conv(const Ctx& c) {
    const Args& a = *c.a;
    const bf16* PRE = (const bf16*)(c.ws + WS_QKVPRE); bf16* OUT = (bf16*)(c.ws + WS_QKV);
    const float* cw = a.in[I_CONV];
#pragma unroll 1
    for (int pass = 0; pass < 3; ++pass) { const int ch0 = pass * 512 + 8 * c.lane;
        f32x4 wt[9][2];
#pragma unroll
        for (int i = 0; i < 9; ++i) { wt[i][0] = *(const f32x4*)(cw + i * 1536 + ch0); wt[i][1] = *(const f32x4*)(cw + i * 1536 + ch0 + 4); }
#pragma unroll 1
        for (int row = c.gw; row < MT; row += c.NGW) {
            int nb_row[9]; bool ok[9];
            if (row < ML) { const int t = row & 2047, gr = t >> 6, gc = t & 63;
#pragma unroll
                for (int dy = -1; dy <= 1; ++dy)
#pragma unroll
                    for (int dx = -1; dx <= 1; ++dx) { const int i = (dy + 1) * 3 + dx + 1; ok[i] = (gr + dy >= 0) && (gr + dy < 32) && (gc + dx >= 0) && (gc + dx < 64); nb_row[i] = row + dy * 64 + dx; } }
            else { const int t = (row - ML) & 255;
#pragma unroll
                for (int i = 0; i < 9; ++i) { ok[i] = false; nb_row[i] = row; }
#pragma unroll
                for (int dx = -1; dx <= 1; ++dx) { ok[4 + dx] = (t + dx >= 0) && (t + dx < 256); nb_row[4 + dx] = row + dx; } }
            v4u in[9];
#pragma unroll
            for (int i = 0; i < 9; ++i) in[i] = ok[i] ? *(const v4u*)(PRE + (size_t)nb_row[i] * 1536 + ch0) : (v4u){0u, 0u, 0u, 0u};
            float o[8];
#pragma unroll
            for (int q = 0; q < 8; ++q) o[q] = 0.f;
#pragma unroll
            for (int i = 0; i < 9; ++i) { const unsigned w[4] = {in[i].x, in[i].y, in[i].z, in[i].w}; const float kk[8] = {wt[i][0].x, wt[i][0].y, wt[i][0].z, wt[i][0].w, wt[i][1].x, wt[i][1].y, wt[i][1].z, wt[i][1].w};
#pragma unroll
                for (int q = 0; q < 4; ++q) { o[2 * q] = fmaf(bflo(w[q]), kk[2 * q], o[2 * q]); o[2 * q + 1] = fmaf(bfhi(w[q]), kk[2 * q + 1], o[2 * q + 1]); } }
            float ssq = 0.f;
#pragma unroll
            for (int q = 0; q < 8; ++q) { o[q] = siluf_(o[q]); ssq = fmaf(o[q], o[q], ssq); }
            if (pass < 2) { const float sc = rsqrtf(row_sum16(ssq) + EPS) * (pass == 0 ? 0.08838834764831845f : 1.f);
#pragma unroll
                for (int q = 0; q < 8; ++q) o[q] *= sc; }
            v4u ov; ov.x = pk2(o[0], o[1]); ov.y = pk2(o[2], o[3]); ov.z = pk2(o[4], o[5]); ov.w = pk2(o[6], o[7]);
            *(v4u*)(OUT + (size_t)row * 1536 + ch0) = ov;
        }
    }
}

__device__ __forceinline__ int scan_row(int b, int dir, int step) {
    if (step < LC) { const int t = dir ? LC - 1 - step : step; return ML + b * LC + t; }
    const int t = step - LC; return b * SEQ + (dir ? SEQ - 1 - t : t);
}
__device__ __forceinline__ void phase_combine(const Ctx& c) {
    const Args& a = *c.a;
    const bf16* OG0 = (const bf16*)(c.ws + WS_OG); const bf16* OG1 = OG0 + (size_t)ML * 512; const bf16* Z = (const bf16*)(c.ws + WS_Z);
    bf16* CAT = (bf16*)(c.ws + WS_CAT);
    for (int row = c.gw; row < ML; row += c.NGW) {
#pragma unroll
        for (int h = 0; h < 4; ++h) { const int ch = h * 128 + 2 * c.lane;
            const unsigned w0 = *(const unsigned*)(OG0 + (size_t)row * 512 + ch), w1 = *(const unsigned*)(OG1 + (size_t)row * 512 + ch), zw = *(const unsigned*)(Z + (size_t)row * 512 + ch);
            const float o0 = bflo(w0) + bflo(w1), o1 = bfhi(w0) + bfhi(w1);
            const float r = rsqrtf(wave_sum(o0 * o0 + o1 * o1) * (1.f / 128.f) + EPS);
            const f32x2 ng = *(const f32x2*)(a.in[I_GDNNORM] + 2 * c.lane);
            *(unsigned*)(CAT + (size_t)row * 1024 + 512 + ch) = pk2(o0 * r * ng.x * siluf_(bflo(zw)), o1 * r * ng.y * siluf_(bfhi(zw))); }
    }
}

__device__ __forceinline__ void phase_rows2(const Ctx& c) {
    const Args& a = *c.a;
    const float* MOD = (const float*)(c.ws + WS_MOD); const float* YRAW = (const float*)(c.ws + WS_YRAW); bf16* HX2 = (bf16*)(c.ws + WS_HX2);
    f32x4 ny[4], nxx[4];
    if (c.gw < ML) {
#pragma unroll
        for (int j = 0; j < 4; ++j) { ny[j] = *((const f32x4*)(YRAW + (size_t)c.gw * D) + c.lane + 64 * j); nxx[j] = *((const f32x4*)(a.in[I_X] + (size_t)c.gw * D) + c.lane + 64 * j); } }
    for (int row = c.gw; row < ML; row += c.NGW) {
        const float* mr = MOD + (row >> 11) * 6144;
        f32x4 y[4], x[4]; float ss = 0.f;
#pragma unroll
        for (int j = 0; j < 4; ++j) { y[j] = ny[j]; x[j] = nxx[j];
            ss += (y[j].x * y[j].x + y[j].y * y[j].y) + (y[j].z * y[j].z + y[j].w * y[j].w); }
        if (row + c.NGW < ML) { const size_t r2 = (size_t)(row + c.NGW);
#pragma unroll
            for (int j = 0; j < 4; ++j) { ny[j] = *((const f32x4*)(YRAW + r2 * D) + c.lane + 64 * j); nxx[j] = *((const f32x4*)(a.in[I_X] + r2 * D) + c.lane + 64 * j); } }
        const float r = rsqrtf(wsum(ss) * (1.f / D) + EPS); float s2 = 0.f;
#pragma unroll
        for (int j = 0; j < 4; ++j) { const int col = 4 * c.lane + 256 * j;
            const f32x4 g4 = *(const f32x4*)(a.in[I_GPOSTMIX] + col), gt = *(const f32x4*)(mr + 2048 + col);
            x[j] = x[j] + gt * ((y[j] * r) * g4);
            *(f32x4*)(a.out + (size_t)row * D + col) = x[j];
            s2 += (x[j].x * x[j].x + x[j].y * x[j].y) + (x[j].z * x[j].z + x[j].w * x[j].w); }
        const float r2 = rsqrtf(wsum(s2) * (1.f / D) + EPS);
#pragma unroll
        for (int j = 0; j < 4; ++j) { const int col = 4 * c.lane + 256 * j;
            const f32x4 g4 = *(const f32x4*)(a.in[I_GPREFFN] + col), sh = *(const f32x4*)(mr + 3072 + col), scl = *(const f32x4*)(mr + 4096 + col);
            const f32x4 hv = (x[j] * r2) * g4 * (scl + 1.f) + sh;
            v2u o; o.x = pk2(hv.x, hv.y); o.y = pk2(hv.z, hv.w);
            *(v2u*)(HX2 + (size_t)row * D + col) = o;
            x[j] = (f32x4){bflo(o.x), bfhi(o.x), bflo(o.y), bfhi(o.y)}; }
        { float mx = 0.f;
#pragma unroll
          for (int j = 0; j < 4; ++j) mx = fmaxf(mx, fmaxf(fmaxf(fabsf(x[j].x), fabsf(x[j].y)), fmaxf(fabsf(x[j].z), fabsf(x[j].w))));
          mx = wmax(mx); const float hs = mx > 0.f ? 256.f / mx : 1.f;
          unsigned char* hq = c.ws + WS_HQ8 + (size_t)row * 2048;
#pragma unroll
          for (int j = 0; j < 4; ++j) { const float a0 = x[j].x * hs, a1 = x[j].y * hs, a2 = x[j].z * hs, a3 = x[j].w * hs;
              int w = __builtin_amdgcn_cvt_pk_fp8_f32(a0, a1, 0, false); w = __builtin_amdgcn_cvt_pk_fp8_f32(a2, a3, w, true);
              const f32x2 b01 = __builtin_amdgcn_cvt_pk_f32_fp8(w, false), b23 = __builtin_amdgcn_cvt_pk_f32_fp8(w, true);
              int w2 = __builtin_amdgcn_cvt_pk_fp8_f32((a0 - b01.x) * 16.f, (a1 - b01.y) * 16.f, 0, false); w2 = __builtin_amdgcn_cvt_pk_fp8_f32((a2 - b23.x) * 16.f, (a3 - b23.y) * 16.f, w2, true);
              *(unsigned*)(hq + 4 * c.lane + 256 * j) = (unsigned)w; *(unsigned*)(hq + 1024 + 4 * c.lane + 256 * j) = (unsigned)w2; }
          if (c.lane == 0) ((float*)(c.ws + WS_HS))[row] = 1.f / hs; }
    }
}


constexpr int KROW = 136;
__device__ __forceinline__ float unfkey(unsigned k) { const unsigned u = (k & 0x80000000u) ? (k ^ 0x80000000u) : ~k; return __builtin_bit_cast(float, u); }
__device__ __forceinline__ void ins16(unsigned (&L)[16], unsigned key) {
#pragma unroll
    for (int q = 0; q < 16; ++q) { const unsigned hi = L[q] > key ? L[q] : key, lo = L[q] > key ? key : L[q]; L[q] = hi; key = lo; }
}
__device__ __forceinline__ void merge16(unsigned (&L)[16]) {
    unsigned R[16];
#pragma unroll
    for (int q = 0; q < 16; ++q) R[q] = (unsigned)__shfl_xor((int)L[15 - q], 32);
#pragma unroll
    for (int q = 0; q < 16; ++q) L[q] = L[q] > R[q] ? L[q] : R[q];
#pragma unroll
    for (int j = 8; j >= 1; j >>= 1)
#pragma unroll
        for (int q = 0; q < 16; ++q) if ((q & j) == 0) { const unsigned hi = L[q] > L[q + j] ? L[q] : L[q + j], lo = L[q] > L[q + j] ? L[q + j] : L[q]; L[q] = hi; L[q + j] = lo; }
}
__device__ __forceinline__ void phase_topk(const Ctx& c) {
    const Args& a = *c.a;
    bf16* kl = (bf16*)c.lds;
    unsigned char* wtab = c.lds + 2 * 128 * KROW * 2 + c.wave * 1088;
    const bf16* QP = (const bf16*)(c.ws + WS_QP); int* IDX = (int*)(c.ws + WS_IDX); float* GATE = (float*)(c.ws + WS_GATE);
    const int r = c.lane & 31, hh = c.lane >> 5;
    { const unsigned char ptab[50] = {0, 1, 2, 3, 4, 5, 6, 7, 8, 9, 10, 11, 12, 13, 14, 15, 16, 17, 18, 19, 20, 21, 22, 23, 32, 33, 34, 35, 36, 48, 49, 50, 51, 64, 65, 66, 80, 81, 96, 97, 112, 113, 128, 144, 160, 176, 192, 208, 224, 240};
      if (c.lane < 50) wtab[1024 + c.lane] = ptab[c.lane < 50 ? c.lane : 0]; }
    for (int item = c.bid; item < 8 * 32; item += c.G) {
        const int h = item & 7, tr = item >> 3;
        __syncthreads();
        for (int i = c.tid; i < 2 * 128 * 64; i += NTHREADS) { const int k2 = i & 63, n = (i >> 6) & 127, p = i >> 13; const f32x2 kv = *(const f32x2*)(a.in[I_KEYS] + ((size_t)((h * 2 + p) * 128 + n)) * 128 + 2 * k2);
            *(unsigned*)(kl + (p * 128 + n) * KROW + 2 * k2) = pk2(kv.x, kv.y); }
        __syncthreads();
        for (int tile = c.wave; tile < 16; tile += NWAVES) {
            const int tok = tr * 512 + tile * 32 + r;
            unsigned LA[16], LB[16];
#pragma unroll
            for (int p = 0; p < 2; ++p) {
                bf16x8 qf[8];
#pragma unroll
                for (int kk = 0; kk < 8; ++kk) qf[kk] = *(const bf16x8*)(QP + (size_t)tok * 2048 + h * 256 + p * 128 + kk * 16 + hh * 8);
                f32x16 acc[4];
#pragma unroll
                for (int nt = 0; nt < 4; ++nt)
#pragma unroll
                    for (int i = 0; i < 16; ++i) acc[nt][i] = 0.f;
#pragma unroll
                for (int kk = 0; kk < 8; ++kk)
#pragma unroll
                    for (int nt = 0; nt < 4; ++nt) acc[nt] = MFMA32(*(const bf16x8*)(kl + (p * 128 + nt * 32 + r) * KROW + kk * 16 + hh * 8), qf[kk], acc[nt]);
                unsigned (&L)[16] = p ? LB : LA;
#pragma unroll
                for (int q = 0; q < 16; ++q) L[q] = 0u;
#pragma unroll
                for (int nt = 0; nt < 4; ++nt)
#pragma unroll
                    for (int i = 0; i < 16; ++i) { const int n = nt * 32 + (i & 3) + 8 * (i >> 2) + 4 * hh; ins16(L, (fkey(acc[nt][i]) & ~127u) | (unsigned)(127 - n)); }
                merge16(L);
            }
            unsigned char* tt = wtab + r * 32;
            if (hh == 0) {
#pragma unroll
                for (int q = 0; q < 16; ++q) tt[q] = (unsigned char)(127u - (LA[q] & 127u)); }
            else {
#pragma unroll
                for (int q = 0; q < 16; ++q) tt[16 + q] = (unsigned char)(127u - (LB[q] & 127u)); }
            float va[16], vb[16];
#pragma unroll
            for (int q = 0; q < 16; ++q) { va[q] = unfkey(LA[q] & ~127u); vb[q] = unfkey(LB[q] & ~127u); }
            unsigned LC[16];
#pragma unroll
            for (int q = 0; q < 16; ++q) LC[q] = 0u;
            { const float s0 = va[0] + vb[0], s1 = va[0] + vb[1]; ins16(LC, (fkey(hh ? s1 : s0) & ~63u) | (unsigned)(63 - (0 + hh))); }
            { const float s0 = va[0] + vb[2], s1 = va[0] + vb[3]; ins16(LC, (fkey(hh ? s1 : s0) & ~63u) | (unsigned)(63 - (2 + hh))); }
            { const float s0 = va[0] + vb[4], s1 = va[0] + vb[5]; ins16(LC, (fkey(hh ? s1 : s0) & ~63u) | (unsigned)(63 - (4 + hh))); }
            { const float s0 = va[0] + vb[6], s1 = va[0] + vb[7]; ins16(LC, (fkey(hh ? s1 : s0) & ~63u) | (unsigned)(63 - (6 + hh))); }
            { const float s0 = va[0] + vb[8], s1 = va[0] + vb[9]; ins16(LC, (fkey(hh ? s1 : s0) & ~63u) | (unsigned)(63 - (8 + hh))); }
            { const float s0 = va[0] + vb[10], s1 = va[0] + vb[11]; ins16(LC, (fkey(hh ? s1 : s0) & ~63u) | (unsigned)(63 - (10 + hh))); }
            { const float s0 = va[0] + vb[12], s1 = va[0] + vb[13]; ins16(LC, (fkey(hh ? s1 : s0) & ~63u) | (unsigned)(63 - (12 + hh))); }
            { const float s0 = va[0] + vb[14], s1 = va[0] + vb[15]; ins16(LC, (fkey(hh ? s1 : s0) & ~63u) | (unsigned)(63 - (14 + hh))); }
            { const float s0 = va[1] + vb[0], s1 = va[1] + vb[1]; ins16(LC, (fkey(hh ? s1 : s0) & ~63u) | (unsigned)(63 - (16 + hh))); }
            { const float s0 = va[1] + vb[2], s1 = va[1] + vb[3]; ins16(LC, (fkey(hh ? s1 : s0) & ~63u) | (unsigned)(63 - (18 + hh))); }
            { const float s0 = va[1] + vb[4], s1 = va[1] + vb[5]; ins16(LC, (fkey(hh ? s1 : s0) & ~63u) | (unsigned)(63 - (20 + hh))); }
            { const float s0 = va[1] + vb[6], s1 = va[1] + vb[7]; ins16(LC, (fkey(hh ? s1 : s0) & ~63u) | (unsigned)(63 - (22 + hh))); }
            { const float s0 = va[2] + vb[0], s1 = va[2] + vb[1]; ins16(LC, (fkey(hh ? s1 : s0) & ~63u) | (unsigned)(63 - (24 + hh))); }
            { const float s0 = va[2] + vb[2], s1 = va[2] + vb[3]; ins16(LC, (fkey(hh ? s1 : s0) & ~63u) | (unsigned)(63 - (26 + hh))); }
            { const float s0 = va[2] + vb[4], s1 = va[3] + vb[0]; ins16(LC, (fkey(hh ? s1 : s0) & ~63u) | (unsigned)(63 - (28 + hh))); }
            { const float s0 = va[3] + vb[1], s1 = va[3] + vb[2]; ins16(LC, (fkey(hh ? s1 : s0) & ~63u) | (unsigned)(63 - (30 + hh))); }
            { const float s0 = va[3] + vb[3], s1 = va[4] + vb[0]; ins16(LC, (fkey(hh ? s1 : s0) & ~63u) | (unsigned)(63 - (32 + hh))); }
            { const float s0 = va[4] + vb[1], s1 = va[4] + vb[2]; ins16(LC, (fkey(hh ? s1 : s0) & ~63u) | (unsigned)(63 - (34 + hh))); }
            { const float s0 = va[5] + vb[0], s1 = va[5] + vb[1]; ins16(LC, (fkey(hh ? s1 : s0) & ~63u) | (unsigned)(63 - (36 + hh))); }
            { const float s0 = va[6] + vb[0], s1 = va[6] + vb[1]; ins16(LC, (fkey(hh ? s1 : s0) & ~63u) | (unsigned)(63 - (38 + hh))); }
            { const float s0 = va[7] + vb[0], s1 = va[7] + vb[1]; ins16(LC, (fkey(hh ? s1 : s0) & ~63u) | (unsigned)(63 - (40 + hh))); }
            { const float s0 = va[8] + vb[0], s1 = va[9] + vb[0]; ins16(LC, (fkey(hh ? s1 : s0) & ~63u) | (unsigned)(63 - (42 + hh))); }
            { const float s0 = va[10] + vb[0], s1 = va[11] + vb[0]; ins16(LC, (fkey(hh ? s1 : s0) & ~63u) | (unsigned)(63 - (44 + hh))); }
            { const float s0 = va[12] + vb[0], s1 = va[13] + vb[0]; ins16(LC, (fkey(hh ? s1 : s0) & ~63u) | (unsigned)(63 - (46 + hh))); }
            { const float s0 = va[14] + vb[0], s1 = va[15] + vb[0]; ins16(LC, (fkey(hh ? s1 : s0) & ~63u) | (unsigned)(63 - (48 + hh))); }
            merge16(LC);
            WAVE_LDS_SYNC();
            float ev[16]; float den = 0.f; const float mx = unfkey(LC[0] & ~63u);
#pragma unroll
            for (int q = 0; q < 16; ++q) { ev[q] = __expf(unfkey(LC[q] & ~63u) - mx); den += ev[q]; }
            const float inv = 1.f / den;
            if (hh == 0) { int ex[16];
#pragma unroll
                for (int q = 0; q < 16; ++q) { const unsigned pc = wtab[1024 + (63u - (LC[q] & 63u))]; ex[q] = (int)tt[pc >> 4] * 128 + (int)tt[16 + (pc & 15u)]; }
#pragma unroll
                for (int q = 0; q < 4; ++q) *(v4u*)(IDX + (size_t)tok * 128 + h * 16 + 4 * q) = (v4u){(unsigned)ex[4 * q], (unsigned)ex[4 * q + 1], (unsigned)ex[4 * q + 2], (unsigned)ex[4 * q + 3]}; }
            else {
#pragma unroll
                for (int q = 0; q < 4; ++q) *(f32x4*)(GATE + (size_t)tok * 128 + h * 16 + 4 * q) = (f32x4){ev[4 * q] * inv, ev[4 * q + 1] * inv, ev[4 * q + 2] * inv, ev[4 * q + 3] * inv}; }
            WAVE_LDS_SYNC();
        }
    }
}

__device__ __forceinline__ void phase_fp8_tables(const Ctx& c) {
    const Args& a = *c.a;
    for (int r = c.gw; r < 2 * NEXP; r += c.NGW) {
        const bool isv = r >= NEXP; const int e = isv ? r - NEXP : r;
        const f32x4* src = (const f32x4*)((isv ? a.in[I_PV] : a.in[I_PU]) + (size_t)e * D) + 4 * c.lane;
        f32x4 v[4]; float m = 0.f;
#pragma unroll
        for (int j = 0; j < 4; ++j) { v[j] = src[j]; m = fmaxf(m, fmaxf(fmaxf(fabsf(v[j].x), fabsf(v[j].y)), fmaxf(fabsf(v[j].z), fabsf(v[j].w)))); }
        m = wmax(m); const float inv = m > 0.f ? 256.f / m : 0.f;
        v4u o; unsigned ow[4];
#pragma unroll
        for (int j = 0; j < 4; ++j) { int w = __builtin_amdgcn_cvt_pk_fp8_f32(v[j].x * inv, v[j].y * inv, 0, false); w = __builtin_amdgcn_cvt_pk_fp8_f32(v[j].z * inv, v[j].w * inv, w, true); ow[j] = (unsigned)w; }
        o.x = ow[0]; o.y = ow[1]; o.z = ow[2]; o.w = ow[3];
        *(v4u*)(c.ws + (isv ? WS_V8 : WS_U8) + (size_t)e * D + 16 * c.lane) = o;
        if (c.lane == 0) ((float*)(c.ws + (isv ? WS_VSC : WS_USC)))[e] = m * (1.f / 256.f);
    }
}
__device__ __forceinline__ void fp8x16_to_f32(const v4u& r, float (&f)[16]) {
    const unsigned w[4] = {r.x, r.y, r.z, r.w};
#pragma unroll
    for (int j = 0; j < 4; ++j) { const f32x2 lo = __builtin_amdgcn_cvt_pk_f32_fp8((int)w[j], false), hi = __builtin_amdgcn_cvt_pk_f32_fp8((int)w[j], true); f[4 * j] = lo.x; f[4 * j + 1] = lo.y; f[4 * j + 2] = hi.x; f[4 * j + 3] = hi.y; }
}
__device__ __forceinline__ unsigned xcc_id() { return (unsigned)__builtin_amdgcn_s_getreg((3 << 11) | 20) & 7u; }

typedef long l64x2 __attribute__((ext_vector_type(2)));
struct E1Bat { l64x2 rw[16]; };
__device__ __forceinline__ void phase_exp1(const Ctx& c) {
    typedef float f32x4m __attribute__((ext_vector_type(4)));
    const int* IDX = (const int*)(c.ws + WS_IDX); const unsigned char* U8 = c.ws + WS_U8; float* PACT = (float*)(c.ws + WS_PACT);
    unsigned* cnt = (unsigned*)(c.ws + WS_CTL) + CW_E1;
    constexpr int CH = 4;
    constexpr int SROW = 144;
    unsigned char* wl = c.lds + c.wave * 8704; int* le = (int*)wl; unsigned char* himg = wl + 2048; float* res = (float*)(wl + 3072); unsigned char* stage = wl + 3584;
    const int xcc = (int)xcc_id(), r16 = c.lane & 15, g4 = c.lane >> 4, row8 = c.lane >> 3, pc8 = c.lane & 7; const bool bcol = r16 < 2;
    int bo = 0;
    for (;;) {
        const int x = (xcc + bo) & 7;
        unsigned t0 = 0; if (c.lane == 0) t0 = __hip_atomic_fetch_add(cnt + 64 * x, (unsigned)CH, __ATOMIC_RELAXED, __HIP_MEMORY_SCOPE_AGENT);
        t0 = (unsigned)__builtin_amdgcn_readfirstlane((int)t0);
        if (t0 >= (unsigned)ML) { if (++bo >= 8) break; continue; }
        { const v4u e0 = *(const v4u*)(IDX + (size_t)t0 * 128 + 4 * c.lane), e1 = *(const v4u*)(IDX + (size_t)t0 * 128 + 256 + 4 * c.lane);
          const v4u im = *(const v4u*)(c.ws + WS_HQ8 + ((size_t)t0 + (c.lane >> 4)) * 2048 + ((c.lane >> 3) & 1) * 1024 + 128 * x + 16 * (c.lane & 7));
          *(v4u*)(le + 4 * c.lane) = e0; *(v4u*)(le + 256 + 4 * c.lane) = e1; *(v4u*)(himg + 16 * c.lane) = im; }
        WAVE_LDS_SYNC();
#define E1_LOAD(G, B) do { const int bb = (B) < CH ? (B) : 0; _Pragma("unroll") for (int i = 0; i < 16; ++i) G.rw[i] = *(const l64x2*)(U8 + (size_t)le[bb * 128 + 8 * i + row8] * D + 128 * x + 16 * pc8); } while (0)
#define E1_COMP(G, B) do { const unsigned char* hb = himg + ((B) * 2 + (r16 & 1)) * 128 + 32 * g4; long bq[4]; _Pragma("unroll") for (int m = 0; m < 4; ++m) { const long v = *(const long*)(hb + 8 * m); bq[m] = bcol ? v : 0l; } \
            _Pragma("unroll") for (int gi = 0; gi < 8; ++gi) { unsigned char* sb = stage + (gi & 1) * (16 * SROW); \
                *(l64x2*)(sb + row8 * SROW + 16 * pc8) = G.rw[2 * gi]; *(l64x2*)(sb + (8 + row8) * SROW + 16 * pc8) = G.rw[2 * gi + 1]; \
                WAVE_LDS_SYNC(); \
                const l64x2 a01 = *(const l64x2*)(sb + r16 * SROW + 32 * g4), a23 = *(const l64x2*)(sb + r16 * SROW + 32 * g4 + 16); \
                f32x4m acc = {0.f, 0.f, 0.f, 0.f}; \
                acc = __builtin_amdgcn_mfma_f32_16x16x32_fp8_fp8(a01.x, bq[0], acc, 0, 0, 0); acc = __builtin_amdgcn_mfma_f32_16x16x32_fp8_fp8(a01.y, bq[1], acc, 0, 0, 0); \
                acc = __builtin_amdgcn_mfma_f32_16x16x32_fp8_fp8(a23.x, bq[2], acc, 0, 0, 0); acc = __builtin_amdgcn_mfma_f32_16x16x32_fp8_fp8(a23.y, bq[3], acc, 0, 0, 0); \
                _Pragma("unroll") for (int q = 0; q < 4; ++q) { const float lo = dppf<0xB1>(acc[q]); if (r16 == 0) res[gi * 16 + 4 * g4 + q] = acc[q] + lo * 0.0625f; } } \
            WAVE_LDS_SYNC(); \
            { float* po = PACT + (size_t)x * ((size_t)ML * 128) + ((size_t)t0 + (B)) * 128; po[c.lane] = res[c.lane]; po[64 + c.lane] = res[64 + c.lane]; } \
            WAVE_LDS_SYNC(); } while (0)
        E1Bat ga, gb;
        E1_LOAD(ga, 0);
#pragma unroll 1
        for (int b2 = 0; b2 < CH; b2 += 2) {
            E1_LOAD(gb, b2 + 1);
            __builtin_amdgcn_sched_barrier(0);
            E1_COMP(ga, b2);
            __builtin_amdgcn_sched_barrier(0);
            E1_LOAD(ga, b2 + 2);
            __builtin_amdgcn_sched_barrier(0);
            E1_COMP(gb, b2 + 1);
            __builtin_amdgcn_sched_barrier(0);
        }
#undef E1_LOAD
#undef E1_COMP
    }
}
__device__ __forceinline__ void phase_exp1b(const Ctx& c) {
    const int* IDX = (const int*)(c.ws + WS_IDX); const float* GATE = (const float*)(c.ws + WS_GATE); const float* HS = (const float*)(c.ws + WS_HS); const float* PACT = (const float*)(c.ws + WS_PACT);
    const float* USC = (const float*)(c.ws + WS_USC); const float* VSC = (const float*)(c.ws + WS_VSC); float* ACT = (float*)(c.ws + WS_ACT);
    for (size_t i = (size_t)c.bid * NTHREADS + c.tid; i < (size_t)ML * 128; i += (size_t)c.G * NTHREADS) {
        float s = 0.f;
#pragma unroll
        for (int x = 0; x < 8; ++x) s += PACT[(size_t)x * ((size_t)ML * 128) + i];
        const int e = IDX[i];
        ACT[i] = gelu_erf(s * HS[i >> 7] * USC[e]) * GATE[i] * VSC[e];
    }
}
__device__ __forceinline__ void phase_exp2(const Ctx& c) {
    const int* IDX = (const int*)(c.ws + WS_IDX); const float* ACT = (const float*)(c.ws + WS_ACT); const unsigned char* V8 = c.ws + WS_V8;
    float* Y = (float*)(c.ws + WS_Y); float* SSQP = (float*)(c.ws + WS_SSQP);
    unsigned* cnt = (unsigned*)(c.ws + WS_CTL) + CW_E2;
    int* li = (int*)(c.lds + c.wave * 1024); float* la = (float*)(li + 128);
    const int xcc = (int)xcc_id(), sub = c.lane & 7, grp = c.lane >> 3;
    const bool b5 = c.lane & 32, b4 = c.lane & 16, b3 = c.lane & 8;
    constexpr int CH = 8;
    int bo = 0, t = 0, tend = 0;
    int iA = 0, iB = 0; float aA = 0.f, aB = 0.f;
    for (;;) {
        if (t >= tend) {
            unsigned t0 = 0; if (c.lane == 0) t0 = __hip_atomic_fetch_add(cnt + 64 * ((xcc + bo) & 7), (unsigned)CH, __ATOMIC_RELAXED, __HIP_MEMORY_SCOPE_AGENT);
            t0 = (unsigned)__builtin_amdgcn_readfirstlane((int)t0);
            if (t0 >= (unsigned)ML) { if (++bo >= 8) break; continue; }
            t = (int)t0; tend = t + CH;
            iA = IDX[(size_t)t * 128 + c.lane]; iB = IDX[(size_t)t * 128 + 64 + c.lane]; aA = ACT[(size_t)t * 128 + c.lane]; aB = ACT[(size_t)t * 128 + 64 + c.lane];
        }
        const int x = (xcc + bo) & 7;
        li[c.lane] = iA; li[64 + c.lane] = iB; la[c.lane] = aA; la[64 + c.lane] = aB;
        if (t + 1 < tend) { iA = IDX[(size_t)(t + 1) * 128 + c.lane]; iB = IDX[(size_t)(t + 1) * 128 + 64 + c.lane]; aA = ACT[(size_t)(t + 1) * 128 + c.lane]; aB = ACT[(size_t)(t + 1) * 128 + 64 + c.lane]; }
        WAVE_LDS_SYNC();
        float acc[16];
#pragma unroll
        for (int q = 0; q < 16; ++q) acc[q] = 0.f;
#pragma unroll
        for (int hf = 0; hf < 2; ++hf) { v4u rows[8]; float av[8];
#pragma unroll
            for (int i = 0; i < 8; ++i) { const int k = 8 * (8 * hf + i) + grp; rows[i] = *(const v4u*)(V8 + (size_t)li[k] * D + x * 128 + 16 * sub); av[i] = la[k]; }
#pragma unroll
            for (int i = 0; i < 8; ++i) { float f[16]; fp8x16_to_f32(rows[i], f);
#pragma unroll
                for (int q = 0; q < 16; ++q) acc[q] = fmaf(av[i], f[q], acc[q]); } }
        float q8[8], q4[4], q2[2];
#pragma unroll
        for (int i = 0; i < 8; ++i) { const float keep = b5 ? acc[i + 8] : acc[i], send = b5 ? acc[i] : acc[i + 8]; q8[i] = keep + __shfl_xor(send, 32); }
#pragma unroll
        for (int i = 0; i < 4; ++i) { const float keep = b4 ? q8[i + 4] : q8[i], send = b4 ? q8[i] : q8[i + 4]; q4[i] = keep + __shfl_xor(send, 16); }
#pragma unroll
        for (int i = 0; i < 2; ++i) { const float keep = b3 ? q4[i + 2] : q4[i], send = b3 ? q4[i] : q4[i + 2]; q2[i] = keep + __shfl_xor(send, 8); }
        const int col = x * 128 + 16 * sub + (b5 ? 8 : 0) + (b4 ? 4 : 0) + (b3 ? 2 : 0);
        *(f32x2*)(Y + (size_t)t * D + col) = (f32x2){q2[0], q2[1]};
        const float ss = wsum(q2[0] * q2[0] + q2[1] * q2[1]);
        SSQP[(size_t)x * ML + t] = ss;
        WAVE_LDS_SYNC();
        ++t;
    }
}
__device__ __forceinline__ void phase_exp3(const Ctx& c) {
    const Args& a = *c.a;
    const float* MOD = (const float*)(c.ws + WS_MOD); const float* Y = (const float*)(c.ws + WS_Y); const float* SSQP = (const float*)(c.ws + WS_SSQP);
    f32x4 ny[4], nx[4]; float nss = 0.f;
#define E3_LOAD(R) do { _Pragma("unroll") for (int j = 0; j < 4; ++j) { const int col = 4 * c.lane + 256 * j; ny[j] = *(const f32x4*)(Y + (size_t)(R) * D + col); nx[j] = *(const f32x4*)(a.out + (size_t)(R) * D + col); } \
        nss = (c.lane < 8) ? SSQP[(size_t)c.lane * ML + (R)] : 0.f; } while (0)
    if (c.gw < ML) E3_LOAD(c.gw);
    for (int row = c.gw; row < ML; row += c.NGW) {
        f32x4 y[4], x1[4];
#pragma unroll
        for (int j = 0; j < 4; ++j) { y[j] = ny[j]; x1[j] = nx[j]; }
        const float ss = row_sum16(nss);
        const float tot = __builtin_bit_cast(float, __builtin_amdgcn_readlane(__builtin_bit_cast(int, ss), 0));
        if (row + c.NGW < ML) E3_LOAD(row + c.NGW);
        const float r = rsqrtf(tot * (1.f / D) + EPS); const float* mr = MOD + (row >> 11) * 6144 + 5120;
#pragma unroll
        for (int j = 0; j < 4; ++j) { const int col = 4 * c.lane + 256 * j;
            const f32x4 g4 = *(const f32x4*)(a.in[I_GPOSTFFN] + col), gt = *(const f32x4*)(mr + col);
            *(f32x4*)(a.out + (size_t)row * D + col) = x1[j] + gt * ((y[j] * r) * g4); }
    }
#undef E3_LOAD
}

constexpr int S5_LPOW = 0, S5_BBAR = 33792, S5_CC = 50176, S5_MM = 66560;
__device__ __forceinline__ void s5_build_group(const Ctx& c, int g, int part) {
    const Args& a = *c.a;
    f32x2* LPOW = (f32x2*)(c.lds + S5_LPOW);
    f32x2* BBAR = (f32x2*)(c.lds + S5_BBAR);
    f32x2* CC = (f32x2*)(c.lds + S5_CC);
    float* MM = (float*)(c.lds + S5_MM);
    __syncthreads();
    if (c.tid < 128) { const int dir = c.tid >> 6, p = c.tid & 63, dg = dir * 32 + g;
        const float dt = expf(a.in[I_LOGDT][dg]), lr = a.in[I_LAMRE][dg * 64 + p], li = a.in[I_LAMIM][dg * 64 + p];
        const double ang = (double)li * (double)dt; const float lrdt = lr * dt;
        for (int e = 0; e <= 32; ++e) { float sn, cs; sincos_d(ang * (double)e, sn, cs); const float mg = expf(lrdt * (float)e); LPOW[(dir * 33 + e) * 64 + p] = (f32x2){mg * cs, mg * sn}; }
        float sn, cs; sincos_d(ang, sn, cs); const float mag = expf(lrdt), lbr = mag * cs, lbi = mag * sn, den = lr * lr + li * li, nr = lbr - 1.f;
        const float cr = (nr * lr + lbi * li) / den, ci = (lbi * lr - nr * li) / den;
        for (int ch = 0; ch < 16; ++ch) { const float br = a.in[I_BRE][(size_t)(dg * 64 + p) * 16 + ch], bi = a.in[I_BIM][(size_t)(dg * 64 + p) * 16 + ch]; BBAR[(dir * 64 + p) * 16 + ch] = (f32x2){cr * br - ci * bi, cr * bi + ci * br}; } }
    for (int i = c.tid; i < 2048; i += NTHREADS) { const int dir = i >> 10, ch = (i >> 6) & 15, p = i & 63, dg = dir * 32 + g; CC[i] = (f32x2){a.in[I_CRE][(size_t)(dg * 16 + ch) * 64 + p], a.in[I_CIM][(size_t)(dg * 16 + ch) * 64 + p]}; }
    __syncthreads();
    for (int task = c.tid; task < 1024; task += NTHREADS) { const int cpb = task & 3, cb = (task >> 2) & 3, lag = (task >> 4) & 31, dir = task >> 9;
        float acc[4][4];
#pragma unroll
        for (int i = 0; i < 4; ++i)
#pragma unroll
            for (int j = 0; j < 4; ++j) acc[i][j] = 0.f;
        for (int p = 0; p < 64; ++p) { const f32x2 l = LPOW[(dir * 33 + lag) * 64 + p]; f32x2 G[4], Cw[4];
#pragma unroll
            for (int j = 0; j < 4; ++j) { const f32x2 bb = BBAR[(dir * 64 + p) * 16 + 4 * cpb + j]; G[j] = (f32x2){l.x * bb.x - l.y * bb.y, l.x * bb.y + l.y * bb.x}; }
#pragma unroll
            for (int i = 0; i < 4; ++i) Cw[i] = CC[(dir * 16 + 4 * cb + i) * 64 + p];
#pragma unroll
            for (int i = 0; i < 4; ++i)
#pragma unroll
                for (int j = 0; j < 4; ++j) acc[i][j] += Cw[i].x * G[j].x - Cw[i].y * G[j].y; }
#pragma unroll
        for (int i = 0; i < 4; ++i)
#pragma unroll
            for (int j = 0; j < 4; ++j) MM[((dir * 32 + lag) * 16 + 4 * cb + i) * 16 + 4 * cpb + j] = acc[i][j]; }
    __syncthreads();
    if (c.tid < 128 && part == 0) { const int dir = c.tid >> 6, p = c.tid & 63; ((f32x2*)(c.ws + WS_LP))[(dir * 32 + g) * 64 + p] = LPOW[(dir * 33 + 32) * 64 + p]; }
    bf16* PMg = (bf16*)(c.ws + WS_PM) + (size_t)g * 256 * 512; bf16* BBg = (bf16*)(c.ws + WS_BB) + (size_t)g * 512 * 768;
    for (int task = part * 32 * 32 + c.tid; task < (part + 1) * 32 * 32; task += NTHREADS) { const int ip = task & 31, n = task >> 5, dir = n >> 7, im = (n >> 6) & 1, p = n & 63, e = dir ? ip : 31 - ip;
        const f32x2 l = LPOW[(dir * 33 + e) * 64 + p]; float o[16];
#pragma unroll
        for (int ch = 0; ch < 16; ++ch) { const f32x2 bb = BBAR[(dir * 64 + p) * 16 + ch]; o[ch] = im ? (l.x * bb.y + l.y * bb.x) : (l.x * bb.x - l.y * bb.y); }
        v4u w0, w1; w0.x = pk2(o[0], o[1]); w0.y = pk2(o[2], o[3]); w0.z = pk2(o[4], o[5]); w0.w = pk2(o[6], o[7]); w1.x = pk2(o[8], o[9]); w1.y = pk2(o[10], o[11]); w1.z = pk2(o[12], o[13]); w1.w = pk2(o[14], o[15]);
        *(v4u*)(PMg + (size_t)n * 512 + ip * 16) = w0; *(v4u*)(PMg + (size_t)n * 512 + ip * 16 + 8) = w1; }
    for (int task = part * 64 * 32 + c.tid; task < (part + 1) * 64 * 32; task += NTHREADS) { const int ip = task & 31, n = task >> 5, i = n >> 4, ch = n & 15; float o[16];
#pragma unroll
        for (int q = 0; q < 16; ++q) o[q] = 0.f;
        if (ip <= i) { const float* m0 = MM + ((0 * 32 + (i - ip)) * 16 + ch) * 16;
#pragma unroll
            for (int q = 0; q < 16; ++q) o[q] += m0[q]; }
        if (ip >= i) { const float* m1 = MM + ((1 * 32 + (ip - i)) * 16 + ch) * 16;
#pragma unroll
            for (int q = 0; q < 16; ++q) o[q] += m1[q]; }
        if (ip == i) { const float dsk = a.in[I_S5D][g * 16 + ch];
#pragma unroll
            for (int q = 0; q < 16; ++q) o[q] += (q == ch) ? dsk : 0.f; }
        v4u w0, w1; w0.x = pk2(o[0], o[1]); w0.y = pk2(o[2], o[3]); w0.z = pk2(o[4], o[5]); w0.w = pk2(o[6], o[7]); w1.x = pk2(o[8], o[9]); w1.y = pk2(o[10], o[11]); w1.z = pk2(o[12], o[13]); w1.w = pk2(o[14], o[15]);
        *(v4u*)(BBg + (size_t)n * 768 + ip * 16) = w0; *(v4u*)(BBg + (size_t)n * 768 + ip * 16 + 8) = w1; }
    for (int task = part * 64 * 32 + c.tid; task < (part + 1) * 64 * 32; task += NTHREADS) { const int p8 = task & 7, part = (task >> 3) & 3, n = task >> 5, i = n >> 4, ch = n & 15, dir = part >> 1, im = part & 1, e = dir ? 32 - i : i + 1; float o[8];
#pragma unroll
        for (int q = 0; q < 8; ++q) { const int p = p8 * 8 + q; const f32x2 l = LPOW[(dir * 33 + e) * 64 + p], cc = CC[(dir * 16 + ch) * 64 + p]; o[q] = im ? -(cc.x * l.y + cc.y * l.x) : (cc.x * l.x - cc.y * l.y); }
        v4u w0; w0.x = pk2(o[0], o[1]); w0.y = pk2(o[2], o[3]); w0.z = pk2(o[4], o[5]); w0.w = pk2(o[6], o[7]);
        *(v4u*)(BBg + (size_t)n * 768 + 512 + part * 64 + p8 * 8) = w0; }
}
__device__ __forceinline__ void s5_state_scan(const Ctx& c, int task) {
    const int dir = task & 1, g = (task >> 1) & 31, b = task >> 6, p = c.lane;
    const f32x2 a = ((const f32x2*)(c.ws + WS_LP))[(dir * 32 + g) * 64 + p];
    const float* SS = (const float*)(c.ws + WS_SS) + (size_t)g * 768 * 256 + dir * 128 + p; bf16* U5 = (bf16*)(c.ws + WS_U5) + (size_t)g * 768 * 768 + 512 + dir * 128 + p;
    float er = 0.f, ei = 0.f;
#pragma unroll 8
    for (int step = 0; step < 72; ++step) {
        const int R = (step < 8) ? 512 + b * 8 + (dir ? 7 - step : step) : b * 64 + (dir ? 71 - step : step - 8);
        if (step >= 8) { U5[(size_t)R * 768] = (bf16)f2bf(er); U5[(size_t)R * 768 + 64] = (bf16)f2bf(ei); }
        const float sr = SS[(size_t)R * 256], si = SS[(size_t)R * 256 + 64];
        const float nr = sr + a.x * er - a.y * ei, ni = si + a.x * ei + a.y * er; er = nr; ei = ni;
    }
}

constexpr int GDN_NCH = 36, GDN_ITEMS = NB * 4 * 2 * GDN_NCH;
constexpr size_t FR_T_BYTES = 8192, FR_ATT_BYTES = 8192, FR_KD_BYTES = 16384, FR_TAB_BYTES = 1024;
__device__ __forceinline__ int crow16(int i, int hh) { return (i & 3) + 8 * (i >> 2) + 4 * hh; }
__device__ __forceinline__ bf16x8 pack_step(const f32x16& x, int s) {
    v4u w; w.x = pk2(x[8 * s + 0], x[8 * s + 1]); w.y = pk2(x[8 * s + 2], x[8 * s + 3]); w.z = pk2(x[8 * s + 4], x[8 * s + 5]); w.w = pk2(x[8 * s + 6], x[8 * s + 7]);
    return __builtin_bit_cast(bf16x8, w);
}
__device__ __forceinline__ unsigned pk2v(float lo, float hi) { asm volatile("" : "+v"(lo), "+v"(hi)); return pk2(lo, hi); }
__device__ __forceinline__ bf16x8 pack_step_v(const f32x16& x, int s) {
    v4u w; w.x = pk2v(x[8 * s + 0], x[8 * s + 1]); w.y = pk2v(x[8 * s + 2], x[8 * s + 3]); w.z = pk2v(x[8 * s + 4], x[8 * s + 5]); w.w = pk2v(x[8 * s + 6], x[8 * s + 7]);
    return __builtin_bit_cast(bf16x8, w);
}
constexpr int GP_KR = 0, GP_QR = 17408, GP_KT = 34816, GP_TAB = 53248, GP_LP = 54272, GP_LPB = 8448 + 256;
__host__ __device__ constexpr int LOFF(int i) { return i < 1 ? 0 : 4 * (((i - 1) >> 2) + 1) * (2 * ((i - 1) >> 2) + ((i - 1) & 3)); }
static_assert(LOFF(1) == 0 && LOFF(2) == 4 && LOFF(5) == 16 && LOFF(6) == 24 && LOFF(64) == 2112, "packed lower-triangular row offsets");
__device__ __forceinline__ void gdn_prep_stage(const Ctx& c, int item, float* Lp) {
    const int n = item % GDN_NCH, bhd = item / GDN_NCH, dir = bhd & 1, h = (bhd >> 1) & 3, b = bhd >> 3;
    const bf16* QKV = (const bf16*)(c.ws + WS_QKV); const float* GB = (const float*)(c.ws + WS_GB);
    bf16* Kr = (bf16*)(c.lds + GP_KR); bf16* Qr = (bf16*)(c.lds + GP_QR); bf16* Kt = (bf16*)(c.lds + GP_KT); float* tab = (float*)(c.lds + GP_TAB);
    unsigned char* frA = c.ws + WS_FRA + (size_t)item * FR_ATT_BYTES; unsigned char* frK = c.ws + WS_FRK + (size_t)item * FR_KD_BYTES; float* frTab = (float*)(c.ws + WS_FRTAB + (size_t)item * FR_TAB_BYTES);
    const int r = c.lane & 31, hh = c.lane >> 5;
    if (c.wave == 0) { const int row = scan_row(b, dir, n * 64 + c.lane); float g = GB[(size_t)row * 16 + dir * 4 + h]; const float beta = GB[(size_t)row * 16 + 8 + dir * 4 + h];
#pragma unroll
        for (int o = 1; o < 64; o <<= 1) { const float t = __shfl_up(g, o); if (c.lane >= o) g += t; }
        const float gl = __shfl(g, 63);
        tab[c.lane] = g; tab[64 + c.lane] = beta; tab[128 + c.lane] = __expf(g); tab[192 + c.lane] = __expf(gl - g); }
    { const int s = c.tid >> 3, seg = c.tid & 7; const int row = scan_row(b, dir, n * 64 + s); const bf16* rp = QKV + (size_t)row * 1536 + h * 128 + seg * 16;
      const v4u q0 = *(const v4u*)rp, q1 = *(const v4u*)(rp + 8), k0 = *(const v4u*)(rp + 512), k1 = *(const v4u*)(rp + 520);
      *(v4u*)(Qr + s * 136 + seg * 16) = q0; *(v4u*)(Qr + s * 136 + seg * 16 + 8) = q1; *(v4u*)(Kr + s * 136 + seg * 16) = k0; *(v4u*)(Kr + s * 136 + seg * 16 + 8) = k1;
      const unsigned kw[8] = {k0.x, k0.y, k0.z, k0.w, k1.x, k1.y, k1.z, k1.w};
#pragma unroll
      for (int e = 0; e < 8; ++e) { Kt[(seg * 16 + 2 * e) * 72 + s] = (bf16)(kw[e] & 0xffffu); Kt[(seg * 16 + 2 * e + 1) * 72 + s] = (bf16)(kw[e] >> 16); } }
    __syncthreads();
    if (c.wave < 3) { const int ct = c.wave ? 1 : 0, st = c.wave == 2 ? 1 : 0;
        f32x16 acc;
#pragma unroll
        for (int i = 0; i < 16; ++i) acc[i] = 0.f;
#pragma unroll
        for (int kk = 0; kk < 8; ++kk) { const bf16x8 a = *(const bf16x8*)(Kr + (ct * 32 + r) * 136 + kk * 16 + hh * 8), bb = *(const bf16x8*)(Kr + (st * 32 + r) * 136 + kk * 16 + hh * 8); acc = MFMA32(a, bb, acc); }
        const int s = st * 32 + r; const float gcs = tab[s];
#pragma unroll
        for (int i = 0; i < 16; ++i) { const int cc = ct * 32 + crow16(i, hh); if (s < cc) Lp[LOFF(cc) + s] = tab[64 + cc] * acc[i] * __expf(tab[cc] - gcs); }
    } else if (c.wave < 6) { const int w = c.wave - 3, st = w == 2 ? 1 : 0, ct = w ? 1 : 0;
        f32x16 acc;
#pragma unroll
        for (int i = 0; i < 16; ++i) acc[i] = 0.f;
#pragma unroll
        for (int kk = 0; kk < 8; ++kk) { const bf16x8 a = *(const bf16x8*)(Kr + (st * 32 + r) * 136 + kk * 16 + hh * 8), bb = *(const bf16x8*)(Qr + (ct * 32 + r) * 136 + kk * 16 + hh * 8); acc = MFMA32(a, bb, acc); }
        const int cc = ct * 32 + r; const float gcc = tab[cc];
#pragma unroll
        for (int i = 0; i < 16; ++i) { const int s = st * 32 + crow16(i, hh); acc[i] = (s <= cc) ? acc[i] * __expf(gcc - tab[s]) : 0.f; }
        *(bf16x8*)(frA + ((size_t)((ct * 4 + 2 * st) * 64 + c.lane)) * 16) = pack_step(acc, 0);
        *(bf16x8*)(frA + ((size_t)((ct * 4 + 2 * st + 1) * 64 + c.lane)) * 16) = pack_step(acc, 1);
    } else { const int w = c.wave - 6;
#pragma unroll
        for (int f = 0; f < 8; ++f) { const int fi = w * 8 + f, dkt = fi >> 2, cb = fi & 3; const bf16* kp = Kt + (dkt * 32 + r) * 72 + 16 * cb + 4 * hh;
            const v2u lo = *(const v2u*)kp, hi = *(const v2u*)(kp + 8); const f32x4 e0 = *(const f32x4*)(tab + 192 + 16 * cb + 4 * hh), e1 = *(const f32x4*)(tab + 192 + 16 * cb + 8 + 4 * hh);
            v4u o; o.x = pk2(bflo(lo.x) * e0.x, bfhi(lo.x) * e0.y); o.y = pk2(bflo(lo.y) * e0.z, bfhi(lo.y) * e0.w); o.z = pk2(bflo(hi.x) * e1.x, bfhi(hi.x) * e1.y); o.w = pk2(bflo(hi.y) * e1.z, bfhi(hi.y) * e1.w);
            *(v4u*)(frK + ((size_t)(fi * 64 + c.lane)) * 16) = o; }
        if (w == 0) { const v4u z = (v4u){0u, 0u, 0u, 0u}; *(v4u*)(frA + ((size_t)((0 * 4 + 2) * 64 + c.lane)) * 16) = z; *(v4u*)(frA + ((size_t)((0 * 4 + 3) * 64 + c.lane)) * 16) = z; }
        else { *(f32x4*)(frTab + 4 * c.lane) = *(const f32x4*)(tab + 4 * c.lane); }
    }
    __syncthreads();
}
__device__ __forceinline__ void gdn_prep_solve(const Ctx& c, int item, float* Lp) {
    float Tr[64];
#pragma unroll
    for (int i = 0; i < 64; ++i) { int le_ = c.lane; asm volatile("" : "+v"(le_)); float a0 = (le_ == i) ? 1.f : 0.f, a1 = 0.f;
#pragma unroll
        for (int s4 = 0; s4 < (i + 3) / 4; ++s4) { const f32x4 l4 = *(const f32x4*)(Lp + LOFF(i) + 4 * s4);
            if (4 * s4 + 0 < i) a0 = fmaf(-l4.x, Tr[4 * s4 + 0], a0); if (4 * s4 + 1 < i) a1 = fmaf(-l4.y, Tr[4 * s4 + 1], a1); if (4 * s4 + 2 < i) a0 = fmaf(-l4.z, Tr[4 * s4 + 2], a0); if (4 * s4 + 3 < i) a1 = fmaf(-l4.w, Tr[4 * s4 + 3], a1); }
        Tr[i] = a0 + a1; { int lo_ = c.lane; asm volatile("" : "+v"(lo_)); Lp[(lo_ < i) ? LOFF(i) + lo_ : 2112 + lo_] = Tr[i]; } }
    WAVE_LDS_SYNC();
    unsigned char* frT = c.ws + WS_FRT + (size_t)item * FR_T_BYTES;
    const int r = c.lane & 31, hh = c.lane >> 5;
#pragma unroll
    for (int f = 0; f < 8; ++f) { const int ct = f >> 2, sb = f & 3, cc = ct * 32 + r; float v[8];
#pragma unroll
        for (int q = 0; q < 2; ++q) { const int s0 = 16 * sb + 8 * q + 4 * hh;
            f32x4 t4 = (f32x4){0.f, 0.f, 0.f, 0.f}; if (s0 < cc) t4 = *(const f32x4*)(Lp + LOFF(cc) + s0);
            v[4 * q + 0] = (s0 + 0 < cc) ? t4.x : (s0 + 0 == cc ? 1.f : 0.f); v[4 * q + 1] = (s0 + 1 < cc) ? t4.y : (s0 + 1 == cc ? 1.f : 0.f);
            v[4 * q + 2] = (s0 + 2 < cc) ? t4.z : (s0 + 2 == cc ? 1.f : 0.f); v[4 * q + 3] = (s0 + 3 < cc) ? t4.w : (s0 + 3 == cc ? 1.f : 0.f); }
        *(v4u*)(frT + ((size_t)(f * 64 + c.lane)) * 16) = (v4u){pk2(v[0], v[1]), pk2(v[2], v[3]), pk2(v[4], v[5]), pk2(v[6], v[7])}; }
}
__device__ __forceinline__ void phase_gdn_prep(const Ctx& c) {
    for (int base = c.bid; base < GDN_ITEMS; base += 8 * c.G) {
        int cnt = 0;
#pragma unroll 1
        for (int q = 0; q < 8; ++q) { const int item = base + q * c.G; if (item < GDN_ITEMS) { gdn_prep_stage(c, item, (float*)(c.lds + GP_LP + q * GP_LPB)); cnt = q + 1; } }
        if (c.wave < cnt) gdn_prep_solve(c, base + c.wave * c.G, (float*)(c.lds + GP_LP + c.wave * GP_LPB));
        __syncthreads();
    }
}

constexpr int GR_K = 0, GR_Q = 16384, GR_T = 32768, GR_A = 40960, GR_KD = 49152, GR_TAB = 65536, GR_BUF = 66560;
__device__ __forceinline__ void gdn_rec_stage(const Ctx& c, int bhd, int n, int buf) {
    const int dir = bhd & 1, h = (bhd >> 1) & 3, b = bhd >> 3, lw = c.wave - 4; const int item = bhd * GDN_NCH + n;
    LAS unsigned char* base = (LAS unsigned char*)c.lds + buf * GR_BUF;
    const unsigned char* QKVb = c.ws + WS_QKV;
#pragma unroll
    for (int q = 0; q < 4; ++q) { const int qi = lw + 4 * q;
        const int s = 4 * qi + (c.lane >> 4), ps = c.lane & 15, p = ps ^ (s & 15); const size_t rowb = (size_t)scan_row(b, dir, n * 64 + s) * 3072 + (size_t)h * 256 + p * 16;
        __builtin_amdgcn_global_load_lds((const unsigned*)(QKVb + rowb + 1024), (LAS unsigned*)(base + GR_K + qi * 1024), 16, 0, 0);
        __builtin_amdgcn_global_load_lds((const unsigned*)(QKVb + rowb), (LAS unsigned*)(base + GR_Q + qi * 1024), 16, 0, 0); }
    const unsigned char* frT = c.ws + WS_FRT + (size_t)item * FR_T_BYTES; const unsigned char* frA = c.ws + WS_FRA + (size_t)item * FR_ATT_BYTES; const unsigned char* frK = c.ws + WS_FRK + (size_t)item * FR_KD_BYTES;
#pragma unroll
    for (int q = 0; q < 2; ++q) { const int qi = lw + 4 * q;
        __builtin_amdgcn_global_load_lds((const unsigned*)(frT + qi * 1024 + c.lane * 16), (LAS unsigned*)(base + GR_T + qi * 1024), 16, 0, 0);
        __builtin_amdgcn_global_load_lds((const unsigned*)(frA + qi * 1024 + c.lane * 16), (LAS unsigned*)(base + GR_A + qi * 1024), 16, 0, 0); }
#pragma unroll
    for (int q = 0; q < 4; ++q) { const int qi = lw + 4 * q;
        __builtin_amdgcn_global_load_lds((const unsigned*)(frK + qi * 1024 + c.lane * 16), (LAS unsigned*)(base + GR_KD + qi * 1024), 16, 0, 0); }
    if (lw == 0) __builtin_amdgcn_global_load_lds((const unsigned*)(c.ws + WS_FRTAB + (size_t)item * FR_TAB_BYTES + c.lane * 16), (LAS unsigned*)(base + GR_TAB), 16, 0, 0);
}
__device__ __forceinline__ bf16x8 gr_rowfrag(const unsigned char* rowp, const int (&po)[16], int kb) {
    const v2u lo = *(const v2u*)(rowp + po[2 * kb]), hi = *(const v2u*)(rowp + po[2 * kb + 1]);
    return __builtin_bit_cast(bf16x8, (v4u){lo.x, lo.y, hi.x, hi.y});
}
__device__ __forceinline__ void gdn_rec_block(const Ctx& c, int bhd) {
    const int dir = bhd & 1, h = (bhd >> 1) & 3, b = bhd >> 3, r = c.lane & 31, hh = c.lane >> 5, dvt = c.wave;
    const bf16* QKV = (const bf16*)(c.ws + WS_QKV); bf16* OG = (bf16*)(c.ws + WS_OG) + (size_t)dir * ML * 512;
    f32x16 S[4];
#pragma unroll
    for (int t = 0; t < 4; ++t)
#pragma unroll
        for (int i = 0; i < 16; ++i) S[t][i] = 0.f;
    int po[16];
#pragma unroll
    for (int p = 0; p < 16; ++p) po[p] = r * 256 + ((p ^ (r & 15)) * 16) + 8 * hh;
    if (c.wave >= 4) gdn_rec_stage(c, bhd, 0, 0);
    asm volatile("s_waitcnt vmcnt(0)" ::: "memory"); __syncthreads();
    for (int n = 0; n < GDN_NCH; ++n) {
        const int buf = n & 1;
        if (c.wave >= 4) { if (n + 1 < GDN_NCH) gdn_rec_stage(c, bhd, n + 1, buf ^ 1); }
        else {
            const unsigned char* base = c.lds + buf * GR_BUF; const float* tab = (const float*)(base + GR_TAB);
            const int row0 = scan_row(b, dir, n * 64), sgn = dir ? -1 : 1;
            const bf16* vcol = QKV + (size_t)row0 * 1536 + 1024 + h * 128 + dvt * 32 + r + (ptrdiff_t)(sgn * 4 * hh) * 1536;
            bf16* ocol = OG + (size_t)row0 * 512 + h * 128 + dvt * 32 + r + (ptrdiff_t)(sgn * 4 * hh) * 512;
            const ptrdiff_t vst = (ptrdiff_t)sgn * 1536, ost = (ptrdiff_t)sgn * 512;
            bf16 vraw[2][16];
#pragma unroll
            for (int st = 0; st < 2; ++st)
#pragma unroll
                for (int i = 0; i < 16; ++i) vraw[st][i] = vcol[vst * (st * 32 + (i & 3) + 8 * (i >> 2))];
            bf16x8 Rf[2][2];
#pragma unroll
            for (int st = 0; st < 2; ++st) { f32x16 acc;
#pragma unroll
                for (int i = 0; i < 16; ++i) acc[i] = 0.f;
#pragma unroll
                for (int kb = 0; kb < 8; ++kb) acc = MFMA32(gr_rowfrag(base + GR_K + st * 8192, po, kb), pack_step_v(S[kb >> 1], kb & 1), acc);
#pragma unroll
                for (int i = 0; i < 16; ++i) { const int s = st * 32 + crow16(i, hh); acc[i] = tab[64 + s] * (bf1(vraw[st][i]) - tab[128 + s] * acc[i]); }
                Rf[st][0] = pack_step(acc, 0); Rf[st][1] = pack_step(acc, 1); asm volatile("" ::: "memory"); }
            bf16x8 Vf[2][2];
#pragma unroll
            for (int ct = 0; ct < 2; ++ct) { f32x16 acc;
#pragma unroll
                for (int i = 0; i < 16; ++i) acc[i] = 0.f;
#pragma unroll
                for (int sb = 0; sb < 4; ++sb) if (sb < 2 * ct + 2) acc = MFMA32(*(const bf16x8*)(base + GR_T + ((ct * 4 + sb) * 64 + c.lane) * 16), Rf[sb >> 1][sb & 1], acc);
                Vf[ct][0] = pack_step(acc, 0); Vf[ct][1] = pack_step(acc, 1); }
            asm volatile("" ::: "memory");
#pragma unroll
            for (int ct = 0; ct < 2; ++ct) { f32x16 acc;
#pragma unroll
                for (int i = 0; i < 16; ++i) acc[i] = 0.f;
#pragma unroll
                for (int kb = 0; kb < 8; ++kb) acc = MFMA32(gr_rowfrag(base + GR_Q + ct * 8192, po, kb), pack_step_v(S[kb >> 1], kb & 1), acc);
#pragma unroll
                for (int i = 0; i < 16; ++i) acc[i] *= tab[128 + ct * 32 + crow16(i, hh)];
#pragma unroll
                for (int cb = 0; cb < 4; ++cb) if (cb < 2 * ct + 2) acc = MFMA32(*(const bf16x8*)(base + GR_A + ((ct * 4 + cb) * 64 + c.lane) * 16), Vf[cb >> 1][cb & 1], acc);
                if (n >= 4) {
#pragma unroll
                    for (int i = 0; i < 16; ++i) ocol[ost * (ct * 32 + (i & 3) + 8 * (i >> 2))] = (bf16)f2bf(acc[i]); }
                asm volatile("" ::: "memory"); }
            const float gtot = tab[128 + 63];
#pragma unroll
            for (int t = 0; t < 4; ++t) {
#pragma unroll
                for (int i = 0; i < 16; ++i) S[t][i] *= gtot;
#pragma unroll
                for (int cb = 0; cb < 4; ++cb) S[t] = MFMA32(*(const bf16x8*)(base + GR_KD + ((t * 4 + cb) * 64 + c.lane) * 16), Vf[cb >> 1][cb & 1], S[t]); }
        }
        if (c.wave >= 4) asm volatile("s_waitcnt vmcnt(0)" ::: "memory"); else asm volatile("s_waitcnt lgkmcnt(0)" ::: "memory");
        __builtin_amdgcn_s_barrier(); asm volatile("" ::: "memory");
    }
    asm volatile("s_waitcnt vmcnt(0)" ::: "memory"); __syncthreads();
}
__device__ __forceinline__ void phase_gdn_rec(const Ctx& c) { for (int bhd = c.bid; bhd < 64; bhd += 64) gdn_rec_block(c, bhd); }

#define XB_TMO      128
#define XB_XCNT(j)  (256  + 64 * (j))
#define XB_XSUB(j)  (1280 + 64 * (j))
#define XB_XGEN(j)  (2304 + 64 * (j))
#define XB_TOP      3328
#define XB_TOPGEN   3392
#define XCD_BAR_WORDS 3456
#define XB_SPIN_CAP (1u << 20)
__device__ __forceinline__ unsigned xb_ld(unsigned* p)              { return __hip_atomic_load(p, __ATOMIC_RELAXED, __HIP_MEMORY_SCOPE_AGENT); }
__device__ __forceinline__ unsigned xb_add(unsigned* p, unsigned v) { return __hip_atomic_fetch_add(p, v, __ATOMIC_RELAXED, __HIP_MEMORY_SCOPE_AGENT); }
__device__ __forceinline__ unsigned xb_xcc_id() { return (unsigned)__builtin_amdgcn_s_getreg((3 << 11) | 20) & 0xFu; }
#define XB_SPIN(cond, bar) do { unsigned _sp = 0; while (cond) { __builtin_amdgcn_s_sleep(1); \
    if ((++_sp & 255u) == 0u) { if (xb_ld(&(bar)[XB_TMO])) break; if (_sp > XB_SPIN_CAP) { atomicAdd(&(bar)[XB_TMO], 1u); break; } } } } while (0)
struct XcdBarrier { unsigned* bar; unsigned x; volatile LAS unsigned* st; };
__device__ __forceinline__ XcdBarrier xcd_barrier_post(unsigned* bar, volatile LAS unsigned* st) {
    XcdBarrier b; b.bar = bar; b.x = xb_xcc_id(); b.st = st;
    if (threadIdx.x == 0) (void)xb_add(&bar[XB_XCNT(b.x)], 1u);
    return b;
}
__device__ __forceinline__ void xcd_barrier_complete(unsigned* bar, unsigned x, unsigned& nloc, unsigned& nx) {
    const unsigned G = gridDim.x * gridDim.y * gridDim.z;
    unsigned sum, cnt, mine, sp = 0u;
    for (;;) {
        sum = 0u; cnt = 0u; mine = 0u;
#pragma unroll
        for (unsigned j = 0; j < 16; ++j) { const unsigned c = xb_ld(&bar[XB_XCNT(j)]); sum += c; cnt += (c > 0u) ? 1u : 0u; mine = (j == x) ? c : mine; }
        if (sum == G) break;
        __builtin_amdgcn_s_sleep(1);
        if ((++sp & 255u) == 0u) { if (xb_ld(&bar[XB_TMO])) break; if (sp > XB_SPIN_CAP) { atomicAdd(&bar[XB_TMO], 1u); break; } }
    }
    nloc = mine > 0u ? mine : 1u; nx = cnt > 0u ? cnt : 1u;
}
__device__ __forceinline__ void xcd_barrier(const XcdBarrier& b) {
    asm volatile("s_waitcnt vmcnt(0)" ::: "memory");
    __syncthreads();
    if (threadIdx.x == 0) {
        unsigned* bar = b.bar;
        __builtin_amdgcn_s_waitcnt(0);
        unsigned nloc = b.st[0], nx = b.st[1];
        if (nloc == 0u) { xcd_barrier_complete(bar, b.x, nloc, nx); b.st[0] = nloc; b.st[1] = nx; }
        const unsigned old = xb_add(&bar[XB_XSUB(b.x)], 1u);
        const unsigned gen = old / nloc;
        if (old + 1u == (gen + 1u) * nloc) {
            __builtin_amdgcn_fence(__ATOMIC_RELEASE, "agent");
            asm volatile("s_waitcnt vmcnt(0)" ::: "memory");
            const unsigned og = xb_add(&bar[XB_TOP], 1u);
            const unsigned tg = og / nx;
            if (og + 1u == (tg + 1u) * nx) xb_add(&bar[XB_TOPGEN], 1u);
            else XB_SPIN(xb_ld(&bar[XB_TOPGEN]) == tg, bar);
            __builtin_amdgcn_fence(__ATOMIC_ACQUIRE, "agent");
            xb_add(&bar[XB_XGEN(b.x)], 1u);
            asm volatile("s_waitcnt vmcnt(0)" ::: "memory");
        } else {
            XB_SPIN(xb_ld(&bar[XB_XGEN(b.x)]) == gen, bar);
            __builtin_amdgcn_fence(__ATOMIC_ACQUIRE, "agent");
            asm volatile("s_waitcnt vmcnt(0)" ::: "memory");
        }
    }
    __syncthreads();
}

constexpr int LDS_MISC = LDS_BYTES - 64;
__global__ void __launch_bounds__(NTHREADS, 2) mk_fwd(Args args) {
    extern __shared__ __attribute__((aligned(16))) unsigned char lds[];
    Ctx c; c.a = &args; c.ws = args.ws; c.lds = lds;
    c.tid = threadIdx.x; c.lane = c.tid & 63; c.wave = __builtin_amdgcn_readfirstlane(c.tid >> 6); c.bid = blockIdx.x; c.G = gridDim.x;
    c.gw = c.bid * NWAVES + c.wave; c.NGW = c.G * NWAVES; c.gwv = c.wave * c.G + c.bid;
    const int lo = args.ph_lo, hi = args.ph_hi;
    PG8_LAS unsigned char* ring = (PG8_LAS unsigned char*)lds;
#ifndef MK_PH_MASK
#define MK_PH_MASK 0xffff
#endif
#define IN(k) (((MK_PH_MASK >> (k)) & 1) && lo <= (k) && (k) < hi)
#if MK_ONE_LAUNCH
    cg::grid_group grid = cg::this_grid();
    if (lo < 0) grid.sync();
    volatile LAS unsigned* st = (volatile LAS unsigned*)((LAS unsigned char*)lds + LDS_MISC);
    if (c.tid < 2) st[c.tid] = 0u;
    __syncthreads();
    const XcdBarrier bar = xcd_barrier_post((unsigned*)(c.ws + WS_CTL) + CW_BAR, st);
#define SEAM(k) do { if (IN(k) && IN((k) + 1)) xcd_barrier(bar); } while (0)
#else
#define SEAM(k) do { } while (0)
#endif
    if (IN(0)) { phase_prep(c); phase_s5_build(c); } SEAM(0);
    if (IN(1)) { phase_norm1(c); } SEAM(1);
    if (IN(2)) { pg8::Gemm g{(const pg8::bf16_t*)(c.ws + WS_HX), (const pg8::bf16_t*)(c.ws + WS_WIN), 1024, 1024, 1024}; pg8::StaticOrder S; S.init(MT, NPROJ, c.G, c.bid);
        pg8::EpiInProj E{(pg8::bf16_t*)(c.ws + WS_U5), (pg8::bf16_t*)(c.ws + WS_QKVPRE), (pg8::bf16_t*)(c.ws + WS_Z)};
        pg8::gemm_phase<pg8::EpiInProj, pg8::StaticOrder, true, true>(ring, g, S, E); } SEAM(2);
    if (IN(3)) { { pg8::Gemm g{(const pg8::bf16_t*)(c.ws + WS_U5), (const pg8::bf16_t*)(c.ws + WS_PM), 768, 512, 512}; pg8::SchedSS S{c.G, c.bid}; pg8::EpiSS E{(float*)(c.ws + WS_SS)};
          pg8::gemm_phase<pg8::EpiSS, pg8::SchedSS, true, true>(ring, g, S, E); }
        __syncthreads(); phase_conv(c); } SEAM(3);
    if (IN(4)) { if (c.wave < 2) s5_state_scan(c, c.bid + c.G * c.wave < 512 ? c.bid + c.G * c.wave : 0); __syncthreads(); phase_gdn_prep(c); } SEAM(4);
    if (IN(5)) { pg8::Gemm g{(const pg8::bf16_t*)(c.ws + WS_U5), (const pg8::bf16_t*)(c.ws + WS_BB), 768, 768, 768}; pg8::SchedS5Y S{c.G, c.bid}; pg8::EpiS5Y E{(pg8::bf16_t*)(c.ws + WS_YG)};
        pg8::gemm_phase<pg8::EpiS5Y, pg8::SchedS5Y, true, true>(ring, g, S, E); } SEAM(5);
    if (IN(6)) { if (c.bid < 64) phase_gdn_rec(c);
        else { pg8::Gemm g{(const pg8::bf16_t*)(c.ws + WS_YG), (const pg8::bf16_t*)(c.ws + WS_WGLU), 512, 512, 512}; pg8::StaticOrder S; S.init(ML, 512, c.G - 64, c.bid - 64);
            pg8::EpiGlu E{(const pg8::bf16_t*)(c.ws + WS_YG), (pg8::bf16_t*)(c.ws + WS_CAT)};
            pg8::gemm_phase<pg8::EpiGlu, pg8::StaticOrder, true, true>(ring, g, S, E); } } SEAM(6);
    if (IN(7)) { phase_combine(c); } SEAM(7);
    if (IN(8)) { pg8::Gemm g{(const pg8::bf16_t*)(c.ws + WS_CAT), (const pg8::bf16_t*)(c.ws + WS_WOUT), 1024, 1024, 1024}; pg8::StaticOrder S; S.init(ML, 1024, c.G, c.bid);
        pg8::EpiF32 E{(float*)(c.ws + WS_YRAW), 1024};
        pg8::gemm_phase<pg8::EpiF32, pg8::StaticOrder, true, true>(ring, g, S, E); } SEAM(8);
    if (IN(9)) { phase_rows2(c); phase_fp8_tables(c); } SEAM(9);
    if (IN(10)) { pg8::Gemm g{(const pg8::bf16_t*)(c.ws + WS_HX2), (const pg8::bf16_t*)(c.ws + WS_WQ), 1024, 1024, 1024}; pg8::StaticOrder S; S.init(ML, 2048, c.G, c.bid);
        pg8::EpiBf16<0> E{(pg8::bf16_t*)(c.ws + WS_QP), 2048, nullptr, 0, 0, 1.f};
        pg8::gemm_phase<pg8::EpiBf16<0>, pg8::StaticOrder, true, true>(ring, g, S, E); } SEAM(10);
    if (IN(11)) { phase_topk(c); } SEAM(11);
    if (IN(12)) { phase_exp1(c); } SEAM(12);
    if (IN(13)) { phase_exp1b(c); } SEAM(13);
    if (IN(14)) { phase_exp2(c); } SEAM(14);
    if (IN(15)) { phase_exp3(c); }
#undef IN
#undef SEAM
}

extern "C" void kernel_launch(void* const* d_in, const int* in_sizes, int n_in, void* d_out, int out_size, void* d_ws, size_t ws_size, hipStream_t stream) {
    static int grid = 0;
    if (grid == 0) {
        if (n_in != 29 || out_size != ML * D || ws_size < WS_END) { fprintf(stderr, "kernel_launch: unexpected shapes (n_in %d out %d ws %zu)\n", n_in, out_size, ws_size); grid = -1; return; }
        int dev = 0, cus = 0, per_cu = 0;
        (void)hipGetDevice(&dev); (void)hipDeviceGetAttribute(&cus, hipDeviceAttributeMultiprocessorCount, dev);
        if (hipFuncSetAttribute((const void*)mk_fwd, hipFuncAttributeMaxDynamicSharedMemorySize, LDS_BYTES) != hipSuccess) { fprintf(stderr, "kernel_launch: hipFuncSetAttribute failed\n"); grid = -1; return; }
        (void)hipOccupancyMaxActiveBlocksPerMultiprocessor(&per_cu, (const void*)mk_fwd, NTHREADS, LDS_BYTES);
        (void)hipGetLastError();
        grid = cus;
        fprintf(stderr, "kernel_launch: cus %d per_cu %d grid %d\n", cus, per_cu, grid);
    }
    if (grid < 0) return;
    Args a{};
    for (int i = 0; i < 29; ++i) a.in[i] = (const float*)d_in[i];
    a.out = (float*)d_out; a.ws = (unsigned char*)d_ws;
    (void)hipMemsetAsync((char*)d_ws + WS_CTL, 0, CTL_ZERO_BYTES, stream);
#if MK_ONE_LAUNCH
    a.ph_lo = 0; a.ph_hi = NPHASES;
    void* kargs[] = {&a};
    hipError_t e = hipLaunchCooperativeKernel((const void*)mk_fwd, dim3(grid), dim3(NTHREADS), kargs, LDS_BYTES, stream);
    if (e != hipSuccess) fprintf(stderr, "kernel_launch: cooperative launch failed: %s\n", hipGetErrorString(e));
#else
    for (int ph = 0; ph < NPHASES; ++ph) { a.ph_lo = ph; a.ph_hi = ph + 1; hipLaunchKernelGGL(mk_fwd, dim3(grid), dim3(NTHREADS), LDS_BYTES, stream, a); }
#endif
}
```

```cpp
#include <hip/hip_runtime.h>
#include <hip/hip_cooperative_groups.h>
#include <cstdio>
#include <cstdint>
namespace cg = cooperative_groups;
namespace pg8 {
#define PG8_LAS __attribute__((address_space(3)))
typedef unsigned short bf16_t;
typedef short bf16x8 __attribute__((ext_vector_type(8)));
typedef float f32x4 __attribute__((ext_vector_type(4)));
typedef unsigned u32x4 __attribute__((ext_vector_type(4)));
constexpr int BM = 256, BK = 64, HALF = 128, HTB = HALF * BK * 2  , STAGE_BYTES = 8 * HTB, NXCD = 8, WGM = 8;

__host__ __device__ __forceinline__ int lds_byte(int r, int c) { const int st = (r >> 4) * 2 + (c >> 5), rr = r & 15, cc = c & 31, ob = rr * 64 + cc * 2; return st * 1024 + (ob ^ (((ob >> 9) & 1) << 5)); }
__host__ __device__ __forceinline__ void stage_rc(int b, int& R, int& C) { const int st = b / 1024, sb = b % 1024, swz = sb ^ (((sb >> 9) & 1) << 5); R = (st >> 1) * 16 + swz / 64; C = (st & 1) * 32 + (swz % 64) / 2; }
__host__ __device__ __forceinline__ int perm32(int rho) { const int n = rho >> 4, i = rho & 15; return 8 * (i >> 2) + 4 * n + (i & 3); }

struct Unit { int pm, pn; };
struct Gemm { const bf16_t* A; const bf16_t* Bt; int lda, ldb, K; };

struct StaticOrder {
    int nM, nN, nwg, G, c;
    __host__ __device__ void init(int M, int N, int G_, int c_) { nM = M / BM; nN = N / BM; nwg = nM * nN; G = G_; c = c_; }
    __host__ __device__ bool next(int i, Unit& u) const {
        const long L = (long)i * G + c; if (L >= nwg) return false;
        int wgid = (int)L; { const int q = nwg / NXCD, r = nwg % NXCD, xcd = wgid % NXCD, off = wgid / NXCD; wgid = (xcd < r ? xcd * (q + 1) : r * (q + 1) + (xcd - r) * q) + off; }
        const int nig = WGM * nN, gid = wgid / nig, fm = gid * WGM, gsz = (nM - fm) < WGM ? (nM - fm) : WGM;
        u.pm = fm + ((wgid % nig) % gsz); u.pn = (wgid % nig) / gsz; return true;
    }
    __device__ __forceinline__ void a_ready(const Unit&) const {}
    __device__ __forceinline__ void done(const Unit&) const {}
};

__device__ __forceinline__ unsigned cvt_pk_bf16(float lo, float hi) { unsigned r; asm volatile("v_cvt_pk_bf16_f32 %0, %1, %2" : "=v"(r) : "v"(lo), "v"(hi)); return r; }
typedef float f32x2 __attribute__((ext_vector_type(2)));
__device__ __forceinline__ f32x2 gelu_pk(f32x2 v) {
    const f32x2 av = __builtin_elementwise_abs(v), d = av * 0.2316418882f + 1.0f;
    f32x2 t; t.x = __builtin_amdgcn_rcpf(d.x); t.y = __builtin_amdgcn_rcpf(d.y);
    f32x2 q = t * 0.5307027145f + (-0.7265760135f); q = q * t + 0.7107068705f; q = q * t + (-0.142248368f); q = q * t + 0.127414796f; q = q * t;
    const f32x2 s = (v * v) * (-0.72134752044f);
    f32x2 e; e.x = __builtin_amdgcn_exp2f(s.x); e.y = __builtin_amdgcn_exp2f(s.y);
    const f32x2 m = v * (q * e), r = v - m;
    f32x2 o; o.x = v.x < 0.f ? m.x : r.x; o.y = v.y < 0.f ? m.y : r.y; return o;
}

template <int ACT  > struct EpiBf16 {
    static constexpr bool PERM = true, AFTER_DRAIN = false; static_assert(ACT == 0 || ACT == 1, "EpiBf16: ACT is 0 (none) or 1 (gelu_pk)");
    bf16_t* O; int ldc; const float* bias; int split_cols; size_t split_stride; float scale0;
    __device__ __forceinline__ void operator()(const f32x4 (&acc)[2][2][4][2], const Unit& u, int wr, int wc, int fr, int fq) const {
        const int row0 = u.pm * BM + wr * 64 + fr; int colt = u.pn * BM; bf16_t* base = O;
        float sc = 1.f; if (split_cols) { const int t = colt / split_cols; base += (size_t)t * split_stride; colt -= t * split_cols; if (t == 0) sc = scale0; }
        const int col0 = colt + wc * 32 + 8 * fq, bcol0 = u.pn * BM + wc * 32 + 8 * fq;
        f32x4 bv[2][2];
#pragma unroll
        for (int bj = 0; bj < 2; ++bj)
#pragma unroll
            for (int n = 0; n < 2; ++n) bv[bj][n] = bias ? *(const f32x4*)(bias + bcol0 + bj * HALF + 4 * n) : (f32x4){0.f, 0.f, 0.f, 0.f};
#pragma unroll
        for (int ai = 0; ai < 2; ++ai)
#pragma unroll
            for (int m = 0; m < 4; ++m) { bf16_t* rowp = base + (size_t)(row0 + ai * HALF + m * 16) * ldc + col0;
#pragma unroll
                for (int bj = 0; bj < 2; ++bj) { f32x4 v0 = acc[ai][bj][m][0] + bv[bj][0], v1 = acc[ai][bj][m][1] + bv[bj][1];
                    if (ACT == 1) { f32x2 a = gelu_pk((f32x2){v0[0], v0[1]}), b = gelu_pk((f32x2){v0[2], v0[3]}), c = gelu_pk((f32x2){v1[0], v1[1]}), d = gelu_pk((f32x2){v1[2], v1[3]});
                        v0 = (f32x4){a.x, a.y, b.x, b.y}; v1 = (f32x4){c.x, c.y, d.x, d.y}; }
                    v0 = v0 * sc; v1 = v1 * sc; u32x4 w; w.x = cvt_pk_bf16(v0[0], v0[1]); w.y = cvt_pk_bf16(v0[2], v0[3]); w.z = cvt_pk_bf16(v1[0], v1[1]); w.w = cvt_pk_bf16(v1[2], v1[3]);
                    *(u32x4*)(rowp + bj * HALF) = w; } }
    }
};

template <class Epi, class Sched, bool ALIGN_EPI = false, bool SP2 = false>
__device__ __forceinline__ void gemm_phase(PG8_LAS unsigned char* lds, const Gemm g, const Sched& S, const Epi& E) {
    const int tid = threadIdx.x, wid = __builtin_amdgcn_readfirstlane(tid >> 6), lane = tid & 63, wr = wid >> 2, wc = wid & 3, fr = lane & 15, fq = lane >> 4;
    const int K = g.K, nt = K / BK;
    unsigned voffA[2], voffB[2];
#pragma unroll
    for (int i = 0; i < 2; ++i) { int R, C; stage_rc(tid * 16 + i * 8192, R, C); const int Rb = Epi::PERM ? ((R & ~31) + perm32(R & 31)) : R;
        voffA[i] = (unsigned)(R * g.lda + C) * 2u; voffB[i] = (unsigned)(Rb * g.ldb + C) * 2u; }
    const size_t kstep = (size_t)(BK * 2);
    const size_t hstepA = (size_t)HALF * g.lda * 2, hstepB = (size_t)HALF * g.ldb * 2;
    const size_t tstepA = 2 * hstepA, tstepB = 2 * hstepB;
    const unsigned ldsw = (unsigned)wid * 1024u;
    const int aoff = lds_byte(wr * 64 + fr, fq * 8), boff = lds_byte(wc * 32 + fr, fq * 8);
#define PG8_SA(b, h) (((b) * 2 + (h)) * HTB)
#define PG8_SB(b, h) ((4 + (b) * 2 + (h)) * HTB)
#define PG8_STAGE(bufoff, gbase, voff) do { _Pragma("unroll") for (int _i = 0; _i < 2; ++_i) \
        __builtin_amdgcn_global_load_lds((const unsigned*)((const char*)(gbase) + (voff)[_i]), (PG8_LAS unsigned*)(lds + (bufoff) + ldsw + _i * 8192), 16, 0, 0); } while (0)
#define PG8_LDA(dst, b, h) do { _Pragma("unroll") for (int m = 0; m < 4; ++m) _Pragma("unroll") for (int k = 0; k < 2; ++k) dst[m][k] = *(const PG8_LAS bf16x8*)(lds + PG8_SA(b, h) + aoff + m * 2048 + k * 1024); } while (0)
#define PG8_LDB(dst, b, h) do { _Pragma("unroll") for (int n = 0; n < 2; ++n) _Pragma("unroll") for (int k = 0; k < 2; ++k) dst[n][k] = *(const PG8_LAS bf16x8*)(lds + PG8_SB(b, h) + boff + n * 2048 + k * 1024); } while (0)
#define PG8_MMA(ai, bj, At, Bt) do { __builtin_amdgcn_s_setprio(1); _Pragma("unroll") for (int m = 0; m < 4; ++m) _Pragma("unroll") for (int n = 0; n < 2; ++n) _Pragma("unroll") for (int k = 0; k < 2; ++k) \
        acc[ai][bj][m][n] = __builtin_amdgcn_mfma_f32_16x16x32_bf16(Bt[n][k], At[m][k], acc[ai][bj][m][n], 0, 0, 0); __builtin_amdgcn_s_setprio(0); } while (0)
#define PG8_WAIT_V(n) asm volatile("s_waitcnt vmcnt(" #n ")" ::: "memory")
#define PG8_WAIT_L(n) asm volatile("s_waitcnt lgkmcnt(" #n ")" ::: "memory")
#define PG8_BAR __builtin_amdgcn_s_barrier()
#define PG8_SCHED __builtin_amdgcn_sched_barrier(0)
    Unit cur, nxt; int ui = 0;
    if (!S.next(0, cur)) return;
    f32x4 acc[2][2][4][2];
#pragma unroll
    for (int a = 0; a < 2; ++a)
#pragma unroll
        for (int b = 0; b < 2; ++b)
#pragma unroll
            for (int m = 0; m < 4; ++m)
#pragma unroll
                for (int n = 0; n < 2; ++n) acc[a][b][m][n] = (f32x4){0.f, 0.f, 0.f, 0.f};
    bf16x8 At[4][2], B0[2][2], B1[2][2];
    const char* cA = (const char*)g.A + (size_t)cur.pm * tstepA; const char* cB = (const char*)g.Bt + (size_t)cur.pn * tstepB;
    S.a_ready(cur);
    if constexpr (SP2) {
        PG8_STAGE(PG8_SB(0, 0), cB, voffB); PG8_STAGE(PG8_SB(0, 1), cB + hstepB, voffB); PG8_STAGE(PG8_SA(0, 0), cA, voffA); PG8_STAGE(PG8_SA(0, 1), cA + hstepA, voffA);
        if (wr == 1) PG8_BAR;
        PG8_WAIT_V(2); PG8_BAR;
        PG8_STAGE(PG8_SB(1, 0), cB + kstep, voffB); PG8_STAGE(PG8_SA(1, 0), cA + kstep, voffA); PG8_STAGE(PG8_SB(1, 1), cB + hstepB + kstep, voffB);
        PG8_WAIT_V(6); PG8_BAR;
    } else {
        PG8_STAGE(PG8_SB(0, 0), cB, voffB); PG8_STAGE(PG8_SA(0, 0), cA, voffA); PG8_STAGE(PG8_SB(0, 1), cB + hstepB, voffB); PG8_STAGE(PG8_SA(0, 1), cA + hstepA, voffA);
        if (wr == 1) PG8_BAR;
        PG8_WAIT_V(4); PG8_BAR;
        PG8_STAGE(PG8_SB(1, 0), cB + kstep, voffB); PG8_STAGE(PG8_SA(1, 0), cA + kstep, voffA); PG8_STAGE(PG8_SB(1, 1), cB + hstepB + kstep, voffB);
        PG8_WAIT_V(6); PG8_BAR;
    }
    for (;;) {
        const bool has_next = S.next(ui + 1, nxt);
        const char* nA = has_next ? (const char*)g.A + (size_t)nxt.pm * tstepA : cA; const char* nB = has_next ? (const char*)g.Bt + (size_t)nxt.pn * tstepB : cB;
        for (int t = 0; t < nt; t += 2) {
            const bool last = (t == nt - 2);
            const char* a1 = cA + (size_t)(t + 1) * kstep;
            const char* a2 = last ? nA : cA + (size_t)(t + 2) * kstep; const char* b2 = last ? nB : cB + (size_t)(t + 2) * kstep;
            const char* a3 = a2 + kstep; const char* b3 = b2 + kstep;
            if (last && has_next) S.a_ready(nxt);
            if constexpr (SP2) {
            PG8_LDB(B0, 0, 0); PG8_LDB(B1, 0, 1); PG8_SCHED; PG8_LDA(At, 0, 0); PG8_STAGE(PG8_SA(1, 1), a1 + hstepA, voffA);
            PG8_WAIT_V(8); PG8_WAIT_L(0); PG8_BAR; PG8_MMA(0, 0, At, B0); PG8_MMA(0, 1, At, B1); PG8_BAR; PG8_SCHED;
            PG8_LDA(At, 0, 1); PG8_STAGE(PG8_SB(0, 0), b2, voffB); PG8_STAGE(PG8_SB(0, 1), b2 + hstepB, voffB); PG8_STAGE(PG8_SA(0, 0), a2, voffA);
            PG8_WAIT_V(8); PG8_WAIT_L(0); PG8_BAR; PG8_MMA(1, 0, At, B0); PG8_MMA(1, 1, At, B1); PG8_BAR; PG8_SCHED;
            PG8_LDB(B0, 1, 0); PG8_LDB(B1, 1, 1); PG8_SCHED; PG8_LDA(At, 1, 0); PG8_STAGE(PG8_SA(0, 1), a2 + hstepA, voffA);
            PG8_WAIT_V(8); PG8_WAIT_L(0); PG8_BAR; PG8_MMA(0, 0, At, B0); PG8_MMA(0, 1, At, B1); PG8_BAR; PG8_SCHED;
            PG8_LDA(At, 1, 1); PG8_STAGE(PG8_SB(1, 0), b3, voffB); PG8_STAGE(PG8_SB(1, 1), b3 + hstepB, voffB); PG8_STAGE(PG8_SA(1, 0), a3, voffA);
            PG8_WAIT_V(8); PG8_WAIT_L(0); PG8_BAR; PG8_MMA(1, 0, At, B0); PG8_MMA(1, 1, At, B1); PG8_BAR; PG8_SCHED;
            } else {
            PG8_LDB(B0, 0, 0); PG8_SCHED; PG8_LDA(At, 0, 0); PG8_STAGE(PG8_SA(1, 1), a1 + hstepA, voffA);
            PG8_WAIT_L(8); PG8_BAR; PG8_WAIT_L(0); PG8_MMA(0, 0, At, B0); PG8_BAR; PG8_SCHED;
            PG8_LDB(B1, 0, 1); PG8_STAGE(PG8_SB(0, 0), b2, voffB);
            PG8_BAR; PG8_WAIT_L(0); PG8_MMA(0, 1, At, B1); PG8_BAR;
            PG8_LDA(At, 0, 1); PG8_STAGE(PG8_SA(0, 0), a2, voffA);
            PG8_BAR; PG8_WAIT_L(0); PG8_MMA(1, 0, At, B0); PG8_BAR; PG8_SCHED;
            PG8_STAGE(PG8_SB(0, 1), b2 + hstepB, voffB);
            PG8_WAIT_V(6); PG8_BAR; PG8_MMA(1, 1, At, B1); PG8_BAR;
            PG8_LDB(B0, 1, 0); PG8_SCHED; PG8_LDA(At, 1, 0); PG8_STAGE(PG8_SA(0, 1), a2 + hstepA, voffA);
            PG8_WAIT_L(8); PG8_BAR; PG8_WAIT_L(0); PG8_MMA(0, 0, At, B0); PG8_BAR; PG8_SCHED;
            PG8_LDB(B1, 1, 1); PG8_STAGE(PG8_SB(1, 0), b3, voffB);
            PG8_BAR; PG8_WAIT_L(0); PG8_MMA(0, 1, At, B1); PG8_BAR;
            PG8_LDA(At, 1, 1); PG8_STAGE(PG8_SA(1, 0), a3, voffA);
            PG8_BAR; PG8_WAIT_L(0); PG8_MMA(1, 0, At, B0); PG8_BAR; PG8_SCHED;
            PG8_STAGE(PG8_SB(1, 1), b3 + hstepB, voffB);
            PG8_WAIT_V(6); PG8_BAR; PG8_MMA(1, 1, At, B1); PG8_BAR;
            }
        }
        if constexpr (ALIGN_EPI) { if (wr == 0) PG8_BAR; }
        if constexpr (!Epi::AFTER_DRAIN) { E(acc, cur, wr, wc, fr, fq); S.done(cur); }
        if (!has_next) break;
#pragma unroll
        for (int a = 0; a < 2; ++a)
#pragma unroll
            for (int b = 0; b < 2; ++b)
#pragma unroll
                for (int m = 0; m < 4; ++m)
#pragma unroll
                    for (int n = 0; n < 2; ++n) acc[a][b][m][n] = (f32x4){0.f, 0.f, 0.f, 0.f};
        cur = nxt; cA = nA; cB = nB; ++ui;
        if constexpr (ALIGN_EPI) { if (wr == 1) PG8_BAR; }
    }
    PG8_WAIT_V(0);
    if constexpr (!ALIGN_EPI) { if (wr == 0) PG8_BAR; }
    PG8_BAR;
    if constexpr (Epi::AFTER_DRAIN) { E.fused(acc, cur, wr, wc, fr, fq, lds, wid, lane); S.done(cur); }
#undef PG8_SA
#undef PG8_SB
#undef PG8_STAGE
#undef PG8_LDA
#undef PG8_LDB
#undef PG8_MMA
#undef PG8_WAIT_V
#undef PG8_WAIT_L
#undef PG8_BAR
#undef PG8_SCHED
}
}

#ifndef MK_EXP_OLD
#define MK_EXP_OLD 0
#endif
#ifndef MK_ONE_LAUNCH
#define MK_ONE_LAUNCH 1
#endif
#define LAS __attribute__((address_space(3)))
typedef unsigned short bf16;
typedef unsigned v4u __attribute__((ext_vector_type(4)));
typedef unsigned v2u __attribute__((ext_vector_type(2)));
typedef float f32x4 __attribute__((ext_vector_type(4)));
typedef float f32x2 __attribute__((ext_vector_type(2)));
typedef short bf16x8 __attribute__((ext_vector_type(8)));
typedef float f32x16 __attribute__((ext_vector_type(16)));
#define MFMA32(a, b, c) __builtin_amdgcn_mfma_f32_32x32x16_bf16((a), (b), (c), 0, 0, 0)

constexpr int D = 1024, NB = 8, SEQ = 2048, LC = 256, ML = NB * SEQ  , MC = NB * LC  , MT = ML + MC  ;
constexpr int PROJ = 2576, NPROJ = 2560;
constexpr int NEXP = 16384, TOPK = 16, KK = 128;
constexpr float EPS = 1e-6f;
constexpr int NTHREADS = 512, NWAVES = 8;
constexpr int LDS_BYTES = 147456;
constexpr int NPHASES = 16;

constexpr size_t MiB = 1u << 20;
constexpr size_t WS_CTL = 0;
constexpr size_t CTL_ZERO_BYTES = 65536;
constexpr int CW_BAR = 0;
constexpr int CW_E1 = 4096, CW_E2 = 4096 + 8 * 64;
constexpr size_t WS_MOD = 1 * MiB;
constexpr size_t WS_LP = 1 * MiB + 512 * 1024;
constexpr size_t WS_WIN = 2 * MiB;
constexpr size_t WS_WOUT = 8 * MiB;
constexpr size_t WS_WGLU = 10 * MiB;
constexpr size_t WS_WQ = 11 * MiB;
constexpr size_t WS_GB = 15 * MiB;
constexpr size_t WS_BB = 17 * MiB;
constexpr size_t WS_PM = 41 * MiB;
constexpr size_t WS_OG = 17 * MiB;
constexpr size_t WS_HX2 = 17 * MiB;
constexpr size_t WS_U5 = 49 * MiB;
constexpr size_t WS_CAT = 49 * MiB;
constexpr size_t WS_IDX = 49 * MiB;
constexpr size_t WS_GATE = 57 * MiB;
constexpr size_t WS_ACT = 65 * MiB;
constexpr size_t WS_SSQP = 73 * MiB;
constexpr size_t WS_Z = 85 * MiB;
constexpr size_t WS_YRAW = 85 * MiB;
constexpr size_t WS_QP = 85 * MiB;
constexpr size_t WS_Y = 85 * MiB;
constexpr size_t WS_HX = 101 * MiB;
constexpr size_t WS_SS = 101 * MiB;
constexpr size_t WS_YG = 101 * MiB;
constexpr size_t WS_FRT = 125 * MiB;
constexpr size_t WS_QKVPRE = 137 * MiB;
constexpr size_t WS_FRA = 143 * MiB;
constexpr size_t WS_FRK = 161 * MiB;
constexpr size_t WS_FRTAB = 197 * MiB;
constexpr size_t WS_QKV = 202 * MiB;
constexpr size_t WS_U8 = 202 * MiB;
constexpr size_t WS_V8 = 218 * MiB;
constexpr size_t WS_USC = 234 * MiB;
constexpr size_t WS_VSC = 234 * MiB + 512 * 1024;
constexpr size_t WS_HQ8 = 150 * MiB;
constexpr size_t WS_HS = 183 * MiB;
constexpr size_t WS_PACT = 85 * MiB;
constexpr size_t WS_END = 256 * MiB;
static_assert(WS_BB + (size_t)32 * 512 * 768 * 2 <= WS_PM && WS_PM + (size_t)32 * 256 * 512 * 2 <= WS_U5 && WS_U5 + (size_t)32 * 768 * 768 * 2 <= WS_Z && WS_Z + (size_t)ML * 512 * 2 <= WS_HX, "ws map a");
static_assert(WS_HX + (size_t)MT * D * 2 <= WS_QKVPRE && WS_SS + (size_t)32 * 768 * 256 * 4 <= WS_FRT && WS_QKVPRE + (size_t)MT * 1536 * 2 <= WS_QKV && WS_QKV + (size_t)MT * 1536 * 2 <= WS_END, "ws map b");
static_assert(WS_FRT + (size_t)2304 * 8192 <= WS_FRA && WS_FRA + (size_t)2304 * 8192 <= WS_FRK && WS_FRK + (size_t)2304 * 16384 <= WS_FRTAB && WS_FRTAB + (size_t)2304 * 1024 <= WS_QKV, "ws map c");
static_assert(WS_OG + (size_t)2 * ML * 512 * 2 <= WS_CAT && WS_CAT + (size_t)ML * D * 2 <= WS_Z && WS_YRAW + (size_t)ML * D * 4 <= WS_U8 && WS_SSQP + (size_t)8 * ML * 4 <= WS_Z && WS_YG + (size_t)ML * 512 * 2 <= WS_FRT, "ws map d");

__device__ __forceinline__ unsigned f2bf(float f) { unsigned u = __builtin_bit_cast(unsigned, f); return (u + 0x7fffu + ((u >> 16) & 1u)) >> 16; }
typedef __bf16 bf16x2_t __attribute__((ext_vector_type(2)));
__device__ __forceinline__ unsigned pk2(float lo, float hi) { const f32x2 v = {lo, hi}; return __builtin_bit_cast(unsigned, __builtin_convertvector(v, bf16x2_t)); }
__device__ __forceinline__ float bflo(unsigned w) { return __builtin_bit_cast(float, w << 16); }
__device__ __forceinline__ float bfhi(unsigned w) { return __builtin_bit_cast(float, w & 0xffff0000u); }
__device__ __forceinline__ float bf1(bf16 h) { return __builtin_bit_cast(float, (unsigned)h << 16); }
__device__ __forceinline__ float wave_sum(float v) {
#pragma unroll
    for (int o = 1; o < 64; o <<= 1) v += __shfl_xor(v, o);
    return v;
}
__device__ __forceinline__ float wave_max(float v) {
#pragma unroll
    for (int o = 1; o < 64; o <<= 1) v = fmaxf(v, __shfl_xor(v, o));
    return v;
}
__device__ __forceinline__ float sigmoidf_(float x) { return 1.f / (1.f + __expf(-x)); }
__device__ __forceinline__ float siluf_(float x) { return x / (1.f + __expf(-x)); }
__device__ __forceinline__ float gelu_erf(float x) { return 0.5f * x * (1.f + erff(x * 0.70710678118654752f)); }
__device__ __forceinline__ void sincos_d(double a, float& s, float& c) {
    const double k = rint(a * 0.63661977236758134308);
    const double r = fma(-k, 1.57079632679489661923, a) - k * 6.123233995736766e-17;
    const double r2 = r * r;
    double sp = -2.5052108385441720e-08; sp = sp * r2 + 2.7557319223985893e-06; sp = sp * r2 - 1.9841269841269841e-04; sp = sp * r2 + 8.3333333333333332e-03; sp = sp * r2 - 1.6666666666666666e-01;
    const double sn = r + r * r2 * sp;
    double cp = 2.0876756987868099e-09; cp = cp * r2 - 2.7557319223985888e-07; cp = cp * r2 + 2.4801587301587302e-05; cp = cp * r2 - 1.3888888888888889e-03; cp = cp * r2 + 4.1666666666666664e-02; cp = cp * r2 - 0.5;
    const double cs = 1.0 + r2 * cp;
    const int q = ((int)k) & 3;
    const double ss = (q == 0) ? sn : (q == 1) ? cs : (q == 2) ? -sn : -cs;
    const double cc = (q == 0) ? cs : (q == 1) ? -sn : (q == 2) ? -cs : sn;
    s = (float)ss; c = (float)cc;
}

struct Args { const float* in[29]; float* out; unsigned char* ws; int ph_lo, ph_hi; };
static_assert(sizeof(Args) == 29 * 8 + 8 + 8 + 8, "Args has no padding");
enum { I_X = 0, I_C, I_CTX, I_CCTX, I_WMOD, I_BMOD, I_GPREMIX, I_GPOSTMIX, I_GPREFFN, I_GPOSTFFN, I_WIN, I_WOUT, I_LAMRE, I_LAMIM, I_LOGDT, I_BRE, I_BIM, I_CRE, I_CIM, I_S5D, I_WGLU,
       I_CONV, I_ALOG, I_DTBIAS, I_GDNNORM, I_WQ, I_KEYS, I_PU, I_PV };

__device__ __forceinline__ const float* in_row(const Args& a, int row) { return row < ML ? a.in[I_X] + (size_t)row * D : a.in[I_CTX] + (size_t)(row - ML) * D; }
__device__ __forceinline__ int mod_row(int row) { return row < ML ? (row >> 11) : 8; }

template <int CTRL> __device__ __forceinline__ float dppf(float v) { return __builtin_bit_cast(float, __builtin_amdgcn_update_dpp(0, __builtin_bit_cast(int, v), CTRL, 0xf, 0xf, true)); }
__device__ __forceinline__ float row_sum16(float v) { v += dppf<0xB1>(v); v += dppf<0x4E>(v); v += dppf<0x141>(v); v += dppf<0x140>(v); return v; }
__device__ __forceinline__ float row_max16(float v) { v = fmaxf(v, dppf<0xB1>(v)); v = fmaxf(v, dppf<0x4E>(v)); v = fmaxf(v, dppf<0x141>(v)); v = fmaxf(v, dppf<0x140>(v)); return v; }
__device__ __forceinline__ float wsum(float v) { v = row_sum16(v); return
    __builtin_bit_cast(float, __builtin_amdgcn_readlane(__builtin_bit_cast(int, v), 0)) + __builtin_bit_cast(float, __builtin_amdgcn_readlane(__builtin_bit_cast(int, v), 16)) +
    __builtin_bit_cast(float, __builtin_amdgcn_readlane(__builtin_bit_cast(int, v), 32)) + __builtin_bit_cast(float, __builtin_amdgcn_readlane(__builtin_bit_cast(int, v), 48)); }
__device__ __forceinline__ float wmax(float v) { v = row_max16(v); return fmaxf(fmaxf(__builtin_bit_cast(float, __builtin_amdgcn_readlane(__builtin_bit_cast(int, v), 0)), __builtin_bit_cast(float, __builtin_amdgcn_readlane(__builtin_bit_cast(int, v), 16))),
    fmaxf(__builtin_bit_cast(float, __builtin_amdgcn_readlane(__builtin_bit_cast(int, v), 32)), __builtin_bit_cast(float, __builtin_amdgcn_readlane(__builtin_bit_cast(int, v), 48)))); }
__device__ __forceinline__ int lane_rank(unsigned long long m) { return __builtin_amdgcn_mbcnt_hi((unsigned)(m >> 32), __builtin_amdgcn_mbcnt_lo((unsigned)m, 0)); }
__device__ __forceinline__ unsigned fkey(float f) { const unsigned u = __builtin_bit_cast(unsigned, f); return u ^ ((unsigned)((int)u >> 31) | 0x80000000u); }
#define WAVE_LDS_SYNC() do { __builtin_amdgcn_fence(__ATOMIC_RELEASE, "wavefront"); __builtin_amdgcn_wave_barrier(); __builtin_amdgcn_fence(__ATOMIC_ACQUIRE, "wavefront"); } while (0)
template <int N> __device__ __forceinline__ unsigned kth_key(const unsigned (&k)[N], int K) {
    unsigned T = 0;
    for (int bit = 31; bit >= 0; --bit) { const unsigned cand = T | (1u << bit); int cnt = 0;
#pragma unroll
        for (int n = 0; n < N; ++n) cnt += __popcll(__ballot(k[n] >= cand));
        if (cnt >= K) T = cand;
        if (cnt == K) break; }
    return T;
}

namespace pg8 {
struct EpiInProj {
    static constexpr bool PERM = true, AFTER_DRAIN = false;
    bf16_t* U; bf16_t* QKV; bf16_t* Z;
    __device__ __forceinline__ void operator()(const f32x4 (&acc)[2][2][4][2], const Unit& u, int wr, int wc, int fr, int fq) const {
        bf16_t* base; int ld, colt; bool lat_only = false;
        const bool s5 = u.pn < 2;
        if (s5) { base = U; ld = 0; colt = u.pn * BM; }
        else if (u.pn < 8) { base = QKV; ld = 1536; colt = (u.pn - 2) * BM; }
        else { base = Z; ld = 512; colt = (u.pn - 8) * BM; lat_only = true; }
        const int row0 = u.pm * BM + wr * 64 + fr, col0 = colt + wc * 32 + 8 * fq;
#pragma unroll
        for (int ai = 0; ai < 2; ++ai)
#pragma unroll
            for (int m = 0; m < 4; ++m) { const int row = row0 + ai * HALF + m * 16; bf16_t* rowp = base + (size_t)row * ld + col0;
                if (lat_only && row >= 16384) continue;
                if (s5) { const int R = row < 16384 ? (row >> 5) : 512 + ((row - 16384) >> 5), ii = row & 31; rowp = base + (size_t)R * 768 + ii * 16 + (col0 & 15); }
#pragma unroll
                for (int bj = 0; bj < 2; ++bj) { const f32x4 v0 = acc[ai][bj][m][0], v1 = acc[ai][bj][m][1];
                    u32x4 w; w.x = cvt_pk_bf16(v0[0], v0[1]); w.y = cvt_pk_bf16(v0[2], v0[3]); w.z = cvt_pk_bf16(v1[0], v1[1]); w.w = cvt_pk_bf16(v1[2], v1[3]);
                    if (s5) *(u32x4*)(rowp + (size_t)((col0 + bj * HALF) >> 4) * (768 * 768)) = w; else *(u32x4*)(rowp + bj * HALF) = w; } }
    }
};
struct EpiGlu {
    static constexpr bool PERM = true, AFTER_DRAIN = false;
    const bf16_t* YG; bf16_t* CAT;
    __device__ __forceinline__ void operator()(const f32x4 (&acc)[2][2][4][2], const Unit& u, int wr, int wc, int fr, int fq) const {
        const int row0 = u.pm * BM + wr * 64 + fr, col0 = u.pn * BM + wc * 32 + 8 * fq;
#pragma unroll
        for (int ai = 0; ai < 2; ++ai)
#pragma unroll
            for (int m = 0; m < 4; ++m) { const int row = row0 + ai * HALF + m * 16;
#pragma unroll
                for (int bj = 0; bj < 2; ++bj) { const f32x4 v0 = acc[ai][bj][m][0], v1 = acc[ai][bj][m][1];
                    const u32x4 y = *(const u32x4*)(YG + (size_t)row * 512 + col0 + bj * HALF);
                    float o[8]; const float a[8] = {v0[0], v0[1], v0[2], v0[3], v1[0], v1[1], v1[2], v1[3]};
                    const unsigned yw[4] = {y.x, y.y, y.z, y.w};
#pragma unroll
                    for (int e = 0; e < 8; ++e) { const float yv = __builtin_bit_cast(float, (e & 1) ? (yw[e >> 1] & 0xffff0000u) : (yw[e >> 1] << 16)); o[e] = yv / (1.f + __expf(-a[e])); }
                    u32x4 w; w.x = cvt_pk_bf16(o[0], o[1]); w.y = cvt_pk_bf16(o[2], o[3]); w.z = cvt_pk_bf16(o[4], o[5]); w.w = cvt_pk_bf16(o[6], o[7]);
                    *(u32x4*)(CAT + (size_t)row * 1024 + col0 + bj * HALF) = w; } }
    }
};
struct EpiF32 {
    static constexpr bool PERM = false, AFTER_DRAIN = false;
    float* C; int ldc;
    __device__ __forceinline__ void operator()(const f32x4 (&acc)[2][2][4][2], const Unit& u, int wr, int wc, int fr, int fq) const {
        const int row0 = u.pm * BM + wr * 64 + fr, col0 = u.pn * BM + wc * 32 + 4 * fq;
#pragma unroll
        for (int ai = 0; ai < 2; ++ai)
#pragma unroll
            for (int m = 0; m < 4; ++m) { float* rowp = C + (size_t)(row0 + ai * HALF + m * 16) * ldc + col0;
#pragma unroll
                for (int bj = 0; bj < 2; ++bj)
#pragma unroll
                    for (int n = 0; n < 2; ++n) *(f32x4*)(rowp + bj * HALF + n * 16) = acc[ai][bj][m][n]; }
    }
};
struct EpiSS {
    static constexpr bool PERM = false, AFTER_DRAIN = false;
    float* C;
    __device__ __forceinline__ void operator()(const f32x4 (&acc)[2][2][4][2], const Unit& u, int wr, int wc, int fr, int fq) const {
        const int row0 = u.pm * BM + wr * 64 + fr, col0 = wc * 32 + 4 * fq;
#pragma unroll
        for (int ai = 0; ai < 2; ++ai)
#pragma unroll
            for (int m = 0; m < 4; ++m) { float* rowp = C + (size_t)(row0 + ai * HALF + m * 16) * 256 + col0;
#pragma unroll
                for (int bj = 0; bj < 2; ++bj)
#pragma unroll
                    for (int n = 0; n < 2; ++n) *(f32x4*)(rowp + bj * HALF + n * 16) = acc[ai][bj][m][n]; }
    }
};
struct SchedSS { int G, c; __device__ bool next(int i, Unit& u) const { const int L = i * G + c; if (L >= 96) return false; u.pm = L; u.pn = L / 3; return true; }
    __device__ __forceinline__ void a_ready(const Unit&) const {} __device__ __forceinline__ void done(const Unit&) const {} };
struct EpiS5Y {
    static constexpr bool PERM = true, AFTER_DRAIN = false;
    bf16_t* YG;
    __device__ __forceinline__ void operator()(const f32x4 (&acc)[2][2][4][2], const Unit& u, int wr, int wc, int fr, int fq) const {
        const int g = u.pn >> 1, R0 = (u.pm - 3 * g) * BM + wr * 64 + fr, n0 = (u.pn & 1) * BM + wc * 32 + 8 * fq;
#pragma unroll
        for (int ai = 0; ai < 2; ++ai)
#pragma unroll
            for (int m = 0; m < 4; ++m) { const int R = R0 + ai * HALF + m * 16;
#pragma unroll
                for (int bj = 0; bj < 2; ++bj) { const int n = n0 + bj * HALF; const f32x4 v0 = acc[ai][bj][m][0], v1 = acc[ai][bj][m][1];
                    const f32x2 a = gelu_pk((f32x2){v0[0], v0[1]}), b = gelu_pk((f32x2){v0[2], v0[3]}), c2 = gelu_pk((f32x2){v1[0], v1[1]}), d = gelu_pk((f32x2){v1[2], v1[3]});
                    u32x4 w; w.x = cvt_pk_bf16(a.x, a.y); w.y = cvt_pk_bf16(b.x, b.y); w.z = cvt_pk_bf16(c2.x, c2.y); w.w = cvt_pk_bf16(d.x, d.y);
                    *(u32x4*)(YG + (size_t)(R * 32 + (n >> 4)) * 512 + g * 16 + (n & 15)) = w; } }
    }
};
struct SchedS5Y { int G, c; __device__ bool next(int i, Unit& u) const { const int L = i * G + c; if (L >= 128) return false; const int g = L >> 2; u.pm = 3 * g + ((L >> 1) & 1); u.pn = 2 * g + (L & 1); return true; }
    __device__ __forceinline__ void a_ready(const Unit&) const {} __device__ __forceinline__ void done(const Unit&) const {} };
}

struct Ctx { const Args* a; unsigned char* ws; unsigned char* lds; int tid, lane, wave, bid, G, gw, NGW, gwv; };

__device__ __forceinline__ void p0_transpose_item(const float* W, int ldw, int nblk, int K, bf16* WT, float* scr, int item, int lane) {
    const int kb = item / nblk, nb = item % nblk, k0 = 64 * kb, n0 = 32 * nb;
#pragma unroll 8
    for (int i = 0; i < 32; ++i) { const int kk = 2 * i + (lane >> 5); scr[kk * 33 + (lane & 31)] = W[(size_t)(k0 + kk) * ldw + n0 + (lane & 31)]; }
    __builtin_amdgcn_fence(__ATOMIC_RELEASE, "wavefront"); __builtin_amdgcn_wave_barrier(); __builtin_amdgcn_fence(__ATOMIC_ACQUIRE, "wavefront");
    const int c = lane & 7;
#pragma unroll
    for (int j = 0; j < 4; ++j) { const int n = (lane >> 3) + 8 * j; const float* s = scr + (8 * c) * 33 + n;
        v4u o; o.x = pk2(s[0 * 33], s[1 * 33]); o.y = pk2(s[2 * 33], s[3 * 33]); o.z = pk2(s[4 * 33], s[5 * 33]); o.w = pk2(s[6 * 33], s[7 * 33]);
        *(v4u*)(WT + (size_t)(n0 + n) * K + k0 + 8 * c) = o; }
    __builtin_amdgcn_fence(__ATOMIC_RELEASE, "wavefront"); __builtin_amdgcn_wave_barrier(); __builtin_amdgcn_fence(__ATOMIC_ACQUIRE, "wavefront");
}
__device__ __forceinline__ void phase_prep(const Ctx& c) {
    const Args& a = *c.a;
    float* scr = (float*)(c.lds + c.wave * 16384);
    constexpr int I_IN = 16 * 80, I_OUT = 16 * 32, I_GLU = 8 * 16, I_Q = 16 * 64;
    for (int it = c.gw; it < I_IN + I_OUT + I_GLU + I_Q; it += c.NGW) {
        int r = it;
        if (r < I_IN) { p0_transpose_item(a.in[I_WIN], PROJ, 80, 1024, (bf16*)(c.ws + WS_WIN), scr, r, c.lane); continue; } r -= I_IN;
        if (r < I_OUT) { p0_transpose_item(a.in[I_WOUT], 1024, 32, 1024, (bf16*)(c.ws + WS_WOUT), scr, r, c.lane); continue; } r -= I_OUT;
        if (r < I_GLU) { p0_transpose_item(a.in[I_WGLU], 512, 16, 512, (bf16*)(c.ws + WS_WGLU), scr, r, c.lane); continue; } r -= I_GLU;
        p0_transpose_item(a.in[I_WQ], 2048, 64, 1024, (bf16*)(c.ws + WS_WQ), scr, r, c.lane);
    }
    __syncthreads();
    float* sc = (float*)c.lds;
    float* red = (float*)(c.lds + 9 * 1024 * 4);
    float* MOD = (float*)(c.ws + WS_MOD);
    bool have = false;
    for (int item = c.bid; item < 96; item += c.G) {
        if (!have) { for (int i = c.tid; i < 9 * 1024; i += NTHREADS) { const int r = i >> 10, k = i & 1023; const float v = r < 8 ? a.in[I_C][r * 1024 + k] : a.in[I_CCTX][k]; sc[i] = siluf_(v); } have = true; __syncthreads(); }
        const int n0 = item * 64;
        float acc[9];
#pragma unroll
        for (int r = 0; r < 9; ++r) acc[r] = 0.f;
        const float* wp = a.in[I_WMOD] + (size_t)(c.wave * 128) * 6144 + n0 + c.lane;
#pragma unroll 16
        for (int k = 0; k < 128; ++k) { const float w = wp[(size_t)k * 6144];
#pragma unroll
            for (int r = 0; r < 9; ++r) acc[r] = fmaf(sc[r * 1024 + c.wave * 128 + k], w, acc[r]); }
#pragma unroll
        for (int r = 0; r < 9; ++r) red[(c.wave * 9 + r) * 64 + c.lane] = acc[r];
        __syncthreads();
        for (int i = c.tid; i < 576; i += NTHREADS) { const int r = i >> 6, l = i & 63; float s = a.in[I_BMOD][n0 + l];
#pragma unroll
            for (int w = 0; w < 8; ++w) s += red[(w * 9 + r) * 64 + l];
            MOD[r * 6144 + n0 + l] = s; }
        __syncthreads();
    }
}
__device__ __forceinline__ void s5_build_group(const Ctx& c, int g, int part);
__device__ __forceinline__ void phase_s5_build(const Ctx& c) { for (int it = c.bid; it < 256; it += c.G) s5_build_group(c, it >> 3, it & 7); }

__device__ __forceinline__ void phase_norm1(const Ctx& c) {
    const Args& a = *c.a;
    float* wabT = (float*)c.lds;
    for (int i = c.tid; i < 1024 * 16; i += NTHREADS) { const int k = i >> 4, j = i & 15; wabT[j * 1028 + k] = a.in[I_WIN][(size_t)k * PROJ + NPROJ + j]; }
    __syncthreads();
    const float* MOD = (const float*)(c.ws + WS_MOD);
    bf16* HX = (bf16*)(c.ws + WS_HX); float* GB = (float*)(c.ws + WS_GB);
    const float* gpre = a.in[I_GPREMIX];
    f32x4 nx[4];
    if (c.gw < MT) { const f32x4* xr = (const f32x4*)in_row(a, c.gw) + c.lane;
#pragma unroll
        for (int j = 0; j < 4; ++j) nx[j] = xr[64 * j]; }
    for (int row = c.gw; row < MT; row += c.NGW) {
        const float* mr = MOD + mod_row(row) * 6144;
        f32x4 v[4]; float ss = 0.f;
#pragma unroll
        for (int j = 0; j < 4; ++j) { v[j] = nx[j]; ss += (v[j].x * v[j].x + v[j].y * v[j].y) + (v[j].z * v[j].z + v[j].w * v[j].w); }
        if (row + c.NGW < MT) { const f32x4* xr = (const f32x4*)in_row(a, row + c.NGW) + c.lane;
#pragma unroll
            for (int j = 0; j < 4; ++j) nx[j] = xr[64 * j]; }
        const float r = rsqrtf(wsum(ss) * (1.f / D) + EPS);
#pragma unroll
        for (int j = 0; j < 4; ++j) { const int col = 4 * c.lane + 256 * j;
            const f32x4 g4 = *(const f32x4*)(gpre + col), sh = *(const f32x4*)(mr + col), scl = *(const f32x4*)(mr + 1024 + col);
            v[j] = (v[j] * r) * g4 * (scl + 1.f) + sh;
            v2u o; o.x = pk2(v[j].x, v[j].y); o.y = pk2(v[j].z, v[j].w);
            *(v2u*)(HX + (size_t)row * D + col) = o; }
        float pj[16];
#pragma unroll
        for (int j = 0; j < 16; ++j) { float s = 0.f;
#pragma unroll
            for (int jj = 0; jj < 4; ++jj) { const f32x4 w = *(const f32x4*)(wabT + j * 1028 + 4 * c.lane + 256 * jj); s += (v[jj].x * w.x + v[jj].y * w.y) + (v[jj].z * w.z + v[jj].w * w.w); }
            pj[j] = s; if ((j & 1) == 1) asm volatile("" ::: "memory"); }
        const bool b5 = c.lane & 32, b4 = c.lane & 16, b3 = c.lane & 8, b2 = c.lane & 4;
        float q8[8], q4[4], q2[2];
#pragma unroll
        for (int i = 0; i < 8; ++i) { const float keep = b5 ? pj[i + 8] : pj[i], send = b5 ? pj[i] : pj[i + 8]; q8[i] = keep + __shfl_xor(send, 32); }
#pragma unroll
        for (int i = 0; i < 4; ++i) { const float keep = b4 ? q8[i + 4] : q8[i], send = b4 ? q8[i] : q8[i + 4]; q4[i] = keep + __shfl_xor(send, 16); }
#pragma unroll
        for (int i = 0; i < 2; ++i) { const float keep = b3 ? q4[i + 2] : q4[i], send = b3 ? q4[i] : q4[i + 2]; q2[i] = keep + dppf<0x140>(send); }
        float mine; { const float keep = b2 ? q2[1] : q2[0], send = b2 ? q2[0] : q2[1]; mine = keep + dppf<0x141>(send); }
        mine += dppf<0xB1>(mine); mine += dppf<0x4E>(mine);
        const int jl = (b5 ? 8 : 0) + (b4 ? 4 : 0) + (b3 ? 2 : 0) + (b2 ? 1 : 0);
        if ((c.lane & 3) == 0) {
            if (jl < 8) { const float t = mine + a.in[I_DTBIAS][jl]; const float sp = t > 20.f ? t : log1pf(expf(t)); GB[(size_t)row * 16 + jl] = -expf(a.in[I_ALOG][jl]) * sp; }
            else GB[(size_t)row * 16 + jl] = 1.f / (1.f + expf(-mine)); }
    }
}

__device__ __forceinline__ void phase_conv(const Ctx& c) {
    const Args& a = *c.a;
    const bf16* PRE = (const bf16*)(c.ws + WS_QKVPRE); bf16* OUT = (bf16*)(c.ws + WS_QKV);
    const float* cw = a.in[I_CONV];
#pragma unroll 1
    for (int pass = 0; pass < 3; ++pass) { const int ch0 = pass * 512 + 8 * c.lane;
        f32x4 wt[9][2];
#pragma unroll
        for (int i = 0; i < 9; ++i) { wt[i][0] = *(const f32x4*)(cw + i * 1536 + ch0); wt[i][1] = *(const f32x4*)(cw + i * 1536 + ch0 + 4); }
#pragma unroll 1
        for (int row = c.gw; row < MT; row += c.NGW) {
            int nb_row[9]; bool ok[9];
            if (row < ML) { const int t = row & 2047, gr = t >> 6, gc = t & 63;
#pragma unroll
                for (int dy = -1; dy <= 1; ++dy)
#pragma unroll
                    for (int dx = -1; dx <= 1; ++dx) { const int i = (dy + 1) * 3 + dx + 1; ok[i] = (gr + dy >= 0) && (gr + dy < 32) && (gc + dx >= 0) && (gc + dx < 64); nb_row[i] = row + dy * 64 + dx; } }
            else { const int t = (row - ML) & 255;
#pragma unroll
                for (int i = 0; i < 9; ++i) { ok[i] = false; nb_row[i] = row; }
#pragma unroll
                for (int dx = -1; dx <= 1; ++dx) { ok[4 + dx] = (t + dx >= 0) && (t + dx < 256); nb_row[4 + dx] = row + dx; } }
            v4u in[9];
#pragma unroll
            for (int i = 0; i < 9; ++i) in[i] = ok[i] ? *(const v4u*)(PRE + (size_t)nb_row[i] * 1536 + ch0) : (v4u){0u, 0u, 0u, 0u};
            float o[8];
#pragma unroll
            for (int q = 0; q < 8; ++q) o[q] = 0.f;
#pragma unroll
            for (int i = 0; i < 9; ++i) { const unsigned w[4] = {in[i].x, in[i].y, in[i].z, in[i].w}; const float kk[8] = {wt[i][0].x, wt[i][0].y, wt[i][0].z, wt[i][0].w, wt[i][1].x, wt[i][1].y, wt[i][1].z, wt[i][1].w};
#pragma unroll
                for (int q = 0; q < 4; ++q) { o[2 * q] = fmaf(bflo(w[q]), kk[2 * q], o[2 * q]); o[2 * q + 1] = fmaf(bfhi(w[q]), kk[2 * q + 1], o[2 * q + 1]); } }
            float ssq = 0.f;
#pragma unroll
            for (int q = 0; q < 8; ++q) { o[q] = siluf_(o[q]); ssq = fmaf(o[q], o[q], ssq); }
            if (pass < 2) { const float sc = rsqrtf(row_sum16(ssq) + EPS) * (pass == 0 ? 0.08838834764831845f : 1.f);
#pragma unroll
                for (int q = 0; q < 8; ++q) o[q] *= sc; }
            v4u ov; ov.x = pk2(o[0], o[1]); ov.y = pk2(o[2], o[3]); ov.z = pk2(o[4], o[5]); ov.w = pk2(o[6], o[7]);
            *(v4u*)(OUT + (size_t)row * 1536 + ch0) = ov;
        }
    }
}

__device__ __forceinline__ int scan_row(int b, int dir, int step) {
    if (step < LC) { const int t = dir ? LC - 1 - step : step; return ML + b * LC + t; }
    const int t = step - LC; return b * SEQ + (dir ? SEQ - 1 - t : t);
}
__device__ __forceinline__ void phase_combine(const Ctx& c) {
    const Args& a = *c.a;
    const bf16* OG0 = (const bf16*)(c.ws + WS_OG); const bf16* OG1 = OG0 + (size_t)ML * 512; const bf16* Z = (const bf16*)(c.ws + WS_Z);
    bf16* CAT = (bf16*)(c.ws + WS_CAT);
    for (int row = c.gw; row < ML; row += c.NGW) {
#pragma unroll
        for (int h = 0; h < 4; ++h) { const int ch = h * 128 + 2 * c.lane;
            const unsigned w0 = *(const unsigned*)(OG0 + (size_t)row * 512 + ch), w1 = *(const unsigned*)(OG1 + (size_t)row * 512 + ch), zw = *(const unsigned*)(Z + (size_t)row * 512 + ch);
            const float o0 = bflo(w0) + bflo(w1), o1 = bfhi(w0) + bfhi(w1);
            const float r = rsqrtf(wave_sum(o0 * o0 + o1 * o1) * (1.f / 128.f) + EPS);
            const f32x2 ng = *(const f32x2*)(a.in[I_GDNNORM] + 2 * c.lane);
            *(unsigned*)(CAT + (size_t)row * 1024 + 512 + ch) = pk2(o0 * r * ng.x * siluf_(bflo(zw)), o1 * r * ng.y * siluf_(bfhi(zw))); }
    }
}

__device__ __forceinline__ void phase_rows2(const Ctx& c) {
    const Args& a = *c.a;
    const float* MOD = (const float*)(c.ws + WS_MOD); const float* YRAW = (const float*)(c.ws + WS_YRAW); bf16* HX2 = (bf16*)(c.ws + WS_HX2);
    f32x4 ny[4], nxx[4];
    if (c.gw < ML) {
#pragma unroll
        for (int j = 0; j < 4; ++j) { ny[j] = *((const f32x4*)(YRAW + (size_t)c.gw * D) + c.lane + 64 * j); nxx[j] = *((const f32x4*)(a.in[I_X] + (size_t)c.gw * D) + c.lane + 64 * j); } }
    for (int row = c.gw; row < ML; row += c.NGW) {
        const float* mr = MOD + (row >> 11) * 6144;
        f32x4 y[4], x[4]; float ss = 0.f;
#pragma unroll
        for (int j = 0; j < 4; ++j) { y[j] = ny[j]; x[j] = nxx[j];
            ss += (y[j].x * y[j].x + y[j].y * y[j].y) + (y[j].z * y[j].z + y[j].w * y[j].w); }
        if (row + c.NGW < ML) { const size_t r2 = (size_t)(row + c.NGW);
#pragma unroll
            for (int j = 0; j < 4; ++j) { ny[j] = *((const f32x4*)(YRAW + r2 * D) + c.lane + 64 * j); nxx[j] = *((const f32x4*)(a.in[I_X] + r2 * D) + c.lane + 64 * j); } }
        const float r = rsqrtf(wsum(ss) * (1.f / D) + EPS); float s2 = 0.f;
#pragma unroll
        for (int j = 0; j < 4; ++j) { const int col = 4 * c.lane + 256 * j;
            const f32x4 g4 = *(const f32x4*)(a.in[I_GPOSTMIX] + col), gt = *(const f32x4*)(mr + 2048 + col);
            x[j] = x[j] + gt * ((y[j] * r) * g4);
            *(f32x4*)(a.out + (size_t)row * D + col) = x[j];
            s2 += (x[j].x * x[j].x + x[j].y * x[j].y) + (x[j].z * x[j].z + x[j].w * x[j].w); }
        const float r2 = rsqrtf(wsum(s2) * (1.f / D) + EPS);
#pragma unroll
        for (int j = 0; j < 4; ++j) { const int col = 4 * c.lane + 256 * j;
            const f32x4 g4 = *(const f32x4*)(a.in[I_GPREFFN] + col), sh = *(const f32x4*)(mr + 3072 + col), scl = *(const f32x4*)(mr + 4096 + col);
            const f32x4 hv = (x[j] * r2) * g4 * (scl + 1.f) + sh;
            v2u o; o.x = pk2(hv.x, hv.y); o.y = pk2(hv.z, hv.w);
            *(v2u*)(HX2 + (size_t)row * D + col) = o;
            x[j] = (f32x4){bflo(o.x), bfhi(o.x), bflo(o.y), bfhi(o.y)}; }
        { float mx = 0.f;
#pragma unroll
          for (int j = 0; j < 4; ++j) mx = fmaxf(mx, fmaxf(fmaxf(fabsf(x[j].x), fabsf(x[j].y)), fmaxf(fabsf(x[j].z), fabsf(x[j].w))));
          mx = wmax(mx); const float hs = mx > 0.f ? 256.f / mx : 1.f;
          unsigned char* hq = c.ws + WS_HQ8 + (size_t)row * 2048;
#pragma unroll
          for (int j = 0; j < 4; ++j) { const float a0 = x[j].x * hs, a1 = x[j].y * hs, a2 = x[j].z * hs, a3 = x[j].w * hs;
              int w = __builtin_amdgcn_cvt_pk_fp8_f32(a0, a1, 0, false); w = __builtin_amdgcn_cvt_pk_fp8_f32(a2, a3, w, true);
              const f32x2 b01 = __builtin_amdgcn_cvt_pk_f32_fp8(w, false), b23 = __builtin_amdgcn_cvt_pk_f32_fp8(w, true);
              int w2 = __builtin_amdgcn_cvt_pk_fp8_f32((a0 - b01.x) * 16.f, (a1 - b01.y) * 16.f, 0, false); w2 = __builtin_amdgcn_cvt_pk_fp8_f32((a2 - b23.x) * 16.f, (a3 - b23.y) * 16.f, w2, true);
              *(unsigned*)(hq + 4 * c.lane + 256 * j) = (unsigned)w; *(unsigned*)(hq + 1024 + 4 * c.lane + 256 * j) = (unsigned)w2; }
          if (c.lane == 0) ((float*)(c.ws + WS_HS))[row] = 1.f / hs; }
    }
}


constexpr int KROW = 136;
__device__ __forceinline__ float unfkey(unsigned k) { const unsigned u = (k & 0x80000000u) ? (k ^ 0x80000000u) : ~k; return __builtin_bit_cast(float, u); }
__device__ __forceinline__ void ins16(unsigned (&L)[16], unsigned key) {
#pragma unroll
    for (int q = 0; q < 16; ++q) { const unsigned hi = L[q] > key ? L[q] : key, lo = L[q] > key ? key : L[q]; L[q] = hi; key = lo; }
}
__device__ __forceinline__ void merge16(unsigned (&L)[16]) {
    unsigned R[16];
#pragma unroll
    for (int q = 0; q < 16; ++q) R[q] = (unsigned)__shfl_xor((int)L[15 - q], 32);
#pragma unroll
    for (int q = 0; q < 16; ++q) L[q] = L[q] > R[q] ? L[q] : R[q];
#pragma unroll
    for (int j = 8; j >= 1; j >>= 1)
#pragma unroll
        for (int q = 0; q < 16; ++q) if ((q & j) == 0) { const unsigned hi = L[q] > L[q + j] ? L[q] : L[q + j], lo = L[q] > L[q + j] ? L[q + j] : L[q]; L[q] = hi; L[q + j] = lo; }
}
__device__ __forceinline__ void phase_topk(const Ctx& c) {
    const Args& a = *c.a;
    bf16* kl = (bf16*)c.lds;
    unsigned char* wtab = c.lds + 2 * 128 * KROW * 2 + c.wave * 1088;
    const bf16* QP = (const bf16*)(c.ws + WS_QP); int* IDX = (int*)(c.ws + WS_IDX); float* GATE = (float*)(c.ws + WS_GATE);
    const int r = c.lane & 31, hh = c.lane >> 5;
    { const unsigned char ptab[50] = {0, 1, 2, 3, 4, 5, 6, 7, 8, 9, 10, 11, 12, 13, 14, 15, 16, 17, 18, 19, 20, 21, 22, 23, 32, 33, 34, 35, 36, 48, 49, 50, 51, 64, 65, 66, 80, 81, 96, 97, 112, 113, 128, 144, 160, 176, 192, 208, 224, 240};
      if (c.lane < 50) wtab[1024 + c.lane] = ptab[c.lane < 50 ? c.lane : 0]; }
    for (int item = c.bid; item < 8 * 32; item += c.G) {
        const int h = item & 7, tr = item >> 3;
        __syncthreads();
        for (int i = c.tid; i < 2 * 128 * 64; i += NTHREADS) { const int k2 = i & 63, n = (i >> 6) & 127, p = i >> 13; const f32x2 kv = *(const f32x2*)(a.in[I_KEYS] + ((size_t)((h * 2 + p) * 128 + n)) * 128 + 2 * k2);
            *(unsigned*)(kl + (p * 128 + n) * KROW + 2 * k2) = pk2(kv.x, kv.y); }
        __syncthreads();
        for (int tile = c.wave; tile < 16; tile += NWAVES) {
            const int tok = tr * 512 + tile * 32 + r;
            unsigned LA[16], LB[16];
#pragma unroll
            for (int p = 0; p < 2; ++p) {
                bf16x8 qf[8];
#pragma unroll
                for (int kk = 0; kk < 8; ++kk) qf[kk] = *(const bf16x8*)(QP + (size_t)tok * 2048 + h * 256 + p * 128 + kk * 16 + hh * 8);
                f32x16 acc[4];
#pragma unroll
                for (int nt = 0; nt < 4; ++nt)
#pragma unroll
                    for (int i = 0; i < 16; ++i) acc[nt][i] = 0.f;
#pragma unroll
                for (int kk = 0; kk < 8; ++kk)
#pragma unroll
                    for (int nt = 0; nt < 4; ++nt) acc[nt] = MFMA32(*(const bf16x8*)(kl + (p * 128 + nt * 32 + r) * KROW + kk * 16 + hh * 8), qf[kk], acc[nt]);
                unsigned (&L)[16] = p ? LB : LA;
#pragma unroll
                for (int q = 0; q < 16; ++q) L[q] = 0u;
#pragma unroll
                for (int nt = 0; nt < 4; ++nt)
#pragma unroll
                    for (int i = 0; i < 16; ++i) { const int n = nt * 32 + (i & 3) + 8 * (i >> 2) + 4 * hh; ins16(L, (fkey(acc[nt][i]) & ~127u) | (unsigned)(127 - n)); }
                merge16(L);
            }
            unsigned char* tt = wtab + r * 32;
            if (hh == 0) {
#pragma unroll
                for (int q = 0; q < 16; ++q) tt[q] = (unsigned char)(127u - (LA[q] & 127u)); }
            else {
#pragma unroll
                for (int q = 0; q < 16; ++q) tt[16 + q] = (unsigned char)(127u - (LB[q] & 127u)); }
            float va[16], vb[16];
#pragma unroll
            for (int q = 0; q < 16; ++q) { va[q] = unfkey(LA[q] & ~127u); vb[q] = unfkey(LB[q] & ~127u); }
            unsigned LC[16];
#pragma unroll
            for (int q = 0; q < 16; ++q) LC[q] = 0u;
            { const float s0 = va[0] + vb[0], s1 = va[0] + vb[1]; ins16(LC, (fkey(hh ? s1 : s0) & ~63u) | (unsigned)(63 - (0 + hh))); }
            { const float s0 = va[0] + vb[2], s1 = va[0] + vb[3]; ins16(LC, (fkey(hh ? s1 : s0) & ~63u) | (unsigned)(63 - (2 + hh))); }
            { const float s0 = va[0] + vb[4], s1 = va[0] + vb[5]; ins16(LC, (fkey(hh ? s1 : s0) & ~63u) | (unsigned)(63 - (4 + hh))); }
            { const float s0 = va[0] + vb[6], s1 = va[0] + vb[7]; ins16(LC, (fkey(hh ? s1 : s0) & ~63u) | (unsigned)(63 - (6 + hh))); }
            { const float s0 = va[0] + vb[8], s1 = va[0] + vb[9]; ins16(LC, (fkey(hh ? s1 : s0) & ~63u) | (unsigned)(63 - (8 + hh))); }
            { const float s0 = va[0] + vb[10], s1 = va[0] + vb[11]; ins16(LC, (fkey(hh ? s1 : s0) & ~63u) | (unsigned)(63 - (10 + hh))); }
            { const float s0 = va[0] + vb[12], s1 = va[0] + vb[13]; ins16(LC, (fkey(hh ? s1 : s0) & ~63u) | (unsigned)(63 - (12 + hh))); }
            { const float s0 = va[0] + vb[14], s1 = va[0] + vb[15]; ins16(LC, (fkey(hh ? s1 : s0) & ~63u) | (unsigned)(63 - (14 + hh))); }
            { const float s0 = va[1] + vb[0], s1 = va[1] + vb[1]; ins16(LC, (fkey(hh ? s1 : s0) & ~63u) | (unsigned)(63 - (16 + hh))); }
            { const float s0 = va[1] + vb[2], s1 = va[1] + vb[3]; ins16(LC, (fkey(hh ? s1 : s0) & ~63u) | (unsigned)(63 - (18 + hh))); }
            { const float s0 = va[1] + vb[4], s1 = va[1] + vb[5]; ins16(LC, (fkey(hh ? s1 : s0) & ~63u) | (unsigned)(63 - (20 + hh))); }
            { const float s0 = va[1] + vb[6], s1 = va[1] + vb[7]; ins16(LC, (fkey(hh ? s1 : s0) & ~63u) | (unsigned)(63 - (22 + hh))); }
            { const float s0 = va[2] + vb[0], s1 = va[2] + vb[1]; ins16(LC, (fkey(hh ? s1 : s0) & ~63u) | (unsigned)(63 - (24 + hh))); }
            { const float s0 = va[2] + vb[2], s1 = va[2] + vb[3]; ins16(LC, (fkey(hh ? s1 : s0) & ~63u) | (unsigned)(63 - (26 + hh))); }
            { const float s0 = va[2] + vb[4], s1 = va[3] + vb[0]; ins16(LC, (fkey(hh ? s1 : s0) & ~63u) | (unsigned)(63 - (28 + hh))); }
            { const float s0 = va[3] + vb[1], s1 = va[3] + vb[2]; ins16(LC, (fkey(hh ? s1 : s0) & ~63u) | (unsigned)(63 - (30 + hh))); }
            { const float s0 = va[3] + vb[3], s1 = va[4] + vb[0]; ins16(LC, (fkey(hh ? s1 : s0) & ~63u) | (unsigned)(63 - (32 + hh))); }
            { const float s0 = va[4] + vb[1], s1 = va[4] + vb[2]; ins16(LC, (fkey(hh ? s1 : s0) & ~63u) | (unsigned)(63 - (34 + hh))); }
            { const float s0 = va[5] + vb[0], s1 = va[5] + vb[1]; ins16(LC, (fkey(hh ? s1 : s0) & ~63u) | (unsigned)(63 - (36 + hh))); }
            { const float s0 = va[6] + vb[0], s1 = va[6] + vb[1]; ins16(LC, (fkey(hh ? s1 : s0) & ~63u) | (unsigned)(63 - (38 + hh))); }
            { const float s0 = va[7] + vb[0], s1 = va[7] + vb[1]; ins16(LC, (fkey(hh ? s1 : s0) & ~63u) | (unsigned)(63 - (40 + hh))); }
            { const float s0 = va[8] + vb[0], s1 = va[9] + vb[0]; ins16(LC, (fkey(hh ? s1 : s0) & ~63u) | (unsigned)(63 - (42 + hh))); }
            { const float s0 = va[10] + vb[0], s1 = va[11] + vb[0]; ins16(LC, (fkey(hh ? s1 : s0) & ~63u) | (unsigned)(63 - (44 + hh))); }
            { const float s0 = va[12] + vb[0], s1 = va[13] + vb[0]; ins16(LC, (fkey(hh ? s1 : s0) & ~63u) | (unsigned)(63 - (46 + hh))); }
            { const float s0 = va[14] + vb[0], s1 = va[15] + vb[0]; ins16(LC, (fkey(hh ? s1 : s0) & ~63u) | (unsigned)(63 - (48 + hh))); }
            merge16(LC);
            WAVE_LDS_SYNC();
            float ev[16]; float den = 0.f; const float mx = unfkey(LC[0] & ~63u);
#pragma unroll
            for (int q = 0; q < 16; ++q) { ev[q] = __expf(unfkey(LC[q] & ~63u) - mx); den += ev[q]; }
            const float inv = 1.f / den;
            if (hh == 0) { int ex[16];
#pragma unroll
                for (int q = 0; q < 16; ++q) { const unsigned pc = wtab[1024 + (63u - (LC[q] & 63u))]; ex[q] = (int)tt[pc >> 4] * 128 + (int)tt[16 + (pc & 15u)]; }
#pragma unroll
                for (int q = 0; q < 4; ++q) *(v4u*)(IDX + (size_t)tok * 128 + h * 16 + 4 * q) = (v4u){(unsigned)ex[4 * q], (unsigned)ex[4 * q + 1], (unsigned)ex[4 * q + 2], (unsigned)ex[4 * q + 3]}; }
            else {
#pragma unroll
                for (int q = 0; q < 4; ++q) *(f32x4*)(GATE + (size_t)tok * 128 + h * 16 + 4 * q) = (f32x4){ev[4 * q] * inv, ev[4 * q + 1] * inv, ev[4 * q + 2] * inv, ev[4 * q + 3] * inv}; }
            WAVE_LDS_SYNC();
        }
    }
}

__device__ __forceinline__ void phase_fp8_tables(const Ctx& c) {
    const Args& a = *c.a;
    for (int r = c.gw; r < 2 * NEXP; r += c.NGW) {
        const bool isv = r >= NEXP; const int e = isv ? r - NEXP : r;
        const f32x4* src = (const f32x4*)((isv ? a.in[I_PV] : a.in[I_PU]) + (size_t)e * D) + 4 * c.lane;
        f32x4 v[4]; float m = 0.f;
#pragma unroll
        for (int j = 0; j < 4; ++j) { v[j] = src[j]; m = fmaxf(m, fmaxf(fmaxf(fabsf(v[j].x), fabsf(v[j].y)), fmaxf(fabsf(v[j].z), fabsf(v[j].w)))); }
        m = wmax(m); const float inv = m > 0.f ? 256.f / m : 0.f;
        v4u o; unsigned ow[4];
#pragma unroll
        for (int j = 0; j < 4; ++j) { int w = __builtin_amdgcn_cvt_pk_fp8_f32(v[j].x * inv, v[j].y * inv, 0, false); w = __builtin_amdgcn_cvt_pk_fp8_f32(v[j].z * inv, v[j].w * inv, w, true); ow[j] = (unsigned)w; }
        o.x = ow[0]; o.y = ow[1]; o.z = ow[2]; o.w = ow[3];
        *(v4u*)(c.ws + (isv ? WS_V8 : WS_U8) + (size_t)e * D + 16 * c.lane) = o;
        if (c.lane == 0) ((float*)(c.ws + (isv ? WS_VSC : WS_USC)))[e] = m * (1.f / 256.f);
    }
}
__device__ __forceinline__ void fp8x16_to_f32(const v4u& r, float (&f)[16]) {
    const unsigned w[4] = {r.x, r.y, r.z, r.w};
#pragma unroll
    for (int j = 0; j < 4; ++j) { const f32x2 lo = __builtin_amdgcn_cvt_pk_f32_fp8((int)w[j], false), hi = __builtin_amdgcn_cvt_pk_f32_fp8((int)w[j], true); f[4 * j] = lo.x; f[4 * j + 1] = lo.y; f[4 * j + 2] = hi.x; f[4 * j + 3] = hi.y; }
}
__device__ __forceinline__ unsigned xcc_id() { return (unsigned)__builtin_amdgcn_s_getreg((3 << 11) | 20) & 7u; }

typedef long l64x2 __attribute__((ext_vector_type(2)));
struct E1Bat { l64x2 rw[16]; };
__device__ __forceinline__ void phase_exp1(const Ctx& c) {
    typedef float f32x4m __attribute__((ext_vector_type(4)));
    const int* IDX = (const int*)(c.ws + WS_IDX); const unsigned char* U8 = c.ws + WS_U8; float* PACT = (float*)(c.ws + WS_PACT);
    unsigned* cnt = (unsigned*)(c.ws + WS_CTL) + CW_E1;
    constexpr int CH = 4;
    constexpr int SROW = 144;
    unsigned char* wl = c.lds + c.wave * 8704; int* le = (int*)wl; unsigned char* himg = wl + 2048; float* res = (float*)(wl + 3072); unsigned char* stage = wl + 3584;
    const int xcc = (int)xcc_id(), r16 = c.lane & 15, g4 = c.lane >> 4, row8 = c.lane >> 3, pc8 = c.lane & 7; const bool bcol = r16 < 2;
    int bo = 0; unsigned tq = 0;
    if (c.lane == 0) tq = __hip_atomic_fetch_add(cnt + 64 * (xcc & 7), (unsigned)CH, __ATOMIC_RELAXED, __HIP_MEMORY_SCOPE_AGENT);
    for (;;) {
        const int x = (xcc + bo) & 7;
        const unsigned t0 = (unsigned)__builtin_amdgcn_readfirstlane((int)tq);
        if (t0 >= (unsigned)ML) { if (++bo >= 8) break; tq = 0; if (c.lane == 0) tq = __hip_atomic_fetch_add(cnt + 64 * ((xcc + bo) & 7), (unsigned)CH, __ATOMIC_RELAXED, __HIP_MEMORY_SCOPE_AGENT); continue; }
        tq = 0; if (c.lane == 0) tq = __hip_atomic_fetch_add(cnt + 64 * x, (unsigned)CH, __ATOMIC_RELAXED, __HIP_MEMORY_SCOPE_AGENT);
        { const v4u e0 = *(const v4u*)(IDX + (size_t)t0 * 128 + 4 * c.lane), e1 = *(const v4u*)(IDX + (size_t)t0 * 128 + 256 + 4 * c.lane);
          const v4u im = *(const v4u*)(c.ws + WS_HQ8 + ((size_t)t0 + (c.lane >> 4)) * 2048 + ((c.lane >> 3) & 1) * 1024 + 128 * x + 16 * (c.lane & 7));
          *(v4u*)(le + 4 * c.lane) = e0; *(v4u*)(le + 256 + 4 * c.lane) = e1; *(v4u*)(himg + 16 * c.lane) = im; }
        WAVE_LDS_SYNC();
#define E1_LOAD(G, B) do { const int bb = (B) < CH ? (B) : 0; _Pragma("unroll") for (int i = 0; i < 16; ++i) G.rw[i] = *(const l64x2*)(U8 + (size_t)le[bb * 128 + 8 * i + row8] * D + 128 * x + 16 * pc8); } while (0)
#define E1_COMP(G, B) do { const unsigned char* hb = himg + ((B) * 2 + (r16 & 1)) * 128 + 32 * g4; long bq[4]; _Pragma("unroll") for (int m = 0; m < 4; ++m) { const long v = *(const long*)(hb + 8 * m); bq[m] = bcol ? v : 0l; } \
            _Pragma("unroll") for (int gi = 0; gi < 8; ++gi) { unsigned char* sb = stage + (gi & 1) * (16 * SROW); \
                *(l64x2*)(sb + row8 * SROW + 16 * pc8) = G.rw[2 * gi]; *(l64x2*)(sb + (8 + row8) * SROW + 16 * pc8) = G.rw[2 * gi + 1]; \
                WAVE_LDS_SYNC(); \
                const l64x2 a01 = *(const l64x2*)(sb + r16 * SROW + 32 * g4), a23 = *(const l64x2*)(sb + r16 * SROW + 32 * g4 + 16); \
                f32x4m acc = {0.f, 0.f, 0.f, 0.f}; \
                acc = __builtin_amdgcn_mfma_f32_16x16x32_fp8_fp8(a01.x, bq[0], acc, 0, 0, 0); acc = __builtin_amdgcn_mfma_f32_16x16x32_fp8_fp8(a01.y, bq[1], acc, 0, 0, 0); \
                acc = __builtin_amdgcn_mfma_f32_16x16x32_fp8_fp8(a23.x, bq[2], acc, 0, 0, 0); acc = __builtin_amdgcn_mfma_f32_16x16x32_fp8_fp8(a23.y, bq[3], acc, 0, 0, 0); \
                _Pragma("unroll") for (int q = 0; q < 4; ++q) { const float lo = dppf<0xB1>(acc[q]); if (r16 == 0) res[gi * 16 + 4 * g4 + q] = acc[q] + lo * 0.0625f; } } \
            WAVE_LDS_SYNC(); \
            { float* po = PACT + (size_t)x * ((size_t)ML * 128) + ((size_t)t0 + (B)) * 128; po[c.lane] = res[c.lane]; po[64 + c.lane] = res[64 + c.lane]; } \
            WAVE_LDS_SYNC(); } while (0)
        E1Bat ga, gb;
        E1_LOAD(ga, 0);
#pragma unroll 1
        for (int b2 = 0; b2 < CH; b2 += 2) {
            E1_LOAD(gb, b2 + 1);
            __builtin_amdgcn_sched_barrier(0);
            E1_COMP(ga, b2);
            __builtin_amdgcn_sched_barrier(0);
            E1_LOAD(ga, b2 + 2);
            __builtin_amdgcn_sched_barrier(0);
            E1_COMP(gb, b2 + 1);
            __builtin_amdgcn_sched_barrier(0);
        }
#undef E1_LOAD
#undef E1_COMP
    }
}
__device__ __forceinline__ void phase_exp1b(const Ctx& c) {
    const int* IDX = (const int*)(c.ws + WS_IDX); const float* GATE = (const float*)(c.ws + WS_GATE); const float* HS = (const float*)(c.ws + WS_HS); const float* PACT = (const float*)(c.ws + WS_PACT);
    const float* USC = (const float*)(c.ws + WS_USC); const float* VSC = (const float*)(c.ws + WS_VSC); float* ACT = (float*)(c.ws + WS_ACT);
    for (size_t i = (size_t)c.bid * NTHREADS + c.tid; i < (size_t)ML * 128; i += (size_t)c.G * NTHREADS) {
        float s = 0.f;
#pragma unroll
        for (int x = 0; x < 8; ++x) s += PACT[(size_t)x * ((size_t)ML * 128) + i];
        const int e = IDX[i];
        ACT[i] = gelu_erf(s * HS[i >> 7] * USC[e]) * GATE[i] * VSC[e];
    }
}
__device__ __forceinline__ void phase_exp2(const Ctx& c) {
    const int* IDX = (const int*)(c.ws + WS_IDX); const float* ACT = (const float*)(c.ws + WS_ACT); const unsigned char* V8 = c.ws + WS_V8;
    float* Y = (float*)(c.ws + WS_Y); float* SSQP = (float*)(c.ws + WS_SSQP);
    unsigned* cnt = (unsigned*)(c.ws + WS_CTL) + CW_E2;
    int* li = (int*)(c.lds + c.wave * 1024); float* la = (float*)(li + 128);
    const int xcc = (int)xcc_id(), sub = c.lane & 7, grp = c.lane >> 3;
    const bool b5 = c.lane & 32, b4 = c.lane & 16, b3 = c.lane & 8;
    constexpr int CH = 8;
    int bo = 0, t = 0, tend = 0;
    int iA = 0, iB = 0; float aA = 0.f, aB = 0.f;
    unsigned tq = 0; if (c.lane == 0) tq = __hip_atomic_fetch_add(cnt + 64 * (xcc & 7), (unsigned)CH, __ATOMIC_RELAXED, __HIP_MEMORY_SCOPE_AGENT);
    for (;;) {
        if (t >= tend) {
            const unsigned t0 = (unsigned)__builtin_amdgcn_readfirstlane((int)tq);
            if (t0 >= (unsigned)ML) { if (++bo >= 8) break; tq = 0; if (c.lane == 0) tq = __hip_atomic_fetch_add(cnt + 64 * ((xcc + bo) & 7), (unsigned)CH, __ATOMIC_RELAXED, __HIP_MEMORY_SCOPE_AGENT); continue; }
            tq = 0; if (c.lane == 0) tq = __hip_atomic_fetch_add(cnt + 64 * ((xcc + bo) & 7), (unsigned)CH, __ATOMIC_RELAXED, __HIP_MEMORY_SCOPE_AGENT);
            t = (int)t0; tend = t + CH;
            iA = IDX[(size_t)t * 128 + c.lane]; iB = IDX[(size_t)t * 128 + 64 + c.lane]; aA = ACT[(size_t)t * 128 + c.lane]; aB = ACT[(size_t)t * 128 + 64 + c.lane];
        }
        const int x = (xcc + bo) & 7;
        li[c.lane] = iA; li[64 + c.lane] = iB; la[c.lane] = aA; la[64 + c.lane] = aB;
        if (t + 1 < tend) { iA = IDX[(size_t)(t + 1) * 128 + c.lane]; iB = IDX[(size_t)(t + 1) * 128 + 64 + c.lane]; aA = ACT[(size_t)(t + 1) * 128 + c.lane]; aB = ACT[(size_t)(t + 1) * 128 + 64 + c.lane]; }
        WAVE_LDS_SYNC();
        float acc[16];
#pragma unroll
        for (int q = 0; q < 16; ++q) acc[q] = 0.f;
#pragma unroll
        for (int hf = 0; hf < 2; ++hf) { v4u rows[8]; float av[8];
#pragma unroll
            for (int i = 0; i < 8; ++i) { const int k = 8 * (8 * hf + i) + grp; rows[i] = *(const v4u*)(V8 + (size_t)li[k] * D + x * 128 + 16 * sub); av[i] = la[k]; }
#pragma unroll
            for (int i = 0; i < 8; ++i) { float f[16]; fp8x16_to_f32(rows[i], f);
#pragma unroll
                for (int q = 0; q < 16; ++q) acc[q] = fmaf(av[i], f[q], acc[q]); } }
        float q8[8], q4[4], q2[2];
#pragma unroll
        for (int i = 0; i < 8; ++i) { const float keep = b5 ? acc[i + 8] : acc[i], send = b5 ? acc[i] : acc[i + 8]; q8[i] = keep + __shfl_xor(send, 32); }
#pragma unroll
        for (int i = 0; i < 4; ++i) { const float keep = b4 ? q8[i + 4] : q8[i], send = b4 ? q8[i] : q8[i + 4]; q4[i] = keep + __shfl_xor(send, 16); }
#pragma unroll
        for (int i = 0; i < 2; ++i) { const float keep = b3 ? q4[i + 2] : q4[i], send = b3 ? q4[i] : q4[i + 2]; q2[i] = keep + __shfl_xor(send, 8); }
        const int col = x * 128 + 16 * sub + (b5 ? 8 : 0) + (b4 ? 4 : 0) + (b3 ? 2 : 0);
        *(f32x2*)(Y + (size_t)t * D + col) = (f32x2){q2[0], q2[1]};
        const float ss = wsum(q2[0] * q2[0] + q2[1] * q2[1]);
        SSQP[(size_t)x * ML + t] = ss;
        WAVE_LDS_SYNC();
        ++t;
    }
}
__device__ __forceinline__ void phase_exp3(const Ctx& c) {
    const Args& a = *c.a;
    const float* MOD = (const float*)(c.ws + WS_MOD); const float* Y = (const float*)(c.ws + WS_Y); const float* SSQP = (const float*)(c.ws + WS_SSQP);
    f32x4 ny[4], nx[4]; float nss = 0.f;
#define E3_LOAD(R) do { _Pragma("unroll") for (int j = 0; j < 4; ++j) { const int col = 4 * c.lane + 256 * j; ny[j] = *(const f32x4*)(Y + (size_t)(R) * D + col); nx[j] = *(const f32x4*)(a.out + (size_t)(R) * D + col); } \
        nss = (c.lane < 8) ? SSQP[(size_t)c.lane * ML + (R)] : 0.f; } while (0)
    if (c.gw < ML) E3_LOAD(c.gw);
    for (int row = c.gw; row < ML; row += c.NGW) {
        f32x4 y[4], x1[4];
#pragma unroll
        for (int j = 0; j < 4; ++j) { y[j] = ny[j]; x1[j] = nx[j]; }
        const float ss = row_sum16(nss);
        const float tot = __builtin_bit_cast(float, __builtin_amdgcn_readlane(__builtin_bit_cast(int, ss), 0));
        if (row + c.NGW < ML) E3_LOAD(row + c.NGW);
        const float r = rsqrtf(tot * (1.f / D) + EPS); const float* mr = MOD + (row >> 11) * 6144 + 5120;
#pragma unroll
        for (int j = 0; j < 4; ++j) { const int col = 4 * c.lane + 256 * j;
            const f32x4 g4 = *(const f32x4*)(a.in[I_GPOSTFFN] + col), gt = *(const f32x4*)(mr + col);
            *(f32x4*)(a.out + (size_t)row * D + col) = x1[j] + gt * ((y[j] * r) * g4); }
    }
#undef E3_LOAD
}

constexpr int S5_LPOW = 0, S5_BBAR = 33792, S5_CC = 50176, S5_MM = 66560;
__device__ __forceinline__ void s5_build_group(const Ctx& c, int g, int part) {
    const Args& a = *c.a;
    f32x2* LPOW = (f32x2*)(c.lds + S5_LPOW);
    f32x2* BBAR = (f32x2*)(c.lds + S5_BBAR);
    f32x2* CC = (f32x2*)(c.lds + S5_CC);
    float* MM = (float*)(c.lds + S5_MM);
    __syncthreads();
    if (c.tid < 128) { const int dir = c.tid >> 6, p = c.tid & 63, dg = dir * 32 + g;
        const float dt = expf(a.in[I_LOGDT][dg]), lr = a.in[I_LAMRE][dg * 64 + p], li = a.in[I_LAMIM][dg * 64 + p];
        const double ang = (double)li * (double)dt; const float lrdt = lr * dt;
        for (int e = 0; e <= 32; ++e) { float sn, cs; sincos_d(ang * (double)e, sn, cs); const float mg = expf(lrdt * (float)e); LPOW[(dir * 33 + e) * 64 + p] = (f32x2){mg * cs, mg * sn}; }
        float sn, cs; sincos_d(ang, sn, cs); const float mag = expf(lrdt), lbr = mag * cs, lbi = mag * sn, den = lr * lr + li * li, nr = lbr - 1.f;
        const float cr = (nr * lr + lbi * li) / den, ci = (lbi * lr - nr * li) / den;
        for (int ch = 0; ch < 16; ++ch) { const float br = a.in[I_BRE][(size_t)(dg * 64 + p) * 16 + ch], bi = a.in[I_BIM][(size_t)(dg * 64 + p) * 16 + ch]; BBAR[(dir * 64 + p) * 16 + ch] = (f32x2){cr * br - ci * bi, cr * bi + ci * br}; } }
    for (int i = c.tid; i < 2048; i += NTHREADS) { const int dir = i >> 10, ch = (i >> 6) & 15, p = i & 63, dg = dir * 32 + g; CC[i] = (f32x2){a.in[I_CRE][(size_t)(dg * 16 + ch) * 64 + p], a.in[I_CIM][(size_t)(dg * 16 + ch) * 64 + p]}; }
    __syncthreads();
    for (int task = c.tid; task < 1024; task += NTHREADS) { const int cpb = task & 3, cb = (task >> 2) & 3, lag = (task >> 4) & 31, dir = task >> 9;
        float acc[4][4];
#pragma unroll
        for (int i = 0; i < 4; ++i)
#pragma unroll
            for (int j = 0; j < 4; ++j) acc[i][j] = 0.f;
        for (int p = 0; p < 64; ++p) { const f32x2 l = LPOW[(dir * 33 + lag) * 64 + p]; f32x2 G[4], Cw[4];
#pragma unroll
            for (int j = 0; j < 4; ++j) { const f32x2 bb = BBAR[(dir * 64 + p) * 16 + 4 * cpb + j]; G[j] = (f32x2){l.x * bb.x - l.y * bb.y, l.x * bb.y + l.y * bb.x}; }
#pragma unroll
            for (int i = 0; i < 4; ++i) Cw[i] = CC[(dir * 16 + 4 * cb + i) * 64 + p];
#pragma unroll
            for (int i = 0; i < 4; ++i)
#pragma unroll
                for (int j = 0; j < 4; ++j) acc[i][j] += Cw[i].x * G[j].x - Cw[i].y * G[j].y; }
#pragma unroll
        for (int i = 0; i < 4; ++i)
#pragma unroll
            for (int j = 0; j < 4; ++j) MM[((dir * 32 + lag) * 16 + 4 * cb + i) * 16 + 4 * cpb + j] = acc[i][j]; }
    __syncthreads();
    if (c.tid < 128 && part == 0) { const int dir = c.tid >> 6, p = c.tid & 63; ((f32x2*)(c.ws + WS_LP))[(dir * 32 + g) * 64 + p] = LPOW[(dir * 33 + 32) * 64 + p]; }
    bf16* PMg = (bf16*)(c.ws + WS_PM) + (size_t)g * 256 * 512; bf16* BBg = (bf16*)(c.ws + WS_BB) + (size_t)g * 512 * 768;
    for (int task = part * 32 * 32 + c.tid; task < (part + 1) * 32 * 32; task += NTHREADS) { const int ip = task & 31, n = task >> 5, dir = n >> 7, im = (n >> 6) & 1, p = n & 63, e = dir ? ip : 31 - ip;
        const f32x2 l = LPOW[(dir * 33 + e) * 64 + p]; float o[16];
#pragma unroll
        for (int ch = 0; ch < 16; ++ch) { const f32x2 bb = BBAR[(dir * 64 + p) * 16 + ch]; o[ch] = im ? (l.x * bb.y + l.y * bb.x) : (l.x * bb.x - l.y * bb.y); }
        v4u w0, w1; w0.x = pk2(o[0], o[1]); w0.y = pk2(o[2], o[3]); w0.z = pk2(o[4], o[5]); w0.w = pk2(o[6], o[7]); w1.x = pk2(o[8], o[9]); w1.y = pk2(o[10], o[11]); w1.z = pk2(o[12], o[13]); w1.w = pk2(o[14], o[15]);
        *(v4u*)(PMg + (size_t)n * 512 + ip * 16) = w0; *(v4u*)(PMg + (size_t)n * 512 + ip * 16 + 8) = w1; }
    for (int task = part * 64 * 32 + c.tid; task < (part + 1) * 64 * 32; task += NTHREADS) { const int ip = task & 31, n = task >> 5, i = n >> 4, ch = n & 15; float o[16];
#pragma unroll
        for (int q = 0; q < 16; ++q) o[q] = 0.f;
        if (ip <= i) { const float* m0 = MM + ((0 * 32 + (i - ip)) * 16 + ch) * 16;
#pragma unroll
            for (int q = 0; q < 16; ++q) o[q] += m0[q]; }
        if (ip >= i) { const float* m1 = MM + ((1 * 32 + (ip - i)) * 16 + ch) * 16;
#pragma unroll
            for (int q = 0; q < 16; ++q) o[q] += m1[q]; }
        if (ip == i) { const float dsk = a.in[I_S5D][g * 16 + ch];
#pragma unroll
            for (int q = 0; q < 16; ++q) o[q] += (q == ch) ? dsk : 0.f; }
        v4u w0, w1; w0.x = pk2(o[0], o[1]); w0.y = pk2(o[2], o[3]); w0.z = pk2(o[4], o[5]); w0.w = pk2(o[6], o[7]); w1.x = pk2(o[8], o[9]); w1.y = pk2(o[10], o[11]); w1.z = pk2(o[12], o[13]); w1.w = pk2(o[14], o[15]);
        *(v4u*)(BBg + (size_t)n * 768 + ip * 16) = w0; *(v4u*)(BBg + (size_t)n * 768 + ip * 16 + 8) = w1; }
    for (int task = part * 64 * 32 + c.tid; task < (part + 1) * 64 * 32; task += NTHREADS) { const int p8 = task & 7, part = (task >> 3) & 3, n = task >> 5, i = n >> 4, ch = n & 15, dir = part >> 1, im = part & 1, e = dir ? 32 - i : i + 1; float o[8];
#pragma unroll
        for (int q = 0; q < 8; ++q) { const int p = p8 * 8 + q; const f32x2 l = LPOW[(dir * 33 + e) * 64 + p], cc = CC[(dir * 16 + ch) * 64 + p]; o[q] = im ? -(cc.x * l.y + cc.y * l.x) : (cc.x * l.x - cc.y * l.y); }
        v4u w0; w0.x = pk2(o[0], o[1]); w0.y = pk2(o[2], o[3]); w0.z = pk2(o[4], o[5]); w0.w = pk2(o[6], o[7]);
        *(v4u*)(BBg + (size_t)n * 768 + 512 + part * 64 + p8 * 8) = w0; }
}
__device__ __forceinline__ void s5_state_scan(const Ctx& c, int task) {
    const int dir = task & 1, g = (task >> 1) & 31, b = task >> 6, p = c.lane;
    const f32x2 a = ((const f32x2*)(c.ws + WS_LP))[(dir * 32 + g) * 64 + p];
    const float* SS = (const float*)(c.ws + WS_SS) + (size_t)g * 768 * 256 + dir * 128 + p; bf16* U5 = (bf16*)(c.ws + WS_U5) + (size_t)g * 768 * 768 + 512 + dir * 128 + p;
    float er = 0.f, ei = 0.f;
#pragma unroll 8
    for (int step = 0; step < 72; ++step) {
        const int R = (step < 8) ? 512 + b * 8 + (dir ? 7 - step : step) : b * 64 + (dir ? 71 - step : step - 8);
        if (step >= 8) { U5[(size_t)R * 768] = (bf16)f2bf(er); U5[(size_t)R * 768 + 64] = (bf16)f2bf(ei); }
        const float sr = SS[(size_t)R * 256], si = SS[(size_t)R * 256 + 64];
        const float nr = sr + a.x * er - a.y * ei, ni = si + a.x * ei + a.y * er; er = nr; ei = ni;
    }
}

constexpr int GDN_NCH = 36, GDN_ITEMS = NB * 4 * 2 * GDN_NCH;
constexpr size_t FR_T_BYTES = 8192, FR_ATT_BYTES = 8192, FR_KD_BYTES = 16384, FR_TAB_BYTES = 1024;
__device__ __forceinline__ int crow16(int i, int hh) { return (i & 3) + 8 * (i >> 2) + 4 * hh; }
__device__ __forceinline__ bf16x8 pack_step(const f32x16& x, int s) {
    v4u w; w.x = pk2(x[8 * s + 0], x[8 * s + 1]); w.y = pk2(x[8 * s + 2], x[8 * s + 3]); w.z = pk2(x[8 * s + 4], x[8 * s + 5]); w.w = pk2(x[8 * s + 6], x[8 * s + 7]);
    return __builtin_bit_cast(bf16x8, w);
}
__device__ __forceinline__ unsigned pk2v(float lo, float hi) { asm volatile("" : "+v"(lo), "+v"(hi)); return pk2(lo, hi); }
__device__ __forceinline__ bf16x8 pack_step_v(const f32x16& x, int s) {
    v4u w; w.x = pk2v(x[8 * s + 0], x[8 * s + 1]); w.y = pk2v(x[8 * s + 2], x[8 * s + 3]); w.z = pk2v(x[8 * s + 4], x[8 * s + 5]); w.w = pk2v(x[8 * s + 6], x[8 * s + 7]);
    return __builtin_bit_cast(bf16x8, w);
}
constexpr int GP_KR = 0, GP_QR = 17408, GP_KT = 34816, GP_TAB = 53248, GP_LP = 54272, GP_LPB = 8448 + 256;
__host__ __device__ constexpr int LOFF(int i) { return i < 1 ? 0 : 4 * (((i - 1) >> 2) + 1) * (2 * ((i - 1) >> 2) + ((i - 1) & 3)); }
static_assert(LOFF(1) == 0 && LOFF(2) == 4 && LOFF(5) == 16 && LOFF(6) == 24 && LOFF(64) == 2112, "packed lower-triangular row offsets");
__device__ __forceinline__ void gdn_prep_stage(const Ctx& c, int item, float* Lp) {
    const int n = item % GDN_NCH, bhd = item / GDN_NCH, dir = bhd & 1, h = (bhd >> 1) & 3, b = bhd >> 3;
    const bf16* QKV = (const bf16*)(c.ws + WS_QKV); const float* GB = (const float*)(c.ws + WS_GB);
    bf16* Kr = (bf16*)(c.lds + GP_KR); bf16* Qr = (bf16*)(c.lds + GP_QR); bf16* Kt = (bf16*)(c.lds + GP_KT); float* tab = (float*)(c.lds + GP_TAB);
    unsigned char* frA = c.ws + WS_FRA + (size_t)item * FR_ATT_BYTES; unsigned char* frK = c.ws + WS_FRK + (size_t)item * FR_KD_BYTES; float* frTab = (float*)(c.ws + WS_FRTAB + (size_t)item * FR_TAB_BYTES);
    const int r = c.lane & 31, hh = c.lane >> 5;
    if (c.wave == 0) { const int row = scan_row(b, dir, n * 64 + c.lane); float g = GB[(size_t)row * 16 + dir * 4 + h]; const float beta = GB[(size_t)row * 16 + 8 + dir * 4 + h];
#pragma unroll
        for (int o = 1; o < 64; o <<= 1) { const float t = __shfl_up(g, o); if (c.lane >= o) g += t; }
        const float gl = __shfl(g, 63);
        tab[c.lane] = g; tab[64 + c.lane] = beta; tab[128 + c.lane] = __expf(g); tab[192 + c.lane] = __expf(gl - g); }
    { const int s = c.tid >> 3, seg = c.tid & 7; const int row = scan_row(b, dir, n * 64 + s); const bf16* rp = QKV + (size_t)row * 1536 + h * 128 + seg * 16;
      const v4u q0 = *(const v4u*)rp, q1 = *(const v4u*)(rp + 8), k0 = *(const v4u*)(rp + 512), k1 = *(const v4u*)(rp + 520);
      *(v4u*)(Qr + s * 136 + seg * 16) = q0; *(v4u*)(Qr + s * 136 + seg * 16 + 8) = q1; *(v4u*)(Kr + s * 136 + seg * 16) = k0; *(v4u*)(Kr + s * 136 + seg * 16 + 8) = k1;
      const unsigned kw[8] = {k0.x, k0.y, k0.z, k0.w, k1.x, k1.y, k1.z, k1.w};
#pragma unroll
      for (int e = 0; e < 8; ++e) { Kt[(seg * 16 + 2 * e) * 72 + s] = (bf16)(kw[e] & 0xffffu); Kt[(seg * 16 + 2 * e + 1) * 72 + s] = (bf16)(kw[e] >> 16); } }
    __syncthreads();
    if (c.wave < 3) { const int ct = c.wave ? 1 : 0, st = c.wave == 2 ? 1 : 0;
        f32x16 acc;
#pragma unroll
        for (int i = 0; i < 16; ++i) acc[i] = 0.f;
#pragma unroll
        for (int kk = 0; kk < 8; ++kk) { const bf16x8 a = *(const bf16x8*)(Kr + (ct * 32 + r) * 136 + kk * 16 + hh * 8), bb = *(const bf16x8*)(Kr + (st * 32 + r) * 136 + kk * 16 + hh * 8); acc = MFMA32(a, bb, acc); }
        const int s = st * 32 + r; const float gcs = tab[s];
#pragma unroll
        for (int i = 0; i < 16; ++i) { const int cc = ct * 32 + crow16(i, hh); if (s < cc) Lp[LOFF(cc) + s] = tab[64 + cc] * acc[i] * __expf(tab[cc] - gcs); }
    } else if (c.wave < 6) { const int w = c.wave - 3, st = w == 2 ? 1 : 0, ct = w ? 1 : 0;
        f32x16 acc;
#pragma unroll
        for (int i = 0; i < 16; ++i) acc[i] = 0.f;
#pragma unroll
        for (int kk = 0; kk < 8; ++kk) { const bf16x8 a = *(const bf16x8*)(Kr + (st * 32 + r) * 136 + kk * 16 + hh * 8), bb = *(const bf16x8*)(Qr + (ct * 32 + r) * 136 + kk * 16 + hh * 8); acc = MFMA32(a, bb, acc); }
        const int cc = ct * 32 + r; const float gcc = tab[cc];
#pragma unroll
        for (int i = 0; i < 16; ++i) { const int s = st * 32 + crow16(i, hh); acc[i] = (s <= cc) ? acc[i] * __expf(gcc - tab[s]) : 0.f; }
        *(bf16x8*)(frA + ((size_t)((ct * 4 + 2 * st) * 64 + c.lane)) * 16) = pack_step(acc, 0);
        *(bf16x8*)(frA + ((size_t)((ct * 4 + 2 * st + 1) * 64 + c.lane)) * 16) = pack_step(acc, 1);
    } else { const int w = c.wave - 6;
#pragma unroll
        for (int f = 0; f < 8; ++f) { const int fi = w * 8 + f, dkt = fi >> 2, cb = fi & 3; const bf16* kp = Kt + (dkt * 32 + r) * 72 + 16 * cb + 4 * hh;
            const v2u lo = *(const v2u*)kp, hi = *(const v2u*)(kp + 8); const f32x4 e0 = *(const f32x4*)(tab + 192 + 16 * cb + 4 * hh), e1 = *(const f32x4*)(tab + 192 + 16 * cb + 8 + 4 * hh);
            v4u o; o.x = pk2(bflo(lo.x) * e0.x, bfhi(lo.x) * e0.y); o.y = pk2(bflo(lo.y) * e0.z, bfhi(lo.y) * e0.w); o.z = pk2(bflo(hi.x) * e1.x, bfhi(hi.x) * e1.y); o.w = pk2(bflo(hi.y) * e1.z, bfhi(hi.y) * e1.w);
            *(v4u*)(frK + ((size_t)(fi * 64 + c.lane)) * 16) = o; }
        if (w == 0) { const v4u z = (v4u){0u, 0u, 0u, 0u}; *(v4u*)(frA + ((size_t)((0 * 4 + 2) * 64 + c.lane)) * 16) = z; *(v4u*)(frA + ((size_t)((0 * 4 + 3) * 64 + c.lane)) * 16) = z; }
        else { *(f32x4*)(frTab + 4 * c.lane) = *(const f32x4*)(tab + 4 * c.lane); }
    }
    __syncthreads();
}
__device__ __forceinline__ void gdn_prep_solve(const Ctx& c, int item, float* Lp) {
    float Tr[64];
#pragma unroll
    for (int i = 0; i < 64; ++i) { int le_ = c.lane; asm volatile("" : "+v"(le_)); float a0 = (le_ == i) ? 1.f : 0.f, a1 = 0.f;
#pragma unroll
        for (int s4 = 0; s4 < (i + 3) / 4; ++s4) { const f32x4 l4 = *(const f32x4*)(Lp + LOFF(i) + 4 * s4);
            if (4 * s4 + 0 < i) a0 = fmaf(-l4.x, Tr[4 * s4 + 0], a0); if (4 * s4 + 1 < i) a1 = fmaf(-l4.y, Tr[4 * s4 + 1], a1); if (4 * s4 + 2 < i) a0 = fmaf(-l4.z, Tr[4 * s4 + 2], a0); if (4 * s4 + 3 < i) a1 = fmaf(-l4.w, Tr[4 * s4 + 3], a1); }
        Tr[i] = a0 + a1; { int lo_ = c.lane; asm volatile("" : "+v"(lo_)); Lp[(lo_ < i) ? LOFF(i) + lo_ : 2112 + lo_] = Tr[i]; } }
    WAVE_LDS_SYNC();
    unsigned char* frT = c.ws + WS_FRT + (size_t)item * FR_T_BYTES;
    const int r = c.lane & 31, hh = c.lane >> 5;
#pragma unroll
    for (int f = 0; f < 8; ++f) { const int ct = f >> 2, sb = f & 3, cc = ct * 32 + r; float v[8];
#pragma unroll
        for (int q = 0; q < 2; ++q) { const int s0 = 16 * sb + 8 * q + 4 * hh;
            f32x4 t4 = (f32x4){0.f, 0.f, 0.f, 0.f}; if (s0 < cc) t4 = *(const f32x4*)(Lp + LOFF(cc) + s0);
            v[4 * q + 0] = (s0 + 0 < cc) ? t4.x : (s0 + 0 == cc ? 1.f : 0.f); v[4 * q + 1] = (s0 + 1 < cc) ? t4.y : (s0 + 1 == cc ? 1.f : 0.f);
            v[4 * q + 2] = (s0 + 2 < cc) ? t4.z : (s0 + 2 == cc ? 1.f : 0.f); v[4 * q + 3] = (s0 + 3 < cc) ? t4.w : (s0 + 3 == cc ? 1.f : 0.f); }
        *(v4u*)(frT + ((size_t)(f * 64 + c.lane)) * 16) = (v4u){pk2(v[0], v[1]), pk2(v[2], v[3]), pk2(v[4], v[5]), pk2(v[6], v[7])}; }
}
__device__ __forceinline__ void phase_gdn_prep(const Ctx& c) {
    for (int base = c.bid; base < GDN_ITEMS; base += 8 * c.G) {
        int cnt = 0;
#pragma unroll 1
        for (int q = 0; q < 8; ++q) { const int item = base + q * c.G; if (item < GDN_ITEMS) { gdn_prep_stage(c, item, (float*)(c.lds + GP_LP + q * GP_LPB)); cnt = q + 1; } }
        if (c.wave < cnt) gdn_prep_solve(c, base + c.wave * c.G, (float*)(c.lds + GP_LP + c.wave * GP_LPB));
        __syncthreads();
    }
}

constexpr int GR_K = 0, GR_Q = 16384, GR_T = 32768, GR_A = 40960, GR_KD = 49152, GR_TAB = 65536, GR_BUF = 66560;
__device__ __forceinline__ void gdn_rec_stage(const Ctx& c, int bhd, int n, int buf) {
    const int dir = bhd & 1, h = (bhd >> 1) & 3, b = bhd >> 3, lw = c.wave - 4; const int item = bhd * GDN_NCH + n;
    LAS unsigned char* base = (LAS unsigned char*)c.lds + buf * GR_BUF;
    const unsigned char* QKVb = c.ws + WS_QKV;
#pragma unroll
    for (int q = 0; q < 4; ++q) { const int qi = lw + 4 * q;
        const int s = 4 * qi + (c.lane >> 4), ps = c.lane & 15, p = ps ^ (s & 15); const size_t rowb = (size_t)scan_row(b, dir, n * 64 + s) * 3072 + (size_t)h * 256 + p * 16;
        __builtin_amdgcn_global_load_lds((const unsigned*)(QKVb + rowb + 1024), (LAS unsigned*)(base + GR_K + qi * 1024), 16, 0, 0);
        __builtin_amdgcn_global_load_lds((const unsigned*)(QKVb + rowb), (LAS unsigned*)(base + GR_Q + qi * 1024), 16, 0, 0); }
    const unsigned char* frT = c.ws + WS_FRT + (size_t)item * FR_T_BYTES; const unsigned char* frA = c.ws + WS_FRA + (size_t)item * FR_ATT_BYTES; const unsigned char* frK = c.ws + WS_FRK + (size_t)item * FR_KD_BYTES;
#pragma unroll
    for (int q = 0; q < 2; ++q) { const int qi = lw + 4 * q;
        __builtin_amdgcn_global_load_lds((const unsigned*)(frT + qi * 1024 + c.lane * 16), (LAS unsigned*)(base + GR_T + qi * 1024), 16, 0, 0);
        __builtin_amdgcn_global_load_lds((const unsigned*)(frA + qi * 1024 + c.lane * 16), (LAS unsigned*)(base + GR_A + qi * 1024), 16, 0, 0); }
#pragma unroll
    for (int q = 0; q < 4; ++q) { const int qi = lw + 4 * q;
        __builtin_amdgcn_global_load_lds((const unsigned*)(frK + qi * 1024 + c.lane * 16), (LAS unsigned*)(base + GR_KD + qi * 1024), 16, 0, 0); }
    if (lw == 0) __builtin_amdgcn_global_load_lds((const unsigned*)(c.ws + WS_FRTAB + (size_t)item * FR_TAB_BYTES + c.lane * 16), (LAS unsigned*)(base + GR_TAB), 16, 0, 0);
}
__device__ __forceinline__ bf16x8 gr_rowfrag(const unsigned char* rowp, const int (&po)[16], int kb) {
    const v2u lo = *(const v2u*)(rowp + po[2 * kb]), hi = *(const v2u*)(rowp + po[2 * kb + 1]);
    return __builtin_bit_cast(bf16x8, (v4u){lo.x, lo.y, hi.x, hi.y});
}
__device__ __forceinline__ void gdn_rec_block(const Ctx& c, int bhd, int dvhalf) {
    const int dir = bhd & 1, h = (bhd >> 1) & 3, b = bhd >> 3, r = c.lane & 31, hh = c.lane >> 5, dvt = 2 * dvhalf + (c.wave & 1);
    const bf16* QKV = (const bf16*)(c.ws + WS_QKV); bf16* OG = (bf16*)(c.ws + WS_OG) + (size_t)dir * ML * 512;
    f32x16 S[4];
#pragma unroll
    for (int t = 0; t < 4; ++t)
#pragma unroll
        for (int i = 0; i < 16; ++i) S[t][i] = 0.f;
    int po[16];
#pragma unroll
    for (int p = 0; p < 16; ++p) po[p] = r * 256 + ((p ^ (r & 15)) * 16) + 8 * hh;
    if (c.wave >= 4) gdn_rec_stage(c, bhd, 0, 0);
    asm volatile("s_waitcnt vmcnt(0)" ::: "memory"); __syncthreads();
    for (int n = 0; n < GDN_NCH; ++n) {
        const int buf = n & 1;
        if (c.wave >= 4) { if (n + 1 < GDN_NCH) gdn_rec_stage(c, bhd, n + 1, buf ^ 1); }
        else if (c.wave < 2) {
            const unsigned char* base = c.lds + buf * GR_BUF; const float* tab = (const float*)(base + GR_TAB);
            const int row0 = scan_row(b, dir, n * 64), sgn = dir ? -1 : 1;
            const bf16* vcol = QKV + (size_t)row0 * 1536 + 1024 + h * 128 + dvt * 32 + r + (ptrdiff_t)(sgn * 4 * hh) * 1536;
            bf16* ocol = OG + (size_t)row0 * 512 + h * 128 + dvt * 32 + r + (ptrdiff_t)(sgn * 4 * hh) * 512;
            const ptrdiff_t vst = (ptrdiff_t)sgn * 1536, ost = (ptrdiff_t)sgn * 512;
            bf16 vraw[2][16];
#pragma unroll
            for (int st = 0; st < 2; ++st)
#pragma unroll
                for (int i = 0; i < 16; ++i) vraw[st][i] = vcol[vst * (st * 32 + (i & 3) + 8 * (i >> 2))];
            bf16x8 Rf[2][2];
#pragma unroll
            for (int st = 0; st < 2; ++st) { f32x16 acc;
#pragma unroll
                for (int i = 0; i < 16; ++i) acc[i] = 0.f;
#pragma unroll
                for (int kb = 0; kb < 8; ++kb) acc = MFMA32(gr_rowfrag(base + GR_K + st * 8192, po, kb), pack_step_v(S[kb >> 1], kb & 1), acc);
#pragma unroll
                for (int i = 0; i < 16; ++i) { const int s = st * 32 + crow16(i, hh); acc[i] = tab[64 + s] * (bf1(vraw[st][i]) - tab[128 + s] * acc[i]); }
                Rf[st][0] = pack_step(acc, 0); Rf[st][1] = pack_step(acc, 1); asm volatile("" ::: "memory"); }
            bf16x8 Vf[2][2];
#pragma unroll
            for (int ct = 0; ct < 2; ++ct) { f32x16 acc;
#pragma unroll
                for (int i = 0; i < 16; ++i) acc[i] = 0.f;
#pragma unroll
                for (int sb = 0; sb < 4; ++sb) if (sb < 2 * ct + 2) acc = MFMA32(*(const bf16x8*)(base + GR_T + ((ct * 4 + sb) * 64 + c.lane) * 16), Rf[sb >> 1][sb & 1], acc);
                Vf[ct][0] = pack_step(acc, 0); Vf[ct][1] = pack_step(acc, 1); }
            asm volatile("" ::: "memory");
#pragma unroll
            for (int ct = 0; ct < 2; ++ct) { f32x16 acc;
#pragma unroll
                for (int i = 0; i < 16; ++i) acc[i] = 0.f;
#pragma unroll
                for (int kb = 0; kb < 8; ++kb) acc = MFMA32(gr_rowfrag(base + GR_Q + ct * 8192, po, kb), pack_step_v(S[kb >> 1], kb & 1), acc);
#pragma unroll
                for (int i = 0; i < 16; ++i) acc[i] *= tab[128 + ct * 32 + crow16(i, hh)];
#pragma unroll
                for (int cb = 0; cb < 4; ++cb) if (cb < 2 * ct + 2) acc = MFMA32(*(const bf16x8*)(base + GR_A + ((ct * 4 + cb) * 64 + c.lane) * 16), Vf[cb >> 1][cb & 1], acc);
                if (n >= 4) {
#pragma unroll
                    for (int i = 0; i < 16; ++i) ocol[ost * (ct * 32 + (i & 3) + 8 * (i >> 2))] = (bf16)f2bf(acc[i]); }
                asm volatile("" ::: "memory"); }
            const float gtot = tab[128 + 63];
#pragma unroll
            for (int t = 0; t < 4; ++t) {
#pragma unroll
                for (int i = 0; i < 16; ++i) S[t][i] *= gtot;
#pragma unroll
                for (int cb = 0; cb < 4; ++cb) S[t] = MFMA32(*(const bf16x8*)(base + GR_KD + ((t * 4 + cb) * 64 + c.lane) * 16), Vf[cb >> 1][cb & 1], S[t]); }
        }
        if (c.wave >= 4) asm volatile("s_waitcnt vmcnt(0)" ::: "memory"); else asm volatile("s_waitcnt lgkmcnt(0)" ::: "memory");
        __builtin_amdgcn_s_barrier(); asm volatile("" ::: "memory");
    }
    asm volatile("s_waitcnt vmcnt(0)" ::: "memory"); __syncthreads();
}
__device__ __forceinline__ void phase_gdn_rec(const Ctx& c) { if (c.bid < 128) gdn_rec_block(c, c.bid >> 1, c.bid & 1); }

#define XB_TMO      128
#define XB_XCNT(j)  (256  + 64 * (j))
#define XB_XSUB(j)  (1280 + 64 * (j))
#define XB_XGEN(j)  (2304 + 64 * (j))
#define XB_TOP      3328
#define XB_TOPGEN   3392
#define XCD_BAR_WORDS 3456
#define XB_SPIN_CAP (1u << 20)
__device__ __forceinline__ unsigned xb_ld(unsigned* p)              { return __hip_atomic_load(p, __ATOMIC_RELAXED, __HIP_MEMORY_SCOPE_AGENT); }
__device__ __forceinline__ unsigned xb_add(unsigned* p, unsigned v) { return __hip_atomic_fetch_add(p, v, __ATOMIC_RELAXED, __HIP_MEMORY_SCOPE_AGENT); }
__device__ __forceinline__ unsigned xb_xcc_id() { return (unsigned)__builtin_amdgcn_s_getreg((3 << 11) | 20) & 0xFu; }
#define XB_SPIN(cond, bar) do { unsigned _sp = 0; while (cond) { __builtin_amdgcn_s_sleep(1); \
    if ((++_sp & 255u) == 0u) { if (xb_ld(&(bar)[XB_TMO])) break; if (_sp > XB_SPIN_CAP) { atomicAdd(&(bar)[XB_TMO], 1u); break; } } } } while (0)
struct XcdBarrier { unsigned* bar; unsigned x; volatile LAS unsigned* st; };
__device__ __forceinline__ XcdBarrier xcd_barrier_post(unsigned* bar, volatile LAS unsigned* st) {
    XcdBarrier b; b.bar = bar; b.x = xb_xcc_id(); b.st = st;
    if (threadIdx.x == 0) (void)xb_add(&bar[XB_XCNT(b.x)], 1u);
    return b;
}
__device__ __forceinline__ void xcd_barrier_complete(unsigned* bar, unsigned x, unsigned& nloc, unsigned& nx) {
    const unsigned G = gridDim.x * gridDim.y * gridDim.z;
    unsigned sum, cnt, mine, sp = 0u;
    for (;;) {
        sum = 0u; cnt = 0u; mine = 0u;
#pragma unroll
        for (unsigned j = 0; j < 16; ++j) { const unsigned c = xb_ld(&bar[XB_XCNT(j)]); sum += c; cnt += (c > 0u) ? 1u : 0u; mine = (j == x) ? c : mine; }
        if (sum == G) break;
        __builtin_amdgcn_s_sleep(1);
        if ((++sp & 255u) == 0u) { if (xb_ld(&bar[XB_TMO])) break; if (sp > XB_SPIN_CAP) { atomicAdd(&bar[XB_TMO], 1u); break; } }
    }
    nloc = mine > 0u ? mine : 1u; nx = cnt > 0u ? cnt : 1u;
}
__device__ __forceinline__ void xcd_barrier(const XcdBarrier& b) {
    asm volatile("s_waitcnt vmcnt(0)" ::: "memory");
    __syncthreads();
    if (threadIdx.x == 0) {
        unsigned* bar = b.bar;
        __builtin_amdgcn_s_waitcnt(0);
        unsigned nloc = b.st[0], nx = b.st[1];
        if (nloc == 0u) { xcd_barrier_complete(bar, b.x, nloc, nx); b.st[0] = nloc; b.st[1] = nx; }
        const unsigned old = xb_add(&bar[XB_XSUB(b.x)], 1u);
        const unsigned gen = old / nloc;
        if (old + 1u == (gen + 1u) * nloc) {
            __builtin_amdgcn_fence(__ATOMIC_RELEASE, "agent");
            asm volatile("s_waitcnt vmcnt(0)" ::: "memory");
            const unsigned og = xb_add(&bar[XB_TOP], 1u);
            const unsigned tg = og / nx;
            if (og + 1u == (tg + 1u) * nx) xb_add(&bar[XB_TOPGEN], 1u);
            else XB_SPIN(xb_ld(&bar[XB_TOPGEN]) == tg, bar);
            __builtin_amdgcn_fence(__ATOMIC_ACQUIRE, "agent");
            xb_add(&bar[XB_XGEN(b.x)], 1u);
            asm volatile("s_waitcnt vmcnt(0)" ::: "memory");
        } else {
            XB_SPIN(xb_ld(&bar[XB_XGEN(b.x)]) == gen, bar);
            __builtin_amdgcn_fence(__ATOMIC_ACQUIRE, "agent");
            asm volatile("s_waitcnt vmcnt(0)" ::: "memory");
        }
    }
    __syncthreads();
}

constexpr int LDS_MISC = LDS_BYTES - 64;
__global__ void __launch_bounds__(NTHREADS, 2) mk_fwd(Args args) {
    extern __shared__ __attribute__((aligned(16))) unsigned char lds[];
    Ctx c; c.a = &args; c.ws = args.ws; c.lds = lds;
    c.tid = threadIdx.x; c.lane = c.tid & 63; c.wave = __builtin_amdgcn_readfirstlane(c.tid >> 6); c.bid = blockIdx.x; c.G = gridDim.x;
    c.gw = c.bid * NWAVES + c.wave; c.NGW = c.G * NWAVES; c.gwv = c.wave * c.G + c.bid;
    const int lo = args.ph_lo, hi = args.ph_hi;
    PG8_LAS unsigned char* ring = (PG8_LAS unsigned char*)lds;
#ifndef MK_PH_MASK
#define MK_PH_MASK 0xffff
#endif
#define IN(k) (((MK_PH_MASK >> (k)) & 1) && lo <= (k) && (k) < hi)
#if MK_ONE_LAUNCH
    cg::grid_group grid = cg::this_grid();
    if (lo < 0) grid.sync();
    volatile LAS unsigned* st = (volatile LAS unsigned*)((LAS unsigned char*)lds + LDS_MISC);
    if (c.tid < 2) st[c.tid] = 0u;
    __syncthreads();
    const XcdBarrier bar = xcd_barrier_post((unsigned*)(c.ws + WS_CTL) + CW_BAR, st);
#define SEAM(k) do { if (IN(k) && IN((k) + 1)) xcd_barrier(bar); } while (0)
#else
#define SEAM(k) do { } while (0)
#endif
    if (IN(0)) { phase_prep(c); phase_s5_build(c); } SEAM(0);
    if (IN(1)) { phase_norm1(c); } SEAM(1);
    if (IN(2)) { pg8::Gemm g{(const pg8::bf16_t*)(c.ws + WS_HX), (const pg8::bf16_t*)(c.ws + WS_WIN), 1024, 1024, 1024}; pg8::StaticOrder S; S.init(MT, NPROJ, c.G, c.bid);
        pg8::EpiInProj E{(pg8::bf16_t*)(c.ws + WS_U5), (pg8::bf16_t*)(c.ws + WS_QKVPRE), (pg8::bf16_t*)(c.ws + WS_Z)};
        pg8::gemm_phase<pg8::EpiInProj, pg8::StaticOrder, true, true>(ring, g, S, E); } SEAM(2);
    if (IN(3)) { { pg8::Gemm g{(const pg8::bf16_t*)(c.ws + WS_U5), (const pg8::bf16_t*)(c.ws + WS_PM), 768, 512, 512}; pg8::SchedSS S{c.G, c.bid}; pg8::EpiSS E{(float*)(c.ws + WS_SS)};
          pg8::gemm_phase<pg8::EpiSS, pg8::SchedSS, true, true>(ring, g, S, E); }
        __syncthreads(); phase_conv(c); } SEAM(3);
    if (IN(4)) { for (int t = c.gwv; t < 512; t += c.NGW) s5_state_scan(c, t); __syncthreads(); phase_gdn_prep(c); } SEAM(4);
    if (IN(5)) { pg8::Gemm g{(const pg8::bf16_t*)(c.ws + WS_U5), (const pg8::bf16_t*)(c.ws + WS_BB), 768, 768, 768}; pg8::SchedS5Y S{c.G, c.bid}; pg8::EpiS5Y E{(pg8::bf16_t*)(c.ws + WS_YG)};
        pg8::gemm_phase<pg8::EpiS5Y, pg8::SchedS5Y, true, true>(ring, g, S, E); } SEAM(5);
    if (IN(6)) { if (c.bid < 128) phase_gdn_rec(c);
        else { pg8::Gemm g{(const pg8::bf16_t*)(c.ws + WS_YG), (const pg8::bf16_t*)(c.ws + WS_WGLU), 512, 512, 512}; pg8::StaticOrder S; S.init(ML, 512, c.G - 128, c.bid - 128);
            pg8::EpiGlu E{(const pg8::bf16_t*)(c.ws + WS_YG), (pg8::bf16_t*)(c.ws + WS_CAT)};
            pg8::gemm_phase<pg8::EpiGlu, pg8::StaticOrder, true, true>(ring, g, S, E); } } SEAM(6);
    if (IN(7)) { phase_combine(c); } SEAM(7);
    if (IN(8)) { pg8::Gemm g{(const pg8::bf16_t*)(c.ws + WS_CAT), (const pg8::bf16_t*)(c.ws + WS_WOUT), 1024, 1024, 1024}; pg8::StaticOrder S; S.init(ML, 1024, c.G, c.bid);
        pg8::EpiF32 E{(float*)(c.ws + WS_YRAW), 1024};
        pg8::gemm_phase<pg8::EpiF32, pg8::StaticOrder, true, true>(ring, g, S, E); } SEAM(8);
    if (IN(9)) { phase_rows2(c); phase_fp8_tables(c); } SEAM(9);
    if (IN(10)) { pg8::Gemm g{(const pg8::bf16_t*)(c.ws + WS_HX2), (const pg8::bf16_t*)(c.ws + WS_WQ), 1024, 1024, 1024}; pg8::StaticOrder S; S.init(ML, 2048, c.G, c.bid);
        pg8::EpiBf16<0> E{(pg8::bf16_t*)(c.ws + WS_QP), 2048, nullptr, 0, 0, 1.f};
        pg8::gemm_phase<pg8::EpiBf16<0>, pg8::StaticOrder, true, true>(ring, g, S, E); } SEAM(10);
    if (IN(11)) { phase_topk(c); } SEAM(11);
    if (IN(12)) { phase_exp1(c); } SEAM(12);
    if (IN(13)) { phase_exp1b(c); } SEAM(13);
    if (IN(14)) { phase_exp2(c); } SEAM(14);
    if (IN(15)) { phase_exp3(c); }
#undef IN
#undef SEAM
}

extern "C" void kernel_launch(void* const* d_in, const int* in_sizes, int n_in, void* d_out, int out_size, void* d_ws, size_t ws_size, hipStream_t stream) {
    static int grid = 0;
    if (grid == 0) {
        if (n_in != 29 || out_size != ML * D || ws_size < WS_END) { fprintf(stderr, "kernel_launch: unexpected shapes (n_in %d out %d ws %zu)\n", n_in, out_size, ws_size); grid = -1; return; }
        int dev = 0, cus = 0, per_cu = 0;
        (void)hipGetDevice(&dev); (void)hipDeviceGetAttribute(&cus, hipDeviceAttributeMultiprocessorCount, dev);
        if (hipFuncSetAttribute((const void*)mk_fwd, hipFuncAttributeMaxDynamicSharedMemorySize, LDS_BYTES) != hipSuccess) { fprintf(stderr, "kernel_launch: hipFuncSetAttribute failed\n"); grid = -1; return; }
        (void)hipOccupancyMaxActiveBlocksPerMultiprocessor(&per_cu, (const void*)mk_fwd, NTHREADS, LDS_BYTES);
        (void)hipGetLastError();
        grid = cus;
        fprintf(stderr, "kernel_launch: cus %d per_cu %d grid %d\n", cus, per_cu, grid);
    }
    if (grid < 0) return;
    Args a{};
    for (int i = 0; i < 29; ++i) a.in[i] = (const float*)d_in[i];
    a.out = (float*)d_out; a.ws = (unsigned char*)d_ws;
    (void)hipMemsetAsync((char*)d_ws + WS_CTL, 0, CTL_ZERO_BYTES, stream);
#if MK_ONE_LAUNCH
    a.ph_lo = 0; a.ph_hi = NPHASES;
    void* kargs[] = {&a};
    hipError_t e = hipLaunchCooperativeKernel((const void*)mk_fwd, dim3(grid), dim3(NTHREADS), kargs, LDS_BYTES, stream);
    if (e != hipSuccess) fprintf(stderr, "kernel_launch: cooperative launch failed: %s\n", hipGetErrorString(e));
#else
    for (int ph = 0; ph < NPHASES; ++ph) { a.ph_lo = ph; a.ph_hi = ph + 1; hipLaunchKernelGGL(mk_fwd, dim3(grid), dim3(NTHREADS), LDS_BYTES, stream, a); }
#endif
}
```

```cpp
#include <hip/hip_runtime.h>
#include <hip/hip_cooperative_groups.h>
#include <cstdio>
#include <cstdint>
namespace cg = cooperative_groups;
namespace pg8 {
#define PG8_LAS __attribute__((address_space(3)))
typedef unsigned short bf16_t;
typedef short bf16x8 __attribute__((ext_vector_type(8)));
typedef float f32x4 __attribute__((ext_vector_type(4)));
typedef unsigned u32x4 __attribute__((ext_vector_type(4)));
constexpr int BM = 256, BK = 64, HALF = 128, HTB = HALF * BK * 2  , STAGE_BYTES = 8 * HTB, NXCD = 8, WGM = 8;

__host__ __device__ __forceinline__ int lds_byte(int r, int c) { const int st = (r >> 4) * 2 + (c >> 5), rr = r & 15, cc = c & 31, ob = rr * 64 + cc * 2; return st * 1024 + (ob ^ (((ob >> 9) & 1) << 5)); }
__host__ __device__ __forceinline__ void stage_rc(int b, int& R, int& C) { const int st = b / 1024, sb = b % 1024, swz = sb ^ (((sb >> 9) & 1) << 5); R = (st >> 1) * 16 + swz / 64; C = (st & 1) * 32 + (swz % 64) / 2; }
__host__ __device__ __forceinline__ int perm32(int rho) { const int n = rho >> 4, i = rho & 15; return 8 * (i >> 2) + 4 * n + (i & 3); }

struct Unit { int pm, pn; };
struct Gemm { const bf16_t* A; const bf16_t* Bt; int lda, ldb, K; };

struct StaticOrder {
    int nM, nN, nwg, G, c;
    __host__ __device__ void init(int M, int N, int G_, int c_) { nM = M / BM; nN = N / BM; nwg = nM * nN; G = G_; c = c_; }
    __host__ __device__ bool next(int i, Unit& u) const {
        const long L = (long)i * G + c; if (L >= nwg) return false;
        int wgid = (int)L; { const int q = nwg / NXCD, r = nwg % NXCD, xcd = wgid % NXCD, off = wgid / NXCD; wgid = (xcd < r ? xcd * (q + 1) : r * (q + 1) + (xcd - r) * q) + off; }
        const int nig = WGM * nN, gid = wgid / nig, fm = gid * WGM, gsz = (nM - fm) < WGM ? (nM - fm) : WGM;
        u.pm = fm + ((wgid % nig) % gsz); u.pn = (wgid % nig) / gsz; return true;
    }
    __device__ __forceinline__ void a_ready(const Unit&) const {}
    __device__ __forceinline__ void done(const Unit&) const {}
};

__device__ __forceinline__ unsigned cvt_pk_bf16(float lo, float hi) { unsigned r; asm volatile("v_cvt_pk_bf16_f32 %0, %1, %2" : "=v"(r) : "v"(lo), "v"(hi)); return r; }
typedef float f32x2 __attribute__((ext_vector_type(2)));
__device__ __forceinline__ f32x2 gelu_pk(f32x2 v) {
    const f32x2 av = __builtin_elementwise_abs(v), d = av * 0.2316418882f + 1.0f;
    f32x2 t; t.x = __builtin_amdgcn_rcpf(d.x); t.y = __builtin_amdgcn_rcpf(d.y);
    f32x2 q = t * 0.5307027145f + (-0.7265760135f); q = q * t + 0.7107068705f; q = q * t + (-0.142248368f); q = q * t + 0.127414796f; q = q * t;
    const f32x2 s = (v * v) * (-0.72134752044f);
    f32x2 e; e.x = __builtin_amdgcn_exp2f(s.x); e.y = __builtin_amdgcn_exp2f(s.y);
    const f32x2 m = v * (q * e), r = v - m;
    f32x2 o; o.x = v.x < 0.f ? m.x : r.x; o.y = v.y < 0.f ? m.y : r.y; return o;
}

template <int ACT  > struct EpiBf16 {
    static constexpr bool PERM = true, AFTER_DRAIN = false; static_assert(ACT == 0 || ACT == 1, "EpiBf16: ACT is 0 (none) or 1 (gelu_pk)");
    bf16_t* O; int ldc; const float* bias; int split_cols; size_t split_stride; float scale0;
    __device__ __forceinline__ void operator()(const f32x4 (&acc)[2][2][4][2], const Unit& u, int wr, int wc, int fr, int fq) const {
        const int row0 = u.pm * BM + wr * 64 + fr; int colt = u.pn * BM; bf16_t* base = O;
        float sc = 1.f; if (split_cols) { const int t = colt / split_cols; base += (size_t)t * split_stride; colt -= t * split_cols; if (t == 0) sc = scale0; }
        const int col0 = colt + wc * 32 + 8 * fq, bcol0 = u.pn * BM + wc * 32 + 8 * fq;
        f32x4 bv[2][2];
#pragma unroll
        for (int bj = 0; bj < 2; ++bj)
#pragma unroll
            for (int n = 0; n < 2; ++n) bv[bj][n] = bias ? *(const f32x4*)(bias + bcol0 + bj * HALF + 4 * n) : (f32x4){0.f, 0.f, 0.f, 0.f};
#pragma unroll
        for (int ai = 0; ai < 2; ++ai)
#pragma unroll
            for (int m = 0; m < 4; ++m) { bf16_t* rowp = base + (size_t)(row0 + ai * HALF + m * 16) * ldc + col0;
#pragma unroll
                for (int bj = 0; bj < 2; ++bj) { f32x4 v0 = acc[ai][bj][m][0] + bv[bj][0], v1 = acc[ai][bj][m][1] + bv[bj][1];
                    if (ACT == 1) { f32x2 a = gelu_pk((f32x2){v0[0], v0[1]}), b = gelu_pk((f32x2){v0[2], v0[3]}), c = gelu_pk((f32x2){v1[0], v1[1]}), d = gelu_pk((f32x2){v1[2], v1[3]});
                        v0 = (f32x4){a.x, a.y, b.x, b.y}; v1 = (f32x4){c.x, c.y, d.x, d.y}; }
                    v0 = v0 * sc; v1 = v1 * sc; u32x4 w; w.x = cvt_pk_bf16(v0[0], v0[1]); w.y = cvt_pk_bf16(v0[2], v0[3]); w.z = cvt_pk_bf16(v1[0], v1[1]); w.w = cvt_pk_bf16(v1[2], v1[3]);
                    *(u32x4*)(rowp + bj * HALF) = w; } }
    }
};

template <class Epi, class Sched, bool ALIGN_EPI = false, bool SP2 = false>
__device__ __forceinline__ void gemm_phase(PG8_LAS unsigned char* lds, const Gemm g, const Sched& S, const Epi& E) {
    const int tid = threadIdx.x, wid = __builtin_amdgcn_readfirstlane(tid >> 6), lane = tid & 63, wr = wid >> 2, wc = wid & 3, fr = lane & 15, fq = lane >> 4;
    const int K = g.K, nt = K / BK;
    unsigned voffA[2], voffB[2];
#pragma unroll
    for (int i = 0; i < 2; ++i) { int R, C; stage_rc(tid * 16 + i * 8192, R, C); const int Rb = Epi::PERM ? ((R & ~31) + perm32(R & 31)) : R;
        voffA[i] = (unsigned)(R * g.lda + C) * 2u; voffB[i] = (unsigned)(Rb * g.ldb + C) * 2u; }
    const size_t kstep = (size_t)(BK * 2);
    const size_t hstepA = (size_t)HALF * g.lda * 2, hstepB = (size_t)HALF * g.ldb * 2;
    const size_t tstepA = 2 * hstepA, tstepB = 2 * hstepB;
    const unsigned ldsw = (unsigned)wid * 1024u;
    const int aoff = lds_byte(wr * 64 + fr, fq * 8), boff = lds_byte(wc * 32 + fr, fq * 8);
#define PG8_SA(b, h) (((b) * 2 + (h)) * HTB)
#define PG8_SB(b, h) ((4 + (b) * 2 + (h)) * HTB)
#define PG8_STAGE(bufoff, gbase, voff) do { _Pragma("unroll") for (int _i = 0; _i < 2; ++_i) \
        __builtin_amdgcn_global_load_lds((const unsigned*)((const char*)(gbase) + (voff)[_i]), (PG8_LAS unsigned*)(lds + (bufoff) + ldsw + _i * 8192), 16, 0, 0); } while (0)
#define PG8_LDA(dst, b, h) do { _Pragma("unroll") for (int m = 0; m < 4; ++m) _Pragma("unroll") for (int k = 0; k < 2; ++k) dst[m][k] = *(const PG8_LAS bf16x8*)(lds + PG8_SA(b, h) + aoff + m * 2048 + k * 1024); } while (0)
#define PG8_LDB(dst, b, h) do { _Pragma("unroll") for (int n = 0; n < 2; ++n) _Pragma("unroll") for (int k = 0; k < 2; ++k) dst[n][k] = *(const PG8_LAS bf16x8*)(lds + PG8_SB(b, h) + boff + n * 2048 + k * 1024); } while (0)
#define PG8_MMA(ai, bj, At, Bt) do { __builtin_amdgcn_s_setprio(1); _Pragma("unroll") for (int m = 0; m < 4; ++m) _Pragma("unroll") for (int n = 0; n < 2; ++n) _Pragma("unroll") for (int k = 0; k < 2; ++k) \
        acc[ai][bj][m][n] = __builtin_amdgcn_mfma_f32_16x16x32_bf16(Bt[n][k], At[m][k], acc[ai][bj][m][n], 0, 0, 0); __builtin_amdgcn_s_setprio(0); } while (0)
#define PG8_WAIT_V(n) asm volatile("s_waitcnt vmcnt(" #n ")" ::: "memory")
#define PG8_WAIT_L(n) asm volatile("s_waitcnt lgkmcnt(" #n ")" ::: "memory")
#define PG8_BAR __builtin_amdgcn_s_barrier()
#define PG8_SCHED __builtin_amdgcn_sched_barrier(0)
    Unit cur, nxt; int ui = 0;
    if (!S.next(0, cur)) return;
    f32x4 acc[2][2][4][2];
#pragma unroll
    for (int a = 0; a < 2; ++a)
#pragma unroll
        for (int b = 0; b < 2; ++b)
#pragma unroll
            for (int m = 0; m < 4; ++m)
#pragma unroll
                for (int n = 0; n < 2; ++n) acc[a][b][m][n] = (f32x4){0.f, 0.f, 0.f, 0.f};
    bf16x8 At[4][2], B0[2][2], B1[2][2];
    const char* cA = (const char*)g.A + (size_t)cur.pm * tstepA; const char* cB = (const char*)g.Bt + (size_t)cur.pn * tstepB;
    S.a_ready(cur);
    if constexpr (SP2) {
        PG8_STAGE(PG8_SB(0, 0), cB, voffB); PG8_STAGE(PG8_SB(0, 1), cB + hstepB, voffB); PG8_STAGE(PG8_SA(0, 0), cA, voffA); PG8_STAGE(PG8_SA(0, 1), cA + hstepA, voffA);
        if (wr == 1) PG8_BAR;
        PG8_WAIT_V(2); PG8_BAR;
        PG8_STAGE(PG8_SB(1, 0), cB + kstep, voffB); PG8_STAGE(PG8_SA(1, 0), cA + kstep, voffA); PG8_STAGE(PG8_SB(1, 1), cB + hstepB + kstep, voffB);
        PG8_WAIT_V(6); PG8_BAR;
    } else {
        PG8_STAGE(PG8_SB(0, 0), cB, voffB); PG8_STAGE(PG8_SA(0, 0), cA, voffA); PG8_STAGE(PG8_SB(0, 1), cB + hstepB, voffB); PG8_STAGE(PG8_SA(0, 1), cA + hstepA, voffA);
        if (wr == 1) PG8_BAR;
        PG8_WAIT_V(4); PG8_BAR;
        PG8_STAGE(PG8_SB(1, 0), cB + kstep, voffB); PG8_STAGE(PG8_SA(1, 0), cA + kstep, voffA); PG8_STAGE(PG8_SB(1, 1), cB + hstepB + kstep, voffB);
        PG8_WAIT_V(6); PG8_BAR;
    }
    for (;;) {
        const bool has_next = S.next(ui + 1, nxt);
        const char* nA = has_next ? (const char*)g.A + (size_t)nxt.pm * tstepA : cA; const char* nB = has_next ? (const char*)g.Bt + (size_t)nxt.pn * tstepB : cB;
        for (int t = 0; t < nt; t += 2) {
            const bool last = (t == nt - 2);
            const char* a1 = cA + (size_t)(t + 1) * kstep;
            const char* a2 = last ? nA : cA + (size_t)(t + 2) * kstep; const char* b2 = last ? nB : cB + (size_t)(t + 2) * kstep;
            const char* a3 = a2 + kstep; const char* b3 = b2 + kstep;
            if (last && has_next) S.a_ready(nxt);
            if constexpr (SP2) {
            PG8_LDB(B0, 0, 0); PG8_LDB(B1, 0, 1); PG8_SCHED; PG8_LDA(At, 0, 0); PG8_STAGE(PG8_SA(1, 1), a1 + hstepA, voffA);
            PG8_WAIT_V(8); PG8_WAIT_L(0); PG8_BAR; PG8_MMA(0, 0, At, B0); PG8_MMA(0, 1, At, B1); PG8_BAR; PG8_SCHED;
            PG8_LDA(At, 0, 1); PG8_STAGE(PG8_SB(0, 0), b2, voffB); PG8_STAGE(PG8_SB(0, 1), b2 + hstepB, voffB); PG8_STAGE(PG8_SA(0, 0), a2, voffA);
            PG8_WAIT_V(8); PG8_WAIT_L(0); PG8_BAR; PG8_MMA(1, 0, At, B0); PG8_MMA(1, 1, At, B1); PG8_BAR; PG8_SCHED;
            PG8_LDB(B0, 1, 0); PG8_LDB(B1, 1, 1); PG8_SCHED; PG8_LDA(At, 1, 0); PG8_STAGE(PG8_SA(0, 1), a2 + hstepA, voffA);
            PG8_WAIT_V(8); PG8_WAIT_L(0); PG8_BAR; PG8_MMA(0, 0, At, B0); PG8_MMA(0, 1, At, B1); PG8_BAR; PG8_SCHED;
            PG8_LDA(At, 1, 1); PG8_STAGE(PG8_SB(1, 0), b3, voffB); PG8_STAGE(PG8_SB(1, 1), b3 + hstepB, voffB); PG8_STAGE(PG8_SA(1, 0), a3, voffA);
            PG8_WAIT_V(8); PG8_WAIT_L(0); PG8_BAR; PG8_MMA(1, 0, At, B0); PG8_MMA(1, 1, At, B1); PG8_BAR; PG8_SCHED;
            } else {
            PG8_LDB(B0, 0, 0); PG8_SCHED; PG8_LDA(At, 0, 0); PG8_STAGE(PG8_SA(1, 1), a1 + hstepA, voffA);
            PG8_WAIT_L(8); PG8_BAR; PG8_WAIT_L(0); PG8_MMA(0, 0, At, B0); PG8_BAR; PG8_SCHED;
            PG8_LDB(B1, 0, 1); PG8_STAGE(PG8_SB(0, 0), b2, voffB);
            PG8_BAR; PG8_WAIT_L(0); PG8_MMA(0, 1, At, B1); PG8_BAR;
            PG8_LDA(At, 0, 1); PG8_STAGE(PG8_SA(0, 0), a2, voffA);
            PG8_BAR; PG8_WAIT_L(0); PG8_MMA(1, 0, At, B0); PG8_BAR; PG8_SCHED;
            PG8_STAGE(PG8_SB(0, 1), b2 + hstepB, voffB);
            PG8_WAIT_V(6); PG8_BAR; PG8_MMA(1, 1, At, B1); PG8_BAR;
            PG8_LDB(B0, 1, 0); PG8_SCHED; PG8_LDA(At, 1, 0); PG8_STAGE(PG8_SA(0, 1), a2 + hstepA, voffA);
            PG8_WAIT_L(8); PG8_BAR; PG8_WAIT_L(0); PG8_MMA(0, 0, At, B0); PG8_BAR; PG8_SCHED;
            PG8_LDB(B1, 1, 1); PG8_STAGE(PG8_SB(1, 0), b3, voffB);
            PG8_BAR; PG8_WAIT_L(0); PG8_MMA(0, 1, At, B1); PG8_BAR;
            PG8_LDA(At, 1, 1); PG8_STAGE(PG8_SA(1, 0), a3, voffA);
            PG8_BAR; PG8_WAIT_L(0); PG8_MMA(1, 0, At, B0); PG8_BAR; PG8_SCHED;
            PG8_STAGE(PG8_SB(1, 1), b3 + hstepB, voffB);
            PG8_WAIT_V(6); PG8_BAR; PG8_MMA(1, 1, At, B1); PG8_BAR;
            }
        }
        if constexpr (ALIGN_EPI) { if (wr == 0) PG8_BAR; }
        if constexpr (!Epi::AFTER_DRAIN) { E(acc, cur, wr, wc, fr, fq); S.done(cur); }
        if (!has_next) break;
#pragma unroll
        for (int a = 0; a < 2; ++a)
#pragma unroll
            for (int b = 0; b < 2; ++b)
#pragma unroll
                for (int m = 0; m < 4; ++m)
#pragma unroll
                    for (int n = 0; n < 2; ++n) acc[a][b][m][n] = (f32x4){0.f, 0.f, 0.f, 0.f};
        cur = nxt; cA = nA; cB = nB; ++ui;
        if constexpr (ALIGN_EPI) { if (wr == 1) PG8_BAR; }
    }
    PG8_WAIT_V(0);
    if constexpr (!ALIGN_EPI) { if (wr == 0) PG8_BAR; }
    PG8_BAR;
    if constexpr (Epi::AFTER_DRAIN) { E.fused(acc, cur, wr, wc, fr, fq, lds, wid, lane); S.done(cur); }
#undef PG8_SA
#undef PG8_SB
#undef PG8_STAGE
#undef PG8_LDA
#undef PG8_LDB
#undef PG8_MMA
#undef PG8_WAIT_V
#undef PG8_WAIT_L
#undef PG8_BAR
#undef PG8_SCHED
}
}

#ifndef MK_EXP_OLD
#define MK_EXP_OLD 0
#endif
#ifndef MK_ONE_LAUNCH
#define MK_ONE_LAUNCH 1
#endif
#define LAS __attribute__((address_space(3)))
typedef unsigned short bf16;
typedef unsigned v4u __attribute__((ext_vector_type(4)));
typedef unsigned v2u __attribute__((ext_vector_type(2)));
typedef float f32x4 __attribute__((ext_vector_type(4)));
typedef float f32x2 __attribute__((ext_vector_type(2)));
typedef short bf16x8 __attribute__((ext_vector_type(8)));
typedef float f32x16 __attribute__((ext_vector_type(16)));
#define MFMA32(a, b, c) __builtin_amdgcn_mfma_f32_32x32x16_bf16((a), (b), (c), 0, 0, 0)

constexpr int D = 1024, NB = 8, SEQ = 2048, LC = 256, ML = NB * SEQ  , MC = NB * LC  , MT = ML + MC  ;
constexpr int PROJ = 2576, NPROJ = 2560;
constexpr int NEXP = 16384, TOPK = 16, KK = 128;
constexpr float EPS = 1e-6f;
constexpr int NTHREADS = 512, NWAVES = 8;
constexpr int LDS_BYTES = 147456;
constexpr int NPHASES = 16;

constexpr size_t MiB = 1u << 20;
constexpr size_t WS_CTL = 0;
constexpr size_t CTL_ZERO_BYTES = 65536;
constexpr int CW_BAR = 0;
constexpr int CW_E1 = 4096, CW_E2 = 4096 + 8 * 64;
constexpr size_t WS_MOD = 1 * MiB;
constexpr size_t WS_LP = 1 * MiB + 512 * 1024;
constexpr size_t WS_WIN = 2 * MiB;
constexpr size_t WS_WOUT = 8 * MiB;
constexpr size_t WS_WGLU = 10 * MiB;
constexpr size_t WS_WQ = 11 * MiB;
constexpr size_t WS_GB = 15 * MiB;
constexpr size_t WS_BB = 17 * MiB;
constexpr size_t WS_PM = 41 * MiB;
constexpr size_t WS_OG = 17 * MiB;
constexpr size_t WS_HX2 = 17 * MiB;
constexpr size_t WS_U5 = 49 * MiB;
constexpr size_t WS_CAT = 49 * MiB;
constexpr size_t WS_IDX = 49 * MiB;
constexpr size_t WS_GATE = 57 * MiB;
constexpr size_t WS_ACT = 65 * MiB;
constexpr size_t WS_SSQP = 73 * MiB;
constexpr size_t WS_Z = 85 * MiB;
constexpr size_t WS_YRAW = 85 * MiB;
constexpr size_t WS_QP = 85 * MiB;
constexpr size_t WS_Y = 85 * MiB;
constexpr size_t WS_HX = 101 * MiB;
constexpr size_t WS_SS = 101 * MiB;
constexpr size_t WS_YG = 101 * MiB;
constexpr size_t WS_FRT = 125 * MiB;
constexpr size_t WS_QKVPRE = 137 * MiB;
constexpr size_t WS_FRA = 143 * MiB;
constexpr size_t WS_FRK = 161 * MiB;
constexpr size_t WS_FRTAB = 197 * MiB;
constexpr size_t WS_QKV = 202 * MiB;
constexpr size_t WS_U8 = 202 * MiB;
constexpr size_t WS_V8 = 218 * MiB;
constexpr size_t WS_USC = 234 * MiB;
constexpr size_t WS_VSC = 234 * MiB + 512 * 1024;
constexpr size_t WS_HQ8 = 150 * MiB;
constexpr size_t WS_HS = 183 * MiB;
constexpr size_t WS_PACT = 85 * MiB;
constexpr size_t WS_END = 256 * MiB;
static_assert(WS_BB + (size_t)32 * 512 * 768 * 2 <= WS_PM && WS_PM + (size_t)32 * 256 * 512 * 2 <= WS_U5 && WS_U5 + (size_t)32 * 768 * 768 * 2 <= WS_Z && WS_Z + (size_t)ML * 512 * 2 <= WS_HX, "ws map a");
static_assert(WS_HX + (size_t)MT * D * 2 <= WS_QKVPRE && WS_SS + (size_t)32 * 768 * 256 * 4 <= WS_FRT && WS_QKVPRE + (size_t)MT * 1536 * 2 <= WS_QKV && WS_QKV + (size_t)MT * 1536 * 2 <= WS_END, "ws map b");
static_assert(WS_FRT + (size_t)2304 * 8192 <= WS_FRA && WS_FRA + (size_t)2304 * 8192 <= WS_FRK && WS_FRK + (size_t)2304 * 16384 <= WS_FRTAB && WS_FRTAB + (size_t)2304 * 1024 <= WS_QKV, "ws map c");
static_assert(WS_OG + (size_t)2 * ML * 512 * 2 <= WS_CAT && WS_CAT + (size_t)ML * D * 2 <= WS_Z && WS_YRAW + (size_t)ML * D * 4 <= WS_U8 && WS_SSQP + (size_t)8 * ML * 4 <= WS_Z && WS_YG + (size_t)ML * 512 * 2 <= WS_FRT, "ws map d");

__device__ __forceinline__ unsigned f2bf(float f) { unsigned u = __builtin_bit_cast(unsigned, f); return (u + 0x7fffu + ((u >> 16) & 1u)) >> 16; }
typedef __bf16 bf16x2_t __attribute__((ext_vector_type(2)));
__device__ __forceinline__ unsigned pk2(float lo, float hi) { const f32x2 v = {lo, hi}; return __builtin_bit_cast(unsigned, __builtin_convertvector(v, bf16x2_t)); }
__device__ __forceinline__ float bflo(unsigned w) { return __builtin_bit_cast(float, w << 16); }
__device__ __forceinline__ float bfhi(unsigned w) { return __builtin_bit_cast(float, w & 0xffff0000u); }
__device__ __forceinline__ float bf1(bf16 h) { return __builtin_bit_cast(float, (unsigned)h << 16); }
__device__ __forceinline__ float wave_sum(float v) {
#pragma unroll
    for (int o = 1; o < 64; o <<= 1) v += __shfl_xor(v, o);
    return v;
}
__device__ __forceinline__ float wave_max(float v) {
#pragma unroll
    for (int o = 1; o < 64; o <<= 1) v = fmaxf(v, __shfl_xor(v, o));
    return v;
}
__device__ __forceinline__ float sigmoidf_(float x) { return 1.f / (1.f + __expf(-x)); }
__device__ __forceinline__ float siluf_(float x) { return x / (1.f + __expf(-x)); }
__device__ __forceinline__ float gelu_erf(float x) { return 0.5f * x * (1.f + erff(x * 0.70710678118654752f)); }
__device__ __forceinline__ void sincos_d(double a, float& s, float& c) {
    const double k = rint(a * 0.63661977236758134308);
    const double r = fma(-k, 1.57079632679489661923, a) - k * 6.123233995736766e-17;
    const double r2 = r * r;
    double sp = -2.5052108385441720e-08; sp = sp * r2 + 2.7557319223985893e-06; sp = sp * r2 - 1.9841269841269841e-04; sp = sp * r2 + 8.3333333333333332e-03; sp = sp * r2 - 1.6666666666666666e-01;
    const double sn = r + r * r2 * sp;
    double cp = 2.0876756987868099e-09; cp = cp * r2 - 2.7557319223985888e-07; cp = cp * r2 + 2.4801587301587302e-05; cp = cp * r2 - 1.3888888888888889e-03; cp = cp * r2 + 4.1666666666666664e-02; cp = cp * r2 - 0.5;
    const double cs = 1.0 + r2 * cp;
    const int q = ((int)k) & 3;
    const double ss = (q == 0) ? sn : (q == 1) ? cs : (q == 2) ? -sn : -cs;
    const double cc = (q == 0) ? cs : (q == 1) ? -sn : (q == 2) ? -cs : sn;
    s = (float)ss; c = (float)cc;
}

struct Args { const float* in[29]; float* out; unsigned char* ws; int ph_lo, ph_hi; };
static_assert(sizeof(Args) == 29 * 8 + 8 + 8 + 8, "Args has no padding");
enum { I_X = 0, I_C, I_CTX, I_CCTX, I_WMOD, I_BMOD, I_GPREMIX, I_GPOSTMIX, I_GPREFFN, I_GPOSTFFN, I_WIN, I_WOUT, I_LAMRE, I_LAMIM, I_LOGDT, I_BRE, I_BIM, I_CRE, I_CIM, I_S5D, I_WGLU,
       I_CONV, I_ALOG, I_DTBIAS, I_GDNNORM, I_WQ, I_KEYS, I_PU, I_PV };

__device__ __forceinline__ const float* in_row(const Args& a, int row) { return row < ML ? a.in[I_X] + (size_t)row * D : a.in[I_CTX] + (size_t)(row - ML) * D; }
__device__ __forceinline__ int mod_row(int row) { return row < ML ? (row >> 11) : 8; }

template <int CTRL> __device__ __forceinline__ float dppf(float v) { return __builtin_bit_cast(float, __builtin_amdgcn_update_dpp(0, __builtin_bit_cast(int, v), CTRL, 0xf, 0xf, true)); }
__device__ __forceinline__ float row_sum16(float v) { v += dppf<0xB1>(v); v += dppf<0x4E>(v); v += dppf<0x141>(v); v += dppf<0x140>(v); return v; }
__device__ __forceinline__ float row_max16(float v) { v = fmaxf(v, dppf<0xB1>(v)); v = fmaxf(v, dppf<0x4E>(v)); v = fmaxf(v, dppf<0x141>(v)); v = fmaxf(v, dppf<0x140>(v)); return v; }
__device__ __forceinline__ float wsum(float v) { v = row_sum16(v); return
    __builtin_bit_cast(float, __builtin_amdgcn_readlane(__builtin_bit_cast(int, v), 0)) + __builtin_bit_cast(float, __builtin_amdgcn_readlane(__builtin_bit_cast(int, v), 16)) +
    __builtin_bit_cast(float, __builtin_amdgcn_readlane(__builtin_bit_cast(int, v), 32)) + __builtin_bit_cast(float, __builtin_amdgcn_readlane(__builtin_bit_cast(int, v), 48)); }
__device__ __forceinline__ float wmax(float v) { v = row_max16(v); return fmaxf(fmaxf(__builtin_bit_cast(float, __builtin_amdgcn_readlane(__builtin_bit_cast(int, v), 0)), __builtin_bit_cast(float, __builtin_amdgcn_readlane(__builtin_bit_cast(int, v), 16))),
    fmaxf(__builtin_bit_cast(float, __builtin_amdgcn_readlane(__builtin_bit_cast(int, v), 32)), __builtin_bit_cast(float, __builtin_amdgcn_readlane(__builtin_bit_cast(int, v), 48)))); }
__device__ __forceinline__ int lane_rank(unsigned long long m) { return __builtin_amdgcn_mbcnt_hi((unsigned)(m >> 32), __builtin_amdgcn_mbcnt_lo((unsigned)m, 0)); }
__device__ __forceinline__ unsigned fkey(float f) { const unsigned u = __builtin_bit_cast(unsigned, f); return u ^ ((unsigned)((int)u >> 31) | 0x80000000u); }
#define WAVE_LDS_SYNC() do { __builtin_amdgcn_fence(__ATOMIC_RELEASE, "wavefront"); __builtin_amdgcn_wave_barrier(); __builtin_amdgcn_fence(__ATOMIC_ACQUIRE, "wavefront"); } while (0)
template <int N> __device__ __forceinline__ unsigned kth_key(const unsigned (&k)[N], int K) {
    unsigned T = 0;
    for (int bit = 31; bit >= 0; --bit) { const unsigned cand = T | (1u << bit); int cnt = 0;
#pragma unroll
        for (int n = 0; n < N; ++n) cnt += __popcll(__ballot(k[n] >= cand));
        if (cnt >= K) T = cand;
        if (cnt == K) break; }
    return T;
}

namespace pg8 {
struct EpiInProj {
    static constexpr bool PERM = true, AFTER_DRAIN = false;
    bf16_t* U; bf16_t* QKV; bf16_t* Z;
    __device__ __forceinline__ void operator()(const f32x4 (&acc)[2][2][4][2], const Unit& u, int wr, int wc, int fr, int fq) const {
        bf16_t* base; int ld, colt; bool lat_only = false;
        const bool s5 = u.pn < 2;
        if (s5) { base = U; ld = 0; colt = u.pn * BM; }
        else if (u.pn < 8) { base = QKV; ld = 1536; colt = (u.pn - 2) * BM; }
        else { base = Z; ld = 512; colt = (u.pn - 8) * BM; lat_only = true; }
        const int row0 = u.pm * BM + wr * 64 + fr, col0 = colt + wc * 32 + 8 * fq;
#pragma unroll
        for (int ai = 0; ai < 2; ++ai)
#pragma unroll
            for (int m = 0; m < 4; ++m) { const int row = row0 + ai * HALF + m * 16; bf16_t* rowp = base + (size_t)row * ld + col0;
                if (lat_only && row >= 16384) continue;
                if (s5) { const int R = row < 16384 ? (row >> 5) : 512 + ((row - 16384) >> 5), ii = row & 31; rowp = base + (size_t)R * 768 + ii * 16 + (col0 & 15); }
#pragma unroll
                for (int bj = 0; bj < 2; ++bj) { const f32x4 v0 = acc[ai][bj][m][0], v1 = acc[ai][bj][m][1];
                    u32x4 w; w.x = cvt_pk_bf16(v0[0], v0[1]); w.y = cvt_pk_bf16(v0[2], v0[3]); w.z = cvt_pk_bf16(v1[0], v1[1]); w.w = cvt_pk_bf16(v1[2], v1[3]);
                    if (s5) *(u32x4*)(rowp + (size_t)((col0 + bj * HALF) >> 4) * (768 * 768)) = w; else *(u32x4*)(rowp + bj * HALF) = w; } }
    }
};
struct EpiGlu {
    static constexpr bool PERM = true, AFTER_DRAIN = false;
    const bf16_t* YG; bf16_t* CAT;
    __device__ __forceinline__ void operator()(const f32x4 (&acc)[2][2][4][2], const Unit& u, int wr, int wc, int fr, int fq) const {
        const int row0 = u.pm * BM + wr * 64 + fr, col0 = u.pn * BM + wc * 32 + 8 * fq;
#pragma unroll
        for (int ai = 0; ai < 2; ++ai)
#pragma unroll
            for (int m = 0; m < 4; ++m) { const int row = row0 + ai * HALF + m * 16;
#pragma unroll
                for (int bj = 0; bj < 2; ++bj) { const f32x4 v0 = acc[ai][bj][m][0], v1 = acc[ai][bj][m][1];
                    const u32x4 y = *(const u32x4*)(YG + (size_t)row * 512 + col0 + bj * HALF);
                    float o[8]; const float a[8] = {v0[0], v0[1], v0[2], v0[3], v1[0], v1[1], v1[2], v1[3]};
                    const unsigned yw[4] = {y.x, y.y, y.z, y.w};
#pragma unroll
                    for (int e = 0; e < 8; ++e) { const float yv = __builtin_bit_cast(float, (e & 1) ? (yw[e >> 1] & 0xffff0000u) : (yw[e >> 1] << 16)); o[e] = yv / (1.f + __expf(-a[e])); }
                    u32x4 w; w.x = cvt_pk_bf16(o[0], o[1]); w.y = cvt_pk_bf16(o[2], o[3]); w.z = cvt_pk_bf16(o[4], o[5]); w.w = cvt_pk_bf16(o[6], o[7]);
                    *(u32x4*)(CAT + (size_t)row * 1024 + col0 + bj * HALF) = w; } }
    }
};
struct EpiF32 {
    static constexpr bool PERM = false, AFTER_DRAIN = false;
    float* C; int ldc;
    __device__ __forceinline__ void operator()(const f32x4 (&acc)[2][2][4][2], const Unit& u, int wr, int wc, int fr, int fq) const {
        const int row0 = u.pm * BM + wr * 64 + fr, col0 = u.pn * BM + wc * 32 + 4 * fq;
#pragma unroll
        for (int ai = 0; ai < 2; ++ai)
#pragma unroll
            for (int m = 0; m < 4; ++m) { float* rowp = C + (size_t)(row0 + ai * HALF + m * 16) * ldc + col0;
#pragma unroll
                for (int bj = 0; bj < 2; ++bj)
#pragma unroll
                    for (int n = 0; n < 2; ++n) *(f32x4*)(rowp + bj * HALF + n * 16) = acc[ai][bj][m][n]; }
    }
};
struct EpiSS {
    static constexpr bool PERM = false, AFTER_DRAIN = false;
    float* C;
    __device__ __forceinline__ void operator()(const f32x4 (&acc)[2][2][4][2], const Unit& u, int wr, int wc, int fr, int fq) const {
        const int row0 = u.pm * BM + wr * 64 + fr, col0 = wc * 32 + 4 * fq;
#pragma unroll
        for (int ai = 0; ai < 2; ++ai)
#pragma unroll
            for (int m = 0; m < 4; ++m) { float* rowp = C + (size_t)(row0 + ai * HALF + m * 16) * 256 + col0;
#pragma unroll
                for (int bj = 0; bj < 2; ++bj)
#pragma unroll
                    for (int n = 0; n < 2; ++n) *(f32x4*)(rowp + bj * HALF + n * 16) = acc[ai][bj][m][n]; }
    }
};
struct SchedSS { int G, c; __device__ bool next(int i, Unit& u) const { const int L = i * G + c; if (L >= 96) return false; u.pm = L; u.pn = L / 3; return true; }
    __device__ __forceinline__ void a_ready(const Unit&) const {} __device__ __forceinline__ void done(const Unit&) const {} };
struct EpiS5Y {
    static constexpr bool PERM = true, AFTER_DRAIN = false;
    bf16_t* YG;
    __device__ __forceinline__ void operator()(const f32x4 (&acc)[2][2][4][2], const Unit& u, int wr, int wc, int fr, int fq) const {
        const int g = u.pn >> 1, R0 = (u.pm - 3 * g) * BM + wr * 64 + fr, n0 = (u.pn & 1) * BM + wc * 32 + 8 * fq;
#pragma unroll
        for (int ai = 0; ai < 2; ++ai)
#pragma unroll
            for (int m = 0; m < 4; ++m) { const int R = R0 + ai * HALF + m * 16;
#pragma unroll
                for (int bj = 0; bj < 2; ++bj) { const int n = n0 + bj * HALF; const f32x4 v0 = acc[ai][bj][m][0], v1 = acc[ai][bj][m][1];
                    const f32x2 a = gelu_pk((f32x2){v0[0], v0[1]}), b = gelu_pk((f32x2){v0[2], v0[3]}), c2 = gelu_pk((f32x2){v1[0], v1[1]}), d = gelu_pk((f32x2){v1[2], v1[3]});
                    u32x4 w; w.x = cvt_pk_bf16(a.x, a.y); w.y = cvt_pk_bf16(b.x, b.y); w.z = cvt_pk_bf16(c2.x, c2.y); w.w = cvt_pk_bf16(d.x, d.y);
                    *(u32x4*)(YG + (size_t)(R * 32 + (n >> 4)) * 512 + g * 16 + (n & 15)) = w; } }
    }
};
struct SchedS5Y { int G, c; __device__ bool next(int i, Unit& u) const { const int L = i * G + c; if (L >= 128) return false; const int g = L >> 2; u.pm = 3 * g + ((L >> 1) & 1); u.pn = 2 * g + (L & 1); return true; }
    __device__ __forceinline__ void a_ready(const Unit&) const {} __device__ __forceinline__ void done(const Unit&) const {} };
}

struct Ctx { const Args* a; unsigned char* ws; unsigned char* lds; int tid, lane, wave, bid, G, gw, NGW, gwv; };

__device__ __forceinline__ void p0_transpose_item(const float* W, int ldw, int nblk, int K, bf16* WT, float* scr, int item, int lane) {
    const int kb = item / nblk, nb = item % nblk, k0 = 64 * kb, n0 = 32 * nb;
#pragma unroll 8
    for (int i = 0; i < 32; ++i) { const int kk = 2 * i + (lane >> 5); scr[kk * 33 + (lane & 31)] = W[(size_t)(k0 + kk) * ldw + n0 + (lane & 31)]; }
    __builtin_amdgcn_fence(__ATOMIC_RELEASE, "wavefront"); __builtin_amdgcn_wave_barrier(); __builtin_amdgcn_fence(__ATOMIC_ACQUIRE, "wavefront");
    const int c = lane & 7;
#pragma unroll
    for (int j = 0; j < 4; ++j) { const int n = (lane >> 3) + 8 * j; const float* s = scr + (8 * c) * 33 + n;
        v4u o; o.x = pk2(s[0 * 33], s[1 * 33]); o.y = pk2(s[2 * 33], s[3 * 33]); o.z = pk2(s[4 * 33], s[5 * 33]); o.w = pk2(s[6 * 33], s[7 * 33]);
        *(v4u*)(WT + (size_t)(n0 + n) * K + k0 + 8 * c) = o; }
    __builtin_amdgcn_fence(__ATOMIC_RELEASE, "wavefront"); __builtin_amdgcn_wave_barrier(); __builtin_amdgcn_fence(__ATOMIC_ACQUIRE, "wavefront");
}
__device__ __forceinline__ void phase_prep(const Ctx& c) {
    const Args& a = *c.a;
    float* scr = (float*)(c.lds + c.wave * 16384);
    constexpr int I_IN = 16 * 80, I_OUT = 16 * 32, I_GLU = 8 * 16, I_Q = 16 * 64;
    for (int it = c.gw; it < I_IN + I_OUT + I_GLU + I_Q; it += c.NGW) {
        int r = it;
        if (r < I_IN) { p0_transpose_item(a.in[I_WIN], PROJ, 80, 1024, (bf16*)(c.ws + WS_WIN), scr, r, c.lane); continue; } r -= I_IN;
        if (r < I_OUT) { p0_transpose_item(a.in[I_WOUT], 1024, 32, 1024, (bf16*)(c.ws + WS_WOUT), scr, r, c.lane); continue; } r -= I_OUT;
        if (r < I_GLU) { p0_transpose_item(a.in[I_WGLU], 512, 16, 512, (bf16*)(c.ws + WS_WGLU), scr, r, c.lane); continue; } r -= I_GLU;
        p0_transpose_item(a.in[I_WQ], 2048, 64, 1024, (bf16*)(c.ws + WS_WQ), scr, r, c.lane);
    }
    __syncthreads();
    float* sc = (float*)c.lds;
    float* red = (float*)(c.lds + 9 * 1024 * 4);
    float* MOD = (float*)(c.ws + WS_MOD);
    bool have = false;
    for (int item = c.bid; item < 96; item += c.G) {
        if (!have) { for (int i = c.tid; i < 9 * 1024; i += NTHREADS) { const int r = i >> 10, k = i & 1023; const float v = r < 8 ? a.in[I_C][r * 1024 + k] : a.in[I_CCTX][k]; sc[i] = siluf_(v); } have = true; __syncthreads(); }
        const int n0 = item * 64;
        float acc[9];
#pragma unroll
        for (int r = 0; r < 9; ++r) acc[r] = 0.f;
        const float* wp = a.in[I_WMOD] + (size_t)(c.wave * 128) * 6144 + n0 + c.lane;
#pragma unroll 16
        for (int k = 0; k < 128; ++k) { const float w = wp[(size_t)k * 6144];
#pragma unroll
            for (int r = 0; r < 9; ++r) acc[r] = fmaf(sc[r * 1024 + c.wave * 128 + k], w, acc[r]); }
#pragma unroll
        for (int r = 0; r < 9; ++r) red[(c.wave * 9 + r) * 64 + c.lane] = acc[r];
        __syncthreads();
        for (int i = c.tid; i < 576; i += NTHREADS) { const int r = i >> 6, l = i & 63; float s = a.in[I_BMOD][n0 + l];
#pragma unroll
            for (int w = 0; w < 8; ++w) s += red[(w * 9 + r) * 64 + l];
            MOD[r * 6144 + n0 + l] = s; }
        __syncthreads();
    }
}
__device__ __forceinline__ void s5_build_group(const Ctx& c, int g, int part);
__device__ __forceinline__ void phase_s5_build(const Ctx& c) { for (int it = c.G - 1 - c.bid; it < 128; it += c.G) if (it >= 0) s5_build_group(c, it >> 2, it & 3); }

__device__ __forceinline__ void phase_norm1(const Ctx& c) {
    const Args& a = *c.a;
    float* wabT = (float*)c.lds;
    for (int i = c.tid; i < 1024 * 16; i += NTHREADS) { const int k = i >> 4, j = i & 15; wabT[j * 1028 + k] = a.in[I_WIN][(size_t)k * PROJ + NPROJ + j]; }
    __syncthreads();
    const float* MOD = (const float*)(c.ws + WS_MOD);
    bf16* HX = (bf16*)(c.ws + WS_HX); float* GB = (float*)(c.ws + WS_GB);
    const float* gpre = a.in[I_GPREMIX];
    f32x4 nx[4];
    if (c.gw < MT) { const f32x4* xr = (const f32x4*)in_row(a, c.gw) + c.lane;
#pragma unroll
        for (int j = 0; j < 4; ++j) nx[j] = xr[64 * j]; }
    for (int row = c.gw; row < MT; row += c.NGW) {
        const float* mr = MOD + mod_row(row) * 6144;
        f32x4 v[4]; float ss = 0.f;
#pragma unroll
        for (int j = 0; j < 4; ++j) { v[j] = nx[j]; ss += (v[j].x * v[j].x + v[j].y * v[j].y) + (v[j].z * v[j].z + v[j].w * v[j].w); }
        if (row + c.NGW < MT) { const f32x4* xr = (const f32x4*)in_row(a, row + c.NGW) + c.lane;
#pragma unroll
            for (int j = 0; j < 4; ++j) nx[j] = xr[64 * j]; }
        const float r = rsqrtf(wsum(ss) * (1.f / D) + EPS);
#pragma unroll
        for (int j = 0; j < 4; ++j) { const int col = 4 * c.lane + 256 * j;
            const f32x4 g4 = *(const f32x4*)(gpre + col), sh = *(const f32x4*)(mr + col), scl = *(const f32x4*)(mr + 1024 + col);
            v[j] = (v[j] * r) * g4 * (scl + 1.f) + sh;
            v2u o; o.x = pk2(v[j].x, v[j].y); o.y = pk2(v[j].z, v[j].w);
            *(v2u*)(HX + (size_t)row * D + col) = o; }
        float pj[16];
#pragma unroll
        for (int j = 0; j < 16; ++j) { float s = 0.f;
#pragma unroll
            for (int jj = 0; jj < 4; ++jj) { const f32x4 w = *(const f32x4*)(wabT + j * 1028 + 4 * c.lane + 256 * jj); s += (v[jj].x * w.x + v[jj].y * w.y) + (v[jj].z * w.z + v[jj].w * w.w); }
            pj[j] = s; if ((j & 1) == 1) asm volatile("" ::: "memory"); }
        const bool b5 = c.lane & 32, b4 = c.lane & 16, b3 = c.lane & 8, b2 = c.lane & 4;
        float q8[8], q4[4], q2[2];
#pragma unroll
        for (int i = 0; i < 8; ++i) { const float keep = b5 ? pj[i + 8] : pj[i], send = b5 ? pj[i] : pj[i + 8]; q8[i] = keep + __shfl_xor(send, 32); }
#pragma unroll
        for (int i = 0; i < 4; ++i) { const float keep = b4 ? q8[i + 4] : q8[i], send = b4 ? q8[i] : q8[i + 4]; q4[i] = keep + __shfl_xor(send, 16); }
#pragma unroll
        for (int i = 0; i < 2; ++i) { const float keep = b3 ? q4[i + 2] : q4[i], send = b3 ? q4[i] : q4[i + 2]; q2[i] = keep + dppf<0x140>(send); }
        float mine; { const float keep = b2 ? q2[1] : q2[0], send = b2 ? q2[0] : q2[1]; mine = keep + dppf<0x141>(send); }
        mine += dppf<0xB1>(mine); mine += dppf<0x4E>(mine);
        const int jl = (b5 ? 8 : 0) + (b4 ? 4 : 0) + (b3 ? 2 : 0) + (b2 ? 1 : 0);
        if ((c.lane & 3) == 0) {
            if (jl < 8) { const float t = mine + a.in[I_DTBIAS][jl]; const float sp = t > 20.f ? t : log1pf(expf(t)); GB[(size_t)row * 16 + jl] = -expf(a.in[I_ALOG][jl]) * sp; }
            else GB[(size_t)row * 16 + jl] = 1.f / (1.f + expf(-mine)); }
    }
}

__device__ __forceinline__ void phase_conv(const Ctx& c) {
    const Args& a = *c.a;
    const bf16* PRE = (const bf16*)(c.ws + WS_QKVPRE); bf16* OUT = (bf16*)(c.ws + WS_QKV);
    const float* cw = a.in[I_CONV];
#pragma unroll 1
    for (int pass = 0; pass < 3; ++pass) { const int ch0 = pass * 512 + 8 * c.lane;
        f32x4 wt[9][2];
#pragma unroll
        for (int i = 0; i < 9; ++i) { wt[i][0] = *(const f32x4*)(cw + i * 1536 + ch0); wt[i][1] = *(const f32x4*)(cw + i * 1536 + ch0 + 4); }
#define CONV_LOAD(DST, ROW) do { const int row_ = (ROW); int nb_row[9]; bool ok[9]; \
            if (row_ < ML) { const int t = row_ & 2047, gr = t >> 6, gc = t & 63; \
                _Pragma("unroll") for (int dy = -1; dy <= 1; ++dy) _Pragma("unroll") for (int dx = -1; dx <= 1; ++dx) { const int i = (dy + 1) * 3 + dx + 1; ok[i] = (gr + dy >= 0) && (gr + dy < 32) && (gc + dx >= 0) && (gc + dx < 64); nb_row[i] = row_ + dy * 64 + dx; } } \
            else { const int t = (row_ - ML) & 255; _Pragma("unroll") for (int i = 0; i < 9; ++i) { ok[i] = false; nb_row[i] = row_; } \
                _Pragma("unroll") for (int dx = -1; dx <= 1; ++dx) { ok[4 + dx] = (t + dx >= 0) && (t + dx < 256); nb_row[4 + dx] = row_ + dx; } } \
            _Pragma("unroll") for (int i = 0; i < 9; ++i) DST[i] = ok[i] ? *(const v4u*)(PRE + (size_t)nb_row[i] * 1536 + ch0) : (v4u){0u, 0u, 0u, 0u}; } while (0)
        v4u nin[9];
        if (c.gw < MT) CONV_LOAD(nin, c.gw);
#pragma unroll 1
        for (int row = c.gw; row < MT; row += c.NGW) {
            v4u in[9];
#pragma unroll
            for (int i = 0; i < 9; ++i) in[i] = nin[i];
            if (row + c.NGW < MT) CONV_LOAD(nin, row + c.NGW);
            float o[8];
#pragma unroll
            for (int q = 0; q < 8; ++q) o[q] = 0.f;
#pragma unroll
            for (int i = 0; i < 9; ++i) { const unsigned w[4] = {in[i].x, in[i].y, in[i].z, in[i].w}; const float kk[8] = {wt[i][0].x, wt[i][0].y, wt[i][0].z, wt[i][0].w, wt[i][1].x, wt[i][1].y, wt[i][1].z, wt[i][1].w};
#pragma unroll
                for (int q = 0; q < 4; ++q) { o[2 * q] = fmaf(bflo(w[q]), kk[2 * q], o[2 * q]); o[2 * q + 1] = fmaf(bfhi(w[q]), kk[2 * q + 1], o[2 * q + 1]); } }
            float ssq = 0.f;
#pragma unroll
            for (int q = 0; q < 8; ++q) { o[q] = siluf_(o[q]); ssq = fmaf(o[q], o[q], ssq); }
            if (pass < 2) { const float sc = rsqrtf(row_sum16(ssq) + EPS) * (pass == 0 ? 0.08838834764831845f : 1.f);
#pragma unroll
                for (int q = 0; q < 8; ++q) o[q] *= sc; }
            v4u ov; ov.x = pk2(o[0], o[1]); ov.y = pk2(o[2], o[3]); ov.z = pk2(o[4], o[5]); ov.w = pk2(o[6], o[7]);
            *(v4u*)(OUT + (size_t)row * 1536 + ch0) = ov;
        }
#undef CONV_LOAD
    }
}

__device__ __forceinline__ int scan_row(int b, int dir, int step) {
    if (step < LC) { const int t = dir ? LC - 1 - step : step; return ML + b * LC + t; }
    const int t = step - LC; return b * SEQ + (dir ? SEQ - 1 - t : t);
}
__device__ __forceinline__ void phase_combine(const Ctx& c) {
    const Args& a = *c.a;
    const bf16* OG0 = (const bf16*)(c.ws + WS_OG); const bf16* OG1 = OG0 + (size_t)ML * 512; const bf16* Z = (const bf16*)(c.ws + WS_Z);
    bf16* CAT = (bf16*)(c.ws + WS_CAT);
    for (int row = c.gw; row < ML; row += c.NGW) {
#pragma unroll
        for (int h = 0; h < 4; ++h) { const int ch = h * 128 + 2 * c.lane;
            const unsigned w0 = *(const unsigned*)(OG0 + (size_t)row * 512 + ch), w1 = *(const unsigned*)(OG1 + (size_t)row * 512 + ch), zw = *(const unsigned*)(Z + (size_t)row * 512 + ch);
            const float o0 = bflo(w0) + bflo(w1), o1 = bfhi(w0) + bfhi(w1);
            const float r = rsqrtf(wave_sum(o0 * o0 + o1 * o1) * (1.f / 128.f) + EPS);
            const f32x2 ng = *(const f32x2*)(a.in[I_GDNNORM] + 2 * c.lane);
            *(unsigned*)(CAT + (size_t)row * 1024 + 512 + ch) = pk2(o0 * r * ng.x * siluf_(bflo(zw)), o1 * r * ng.y * siluf_(bfhi(zw))); }
    }
}

__device__ __forceinline__ void phase_rows2(const Ctx& c) {
    const Args& a = *c.a;
    const float* MOD = (const float*)(c.ws + WS_MOD); const bf16* YRAW = (const bf16*)(c.ws + WS_YRAW); bf16* HX2 = (bf16*)(c.ws + WS_HX2);
    v2u ny[4]; f32x4 nxx[4];
    if (c.gw < ML) {
#pragma unroll
        for (int j = 0; j < 4; ++j) { ny[j] = *((const v2u*)(YRAW + (size_t)c.gw * D) + c.lane + 64 * j); nxx[j] = *((const f32x4*)(a.in[I_X] + (size_t)c.gw * D) + c.lane + 64 * j); } }
    for (int row = c.gw; row < ML; row += c.NGW) {
        const float* mr = MOD + (row >> 11) * 6144;
        f32x4 y[4], x[4]; float ss = 0.f;
#pragma unroll
        for (int j = 0; j < 4; ++j) { y[j] = (f32x4){bflo(ny[j].x), bfhi(ny[j].x), bflo(ny[j].y), bfhi(ny[j].y)}; x[j] = nxx[j];
            ss += (y[j].x * y[j].x + y[j].y * y[j].y) + (y[j].z * y[j].z + y[j].w * y[j].w); }
        if (row + c.NGW < ML) { const size_t r2 = (size_t)(row + c.NGW);
#pragma unroll
            for (int j = 0; j < 4; ++j) { ny[j] = *((const v2u*)(YRAW + r2 * D) + c.lane + 64 * j); nxx[j] = *((const f32x4*)(a.in[I_X] + r2 * D) + c.lane + 64 * j); } }
        const float r = rsqrtf(wsum(ss) * (1.f / D) + EPS); float s2 = 0.f;
#pragma unroll
        for (int j = 0; j < 4; ++j) { const int col = 4 * c.lane + 256 * j;
            const f32x4 g4 = *(const f32x4*)(a.in[I_GPOSTMIX] + col), gt = *(const f32x4*)(mr + 2048 + col);
            x[j] = x[j] + gt * ((y[j] * r) * g4);
            *(f32x4*)(a.out + (size_t)row * D + col) = x[j];
            s2 += (x[j].x * x[j].x + x[j].y * x[j].y) + (x[j].z * x[j].z + x[j].w * x[j].w); }
        const float r2 = rsqrtf(wsum(s2) * (1.f / D) + EPS);
#pragma unroll
        for (int j = 0; j < 4; ++j) { const int col = 4 * c.lane + 256 * j;
            const f32x4 g4 = *(const f32x4*)(a.in[I_GPREFFN] + col), sh = *(const f32x4*)(mr + 3072 + col), scl = *(const f32x4*)(mr + 4096 + col);
            const f32x4 hv = (x[j] * r2) * g4 * (scl + 1.f) + sh;
            v2u o; o.x = pk2(hv.x, hv.y); o.y = pk2(hv.z, hv.w);
            *(v2u*)(HX2 + (size_t)row * D + col) = o;
            x[j] = (f32x4){bflo(o.x), bfhi(o.x), bflo(o.y), bfhi(o.y)}; }
        { float mx = 0.f;
#pragma unroll
          for (int j = 0; j < 4; ++j) mx = fmaxf(mx, fmaxf(fmaxf(fabsf(x[j].x), fabsf(x[j].y)), fmaxf(fabsf(x[j].z), fabsf(x[j].w))));
          mx = wmax(mx); const float hs = mx > 0.f ? 256.f / mx : 1.f;
          unsigned char* hq = c.ws + WS_HQ8 + (size_t)row * 2048;
#pragma unroll
          for (int j = 0; j < 4; ++j) { const float a0 = x[j].x * hs, a1 = x[j].y * hs, a2 = x[j].z * hs, a3 = x[j].w * hs;
              int w = __builtin_amdgcn_cvt_pk_fp8_f32(a0, a1, 0, false); w = __builtin_amdgcn_cvt_pk_fp8_f32(a2, a3, w, true);
              const f32x2 b01 = __builtin_amdgcn_cvt_pk_f32_fp8(w, false), b23 = __builtin_amdgcn_cvt_pk_f32_fp8(w, true);
              int w2 = __builtin_amdgcn_cvt_pk_fp8_f32((a0 - b01.x) * 16.f, (a1 - b01.y) * 16.f, 0, false); w2 = __builtin_amdgcn_cvt_pk_fp8_f32((a2 - b23.x) * 16.f, (a3 - b23.y) * 16.f, w2, true);
              *(unsigned*)(hq + 4 * c.lane + 256 * j) = (unsigned)w; *(unsigned*)(hq + 1024 + 4 * c.lane + 256 * j) = (unsigned)w2; }
          if (c.lane == 0) ((float*)(c.ws + WS_HS))[row] = 1.f / hs; }
    }
}


constexpr int KROW = 136;
__device__ __forceinline__ float unfkey(unsigned k) { const unsigned u = (k & 0x80000000u) ? (k ^ 0x80000000u) : ~k; return __builtin_bit_cast(float, u); }
__device__ __forceinline__ void ins16(unsigned (&L)[16], unsigned key) {
#pragma unroll
    for (int q = 0; q < 16; ++q) { const unsigned hi = L[q] > key ? L[q] : key, lo = L[q] > key ? key : L[q]; L[q] = hi; key = lo; }
}
__device__ __forceinline__ void merge16(unsigned (&L)[16]) {
    unsigned R[16];
#pragma unroll
    for (int q = 0; q < 16; ++q) R[q] = (unsigned)__shfl_xor((int)L[15 - q], 32);
#pragma unroll
    for (int q = 0; q < 16; ++q) L[q] = L[q] > R[q] ? L[q] : R[q];
#pragma unroll
    for (int j = 8; j >= 1; j >>= 1)
#pragma unroll
        for (int q = 0; q < 16; ++q) if ((q & j) == 0) { const unsigned hi = L[q] > L[q + j] ? L[q] : L[q + j], lo = L[q] > L[q + j] ? L[q + j] : L[q]; L[q] = hi; L[q + j] = lo; }
}
__device__ __forceinline__ void phase_topk(const Ctx& c) {
    const Args& a = *c.a;
    bf16* kl = (bf16*)c.lds;
    unsigned char* wtab = c.lds + 2 * 128 * KROW * 2 + c.wave * 1088;
    const bf16* QP = (const bf16*)(c.ws + WS_QP); int* IDX = (int*)(c.ws + WS_IDX); float* GATE = (float*)(c.ws + WS_GATE);
    const int r = c.lane & 31, hh = c.lane >> 5;
    { const unsigned char ptab[50] = {0, 1, 2, 3, 4, 5, 6, 7, 8, 9, 10, 11, 12, 13, 14, 15, 16, 17, 18, 19, 20, 21, 22, 23, 32, 33, 34, 35, 36, 48, 49, 50, 51, 64, 65, 66, 80, 81, 96, 97, 112, 113, 128, 144, 160, 176, 192, 208, 224, 240};
      if (c.lane < 50) wtab[1024 + c.lane] = ptab[c.lane < 50 ? c.lane : 0]; }
    for (int item = c.bid; item < 8 * 32; item += c.G) {
        const int h = item & 7, tr = item >> 3;
        __syncthreads();
        for (int i = c.tid; i < 2 * 128 * 64; i += NTHREADS) { const int k2 = i & 63, n = (i >> 6) & 127, p = i >> 13; const f32x2 kv = *(const f32x2*)(a.in[I_KEYS] + ((size_t)((h * 2 + p) * 128 + n)) * 128 + 2 * k2);
            *(unsigned*)(kl + (p * 128 + n) * KROW + 2 * k2) = pk2(kv.x, kv.y); }
        __syncthreads();
        for (int tile = c.wave; tile < 16; tile += NWAVES) {
            const int tok = tr * 512 + tile * 32 + r;
            unsigned LA[16], LB[16];
#pragma unroll
            for (int p = 0; p < 2; ++p) {
                bf16x8 qf[8];
#pragma unroll
                for (int kk = 0; kk < 8; ++kk) qf[kk] = *(const bf16x8*)(QP + (size_t)tok * 2048 + h * 256 + p * 128 + kk * 16 + hh * 8);
                f32x16 acc[4];
#pragma unroll
                for (int nt = 0; nt < 4; ++nt)
#pragma unroll
                    for (int i = 0; i < 16; ++i) acc[nt][i] = 0.f;
#pragma unroll
                for (int kk = 0; kk < 8; ++kk)
#pragma unroll
                    for (int nt = 0; nt < 4; ++nt) acc[nt] = MFMA32(*(const bf16x8*)(kl + (p * 128 + nt * 32 + r) * KROW + kk * 16 + hh * 8), qf[kk], acc[nt]);
                unsigned (&L)[16] = p ? LB : LA;
#pragma unroll
                for (int q = 0; q < 16; ++q) L[q] = 0u;
#pragma unroll
                for (int nt = 0; nt < 4; ++nt)
#pragma unroll
                    for (int i = 0; i < 16; ++i) { const int n = nt * 32 + (i & 3) + 8 * (i >> 2) + 4 * hh; ins16(L, (fkey(acc[nt][i]) & ~127u) | (unsigned)(127 - n)); }
                merge16(L);
            }
            unsigned char* tt = wtab + r * 32;
            if (hh == 0) {
#pragma unroll
                for (int q = 0; q < 16; ++q) tt[q] = (unsigned char)(127u - (LA[q] & 127u)); }
            else {
#pragma unroll
                for (int q = 0; q < 16; ++q) tt[16 + q] = (unsigned char)(127u - (LB[q] & 127u)); }
            float va[16], vb[16];
#pragma unroll
            for (int q = 0; q < 16; ++q) { va[q] = unfkey(LA[q] & ~127u); vb[q] = unfkey(LB[q] & ~127u); }
            unsigned LC[16];
#pragma unroll
            for (int q = 0; q < 16; ++q) LC[q] = 0u;
            { const float s0 = va[0] + vb[0], s1 = va[0] + vb[1]; ins16(LC, (fkey(hh ? s1 : s0) & ~63u) | (unsigned)(63 - (0 + hh))); }
            { const float s0 = va[0] + vb[2], s1 = va[0] + vb[3]; ins16(LC, (fkey(hh ? s1 : s0) & ~63u) | (unsigned)(63 - (2 + hh))); }
            { const float s0 = va[0] + vb[4], s1 = va[0] + vb[5]; ins16(LC, (fkey(hh ? s1 : s0) & ~63u) | (unsigned)(63 - (4 + hh))); }
            { const float s0 = va[0] + vb[6], s1 = va[0] + vb[7]; ins16(LC, (fkey(hh ? s1 : s0) & ~63u) | (unsigned)(63 - (6 + hh))); }
            { const float s0 = va[0] + vb[8], s1 = va[0] + vb[9]; ins16(LC, (fkey(hh ? s1 : s0) & ~63u) | (unsigned)(63 - (8 + hh))); }
            { const float s0 = va[0] + vb[10], s1 = va[0] + vb[11]; ins16(LC, (fkey(hh ? s1 : s0) & ~63u) | (unsigned)(63 - (10 + hh))); }
            { const float s0 = va[0] + vb[12], s1 = va[0] + vb[13]; ins16(LC, (fkey(hh ? s1 : s0) & ~63u) | (unsigned)(63 - (12 + hh))); }
            { const float s0 = va[0] + vb[14], s1 = va[0] + vb[15]; ins16(LC, (fkey(hh ? s1 : s0) & ~63u) | (unsigned)(63 - (14 + hh))); }
            { const float s0 = va[1] + vb[0], s1 = va[1] + vb[1]; ins16(LC, (fkey(hh ? s1 : s0) & ~63u) | (unsigned)(63 - (16 + hh))); }
            { const float s0 = va[1] + vb[2], s1 = va[1] + vb[3]; ins16(LC, (fkey(hh ? s1 : s0) & ~63u) | (unsigned)(63 - (18 + hh))); }
            { const float s0 = va[1] + vb[4], s1 = va[1] + vb[5]; ins16(LC, (fkey(hh ? s1 : s0) & ~63u) | (unsigned)(63 - (20 + hh))); }
            { const float s0 = va[1] + vb[6], s1 = va[1] + vb[7]; ins16(LC, (fkey(hh ? s1 : s0) & ~63u) | (unsigned)(63 - (22 + hh))); }
            { const float s0 = va[2] + vb[0], s1 = va[2] + vb[1]; ins16(LC, (fkey(hh ? s1 : s0) & ~63u) | (unsigned)(63 - (24 + hh))); }
            { const float s0 = va[2] + vb[2], s1 = va[2] + vb[3]; ins16(LC, (fkey(hh ? s1 : s0) & ~63u) | (unsigned)(63 - (26 + hh))); }
            { const float s0 = va[2] + vb[4], s1 = va[3] + vb[0]; ins16(LC, (fkey(hh ? s1 : s0) & ~63u) | (unsigned)(63 - (28 + hh))); }
            { const float s0 = va[3] + vb[1], s1 = va[3] + vb[2]; ins16(LC, (fkey(hh ? s1 : s0) & ~63u) | (unsigned)(63 - (30 + hh))); }
            { const float s0 = va[3] + vb[3], s1 = va[4] + vb[0]; ins16(LC, (fkey(hh ? s1 : s0) & ~63u) | (unsigned)(63 - (32 + hh))); }
            { const float s0 = va[4] + vb[1], s1 = va[4] + vb[2]; ins16(LC, (fkey(hh ? s1 : s0) & ~63u) | (unsigned)(63 - (34 + hh))); }
            { const float s0 = va[5] + vb[0], s1 = va[5] + vb[1]; ins16(LC, (fkey(hh ? s1 : s0) & ~63u) | (unsigned)(63 - (36 + hh))); }
            { const float s0 = va[6] + vb[0], s1 = va[6] + vb[1]; ins16(LC, (fkey(hh ? s1 : s0) & ~63u) | (unsigned)(63 - (38 + hh))); }
            { const float s0 = va[7] + vb[0], s1 = va[7] + vb[1]; ins16(LC, (fkey(hh ? s1 : s0) & ~63u) | (unsigned)(63 - (40 + hh))); }
            { const float s0 = va[8] + vb[0], s1 = va[9] + vb[0]; ins16(LC, (fkey(hh ? s1 : s0) & ~63u) | (unsigned)(63 - (42 + hh))); }
            { const float s0 = va[10] + vb[0], s1 = va[11] + vb[0]; ins16(LC, (fkey(hh ? s1 : s0) & ~63u) | (unsigned)(63 - (44 + hh))); }
            { const float s0 = va[12] + vb[0], s1 = va[13] + vb[0]; ins16(LC, (fkey(hh ? s1 : s0) & ~63u) | (unsigned)(63 - (46 + hh))); }
            { const float s0 = va[14] + vb[0], s1 = va[15] + vb[0]; ins16(LC, (fkey(hh ? s1 : s0) & ~63u) | (unsigned)(63 - (48 + hh))); }
            merge16(LC);
            WAVE_LDS_SYNC();
            float ev[16]; float den = 0.f; const float mx = unfkey(LC[0] & ~63u);
#pragma unroll
            for (int q = 0; q < 16; ++q) { ev[q] = __expf(unfkey(LC[q] & ~63u) - mx); den += ev[q]; }
            const float inv = 1.f / den;
            if (hh == 0) { int ex[16];
#pragma unroll
                for (int q = 0; q < 16; ++q) { const unsigned pc = wtab[1024 + (63u - (LC[q] & 63u))]; ex[q] = (int)tt[pc >> 4] * 128 + (int)tt[16 + (pc & 15u)]; }
#pragma unroll
                for (int q = 0; q < 4; ++q) *(v4u*)(IDX + (size_t)tok * 128 + h * 16 + 4 * q) = (v4u){(unsigned)ex[4 * q], (unsigned)ex[4 * q + 1], (unsigned)ex[4 * q + 2], (unsigned)ex[4 * q + 3]}; }
            else {
#pragma unroll
                for (int q = 0; q < 4; ++q) *(f32x4*)(GATE + (size_t)tok * 128 + h * 16 + 4 * q) = (f32x4){ev[4 * q] * inv, ev[4 * q + 1] * inv, ev[4 * q + 2] * inv, ev[4 * q + 3] * inv}; }
            WAVE_LDS_SYNC();
        }
    }
}

__device__ __forceinline__ void phase_fp8_tables(const Ctx& c) {
    const Args& a = *c.a;
    for (int r = c.gw; r < 2 * NEXP; r += c.NGW) {
        const bool isv = r >= NEXP; const int e = isv ? r - NEXP : r;
        const f32x4* src = (const f32x4*)((isv ? a.in[I_PV] : a.in[I_PU]) + (size_t)e * D) + 4 * c.lane;
        f32x4 v[4]; float m = 0.f;
#pragma unroll
        for (int j = 0; j < 4; ++j) { v[j] = src[j]; m = fmaxf(m, fmaxf(fmaxf(fabsf(v[j].x), fabsf(v[j].y)), fmaxf(fabsf(v[j].z), fabsf(v[j].w)))); }
        m = wmax(m); const float inv = m > 0.f ? 256.f / m : 0.f;
        v4u o; unsigned ow[4];
#pragma unroll
        for (int j = 0; j < 4; ++j) { int w = __builtin_amdgcn_cvt_pk_fp8_f32(v[j].x * inv, v[j].y * inv, 0, false); w = __builtin_amdgcn_cvt_pk_fp8_f32(v[j].z * inv, v[j].w * inv, w, true); ow[j] = (unsigned)w; }
        o.x = ow[0]; o.y = ow[1]; o.z = ow[2]; o.w = ow[3];
        *(v4u*)(c.ws + (isv ? WS_V8 : WS_U8) + (size_t)e * D + 16 * c.lane) = o;
        if (c.lane == 0) ((float*)(c.ws + (isv ? WS_VSC : WS_USC)))[e] = m * (1.f / 256.f);
    }
}
__device__ __forceinline__ void fp8x16_to_f32(const v4u& r, float (&f)[16]) {
    const unsigned w[4] = {r.x, r.y, r.z, r.w};
#pragma unroll
    for (int j = 0; j < 4; ++j) { const f32x2 lo = __builtin_amdgcn_cvt_pk_f32_fp8((int)w[j], false), hi = __builtin_amdgcn_cvt_pk_f32_fp8((int)w[j], true); f[4 * j] = lo.x; f[4 * j + 1] = lo.y; f[4 * j + 2] = hi.x; f[4 * j + 3] = hi.y; }
}
__device__ __forceinline__ unsigned xcc_id() { return (unsigned)__builtin_amdgcn_s_getreg((3 << 11) | 20) & 7u; }

typedef long l64x2 __attribute__((ext_vector_type(2)));
struct E1Bat { l64x2 rw[16]; };
__device__ __forceinline__ void phase_exp1(const Ctx& c) {
    typedef float f32x4m __attribute__((ext_vector_type(4)));
    const int* IDX = (const int*)(c.ws + WS_IDX); const unsigned char* U8 = c.ws + WS_U8; float* PACT = (float*)(c.ws + WS_PACT);
    unsigned* cnt = (unsigned*)(c.ws + WS_CTL) + CW_E1;
    constexpr int CH = 4;
    constexpr int SROW = 144;
    unsigned char* wl = c.lds + c.wave * 8704; int* le = (int*)wl; unsigned char* himg = wl + 2048; float* res = (float*)(wl + 3072); unsigned char* stage = wl + 3584;
    const int xcc = (int)xcc_id(), r16 = c.lane & 15, g4 = c.lane >> 4, row8 = c.lane >> 3, pc8 = c.lane & 7; const bool bcol = r16 < 2;
    int bo = 0; unsigned tq = 0;
    if (c.lane == 0) tq = __hip_atomic_fetch_add(cnt + 64 * (xcc & 7), (unsigned)CH, __ATOMIC_RELAXED, __HIP_MEMORY_SCOPE_AGENT);
    for (;;) {
        const int x = (xcc + bo) & 7;
        const unsigned t0 = (unsigned)__builtin_amdgcn_readfirstlane((int)tq);
        if (t0 >= (unsigned)ML) { if (++bo >= 8) break; tq = 0; if (c.lane == 0) tq = __hip_atomic_fetch_add(cnt + 64 * ((xcc + bo) & 7), (unsigned)CH, __ATOMIC_RELAXED, __HIP_MEMORY_SCOPE_AGENT); continue; }
        tq = 0; if (c.lane == 0) tq = __hip_atomic_fetch_add(cnt + 64 * x, (unsigned)CH, __ATOMIC_RELAXED, __HIP_MEMORY_SCOPE_AGENT);
        { const v4u e0 = *(const v4u*)(IDX + (size_t)t0 * 128 + 4 * c.lane), e1 = *(const v4u*)(IDX + (size_t)t0 * 128 + 256 + 4 * c.lane);
          const v4u im = *(const v4u*)(c.ws + WS_HQ8 + ((size_t)t0 + (c.lane >> 4)) * 2048 + ((c.lane >> 3) & 1) * 1024 + 128 * x + 16 * (c.lane & 7));
          *(v4u*)(le + 4 * c.lane) = e0; *(v4u*)(le + 256 + 4 * c.lane) = e1; *(v4u*)(himg + 16 * c.lane) = im; }
        WAVE_LDS_SYNC();
#define E1_LOAD(G, B) do { const int bb = (B) < CH ? (B) : 0; _Pragma("unroll") for (int i = 0; i < 16; ++i) G.rw[i] = *(const l64x2*)(U8 + (size_t)le[bb * 128 + 8 * i + row8] * D + 128 * x + 16 * pc8); } while (0)
#define E1_COMP(G, B) do { const unsigned char* hb = himg + ((B) * 2 + (r16 & 1)) * 128 + 32 * g4; long bq[4]; _Pragma("unroll") for (int m = 0; m < 4; ++m) { const long v = *(const long*)(hb + 8 * m); bq[m] = bcol ? v : 0l; } \
            _Pragma("unroll") for (int gi = 0; gi < 8; ++gi) { unsigned char* sb = stage + (gi & 1) * (16 * SROW); \
                *(l64x2*)(sb + row8 * SROW + 16 * pc8) = G.rw[2 * gi]; *(l64x2*)(sb + (8 + row8) * SROW + 16 * pc8) = G.rw[2 * gi + 1]; \
                WAVE_LDS_SYNC(); \
                const l64x2 a01 = *(const l64x2*)(sb + r16 * SROW + 32 * g4), a23 = *(const l64x2*)(sb + r16 * SROW + 32 * g4 + 16); \
                f32x4m acc = {0.f, 0.f, 0.f, 0.f}; \
                acc = __builtin_amdgcn_mfma_f32_16x16x32_fp8_fp8(a01.x, bq[0], acc, 0, 0, 0); acc = __builtin_amdgcn_mfma_f32_16x16x32_fp8_fp8(a01.y, bq[1], acc, 0, 0, 0); \
                acc = __builtin_amdgcn_mfma_f32_16x16x32_fp8_fp8(a23.x, bq[2], acc, 0, 0, 0); acc = __builtin_amdgcn_mfma_f32_16x16x32_fp8_fp8(a23.y, bq[3], acc, 0, 0, 0); \
                _Pragma("unroll") for (int q = 0; q < 4; ++q) { const float lo = dppf<0xB1>(acc[q]); if (r16 == 0) res[gi * 16 + 4 * g4 + q] = acc[q] + lo * 0.0625f; } } \
            WAVE_LDS_SYNC(); \
            { float* po = PACT + (size_t)x * ((size_t)ML * 128) + ((size_t)t0 + (B)) * 128; po[c.lane] = res[c.lane]; po[64 + c.lane] = res[64 + c.lane]; } \
            WAVE_LDS_SYNC(); } while (0)
        E1Bat ga, gb;
        E1_LOAD(ga, 0);
#pragma unroll 1
        for (int b2 = 0; b2 < CH; b2 += 2) {
            E1_LOAD(gb, b2 + 1);
            __builtin_amdgcn_sched_barrier(0);
            E1_COMP(ga, b2);
            __builtin_amdgcn_sched_barrier(0);
            E1_LOAD(ga, b2 + 2);
            __builtin_amdgcn_sched_barrier(0);
            E1_COMP(gb, b2 + 1);
            __builtin_amdgcn_sched_barrier(0);
        }
#undef E1_LOAD
#undef E1_COMP
    }
}
__device__ __forceinline__ void phase_exp1b(const Ctx& c) {
    const int* IDX = (const int*)(c.ws + WS_IDX); const float* GATE = (const float*)(c.ws + WS_GATE); const float* HS = (const float*)(c.ws + WS_HS); const float* PACT = (const float*)(c.ws + WS_PACT);
    const float* USC = (const float*)(c.ws + WS_USC); const float* VSC = (const float*)(c.ws + WS_VSC); float* ACT = (float*)(c.ws + WS_ACT);
    for (size_t i = (size_t)c.bid * NTHREADS + c.tid; i < (size_t)ML * 128; i += (size_t)c.G * NTHREADS) {
        float s = 0.f;
#pragma unroll
        for (int x = 0; x < 8; ++x) s += PACT[(size_t)x * ((size_t)ML * 128) + i];
        const int e = IDX[i];
        ACT[i] = gelu_erf(s * HS[i >> 7] * USC[e]) * GATE[i] * VSC[e];
    }
}
__device__ __forceinline__ void phase_exp2(const Ctx& c) {
    const int* IDX = (const int*)(c.ws + WS_IDX); const float* ACT = (const float*)(c.ws + WS_ACT); const unsigned char* V8 = c.ws + WS_V8;
    bf16* Y = (bf16*)(c.ws + WS_Y); float* SSQP = (float*)(c.ws + WS_SSQP);
    unsigned* cnt = (unsigned*)(c.ws + WS_CTL) + CW_E2;
    int* li = (int*)(c.lds + c.wave * 1024); float* la = (float*)(li + 128);
    const int xcc = (int)xcc_id(), sub = c.lane & 7, grp = c.lane >> 3;
    const bool b5 = c.lane & 32, b4 = c.lane & 16, b3 = c.lane & 8;
    constexpr int CH = 8;
    int bo = 0, t = 0, tend = 0;
    int iA = 0, iB = 0; float aA = 0.f, aB = 0.f;
    unsigned tq = 0; if (c.lane == 0) tq = __hip_atomic_fetch_add(cnt + 64 * (xcc & 7), (unsigned)CH, __ATOMIC_RELAXED, __HIP_MEMORY_SCOPE_AGENT);
    for (;;) {
        if (t >= tend) {
            const unsigned t0 = (unsigned)__builtin_amdgcn_readfirstlane((int)tq);
            if (t0 >= (unsigned)ML) { if (++bo >= 8) break; tq = 0; if (c.lane == 0) tq = __hip_atomic_fetch_add(cnt + 64 * ((xcc + bo) & 7), (unsigned)CH, __ATOMIC_RELAXED, __HIP_MEMORY_SCOPE_AGENT); continue; }
            tq = 0; if (c.lane == 0) tq = __hip_atomic_fetch_add(cnt + 64 * ((xcc + bo) & 7), (unsigned)CH, __ATOMIC_RELAXED, __HIP_MEMORY_SCOPE_AGENT);
            t = (int)t0; tend = t + CH;
            iA = IDX[(size_t)t * 128 + c.lane]; iB = IDX[(size_t)t * 128 + 64 + c.lane]; aA = ACT[(size_t)t * 128 + c.lane]; aB = ACT[(size_t)t * 128 + 64 + c.lane];
        }
        const int x = (xcc + bo) & 7;
        li[c.lane] = iA; li[64 + c.lane] = iB; la[c.lane] = aA; la[64 + c.lane] = aB;
        if (t + 1 < tend) { iA = IDX[(size_t)(t + 1) * 128 + c.lane]; iB = IDX[(size_t)(t + 1) * 128 + 64 + c.lane]; aA = ACT[(size_t)(t + 1) * 128 + c.lane]; aB = ACT[(size_t)(t + 1) * 128 + 64 + c.lane]; }
        WAVE_LDS_SYNC();
        float acc[16];
#pragma unroll
        for (int q = 0; q < 16; ++q) acc[q] = 0.f;
#pragma unroll
        for (int hf = 0; hf < 2; ++hf) { v4u rows[8]; float av[8];
#pragma unroll
            for (int i = 0; i < 8; ++i) { const int k = 8 * (8 * hf + i) + grp; rows[i] = *(const v4u*)(V8 + (size_t)li[k] * D + x * 128 + 16 * sub); av[i] = la[k]; }
#pragma unroll
            for (int i = 0; i < 8; ++i) { float f[16]; fp8x16_to_f32(rows[i], f);
#pragma unroll
                for (int q = 0; q < 16; ++q) acc[q] = fmaf(av[i], f[q], acc[q]); } }
        float q8[8], q4[4], q2[2];
#pragma unroll
        for (int i = 0; i < 8; ++i) { const float keep = b5 ? acc[i + 8] : acc[i], send = b5 ? acc[i] : acc[i + 8]; q8[i] = keep + __shfl_xor(send, 32); }
#pragma unroll
        for (int i = 0; i < 4; ++i) { const float keep = b4 ? q8[i + 4] : q8[i], send = b4 ? q8[i] : q8[i + 4]; q4[i] = keep + __shfl_xor(send, 16); }
#pragma unroll
        for (int i = 0; i < 2; ++i) { const float keep = b3 ? q4[i + 2] : q4[i], send = b3 ? q4[i] : q4[i + 2]; q2[i] = keep + __shfl_xor(send, 8); }
        const int col = x * 128 + 16 * sub + (b5 ? 8 : 0) + (b4 ? 4 : 0) + (b3 ? 2 : 0);
        *(unsigned*)(Y + (size_t)t * D + col) = pk2(q2[0], q2[1]);
        const float ss = wsum(q2[0] * q2[0] + q2[1] * q2[1]);
        SSQP[(size_t)x * ML + t] = ss;
        WAVE_LDS_SYNC();
        ++t;
    }
}
__device__ __forceinline__ void phase_exp3(const Ctx& c) {
    const Args& a = *c.a;
    const float* MOD = (const float*)(c.ws + WS_MOD); const bf16* Y = (const bf16*)(c.ws + WS_Y); const float* SSQP = (const float*)(c.ws + WS_SSQP);
    v2u ny[4]; f32x4 nx[4]; float nss = 0.f;
#define E3_LOAD(R) do { _Pragma("unroll") for (int j = 0; j < 4; ++j) { const int col = 4 * c.lane + 256 * j; ny[j] = *(const v2u*)(Y + (size_t)(R) * D + col); nx[j] = *(const f32x4*)(a.out + (size_t)(R) * D + col); } \
        nss = (c.lane < 8) ? SSQP[(size_t)c.lane * ML + (R)] : 0.f; } while (0)
    if (c.gw < ML) E3_LOAD(c.gw);
    for (int row = c.gw; row < ML; row += c.NGW) {
        f32x4 y[4], x1[4];
#pragma unroll
        for (int j = 0; j < 4; ++j) { y[j] = (f32x4){bflo(ny[j].x), bfhi(ny[j].x), bflo(ny[j].y), bfhi(ny[j].y)}; x1[j] = nx[j]; }
        const float ss = row_sum16(nss);
        const float tot = __builtin_bit_cast(float, __builtin_amdgcn_readlane(__builtin_bit_cast(int, ss), 0));
        if (row + c.NGW < ML) E3_LOAD(row + c.NGW);
        const float r = rsqrtf(tot * (1.f / D) + EPS); const float* mr = MOD + (row >> 11) * 6144 + 5120;
#pragma unroll
        for (int j = 0; j < 4; ++j) { const int col = 4 * c.lane + 256 * j;
            const f32x4 g4 = *(const f32x4*)(a.in[I_GPOSTFFN] + col), gt = *(const f32x4*)(mr + col);
            *(f32x4*)(a.out + (size_t)row * D + col) = x1[j] + gt * ((y[j] * r) * g4); }
    }
#undef E3_LOAD
}

constexpr int S5_LPOW = 0, S5_BBAR = 33792, S5_CC = 50176, S5_MM = 66560;
__device__ __forceinline__ void s5_build_group(const Ctx& c, int g, int part) {
    const Args& a = *c.a;
    f32x2* LPOW = (f32x2*)(c.lds + S5_LPOW);
    f32x2* BBAR = (f32x2*)(c.lds + S5_BBAR);
    f32x2* CC = (f32x2*)(c.lds + S5_CC);
    float* MM = (float*)(c.lds + S5_MM);
    __syncthreads();
    if (c.tid < 128) { const int dir = c.tid >> 6, p = c.tid & 63, dg = dir * 32 + g;
        const float dt = expf(a.in[I_LOGDT][dg]), lr = a.in[I_LAMRE][dg * 64 + p], li = a.in[I_LAMIM][dg * 64 + p];
        const double ang = (double)li * (double)dt; const float lrdt = lr * dt;
        for (int e = 0; e <= 32; ++e) { float sn, cs; sincos_d(ang * (double)e, sn, cs); const float mg = expf(lrdt * (float)e); LPOW[(dir * 33 + e) * 64 + p] = (f32x2){mg * cs, mg * sn}; }
        float sn, cs; sincos_d(ang, sn, cs); const float mag = expf(lrdt), lbr = mag * cs, lbi = mag * sn, den = lr * lr + li * li, nr = lbr - 1.f;
        const float cr = (nr * lr + lbi * li) / den, ci = (lbi * lr - nr * li) / den;
        for (int ch = 0; ch < 16; ++ch) { const float br = a.in[I_BRE][(size_t)(dg * 64 + p) * 16 + ch], bi = a.in[I_BIM][(size_t)(dg * 64 + p) * 16 + ch]; BBAR[(dir * 64 + p) * 16 + ch] = (f32x2){cr * br - ci * bi, cr * bi + ci * br}; } }
    for (int i = c.tid; i < 2048; i += NTHREADS) { const int dir = i >> 10, ch = (i >> 6) & 15, p = i & 63, dg = dir * 32 + g; CC[i] = (f32x2){a.in[I_CRE][(size_t)(dg * 16 + ch) * 64 + p], a.in[I_CIM][(size_t)(dg * 16 + ch) * 64 + p]}; }
    __syncthreads();
    for (int task = c.tid; task < 1024; task += NTHREADS) { const int cpb = task & 3, cb = (task >> 2) & 3, lag = (task >> 4) & 31, dir = task >> 9;
        float acc[4][4];
#pragma unroll
        for (int i = 0; i < 4; ++i)
#pragma unroll
            for (int j = 0; j < 4; ++j) acc[i][j] = 0.f;
        for (int p = 0; p < 64; ++p) { const f32x2 l = LPOW[(dir * 33 + lag) * 64 + p]; f32x2 G[4], Cw[4];
#pragma unroll
            for (int j = 0; j < 4; ++j) { const f32x2 bb = BBAR[(dir * 64 + p) * 16 + 4 * cpb + j]; G[j] = (f32x2){l.x * bb.x - l.y * bb.y, l.x * bb.y + l.y * bb.x}; }
#pragma unroll
            for (int i = 0; i < 4; ++i) Cw[i] = CC[(dir * 16 + 4 * cb + i) * 64 + p];
#pragma unroll
            for (int i = 0; i < 4; ++i)
#pragma unroll
                for (int j = 0; j < 4; ++j) acc[i][j] += Cw[i].x * G[j].x - Cw[i].y * G[j].y; }
#pragma unroll
        for (int i = 0; i < 4; ++i)
#pragma unroll
            for (int j = 0; j < 4; ++j) MM[((dir * 32 + lag) * 16 + 4 * cb + i) * 16 + 4 * cpb + j] = acc[i][j]; }
    __syncthreads();
    if (c.tid < 128 && part == 0) { const int dir = c.tid >> 6, p = c.tid & 63; ((f32x2*)(c.ws + WS_LP))[(dir * 32 + g) * 64 + p] = LPOW[(dir * 33 + 32) * 64 + p]; }
    bf16* PMg = (bf16*)(c.ws + WS_PM) + (size_t)g * 256 * 512; bf16* BBg = (bf16*)(c.ws + WS_BB) + (size_t)g * 512 * 768;
    for (int task = part * 64 * 32 + c.tid; task < (part + 1) * 64 * 32; task += NTHREADS) { const int ip = task & 31, n = task >> 5, dir = n >> 7, im = (n >> 6) & 1, p = n & 63, e = dir ? ip : 31 - ip;
        const f32x2 l = LPOW[(dir * 33 + e) * 64 + p]; float o[16];
#pragma unroll
        for (int ch = 0; ch < 16; ++ch) { const f32x2 bb = BBAR[(dir * 64 + p) * 16 + ch]; o[ch] = im ? (l.x * bb.y + l.y * bb.x) : (l.x * bb.x - l.y * bb.y); }
        v4u w0, w1; w0.x = pk2(o[0], o[1]); w0.y = pk2(o[2], o[3]); w0.z = pk2(o[4], o[5]); w0.w = pk2(o[6], o[7]); w1.x = pk2(o[8], o[9]); w1.y = pk2(o[10], o[11]); w1.z = pk2(o[12], o[13]); w1.w = pk2(o[14], o[15]);
        *(v4u*)(PMg + (size_t)n * 512 + ip * 16) = w0; *(v4u*)(PMg + (size_t)n * 512 + ip * 16 + 8) = w1; }
    for (int task = part * 128 * 32 + c.tid; task < (part + 1) * 128 * 32; task += NTHREADS) { const int ip = task & 31, n = task >> 5, i = n >> 4, ch = n & 15; float o[16];
#pragma unroll
        for (int q = 0; q < 16; ++q) o[q] = 0.f;
        if (ip <= i) { const float* m0 = MM + ((0 * 32 + (i - ip)) * 16 + ch) * 16;
#pragma unroll
            for (int q = 0; q < 16; ++q) o[q] += m0[q]; }
        if (ip >= i) { const float* m1 = MM + ((1 * 32 + (ip - i)) * 16 + ch) * 16;
#pragma unroll
            for (int q = 0; q < 16; ++q) o[q] += m1[q]; }
        if (ip == i) { const float dsk = a.in[I_S5D][g * 16 + ch];
#pragma unroll
            for (int q = 0; q < 16; ++q) o[q] += (q == ch) ? dsk : 0.f; }
        v4u w0, w1; w0.x = pk2(o[0], o[1]); w0.y = pk2(o[2], o[3]); w0.z = pk2(o[4], o[5]); w0.w = pk2(o[6], o[7]); w1.x = pk2(o[8], o[9]); w1.y = pk2(o[10], o[11]); w1.z = pk2(o[12], o[13]); w1.w = pk2(o[14], o[15]);
        *(v4u*)(BBg + (size_t)n * 768 + ip * 16) = w0; *(v4u*)(BBg + (size_t)n * 768 + ip * 16 + 8) = w1; }
    for (int task = part * 128 * 32 + c.tid; task < (part + 1) * 128 * 32; task += NTHREADS) { const int p8 = task & 7, part = (task >> 3) & 3, n = task >> 5, i = n >> 4, ch = n & 15, dir = part >> 1, im = part & 1, e = dir ? 32 - i : i + 1; float o[8];
#pragma unroll
        for (int q = 0; q < 8; ++q) { const int p = p8 * 8 + q; const f32x2 l = LPOW[(dir * 33 + e) * 64 + p], cc = CC[(dir * 16 + ch) * 64 + p]; o[q] = im ? -(cc.x * l.y + cc.y * l.x) : (cc.x * l.x - cc.y * l.y); }
        v4u w0; w0.x = pk2(o[0], o[1]); w0.y = pk2(o[2], o[3]); w0.z = pk2(o[4], o[5]); w0.w = pk2(o[6], o[7]);
        *(v4u*)(BBg + (size_t)n * 768 + 512 + part * 64 + p8 * 8) = w0; }
}
__device__ __forceinline__ void s5_state_scan(const Ctx& c, int task) {
    const int dir = task & 1, g = (task >> 1) & 31, b = task >> 6, p = c.lane;
    const f32x2 a = ((const f32x2*)(c.ws + WS_LP))[(dir * 32 + g) * 64 + p];
    const float* SS = (const float*)(c.ws + WS_SS) + (size_t)g * 768 * 256 + dir * 128 + p; bf16* U5 = (bf16*)(c.ws + WS_U5) + (size_t)g * 768 * 768 + 512 + dir * 128 + p;
    float er = 0.f, ei = 0.f;
#pragma unroll 24
    for (int step = 0; step < 72; ++step) {
        const int R = (step < 8) ? 512 + b * 8 + (dir ? 7 - step : step) : b * 64 + (dir ? 71 - step : step - 8);
        if (step >= 8) { U5[(size_t)R * 768] = (bf16)f2bf(er); U5[(size_t)R * 768 + 64] = (bf16)f2bf(ei); }
        const float sr = SS[(size_t)R * 256], si = SS[(size_t)R * 256 + 64];
        const float nr = sr + a.x * er - a.y * ei, ni = si + a.x * ei + a.y * er; er = nr; ei = ni;
    }
}

constexpr int GDN_NCH = 36, GDN_ITEMS = NB * 4 * 2 * GDN_NCH;
constexpr size_t FR_T_BYTES = 8192, FR_ATT_BYTES = 8192, FR_KD_BYTES = 16384, FR_TAB_BYTES = 1024;
__device__ __forceinline__ int crow16(int i, int hh) { return (i & 3) + 8 * (i >> 2) + 4 * hh; }
__device__ __forceinline__ bf16x8 pack_step(const f32x16& x, int s) {
    v4u w; w.x = pk2(x[8 * s + 0], x[8 * s + 1]); w.y = pk2(x[8 * s + 2], x[8 * s + 3]); w.z = pk2(x[8 * s + 4], x[8 * s + 5]); w.w = pk2(x[8 * s + 6], x[8 * s + 7]);
    return __builtin_bit_cast(bf16x8, w);
}
__device__ __forceinline__ unsigned pk2v(float lo, float hi) { asm volatile("" : "+v"(lo), "+v"(hi)); return pk2(lo, hi); }
__device__ __forceinline__ bf16x8 pack_step_v(const f32x16& x, int s) {
    v4u w; w.x = pk2v(x[8 * s + 0], x[8 * s + 1]); w.y = pk2v(x[8 * s + 2], x[8 * s + 3]); w.z = pk2v(x[8 * s + 4], x[8 * s + 5]); w.w = pk2v(x[8 * s + 6], x[8 * s + 7]);
    return __builtin_bit_cast(bf16x8, w);
}
constexpr int GP_KR = 0, GP_QR = 17408, GP_KT = 34816, GP_TAB = 53248, GP_LP = 54272, GP_LPB = 8448 + 256;
__host__ __device__ constexpr int LOFF(int i) { return i < 1 ? 0 : 4 * (((i - 1) >> 2) + 1) * (2 * ((i - 1) >> 2) + ((i - 1) & 3)); }
static_assert(LOFF(1) == 0 && LOFF(2) == 4 && LOFF(5) == 16 && LOFF(6) == 24 && LOFF(64) == 2112, "packed lower-triangular row offsets");
__device__ __forceinline__ void gdn_prep_stage(const Ctx& c, int item, float* Lp) {
    const int n = item % GDN_NCH, bhd = item / GDN_NCH, dir = bhd & 1, h = (bhd >> 1) & 3, b = bhd >> 3;
    const bf16* QKV = (const bf16*)(c.ws + WS_QKV); const float* GB = (const float*)(c.ws + WS_GB);
    bf16* Kr = (bf16*)(c.lds + GP_KR); bf16* Qr = (bf16*)(c.lds + GP_QR); bf16* Kt = (bf16*)(c.lds + GP_KT); float* tab = (float*)(c.lds + GP_TAB);
    unsigned char* frA = c.ws + WS_FRA + (size_t)item * FR_ATT_BYTES; unsigned char* frK = c.ws + WS_FRK + (size_t)item * FR_KD_BYTES; float* frTab = (float*)(c.ws + WS_FRTAB + (size_t)item * FR_TAB_BYTES);
    const int r = c.lane & 31, hh = c.lane >> 5;
    if (c.wave == 0) { const int row = scan_row(b, dir, n * 64 + c.lane); float g = GB[(size_t)row * 16 + dir * 4 + h]; const float beta = GB[(size_t)row * 16 + 8 + dir * 4 + h];
#pragma unroll
        for (int o = 1; o < 64; o <<= 1) { const float t = __shfl_up(g, o); if (c.lane >= o) g += t; }
        const float gl = __shfl(g, 63);
        tab[c.lane] = g; tab[64 + c.lane] = beta; tab[128 + c.lane] = __expf(g); tab[192 + c.lane] = __expf(gl - g); }
    { const int s = c.tid >> 3, seg = c.tid & 7; const int row = scan_row(b, dir, n * 64 + s); const bf16* rp = QKV + (size_t)row * 1536 + h * 128 + seg * 16;
      const v4u q0 = *(const v4u*)rp, q1 = *(const v4u*)(rp + 8), k0 = *(const v4u*)(rp + 512), k1 = *(const v4u*)(rp + 520);
      *(v4u*)(Qr + s * 136 + seg * 16) = q0; *(v4u*)(Qr + s * 136 + seg * 16 + 8) = q1; *(v4u*)(Kr + s * 136 + seg * 16) = k0; *(v4u*)(Kr + s * 136 + seg * 16 + 8) = k1;
      const unsigned kw[8] = {k0.x, k0.y, k0.z, k0.w, k1.x, k1.y, k1.z, k1.w};
#pragma unroll
      for (int e = 0; e < 8; ++e) { Kt[(seg * 16 + 2 * e) * 72 + s] = (bf16)(kw[e] & 0xffffu); Kt[(seg * 16 + 2 * e + 1) * 72 + s] = (bf16)(kw[e] >> 16); } }
    __syncthreads();
    if (c.wave < 3) { const int ct = c.wave ? 1 : 0, st = c.wave == 2 ? 1 : 0;
        f32x16 acc;
#pragma unroll
        for (int i = 0; i < 16; ++i) acc[i] = 0.f;
#pragma unroll
        for (int kk = 0; kk < 8; ++kk) { const bf16x8 a = *(const bf16x8*)(Kr + (ct * 32 + r) * 136 + kk * 16 + hh * 8), bb = *(const bf16x8*)(Kr + (st * 32 + r) * 136 + kk * 16 + hh * 8); acc = MFMA32(a, bb, acc); }
        const int s = st * 32 + r; const float gcs = tab[s];
#pragma unroll
        for (int i = 0; i < 16; ++i) { const int cc = ct * 32 + crow16(i, hh); if (s < cc) Lp[LOFF(cc) + s] = tab[64 + cc] * acc[i] * __expf(tab[cc] - gcs); }
    } else if (c.wave < 6) { const int w = c.wave - 3, st = w == 2 ? 1 : 0, ct = w ? 1 : 0;
        f32x16 acc;
#pragma unroll
        for (int i = 0; i < 16; ++i) acc[i] = 0.f;
#pragma unroll
        for (int kk = 0; kk < 8; ++kk) { const bf16x8 a = *(const bf16x8*)(Kr + (st * 32 + r) * 136 + kk * 16 + hh * 8), bb = *(const bf16x8*)(Qr + (ct * 32 + r) * 136 + kk * 16 + hh * 8); acc = MFMA32(a, bb, acc); }
        const int cc = ct * 32 + r; const float gcc = tab[cc];
#pragma unroll
        for (int i = 0; i < 16; ++i) { const int s = st * 32 + crow16(i, hh); acc[i] = (s <= cc) ? acc[i] * __expf(gcc - tab[s]) : 0.f; }
        *(bf16x8*)(frA + ((size_t)((ct * 4 + 2 * st) * 64 + c.lane)) * 16) = pack_step(acc, 0);
        *(bf16x8*)(frA + ((size_t)((ct * 4 + 2 * st + 1) * 64 + c.lane)) * 16) = pack_step(acc, 1);
    } else { const int w = c.wave - 6;
#pragma unroll
        for (int f = 0; f < 8; ++f) { const int fi = w * 8 + f, dkt = fi >> 2, cb = fi & 3; const bf16* kp = Kt + (dkt * 32 + r) * 72 + 16 * cb + 4 * hh;
            const v2u lo = *(const v2u*)kp, hi = *(const v2u*)(kp + 8); const f32x4 e0 = *(const f32x4*)(tab + 192 + 16 * cb + 4 * hh), e1 = *(const f32x4*)(tab + 192 + 16 * cb + 8 + 4 * hh);
            v4u o; o.x = pk2(bflo(lo.x) * e0.x, bfhi(lo.x) * e0.y); o.y = pk2(bflo(lo.y) * e0.z, bfhi(lo.y) * e0.w); o.z = pk2(bflo(hi.x) * e1.x, bfhi(hi.x) * e1.y); o.w = pk2(bflo(hi.y) * e1.z, bfhi(hi.y) * e1.w);
            *(v4u*)(frK + ((size_t)(fi * 64 + c.lane)) * 16) = o; }
        if (w == 0) { const v4u z = (v4u){0u, 0u, 0u, 0u}; *(v4u*)(frA + ((size_t)((0 * 4 + 2) * 64 + c.lane)) * 16) = z; *(v4u*)(frA + ((size_t)((0 * 4 + 3) * 64 + c.lane)) * 16) = z; }
        else { *(f32x4*)(frTab + 4 * c.lane) = *(const f32x4*)(tab + 4 * c.lane); }
    }
    __syncthreads();
}
__device__ __forceinline__ void gdn_prep_solve(const Ctx& c, int item, float* Lp) {
    float Tr[64];
#pragma unroll
    for (int i = 0; i < 64; ++i) { int le_ = c.lane; asm volatile("" : "+v"(le_)); float a0 = (le_ == i) ? 1.f : 0.f, a1 = 0.f;
#pragma unroll
        for (int s4 = 0; s4 < (i + 3) / 4; ++s4) { const f32x4 l4 = *(const f32x4*)(Lp + LOFF(i) + 4 * s4);
            if (4 * s4 + 0 < i) a0 = fmaf(-l4.x, Tr[4 * s4 + 0], a0); if (4 * s4 + 1 < i) a1 = fmaf(-l4.y, Tr[4 * s4 + 1], a1); if (4 * s4 + 2 < i) a0 = fmaf(-l4.z, Tr[4 * s4 + 2], a0); if (4 * s4 + 3 < i) a1 = fmaf(-l4.w, Tr[4 * s4 + 3], a1); }
        Tr[i] = a0 + a1; { int lo_ = c.lane; asm volatile("" : "+v"(lo_)); Lp[(lo_ < i) ? LOFF(i) + lo_ : 2112 + lo_] = Tr[i]; } }
    WAVE_LDS_SYNC();
    unsigned char* frT = c.ws + WS_FRT + (size_t)item * FR_T_BYTES;
    const int r = c.lane & 31, hh = c.lane >> 5;
#pragma unroll
    for (int f = 0; f < 8; ++f) { const int ct = f >> 2, sb = f & 3, cc = ct * 32 + r; float v[8];
#pragma unroll
        for (int q = 0; q < 2; ++q) { const int s0 = 16 * sb + 8 * q + 4 * hh;
            f32x4 t4 = (f32x4){0.f, 0.f, 0.f, 0.f}; if (s0 < cc) t4 = *(const f32x4*)(Lp + LOFF(cc) + s0);
            v[4 * q + 0] = (s0 + 0 < cc) ? t4.x : (s0 + 0 == cc ? 1.f : 0.f); v[4 * q + 1] = (s0 + 1 < cc) ? t4.y : (s0 + 1 == cc ? 1.f : 0.f);
            v[4 * q + 2] = (s0 + 2 < cc) ? t4.z : (s0 + 2 == cc ? 1.f : 0.f); v[4 * q + 3] = (s0 + 3 < cc) ? t4.w : (s0 + 3 == cc ? 1.f : 0.f); }
        *(v4u*)(frT + ((size_t)(f * 64 + c.lane)) * 16) = (v4u){pk2(v[0], v[1]), pk2(v[2], v[3]), pk2(v[4], v[5]), pk2(v[6], v[7])}; }
}
__device__ __forceinline__ void phase_gdn_prep(const Ctx& c) {
    for (int base = c.bid; base < GDN_ITEMS; base += 8 * c.G) {
        int cnt = 0;
#pragma unroll 1
        for (int q = 0; q < 8; ++q) { const int item = base + q * c.G; if (item < GDN_ITEMS) { gdn_prep_stage(c, item, (float*)(c.lds + GP_LP + q * GP_LPB)); cnt = q + 1; } }
        if (c.wave < cnt) gdn_prep_solve(c, base + c.wave * c.G, (float*)(c.lds + GP_LP + c.wave * GP_LPB));
        __syncthreads();
    }
}

constexpr int GR_K = 0, GR_Q = 16384, GR_T = 32768, GR_A = 40960, GR_KD = 49152, GR_TAB = 65536, GR_BUF = 66560;
__device__ __forceinline__ void gdn_rec_stage(const Ctx& c, int bhd, int n, int buf) {
    const int dir = bhd & 1, h = (bhd >> 1) & 3, b = bhd >> 3, lw = c.wave - 4; const int item = bhd * GDN_NCH + n;
    LAS unsigned char* base = (LAS unsigned char*)c.lds + buf * GR_BUF;
    const unsigned char* QKVb = c.ws + WS_QKV;
#pragma unroll
    for (int q = 0; q < 4; ++q) { const int qi = lw + 4 * q;
        const int s = 4 * qi + (c.lane >> 4), ps = c.lane & 15, p = ps ^ (s & 15); const size_t rowb = (size_t)scan_row(b, dir, n * 64 + s) * 3072 + (size_t)h * 256 + p * 16;
        __builtin_amdgcn_global_load_lds((const unsigned*)(QKVb + rowb + 1024), (LAS unsigned*)(base + GR_K + qi * 1024), 16, 0, 0);
        __builtin_amdgcn_global_load_lds((const unsigned*)(QKVb + rowb), (LAS unsigned*)(base + GR_Q + qi * 1024), 16, 0, 0); }
    const unsigned char* frT = c.ws + WS_FRT + (size_t)item * FR_T_BYTES; const unsigned char* frA = c.ws + WS_FRA + (size_t)item * FR_ATT_BYTES; const unsigned char* frK = c.ws + WS_FRK + (size_t)item * FR_KD_BYTES;
#pragma unroll
    for (int q = 0; q < 2; ++q) { const int qi = lw + 4 * q;
        __builtin_amdgcn_global_load_lds((const unsigned*)(frT + qi * 1024 + c.lane * 16), (LAS unsigned*)(base + GR_T + qi * 1024), 16, 0, 0);
        __builtin_amdgcn_global_load_lds((const unsigned*)(frA + qi * 1024 + c.lane * 16), (LAS unsigned*)(base + GR_A + qi * 1024), 16, 0, 0); }
#pragma unroll
    for (int q = 0; q < 4; ++q) { const int qi = lw + 4 * q;
        __builtin_amdgcn_global_load_lds((const unsigned*)(frK + qi * 1024 + c.lane * 16), (LAS unsigned*)(base + GR_KD + qi * 1024), 16, 0, 0); }
    if (lw == 0) __builtin_amdgcn_global_load_lds((const unsigned*)(c.ws + WS_FRTAB + (size_t)item * FR_TAB_BYTES + c.lane * 16), (LAS unsigned*)(base + GR_TAB), 16, 0, 0);
}
__device__ __forceinline__ bf16x8 gr_rowfrag(const unsigned char* rowp, const int (&po)[16], int kb) {
    const v2u lo = *(const v2u*)(rowp + po[2 * kb]), hi = *(const v2u*)(rowp + po[2 * kb + 1]);
    return __builtin_bit_cast(bf16x8, (v4u){lo.x, lo.y, hi.x, hi.y});
}
__device__ __forceinline__ void gdn_rec_block(const Ctx& c, int bhd, int dvhalf) {
    const int dir = bhd & 1, h = (bhd >> 1) & 3, b = bhd >> 3, r = c.lane & 31, hh = c.lane >> 5, dvt = 2 * dvhalf + (c.wave & 1);
    const bf16* QKV = (const bf16*)(c.ws + WS_QKV); bf16* OG = (bf16*)(c.ws + WS_OG) + (size_t)dir * ML * 512;
    f32x16 S[4];
#pragma unroll
    for (int t = 0; t < 4; ++t)
#pragma unroll
        for (int i = 0; i < 16; ++i) S[t][i] = 0.f;
    int po[16];
#pragma unroll
    for (int p = 0; p < 16; ++p) po[p] = r * 256 + ((p ^ (r & 15)) * 16) + 8 * hh;
    if (c.wave >= 4) gdn_rec_stage(c, bhd, 0, 0);
    asm volatile("s_waitcnt vmcnt(0)" ::: "memory"); __syncthreads();
    for (int n = 0; n < GDN_NCH; ++n) {
        const int buf = n & 1;
        if (c.wave >= 4) { if (n + 1 < GDN_NCH) gdn_rec_stage(c, bhd, n + 1, buf ^ 1); }
        else if (c.wave < 2) {
            const unsigned char* base = c.lds + buf * GR_BUF; const float* tab = (const float*)(base + GR_TAB);
            const int row0 = scan_row(b, dir, n * 64), sgn = dir ? -1 : 1;
            const bf16* vcol = QKV + (size_t)row0 * 1536 + 1024 + h * 128 + dvt * 32 + r + (ptrdiff_t)(sgn * 4 * hh) * 1536;
            bf16* ocol = OG + (size_t)row0 * 512 + h * 128 + dvt * 32 + r + (ptrdiff_t)(sgn * 4 * hh) * 512;
            const ptrdiff_t vst = (ptrdiff_t)sgn * 1536, ost = (ptrdiff_t)sgn * 512;
            bf16 vraw[2][16];
#pragma unroll
            for (int st = 0; st < 2; ++st)
#pragma unroll
                for (int i = 0; i < 16; ++i) vraw[st][i] = vcol[vst * (st * 32 + (i & 3) + 8 * (i >> 2))];
            bf16x8 Rf[2][2];
#pragma unroll
            for (int st = 0; st < 2; ++st) { f32x16 acc;
#pragma unroll
                for (int i = 0; i < 16; ++i) acc[i] = 0.f;
#pragma unroll
                for (int kb = 0; kb < 8; ++kb) acc = MFMA32(gr_rowfrag(base + GR_K + st * 8192, po, kb), pack_step_v(S[kb >> 1], kb & 1), acc);
#pragma unroll
                for (int i = 0; i < 16; ++i) { const int s = st * 32 + crow16(i, hh); acc[i] = tab[64 + s] * (bf1(vraw[st][i]) - tab[128 + s] * acc[i]); }
                Rf[st][0] = pack_step(acc, 0); Rf[st][1] = pack_step(acc, 1); asm volatile("" ::: "memory"); }
            bf16x8 Vf[2][2];
#pragma unroll
            for (int ct = 0; ct < 2; ++ct) { f32x16 acc;
#pragma unroll
                for (int i = 0; i < 16; ++i) acc[i] = 0.f;
#pragma unroll
                for (int sb = 0; sb < 4; ++sb) if (sb < 2 * ct + 2) acc = MFMA32(*(const bf16x8*)(base + GR_T + ((ct * 4 + sb) * 64 + c.lane) * 16), Rf[sb >> 1][sb & 1], acc);
                Vf[ct][0] = pack_step(acc, 0); Vf[ct][1] = pack_step(acc, 1); }
            asm volatile("" ::: "memory");
#pragma unroll
            for (int ct = 0; ct < 2; ++ct) { f32x16 acc;
#pragma unroll
                for (int i = 0; i < 16; ++i) acc[i] = 0.f;
#pragma unroll
                for (int kb = 0; kb < 8; ++kb) acc = MFMA32(gr_rowfrag(base + GR_Q + ct * 8192, po, kb), pack_step_v(S[kb >> 1], kb & 1), acc);
#pragma unroll
                for (int i = 0; i < 16; ++i) acc[i] *= tab[128 + ct * 32 + crow16(i, hh)];
#pragma unroll
                for (int cb = 0; cb < 4; ++cb) if (cb < 2 * ct + 2) acc = MFMA32(*(const bf16x8*)(base + GR_A + ((ct * 4 + cb) * 64 + c.lane) * 16), Vf[cb >> 1][cb & 1], acc);
                if (n >= 4) {
#pragma unroll
                    for (int i = 0; i < 16; ++i) ocol[ost * (ct * 32 + (i & 3) + 8 * (i >> 2))] = (bf16)f2bf(acc[i]); }
                asm volatile("" ::: "memory"); }
            const float gtot = tab[128 + 63];
#pragma unroll
            for (int t = 0; t < 4; ++t) {
#pragma unroll
                for (int i = 0; i < 16; ++i) S[t][i] *= gtot;
#pragma unroll
                for (int cb = 0; cb < 4; ++cb) S[t] = MFMA32(*(const bf16x8*)(base + GR_KD + ((t * 4 + cb) * 64 + c.lane) * 16), Vf[cb >> 1][cb & 1], S[t]); }
        }
        if (c.wave >= 4) asm volatile("s_waitcnt vmcnt(0)" ::: "memory"); else asm volatile("s_waitcnt lgkmcnt(0)" ::: "memory");
        __builtin_amdgcn_s_barrier(); asm volatile("" ::: "memory");
    }
    asm volatile("s_waitcnt vmcnt(0)" ::: "memory"); __syncthreads();
}
__device__ __forceinline__ void phase_gdn_rec(const Ctx& c) { if (c.bid < 128) gdn_rec_block(c, c.bid >> 1, c.bid & 1); }

#define XB_TMO      128
#define XB_XCNT(j)  (256  + 64 * (j))
#define XB_XSUB(j)  (1280 + 64 * (j))
#define XB_XGEN(j)  (2304 + 64 * (j))
#define XB_TOP      3328
#define XB_TOPGEN   3392
#define XCD_BAR_WORDS 3456
#define XB_SPIN_CAP (1u << 20)
__device__ __forceinline__ unsigned xb_ld(unsigned* p)              { return __hip_atomic_load(p, __ATOMIC_RELAXED, __HIP_MEMORY_SCOPE_AGENT); }
__device__ __forceinline__ unsigned xb_add(unsigned* p, unsigned v) { return __hip_atomic_fetch_add(p, v, __ATOMIC_RELAXED, __HIP_MEMORY_SCOPE_AGENT); }
__device__ __forceinline__ unsigned xb_xcc_id() { return (unsigned)__builtin_amdgcn_s_getreg((3 << 11) | 20) & 0xFu; }
#define XB_SPIN(cond, bar) do { unsigned _sp = 0; while (cond) { __builtin_amdgcn_s_sleep(1); \
    if ((++_sp & 255u) == 0u) { if (xb_ld(&(bar)[XB_TMO])) break; if (_sp > XB_SPIN_CAP) { atomicAdd(&(bar)[XB_TMO], 1u); break; } } } } while (0)
struct XcdBarrier { unsigned* bar; unsigned x; volatile LAS unsigned* st; };
__device__ __forceinline__ XcdBarrier xcd_barrier_post(unsigned* bar, volatile LAS unsigned* st) {
    XcdBarrier b; b.bar = bar; b.x = xb_xcc_id(); b.st = st;
    if (threadIdx.x == 0) (void)xb_add(&bar[XB_XCNT(b.x)], 1u);
    return b;
}
__device__ __forceinline__ void xcd_barrier_complete(unsigned* bar, unsigned x, unsigned& nloc, unsigned& nx) {
    const unsigned G = gridDim.x * gridDim.y * gridDim.z;
    unsigned sum, cnt, mine, sp = 0u;
    for (;;) {
        sum = 0u; cnt = 0u; mine = 0u;
#pragma unroll
        for (unsigned j = 0; j < 16; ++j) { const unsigned c = xb_ld(&bar[XB_XCNT(j)]); sum += c; cnt += (c > 0u) ? 1u : 0u; mine = (j == x) ? c : mine; }
        if (sum == G) break;
        __builtin_amdgcn_s_sleep(1);
        if ((++sp & 255u) == 0u) { if (xb_ld(&bar[XB_TMO])) break; if (sp > XB_SPIN_CAP) { atomicAdd(&bar[XB_TMO], 1u); break; } }
    }
    nloc = mine > 0u ? mine : 1u; nx = cnt > 0u ? cnt : 1u;
}
__device__ __forceinline__ void xcd_barrier(const XcdBarrier& b) {
    asm volatile("s_waitcnt vmcnt(0)" ::: "memory");
    __syncthreads();
    if (threadIdx.x == 0) {
        unsigned* bar = b.bar;
        __builtin_amdgcn_s_waitcnt(0);
        unsigned nloc = b.st[0], nx = b.st[1];
        if (nloc == 0u) { xcd_barrier_complete(bar, b.x, nloc, nx); b.st[0] = nloc; b.st[1] = nx; }
        const unsigned old = xb_add(&bar[XB_XSUB(b.x)], 1u);
        const unsigned gen = old / nloc;
        if (old + 1u == (gen + 1u) * nloc) {
            __builtin_amdgcn_fence(__ATOMIC_RELEASE, "agent");
            asm volatile("s_waitcnt vmcnt(0)" ::: "memory");
            const unsigned og = xb_add(&bar[XB_TOP], 1u);
            const unsigned tg = og / nx;
            if (og + 1u == (tg + 1u) * nx) xb_add(&bar[XB_TOPGEN], 1u);
            else XB_SPIN(xb_ld(&bar[XB_TOPGEN]) == tg, bar);
            __builtin_amdgcn_fence(__ATOMIC_ACQUIRE, "agent");
            xb_add(&bar[XB_XGEN(b.x)], 1u);
            asm volatile("s_waitcnt vmcnt(0)" ::: "memory");
        } else {
            XB_SPIN(xb_ld(&bar[XB_XGEN(b.x)]) == gen, bar);
            __builtin_amdgcn_fence(__ATOMIC_ACQUIRE, "agent");
            asm volatile("s_waitcnt vmcnt(0)" ::: "memory");
        }
    }
    __syncthreads();
}

constexpr int LDS_MISC = LDS_BYTES - 64;
__global__ void __launch_bounds__(NTHREADS, 2) mk_fwd(Args args) {
    extern __shared__ __attribute__((aligned(16))) unsigned char lds[];
    Ctx c; c.a = &args; c.ws = args.ws; c.lds = lds;
    c.tid = threadIdx.x; c.lane = c.tid & 63; c.wave = __builtin_amdgcn_readfirstlane(c.tid >> 6); c.bid = blockIdx.x; c.G = gridDim.x;
    c.gw = c.bid * NWAVES + c.wave; c.NGW = c.G * NWAVES; c.gwv = c.wave * c.G + c.bid;
    const int lo = args.ph_lo, hi = args.ph_hi;
    PG8_LAS unsigned char* ring = (PG8_LAS unsigned char*)lds;
#ifndef MK_PH_MASK
#define MK_PH_MASK 0xffff
#endif
#define IN(k) (((MK_PH_MASK >> (k)) & 1) && lo <= (k) && (k) < hi)
#if MK_ONE_LAUNCH
    cg::grid_group grid = cg::this_grid();
    if (lo < 0) grid.sync();
    volatile LAS unsigned* st = (volatile LAS unsigned*)((LAS unsigned char*)lds + LDS_MISC);
    if (c.tid < 2) st[c.tid] = 0u;
    __syncthreads();
    const XcdBarrier bar = xcd_barrier_post((unsigned*)(c.ws + WS_CTL) + CW_BAR, st);
#define SEAM(k) do { if (IN(k) && IN((k) + 1)) xcd_barrier(bar); } while (0)
#else
#define SEAM(k) do { } while (0)
#endif
    if (IN(0)) { phase_prep(c); phase_s5_build(c); } SEAM(0);
    if (IN(1)) { phase_norm1(c); } SEAM(1);
    if (IN(2)) { pg8::Gemm g{(const pg8::bf16_t*)(c.ws + WS_HX), (const pg8::bf16_t*)(c.ws + WS_WIN), 1024, 1024, 1024}; pg8::StaticOrder S; S.init(MT, NPROJ, c.G, c.bid);
        pg8::EpiInProj E{(pg8::bf16_t*)(c.ws + WS_U5), (pg8::bf16_t*)(c.ws + WS_QKVPRE), (pg8::bf16_t*)(c.ws + WS_Z)};
        pg8::gemm_phase<pg8::EpiInProj, pg8::StaticOrder, true, true>(ring, g, S, E); } SEAM(2);
    if (IN(3)) { { pg8::Gemm g{(const pg8::bf16_t*)(c.ws + WS_U5), (const pg8::bf16_t*)(c.ws + WS_PM), 768, 512, 512}; pg8::SchedSS S{c.G, c.bid}; pg8::EpiSS E{(float*)(c.ws + WS_SS)};
          pg8::gemm_phase<pg8::EpiSS, pg8::SchedSS, true, true>(ring, g, S, E); }
        __syncthreads(); phase_conv(c); } SEAM(3);
    if (IN(4)) { for (int t = c.gwv; t < 512; t += c.NGW) s5_state_scan(c, t); __syncthreads(); phase_gdn_prep(c); } SEAM(4);
    if (IN(5)) { pg8::Gemm g{(const pg8::bf16_t*)(c.ws + WS_U5), (const pg8::bf16_t*)(c.ws + WS_BB), 768, 768, 768}; pg8::SchedS5Y S{c.G, c.bid}; pg8::EpiS5Y E{(pg8::bf16_t*)(c.ws + WS_YG)};
        pg8::gemm_phase<pg8::EpiS5Y, pg8::SchedS5Y, true, true>(ring, g, S, E); } SEAM(5);
    if (IN(6)) { if (c.bid < 128) phase_gdn_rec(c);
        else { pg8::Gemm g{(const pg8::bf16_t*)(c.ws + WS_YG), (const pg8::bf16_t*)(c.ws + WS_WGLU), 512, 512, 512}; pg8::StaticOrder S; S.init(ML, 512, c.G - 128, c.bid - 128);
            pg8::EpiGlu E{(const pg8::bf16_t*)(c.ws + WS_YG), (pg8::bf16_t*)(c.ws + WS_CAT)};
            pg8::gemm_phase<pg8::EpiGlu, pg8::StaticOrder, true, true>(ring, g, S, E); } } SEAM(6);
    if (IN(7)) { phase_combine(c); } SEAM(7);
    if (IN(8)) { pg8::Gemm g{(const pg8::bf16_t*)(c.ws + WS_CAT), (const pg8::bf16_t*)(c.ws + WS_WOUT), 1024, 1024, 1024}; pg8::StaticOrder S; S.init(ML, 1024, c.G, c.bid);
        pg8::EpiBf16<0> E{(pg8::bf16_t*)(c.ws + WS_YRAW), 1024, nullptr, 0, 0, 1.f};
        pg8::gemm_phase<pg8::EpiBf16<0>, pg8::StaticOrder, true, true>(ring, g, S, E); } SEAM(8);
    if (IN(9)) { phase_rows2(c); phase_fp8_tables(c); } SEAM(9);
    if (IN(10)) { pg8::Gemm g{(const pg8::bf16_t*)(c.ws + WS_HX2), (const pg8::bf16_t*)(c.ws + WS_WQ), 1024, 1024, 1024}; pg8::StaticOrder S; S.init(ML, 2048, c.G, c.bid);
        pg8::EpiBf16<0> E{(pg8::bf16_t*)(c.ws + WS_QP), 2048, nullptr, 0, 0, 1.f};
        pg8::gemm_phase<pg8::EpiBf16<0>, pg8::StaticOrder, true, true>(ring, g, S, E); } SEAM(10);
    if (IN(11)) { phase_topk(c); } SEAM(11);
    if (IN(12)) { phase_exp1(c); } SEAM(12);
    if (IN(13)) { phase_exp1b(c); } SEAM(13);
    if (IN(14)) { phase_exp2(c); } SEAM(14);
    if (IN(15)) { phase_exp3(c); }
#undef IN
#undef SEAM
}

extern "C" void kernel_launch(void* const* d_in, const int* in_sizes, int n_in, void* d_out, int out_size, void* d_ws, size_t ws_size, hipStream_t stream) {
    static int grid = 0;
    if (grid == 0) {
        if (n_in != 29 || out_size != ML * D || ws_size < WS_END) { fprintf(stderr, "kernel_launch: unexpected shapes (n_in %d out %d ws %zu)\n", n_in, out_size, ws_size); grid = -1; return; }
        int dev = 0, cus = 0, per_cu = 0;
        (void)hipGetDevice(&dev); (void)hipDeviceGetAttribute(&cus, hipDeviceAttributeMultiprocessorCount, dev);
        if (hipFuncSetAttribute((const void*)mk_fwd, hipFuncAttributeMaxDynamicSharedMemorySize, LDS_BYTES) != hipSuccess) { fprintf(stderr, "kernel_launch: hipFuncSetAttribute failed\n"); grid = -1; return; }
        (void)hipOccupancyMaxActiveBlocksPerMultiprocessor(&per_cu, (const void*)mk_fwd, NTHREADS, LDS_BYTES);
        (void)hipGetLastError();
        grid = cus;
        fprintf(stderr, "kernel_launch: cus %d per_cu %d grid %d\n", cus, per_cu, grid);
    }
    if (grid < 0) return;
    Args a{};
    for (int i = 0; i < 29; ++i) a.in[i] = (const float*)d_in[i];
    a.out = (float*)d_out; a.ws = (unsigned char*)d_ws;
    (void)hipMemsetAsync((char*)d_ws + WS_CTL, 0, CTL_ZERO_BYTES, stream);
#if MK_ONE_LAUNCH
    a.ph_lo = 0; a.ph_hi = NPHASES;
    void* kargs[] = {&a};
    hipError_t e = hipLaunchCooperativeKernel((const void*)mk_fwd, dim3(grid), dim3(NTHREADS), kargs, LDS_BYTES, stream);
    if (e != hipSuccess) fprintf(stderr, "kernel_launch: cooperative launch failed: %s\n", hipGetErrorString(e));
#else
    for (int ph = 0; ph < NPHASES; ++ph) { a.ph_lo = ph; a.ph_hi = ph + 1; hipLaunchKernelGGL(mk_fwd, dim3(grid), dim3(NTHREADS), LDS_BYTES, stream, a); }
#endif
}
```

```cpp
#include <hip/hip_runtime.h>
#include <hip/hip_cooperative_groups.h>
#include <cstdio>
#include <cstdint>
namespace cg = cooperative_groups;
namespace pg8 {
#define PG8_LAS __attribute__((address_space(3)))
typedef unsigned short bf16_t;
typedef short bf16x8 __attribute__((ext_vector_type(8)));
typedef float f32x4 __attribute__((ext_vector_type(4)));
typedef unsigned u32x4 __attribute__((ext_vector_type(4)));
constexpr int BM = 256, BK = 64, HALF = 128, HTB = HALF * BK * 2  , STAGE_BYTES = 8 * HTB, NXCD = 8, WGM = 8;

__host__ __device__ __forceinline__ int lds_byte(int r, int c) { const int st = (r >> 4) * 2 + (c >> 5), rr = r & 15, cc = c & 31, ob = rr * 64 + cc * 2; return st * 1024 + (ob ^ (((ob >> 9) & 1) << 5)); }
__host__ __device__ __forceinline__ void stage_rc(int b, int& R, int& C) { const int st = b / 1024, sb = b % 1024, swz = sb ^ (((sb >> 9) & 1) << 5); R = (st >> 1) * 16 + swz / 64; C = (st & 1) * 32 + (swz % 64) / 2; }
__host__ __device__ __forceinline__ int perm32(int rho) { const int n = rho >> 4, i = rho & 15; return 8 * (i >> 2) + 4 * n + (i & 3); }

struct Unit { int pm, pn; };
struct Gemm { const bf16_t* A; const bf16_t* Bt; int lda, ldb, K; };

struct StaticOrder {
    int nM, nN, nwg, G, c;
    __host__ __device__ void init(int M, int N, int G_, int c_) { nM = M / BM; nN = N / BM; nwg = nM * nN; G = G_; c = c_; }
    __host__ __device__ bool next(int i, Unit& u) const {
        const long L = (long)i * G + c; if (L >= nwg) return false;
        int wgid = (int)L; { const int q = nwg / NXCD, r = nwg % NXCD, xcd = wgid % NXCD, off = wgid / NXCD; wgid = (xcd < r ? xcd * (q + 1) : r * (q + 1) + (xcd - r) * q) + off; }
        const int nig = WGM * nN, gid = wgid / nig, fm = gid * WGM, gsz = (nM - fm) < WGM ? (nM - fm) : WGM;
        u.pm = fm + ((wgid % nig) % gsz); u.pn = (wgid % nig) / gsz; return true;
    }
    __device__ __forceinline__ void a_ready(const Unit&) const {}
    __device__ __forceinline__ void done(const Unit&) const {}
};

__device__ __forceinline__ unsigned cvt_pk_bf16(float lo, float hi) { unsigned r; asm volatile("v_cvt_pk_bf16_f32 %0, %1, %2" : "=v"(r) : "v"(lo), "v"(hi)); return r; }
typedef float f32x2 __attribute__((ext_vector_type(2)));
__device__ __forceinline__ f32x2 gelu_pk(f32x2 v) {
    const f32x2 av = __builtin_elementwise_abs(v), d = av * 0.2316418882f + 1.0f;
    f32x2 t; t.x = __builtin_amdgcn_rcpf(d.x); t.y = __builtin_amdgcn_rcpf(d.y);
    f32x2 q = t * 0.5307027145f + (-0.7265760135f); q = q * t + 0.7107068705f; q = q * t + (-0.142248368f); q = q * t + 0.127414796f; q = q * t;
    const f32x2 s = (v * v) * (-0.72134752044f);
    f32x2 e; e.x = __builtin_amdgcn_exp2f(s.x); e.y = __builtin_amdgcn_exp2f(s.y);
    const f32x2 m = v * (q * e), r = v - m;
    f32x2 o; o.x = v.x < 0.f ? m.x : r.x; o.y = v.y < 0.f ? m.y : r.y; return o;
}

template <int ACT  > struct EpiBf16 {
    static constexpr bool PERM = true, AFTER_DRAIN = false; static_assert(ACT == 0 || ACT == 1, "EpiBf16: ACT is 0 (none) or 1 (gelu_pk)");
    bf16_t* O; int ldc; const float* bias; int split_cols; size_t split_stride; float scale0;
    __device__ __forceinline__ void operator()(const f32x4 (&acc)[2][2][4][2], const Unit& u, int wr, int wc, int fr, int fq) const {
        const int row0 = u.pm * BM + wr * 64 + fr; int colt = u.pn * BM; bf16_t* base = O;
        float sc = 1.f; if (split_cols) { const int t = colt / split_cols; base += (size_t)t * split_stride; colt -= t * split_cols; if (t == 0) sc = scale0; }
        const int col0 = colt + wc * 32 + 8 * fq, bcol0 = u.pn * BM + wc * 32 + 8 * fq;
        f32x4 bv[2][2];
#pragma unroll
        for (int bj = 0; bj < 2; ++bj)
#pragma unroll
            for (int n = 0; n < 2; ++n) bv[bj][n] = bias ? *(const f32x4*)(bias + bcol0 + bj * HALF + 4 * n) : (f32x4){0.f, 0.f, 0.f, 0.f};
#pragma unroll
        for (int ai = 0; ai < 2; ++ai)
#pragma unroll
            for (int m = 0; m < 4; ++m) { bf16_t* rowp = base + (size_t)(row0 + ai * HALF + m * 16) * ldc + col0;
#pragma unroll
                for (int bj = 0; bj < 2; ++bj) { f32x4 v0 = acc[ai][bj][m][0] + bv[bj][0], v1 = acc[ai][bj][m][1] + bv[bj][1];
                    if (ACT == 1) { f32x2 a = gelu_pk((f32x2){v0[0], v0[1]}), b = gelu_pk((f32x2){v0[2], v0[3]}), c = gelu_pk((f32x2){v1[0], v1[1]}), d = gelu_pk((f32x2){v1[2], v1[3]});
                        v0 = (f32x4){a.x, a.y, b.x, b.y}; v1 = (f32x4){c.x, c.y, d.x, d.y}; }
                    v0 = v0 * sc; v1 = v1 * sc; u32x4 w; w.x = cvt_pk_bf16(v0[0], v0[1]); w.y = cvt_pk_bf16(v0[2], v0[3]); w.z = cvt_pk_bf16(v1[0], v1[1]); w.w = cvt_pk_bf16(v1[2], v1[3]);
                    *(u32x4*)(rowp + bj * HALF) = w; } }
    }
};

template <class Epi, class Sched, bool ALIGN_EPI = false, bool SP2 = false>
__device__ __forceinline__ void gemm_phase(PG8_LAS unsigned char* lds, const Gemm g, const Sched& S, const Epi& E) {
    const int tid = threadIdx.x, wid = __builtin_amdgcn_readfirstlane(tid >> 6), lane = tid & 63, wr = wid >> 2, wc = wid & 3, fr = lane & 15, fq = lane >> 4;
    const int K = g.K, nt = K / BK;
    unsigned voffA[2], voffB[2];
#pragma unroll
    for (int i = 0; i < 2; ++i) { int R, C; stage_rc(tid * 16 + i * 8192, R, C); const int Rb = Epi::PERM ? ((R & ~31) + perm32(R & 31)) : R;
        voffA[i] = (unsigned)(R * g.lda + C) * 2u; voffB[i] = (unsigned)(Rb * g.ldb + C) * 2u; }
    const size_t kstep = (size_t)(BK * 2);
    const size_t hstepA = (size_t)HALF * g.lda * 2, hstepB = (size_t)HALF * g.ldb * 2;
    const size_t tstepA = 2 * hstepA, tstepB = 2 * hstepB;
    const unsigned ldsw = (unsigned)wid * 1024u;
    const int aoff = lds_byte(wr * 64 + fr, fq * 8), boff = lds_byte(wc * 32 + fr, fq * 8);
#define PG8_SA(b, h) (((b) * 2 + (h)) * HTB)
#define PG8_SB(b, h) ((4 + (b) * 2 + (h)) * HTB)
#define PG8_STAGE(bufoff, gbase, voff) do { _Pragma("unroll") for (int _i = 0; _i < 2; ++_i) \
        __builtin_amdgcn_global_load_lds((const unsigned*)((const char*)(gbase) + (voff)[_i]), (PG8_LAS unsigned*)(lds + (bufoff) + ldsw + _i * 8192), 16, 0, 0); } while (0)
#define PG8_LDA(dst, b, h) do { _Pragma("unroll") for (int m = 0; m < 4; ++m) _Pragma("unroll") for (int k = 0; k < 2; ++k) dst[m][k] = *(const PG8_LAS bf16x8*)(lds + PG8_SA(b, h) + aoff + m * 2048 + k * 1024); } while (0)
#define PG8_LDB(dst, b, h) do { _Pragma("unroll") for (int n = 0; n < 2; ++n) _Pragma("unroll") for (int k = 0; k < 2; ++k) dst[n][k] = *(const PG8_LAS bf16x8*)(lds + PG8_SB(b, h) + boff + n * 2048 + k * 1024); } while (0)
#define PG8_MMA(ai, bj, At, Bt) do { __builtin_amdgcn_s_setprio(1); _Pragma("unroll") for (int m = 0; m < 4; ++m) _Pragma("unroll") for (int n = 0; n < 2; ++n) _Pragma("unroll") for (int k = 0; k < 2; ++k) \
        acc[ai][bj][m][n] = __builtin_amdgcn_mfma_f32_16x16x32_bf16(Bt[n][k], At[m][k], acc[ai][bj][m][n], 0, 0, 0); __builtin_amdgcn_s_setprio(0); } while (0)
#define PG8_WAIT_V(n) asm volatile("s_waitcnt vmcnt(" #n ")" ::: "memory")
#define PG8_WAIT_L(n) asm volatile("s_waitcnt lgkmcnt(" #n ")" ::: "memory")
#define PG8_BAR __builtin_amdgcn_s_barrier()
#define PG8_SCHED __builtin_amdgcn_sched_barrier(0)
    Unit cur, nxt; int ui = 0;
    if (!S.next(0, cur)) return;
    f32x4 acc[2][2][4][2];
#pragma unroll
    for (int a = 0; a < 2; ++a)
#pragma unroll
        for (int b = 0; b < 2; ++b)
#pragma unroll
            for (int m = 0; m < 4; ++m)
#pragma unroll
                for (int n = 0; n < 2; ++n) acc[a][b][m][n] = (f32x4){0.f, 0.f, 0.f, 0.f};
    bf16x8 At[4][2], B0[2][2], B1[2][2];
    const char* cA = (const char*)g.A + (size_t)cur.pm * tstepA; const char* cB = (const char*)g.Bt + (size_t)cur.pn * tstepB;
    S.a_ready(cur);
    if constexpr (SP2) {
        PG8_STAGE(PG8_SB(0, 0), cB, voffB); PG8_STAGE(PG8_SB(0, 1), cB + hstepB, voffB); PG8_STAGE(PG8_SA(0, 0), cA, voffA); PG8_STAGE(PG8_SA(0, 1), cA + hstepA, voffA);
        if (wr == 1) PG8_BAR;
        PG8_WAIT_V(2); PG8_BAR;
        PG8_STAGE(PG8_SB(1, 0), cB + kstep, voffB); PG8_STAGE(PG8_SA(1, 0), cA + kstep, voffA); PG8_STAGE(PG8_SB(1, 1), cB + hstepB + kstep, voffB);
        PG8_WAIT_V(6); PG8_BAR;
    } else {
        PG8_STAGE(PG8_SB(0, 0), cB, voffB); PG8_STAGE(PG8_SA(0, 0), cA, voffA); PG8_STAGE(PG8_SB(0, 1), cB + hstepB, voffB); PG8_STAGE(PG8_SA(0, 1), cA + hstepA, voffA);
        if (wr == 1) PG8_BAR;
        PG8_WAIT_V(4); PG8_BAR;
        PG8_STAGE(PG8_SB(1, 0), cB + kstep, voffB); PG8_STAGE(PG8_SA(1, 0), cA + kstep, voffA); PG8_STAGE(PG8_SB(1, 1), cB + hstepB + kstep, voffB);
        PG8_WAIT_V(6); PG8_BAR;
    }
    for (;;) {
        const bool has_next = S.next(ui + 1, nxt);
        const char* nA = has_next ? (const char*)g.A + (size_t)nxt.pm * tstepA : cA; const char* nB = has_next ? (const char*)g.Bt + (size_t)nxt.pn * tstepB : cB;
        for (int t = 0; t < nt; t += 2) {
            const bool last = (t == nt - 2);
            const char* a1 = cA + (size_t)(t + 1) * kstep;
            const char* a2 = last ? nA : cA + (size_t)(t + 2) * kstep; const char* b2 = last ? nB : cB + (size_t)(t + 2) * kstep;
            const char* a3 = a2 + kstep; const char* b3 = b2 + kstep;
            if (last && has_next) S.a_ready(nxt);
            if constexpr (SP2) {
            PG8_LDB(B0, 0, 0); PG8_LDB(B1, 0, 1); PG8_SCHED; PG8_LDA(At, 0, 0); PG8_STAGE(PG8_SA(1, 1), a1 + hstepA, voffA);
            PG8_WAIT_V(8); PG8_WAIT_L(0); PG8_BAR; PG8_MMA(0, 0, At, B0); PG8_MMA(0, 1, At, B1); PG8_BAR; PG8_SCHED;
            PG8_LDA(At, 0, 1); PG8_STAGE(PG8_SB(0, 0), b2, voffB); PG8_STAGE(PG8_SB(0, 1), b2 + hstepB, voffB); PG8_STAGE(PG8_SA(0, 0), a2, voffA);
            PG8_WAIT_V(8); PG8_WAIT_L(0); PG8_BAR; PG8_MMA(1, 0, At, B0); PG8_MMA(1, 1, At, B1); PG8_BAR; PG8_SCHED;
            PG8_LDB(B0, 1, 0); PG8_LDB(B1, 1, 1); PG8_SCHED; PG8_LDA(At, 1, 0); PG8_STAGE(PG8_SA(0, 1), a2 + hstepA, voffA);
            PG8_WAIT_V(8); PG8_WAIT_L(0); PG8_BAR; PG8_MMA(0, 0, At, B0); PG8_MMA(0, 1, At, B1); PG8_BAR; PG8_SCHED;
            PG8_LDA(At, 1, 1); PG8_STAGE(PG8_SB(1, 0), b3, voffB); PG8_STAGE(PG8_SB(1, 1), b3 + hstepB, voffB); PG8_STAGE(PG8_SA(1, 0), a3, voffA);
            PG8_WAIT_V(8); PG8_WAIT_L(0); PG8_BAR; PG8_MMA(1, 0, At, B0); PG8_MMA(1, 1, At, B1); PG8_BAR; PG8_SCHED;
            } else {
            PG8_LDB(B0, 0, 0); PG8_SCHED; PG8_LDA(At, 0, 0); PG8_STAGE(PG8_SA(1, 1), a1 + hstepA, voffA);
            PG8_WAIT_L(8); PG8_BAR; PG8_WAIT_L(0); PG8_MMA(0, 0, At, B0); PG8_BAR; PG8_SCHED;
            PG8_LDB(B1, 0, 1); PG8_STAGE(PG8_SB(0, 0), b2, voffB);
            PG8_BAR; PG8_WAIT_L(0); PG8_MMA(0, 1, At, B1); PG8_BAR;
            PG8_LDA(At, 0, 1); PG8_STAGE(PG8_SA(0, 0), a2, voffA);
            PG8_BAR; PG8_WAIT_L(0); PG8_MMA(1, 0, At, B0); PG8_BAR; PG8_SCHED;
            PG8_STAGE(PG8_SB(0, 1), b2 + hstepB, voffB);
            PG8_WAIT_V(6); PG8_BAR; PG8_MMA(1, 1, At, B1); PG8_BAR;
            PG8_LDB(B0, 1, 0); PG8_SCHED; PG8_LDA(At, 1, 0); PG8_STAGE(PG8_SA(0, 1), a2 + hstepA, voffA);
            PG8_WAIT_L(8); PG8_BAR; PG8_WAIT_L(0); PG8_MMA(0, 0, At, B0); PG8_BAR; PG8_SCHED;
            PG8_LDB(B1, 1, 1); PG8_STAGE(PG8_SB(1, 0), b3, voffB);
            PG8_BAR; PG8_WAIT_L(0); PG8_MMA(0, 1, At, B1); PG8_BAR;
            PG8_LDA(At, 1, 1); PG8_STAGE(PG8_SA(1, 0), a3, voffA);
            PG8_BAR; PG8_WAIT_L(0); PG8_MMA(1, 0, At, B0); PG8_BAR; PG8_SCHED;
            PG8_STAGE(PG8_SB(1, 1), b3 + hstepB, voffB);
            PG8_WAIT_V(6); PG8_BAR; PG8_MMA(1, 1, At, B1); PG8_BAR;
            }
        }
        if constexpr (ALIGN_EPI) { if (wr == 0) PG8_BAR; }
        if constexpr (!Epi::AFTER_DRAIN) { E(acc, cur, wr, wc, fr, fq); S.done(cur); }
        if (!has_next) break;
#pragma unroll
        for (int a = 0; a < 2; ++a)
#pragma unroll
            for (int b = 0; b < 2; ++b)
#pragma unroll
                for (int m = 0; m < 4; ++m)
#pragma unroll
                    for (int n = 0; n < 2; ++n) acc[a][b][m][n] = (f32x4){0.f, 0.f, 0.f, 0.f};
        cur = nxt; cA = nA; cB = nB; ++ui;
        if constexpr (ALIGN_EPI) { if (wr == 1) PG8_BAR; }
    }
    PG8_WAIT_V(0);
    if constexpr (!ALIGN_EPI) { if (wr == 0) PG8_BAR; }
    PG8_BAR;
    if constexpr (Epi::AFTER_DRAIN) { E.fused(acc, cur, wr, wc, fr, fq, lds, wid, lane); S.done(cur); }
#undef PG8_SA
#undef PG8_SB
#undef PG8_STAGE
#undef PG8_LDA
#undef PG8_LDB
#undef PG8_MMA
#undef PG8_WAIT_V
#undef PG8_WAIT_L
#undef PG8_BAR
#undef PG8_SCHED
}
}

#ifndef MK_EXP_OLD
#define MK_EXP_OLD 0
#endif
#ifndef MK_ONE_LAUNCH
#define MK_ONE_LAUNCH 1
#endif
#define LAS __attribute__((address_space(3)))
typedef unsigned short bf16;
typedef unsigned v4u __attribute__((ext_vector_type(4)));
typedef unsigned v2u __attribute__((ext_vector_type(2)));
typedef float f32x4 __attribute__((ext_vector_type(4)));
typedef float f32x2 __attribute__((ext_vector_type(2)));
typedef short bf16x8 __attribute__((ext_vector_type(8)));
typedef float f32x16 __attribute__((ext_vector_type(16)));
#define MFMA32(a, b, c) __builtin_amdgcn_mfma_f32_32x32x16_bf16((a), (b), (c), 0, 0, 0)

constexpr int D = 1024, NB = 8, SEQ = 2048, LC = 256, ML = NB * SEQ  , MC = NB * LC  , MT = ML + MC  ;
constexpr int PROJ = 2576, NPROJ = 2560;
constexpr int NEXP = 16384, TOPK = 16, KK = 128;
constexpr float EPS = 1e-6f;
constexpr int NTHREADS = 512, NWAVES = 8;
constexpr int LDS_BYTES = 147456;
constexpr int NPHASES = 16;

constexpr size_t MiB = 1u << 20;
constexpr size_t WS_CTL = 0;
constexpr size_t CTL_ZERO_BYTES = 65536;
constexpr int CW_BAR = 0;
constexpr int CW_E1 = 4096, CW_E2 = 4096 + 8 * 64;
constexpr size_t WS_MOD = 1 * MiB;
constexpr size_t WS_LP = 1 * MiB + 512 * 1024;
constexpr size_t WS_WIN = 2 * MiB;
constexpr size_t WS_WOUT = 8 * MiB;
constexpr size_t WS_WGLU = 10 * MiB;
constexpr size_t WS_WQ = 11 * MiB;
constexpr size_t WS_GB = 15 * MiB;
constexpr size_t WS_BB = 17 * MiB;
constexpr size_t WS_PM = 41 * MiB;
constexpr size_t WS_OG = 17 * MiB;
constexpr size_t WS_HX2 = 17 * MiB;
constexpr size_t WS_U5 = 49 * MiB;
constexpr size_t WS_CAT = 49 * MiB;
constexpr size_t WS_IDX = 49 * MiB;
constexpr size_t WS_GATE = 57 * MiB;
constexpr size_t WS_ACT = 65 * MiB;
constexpr size_t WS_SSQP = 73 * MiB;
constexpr size_t WS_Z = 85 * MiB;
constexpr size_t WS_YRAW = 85 * MiB;
constexpr size_t WS_QP = 85 * MiB;
constexpr size_t WS_Y = 85 * MiB;
constexpr size_t WS_HX = 101 * MiB;
constexpr size_t WS_SS = 101 * MiB;
constexpr size_t WS_YG = 101 * MiB;
constexpr size_t WS_FRT = 125 * MiB;
constexpr size_t WS_QKVPRE = 137 * MiB;
constexpr size_t WS_FRA = 143 * MiB;
constexpr size_t WS_FRK = 161 * MiB;
constexpr size_t WS_FRTAB = 197 * MiB;
constexpr size_t WS_QKV = 202 * MiB;
constexpr size_t WS_U8 = 202 * MiB;
constexpr size_t WS_V8 = 218 * MiB;
constexpr size_t WS_USC = 234 * MiB;
constexpr size_t WS_VSC = 234 * MiB + 512 * 1024;
constexpr size_t WS_HQ8 = 150 * MiB;
constexpr size_t WS_HS = 183 * MiB;
constexpr size_t WS_PACT = 85 * MiB;
constexpr size_t WS_END = 256 * MiB;
static_assert(WS_BB + (size_t)32 * 512 * 768 * 2 <= WS_PM && WS_PM + (size_t)32 * 256 * 512 * 2 <= WS_U5 && WS_U5 + (size_t)32 * 768 * 768 * 2 <= WS_Z && WS_Z + (size_t)ML * 512 * 2 <= WS_HX, "ws map a");
static_assert(WS_HX + (size_t)MT * D * 2 <= WS_QKVPRE && WS_SS + (size_t)32 * 768 * 256 * 4 <= WS_FRT && WS_QKVPRE + (size_t)MT * 1536 * 2 <= WS_QKV && WS_QKV + (size_t)MT * 1536 * 2 <= WS_END, "ws map b");
static_assert(WS_FRT + (size_t)2304 * 8192 <= WS_FRA && WS_FRA + (size_t)2304 * 8192 <= WS_FRK && WS_FRK + (size_t)2304 * 16384 <= WS_FRTAB && WS_FRTAB + (size_t)2304 * 1024 <= WS_QKV, "ws map c");
static_assert(WS_OG + (size_t)2 * ML * 512 * 2 <= WS_CAT && WS_CAT + (size_t)ML * D * 2 <= WS_Z && WS_YRAW + (size_t)ML * D * 4 <= WS_U8 && WS_SSQP + (size_t)8 * ML * 4 <= WS_Z && WS_YG + (size_t)ML * 512 * 2 <= WS_FRT, "ws map d");

__device__ __forceinline__ unsigned f2bf(float f) { unsigned u = __builtin_bit_cast(unsigned, f); return (u + 0x7fffu + ((u >> 16) & 1u)) >> 16; }
typedef __bf16 bf16x2_t __attribute__((ext_vector_type(2)));
__device__ __forceinline__ unsigned pk2(float lo, float hi) { const f32x2 v = {lo, hi}; return __builtin_bit_cast(unsigned, __builtin_convertvector(v, bf16x2_t)); }
__device__ __forceinline__ float bflo(unsigned w) { return __builtin_bit_cast(float, w << 16); }
__device__ __forceinline__ float bfhi(unsigned w) { return __builtin_bit_cast(float, w & 0xffff0000u); }
__device__ __forceinline__ float bf1(bf16 h) { return __builtin_bit_cast(float, (unsigned)h << 16); }
__device__ __forceinline__ float wave_sum(float v) {
#pragma unroll
    for (int o = 1; o < 64; o <<= 1) v += __shfl_xor(v, o);
    return v;
}
__device__ __forceinline__ float wave_max(float v) {
#pragma unroll
    for (int o = 1; o < 64; o <<= 1) v = fmaxf(v, __shfl_xor(v, o));
    return v;
}
__device__ __forceinline__ float sigmoidf_(float x) { return 1.f / (1.f + __expf(-x)); }
__device__ __forceinline__ float siluf_(float x) { return x / (1.f + __expf(-x)); }
__device__ __forceinline__ float gelu_erf(float x) { return 0.5f * x * (1.f + erff(x * 0.70710678118654752f)); }
__device__ __forceinline__ void sincos_d(double a, float& s, float& c) {
    const double k = rint(a * 0.63661977236758134308);
    const double r = fma(-k, 1.57079632679489661923, a) - k * 6.123233995736766e-17;
    const double r2 = r * r;
    double sp = -2.5052108385441720e-08; sp = sp * r2 + 2.7557319223985893e-06; sp = sp * r2 - 1.9841269841269841e-04; sp = sp * r2 + 8.3333333333333332e-03; sp = sp * r2 - 1.6666666666666666e-01;
    const double sn = r + r * r2 * sp;
    double cp = 2.0876756987868099e-09; cp = cp * r2 - 2.7557319223985888e-07; cp = cp * r2 + 2.4801587301587302e-05; cp = cp * r2 - 1.3888888888888889e-03; cp = cp * r2 + 4.1666666666666664e-02; cp = cp * r2 - 0.5;
    const double cs = 1.0 + r2 * cp;
    const int q = ((int)k) & 3;
    const double ss = (q == 0) ? sn : (q == 1) ? cs : (q == 2) ? -sn : -cs;
    const double cc = (q == 0) ? cs : (q == 1) ? -sn : (q == 2) ? -cs : sn;
    s = (float)ss; c = (float)cc;
}

struct Args { const float* in[29]; float* out; unsigned char* ws; int ph_lo, ph_hi; };
static_assert(sizeof(Args) == 29 * 8 + 8 + 8 + 8, "Args has no padding");
enum { I_X = 0, I_C, I_CTX, I_CCTX, I_WMOD, I_BMOD, I_GPREMIX, I_GPOSTMIX, I_GPREFFN, I_GPOSTFFN, I_WIN, I_WOUT, I_LAMRE, I_LAMIM, I_LOGDT, I_BRE, I_BIM, I_CRE, I_CIM, I_S5D, I_WGLU,
       I_CONV, I_ALOG, I_DTBIAS, I_GDNNORM, I_WQ, I_KEYS, I_PU, I_PV };

__device__ __forceinline__ const float* in_row(const Args& a, int row) { return row < ML ? a.in[I_X] + (size_t)row * D : a.in[I_CTX] + (size_t)(row - ML) * D; }
__device__ __forceinline__ int mod_row(int row) { return row < ML ? (row >> 11) : 8; }

template <int CTRL> __device__ __forceinline__ float dppf(float v) { return __builtin_bit_cast(float, __builtin_amdgcn_update_dpp(0, __builtin_bit_cast(int, v), CTRL, 0xf, 0xf, true)); }
__device__ __forceinline__ float row_sum16(float v) { v += dppf<0xB1>(v); v += dppf<0x4E>(v); v += dppf<0x141>(v); v += dppf<0x140>(v); return v; }
__device__ __forceinline__ float row_max16(float v) { v = fmaxf(v, dppf<0xB1>(v)); v = fmaxf(v, dppf<0x4E>(v)); v = fmaxf(v, dppf<0x141>(v)); v = fmaxf(v, dppf<0x140>(v)); return v; }
__device__ __forceinline__ float wsum(float v) { v = row_sum16(v); return
    __builtin_bit_cast(float, __builtin_amdgcn_readlane(__builtin_bit_cast(int, v), 0)) + __builtin_bit_cast(float, __builtin_amdgcn_readlane(__builtin_bit_cast(int, v), 16)) +
    __builtin_bit_cast(float, __builtin_amdgcn_readlane(__builtin_bit_cast(int, v), 32)) + __builtin_bit_cast(float, __builtin_amdgcn_readlane(__builtin_bit_cast(int, v), 48)); }
__device__ __forceinline__ float wmax(float v) { v = row_max16(v); return fmaxf(fmaxf(__builtin_bit_cast(float, __builtin_amdgcn_readlane(__builtin_bit_cast(int, v), 0)), __builtin_bit_cast(float, __builtin_amdgcn_readlane(__builtin_bit_cast(int, v), 16))),
    fmaxf(__builtin_bit_cast(float, __builtin_amdgcn_readlane(__builtin_bit_cast(int, v), 32)), __builtin_bit_cast(float, __builtin_amdgcn_readlane(__builtin_bit_cast(int, v), 48)))); }
__device__ __forceinline__ int lane_rank(unsigned long long m) { return __builtin_amdgcn_mbcnt_hi((unsigned)(m >> 32), __builtin_amdgcn_mbcnt_lo((unsigned)m, 0)); }
__device__ __forceinline__ unsigned fkey(float f) { const unsigned u = __builtin_bit_cast(unsigned, f); return u ^ ((unsigned)((int)u >> 31) | 0x80000000u); }
#define WAVE_LDS_SYNC() do { __builtin_amdgcn_fence(__ATOMIC_RELEASE, "wavefront"); __builtin_amdgcn_wave_barrier(); __builtin_amdgcn_fence(__ATOMIC_ACQUIRE, "wavefront"); } while (0)
template <int N> __device__ __forceinline__ unsigned kth_key(const unsigned (&k)[N], int K) {
    unsigned T = 0;
    for (int bit = 31; bit >= 0; --bit) { const unsigned cand = T | (1u << bit); int cnt = 0;
#pragma unroll
        for (int n = 0; n < N; ++n) cnt += __popcll(__ballot(k[n] >= cand));
        if (cnt >= K) T = cand;
        if (cnt == K) break; }
    return T;
}

namespace pg8 {
struct EpiInProj {
    static constexpr bool PERM = true, AFTER_DRAIN = false;
    bf16_t* U; bf16_t* QKV; bf16_t* Z;
    __device__ __forceinline__ void operator()(const f32x4 (&acc)[2][2][4][2], const Unit& u, int wr, int wc, int fr, int fq) const {
        bf16_t* base; int ld, colt; bool lat_only = false;
        const bool s5 = u.pn < 2;
        if (s5) { base = U; ld = 0; colt = u.pn * BM; }
        else if (u.pn < 8) { base = QKV; ld = 1536; colt = (u.pn - 2) * BM; }
        else { base = Z; ld = 512; colt = (u.pn - 8) * BM; lat_only = true; }
        const int row0 = u.pm * BM + wr * 64 + fr, col0 = colt + wc * 32 + 8 * fq;
#pragma unroll
        for (int ai = 0; ai < 2; ++ai)
#pragma unroll
            for (int m = 0; m < 4; ++m) { const int row = row0 + ai * HALF + m * 16; bf16_t* rowp = base + (size_t)row * ld + col0;
                if (lat_only && row >= 16384) continue;
                if (s5) { const int R = row < 16384 ? (row >> 5) : 512 + ((row - 16384) >> 5), ii = row & 31; rowp = base + (size_t)R * 768 + ii * 16 + (col0 & 15); }
#pragma unroll
                for (int bj = 0; bj < 2; ++bj) { const f32x4 v0 = acc[ai][bj][m][0], v1 = acc[ai][bj][m][1];
                    u32x4 w; w.x = cvt_pk_bf16(v0[0], v0[1]); w.y = cvt_pk_bf16(v0[2], v0[3]); w.z = cvt_pk_bf16(v1[0], v1[1]); w.w = cvt_pk_bf16(v1[2], v1[3]);
                    if (s5) *(u32x4*)(rowp + (size_t)((col0 + bj * HALF) >> 4) * (768 * 768)) = w; else *(u32x4*)(rowp + bj * HALF) = w; } }
    }
};
struct EpiGlu {
    static constexpr bool PERM = true, AFTER_DRAIN = false;
    const bf16_t* YG; bf16_t* CAT;
    __device__ __forceinline__ void operator()(const f32x4 (&acc)[2][2][4][2], const Unit& u, int wr, int wc, int fr, int fq) const {
        const int row0 = u.pm * BM + wr * 64 + fr, col0 = u.pn * BM + wc * 32 + 8 * fq;
#pragma unroll
        for (int ai = 0; ai < 2; ++ai)
#pragma unroll
            for (int m = 0; m < 4; ++m) { const int row = row0 + ai * HALF + m * 16;
#pragma unroll
                for (int bj = 0; bj < 2; ++bj) { const f32x4 v0 = acc[ai][bj][m][0], v1 = acc[ai][bj][m][1];
                    const u32x4 y = *(const u32x4*)(YG + (size_t)row * 512 + col0 + bj * HALF);
                    float o[8]; const float a[8] = {v0[0], v0[1], v0[2], v0[3], v1[0], v1[1], v1[2], v1[3]};
                    const unsigned yw[4] = {y.x, y.y, y.z, y.w};
#pragma unroll
                    for (int e = 0; e < 8; ++e) { const float yv = __builtin_bit_cast(float, (e & 1) ? (yw[e >> 1] & 0xffff0000u) : (yw[e >> 1] << 16)); o[e] = yv / (1.f + __expf(-a[e])); }
                    u32x4 w; w.x = cvt_pk_bf16(o[0], o[1]); w.y = cvt_pk_bf16(o[2], o[3]); w.z = cvt_pk_bf16(o[4], o[5]); w.w = cvt_pk_bf16(o[6], o[7]);
                    *(u32x4*)(CAT + (size_t)row * 1024 + col0 + bj * HALF) = w; } }
    }
};
struct EpiF32 {
    static constexpr bool PERM = false, AFTER_DRAIN = false;
    float* C; int ldc;
    __device__ __forceinline__ void operator()(const f32x4 (&acc)[2][2][4][2], const Unit& u, int wr, int wc, int fr, int fq) const {
        const int row0 = u.pm * BM + wr * 64 + fr, col0 = u.pn * BM + wc * 32 + 4 * fq;
#pragma unroll
        for (int ai = 0; ai < 2; ++ai)
#pragma unroll
            for (int m = 0; m < 4; ++m) { float* rowp = C + (size_t)(row0 + ai * HALF + m * 16) * ldc + col0;
#pragma unroll
                for (int bj = 0; bj < 2; ++bj)
#pragma unroll
                    for (int n = 0; n < 2; ++n) *(f32x4*)(rowp + bj * HALF + n * 16) = acc[ai][bj][m][n]; }
    }
};
struct EpiSS {
    static constexpr bool PERM = false, AFTER_DRAIN = false;
    float* C;
    __device__ __forceinline__ void operator()(const f32x4 (&acc)[2][2][4][2], const Unit& u, int wr, int wc, int fr, int fq) const {
        const int row0 = u.pm * BM + wr * 64 + fr, col0 = wc * 32 + 4 * fq;
#pragma unroll
        for (int ai = 0; ai < 2; ++ai)
#pragma unroll
            for (int m = 0; m < 4; ++m) { float* rowp = C + (size_t)(row0 + ai * HALF + m * 16) * 256 + col0;
#pragma unroll
                for (int bj = 0; bj < 2; ++bj)
#pragma unroll
                    for (int n = 0; n < 2; ++n) *(f32x4*)(rowp + bj * HALF + n * 16) = acc[ai][bj][m][n]; }
    }
};
struct SchedSS { int G, c; __device__ bool next(int i, Unit& u) const { const int L = i * G + c; if (L >= 96) return false; u.pm = L; u.pn = L / 3; return true; }
    __device__ __forceinline__ void a_ready(const Unit&) const {} __device__ __forceinline__ void done(const Unit&) const {} };
struct EpiS5Y {
    static constexpr bool PERM = true, AFTER_DRAIN = false;
    bf16_t* YG;
    __device__ __forceinline__ void operator()(const f32x4 (&acc)[2][2][4][2], const Unit& u, int wr, int wc, int fr, int fq) const {
        const int g = u.pn >> 1, R0 = (u.pm - 3 * g) * BM + wr * 64 + fr, n0 = (u.pn & 1) * BM + wc * 32 + 8 * fq;
#pragma unroll
        for (int ai = 0; ai < 2; ++ai)
#pragma unroll
            for (int m = 0; m < 4; ++m) { const int R = R0 + ai * HALF + m * 16;
#pragma unroll
                for (int bj = 0; bj < 2; ++bj) { const int n = n0 + bj * HALF; const f32x4 v0 = acc[ai][bj][m][0], v1 = acc[ai][bj][m][1];
                    const f32x2 a = gelu_pk((f32x2){v0[0], v0[1]}), b = gelu_pk((f32x2){v0[2], v0[3]}), c2 = gelu_pk((f32x2){v1[0], v1[1]}), d = gelu_pk((f32x2){v1[2], v1[3]});
                    u32x4 w; w.x = cvt_pk_bf16(a.x, a.y); w.y = cvt_pk_bf16(b.x, b.y); w.z = cvt_pk_bf16(c2.x, c2.y); w.w = cvt_pk_bf16(d.x, d.y);
                    *(u32x4*)(YG + (size_t)(R * 32 + (n >> 4)) * 512 + g * 16 + (n & 15)) = w; } }
    }
};
struct SchedS5Y { int G, c; __device__ bool next(int i, Unit& u) const { const int L = i * G + c; if (L >= 128) return false; const int g = L >> 2; u.pm = 3 * g + ((L >> 1) & 1); u.pn = 2 * g + (L & 1); return true; }
    __device__ __forceinline__ void a_ready(const Unit&) const {} __device__ __forceinline__ void done(const Unit&) const {} };
}

struct Ctx { const Args* a; unsigned char* ws; unsigned char* lds; int tid, lane, wave, bid, G, gw, NGW, gwv; };

__device__ __forceinline__ void p0_transpose_item(const float* W, int ldw, int nblk, int K, bf16* WT, float* scr, int item, int lane) {
    const int kb = item / nblk, nb = item % nblk, k0 = 64 * kb, n0 = 32 * nb;
#pragma unroll 8
    for (int i = 0; i < 32; ++i) { const int kk = 2 * i + (lane >> 5); scr[kk * 33 + (lane & 31)] = W[(size_t)(k0 + kk) * ldw + n0 + (lane & 31)]; }
    __builtin_amdgcn_fence(__ATOMIC_RELEASE, "wavefront"); __builtin_amdgcn_wave_barrier(); __builtin_amdgcn_fence(__ATOMIC_ACQUIRE, "wavefront");
    const int c = lane & 7;
#pragma unroll
    for (int j = 0; j < 4; ++j) { const int n = (lane >> 3) + 8 * j; const float* s = scr + (8 * c) * 33 + n;
        v4u o; o.x = pk2(s[0 * 33], s[1 * 33]); o.y = pk2(s[2 * 33], s[3 * 33]); o.z = pk2(s[4 * 33], s[5 * 33]); o.w = pk2(s[6 * 33], s[7 * 33]);
        *(v4u*)(WT + (size_t)(n0 + n) * K + k0 + 8 * c) = o; }
    __builtin_amdgcn_fence(__ATOMIC_RELEASE, "wavefront"); __builtin_amdgcn_wave_barrier(); __builtin_amdgcn_fence(__ATOMIC_ACQUIRE, "wavefront");
}
__device__ __forceinline__ void phase_prep(const Ctx& c) {
    const Args& a = *c.a;
    float* scr = (float*)(c.lds + c.wave * 16384);
    constexpr int I_IN = 16 * 80, I_OUT = 16 * 32, I_GLU = 8 * 16, I_Q = 16 * 64;
    for (int it = c.gw; it < I_IN + I_OUT + I_GLU + I_Q; it += c.NGW) {
        int r = it;
        if (r < I_IN) { p0_transpose_item(a.in[I_WIN], PROJ, 80, 1024, (bf16*)(c.ws + WS_WIN), scr, r, c.lane); continue; } r -= I_IN;
        if (r < I_OUT) { p0_transpose_item(a.in[I_WOUT], 1024, 32, 1024, (bf16*)(c.ws + WS_WOUT), scr, r, c.lane); continue; } r -= I_OUT;
        if (r < I_GLU) { p0_transpose_item(a.in[I_WGLU], 512, 16, 512, (bf16*)(c.ws + WS_WGLU), scr, r, c.lane); continue; } r -= I_GLU;
        p0_transpose_item(a.in[I_WQ], 2048, 64, 1024, (bf16*)(c.ws + WS_WQ), scr, r, c.lane);
    }
    __syncthreads();
    float* sc = (float*)c.lds;
    float* red = (float*)(c.lds + 9 * 1024 * 4);
    float* MOD = (float*)(c.ws + WS_MOD);
    bool have = false;
    for (int item = c.bid; item < 96; item += c.G) {
        if (!have) { for (int i = c.tid; i < 9 * 1024; i += NTHREADS) { const int r = i >> 10, k = i & 1023; const float v = r < 8 ? a.in[I_C][r * 1024 + k] : a.in[I_CCTX][k]; sc[i] = siluf_(v); } have = true; __syncthreads(); }
        const int n0 = item * 64;
        float acc[9];
#pragma unroll
        for (int r = 0; r < 9; ++r) acc[r] = 0.f;
        const float* wp = a.in[I_WMOD] + (size_t)(c.wave * 128) * 6144 + n0 + c.lane;
#pragma unroll 16
        for (int k = 0; k < 128; ++k) { const float w = wp[(size_t)k * 6144];
#pragma unroll
            for (int r = 0; r < 9; ++r) acc[r] = fmaf(sc[r * 1024 + c.wave * 128 + k], w, acc[r]); }
#pragma unroll
        for (int r = 0; r < 9; ++r) red[(c.wave * 9 + r) * 64 + c.lane] = acc[r];
        __syncthreads();
        for (int i = c.tid; i < 576; i += NTHREADS) { const int r = i >> 6, l = i & 63; float s = a.in[I_BMOD][n0 + l];
#pragma unroll
            for (int w = 0; w < 8; ++w) s += red[(w * 9 + r) * 64 + l];
            MOD[r * 6144 + n0 + l] = s; }
        __syncthreads();
    }
}
__device__ __forceinline__ void s5_build_group(const Ctx& c, int g, int part);
__device__ __forceinline__ void phase_s5_build(const Ctx& c) { for (int it = c.G - 1 - c.bid; it < 128; it += c.G) if (it >= 0) s5_build_group(c, it >> 2, it & 3); }

__device__ __forceinline__ void phase_norm1(const Ctx& c) {
    const Args& a = *c.a;
    float* wabT = (float*)c.lds;
    { f32x4 wv[8];
#pragma unroll
      for (int q = 0; q < 8; ++q) { const int i = c.tid + NTHREADS * q, kk = i >> 2, qq = i & 3; wv[q] = *(const f32x4*)(a.in[I_WIN] + (size_t)kk * PROJ + NPROJ + 4 * qq); }
#pragma unroll
      for (int q = 0; q < 8; ++q) { const int i = c.tid + NTHREADS * q, kk = i >> 2, qq = i & 3; wabT[(4 * qq + 0) * 1028 + kk] = wv[q].x; wabT[(4 * qq + 1) * 1028 + kk] = wv[q].y; wabT[(4 * qq + 2) * 1028 + kk] = wv[q].z; wabT[(4 * qq + 3) * 1028 + kk] = wv[q].w; } }
    __syncthreads();
    const float* MOD = (const float*)(c.ws + WS_MOD);
    bf16* HX = (bf16*)(c.ws + WS_HX); float* GB = (float*)(c.ws + WS_GB);
    const float* gpre = a.in[I_GPREMIX];
    f32x4 nx[4];
    if (c.gw < MT) { const f32x4* xr = (const f32x4*)in_row(a, c.gw) + c.lane;
#pragma unroll
        for (int j = 0; j < 4; ++j) nx[j] = xr[64 * j]; }
    for (int row = c.gw; row < MT; row += c.NGW) {
        const float* mr = MOD + mod_row(row) * 6144;
        f32x4 v[4]; float ss = 0.f;
#pragma unroll
        for (int j = 0; j < 4; ++j) { v[j] = nx[j]; ss += (v[j].x * v[j].x + v[j].y * v[j].y) + (v[j].z * v[j].z + v[j].w * v[j].w); }
        if (row + c.NGW < MT) { const f32x4* xr = (const f32x4*)in_row(a, row + c.NGW) + c.lane;
#pragma unroll
            for (int j = 0; j < 4; ++j) nx[j] = xr[64 * j]; }
        const float r = rsqrtf(wsum(ss) * (1.f / D) + EPS);
#pragma unroll
        for (int j = 0; j < 4; ++j) { const int col = 4 * c.lane + 256 * j;
            const f32x4 g4 = *(const f32x4*)(gpre + col), sh = *(const f32x4*)(mr + col), scl = *(const f32x4*)(mr + 1024 + col);
            v[j] = (v[j] * r) * g4 * (scl + 1.f) + sh;
            v2u o; o.x = pk2(v[j].x, v[j].y); o.y = pk2(v[j].z, v[j].w);
            *(v2u*)(HX + (size_t)row * D + col) = o; }
        float pj[16];
#pragma unroll
        for (int j = 0; j < 16; ++j) { float s = 0.f;
#pragma unroll
            for (int jj = 0; jj < 4; ++jj) { const f32x4 w = *(const f32x4*)(wabT + j * 1028 + 4 * c.lane + 256 * jj); s += (v[jj].x * w.x + v[jj].y * w.y) + (v[jj].z * w.z + v[jj].w * w.w); }
            pj[j] = s; if ((j & 1) == 1) asm volatile("" ::: "memory"); }
        const bool b5 = c.lane & 32, b4 = c.lane & 16, b3 = c.lane & 8, b2 = c.lane & 4;
        float q8[8], q4[4], q2[2];
#pragma unroll
        for (int i = 0; i < 8; ++i) { const float keep = b5 ? pj[i + 8] : pj[i], send = b5 ? pj[i] : pj[i + 8]; q8[i] = keep + __shfl_xor(send, 32); }
#pragma unroll
        for (int i = 0; i < 4; ++i) { const float keep = b4 ? q8[i + 4] : q8[i], send = b4 ? q8[i] : q8[i + 4]; q4[i] = keep + __shfl_xor(send, 16); }
#pragma unroll
        for (int i = 0; i < 2; ++i) { const float keep = b3 ? q4[i + 2] : q4[i], send = b3 ? q4[i] : q4[i + 2]; q2[i] = keep + dppf<0x140>(send); }
        float mine; { const float keep = b2 ? q2[1] : q2[0], send = b2 ? q2[0] : q2[1]; mine = keep + dppf<0x141>(send); }
        mine += dppf<0xB1>(mine); mine += dppf<0x4E>(mine);
        const int jl = (b5 ? 8 : 0) + (b4 ? 4 : 0) + (b3 ? 2 : 0) + (b2 ? 1 : 0);
        if ((c.lane & 3) == 0) {
            if (jl < 8) { const float t = mine + a.in[I_DTBIAS][jl]; const float sp = t > 20.f ? t : log1pf(expf(t)); GB[(size_t)row * 16 + jl] = -expf(a.in[I_ALOG][jl]) * sp; }
            else GB[(size_t)row * 16 + jl] = 1.f / (1.f + expf(-mine)); }
    }
}

__device__ __forceinline__ void phase_conv(const Ctx& c) {
    const Args& a = *c.a;
    const bf16* PRE = (const bf16*)(c.ws + WS_QKVPRE); bf16* OUT = (bf16*)(c.ws + WS_QKV);
    const float* cw = a.in[I_CONV];
#pragma unroll 1
    for (int pass = 0; pass < 3; ++pass) { const int ch0 = pass * 512 + 8 * c.lane;
        f32x4 wt[9][2];
#pragma unroll
        for (int i = 0; i < 9; ++i) { wt[i][0] = *(const f32x4*)(cw + i * 1536 + ch0); wt[i][1] = *(const f32x4*)(cw + i * 1536 + ch0 + 4); }
#define CONV_LOAD(DST, ROW) do { const int row_ = (ROW); int nb_row[9]; bool ok[9]; \
            if (row_ < ML) { const int t = row_ & 2047, gr = t >> 6, gc = t & 63; \
                _Pragma("unroll") for (int dy = -1; dy <= 1; ++dy) _Pragma("unroll") for (int dx = -1; dx <= 1; ++dx) { const int i = (dy + 1) * 3 + dx + 1; ok[i] = (gr + dy >= 0) && (gr + dy < 32) && (gc + dx >= 0) && (gc + dx < 64); nb_row[i] = row_ + dy * 64 + dx; } } \
            else { const int t = (row_ - ML) & 255; _Pragma("unroll") for (int i = 0; i < 9; ++i) { ok[i] = false; nb_row[i] = row_; } \
                _Pragma("unroll") for (int dx = -1; dx <= 1; ++dx) { ok[4 + dx] = (t + dx >= 0) && (t + dx < 256); nb_row[4 + dx] = row_ + dx; } } \
            _Pragma("unroll") for (int i = 0; i < 9; ++i) DST[i] = ok[i] ? *(const v4u*)(PRE + (size_t)nb_row[i] * 1536 + ch0) : (v4u){0u, 0u, 0u, 0u}; } while (0)
        v4u nin[9];
        if (c.gw < MT) CONV_LOAD(nin, c.gw);
#pragma unroll 1
        for (int row = c.gw; row < MT; row += c.NGW) {
            v4u in[9];
#pragma unroll
            for (int i = 0; i < 9; ++i) in[i] = nin[i];
            if (row + c.NGW < MT) CONV_LOAD(nin, row + c.NGW);
            float o[8];
#pragma unroll
            for (int q = 0; q < 8; ++q) o[q] = 0.f;
#pragma unroll
            for (int i = 0; i < 9; ++i) { const unsigned w[4] = {in[i].x, in[i].y, in[i].z, in[i].w}; const float kk[8] = {wt[i][0].x, wt[i][0].y, wt[i][0].z, wt[i][0].w, wt[i][1].x, wt[i][1].y, wt[i][1].z, wt[i][1].w};
#pragma unroll
                for (int q = 0; q < 4; ++q) { o[2 * q] = fmaf(bflo(w[q]), kk[2 * q], o[2 * q]); o[2 * q + 1] = fmaf(bfhi(w[q]), kk[2 * q + 1], o[2 * q + 1]); } }
            float ssq = 0.f;
#pragma unroll
            for (int q = 0; q < 8; ++q) { o[q] = siluf_(o[q]); ssq = fmaf(o[q], o[q], ssq); }
            if (pass < 2) { const float sc = rsqrtf(row_sum16(ssq) + EPS) * (pass == 0 ? 0.08838834764831845f : 1.f);
#pragma unroll
                for (int q = 0; q < 8; ++q) o[q] *= sc; }
            v4u ov; ov.x = pk2(o[0], o[1]); ov.y = pk2(o[2], o[3]); ov.z = pk2(o[4], o[5]); ov.w = pk2(o[6], o[7]);
            *(v4u*)(OUT + (size_t)row * 1536 + ch0) = ov;
        }
#undef CONV_LOAD
    }
}

__device__ __forceinline__ int scan_row(int b, int dir, int step) {
    if (step < LC) { const int t = dir ? LC - 1 - step : step; return ML + b * LC + t; }
    const int t = step - LC; return b * SEQ + (dir ? SEQ - 1 - t : t);
}
__device__ __forceinline__ void phase_combine(const Ctx& c) {
    const Args& a = *c.a;
    const bf16* OG0 = (const bf16*)(c.ws + WS_OG); const bf16* OG1 = OG0 + (size_t)ML * 512; const bf16* Z = (const bf16*)(c.ws + WS_Z);
    bf16* CAT = (bf16*)(c.ws + WS_CAT);
    for (int row = c.gw; row < ML; row += c.NGW) {
#pragma unroll
        for (int h = 0; h < 4; ++h) { const int ch = h * 128 + 2 * c.lane;
            const unsigned w0 = *(const unsigned*)(OG0 + (size_t)row * 512 + ch), w1 = *(const unsigned*)(OG1 + (size_t)row * 512 + ch), zw = *(const unsigned*)(Z + (size_t)row * 512 + ch);
            const float o0 = bflo(w0) + bflo(w1), o1 = bfhi(w0) + bfhi(w1);
            const float r = rsqrtf(wave_sum(o0 * o0 + o1 * o1) * (1.f / 128.f) + EPS);
            const f32x2 ng = *(const f32x2*)(a.in[I_GDNNORM] + 2 * c.lane);
            *(unsigned*)(CAT + (size_t)row * 1024 + 512 + ch) = pk2(o0 * r * ng.x * siluf_(bflo(zw)), o1 * r * ng.y * siluf_(bfhi(zw))); }
    }
}

__device__ __forceinline__ void phase_rows2(const Ctx& c) {
    const Args& a = *c.a;
    const float* MOD = (const float*)(c.ws + WS_MOD); const bf16* YRAW = (const bf16*)(c.ws + WS_YRAW); bf16* HX2 = (bf16*)(c.ws + WS_HX2);
    v2u ny[4]; f32x4 nxx[4];
    if (c.gw < ML) {
#pragma unroll
        for (int j = 0; j < 4; ++j) { ny[j] = *((const v2u*)(YRAW + (size_t)c.gw * D) + c.lane + 64 * j); nxx[j] = *((const f32x4*)(a.in[I_X] + (size_t)c.gw * D) + c.lane + 64 * j); } }
    for (int row = c.gw; row < ML; row += c.NGW) {
        const float* mr = MOD + (row >> 11) * 6144;
        f32x4 y[4], x[4]; float ss = 0.f;
#pragma unroll
        for (int j = 0; j < 4; ++j) { y[j] = (f32x4){bflo(ny[j].x), bfhi(ny[j].x), bflo(ny[j].y), bfhi(ny[j].y)}; x[j] = nxx[j];
            ss += (y[j].x * y[j].x + y[j].y * y[j].y) + (y[j].z * y[j].z + y[j].w * y[j].w); }
        if (row + c.NGW < ML) { const size_t r2 = (size_t)(row + c.NGW);
#pragma unroll
            for (int j = 0; j < 4; ++j) { ny[j] = *((const v2u*)(YRAW + r2 * D) + c.lane + 64 * j); nxx[j] = *((const f32x4*)(a.in[I_X] + r2 * D) + c.lane + 64 * j); } }
        const float r = rsqrtf(wsum(ss) * (1.f / D) + EPS); float s2 = 0.f;
#pragma unroll
        for (int j = 0; j < 4; ++j) { const int col = 4 * c.lane + 256 * j;
            const f32x4 g4 = *(const f32x4*)(a.in[I_GPOSTMIX] + col), gt = *(const f32x4*)(mr + 2048 + col);
            x[j] = x[j] + gt * ((y[j] * r) * g4);
            *(f32x4*)(a.out + (size_t)row * D + col) = x[j];
            s2 += (x[j].x * x[j].x + x[j].y * x[j].y) + (x[j].z * x[j].z + x[j].w * x[j].w); }
        const float r2 = rsqrtf(wsum(s2) * (1.f / D) + EPS);
#pragma unroll
        for (int j = 0; j < 4; ++j) { const int col = 4 * c.lane + 256 * j;
            const f32x4 g4 = *(const f32x4*)(a.in[I_GPREFFN] + col), sh = *(const f32x4*)(mr + 3072 + col), scl = *(const f32x4*)(mr + 4096 + col);
            const f32x4 hv = (x[j] * r2) * g4 * (scl + 1.f) + sh;
            v2u o; o.x = pk2(hv.x, hv.y); o.y = pk2(hv.z, hv.w);
            *(v2u*)(HX2 + (size_t)row * D + col) = o;
            x[j] = (f32x4){bflo(o.x), bfhi(o.x), bflo(o.y), bfhi(o.y)}; }
        { float mx = 0.f;
#pragma unroll
          for (int j = 0; j < 4; ++j) mx = fmaxf(mx, fmaxf(fmaxf(fabsf(x[j].x), fabsf(x[j].y)), fmaxf(fabsf(x[j].z), fabsf(x[j].w))));
          mx = wmax(mx); const float hs = mx > 0.f ? 256.f / mx : 1.f;
          unsigned char* hq = c.ws + WS_HQ8 + (size_t)row * 2048;
#pragma unroll
          for (int j = 0; j < 4; ++j) { const float a0 = x[j].x * hs, a1 = x[j].y * hs, a2 = x[j].z * hs, a3 = x[j].w * hs;
              int w = __builtin_amdgcn_cvt_pk_fp8_f32(a0, a1, 0, false); w = __builtin_amdgcn_cvt_pk_fp8_f32(a2, a3, w, true);
              const f32x2 b01 = __builtin_amdgcn_cvt_pk_f32_fp8(w, false), b23 = __builtin_amdgcn_cvt_pk_f32_fp8(w, true);
              int w2 = __builtin_amdgcn_cvt_pk_fp8_f32((a0 - b01.x) * 16.f, (a1 - b01.y) * 16.f, 0, false); w2 = __builtin_amdgcn_cvt_pk_fp8_f32((a2 - b23.x) * 16.f, (a3 - b23.y) * 16.f, w2, true);
              *(unsigned*)(hq + 4 * c.lane + 256 * j) = (unsigned)w; *(unsigned*)(hq + 1024 + 4 * c.lane + 256 * j) = (unsigned)w2; }
          if (c.lane == 0) ((float*)(c.ws + WS_HS))[row] = 1.f / hs; }
    }
}


constexpr int KROW = 136;
__device__ __forceinline__ float unfkey(unsigned k) { const unsigned u = (k & 0x80000000u) ? (k ^ 0x80000000u) : ~k; return __builtin_bit_cast(float, u); }
__device__ __forceinline__ void ins16(unsigned (&L)[16], unsigned key) {
#pragma unroll
    for (int q = 0; q < 16; ++q) { const unsigned hi = L[q] > key ? L[q] : key, lo = L[q] > key ? key : L[q]; L[q] = hi; key = lo; }
}
__device__ __forceinline__ void merge16(unsigned (&L)[16]) {
    unsigned R[16];
#pragma unroll
    for (int q = 0; q < 16; ++q) R[q] = (unsigned)__shfl_xor((int)L[15 - q], 32);
#pragma unroll
    for (int q = 0; q < 16; ++q) L[q] = L[q] > R[q] ? L[q] : R[q];
#pragma unroll
    for (int j = 8; j >= 1; j >>= 1)
#pragma unroll
        for (int q = 0; q < 16; ++q) if ((q & j) == 0) { const unsigned hi = L[q] > L[q + j] ? L[q] : L[q + j], lo = L[q] > L[q + j] ? L[q + j] : L[q]; L[q] = hi; L[q + j] = lo; }
}
__device__ __forceinline__ void phase_topk(const Ctx& c) {
    const Args& a = *c.a;
    bf16* kl = (bf16*)c.lds;
    unsigned char* wtab = c.lds + 2 * 128 * KROW * 2 + c.wave * 1088;
    const bf16* QP = (const bf16*)(c.ws + WS_QP); int* IDX = (int*)(c.ws + WS_IDX); float* GATE = (float*)(c.ws + WS_GATE);
    const int r = c.lane & 31, hh = c.lane >> 5;
    { const unsigned char ptab[50] = {0, 1, 2, 3, 4, 5, 6, 7, 8, 9, 10, 11, 12, 13, 14, 15, 16, 17, 18, 19, 20, 21, 22, 23, 32, 33, 34, 35, 36, 48, 49, 50, 51, 64, 65, 66, 80, 81, 96, 97, 112, 113, 128, 144, 160, 176, 192, 208, 224, 240};
      if (c.lane < 50) wtab[1024 + c.lane] = ptab[c.lane < 50 ? c.lane : 0]; }
    for (int item = c.bid; item < 8 * 32; item += c.G) {
        const int h = item & 7, tr = item >> 3;
        __syncthreads();
        for (int i = c.tid; i < 2 * 128 * 64; i += NTHREADS) { const int k2 = i & 63, n = (i >> 6) & 127, p = i >> 13; const f32x2 kv = *(const f32x2*)(a.in[I_KEYS] + ((size_t)((h * 2 + p) * 128 + n)) * 128 + 2 * k2);
            *(unsigned*)(kl + (p * 128 + n) * KROW + 2 * k2) = pk2(kv.x, kv.y); }
        __syncthreads();
        for (int tile = c.wave; tile < 16; tile += NWAVES) {
            const int tok = tr * 512 + tile * 32 + r;
            unsigned LA[16], LB[16];
#pragma unroll
            for (int p = 0; p < 2; ++p) {
                bf16x8 qf[8];
#pragma unroll
                for (int kk = 0; kk < 8; ++kk) qf[kk] = *(const bf16x8*)(QP + (size_t)tok * 2048 + h * 256 + p * 128 + kk * 16 + hh * 8);
                f32x16 acc[4];
#pragma unroll
                for (int nt = 0; nt < 4; ++nt)
#pragma unroll
                    for (int i = 0; i < 16; ++i) acc[nt][i] = 0.f;
#pragma unroll
                for (int kk = 0; kk < 8; ++kk)
#pragma unroll
                    for (int nt = 0; nt < 4; ++nt) acc[nt] = MFMA32(*(const bf16x8*)(kl + (p * 128 + nt * 32 + r) * KROW + kk * 16 + hh * 8), qf[kk], acc[nt]);
                unsigned (&L)[16] = p ? LB : LA;
#pragma unroll
                for (int q = 0; q < 16; ++q) L[q] = 0u;
#pragma unroll
                for (int nt = 0; nt < 4; ++nt)
#pragma unroll
                    for (int i = 0; i < 16; ++i) { const int n = nt * 32 + (i & 3) + 8 * (i >> 2) + 4 * hh; ins16(L, (fkey(acc[nt][i]) & ~127u) | (unsigned)(127 - n)); }
                merge16(L);
            }
            unsigned char* tt = wtab + r * 32;
            if (hh == 0) {
#pragma unroll
                for (int q = 0; q < 16; ++q) tt[q] = (unsigned char)(127u - (LA[q] & 127u)); }
            else {
#pragma unroll
                for (int q = 0; q < 16; ++q) tt[16 + q] = (unsigned char)(127u - (LB[q] & 127u)); }
            float va[16], vb[16];
#pragma unroll
            for (int q = 0; q < 16; ++q) { va[q] = unfkey(LA[q] & ~127u); vb[q] = unfkey(LB[q] & ~127u); }
            unsigned LC[16];
#pragma unroll
            for (int q = 0; q < 16; ++q) LC[q] = 0u;
            { const float s0 = va[0] + vb[0], s1 = va[0] + vb[1]; ins16(LC, (fkey(hh ? s1 : s0) & ~63u) | (unsigned)(63 - (0 + hh))); }
            { const float s0 = va[0] + vb[2], s1 = va[0] + vb[3]; ins16(LC, (fkey(hh ? s1 : s0) & ~63u) | (unsigned)(63 - (2 + hh))); }
            { const float s0 = va[0] + vb[4], s1 = va[0] + vb[5]; ins16(LC, (fkey(hh ? s1 : s0) & ~63u) | (unsigned)(63 - (4 + hh))); }
            { const float s0 = va[0] + vb[6], s1 = va[0] + vb[7]; ins16(LC, (fkey(hh ? s1 : s0) & ~63u) | (unsigned)(63 - (6 + hh))); }
            { const float s0 = va[0] + vb[8], s1 = va[0] + vb[9]; ins16(LC, (fkey(hh ? s1 : s0) & ~63u) | (unsigned)(63 - (8 + hh))); }
            { const float s0 = va[0] + vb[10], s1 = va[0] + vb[11]; ins16(LC, (fkey(hh ? s1 : s0) & ~63u) | (unsigned)(63 - (10 + hh))); }
            { const float s0 = va[0] + vb[12], s1 = va[0] + vb[13]; ins16(LC, (fkey(hh ? s1 : s0) & ~63u) | (unsigned)(63 - (12 + hh))); }
            { const float s0 = va[0] + vb[14], s1 = va[0] + vb[15]; ins16(LC, (fkey(hh ? s1 : s0) & ~63u) | (unsigned)(63 - (14 + hh))); }
            { const float s0 = va[1] + vb[0], s1 = va[1] + vb[1]; ins16(LC, (fkey(hh ? s1 : s0) & ~63u) | (unsigned)(63 - (16 + hh))); }
            { const float s0 = va[1] + vb[2], s1 = va[1] + vb[3]; ins16(LC, (fkey(hh ? s1 : s0) & ~63u) | (unsigned)(63 - (18 + hh))); }
            { const float s0 = va[1] + vb[4], s1 = va[1] + vb[5]; ins16(LC, (fkey(hh ? s1 : s0) & ~63u) | (unsigned)(63 - (20 + hh))); }
            { const float s0 = va[1] + vb[6], s1 = va[1] + vb[7]; ins16(LC, (fkey(hh ? s1 : s0) & ~63u) | (unsigned)(63 - (22 + hh))); }
            { const float s0 = va[2] + vb[0], s1 = va[2] + vb[1]; ins16(LC, (fkey(hh ? s1 : s0) & ~63u) | (unsigned)(63 - (24 + hh))); }
            { const float s0 = va[2] + vb[2], s1 = va[2] + vb[3]; ins16(LC, (fkey(hh ? s1 : s0) & ~63u) | (unsigned)(63 - (26 + hh))); }
            { const float s0 = va[2] + vb[4], s1 = va[3] + vb[0]; ins16(LC, (fkey(hh ? s1 : s0) & ~63u) | (unsigned)(63 - (28 + hh))); }
            { const float s0 = va[3] + vb[1], s1 = va[3] + vb[2]; ins16(LC, (fkey(hh ? s1 : s0) & ~63u) | (unsigned)(63 - (30 + hh))); }
            { const float s0 = va[3] + vb[3], s1 = va[4] + vb[0]; ins16(LC, (fkey(hh ? s1 : s0) & ~63u) | (unsigned)(63 - (32 + hh))); }
            { const float s0 = va[4] + vb[1], s1 = va[4] + vb[2]; ins16(LC, (fkey(hh ? s1 : s0) & ~63u) | (unsigned)(63 - (34 + hh))); }
            { const float s0 = va[5] + vb[0], s1 = va[5] + vb[1]; ins16(LC, (fkey(hh ? s1 : s0) & ~63u) | (unsigned)(63 - (36 + hh))); }
            { const float s0 = va[6] + vb[0], s1 = va[6] + vb[1]; ins16(LC, (fkey(hh ? s1 : s0) & ~63u) | (unsigned)(63 - (38 + hh))); }
            { const float s0 = va[7] + vb[0], s1 = va[7] + vb[1]; ins16(LC, (fkey(hh ? s1 : s0) & ~63u) | (unsigned)(63 - (40 + hh))); }
            { const float s0 = va[8] + vb[0], s1 = va[9] + vb[0]; ins16(LC, (fkey(hh ? s1 : s0) & ~63u) | (unsigned)(63 - (42 + hh))); }
            { const float s0 = va[10] + vb[0], s1 = va[11] + vb[0]; ins16(LC, (fkey(hh ? s1 : s0) & ~63u) | (unsigned)(63 - (44 + hh))); }
            { const float s0 = va[12] + vb[0], s1 = va[13] + vb[0]; ins16(LC, (fkey(hh ? s1 : s0) & ~63u) | (unsigned)(63 - (46 + hh))); }
            { const float s0 = va[14] + vb[0], s1 = va[15] + vb[0]; ins16(LC, (fkey(hh ? s1 : s0) & ~63u) | (unsigned)(63 - (48 + hh))); }
            merge16(LC);
            WAVE_LDS_SYNC();
            float ev[16]; float den = 0.f; const float mx = unfkey(LC[0] & ~63u);
#pragma unroll
            for (int q = 0; q < 16; ++q) { ev[q] = __expf(unfkey(LC[q] & ~63u) - mx); den += ev[q]; }
            const float inv = 1.f / den;
            if (hh == 0) { int ex[16];
#pragma unroll
                for (int q = 0; q < 16; ++q) { const unsigned pc = wtab[1024 + (63u - (LC[q] & 63u))]; ex[q] = (int)tt[pc >> 4] * 128 + (int)tt[16 + (pc & 15u)]; }
#pragma unroll
                for (int q = 0; q < 4; ++q) *(v4u*)(IDX + (size_t)tok * 128 + h * 16 + 4 * q) = (v4u){(unsigned)ex[4 * q], (unsigned)ex[4 * q + 1], (unsigned)ex[4 * q + 2], (unsigned)ex[4 * q + 3]}; }
            else {
#pragma unroll
                for (int q = 0; q < 4; ++q) *(f32x4*)(GATE + (size_t)tok * 128 + h * 16 + 4 * q) = (f32x4){ev[4 * q] * inv, ev[4 * q + 1] * inv, ev[4 * q + 2] * inv, ev[4 * q + 3] * inv}; }
            WAVE_LDS_SYNC();
        }
    }
}

__device__ __forceinline__ void phase_fp8_tables(const Ctx& c) {
    const Args& a = *c.a;
    for (int r = c.gw; r < 2 * NEXP; r += c.NGW) {
        const bool isv = r >= NEXP; const int e = isv ? r - NEXP : r;
        const f32x4* src = (const f32x4*)((isv ? a.in[I_PV] : a.in[I_PU]) + (size_t)e * D) + 4 * c.lane;
        f32x4 v[4]; float m = 0.f;
#pragma unroll
        for (int j = 0; j < 4; ++j) { v[j] = src[j]; m = fmaxf(m, fmaxf(fmaxf(fabsf(v[j].x), fabsf(v[j].y)), fmaxf(fabsf(v[j].z), fabsf(v[j].w)))); }
        m = wmax(m); const float inv = m > 0.f ? 256.f / m : 0.f;
        v4u o; unsigned ow[4];
#pragma unroll
        for (int j = 0; j < 4; ++j) { int w = __builtin_amdgcn_cvt_pk_fp8_f32(v[j].x * inv, v[j].y * inv, 0, false); w = __builtin_amdgcn_cvt_pk_fp8_f32(v[j].z * inv, v[j].w * inv, w, true); ow[j] = (unsigned)w; }
        o.x = ow[0]; o.y = ow[1]; o.z = ow[2]; o.w = ow[3];
        *(v4u*)(c.ws + (isv ? WS_V8 : WS_U8) + (size_t)e * D + 16 * c.lane) = o;
        if (c.lane == 0) ((float*)(c.ws + (isv ? WS_VSC : WS_USC)))[e] = m * (1.f / 256.f);
    }
}
__device__ __forceinline__ void fp8x16_to_f32(const v4u& r, float (&f)[16]) {
    const unsigned w[4] = {r.x, r.y, r.z, r.w};
#pragma unroll
    for (int j = 0; j < 4; ++j) { const f32x2 lo = __builtin_amdgcn_cvt_pk_f32_fp8((int)w[j], false), hi = __builtin_amdgcn_cvt_pk_f32_fp8((int)w[j], true); f[4 * j] = lo.x; f[4 * j + 1] = lo.y; f[4 * j + 2] = hi.x; f[4 * j + 3] = hi.y; }
}
__device__ __forceinline__ unsigned xcc_id() { return (unsigned)__builtin_amdgcn_s_getreg((3 << 11) | 20) & 7u; }

typedef long l64x2 __attribute__((ext_vector_type(2)));
struct E1Bat { l64x2 rw[16]; };
__device__ __forceinline__ void phase_exp1(const Ctx& c) {
    typedef float f32x4m __attribute__((ext_vector_type(4)));
    const int* IDX = (const int*)(c.ws + WS_IDX); const unsigned char* U8 = c.ws + WS_U8; float* PACT = (float*)(c.ws + WS_PACT);
    unsigned* cnt = (unsigned*)(c.ws + WS_CTL) + CW_E1;
    constexpr int CH = 8;
    constexpr int SROW = 144;
    unsigned char* wl = c.lds + c.wave * 11776; int* le = (int*)wl; unsigned char* himg = wl + 4096; float* res = (float*)(wl + 6144); unsigned char* stage = wl + 6656;
    const int xcc = (int)xcc_id(), r16 = c.lane & 15, g4 = c.lane >> 4, row8 = c.lane >> 3, pc8 = c.lane & 7; const bool bcol = r16 < 2;
    int bo = 0; unsigned tq = 0;
    if (c.lane == 0) tq = __hip_atomic_fetch_add(cnt + 64 * (xcc & 7), (unsigned)CH, __ATOMIC_RELAXED, __HIP_MEMORY_SCOPE_AGENT);
    for (;;) {
        const int x = (xcc + bo) & 7;
        const unsigned t0 = (unsigned)__builtin_amdgcn_readfirstlane((int)tq);
        if (t0 >= (unsigned)ML) { if (++bo >= 8) break; tq = 0; if (c.lane == 0) tq = __hip_atomic_fetch_add(cnt + 64 * ((xcc + bo) & 7), (unsigned)CH, __ATOMIC_RELAXED, __HIP_MEMORY_SCOPE_AGENT); continue; }
        tq = 0; if (c.lane == 0) tq = __hip_atomic_fetch_add(cnt + 64 * x, (unsigned)CH, __ATOMIC_RELAXED, __HIP_MEMORY_SCOPE_AGENT);
        { v4u ee[4], im[2];
#pragma unroll
          for (int q = 0; q < 4; ++q) ee[q] = *(const v4u*)(IDX + (size_t)t0 * 128 + 256 * q + 4 * c.lane);
#pragma unroll
          for (int q = 0; q < 2; ++q) { const int p = c.lane + 64 * q; im[q] = *(const v4u*)(c.ws + WS_HQ8 + ((size_t)t0 + (p >> 4)) * 2048 + ((p >> 3) & 1) * 1024 + 128 * x + 16 * (p & 7)); }
#pragma unroll
          for (int q = 0; q < 4; ++q) *(v4u*)(le + 256 * q + 4 * c.lane) = ee[q];
#pragma unroll
          for (int q = 0; q < 2; ++q) *(v4u*)(himg + 16 * (c.lane + 64 * q)) = im[q]; }
        WAVE_LDS_SYNC();
#define E1_LOAD(G, B) do { const int bb = (B) < CH ? (B) : 0; _Pragma("unroll") for (int i = 0; i < 16; ++i) G.rw[i] = *(const l64x2*)(U8 + (size_t)le[bb * 128 + 8 * i + row8] * D + 128 * x + 16 * pc8); } while (0)
#define E1_COMP(G, B) do { const unsigned char* hb = himg + ((B) * 2 + (r16 & 1)) * 128 + 32 * g4; long bq[4]; _Pragma("unroll") for (int m = 0; m < 4; ++m) { const long v = *(const long*)(hb + 8 * m); bq[m] = bcol ? v : 0l; } \
            _Pragma("unroll") for (int gi = 0; gi < 8; ++gi) { unsigned char* sb = stage + (gi & 1) * (16 * SROW); \
                *(l64x2*)(sb + row8 * SROW + 16 * pc8) = G.rw[2 * gi]; *(l64x2*)(sb + (8 + row8) * SROW + 16 * pc8) = G.rw[2 * gi + 1]; \
                WAVE_LDS_SYNC(); \
                const l64x2 a01 = *(const l64x2*)(sb + r16 * SROW + 32 * g4), a23 = *(const l64x2*)(sb + r16 * SROW + 32 * g4 + 16); \
                f32x4m acc = {0.f, 0.f, 0.f, 0.f}; \
                acc = __builtin_amdgcn_mfma_f32_16x16x32_fp8_fp8(a01.x, bq[0], acc, 0, 0, 0); acc = __builtin_amdgcn_mfma_f32_16x16x32_fp8_fp8(a01.y, bq[1], acc, 0, 0, 0); \
                acc = __builtin_amdgcn_mfma_f32_16x16x32_fp8_fp8(a23.x, bq[2], acc, 0, 0, 0); acc = __builtin_amdgcn_mfma_f32_16x16x32_fp8_fp8(a23.y, bq[3], acc, 0, 0, 0); \
                _Pragma("unroll") for (int q = 0; q < 4; ++q) { const float lo = dppf<0xB1>(acc[q]); if (r16 == 0) res[gi * 16 + 4 * g4 + q] = acc[q] + lo * 0.0625f; } } \
            WAVE_LDS_SYNC(); \
            { float* po = PACT + (size_t)x * ((size_t)ML * 128) + ((size_t)t0 + (B)) * 128; po[c.lane] = res[c.lane]; po[64 + c.lane] = res[64 + c.lane]; } \
            WAVE_LDS_SYNC(); } while (0)
        E1Bat ga, gb;
        E1_LOAD(ga, 0);
#pragma unroll 1
        for (int b2 = 0; b2 < CH; b2 += 2) {
            E1_LOAD(gb, b2 + 1);
            __builtin_amdgcn_sched_barrier(0);
            E1_COMP(ga, b2);
            __builtin_amdgcn_sched_barrier(0);
            E1_LOAD(ga, b2 + 2);
            __builtin_amdgcn_sched_barrier(0);
            E1_COMP(gb, b2 + 1);
            __builtin_amdgcn_sched_barrier(0);
        }
#undef E1_LOAD
#undef E1_COMP
    }
}
__device__ __forceinline__ void phase_exp1b(const Ctx& c) {
    const int* IDX = (const int*)(c.ws + WS_IDX); const float* GATE = (const float*)(c.ws + WS_GATE); const float* HS = (const float*)(c.ws + WS_HS); const float* PACT = (const float*)(c.ws + WS_PACT);
    const float* USC = (const float*)(c.ws + WS_USC); const float* VSC = (const float*)(c.ws + WS_VSC); float* ACT = (float*)(c.ws + WS_ACT);
    for (size_t i = (size_t)c.bid * NTHREADS + c.tid; i < (size_t)ML * 128; i += (size_t)c.G * NTHREADS) {
        float s = 0.f;
#pragma unroll
        for (int x = 0; x < 8; ++x) s += PACT[(size_t)x * ((size_t)ML * 128) + i];
        const int e = IDX[i];
        ACT[i] = gelu_erf(s * HS[i >> 7] * USC[e]) * GATE[i] * VSC[e];
    }
}
__device__ __forceinline__ void phase_exp2(const Ctx& c) {
    const int* IDX = (const int*)(c.ws + WS_IDX); const float* ACT = (const float*)(c.ws + WS_ACT); const unsigned char* V8 = c.ws + WS_V8;
    bf16* Y = (bf16*)(c.ws + WS_Y); float* SSQP = (float*)(c.ws + WS_SSQP);
    unsigned* cnt = (unsigned*)(c.ws + WS_CTL) + CW_E2;
    int* li = (int*)(c.lds + c.wave * 1024); float* la = (float*)(li + 128);
    const int xcc = (int)xcc_id(), sub = c.lane & 7, grp = c.lane >> 3;
    const bool b5 = c.lane & 32, b4 = c.lane & 16, b3 = c.lane & 8;
    constexpr int CH = 8;
    int bo = 0, t = 0, tend = 0;
    int iA = 0, iB = 0; float aA = 0.f, aB = 0.f;
    unsigned tq = 0; if (c.lane == 0) tq = __hip_atomic_fetch_add(cnt + 64 * (xcc & 7), (unsigned)CH, __ATOMIC_RELAXED, __HIP_MEMORY_SCOPE_AGENT);
    for (;;) {
        if (t >= tend) {
            const unsigned t0 = (unsigned)__builtin_amdgcn_readfirstlane((int)tq);
            if (t0 >= (unsigned)ML) { if (++bo >= 8) break; tq = 0; if (c.lane == 0) tq = __hip_atomic_fetch_add(cnt + 64 * ((xcc + bo) & 7), (unsigned)CH, __ATOMIC_RELAXED, __HIP_MEMORY_SCOPE_AGENT); continue; }
            tq = 0; if (c.lane == 0) tq = __hip_atomic_fetch_add(cnt + 64 * ((xcc + bo) & 7), (unsigned)CH, __ATOMIC_RELAXED, __HIP_MEMORY_SCOPE_AGENT);
            t = (int)t0; tend = t + CH;
            iA = IDX[(size_t)t * 128 + c.lane]; iB = IDX[(size_t)t * 128 + 64 + c.lane]; aA = ACT[(size_t)t * 128 + c.lane]; aB = ACT[(size_t)t * 128 + 64 + c.lane];
        }
        const int x = (xcc + bo) & 7;
        li[c.lane] = iA; li[64 + c.lane] = iB; la[c.lane] = aA; la[64 + c.lane] = aB;
        if (t + 1 < tend) { iA = IDX[(size_t)(t + 1) * 128 + c.lane]; iB = IDX[(size_t)(t + 1) * 128 + 64 + c.lane]; aA = ACT[(size_t)(t + 1) * 128 + c.lane]; aB = ACT[(size_t)(t + 1) * 128 + 64 + c.lane]; }
        WAVE_LDS_SYNC();
        float acc[16];
#pragma unroll
        for (int q = 0; q < 16; ++q) acc[q] = 0.f;
#pragma unroll
        for (int hf = 0; hf < 2; ++hf) { v4u rows[8]; float av[8];
#pragma unroll
            for (int i = 0; i < 8; ++i) { const int k = 8 * (8 * hf + i) + grp; rows[i] = *(const v4u*)(V8 + (size_t)li[k] * D + x * 128 + 16 * sub); av[i] = la[k]; }
#pragma unroll
            for (int i = 0; i < 8; ++i) { float f[16]; fp8x16_to_f32(rows[i], f);
#pragma unroll
                for (int q = 0; q < 16; ++q) acc[q] = fmaf(av[i], f[q], acc[q]); } }
        float q8[8], q4[4], q2[2];
#pragma unroll
        for (int i = 0; i < 8; ++i) { const float keep = b5 ? acc[i + 8] : acc[i], send = b5 ? acc[i] : acc[i + 8]; q8[i] = keep + __shfl_xor(send, 32); }
#pragma unroll
        for (int i = 0; i < 4; ++i) { const float keep = b4 ? q8[i + 4] : q8[i], send = b4 ? q8[i] : q8[i + 4]; q4[i] = keep + __shfl_xor(send, 16); }
#pragma unroll
        for (int i = 0; i < 2; ++i) { const float keep = b3 ? q4[i + 2] : q4[i], send = b3 ? q4[i] : q4[i + 2]; q2[i] = keep + __shfl_xor(send, 8); }
        const int col = x * 128 + 16 * sub + (b5 ? 8 : 0) + (b4 ? 4 : 0) + (b3 ? 2 : 0);
        *(unsigned*)(Y + (size_t)t * D + col) = pk2(q2[0], q2[1]);
        const float ss = wsum(q2[0] * q2[0] + q2[1] * q2[1]);
        SSQP[(size_t)x * ML + t] = ss;
        WAVE_LDS_SYNC();
        ++t;
    }
}
__device__ __forceinline__ void phase_exp3(const Ctx& c) {
    const Args& a = *c.a;
    const float* MOD = (const float*)(c.ws + WS_MOD); const bf16* Y = (const bf16*)(c.ws + WS_Y); const float* SSQP = (const float*)(c.ws + WS_SSQP);
    v2u ny[4]; f32x4 nx[4]; float nss = 0.f;
#define E3_LOAD(R) do { _Pragma("unroll") for (int j = 0; j < 4; ++j) { const int col = 4 * c.lane + 256 * j; ny[j] = *(const v2u*)(Y + (size_t)(R) * D + col); nx[j] = *(const f32x4*)(a.out + (size_t)(R) * D + col); } \
        nss = (c.lane < 8) ? SSQP[(size_t)c.lane * ML + (R)] : 0.f; } while (0)
    if (c.gw < ML) E3_LOAD(c.gw);
    for (int row = c.gw; row < ML; row += c.NGW) {
        f32x4 y[4], x1[4];
#pragma unroll
        for (int j = 0; j < 4; ++j) { y[j] = (f32x4){bflo(ny[j].x), bfhi(ny[j].x), bflo(ny[j].y), bfhi(ny[j].y)}; x1[j] = nx[j]; }
        const float ss = row_sum16(nss);
        const float tot = __builtin_bit_cast(float, __builtin_amdgcn_readlane(__builtin_bit_cast(int, ss), 0));
        if (row + c.NGW < ML) E3_LOAD(row + c.NGW);
        const float r = rsqrtf(tot * (1.f / D) + EPS); const float* mr = MOD + (row >> 11) * 6144 + 5120;
#pragma unroll
        for (int j = 0; j < 4; ++j) { const int col = 4 * c.lane + 256 * j;
            const f32x4 g4 = *(const f32x4*)(a.in[I_GPOSTFFN] + col), gt = *(const f32x4*)(mr + col);
            *(f32x4*)(a.out + (size_t)row * D + col) = x1[j] + gt * ((y[j] * r) * g4); }
    }
#undef E3_LOAD
}

constexpr int S5_LPOW = 0, S5_BBAR = 33792, S5_CC = 50176, S5_MM = 66560;
__device__ __forceinline__ void s5_build_group(const Ctx& c, int g, int part) {
    const Args& a = *c.a;
    f32x2* LPOW = (f32x2*)(c.lds + S5_LPOW);
    f32x2* BBAR = (f32x2*)(c.lds + S5_BBAR);
    f32x2* CC = (f32x2*)(c.lds + S5_CC);
    float* MM = (float*)(c.lds + S5_MM);
    __syncthreads();
    if (c.tid < 128) { const int dir = c.tid >> 6, p = c.tid & 63, dg = dir * 32 + g;
        const float dt = expf(a.in[I_LOGDT][dg]), lr = a.in[I_LAMRE][dg * 64 + p], li = a.in[I_LAMIM][dg * 64 + p];
        const double ang = (double)li * (double)dt; const float lrdt = lr * dt;
        for (int e = 0; e <= 32; ++e) { float sn, cs; sincos_d(ang * (double)e, sn, cs); const float mg = expf(lrdt * (float)e); LPOW[(dir * 33 + e) * 64 + p] = (f32x2){mg * cs, mg * sn}; }
        float sn, cs; sincos_d(ang, sn, cs); const float mag = expf(lrdt), lbr = mag * cs, lbi = mag * sn, den = lr * lr + li * li, nr = lbr - 1.f;
        const float cr = (nr * lr + lbi * li) / den, ci = (lbi * lr - nr * li) / den;
        for (int ch = 0; ch < 16; ++ch) { const float br = a.in[I_BRE][(size_t)(dg * 64 + p) * 16 + ch], bi = a.in[I_BIM][(size_t)(dg * 64 + p) * 16 + ch]; BBAR[(dir * 64 + p) * 16 + ch] = (f32x2){cr * br - ci * bi, cr * bi + ci * br}; } }
    for (int i = c.tid; i < 2048; i += NTHREADS) { const int dir = i >> 10, ch = (i >> 6) & 15, p = i & 63, dg = dir * 32 + g; CC[i] = (f32x2){a.in[I_CRE][(size_t)(dg * 16 + ch) * 64 + p], a.in[I_CIM][(size_t)(dg * 16 + ch) * 64 + p]}; }
    __syncthreads();
    for (int task = c.tid; task < 1024; task += NTHREADS) { const int cpb = task & 3, cb = (task >> 2) & 3, lag = (task >> 4) & 31, dir = task >> 9;
        float acc[4][4];
#pragma unroll
        for (int i = 0; i < 4; ++i)
#pragma unroll
            for (int j = 0; j < 4; ++j) acc[i][j] = 0.f;
        for (int p = 0; p < 64; ++p) { const f32x2 l = LPOW[(dir * 33 + lag) * 64 + p]; f32x2 G[4], Cw[4];
#pragma unroll
            for (int j = 0; j < 4; ++j) { const f32x2 bb = BBAR[(dir * 64 + p) * 16 + 4 * cpb + j]; G[j] = (f32x2){l.x * bb.x - l.y * bb.y, l.x * bb.y + l.y * bb.x}; }
#pragma unroll
            for (int i = 0; i < 4; ++i) Cw[i] = CC[(dir * 16 + 4 * cb + i) * 64 + p];
#pragma unroll
            for (int i = 0; i < 4; ++i)
#pragma unroll
                for (int j = 0; j < 4; ++j) acc[i][j] += Cw[i].x * G[j].x - Cw[i].y * G[j].y; }
#pragma unroll
        for (int i = 0; i < 4; ++i)
#pragma unroll
            for (int j = 0; j < 4; ++j) MM[((dir * 32 + lag) * 16 + 4 * cb + i) * 16 + 4 * cpb + j] = acc[i][j]; }
    __syncthreads();
    if (c.tid < 128 && part == 0) { const int dir = c.tid >> 6, p = c.tid & 63; ((f32x2*)(c.ws + WS_LP))[(dir * 32 + g) * 64 + p] = LPOW[(dir * 33 + 32) * 64 + p]; }
    bf16* PMg = (bf16*)(c.ws + WS_PM) + (size_t)g * 256 * 512; bf16* BBg = (bf16*)(c.ws + WS_BB) + (size_t)g * 512 * 768;
    for (int task = part * 64 * 32 + c.tid; task < (part + 1) * 64 * 32; task += NTHREADS) { const int ip = task & 31, n = task >> 5, dir = n >> 7, im = (n >> 6) & 1, p = n & 63, e = dir ? ip : 31 - ip;
        const f32x2 l = LPOW[(dir * 33 + e) * 64 + p]; float o[16];
#pragma unroll
        for (int ch = 0; ch < 16; ++ch) { const f32x2 bb = BBAR[(dir * 64 + p) * 16 + ch]; o[ch] = im ? (l.x * bb.y + l.y * bb.x) : (l.x * bb.x - l.y * bb.y); }
        v4u w0, w1; w0.x = pk2(o[0], o[1]); w0.y = pk2(o[2], o[3]); w0.z = pk2(o[4], o[5]); w0.w = pk2(o[6], o[7]); w1.x = pk2(o[8], o[9]); w1.y = pk2(o[10], o[11]); w1.z = pk2(o[12], o[13]); w1.w = pk2(o[14], o[15]);
        *(v4u*)(PMg + (size_t)n * 512 + ip * 16) = w0; *(v4u*)(PMg + (size_t)n * 512 + ip * 16 + 8) = w1; }
    for (int task = part * 128 * 32 + c.tid; task < (part + 1) * 128 * 32; task += NTHREADS) { const int ip = task & 31, n = task >> 5, i = n >> 4, ch = n & 15; float o[16];
#pragma unroll
        for (int q = 0; q < 16; ++q) o[q] = 0.f;
        if (ip <= i) { const float* m0 = MM + ((0 * 32 + (i - ip)) * 16 + ch) * 16;
#pragma unroll
            for (int q = 0; q < 16; ++q) o[q] += m0[q]; }
        if (ip >= i) { const float* m1 = MM + ((1 * 32 + (ip - i)) * 16 + ch) * 16;
#pragma unroll
            for (int q = 0; q < 16; ++q) o[q] += m1[q]; }
        if (ip == i) { const float dsk = a.in[I_S5D][g * 16 + ch];
#pragma unroll
            for (int q = 0; q < 16; ++q) o[q] += (q == ch) ? dsk : 0.f; }
        v4u w0, w1; w0.x = pk2(o[0], o[1]); w0.y = pk2(o[2], o[3]); w0.z = pk2(o[4], o[5]); w0.w = pk2(o[6], o[7]); w1.x = pk2(o[8], o[9]); w1.y = pk2(o[10], o[11]); w1.z = pk2(o[12], o[13]); w1.w = pk2(o[14], o[15]);
        *(v4u*)(BBg + (size_t)n * 768 + ip * 16) = w0; *(v4u*)(BBg + (size_t)n * 768 + ip * 16 + 8) = w1; }
    for (int task = part * 128 * 32 + c.tid; task < (part + 1) * 128 * 32; task += NTHREADS) { const int p8 = task & 7, part = (task >> 3) & 3, n = task >> 5, i = n >> 4, ch = n & 15, dir = part >> 1, im = part & 1, e = dir ? 32 - i : i + 1; float o[8];
#pragma unroll
        for (int q = 0; q < 8; ++q) { const int p = p8 * 8 + q; const f32x2 l = LPOW[(dir * 33 + e) * 64 + p], cc = CC[(dir * 16 + ch) * 64 + p]; o[q] = im ? -(cc.x * l.y + cc.y * l.x) : (cc.x * l.x - cc.y * l.y); }
        v4u w0; w0.x = pk2(o[0], o[1]); w0.y = pk2(o[2], o[3]); w0.z = pk2(o[4], o[5]); w0.w = pk2(o[6], o[7]);
        *(v4u*)(BBg + (size_t)n * 768 + 512 + part * 64 + p8 * 8) = w0; }
}
__device__ __forceinline__ void s5_state_scan(const Ctx& c, int task) {
    const int dir = task & 1, g = (task >> 1) & 31, b = task >> 6, p = c.lane;
    const f32x2 a = ((const f32x2*)(c.ws + WS_LP))[(dir * 32 + g) * 64 + p];
    const float* SS = (const float*)(c.ws + WS_SS) + (size_t)g * 768 * 256 + dir * 128 + p; bf16* U5 = (bf16*)(c.ws + WS_U5) + (size_t)g * 768 * 768 + 512 + dir * 128 + p;
    float er = 0.f, ei = 0.f;
#pragma unroll 24
    for (int step = 0; step < 72; ++step) {
        const int R = (step < 8) ? 512 + b * 8 + (dir ? 7 - step : step) : b * 64 + (dir ? 71 - step : step - 8);
        if (step >= 8) { U5[(size_t)R * 768] = (bf16)f2bf(er); U5[(size_t)R * 768 + 64] = (bf16)f2bf(ei); }
        const float sr = SS[(size_t)R * 256], si = SS[(size_t)R * 256 + 64];
        const float nr = sr + a.x * er - a.y * ei, ni = si + a.x * ei + a.y * er; er = nr; ei = ni;
    }
}

constexpr int GDN_NCH = 36, GDN_ITEMS = NB * 4 * 2 * GDN_NCH;
constexpr size_t FR_T_BYTES = 8192, FR_ATT_BYTES = 8192, FR_KD_BYTES = 16384, FR_TAB_BYTES = 1024;
__device__ __forceinline__ int crow16(int i, int hh) { return (i & 3) + 8 * (i >> 2) + 4 * hh; }
__device__ __forceinline__ bf16x8 pack_step(const f32x16& x, int s) {
    v4u w; w.x = pk2(x[8 * s + 0], x[8 * s + 1]); w.y = pk2(x[8 * s + 2], x[8 * s + 3]); w.z = pk2(x[8 * s + 4], x[8 * s + 5]); w.w = pk2(x[8 * s + 6], x[8 * s + 7]);
    return __builtin_bit_cast(bf16x8, w);
}
__device__ __forceinline__ unsigned pk2v(float lo, float hi) { asm volatile("" : "+v"(lo), "+v"(hi)); return pk2(lo, hi); }
__device__ __forceinline__ bf16x8 pack_step_v(const f32x16& x, int s) {
    v4u w; w.x = pk2v(x[8 * s + 0], x[8 * s + 1]); w.y = pk2v(x[8 * s + 2], x[8 * s + 3]); w.z = pk2v(x[8 * s + 4], x[8 * s + 5]); w.w = pk2v(x[8 * s + 6], x[8 * s + 7]);
    return __builtin_bit_cast(bf16x8, w);
}
constexpr int GP_KR = 0, GP_QR = 17408, GP_KT = 34816, GP_TAB = 53248, GP_LP = 54272, GP_LPB = 8448 + 256;
__host__ __device__ constexpr int LOFF(int i) { return i < 1 ? 0 : 4 * (((i - 1) >> 2) + 1) * (2 * ((i - 1) >> 2) + ((i - 1) & 3)); }
static_assert(LOFF(1) == 0 && LOFF(2) == 4 && LOFF(5) == 16 && LOFF(6) == 24 && LOFF(64) == 2112, "packed lower-triangular row offsets");
__device__ __forceinline__ void gdn_prep_stage(const Ctx& c, int item, float* Lp) {
    const int n = item % GDN_NCH, bhd = item / GDN_NCH, dir = bhd & 1, h = (bhd >> 1) & 3, b = bhd >> 3;
    const bf16* QKV = (const bf16*)(c.ws + WS_QKV); const float* GB = (const float*)(c.ws + WS_GB);
    bf16* Kr = (bf16*)(c.lds + GP_KR); bf16* Qr = (bf16*)(c.lds + GP_QR); bf16* Kt = (bf16*)(c.lds + GP_KT); float* tab = (float*)(c.lds + GP_TAB);
    unsigned char* frA = c.ws + WS_FRA + (size_t)item * FR_ATT_BYTES; unsigned char* frK = c.ws + WS_FRK + (size_t)item * FR_KD_BYTES; float* frTab = (float*)(c.ws + WS_FRTAB + (size_t)item * FR_TAB_BYTES);
    const int r = c.lane & 31, hh = c.lane >> 5;
    if (c.wave == 0) { const int row = scan_row(b, dir, n * 64 + c.lane); float g = GB[(size_t)row * 16 + dir * 4 + h]; const float beta = GB[(size_t)row * 16 + 8 + dir * 4 + h];
#pragma unroll
        for (int o = 1; o < 64; o <<= 1) { const float t = __shfl_up(g, o); if (c.lane >= o) g += t; }
        const float gl = __shfl(g, 63);
        tab[c.lane] = g; tab[64 + c.lane] = beta; tab[128 + c.lane] = __expf(g); tab[192 + c.lane] = __expf(gl - g); }
    { const int s = c.tid >> 3, seg = c.tid & 7; const int row = scan_row(b, dir, n * 64 + s); const bf16* rp = QKV + (size_t)row * 1536 + h * 128 + seg * 16;
      const v4u q0 = *(const v4u*)rp, q1 = *(const v4u*)(rp + 8), k0 = *(const v4u*)(rp + 512), k1 = *(const v4u*)(rp + 520);
      *(v4u*)(Qr + s * 136 + seg * 16) = q0; *(v4u*)(Qr + s * 136 + seg * 16 + 8) = q1; *(v4u*)(Kr + s * 136 + seg * 16) = k0; *(v4u*)(Kr + s * 136 + seg * 16 + 8) = k1;
      const unsigned kw[8] = {k0.x, k0.y, k0.z, k0.w, k1.x, k1.y, k1.z, k1.w};
#pragma unroll
      for (int e = 0; e < 8; ++e) { Kt[(seg * 16 + 2 * e) * 72 + s] = (bf16)(kw[e] & 0xffffu); Kt[(seg * 16 + 2 * e + 1) * 72 + s] = (bf16)(kw[e] >> 16); } }
    __syncthreads();
    if (c.wave < 3) { const int ct = c.wave ? 1 : 0, st = c.wave == 2 ? 1 : 0;
        f32x16 acc;
#pragma unroll
        for (int i = 0; i < 16; ++i) acc[i] = 0.f;
#pragma unroll
        for (int kk = 0; kk < 8; ++kk) { const bf16x8 a = *(const bf16x8*)(Kr + (ct * 32 + r) * 136 + kk * 16 + hh * 8), bb = *(const bf16x8*)(Kr + (st * 32 + r) * 136 + kk * 16 + hh * 8); acc = MFMA32(a, bb, acc); }
        const int s = st * 32 + r; const float gcs = tab[s];
#pragma unroll
        for (int i = 0; i < 16; ++i) { const int cc = ct * 32 + crow16(i, hh); if (s < cc) Lp[LOFF(cc) + s] = tab[64 + cc] * acc[i] * __expf(tab[cc] - gcs); }
    } else if (c.wave < 6) { const int w = c.wave - 3, st = w == 2 ? 1 : 0, ct = w ? 1 : 0;
        f32x16 acc;
#pragma unroll
        for (int i = 0; i < 16; ++i) acc[i] = 0.f;
#pragma unroll
        for (int kk = 0; kk < 8; ++kk) { const bf16x8 a = *(const bf16x8*)(Kr + (st * 32 + r) * 136 + kk * 16 + hh * 8), bb = *(const bf16x8*)(Qr + (ct * 32 + r) * 136 + kk * 16 + hh * 8); acc = MFMA32(a, bb, acc); }
        const int cc = ct * 32 + r; const float gcc = tab[cc];
#pragma unroll
        for (int i = 0; i < 16; ++i) { const int s = st * 32 + crow16(i, hh); acc[i] = (s <= cc) ? acc[i] * __expf(gcc - tab[s]) : 0.f; }
        *(bf16x8*)(frA + ((size_t)((ct * 4 + 2 * st) * 64 + c.lane)) * 16) = pack_step(acc, 0);
        *(bf16x8*)(frA + ((size_t)((ct * 4 + 2 * st + 1) * 64 + c.lane)) * 16) = pack_step(acc, 1);
    } else { const int w = c.wave - 6;
#pragma unroll
        for (int f = 0; f < 8; ++f) { const int fi = w * 8 + f, dkt = fi >> 2, cb = fi & 3; const bf16* kp = Kt + (dkt * 32 + r) * 72 + 16 * cb + 4 * hh;
            const v2u lo = *(const v2u*)kp, hi = *(const v2u*)(kp + 8); const f32x4 e0 = *(const f32x4*)(tab + 192 + 16 * cb + 4 * hh), e1 = *(const f32x4*)(tab + 192 + 16 * cb + 8 + 4 * hh);
            v4u o; o.x = pk2(bflo(lo.x) * e0.x, bfhi(lo.x) * e0.y); o.y = pk2(bflo(lo.y) * e0.z, bfhi(lo.y) * e0.w); o.z = pk2(bflo(hi.x) * e1.x, bfhi(hi.x) * e1.y); o.w = pk2(bflo(hi.y) * e1.z, bfhi(hi.y) * e1.w);
            *(v4u*)(frK + ((size_t)(fi * 64 + c.lane)) * 16) = o; }
        if (w == 0) { const v4u z = (v4u){0u, 0u, 0u, 0u}; *(v4u*)(frA + ((size_t)((0 * 4 + 2) * 64 + c.lane)) * 16) = z; *(v4u*)(frA + ((size_t)((0 * 4 + 3) * 64 + c.lane)) * 16) = z; }
        else { *(f32x4*)(frTab + 4 * c.lane) = *(const f32x4*)(tab + 4 * c.lane); }
    }
    __syncthreads();
}
__device__ __forceinline__ void gdn_prep_solve(const Ctx& c, int item, float* Lp) {
    float Tr[64];
#pragma unroll
    for (int i = 0; i < 64; ++i) { int le_ = c.lane; asm volatile("" : "+v"(le_)); float a0 = (le_ == i) ? 1.f : 0.f, a1 = 0.f;
#pragma unroll
        for (int s4 = 0; s4 < (i + 3) / 4; ++s4) { const f32x4 l4 = *(const f32x4*)(Lp + LOFF(i) + 4 * s4);
            if (4 * s4 + 0 < i) a0 = fmaf(-l4.x, Tr[4 * s4 + 0], a0); if (4 * s4 + 1 < i) a1 = fmaf(-l4.y, Tr[4 * s4 + 1], a1); if (4 * s4 + 2 < i) a0 = fmaf(-l4.z, Tr[4 * s4 + 2], a0); if (4 * s4 + 3 < i) a1 = fmaf(-l4.w, Tr[4 * s4 + 3], a1); }
        Tr[i] = a0 + a1; { int lo_ = c.lane; asm volatile("" : "+v"(lo_)); Lp[(lo_ < i) ? LOFF(i) + lo_ : 2112 + lo_] = Tr[i]; } }
    WAVE_LDS_SYNC();
    unsigned char* frT = c.ws + WS_FRT + (size_t)item * FR_T_BYTES;
    const int r = c.lane & 31, hh = c.lane >> 5;
#pragma unroll
    for (int f = 0; f < 8; ++f) { const int ct = f >> 2, sb = f & 3, cc = ct * 32 + r; float v[8];
#pragma unroll
        for (int q = 0; q < 2; ++q) { const int s0 = 16 * sb + 8 * q + 4 * hh;
            f32x4 t4 = (f32x4){0.f, 0.f, 0.f, 0.f}; if (s0 < cc) t4 = *(const f32x4*)(Lp + LOFF(cc) + s0);
            v[4 * q + 0] = (s0 + 0 < cc) ? t4.x : (s0 + 0 == cc ? 1.f : 0.f); v[4 * q + 1] = (s0 + 1 < cc) ? t4.y : (s0 + 1 == cc ? 1.f : 0.f);
            v[4 * q + 2] = (s0 + 2 < cc) ? t4.z : (s0 + 2 == cc ? 1.f : 0.f); v[4 * q + 3] = (s0 + 3 < cc) ? t4.w : (s0 + 3 == cc ? 1.f : 0.f); }
        *(v4u*)(frT + ((size_t)(f * 64 + c.lane)) * 16) = (v4u){pk2(v[0], v[1]), pk2(v[2], v[3]), pk2(v[4], v[5]), pk2(v[6], v[7])}; }
}
__device__ __forceinline__ void phase_gdn_prep(const Ctx& c) {
    for (int base = c.bid; base < GDN_ITEMS; base += 8 * c.G) {
        int cnt = 0;
#pragma unroll 1
        for (int q = 0; q < 8; ++q) { const int item = base + q * c.G; if (item < GDN_ITEMS) { gdn_prep_stage(c, item, (float*)(c.lds + GP_LP + q * GP_LPB)); cnt = q + 1; } }
        if (c.wave < cnt) gdn_prep_solve(c, base + c.wave * c.G, (float*)(c.lds + GP_LP + c.wave * GP_LPB));
        __syncthreads();
    }
}

constexpr int GR_K = 0, GR_Q = 16384, GR_T = 32768, GR_A = 40960, GR_KD = 49152, GR_TAB = 65536, GR_BUF = 66560;
__device__ __forceinline__ void gdn_rec_stage(const Ctx& c, int bhd, int n, int buf) {
    const int dir = bhd & 1, h = (bhd >> 1) & 3, b = bhd >> 3, lw = c.wave - 4; const int item = bhd * GDN_NCH + n;
    LAS unsigned char* base = (LAS unsigned char*)c.lds + buf * GR_BUF;
    const unsigned char* QKVb = c.ws + WS_QKV;
#pragma unroll
    for (int q = 0; q < 4; ++q) { const int qi = lw + 4 * q;
        const int s = 4 * qi + (c.lane >> 4), ps = c.lane & 15, p = ps ^ (s & 15); const size_t rowb = (size_t)scan_row(b, dir, n * 64 + s) * 3072 + (size_t)h * 256 + p * 16;
        __builtin_amdgcn_global_load_lds((const unsigned*)(QKVb + rowb + 1024), (LAS unsigned*)(base + GR_K + qi * 1024), 16, 0, 0);
        __builtin_amdgcn_global_load_lds((const unsigned*)(QKVb + rowb), (LAS unsigned*)(base + GR_Q + qi * 1024), 16, 0, 0); }
    const unsigned char* frT = c.ws + WS_FRT + (size_t)item * FR_T_BYTES; const unsigned char* frA = c.ws + WS_FRA + (size_t)item * FR_ATT_BYTES; const unsigned char* frK = c.ws + WS_FRK + (size_t)item * FR_KD_BYTES;
#pragma unroll
    for (int q = 0; q < 2; ++q) { const int qi = lw + 4 * q;
        __builtin_amdgcn_global_load_lds((const unsigned*)(frT + qi * 1024 + c.lane * 16), (LAS unsigned*)(base + GR_T + qi * 1024), 16, 0, 0);
        __builtin_amdgcn_global_load_lds((const unsigned*)(frA + qi * 1024 + c.lane * 16), (LAS unsigned*)(base + GR_A + qi * 1024), 16, 0, 0); }
#pragma unroll
    for (int q = 0; q < 4; ++q) { const int qi = lw + 4 * q;
        __builtin_amdgcn_global_load_lds((const unsigned*)(frK + qi * 1024 + c.lane * 16), (LAS unsigned*)(base + GR_KD + qi * 1024), 16, 0, 0); }
    if (lw == 0) __builtin_amdgcn_global_load_lds((const unsigned*)(c.ws + WS_FRTAB + (size_t)item * FR_TAB_BYTES + c.lane * 16), (LAS unsigned*)(base + GR_TAB), 16, 0, 0);
}
__device__ __forceinline__ bf16x8 gr_rowfrag(const unsigned char* rowp, const int (&po)[16], int kb) {
    const v2u lo = *(const v2u*)(rowp + po[2 * kb]), hi = *(const v2u*)(rowp + po[2 * kb + 1]);
    return __builtin_bit_cast(bf16x8, (v4u){lo.x, lo.y, hi.x, hi.y});
}
__device__ __forceinline__ void gdn_rec_block(const Ctx& c, int bhd, int dvhalf) {
    const int dir = bhd & 1, h = (bhd >> 1) & 3, b = bhd >> 3, r = c.lane & 31, hh = c.lane >> 5, dvt = 2 * dvhalf + (c.wave & 1);
    const bf16* QKV = (const bf16*)(c.ws + WS_QKV); bf16* OG = (bf16*)(c.ws + WS_OG) + (size_t)dir * ML * 512;
    f32x16 S[4];
#pragma unroll
    for (int t = 0; t < 4; ++t)
#pragma unroll
        for (int i = 0; i < 16; ++i) S[t][i] = 0.f;
    int po[16];
#pragma unroll
    for (int p = 0; p < 16; ++p) po[p] = r * 256 + ((p ^ (r & 15)) * 16) + 8 * hh;
    if (c.wave >= 4) gdn_rec_stage(c, bhd, 0, 0);
    asm volatile("s_waitcnt vmcnt(0)" ::: "memory"); __syncthreads();
    for (int n = 0; n < GDN_NCH; ++n) {
        const int buf = n & 1;
        if (c.wave >= 4) { if (n + 1 < GDN_NCH) gdn_rec_stage(c, bhd, n + 1, buf ^ 1); }
        else if (c.wave < 2) {
            const unsigned char* base = c.lds + buf * GR_BUF; const float* tab = (const float*)(base + GR_TAB);
            const int row0 = scan_row(b, dir, n * 64), sgn = dir ? -1 : 1;
            const bf16* vcol = QKV + (size_t)row0 * 1536 + 1024 + h * 128 + dvt * 32 + r + (ptrdiff_t)(sgn * 4 * hh) * 1536;
            bf16* ocol = OG + (size_t)row0 * 512 + h * 128 + dvt * 32 + r + (ptrdiff_t)(sgn * 4 * hh) * 512;
            const ptrdiff_t vst = (ptrdiff_t)sgn * 1536, ost = (ptrdiff_t)sgn * 512;
            bf16 vraw[2][16];
#pragma unroll
            for (int st = 0; st < 2; ++st)
#pragma unroll
                for (int i = 0; i < 16; ++i) vraw[st][i] = vcol[vst * (st * 32 + (i & 3) + 8 * (i >> 2))];
            bf16x8 Rf[2][2];
#pragma unroll
            for (int st = 0; st < 2; ++st) { f32x16 acc;
#pragma unroll
                for (int i = 0; i < 16; ++i) acc[i] = 0.f;
#pragma unroll
                for (int kb = 0; kb < 8; ++kb) acc = MFMA32(gr_rowfrag(base + GR_K + st * 8192, po, kb), pack_step_v(S[kb >> 1], kb & 1), acc);
#pragma unroll
                for (int i = 0; i < 16; ++i) { const int s = st * 32 + crow16(i, hh); acc[i] = tab[64 + s] * (bf1(vraw[st][i]) - tab[128 + s] * acc[i]); }
                Rf[st][0] = pack_step(acc, 0); Rf[st][1] = pack_step(acc, 1); asm volatile("" ::: "memory"); }
            bf16x8 Vf[2][2];
#pragma unroll
            for (int ct = 0; ct < 2; ++ct) { f32x16 acc;
#pragma unroll
                for (int i = 0; i < 16; ++i) acc[i] = 0.f;
#pragma unroll
                for (int sb = 0; sb < 4; ++sb) if (sb < 2 * ct + 2) acc = MFMA32(*(const bf16x8*)(base + GR_T + ((ct * 4 + sb) * 64 + c.lane) * 16), Rf[sb >> 1][sb & 1], acc);
                Vf[ct][0] = pack_step(acc, 0); Vf[ct][1] = pack_step(acc, 1); }
            asm volatile("" ::: "memory");
#pragma unroll
            for (int ct = 0; ct < 2; ++ct) { f32x16 acc;
#pragma unroll
                for (int i = 0; i < 16; ++i) acc[i] = 0.f;
#pragma unroll
                for (int kb = 0; kb < 8; ++kb) acc = MFMA32(gr_rowfrag(base + GR_Q + ct * 8192, po, kb), pack_step_v(S[kb >> 1], kb & 1), acc);
#pragma unroll
                for (int i = 0; i < 16; ++i) acc[i] *= tab[128 + ct * 32 + crow16(i, hh)];
#pragma unroll
                for (int cb = 0; cb < 4; ++cb) if (cb < 2 * ct + 2) acc = MFMA32(*(const bf16x8*)(base + GR_A + ((ct * 4 + cb) * 64 + c.lane) * 16), Vf[cb >> 1][cb & 1], acc);
                if (n >= 4) {
#pragma unroll
                    for (int i = 0; i < 16; ++i) ocol[ost * (ct * 32 + (i & 3) + 8 * (i >> 2))] = (bf16)f2bf(acc[i]); }
                asm volatile("" ::: "memory"); }
            const float gtot = tab[128 + 63];
#pragma unroll
            for (int t = 0; t < 4; ++t) {
#pragma unroll
                for (int i = 0; i < 16; ++i) S[t][i] *= gtot;
#pragma unroll
                for (int cb = 0; cb < 4; ++cb) S[t] = MFMA32(*(const bf16x8*)(base + GR_KD + ((t * 4 + cb) * 64 + c.lane) * 16), Vf[cb >> 1][cb & 1], S[t]); }
        }
        if (c.wave >= 4) asm volatile("s_waitcnt vmcnt(0)" ::: "memory"); else asm volatile("s_waitcnt lgkmcnt(0)" ::: "memory");
        __builtin_amdgcn_s_barrier(); asm volatile("" ::: "memory");
    }
    asm volatile("s_waitcnt vmcnt(0)" ::: "memory"); __syncthreads();
}
__device__ __forceinline__ void phase_gdn_rec(const Ctx& c) { if (c.bid < 128) gdn_rec_block(c, c.bid >> 1, c.bid & 1); }

#define XB_TMO      128
#define XB_XCNT(j)  (256  + 64 * (j))
#define XB_XSUB(j)  (1280 + 64 * (j))
#define XB_XGEN(j)  (2304 + 64 * (j))
#define XB_TOP      3328
#define XB_TOPGEN   3392
#define XCD_BAR_WORDS 3456
#define XB_SPIN_CAP (1u << 20)
__device__ __forceinline__ unsigned xb_ld(unsigned* p)              { return __hip_atomic_load(p, __ATOMIC_RELAXED, __HIP_MEMORY_SCOPE_AGENT); }
__device__ __forceinline__ unsigned xb_add(unsigned* p, unsigned v) { return __hip_atomic_fetch_add(p, v, __ATOMIC_RELAXED, __HIP_MEMORY_SCOPE_AGENT); }
__device__ __forceinline__ unsigned xb_xcc_id() { return (unsigned)__builtin_amdgcn_s_getreg((3 << 11) | 20) & 0xFu; }
#define XB_SPIN(cond, bar) do { unsigned _sp = 0; while (cond) { __builtin_amdgcn_s_sleep(1); \
    if ((++_sp & 255u) == 0u) { if (xb_ld(&(bar)[XB_TMO])) break; if (_sp > XB_SPIN_CAP) { atomicAdd(&(bar)[XB_TMO], 1u); break; } } } } while (0)
struct XcdBarrier { unsigned* bar; unsigned x; volatile LAS unsigned* st; };
__device__ __forceinline__ XcdBarrier xcd_barrier_post(unsigned* bar, volatile LAS unsigned* st) {
    XcdBarrier b; b.bar = bar; b.x = xb_xcc_id(); b.st = st;
    if (threadIdx.x == 0) (void)xb_add(&bar[XB_XCNT(b.x)], 1u);
    return b;
}
__device__ __forceinline__ void xcd_barrier_complete(unsigned* bar, unsigned x, unsigned& nloc, unsigned& nx) {
    const unsigned G = gridDim.x * gridDim.y * gridDim.z;
    unsigned sum, cnt, mine, sp = 0u;
    for (;;) {
        sum = 0u; cnt = 0u; mine = 0u;
#pragma unroll
        for (unsigned j = 0; j < 16; ++j) { const unsigned c = xb_ld(&bar[XB_XCNT(j)]); sum += c; cnt += (c > 0u) ? 1u : 0u; mine = (j == x) ? c : mine; }
        if (sum == G) break;
        __builtin_amdgcn_s_sleep(1);
        if ((++sp & 255u) == 0u) { if (xb_ld(&bar[XB_TMO])) break; if (sp > XB_SPIN_CAP) { atomicAdd(&bar[XB_TMO], 1u); break; } }
    }
    nloc = mine > 0u ? mine : 1u; nx = cnt > 0u ? cnt : 1u;
}
__device__ __forceinline__ void xcd_barrier(const XcdBarrier& b) {
    asm volatile("s_waitcnt vmcnt(0)" ::: "memory");
    __syncthreads();
    if (threadIdx.x == 0) {
        unsigned* bar = b.bar;
        __builtin_amdgcn_s_waitcnt(0);
        unsigned nloc = b.st[0], nx = b.st[1];
        if (nloc == 0u) { xcd_barrier_complete(bar, b.x, nloc, nx); b.st[0] = nloc; b.st[1] = nx; }
        const unsigned old = xb_add(&bar[XB_XSUB(b.x)], 1u);
        const unsigned gen = old / nloc;
        if (old + 1u == (gen + 1u) * nloc) {
            __builtin_amdgcn_fence(__ATOMIC_RELEASE, "agent");
            asm volatile("s_waitcnt vmcnt(0)" ::: "memory");
            const unsigned og = xb_add(&bar[XB_TOP], 1u);
            const unsigned tg = og / nx;
            if (og + 1u == (tg + 1u) * nx) xb_add(&bar[XB_TOPGEN], 1u);
            else XB_SPIN(xb_ld(&bar[XB_TOPGEN]) == tg, bar);
            __builtin_amdgcn_fence(__ATOMIC_ACQUIRE, "agent");
            xb_add(&bar[XB_XGEN(b.x)], 1u);
            asm volatile("s_waitcnt vmcnt(0)" ::: "memory");
        } else {
            XB_SPIN(xb_ld(&bar[XB_XGEN(b.x)]) == gen, bar);
            __builtin_amdgcn_fence(__ATOMIC_ACQUIRE, "agent");
            asm volatile("s_waitcnt vmcnt(0)" ::: "memory");
        }
    }
    __syncthreads();
}

constexpr int LDS_MISC = LDS_BYTES - 64;
__global__ void __launch_bounds__(NTHREADS, 2) mk_fwd(Args args) {
    extern __shared__ __attribute__((aligned(16))) unsigned char lds[];
    Ctx c; c.a = &args; c.ws = args.ws; c.lds = lds;
    c.tid = threadIdx.x; c.lane = c.tid & 63; c.wave = __builtin_amdgcn_readfirstlane(c.tid >> 6); c.bid = blockIdx.x; c.G = gridDim.x;
    c.gw = c.bid * NWAVES + c.wave; c.NGW = c.G * NWAVES; c.gwv = c.wave * c.G + c.bid;
    const int lo = args.ph_lo, hi = args.ph_hi;
    PG8_LAS unsigned char* ring = (PG8_LAS unsigned char*)lds;
#ifndef MK_PH_MASK
#define MK_PH_MASK 0xffff
#endif
#define IN(k) (((MK_PH_MASK >> (k)) & 1) && lo <= (k) && (k) < hi)
#if MK_ONE_LAUNCH
    cg::grid_group grid = cg::this_grid();
    if (lo < 0) grid.sync();
    volatile LAS unsigned* st = (volatile LAS unsigned*)((LAS unsigned char*)lds + LDS_MISC);
    if (c.tid < 2) st[c.tid] = 0u;
    __syncthreads();
    const XcdBarrier bar = xcd_barrier_post((unsigned*)(c.ws + WS_CTL) + CW_BAR, st);
#define SEAM(k) do { if (IN(k) && IN((k) + 1)) xcd_barrier(bar); } while (0)
#else
#define SEAM(k) do { } while (0)
#endif
    if (IN(0)) { phase_prep(c); phase_s5_build(c); } SEAM(0);
    if (IN(1)) { phase_norm1(c); } SEAM(1);
    if (IN(2)) { pg8::Gemm g{(const pg8::bf16_t*)(c.ws + WS_HX), (const pg8::bf16_t*)(c.ws + WS_WIN), 1024, 1024, 1024}; pg8::StaticOrder S; S.init(MT, NPROJ, c.G, c.bid);
        pg8::EpiInProj E{(pg8::bf16_t*)(c.ws + WS_U5), (pg8::bf16_t*)(c.ws + WS_QKVPRE), (pg8::bf16_t*)(c.ws + WS_Z)};
        pg8::gemm_phase<pg8::EpiInProj, pg8::StaticOrder, true, true>(ring, g, S, E); } SEAM(2);
    if (IN(3)) { { pg8::Gemm g{(const pg8::bf16_t*)(c.ws + WS_U5), (const pg8::bf16_t*)(c.ws + WS_PM), 768, 512, 512}; pg8::SchedSS S{c.G, c.bid}; pg8::EpiSS E{(float*)(c.ws + WS_SS)};
          pg8::gemm_phase<pg8::EpiSS, pg8::SchedSS, true, true>(ring, g, S, E); }
        __syncthreads(); phase_conv(c); } SEAM(3);
    if (IN(4)) { for (int t = c.gwv; t < 512; t += c.NGW) s5_state_scan(c, t); __syncthreads(); phase_gdn_prep(c); } SEAM(4);
    if (IN(5)) { pg8::Gemm g{(const pg8::bf16_t*)(c.ws + WS_U5), (const pg8::bf16_t*)(c.ws + WS_BB), 768, 768, 768}; pg8::SchedS5Y S{c.G, c.bid}; pg8::EpiS5Y E{(pg8::bf16_t*)(c.ws + WS_YG)};
        pg8::gemm_phase<pg8::EpiS5Y, pg8::SchedS5Y, true, true>(ring, g, S, E); } SEAM(5);
    if (IN(6)) { if (c.bid < 128) phase_gdn_rec(c);
        else { pg8::Gemm g{(const pg8::bf16_t*)(c.ws + WS_YG), (const pg8::bf16_t*)(c.ws + WS_WGLU), 512, 512, 512}; pg8::StaticOrder S; S.init(ML, 512, c.G - 128, c.bid - 128);
            pg8::EpiGlu E{(const pg8::bf16_t*)(c.ws + WS_YG), (pg8::bf16_t*)(c.ws + WS_CAT)};
            pg8::gemm_phase<pg8::EpiGlu, pg8::StaticOrder, true, true>(ring, g, S, E); } } SEAM(6);
    if (IN(7)) { phase_combine(c); } SEAM(7);
    if (IN(8)) { pg8::Gemm g{(const pg8::bf16_t*)(c.ws + WS_CAT), (const pg8::bf16_t*)(c.ws + WS_WOUT), 1024, 1024, 1024}; pg8::StaticOrder S; S.init(ML, 1024, c.G, c.bid);
        pg8::EpiBf16<0> E{(pg8::bf16_t*)(c.ws + WS_YRAW), 1024, nullptr, 0, 0, 1.f};
        pg8::gemm_phase<pg8::EpiBf16<0>, pg8::StaticOrder, true, true>(ring, g, S, E); } SEAM(8);
    if (IN(9)) { phase_rows2(c); phase_fp8_tables(c); } SEAM(9);
    if (IN(10)) { pg8::Gemm g{(const pg8::bf16_t*)(c.ws + WS_HX2), (const pg8::bf16_t*)(c.ws + WS_WQ), 1024, 1024, 1024}; pg8::StaticOrder S; S.init(ML, 2048, c.G, c.bid);
        pg8::EpiBf16<0> E{(pg8::bf16_t*)(c.ws + WS_QP), 2048, nullptr, 0, 0, 1.f};
        pg8::gemm_phase<pg8::EpiBf16<0>, pg8::StaticOrder, true, true>(ring, g, S, E); } SEAM(10);
    if (IN(11)) { phase_topk(c); } SEAM(11);
    if (IN(12)) { phase_exp1(c); } SEAM(12);
    if (IN(13)) { phase_exp1b(c); } SEAM(13);
    if (IN(14)) { phase_exp2(c); } SEAM(14);
    if (IN(15)) { phase_exp3(c); }
#undef IN
#undef SEAM
}

extern "C" void kernel_launch(void* const* d_in, const int* in_sizes, int n_in, void* d_out, int out_size, void* d_ws, size_t ws_size, hipStream_t stream) {
    static int grid = 0;
    if (grid == 0) {
        if (n_in != 29 || out_size != ML * D || ws_size < WS_END) { fprintf(stderr, "kernel_launch: unexpected shapes (n_in %d out %d ws %zu)\n", n_in, out_size, ws_size); grid = -1; return; }
        int dev = 0, cus = 0, per_cu = 0;
        (void)hipGetDevice(&dev); (void)hipDeviceGetAttribute(&cus, hipDeviceAttributeMultiprocessorCount, dev);
        if (hipFuncSetAttribute((const void*)mk_fwd, hipFuncAttributeMaxDynamicSharedMemorySize, LDS_BYTES) != hipSuccess) { fprintf(stderr, "kernel_launch: hipFuncSetAttribute failed\n"); grid = -1; return; }
        (void)hipOccupancyMaxActiveBlocksPerMultiprocessor(&per_cu, (const void*)mk_fwd, NTHREADS, LDS_BYTES);
        (void)hipGetLastError();
        grid = cus;
        fprintf(stderr, "kernel_launch: cus %d per_cu %d grid %d\n", cus, per_cu, grid);
    }
    if (grid < 0) return;
    Args a{};
    for (int i = 0; i < 29; ++i) a.in[i] = (const float*)d_in[i];
    a.out = (float*)d_out; a.ws = (unsigned char*)d_ws;
    (void)hipMemsetAsync((char*)d_ws + WS_CTL, 0, CTL_ZERO_BYTES, stream);
#if MK_ONE_LAUNCH
    a.ph_lo = 0; a.ph_hi = NPHASES;
    void* kargs[] = {&a};
    hipError_t e = hipLaunchCooperativeKernel((const void*)mk_fwd, dim3(grid), dim3(NTHREADS), kargs, LDS_BYTES, stream);
    if (e != hipSuccess) fprintf(stderr, "kernel_launch: cooperative launch failed: %s\n", hipGetErrorString(e));
#else
    for (int ph = 0; ph < NPHASES; ++ph) { a.ph_lo = ph; a.ph_hi = ph + 1; hipLaunchKernelGGL(mk_fwd, dim3(grid), dim3(NTHREADS), LDS_BYTES, stream, a); }
#endif
}
```

```cpp
#include <hip/hip_runtime.h>
#include <hip/hip_cooperative_groups.h>
#include <cstdio>
#include <cstdint>
namespace cg = cooperative_groups;
namespace pg8 {
#define PG8_LAS __attribute__((address_space(3)))
typedef unsigned short bf16_t;
typedef short bf16x8 __attribute__((ext_vector_type(8)));
typedef float f32x4 __attribute__((ext_vector_type(4)));
typedef unsigned u32x4 __attribute__((ext_vector_type(4)));
constexpr int BM = 256, BK = 64, HALF = 128, HTB = HALF * BK * 2  , STAGE_BYTES = 8 * HTB, NXCD = 8, WGM = 8;

__host__ __device__ __forceinline__ int lds_byte(int r, int c) { const int st = (r >> 4) * 2 + (c >> 5), rr = r & 15, cc = c & 31, ob = rr * 64 + cc * 2; return st * 1024 + (ob ^ (((ob >> 9) & 1) << 5)); }
__host__ __device__ __forceinline__ void stage_rc(int b, int& R, int& C) { const int st = b / 1024, sb = b % 1024, swz = sb ^ (((sb >> 9) & 1) << 5); R = (st >> 1) * 16 + swz / 64; C = (st & 1) * 32 + (swz % 64) / 2; }
__host__ __device__ __forceinline__ int perm32(int rho) { const int n = rho >> 4, i = rho & 15; return 8 * (i >> 2) + 4 * n + (i & 3); }

struct Unit { int pm, pn; };
struct Gemm { const bf16_t* A; const bf16_t* Bt; int lda, ldb, K; };

struct StaticOrder {
    int nM, nN, nwg, G, c;
    __host__ __device__ void init(int M, int N, int G_, int c_) { nM = M / BM; nN = N / BM; nwg = nM * nN; G = G_; c = c_; }
    __host__ __device__ bool next(int i, Unit& u) const {
        const long L = (long)i * G + c; if (L >= nwg) return false;
        int wgid = (int)L; { const int q = nwg / NXCD, r = nwg % NXCD, xcd = wgid % NXCD, off = wgid / NXCD; wgid = (xcd < r ? xcd * (q + 1) : r * (q + 1) + (xcd - r) * q) + off; }
        const int nig = WGM * nN, gid = wgid / nig, fm = gid * WGM, gsz = (nM - fm) < WGM ? (nM - fm) : WGM;
        u.pm = fm + ((wgid % nig) % gsz); u.pn = (wgid % nig) / gsz; return true;
    }
    __device__ __forceinline__ void a_ready(const Unit&) const {}
    __device__ __forceinline__ void done(const Unit&) const {}
};

__device__ __forceinline__ unsigned cvt_pk_bf16(float lo, float hi) { unsigned r; asm volatile("v_cvt_pk_bf16_f32 %0, %1, %2" : "=v"(r) : "v"(lo), "v"(hi)); return r; }
typedef float f32x2 __attribute__((ext_vector_type(2)));
__device__ __forceinline__ f32x2 gelu_pk(f32x2 v) {
    const f32x2 av = __builtin_elementwise_abs(v), d = av * 0.2316418882f + 1.0f;
    f32x2 t; t.x = __builtin_amdgcn_rcpf(d.x); t.y = __builtin_amdgcn_rcpf(d.y);
    f32x2 q = t * 0.5307027145f + (-0.7265760135f); q = q * t + 0.7107068705f; q = q * t + (-0.142248368f); q = q * t + 0.127414796f; q = q * t;
    const f32x2 s = (v * v) * (-0.72134752044f);
    f32x2 e; e.x = __builtin_amdgcn_exp2f(s.x); e.y = __builtin_amdgcn_exp2f(s.y);
    const f32x2 m = v * (q * e), r = v - m;
    f32x2 o; o.x = v.x < 0.f ? m.x : r.x; o.y = v.y < 0.f ? m.y : r.y; return o;
}

template <int ACT  > struct EpiBf16 {
    static constexpr bool PERM = true, AFTER_DRAIN = false; static_assert(ACT == 0 || ACT == 1, "EpiBf16: ACT is 0 (none) or 1 (gelu_pk)");
    bf16_t* O; int ldc; const float* bias; int split_cols; size_t split_stride; float scale0;
    __device__ __forceinline__ void operator()(const f32x4 (&acc)[2][2][4][2], const Unit& u, int wr, int wc, int fr, int fq) const {
        const int row0 = u.pm * BM + wr * 64 + fr; int colt = u.pn * BM; bf16_t* base = O;
        float sc = 1.f; if (split_cols) { const int t = colt / split_cols; base += (size_t)t * split_stride; colt -= t * split_cols; if (t == 0) sc = scale0; }
        const int col0 = colt + wc * 32 + 8 * fq, bcol0 = u.pn * BM + wc * 32 + 8 * fq;
        f32x4 bv[2][2];
#pragma unroll
        for (int bj = 0; bj < 2; ++bj)
#pragma unroll
            for (int n = 0; n < 2; ++n) bv[bj][n] = bias ? *(const f32x4*)(bias + bcol0 + bj * HALF + 4 * n) : (f32x4){0.f, 0.f, 0.f, 0.f};
#pragma unroll
        for (int ai = 0; ai < 2; ++ai)
#pragma unroll
            for (int m = 0; m < 4; ++m) { bf16_t* rowp = base + (size_t)(row0 + ai * HALF + m * 16) * ldc + col0;
#pragma unroll
                for (int bj = 0; bj < 2; ++bj) { f32x4 v0 = acc[ai][bj][m][0] + bv[bj][0], v1 = acc[ai][bj][m][1] + bv[bj][1];
                    if (ACT == 1) { f32x2 a = gelu_pk((f32x2){v0[0], v0[1]}), b = gelu_pk((f32x2){v0[2], v0[3]}), c = gelu_pk((f32x2){v1[0], v1[1]}), d = gelu_pk((f32x2){v1[2], v1[3]});
                        v0 = (f32x4){a.x, a.y, b.x, b.y}; v1 = (f32x4){c.x, c.y, d.x, d.y}; }
                    v0 = v0 * sc; v1 = v1 * sc; u32x4 w; w.x = cvt_pk_bf16(v0[0], v0[1]); w.y = cvt_pk_bf16(v0[2], v0[3]); w.z = cvt_pk_bf16(v1[0], v1[1]); w.w = cvt_pk_bf16(v1[2], v1[3]);
                    *(u32x4*)(rowp + bj * HALF) = w; } }
    }
};

template <class Epi, class Sched, bool ALIGN_EPI = false, bool SP2 = false>
__device__ __forceinline__ void gemm_phase(PG8_LAS unsigned char* lds, const Gemm g, const Sched& S, const Epi& E) {
    const int tid = threadIdx.x, wid = __builtin_amdgcn_readfirstlane(tid >> 6), lane = tid & 63, wr = wid >> 2, wc = wid & 3, fr = lane & 15, fq = lane >> 4;
    const int K = g.K, nt = K / BK;
    unsigned voffA[2], voffB[2];
#pragma unroll
    for (int i = 0; i < 2; ++i) { int R, C; stage_rc(tid * 16 + i * 8192, R, C); const int Rb = Epi::PERM ? ((R & ~31) + perm32(R & 31)) : R;
        voffA[i] = (unsigned)(R * g.lda + C) * 2u; voffB[i] = (unsigned)(Rb * g.ldb + C) * 2u; }
    const size_t kstep = (size_t)(BK * 2);
    const size_t hstepA = (size_t)HALF * g.lda * 2, hstepB = (size_t)HALF * g.ldb * 2;
    const size_t tstepA = 2 * hstepA, tstepB = 2 * hstepB;
    const unsigned ldsw = (unsigned)wid * 1024u;
    const int aoff = lds_byte(wr * 64 + fr, fq * 8), boff = lds_byte(wc * 32 + fr, fq * 8);
#define PG8_SA(b, h) (((b) * 2 + (h)) * HTB)
#define PG8_SB(b, h) ((4 + (b) * 2 + (h)) * HTB)
#define PG8_STAGE(bufoff, gbase, voff) do { _Pragma("unroll") for (int _i = 0; _i < 2; ++_i) \
        __builtin_amdgcn_global_load_lds((const unsigned*)((const char*)(gbase) + (voff)[_i]), (PG8_LAS unsigned*)(lds + (bufoff) + ldsw + _i * 8192), 16, 0, 0); } while (0)
#define PG8_LDA(dst, b, h) do { _Pragma("unroll") for (int m = 0; m < 4; ++m) _Pragma("unroll") for (int k = 0; k < 2; ++k) dst[m][k] = *(const PG8_LAS bf16x8*)(lds + PG8_SA(b, h) + aoff + m * 2048 + k * 1024); } while (0)
#define PG8_LDB(dst, b, h) do { _Pragma("unroll") for (int n = 0; n < 2; ++n) _Pragma("unroll") for (int k = 0; k < 2; ++k) dst[n][k] = *(const PG8_LAS bf16x8*)(lds + PG8_SB(b, h) + boff + n * 2048 + k * 1024); } while (0)
#define PG8_MMA(ai, bj, At, Bt) do { __builtin_amdgcn_s_setprio(1); _Pragma("unroll") for (int m = 0; m < 4; ++m) _Pragma("unroll") for (int n = 0; n < 2; ++n) _Pragma("unroll") for (int k = 0; k < 2; ++k) \
        acc[ai][bj][m][n] = __builtin_amdgcn_mfma_f32_16x16x32_bf16(Bt[n][k], At[m][k], acc[ai][bj][m][n], 0, 0, 0); __builtin_amdgcn_s_setprio(0); } while (0)
#define PG8_WAIT_V(n) asm volatile("s_waitcnt vmcnt(" #n ")" ::: "memory")
#define PG8_WAIT_L(n) asm volatile("s_waitcnt lgkmcnt(" #n ")" ::: "memory")
#define PG8_BAR __builtin_amdgcn_s_barrier()
#define PG8_SCHED __builtin_amdgcn_sched_barrier(0)
    Unit cur, nxt; int ui = 0;
    if (!S.next(0, cur)) return;
    f32x4 acc[2][2][4][2];
#pragma unroll
    for (int a = 0; a < 2; ++a)
#pragma unroll
        for (int b = 0; b < 2; ++b)
#pragma unroll
            for (int m = 0; m < 4; ++m)
#pragma unroll
                for (int n = 0; n < 2; ++n) acc[a][b][m][n] = (f32x4){0.f, 0.f, 0.f, 0.f};
    bf16x8 At[4][2], B0[2][2], B1[2][2];
    const char* cA = (const char*)g.A + (size_t)cur.pm * tstepA; const char* cB = (const char*)g.Bt + (size_t)cur.pn * tstepB;
    S.a_ready(cur);
    if constexpr (SP2) {
        PG8_STAGE(PG8_SB(0, 0), cB, voffB); PG8_STAGE(PG8_SB(0, 1), cB + hstepB, voffB); PG8_STAGE(PG8_SA(0, 0), cA, voffA); PG8_STAGE(PG8_SA(0, 1), cA + hstepA, voffA);
        if (wr == 1) PG8_BAR;
        PG8_WAIT_V(2); PG8_BAR;
        PG8_STAGE(PG8_SB(1, 0), cB + kstep, voffB); PG8_STAGE(PG8_SA(1, 0), cA + kstep, voffA); PG8_STAGE(PG8_SB(1, 1), cB + hstepB + kstep, voffB);
        PG8_WAIT_V(6); PG8_BAR;
    } else {
        PG8_STAGE(PG8_SB(0, 0), cB, voffB); PG8_STAGE(PG8_SA(0, 0), cA, voffA); PG8_STAGE(PG8_SB(0, 1), cB + hstepB, voffB); PG8_STAGE(PG8_SA(0, 1), cA + hstepA, voffA);
        if (wr == 1) PG8_BAR;
        PG8_WAIT_V(4); PG8_BAR;
        PG8_STAGE(PG8_SB(1, 0), cB + kstep, voffB); PG8_STAGE(PG8_SA(1, 0), cA + kstep, voffA); PG8_STAGE(PG8_SB(1, 1), cB + hstepB + kstep, voffB);
        PG8_WAIT_V(6); PG8_BAR;
    }
    for (;;) {
        const bool has_next = S.next(ui + 1, nxt);
        const char* nA = has_next ? (const char*)g.A + (size_t)nxt.pm * tstepA : cA; const char* nB = has_next ? (const char*)g.Bt + (size_t)nxt.pn * tstepB : cB;
        for (int t = 0; t < nt; t += 2) {
            const bool last = (t == nt - 2);
            const char* a1 = cA + (size_t)(t + 1) * kstep;
            const char* a2 = last ? nA : cA + (size_t)(t + 2) * kstep; const char* b2 = last ? nB : cB + (size_t)(t + 2) * kstep;
            const char* a3 = a2 + kstep; const char* b3 = b2 + kstep;
            if (last && has_next) S.a_ready(nxt);
            if constexpr (SP2) {
            PG8_LDB(B0, 0, 0); PG8_LDB(B1, 0, 1); PG8_SCHED; PG8_LDA(At, 0, 0); PG8_STAGE(PG8_SA(1, 1), a1 + hstepA, voffA);
            PG8_WAIT_V(8); PG8_WAIT_L(0); PG8_BAR; PG8_MMA(0, 0, At, B0); PG8_MMA(0, 1, At, B1); PG8_BAR; PG8_SCHED;
            PG8_LDA(At, 0, 1); PG8_STAGE(PG8_SB(0, 0), b2, voffB); PG8_STAGE(PG8_SB(0, 1), b2 + hstepB, voffB); PG8_STAGE(PG8_SA(0, 0), a2, voffA);
            PG8_WAIT_V(8); PG8_WAIT_L(0); PG8_BAR; PG8_MMA(1, 0, At, B0); PG8_MMA(1, 1, At, B1); PG8_BAR; PG8_SCHED;
            PG8_LDB(B0, 1, 0); PG8_LDB(B1, 1, 1); PG8_SCHED; PG8_LDA(At, 1, 0); PG8_STAGE(PG8_SA(0, 1), a2 + hstepA, voffA);
            PG8_WAIT_V(8); PG8_WAIT_L(0); PG8_BAR; PG8_MMA(0, 0, At, B0); PG8_MMA(0, 1, At, B1); PG8_BAR; PG8_SCHED;
            PG8_LDA(At, 1, 1); PG8_STAGE(PG8_SB(1, 0), b3, voffB); PG8_STAGE(PG8_SB(1, 1), b3 + hstepB, voffB); PG8_STAGE(PG8_SA(1, 0), a3, voffA);
            PG8_WAIT_V(8); PG8_WAIT_L(0); PG8_BAR; PG8_MMA(1, 0, At, B0); PG8_MMA(1, 1, At, B1); PG8_BAR; PG8_SCHED;
            } else {
            PG8_LDB(B0, 0, 0); PG8_SCHED; PG8_LDA(At, 0, 0); PG8_STAGE(PG8_SA(1, 1), a1 + hstepA, voffA);
            PG8_WAIT_L(8); PG8_BAR; PG8_WAIT_L(0); PG8_MMA(0, 0, At, B0); PG8_BAR; PG8_SCHED;
            PG8_LDB(B1, 0, 1); PG8_STAGE(PG8_SB(0, 0), b2, voffB);
            PG8_BAR; PG8_WAIT_L(0); PG8_MMA(0, 1, At, B1); PG8_BAR;
            PG8_LDA(At, 0, 1); PG8_STAGE(PG8_SA(0, 0), a2, voffA);
            PG8_BAR; PG8_WAIT_L(0); PG8_MMA(1, 0, At, B0); PG8_BAR; PG8_SCHED;
            PG8_STAGE(PG8_SB(0, 1), b2 + hstepB, voffB);
            PG8_WAIT_V(6); PG8_BAR; PG8_MMA(1, 1, At, B1); PG8_BAR;
            PG8_LDB(B0, 1, 0); PG8_SCHED; PG8_LDA(At, 1, 0); PG8_STAGE(PG8_SA(0, 1), a2 + hstepA, voffA);
            PG8_WAIT_L(8); PG8_BAR; PG8_WAIT_L(0); PG8_MMA(0, 0, At, B0); PG8_BAR; PG8_SCHED;
            PG8_LDB(B1, 1, 1); PG8_STAGE(PG8_SB(1, 0), b3, voffB);
            PG8_BAR; PG8_WAIT_L(0); PG8_MMA(0, 1, At, B1); PG8_BAR;
            PG8_LDA(At, 1, 1); PG8_STAGE(PG8_SA(1, 0), a3, voffA);
            PG8_BAR; PG8_WAIT_L(0); PG8_MMA(1, 0, At, B0); PG8_BAR; PG8_SCHED;
            PG8_STAGE(PG8_SB(1, 1), b3 + hstepB, voffB);
            PG8_WAIT_V(6); PG8_BAR; PG8_MMA(1, 1, At, B1); PG8_BAR;
            }
        }
        if constexpr (ALIGN_EPI) { if (wr == 0) PG8_BAR; }
        if constexpr (!Epi::AFTER_DRAIN) { E(acc, cur, wr, wc, fr, fq); S.done(cur); }
        if (!has_next) break;
#pragma unroll
        for (int a = 0; a < 2; ++a)
#pragma unroll
            for (int b = 0; b < 2; ++b)
#pragma unroll
                for (int m = 0; m < 4; ++m)
#pragma unroll
                    for (int n = 0; n < 2; ++n) acc[a][b][m][n] = (f32x4){0.f, 0.f, 0.f, 0.f};
        cur = nxt; cA = nA; cB = nB; ++ui;
        if constexpr (ALIGN_EPI) { if (wr == 1) PG8_BAR; }
    }
    PG8_WAIT_V(0);
    if constexpr (!ALIGN_EPI) { if (wr == 0) PG8_BAR; }
    PG8_BAR;
    if constexpr (Epi::AFTER_DRAIN) { E.fused(acc, cur, wr, wc, fr, fq, lds, wid, lane); S.done(cur); }
#undef PG8_SA
#undef PG8_SB
#undef PG8_STAGE
#undef PG8_LDA
#undef PG8_LDB
#undef PG8_MMA
#undef PG8_WAIT_V
#undef PG8_WAIT_L
#undef PG8_BAR
#undef PG8_SCHED
}
}

#ifndef MK_EXP_OLD
#define MK_EXP_OLD 0
#endif
#ifndef MK_ONE_LAUNCH
#define MK_ONE_LAUNCH 1
#endif
#define LAS __attribute__((address_space(3)))
typedef unsigned short bf16;
typedef unsigned v4u __attribute__((ext_vector_type(4)));
typedef unsigned v2u __attribute__((ext_vector_type(2)));
typedef float f32x4 __attribute__((ext_vector_type(4)));
typedef float f32x2 __attribute__((ext_vector_type(2)));
typedef short bf16x8 __attribute__((ext_vector_type(8)));
typedef float f32x16 __attribute__((ext_vector_type(16)));
#define MFMA32(a, b, c) __builtin_amdgcn_mfma_f32_32x32x16_bf16((a), (b), (c), 0, 0, 0)

constexpr int D = 1024, NB = 8, SEQ = 2048, LC = 256, ML = NB * SEQ  , MC = NB * LC  , MT = ML + MC  ;
constexpr int PROJ = 2576, NPROJ = 2560;
constexpr int NEXP = 16384, TOPK = 16, KK = 128;
constexpr float EPS = 1e-6f;
constexpr int NTHREADS = 512, NWAVES = 8;
constexpr int LDS_BYTES = 147456;
constexpr int NPHASES = 16;

constexpr size_t MiB = 1u << 20;
constexpr size_t WS_CTL = 0;
constexpr size_t CTL_ZERO_BYTES = 65536;
constexpr int CW_BAR = 0;
constexpr int CW_E1 = 4096, CW_E2 = 4096 + 8 * 64;
constexpr size_t WS_MOD = 1 * MiB;
constexpr size_t WS_LP = 1 * MiB + 512 * 1024;
constexpr size_t WS_WIN = 2 * MiB;
constexpr size_t WS_WOUT = 8 * MiB;
constexpr size_t WS_WGLU = 10 * MiB;
constexpr size_t WS_WQ = 11 * MiB;
constexpr size_t WS_GB = 15 * MiB;
constexpr size_t WS_BB = 17 * MiB;
constexpr size_t WS_PM = 41 * MiB;
constexpr size_t WS_OG = 17 * MiB;
constexpr size_t WS_HX2 = 17 * MiB;
constexpr size_t WS_U5 = 49 * MiB;
constexpr size_t WS_CAT = 49 * MiB;
constexpr size_t WS_IDX = 49 * MiB;
constexpr size_t WS_GATE = 57 * MiB;
constexpr size_t WS_ACT = 65 * MiB;
constexpr size_t WS_SSQP = 73 * MiB;
constexpr size_t WS_Z = 85 * MiB;
constexpr size_t WS_YRAW = 85 * MiB;
constexpr size_t WS_QP = 85 * MiB;
constexpr size_t WS_Y = 85 * MiB;
constexpr size_t WS_HX = 101 * MiB;
constexpr size_t WS_SS = 101 * MiB;
constexpr size_t WS_YG = 101 * MiB;
constexpr size_t WS_FRT = 125 * MiB;
constexpr size_t WS_QKVPRE = 137 * MiB;
constexpr size_t WS_FRA = 143 * MiB;
constexpr size_t WS_FRK = 161 * MiB;
constexpr size_t WS_FRTAB = 197 * MiB;
constexpr size_t WS_QKV = 202 * MiB;
constexpr size_t WS_U8 = 202 * MiB;
constexpr size_t WS_V8 = 218 * MiB;
constexpr size_t WS_USC = 234 * MiB;
constexpr size_t WS_VSC = 234 * MiB + 512 * 1024;
constexpr size_t WS_HQ8 = 150 * MiB;
constexpr size_t WS_HS = 183 * MiB;
constexpr size_t WS_PACT = 85 * MiB;
constexpr size_t WS_END = 256 * MiB;
static_assert(WS_BB + (size_t)32 * 512 * 768 * 2 <= WS_PM && WS_PM + (size_t)32 * 256 * 512 * 2 <= WS_U5 && WS_U5 + (size_t)32 * 768 * 768 * 2 <= WS_Z && WS_Z + (size_t)ML * 512 * 2 <= WS_HX, "ws map a");
static_assert(WS_HX + (size_t)MT * D * 2 <= WS_QKVPRE && WS_SS + (size_t)32 * 768 * 256 * 4 <= WS_FRT && WS_QKVPRE + (size_t)MT * 1536 * 2 <= WS_QKV && WS_QKV + (size_t)MT * 1536 * 2 <= WS_END, "ws map b");
static_assert(WS_FRT + (size_t)2304 * 8192 <= WS_FRA && WS_FRA + (size_t)2304 * 8192 <= WS_FRK && WS_FRK + (size_t)2304 * 16384 <= WS_FRTAB && WS_FRTAB + (size_t)2304 * 1024 <= WS_QKV, "ws map c");
static_assert(WS_OG + (size_t)2 * ML * 512 * 2 <= WS_CAT && WS_CAT + (size_t)ML * D * 2 <= WS_Z && WS_YRAW + (size_t)ML * D * 4 <= WS_U8 && WS_SSQP + (size_t)8 * ML * 4 <= WS_Z && WS_YG + (size_t)ML * 512 * 2 <= WS_FRT, "ws map d");

__device__ __forceinline__ unsigned f2bf(float f) { unsigned u = __builtin_bit_cast(unsigned, f); return (u + 0x7fffu + ((u >> 16) & 1u)) >> 16; }
typedef __bf16 bf16x2_t __attribute__((ext_vector_type(2)));
__device__ __forceinline__ unsigned pk2(float lo, float hi) { const f32x2 v = {lo, hi}; return __builtin_bit_cast(unsigned, __builtin_convertvector(v, bf16x2_t)); }
__device__ __forceinline__ float bflo(unsigned w) { return __builtin_bit_cast(float, w << 16); }
__device__ __forceinline__ float bfhi(unsigned w) { return __builtin_bit_cast(float, w & 0xffff0000u); }
__device__ __forceinline__ float bf1(bf16 h) { return __builtin_bit_cast(float, (unsigned)h << 16); }
__device__ __forceinline__ float wave_sum(float v) {
#pragma unroll
    for (int o = 1; o < 64; o <<= 1) v += __shfl_xor(v, o);
    return v;
}
__device__ __forceinline__ float wave_max(float v) {
#pragma unroll
    for (int o = 1; o < 64; o <<= 1) v = fmaxf(v, __shfl_xor(v, o));
    return v;
}
__device__ __forceinline__ float sigmoidf_(float x) { return __builtin_amdgcn_rcpf(1.f + __expf(-x)); }
__device__ __forceinline__ float siluf_(float x) { return x * __builtin_amdgcn_rcpf(1.f + __expf(-x)); }
__device__ __forceinline__ float gelu_erf(float x) { return 0.5f * x * (1.f + erff(x * 0.70710678118654752f)); }
__device__ __forceinline__ void sincos_d(double a, float& s, float& c) {
    const double k = rint(a * 0.63661977236758134308);
    const double r = fma(-k, 1.57079632679489661923, a) - k * 6.123233995736766e-17;
    const double r2 = r * r;
    double sp = -2.5052108385441720e-08; sp = sp * r2 + 2.7557319223985893e-06; sp = sp * r2 - 1.9841269841269841e-04; sp = sp * r2 + 8.3333333333333332e-03; sp = sp * r2 - 1.6666666666666666e-01;
    const double sn = r + r * r2 * sp;
    double cp = 2.0876756987868099e-09; cp = cp * r2 - 2.7557319223985888e-07; cp = cp * r2 + 2.4801587301587302e-05; cp = cp * r2 - 1.3888888888888889e-03; cp = cp * r2 + 4.1666666666666664e-02; cp = cp * r2 - 0.5;
    const double cs = 1.0 + r2 * cp;
    const int q = ((int)k) & 3;
    const double ss = (q == 0) ? sn : (q == 1) ? cs : (q == 2) ? -sn : -cs;
    const double cc = (q == 0) ? cs : (q == 1) ? -sn : (q == 2) ? -cs : sn;
    s = (float)ss; c = (float)cc;
}

struct Args { const float* in[29]; float* out; unsigned char* ws; int ph_lo, ph_hi; };
static_assert(sizeof(Args) == 29 * 8 + 8 + 8 + 8, "Args has no padding");
enum { I_X = 0, I_C, I_CTX, I_CCTX, I_WMOD, I_BMOD, I_GPREMIX, I_GPOSTMIX, I_GPREFFN, I_GPOSTFFN, I_WIN, I_WOUT, I_LAMRE, I_LAMIM, I_LOGDT, I_BRE, I_BIM, I_CRE, I_CIM, I_S5D, I_WGLU,
       I_CONV, I_ALOG, I_DTBIAS, I_GDNNORM, I_WQ, I_KEYS, I_PU, I_PV };

__device__ __forceinline__ const float* in_row(const Args& a, int row) { return row < ML ? a.in[I_X] + (size_t)row * D : a.in[I_CTX] + (size_t)(row - ML) * D; }
__device__ __forceinline__ int mod_row(int row) { return row < ML ? (row >> 11) : 8; }

template <int CTRL> __device__ __forceinline__ float dppf(float v) { return __builtin_bit_cast(float, __builtin_amdgcn_update_dpp(0, __builtin_bit_cast(int, v), CTRL, 0xf, 0xf, true)); }
__device__ __forceinline__ float row_sum16(float v) { v += dppf<0xB1>(v); v += dppf<0x4E>(v); v += dppf<0x141>(v); v += dppf<0x140>(v); return v; }
__device__ __forceinline__ float row_max16(float v) { v = fmaxf(v, dppf<0xB1>(v)); v = fmaxf(v, dppf<0x4E>(v)); v = fmaxf(v, dppf<0x141>(v)); v = fmaxf(v, dppf<0x140>(v)); return v; }
__device__ __forceinline__ float wsum(float v) { v = row_sum16(v); return
    __builtin_bit_cast(float, __builtin_amdgcn_readlane(__builtin_bit_cast(int, v), 0)) + __builtin_bit_cast(float, __builtin_amdgcn_readlane(__builtin_bit_cast(int, v), 16)) +
    __builtin_bit_cast(float, __builtin_amdgcn_readlane(__builtin_bit_cast(int, v), 32)) + __builtin_bit_cast(float, __builtin_amdgcn_readlane(__builtin_bit_cast(int, v), 48)); }
__device__ __forceinline__ float wmax(float v) { v = row_max16(v); return fmaxf(fmaxf(__builtin_bit_cast(float, __builtin_amdgcn_readlane(__builtin_bit_cast(int, v), 0)), __builtin_bit_cast(float, __builtin_amdgcn_readlane(__builtin_bit_cast(int, v), 16))),
    fmaxf(__builtin_bit_cast(float, __builtin_amdgcn_readlane(__builtin_bit_cast(int, v), 32)), __builtin_bit_cast(float, __builtin_amdgcn_readlane(__builtin_bit_cast(int, v), 48)))); }
__device__ __forceinline__ int lane_rank(unsigned long long m) { return __builtin_amdgcn_mbcnt_hi((unsigned)(m >> 32), __builtin_amdgcn_mbcnt_lo((unsigned)m, 0)); }
__device__ __forceinline__ unsigned fkey(float f) { const unsigned u = __builtin_bit_cast(unsigned, f); return u ^ ((unsigned)((int)u >> 31) | 0x80000000u); }
#define WAVE_LDS_SYNC() do { __builtin_amdgcn_fence(__ATOMIC_RELEASE, "wavefront"); __builtin_amdgcn_wave_barrier(); __builtin_amdgcn_fence(__ATOMIC_ACQUIRE, "wavefront"); } while (0)
template <int N> __device__ __forceinline__ unsigned kth_key(const unsigned (&k)[N], int K) {
    unsigned T = 0;
    for (int bit = 31; bit >= 0; --bit) { const unsigned cand = T | (1u << bit); int cnt = 0;
#pragma unroll
        for (int n = 0; n < N; ++n) cnt += __popcll(__ballot(k[n] >= cand));
        if (cnt >= K) T = cand;
        if (cnt == K) break; }
    return T;
}

namespace pg8 {
struct EpiInProj {
    static constexpr bool PERM = true, AFTER_DRAIN = false;
    bf16_t* U; bf16_t* QKV; bf16_t* Z;
    __device__ __forceinline__ void operator()(const f32x4 (&acc)[2][2][4][2], const Unit& u, int wr, int wc, int fr, int fq) const {
        bf16_t* base; int ld, colt; bool lat_only = false;
        const bool s5 = u.pn < 2;
        if (s5) { base = U; ld = 0; colt = u.pn * BM; }
        else if (u.pn < 8) { base = QKV; ld = 1536; colt = (u.pn - 2) * BM; }
        else { base = Z; ld = 512; colt = (u.pn - 8) * BM; lat_only = true; }
        const int row0 = u.pm * BM + wr * 64 + fr, col0 = colt + wc * 32 + 8 * fq;
#pragma unroll
        for (int ai = 0; ai < 2; ++ai)
#pragma unroll
            for (int m = 0; m < 4; ++m) { const int row = row0 + ai * HALF + m * 16; bf16_t* rowp = base + (size_t)row * ld + col0;
                if (lat_only && row >= 16384) continue;
                if (s5) { const int R = row < 16384 ? (row >> 5) : 512 + ((row - 16384) >> 5), ii = row & 31; rowp = base + (size_t)R * 768 + ii * 16 + (col0 & 15); }
#pragma unroll
                for (int bj = 0; bj < 2; ++bj) { const f32x4 v0 = acc[ai][bj][m][0], v1 = acc[ai][bj][m][1];
                    u32x4 w; w.x = cvt_pk_bf16(v0[0], v0[1]); w.y = cvt_pk_bf16(v0[2], v0[3]); w.z = cvt_pk_bf16(v1[0], v1[1]); w.w = cvt_pk_bf16(v1[2], v1[3]);
                    if (s5) *(u32x4*)(rowp + (size_t)((col0 + bj * HALF) >> 4) * (768 * 768)) = w; else *(u32x4*)(rowp + bj * HALF) = w; } }
    }
};
struct EpiGlu {
    static constexpr bool PERM = true, AFTER_DRAIN = false;
    const bf16_t* YG; bf16_t* CAT;
    __device__ __forceinline__ void operator()(const f32x4 (&acc)[2][2][4][2], const Unit& u, int wr, int wc, int fr, int fq) const {
        const int row0 = u.pm * BM + wr * 64 + fr, col0 = u.pn * BM + wc * 32 + 8 * fq;
#pragma unroll
        for (int ai = 0; ai < 2; ++ai)
#pragma unroll
            for (int m = 0; m < 4; ++m) { const int row = row0 + ai * HALF + m * 16;
#pragma unroll
                for (int bj = 0; bj < 2; ++bj) { const f32x4 v0 = acc[ai][bj][m][0], v1 = acc[ai][bj][m][1];
                    const u32x4 y = *(const u32x4*)(YG + (size_t)row * 512 + col0 + bj * HALF);
                    float o[8]; const float a[8] = {v0[0], v0[1], v0[2], v0[3], v1[0], v1[1], v1[2], v1[3]};
                    const unsigned yw[4] = {y.x, y.y, y.z, y.w};
#pragma unroll
                    for (int e = 0; e < 8; ++e) { const float yv = __builtin_bit_cast(float, (e & 1) ? (yw[e >> 1] & 0xffff0000u) : (yw[e >> 1] << 16)); o[e] = yv * __builtin_amdgcn_rcpf(1.f + __expf(-a[e])); }
                    u32x4 w; w.x = cvt_pk_bf16(o[0], o[1]); w.y = cvt_pk_bf16(o[2], o[3]); w.z = cvt_pk_bf16(o[4], o[5]); w.w = cvt_pk_bf16(o[6], o[7]);
                    *(u32x4*)(CAT + (size_t)row * 1024 + col0 + bj * HALF) = w; } }
    }
};
struct EpiF32 {
    static constexpr bool PERM = false, AFTER_DRAIN = false;
    float* C; int ldc;
    __device__ __forceinline__ void operator()(const f32x4 (&acc)[2][2][4][2], const Unit& u, int wr, int wc, int fr, int fq) const {
        const int row0 = u.pm * BM + wr * 64 + fr, col0 = u.pn * BM + wc * 32 + 4 * fq;
#pragma unroll
        for (int ai = 0; ai < 2; ++ai)
#pragma unroll
            for (int m = 0; m < 4; ++m) { float* rowp = C + (size_t)(row0 + ai * HALF + m * 16) * ldc + col0;
#pragma unroll
                for (int bj = 0; bj < 2; ++bj)
#pragma unroll
                    for (int n = 0; n < 2; ++n) *(f32x4*)(rowp + bj * HALF + n * 16) = acc[ai][bj][m][n]; }
    }
};
struct EpiSS {
    static constexpr bool PERM = false, AFTER_DRAIN = false;
    float* C;
    __device__ __forceinline__ void operator()(const f32x4 (&acc)[2][2][4][2], const Unit& u, int wr, int wc, int fr, int fq) const {
        const int row0 = u.pm * BM + wr * 64 + fr, col0 = wc * 32 + 4 * fq;
#pragma unroll
        for (int ai = 0; ai < 2; ++ai)
#pragma unroll
            for (int m = 0; m < 4; ++m) { float* rowp = C + (size_t)(row0 + ai * HALF + m * 16) * 256 + col0;
#pragma unroll
                for (int bj = 0; bj < 2; ++bj)
#pragma unroll
                    for (int n = 0; n < 2; ++n) *(f32x4*)(rowp + bj * HALF + n * 16) = acc[ai][bj][m][n]; }
    }
};
struct SchedSS { int G, c; __device__ bool next(int i, Unit& u) const { const int L = i * G + c; if (L >= 96) return false; u.pm = L; u.pn = L / 3; return true; }
    __device__ __forceinline__ void a_ready(const Unit&) const {} __device__ __forceinline__ void done(const Unit&) const {} };
struct EpiS5Y {
    static constexpr bool PERM = true, AFTER_DRAIN = false;
    bf16_t* YG;
    __device__ __forceinline__ void operator()(const f32x4 (&acc)[2][2][4][2], const Unit& u, int wr, int wc, int fr, int fq) const {
        const int g = u.pn >> 1, R0 = (u.pm - 3 * g) * BM + wr * 64 + fr, n0 = (u.pn & 1) * BM + wc * 32 + 8 * fq;
#pragma unroll
        for (int ai = 0; ai < 2; ++ai)
#pragma unroll
            for (int m = 0; m < 4; ++m) { const int R = R0 + ai * HALF + m * 16;
#pragma unroll
                for (int bj = 0; bj < 2; ++bj) { const int n = n0 + bj * HALF; const f32x4 v0 = acc[ai][bj][m][0], v1 = acc[ai][bj][m][1];
                    const f32x2 a = gelu_pk((f32x2){v0[0], v0[1]}), b = gelu_pk((f32x2){v0[2], v0[3]}), c2 = gelu_pk((f32x2){v1[0], v1[1]}), d = gelu_pk((f32x2){v1[2], v1[3]});
                    u32x4 w; w.x = cvt_pk_bf16(a.x, a.y); w.y = cvt_pk_bf16(b.x, b.y); w.z = cvt_pk_bf16(c2.x, c2.y); w.w = cvt_pk_bf16(d.x, d.y);
                    *(u32x4*)(YG + (size_t)(R * 32 + (n >> 4)) * 512 + g * 16 + (n & 15)) = w; } }
    }
};
struct SchedS5Y { int G, c; __device__ bool next(int i, Unit& u) const { const int L = i * G + c; if (L >= 128) return false; const int g = L >> 2; u.pm = 3 * g + ((L >> 1) & 1); u.pn = 2 * g + (L & 1); return true; }
    __device__ __forceinline__ void a_ready(const Unit&) const {} __device__ __forceinline__ void done(const Unit&) const {} };
}

struct Ctx { const Args* a; unsigned char* ws; unsigned char* lds; int tid, lane, wave, bid, G, gw, NGW, gwv; };

__device__ __forceinline__ void p0_transpose_item(const float* W, int ldw, int nblk, int K, bf16* WT, float* scr, int item, int lane) {
    const int kb = item / nblk, nb = item % nblk, k0 = 64 * kb, n0 = 32 * nb;
#pragma unroll 8
    for (int i = 0; i < 32; ++i) { const int kk = 2 * i + (lane >> 5); scr[kk * 33 + (lane & 31)] = W[(size_t)(k0 + kk) * ldw + n0 + (lane & 31)]; }
    __builtin_amdgcn_fence(__ATOMIC_RELEASE, "wavefront"); __builtin_amdgcn_wave_barrier(); __builtin_amdgcn_fence(__ATOMIC_ACQUIRE, "wavefront");
    const int c = lane & 7;
#pragma unroll
    for (int j = 0; j < 4; ++j) { const int n = (lane >> 3) + 8 * j; const float* s = scr + (8 * c) * 33 + n;
        v4u o; o.x = pk2(s[0 * 33], s[1 * 33]); o.y = pk2(s[2 * 33], s[3 * 33]); o.z = pk2(s[4 * 33], s[5 * 33]); o.w = pk2(s[6 * 33], s[7 * 33]);
        *(v4u*)(WT + (size_t)(n0 + n) * K + k0 + 8 * c) = o; }
    __builtin_amdgcn_fence(__ATOMIC_RELEASE, "wavefront"); __builtin_amdgcn_wave_barrier(); __builtin_amdgcn_fence(__ATOMIC_ACQUIRE, "wavefront");
}
__device__ __forceinline__ void phase_prep(const Ctx& c) {
    const Args& a = *c.a;
    float* scr = (float*)(c.lds + c.wave * 16384);
    constexpr int I_IN = 16 * 80, I_OUT = 16 * 32, I_GLU = 8 * 16, I_Q = 16 * 64;
    for (int it = c.gw; it < I_IN + I_OUT + I_GLU + I_Q; it += c.NGW) {
        int r = it;
        if (r < I_IN) { p0_transpose_item(a.in[I_WIN], PROJ, 80, 1024, (bf16*)(c.ws + WS_WIN), scr, r, c.lane); continue; } r -= I_IN;
        if (r < I_OUT) { p0_transpose_item(a.in[I_WOUT], 1024, 32, 1024, (bf16*)(c.ws + WS_WOUT), scr, r, c.lane); continue; } r -= I_OUT;
        if (r < I_GLU) { p0_transpose_item(a.in[I_WGLU], 512, 16, 512, (bf16*)(c.ws + WS_WGLU), scr, r, c.lane); continue; } r -= I_GLU;
        p0_transpose_item(a.in[I_WQ], 2048, 64, 1024, (bf16*)(c.ws + WS_WQ), scr, r, c.lane);
    }
    __syncthreads();
    float* sc = (float*)c.lds;
    float* red = (float*)(c.lds + 9 * 1024 * 4);
    float* MOD = (float*)(c.ws + WS_MOD);
    bool have = false;
    for (int item = c.bid; item < 96; item += c.G) {
        if (!have) { for (int i = c.tid; i < 9 * 1024; i += NTHREADS) { const int r = i >> 10, k = i & 1023; const float v = r < 8 ? a.in[I_C][r * 1024 + k] : a.in[I_CCTX][k]; sc[i] = siluf_(v); } have = true; __syncthreads(); }
        const int n0 = item * 64;
        float acc[9];
#pragma unroll
        for (int r = 0; r < 9; ++r) acc[r] = 0.f;
        const float* wp = a.in[I_WMOD] + (size_t)(c.wave * 128) * 6144 + n0 + c.lane;
#pragma unroll 16
        for (int k = 0; k < 128; ++k) { const float w = wp[(size_t)k * 6144];
#pragma unroll
            for (int r = 0; r < 9; ++r) acc[r] = fmaf(sc[r * 1024 + c.wave * 128 + k], w, acc[r]); }
#pragma unroll
        for (int r = 0; r < 9; ++r) red[(c.wave * 9 + r) * 64 + c.lane] = acc[r];
        __syncthreads();
        for (int i = c.tid; i < 576; i += NTHREADS) { const int r = i >> 6, l = i & 63; float s = a.in[I_BMOD][n0 + l];
#pragma unroll
            for (int w = 0; w < 8; ++w) s += red[(w * 9 + r) * 64 + l];
            MOD[r * 6144 + n0 + l] = s; }
        __syncthreads();
    }
}
__device__ __forceinline__ void s5_build_group(const Ctx& c, int g, int part);
__device__ __forceinline__ void phase_s5_build(const Ctx& c) { for (int it = c.G - 1 - c.bid; it < 128; it += c.G) if (it >= 0) s5_build_group(c, it >> 2, it & 3); }

__device__ __forceinline__ void phase_norm1(const Ctx& c) {
    const Args& a = *c.a;
    float* wabT = (float*)c.lds;
    { f32x4 wv[8];
#pragma unroll
      for (int q = 0; q < 8; ++q) { const int i = c.tid + NTHREADS * q, kk = i >> 2, qq = i & 3; wv[q] = *(const f32x4*)(a.in[I_WIN] + (size_t)kk * PROJ + NPROJ + 4 * qq); }
#pragma unroll
      for (int q = 0; q < 8; ++q) { const int i = c.tid + NTHREADS * q, kk = i >> 2, qq = i & 3; wabT[(4 * qq + 0) * 1028 + kk] = wv[q].x; wabT[(4 * qq + 1) * 1028 + kk] = wv[q].y; wabT[(4 * qq + 2) * 1028 + kk] = wv[q].z; wabT[(4 * qq + 3) * 1028 + kk] = wv[q].w; } }
    __syncthreads();
    const float* MOD = (const float*)(c.ws + WS_MOD);
    bf16* HX = (bf16*)(c.ws + WS_HX); float* GB = (float*)(c.ws + WS_GB);
    const float* gpre = a.in[I_GPREMIX];
    f32x4 nx[4];
    if (c.gw < MT) { const f32x4* xr = (const f32x4*)in_row(a, c.gw) + c.lane;
#pragma unroll
        for (int j = 0; j < 4; ++j) nx[j] = xr[64 * j]; }
    for (int row = c.gw; row < MT; row += c.NGW) {
        const float* mr = MOD + mod_row(row) * 6144;
        f32x4 v[4]; float ss = 0.f;
#pragma unroll
        for (int j = 0; j < 4; ++j) { v[j] = nx[j]; ss += (v[j].x * v[j].x + v[j].y * v[j].y) + (v[j].z * v[j].z + v[j].w * v[j].w); }
        if (row + c.NGW < MT) { const f32x4* xr = (const f32x4*)in_row(a, row + c.NGW) + c.lane;
#pragma unroll
            for (int j = 0; j < 4; ++j) nx[j] = xr[64 * j]; }
        const float r = rsqrtf(wsum(ss) * (1.f / D) + EPS);
#pragma unroll
        for (int j = 0; j < 4; ++j) { const int col = 4 * c.lane + 256 * j;
            const f32x4 g4 = *(const f32x4*)(gpre + col), sh = *(const f32x4*)(mr + col), scl = *(const f32x4*)(mr + 1024 + col);
            v[j] = (v[j] * r) * g4 * (scl + 1.f) + sh;
            v2u o; o.x = pk2(v[j].x, v[j].y); o.y = pk2(v[j].z, v[j].w);
            *(v2u*)(HX + (size_t)row * D + col) = o; }
        float pj[16];
#pragma unroll
        for (int j = 0; j < 16; ++j) { float s = 0.f;
#pragma unroll
            for (int jj = 0; jj < 4; ++jj) { const f32x4 w = *(const f32x4*)(wabT + j * 1028 + 4 * c.lane + 256 * jj); s += (v[jj].x * w.x + v[jj].y * w.y) + (v[jj].z * w.z + v[jj].w * w.w); }
            pj[j] = s; if ((j & 1) == 1) asm volatile("" ::: "memory"); }
        const bool b5 = c.lane & 32, b4 = c.lane & 16, b3 = c.lane & 8, b2 = c.lane & 4;
        float q8[8], q4[4], q2[2];
#pragma unroll
        for (int i = 0; i < 8; ++i) { const float keep = b5 ? pj[i + 8] : pj[i], send = b5 ? pj[i] : pj[i + 8]; q8[i] = keep + __shfl_xor(send, 32); }
#pragma unroll
        for (int i = 0; i < 4; ++i) { const float keep = b4 ? q8[i + 4] : q8[i], send = b4 ? q8[i] : q8[i + 4]; q4[i] = keep + __shfl_xor(send, 16); }
#pragma unroll
        for (int i = 0; i < 2; ++i) { const float keep = b3 ? q4[i + 2] : q4[i], send = b3 ? q4[i] : q4[i + 2]; q2[i] = keep + dppf<0x140>(send); }
        float mine; { const float keep = b2 ? q2[1] : q2[0], send = b2 ? q2[0] : q2[1]; mine = keep + dppf<0x141>(send); }
        mine += dppf<0xB1>(mine); mine += dppf<0x4E>(mine);
        const int jl = (b5 ? 8 : 0) + (b4 ? 4 : 0) + (b3 ? 2 : 0) + (b2 ? 1 : 0);
        if ((c.lane & 3) == 0) {
            if (jl < 8) { const float t = mine + a.in[I_DTBIAS][jl]; const float sp = t > 20.f ? t : log1pf(expf(t)); GB[(size_t)row * 16 + jl] = -expf(a.in[I_ALOG][jl]) * sp; }
            else GB[(size_t)row * 16 + jl] = 1.f / (1.f + expf(-mine)); }
    }
}

__device__ __forceinline__ void phase_conv(const Ctx& c) {
    const Args& a = *c.a;
    const bf16* PRE = (const bf16*)(c.ws + WS_QKVPRE); bf16* OUT = (bf16*)(c.ws + WS_QKV);
    const float* cw = a.in[I_CONV];
#pragma unroll 1
    for (int pass = 0; pass < 3; ++pass) { const int ch0 = pass * 512 + 8 * c.lane;
        f32x4 wt[9][2];
#pragma unroll
        for (int i = 0; i < 9; ++i) { wt[i][0] = *(const f32x4*)(cw + i * 1536 + ch0); wt[i][1] = *(const f32x4*)(cw + i * 1536 + ch0 + 4); }
#define CONV_LOAD(DST, ROW) do { const int row_ = (ROW); int nb_row[9]; bool ok[9]; \
            if (row_ < ML) { const int t = row_ & 2047, gr = t >> 6, gc = t & 63; \
                _Pragma("unroll") for (int dy = -1; dy <= 1; ++dy) _Pragma("unroll") for (int dx = -1; dx <= 1; ++dx) { const int i = (dy + 1) * 3 + dx + 1; ok[i] = (gr + dy >= 0) && (gr + dy < 32) && (gc + dx >= 0) && (gc + dx < 64); nb_row[i] = row_ + dy * 64 + dx; } } \
            else { const int t = (row_ - ML) & 255; _Pragma("unroll") for (int i = 0; i < 9; ++i) { ok[i] = false; nb_row[i] = row_; } \
                _Pragma("unroll") for (int dx = -1; dx <= 1; ++dx) { ok[4 + dx] = (t + dx >= 0) && (t + dx < 256); nb_row[4 + dx] = row_ + dx; } } \
            _Pragma("unroll") for (int i = 0; i < 9; ++i) DST[i] = ok[i] ? *(const v4u*)(PRE + (size_t)nb_row[i] * 1536 + ch0) : (v4u){0u, 0u, 0u, 0u}; } while (0)
        v4u nin[9];
        if (c.gw < MT) CONV_LOAD(nin, c.gw);
#pragma unroll 1
        for (int row = c.gw; row < MT; row += c.NGW) {
            v4u in[9];
#pragma unroll
            for (int i = 0; i < 9; ++i) in[i] = nin[i];
            if (row + c.NGW < MT) CONV_LOAD(nin, row + c.NGW);
            float o[8];
#pragma unroll
            for (int q = 0; q < 8; ++q) o[q] = 0.f;
#pragma unroll
            for (int i = 0; i < 9; ++i) { const unsigned w[4] = {in[i].x, in[i].y, in[i].z, in[i].w}; const float kk[8] = {wt[i][0].x, wt[i][0].y, wt[i][0].z, wt[i][0].w, wt[i][1].x, wt[i][1].y, wt[i][1].z, wt[i][1].w};
#pragma unroll
                for (int q = 0; q < 4; ++q) { o[2 * q] = fmaf(bflo(w[q]), kk[2 * q], o[2 * q]); o[2 * q + 1] = fmaf(bfhi(w[q]), kk[2 * q + 1], o[2 * q + 1]); } }
            float ssq = 0.f;
#pragma unroll
            for (int q = 0; q < 8; ++q) { o[q] = siluf_(o[q]); ssq = fmaf(o[q], o[q], ssq); }
            if (pass < 2) { const float sc = rsqrtf(row_sum16(ssq) + EPS) * (pass == 0 ? 0.08838834764831845f : 1.f);
#pragma unroll
                for (int q = 0; q < 8; ++q) o[q] *= sc; }
            v4u ov; ov.x = pk2(o[0], o[1]); ov.y = pk2(o[2], o[3]); ov.z = pk2(o[4], o[5]); ov.w = pk2(o[6], o[7]);
            *(v4u*)(OUT + (size_t)row * 1536 + ch0) = ov;
        }
#undef CONV_LOAD
    }
}

__device__ __forceinline__ int scan_row(int b, int dir, int step) {
    if (step < LC) { const int t = dir ? LC - 1 - step : step; return ML + b * LC + t; }
    const int t = step - LC; return b * SEQ + (dir ? SEQ - 1 - t : t);
}
__device__ __forceinline__ void phase_combine(const Ctx& c) {
    const Args& a = *c.a;
    const bf16* OG0 = (const bf16*)(c.ws + WS_OG); const bf16* OG1 = OG0 + (size_t)ML * 512; const bf16* Z = (const bf16*)(c.ws + WS_Z);
    bf16* CAT = (bf16*)(c.ws + WS_CAT);
    for (int row = c.gw; row < ML; row += c.NGW) {
#pragma unroll
        for (int h = 0; h < 4; ++h) { const int ch = h * 128 + 2 * c.lane;
            const unsigned w0 = *(const unsigned*)(OG0 + (size_t)row * 512 + ch), w1 = *(const unsigned*)(OG1 + (size_t)row * 512 + ch), zw = *(const unsigned*)(Z + (size_t)row * 512 + ch);
            const float o0 = bflo(w0) + bflo(w1), o1 = bfhi(w0) + bfhi(w1);
            const float r = rsqrtf(wave_sum(o0 * o0 + o1 * o1) * (1.f / 128.f) + EPS);
            const f32x2 ng = *(const f32x2*)(a.in[I_GDNNORM] + 2 * c.lane);
            *(unsigned*)(CAT + (size_t)row * 1024 + 512 + ch) = pk2(o0 * r * ng.x * siluf_(bflo(zw)), o1 * r * ng.y * siluf_(bfhi(zw))); }
    }
}

__device__ __forceinline__ void phase_rows2(const Ctx& c) {
    const Args& a = *c.a;
    const float* MOD = (const float*)(c.ws + WS_MOD); const bf16* YRAW = (const bf16*)(c.ws + WS_YRAW); bf16* HX2 = (bf16*)(c.ws + WS_HX2);
    v2u ny[4]; f32x4 nxx[4];
    if (c.gw < ML) {
#pragma unroll
        for (int j = 0; j < 4; ++j) { ny[j] = *((const v2u*)(YRAW + (size_t)c.gw * D) + c.lane + 64 * j); nxx[j] = *((const f32x4*)(a.in[I_X] + (size_t)c.gw * D) + c.lane + 64 * j); } }
    for (int row = c.gw; row < ML; row += c.NGW) {
        const float* mr = MOD + (row >> 11) * 6144;
        f32x4 y[4], x[4]; float ss = 0.f;
#pragma unroll
        for (int j = 0; j < 4; ++j) { y[j] = (f32x4){bflo(ny[j].x), bfhi(ny[j].x), bflo(ny[j].y), bfhi(ny[j].y)}; x[j] = nxx[j];
            ss += (y[j].x * y[j].x + y[j].y * y[j].y) + (y[j].z * y[j].z + y[j].w * y[j].w); }
        if (row + c.NGW < ML) { const size_t r2 = (size_t)(row + c.NGW);
#pragma unroll
            for (int j = 0; j < 4; ++j) { ny[j] = *((const v2u*)(YRAW + r2 * D) + c.lane + 64 * j); nxx[j] = *((const f32x4*)(a.in[I_X] + r2 * D) + c.lane + 64 * j); } }
        const float r = rsqrtf(wsum(ss) * (1.f / D) + EPS); float s2 = 0.f;
#pragma unroll
        for (int j = 0; j < 4; ++j) { const int col = 4 * c.lane + 256 * j;
            const f32x4 g4 = *(const f32x4*)(a.in[I_GPOSTMIX] + col), gt = *(const f32x4*)(mr + 2048 + col);
            x[j] = x[j] + gt * ((y[j] * r) * g4);
            *(f32x4*)(a.out + (size_t)row * D + col) = x[j];
            s2 += (x[j].x * x[j].x + x[j].y * x[j].y) + (x[j].z * x[j].z + x[j].w * x[j].w); }
        const float r2 = rsqrtf(wsum(s2) * (1.f / D) + EPS);
#pragma unroll
        for (int j = 0; j < 4; ++j) { const int col = 4 * c.lane + 256 * j;
            const f32x4 g4 = *(const f32x4*)(a.in[I_GPREFFN] + col), sh = *(const f32x4*)(mr + 3072 + col), scl = *(const f32x4*)(mr + 4096 + col);
            const f32x4 hv = (x[j] * r2) * g4 * (scl + 1.f) + sh;
            v2u o; o.x = pk2(hv.x, hv.y); o.y = pk2(hv.z, hv.w);
            *(v2u*)(HX2 + (size_t)row * D + col) = o;
            x[j] = (f32x4){bflo(o.x), bfhi(o.x), bflo(o.y), bfhi(o.y)}; }
        { float mx = 0.f;
#pragma unroll
          for (int j = 0; j < 4; ++j) mx = fmaxf(mx, fmaxf(fmaxf(fabsf(x[j].x), fabsf(x[j].y)), fmaxf(fabsf(x[j].z), fabsf(x[j].w))));
          mx = wmax(mx); const float hs = mx > 0.f ? 256.f / mx : 1.f;
          unsigned char* hq = c.ws + WS_HQ8 + (size_t)row * 2048;
#pragma unroll
          for (int j = 0; j < 4; ++j) { const float a0 = x[j].x * hs, a1 = x[j].y * hs, a2 = x[j].z * hs, a3 = x[j].w * hs;
              int w = __builtin_amdgcn_cvt_pk_fp8_f32(a0, a1, 0, false); w = __builtin_amdgcn_cvt_pk_fp8_f32(a2, a3, w, true);
              const f32x2 b01 = __builtin_amdgcn_cvt_pk_f32_fp8(w, false), b23 = __builtin_amdgcn_cvt_pk_f32_fp8(w, true);
              int w2 = __builtin_amdgcn_cvt_pk_fp8_f32((a0 - b01.x) * 16.f, (a1 - b01.y) * 16.f, 0, false); w2 = __builtin_amdgcn_cvt_pk_fp8_f32((a2 - b23.x) * 16.f, (a3 - b23.y) * 16.f, w2, true);
              *(unsigned*)(hq + 4 * c.lane + 256 * j) = (unsigned)w; *(unsigned*)(hq + 1024 + 4 * c.lane + 256 * j) = (unsigned)w2; }
          if (c.lane == 0) ((float*)(c.ws + WS_HS))[row] = 1.f / hs; }
    }
}


constexpr int KROW = 136;
__device__ __forceinline__ float unfkey(unsigned k) { const unsigned u = (k & 0x80000000u) ? (k ^ 0x80000000u) : ~k; return __builtin_bit_cast(float, u); }
__device__ __forceinline__ void ins16(unsigned (&L)[16], unsigned key) {
#pragma unroll
    for (int q = 0; q < 16; ++q) { const unsigned hi = L[q] > key ? L[q] : key, lo = L[q] > key ? key : L[q]; L[q] = hi; key = lo; }
}
__device__ __forceinline__ void merge16(unsigned (&L)[16]) {
    unsigned R[16];
#pragma unroll
    for (int q = 0; q < 16; ++q) R[q] = (unsigned)__shfl_xor((int)L[15 - q], 32);
#pragma unroll
    for (int q = 0; q < 16; ++q) L[q] = L[q] > R[q] ? L[q] : R[q];
#pragma unroll
    for (int j = 8; j >= 1; j >>= 1)
#pragma unroll
        for (int q = 0; q < 16; ++q) if ((q & j) == 0) { const unsigned hi = L[q] > L[q + j] ? L[q] : L[q + j], lo = L[q] > L[q + j] ? L[q + j] : L[q]; L[q] = hi; L[q + j] = lo; }
}
__device__ __forceinline__ void phase_topk(const Ctx& c) {
    const Args& a = *c.a;
    bf16* kl = (bf16*)c.lds;
    unsigned char* wtab = c.lds + 2 * 128 * KROW * 2 + c.wave * 1088;
    const bf16* QP = (const bf16*)(c.ws + WS_QP); int* IDX = (int*)(c.ws + WS_IDX); float* GATE = (float*)(c.ws + WS_GATE);
    const int r = c.lane & 31, hh = c.lane >> 5;
    { const unsigned char ptab[50] = {0, 1, 2, 3, 4, 5, 6, 7, 8, 9, 10, 11, 12, 13, 14, 15, 16, 17, 18, 19, 20, 21, 22, 23, 32, 33, 34, 35, 36, 48, 49, 50, 51, 64, 65, 66, 80, 81, 96, 97, 112, 113, 128, 144, 160, 176, 192, 208, 224, 240};
      if (c.lane < 50) wtab[1024 + c.lane] = ptab[c.lane < 50 ? c.lane : 0]; }
    for (int item = c.bid; item < 8 * 32; item += c.G) {
        const int h = item & 7, tr = item >> 3;
        __syncthreads();
        for (int i = c.tid; i < 2 * 128 * 64; i += NTHREADS) { const int k2 = i & 63, n = (i >> 6) & 127, p = i >> 13; const f32x2 kv = *(const f32x2*)(a.in[I_KEYS] + ((size_t)((h * 2 + p) * 128 + n)) * 128 + 2 * k2);
            *(unsigned*)(kl + (p * 128 + n) * KROW + 2 * k2) = pk2(kv.x, kv.y); }
        __syncthreads();
        for (int tile = c.wave; tile < 16; tile += NWAVES) {
            const int tok = tr * 512 + tile * 32 + r;
            unsigned LA[16], LB[16];
#pragma unroll
            for (int p = 0; p < 2; ++p) {
                bf16x8 qf[8];
#pragma unroll
                for (int kk = 0; kk < 8; ++kk) qf[kk] = *(const bf16x8*)(QP + (size_t)tok * 2048 + h * 256 + p * 128 + kk * 16 + hh * 8);
                f32x16 acc[4];
#pragma unroll
                for (int nt = 0; nt < 4; ++nt)
#pragma unroll
                    for (int i = 0; i < 16; ++i) acc[nt][i] = 0.f;
#pragma unroll
                for (int kk = 0; kk < 8; ++kk)
#pragma unroll
                    for (int nt = 0; nt < 4; ++nt) acc[nt] = MFMA32(*(const bf16x8*)(kl + (p * 128 + nt * 32 + r) * KROW + kk * 16 + hh * 8), qf[kk], acc[nt]);
                unsigned (&L)[16] = p ? LB : LA;
#pragma unroll
                for (int q = 0; q < 16; ++q) L[q] = 0u;
#pragma unroll
                for (int nt = 0; nt < 4; ++nt)
#pragma unroll
                    for (int i = 0; i < 16; ++i) { const int n = nt * 32 + (i & 3) + 8 * (i >> 2) + 4 * hh; ins16(L, (fkey(acc[nt][i]) & ~127u) | (unsigned)(127 - n)); }
                merge16(L);
            }
            unsigned char* tt = wtab + r * 32;
            if (hh == 0) {
#pragma unroll
                for (int q = 0; q < 16; ++q) tt[q] = (unsigned char)(127u - (LA[q] & 127u)); }
            else {
#pragma unroll
                for (int q = 0; q < 16; ++q) tt[16 + q] = (unsigned char)(127u - (LB[q] & 127u)); }
            float va[16], vb[16];
#pragma unroll
            for (int q = 0; q < 16; ++q) { va[q] = unfkey(LA[q] & ~127u); vb[q] = unfkey(LB[q] & ~127u); }
            unsigned LC[16];
#pragma unroll
            for (int q = 0; q < 16; ++q) LC[q] = 0u;
            { const float s0 = va[0] + vb[0], s1 = va[0] + vb[1]; ins16(LC, (fkey(hh ? s1 : s0) & ~63u) | (unsigned)(63 - (0 + hh))); }
            { const float s0 = va[0] + vb[2], s1 = va[0] + vb[3]; ins16(LC, (fkey(hh ? s1 : s0) & ~63u) | (unsigned)(63 - (2 + hh))); }
            { const float s0 = va[0] + vb[4], s1 = va[0] + vb[5]; ins16(LC, (fkey(hh ? s1 : s0) & ~63u) | (unsigned)(63 - (4 + hh))); }
            { const float s0 = va[0] + vb[6], s1 = va[0] + vb[7]; ins16(LC, (fkey(hh ? s1 : s0) & ~63u) | (unsigned)(63 - (6 + hh))); }
            { const float s0 = va[0] + vb[8], s1 = va[0] + vb[9]; ins16(LC, (fkey(hh ? s1 : s0) & ~63u) | (unsigned)(63 - (8 + hh))); }
            { const float s0 = va[0] + vb[10], s1 = va[0] + vb[11]; ins16(LC, (fkey(hh ? s1 : s0) & ~63u) | (unsigned)(63 - (10 + hh))); }
            { const float s0 = va[0] + vb[12], s1 = va[0] + vb[13]; ins16(LC, (fkey(hh ? s1 : s0) & ~63u) | (unsigned)(63 - (12 + hh))); }
            { const float s0 = va[0] + vb[14], s1 = va[0] + vb[15]; ins16(LC, (fkey(hh ? s1 : s0) & ~63u) | (unsigned)(63 - (14 + hh))); }
            { const float s0 = va[1] + vb[0], s1 = va[1] + vb[1]; ins16(LC, (fkey(hh ? s1 : s0) & ~63u) | (unsigned)(63 - (16 + hh))); }
            { const float s0 = va[1] + vb[2], s1 = va[1] + vb[3]; ins16(LC, (fkey(hh ? s1 : s0) & ~63u) | (unsigned)(63 - (18 + hh))); }
            { const float s0 = va[1] + vb[4], s1 = va[1] + vb[5]; ins16(LC, (fkey(hh ? s1 : s0) & ~63u) | (unsigned)(63 - (20 + hh))); }
            { const float s0 = va[1] + vb[6], s1 = va[1] + vb[7]; ins16(LC, (fkey(hh ? s1 : s0) & ~63u) | (unsigned)(63 - (22 + hh))); }
            { const float s0 = va[2] + vb[0], s1 = va[2] + vb[1]; ins16(LC, (fkey(hh ? s1 : s0) & ~63u) | (unsigned)(63 - (24 + hh))); }
            { const float s0 = va[2] + vb[2], s1 = va[2] + vb[3]; ins16(LC, (fkey(hh ? s1 : s0) & ~63u) | (unsigned)(63 - (26 + hh))); }
            { const float s0 = va[2] + vb[4], s1 = va[3] + vb[0]; ins16(LC, (fkey(hh ? s1 : s0) & ~63u) | (unsigned)(63 - (28 + hh))); }
            { const float s0 = va[3] + vb[1], s1 = va[3] + vb[2]; ins16(LC, (fkey(hh ? s1 : s0) & ~63u) | (unsigned)(63 - (30 + hh))); }
            { const float s0 = va[3] + vb[3], s1 = va[4] + vb[0]; ins16(LC, (fkey(hh ? s1 : s0) & ~63u) | (unsigned)(63 - (32 + hh))); }
            { const float s0 = va[4] + vb[1], s1 = va[4] + vb[2]; ins16(LC, (fkey(hh ? s1 : s0) & ~63u) | (unsigned)(63 - (34 + hh))); }
            { const float s0 = va[5] + vb[0], s1 = va[5] + vb[1]; ins16(LC, (fkey(hh ? s1 : s0) & ~63u) | (unsigned)(63 - (36 + hh))); }
            { const float s0 = va[6] + vb[0], s1 = va[6] + vb[1]; ins16(LC, (fkey(hh ? s1 : s0) & ~63u) | (unsigned)(63 - (38 + hh))); }
            { const float s0 = va[7] + vb[0], s1 = va[7] + vb[1]; ins16(LC, (fkey(hh ? s1 : s0) & ~63u) | (unsigned)(63 - (40 + hh))); }
            { const float s0 = va[8] + vb[0], s1 = va[9] + vb[0]; ins16(LC, (fkey(hh ? s1 : s0) & ~63u) | (unsigned)(63 - (42 + hh))); }
            { const float s0 = va[10] + vb[0], s1 = va[11] + vb[0]; ins16(LC, (fkey(hh ? s1 : s0) & ~63u) | (unsigned)(63 - (44 + hh))); }
            { const float s0 = va[12] + vb[0], s1 = va[13] + vb[0]; ins16(LC, (fkey(hh ? s1 : s0) & ~63u) | (unsigned)(63 - (46 + hh))); }
            { const float s0 = va[14] + vb[0], s1 = va[15] + vb[0]; ins16(LC, (fkey(hh ? s1 : s0) & ~63u) | (unsigned)(63 - (48 + hh))); }
            merge16(LC);
            WAVE_LDS_SYNC();
            float ev[16]; float den = 0.f; const float mx = unfkey(LC[0] & ~63u);
#pragma unroll
            for (int q = 0; q < 16; ++q) { ev[q] = __expf(unfkey(LC[q] & ~63u) - mx); den += ev[q]; }
            const float inv = 1.f / den;
            if (hh == 0) { int ex[16];
#pragma unroll
                for (int q = 0; q < 16; ++q) { const unsigned pc = wtab[1024 + (63u - (LC[q] & 63u))]; ex[q] = (int)tt[pc >> 4] * 128 + (int)tt[16 + (pc & 15u)]; }
#pragma unroll
                for (int q = 0; q < 4; ++q) *(v4u*)(IDX + (size_t)tok * 128 + h * 16 + 4 * q) = (v4u){(unsigned)ex[4 * q], (unsigned)ex[4 * q + 1], (unsigned)ex[4 * q + 2], (unsigned)ex[4 * q + 3]}; }
            else {
#pragma unroll
                for (int q = 0; q < 4; ++q) *(f32x4*)(GATE + (size_t)tok * 128 + h * 16 + 4 * q) = (f32x4){ev[4 * q] * inv, ev[4 * q + 1] * inv, ev[4 * q + 2] * inv, ev[4 * q + 3] * inv}; }
            WAVE_LDS_SYNC();
        }
    }
}

__device__ __forceinline__ void phase_fp8_tables(const Ctx& c) {
    const Args& a = *c.a;
    for (int r = c.gw; r < 2 * NEXP; r += c.NGW) {
        const bool isv = r >= NEXP; const int e = isv ? r - NEXP : r;
        const f32x4* src = (const f32x4*)((isv ? a.in[I_PV] : a.in[I_PU]) + (size_t)e * D) + c.lane;
        f32x4 v[4]; float m = 0.f;
#pragma unroll
        for (int j = 0; j < 4; ++j) { v[j] = src[64 * j]; m = fmaxf(m, fmaxf(fmaxf(fabsf(v[j].x), fabsf(v[j].y)), fmaxf(fabsf(v[j].z), fabsf(v[j].w)))); }
        m = wmax(m); const float inv = m > 0.f ? 256.f / m : 0.f;
        unsigned char* dst = c.ws + (isv ? WS_V8 : WS_U8) + (size_t)e * D + 4 * c.lane;
#pragma unroll
        for (int j = 0; j < 4; ++j) { int w = __builtin_amdgcn_cvt_pk_fp8_f32(v[j].x * inv, v[j].y * inv, 0, false); w = __builtin_amdgcn_cvt_pk_fp8_f32(v[j].z * inv, v[j].w * inv, w, true); *(unsigned*)(dst + 256 * j) = (unsigned)w; }
        if (c.lane == 0) ((float*)(c.ws + (isv ? WS_VSC : WS_USC)))[e] = m * (1.f / 256.f);
    }
}
__device__ __forceinline__ void fp8x16_to_f32(const v4u& r, float (&f)[16]) {
    const unsigned w[4] = {r.x, r.y, r.z, r.w};
#pragma unroll
    for (int j = 0; j < 4; ++j) { const f32x2 lo = __builtin_amdgcn_cvt_pk_f32_fp8((int)w[j], false), hi = __builtin_amdgcn_cvt_pk_f32_fp8((int)w[j], true); f[4 * j] = lo.x; f[4 * j + 1] = lo.y; f[4 * j + 2] = hi.x; f[4 * j + 3] = hi.y; }
}
__device__ __forceinline__ unsigned xcc_id() { return (unsigned)__builtin_amdgcn_s_getreg((3 << 11) | 20) & 7u; }

typedef long l64x2 __attribute__((ext_vector_type(2)));
struct E1Bat { l64x2 rw[16]; };
__device__ __forceinline__ void phase_exp1(const Ctx& c) {
    typedef float f32x4m __attribute__((ext_vector_type(4)));
    const int* IDX = (const int*)(c.ws + WS_IDX); const unsigned char* U8 = c.ws + WS_U8; float* PACT = (float*)(c.ws + WS_PACT);
    unsigned* cnt = (unsigned*)(c.ws + WS_CTL) + CW_E1;
    constexpr int CH = 8;
    constexpr int SROW = 144;
    unsigned char* wl = c.lds + c.wave * 11776; int* le = (int*)wl; unsigned char* himg = wl + 4096; float* res = (float*)(wl + 6144); unsigned char* stage = wl + 6656;
    const int xcc = (int)xcc_id(), r16 = c.lane & 15, g4 = c.lane >> 4, row8 = c.lane >> 3, pc8 = c.lane & 7; const bool bcol = r16 < 2;
    int bo = 0; unsigned tq = 0;
    if (c.lane == 0) tq = __hip_atomic_fetch_add(cnt + 64 * (xcc & 7), (unsigned)CH, __ATOMIC_RELAXED, __HIP_MEMORY_SCOPE_AGENT);
    for (;;) {
        const int x = (xcc + bo) & 7;
        const unsigned t0 = (unsigned)__builtin_amdgcn_readfirstlane((int)tq);
        if (t0 >= (unsigned)ML) { if (++bo >= 8) break; tq = 0; if (c.lane == 0) tq = __hip_atomic_fetch_add(cnt + 64 * ((xcc + bo) & 7), (unsigned)CH, __ATOMIC_RELAXED, __HIP_MEMORY_SCOPE_AGENT); continue; }
        tq = 0; if (c.lane == 0) tq = __hip_atomic_fetch_add(cnt + 64 * x, (unsigned)CH, __ATOMIC_RELAXED, __HIP_MEMORY_SCOPE_AGENT);
        { v4u ee[4], im[2];
#pragma unroll
          for (int q = 0; q < 4; ++q) ee[q] = *(const v4u*)(IDX + (size_t)t0 * 128 + 256 * q + 4 * c.lane);
#pragma unroll
          for (int q = 0; q < 2; ++q) { const int p = c.lane + 64 * q; im[q] = *(const v4u*)(c.ws + WS_HQ8 + ((size_t)t0 + (p >> 4)) * 2048 + ((p >> 3) & 1) * 1024 + 128 * x + 16 * (p & 7)); }
#pragma unroll
          for (int q = 0; q < 4; ++q) *(v4u*)(le + 256 * q + 4 * c.lane) = ee[q];
#pragma unroll
          for (int q = 0; q < 2; ++q) *(v4u*)(himg + 16 * (c.lane + 64 * q)) = im[q]; }
        WAVE_LDS_SYNC();
#define E1_LOAD(G, B) do { const int bb = (B) < CH ? (B) : 0; _Pragma("unroll") for (int i = 0; i < 16; ++i) G.rw[i] = *(const l64x2*)(U8 + (size_t)le[bb * 128 + 8 * i + row8] * D + 128 * x + 16 * pc8); } while (0)
#define E1_COMP(G, B) do { const unsigned char* hb = himg + ((B) * 2 + (r16 & 1)) * 128 + 32 * g4; long bq[4]; _Pragma("unroll") for (int m = 0; m < 4; ++m) { const long v = *(const long*)(hb + 8 * m); bq[m] = bcol ? v : 0l; } \
            _Pragma("unroll") for (int gi = 0; gi < 8; ++gi) { unsigned char* sb = stage + (gi & 1) * (16 * SROW); \
                *(l64x2*)(sb + row8 * SROW + 16 * pc8) = G.rw[2 * gi]; *(l64x2*)(sb + (8 + row8) * SROW + 16 * pc8) = G.rw[2 * gi + 1]; \
                WAVE_LDS_SYNC(); \
                const l64x2 a01 = *(const l64x2*)(sb + r16 * SROW + 32 * g4), a23 = *(const l64x2*)(sb + r16 * SROW + 32 * g4 + 16); \
                f32x4m acc = {0.f, 0.f, 0.f, 0.f}; \
                acc = __builtin_amdgcn_mfma_f32_16x16x32_fp8_fp8(a01.x, bq[0], acc, 0, 0, 0); acc = __builtin_amdgcn_mfma_f32_16x16x32_fp8_fp8(a01.y, bq[1], acc, 0, 0, 0); \
                acc = __builtin_amdgcn_mfma_f32_16x16x32_fp8_fp8(a23.x, bq[2], acc, 0, 0, 0); acc = __builtin_amdgcn_mfma_f32_16x16x32_fp8_fp8(a23.y, bq[3], acc, 0, 0, 0); \
                _Pragma("unroll") for (int q = 0; q < 4; ++q) { const float lo = dppf<0xB1>(acc[q]); if (r16 == 0) res[gi * 16 + 4 * g4 + q] = acc[q] + lo * 0.0625f; } } \
            WAVE_LDS_SYNC(); \
            { float* po = PACT + (size_t)x * ((size_t)ML * 128) + ((size_t)t0 + (B)) * 128; po[c.lane] = res[c.lane]; po[64 + c.lane] = res[64 + c.lane]; } \
            WAVE_LDS_SYNC(); } while (0)
        E1Bat ga, gb;
        E1_LOAD(ga, 0);
#pragma unroll 1
        for (int b2 = 0; b2 < CH; b2 += 2) {
            E1_LOAD(gb, b2 + 1);
            __builtin_amdgcn_sched_barrier(0);
            E1_COMP(ga, b2);
            __builtin_amdgcn_sched_barrier(0);
            E1_LOAD(ga, b2 + 2);
            __builtin_amdgcn_sched_barrier(0);
            E1_COMP(gb, b2 + 1);
            __builtin_amdgcn_sched_barrier(0);
        }
#undef E1_LOAD
#undef E1_COMP
    }
}
__device__ __forceinline__ void phase_exp1b(const Ctx& c) {
    const int* IDX = (const int*)(c.ws + WS_IDX); const float* GATE = (const float*)(c.ws + WS_GATE); const float* HS = (const float*)(c.ws + WS_HS); const float* PACT = (const float*)(c.ws + WS_PACT);
    const float* USC = (const float*)(c.ws + WS_USC); const float* VSC = (const float*)(c.ws + WS_VSC); float* ACT = (float*)(c.ws + WS_ACT);
    for (size_t i = (size_t)c.bid * NTHREADS + c.tid; i < (size_t)ML * 128; i += (size_t)c.G * NTHREADS) {
        float s = 0.f;
#pragma unroll
        for (int x = 0; x < 8; ++x) s += PACT[(size_t)x * ((size_t)ML * 128) + i];
        const int e = IDX[i];
        ACT[i] = gelu_erf(s * HS[i >> 7] * USC[e]) * GATE[i] * VSC[e];
    }
}
__device__ __forceinline__ void phase_exp2(const Ctx& c) {
    const int* IDX = (const int*)(c.ws + WS_IDX); const float* ACT = (const float*)(c.ws + WS_ACT); const unsigned char* V8 = c.ws + WS_V8;
    bf16* Y = (bf16*)(c.ws + WS_Y); float* SSQP = (float*)(c.ws + WS_SSQP);
    unsigned* cnt = (unsigned*)(c.ws + WS_CTL) + CW_E2;
    int* li = (int*)(c.lds + c.wave * 1024); float* la = (float*)(li + 128);
    const int xcc = (int)xcc_id(), sub = c.lane & 7, grp = c.lane >> 3;
    const bool b5 = c.lane & 32, b4 = c.lane & 16, b3 = c.lane & 8;
    constexpr int CH = 8;
    int bo = 0, t = 0, tend = 0;
    int iA = 0, iB = 0; float aA = 0.f, aB = 0.f;
    unsigned tq = 0; if (c.lane == 0) tq = __hip_atomic_fetch_add(cnt + 64 * (xcc & 7), (unsigned)CH, __ATOMIC_RELAXED, __HIP_MEMORY_SCOPE_AGENT);
    for (;;) {
        if (t >= tend) {
            const unsigned t0 = (unsigned)__builtin_amdgcn_readfirstlane((int)tq);
            if (t0 >= (unsigned)ML) { if (++bo >= 8) break; tq = 0; if (c.lane == 0) tq = __hip_atomic_fetch_add(cnt + 64 * ((xcc + bo) & 7), (unsigned)CH, __ATOMIC_RELAXED, __HIP_MEMORY_SCOPE_AGENT); continue; }
            tq = 0; if (c.lane == 0) tq = __hip_atomic_fetch_add(cnt + 64 * ((xcc + bo) & 7), (unsigned)CH, __ATOMIC_RELAXED, __HIP_MEMORY_SCOPE_AGENT);
            t = (int)t0; tend = t + CH;
            iA = IDX[(size_t)t * 128 + c.lane]; iB = IDX[(size_t)t * 128 + 64 + c.lane]; aA = ACT[(size_t)t * 128 + c.lane]; aB = ACT[(size_t)t * 128 + 64 + c.lane];
        }
        const int x = (xcc + bo) & 7;
        li[c.lane] = iA; li[64 + c.lane] = iB; la[c.lane] = aA; la[64 + c.lane] = aB;
        if (t + 1 < tend) { iA = IDX[(size_t)(t + 1) * 128 + c.lane]; iB = IDX[(size_t)(t + 1) * 128 + 64 + c.lane]; aA = ACT[(size_t)(t + 1) * 128 + c.lane]; aB = ACT[(size_t)(t + 1) * 128 + 64 + c.lane]; }
        WAVE_LDS_SYNC();
        float acc[16];
#pragma unroll
        for (int q = 0; q < 16; ++q) acc[q] = 0.f;
#pragma unroll
        for (int hf = 0; hf < 2; ++hf) { v4u rows[8]; float av[8];
#pragma unroll
            for (int i = 0; i < 8; ++i) { const int k = 8 * (8 * hf + i) + grp; rows[i] = *(const v4u*)(V8 + (size_t)li[k] * D + x * 128 + 16 * sub); av[i] = la[k]; }
#pragma unroll
            for (int i = 0; i < 8; ++i) { float f[16]; fp8x16_to_f32(rows[i], f);
#pragma unroll
                for (int q = 0; q < 16; ++q) acc[q] = fmaf(av[i], f[q], acc[q]); } }
        float q8[8], q4[4], q2[2];
#pragma unroll
        for (int i = 0; i < 8; ++i) { const float keep = b5 ? acc[i + 8] : acc[i], send = b5 ? acc[i] : acc[i + 8]; q8[i] = keep + __shfl_xor(send, 32); }
#pragma unroll
        for (int i = 0; i < 4; ++i) { const float keep = b4 ? q8[i + 4] : q8[i], send = b4 ? q8[i] : q8[i + 4]; q4[i] = keep + __shfl_xor(send, 16); }
#pragma unroll
        for (int i = 0; i < 2; ++i) { const float keep = b3 ? q4[i + 2] : q4[i], send = b3 ? q4[i] : q4[i + 2]; q2[i] = keep + __shfl_xor(send, 8); }
        const int col = x * 128 + 16 * sub + (b5 ? 8 : 0) + (b4 ? 4 : 0) + (b3 ? 2 : 0);
        *(unsigned*)(Y + (size_t)t * D + col) = pk2(q2[0], q2[1]);
        const float ss = wsum(q2[0] * q2[0] + q2[1] * q2[1]);
        SSQP[(size_t)x * ML + t] = ss;
        WAVE_LDS_SYNC();
        ++t;
    }
}
__device__ __forceinline__ void phase_exp3(const Ctx& c) {
    const Args& a = *c.a;
    const float* MOD = (const float*)(c.ws + WS_MOD); const bf16* Y = (const bf16*)(c.ws + WS_Y); const float* SSQP = (const float*)(c.ws + WS_SSQP);
    v2u ny[4]; f32x4 nx[4]; float nss = 0.f;
#define E3_LOAD(R) do { _Pragma("unroll") for (int j = 0; j < 4; ++j) { const int col = 4 * c.lane + 256 * j; ny[j] = *(const v2u*)(Y + (size_t)(R) * D + col); nx[j] = *(const f32x4*)(a.out + (size_t)(R) * D + col); } \
        nss = (c.lane < 8) ? SSQP[(size_t)c.lane * ML + (R)] : 0.f; } while (0)
    if (c.gw < ML) E3_LOAD(c.gw);
    for (int row = c.gw; row < ML; row += c.NGW) {
        f32x4 y[4], x1[4];
#pragma unroll
        for (int j = 0; j < 4; ++j) { y[j] = (f32x4){bflo(ny[j].x), bfhi(ny[j].x), bflo(ny[j].y), bfhi(ny[j].y)}; x1[j] = nx[j]; }
        const float ss = row_sum16(nss);
        const float tot = __builtin_bit_cast(float, __builtin_amdgcn_readlane(__builtin_bit_cast(int, ss), 0));
        if (row + c.NGW < ML) E3_LOAD(row + c.NGW);
        const float r = rsqrtf(tot * (1.f / D) + EPS); const float* mr = MOD + (row >> 11) * 6144 + 5120;
#pragma unroll
        for (int j = 0; j < 4; ++j) { const int col = 4 * c.lane + 256 * j;
            const f32x4 g4 = *(const f32x4*)(a.in[I_GPOSTFFN] + col), gt = *(const f32x4*)(mr + col);
            *(f32x4*)(a.out + (size_t)row * D + col) = x1[j] + gt * ((y[j] * r) * g4); }
    }
#undef E3_LOAD
}

constexpr int S5_LPOW = 0, S5_BBAR = 33792, S5_CC = 50176, S5_MM = 66560;
__device__ __forceinline__ void s5_build_group(const Ctx& c, int g, int part) {
    const Args& a = *c.a;
    f32x2* LPOW = (f32x2*)(c.lds + S5_LPOW);
    f32x2* BBAR = (f32x2*)(c.lds + S5_BBAR);
    f32x2* CC = (f32x2*)(c.lds + S5_CC);
    float* MM = (float*)(c.lds + S5_MM);
    __syncthreads();
    if (c.tid < 128) { const int dir = c.tid >> 6, p = c.tid & 63, dg = dir * 32 + g;
        const float dt = expf(a.in[I_LOGDT][dg]), lr = a.in[I_LAMRE][dg * 64 + p], li = a.in[I_LAMIM][dg * 64 + p];
        const double ang = (double)li * (double)dt; const float lrdt = lr * dt;
        for (int e = 0; e <= 32; ++e) { float sn, cs; sincos_d(ang * (double)e, sn, cs); const float mg = expf(lrdt * (float)e); LPOW[(dir * 33 + e) * 64 + p] = (f32x2){mg * cs, mg * sn}; }
        float sn, cs; sincos_d(ang, sn, cs); const float mag = expf(lrdt), lbr = mag * cs, lbi = mag * sn, den = lr * lr + li * li, nr = lbr - 1.f;
        const float cr = (nr * lr + lbi * li) / den, ci = (lbi * lr - nr * li) / den;
        for (int ch = 0; ch < 16; ++ch) { const float br = a.in[I_BRE][(size_t)(dg * 64 + p) * 16 + ch], bi = a.in[I_BIM][(size_t)(dg * 64 + p) * 16 + ch]; BBAR[(dir * 64 + p) * 16 + ch] = (f32x2){cr * br - ci * bi, cr * bi + ci * br}; } }
    for (int i = c.tid; i < 2048; i += NTHREADS) { const int dir = i >> 10, ch = (i >> 6) & 15, p = i & 63, dg = dir * 32 + g; CC[i] = (f32x2){a.in[I_CRE][(size_t)(dg * 16 + ch) * 64 + p], a.in[I_CIM][(size_t)(dg * 16 + ch) * 64 + p]}; }
    __syncthreads();
    for (int task = c.tid; task < 1024; task += NTHREADS) { const int cpb = task & 3, cb = (task >> 2) & 3, lag = (task >> 4) & 31, dir = task >> 9;
        float acc[4][4];
#pragma unroll
        for (int i = 0; i < 4; ++i)
#pragma unroll
            for (int j = 0; j < 4; ++j) acc[i][j] = 0.f;
        for (int p = 0; p < 64; ++p) { const f32x2 l = LPOW[(dir * 33 + lag) * 64 + p]; f32x2 G[4], Cw[4];
#pragma unroll
            for (int j = 0; j < 4; ++j) { const f32x2 bb = BBAR[(dir * 64 + p) * 16 + 4 * cpb + j]; G[j] = (f32x2){l.x * bb.x - l.y * bb.y, l.x * bb.y + l.y * bb.x}; }
#pragma unroll
            for (int i = 0; i < 4; ++i) Cw[i] = CC[(dir * 16 + 4 * cb + i) * 64 + p];
#pragma unroll
            for (int i = 0; i < 4; ++i)
#pragma unroll
                for (int j = 0; j < 4; ++j) acc[i][j] += Cw[i].x * G[j].x - Cw[i].y * G[j].y; }
#pragma unroll
        for (int i = 0; i < 4; ++i)
#pragma unroll
            for (int j = 0; j < 4; ++j) MM[((dir * 32 + lag) * 16 + 4 * cb + i) * 16 + 4 * cpb + j] = acc[i][j]; }
    __syncthreads();
    if (c.tid < 128 && part == 0) { const int dir = c.tid >> 6, p = c.tid & 63; ((f32x2*)(c.ws + WS_LP))[(dir * 32 + g) * 64 + p] = LPOW[(dir * 33 + 32) * 64 + p]; }
    bf16* PMg = (bf16*)(c.ws + WS_PM) + (size_t)g * 256 * 512; bf16* BBg = (bf16*)(c.ws + WS_BB) + (size_t)g * 512 * 768;
    for (int task = part * 64 * 32 + c.tid; task < (part + 1) * 64 * 32; task += NTHREADS) { const int ip = task & 31, n = task >> 5, dir = n >> 7, im = (n >> 6) & 1, p = n & 63, e = dir ? ip : 31 - ip;
        const f32x2 l = LPOW[(dir * 33 + e) * 64 + p]; float o[16];
#pragma unroll
        for (int ch = 0; ch < 16; ++ch) { const f32x2 bb = BBAR[(dir * 64 + p) * 16 + ch]; o[ch] = im ? (l.x * bb.y + l.y * bb.x) : (l.x * bb.x - l.y * bb.y); }
        v4u w0, w1; w0.x = pk2(o[0], o[1]); w0.y = pk2(o[2], o[3]); w0.z = pk2(o[4], o[5]); w0.w = pk2(o[6], o[7]); w1.x = pk2(o[8], o[9]); w1.y = pk2(o[10], o[11]); w1.z = pk2(o[12], o[13]); w1.w = pk2(o[14], o[15]);
        *(v4u*)(PMg + (size_t)n * 512 + ip * 16) = w0; *(v4u*)(PMg + (size_t)n * 512 + ip * 16 + 8) = w1; }
    for (int task = part * 128 * 32 + c.tid; task < (part + 1) * 128 * 32; task += NTHREADS) { const int ip = task & 31, n = task >> 5, i = n >> 4, ch = n & 15; float o[16];
#pragma unroll
        for (int q = 0; q < 16; ++q) o[q] = 0.f;
        if (ip <= i) { const float* m0 = MM + ((0 * 32 + (i - ip)) * 16 + ch) * 16;
#pragma unroll
            for (int q = 0; q < 16; ++q) o[q] += m0[q]; }
        if (ip >= i) { const float* m1 = MM + ((1 * 32 + (ip - i)) * 16 + ch) * 16;
#pragma unroll
            for (int q = 0; q < 16; ++q) o[q] += m1[q]; }
        if (ip == i) { const float dsk = a.in[I_S5D][g * 16 + ch];
#pragma unroll
            for (int q = 0; q < 16; ++q) o[q] += (q == ch) ? dsk : 0.f; }
        v4u w0, w1; w0.x = pk2(o[0], o[1]); w0.y = pk2(o[2], o[3]); w0.z = pk2(o[4], o[5]); w0.w = pk2(o[6], o[7]); w1.x = pk2(o[8], o[9]); w1.y = pk2(o[10], o[11]); w1.z = pk2(o[12], o[13]); w1.w = pk2(o[14], o[15]);
        *(v4u*)(BBg + (size_t)n * 768 + ip * 16) = w0; *(v4u*)(BBg + (size_t)n * 768 + ip * 16 + 8) = w1; }
    for (int task = part * 128 * 32 + c.tid; task < (part + 1) * 128 * 32; task += NTHREADS) { const int p8 = task & 7, part = (task >> 3) & 3, n = task >> 5, i = n >> 4, ch = n & 15, dir = part >> 1, im = part & 1, e = dir ? 32 - i : i + 1; float o[8];
#pragma unroll
        for (int q = 0; q < 8; ++q) { const int p = p8 * 8 + q; const f32x2 l = LPOW[(dir * 33 + e) * 64 + p], cc = CC[(dir * 16 + ch) * 64 + p]; o[q] = im ? -(cc.x * l.y + cc.y * l.x) : (cc.x * l.x - cc.y * l.y); }
        v4u w0; w0.x = pk2(o[0], o[1]); w0.y = pk2(o[2], o[3]); w0.z = pk2(o[4], o[5]); w0.w = pk2(o[6], o[7]);
        *(v4u*)(BBg + (size_t)n * 768 + 512 + part * 64 + p8 * 8) = w0; }
}
__device__ __forceinline__ void s5_state_scan(const Ctx& c, int task) {
    const int dir = task & 1, g = (task >> 1) & 31, b = task >> 6, p = c.lane;
    const f32x2 a = ((const f32x2*)(c.ws + WS_LP))[(dir * 32 + g) * 64 + p];
    const float* SS = (const float*)(c.ws + WS_SS) + (size_t)g * 768 * 256 + dir * 128 + p; bf16* U5 = (bf16*)(c.ws + WS_U5) + (size_t)g * 768 * 768 + 512 + dir * 128 + p;
    float er = 0.f, ei = 0.f;
#pragma unroll 24
    for (int step = 0; step < 72; ++step) {
        const int R = (step < 8) ? 512 + b * 8 + (dir ? 7 - step : step) : b * 64 + (dir ? 71 - step : step - 8);
        if (step >= 8) { U5[(size_t)R * 768] = (bf16)f2bf(er); U5[(size_t)R * 768 + 64] = (bf16)f2bf(ei); }
        const float sr = SS[(size_t)R * 256], si = SS[(size_t)R * 256 + 64];
        const float nr = sr + a.x * er - a.y * ei, ni = si + a.x * ei + a.y * er; er = nr; ei = ni;
    }
}

constexpr int GDN_NCH = 36, GDN_ITEMS = NB * 4 * 2 * GDN_NCH;
constexpr size_t FR_T_BYTES = 8192, FR_ATT_BYTES = 8192, FR_KD_BYTES = 16384, FR_TAB_BYTES = 1024;
__device__ __forceinline__ int crow16(int i, int hh) { return (i & 3) + 8 * (i >> 2) + 4 * hh; }
__device__ __forceinline__ bf16x8 pack_step(const f32x16& x, int s) {
    v4u w; w.x = pk2(x[8 * s + 0], x[8 * s + 1]); w.y = pk2(x[8 * s + 2], x[8 * s + 3]); w.z = pk2(x[8 * s + 4], x[8 * s + 5]); w.w = pk2(x[8 * s + 6], x[8 * s + 7]);
    return __builtin_bit_cast(bf16x8, w);
}
__device__ __forceinline__ unsigned pk2v(float lo, float hi) { asm volatile("" : "+v"(lo), "+v"(hi)); return pk2(lo, hi); }
__device__ __forceinline__ bf16x8 pack_step_v(const f32x16& x, int s) {
    v4u w; w.x = pk2v(x[8 * s + 0], x[8 * s + 1]); w.y = pk2v(x[8 * s + 2], x[8 * s + 3]); w.z = pk2v(x[8 * s + 4], x[8 * s + 5]); w.w = pk2v(x[8 * s + 6], x[8 * s + 7]);
    return __builtin_bit_cast(bf16x8, w);
}
constexpr int GP_KR = 0, GP_QR = 17408, GP_KT = 34816, GP_TAB = 53248, GP_LP = 54272, GP_LPB = 8448 + 256;
__host__ __device__ constexpr int LOFF(int i) { return i < 1 ? 0 : 4 * (((i - 1) >> 2) + 1) * (2 * ((i - 1) >> 2) + ((i - 1) & 3)); }
static_assert(LOFF(1) == 0 && LOFF(2) == 4 && LOFF(5) == 16 && LOFF(6) == 24 && LOFF(64) == 2112, "packed lower-triangular row offsets");
__device__ __forceinline__ void gdn_prep_stage(const Ctx& c, int item, float* Lp) {
    const int n = item % GDN_NCH, bhd = item / GDN_NCH, dir = bhd & 1, h = (bhd >> 1) & 3, b = bhd >> 3;
    const bf16* QKV = (const bf16*)(c.ws + WS_QKV); const float* GB = (const float*)(c.ws + WS_GB);
    bf16* Kr = (bf16*)(c.lds + GP_KR); bf16* Qr = (bf16*)(c.lds + GP_QR); bf16* Kt = (bf16*)(c.lds + GP_KT); float* tab = (float*)(c.lds + GP_TAB);
    unsigned char* frA = c.ws + WS_FRA + (size_t)item * FR_ATT_BYTES; unsigned char* frK = c.ws + WS_FRK + (size_t)item * FR_KD_BYTES; float* frTab = (float*)(c.ws + WS_FRTAB + (size_t)item * FR_TAB_BYTES);
    const int r = c.lane & 31, hh = c.lane >> 5;
    if (c.wave == 0) { const int row = scan_row(b, dir, n * 64 + c.lane); float g = GB[(size_t)row * 16 + dir * 4 + h]; const float beta = GB[(size_t)row * 16 + 8 + dir * 4 + h];
#pragma unroll
        for (int o = 1; o < 64; o <<= 1) { const float t = __shfl_up(g, o); if (c.lane >= o) g += t; }
        const float gl = __shfl(g, 63);
        tab[c.lane] = g; tab[64 + c.lane] = beta; tab[128 + c.lane] = __expf(g); tab[192 + c.lane] = __expf(gl - g); }
    { const int s = c.tid >> 3, seg = c.tid & 7; const int row = scan_row(b, dir, n * 64 + s); const bf16* rp = QKV + (size_t)row * 1536 + h * 128 + seg * 16;
      const v4u q0 = *(const v4u*)rp, q1 = *(const v4u*)(rp + 8), k0 = *(const v4u*)(rp + 512), k1 = *(const v4u*)(rp + 520);
      *(v4u*)(Qr + s * 136 + seg * 16) = q0; *(v4u*)(Qr + s * 136 + seg * 16 + 8) = q1; *(v4u*)(Kr + s * 136 + seg * 16) = k0; *(v4u*)(Kr + s * 136 + seg * 16 + 8) = k1;
      const unsigned kw[8] = {k0.x, k0.y, k0.z, k0.w, k1.x, k1.y, k1.z, k1.w};
#pragma unroll
      for (int e = 0; e < 8; ++e) { Kt[(seg * 16 + 2 * e) * 72 + s] = (bf16)(kw[e] & 0xffffu); Kt[(seg * 16 + 2 * e + 1) * 72 + s] = (bf16)(kw[e] >> 16); } }
    __syncthreads();
    if (c.wave < 3) { const int ct = c.wave ? 1 : 0, st = c.wave == 2 ? 1 : 0;
        f32x16 acc;
#pragma unroll
        for (int i = 0; i < 16; ++i) acc[i] = 0.f;
#pragma unroll
        for (int kk = 0; kk < 8; ++kk) { const bf16x8 a = *(const bf16x8*)(Kr + (ct * 32 + r) * 136 + kk * 16 + hh * 8), bb = *(const bf16x8*)(Kr + (st * 32 + r) * 136 + kk * 16 + hh * 8); acc = MFMA32(a, bb, acc); }
        const int s = st * 32 + r; const float gcs = tab[s];
#pragma unroll
        for (int i = 0; i < 16; ++i) { const int cc = ct * 32 + crow16(i, hh); if (s < cc) Lp[LOFF(cc) + s] = tab[64 + cc] * acc[i] * __expf(tab[cc] - gcs); }
    } else if (c.wave < 6) { const int w = c.wave - 3, st = w == 2 ? 1 : 0, ct = w ? 1 : 0;
        f32x16 acc;
#pragma unroll
        for (int i = 0; i < 16; ++i) acc[i] = 0.f;
#pragma unroll
        for (int kk = 0; kk < 8; ++kk) { const bf16x8 a = *(const bf16x8*)(Kr + (st * 32 + r) * 136 + kk * 16 + hh * 8), bb = *(const bf16x8*)(Qr + (ct * 32 + r) * 136 + kk * 16 + hh * 8); acc = MFMA32(a, bb, acc); }
        const int cc = ct * 32 + r; const float gcc = tab[cc];
#pragma unroll
        for (int i = 0; i < 16; ++i) { const int s = st * 32 + crow16(i, hh); acc[i] = (s <= cc) ? acc[i] * __expf(gcc - tab[s]) : 0.f; }
        *(bf16x8*)(frA + ((size_t)((ct * 4 + 2 * st) * 64 + c.lane)) * 16) = pack_step(acc, 0);
        *(bf16x8*)(frA + ((size_t)((ct * 4 + 2 * st + 1) * 64 + c.lane)) * 16) = pack_step(acc, 1);
    } else { const int w = c.wave - 6;
#pragma unroll
        for (int f = 0; f < 8; ++f) { const int fi = w * 8 + f, dkt = fi >> 2, cb = fi & 3; const bf16* kp = Kt + (dkt * 32 + r) * 72 + 16 * cb + 4 * hh;
            const v2u lo = *(const v2u*)kp, hi = *(const v2u*)(kp + 8); const f32x4 e0 = *(const f32x4*)(tab + 192 + 16 * cb + 4 * hh), e1 = *(const f32x4*)(tab + 192 + 16 * cb + 8 + 4 * hh);
            v4u o; o.x = pk2(bflo(lo.x) * e0.x, bfhi(lo.x) * e0.y); o.y = pk2(bflo(lo.y) * e0.z, bfhi(lo.y) * e0.w); o.z = pk2(bflo(hi.x) * e1.x, bfhi(hi.x) * e1.y); o.w = pk2(bflo(hi.y) * e1.z, bfhi(hi.y) * e1.w);
            *(v4u*)(frK + ((size_t)(fi * 64 + c.lane)) * 16) = o; }
        if (w == 0) { const v4u z = (v4u){0u, 0u, 0u, 0u}; *(v4u*)(frA + ((size_t)((0 * 4 + 2) * 64 + c.lane)) * 16) = z; *(v4u*)(frA + ((size_t)((0 * 4 + 3) * 64 + c.lane)) * 16) = z; }
        else { *(f32x4*)(frTab + 4 * c.lane) = *(const f32x4*)(tab + 4 * c.lane); }
    }
    __syncthreads();
}
__device__ __forceinline__ void gdn_prep_solve(const Ctx& c, int item, float* Lp) {
    float Tr[64];
#pragma unroll
    for (int i = 0; i < 64; ++i) { int le_ = c.lane; asm volatile("" : "+v"(le_)); float a0 = (le_ == i) ? 1.f : 0.f, a1 = 0.f;
#pragma unroll
        for (int s4 = 0; s4 < (i + 3) / 4; ++s4) { const f32x4 l4 = *(const f32x4*)(Lp + LOFF(i) + 4 * s4);
            if (4 * s4 + 0 < i) a0 = fmaf(-l4.x, Tr[4 * s4 + 0], a0); if (4 * s4 + 1 < i) a1 = fmaf(-l4.y, Tr[4 * s4 + 1], a1); if (4 * s4 + 2 < i) a0 = fmaf(-l4.z, Tr[4 * s4 + 2], a0); if (4 * s4 + 3 < i) a1 = fmaf(-l4.w, Tr[4 * s4 + 3], a1); }
        Tr[i] = a0 + a1; { int lo_ = c.lane; asm volatile("" : "+v"(lo_)); Lp[(lo_ < i) ? LOFF(i) + lo_ : 2112 + lo_] = Tr[i]; } }
    WAVE_LDS_SYNC();
    unsigned char* frT = c.ws + WS_FRT + (size_t)item * FR_T_BYTES;
    const int r = c.lane & 31, hh = c.lane >> 5;
#pragma unroll
    for (int f = 0; f < 8; ++f) { const int ct = f >> 2, sb = f & 3, cc = ct * 32 + r; float v[8];
#pragma unroll
        for (int q = 0; q < 2; ++q) { const int s0 = 16 * sb + 8 * q + 4 * hh;
            f32x4 t4 = (f32x4){0.f, 0.f, 0.f, 0.f}; if (s0 < cc) t4 = *(const f32x4*)(Lp + LOFF(cc) + s0);
            v[4 * q + 0] = (s0 + 0 < cc) ? t4.x : (s0 + 0 == cc ? 1.f : 0.f); v[4 * q + 1] = (s0 + 1 < cc) ? t4.y : (s0 + 1 == cc ? 1.f : 0.f);
            v[4 * q + 2] = (s0 + 2 < cc) ? t4.z : (s0 + 2 == cc ? 1.f : 0.f); v[4 * q + 3] = (s0 + 3 < cc) ? t4.w : (s0 + 3 == cc ? 1.f : 0.f); }
        *(v4u*)(frT + ((size_t)(f * 64 + c.lane)) * 16) = (v4u){pk2(v[0], v[1]), pk2(v[2], v[3]), pk2(v[4], v[5]), pk2(v[6], v[7])}; }
}
__device__ __forceinline__ void phase_gdn_prep(const Ctx& c) {
    for (int base = c.bid; base < GDN_ITEMS; base += 8 * c.G) {
        int cnt = 0;
#pragma unroll 1
        for (int q = 0; q < 8; ++q) { const int item = base + q * c.G; if (item < GDN_ITEMS) { gdn_prep_stage(c, item, (float*)(c.lds + GP_LP + q * GP_LPB)); cnt = q + 1; } }
        if (c.wave < cnt) gdn_prep_solve(c, base + c.wave * c.G, (float*)(c.lds + GP_LP + c.wave * GP_LPB));
        __syncthreads();
    }
}

constexpr int GR_K = 0, GR_Q = 16384, GR_T = 32768, GR_A = 40960, GR_KD = 49152, GR_TAB = 65536, GR_BUF = 66560;
__device__ __forceinline__ void gdn_rec_stage(const Ctx& c, int bhd, int n, int buf) {
    const int dir = bhd & 1, h = (bhd >> 1) & 3, b = bhd >> 3, lw = c.wave - 4; const int item = bhd * GDN_NCH + n;
    LAS unsigned char* base = (LAS unsigned char*)c.lds + buf * GR_BUF;
    const unsigned char* QKVb = c.ws + WS_QKV;
#pragma unroll
    for (int q = 0; q < 4; ++q) { const int qi = lw + 4 * q;
        const int s = 4 * qi + (c.lane >> 4), ps = c.lane & 15, p = ps ^ (s & 15); const size_t rowb = (size_t)scan_row(b, dir, n * 64 + s) * 3072 + (size_t)h * 256 + p * 16;
        __builtin_amdgcn_global_load_lds((const unsigned*)(QKVb + rowb + 1024), (LAS unsigned*)(base + GR_K + qi * 1024), 16, 0, 0);
        __builtin_amdgcn_global_load_lds((const unsigned*)(QKVb + rowb), (LAS unsigned*)(base + GR_Q + qi * 1024), 16, 0, 0); }
    const unsigned char* frT = c.ws + WS_FRT + (size_t)item * FR_T_BYTES; const unsigned char* frA = c.ws + WS_FRA + (size_t)item * FR_ATT_BYTES; const unsigned char* frK = c.ws + WS_FRK + (size_t)item * FR_KD_BYTES;
#pragma unroll
    for (int q = 0; q < 2; ++q) { const int qi = lw + 4 * q;
        __builtin_amdgcn_global_load_lds((const unsigned*)(frT + qi * 1024 + c.lane * 16), (LAS unsigned*)(base + GR_T + qi * 1024), 16, 0, 0);
        __builtin_amdgcn_global_load_lds((const unsigned*)(frA + qi * 1024 + c.lane * 16), (LAS unsigned*)(base + GR_A + qi * 1024), 16, 0, 0); }
#pragma unroll
    for (int q = 0; q < 4; ++q) { const int qi = lw + 4 * q;
        __builtin_amdgcn_global_load_lds((const unsigned*)(frK + qi * 1024 + c.lane * 16), (LAS unsigned*)(base + GR_KD + qi * 1024), 16, 0, 0); }
    if (lw == 0) __builtin_amdgcn_global_load_lds((const unsigned*)(c.ws + WS_FRTAB + (size_t)item * FR_TAB_BYTES + c.lane * 16), (LAS unsigned*)(base + GR_TAB), 16, 0, 0);
}
__device__ __forceinline__ bf16x8 gr_rowfrag(const unsigned char* rowp, const int (&po)[16], int kb) {
    const v2u lo = *(const v2u*)(rowp + po[2 * kb]), hi = *(const v2u*)(rowp + po[2 * kb + 1]);
    return __builtin_bit_cast(bf16x8, (v4u){lo.x, lo.y, hi.x, hi.y});
}
__device__ __forceinline__ void gdn_rec_block(const Ctx& c, int bhd, int dvhalf) {
    const int dir = bhd & 1, h = (bhd >> 1) & 3, b = bhd >> 3, r = c.lane & 31, hh = c.lane >> 5, dvt = 2 * dvhalf + (c.wave & 1);
    const bf16* QKV = (const bf16*)(c.ws + WS_QKV); bf16* OG = (bf16*)(c.ws + WS_OG) + (size_t)dir * ML * 512;
    f32x16 S[4];
#pragma unroll
    for (int t = 0; t < 4; ++t)
#pragma unroll
        for (int i = 0; i < 16; ++i) S[t][i] = 0.f;
    int po[16];
#pragma unroll
    for (int p = 0; p < 16; ++p) po[p] = r * 256 + ((p ^ (r & 15)) * 16) + 8 * hh;
    if (c.wave >= 4) gdn_rec_stage(c, bhd, 0, 0);
    asm volatile("s_waitcnt vmcnt(0)" ::: "memory"); __syncthreads();
    for (int n = 0; n < GDN_NCH; ++n) {
        const int buf = n & 1;
        if (c.wave >= 4) { if (n + 1 < GDN_NCH) gdn_rec_stage(c, bhd, n + 1, buf ^ 1); }
        else if (c.wave < 2) {
            const unsigned char* base = c.lds + buf * GR_BUF; const float* tab = (const float*)(base + GR_TAB);
            const int row0 = scan_row(b, dir, n * 64), sgn = dir ? -1 : 1;
            const bf16* vcol = QKV + (size_t)row0 * 1536 + 1024 + h * 128 + dvt * 32 + r + (ptrdiff_t)(sgn * 4 * hh) * 1536;
            bf16* ocol = OG + (size_t)row0 * 512 + h * 128 + dvt * 32 + r + (ptrdiff_t)(sgn * 4 * hh) * 512;
            const ptrdiff_t vst = (ptrdiff_t)sgn * 1536, ost = (ptrdiff_t)sgn * 512;
            bf16 vraw[2][16];
#pragma unroll
            for (int st = 0; st < 2; ++st)
#pragma unroll
                for (int i = 0; i < 16; ++i) vraw[st][i] = vcol[vst * (st * 32 + (i & 3) + 8 * (i >> 2))];
            bf16x8 Rf[2][2];
#pragma unroll
            for (int st = 0; st < 2; ++st) { f32x16 acc;
#pragma unroll
                for (int i = 0; i < 16; ++i) acc[i] = 0.f;
#pragma unroll
                for (int kb = 0; kb < 8; ++kb) acc = MFMA32(gr_rowfrag(base + GR_K + st * 8192, po, kb), pack_step_v(S[kb >> 1], kb & 1), acc);
#pragma unroll
                for (int i = 0; i < 16; ++i) { const int s = st * 32 + crow16(i, hh); acc[i] = tab[64 + s] * (bf1(vraw[st][i]) - tab[128 + s] * acc[i]); }
                Rf[st][0] = pack_step(acc, 0); Rf[st][1] = pack_step(acc, 1); asm volatile("" ::: "memory"); }
            bf16x8 Vf[2][2];
#pragma unroll
            for (int ct = 0; ct < 2; ++ct) { f32x16 acc;
#pragma unroll
                for (int i = 0; i < 16; ++i) acc[i] = 0.f;
#pragma unroll
                for (int sb = 0; sb < 4; ++sb) if (sb < 2 * ct + 2) acc = MFMA32(*(const bf16x8*)(base + GR_T + ((ct * 4 + sb) * 64 + c.lane) * 16), Rf[sb >> 1][sb & 1], acc);
                Vf[ct][0] = pack_step(acc, 0); Vf[ct][1] = pack_step(acc, 1); }
            asm volatile("" ::: "memory");
#pragma unroll
            for (int ct = 0; ct < 2; ++ct) { f32x16 acc;
#pragma unroll
                for (int i = 0; i < 16; ++i) acc[i] = 0.f;
#pragma unroll
                for (int kb = 0; kb < 8; ++kb) acc = MFMA32(gr_rowfrag(base + GR_Q + ct * 8192, po, kb), pack_step_v(S[kb >> 1], kb & 1), acc);
#pragma unroll
                for (int i = 0; i < 16; ++i) acc[i] *= tab[128 + ct * 32 + crow16(i, hh)];
#pragma unroll
                for (int cb = 0; cb < 4; ++cb) if (cb < 2 * ct + 2) acc = MFMA32(*(const bf16x8*)(base + GR_A + ((ct * 4 + cb) * 64 + c.lane) * 16), Vf[cb >> 1][cb & 1], acc);
                if (n >= 4) {
#pragma unroll
                    for (int i = 0; i < 16; ++i) ocol[ost * (ct * 32 + (i & 3) + 8 * (i >> 2))] = (bf16)f2bf(acc[i]); }
                asm volatile("" ::: "memory"); }
            const float gtot = tab[128 + 63];
#pragma unroll
            for (int t = 0; t < 4; ++t) {
#pragma unroll
                for (int i = 0; i < 16; ++i) S[t][i] *= gtot;
#pragma unroll
                for (int cb = 0; cb < 4; ++cb) S[t] = MFMA32(*(const bf16x8*)(base + GR_KD + ((t * 4 + cb) * 64 + c.lane) * 16), Vf[cb >> 1][cb & 1], S[t]); }
        }
        if (c.wave >= 4) asm volatile("s_waitcnt vmcnt(0)" ::: "memory"); else asm volatile("s_waitcnt lgkmcnt(0)" ::: "memory");
        __builtin_amdgcn_s_barrier(); asm volatile("" ::: "memory");
    }
    asm volatile("s_waitcnt vmcnt(0)" ::: "memory"); __syncthreads();
}
__device__ __forceinline__ void phase_gdn_rec(const Ctx& c) { if (c.bid < 128) gdn_rec_block(c, c.bid >> 1, c.bid & 1); }

#define XB_TMO      128
#define XB_XCNT(j)  (256  + 64 * (j))
#define XB_XSUB(j)  (1280 + 64 * (j))
#define XB_XGEN(j)  (2304 + 64 * (j))
#define XB_TOP      3328
#define XB_TOPGEN   3392
#define XCD_BAR_WORDS 3456
#define XB_SPIN_CAP (1u << 20)
__device__ __forceinline__ unsigned xb_ld(unsigned* p)              { return __hip_atomic_load(p, __ATOMIC_RELAXED, __HIP_MEMORY_SCOPE_AGENT); }
__device__ __forceinline__ unsigned xb_add(unsigned* p, unsigned v) { return __hip_atomic_fetch_add(p, v, __ATOMIC_RELAXED, __HIP_MEMORY_SCOPE_AGENT); }
__device__ __forceinline__ unsigned xb_xcc_id() { return (unsigned)__builtin_amdgcn_s_getreg((3 << 11) | 20) & 0xFu; }
#define XB_SPIN(cond, bar) do { unsigned _sp = 0; while (cond) { __builtin_amdgcn_s_sleep(1); \
    if ((++_sp & 255u) == 0u) { if (xb_ld(&(bar)[XB_TMO])) break; if (_sp > XB_SPIN_CAP) { atomicAdd(&(bar)[XB_TMO], 1u); break; } } } } while (0)
struct XcdBarrier { unsigned* bar; unsigned x; volatile LAS unsigned* st; };
__device__ __forceinline__ XcdBarrier xcd_barrier_post(unsigned* bar, volatile LAS unsigned* st) {
    XcdBarrier b; b.bar = bar; b.x = xb_xcc_id(); b.st = st;
    if (threadIdx.x == 0) (void)xb_add(&bar[XB_XCNT(b.x)], 1u);
    return b;
}
__device__ __forceinline__ void xcd_barrier_complete(unsigned* bar, unsigned x, unsigned& nloc, unsigned& nx) {
    const unsigned G = gridDim.x * gridDim.y * gridDim.z;
    unsigned sum, cnt, mine, sp = 0u;
    for (;;) {
        sum = 0u; cnt = 0u; mine = 0u;
#pragma unroll
        for (unsigned j = 0; j < 16; ++j) { const unsigned c = xb_ld(&bar[XB_XCNT(j)]); sum += c; cnt += (c > 0u) ? 1u : 0u; mine = (j == x) ? c : mine; }
        if (sum == G) break;
        __builtin_amdgcn_s_sleep(1);
        if ((++sp & 255u) == 0u) { if (xb_ld(&bar[XB_TMO])) break; if (sp > XB_SPIN_CAP) { atomicAdd(&bar[XB_TMO], 1u); break; } }
    }
    nloc = mine > 0u ? mine : 1u; nx = cnt > 0u ? cnt : 1u;
}
__device__ __forceinline__ void xcd_barrier(const XcdBarrier& b) {
    asm volatile("s_waitcnt vmcnt(0)" ::: "memory");
    __syncthreads();
    if (threadIdx.x == 0) {
        unsigned* bar = b.bar;
        __builtin_amdgcn_s_waitcnt(0);
        unsigned nloc = b.st[0], nx = b.st[1];
        if (nloc == 0u) { xcd_barrier_complete(bar, b.x, nloc, nx); b.st[0] = nloc; b.st[1] = nx; }
        const unsigned old = xb_add(&bar[XB_XSUB(b.x)], 1u);
        const unsigned gen = old / nloc;
        if (old + 1u == (gen + 1u) * nloc) {
            __builtin_amdgcn_fence(__ATOMIC_RELEASE, "agent");
            asm volatile("s_waitcnt vmcnt(0)" ::: "memory");
            const unsigned og = xb_add(&bar[XB_TOP], 1u);
            const unsigned tg = og / nx;
            if (og + 1u == (tg + 1u) * nx) xb_add(&bar[XB_TOPGEN], 1u);
            else XB_SPIN(xb_ld(&bar[XB_TOPGEN]) == tg, bar);
            __builtin_amdgcn_fence(__ATOMIC_ACQUIRE, "agent");
            xb_add(&bar[XB_XGEN(b.x)], 1u);
            asm volatile("s_waitcnt vmcnt(0)" ::: "memory");
        } else {
            XB_SPIN(xb_ld(&bar[XB_XGEN(b.x)]) == gen, bar);
            __builtin_amdgcn_fence(__ATOMIC_ACQUIRE, "agent");
            asm volatile("s_waitcnt vmcnt(0)" ::: "memory");
        }
    }
    __syncthreads();
}

constexpr int LDS_MISC = LDS_BYTES - 64;
__global__ void __launch_bounds__(NTHREADS, 2) mk_fwd(Args args) {
    extern __shared__ __attribute__((aligned(16))) unsigned char lds[];
    Ctx c; c.a = &args; c.ws = args.ws; c.lds = lds;
    c.tid = threadIdx.x; c.lane = c.tid & 63; c.wave = __builtin_amdgcn_readfirstlane(c.tid >> 6); c.bid = blockIdx.x; c.G = gridDim.x;
    c.gw = c.bid * NWAVES + c.wave; c.NGW = c.G * NWAVES; c.gwv = c.wave * c.G + c.bid;
    const int lo = args.ph_lo, hi = args.ph_hi;
    PG8_LAS unsigned char* ring = (PG8_LAS unsigned char*)lds;
#ifndef MK_PH_MASK
#define MK_PH_MASK 0xffff
#endif
#define IN(k) (((MK_PH_MASK >> (k)) & 1) && lo <= (k) && (k) < hi)
#if MK_ONE_LAUNCH
    cg::grid_group grid = cg::this_grid();
    if (lo < 0) grid.sync();
    volatile LAS unsigned* st = (volatile LAS unsigned*)((LAS unsigned char*)lds + LDS_MISC);
    if (c.tid < 2) st[c.tid] = 0u;
    __syncthreads();
    const XcdBarrier bar = xcd_barrier_post((unsigned*)(c.ws + WS_CTL) + CW_BAR, st);
#define SEAM(k) do { if (IN(k) && IN((k) + 1)) xcd_barrier(bar); } while (0)
#else
#define SEAM(k) do { } while (0)
#endif
    if (IN(0)) { phase_prep(c); phase_s5_build(c); } SEAM(0);
    if (IN(1)) { phase_norm1(c); } SEAM(1);
    if (IN(2)) { pg8::Gemm g{(const pg8::bf16_t*)(c.ws + WS_HX), (const pg8::bf16_t*)(c.ws + WS_WIN), 1024, 1024, 1024}; pg8::StaticOrder S; S.init(MT, NPROJ, c.G, c.bid);
        pg8::EpiInProj E{(pg8::bf16_t*)(c.ws + WS_U5), (pg8::bf16_t*)(c.ws + WS_QKVPRE), (pg8::bf16_t*)(c.ws + WS_Z)};
        pg8::gemm_phase<pg8::EpiInProj, pg8::StaticOrder, true, true>(ring, g, S, E); } SEAM(2);
    if (IN(3)) { { pg8::Gemm g{(const pg8::bf16_t*)(c.ws + WS_U5), (const pg8::bf16_t*)(c.ws + WS_PM), 768, 512, 512}; pg8::SchedSS S{c.G, c.bid}; pg8::EpiSS E{(float*)(c.ws + WS_SS)};
          pg8::gemm_phase<pg8::EpiSS, pg8::SchedSS, true, true>(ring, g, S, E); }
        __syncthreads(); phase_conv(c); } SEAM(3);
    if (IN(4)) { for (int t = c.gwv; t < 512; t += c.NGW) s5_state_scan(c, t); __syncthreads(); phase_gdn_prep(c); } SEAM(4);
    if (IN(5)) { pg8::Gemm g{(const pg8::bf16_t*)(c.ws + WS_U5), (const pg8::bf16_t*)(c.ws + WS_BB), 768, 768, 768}; pg8::SchedS5Y S{c.G, c.bid}; pg8::EpiS5Y E{(pg8::bf16_t*)(c.ws + WS_YG)};
        pg8::gemm_phase<pg8::EpiS5Y, pg8::SchedS5Y, true, true>(ring, g, S, E); } SEAM(5);
    if (IN(6)) { if (c.bid < 128) phase_gdn_rec(c);
        else { pg8::Gemm g{(const pg8::bf16_t*)(c.ws + WS_YG), (const pg8::bf16_t*)(c.ws + WS_WGLU), 512, 512, 512}; pg8::StaticOrder S; S.init(ML, 512, c.G - 128, c.bid - 128);
            pg8::EpiGlu E{(const pg8::bf16_t*)(c.ws + WS_YG), (pg8::bf16_t*)(c.ws + WS_CAT)};
            pg8::gemm_phase<pg8::EpiGlu, pg8::StaticOrder, true, true>(ring, g, S, E); } } SEAM(6);
    if (IN(7)) { phase_combine(c); } SEAM(7);
    if (IN(8)) { pg8::Gemm g{(const pg8::bf16_t*)(c.ws + WS_CAT), (const pg8::bf16_t*)(c.ws + WS_WOUT), 1024, 1024, 1024}; pg8::StaticOrder S; S.init(ML, 1024, c.G, c.bid);
        pg8::EpiBf16<0> E{(pg8::bf16_t*)(c.ws + WS_YRAW), 1024, nullptr, 0, 0, 1.f};
        pg8::gemm_phase<pg8::EpiBf16<0>, pg8::StaticOrder, true, true>(ring, g, S, E); } SEAM(8);
    if (IN(9)) { phase_rows2(c); phase_fp8_tables(c); } SEAM(9);
    if (IN(10)) { pg8::Gemm g{(const pg8::bf16_t*)(c.ws + WS_HX2), (const pg8::bf16_t*)(c.ws + WS_WQ), 1024, 1024, 1024}; pg8::StaticOrder S; S.init(ML, 2048, c.G, c.bid);
        pg8::EpiBf16<0> E{(pg8::bf16_t*)(c.ws + WS_QP), 2048, nullptr, 0, 0, 1.f};
        pg8::gemm_phase<pg8::EpiBf16<0>, pg8::StaticOrder, true, true>(ring, g, S, E); } SEAM(10);
    if (IN(11)) { phase_topk(c); } SEAM(11);
    if (IN(12)) { phase_exp1(c); } SEAM(12);
    if (IN(13)) { phase_exp1b(c); } SEAM(13);
    if (IN(14)) { phase_exp2(c); } SEAM(14);
    if (IN(15)) { phase_exp3(c); }
#undef IN
#undef SEAM
}

extern "C" void kernel_launch(void* const* d_in, const int* in_sizes, int n_in, void* d_out, int out_size, void* d_ws, size_t ws_size, hipStream_t stream) {
    static int grid = 0;
    if (grid == 0) {
        if (n_in != 29 || out_size != ML * D || ws_size < WS_END) { fprintf(stderr, "kernel_launch: unexpected shapes (n_in %d out %d ws %zu)\n", n_in, out_size, ws_size); grid = -1; return; }
        int dev = 0, cus = 0, per_cu = 0;
        (void)hipGetDevice(&dev); (void)hipDeviceGetAttribute(&cus, hipDeviceAttributeMultiprocessorCount, dev);
        if (hipFuncSetAttribute((const void*)mk_fwd, hipFuncAttributeMaxDynamicSharedMemorySize, LDS_BYTES) != hipSuccess) { fprintf(stderr, "kernel_launch: hipFuncSetAttribute failed\n"); grid = -1; return; }
        (void)hipOccupancyMaxActiveBlocksPerMultiprocessor(&per_cu, (const void*)mk_fwd, NTHREADS, LDS_BYTES);
        (void)hipGetLastError();
        grid = cus;
        fprintf(stderr, "kernel_launch: cus %d per_cu %d grid %d\n", cus, per_cu, grid);
    }
    if (grid < 0) return;
    Args a{};
    for (int i = 0; i < 29; ++i) a.in[i] = (const float*)d_in[i];
    a.out = (float*)d_out; a.ws = (unsigned char*)d_ws;
    (void)hipMemsetAsync((char*)d_ws + WS_CTL, 0, CTL_ZERO_BYTES, stream);
#if MK_ONE_LAUNCH
    a.ph_lo = 0; a.ph_hi = NPHASES;
    void* kargs[] = {&a};
    hipError_t e = hipLaunchCooperativeKernel((const void*)mk_fwd, dim3(grid), dim3(NTHREADS), kargs, LDS_BYTES, stream);
    if (e != hipSuccess) fprintf(stderr, "kernel_launch: cooperative launch failed: %s\n", hipGetErrorString(e));
#else
    for (int ph = 0; ph < NPHASES; ++ph) { a.ph_lo = ph; a.ph_hi = ph + 1; hipLaunchKernelGGL(mk_fwd, dim3(grid), dim3(NTHREADS), LDS_BYTES, stream, a); }
#endif
}
```

```cpp
#include <hip/hip_runtime.h>
#include <hip/hip_cooperative_groups.h>
#include <cstdio>
#include <cstdint>
namespace cg = cooperative_groups;
namespace pg8 {
#define PG8_LAS __attribute__((address_space(3)))
typedef unsigned short bf16_t;
typedef short bf16x8 __attribute__((ext_vector_type(8)));
typedef float f32x4 __attribute__((ext_vector_type(4)));
typedef unsigned u32x4 __attribute__((ext_vector_type(4)));
constexpr int BM = 256, BK = 64, HALF = 128, HTB = HALF * BK * 2  , STAGE_BYTES = 8 * HTB, NXCD = 8, WGM = 8;

__host__ __device__ __forceinline__ int lds_byte(int r, int c) { const int st = (r >> 4) * 2 + (c >> 5), rr = r & 15, cc = c & 31, ob = rr * 64 + cc * 2; return st * 1024 + (ob ^ (((ob >> 9) & 1) << 5)); }
__host__ __device__ __forceinline__ void stage_rc(int b, int& R, int& C) { const int st = b / 1024, sb = b % 1024, swz = sb ^ (((sb >> 9) & 1) << 5); R = (st >> 1) * 16 + swz / 64; C = (st & 1) * 32 + (swz % 64) / 2; }
__host__ __device__ __forceinline__ int perm32(int rho) { const int n = rho >> 4, i = rho & 15; return 8 * (i >> 2) + 4 * n + (i & 3); }

struct Unit { int pm, pn; };
struct Gemm { const bf16_t* A; const bf16_t* Bt; int lda, ldb, K; };

struct StaticOrder {
    int nM, nN, nwg, G, c;
    __host__ __device__ void init(int M, int N, int G_, int c_) { nM = M / BM; nN = N / BM; nwg = nM * nN; G = G_; c = c_; }
    __host__ __device__ bool next(int i, Unit& u) const {
        const long L = (long)i * G + c; if (L >= nwg) return false;
        int wgid = (int)L; { const int q = nwg / NXCD, r = nwg % NXCD, xcd = wgid % NXCD, off = wgid / NXCD; wgid = (xcd < r ? xcd * (q + 1) : r * (q + 1) + (xcd - r) * q) + off; }
        const int nig = WGM * nN, gid = wgid / nig, fm = gid * WGM, gsz = (nM - fm) < WGM ? (nM - fm) : WGM;
        u.pm = fm + ((wgid % nig) % gsz); u.pn = (wgid % nig) / gsz; return true;
    }
    __device__ __forceinline__ void a_ready(const Unit&) const {}
    __device__ __forceinline__ void done(const Unit&) const {}
};

__device__ __forceinline__ unsigned cvt_pk_bf16(float lo, float hi) { unsigned r; asm volatile("v_cvt_pk_bf16_f32 %0, %1, %2" : "=v"(r) : "v"(lo), "v"(hi)); return r; }
typedef float f32x2 __attribute__((ext_vector_type(2)));
__device__ __forceinline__ f32x2 gelu_pk(f32x2 v) {
    const f32x2 av = __builtin_elementwise_abs(v), d = av * 0.2316418882f + 1.0f;
    f32x2 t; t.x = __builtin_amdgcn_rcpf(d.x); t.y = __builtin_amdgcn_rcpf(d.y);
    f32x2 q = t * 0.5307027145f + (-0.7265760135f); q = q * t + 0.7107068705f; q = q * t + (-0.142248368f); q = q * t + 0.127414796f; q = q * t;
    const f32x2 s = (v * v) * (-0.72134752044f);
    f32x2 e; e.x = __builtin_amdgcn_exp2f(s.x); e.y = __builtin_amdgcn_exp2f(s.y);
    const f32x2 m = v * (q * e), r = v - m;
    f32x2 o; o.x = v.x < 0.f ? m.x : r.x; o.y = v.y < 0.f ? m.y : r.y; return o;
}

template <int ACT  > struct EpiBf16 {
    static constexpr bool PERM = true, AFTER_DRAIN = false; static_assert(ACT == 0 || ACT == 1, "EpiBf16: ACT is 0 (none) or 1 (gelu_pk)");
    bf16_t* O; int ldc; const float* bias; int split_cols; size_t split_stride; float scale0;
    __device__ __forceinline__ void operator()(const f32x4 (&acc)[2][2][4][2], const Unit& u, int wr, int wc, int fr, int fq) const {
        const int row0 = u.pm * BM + wr * 64 + fr; int colt = u.pn * BM; bf16_t* base = O;
        float sc = 1.f; if (split_cols) { const int t = colt / split_cols; base += (size_t)t * split_stride; colt -= t * split_cols; if (t == 0) sc = scale0; }
        const int col0 = colt + wc * 32 + 8 * fq, bcol0 = u.pn * BM + wc * 32 + 8 * fq;
        f32x4 bv[2][2];
#pragma unroll
        for (int bj = 0; bj < 2; ++bj)
#pragma unroll
            for (int n = 0; n < 2; ++n) bv[bj][n] = bias ? *(const f32x4*)(bias + bcol0 + bj * HALF + 4 * n) : (f32x4){0.f, 0.f, 0.f, 0.f};
#pragma unroll
        for (int ai = 0; ai < 2; ++ai)
#pragma unroll
            for (int m = 0; m < 4; ++m) { bf16_t* rowp = base + (size_t)(row0 + ai * HALF + m * 16) * ldc + col0;
#pragma unroll
                for (int bj = 0; bj < 2; ++bj) { f32x4 v0 = acc[ai][bj][m][0] + bv[bj][0], v1 = acc[ai][bj][m][1] + bv[bj][1];
                    if (ACT == 1) { f32x2 a = gelu_pk((f32x2){v0[0], v0[1]}), b = gelu_pk((f32x2){v0[2], v0[3]}), c = gelu_pk((f32x2){v1[0], v1[1]}), d = gelu_pk((f32x2){v1[2], v1[3]});
                        v0 = (f32x4){a.x, a.y, b.x, b.y}; v1 = (f32x4){c.x, c.y, d.x, d.y}; }
                    v0 = v0 * sc; v1 = v1 * sc; u32x4 w; w.x = cvt_pk_bf16(v0[0], v0[1]); w.y = cvt_pk_bf16(v0[2], v0[3]); w.z = cvt_pk_bf16(v1[0], v1[1]); w.w = cvt_pk_bf16(v1[2], v1[3]);
                    *(u32x4*)(rowp + bj * HALF) = w; } }
    }
};

template <class Epi, class Sched, bool ALIGN_EPI = false, bool SP2 = false>
__device__ __forceinline__ void gemm_phase(PG8_LAS unsigned char* lds, const Gemm g, const Sched& S, const Epi& E) {
    const int tid = threadIdx.x, wid = __builtin_amdgcn_readfirstlane(tid >> 6), lane = tid & 63, wr = wid >> 2, wc = wid & 3, fr = lane & 15, fq = lane >> 4;
    const int K = g.K, nt = K / BK;
    unsigned voffA[2], voffB[2];
#pragma unroll
    for (int i = 0; i < 2; ++i) { int R, C; stage_rc(tid * 16 + i * 8192, R, C); const int Rb = Epi::PERM ? ((R & ~31) + perm32(R & 31)) : R;
        voffA[i] = (unsigned)(R * g.lda + C) * 2u; voffB[i] = (unsigned)(Rb * g.ldb + C) * 2u; }
    const size_t kstep = (size_t)(BK * 2);
    const size_t hstepA = (size_t)HALF * g.lda * 2, hstepB = (size_t)HALF * g.ldb * 2;
    const size_t tstepA = 2 * hstepA, tstepB = 2 * hstepB;
    const unsigned ldsw = (unsigned)wid * 1024u;
    const int aoff = lds_byte(wr * 64 + fr, fq * 8), boff = lds_byte(wc * 32 + fr, fq * 8);
#define PG8_SA(b, h) (((b) * 2 + (h)) * HTB)
#define PG8_SB(b, h) ((4 + (b) * 2 + (h)) * HTB)
#define PG8_STAGE(bufoff, gbase, voff) do { _Pragma("unroll") for (int _i = 0; _i < 2; ++_i) \
        __builtin_amdgcn_global_load_lds((const unsigned*)((const char*)(gbase) + (voff)[_i]), (PG8_LAS unsigned*)(lds + (bufoff) + ldsw + _i * 8192), 16, 0, 0); } while (0)
#define PG8_LDA(dst, b, h) do { _Pragma("unroll") for (int m = 0; m < 4; ++m) _Pragma("unroll") for (int k = 0; k < 2; ++k) dst[m][k] = *(const PG8_LAS bf16x8*)(lds + PG8_SA(b, h) + aoff + m * 2048 + k * 1024); } while (0)
#define PG8_LDB(dst, b, h) do { _Pragma("unroll") for (int n = 0; n < 2; ++n) _Pragma("unroll") for (int k = 0; k < 2; ++k) dst[n][k] = *(const PG8_LAS bf16x8*)(lds + PG8_SB(b, h) + boff + n * 2048 + k * 1024); } while (0)
#define PG8_MMA(ai, bj, At, Bt) do { __builtin_amdgcn_s_setprio(1); _Pragma("unroll") for (int m = 0; m < 4; ++m) _Pragma("unroll") for (int n = 0; n < 2; ++n) _Pragma("unroll") for (int k = 0; k < 2; ++k) \
        acc[ai][bj][m][n] = __builtin_amdgcn_mfma_f32_16x16x32_bf16(Bt[n][k], At[m][k], acc[ai][bj][m][n], 0, 0, 0); __builtin_amdgcn_s_setprio(0); } while (0)
#define PG8_WAIT_V(n) asm volatile("s_waitcnt vmcnt(" #n ")" ::: "memory")
#define PG8_WAIT_L(n) asm volatile("s_waitcnt lgkmcnt(" #n ")" ::: "memory")
#define PG8_BAR __builtin_amdgcn_s_barrier()
#define PG8_SCHED __builtin_amdgcn_sched_barrier(0)
    Unit cur, nxt; int ui = 0;
    if (!S.next(0, cur)) return;
    f32x4 acc[2][2][4][2];
#pragma unroll
    for (int a = 0; a < 2; ++a)
#pragma unroll
        for (int b = 0; b < 2; ++b)
#pragma unroll
            for (int m = 0; m < 4; ++m)
#pragma unroll
                for (int n = 0; n < 2; ++n) acc[a][b][m][n] = (f32x4){0.f, 0.f, 0.f, 0.f};
    bf16x8 At[4][2], B0[2][2], B1[2][2];
    const char* cA = (const char*)g.A + (size_t)cur.pm * tstepA; const char* cB = (const char*)g.Bt + (size_t)cur.pn * tstepB;
    S.a_ready(cur);
    if constexpr (SP2) {
        PG8_STAGE(PG8_SB(0, 0), cB, voffB); PG8_STAGE(PG8_SB(0, 1), cB + hstepB, voffB); PG8_STAGE(PG8_SA(0, 0), cA, voffA); PG8_STAGE(PG8_SA(0, 1), cA + hstepA, voffA);
        if (wr == 1) PG8_BAR;
        PG8_WAIT_V(2); PG8_BAR;
        PG8_STAGE(PG8_SB(1, 0), cB + kstep, voffB); PG8_STAGE(PG8_SA(1, 0), cA + kstep, voffA); PG8_STAGE(PG8_SB(1, 1), cB + hstepB + kstep, voffB);
        PG8_WAIT_V(6); PG8_BAR;
    } else {
        PG8_STAGE(PG8_SB(0, 0), cB, voffB); PG8_STAGE(PG8_SA(0, 0), cA, voffA); PG8_STAGE(PG8_SB(0, 1), cB + hstepB, voffB); PG8_STAGE(PG8_SA(0, 1), cA + hstepA, voffA);
        if (wr == 1) PG8_BAR;
        PG8_WAIT_V(4); PG8_BAR;
        PG8_STAGE(PG8_SB(1, 0), cB + kstep, voffB); PG8_STAGE(PG8_SA(1, 0), cA + kstep, voffA); PG8_STAGE(PG8_SB(1, 1), cB + hstepB + kstep, voffB);
        PG8_WAIT_V(6); PG8_BAR;
    }
    for (;;) {
        const bool has_next = S.next(ui + 1, nxt);
        const char* nA = has_next ? (const char*)g.A + (size_t)nxt.pm * tstepA : cA; const char* nB = has_next ? (const char*)g.Bt + (size_t)nxt.pn * tstepB : cB;
        for (int t = 0; t < nt; t += 2) {
            const bool last = (t == nt - 2);
            const char* a1 = cA + (size_t)(t + 1) * kstep;
            const char* a2 = last ? nA : cA + (size_t)(t + 2) * kstep; const char* b2 = last ? nB : cB + (size_t)(t + 2) * kstep;
            const char* a3 = a2 + kstep; const char* b3 = b2 + kstep;
            if (last && has_next) S.a_ready(nxt);
            if constexpr (SP2) {
            PG8_LDB(B0, 0, 0); PG8_LDB(B1, 0, 1); PG8_SCHED; PG8_LDA(At, 0, 0); PG8_STAGE(PG8_SA(1, 1), a1 + hstepA, voffA);
            PG8_WAIT_V(8); PG8_WAIT_L(0); PG8_BAR; PG8_MMA(0, 0, At, B0); PG8_MMA(0, 1, At, B1); PG8_BAR; PG8_SCHED;
            PG8_LDA(At, 0, 1); PG8_STAGE(PG8_SB(0, 0), b2, voffB); PG8_STAGE(PG8_SB(0, 1), b2 + hstepB, voffB); PG8_STAGE(PG8_SA(0, 0), a2, voffA);
            PG8_WAIT_V(8); PG8_WAIT_L(0); PG8_BAR; PG8_MMA(1, 0, At, B0); PG8_MMA(1, 1, At, B1); PG8_BAR; PG8_SCHED;
            PG8_LDB(B0, 1, 0); PG8_LDB(B1, 1, 1); PG8_SCHED; PG8_LDA(At, 1, 0); PG8_STAGE(PG8_SA(0, 1), a2 + hstepA, voffA);
            PG8_WAIT_V(8); PG8_WAIT_L(0); PG8_BAR; PG8_MMA(0, 0, At, B0); PG8_MMA(0, 1, At, B1); PG8_BAR; PG8_SCHED;
            PG8_LDA(At, 1, 1); PG8_STAGE(PG8_SB(1, 0), b3, voffB); PG8_STAGE(PG8_SB(1, 1), b3 + hstepB, voffB); PG8_STAGE(PG8_SA(1, 0), a3, voffA);
            PG8_WAIT_V(8); PG8_WAIT_L(0); PG8_BAR; PG8_MMA(1, 0, At, B0); PG8_MMA(1, 1, At, B1); PG8_BAR; PG8_SCHED;
            } else {
            PG8_LDB(B0, 0, 0); PG8_SCHED; PG8_LDA(At, 0, 0); PG8_STAGE(PG8_SA(1, 1), a1 + hstepA, voffA);
            PG8_WAIT_L(8); PG8_BAR; PG8_WAIT_L(0); PG8_MMA(0, 0, At, B0); PG8_BAR; PG8_SCHED;
            PG8_LDB(B1, 0, 1); PG8_STAGE(PG8_SB(0, 0), b2, voffB);
            PG8_BAR; PG8_WAIT_L(0); PG8_MMA(0, 1, At, B1); PG8_BAR;
            PG8_LDA(At, 0, 1); PG8_STAGE(PG8_SA(0, 0), a2, voffA);
            PG8_BAR; PG8_WAIT_L(0); PG8_MMA(1, 0, At, B0); PG8_BAR; PG8_SCHED;
            PG8_STAGE(PG8_SB(0, 1), b2 + hstepB, voffB);
            PG8_WAIT_V(6); PG8_BAR; PG8_MMA(1, 1, At, B1); PG8_BAR;
            PG8_LDB(B0, 1, 0); PG8_SCHED; PG8_LDA(At, 1, 0); PG8_STAGE(PG8_SA(0, 1), a2 + hstepA, voffA);
            PG8_WAIT_L(8); PG8_BAR; PG8_WAIT_L(0); PG8_MMA(0, 0, At, B0); PG8_BAR; PG8_SCHED;
            PG8_LDB(B1, 1, 1); PG8_STAGE(PG8_SB(1, 0), b3, voffB);
            PG8_BAR; PG8_WAIT_L(0); PG8_MMA(0, 1, At, B1); PG8_BAR;
            PG8_LDA(At, 1, 1); PG8_STAGE(PG8_SA(1, 0), a3, voffA);
            PG8_BAR; PG8_WAIT_L(0); PG8_MMA(1, 0, At, B0); PG8_BAR; PG8_SCHED;
            PG8_STAGE(PG8_SB(1, 1), b3 + hstepB, voffB);
            PG8_WAIT_V(6); PG8_BAR; PG8_MMA(1, 1, At, B1); PG8_BAR;
            }
        }
        if constexpr (ALIGN_EPI) { if (wr == 0) PG8_BAR; }
        if constexpr (!Epi::AFTER_DRAIN) { E(acc, cur, wr, wc, fr, fq); S.done(cur); }
        if (!has_next) break;
#pragma unroll
        for (int a = 0; a < 2; ++a)
#pragma unroll
            for (int b = 0; b < 2; ++b)
#pragma unroll
                for (int m = 0; m < 4; ++m)
#pragma unroll
                    for (int n = 0; n < 2; ++n) acc[a][b][m][n] = (f32x4){0.f, 0.f, 0.f, 0.f};
        cur = nxt; cA = nA; cB = nB; ++ui;
        if constexpr (ALIGN_EPI) { if (wr == 1) PG8_BAR; }
    }
    PG8_WAIT_V(0);
    if constexpr (!ALIGN_EPI) { if (wr == 0) PG8_BAR; }
    PG8_BAR;
    if constexpr (Epi::AFTER_DRAIN) { E.fused(acc, cur, wr, wc, fr, fq, lds, wid, lane); S.done(cur); }
#undef PG8_SA
#undef PG8_SB
#undef PG8_STAGE
#undef PG8_LDA
#undef PG8_LDB
#undef PG8_MMA
#undef PG8_WAIT_V
#undef PG8_WAIT_L
#undef PG8_BAR
#undef PG8_SCHED
}
}

#ifndef MK_EXP_OLD
#define MK_EXP_OLD 0
#endif
#ifndef MK_ONE_LAUNCH
#define MK_ONE_LAUNCH 1
#endif
#define LAS __attribute__((address_space(3)))
typedef unsigned short bf16;
typedef unsigned v4u __attribute__((ext_vector_type(4)));
typedef unsigned v2u __attribute__((ext_vector_type(2)));
typedef float f32x4 __attribute__((ext_vector_type(4)));
typedef float f32x2 __attribute__((ext_vector_type(2)));
typedef short bf16x8 __attribute__((ext_vector_type(8)));
typedef float f32x16 __attribute__((ext_vector_type(16)));
#define MFMA32(a, b, c) __builtin_amdgcn_mfma_f32_32x32x16_bf16((a), (b), (c), 0, 0, 0)

constexpr int D = 1024, NB = 8, SEQ = 2048, LC = 256, ML = NB * SEQ  , MC = NB * LC  , MT = ML + MC  ;
constexpr int PROJ = 2576, NPROJ = 2560;
constexpr int NEXP = 16384, TOPK = 16, KK = 128;
constexpr float EPS = 1e-6f;
constexpr int NTHREADS = 512, NWAVES = 8;
constexpr int LDS_BYTES = 147456;
constexpr int NPHASES = 16;

constexpr size_t MiB = 1u << 20;
constexpr size_t WS_CTL = 0;
constexpr size_t CTL_ZERO_BYTES = 65536;
constexpr int CW_BAR = 0;
constexpr int CW_E1 = 4096, CW_E2 = 4096 + 8 * 64;
constexpr size_t WS_MOD = 1 * MiB;
constexpr size_t WS_LP = 1 * MiB + 512 * 1024;
constexpr size_t WS_WIN = 2 * MiB;
constexpr size_t WS_WOUT = 8 * MiB;
constexpr size_t WS_WGLU = 10 * MiB;
constexpr size_t WS_WQ = 11 * MiB;
constexpr size_t WS_GB = 15 * MiB;
constexpr size_t WS_BB = 17 * MiB;
constexpr size_t WS_PM = 41 * MiB;
constexpr size_t WS_OG = 17 * MiB;
constexpr size_t WS_HX2 = 17 * MiB;
constexpr size_t WS_U5 = 49 * MiB;
constexpr size_t WS_CAT = 49 * MiB;
constexpr size_t WS_IDX = 49 * MiB;
constexpr size_t WS_GATE = 57 * MiB;
constexpr size_t WS_ACT = 65 * MiB;
constexpr size_t WS_SSQP = 73 * MiB;
constexpr size_t WS_Z = 85 * MiB;
constexpr size_t WS_YRAW = 85 * MiB;
constexpr size_t WS_QP = 85 * MiB;
constexpr size_t WS_Y = 85 * MiB;
constexpr size_t WS_HX = 101 * MiB;
constexpr size_t WS_SS = 101 * MiB;
constexpr size_t WS_YG = 101 * MiB;
constexpr size_t WS_FRT = 125 * MiB;
constexpr size_t WS_QKVPRE = 137 * MiB;
constexpr size_t WS_FRA = 143 * MiB;
constexpr size_t WS_FRK = 161 * MiB;
constexpr size_t WS_FRTAB = 197 * MiB;
constexpr size_t WS_QKV = 202 * MiB;
constexpr size_t WS_U8 = 202 * MiB;
constexpr size_t WS_V8 = 218 * MiB;
constexpr size_t WS_USC = 234 * MiB;
constexpr size_t WS_VSC = 234 * MiB + 512 * 1024;
constexpr size_t WS_HQ8 = 150 * MiB;
constexpr size_t WS_HS = 183 * MiB;
constexpr size_t WS_PACT = 85 * MiB;
constexpr size_t WS_END = 256 * MiB;
static_assert(WS_BB + (size_t)32 * 512 * 768 * 2 <= WS_PM && WS_PM + (size_t)32 * 256 * 512 * 2 <= WS_U5 && WS_U5 + (size_t)32 * 768 * 768 * 2 <= WS_Z && WS_Z + (size_t)ML * 512 * 2 <= WS_HX, "ws map a");
static_assert(WS_HX + (size_t)MT * D * 2 <= WS_QKVPRE && WS_SS + (size_t)32 * 768 * 256 * 4 <= WS_FRT && WS_QKVPRE + (size_t)MT * 1536 * 2 <= WS_QKV && WS_QKV + (size_t)MT * 1536 * 2 <= WS_END, "ws map b");
static_assert(WS_FRT + (size_t)2304 * 8192 <= WS_FRA && WS_FRA + (size_t)2304 * 8192 <= WS_FRK && WS_FRK + (size_t)2304 * 16384 <= WS_FRTAB && WS_FRTAB + (size_t)2304 * 1024 <= WS_QKV, "ws map c");
static_assert(WS_OG + (size_t)2 * ML * 512 * 2 <= WS_CAT && WS_CAT + (size_t)ML * D * 2 <= WS_Z && WS_YRAW + (size_t)ML * D * 4 <= WS_U8 && WS_SSQP + (size_t)8 * ML * 4 <= WS_Z && WS_YG + (size_t)ML * 512 * 2 <= WS_FRT, "ws map d");

__device__ __forceinline__ unsigned f2bf(float f) { unsigned u = __builtin_bit_cast(unsigned, f); return (u + 0x7fffu + ((u >> 16) & 1u)) >> 16; }
typedef __bf16 bf16x2_t __attribute__((ext_vector_type(2)));
__device__ __forceinline__ unsigned pk2(float lo, float hi) { const f32x2 v = {lo, hi}; return __builtin_bit_cast(unsigned, __builtin_convertvector(v, bf16x2_t)); }
__device__ __forceinline__ float bflo(unsigned w) { return __builtin_bit_cast(float, w << 16); }
__device__ __forceinline__ float bfhi(unsigned w) { return __builtin_bit_cast(float, w & 0xffff0000u); }
__device__ __forceinline__ float bf1(bf16 h) { return __builtin_bit_cast(float, (unsigned)h << 16); }
__device__ __forceinline__ float wave_sum(float v) {
#pragma unroll
    for (int o = 1; o < 64; o <<= 1) v += __shfl_xor(v, o);
    return v;
}
__device__ __forceinline__ float wave_max(float v) {
#pragma unroll
    for (int o = 1; o < 64; o <<= 1) v = fmaxf(v, __shfl_xor(v, o));
    return v;
}
__device__ __forceinline__ float sigmoidf_(float x) { return __builtin_amdgcn_rcpf(1.f + __expf(-x)); }
__device__ __forceinline__ float siluf_(float x) { return x * __builtin_amdgcn_rcpf(1.f + __expf(-x)); }
__device__ __forceinline__ float gelu_erf(float x) { return 0.5f * x * (1.f + erff(x * 0.70710678118654752f)); }
__device__ __forceinline__ void sincos_d(double a, float& s, float& c) {
    const double k = rint(a * 0.63661977236758134308);
    const double r = fma(-k, 1.57079632679489661923, a) - k * 6.123233995736766e-17;
    const double r2 = r * r;
    double sp = -2.5052108385441720e-08; sp = sp * r2 + 2.7557319223985893e-06; sp = sp * r2 - 1.9841269841269841e-04; sp = sp * r2 + 8.3333333333333332e-03; sp = sp * r2 - 1.6666666666666666e-01;
    const double sn = r + r * r2 * sp;
    double cp = 2.0876756987868099e-09; cp = cp * r2 - 2.7557319223985888e-07; cp = cp * r2 + 2.4801587301587302e-05; cp = cp * r2 - 1.3888888888888889e-03; cp = cp * r2 + 4.1666666666666664e-02; cp = cp * r2 - 0.5;
    const double cs = 1.0 + r2 * cp;
    const int q = ((int)k) & 3;
    const double ss = (q == 0) ? sn : (q == 1) ? cs : (q == 2) ? -sn : -cs;
    const double cc = (q == 0) ? cs : (q == 1) ? -sn : (q == 2) ? -cs : sn;
    s = (float)ss; c = (float)cc;
}

struct Args { const float* in[29]; float* out; unsigned char* ws; int ph_lo, ph_hi; };
static_assert(sizeof(Args) == 29 * 8 + 8 + 8 + 8, "Args has no padding");
enum { I_X = 0, I_C, I_CTX, I_CCTX, I_WMOD, I_BMOD, I_GPREMIX, I_GPOSTMIX, I_GPREFFN, I_GPOSTFFN, I_WIN, I_WOUT, I_LAMRE, I_LAMIM, I_LOGDT, I_BRE, I_BIM, I_CRE, I_CIM, I_S5D, I_WGLU,
       I_CONV, I_ALOG, I_DTBIAS, I_GDNNORM, I_WQ, I_KEYS, I_PU, I_PV };

__device__ __forceinline__ const float* in_row(const Args& a, int row) { return row < ML ? a.in[I_X] + (size_t)row * D : a.in[I_CTX] + (size_t)(row - ML) * D; }
__device__ __forceinline__ int mod_row(int row) { return row < ML ? (row >> 11) : 8; }

template <int CTRL> __device__ __forceinline__ float dppf(float v) { return __builtin_bit_cast(float, __builtin_amdgcn_update_dpp(0, __builtin_bit_cast(int, v), CTRL, 0xf, 0xf, true)); }
__device__ __forceinline__ float row_sum16(float v) { v += dppf<0xB1>(v); v += dppf<0x4E>(v); v += dppf<0x141>(v); v += dppf<0x140>(v); return v; }
__device__ __forceinline__ float row_max16(float v) { v = fmaxf(v, dppf<0xB1>(v)); v = fmaxf(v, dppf<0x4E>(v)); v = fmaxf(v, dppf<0x141>(v)); v = fmaxf(v, dppf<0x140>(v)); return v; }
__device__ __forceinline__ float wsum(float v) { v = row_sum16(v); return
    __builtin_bit_cast(float, __builtin_amdgcn_readlane(__builtin_bit_cast(int, v), 0)) + __builtin_bit_cast(float, __builtin_amdgcn_readlane(__builtin_bit_cast(int, v), 16)) +
    __builtin_bit_cast(float, __builtin_amdgcn_readlane(__builtin_bit_cast(int, v), 32)) + __builtin_bit_cast(float, __builtin_amdgcn_readlane(__builtin_bit_cast(int, v), 48)); }
__device__ __forceinline__ float wmax(float v) { v = row_max16(v); return fmaxf(fmaxf(__builtin_bit_cast(float, __builtin_amdgcn_readlane(__builtin_bit_cast(int, v), 0)), __builtin_bit_cast(float, __builtin_amdgcn_readlane(__builtin_bit_cast(int, v), 16))),
    fmaxf(__builtin_bit_cast(float, __builtin_amdgcn_readlane(__builtin_bit_cast(int, v), 32)), __builtin_bit_cast(float, __builtin_amdgcn_readlane(__builtin_bit_cast(int, v), 48)))); }
__device__ __forceinline__ int lane_rank(unsigned long long m) { return __builtin_amdgcn_mbcnt_hi((unsigned)(m >> 32), __builtin_amdgcn_mbcnt_lo((unsigned)m, 0)); }
__device__ __forceinline__ unsigned fkey(float f) { const unsigned u = __builtin_bit_cast(unsigned, f); return u ^ ((unsigned)((int)u >> 31) | 0x80000000u); }
#define WAVE_LDS_SYNC() do { __builtin_amdgcn_fence(__ATOMIC_RELEASE, "wavefront"); __builtin_amdgcn_wave_barrier(); __builtin_amdgcn_fence(__ATOMIC_ACQUIRE, "wavefront"); } while (0)
template <int N> __device__ __forceinline__ unsigned kth_key(const unsigned (&k)[N], int K) {
    unsigned T = 0;
    for (int bit = 31; bit >= 0; --bit) { const unsigned cand = T | (1u << bit); int cnt = 0;
#pragma unroll
        for (int n = 0; n < N; ++n) cnt += __popcll(__ballot(k[n] >= cand));
        if (cnt >= K) T = cand;
        if (cnt == K) break; }
    return T;
}

namespace pg8 {
struct EpiInProj {
    static constexpr bool PERM = true, AFTER_DRAIN = false;
    bf16_t* U; bf16_t* QKV; bf16_t* Z;
    __device__ __forceinline__ void operator()(const f32x4 (&acc)[2][2][4][2], const Unit& u, int wr, int wc, int fr, int fq) const {
        bf16_t* base; int ld, colt; bool lat_only = false;
        const bool s5 = u.pn < 2;
        if (s5) { base = U; ld = 0; colt = u.pn * BM; }
        else if (u.pn < 8) { base = QKV; ld = 1536; colt = (u.pn - 2) * BM; }
        else { base = Z; ld = 512; colt = (u.pn - 8) * BM; lat_only = true; }
        const int row0 = u.pm * BM + wr * 64 + fr, col0 = colt + wc * 32 + 8 * fq;
#pragma unroll
        for (int ai = 0; ai < 2; ++ai)
#pragma unroll
            for (int m = 0; m < 4; ++m) { const int row = row0 + ai * HALF + m * 16; bf16_t* rowp = base + (size_t)row * ld + col0;
                if (lat_only && row >= 16384) continue;
                if (s5) { const int R = row < 16384 ? (row >> 5) : 512 + ((row - 16384) >> 5), ii = row & 31; rowp = base + (size_t)R * 768 + ii * 16 + (col0 & 15); }
#pragma unroll
                for (int bj = 0; bj < 2; ++bj) { const f32x4 v0 = acc[ai][bj][m][0], v1 = acc[ai][bj][m][1];
                    u32x4 w; w.x = cvt_pk_bf16(v0[0], v0[1]); w.y = cvt_pk_bf16(v0[2], v0[3]); w.z = cvt_pk_bf16(v1[0], v1[1]); w.w = cvt_pk_bf16(v1[2], v1[3]);
                    if (s5) *(u32x4*)(rowp + (size_t)((col0 + bj * HALF) >> 4) * (768 * 768)) = w; else *(u32x4*)(rowp + bj * HALF) = w; } }
    }
};
struct EpiGlu {
    static constexpr bool PERM = true, AFTER_DRAIN = false;
    const bf16_t* YG; bf16_t* CAT;
    __device__ __forceinline__ void operator()(const f32x4 (&acc)[2][2][4][2], const Unit& u, int wr, int wc, int fr, int fq) const {
        const int row0 = u.pm * BM + wr * 64 + fr, col0 = u.pn * BM + wc * 32 + 8 * fq;
#pragma unroll
        for (int ai = 0; ai < 2; ++ai)
#pragma unroll
            for (int m = 0; m < 4; ++m) { const int row = row0 + ai * HALF + m * 16;
#pragma unroll
                for (int bj = 0; bj < 2; ++bj) { const f32x4 v0 = acc[ai][bj][m][0], v1 = acc[ai][bj][m][1];
                    const u32x4 y = *(const u32x4*)(YG + (size_t)row * 512 + col0 + bj * HALF);
                    float o[8]; const float a[8] = {v0[0], v0[1], v0[2], v0[3], v1[0], v1[1], v1[2], v1[3]};
                    const unsigned yw[4] = {y.x, y.y, y.z, y.w};
#pragma unroll
                    for (int e = 0; e < 8; ++e) { const float yv = __builtin_bit_cast(float, (e & 1) ? (yw[e >> 1] & 0xffff0000u) : (yw[e >> 1] << 16)); o[e] = yv * __builtin_amdgcn_rcpf(1.f + __expf(-a[e])); }
                    u32x4 w; w.x = cvt_pk_bf16(o[0], o[1]); w.y = cvt_pk_bf16(o[2], o[3]); w.z = cvt_pk_bf16(o[4], o[5]); w.w = cvt_pk_bf16(o[6], o[7]);
                    *(u32x4*)(CAT + (size_t)row * 1024 + col0 + bj * HALF) = w; } }
    }
};
struct EpiF32 {
    static constexpr bool PERM = false, AFTER_DRAIN = false;
    float* C; int ldc;
    __device__ __forceinline__ void operator()(const f32x4 (&acc)[2][2][4][2], const Unit& u, int wr, int wc, int fr, int fq) const {
        const int row0 = u.pm * BM + wr * 64 + fr, col0 = u.pn * BM + wc * 32 + 4 * fq;
#pragma unroll
        for (int ai = 0; ai < 2; ++ai)
#pragma unroll
            for (int m = 0; m < 4; ++m) { float* rowp = C + (size_t)(row0 + ai * HALF + m * 16) * ldc + col0;
#pragma unroll
                for (int bj = 0; bj < 2; ++bj)
#pragma unroll
                    for (int n = 0; n < 2; ++n) *(f32x4*)(rowp + bj * HALF + n * 16) = acc[ai][bj][m][n]; }
    }
};
struct EpiSS {
    static constexpr bool PERM = false, AFTER_DRAIN = false;
    float* C;
    __device__ __forceinline__ void operator()(const f32x4 (&acc)[2][2][4][2], const Unit& u, int wr, int wc, int fr, int fq) const {
        const int row0 = u.pm * BM + wr * 64 + fr, col0 = wc * 32 + 4 * fq;
#pragma unroll
        for (int ai = 0; ai < 2; ++ai)
#pragma unroll
            for (int m = 0; m < 4; ++m) { float* rowp = C + (size_t)(row0 + ai * HALF + m * 16) * 256 + col0;
#pragma unroll
                for (int bj = 0; bj < 2; ++bj)
#pragma unroll
                    for (int n = 0; n < 2; ++n) *(f32x4*)(rowp + bj * HALF + n * 16) = acc[ai][bj][m][n]; }
    }
};
struct SchedSS { int G, c; __device__ bool next(int i, Unit& u) const { const int L = i * G + c; if (L >= 96) return false; u.pm = L; u.pn = L / 3; return true; }
    __device__ __forceinline__ void a_ready(const Unit&) const {} __device__ __forceinline__ void done(const Unit&) const {} };
struct EpiS5Y {
    static constexpr bool PERM = true, AFTER_DRAIN = false;
    bf16_t* YG;
    __device__ __forceinline__ void operator()(const f32x4 (&acc)[2][2][4][2], const Unit& u, int wr, int wc, int fr, int fq) const {
        const int g = u.pn >> 1, R0 = (u.pm - 3 * g) * BM + wr * 64 + fr, n0 = (u.pn & 1) * BM + wc * 32 + 8 * fq;
#pragma unroll
        for (int ai = 0; ai < 2; ++ai)
#pragma unroll
            for (int m = 0; m < 4; ++m) { const int R = R0 + ai * HALF + m * 16;
#pragma unroll
                for (int bj = 0; bj < 2; ++bj) { const int n = n0 + bj * HALF; const f32x4 v0 = acc[ai][bj][m][0], v1 = acc[ai][bj][m][1];
                    const f32x2 a = gelu_pk((f32x2){v0[0], v0[1]}), b = gelu_pk((f32x2){v0[2], v0[3]}), c2 = gelu_pk((f32x2){v1[0], v1[1]}), d = gelu_pk((f32x2){v1[2], v1[3]});
                    u32x4 w; w.x = cvt_pk_bf16(a.x, a.y); w.y = cvt_pk_bf16(b.x, b.y); w.z = cvt_pk_bf16(c2.x, c2.y); w.w = cvt_pk_bf16(d.x, d.y);
                    *(u32x4*)(YG + (size_t)(R * 32 + (n >> 4)) * 512 + g * 16 + (n & 15)) = w; } }
    }
};
struct SchedS5Y { int G, c; __device__ bool next(int i, Unit& u) const { const int L = i * G + c; if (L >= 128) return false; const int g = L >> 2; u.pm = 3 * g + ((L >> 1) & 1); u.pn = 2 * g + (L & 1); return true; }
    __device__ __forceinline__ void a_ready(const Unit&) const {} __device__ __forceinline__ void done(const Unit&) const {} };
}

struct Ctx { const Args* a; unsigned char* ws; unsigned char* lds; int tid, lane, wave, bid, G, gw, NGW, gwv; };

__device__ __forceinline__ void p0_transpose_item(const float* W, int ldw, int nblk, int K, bf16* WT, float* scr, int item, int lane) {
    const int kb = item / nblk, nb = item % nblk, k0 = 64 * kb, n0 = 32 * nb;
#pragma unroll 8
    for (int i = 0; i < 32; ++i) { const int kk = 2 * i + (lane >> 5); scr[kk * 33 + (lane & 31)] = W[(size_t)(k0 + kk) * ldw + n0 + (lane & 31)]; }
    __builtin_amdgcn_fence(__ATOMIC_RELEASE, "wavefront"); __builtin_amdgcn_wave_barrier(); __builtin_amdgcn_fence(__ATOMIC_ACQUIRE, "wavefront");
    const int c = lane & 7;
#pragma unroll
    for (int j = 0; j < 4; ++j) { const int n = (lane >> 3) + 8 * j; const float* s = scr + (8 * c) * 33 + n;
        v4u o; o.x = pk2(s[0 * 33], s[1 * 33]); o.y = pk2(s[2 * 33], s[3 * 33]); o.z = pk2(s[4 * 33], s[5 * 33]); o.w = pk2(s[6 * 33], s[7 * 33]);
        *(v4u*)(WT + (size_t)(n0 + n) * K + k0 + 8 * c) = o; }
    __builtin_amdgcn_fence(__ATOMIC_RELEASE, "wavefront"); __builtin_amdgcn_wave_barrier(); __builtin_amdgcn_fence(__ATOMIC_ACQUIRE, "wavefront");
}
__device__ __forceinline__ void phase_prep(const Ctx& c) {
    const Args& a = *c.a;
    float* scr = (float*)(c.lds + c.wave * 16384);
    constexpr int I_IN = 16 * 80, I_OUT = 16 * 32, I_GLU = 8 * 16, I_Q = 16 * 64;
    for (int it = c.gw; it < I_IN + I_OUT + I_GLU + I_Q; it += c.NGW) {
        int r = it;
        if (r < I_IN) { p0_transpose_item(a.in[I_WIN], PROJ, 80, 1024, (bf16*)(c.ws + WS_WIN), scr, r, c.lane); continue; } r -= I_IN;
        if (r < I_OUT) { p0_transpose_item(a.in[I_WOUT], 1024, 32, 1024, (bf16*)(c.ws + WS_WOUT), scr, r, c.lane); continue; } r -= I_OUT;
        if (r < I_GLU) { p0_transpose_item(a.in[I_WGLU], 512, 16, 512, (bf16*)(c.ws + WS_WGLU), scr, r, c.lane); continue; } r -= I_GLU;
        p0_transpose_item(a.in[I_WQ], 2048, 64, 1024, (bf16*)(c.ws + WS_WQ), scr, r, c.lane);
    }
    __syncthreads();
    float* sc = (float*)c.lds;
    float* red = (float*)(c.lds + 9 * 1024 * 4);
    float* MOD = (float*)(c.ws + WS_MOD);
    bool have = false;
    for (int item = c.bid; item < 96; item += c.G) {
        if (!have) { for (int i = c.tid; i < 9 * 1024; i += NTHREADS) { const int r = i >> 10, k = i & 1023; const float v = r < 8 ? a.in[I_C][r * 1024 + k] : a.in[I_CCTX][k]; sc[i] = siluf_(v); } have = true; __syncthreads(); }
        const int n0 = item * 64;
        float acc[9];
#pragma unroll
        for (int r = 0; r < 9; ++r) acc[r] = 0.f;
        const float* wp = a.in[I_WMOD] + (size_t)(c.wave * 128) * 6144 + n0 + c.lane;
#pragma unroll 16
        for (int k = 0; k < 128; ++k) { const float w = wp[(size_t)k * 6144];
#pragma unroll
            for (int r = 0; r < 9; ++r) acc[r] = fmaf(sc[r * 1024 + c.wave * 128 + k], w, acc[r]); }
#pragma unroll
        for (int r = 0; r < 9; ++r) red[(c.wave * 9 + r) * 64 + c.lane] = acc[r];
        __syncthreads();
        for (int i = c.tid; i < 576; i += NTHREADS) { const int r = i >> 6, l = i & 63; float s = a.in[I_BMOD][n0 + l];
#pragma unroll
            for (int w = 0; w < 8; ++w) s += red[(w * 9 + r) * 64 + l];
            MOD[r * 6144 + n0 + l] = s; }
        __syncthreads();
    }
}
__device__ __forceinline__ void s5_build_group(const Ctx& c, int g, int part);
__device__ __forceinline__ void phase_s5_build(const Ctx& c) { for (int it = c.G - 1 - c.bid; it < 128; it += c.G) if (it >= 0) s5_build_group(c, it >> 2, it & 3); }

__device__ __forceinline__ void phase_norm1(const Ctx& c) {
    const Args& a = *c.a;
    float* wabT = (float*)c.lds;
    { f32x4 wv[8];
#pragma unroll
      for (int q = 0; q < 8; ++q) { const int i = c.tid + NTHREADS * q, kk = i >> 2, qq = i & 3; wv[q] = *(const f32x4*)(a.in[I_WIN] + (size_t)kk * PROJ + NPROJ + 4 * qq); }
#pragma unroll
      for (int q = 0; q < 8; ++q) { const int i = c.tid + NTHREADS * q, kk = i >> 2, qq = i & 3; wabT[(4 * qq + 0) * 1028 + kk] = wv[q].x; wabT[(4 * qq + 1) * 1028 + kk] = wv[q].y; wabT[(4 * qq + 2) * 1028 + kk] = wv[q].z; wabT[(4 * qq + 3) * 1028 + kk] = wv[q].w; } }
    __syncthreads();
    const float* MOD = (const float*)(c.ws + WS_MOD);
    bf16* HX = (bf16*)(c.ws + WS_HX); float* GB = (float*)(c.ws + WS_GB);
    const float* gpre = a.in[I_GPREMIX];
    f32x4 nx[4];
    if (c.gw < MT) { const f32x4* xr = (const f32x4*)in_row(a, c.gw) + c.lane;
#pragma unroll
        for (int j = 0; j < 4; ++j) nx[j] = xr[64 * j]; }
    for (int row = c.gw; row < MT; row += c.NGW) {
        const float* mr = MOD + mod_row(row) * 6144;
        f32x4 v[4]; float ss = 0.f;
#pragma unroll
        for (int j = 0; j < 4; ++j) { v[j] = nx[j]; ss += (v[j].x * v[j].x + v[j].y * v[j].y) + (v[j].z * v[j].z + v[j].w * v[j].w); }
        if (row + c.NGW < MT) { const f32x4* xr = (const f32x4*)in_row(a, row + c.NGW) + c.lane;
#pragma unroll
            for (int j = 0; j < 4; ++j) nx[j] = xr[64 * j]; }
        const float r = rsqrtf(wsum(ss) * (1.f / D) + EPS);
#pragma unroll
        for (int j = 0; j < 4; ++j) { const int col = 4 * c.lane + 256 * j;
            const f32x4 g4 = *(const f32x4*)(gpre + col), sh = *(const f32x4*)(mr + col), scl = *(const f32x4*)(mr + 1024 + col);
            v[j] = (v[j] * r) * g4 * (scl + 1.f) + sh;
            v2u o; o.x = pk2(v[j].x, v[j].y); o.y = pk2(v[j].z, v[j].w);
            *(v2u*)(HX + (size_t)row * D + col) = o; }
        float pj[16];
#pragma unroll
        for (int j = 0; j < 16; ++j) { float s = 0.f;
#pragma unroll
            for (int jj = 0; jj < 4; ++jj) { const f32x4 w = *(const f32x4*)(wabT + j * 1028 + 4 * c.lane + 256 * jj); s += (v[jj].x * w.x + v[jj].y * w.y) + (v[jj].z * w.z + v[jj].w * w.w); }
            pj[j] = s; if ((j & 1) == 1) asm volatile("" ::: "memory"); }
        const bool b5 = c.lane & 32, b4 = c.lane & 16, b3 = c.lane & 8, b2 = c.lane & 4;
        float q8[8], q4[4], q2[2];
#pragma unroll
        for (int i = 0; i < 8; ++i) { const float keep = b5 ? pj[i + 8] : pj[i], send = b5 ? pj[i] : pj[i + 8]; q8[i] = keep + __shfl_xor(send, 32); }
#pragma unroll
        for (int i = 0; i < 4; ++i) { const float keep = b4 ? q8[i + 4] : q8[i], send = b4 ? q8[i] : q8[i + 4]; q4[i] = keep + __shfl_xor(send, 16); }
#pragma unroll
        for (int i = 0; i < 2; ++i) { const float keep = b3 ? q4[i + 2] : q4[i], send = b3 ? q4[i] : q4[i + 2]; q2[i] = keep + dppf<0x140>(send); }
        float mine; { const float keep = b2 ? q2[1] : q2[0], send = b2 ? q2[0] : q2[1]; mine = keep + dppf<0x141>(send); }
        mine += dppf<0xB1>(mine); mine += dppf<0x4E>(mine);
        const int jl = (b5 ? 8 : 0) + (b4 ? 4 : 0) + (b3 ? 2 : 0) + (b2 ? 1 : 0);
        if ((c.lane & 3) == 0) {
            if (jl < 8) { const float t = mine + a.in[I_DTBIAS][jl]; const float sp = t > 20.f ? t : log1pf(expf(t)); GB[(size_t)row * 16 + jl] = -expf(a.in[I_ALOG][jl]) * sp; }
            else GB[(size_t)row * 16 + jl] = 1.f / (1.f + expf(-mine)); }
    }
}

__device__ __forceinline__ void phase_conv(const Ctx& c) {
    const Args& a = *c.a;
    const bf16* PRE = (const bf16*)(c.ws + WS_QKVPRE); bf16* OUT = (bf16*)(c.ws + WS_QKV);
    const float* cw = a.in[I_CONV];
#pragma unroll 1
    for (int pass = 0; pass < 3; ++pass) { const int ch0 = pass * 512 + 8 * c.lane;
        f32x4 wt[9][2];
#pragma unroll
        for (int i = 0; i < 9; ++i) { wt[i][0] = *(const f32x4*)(cw + i * 1536 + ch0); wt[i][1] = *(const f32x4*)(cw + i * 1536 + ch0 + 4); }
#define CONV_LOAD(DST, ROW) do { const int row_ = (ROW); int nb_row[9]; bool ok[9]; \
            if (row_ < ML) { const int t = row_ & 2047, gr = t >> 6, gc = t & 63; \
                _Pragma("unroll") for (int dy = -1; dy <= 1; ++dy) _Pragma("unroll") for (int dx = -1; dx <= 1; ++dx) { const int i = (dy + 1) * 3 + dx + 1; ok[i] = (gr + dy >= 0) && (gr + dy < 32) && (gc + dx >= 0) && (gc + dx < 64); nb_row[i] = row_ + dy * 64 + dx; } } \
            else { const int t = (row_ - ML) & 255; _Pragma("unroll") for (int i = 0; i < 9; ++i) { ok[i] = false; nb_row[i] = row_; } \
                _Pragma("unroll") for (int dx = -1; dx <= 1; ++dx) { ok[4 + dx] = (t + dx >= 0) && (t + dx < 256); nb_row[4 + dx] = row_ + dx; } } \
            _Pragma("unroll") for (int i = 0; i < 9; ++i) DST[i] = ok[i] ? *(const v4u*)(PRE + (size_t)nb_row[i] * 1536 + ch0) : (v4u){0u, 0u, 0u, 0u}; } while (0)
        v4u nin[9];
        if (c.gw < MT) CONV_LOAD(nin, c.gw);
#pragma unroll 1
        for (int row = c.gw; row < MT; row += c.NGW) {
            v4u in[9];
#pragma unroll
            for (int i = 0; i < 9; ++i) in[i] = nin[i];
            if (row + c.NGW < MT) CONV_LOAD(nin, row + c.NGW);
            float o[8];
#pragma unroll
            for (int q = 0; q < 8; ++q) o[q] = 0.f;
#pragma unroll
            for (int i = 0; i < 9; ++i) { const unsigned w[4] = {in[i].x, in[i].y, in[i].z, in[i].w}; const float kk[8] = {wt[i][0].x, wt[i][0].y, wt[i][0].z, wt[i][0].w, wt[i][1].x, wt[i][1].y, wt[i][1].z, wt[i][1].w};
#pragma unroll
                for (int q = 0; q < 4; ++q) { o[2 * q] = fmaf(bflo(w[q]), kk[2 * q], o[2 * q]); o[2 * q + 1] = fmaf(bfhi(w[q]), kk[2 * q + 1], o[2 * q + 1]); } }
            float ssq = 0.f;
#pragma unroll
            for (int q = 0; q < 8; ++q) { o[q] = siluf_(o[q]); ssq = fmaf(o[q], o[q], ssq); }
            if (pass < 2) { const float sc = rsqrtf(row_sum16(ssq) + EPS) * (pass == 0 ? 0.08838834764831845f : 1.f);
#pragma unroll
                for (int q = 0; q < 8; ++q) o[q] *= sc; }
            v4u ov; ov.x = pk2(o[0], o[1]); ov.y = pk2(o[2], o[3]); ov.z = pk2(o[4], o[5]); ov.w = pk2(o[6], o[7]);
            *(v4u*)(OUT + (size_t)row * 1536 + ch0) = ov;
        }
#undef CONV_LOAD
    }
}

__device__ __forceinline__ int scan_row(int b, int dir, int step) {
    if (step < LC) { const int t = dir ? LC - 1 - step : step; return ML + b * LC + t; }
    const int t = step - LC; return b * SEQ + (dir ? SEQ - 1 - t : t);
}
__device__ __forceinline__ void phase_combine(const Ctx& c) {
    const Args& a = *c.a;
    const bf16* OG0 = (const bf16*)(c.ws + WS_OG); const bf16* OG1 = OG0 + (size_t)ML * 512; const bf16* Z = (const bf16*)(c.ws + WS_Z);
    bf16* CAT = (bf16*)(c.ws + WS_CAT);
    for (int row = c.gw; row < ML; row += c.NGW) {
#pragma unroll
        for (int h = 0; h < 4; ++h) { const int ch = h * 128 + 2 * c.lane;
            const unsigned w0 = *(const unsigned*)(OG0 + (size_t)row * 512 + ch), w1 = *(const unsigned*)(OG1 + (size_t)row * 512 + ch), zw = *(const unsigned*)(Z + (size_t)row * 512 + ch);
            const float o0 = bflo(w0) + bflo(w1), o1 = bfhi(w0) + bfhi(w1);
            const float r = rsqrtf(wave_sum(o0 * o0 + o1 * o1) * (1.f / 128.f) + EPS);
            const f32x2 ng = *(const f32x2*)(a.in[I_GDNNORM] + 2 * c.lane);
            *(unsigned*)(CAT + (size_t)row * 1024 + 512 + ch) = pk2(o0 * r * ng.x * siluf_(bflo(zw)), o1 * r * ng.y * siluf_(bfhi(zw))); }
    }
}

__device__ __forceinline__ void phase_rows2(const Ctx& c) {
    const Args& a = *c.a;
    const float* MOD = (const float*)(c.ws + WS_MOD); const bf16* YRAW = (const bf16*)(c.ws + WS_YRAW); bf16* HX2 = (bf16*)(c.ws + WS_HX2);
    v2u ny[4]; f32x4 nxx[4];
    if (c.gw < ML) {
#pragma unroll
        for (int j = 0; j < 4; ++j) { ny[j] = *((const v2u*)(YRAW + (size_t)c.gw * D) + c.lane + 64 * j); nxx[j] = *((const f32x4*)(a.in[I_X] + (size_t)c.gw * D) + c.lane + 64 * j); } }
    for (int row = c.gw; row < ML; row += c.NGW) {
        const float* mr = MOD + (row >> 11) * 6144;
        f32x4 y[4], x[4]; float ss = 0.f;
#pragma unroll
        for (int j = 0; j < 4; ++j) { y[j] = (f32x4){bflo(ny[j].x), bfhi(ny[j].x), bflo(ny[j].y), bfhi(ny[j].y)}; x[j] = nxx[j];
            ss += (y[j].x * y[j].x + y[j].y * y[j].y) + (y[j].z * y[j].z + y[j].w * y[j].w); }
        if (row + c.NGW < ML) { const size_t r2 = (size_t)(row + c.NGW);
#pragma unroll
            for (int j = 0; j < 4; ++j) { ny[j] = *((const v2u*)(YRAW + r2 * D) + c.lane + 64 * j); nxx[j] = *((const f32x4*)(a.in[I_X] + r2 * D) + c.lane + 64 * j); } }
        const float r = rsqrtf(wsum(ss) * (1.f / D) + EPS); float s2 = 0.f;
#pragma unroll
        for (int j = 0; j < 4; ++j) { const int col = 4 * c.lane + 256 * j;
            const f32x4 g4 = *(const f32x4*)(a.in[I_GPOSTMIX] + col), gt = *(const f32x4*)(mr + 2048 + col);
            x[j] = x[j] + gt * ((y[j] * r) * g4);
            *(f32x4*)(a.out + (size_t)row * D + col) = x[j];
            s2 += (x[j].x * x[j].x + x[j].y * x[j].y) + (x[j].z * x[j].z + x[j].w * x[j].w); }
        const float r2 = rsqrtf(wsum(s2) * (1.f / D) + EPS);
#pragma unroll
        for (int j = 0; j < 4; ++j) { const int col = 4 * c.lane + 256 * j;
            const f32x4 g4 = *(const f32x4*)(a.in[I_GPREFFN] + col), sh = *(const f32x4*)(mr + 3072 + col), scl = *(const f32x4*)(mr + 4096 + col);
            const f32x4 hv = (x[j] * r2) * g4 * (scl + 1.f) + sh;
            v2u o; o.x = pk2(hv.x, hv.y); o.y = pk2(hv.z, hv.w);
            *(v2u*)(HX2 + (size_t)row * D + col) = o;
            x[j] = (f32x4){bflo(o.x), bfhi(o.x), bflo(o.y), bfhi(o.y)}; }
        { float mx = 0.f;
#pragma unroll
          for (int j = 0; j < 4; ++j) mx = fmaxf(mx, fmaxf(fmaxf(fabsf(x[j].x), fabsf(x[j].y)), fmaxf(fabsf(x[j].z), fabsf(x[j].w))));
          mx = wmax(mx); const float hs = mx > 0.f ? 256.f / mx : 1.f;
          unsigned char* hq = c.ws + WS_HQ8 + (size_t)row * 2048;
#pragma unroll
          for (int j = 0; j < 4; ++j) { const float a0 = x[j].x * hs, a1 = x[j].y * hs, a2 = x[j].z * hs, a3 = x[j].w * hs;
              int w = __builtin_amdgcn_cvt_pk_fp8_f32(a0, a1, 0, false); w = __builtin_amdgcn_cvt_pk_fp8_f32(a2, a3, w, true);
              const f32x2 b01 = __builtin_amdgcn_cvt_pk_f32_fp8(w, false), b23 = __builtin_amdgcn_cvt_pk_f32_fp8(w, true);
              int w2 = __builtin_amdgcn_cvt_pk_fp8_f32((a0 - b01.x) * 16.f, (a1 - b01.y) * 16.f, 0, false); w2 = __builtin_amdgcn_cvt_pk_fp8_f32((a2 - b23.x) * 16.f, (a3 - b23.y) * 16.f, w2, true);
              *(unsigned*)(hq + 4 * c.lane + 256 * j) = (unsigned)w; *(unsigned*)(hq + 1024 + 4 * c.lane + 256 * j) = (unsigned)w2; }
          if (c.lane == 0) ((float*)(c.ws + WS_HS))[row] = 1.f / hs; }
    }
}


constexpr int KROW = 136;
__device__ __forceinline__ float unfkey(unsigned k) { const unsigned u = (k & 0x80000000u) ? (k ^ 0x80000000u) : ~k; return __builtin_bit_cast(float, u); }
__device__ __forceinline__ void ins16(unsigned (&L)[16], unsigned key) {
#pragma unroll
    for (int q = 0; q < 16; ++q) { const unsigned hi = L[q] > key ? L[q] : key, lo = L[q] > key ? key : L[q]; L[q] = hi; key = lo; }
}
__device__ __forceinline__ void sort16_desc(unsigned (&a)[16]) {
#pragma unroll
    for (int kk = 2; kk <= 16; kk <<= 1)
#pragma unroll
        for (int j = kk >> 1; j >= 1; j >>= 1)
#pragma unroll
            for (int i = 0; i < 16; ++i) { const int l = i ^ j; if (l > i) { const unsigned hi = a[i] > a[l] ? a[i] : a[l], lo = a[i] > a[l] ? a[l] : a[i]; if ((i & kk) == 0) { a[i] = hi; a[l] = lo; } else { a[i] = lo; a[l] = hi; } } }
}
__device__ __forceinline__ void top16_of_two(unsigned (&A)[16], const unsigned (&B)[16]) {
#pragma unroll
    for (int q = 0; q < 16; ++q) A[q] = A[q] > B[15 - q] ? A[q] : B[15 - q];
#pragma unroll
    for (int j = 8; j >= 1; j >>= 1)
#pragma unroll
        for (int q = 0; q < 16; ++q) if ((q & j) == 0) { const unsigned hi = A[q] > A[q + j] ? A[q] : A[q + j], lo = A[q] > A[q + j] ? A[q + j] : A[q]; A[q] = hi; A[q + j] = lo; }
}
__device__ __forceinline__ void merge16(unsigned (&L)[16]) {
    unsigned R[16];
#pragma unroll
    for (int q = 0; q < 16; ++q) R[q] = (unsigned)__shfl_xor((int)L[15 - q], 32);
#pragma unroll
    for (int q = 0; q < 16; ++q) L[q] = L[q] > R[q] ? L[q] : R[q];
#pragma unroll
    for (int j = 8; j >= 1; j >>= 1)
#pragma unroll
        for (int q = 0; q < 16; ++q) if ((q & j) == 0) { const unsigned hi = L[q] > L[q + j] ? L[q] : L[q + j], lo = L[q] > L[q + j] ? L[q + j] : L[q]; L[q] = hi; L[q + j] = lo; }
}
__device__ __forceinline__ void phase_topk(const Ctx& c) {
    const Args& a = *c.a;
    bf16* kl = (bf16*)c.lds;
    unsigned char* wtab = c.lds + 2 * 128 * KROW * 2 + c.wave * 1088;
    const bf16* QP = (const bf16*)(c.ws + WS_QP); int* IDX = (int*)(c.ws + WS_IDX); float* GATE = (float*)(c.ws + WS_GATE);
    const int r = c.lane & 31, hh = c.lane >> 5;
    { const unsigned char ptab[50] = {0, 1, 2, 3, 4, 5, 6, 7, 8, 9, 10, 11, 12, 13, 14, 15, 16, 17, 18, 19, 20, 21, 22, 23, 32, 33, 34, 35, 36, 48, 49, 50, 51, 64, 65, 66, 80, 81, 96, 97, 112, 113, 128, 144, 160, 176, 192, 208, 224, 240};
      if (c.lane < 50) wtab[1024 + c.lane] = ptab[c.lane < 50 ? c.lane : 0]; }
    for (int item = c.bid; item < 8 * 32; item += c.G) {
        const int h = item & 7, tr = item >> 3;
        __syncthreads();
        for (int i = c.tid; i < 2 * 128 * 64; i += NTHREADS) { const int k2 = i & 63, n = (i >> 6) & 127, p = i >> 13; const f32x2 kv = *(const f32x2*)(a.in[I_KEYS] + ((size_t)((h * 2 + p) * 128 + n)) * 128 + 2 * k2);
            *(unsigned*)(kl + (p * 128 + n) * KROW + 2 * k2) = pk2(kv.x, kv.y); }
        __syncthreads();
        for (int tile = c.wave; tile < 16; tile += NWAVES) {
            const int tok = tr * 512 + tile * 32 + r;
            unsigned LA[16], LB[16];
#pragma unroll
            for (int p = 0; p < 2; ++p) {
                bf16x8 qf[8];
#pragma unroll
                for (int kk = 0; kk < 8; ++kk) qf[kk] = *(const bf16x8*)(QP + (size_t)tok * 2048 + h * 256 + p * 128 + kk * 16 + hh * 8);
                f32x16 acc[4];
#pragma unroll
                for (int nt = 0; nt < 4; ++nt)
#pragma unroll
                    for (int i = 0; i < 16; ++i) acc[nt][i] = 0.f;
#pragma unroll
                for (int kk = 0; kk < 8; ++kk)
#pragma unroll
                    for (int nt = 0; nt < 4; ++nt) acc[nt] = MFMA32(*(const bf16x8*)(kl + (p * 128 + nt * 32 + r) * KROW + kk * 16 + hh * 8), qf[kk], acc[nt]);
                unsigned (&L)[16] = p ? LB : LA;
                unsigned G1[16], G2[16], G3[16];
#pragma unroll
                for (int i = 0; i < 16; ++i) { const int n0 = (i & 3) + 8 * (i >> 2) + 4 * hh;
                    L[i] = (fkey(acc[0][i]) & ~127u) | (unsigned)(127 - n0); G1[i] = (fkey(acc[1][i]) & ~127u) | (unsigned)(127 - (32 + n0));
                    G2[i] = (fkey(acc[2][i]) & ~127u) | (unsigned)(127 - (64 + n0)); G3[i] = (fkey(acc[3][i]) & ~127u) | (unsigned)(127 - (96 + n0)); }
                sort16_desc(L); sort16_desc(G1); sort16_desc(G2); sort16_desc(G3);
                top16_of_two(L, G1); top16_of_two(G2, G3); top16_of_two(L, G2);
                merge16(L);
            }
            unsigned char* tt = wtab + r * 32;
            if (hh == 0) {
#pragma unroll
                for (int q = 0; q < 16; ++q) tt[q] = (unsigned char)(127u - (LA[q] & 127u)); }
            else {
#pragma unroll
                for (int q = 0; q < 16; ++q) tt[16 + q] = (unsigned char)(127u - (LB[q] & 127u)); }
            float va[16], vb[16];
#pragma unroll
            for (int q = 0; q < 16; ++q) { va[q] = unfkey(LA[q] & ~127u); vb[q] = unfkey(LB[q] & ~127u); }
            unsigned LC[16];
#pragma unroll
            for (int q = 0; q < 16; ++q) LC[q] = 0u;
            { const float s0 = va[0] + vb[0], s1 = va[0] + vb[1]; ins16(LC, (fkey(hh ? s1 : s0) & ~63u) | (unsigned)(63 - (0 + hh))); }
            { const float s0 = va[0] + vb[2], s1 = va[0] + vb[3]; ins16(LC, (fkey(hh ? s1 : s0) & ~63u) | (unsigned)(63 - (2 + hh))); }
            { const float s0 = va[0] + vb[4], s1 = va[0] + vb[5]; ins16(LC, (fkey(hh ? s1 : s0) & ~63u) | (unsigned)(63 - (4 + hh))); }
            { const float s0 = va[0] + vb[6], s1 = va[0] + vb[7]; ins16(LC, (fkey(hh ? s1 : s0) & ~63u) | (unsigned)(63 - (6 + hh))); }
            { const float s0 = va[0] + vb[8], s1 = va[0] + vb[9]; ins16(LC, (fkey(hh ? s1 : s0) & ~63u) | (unsigned)(63 - (8 + hh))); }
            { const float s0 = va[0] + vb[10], s1 = va[0] + vb[11]; ins16(LC, (fkey(hh ? s1 : s0) & ~63u) | (unsigned)(63 - (10 + hh))); }
            { const float s0 = va[0] + vb[12], s1 = va[0] + vb[13]; ins16(LC, (fkey(hh ? s1 : s0) & ~63u) | (unsigned)(63 - (12 + hh))); }
            { const float s0 = va[0] + vb[14], s1 = va[0] + vb[15]; ins16(LC, (fkey(hh ? s1 : s0) & ~63u) | (unsigned)(63 - (14 + hh))); }
            { const float s0 = va[1] + vb[0], s1 = va[1] + vb[1]; ins16(LC, (fkey(hh ? s1 : s0) & ~63u) | (unsigned)(63 - (16 + hh))); }
            { const float s0 = va[1] + vb[2], s1 = va[1] + vb[3]; ins16(LC, (fkey(hh ? s1 : s0) & ~63u) | (unsigned)(63 - (18 + hh))); }
            { const float s0 = va[1] + vb[4], s1 = va[1] + vb[5]; ins16(LC, (fkey(hh ? s1 : s0) & ~63u) | (unsigned)(63 - (20 + hh))); }
            { const float s0 = va[1] + vb[6], s1 = va[1] + vb[7]; ins16(LC, (fkey(hh ? s1 : s0) & ~63u) | (unsigned)(63 - (22 + hh))); }
            { const float s0 = va[2] + vb[0], s1 = va[2] + vb[1]; ins16(LC, (fkey(hh ? s1 : s0) & ~63u) | (unsigned)(63 - (24 + hh))); }
            { const float s0 = va[2] + vb[2], s1 = va[2] + vb[3]; ins16(LC, (fkey(hh ? s1 : s0) & ~63u) | (unsigned)(63 - (26 + hh))); }
            { const float s0 = va[2] + vb[4], s1 = va[3] + vb[0]; ins16(LC, (fkey(hh ? s1 : s0) & ~63u) | (unsigned)(63 - (28 + hh))); }
            { const float s0 = va[3] + vb[1], s1 = va[3] + vb[2]; ins16(LC, (fkey(hh ? s1 : s0) & ~63u) | (unsigned)(63 - (30 + hh))); }
            { const float s0 = va[3] + vb[3], s1 = va[4] + vb[0]; ins16(LC, (fkey(hh ? s1 : s0) & ~63u) | (unsigned)(63 - (32 + hh))); }
            { const float s0 = va[4] + vb[1], s1 = va[4] + vb[2]; ins16(LC, (fkey(hh ? s1 : s0) & ~63u) | (unsigned)(63 - (34 + hh))); }
            { const float s0 = va[5] + vb[0], s1 = va[5] + vb[1]; ins16(LC, (fkey(hh ? s1 : s0) & ~63u) | (unsigned)(63 - (36 + hh))); }
            { const float s0 = va[6] + vb[0], s1 = va[6] + vb[1]; ins16(LC, (fkey(hh ? s1 : s0) & ~63u) | (unsigned)(63 - (38 + hh))); }
            { const float s0 = va[7] + vb[0], s1 = va[7] + vb[1]; ins16(LC, (fkey(hh ? s1 : s0) & ~63u) | (unsigned)(63 - (40 + hh))); }
            { const float s0 = va[8] + vb[0], s1 = va[9] + vb[0]; ins16(LC, (fkey(hh ? s1 : s0) & ~63u) | (unsigned)(63 - (42 + hh))); }
            { const float s0 = va[10] + vb[0], s1 = va[11] + vb[0]; ins16(LC, (fkey(hh ? s1 : s0) & ~63u) | (unsigned)(63 - (44 + hh))); }
            { const float s0 = va[12] + vb[0], s1 = va[13] + vb[0]; ins16(LC, (fkey(hh ? s1 : s0) & ~63u) | (unsigned)(63 - (46 + hh))); }
            { const float s0 = va[14] + vb[0], s1 = va[15] + vb[0]; ins16(LC, (fkey(hh ? s1 : s0) & ~63u) | (unsigned)(63 - (48 + hh))); }
            merge16(LC);
            WAVE_LDS_SYNC();
            float ev[16]; float den = 0.f; const float mx = unfkey(LC[0] & ~63u);
#pragma unroll
            for (int q = 0; q < 16; ++q) { ev[q] = __expf(unfkey(LC[q] & ~63u) - mx); den += ev[q]; }
            const float inv = 1.f / den;
            if (hh == 0) { int ex[16];
#pragma unroll
                for (int q = 0; q < 16; ++q) { const unsigned pc = wtab[1024 + (63u - (LC[q] & 63u))]; ex[q] = (int)tt[pc >> 4] * 128 + (int)tt[16 + (pc & 15u)]; }
#pragma unroll
                for (int q = 0; q < 4; ++q) *(v4u*)(IDX + (size_t)tok * 128 + h * 16 + 4 * q) = (v4u){(unsigned)ex[4 * q], (unsigned)ex[4 * q + 1], (unsigned)ex[4 * q + 2], (unsigned)ex[4 * q + 3]}; }
            else {
#pragma unroll
                for (int q = 0; q < 4; ++q) *(f32x4*)(GATE + (size_t)tok * 128 + h * 16 + 4 * q) = (f32x4){ev[4 * q] * inv, ev[4 * q + 1] * inv, ev[4 * q + 2] * inv, ev[4 * q + 3] * inv}; }
            WAVE_LDS_SYNC();
        }
    }
}

__device__ __forceinline__ void phase_fp8_tables(const Ctx& c) {
    const Args& a = *c.a;
    for (int r = c.gw; r < 2 * NEXP; r += c.NGW) {
        const bool isv = r >= NEXP; const int e = isv ? r - NEXP : r;
        const f32x4* src = (const f32x4*)((isv ? a.in[I_PV] : a.in[I_PU]) + (size_t)e * D) + c.lane;
        f32x4 v[4]; float m = 0.f;
#pragma unroll
        for (int j = 0; j < 4; ++j) { v[j] = src[64 * j]; m = fmaxf(m, fmaxf(fmaxf(fabsf(v[j].x), fabsf(v[j].y)), fmaxf(fabsf(v[j].z), fabsf(v[j].w)))); }
        m = wmax(m); const float inv = m > 0.f ? 256.f / m : 0.f;
        unsigned char* dst = c.ws + (isv ? WS_V8 : WS_U8) + (size_t)e * D + 4 * c.lane;
#pragma unroll
        for (int j = 0; j < 4; ++j) { int w = __builtin_amdgcn_cvt_pk_fp8_f32(v[j].x * inv, v[j].y * inv, 0, false); w = __builtin_amdgcn_cvt_pk_fp8_f32(v[j].z * inv, v[j].w * inv, w, true); *(unsigned*)(dst + 256 * j) = (unsigned)w; }
        if (c.lane == 0) ((float*)(c.ws + (isv ? WS_VSC : WS_USC)))[e] = m * (1.f / 256.f);
    }
}
__device__ __forceinline__ void fp8x16_to_f32(const v4u& r, float (&f)[16]) {
    const unsigned w[4] = {r.x, r.y, r.z, r.w};
#pragma unroll
    for (int j = 0; j < 4; ++j) { const f32x2 lo = __builtin_amdgcn_cvt_pk_f32_fp8((int)w[j], false), hi = __builtin_amdgcn_cvt_pk_f32_fp8((int)w[j], true); f[4 * j] = lo.x; f[4 * j + 1] = lo.y; f[4 * j + 2] = hi.x; f[4 * j + 3] = hi.y; }
}
__device__ __forceinline__ unsigned xcc_id() { return (unsigned)__builtin_amdgcn_s_getreg((3 << 11) | 20) & 7u; }

typedef long l64x2 __attribute__((ext_vector_type(2)));
struct E1Bat { l64x2 rw[16]; };
__device__ __forceinline__ void phase_exp1(const Ctx& c) {
    typedef float f32x4m __attribute__((ext_vector_type(4)));
    const int* IDX = (const int*)(c.ws + WS_IDX); const unsigned char* U8 = c.ws + WS_U8; float* PACT = (float*)(c.ws + WS_PACT);
    unsigned* cnt = (unsigned*)(c.ws + WS_CTL) + CW_E1;
    constexpr int CH = 8;
    constexpr int SROW = 144;
    unsigned char* wl = c.lds + c.wave * 11776; int* le = (int*)wl; unsigned char* himg = wl + 4096; float* res = (float*)(wl + 6144); unsigned char* stage = wl + 6656;
    const int xcc = (int)xcc_id(), r16 = c.lane & 15, g4 = c.lane >> 4, row8 = c.lane >> 3, pc8 = c.lane & 7; const bool bcol = r16 < 2;
    int bo = 0; unsigned tq = 0;
    if (c.lane == 0) tq = __hip_atomic_fetch_add(cnt + 64 * (xcc & 7), (unsigned)CH, __ATOMIC_RELAXED, __HIP_MEMORY_SCOPE_AGENT);
    for (;;) {
        const int x = (xcc + bo) & 7;
        const unsigned t0 = (unsigned)__builtin_amdgcn_readfirstlane((int)tq);
        if (t0 >= (unsigned)ML) { if (++bo >= 8) break; tq = 0; if (c.lane == 0) tq = __hip_atomic_fetch_add(cnt + 64 * ((xcc + bo) & 7), (unsigned)CH, __ATOMIC_RELAXED, __HIP_MEMORY_SCOPE_AGENT); continue; }
        tq = 0; if (c.lane == 0) tq = __hip_atomic_fetch_add(cnt + 64 * x, (unsigned)CH, __ATOMIC_RELAXED, __HIP_MEMORY_SCOPE_AGENT);
        { v4u ee[4], im[2];
#pragma unroll
          for (int q = 0; q < 4; ++q) ee[q] = *(const v4u*)(IDX + (size_t)t0 * 128 + 256 * q + 4 * c.lane);
#pragma unroll
          for (int q = 0; q < 2; ++q) { const int p = c.lane + 64 * q; im[q] = *(const v4u*)(c.ws + WS_HQ8 + ((size_t)t0 + (p >> 4)) * 2048 + ((p >> 3) & 1) * 1024 + 128 * x + 16 * (p & 7)); }
#pragma unroll
          for (int q = 0; q < 4; ++q) *(v4u*)(le + 256 * q + 4 * c.lane) = ee[q];
#pragma unroll
          for (int q = 0; q < 2; ++q) *(v4u*)(himg + 16 * (c.lane + 64 * q)) = im[q]; }
        WAVE_LDS_SYNC();
#define E1_LOAD(G, B) do { const int bb = (B) < CH ? (B) : 0; _Pragma("unroll") for (int i = 0; i < 16; ++i) G.rw[i] = *(const l64x2*)(U8 + (size_t)le[bb * 128 + 8 * i + row8] * D + 128 * x + 16 * pc8); } while (0)
#define E1_COMP(G, B) do { const unsigned char* hb = himg + ((B) * 2 + (r16 & 1)) * 128 + 32 * g4; long bq[4]; _Pragma("unroll") for (int m = 0; m < 4; ++m) { const long v = *(const long*)(hb + 8 * m); bq[m] = bcol ? v : 0l; } \
            _Pragma("unroll") for (int gi = 0; gi < 8; ++gi) { unsigned char* sb = stage + (gi & 1) * (16 * SROW); \
                *(l64x2*)(sb + row8 * SROW + 16 * pc8) = G.rw[2 * gi]; *(l64x2*)(sb + (8 + row8) * SROW + 16 * pc8) = G.rw[2 * gi + 1]; \
                WAVE_LDS_SYNC(); \
                const l64x2 a01 = *(const l64x2*)(sb + r16 * SROW + 32 * g4), a23 = *(const l64x2*)(sb + r16 * SROW + 32 * g4 + 16); \
                f32x4m acc = {0.f, 0.f, 0.f, 0.f}; \
                acc = __builtin_amdgcn_mfma_f32_16x16x32_fp8_fp8(a01.x, bq[0], acc, 0, 0, 0); acc = __builtin_amdgcn_mfma_f32_16x16x32_fp8_fp8(a01.y, bq[1], acc, 0, 0, 0); \
                acc = __builtin_amdgcn_mfma_f32_16x16x32_fp8_fp8(a23.x, bq[2], acc, 0, 0, 0); acc = __builtin_amdgcn_mfma_f32_16x16x32_fp8_fp8(a23.y, bq[3], acc, 0, 0, 0); \
                _Pragma("unroll") for (int q = 0; q < 4; ++q) { const float lo = dppf<0xB1>(acc[q]); if (r16 == 0) res[gi * 16 + 4 * g4 + q] = acc[q] + lo * 0.0625f; } } \
            WAVE_LDS_SYNC(); \
            { float* po = PACT + (size_t)x * ((size_t)ML * 128) + ((size_t)t0 + (B)) * 128; po[c.lane] = res[c.lane]; po[64 + c.lane] = res[64 + c.lane]; } \
            WAVE_LDS_SYNC(); } while (0)
        E1Bat ga, gb;
        E1_LOAD(ga, 0);
#pragma unroll 1
        for (int b2 = 0; b2 < CH; b2 += 2) {
            E1_LOAD(gb, b2 + 1);
            __builtin_amdgcn_sched_barrier(0);
            E1_COMP(ga, b2);
            __builtin_amdgcn_sched_barrier(0);
            E1_LOAD(ga, b2 + 2);
            __builtin_amdgcn_sched_barrier(0);
            E1_COMP(gb, b2 + 1);
            __builtin_amdgcn_sched_barrier(0);
        }
#undef E1_LOAD
#undef E1_COMP
    }
}
__device__ __forceinline__ void phase_exp1b(const Ctx& c) {
    const int* IDX = (const int*)(c.ws + WS_IDX); const float* GATE = (const float*)(c.ws + WS_GATE); const float* HS = (const float*)(c.ws + WS_HS); const float* PACT = (const float*)(c.ws + WS_PACT);
    const float* USC = (const float*)(c.ws + WS_USC); const float* VSC = (const float*)(c.ws + WS_VSC); float* ACT = (float*)(c.ws + WS_ACT);
    for (size_t i = (size_t)c.bid * NTHREADS + c.tid; i < (size_t)ML * 128; i += (size_t)c.G * NTHREADS) {
        float s = 0.f;
#pragma unroll
        for (int x = 0; x < 8; ++x) s += PACT[(size_t)x * ((size_t)ML * 128) + i];
        const int e = IDX[i];
        ACT[i] = gelu_erf(s * HS[i >> 7] * USC[e]) * GATE[i] * VSC[e];
    }
}
__device__ __forceinline__ void phase_exp2(const Ctx& c) {
    const int* IDX = (const int*)(c.ws + WS_IDX); const float* ACT = (const float*)(c.ws + WS_ACT); const unsigned char* V8 = c.ws + WS_V8;
    bf16* Y = (bf16*)(c.ws + WS_Y); float* SSQP = (float*)(c.ws + WS_SSQP);
    unsigned* cnt = (unsigned*)(c.ws + WS_CTL) + CW_E2;
    int* li = (int*)(c.lds + c.wave * 1024); float* la = (float*)(li + 128);
    const int xcc = (int)xcc_id(), sub = c.lane & 7, grp = c.lane >> 3;
    const bool b5 = c.lane & 32, b4 = c.lane & 16, b3 = c.lane & 8;
    constexpr int CH = 8;
    int bo = 0, t = 0, tend = 0;
    int iA = 0, iB = 0; float aA = 0.f, aB = 0.f;
    unsigned tq = 0; if (c.lane == 0) tq = __hip_atomic_fetch_add(cnt + 64 * (xcc & 7), (unsigned)CH, __ATOMIC_RELAXED, __HIP_MEMORY_SCOPE_AGENT);
    for (;;) {
        if (t >= tend) {
            const unsigned t0 = (unsigned)__builtin_amdgcn_readfirstlane((int)tq);
            if (t0 >= (unsigned)ML) { if (++bo >= 8) break; tq = 0; if (c.lane == 0) tq = __hip_atomic_fetch_add(cnt + 64 * ((xcc + bo) & 7), (unsigned)CH, __ATOMIC_RELAXED, __HIP_MEMORY_SCOPE_AGENT); continue; }
            tq = 0; if (c.lane == 0) tq = __hip_atomic_fetch_add(cnt + 64 * ((xcc + bo) & 7), (unsigned)CH, __ATOMIC_RELAXED, __HIP_MEMORY_SCOPE_AGENT);
            t = (int)t0; tend = t + CH;
            iA = IDX[(size_t)t * 128 + c.lane]; iB = IDX[(size_t)t * 128 + 64 + c.lane]; aA = ACT[(size_t)t * 128 + c.lane]; aB = ACT[(size_t)t * 128 + 64 + c.lane];
        }
        const int x = (xcc + bo) & 7;
        li[c.lane] = iA; li[64 + c.lane] = iB; la[c.lane] = aA; la[64 + c.lane] = aB;
        if (t + 1 < tend) { iA = IDX[(size_t)(t + 1) * 128 + c.lane]; iB = IDX[(size_t)(t + 1) * 128 + 64 + c.lane]; aA = ACT[(size_t)(t + 1) * 128 + c.lane]; aB = ACT[(size_t)(t + 1) * 128 + 64 + c.lane]; }
        WAVE_LDS_SYNC();
        float acc[16];
#pragma unroll
        for (int q = 0; q < 16; ++q) acc[q] = 0.f;
#pragma unroll
        for (int hf = 0; hf < 2; ++hf) { v4u rows[8]; float av[8];
#pragma unroll
            for (int i = 0; i < 8; ++i) { const int k = 8 * (8 * hf + i) + grp; rows[i] = *(const v4u*)(V8 + (size_t)li[k] * D + x * 128 + 16 * sub); av[i] = la[k]; }
#pragma unroll
            for (int i = 0; i < 8; ++i) { float f[16]; fp8x16_to_f32(rows[i], f);
#pragma unroll
                for (int q = 0; q < 16; ++q) acc[q] = fmaf(av[i], f[q], acc[q]); } }
        float q8[8], q4[4], q2[2];
#pragma unroll
        for (int i = 0; i < 8; ++i) { const float keep = b5 ? acc[i + 8] : acc[i], send = b5 ? acc[i] : acc[i + 8]; q8[i] = keep + __shfl_xor(send, 32); }
#pragma unroll
        for (int i = 0; i < 4; ++i) { const float keep = b4 ? q8[i + 4] : q8[i], send = b4 ? q8[i] : q8[i + 4]; q4[i] = keep + __shfl_xor(send, 16); }
#pragma unroll
        for (int i = 0; i < 2; ++i) { const float keep = b3 ? q4[i + 2] : q4[i], send = b3 ? q4[i] : q4[i + 2]; q2[i] = keep + __shfl_xor(send, 8); }
        const int col = x * 128 + 16 * sub + (b5 ? 8 : 0) + (b4 ? 4 : 0) + (b3 ? 2 : 0);
        *(unsigned*)(Y + (size_t)t * D + col) = pk2(q2[0], q2[1]);
        const float ss = wsum(q2[0] * q2[0] + q2[1] * q2[1]);
        SSQP[(size_t)x * ML + t] = ss;
        WAVE_LDS_SYNC();
        ++t;
    }
}
__device__ __forceinline__ void phase_exp3(const Ctx& c) {
    const Args& a = *c.a;
    const float* MOD = (const float*)(c.ws + WS_MOD); const bf16* Y = (const bf16*)(c.ws + WS_Y); const float* SSQP = (const float*)(c.ws + WS_SSQP);
    v2u ny[4]; f32x4 nx[4]; float nss = 0.f;
#define E3_LOAD(R) do { _Pragma("unroll") for (int j = 0; j < 4; ++j) { const int col = 4 * c.lane + 256 * j; ny[j] = *(const v2u*)(Y + (size_t)(R) * D + col); nx[j] = *(const f32x4*)(a.out + (size_t)(R) * D + col); } \
        nss = (c.lane < 8) ? SSQP[(size_t)c.lane * ML + (R)] : 0.f; } while (0)
    if (c.gw < ML) E3_LOAD(c.gw);
    for (int row = c.gw; row < ML; row += c.NGW) {
        f32x4 y[4], x1[4];
#pragma unroll
        for (int j = 0; j < 4; ++j) { y[j] = (f32x4){bflo(ny[j].x), bfhi(ny[j].x), bflo(ny[j].y), bfhi(ny[j].y)}; x1[j] = nx[j]; }
        const float ss = row_sum16(nss);
        const float tot = __builtin_bit_cast(float, __builtin_amdgcn_readlane(__builtin_bit_cast(int, ss), 0));
        if (row + c.NGW < ML) E3_LOAD(row + c.NGW);
        const float r = rsqrtf(tot * (1.f / D) + EPS); const float* mr = MOD + (row >> 11) * 6144 + 5120;
#pragma unroll
        for (int j = 0; j < 4; ++j) { const int col = 4 * c.lane + 256 * j;
            const f32x4 g4 = *(const f32x4*)(a.in[I_GPOSTFFN] + col), gt = *(const f32x4*)(mr + col);
            *(f32x4*)(a.out + (size_t)row * D + col) = x1[j] + gt * ((y[j] * r) * g4); }
    }
#undef E3_LOAD
}

constexpr int S5_LPOW = 0, S5_BBAR = 33792, S5_CC = 50176, S5_MM = 66560;
__device__ __forceinline__ void s5_build_group(const Ctx& c, int g, int part) {
    const Args& a = *c.a;
    f32x2* LPOW = (f32x2*)(c.lds + S5_LPOW);
    f32x2* BBAR = (f32x2*)(c.lds + S5_BBAR);
    f32x2* CC = (f32x2*)(c.lds + S5_CC);
    float* MM = (float*)(c.lds + S5_MM);
    __syncthreads();
    if (c.tid < 128) { const int dir = c.tid >> 6, p = c.tid & 63, dg = dir * 32 + g;
        const float dt = expf(a.in[I_LOGDT][dg]), lr = a.in[I_LAMRE][dg * 64 + p], li = a.in[I_LAMIM][dg * 64 + p];
        const double ang = (double)li * (double)dt; const float lrdt = lr * dt;
        for (int e = 0; e <= 32; ++e) { float sn, cs; sincos_d(ang * (double)e, sn, cs); const float mg = expf(lrdt * (float)e); LPOW[(dir * 33 + e) * 64 + p] = (f32x2){mg * cs, mg * sn}; }
        float sn, cs; sincos_d(ang, sn, cs); const float mag = expf(lrdt), lbr = mag * cs, lbi = mag * sn, den = lr * lr + li * li, nr = lbr - 1.f;
        const float cr = (nr * lr + lbi * li) / den, ci = (lbi * lr - nr * li) / den;
        for (int ch = 0; ch < 16; ++ch) { const float br = a.in[I_BRE][(size_t)(dg * 64 + p) * 16 + ch], bi = a.in[I_BIM][(size_t)(dg * 64 + p) * 16 + ch]; BBAR[(dir * 64 + p) * 16 + ch] = (f32x2){cr * br - ci * bi, cr * bi + ci * br}; } }
    for (int i = c.tid; i < 2048; i += NTHREADS) { const int dir = i >> 10, ch = (i >> 6) & 15, p = i & 63, dg = dir * 32 + g; CC[i] = (f32x2){a.in[I_CRE][(size_t)(dg * 16 + ch) * 64 + p], a.in[I_CIM][(size_t)(dg * 16 + ch) * 64 + p]}; }
    __syncthreads();
    for (int task = c.tid; task < 1024; task += NTHREADS) { const int cpb = task & 3, cb = (task >> 2) & 3, lag = (task >> 4) & 31, dir = task >> 9;
        float acc[4][4];
#pragma unroll
        for (int i = 0; i < 4; ++i)
#pragma unroll
            for (int j = 0; j < 4; ++j) acc[i][j] = 0.f;
        for (int p = 0; p < 64; ++p) { const f32x2 l = LPOW[(dir * 33 + lag) * 64 + p]; f32x2 G[4], Cw[4];
#pragma unroll
            for (int j = 0; j < 4; ++j) { const f32x2 bb = BBAR[(dir * 64 + p) * 16 + 4 * cpb + j]; G[j] = (f32x2){l.x * bb.x - l.y * bb.y, l.x * bb.y + l.y * bb.x}; }
#pragma unroll
            for (int i = 0; i < 4; ++i) Cw[i] = CC[(dir * 16 + 4 * cb + i) * 64 + p];
#pragma unroll
            for (int i = 0; i < 4; ++i)
#pragma unroll
                for (int j = 0; j < 4; ++j) acc[i][j] += Cw[i].x * G[j].x - Cw[i].y * G[j].y; }
#pragma unroll
        for (int i = 0; i < 4; ++i)
#pragma unroll
            for (int j = 0; j < 4; ++j) MM[((dir * 32 + lag) * 16 + 4 * cb + i) * 16 + 4 * cpb + j] = acc[i][j]; }
    __syncthreads();
    if (c.tid < 128 && part == 0) { const int dir = c.tid >> 6, p = c.tid & 63; ((f32x2*)(c.ws + WS_LP))[(dir * 32 + g) * 64 + p] = LPOW[(dir * 33 + 32) * 64 + p]; }
    bf16* PMg = (bf16*)(c.ws + WS_PM) + (size_t)g * 256 * 512; bf16* BBg = (bf16*)(c.ws + WS_BB) + (size_t)g * 512 * 768;
    for (int task = part * 64 * 32 + c.tid; task < (part + 1) * 64 * 32; task += NTHREADS) { const int ip = task & 31, n = task >> 5, dir = n >> 7, im = (n >> 6) & 1, p = n & 63, e = dir ? ip : 31 - ip;
        const f32x2 l = LPOW[(dir * 33 + e) * 64 + p]; float o[16];
#pragma unroll
        for (int ch = 0; ch < 16; ++ch) { const f32x2 bb = BBAR[(dir * 64 + p) * 16 + ch]; o[ch] = im ? (l.x * bb.y + l.y * bb.x) : (l.x * bb.x - l.y * bb.y); }
        v4u w0, w1; w0.x = pk2(o[0], o[1]); w0.y = pk2(o[2], o[3]); w0.z = pk2(o[4], o[5]); w0.w = pk2(o[6], o[7]); w1.x = pk2(o[8], o[9]); w1.y = pk2(o[10], o[11]); w1.z = pk2(o[12], o[13]); w1.w = pk2(o[14], o[15]);
        *(v4u*)(PMg + (size_t)n * 512 + ip * 16) = w0; *(v4u*)(PMg + (size_t)n * 512 + ip * 16 + 8) = w1; }
    for (int task = part * 128 * 32 + c.tid; task < (part + 1) * 128 * 32; task += NTHREADS) { const int ip = task & 31, n = task >> 5, i = n >> 4, ch = n & 15; float o[16];
#pragma unroll
        for (int q = 0; q < 16; ++q) o[q] = 0.f;
        if (ip <= i) { const float* m0 = MM + ((0 * 32 + (i - ip)) * 16 + ch) * 16;
#pragma unroll
            for (int q = 0; q < 16; ++q) o[q] += m0[q]; }
        if (ip >= i) { const float* m1 = MM + ((1 * 32 + (ip - i)) * 16 + ch) * 16;
#pragma unroll
            for (int q = 0; q < 16; ++q) o[q] += m1[q]; }
        if (ip == i) { const float dsk = a.in[I_S5D][g * 16 + ch];
#pragma unroll
            for (int q = 0; q < 16; ++q) o[q] += (q == ch) ? dsk : 0.f; }
        v4u w0, w1; w0.x = pk2(o[0], o[1]); w0.y = pk2(o[2], o[3]); w0.z = pk2(o[4], o[5]); w0.w = pk2(o[6], o[7]); w1.x = pk2(o[8], o[9]); w1.y = pk2(o[10], o[11]); w1.z = pk2(o[12], o[13]); w1.w = pk2(o[14], o[15]);
        *(v4u*)(BBg + (size_t)n * 768 + ip * 16) = w0; *(v4u*)(BBg + (size_t)n * 768 + ip * 16 + 8) = w1; }
    for (int task = part * 128 * 32 + c.tid; task < (part + 1) * 128 * 32; task += NTHREADS) { const int p8 = task & 7, part = (task >> 3) & 3, n = task >> 5, i = n >> 4, ch = n & 15, dir = part >> 1, im = part & 1, e = dir ? 32 - i : i + 1; float o[8];
#pragma unroll
        for (int q = 0; q < 8; ++q) { const int p = p8 * 8 + q; const f32x2 l = LPOW[(dir * 33 + e) * 64 + p], cc = CC[(dir * 16 + ch) * 64 + p]; o[q] = im ? -(cc.x * l.y + cc.y * l.x) : (cc.x * l.x - cc.y * l.y); }
        v4u w0; w0.x = pk2(o[0], o[1]); w0.y = pk2(o[2], o[3]); w0.z = pk2(o[4], o[5]); w0.w = pk2(o[6], o[7]);
        *(v4u*)(BBg + (size_t)n * 768 + 512 + part * 64 + p8 * 8) = w0; }
}
__device__ __forceinline__ void s5_state_scan(const Ctx& c, int task) {
    const int dir = task & 1, g = (task >> 1) & 31, b = task >> 6, p = c.lane;
    const f32x2 a = ((const f32x2*)(c.ws + WS_LP))[(dir * 32 + g) * 64 + p];
    const float* SS = (const float*)(c.ws + WS_SS) + (size_t)g * 768 * 256 + dir * 128 + p; bf16* U5 = (bf16*)(c.ws + WS_U5) + (size_t)g * 768 * 768 + 512 + dir * 128 + p;
    float er = 0.f, ei = 0.f;
#pragma unroll 24
    for (int step = 0; step < 72; ++step) {
        const int R = (step < 8) ? 512 + b * 8 + (dir ? 7 - step : step) : b * 64 + (dir ? 71 - step : step - 8);
        if (step >= 8) { U5[(size_t)R * 768] = (bf16)f2bf(er); U5[(size_t)R * 768 + 64] = (bf16)f2bf(ei); }
        const float sr = SS[(size_t)R * 256], si = SS[(size_t)R * 256 + 64];
        const float nr = sr + a.x * er - a.y * ei, ni = si + a.x * ei + a.y * er; er = nr; ei = ni;
    }
}

constexpr int GDN_NCH = 36, GDN_ITEMS = NB * 4 * 2 * GDN_NCH;
constexpr size_t FR_T_BYTES = 8192, FR_ATT_BYTES = 8192, FR_KD_BYTES = 16384, FR_TAB_BYTES = 1024;
__device__ __forceinline__ int crow16(int i, int hh) { return (i & 3) + 8 * (i >> 2) + 4 * hh; }
__device__ __forceinline__ bf16x8 pack_step(const f32x16& x, int s) {
    v4u w; w.x = pk2(x[8 * s + 0], x[8 * s + 1]); w.y = pk2(x[8 * s + 2], x[8 * s + 3]); w.z = pk2(x[8 * s + 4], x[8 * s + 5]); w.w = pk2(x[8 * s + 6], x[8 * s + 7]);
    return __builtin_bit_cast(bf16x8, w);
}
__device__ __forceinline__ unsigned pk2v(float lo, float hi) { asm volatile("" : "+v"(lo), "+v"(hi)); return pk2(lo, hi); }
__device__ __forceinline__ bf16x8 pack_step_v(const f32x16& x, int s) {
    v4u w; w.x = pk2v(x[8 * s + 0], x[8 * s + 1]); w.y = pk2v(x[8 * s + 2], x[8 * s + 3]); w.z = pk2v(x[8 * s + 4], x[8 * s + 5]); w.w = pk2v(x[8 * s + 6], x[8 * s + 7]);
    return __builtin_bit_cast(bf16x8, w);
}
constexpr int GP_KR = 0, GP_QR = 17408, GP_KT = 34816, GP_TAB = 53248, GP_LP = 54272, GP_LPB = 8448 + 256;
__host__ __device__ constexpr int LOFF(int i) { return i < 1 ? 0 : 4 * (((i - 1) >> 2) + 1) * (2 * ((i - 1) >> 2) + ((i - 1) & 3)); }
static_assert(LOFF(1) == 0 && LOFF(2) == 4 && LOFF(5) == 16 && LOFF(6) == 24 && LOFF(64) == 2112, "packed lower-triangular row offsets");
__device__ __forceinline__ void gdn_prep_stage(const Ctx& c, int item, float* Lp) {
    const int n = item % GDN_NCH, bhd = item / GDN_NCH, dir = bhd & 1, h = (bhd >> 1) & 3, b = bhd >> 3;
    const bf16* QKV = (const bf16*)(c.ws + WS_QKV); const float* GB = (const float*)(c.ws + WS_GB);
    bf16* Kr = (bf16*)(c.lds + GP_KR); bf16* Qr = (bf16*)(c.lds + GP_QR); bf16* Kt = (bf16*)(c.lds + GP_KT); float* tab = (float*)(c.lds + GP_TAB);
    unsigned char* frA = c.ws + WS_FRA + (size_t)item * FR_ATT_BYTES; unsigned char* frK = c.ws + WS_FRK + (size_t)item * FR_KD_BYTES; float* frTab = (float*)(c.ws + WS_FRTAB + (size_t)item * FR_TAB_BYTES);
    const int r = c.lane & 31, hh = c.lane >> 5;
    if (c.wave == 0) { const int row = scan_row(b, dir, n * 64 + c.lane); float g = GB[(size_t)row * 16 + dir * 4 + h]; const float beta = GB[(size_t)row * 16 + 8 + dir * 4 + h];
#pragma unroll
        for (int o = 1; o < 64; o <<= 1) { const float t = __shfl_up(g, o); if (c.lane >= o) g += t; }
        const float gl = __shfl(g, 63);
        tab[c.lane] = g; tab[64 + c.lane] = beta; tab[128 + c.lane] = __expf(g); tab[192 + c.lane] = __expf(gl - g); }
    { const int s = c.tid >> 3, seg = c.tid & 7; const int row = scan_row(b, dir, n * 64 + s); const bf16* rp = QKV + (size_t)row * 1536 + h * 128 + seg * 16;
      const v4u q0 = *(const v4u*)rp, q1 = *(const v4u*)(rp + 8), k0 = *(const v4u*)(rp + 512), k1 = *(const v4u*)(rp + 520);
      *(v4u*)(Qr + s * 136 + seg * 16) = q0; *(v4u*)(Qr + s * 136 + seg * 16 + 8) = q1; *(v4u*)(Kr + s * 136 + seg * 16) = k0; *(v4u*)(Kr + s * 136 + seg * 16 + 8) = k1;
      const unsigned kw[8] = {k0.x, k0.y, k0.z, k0.w, k1.x, k1.y, k1.z, k1.w};
#pragma unroll
      for (int e = 0; e < 8; ++e) { Kt[(seg * 16 + 2 * e) * 72 + s] = (bf16)(kw[e] & 0xffffu); Kt[(seg * 16 + 2 * e + 1) * 72 + s] = (bf16)(kw[e] >> 16); } }
    __syncthreads();
    if (c.wave < 3) { const int ct = c.wave ? 1 : 0, st = c.wave == 2 ? 1 : 0;
        f32x16 acc;
#pragma unroll
        for (int i = 0; i < 16; ++i) acc[i] = 0.f;
#pragma unroll
        for (int kk = 0; kk < 8; ++kk) { const bf16x8 a = *(const bf16x8*)(Kr + (ct * 32 + r) * 136 + kk * 16 + hh * 8), bb = *(const bf16x8*)(Kr + (st * 32 + r) * 136 + kk * 16 + hh * 8); acc = MFMA32(a, bb, acc); }
        const int s = st * 32 + r; const float gcs = tab[s];
#pragma unroll
        for (int i = 0; i < 16; ++i) { const int cc = ct * 32 + crow16(i, hh); if (s < cc) Lp[LOFF(cc) + s] = tab[64 + cc] * acc[i] * __expf(tab[cc] - gcs); }
    } else if (c.wave < 6) { const int w = c.wave - 3, st = w == 2 ? 1 : 0, ct = w ? 1 : 0;
        f32x16 acc;
#pragma unroll
        for (int i = 0; i < 16; ++i) acc[i] = 0.f;
#pragma unroll
        for (int kk = 0; kk < 8; ++kk) { const bf16x8 a = *(const bf16x8*)(Kr + (st * 32 + r) * 136 + kk * 16 + hh * 8), bb = *(const bf16x8*)(Qr + (ct * 32 + r) * 136 + kk * 16 + hh * 8); acc = MFMA32(a, bb, acc); }
        const int cc = ct * 32 + r; const float gcc = tab[cc];
#pragma unroll
        for (int i = 0; i < 16; ++i) { const int s = st * 32 + crow16(i, hh); acc[i] = (s <= cc) ? acc[i] * __expf(gcc - tab[s]) : 0.f; }
        *(bf16x8*)(frA + ((size_t)((ct * 4 + 2 * st) * 64 + c.lane)) * 16) = pack_step(acc, 0);
        *(bf16x8*)(frA + ((size_t)((ct * 4 + 2 * st + 1) * 64 + c.lane)) * 16) = pack_step(acc, 1);
    } else { const int w = c.wave - 6;
#pragma unroll
        for (int f = 0; f < 8; ++f) { const int fi = w * 8 + f, dkt = fi >> 2, cb = fi & 3; const bf16* kp = Kt + (dkt * 32 + r) * 72 + 16 * cb + 4 * hh;
            const v2u lo = *(const v2u*)kp, hi = *(const v2u*)(kp + 8); const f32x4 e0 = *(const f32x4*)(tab + 192 + 16 * cb + 4 * hh), e1 = *(const f32x4*)(tab + 192 + 16 * cb + 8 + 4 * hh);
            v4u o; o.x = pk2(bflo(lo.x) * e0.x, bfhi(lo.x) * e0.y); o.y = pk2(bflo(lo.y) * e0.z, bfhi(lo.y) * e0.w); o.z = pk2(bflo(hi.x) * e1.x, bfhi(hi.x) * e1.y); o.w = pk2(bflo(hi.y) * e1.z, bfhi(hi.y) * e1.w);
            *(v4u*)(frK + ((size_t)(fi * 64 + c.lane)) * 16) = o; }
        if (w == 0) { const v4u z = (v4u){0u, 0u, 0u, 0u}; *(v4u*)(frA + ((size_t)((0 * 4 + 2) * 64 + c.lane)) * 16) = z; *(v4u*)(frA + ((size_t)((0 * 4 + 3) * 64 + c.lane)) * 16) = z; }
        else { *(f32x4*)(frTab + 4 * c.lane) = *(const f32x4*)(tab + 4 * c.lane); }
    }
    __syncthreads();
}
__device__ __forceinline__ void gdn_prep_solve(const Ctx& c, int item, float* Lp) {
    float Tr[64];
#pragma unroll
    for (int i = 0; i < 64; ++i) { int le_ = c.lane; asm volatile("" : "+v"(le_)); float a0 = (le_ == i) ? 1.f : 0.f, a1 = 0.f;
#pragma unroll
        for (int s4 = 0; s4 < (i + 3) / 4; ++s4) { const f32x4 l4 = *(const f32x4*)(Lp + LOFF(i) + 4 * s4);
            if (4 * s4 + 0 < i) a0 = fmaf(-l4.x, Tr[4 * s4 + 0], a0); if (4 * s4 + 1 < i) a1 = fmaf(-l4.y, Tr[4 * s4 + 1], a1); if (4 * s4 + 2 < i) a0 = fmaf(-l4.z, Tr[4 * s4 + 2], a0); if (4 * s4 + 3 < i) a1 = fmaf(-l4.w, Tr[4 * s4 + 3], a1); }
        Tr[i] = a0 + a1; { int lo_ = c.lane; asm volatile("" : "+v"(lo_)); Lp[(lo_ < i) ? LOFF(i) + lo_ : 2112 + lo_] = Tr[i]; } }
    WAVE_LDS_SYNC();
    unsigned char* frT = c.ws + WS_FRT + (size_t)item * FR_T_BYTES;
    const int r = c.lane & 31, hh = c.lane >> 5;
#pragma unroll
    for (int f = 0; f < 8; ++f) { const int ct = f >> 2, sb = f & 3, cc = ct * 32 + r; float v[8];
#pragma unroll
        for (int q = 0; q < 2; ++q) { const int s0 = 16 * sb + 8 * q + 4 * hh;
            f32x4 t4 = (f32x4){0.f, 0.f, 0.f, 0.f}; if (s0 < cc) t4 = *(const f32x4*)(Lp + LOFF(cc) + s0);
            v[4 * q + 0] = (s0 + 0 < cc) ? t4.x : (s0 + 0 == cc ? 1.f : 0.f); v[4 * q + 1] = (s0 + 1 < cc) ? t4.y : (s0 + 1 == cc ? 1.f : 0.f);
            v[4 * q + 2] = (s0 + 2 < cc) ? t4.z : (s0 + 2 == cc ? 1.f : 0.f); v[4 * q + 3] = (s0 + 3 < cc) ? t4.w : (s0 + 3 == cc ? 1.f : 0.f); }
        *(v4u*)(frT + ((size_t)(f * 64 + c.lane)) * 16) = (v4u){pk2(v[0], v[1]), pk2(v[2], v[3]), pk2(v[4], v[5]), pk2(v[6], v[7])}; }
}
__device__ __forceinline__ void phase_gdn_prep(const Ctx& c) {
    for (int base = c.bid; base < GDN_ITEMS; base += 8 * c.G) {
        int cnt = 0;
#pragma unroll 1
        for (int q = 0; q < 8; ++q) { const int item = base + q * c.G; if (item < GDN_ITEMS) { gdn_prep_stage(c, item, (float*)(c.lds + GP_LP + q * GP_LPB)); cnt = q + 1; } }
        if (c.wave < cnt) gdn_prep_solve(c, base + c.wave * c.G, (float*)(c.lds + GP_LP + c.wave * GP_LPB));
        __syncthreads();
    }
}

constexpr int GR_K = 0, GR_Q = 16384, GR_T = 32768, GR_A = 40960, GR_KD = 49152, GR_TAB = 65536, GR_BUF = 66560;
__device__ __forceinline__ void gdn_rec_stage(const Ctx& c, int bhd, int n, int buf) {
    const int dir = bhd & 1, h = (bhd >> 1) & 3, b = bhd >> 3, lw = c.wave - 4; const int item = bhd * GDN_NCH + n;
    LAS unsigned char* base = (LAS unsigned char*)c.lds + buf * GR_BUF;
    const unsigned char* QKVb = c.ws + WS_QKV;
#pragma unroll
    for (int q = 0; q < 4; ++q) { const int qi = lw + 4 * q;
        const int s = 4 * qi + (c.lane >> 4), ps = c.lane & 15, p = ps ^ (s & 15); const size_t rowb = (size_t)scan_row(b, dir, n * 64 + s) * 3072 + (size_t)h * 256 + p * 16;
        __builtin_amdgcn_global_load_lds((const unsigned*)(QKVb + rowb + 1024), (LAS unsigned*)(base + GR_K + qi * 1024), 16, 0, 0);
        __builtin_amdgcn_global_load_lds((const unsigned*)(QKVb + rowb), (LAS unsigned*)(base + GR_Q + qi * 1024), 16, 0, 0); }
    const unsigned char* frT = c.ws + WS_FRT + (size_t)item * FR_T_BYTES; const unsigned char* frA = c.ws + WS_FRA + (size_t)item * FR_ATT_BYTES; const unsigned char* frK = c.ws + WS_FRK + (size_t)item * FR_KD_BYTES;
#pragma unroll
    for (int q = 0; q < 2; ++q) { const int qi = lw + 4 * q;
        __builtin_amdgcn_global_load_lds((const unsigned*)(frT + qi * 1024 + c.lane * 16), (LAS unsigned*)(base + GR_T + qi * 1024), 16, 0, 0);
        __builtin_amdgcn_global_load_lds((const unsigned*)(frA + qi * 1024 + c.lane * 16), (LAS unsigned*)(base + GR_A + qi * 1024), 16, 0, 0); }
#pragma unroll
    for (int q = 0; q < 4; ++q) { const int qi = lw + 4 * q;
        __builtin_amdgcn_global_load_lds((const unsigned*)(frK + qi * 1024 + c.lane * 16), (LAS unsigned*)(base + GR_KD + qi * 1024), 16, 0, 0); }
    if (lw == 0) __builtin_amdgcn_global_load_lds((const unsigned*)(c.ws + WS_FRTAB + (size_t)item * FR_TAB_BYTES + c.lane * 16), (LAS unsigned*)(base + GR_TAB), 16, 0, 0);
}
__device__ __forceinline__ bf16x8 gr_rowfrag(const unsigned char* rowp, const int (&po)[16], int kb) {
    const v2u lo = *(const v2u*)(rowp + po[2 * kb]), hi = *(const v2u*)(rowp + po[2 * kb + 1]);
    return __builtin_bit_cast(bf16x8, (v4u){lo.x, lo.y, hi.x, hi.y});
}
__device__ __forceinline__ void gdn_rec_block(const Ctx& c, int bhd, int dvhalf) {
    const int dir = bhd & 1, h = (bhd >> 1) & 3, b = bhd >> 3, r = c.lane & 31, hh = c.lane >> 5, dvt = 2 * dvhalf + (c.wave & 1);
    const bf16* QKV = (const bf16*)(c.ws + WS_QKV); bf16* OG = (bf16*)(c.ws + WS_OG) + (size_t)dir * ML * 512;
    f32x16 S[4];
#pragma unroll
    for (int t = 0; t < 4; ++t)
#pragma unroll
        for (int i = 0; i < 16; ++i) S[t][i] = 0.f;
    int po[16];
#pragma unroll
    for (int p = 0; p < 16; ++p) po[p] = r * 256 + ((p ^ (r & 15)) * 16) + 8 * hh;
    if (c.wave >= 4) gdn_rec_stage(c, bhd, 0, 0);
    asm volatile("s_waitcnt vmcnt(0)" ::: "memory"); __syncthreads();
    for (int n = 0; n < GDN_NCH; ++n) {
        const int buf = n & 1;
        if (c.wave >= 4) { if (n + 1 < GDN_NCH) gdn_rec_stage(c, bhd, n + 1, buf ^ 1); }
        else if (c.wave < 2) {
            const unsigned char* base = c.lds + buf * GR_BUF; const float* tab = (const float*)(base + GR_TAB);
            const int row0 = scan_row(b, dir, n * 64), sgn = dir ? -1 : 1;
            const bf16* vcol = QKV + (size_t)row0 * 1536 + 1024 + h * 128 + dvt * 32 + r + (ptrdiff_t)(sgn * 4 * hh) * 1536;
            bf16* ocol = OG + (size_t)row0 * 512 + h * 128 + dvt * 32 + r + (ptrdiff_t)(sgn * 4 * hh) * 512;
            const ptrdiff_t vst = (ptrdiff_t)sgn * 1536, ost = (ptrdiff_t)sgn * 512;
            bf16 vraw[2][16];
#pragma unroll
            for (int st = 0; st < 2; ++st)
#pragma unroll
                for (int i = 0; i < 16; ++i) vraw[st][i] = vcol[vst * (st * 32 + (i & 3) + 8 * (i >> 2))];
            bf16x8 Rf[2][2];
#pragma unroll
            for (int st = 0; st < 2; ++st) { f32x16 acc;
#pragma unroll
                for (int i = 0; i < 16; ++i) acc[i] = 0.f;
#pragma unroll
                for (int kb = 0; kb < 8; ++kb) acc = MFMA32(gr_rowfrag(base + GR_K + st * 8192, po, kb), pack_step_v(S[kb >> 1], kb & 1), acc);
#pragma unroll
                for (int i = 0; i < 16; ++i) { const int s = st * 32 + crow16(i, hh); acc[i] = tab[64 + s] * (bf1(vraw[st][i]) - tab[128 + s] * acc[i]); }
                Rf[st][0] = pack_step(acc, 0); Rf[st][1] = pack_step(acc, 1); asm volatile("" ::: "memory"); }
            bf16x8 Vf[2][2];
#pragma unroll
            for (int ct = 0; ct < 2; ++ct) { f32x16 acc;
#pragma unroll
                for (int i = 0; i < 16; ++i) acc[i] = 0.f;
#pragma unroll
                for (int sb = 0; sb < 4; ++sb) if (sb < 2 * ct + 2) acc = MFMA32(*(const bf16x8*)(base + GR_T + ((ct * 4 + sb) * 64 + c.lane) * 16), Rf[sb >> 1][sb & 1], acc);
                Vf[ct][0] = pack_step(acc, 0); Vf[ct][1] = pack_step(acc, 1); }
            asm volatile("" ::: "memory");
#pragma unroll
            for (int ct = 0; ct < 2; ++ct) { f32x16 acc;
#pragma unroll
                for (int i = 0; i < 16; ++i) acc[i] = 0.f;
#pragma unroll
                for (int kb = 0; kb < 8; ++kb) acc = MFMA32(gr_rowfrag(base + GR_Q + ct * 8192, po, kb), pack_step_v(S[kb >> 1], kb & 1), acc);
#pragma unroll
                for (int i = 0; i < 16; ++i) acc[i] *= tab[128 + ct * 32 + crow16(i, hh)];
#pragma unroll
                for (int cb = 0; cb < 4; ++cb) if (cb < 2 * ct + 2) acc = MFMA32(*(const bf16x8*)(base + GR_A + ((ct * 4 + cb) * 64 + c.lane) * 16), Vf[cb >> 1][cb & 1], acc);
                if (n >= 4) {
#pragma unroll
                    for (int i = 0; i < 16; ++i) ocol[ost * (ct * 32 + (i & 3) + 8 * (i >> 2))] = (bf16)f2bf(acc[i]); }
                asm volatile("" ::: "memory"); }
            const float gtot = tab[128 + 63];
#pragma unroll
            for (int t = 0; t < 4; ++t) {
#pragma unroll
                for (int i = 0; i < 16; ++i) S[t][i] *= gtot;
#pragma unroll
                for (int cb = 0; cb < 4; ++cb) S[t] = MFMA32(*(const bf16x8*)(base + GR_KD + ((t * 4 + cb) * 64 + c.lane) * 16), Vf[cb >> 1][cb & 1], S[t]); }
        }
        if (c.wave >= 4) asm volatile("s_waitcnt vmcnt(0)" ::: "memory"); else asm volatile("s_waitcnt lgkmcnt(0)" ::: "memory");
        __builtin_amdgcn_s_barrier(); asm volatile("" ::: "memory");
    }
    asm volatile("s_waitcnt vmcnt(0)" ::: "memory"); __syncthreads();
}
__device__ __forceinline__ void phase_gdn_rec(const Ctx& c) { if (c.bid < 128) gdn_rec_block(c, c.bid >> 1, c.bid & 1); }

#define XB_TMO      128
#define XB_XCNT(j)  (256  + 64 * (j))
#define XB_XSUB(j)  (1280 + 64 * (j))
#define XB_XGEN(j)  (2304 + 64 * (j))
#define XB_TOP      3328
#define XB_TOPGEN   3392
#define XCD_BAR_WORDS 3456
#define XB_SPIN_CAP (1u << 20)
__device__ __forceinline__ unsigned xb_ld(unsigned* p)              { return __hip_atomic_load(p, __ATOMIC_RELAXED, __HIP_MEMORY_SCOPE_AGENT); }
__device__ __forceinline__ unsigned xb_add(unsigned* p, unsigned v) { return __hip_atomic_fetch_add(p, v, __ATOMIC_RELAXED, __HIP_MEMORY_SCOPE_AGENT); }
__device__ __forceinline__ unsigned xb_xcc_id() { return (unsigned)__builtin_amdgcn_s_getreg((3 << 11) | 20) & 0xFu; }
#define XB_SPIN(cond, bar) do { unsigned _sp = 0; while (cond) { __builtin_amdgcn_s_sleep(1); \
    if ((++_sp & 255u) == 0u) { if (xb_ld(&(bar)[XB_TMO])) break; if (_sp > XB_SPIN_CAP) { atomicAdd(&(bar)[XB_TMO], 1u); break; } } } } while (0)
struct XcdBarrier { unsigned* bar; unsigned x; volatile LAS unsigned* st; };
__device__ __forceinline__ XcdBarrier xcd_barrier_post(unsigned* bar, volatile LAS unsigned* st) {
    XcdBarrier b; b.bar = bar; b.x = xb_xcc_id(); b.st = st;
    if (threadIdx.x == 0) (void)xb_add(&bar[XB_XCNT(b.x)], 1u);
    return b;
}
__device__ __forceinline__ void xcd_barrier_complete(unsigned* bar, unsigned x, unsigned& nloc, unsigned& nx) {
    const unsigned G = gridDim.x * gridDim.y * gridDim.z;
    unsigned sum, cnt, mine, sp = 0u;
    for (;;) {
        sum = 0u; cnt = 0u; mine = 0u;
#pragma unroll
        for (unsigned j = 0; j < 16; ++j) { const unsigned c = xb_ld(&bar[XB_XCNT(j)]); sum += c; cnt += (c > 0u) ? 1u : 0u; mine = (j == x) ? c : mine; }
        if (sum == G) break;
        __builtin_amdgcn_s_sleep(1);
        if ((++sp & 255u) == 0u) { if (xb_ld(&bar[XB_TMO])) break; if (sp > XB_SPIN_CAP) { atomicAdd(&bar[XB_TMO], 1u); break; } }
    }
    nloc = mine > 0u ? mine : 1u; nx = cnt > 0u ? cnt : 1u;
}
__device__ __forceinline__ void xcd_barrier(const XcdBarrier& b) {
    asm volatile("s_waitcnt vmcnt(0)" ::: "memory");
    __syncthreads();
    if (threadIdx.x == 0) {
        unsigned* bar = b.bar;
        __builtin_amdgcn_s_waitcnt(0);
        unsigned nloc = b.st[0], nx = b.st[1];
        if (nloc == 0u) { xcd_barrier_complete(bar, b.x, nloc, nx); b.st[0] = nloc; b.st[1] = nx; }
        const unsigned old = xb_add(&bar[XB_XSUB(b.x)], 1u);
        const unsigned gen = old / nloc;
        if (old + 1u == (gen + 1u) * nloc) {
            __builtin_amdgcn_fence(__ATOMIC_RELEASE, "agent");
            asm volatile("s_waitcnt vmcnt(0)" ::: "memory");
            const unsigned og = xb_add(&bar[XB_TOP], 1u);
            const unsigned tg = og / nx;
            if (og + 1u == (tg + 1u) * nx) xb_add(&bar[XB_TOPGEN], 1u);
            else XB_SPIN(xb_ld(&bar[XB_TOPGEN]) == tg, bar);
            __builtin_amdgcn_fence(__ATOMIC_ACQUIRE, "agent");
            xb_add(&bar[XB_XGEN(b.x)], 1u);
            asm volatile("s_waitcnt vmcnt(0)" ::: "memory");
        } else {
            XB_SPIN(xb_ld(&bar[XB_XGEN(b.x)]) == gen, bar);
            __builtin_amdgcn_fence(__ATOMIC_ACQUIRE, "agent");
            asm volatile("s_waitcnt vmcnt(0)" ::: "memory");
        }
    }
    __syncthreads();
}

constexpr int LDS_MISC = LDS_BYTES - 64;
__global__ void __launch_bounds__(NTHREADS, 2) mk_fwd(Args args) {
    extern __shared__ __attribute__((aligned(16))) unsigned char lds[];
    Ctx c; c.a = &args; c.ws = args.ws; c.lds = lds;
    c.tid = threadIdx.x; c.lane = c.tid & 63; c.wave = __builtin_amdgcn_readfirstlane(c.tid >> 6); c.bid = blockIdx.x; c.G = gridDim.x;
    c.gw = c.bid * NWAVES + c.wave; c.NGW = c.G * NWAVES; c.gwv = c.wave * c.G + c.bid;
    const int lo = args.ph_lo, hi = args.ph_hi;
    PG8_LAS unsigned char* ring = (PG8_LAS unsigned char*)lds;
#ifndef MK_PH_MASK
#define MK_PH_MASK 0xffff
#endif
#define IN(k) (((MK_PH_MASK >> (k)) & 1) && lo <= (k) && (k) < hi)
#if MK_ONE_LAUNCH
    cg::grid_group grid = cg::this_grid();
    if (lo < 0) grid.sync();
    volatile LAS unsigned* st = (volatile LAS unsigned*)((LAS unsigned char*)lds + LDS_MISC);
    if (c.tid < 2) st[c.tid] = 0u;
    __syncthreads();
    const XcdBarrier bar = xcd_barrier_post((unsigned*)(c.ws + WS_CTL) + CW_BAR, st);
#define SEAM(k) do { if (IN(k) && IN((k) + 1)) xcd_barrier(bar); } while (0)
#else
#define SEAM(k) do { } while (0)
#endif
    if (IN(0)) { phase_prep(c); phase_s5_build(c); } SEAM(0);
    if (IN(1)) { phase_norm1(c); } SEAM(1);
    if (IN(2)) { pg8::Gemm g{(const pg8::bf16_t*)(c.ws + WS_HX), (const pg8::bf16_t*)(c.ws + WS_WIN), 1024, 1024, 1024}; pg8::StaticOrder S; S.init(MT, NPROJ, c.G, c.bid);
        pg8::EpiInProj E{(pg8::bf16_t*)(c.ws + WS_U5), (pg8::bf16_t*)(c.ws + WS_QKVPRE), (pg8::bf16_t*)(c.ws + WS_Z)};
        pg8::gemm_phase<pg8::EpiInProj, pg8::StaticOrder, true, true>(ring, g, S, E); } SEAM(2);
    if (IN(3)) { { pg8::Gemm g{(const pg8::bf16_t*)(c.ws + WS_U5), (const pg8::bf16_t*)(c.ws + WS_PM), 768, 512, 512}; pg8::SchedSS S{c.G, c.bid}; pg8::EpiSS E{(float*)(c.ws + WS_SS)};
          pg8::gemm_phase<pg8::EpiSS, pg8::SchedSS, true, true>(ring, g, S, E); }
        __syncthreads(); phase_conv(c); } SEAM(3);
    if (IN(4)) { for (int t = c.gwv; t < 512; t += c.NGW) s5_state_scan(c, t); __syncthreads(); phase_gdn_prep(c); } SEAM(4);
    if (IN(5)) { pg8::Gemm g{(const pg8::bf16_t*)(c.ws + WS_U5), (const pg8::bf16_t*)(c.ws + WS_BB), 768, 768, 768}; pg8::SchedS5Y S{c.G, c.bid}; pg8::EpiS5Y E{(pg8::bf16_t*)(c.ws + WS_YG)};
        pg8::gemm_phase<pg8::EpiS5Y, pg8::SchedS5Y, true, true>(ring, g, S, E); } SEAM(5);
    if (IN(6)) { if (c.bid < 128) phase_gdn_rec(c);
        else { pg8::Gemm g{(const pg8::bf16_t*)(c.ws + WS_YG), (const pg8::bf16_t*)(c.ws + WS_WGLU), 512, 512, 512}; pg8::StaticOrder S; S.init(ML, 512, c.G - 128, c.bid - 128);
            pg8::EpiGlu E{(const pg8::bf16_t*)(c.ws + WS_YG), (pg8::bf16_t*)(c.ws + WS_CAT)};
            pg8::gemm_phase<pg8::EpiGlu, pg8::StaticOrder, true, true>(ring, g, S, E); } } SEAM(6);
    if (IN(7)) { phase_combine(c); } SEAM(7);
    if (IN(8)) { pg8::Gemm g{(const pg8::bf16_t*)(c.ws + WS_CAT), (const pg8::bf16_t*)(c.ws + WS_WOUT), 1024, 1024, 1024}; pg8::StaticOrder S; S.init(ML, 1024, c.G, c.bid);
        pg8::EpiBf16<0> E{(pg8::bf16_t*)(c.ws + WS_YRAW), 1024, nullptr, 0, 0, 1.f};
        pg8::gemm_phase<pg8::EpiBf16<0>, pg8::StaticOrder, true, true>(ring, g, S, E); } SEAM(8);
    if (IN(9)) { phase_rows2(c); phase_fp8_tables(c); } SEAM(9);
    if (IN(10)) { pg8::Gemm g{(const pg8::bf16_t*)(c.ws + WS_HX2), (const pg8::bf16_t*)(c.ws + WS_WQ), 1024, 1024, 1024}; pg8::StaticOrder S; S.init(ML, 2048, c.G, c.bid);
        pg8::EpiBf16<0> E{(pg8::bf16_t*)(c.ws + WS_QP), 2048, nullptr, 0, 0, 1.f};
        pg8::gemm_phase<pg8::EpiBf16<0>, pg8::StaticOrder, true, true>(ring, g, S, E); } SEAM(10);
    if (IN(11)) { phase_topk(c); } SEAM(11);
    if (IN(12)) { phase_exp1(c); } SEAM(12);
    if (IN(13)) { phase_exp1b(c); } SEAM(13);
    if (IN(14)) { phase_exp2(c); } SEAM(14);
    if (IN(15)) { phase_exp3(c); }
#undef IN
#undef SEAM
}

extern "C" void kernel_launch(void* const* d_in, const int* in_sizes, int n_in, void* d_out, int out_size, void* d_ws, size_t ws_size, hipStream_t stream) {
    static int grid = 0;
    if (grid == 0) {
        if (n_in != 29 || out_size != ML * D || ws_size < WS_END) { fprintf(stderr, "kernel_launch: unexpected shapes (n_in %d out %d ws %zu)\n", n_in, out_size, ws_size); grid = -1; return; }
        int dev = 0, cus = 0, per_cu = 0;
        (void)hipGetDevice(&dev); (void)hipDeviceGetAttribute(&cus, hipDeviceAttributeMultiprocessorCount, dev);
        if (hipFuncSetAttribute((const void*)mk_fwd, hipFuncAttributeMaxDynamicSharedMemorySize, LDS_BYTES) != hipSuccess) { fprintf(stderr, "kernel_launch: hipFuncSetAttribute failed\n"); grid = -1; return; }
        (void)hipOccupancyMaxActiveBlocksPerMultiprocessor(&per_cu, (const void*)mk_fwd, NTHREADS, LDS_BYTES);
        (void)hipGetLastError();
        grid = cus;
        fprintf(stderr, "kernel_launch: cus %d per_cu %d grid %d\n", cus, per_cu, grid);
    }
    if (grid < 0) return;
    Args a{};
    for (int i = 0; i < 29; ++i) a.in[i] = (const float*)d_in[i];
    a.out = (float*)d_out; a.ws = (unsigned char*)d_ws;
    (void)hipMemsetAsync((char*)d_ws + WS_CTL, 0, CTL_ZERO_BYTES, stream);
#if MK_ONE_LAUNCH
    a.ph_lo = 0; a.ph_hi = NPHASES;
    void* kargs[] = {&a};
    hipError_t e = hipLaunchCooperativeKernel((const void*)mk_fwd, dim3(grid), dim3(NTHREADS), kargs, LDS_BYTES, stream);
    if (e != hipSuccess) fprintf(stderr, "kernel_launch: cooperative launch failed: %s\n", hipGetErrorString(e));
#else
    for (int ph = 0; ph < NPHASES; ++ph) { a.ph_lo = ph; a.ph_hi = ph + 1; hipLaunchKernelGGL(mk_fwd, dim3(grid), dim3(NTHREADS), LDS_BYTES, stream, a); }
#endif
}
```

```cpp
#include <hip/hip_runtime.h>
#include <hip/hip_cooperative_groups.h>
#include <cstdio>
#include <cstdint>
namespace cg = cooperative_groups;
namespace pg8 {
#define PG8_LAS __attribute__((address_space(3)))
typedef unsigned short bf16_t;
typedef short bf16x8 __attribute__((ext_vector_type(8)));
typedef float f32x4 __attribute__((ext_vector_type(4)));
typedef unsigned u32x4 __attribute__((ext_vector_type(4)));
constexpr int BM = 256, BK = 64, HALF = 128, HTB = HALF * BK * 2  , STAGE_BYTES = 8 * HTB, NXCD = 8, WGM = 8;

__host__ __device__ __forceinline__ int lds_byte(int r, int c) { const int st = (r >> 4) * 2 + (c >> 5), rr = r & 15, cc = c & 31, ob = rr * 64 + cc * 2; return st * 1024 + (ob ^ (((ob >> 9) & 1) << 5)); }
__host__ __device__ __forceinline__ void stage_rc(int b, int& R, int& C) { const int st = b / 1024, sb = b % 1024, swz = sb ^ (((sb >> 9) & 1) << 5); R = (st >> 1) * 16 + swz / 64; C = (st & 1) * 32 + (swz % 64) / 2; }
__host__ __device__ __forceinline__ int perm32(int rho) { const int n = rho >> 4, i = rho & 15; return 8 * (i >> 2) + 4 * n + (i & 3); }

struct Unit { int pm, pn; };
struct Gemm { const bf16_t* A; const bf16_t* Bt; int lda, ldb, K; };

struct StaticOrder {
    int nM, nN, nwg, G, c;
    __host__ __device__ void init(int M, int N, int G_, int c_) { nM = M / BM; nN = N / BM; nwg = nM * nN; G = G_; c = c_; }
    __host__ __device__ bool next(int i, Unit& u) const {
        const long L = (long)i * G + c; if (L >= nwg) return false;
        int wgid = (int)L; { const int q = nwg / NXCD, r = nwg % NXCD, xcd = wgid % NXCD, off = wgid / NXCD; wgid = (xcd < r ? xcd * (q + 1) : r * (q + 1) + (xcd - r) * q) + off; }
        const int nig = WGM * nN, gid = wgid / nig, fm = gid * WGM, gsz = (nM - fm) < WGM ? (nM - fm) : WGM;
        u.pm = fm + ((wgid % nig) % gsz); u.pn = (wgid % nig) / gsz; return true;
    }
    __device__ __forceinline__ void a_ready(const Unit&) const {}
    __device__ __forceinline__ void done(const Unit&) const {}
};

__device__ __forceinline__ unsigned cvt_pk_bf16(float lo, float hi) { unsigned r; asm volatile("v_cvt_pk_bf16_f32 %0, %1, %2" : "=v"(r) : "v"(lo), "v"(hi)); return r; }
typedef float f32x2 __attribute__((ext_vector_type(2)));
__device__ __forceinline__ f32x2 gelu_pk(f32x2 v) {
    const f32x2 av = __builtin_elementwise_abs(v), d = av * 0.2316418882f + 1.0f;
    f32x2 t; t.x = __builtin_amdgcn_rcpf(d.x); t.y = __builtin_amdgcn_rcpf(d.y);
    f32x2 q = t * 0.5307027145f + (-0.7265760135f); q = q * t + 0.7107068705f; q = q * t + (-0.142248368f); q = q * t + 0.127414796f; q = q * t;
    const f32x2 s = (v * v) * (-0.72134752044f);
    f32x2 e; e.x = __builtin_amdgcn_exp2f(s.x); e.y = __builtin_amdgcn_exp2f(s.y);
    const f32x2 m = v * (q * e), r = v - m;
    f32x2 o; o.x = v.x < 0.f ? m.x : r.x; o.y = v.y < 0.f ? m.y : r.y; return o;
}

template <int ACT  > struct EpiBf16 {
    static constexpr bool PERM = true, AFTER_DRAIN = false; static_assert(ACT == 0 || ACT == 1, "EpiBf16: ACT is 0 (none) or 1 (gelu_pk)");
    bf16_t* O; int ldc; const float* bias; int split_cols; size_t split_stride; float scale0;
    __device__ __forceinline__ void operator()(const f32x4 (&acc)[2][2][4][2], const Unit& u, int wr, int wc, int fr, int fq) const {
        const int row0 = u.pm * BM + wr * 64 + fr; int colt = u.pn * BM; bf16_t* base = O;
        float sc = 1.f; if (split_cols) { const int t = colt / split_cols; base += (size_t)t * split_stride; colt -= t * split_cols; if (t == 0) sc = scale0; }
        const int col0 = colt + wc * 32 + 8 * fq, bcol0 = u.pn * BM + wc * 32 + 8 * fq;
        f32x4 bv[2][2];
#pragma unroll
        for (int bj = 0; bj < 2; ++bj)
#pragma unroll
            for (int n = 0; n < 2; ++n) bv[bj][n] = bias ? *(const f32x4*)(bias + bcol0 + bj * HALF + 4 * n) : (f32x4){0.f, 0.f, 0.f, 0.f};
#pragma unroll
        for (int ai = 0; ai < 2; ++ai)
#pragma unroll
            for (int m = 0; m < 4; ++m) { bf16_t* rowp = base + (size_t)(row0 + ai * HALF + m * 16) * ldc + col0;
#pragma unroll
                for (int bj = 0; bj < 2; ++bj) { f32x4 v0 = acc[ai][bj][m][0] + bv[bj][0], v1 = acc[ai][bj][m][1] + bv[bj][1];
                    if (ACT == 1) { f32x2 a = gelu_pk((f32x2){v0[0], v0[1]}), b = gelu_pk((f32x2){v0[2], v0[3]}), c = gelu_pk((f32x2){v1[0], v1[1]}), d = gelu_pk((f32x2){v1[2], v1[3]});
                        v0 = (f32x4){a.x, a.y, b.x, b.y}; v1 = (f32x4){c.x, c.y, d.x, d.y}; }
                    v0 = v0 * sc; v1 = v1 * sc; u32x4 w; w.x = cvt_pk_bf16(v0[0], v0[1]); w.y = cvt_pk_bf16(v0[2], v0[3]); w.z = cvt_pk_bf16(v1[0], v1[1]); w.w = cvt_pk_bf16(v1[2], v1[3]);
                    *(u32x4*)(rowp + bj * HALF) = w; } }
    }
};

template <class Epi, class Sched, bool ALIGN_EPI = false, bool SP2 = false>
__device__ __forceinline__ void gemm_phase(PG8_LAS unsigned char* lds, const Gemm g, const Sched& S, const Epi& E) {
    const int tid = threadIdx.x, wid = __builtin_amdgcn_readfirstlane(tid >> 6), lane = tid & 63, wr = wid >> 2, wc = wid & 3, fr = lane & 15, fq = lane >> 4;
    const int K = g.K, nt = K / BK;
    unsigned voffA[2], voffB[2];
#pragma unroll
    for (int i = 0; i < 2; ++i) { int R, C; stage_rc(tid * 16 + i * 8192, R, C); const int Rb = Epi::PERM ? ((R & ~31) + perm32(R & 31)) : R;
        voffA[i] = (unsigned)(R * g.lda + C) * 2u; voffB[i] = (unsigned)(Rb * g.ldb + C) * 2u; }
    const size_t kstep = (size_t)(BK * 2);
    const size_t hstepA = (size_t)HALF * g.lda * 2, hstepB = (size_t)HALF * g.ldb * 2;
    const size_t tstepA = 2 * hstepA, tstepB = 2 * hstepB;
    const unsigned ldsw = (unsigned)wid * 1024u;
    const int aoff = lds_byte(wr * 64 + fr, fq * 8), boff = lds_byte(wc * 32 + fr, fq * 8);
#define PG8_SA(b, h) (((b) * 2 + (h)) * HTB)
#define PG8_SB(b, h) ((4 + (b) * 2 + (h)) * HTB)
#define PG8_STAGE(bufoff, gbase, voff) do { _Pragma("unroll") for (int _i = 0; _i < 2; ++_i) \
        __builtin_amdgcn_global_load_lds((const unsigned*)((const char*)(gbase) + (voff)[_i]), (PG8_LAS unsigned*)(lds + (bufoff) + ldsw + _i * 8192), 16, 0, 0); } while (0)
#define PG8_LDA(dst, b, h) do { _Pragma("unroll") for (int m = 0; m < 4; ++m) _Pragma("unroll") for (int k = 0; k < 2; ++k) dst[m][k] = *(const PG8_LAS bf16x8*)(lds + PG8_SA(b, h) + aoff + m * 2048 + k * 1024); } while (0)
#define PG8_LDB(dst, b, h) do { _Pragma("unroll") for (int n = 0; n < 2; ++n) _Pragma("unroll") for (int k = 0; k < 2; ++k) dst[n][k] = *(const PG8_LAS bf16x8*)(lds + PG8_SB(b, h) + boff + n * 2048 + k * 1024); } while (0)
#define PG8_MMA(ai, bj, At, Bt) do { __builtin_amdgcn_s_setprio(1); _Pragma("unroll") for (int m = 0; m < 4; ++m) _Pragma("unroll") for (int n = 0; n < 2; ++n) _Pragma("unroll") for (int k = 0; k < 2; ++k) \
        acc[ai][bj][m][n] = __builtin_amdgcn_mfma_f32_16x16x32_bf16(Bt[n][k], At[m][k], acc[ai][bj][m][n], 0, 0, 0); __builtin_amdgcn_s_setprio(0); } while (0)
#define PG8_WAIT_V(n) asm volatile("s_waitcnt vmcnt(" #n ")" ::: "memory")
#define PG8_WAIT_L(n) asm volatile("s_waitcnt lgkmcnt(" #n ")" ::: "memory")
#define PG8_BAR __builtin_amdgcn_s_barrier()
#define PG8_SCHED __builtin_amdgcn_sched_barrier(0)
    Unit cur, nxt; int ui = 0;
    if (!S.next(0, cur)) return;
    f32x4 acc[2][2][4][2];
#pragma unroll
    for (int a = 0; a < 2; ++a)
#pragma unroll
        for (int b = 0; b < 2; ++b)
#pragma unroll
            for (int m = 0; m < 4; ++m)
#pragma unroll
                for (int n = 0; n < 2; ++n) acc[a][b][m][n] = (f32x4){0.f, 0.f, 0.f, 0.f};
    bf16x8 At[4][2], B0[2][2], B1[2][2];
    const char* cA = (const char*)g.A + (size_t)cur.pm * tstepA; const char* cB = (const char*)g.Bt + (size_t)cur.pn * tstepB;
    S.a_ready(cur);
    if constexpr (SP2) {
        PG8_STAGE(PG8_SB(0, 0), cB, voffB); PG8_STAGE(PG8_SB(0, 1), cB + hstepB, voffB); PG8_STAGE(PG8_SA(0, 0), cA, voffA); PG8_STAGE(PG8_SA(0, 1), cA + hstepA, voffA);
        if (wr == 1) PG8_BAR;
        PG8_WAIT_V(2); PG8_BAR;
        PG8_STAGE(PG8_SB(1, 0), cB + kstep, voffB); PG8_STAGE(PG8_SA(1, 0), cA + kstep, voffA); PG8_STAGE(PG8_SB(1, 1), cB + hstepB + kstep, voffB);
        PG8_WAIT_V(6); PG8_BAR;
    } else {
        PG8_STAGE(PG8_SB(0, 0), cB, voffB); PG8_STAGE(PG8_SA(0, 0), cA, voffA); PG8_STAGE(PG8_SB(0, 1), cB + hstepB, voffB); PG8_STAGE(PG8_SA(0, 1), cA + hstepA, voffA);
        if (wr == 1) PG8_BAR;
        PG8_WAIT_V(4); PG8_BAR;
        PG8_STAGE(PG8_SB(1, 0), cB + kstep, voffB); PG8_STAGE(PG8_SA(1, 0), cA + kstep, voffA); PG8_STAGE(PG8_SB(1, 1), cB + hstepB + kstep, voffB);
        PG8_WAIT_V(6); PG8_BAR;
    }
    for (;;) {
        const bool has_next = S.next(ui + 1, nxt);
        const char* nA = has_next ? (const char*)g.A + (size_t)nxt.pm * tstepA : cA; const char* nB = has_next ? (const char*)g.Bt + (size_t)nxt.pn * tstepB : cB;
        for (int t = 0; t < nt; t += 2) {
            const bool last = (t == nt - 2);
            const char* a1 = cA + (size_t)(t + 1) * kstep;
            const char* a2 = last ? nA : cA + (size_t)(t + 2) * kstep; const char* b2 = last ? nB : cB + (size_t)(t + 2) * kstep;
            const char* a3 = a2 + kstep; const char* b3 = b2 + kstep;
            if (last && has_next) S.a_ready(nxt);
            if constexpr (SP2) {
            PG8_LDB(B0, 0, 0); PG8_LDB(B1, 0, 1); PG8_SCHED; PG8_LDA(At, 0, 0); PG8_STAGE(PG8_SA(1, 1), a1 + hstepA, voffA);
            PG8_WAIT_V(8); PG8_WAIT_L(0); PG8_BAR; PG8_MMA(0, 0, At, B0); PG8_MMA(0, 1, At, B1); PG8_BAR; PG8_SCHED;
            PG8_LDA(At, 0, 1); PG8_STAGE(PG8_SB(0, 0), b2, voffB); PG8_STAGE(PG8_SB(0, 1), b2 + hstepB, voffB); PG8_STAGE(PG8_SA(0, 0), a2, voffA);
            PG8_WAIT_V(8); PG8_WAIT_L(0); PG8_BAR; PG8_MMA(1, 0, At, B0); PG8_MMA(1, 1, At, B1); PG8_BAR; PG8_SCHED;
            PG8_LDB(B0, 1, 0); PG8_LDB(B1, 1, 1); PG8_SCHED; PG8_LDA(At, 1, 0); PG8_STAGE(PG8_SA(0, 1), a2 + hstepA, voffA);
            PG8_WAIT_V(8); PG8_WAIT_L(0); PG8_BAR; PG8_MMA(0, 0, At, B0); PG8_MMA(0, 1, At, B1); PG8_BAR; PG8_SCHED;
            PG8_LDA(At, 1, 1); PG8_STAGE(PG8_SB(1, 0), b3, voffB); PG8_STAGE(PG8_SB(1, 1), b3 + hstepB, voffB); PG8_STAGE(PG8_SA(1, 0), a3, voffA);
            PG8_WAIT_V(8); PG8_WAIT_L(0); PG8_BAR; PG8_MMA(1, 0, At, B0); PG8_MMA(1, 1, At, B1); PG8_BAR; PG8_SCHED;
            } else {
            PG8_LDB(B0, 0, 0); PG8_SCHED; PG8_LDA(At, 0, 0); PG8_STAGE(PG8_SA(1, 1), a1 + hstepA, voffA);
            PG8_WAIT_L(8); PG8_BAR; PG8_WAIT_L(0); PG8_MMA(0, 0, At, B0); PG8_BAR; PG8_SCHED;
            PG8_LDB(B1, 0, 1); PG8_STAGE(PG8_SB(0, 0), b2, voffB);
            PG8_BAR; PG8_WAIT_L(0); PG8_MMA(0, 1, At, B1); PG8_BAR;
            PG8_LDA(At, 0, 1); PG8_STAGE(PG8_SA(0, 0), a2, voffA);
            PG8_BAR; PG8_WAIT_L(0); PG8_MMA(1, 0, At, B0); PG8_BAR; PG8_SCHED;
            PG8_STAGE(PG8_SB(0, 1), b2 + hstepB, voffB);
            PG8_WAIT_V(6); PG8_BAR; PG8_MMA(1, 1, At, B1); PG8_BAR;
            PG8_LDB(B0, 1, 0); PG8_SCHED; PG8_LDA(At, 1, 0); PG8_STAGE(PG8_SA(0, 1), a2 + hstepA, voffA);
            PG8_WAIT_L(8); PG8_BAR; PG8_WAIT_L(0); PG8_MMA(0, 0, At, B0); PG8_BAR; PG8_SCHED;
            PG8_LDB(B1, 1, 1); PG8_STAGE(PG8_SB(1, 0), b3, voffB);
            PG8_BAR; PG8_WAIT_L(0); PG8_MMA(0, 1, At, B1); PG8_BAR;
            PG8_LDA(At, 1, 1); PG8_STAGE(PG8_SA(1, 0), a3, voffA);
            PG8_BAR; PG8_WAIT_L(0); PG8_MMA(1, 0, At, B0); PG8_BAR; PG8_SCHED;
            PG8_STAGE(PG8_SB(1, 1), b3 + hstepB, voffB);
            PG8_WAIT_V(6); PG8_BAR; PG8_MMA(1, 1, At, B1); PG8_BAR;
            }
        }
        if constexpr (ALIGN_EPI) { if (wr == 0) PG8_BAR; }
        if constexpr (!Epi::AFTER_DRAIN) { E(acc, cur, wr, wc, fr, fq); S.done(cur); }
        if (!has_next) break;
#pragma unroll
        for (int a = 0; a < 2; ++a)
#pragma unroll
            for (int b = 0; b < 2; ++b)
#pragma unroll
                for (int m = 0; m < 4; ++m)
#pragma unroll
                    for (int n = 0; n < 2; ++n) acc[a][b][m][n] = (f32x4){0.f, 0.f, 0.f, 0.f};
        cur = nxt; cA = nA; cB = nB; ++ui;
        if constexpr (ALIGN_EPI) { if (wr == 1) PG8_BAR; }
    }
    PG8_WAIT_V(0);
    if constexpr (!ALIGN_EPI) { if (wr == 0) PG8_BAR; }
    PG8_BAR;
    if constexpr (Epi::AFTER_DRAIN) { E.fused(acc, cur, wr, wc, fr, fq, lds, wid, lane); S.done(cur); }
#undef PG8_SA
#undef PG8_SB
#undef PG8_STAGE
#undef PG8_LDA
#undef PG8_LDB
#undef PG8_MMA
#undef PG8_WAIT_V
#undef PG8_WAIT_L
#undef PG8_BAR
#undef PG8_SCHED
}
}

#ifndef MK_EXP_OLD
#define MK_EXP_OLD 0
#endif
#ifndef MK_ONE_LAUNCH
#define MK_ONE_LAUNCH 1
#endif
#define LAS __attribute__((address_space(3)))
typedef unsigned short bf16;
typedef unsigned v4u __attribute__((ext_vector_type(4)));
typedef unsigned v2u __attribute__((ext_vector_type(2)));
typedef float f32x4 __attribute__((ext_vector_type(4)));
typedef float f32x2 __attribute__((ext_vector_type(2)));
typedef short bf16x8 __attribute__((ext_vector_type(8)));
typedef float f32x16 __attribute__((ext_vector_type(16)));
#define MFMA32(a, b, c) __builtin_amdgcn_mfma_f32_32x32x16_bf16((a), (b), (c), 0, 0, 0)

constexpr int D = 1024, NB = 8, SEQ = 2048, LC = 256, ML = NB * SEQ  , MC = NB * LC  , MT = ML + MC  ;
constexpr int PROJ = 2576, NPROJ = 2560;
constexpr int NEXP = 16384, TOPK = 16, KK = 128;
constexpr float EPS = 1e-6f;
constexpr int NTHREADS = 512, NWAVES = 8;
constexpr int LDS_BYTES = 147456;
constexpr int NPHASES = 16;

constexpr size_t MiB = 1u << 20;
constexpr size_t WS_CTL = 0;
constexpr size_t CTL_ZERO_BYTES = 65536;
constexpr int CW_BAR = 0;
constexpr int CW_E1 = 4096, CW_E2 = 4096 + 8 * 64;
constexpr size_t WS_MOD = 1 * MiB;
constexpr size_t WS_LP = 1 * MiB + 512 * 1024;
constexpr size_t WS_WIN = 2 * MiB;
constexpr size_t WS_WOUT = 8 * MiB;
constexpr size_t WS_WGLU = 10 * MiB;
constexpr size_t WS_WQ = 11 * MiB;
constexpr size_t WS_GB = 15 * MiB;
constexpr size_t WS_BB = 17 * MiB;
constexpr size_t WS_PM = 41 * MiB;
constexpr size_t WS_OG = 17 * MiB;
constexpr size_t WS_HX2 = 17 * MiB;
constexpr size_t WS_U5 = 49 * MiB;
constexpr size_t WS_CAT = 49 * MiB;
constexpr size_t WS_IDX = 49 * MiB;
constexpr size_t WS_GATE = 57 * MiB;
constexpr size_t WS_ACT = 65 * MiB;
constexpr size_t WS_SSQP = 73 * MiB;
constexpr size_t WS_Z = 85 * MiB;
constexpr size_t WS_YRAW = 85 * MiB;
constexpr size_t WS_QP = 85 * MiB;
constexpr size_t WS_Y = 85 * MiB;
constexpr size_t WS_HX = 101 * MiB;
constexpr size_t WS_SS = 101 * MiB;
constexpr size_t WS_YG = 101 * MiB;
constexpr size_t WS_FRT = 125 * MiB;
constexpr size_t WS_QKVPRE = 137 * MiB;
constexpr size_t WS_FRA = 143 * MiB;
constexpr size_t WS_FRK = 161 * MiB;
constexpr size_t WS_FRTAB = 197 * MiB;
constexpr size_t WS_QKV = 202 * MiB;
constexpr size_t WS_U8 = 202 * MiB;
constexpr size_t WS_V8 = 218 * MiB;
constexpr size_t WS_USC = 234 * MiB;
constexpr size_t WS_VSC = 234 * MiB + 512 * 1024;
constexpr size_t WS_HQ8 = 150 * MiB;
constexpr size_t WS_HS = 183 * MiB;
constexpr size_t WS_PACT = 85 * MiB;
constexpr size_t WS_END = 256 * MiB;
static_assert(WS_BB + (size_t)32 * 512 * 768 * 2 <= WS_PM && WS_PM + (size_t)32 * 256 * 512 * 2 <= WS_U5 && WS_U5 + (size_t)32 * 768 * 768 * 2 <= WS_Z && WS_Z + (size_t)ML * 512 * 2 <= WS_HX, "ws map a");
static_assert(WS_HX + (size_t)MT * D * 2 <= WS_QKVPRE && WS_SS + (size_t)32 * 768 * 256 * 4 <= WS_FRT && WS_QKVPRE + (size_t)MT * 1536 * 2 <= WS_QKV && WS_QKV + (size_t)MT * 1536 * 2 <= WS_END, "ws map b");
static_assert(WS_FRT + (size_t)2304 * 8192 <= WS_FRA && WS_FRA + (size_t)2304 * 8192 <= WS_FRK && WS_FRK + (size_t)2304 * 16384 <= WS_FRTAB && WS_FRTAB + (size_t)2304 * 1024 <= WS_QKV, "ws map c");
static_assert(WS_OG + (size_t)2 * ML * 512 * 2 <= WS_CAT && WS_CAT + (size_t)ML * D * 2 <= WS_Z && WS_YRAW + (size_t)ML * D * 4 <= WS_U8 && WS_SSQP + (size_t)8 * ML * 4 <= WS_Z && WS_YG + (size_t)ML * 512 * 2 <= WS_FRT, "ws map d");

__device__ __forceinline__ unsigned f2bf(float f) { unsigned u = __builtin_bit_cast(unsigned, f); return (u + 0x7fffu + ((u >> 16) & 1u)) >> 16; }
typedef __bf16 bf16x2_t __attribute__((ext_vector_type(2)));
__device__ __forceinline__ unsigned pk2(float lo, float hi) { const f32x2 v = {lo, hi}; return __builtin_bit_cast(unsigned, __builtin_convertvector(v, bf16x2_t)); }
__device__ __forceinline__ float bflo(unsigned w) { return __builtin_bit_cast(float, w << 16); }
__device__ __forceinline__ float bfhi(unsigned w) { return __builtin_bit_cast(float, w & 0xffff0000u); }
__device__ __forceinline__ float bf1(bf16 h) { return __builtin_bit_cast(float, (unsigned)h << 16); }
__device__ __forceinline__ float wave_sum(float v) {
#pragma unroll
    for (int o = 1; o < 64; o <<= 1) v += __shfl_xor(v, o);
    return v;
}
__device__ __forceinline__ float wave_max(float v) {
#pragma unroll
    for (int o = 1; o < 64; o <<= 1) v = fmaxf(v, __shfl_xor(v, o));
    return v;
}
__device__ __forceinline__ float sigmoidf_(float x) { return __builtin_amdgcn_rcpf(1.f + __expf(-x)); }
__device__ __forceinline__ float siluf_(float x) { return x * __builtin_amdgcn_rcpf(1.f + __expf(-x)); }
__device__ __forceinline__ float gelu_erf(float x) { return 0.5f * x * (1.f + erff(x * 0.70710678118654752f)); }
__device__ __forceinline__ void sincos_d(double a, float& s, float& c) {
    const double k = rint(a * 0.63661977236758134308);
    const double r = fma(-k, 1.57079632679489661923, a) - k * 6.123233995736766e-17;
    const double r2 = r * r;
    double sp = -2.5052108385441720e-08; sp = sp * r2 + 2.7557319223985893e-06; sp = sp * r2 - 1.9841269841269841e-04; sp = sp * r2 + 8.3333333333333332e-03; sp = sp * r2 - 1.6666666666666666e-01;
    const double sn = r + r * r2 * sp;
    double cp = 2.0876756987868099e-09; cp = cp * r2 - 2.7557319223985888e-07; cp = cp * r2 + 2.4801587301587302e-05; cp = cp * r2 - 1.3888888888888889e-03; cp = cp * r2 + 4.1666666666666664e-02; cp = cp * r2 - 0.5;
    const double cs = 1.0 + r2 * cp;
    const int q = ((int)k) & 3;
    const double ss = (q == 0) ? sn : (q == 1) ? cs : (q == 2) ? -sn : -cs;
    const double cc = (q == 0) ? cs : (q == 1) ? -sn : (q == 2) ? -cs : sn;
    s = (float)ss; c = (float)cc;
}

struct Args { const float* in[29]; float* out; unsigned char* ws; int ph_lo, ph_hi; };
static_assert(sizeof(Args) == 29 * 8 + 8 + 8 + 8, "Args has no padding");
enum { I_X = 0, I_C, I_CTX, I_CCTX, I_WMOD, I_BMOD, I_GPREMIX, I_GPOSTMIX, I_GPREFFN, I_GPOSTFFN, I_WIN, I_WOUT, I_LAMRE, I_LAMIM, I_LOGDT, I_BRE, I_BIM, I_CRE, I_CIM, I_S5D, I_WGLU,
       I_CONV, I_ALOG, I_DTBIAS, I_GDNNORM, I_WQ, I_KEYS, I_PU, I_PV };

__device__ __forceinline__ const float* in_row(const Args& a, int row) { return row < ML ? a.in[I_X] + (size_t)row * D : a.in[I_CTX] + (size_t)(row - ML) * D; }
__device__ __forceinline__ int mod_row(int row) { return row < ML ? (row >> 11) : 8; }

template <int CTRL> __device__ __forceinline__ float dppf(float v) { return __builtin_bit_cast(float, __builtin_amdgcn_update_dpp(0, __builtin_bit_cast(int, v), CTRL, 0xf, 0xf, true)); }
__device__ __forceinline__ float row_sum16(float v) { v += dppf<0xB1>(v); v += dppf<0x4E>(v); v += dppf<0x141>(v); v += dppf<0x140>(v); return v; }
__device__ __forceinline__ float row_max16(float v) { v = fmaxf(v, dppf<0xB1>(v)); v = fmaxf(v, dppf<0x4E>(v)); v = fmaxf(v, dppf<0x141>(v)); v = fmaxf(v, dppf<0x140>(v)); return v; }
__device__ __forceinline__ float wsum(float v) { v = row_sum16(v); return
    __builtin_bit_cast(float, __builtin_amdgcn_readlane(__builtin_bit_cast(int, v), 0)) + __builtin_bit_cast(float, __builtin_amdgcn_readlane(__builtin_bit_cast(int, v), 16)) +
    __builtin_bit_cast(float, __builtin_amdgcn_readlane(__builtin_bit_cast(int, v), 32)) + __builtin_bit_cast(float, __builtin_amdgcn_readlane(__builtin_bit_cast(int, v), 48)); }
__device__ __forceinline__ float wmax(float v) { v = row_max16(v); return fmaxf(fmaxf(__builtin_bit_cast(float, __builtin_amdgcn_readlane(__builtin_bit_cast(int, v), 0)), __builtin_bit_cast(float, __builtin_amdgcn_readlane(__builtin_bit_cast(int, v), 16))),
    fmaxf(__builtin_bit_cast(float, __builtin_amdgcn_readlane(__builtin_bit_cast(int, v), 32)), __builtin_bit_cast(float, __builtin_amdgcn_readlane(__builtin_bit_cast(int, v), 48)))); }
__device__ __forceinline__ int lane_rank(unsigned long long m) { return __builtin_amdgcn_mbcnt_hi((unsigned)(m >> 32), __builtin_amdgcn_mbcnt_lo((unsigned)m, 0)); }
__device__ __forceinline__ unsigned fkey(float f) { const unsigned u = __builtin_bit_cast(unsigned, f); return u ^ ((unsigned)((int)u >> 31) | 0x80000000u); }
#define WAVE_LDS_SYNC() do { __builtin_amdgcn_fence(__ATOMIC_RELEASE, "wavefront"); __builtin_amdgcn_wave_barrier(); __builtin_amdgcn_fence(__ATOMIC_ACQUIRE, "wavefront"); } while (0)
template <int N> __device__ __forceinline__ unsigned kth_key(const unsigned (&k)[N], int K) {
    unsigned T = 0;
    for (int bit = 31; bit >= 0; --bit) { const unsigned cand = T | (1u << bit); int cnt = 0;
#pragma unroll
        for (int n = 0; n < N; ++n) cnt += __popcll(__ballot(k[n] >= cand));
        if (cnt >= K) T = cand;
        if (cnt == K) break; }
    return T;
}

namespace pg8 {
struct EpiInProj {
    static constexpr bool PERM = true, AFTER_DRAIN = false;
    bf16_t* U; bf16_t* QKV; bf16_t* Z;
    __device__ __forceinline__ void operator()(const f32x4 (&acc)[2][2][4][2], const Unit& u, int wr, int wc, int fr, int fq) const {
        bf16_t* base; int ld, colt; bool lat_only = false;
        const bool s5 = u.pn < 2;
        if (s5) { base = U; ld = 0; colt = u.pn * BM; }
        else if (u.pn < 8) { base = QKV; ld = 1536; colt = (u.pn - 2) * BM; }
        else { base = Z; ld = 512; colt = (u.pn - 8) * BM; lat_only = true; }
        const int row0 = u.pm * BM + wr * 64 + fr, col0 = colt + wc * 32 + 8 * fq;
#pragma unroll
        for (int ai = 0; ai < 2; ++ai)
#pragma unroll
            for (int m = 0; m < 4; ++m) { const int row = row0 + ai * HALF + m * 16; bf16_t* rowp = base + (size_t)row * ld + col0;
                if (lat_only && row >= 16384) continue;
                if (s5) { const int R = row < 16384 ? (row >> 5) : 512 + ((row - 16384) >> 5), ii = row & 31; rowp = base + (size_t)R * 768 + ii * 16 + (col0 & 15); }
#pragma unroll
                for (int bj = 0; bj < 2; ++bj) { const f32x4 v0 = acc[ai][bj][m][0], v1 = acc[ai][bj][m][1];
                    u32x4 w; w.x = cvt_pk_bf16(v0[0], v0[1]); w.y = cvt_pk_bf16(v0[2], v0[3]); w.z = cvt_pk_bf16(v1[0], v1[1]); w.w = cvt_pk_bf16(v1[2], v1[3]);
                    if (s5) *(u32x4*)(rowp + (size_t)((col0 + bj * HALF) >> 4) * (768 * 768)) = w; else *(u32x4*)(rowp + bj * HALF) = w; } }
    }
};
struct EpiGlu {
    static constexpr bool PERM = true, AFTER_DRAIN = false;
    const bf16_t* YG; bf16_t* CAT;
    __device__ __forceinline__ void operator()(const f32x4 (&acc)[2][2][4][2], const Unit& u, int wr, int wc, int fr, int fq) const {
        const int row0 = u.pm * BM + wr * 64 + fr, col0 = u.pn * BM + wc * 32 + 8 * fq;
#pragma unroll
        for (int ai = 0; ai < 2; ++ai)
#pragma unroll
            for (int m = 0; m < 4; ++m) { const int row = row0 + ai * HALF + m * 16;
#pragma unroll
                for (int bj = 0; bj < 2; ++bj) { const f32x4 v0 = acc[ai][bj][m][0], v1 = acc[ai][bj][m][1];
                    const u32x4 y = *(const u32x4*)(YG + (size_t)row * 512 + col0 + bj * HALF);
                    float o[8]; const float a[8] = {v0[0], v0[1], v0[2], v0[3], v1[0], v1[1], v1[2], v1[3]};
                    const unsigned yw[4] = {y.x, y.y, y.z, y.w};
#pragma unroll
                    for (int e = 0; e < 8; ++e) { const float yv = __builtin_bit_cast(float, (e & 1) ? (yw[e >> 1] & 0xffff0000u) : (yw[e >> 1] << 16)); o[e] = yv * __builtin_amdgcn_rcpf(1.f + __expf(-a[e])); }
                    u32x4 w; w.x = cvt_pk_bf16(o[0], o[1]); w.y = cvt_pk_bf16(o[2], o[3]); w.z = cvt_pk_bf16(o[4], o[5]); w.w = cvt_pk_bf16(o[6], o[7]);
                    *(u32x4*)(CAT + (size_t)row * 1024 + col0 + bj * HALF) = w; } }
    }
};
struct EpiF32 {
    static constexpr bool PERM = false, AFTER_DRAIN = false;
    float* C; int ldc;
    __device__ __forceinline__ void operator()(const f32x4 (&acc)[2][2][4][2], const Unit& u, int wr, int wc, int fr, int fq) const {
        const int row0 = u.pm * BM + wr * 64 + fr, col0 = u.pn * BM + wc * 32 + 4 * fq;
#pragma unroll
        for (int ai = 0; ai < 2; ++ai)
#pragma unroll
            for (int m = 0; m < 4; ++m) { float* rowp = C + (size_t)(row0 + ai * HALF + m * 16) * ldc + col0;
#pragma unroll
                for (int bj = 0; bj < 2; ++bj)
#pragma unroll
                    for (int n = 0; n < 2; ++n) *(f32x4*)(rowp + bj * HALF + n * 16) = acc[ai][bj][m][n]; }
    }
};
struct EpiSS {
    static constexpr bool PERM = false, AFTER_DRAIN = false;
    float* C;
    __device__ __forceinline__ void operator()(const f32x4 (&acc)[2][2][4][2], const Unit& u, int wr, int wc, int fr, int fq) const {
        const int row0 = u.pm * BM + wr * 64 + fr, col0 = wc * 32 + 4 * fq;
#pragma unroll
        for (int ai = 0; ai < 2; ++ai)
#pragma unroll
            for (int m = 0; m < 4; ++m) { float* rowp = C + (size_t)(row0 + ai * HALF + m * 16) * 256 + col0;
#pragma unroll
                for (int bj = 0; bj < 2; ++bj)
#pragma unroll
                    for (int n = 0; n < 2; ++n) *(f32x4*)(rowp + bj * HALF + n * 16) = acc[ai][bj][m][n]; }
    }
};
struct SchedSS { int G, c; __device__ bool next(int i, Unit& u) const { const int L = i * G + c; if (L >= 96) return false; u.pm = L; u.pn = L / 3; return true; }
    __device__ __forceinline__ void a_ready(const Unit&) const {} __device__ __forceinline__ void done(const Unit&) const {} };
struct EpiS5Y {
    static constexpr bool PERM = true, AFTER_DRAIN = false;
    bf16_t* YG;
    __device__ __forceinline__ void operator()(const f32x4 (&acc)[2][2][4][2], const Unit& u, int wr, int wc, int fr, int fq) const {
        const int g = u.pn >> 1, R0 = (u.pm - 3 * g) * BM + wr * 64 + fr, n0 = (u.pn & 1) * BM + wc * 32 + 8 * fq;
#pragma unroll
        for (int ai = 0; ai < 2; ++ai)
#pragma unroll
            for (int m = 0; m < 4; ++m) { const int R = R0 + ai * HALF + m * 16;
#pragma unroll
                for (int bj = 0; bj < 2; ++bj) { const int n = n0 + bj * HALF; const f32x4 v0 = acc[ai][bj][m][0], v1 = acc[ai][bj][m][1];
                    const f32x2 a = gelu_pk((f32x2){v0[0], v0[1]}), b = gelu_pk((f32x2){v0[2], v0[3]}), c2 = gelu_pk((f32x2){v1[0], v1[1]}), d = gelu_pk((f32x2){v1[2], v1[3]});
                    u32x4 w; w.x = cvt_pk_bf16(a.x, a.y); w.y = cvt_pk_bf16(b.x, b.y); w.z = cvt_pk_bf16(c2.x, c2.y); w.w = cvt_pk_bf16(d.x, d.y);
                    *(u32x4*)(YG + (size_t)(R * 32 + (n >> 4)) * 512 + g * 16 + (n & 15)) = w; } }
    }
};
struct SchedS5Y { int G, c; __device__ bool next(int i, Unit& u) const { const int L = i * G + c; if (L >= 128) return false; const int g = L >> 2; u.pm = 3 * g + ((L >> 1) & 1); u.pn = 2 * g + (L & 1); return true; }
    __device__ __forceinline__ void a_ready(const Unit&) const {} __device__ __forceinline__ void done(const Unit&) const {} };
}

struct Ctx { const Args* a; unsigned char* ws; unsigned char* lds; int tid, lane, wave, bid, G, gw, NGW, gwv; };

__device__ __forceinline__ void p0_transpose_item(const float* W, int ldw, int nblk, int K, bf16* WT, float* scr, int item, int lane) {
    const int kb = item / nblk, nb = item % nblk, k0 = 64 * kb, n0 = 32 * nb;
#pragma unroll 8
    for (int i = 0; i < 32; ++i) { const int kk = 2 * i + (lane >> 5); scr[kk * 33 + (lane & 31)] = W[(size_t)(k0 + kk) * ldw + n0 + (lane & 31)]; }
    __builtin_amdgcn_fence(__ATOMIC_RELEASE, "wavefront"); __builtin_amdgcn_wave_barrier(); __builtin_amdgcn_fence(__ATOMIC_ACQUIRE, "wavefront");
    const int c = lane & 7;
#pragma unroll
    for (int j = 0; j < 4; ++j) { const int n = (lane >> 3) + 8 * j; const float* s = scr + (8 * c) * 33 + n;
        v4u o; o.x = pk2(s[0 * 33], s[1 * 33]); o.y = pk2(s[2 * 33], s[3 * 33]); o.z = pk2(s[4 * 33], s[5 * 33]); o.w = pk2(s[6 * 33], s[7 * 33]);
        *(v4u*)(WT + (size_t)(n0 + n) * K + k0 + 8 * c) = o; }
    __builtin_amdgcn_fence(__ATOMIC_RELEASE, "wavefront"); __builtin_amdgcn_wave_barrier(); __builtin_amdgcn_fence(__ATOMIC_ACQUIRE, "wavefront");
}
__device__ __forceinline__ void phase_prep(const Ctx& c) {
    const Args& a = *c.a;
    float* scr = (float*)(c.lds + c.wave * 16384);
    constexpr int I_IN = 16 * 80, I_OUT = 16 * 32, I_GLU = 8 * 16, I_Q = 16 * 64;
    for (int it = c.gw; it < I_IN + I_OUT + I_GLU + I_Q; it += c.NGW) {
        int r = it;
        if (r < I_IN) { p0_transpose_item(a.in[I_WIN], PROJ, 80, 1024, (bf16*)(c.ws + WS_WIN), scr, r, c.lane); continue; } r -= I_IN;
        if (r < I_OUT) { p0_transpose_item(a.in[I_WOUT], 1024, 32, 1024, (bf16*)(c.ws + WS_WOUT), scr, r, c.lane); continue; } r -= I_OUT;
        if (r < I_GLU) { p0_transpose_item(a.in[I_WGLU], 512, 16, 512, (bf16*)(c.ws + WS_WGLU), scr, r, c.lane); continue; } r -= I_GLU;
        p0_transpose_item(a.in[I_WQ], 2048, 64, 1024, (bf16*)(c.ws + WS_WQ), scr, r, c.lane);
    }
    __syncthreads();
    float* sc = (float*)c.lds;
    float* red = (float*)(c.lds + 9 * 1024 * 4);
    float* MOD = (float*)(c.ws + WS_MOD);
    bool have = false;
    for (int item = c.bid; item < 96; item += c.G) {
        if (!have) { for (int i = c.tid; i < 9 * 1024; i += NTHREADS) { const int r = i >> 10, k = i & 1023; const float v = r < 8 ? a.in[I_C][r * 1024 + k] : a.in[I_CCTX][k]; sc[i] = siluf_(v); } have = true; __syncthreads(); }
        const int n0 = item * 64;
        float acc[9];
#pragma unroll
        for (int r = 0; r < 9; ++r) acc[r] = 0.f;
        const float* wp = a.in[I_WMOD] + (size_t)(c.wave * 128) * 6144 + n0 + c.lane;
#pragma unroll 16
        for (int k = 0; k < 128; ++k) { const float w = wp[(size_t)k * 6144];
#pragma unroll
            for (int r = 0; r < 9; ++r) acc[r] = fmaf(sc[r * 1024 + c.wave * 128 + k], w, acc[r]); }
#pragma unroll
        for (int r = 0; r < 9; ++r) red[(c.wave * 9 + r) * 64 + c.lane] = acc[r];
        __syncthreads();
        for (int i = c.tid; i < 576; i += NTHREADS) { const int r = i >> 6, l = i & 63; float s = a.in[I_BMOD][n0 + l];
#pragma unroll
            for (int w = 0; w < 8; ++w) s += red[(w * 9 + r) * 64 + l];
            MOD[r * 6144 + n0 + l] = s; }
        __syncthreads();
    }
}
__device__ __forceinline__ void s5_build_group(const Ctx& c, int g, int part);
__device__ __forceinline__ void phase_s5_build(const Ctx& c) { for (int it = c.G - 1 - c.bid; it < 128; it += c.G) if (it >= 0) s5_build_group(c, it >> 2, it & 3); }

__device__ __forceinline__ void phase_norm1(const Ctx& c) {
    const Args& a = *c.a;
    float* wabT = (float*)c.lds;
    { f32x4 wv[8];
#pragma unroll
      for (int q = 0; q < 8; ++q) { const int i = c.tid + NTHREADS * q, kk = i >> 2, qq = i & 3; wv[q] = *(const f32x4*)(a.in[I_WIN] + (size_t)kk * PROJ + NPROJ + 4 * qq); }
#pragma unroll
      for (int q = 0; q < 8; ++q) { const int i = c.tid + NTHREADS * q, kk = i >> 2, qq = i & 3; wabT[(4 * qq + 0) * 1028 + kk] = wv[q].x; wabT[(4 * qq + 1) * 1028 + kk] = wv[q].y; wabT[(4 * qq + 2) * 1028 + kk] = wv[q].z; wabT[(4 * qq + 3) * 1028 + kk] = wv[q].w; } }
    __syncthreads();
    const float* MOD = (const float*)(c.ws + WS_MOD);
    bf16* HX = (bf16*)(c.ws + WS_HX); float* GB = (float*)(c.ws + WS_GB);
    const float* gpre = a.in[I_GPREMIX];
    f32x4 nx[4];
    if (c.gw < MT) { const f32x4* xr = (const f32x4*)in_row(a, c.gw) + c.lane;
#pragma unroll
        for (int j = 0; j < 4; ++j) nx[j] = xr[64 * j]; }
    for (int row = c.gw; row < MT; row += c.NGW) {
        const float* mr = MOD + mod_row(row) * 6144;
        f32x4 v[4]; float ss = 0.f;
#pragma unroll
        for (int j = 0; j < 4; ++j) { v[j] = nx[j]; ss += (v[j].x * v[j].x + v[j].y * v[j].y) + (v[j].z * v[j].z + v[j].w * v[j].w); }
        if (row + c.NGW < MT) { const f32x4* xr = (const f32x4*)in_row(a, row + c.NGW) + c.lane;
#pragma unroll
            for (int j = 0; j < 4; ++j) nx[j] = xr[64 * j]; }
        const float r = rsqrtf(wsum(ss) * (1.f / D) + EPS);
#pragma unroll
        for (int j = 0; j < 4; ++j) { const int col = 4 * c.lane + 256 * j;
            const f32x4 g4 = *(const f32x4*)(gpre + col), sh = *(const f32x4*)(mr + col), scl = *(const f32x4*)(mr + 1024 + col);
            v[j] = (v[j] * r) * g4 * (scl + 1.f) + sh;
            v2u o; o.x = pk2(v[j].x, v[j].y); o.y = pk2(v[j].z, v[j].w);
            *(v2u*)(HX + (size_t)row * D + col) = o; }
        float pj[16];
#pragma unroll
        for (int j = 0; j < 16; ++j) { float s = 0.f;
#pragma unroll
            for (int jj = 0; jj < 4; ++jj) { const f32x4 w = *(const f32x4*)(wabT + j * 1028 + 4 * c.lane + 256 * jj); s += (v[jj].x * w.x + v[jj].y * w.y) + (v[jj].z * w.z + v[jj].w * w.w); }
            pj[j] = s; if ((j & 1) == 1) asm volatile("" ::: "memory"); }
        const bool b5 = c.lane & 32, b4 = c.lane & 16, b3 = c.lane & 8, b2 = c.lane & 4;
        float q8[8], q4[4], q2[2];
#pragma unroll
        for (int i = 0; i < 8; ++i) { const float keep = b5 ? pj[i + 8] : pj[i], send = b5 ? pj[i] : pj[i + 8]; q8[i] = keep + __shfl_xor(send, 32); }
#pragma unroll
        for (int i = 0; i < 4; ++i) { const float keep = b4 ? q8[i + 4] : q8[i], send = b4 ? q8[i] : q8[i + 4]; q4[i] = keep + __shfl_xor(send, 16); }
#pragma unroll
        for (int i = 0; i < 2; ++i) { const float keep = b3 ? q4[i + 2] : q4[i], send = b3 ? q4[i] : q4[i + 2]; q2[i] = keep + dppf<0x140>(send); }
        float mine; { const float keep = b2 ? q2[1] : q2[0], send = b2 ? q2[0] : q2[1]; mine = keep + dppf<0x141>(send); }
        mine += dppf<0xB1>(mine); mine += dppf<0x4E>(mine);
        const int jl = (b5 ? 8 : 0) + (b4 ? 4 : 0) + (b3 ? 2 : 0) + (b2 ? 1 : 0);
        if ((c.lane & 3) == 0) {
            if (jl < 8) { const float t = mine + a.in[I_DTBIAS][jl]; const float sp = t > 20.f ? t : log1pf(expf(t)); GB[(size_t)row * 16 + jl] = -expf(a.in[I_ALOG][jl]) * sp; }
            else GB[(size_t)row * 16 + jl] = 1.f / (1.f + expf(-mine)); }
    }
}

__device__ __forceinline__ void phase_conv(const Ctx& c) {
    const Args& a = *c.a;
    const bf16* PRE = (const bf16*)(c.ws + WS_QKVPRE); bf16* OUT = (bf16*)(c.ws + WS_QKV);
    const float* cw = a.in[I_CONV];
#pragma unroll 1
    for (int pass = 0; pass < 3; ++pass) { const int ch0 = pass * 512 + 8 * c.lane;
        f32x4 wt[9][2];
#pragma unroll
        for (int i = 0; i < 9; ++i) { wt[i][0] = *(const f32x4*)(cw + i * 1536 + ch0); wt[i][1] = *(const f32x4*)(cw + i * 1536 + ch0 + 4); }
#define CONV_LOAD(DST, ROW) do { const int row_ = (ROW); int nb_row[9]; bool ok[9]; \
            if (row_ < ML) { const int t = row_ & 2047, gr = t >> 6, gc = t & 63; \
                _Pragma("unroll") for (int dy = -1; dy <= 1; ++dy) _Pragma("unroll") for (int dx = -1; dx <= 1; ++dx) { const int i = (dy + 1) * 3 + dx + 1; ok[i] = (gr + dy >= 0) && (gr + dy < 32) && (gc + dx >= 0) && (gc + dx < 64); nb_row[i] = row_ + dy * 64 + dx; } } \
            else { const int t = (row_ - ML) & 255; _Pragma("unroll") for (int i = 0; i < 9; ++i) { ok[i] = false; nb_row[i] = row_; } \
                _Pragma("unroll") for (int dx = -1; dx <= 1; ++dx) { ok[4 + dx] = (t + dx >= 0) && (t + dx < 256); nb_row[4 + dx] = row_ + dx; } } \
            _Pragma("unroll") for (int i = 0; i < 9; ++i) DST[i] = ok[i] ? *(const v4u*)(PRE + (size_t)nb_row[i] * 1536 + ch0) : (v4u){0u, 0u, 0u, 0u}; } while (0)
        v4u nin[9];
        if (c.gw < MT) CONV_LOAD(nin, c.gw);
#pragma unroll 1
        for (int row = c.gw; row < MT; row += c.NGW) {
            v4u in[9];
#pragma unroll
            for (int i = 0; i < 9; ++i) in[i] = nin[i];
            if (row + c.NGW < MT) CONV_LOAD(nin, row + c.NGW);
            float o[8];
#pragma unroll
            for (int q = 0; q < 8; ++q) o[q] = 0.f;
#pragma unroll
            for (int i = 0; i < 9; ++i) { const unsigned w[4] = {in[i].x, in[i].y, in[i].z, in[i].w}; const float kk[8] = {wt[i][0].x, wt[i][0].y, wt[i][0].z, wt[i][0].w, wt[i][1].x, wt[i][1].y, wt[i][1].z, wt[i][1].w};
#pragma unroll
                for (int q = 0; q < 4; ++q) { o[2 * q] = fmaf(bflo(w[q]), kk[2 * q], o[2 * q]); o[2 * q + 1] = fmaf(bfhi(w[q]), kk[2 * q + 1], o[2 * q + 1]); } }
            float ssq = 0.f;
#pragma unroll
            for (int q = 0; q < 8; ++q) { o[q] = siluf_(o[q]); ssq = fmaf(o[q], o[q], ssq); }
            if (pass < 2) { const float sc = rsqrtf(row_sum16(ssq) + EPS) * (pass == 0 ? 0.08838834764831845f : 1.f);
#pragma unroll
                for (int q = 0; q < 8; ++q) o[q] *= sc; }
            v4u ov; ov.x = pk2(o[0], o[1]); ov.y = pk2(o[2], o[3]); ov.z = pk2(o[4], o[5]); ov.w = pk2(o[6], o[7]);
            *(v4u*)(OUT + (size_t)row * 1536 + ch0) = ov;
        }
#undef CONV_LOAD
    }
}

__device__ __forceinline__ int scan_row(int b, int dir, int step) {
    if (step < LC) { const int t = dir ? LC - 1 - step : step; return ML + b * LC + t; }
    const int t = step - LC; return b * SEQ + (dir ? SEQ - 1 - t : t);
}
__device__ __forceinline__ void phase_combine(const Ctx& c) {
    const Args& a = *c.a;
    const bf16* OG0 = (const bf16*)(c.ws + WS_OG); const bf16* OG1 = OG0 + (size_t)ML * 512; const bf16* Z = (const bf16*)(c.ws + WS_Z);
    bf16* CAT = (bf16*)(c.ws + WS_CAT);
    for (int row = c.gw; row < ML; row += c.NGW) {
#pragma unroll
        for (int h = 0; h < 4; ++h) { const int ch = h * 128 + 2 * c.lane;
            const unsigned w0 = *(const unsigned*)(OG0 + (size_t)row * 512 + ch), w1 = *(const unsigned*)(OG1 + (size_t)row * 512 + ch), zw = *(const unsigned*)(Z + (size_t)row * 512 + ch);
            const float o0 = bflo(w0) + bflo(w1), o1 = bfhi(w0) + bfhi(w1);
            const float r = rsqrtf(wave_sum(o0 * o0 + o1 * o1) * (1.f / 128.f) + EPS);
            const f32x2 ng = *(const f32x2*)(a.in[I_GDNNORM] + 2 * c.lane);
            *(unsigned*)(CAT + (size_t)row * 1024 + 512 + ch) = pk2(o0 * r * ng.x * siluf_(bflo(zw)), o1 * r * ng.y * siluf_(bfhi(zw))); }
    }
}

__device__ __forceinline__ void phase_rows2(const Ctx& c) {
    const Args& a = *c.a;
    const float* MOD = (const float*)(c.ws + WS_MOD); const bf16* YRAW = (const bf16*)(c.ws + WS_YRAW); bf16* HX2 = (bf16*)(c.ws + WS_HX2);
    v2u ny[4]; f32x4 nxx[4];
    if (c.gw < ML) {
#pragma unroll
        for (int j = 0; j < 4; ++j) { ny[j] = *((const v2u*)(YRAW + (size_t)c.gw * D) + c.lane + 64 * j); nxx[j] = *((const f32x4*)(a.in[I_X] + (size_t)c.gw * D) + c.lane + 64 * j); } }
    for (int row = c.gw; row < ML; row += c.NGW) {
        const float* mr = MOD + (row >> 11) * 6144;
        f32x4 y[4], x[4]; float ss = 0.f;
#pragma unroll
        for (int j = 0; j < 4; ++j) { y[j] = (f32x4){bflo(ny[j].x), bfhi(ny[j].x), bflo(ny[j].y), bfhi(ny[j].y)}; x[j] = nxx[j];
            ss += (y[j].x * y[j].x + y[j].y * y[j].y) + (y[j].z * y[j].z + y[j].w * y[j].w); }
        if (row + c.NGW < ML) { const size_t r2 = (size_t)(row + c.NGW);
#pragma unroll
            for (int j = 0; j < 4; ++j) { ny[j] = *((const v2u*)(YRAW + r2 * D) + c.lane + 64 * j); nxx[j] = *((const f32x4*)(a.in[I_X] + r2 * D) + c.lane + 64 * j); } }
        const float r = rsqrtf(wsum(ss) * (1.f / D) + EPS); float s2 = 0.f;
#pragma unroll
        for (int j = 0; j < 4; ++j) { const int col = 4 * c.lane + 256 * j;
            const f32x4 g4 = *(const f32x4*)(a.in[I_GPOSTMIX] + col), gt = *(const f32x4*)(mr + 2048 + col);
            x[j] = x[j] + gt * ((y[j] * r) * g4);
            *(f32x4*)(a.out + (size_t)row * D + col) = x[j];
            s2 += (x[j].x * x[j].x + x[j].y * x[j].y) + (x[j].z * x[j].z + x[j].w * x[j].w); }
        const float r2 = rsqrtf(wsum(s2) * (1.f / D) + EPS);
#pragma unroll
        for (int j = 0; j < 4; ++j) { const int col = 4 * c.lane + 256 * j;
            const f32x4 g4 = *(const f32x4*)(a.in[I_GPREFFN] + col), sh = *(const f32x4*)(mr + 3072 + col), scl = *(const f32x4*)(mr + 4096 + col);
            const f32x4 hv = (x[j] * r2) * g4 * (scl + 1.f) + sh;
            v2u o; o.x = pk2(hv.x, hv.y); o.y = pk2(hv.z, hv.w);
            *(v2u*)(HX2 + (size_t)row * D + col) = o;
            x[j] = (f32x4){bflo(o.x), bfhi(o.x), bflo(o.y), bfhi(o.y)}; }
        { float mx = 0.f;
#pragma unroll
          for (int j = 0; j < 4; ++j) mx = fmaxf(mx, fmaxf(fmaxf(fabsf(x[j].x), fabsf(x[j].y)), fmaxf(fabsf(x[j].z), fabsf(x[j].w))));
          mx = wmax(mx); const float hs = mx > 0.f ? 256.f / mx : 1.f;
          unsigned char* hq = c.ws + WS_HQ8 + (size_t)row * 2048;
#pragma unroll
          for (int j = 0; j < 4; ++j) { const float a0 = x[j].x * hs, a1 = x[j].y * hs, a2 = x[j].z * hs, a3 = x[j].w * hs;
              int w = __builtin_amdgcn_cvt_pk_fp8_f32(a0, a1, 0, false); w = __builtin_amdgcn_cvt_pk_fp8_f32(a2, a3, w, true);
              const f32x2 b01 = __builtin_amdgcn_cvt_pk_f32_fp8(w, false), b23 = __builtin_amdgcn_cvt_pk_f32_fp8(w, true);
              int w2 = __builtin_amdgcn_cvt_pk_fp8_f32((a0 - b01.x) * 16.f, (a1 - b01.y) * 16.f, 0, false); w2 = __builtin_amdgcn_cvt_pk_fp8_f32((a2 - b23.x) * 16.f, (a3 - b23.y) * 16.f, w2, true);
              *(unsigned*)(hq + 4 * c.lane + 256 * j) = (unsigned)w; *(unsigned*)(hq + 1024 + 4 * c.lane + 256 * j) = (unsigned)w2; }
          if (c.lane == 0) ((float*)(c.ws + WS_HS))[row] = 1.f / hs; }
    }
}


constexpr int KROW = 136;
__device__ __forceinline__ float unfkey(unsigned k) { const unsigned u = (k & 0x80000000u) ? (k ^ 0x80000000u) : ~k; return __builtin_bit_cast(float, u); }
__device__ __forceinline__ void ins16(unsigned (&L)[16], unsigned key) {
#pragma unroll
    for (int q = 0; q < 16; ++q) { const unsigned hi = L[q] > key ? L[q] : key, lo = L[q] > key ? key : L[q]; L[q] = hi; key = lo; }
}
__device__ __forceinline__ void sort16_desc(unsigned (&a)[16]) {
#pragma unroll
    for (int kk = 2; kk <= 16; kk <<= 1)
#pragma unroll
        for (int j = kk >> 1; j >= 1; j >>= 1)
#pragma unroll
            for (int i = 0; i < 16; ++i) { const int l = i ^ j; if (l > i) { const unsigned hi = a[i] > a[l] ? a[i] : a[l], lo = a[i] > a[l] ? a[l] : a[i]; if ((i & kk) == 0) { a[i] = hi; a[l] = lo; } else { a[i] = lo; a[l] = hi; } } }
}
__device__ __forceinline__ void top16_of_two(unsigned (&A)[16], const unsigned (&B)[16]) {
#pragma unroll
    for (int q = 0; q < 16; ++q) A[q] = A[q] > B[15 - q] ? A[q] : B[15 - q];
#pragma unroll
    for (int j = 8; j >= 1; j >>= 1)
#pragma unroll
        for (int q = 0; q < 16; ++q) if ((q & j) == 0) { const unsigned hi = A[q] > A[q + j] ? A[q] : A[q + j], lo = A[q] > A[q + j] ? A[q + j] : A[q]; A[q] = hi; A[q + j] = lo; }
}
__device__ __forceinline__ void merge16(unsigned (&L)[16]) {
    unsigned R[16];
#pragma unroll
    for (int q = 0; q < 16; ++q) R[q] = (unsigned)__shfl_xor((int)L[15 - q], 32);
#pragma unroll
    for (int q = 0; q < 16; ++q) L[q] = L[q] > R[q] ? L[q] : R[q];
#pragma unroll
    for (int j = 8; j >= 1; j >>= 1)
#pragma unroll
        for (int q = 0; q < 16; ++q) if ((q & j) == 0) { const unsigned hi = L[q] > L[q + j] ? L[q] : L[q + j], lo = L[q] > L[q + j] ? L[q + j] : L[q]; L[q] = hi; L[q + j] = lo; }
}
__device__ __forceinline__ void phase_topk(const Ctx& c) {
    const Args& a = *c.a;
    bf16* kl = (bf16*)c.lds;
    unsigned char* wtab = c.lds + 2 * 128 * KROW * 2 + c.wave * 1088;
    const bf16* QP = (const bf16*)(c.ws + WS_QP); int* IDX = (int*)(c.ws + WS_IDX); float* GATE = (float*)(c.ws + WS_GATE);
    const int r = c.lane & 31, hh = c.lane >> 5;
    { const unsigned char ptab[50] = {0, 1, 2, 3, 4, 5, 6, 7, 8, 9, 10, 11, 12, 13, 14, 15, 16, 17, 18, 19, 20, 21, 22, 23, 32, 33, 34, 35, 36, 48, 49, 50, 51, 64, 65, 66, 80, 81, 96, 97, 112, 113, 128, 144, 160, 176, 192, 208, 224, 240};
      if (c.lane < 50) wtab[1024 + c.lane] = ptab[c.lane < 50 ? c.lane : 0]; }
    for (int item = c.bid; item < 8 * 32; item += c.G) {
        const int h = item & 7, tr = item >> 3;
        __syncthreads();
        for (int i = c.tid; i < 2 * 128 * 64; i += NTHREADS) { const int k2 = i & 63, n = (i >> 6) & 127, p = i >> 13; const f32x2 kv = *(const f32x2*)(a.in[I_KEYS] + ((size_t)((h * 2 + p) * 128 + n)) * 128 + 2 * k2);
            *(unsigned*)(kl + (p * 128 + n) * KROW + 2 * k2) = pk2(kv.x, kv.y); }
        __syncthreads();
        for (int tile = c.wave; tile < 16; tile += NWAVES) {
            const int tok = tr * 512 + tile * 32 + r;
            unsigned LA[16], LB[16];
#pragma unroll
            for (int p = 0; p < 2; ++p) {
                bf16x8 qf[8];
#pragma unroll
                for (int kk = 0; kk < 8; ++kk) qf[kk] = *(const bf16x8*)(QP + (size_t)tok * 2048 + h * 256 + p * 128 + kk * 16 + hh * 8);
                f32x16 acc[4];
#pragma unroll
                for (int nt = 0; nt < 4; ++nt)
#pragma unroll
                    for (int i = 0; i < 16; ++i) acc[nt][i] = 0.f;
#pragma unroll
                for (int kk = 0; kk < 8; ++kk)
#pragma unroll
                    for (int nt = 0; nt < 4; ++nt) acc[nt] = MFMA32(*(const bf16x8*)(kl + (p * 128 + nt * 32 + r) * KROW + kk * 16 + hh * 8), qf[kk], acc[nt]);
                unsigned (&L)[16] = p ? LB : LA;
                unsigned G1[16], G2[16], G3[16];
#pragma unroll
                for (int i = 0; i < 16; ++i) { const int n0 = (i & 3) + 8 * (i >> 2) + 4 * hh;
                    L[i] = (fkey(acc[0][i]) & ~127u) | (unsigned)(127 - n0); G1[i] = (fkey(acc[1][i]) & ~127u) | (unsigned)(127 - (32 + n0));
                    G2[i] = (fkey(acc[2][i]) & ~127u) | (unsigned)(127 - (64 + n0)); G3[i] = (fkey(acc[3][i]) & ~127u) | (unsigned)(127 - (96 + n0)); }
                sort16_desc(L); sort16_desc(G1); sort16_desc(G2); sort16_desc(G3);
                top16_of_two(L, G1); top16_of_two(G2, G3); top16_of_two(L, G2);
                merge16(L);
            }
            unsigned char* tt = wtab + r * 32;
            if (hh == 0) {
#pragma unroll
                for (int q = 0; q < 16; ++q) tt[q] = (unsigned char)(127u - (LA[q] & 127u)); }
            else {
#pragma unroll
                for (int q = 0; q < 16; ++q) tt[16 + q] = (unsigned char)(127u - (LB[q] & 127u)); }
            float va[16], vb[16];
#pragma unroll
            for (int q = 0; q < 16; ++q) { va[q] = unfkey(LA[q] & ~127u); vb[q] = unfkey(LB[q] & ~127u); }
            unsigned LC[16];
#pragma unroll
            for (int q = 0; q < 16; ++q) LC[q] = 0u;
            { const float s0 = va[0] + vb[0], s1 = va[0] + vb[1]; ins16(LC, (fkey(hh ? s1 : s0) & ~63u) | (unsigned)(63 - (0 + hh))); }
            { const float s0 = va[0] + vb[2], s1 = va[0] + vb[3]; ins16(LC, (fkey(hh ? s1 : s0) & ~63u) | (unsigned)(63 - (2 + hh))); }
            { const float s0 = va[0] + vb[4], s1 = va[0] + vb[5]; ins16(LC, (fkey(hh ? s1 : s0) & ~63u) | (unsigned)(63 - (4 + hh))); }
            { const float s0 = va[0] + vb[6], s1 = va[0] + vb[7]; ins16(LC, (fkey(hh ? s1 : s0) & ~63u) | (unsigned)(63 - (6 + hh))); }
            { const float s0 = va[0] + vb[8], s1 = va[0] + vb[9]; ins16(LC, (fkey(hh ? s1 : s0) & ~63u) | (unsigned)(63 - (8 + hh))); }
            { const float s0 = va[0] + vb[10], s1 = va[0] + vb[11]; ins16(LC, (fkey(hh ? s1 : s0) & ~63u) | (unsigned)(63 - (10 + hh))); }
            { const float s0 = va[0] + vb[12], s1 = va[0] + vb[13]; ins16(LC, (fkey(hh ? s1 : s0) & ~63u) | (unsigned)(63 - (12 + hh))); }
            { const float s0 = va[0] + vb[14], s1 = va[0] + vb[15]; ins16(LC, (fkey(hh ? s1 : s0) & ~63u) | (unsigned)(63 - (14 + hh))); }
            { const float s0 = va[1] + vb[0], s1 = va[1] + vb[1]; ins16(LC, (fkey(hh ? s1 : s0) & ~63u) | (unsigned)(63 - (16 + hh))); }
            { const float s0 = va[1] + vb[2], s1 = va[1] + vb[3]; ins16(LC, (fkey(hh ? s1 : s0) & ~63u) | (unsigned)(63 - (18 + hh))); }
            { const float s0 = va[1] + vb[4], s1 = va[1] + vb[5]; ins16(LC, (fkey(hh ? s1 : s0) & ~63u) | (unsigned)(63 - (20 + hh))); }
            { const float s0 = va[1] + vb[6], s1 = va[1] + vb[7]; ins16(LC, (fkey(hh ? s1 : s0) & ~63u) | (unsigned)(63 - (22 + hh))); }
            { const float s0 = va[2] + vb[0], s1 = va[2] + vb[1]; ins16(LC, (fkey(hh ? s1 : s0) & ~63u) | (unsigned)(63 - (24 + hh))); }
            { const float s0 = va[2] + vb[2], s1 = va[2] + vb[3]; ins16(LC, (fkey(hh ? s1 : s0) & ~63u) | (unsigned)(63 - (26 + hh))); }
            { const float s0 = va[2] + vb[4], s1 = va[3] + vb[0]; ins16(LC, (fkey(hh ? s1 : s0) & ~63u) | (unsigned)(63 - (28 + hh))); }
            { const float s0 = va[3] + vb[1], s1 = va[3] + vb[2]; ins16(LC, (fkey(hh ? s1 : s0) & ~63u) | (unsigned)(63 - (30 + hh))); }
            { const float s0 = va[3] + vb[3], s1 = va[4] + vb[0]; ins16(LC, (fkey(hh ? s1 : s0) & ~63u) | (unsigned)(63 - (32 + hh))); }
            { const float s0 = va[4] + vb[1], s1 = va[4] + vb[2]; ins16(LC, (fkey(hh ? s1 : s0) & ~63u) | (unsigned)(63 - (34 + hh))); }
            { const float s0 = va[5] + vb[0], s1 = va[5] + vb[1]; ins16(LC, (fkey(hh ? s1 : s0) & ~63u) | (unsigned)(63 - (36 + hh))); }
            { const float s0 = va[6] + vb[0], s1 = va[6] + vb[1]; ins16(LC, (fkey(hh ? s1 : s0) & ~63u) | (unsigned)(63 - (38 + hh))); }
            { const float s0 = va[7] + vb[0], s1 = va[7] + vb[1]; ins16(LC, (fkey(hh ? s1 : s0) & ~63u) | (unsigned)(63 - (40 + hh))); }
            { const float s0 = va[8] + vb[0], s1 = va[9] + vb[0]; ins16(LC, (fkey(hh ? s1 : s0) & ~63u) | (unsigned)(63 - (42 + hh))); }
            { const float s0 = va[10] + vb[0], s1 = va[11] + vb[0]; ins16(LC, (fkey(hh ? s1 : s0) & ~63u) | (unsigned)(63 - (44 + hh))); }
            { const float s0 = va[12] + vb[0], s1 = va[13] + vb[0]; ins16(LC, (fkey(hh ? s1 : s0) & ~63u) | (unsigned)(63 - (46 + hh))); }
            { const float s0 = va[14] + vb[0], s1 = va[15] + vb[0]; ins16(LC, (fkey(hh ? s1 : s0) & ~63u) | (unsigned)(63 - (48 + hh))); }
            merge16(LC);
            WAVE_LDS_SYNC();
            float ev[16]; float den = 0.f; const float mx = unfkey(LC[0] & ~63u);
#pragma unroll
            for (int q = 0; q < 16; ++q) { ev[q] = __expf(unfkey(LC[q] & ~63u) - mx); den += ev[q]; }
            const float inv = 1.f / den;
            if (hh == 0) { int ex[16];
#pragma unroll
                for (int q = 0; q < 16; ++q) { const unsigned pc = wtab[1024 + (63u - (LC[q] & 63u))]; ex[q] = (int)tt[pc >> 4] * 128 + (int)tt[16 + (pc & 15u)]; }
#pragma unroll
                for (int q = 0; q < 4; ++q) *(v4u*)(IDX + (size_t)tok * 128 + h * 16 + 4 * q) = (v4u){(unsigned)ex[4 * q], (unsigned)ex[4 * q + 1], (unsigned)ex[4 * q + 2], (unsigned)ex[4 * q + 3]}; }
            else {
#pragma unroll
                for (int q = 0; q < 4; ++q) *(f32x4*)(GATE + (size_t)tok * 128 + h * 16 + 4 * q) = (f32x4){ev[4 * q] * inv, ev[4 * q + 1] * inv, ev[4 * q + 2] * inv, ev[4 * q + 3] * inv}; }
            WAVE_LDS_SYNC();
        }
    }
}

__device__ __forceinline__ void phase_fp8_tables(const Ctx& c) {
    const Args& a = *c.a;
    for (int r = c.gw; r < 2 * NEXP; r += c.NGW) {
        const bool isv = r >= NEXP; const int e = isv ? r - NEXP : r;
        const f32x4* src = (const f32x4*)((isv ? a.in[I_PV] : a.in[I_PU]) + (size_t)e * D) + c.lane;
        f32x4 v[4]; float m = 0.f;
#pragma unroll
        for (int j = 0; j < 4; ++j) { v[j] = src[64 * j]; m = fmaxf(m, fmaxf(fmaxf(fabsf(v[j].x), fabsf(v[j].y)), fmaxf(fabsf(v[j].z), fabsf(v[j].w)))); }
        m = wmax(m); const float inv = m > 0.f ? 256.f / m : 0.f;
        unsigned char* dst = c.ws + (isv ? WS_V8 : WS_U8) + (size_t)e * D + 4 * c.lane;
#pragma unroll
        for (int j = 0; j < 4; ++j) { int w = __builtin_amdgcn_cvt_pk_fp8_f32(v[j].x * inv, v[j].y * inv, 0, false); w = __builtin_amdgcn_cvt_pk_fp8_f32(v[j].z * inv, v[j].w * inv, w, true); *(unsigned*)(dst + 256 * j) = (unsigned)w; }
        if (c.lane == 0) ((float*)(c.ws + (isv ? WS_VSC : WS_USC)))[e] = m * (1.f / 256.f);
    }
}
__device__ __forceinline__ void fp8x16_to_f32(const v4u& r, float (&f)[16]) {
    const unsigned w[4] = {r.x, r.y, r.z, r.w};
#pragma unroll
    for (int j = 0; j < 4; ++j) { const f32x2 lo = __builtin_amdgcn_cvt_pk_f32_fp8((int)w[j], false), hi = __builtin_amdgcn_cvt_pk_f32_fp8((int)w[j], true); f[4 * j] = lo.x; f[4 * j + 1] = lo.y; f[4 * j + 2] = hi.x; f[4 * j + 3] = hi.y; }
}
__device__ __forceinline__ unsigned xcc_id() { return (unsigned)__builtin_amdgcn_s_getreg((3 << 11) | 20) & 7u; }

typedef long l64x2 __attribute__((ext_vector_type(2)));
struct E1Bat { l64x2 rw[16]; };
__device__ __forceinline__ void phase_exp1(const Ctx& c) {
    typedef float f32x4m __attribute__((ext_vector_type(4)));
    const int* IDX = (const int*)(c.ws + WS_IDX); const unsigned char* U8 = c.ws + WS_U8; float* PACT = (float*)(c.ws + WS_PACT);
    unsigned* cnt = (unsigned*)(c.ws + WS_CTL) + CW_E1;
    constexpr int CH = 8;
    constexpr int SROW = 144;
    unsigned char* wl = c.lds + c.wave * 11776; int* le = (int*)wl; unsigned char* himg = wl + 4096; float* res = (float*)(wl + 6144); unsigned char* stage = wl + 6656;
    const int xcc = (int)xcc_id(), r16 = c.lane & 15, g4 = c.lane >> 4, row8 = c.lane >> 3, pc8 = c.lane & 7; const bool bcol = r16 < 2;
    int bo = 0; unsigned tq = 0;
    if (c.lane == 0) tq = __hip_atomic_fetch_add(cnt + 64 * (xcc & 7), (unsigned)CH, __ATOMIC_RELAXED, __HIP_MEMORY_SCOPE_AGENT);
    for (;;) {
        const int x = (xcc + bo) & 7;
        const unsigned t0 = (unsigned)__builtin_amdgcn_readfirstlane((int)tq);
        if (t0 >= (unsigned)ML) { if (++bo >= 8) break; tq = 0; if (c.lane == 0) tq = __hip_atomic_fetch_add(cnt + 64 * ((xcc + bo) & 7), (unsigned)CH, __ATOMIC_RELAXED, __HIP_MEMORY_SCOPE_AGENT); continue; }
        tq = 0; if (c.lane == 0) tq = __hip_atomic_fetch_add(cnt + 64 * x, (unsigned)CH, __ATOMIC_RELAXED, __HIP_MEMORY_SCOPE_AGENT);
        { v4u ee[4], im[2];
#pragma unroll
          for (int q = 0; q < 4; ++q) ee[q] = *(const v4u*)(IDX + (size_t)t0 * 128 + 256 * q + 4 * c.lane);
#pragma unroll
          for (int q = 0; q < 2; ++q) { const int p = c.lane + 64 * q; im[q] = *(const v4u*)(c.ws + WS_HQ8 + ((size_t)t0 + (p >> 4)) * 2048 + ((p >> 3) & 1) * 1024 + 128 * x + 16 * (p & 7)); }
#pragma unroll
          for (int q = 0; q < 4; ++q) *(v4u*)(le + 256 * q + 4 * c.lane) = ee[q];
#pragma unroll
          for (int q = 0; q < 2; ++q) *(v4u*)(himg + 16 * (c.lane + 64 * q)) = im[q]; }
        WAVE_LDS_SYNC();
#define E1_LOAD(G, B) do { const int bb = (B) < CH ? (B) : 0; _Pragma("unroll") for (int i = 0; i < 16; ++i) G.rw[i] = *(const l64x2*)(U8 + (size_t)le[bb * 128 + 8 * i + row8] * D + 128 * x + 16 * pc8); } while (0)
#define E1_COMP(G, B) do { const unsigned char* hb = himg + ((B) * 2 + (r16 & 1)) * 128 + 32 * g4; long bq[4]; _Pragma("unroll") for (int m = 0; m < 4; ++m) { const long v = *(const long*)(hb + 8 * m); bq[m] = bcol ? v : 0l; } \
            _Pragma("unroll") for (int gi = 0; gi < 8; ++gi) { unsigned char* sb = stage + (gi & 1) * (16 * SROW); \
                *(l64x2*)(sb + row8 * SROW + 16 * pc8) = G.rw[2 * gi]; *(l64x2*)(sb + (8 + row8) * SROW + 16 * pc8) = G.rw[2 * gi + 1]; \
                WAVE_LDS_SYNC(); \
                const l64x2 a01 = *(const l64x2*)(sb + r16 * SROW + 32 * g4), a23 = *(const l64x2*)(sb + r16 * SROW + 32 * g4 + 16); \
                f32x4m acc = {0.f, 0.f, 0.f, 0.f}; \
                acc = __builtin_amdgcn_mfma_f32_16x16x32_fp8_fp8(a01.x, bq[0], acc, 0, 0, 0); acc = __builtin_amdgcn_mfma_f32_16x16x32_fp8_fp8(a01.y, bq[1], acc, 0, 0, 0); \
                acc = __builtin_amdgcn_mfma_f32_16x16x32_fp8_fp8(a23.x, bq[2], acc, 0, 0, 0); acc = __builtin_amdgcn_mfma_f32_16x16x32_fp8_fp8(a23.y, bq[3], acc, 0, 0, 0); \
                _Pragma("unroll") for (int q = 0; q < 4; ++q) { const float lo = dppf<0xB1>(acc[q]); if (r16 == 0) res[gi * 16 + 4 * g4 + q] = acc[q] + lo * 0.0625f; } } \
            WAVE_LDS_SYNC(); \
            { float* po = PACT + (size_t)x * ((size_t)ML * 128) + ((size_t)t0 + (B)) * 128; po[c.lane] = res[c.lane]; po[64 + c.lane] = res[64 + c.lane]; } \
            WAVE_LDS_SYNC(); } while (0)
        E1Bat ga, gb;
        E1_LOAD(ga, 0);
#pragma unroll 1
        for (int b2 = 0; b2 < CH; b2 += 2) {
            E1_LOAD(gb, b2 + 1);
            __builtin_amdgcn_sched_barrier(0);
            E1_COMP(ga, b2);
            __builtin_amdgcn_sched_barrier(0);
            E1_LOAD(ga, b2 + 2);
            __builtin_amdgcn_sched_barrier(0);
            E1_COMP(gb, b2 + 1);
            __builtin_amdgcn_sched_barrier(0);
        }
#undef E1_LOAD
#undef E1_COMP
    }
}
__device__ __forceinline__ void phase_exp1b(const Ctx& c) {
    const int* IDX = (const int*)(c.ws + WS_IDX); const float* GATE = (const float*)(c.ws + WS_GATE); const float* HS = (const float*)(c.ws + WS_HS); const float* PACT = (const float*)(c.ws + WS_PACT);
    const float* USC = (const float*)(c.ws + WS_USC); const float* VSC = (const float*)(c.ws + WS_VSC); float* ACT = (float*)(c.ws + WS_ACT);
    for (size_t i = (size_t)c.bid * NTHREADS + c.tid; i < (size_t)ML * 128; i += (size_t)c.G * NTHREADS) {
        float s = 0.f;
#pragma unroll
        for (int x = 0; x < 8; ++x) s += PACT[(size_t)x * ((size_t)ML * 128) + i];
        const int e = IDX[i];
        ACT[i] = gelu_erf(s * HS[i >> 7] * USC[e]) * GATE[i] * VSC[e];
    }
}
__device__ __forceinline__ void phase_exp2(const Ctx& c) {
    const int* IDX = (const int*)(c.ws + WS_IDX); const float* ACT = (const float*)(c.ws + WS_ACT); const unsigned char* V8 = c.ws + WS_V8;
    bf16* Y = (bf16*)(c.ws + WS_Y); float* SSQP = (float*)(c.ws + WS_SSQP);
    unsigned* cnt = (unsigned*)(c.ws + WS_CTL) + CW_E2;
    int* li = (int*)(c.lds + c.wave * 1024); float* la = (float*)(li + 128);
    const int xcc = (int)xcc_id(), sub = c.lane & 7, grp = c.lane >> 3;
    const bool b5 = c.lane & 32, b4 = c.lane & 16, b3 = c.lane & 8;
    constexpr int CH = 8;
    int bo = 0, t = 0, tend = 0;
    int iA = 0, iB = 0; float aA = 0.f, aB = 0.f;
    unsigned tq = 0; if (c.lane == 0) tq = __hip_atomic_fetch_add(cnt + 64 * (xcc & 7), (unsigned)CH, __ATOMIC_RELAXED, __HIP_MEMORY_SCOPE_AGENT);
    for (;;) {
        if (t >= tend) {
            const unsigned t0 = (unsigned)__builtin_amdgcn_readfirstlane((int)tq);
            if (t0 >= (unsigned)ML) { if (++bo >= 8) break; tq = 0; if (c.lane == 0) tq = __hip_atomic_fetch_add(cnt + 64 * ((xcc + bo) & 7), (unsigned)CH, __ATOMIC_RELAXED, __HIP_MEMORY_SCOPE_AGENT); continue; }
            tq = 0; if (c.lane == 0) tq = __hip_atomic_fetch_add(cnt + 64 * ((xcc + bo) & 7), (unsigned)CH, __ATOMIC_RELAXED, __HIP_MEMORY_SCOPE_AGENT);
            t = (int)t0; tend = t + CH;
            iA = IDX[(size_t)t * 128 + c.lane]; iB = IDX[(size_t)t * 128 + 64 + c.lane]; aA = ACT[(size_t)t * 128 + c.lane]; aB = ACT[(size_t)t * 128 + 64 + c.lane];
        }
        const int x = (xcc + bo) & 7;
        li[c.lane] = iA; li[64 + c.lane] = iB; la[c.lane] = aA; la[64 + c.lane] = aB;
        if (t + 1 < tend) { iA = IDX[(size_t)(t + 1) * 128 + c.lane]; iB = IDX[(size_t)(t + 1) * 128 + 64 + c.lane]; aA = ACT[(size_t)(t + 1) * 128 + c.lane]; aB = ACT[(size_t)(t + 1) * 128 + 64 + c.lane]; }
        WAVE_LDS_SYNC();
        float acc[16];
#pragma unroll
        for (int q = 0; q < 16; ++q) acc[q] = 0.f;
#pragma unroll
        for (int hf = 0; hf < 2; ++hf) { v4u rows[8]; float av[8];
#pragma unroll
            for (int i = 0; i < 8; ++i) { const int k = 8 * (8 * hf + i) + grp; rows[i] = *(const v4u*)(V8 + (size_t)li[k] * D + x * 128 + 16 * sub); av[i] = la[k]; }
#pragma unroll
            for (int i = 0; i < 8; ++i) { float f[16]; fp8x16_to_f32(rows[i], f);
#pragma unroll
                for (int q = 0; q < 16; ++q) acc[q] = fmaf(av[i], f[q], acc[q]); } }
        float q8[8], q4[4], q2[2];
#pragma unroll
        for (int i = 0; i < 8; ++i) { const float keep = b5 ? acc[i + 8] : acc[i], send = b5 ? acc[i] : acc[i + 8]; q8[i] = keep + __shfl_xor(send, 32); }
#pragma unroll
        for (int i = 0; i < 4; ++i) { const float keep = b4 ? q8[i + 4] : q8[i], send = b4 ? q8[i] : q8[i + 4]; q4[i] = keep + __shfl_xor(send, 16); }
#pragma unroll
        for (int i = 0; i < 2; ++i) { const float keep = b3 ? q4[i + 2] : q4[i], send = b3 ? q4[i] : q4[i + 2]; q2[i] = keep + __shfl_xor(send, 8); }
        const int col = x * 128 + 16 * sub + (b5 ? 8 : 0) + (b4 ? 4 : 0) + (b3 ? 2 : 0);
        *(unsigned*)(Y + (size_t)t * D + col) = pk2(q2[0], q2[1]);
        const float ss = wsum(q2[0] * q2[0] + q2[1] * q2[1]);
        SSQP[(size_t)x * ML + t] = ss;
        WAVE_LDS_SYNC();
        ++t;
    }
}
__device__ __forceinline__ void phase_exp3(const Ctx& c) {
    const Args& a = *c.a;
    const float* MOD = (const float*)(c.ws + WS_MOD); const bf16* Y = (const bf16*)(c.ws + WS_Y); const float* SSQP = (const float*)(c.ws + WS_SSQP);
    v2u ny[4]; f32x4 nx[4]; float nss = 0.f;
#define E3_LOAD(R) do { _Pragma("unroll") for (int j = 0; j < 4; ++j) { const int col = 4 * c.lane + 256 * j; ny[j] = *(const v2u*)(Y + (size_t)(R) * D + col); nx[j] = *(const f32x4*)(a.out + (size_t)(R) * D + col); } \
        nss = (c.lane < 8) ? SSQP[(size_t)c.lane * ML + (R)] : 0.f; } while (0)
    if (c.gw < ML) E3_LOAD(c.gw);
    for (int row = c.gw; row < ML; row += c.NGW) {
        f32x4 y[4], x1[4];
#pragma unroll
        for (int j = 0; j < 4; ++j) { y[j] = (f32x4){bflo(ny[j].x), bfhi(ny[j].x), bflo(ny[j].y), bfhi(ny[j].y)}; x1[j] = nx[j]; }
        const float ss = row_sum16(nss);
        const float tot = __builtin_bit_cast(float, __builtin_amdgcn_readlane(__builtin_bit_cast(int, ss), 0));
        if (row + c.NGW < ML) E3_LOAD(row + c.NGW);
        const float r = rsqrtf(tot * (1.f / D) + EPS); const float* mr = MOD + (row >> 11) * 6144 + 5120;
#pragma unroll
        for (int j = 0; j < 4; ++j) { const int col = 4 * c.lane + 256 * j;
            const f32x4 g4 = *(const f32x4*)(a.in[I_GPOSTFFN] + col), gt = *(const f32x4*)(mr + col);
            *(f32x4*)(a.out + (size_t)row * D + col) = x1[j] + gt * ((y[j] * r) * g4); }
    }
#undef E3_LOAD
}

constexpr int S5_LPOW = 0, S5_BBAR = 33792, S5_CC = 50176, S5_MM = 66560;
__device__ __forceinline__ void s5_build_group(const Ctx& c, int g, int part) {
    const Args& a = *c.a;
    f32x2* LPOW = (f32x2*)(c.lds + S5_LPOW);
    f32x2* BBAR = (f32x2*)(c.lds + S5_BBAR);
    f32x2* CC = (f32x2*)(c.lds + S5_CC);
    float* MM = (float*)(c.lds + S5_MM);
    __syncthreads();
    if (c.tid < 128) { const int dir = c.tid >> 6, p = c.tid & 63, dg = dir * 32 + g;
        const float dt = expf(a.in[I_LOGDT][dg]), lr = a.in[I_LAMRE][dg * 64 + p], li = a.in[I_LAMIM][dg * 64 + p];
        const double ang = (double)li * (double)dt; const float lrdt = lr * dt;
        for (int e = 0; e <= 32; ++e) { float sn, cs; sincos_d(ang * (double)e, sn, cs); const float mg = expf(lrdt * (float)e); LPOW[(dir * 33 + e) * 64 + p] = (f32x2){mg * cs, mg * sn}; }
        float sn, cs; sincos_d(ang, sn, cs); const float mag = expf(lrdt), lbr = mag * cs, lbi = mag * sn, den = lr * lr + li * li, nr = lbr - 1.f;
        const float cr = (nr * lr + lbi * li) / den, ci = (lbi * lr - nr * li) / den;
        for (int ch = 0; ch < 16; ++ch) { const float br = a.in[I_BRE][(size_t)(dg * 64 + p) * 16 + ch], bi = a.in[I_BIM][(size_t)(dg * 64 + p) * 16 + ch]; BBAR[(dir * 64 + p) * 16 + ch] = (f32x2){cr * br - ci * bi, cr * bi + ci * br}; } }
    for (int i = c.tid; i < 2048; i += NTHREADS) { const int dir = i >> 10, ch = (i >> 6) & 15, p = i & 63, dg = dir * 32 + g; CC[i] = (f32x2){a.in[I_CRE][(size_t)(dg * 16 + ch) * 64 + p], a.in[I_CIM][(size_t)(dg * 16 + ch) * 64 + p]}; }
    __syncthreads();
    for (int task = c.tid; task < 1024; task += NTHREADS) { const int cpb = task & 3, cb = (task >> 2) & 3, lag = (task >> 4) & 31, dir = task >> 9;
        float acc[4][4];
#pragma unroll
        for (int i = 0; i < 4; ++i)
#pragma unroll
            for (int j = 0; j < 4; ++j) acc[i][j] = 0.f;
        for (int p = 0; p < 64; ++p) { const f32x2 l = LPOW[(dir * 33 + lag) * 64 + p]; f32x2 G[4], Cw[4];
#pragma unroll
            for (int j = 0; j < 4; ++j) { const f32x2 bb = BBAR[(dir * 64 + p) * 16 + 4 * cpb + j]; G[j] = (f32x2){l.x * bb.x - l.y * bb.y, l.x * bb.y + l.y * bb.x}; }
#pragma unroll
            for (int i = 0; i < 4; ++i) Cw[i] = CC[(dir * 16 + 4 * cb + i) * 64 + p];
#pragma unroll
            for (int i = 0; i < 4; ++i)
#pragma unroll
                for (int j = 0; j < 4; ++j) acc[i][j] += Cw[i].x * G[j].x - Cw[i].y * G[j].y; }
#pragma unroll
        for (int i = 0; i < 4; ++i)
#pragma unroll
            for (int j = 0; j < 4; ++j) MM[((dir * 32 + lag) * 16 + 4 * cb + i) * 16 + 4 * cpb + j] = acc[i][j]; }
    __syncthreads();
    if (c.tid < 128 && part == 0) { const int dir = c.tid >> 6, p = c.tid & 63; ((f32x2*)(c.ws + WS_LP))[(dir * 32 + g) * 64 + p] = LPOW[(dir * 33 + 32) * 64 + p]; }
    bf16* PMg = (bf16*)(c.ws + WS_PM) + (size_t)g * 256 * 512; bf16* BBg = (bf16*)(c.ws + WS_BB) + (size_t)g * 512 * 768;
    for (int task = part * 64 * 32 + c.tid; task < (part + 1) * 64 * 32; task += NTHREADS) { const int ip = task & 31, n = task >> 5, dir = n >> 7, im = (n >> 6) & 1, p = n & 63, e = dir ? ip : 31 - ip;
        const f32x2 l = LPOW[(dir * 33 + e) * 64 + p]; float o[16];
#pragma unroll
        for (int ch = 0; ch < 16; ++ch) { const f32x2 bb = BBAR[(dir * 64 + p) * 16 + ch]; o[ch] = im ? (l.x * bb.y + l.y * bb.x) : (l.x * bb.x - l.y * bb.y); }
        v4u w0, w1; w0.x = pk2(o[0], o[1]); w0.y = pk2(o[2], o[3]); w0.z = pk2(o[4], o[5]); w0.w = pk2(o[6], o[7]); w1.x = pk2(o[8], o[9]); w1.y = pk2(o[10], o[11]); w1.z = pk2(o[12], o[13]); w1.w = pk2(o[14], o[15]);
        *(v4u*)(PMg + (size_t)n * 512 + ip * 16) = w0; *(v4u*)(PMg + (size_t)n * 512 + ip * 16 + 8) = w1; }
    for (int task = part * 128 * 32 + c.tid; task < (part + 1) * 128 * 32; task += NTHREADS) { const int ip = task & 31, n = task >> 5, i = n >> 4, ch = n & 15; float o[16];
#pragma unroll
        for (int q = 0; q < 16; ++q) o[q] = 0.f;
        if (ip <= i) { const float* m0 = MM + ((0 * 32 + (i - ip)) * 16 + ch) * 16;
#pragma unroll
            for (int q = 0; q < 16; ++q) o[q] += m0[q]; }
        if (ip >= i) { const float* m1 = MM + ((1 * 32 + (ip - i)) * 16 + ch) * 16;
#pragma unroll
            for (int q = 0; q < 16; ++q) o[q] += m1[q]; }
        if (ip == i) { const float dsk = a.in[I_S5D][g * 16 + ch];
#pragma unroll
            for (int q = 0; q < 16; ++q) o[q] += (q == ch) ? dsk : 0.f; }
        v4u w0, w1; w0.x = pk2(o[0], o[1]); w0.y = pk2(o[2], o[3]); w0.z = pk2(o[4], o[5]); w0.w = pk2(o[6], o[7]); w1.x = pk2(o[8], o[9]); w1.y = pk2(o[10], o[11]); w1.z = pk2(o[12], o[13]); w1.w = pk2(o[14], o[15]);
        *(v4u*)(BBg + (size_t)n * 768 + ip * 16) = w0; *(v4u*)(BBg + (size_t)n * 768 + ip * 16 + 8) = w1; }
    for (int task = part * 128 * 32 + c.tid; task < (part + 1) * 128 * 32; task += NTHREADS) { const int p8 = task & 7, part = (task >> 3) & 3, n = task >> 5, i = n >> 4, ch = n & 15, dir = part >> 1, im = part & 1, e = dir ? 32 - i : i + 1; float o[8];
#pragma unroll
        for (int q = 0; q < 8; ++q) { const int p = p8 * 8 + q; const f32x2 l = LPOW[(dir * 33 + e) * 64 + p], cc = CC[(dir * 16 + ch) * 64 + p]; o[q] = im ? -(cc.x * l.y + cc.y * l.x) : (cc.x * l.x - cc.y * l.y); }
        v4u w0; w0.x = pk2(o[0], o[1]); w0.y = pk2(o[2], o[3]); w0.z = pk2(o[4], o[5]); w0.w = pk2(o[6], o[7]);
        *(v4u*)(BBg + (size_t)n * 768 + 512 + part * 64 + p8 * 8) = w0; }
}
__device__ __forceinline__ void s5_state_scan(const Ctx& c, int task) {
    const int dir = task & 1, g = (task >> 1) & 31, b = task >> 6, p = c.lane;
    const f32x2 a = ((const f32x2*)(c.ws + WS_LP))[(dir * 32 + g) * 64 + p];
    const float* SS = (const float*)(c.ws + WS_SS) + (size_t)g * 768 * 256 + dir * 128 + p; bf16* U5 = (bf16*)(c.ws + WS_U5) + (size_t)g * 768 * 768 + 512 + dir * 128 + p;
    float er = 0.f, ei = 0.f;
#pragma unroll 24
    for (int step = 0; step < 72; ++step) {
        const int R = (step < 8) ? 512 + b * 8 + (dir ? 7 - step : step) : b * 64 + (dir ? 71 - step : step - 8);
        if (step >= 8) { U5[(size_t)R * 768] = (bf16)f2bf(er); U5[(size_t)R * 768 + 64] = (bf16)f2bf(ei); }
        const float sr = SS[(size_t)R * 256], si = SS[(size_t)R * 256 + 64];
        const float nr = sr + a.x * er - a.y * ei, ni = si + a.x * ei + a.y * er; er = nr; ei = ni;
    }
}

constexpr int GDN_NCH = 36, GDN_ITEMS = NB * 4 * 2 * GDN_NCH;
constexpr size_t FR_T_BYTES = 8192, FR_ATT_BYTES = 8192, FR_KD_BYTES = 16384, FR_TAB_BYTES = 1024;
__device__ __forceinline__ int crow16(int i, int hh) { return (i & 3) + 8 * (i >> 2) + 4 * hh; }
__device__ __forceinline__ bf16x8 pack_step(const f32x16& x, int s) {
    v4u w; w.x = pk2(x[8 * s + 0], x[8 * s + 1]); w.y = pk2(x[8 * s + 2], x[8 * s + 3]); w.z = pk2(x[8 * s + 4], x[8 * s + 5]); w.w = pk2(x[8 * s + 6], x[8 * s + 7]);
    return __builtin_bit_cast(bf16x8, w);
}
__device__ __forceinline__ unsigned pk2v(float lo, float hi) { asm volatile("" : "+v"(lo), "+v"(hi)); return pk2(lo, hi); }
__device__ __forceinline__ bf16x8 pack_step_v(const f32x16& x, int s) {
    v4u w; w.x = pk2v(x[8 * s + 0], x[8 * s + 1]); w.y = pk2v(x[8 * s + 2], x[8 * s + 3]); w.z = pk2v(x[8 * s + 4], x[8 * s + 5]); w.w = pk2v(x[8 * s + 6], x[8 * s + 7]);
    return __builtin_bit_cast(bf16x8, w);
}
constexpr int GP_KR = 0, GP_QR = 17408, GP_KT = 34816, GP_TAB = 53248, GP_LP = 54272, GP_LPB = 8448 + 256;
__host__ __device__ constexpr int LOFF(int i) { return i < 1 ? 0 : 4 * (((i - 1) >> 2) + 1) * (2 * ((i - 1) >> 2) + ((i - 1) & 3)); }
static_assert(LOFF(1) == 0 && LOFF(2) == 4 && LOFF(5) == 16 && LOFF(6) == 24 && LOFF(64) == 2112, "packed lower-triangular row offsets");
struct GpPre { v4u q0, q1, k0, k1; float g, beta; };
__device__ __forceinline__ void gdn_prep_load(const Ctx& c, int item, GpPre& p) {
    const int n = item % GDN_NCH, bhd = item / GDN_NCH, dir = bhd & 1, h = (bhd >> 1) & 3, b = bhd >> 3;
    const bf16* QKV = (const bf16*)(c.ws + WS_QKV); const float* GB = (const float*)(c.ws + WS_GB);
    const int s = c.tid >> 3, seg = c.tid & 7; const bf16* rp = QKV + (size_t)scan_row(b, dir, n * 64 + s) * 1536 + h * 128 + seg * 16;
    p.q0 = *(const v4u*)rp; p.q1 = *(const v4u*)(rp + 8); p.k0 = *(const v4u*)(rp + 512); p.k1 = *(const v4u*)(rp + 520);
    const size_t rl = (size_t)scan_row(b, dir, n * 64 + c.lane) * 16 + dir * 4 + h; p.g = GB[rl]; p.beta = GB[rl + 8];
}
__device__ __forceinline__ void gdn_prep_stage(const Ctx& c, int item, int item_next, float* Lp, GpPre& p) {
    bf16* Kr = (bf16*)(c.lds + GP_KR); bf16* Qr = (bf16*)(c.lds + GP_QR); bf16* Kt = (bf16*)(c.lds + GP_KT); float* tab = (float*)(c.lds + GP_TAB);
    unsigned char* frA = c.ws + WS_FRA + (size_t)item * FR_ATT_BYTES; unsigned char* frK = c.ws + WS_FRK + (size_t)item * FR_KD_BYTES; float* frTab = (float*)(c.ws + WS_FRTAB + (size_t)item * FR_TAB_BYTES);
    const int r = c.lane & 31, hh = c.lane >> 5;
    if (c.wave == 0) { float g = p.g; const float beta = p.beta;
#pragma unroll
        for (int o = 1; o < 64; o <<= 1) { const float t = __shfl_up(g, o); if (c.lane >= o) g += t; }
        const float gl = __shfl(g, 63);
        tab[c.lane] = g; tab[64 + c.lane] = beta; tab[128 + c.lane] = __expf(g); tab[192 + c.lane] = __expf(gl - g); }
    { const int s = c.tid >> 3, seg = c.tid & 7;
      const v4u q0 = p.q0, q1 = p.q1, k0 = p.k0, k1 = p.k1;
      gdn_prep_load(c, item_next, p);
      *(v4u*)(Qr + s * 136 + seg * 16) = q0; *(v4u*)(Qr + s * 136 + seg * 16 + 8) = q1; *(v4u*)(Kr + s * 136 + seg * 16) = k0; *(v4u*)(Kr + s * 136 + seg * 16 + 8) = k1;
      const unsigned kw[8] = {k0.x, k0.y, k0.z, k0.w, k1.x, k1.y, k1.z, k1.w};
#pragma unroll
      for (int e = 0; e < 8; ++e) { Kt[(seg * 16 + 2 * e) * 72 + s] = (bf16)(kw[e] & 0xffffu); Kt[(seg * 16 + 2 * e + 1) * 72 + s] = (bf16)(kw[e] >> 16); } }
    __syncthreads();
    if (c.wave < 3) { const int ct = c.wave ? 1 : 0, st = c.wave == 2 ? 1 : 0;
        f32x16 acc;
#pragma unroll
        for (int i = 0; i < 16; ++i) acc[i] = 0.f;
#pragma unroll
        for (int kk = 0; kk < 8; ++kk) { const bf16x8 a = *(const bf16x8*)(Kr + (ct * 32 + r) * 136 + kk * 16 + hh * 8), bb = *(const bf16x8*)(Kr + (st * 32 + r) * 136 + kk * 16 + hh * 8); acc = MFMA32(a, bb, acc); }
        const int s = st * 32 + r; const float gcs = tab[s];
#pragma unroll
        for (int i = 0; i < 16; ++i) { const int cc = ct * 32 + crow16(i, hh); if (s < cc) Lp[LOFF(cc) + s] = tab[64 + cc] * acc[i] * __expf(tab[cc] - gcs); }
    } else if (c.wave < 6) { const int w = c.wave - 3, st = w == 2 ? 1 : 0, ct = w ? 1 : 0;
        f32x16 acc;
#pragma unroll
        for (int i = 0; i < 16; ++i) acc[i] = 0.f;
#pragma unroll
        for (int kk = 0; kk < 8; ++kk) { const bf16x8 a = *(const bf16x8*)(Kr + (st * 32 + r) * 136 + kk * 16 + hh * 8), bb = *(const bf16x8*)(Qr + (ct * 32 + r) * 136 + kk * 16 + hh * 8); acc = MFMA32(a, bb, acc); }
        const int cc = ct * 32 + r; const float gcc = tab[cc];
#pragma unroll
        for (int i = 0; i < 16; ++i) { const int s = st * 32 + crow16(i, hh); acc[i] = (s <= cc) ? acc[i] * __expf(gcc - tab[s]) : 0.f; }
        *(bf16x8*)(frA + ((size_t)((ct * 4 + 2 * st) * 64 + c.lane)) * 16) = pack_step(acc, 0);
        *(bf16x8*)(frA + ((size_t)((ct * 4 + 2 * st + 1) * 64 + c.lane)) * 16) = pack_step(acc, 1);
    } else { const int w = c.wave - 6;
#pragma unroll
        for (int f = 0; f < 8; ++f) { const int fi = w * 8 + f, dkt = fi >> 2, cb = fi & 3; const bf16* kp = Kt + (dkt * 32 + r) * 72 + 16 * cb + 4 * hh;
            const v2u lo = *(const v2u*)kp, hi = *(const v2u*)(kp + 8); const f32x4 e0 = *(const f32x4*)(tab + 192 + 16 * cb + 4 * hh), e1 = *(const f32x4*)(tab + 192 + 16 * cb + 8 + 4 * hh);
            v4u o; o.x = pk2(bflo(lo.x) * e0.x, bfhi(lo.x) * e0.y); o.y = pk2(bflo(lo.y) * e0.z, bfhi(lo.y) * e0.w); o.z = pk2(bflo(hi.x) * e1.x, bfhi(hi.x) * e1.y); o.w = pk2(bflo(hi.y) * e1.z, bfhi(hi.y) * e1.w);
            *(v4u*)(frK + ((size_t)(fi * 64 + c.lane)) * 16) = o; }
        if (w == 0) { const v4u z = (v4u){0u, 0u, 0u, 0u}; *(v4u*)(frA + ((size_t)((0 * 4 + 2) * 64 + c.lane)) * 16) = z; *(v4u*)(frA + ((size_t)((0 * 4 + 3) * 64 + c.lane)) * 16) = z; }
        else { *(f32x4*)(frTab + 4 * c.lane) = *(const f32x4*)(tab + 4 * c.lane); }
    }
    __syncthreads();
}
__device__ __forceinline__ int loff_rt(int i) { return i < 1 ? 0 : 4 * (((i - 1) >> 2) + 1) * (2 * ((i - 1) >> 2) + ((i - 1) & 3)); }
__device__ __forceinline__ void gdn_prep_solve(const Ctx& c, int item, float* Lp) {
    const int r = c.lane & 31, hh = c.lane >> 5;
    { float Tr[32];
#pragma unroll
      for (int i = 0; i < 32; ++i) { int je = r, bl = hh; asm volatile("" : "+v"(je), "+v"(bl)); float a0 = (je == i) ? 1.f : 0.f, a1 = 0.f;
          const int ro = bl ? LOFF(32 + i) + 32 : LOFF(i);
#pragma unroll
          for (int s4 = 0; s4 < (i + 3) / 4; ++s4) { const f32x4 l4 = *(const f32x4*)(Lp + ro + 4 * s4);
              if (4 * s4 + 0 < i) a0 = fmaf(-l4.x, Tr[4 * s4 + 0], a0); if (4 * s4 + 1 < i) a1 = fmaf(-l4.y, Tr[4 * s4 + 1], a1); if (4 * s4 + 2 < i) a0 = fmaf(-l4.z, Tr[4 * s4 + 2], a0); if (4 * s4 + 3 < i) a1 = fmaf(-l4.w, Tr[4 * s4 + 3], a1); }
          Tr[i] = a0 + a1; Lp[(je < i) ? ro + je : 2112 + 32 * bl + je] = Tr[i]; } }
    WAVE_LDS_SYNC();
    { const int offA = loff_rt(32 + r);
      f32x16 X;
#pragma unroll
      for (int i = 0; i < 16; ++i) X[i] = 0.f;
#pragma unroll
      for (int q = 0; q < 4; ++q) { const f32x4 a4 = *(const f32x4*)(Lp + offA + 16 * hh + 4 * q);
#pragma unroll
          for (int e = 0; e < 4; ++e) { const int kk = 4 * q + e; int hq = hh; asm volatile("" : "+v"(hq)); const int k = 16 * hq + kk;
              const float t = Lp[(hq ? LOFF(16 + kk) : LOFF(kk)) + r]; const float b = (r < k) ? t : (r == k ? 1.f : 0.f);
              X = __builtin_amdgcn_mfma_f32_32x32x2f32(a4[e], b, X, 0, 0, 0); } }
      f32x16 Y;
#pragma unroll
      for (int i = 0; i < 16; ++i) Y[i] = 0.f;
#pragma unroll
      for (int q = 0; q < 4; ++q) { const int k0 = 8 * q + 4 * hh; const f32x4 t4 = *(const f32x4*)(Lp + offA + 32 + k0);
#pragma unroll
          for (int e = 0; e < 4; ++e) { const int kq = k0 + e; const float av = (kq < r) ? t4[e] : (kq == r ? 1.f : 0.f);
              Y = __builtin_amdgcn_mfma_f32_32x32x2f32(av, X[4 * q + e], Y, 0, 0, 0); } }
#pragma unroll
      for (int i = 0; i < 16; ++i) { int hq = hh; asm volatile("" : "+v"(hq)); const int cb = (i & 3) + 8 * (i >> 2);
          Lp[(hq ? LOFF(32 + cb + 4) : LOFF(32 + cb)) + r] = -Y[i]; } }
    WAVE_LDS_SYNC();
    unsigned char* frT = c.ws + WS_FRT + (size_t)item * FR_T_BYTES;
#pragma unroll
    for (int f = 0; f < 8; ++f) { const int ct = f >> 2, sb = f & 3, cc = ct * 32 + r; float v[8];
#pragma unroll
        for (int q = 0; q < 2; ++q) { const int s0 = 16 * sb + 8 * q + 4 * hh;
            f32x4 t4 = (f32x4){0.f, 0.f, 0.f, 0.f}; if (s0 < cc) t4 = *(const f32x4*)(Lp + LOFF(cc) + s0);
            v[4 * q + 0] = (s0 + 0 < cc) ? t4.x : (s0 + 0 == cc ? 1.f : 0.f); v[4 * q + 1] = (s0 + 1 < cc) ? t4.y : (s0 + 1 == cc ? 1.f : 0.f);
            v[4 * q + 2] = (s0 + 2 < cc) ? t4.z : (s0 + 2 == cc ? 1.f : 0.f); v[4 * q + 3] = (s0 + 3 < cc) ? t4.w : (s0 + 3 == cc ? 1.f : 0.f); }
        *(v4u*)(frT + ((size_t)(f * 64 + c.lane)) * 16) = (v4u){pk2(v[0], v[1]), pk2(v[2], v[3]), pk2(v[4], v[5]), pk2(v[6], v[7])}; }
}
__device__ __forceinline__ void phase_gdn_prep(const Ctx& c) {
    const int nit = c.bid < GDN_ITEMS ? (GDN_ITEMS - 1 - c.bid) / c.G + 1 : 0;
    bool scanned = false;
    if (nit > 0) {
        GpPre p; gdn_prep_load(c, c.bid, p);
#pragma unroll 1
        for (int j = 0; j < nit; ++j) { const int item = c.bid + j * c.G, q = j & 7; int nx = item + c.G; nx = nx < GDN_ITEMS ? nx : item;
            gdn_prep_stage(c, item, nx, (float*)(c.lds + GP_LP + q * GP_LPB), p);
            if (q == 7 || j == nit - 1) { const int cnt = q + 1;
                if (c.wave < cnt) gdn_prep_solve(c, c.bid + ((j & ~7) + c.wave) * c.G, (float*)(c.lds + GP_LP + c.wave * GP_LPB));
                else if (j == nit - 1) { for (int t = c.bid + (c.wave - cnt) * c.G; t < 512; t += (8 - cnt) * c.G) s5_state_scan(c, t); }
                if (j == nit - 1 && cnt < 8) scanned = true;
                __syncthreads(); } }
    }
    if (!scanned) for (int t = c.bid + c.wave * c.G; t < 512; t += 8 * c.G) s5_state_scan(c, t);
}

constexpr int GR_K = 0, GR_Q = 16384, GR_T = 32768, GR_A = 40960, GR_KD = 49152, GR_TAB = 65536, GR_BUF = 66560;
__device__ __forceinline__ void gdn_rec_stage(const Ctx& c, int bhd, int n, int buf) {
    const int dir = bhd & 1, h = (bhd >> 1) & 3, b = bhd >> 3, lw = c.wave - 4; const int item = bhd * GDN_NCH + n;
    LAS unsigned char* base = (LAS unsigned char*)c.lds + buf * GR_BUF;
    const unsigned char* QKVb = c.ws + WS_QKV;
#pragma unroll
    for (int q = 0; q < 4; ++q) { const int qi = lw + 4 * q;
        const int s = 4 * qi + (c.lane >> 4), ps = c.lane & 15, p = ps ^ (s & 15); const size_t rowb = (size_t)scan_row(b, dir, n * 64 + s) * 3072 + (size_t)h * 256 + p * 16;
        __builtin_amdgcn_global_load_lds((const unsigned*)(QKVb + rowb + 1024), (LAS unsigned*)(base + GR_K + qi * 1024), 16, 0, 0);
        __builtin_amdgcn_global_load_lds((const unsigned*)(QKVb + rowb), (LAS unsigned*)(base + GR_Q + qi * 1024), 16, 0, 0); }
    const unsigned char* frT = c.ws + WS_FRT + (size_t)item * FR_T_BYTES; const unsigned char* frA = c.ws + WS_FRA + (size_t)item * FR_ATT_BYTES; const unsigned char* frK = c.ws + WS_FRK + (size_t)item * FR_KD_BYTES;
#pragma unroll
    for (int q = 0; q < 2; ++q) { const int qi = lw + 4 * q;
        __builtin_amdgcn_global_load_lds((const unsigned*)(frT + qi * 1024 + c.lane * 16), (LAS unsigned*)(base + GR_T + qi * 1024), 16, 0, 0);
        __builtin_amdgcn_global_load_lds((const unsigned*)(frA + qi * 1024 + c.lane * 16), (LAS unsigned*)(base + GR_A + qi * 1024), 16, 0, 0); }
#pragma unroll
    for (int q = 0; q < 4; ++q) { const int qi = lw + 4 * q;
        __builtin_amdgcn_global_load_lds((const unsigned*)(frK + qi * 1024 + c.lane * 16), (LAS unsigned*)(base + GR_KD + qi * 1024), 16, 0, 0); }
    if (lw == 0) __builtin_amdgcn_global_load_lds((const unsigned*)(c.ws + WS_FRTAB + (size_t)item * FR_TAB_BYTES + c.lane * 16), (LAS unsigned*)(base + GR_TAB), 16, 0, 0);
}
__device__ __forceinline__ bf16x8 gr_rowfrag(const unsigned char* rowp, const int (&po)[16], int kb) {
    const v2u lo = *(const v2u*)(rowp + po[2 * kb]), hi = *(const v2u*)(rowp + po[2 * kb + 1]);
    return __builtin_bit_cast(bf16x8, (v4u){lo.x, lo.y, hi.x, hi.y});
}
__device__ __forceinline__ void gdn_rec_block(const Ctx& c, int bhd, int dvhalf) {
    const int dir = bhd & 1, h = (bhd >> 1) & 3, b = bhd >> 3, r = c.lane & 31, hh = c.lane >> 5, dvt = 2 * dvhalf + (c.wave & 1);
    const bf16* QKV = (const bf16*)(c.ws + WS_QKV); bf16* OG = (bf16*)(c.ws + WS_OG) + (size_t)dir * ML * 512;
    f32x16 S[4];
#pragma unroll
    for (int t = 0; t < 4; ++t)
#pragma unroll
        for (int i = 0; i < 16; ++i) S[t][i] = 0.f;
    int po[16];
#pragma unroll
    for (int p = 0; p < 16; ++p) po[p] = r * 256 + ((p ^ (r & 15)) * 16) + 8 * hh;
    if (c.wave >= 4) gdn_rec_stage(c, bhd, 0, 0);
    asm volatile("s_waitcnt vmcnt(0)" ::: "memory"); __syncthreads();
    for (int n = 0; n < GDN_NCH; ++n) {
        const int buf = n & 1;
        if (c.wave >= 4) { if (n + 1 < GDN_NCH) gdn_rec_stage(c, bhd, n + 1, buf ^ 1); }
        else if (c.wave < 2) {
            const unsigned char* base = c.lds + buf * GR_BUF; const float* tab = (const float*)(base + GR_TAB);
            const int row0 = scan_row(b, dir, n * 64), sgn = dir ? -1 : 1;
            const bf16* vcol = QKV + (size_t)row0 * 1536 + 1024 + h * 128 + dvt * 32 + r + (ptrdiff_t)(sgn * 4 * hh) * 1536;
            bf16* ocol = OG + (size_t)row0 * 512 + h * 128 + dvt * 32 + r + (ptrdiff_t)(sgn * 4 * hh) * 512;
            const ptrdiff_t vst = (ptrdiff_t)sgn * 1536, ost = (ptrdiff_t)sgn * 512;
            bf16 vraw[2][16];
#pragma unroll
            for (int st = 0; st < 2; ++st)
#pragma unroll
                for (int i = 0; i < 16; ++i) vraw[st][i] = vcol[vst * (st * 32 + (i & 3) + 8 * (i >> 2))];
            bf16x8 Rf[2][2];
#pragma unroll
            for (int st = 0; st < 2; ++st) { f32x16 acc;
#pragma unroll
                for (int i = 0; i < 16; ++i) acc[i] = 0.f;
#pragma unroll
                for (int kb = 0; kb < 8; ++kb) acc = MFMA32(gr_rowfrag(base + GR_K + st * 8192, po, kb), pack_step_v(S[kb >> 1], kb & 1), acc);
#pragma unroll
                for (int i = 0; i < 16; ++i) { const int s = st * 32 + crow16(i, hh); acc[i] = tab[64 + s] * (bf1(vraw[st][i]) - tab[128 + s] * acc[i]); }
                Rf[st][0] = pack_step(acc, 0); Rf[st][1] = pack_step(acc, 1); asm volatile("" ::: "memory"); }
            bf16x8 Vf[2][2];
#pragma unroll
            for (int ct = 0; ct < 2; ++ct) { f32x16 acc;
#pragma unroll
                for (int i = 0; i < 16; ++i) acc[i] = 0.f;
#pragma unroll
                for (int sb = 0; sb < 4; ++sb) if (sb < 2 * ct + 2) acc = MFMA32(*(const bf16x8*)(base + GR_T + ((ct * 4 + sb) * 64 + c.lane) * 16), Rf[sb >> 1][sb & 1], acc);
                Vf[ct][0] = pack_step(acc, 0); Vf[ct][1] = pack_step(acc, 1); }
            asm volatile("" ::: "memory");
#pragma unroll
            for (int ct = 0; ct < 2; ++ct) { f32x16 acc;
#pragma unroll
                for (int i = 0; i < 16; ++i) acc[i] = 0.f;
#pragma unroll
                for (int kb = 0; kb < 8; ++kb) acc = MFMA32(gr_rowfrag(base + GR_Q + ct * 8192, po, kb), pack_step_v(S[kb >> 1], kb & 1), acc);
#pragma unroll
                for (int i = 0; i < 16; ++i) acc[i] *= tab[128 + ct * 32 + crow16(i, hh)];
#pragma unroll
                for (int cb = 0; cb < 4; ++cb) if (cb < 2 * ct + 2) acc = MFMA32(*(const bf16x8*)(base + GR_A + ((ct * 4 + cb) * 64 + c.lane) * 16), Vf[cb >> 1][cb & 1], acc);
                if (n >= 4) {
#pragma unroll
                    for (int i = 0; i < 16; ++i) ocol[ost * (ct * 32 + (i & 3) + 8 * (i >> 2))] = (bf16)f2bf(acc[i]); }
                asm volatile("" ::: "memory"); }
            const float gtot = tab[128 + 63];
#pragma unroll
            for (int t = 0; t < 4; ++t) {
#pragma unroll
                for (int i = 0; i < 16; ++i) S[t][i] *= gtot;
#pragma unroll
                for (int cb = 0; cb < 4; ++cb) S[t] = MFMA32(*(const bf16x8*)(base + GR_KD + ((t * 4 + cb) * 64 + c.lane) * 16), Vf[cb >> 1][cb & 1], S[t]); }
        }
        if (c.wave >= 4) asm volatile("s_waitcnt vmcnt(0)" ::: "memory"); else asm volatile("s_waitcnt lgkmcnt(0)" ::: "memory");
        __builtin_amdgcn_s_barrier(); asm volatile("" ::: "memory");
    }
    asm volatile("s_waitcnt vmcnt(0)" ::: "memory"); __syncthreads();
}
__device__ __forceinline__ void phase_gdn_rec(const Ctx& c) { if (c.bid < 128) gdn_rec_block(c, c.bid >> 1, c.bid & 1); }

#define XB_TMO      128
#define XB_XCNT(j)  (256  + 64 * (j))
#define XB_XSUB(j)  (1280 + 64 * (j))
#define XB_XGEN(j)  (2304 + 64 * (j))
#define XB_TOP      3328
#define XB_TOPGEN   3392
#define XCD_BAR_WORDS 3456
#define XB_SPIN_CAP (1u << 20)
__device__ __forceinline__ unsigned xb_ld(unsigned* p)              { return __hip_atomic_load(p, __ATOMIC_RELAXED, __HIP_MEMORY_SCOPE_AGENT); }
__device__ __forceinline__ unsigned xb_add(unsigned* p, unsigned v) { return __hip_atomic_fetch_add(p, v, __ATOMIC_RELAXED, __HIP_MEMORY_SCOPE_AGENT); }
__device__ __forceinline__ unsigned xb_xcc_id() { return (unsigned)__builtin_amdgcn_s_getreg((3 << 11) | 20) & 0xFu; }
#define XB_SPIN(cond, bar) do { unsigned _sp = 0; while (cond) { __builtin_amdgcn_s_sleep(1); \
    if ((++_sp & 255u) == 0u) { if (xb_ld(&(bar)[XB_TMO])) break; if (_sp > XB_SPIN_CAP) { atomicAdd(&(bar)[XB_TMO], 1u); break; } } } } while (0)
struct XcdBarrier { unsigned* bar; unsigned x; volatile LAS unsigned* st; };
__device__ __forceinline__ XcdBarrier xcd_barrier_post(unsigned* bar, volatile LAS unsigned* st) {
    XcdBarrier b; b.bar = bar; b.x = xb_xcc_id(); b.st = st;
    if (threadIdx.x == 0) (void)xb_add(&bar[XB_XCNT(b.x)], 1u);
    return b;
}
__device__ __forceinline__ void xcd_barrier_complete(unsigned* bar, unsigned x, unsigned& nloc, unsigned& nx) {
    const unsigned G = gridDim.x * gridDim.y * gridDim.z;
    unsigned sum, cnt, mine, sp = 0u;
    for (;;) {
        sum = 0u; cnt = 0u; mine = 0u;
#pragma unroll
        for (unsigned j = 0; j < 16; ++j) { const unsigned c = xb_ld(&bar[XB_XCNT(j)]); sum += c; cnt += (c > 0u) ? 1u : 0u; mine = (j == x) ? c : mine; }
        if (sum == G) break;
        __builtin_amdgcn_s_sleep(1);
        if ((++sp & 255u) == 0u) { if (xb_ld(&bar[XB_TMO])) break; if (sp > XB_SPIN_CAP) { atomicAdd(&bar[XB_TMO], 1u); break; } }
    }
    nloc = mine > 0u ? mine : 1u; nx = cnt > 0u ? cnt : 1u;
}
__device__ __forceinline__ void xcd_barrier(const XcdBarrier& b) {
    asm volatile("s_waitcnt vmcnt(0)" ::: "memory");
    __syncthreads();
    if (threadIdx.x == 0) {
        unsigned* bar = b.bar;
        __builtin_amdgcn_s_waitcnt(0);
        unsigned nloc = b.st[0], nx = b.st[1];
        if (nloc == 0u) { xcd_barrier_complete(bar, b.x, nloc, nx); b.st[0] = nloc; b.st[1] = nx; }
        const unsigned old = xb_add(&bar[XB_XSUB(b.x)], 1u);
        const unsigned gen = old / nloc;
        if (old + 1u == (gen + 1u) * nloc) {
            __builtin_amdgcn_fence(__ATOMIC_RELEASE, "agent");
            asm volatile("s_waitcnt vmcnt(0)" ::: "memory");
            const unsigned og = xb_add(&bar[XB_TOP], 1u);
            const unsigned tg = og / nx;
            if (og + 1u == (tg + 1u) * nx) xb_add(&bar[XB_TOPGEN], 1u);
            else XB_SPIN(xb_ld(&bar[XB_TOPGEN]) == tg, bar);
            __builtin_amdgcn_fence(__ATOMIC_ACQUIRE, "agent");
            xb_add(&bar[XB_XGEN(b.x)], 1u);
            asm volatile("s_waitcnt vmcnt(0)" ::: "memory");
        } else {
            XB_SPIN(xb_ld(&bar[XB_XGEN(b.x)]) == gen, bar);
            __builtin_amdgcn_fence(__ATOMIC_ACQUIRE, "agent");
            asm volatile("s_waitcnt vmcnt(0)" ::: "memory");
        }
    }
    __syncthreads();
}

constexpr int LDS_MISC = LDS_BYTES - 64;
__global__ void __launch_bounds__(NTHREADS, 2) mk_fwd(Args args) {
    extern __shared__ __attribute__((aligned(16))) unsigned char lds[];
    Ctx c; c.a = &args; c.ws = args.ws; c.lds = lds;
    c.tid = threadIdx.x; c.lane = c.tid & 63; c.wave = __builtin_amdgcn_readfirstlane(c.tid >> 6); c.bid = blockIdx.x; c.G = gridDim.x;
    c.gw = c.bid * NWAVES + c.wave; c.NGW = c.G * NWAVES; c.gwv = c.wave * c.G + c.bid;
    const int lo = args.ph_lo, hi = args.ph_hi;
    PG8_LAS unsigned char* ring = (PG8_LAS unsigned char*)lds;
#ifndef MK_PH_MASK
#define MK_PH_MASK 0xffff
#endif
#define IN(k) (((MK_PH_MASK >> (k)) & 1) && lo <= (k) && (k) < hi)
#if MK_ONE_LAUNCH
    cg::grid_group grid = cg::this_grid();
    if (lo < 0) grid.sync();
    volatile LAS unsigned* st = (volatile LAS unsigned*)((LAS unsigned char*)lds + LDS_MISC);
    if (c.tid < 2) st[c.tid] = 0u;
    __syncthreads();
    const XcdBarrier bar = xcd_barrier_post((unsigned*)(c.ws + WS_CTL) + CW_BAR, st);
#define SEAM(k) do { if (IN(k) && IN((k) + 1)) xcd_barrier(bar); } while (0)
#else
#define SEAM(k) do { } while (0)
#endif
    if (IN(0)) { phase_prep(c); phase_s5_build(c); } SEAM(0);
    if (IN(1)) { phase_norm1(c); } SEAM(1);
    if (IN(2)) { pg8::Gemm g{(const pg8::bf16_t*)(c.ws + WS_HX), (const pg8::bf16_t*)(c.ws + WS_WIN), 1024, 1024, 1024}; pg8::StaticOrder S; S.init(MT, NPROJ, c.G, c.bid);
        pg8::EpiInProj E{(pg8::bf16_t*)(c.ws + WS_U5), (pg8::bf16_t*)(c.ws + WS_QKVPRE), (pg8::bf16_t*)(c.ws + WS_Z)};
        pg8::gemm_phase<pg8::EpiInProj, pg8::StaticOrder, true, true>(ring, g, S, E); } SEAM(2);
    if (IN(3)) { { pg8::Gemm g{(const pg8::bf16_t*)(c.ws + WS_U5), (const pg8::bf16_t*)(c.ws + WS_PM), 768, 512, 512}; pg8::SchedSS S{c.G, c.bid}; pg8::EpiSS E{(float*)(c.ws + WS_SS)};
          pg8::gemm_phase<pg8::EpiSS, pg8::SchedSS, true, true>(ring, g, S, E); }
        __syncthreads(); phase_conv(c); } SEAM(3);
    if (IN(4)) { phase_gdn_prep(c); } SEAM(4);
    if (IN(5)) { pg8::Gemm g{(const pg8::bf16_t*)(c.ws + WS_U5), (const pg8::bf16_t*)(c.ws + WS_BB), 768, 768, 768}; pg8::SchedS5Y S{c.G, c.bid}; pg8::EpiS5Y E{(pg8::bf16_t*)(c.ws + WS_YG)};
        pg8::gemm_phase<pg8::EpiS5Y, pg8::SchedS5Y, true, true>(ring, g, S, E); } SEAM(5);
    if (IN(6)) { if (c.bid < 128) phase_gdn_rec(c);
        else { pg8::Gemm g{(const pg8::bf16_t*)(c.ws + WS_YG), (const pg8::bf16_t*)(c.ws + WS_WGLU), 512, 512, 512}; pg8::StaticOrder S; S.init(ML, 512, c.G - 128, c.bid - 128);
            pg8::EpiGlu E{(const pg8::bf16_t*)(c.ws + WS_YG), (pg8::bf16_t*)(c.ws + WS_CAT)};
            pg8::gemm_phase<pg8::EpiGlu, pg8::StaticOrder, true, true>(ring, g, S, E); } } SEAM(6);
    if (IN(7)) { phase_combine(c); } SEAM(7);
    if (IN(8)) { pg8::Gemm g{(const pg8::bf16_t*)(c.ws + WS_CAT), (const pg8::bf16_t*)(c.ws + WS_WOUT), 1024, 1024, 1024}; pg8::StaticOrder S; S.init(ML, 1024, c.G, c.bid);
        pg8::EpiBf16<0> E{(pg8::bf16_t*)(c.ws + WS_YRAW), 1024, nullptr, 0, 0, 1.f};
        pg8::gemm_phase<pg8::EpiBf16<0>, pg8::StaticOrder, true, true>(ring, g, S, E); } SEAM(8);
    if (IN(9)) { phase_rows2(c); phase_fp8_tables(c); } SEAM(9);
    if (IN(10)) { pg8::Gemm g{(const pg8::bf16_t*)(c.ws + WS_HX2), (const pg8::bf16_t*)(c.ws + WS_WQ), 1024, 1024, 1024}; pg8::StaticOrder S; S.init(ML, 2048, c.G, c.bid);
        pg8::EpiBf16<0> E{(pg8::bf16_t*)(c.ws + WS_QP), 2048, nullptr, 0, 0, 1.f};
        pg8::gemm_phase<pg8::EpiBf16<0>, pg8::StaticOrder, true, true>(ring, g, S, E); } SEAM(10);
    if (IN(11)) { phase_topk(c); } SEAM(11);
    if (IN(12)) { phase_exp1(c); } SEAM(12);
    if (IN(13)) { phase_exp1b(c); } SEAM(13);
    if (IN(14)) { phase_exp2(c); } SEAM(14);
    if (IN(15)) { phase_exp3(c); }
#undef IN
#undef SEAM
}

extern "C" void kernel_launch(void* const* d_in, const int* in_sizes, int n_in, void* d_out, int out_size, void* d_ws, size_t ws_size, hipStream_t stream) {
    static int grid = 0;
    if (grid == 0) {
        if (n_in != 29 || out_size != ML * D || ws_size < WS_END) { fprintf(stderr, "kernel_launch: unexpected shapes (n_in %d out %d ws %zu)\n", n_in, out_size, ws_size); grid = -1; return; }
        int dev = 0, cus = 0, per_cu = 0;
        (void)hipGetDevice(&dev); (void)hipDeviceGetAttribute(&cus, hipDeviceAttributeMultiprocessorCount, dev);
        if (hipFuncSetAttribute((const void*)mk_fwd, hipFuncAttributeMaxDynamicSharedMemorySize, LDS_BYTES) != hipSuccess) { fprintf(stderr, "kernel_launch: hipFuncSetAttribute failed\n"); grid = -1; return; }
        (void)hipOccupancyMaxActiveBlocksPerMultiprocessor(&per_cu, (const void*)mk_fwd, NTHREADS, LDS_BYTES);
        (void)hipGetLastError();
        grid = cus;
        fprintf(stderr, "kernel_launch: cus %d per_cu %d grid %d\n", cus, per_cu, grid);
    }
    if (grid < 0) return;
    Args a{};
    for (int i = 0; i < 29; ++i) a.in[i] = (const float*)d_in[i];
    a.out = (float*)d_out; a.ws = (unsigned char*)d_ws;
    (void)hipMemsetAsync((char*)d_ws + WS_CTL, 0, CTL_ZERO_BYTES, stream);
#if MK_ONE_LAUNCH
    a.ph_lo = 0; a.ph_hi = NPHASES;
    void* kargs[] = {&a};
    hipError_t e = hipLaunchCooperativeKernel((const void*)mk_fwd, dim3(grid), dim3(NTHREADS), kargs, LDS_BYTES, stream);
    if (e != hipSuccess) fprintf(stderr, "kernel_launch: cooperative launch failed: %s\n", hipGetErrorString(e));
#else
    for (int ph = 0; ph < NPHASES; ++ph) { a.ph_lo = ph; a.ph_hi = ph + 1; hipLaunchKernelGGL(mk_fwd, dim3(grid), dim3(NTHREADS), LDS_BYTES, stream, a); }
#endif
}
```

```cpp
#include <hip/hip_runtime.h>
#include <hip/hip_cooperative_groups.h>
#include <cstdio>
#include <cstdint>
namespace cg = cooperative_groups;
namespace pg8 {
#define PG8_LAS __attribute__((address_space(3)))
typedef unsigned short bf16_t;
typedef short bf16x8 __attribute__((ext_vector_type(8)));
typedef float f32x4 __attribute__((ext_vector_type(4)));
typedef unsigned u32x4 __attribute__((ext_vector_type(4)));
constexpr int BM = 256, BK = 64, HALF = 128, HTB = HALF * BK * 2  , STAGE_BYTES = 8 * HTB, NXCD = 8, WGM = 8;

__host__ __device__ __forceinline__ int lds_byte(int r, int c) { const int st = (r >> 4) * 2 + (c >> 5), rr = r & 15, cc = c & 31, ob = rr * 64 + cc * 2; return st * 1024 + (ob ^ (((ob >> 9) & 1) << 5)); }
__host__ __device__ __forceinline__ void stage_rc(int b, int& R, int& C) { const int st = b / 1024, sb = b % 1024, swz = sb ^ (((sb >> 9) & 1) << 5); R = (st >> 1) * 16 + swz / 64; C = (st & 1) * 32 + (swz % 64) / 2; }
__host__ __device__ __forceinline__ int perm32(int rho) { const int n = rho >> 4, i = rho & 15; return 8 * (i >> 2) + 4 * n + (i & 3); }

struct Unit { int pm, pn; };
struct Gemm { const bf16_t* A; const bf16_t* Bt; int lda, ldb, K; };

struct StaticOrder {
    int nM, nN, nwg, G, c;
    __host__ __device__ void init(int M, int N, int G_, int c_) { nM = M / BM; nN = N / BM; nwg = nM * nN; G = G_; c = c_; }
    __host__ __device__ bool next(int i, Unit& u) const {
        const long L = (long)i * G + c; if (L >= nwg) return false;
        int wgid = (int)L; { const int q = nwg / NXCD, r = nwg % NXCD, xcd = wgid % NXCD, off = wgid / NXCD; wgid = (xcd < r ? xcd * (q + 1) : r * (q + 1) + (xcd - r) * q) + off; }
        const int nig = WGM * nN, gid = wgid / nig, fm = gid * WGM, gsz = (nM - fm) < WGM ? (nM - fm) : WGM;
        u.pm = fm + ((wgid % nig) % gsz); u.pn = (wgid % nig) / gsz; return true;
    }
    __device__ __forceinline__ void a_ready(const Unit&) const {}
    __device__ __forceinline__ void done(const Unit&) const {}
};

__device__ __forceinline__ unsigned cvt_pk_bf16(float lo, float hi) { unsigned r; asm volatile("v_cvt_pk_bf16_f32 %0, %1, %2" : "=v"(r) : "v"(lo), "v"(hi)); return r; }
typedef float f32x2 __attribute__((ext_vector_type(2)));
__device__ __forceinline__ f32x2 gelu_pk(f32x2 v) {
    const f32x2 av = __builtin_elementwise_abs(v), d = av * 0.2316418882f + 1.0f;
    f32x2 t; t.x = __builtin_amdgcn_rcpf(d.x); t.y = __builtin_amdgcn_rcpf(d.y);
    f32x2 q = t * 0.5307027145f + (-0.7265760135f); q = q * t + 0.7107068705f; q = q * t + (-0.142248368f); q = q * t + 0.127414796f; q = q * t;
    const f32x2 s = (v * v) * (-0.72134752044f);
    f32x2 e; e.x = __builtin_amdgcn_exp2f(s.x); e.y = __builtin_amdgcn_exp2f(s.y);
    const f32x2 m = v * (q * e), r = v - m;
    f32x2 o; o.x = v.x < 0.f ? m.x : r.x; o.y = v.y < 0.f ? m.y : r.y; return o;
}

template <int ACT  > struct EpiBf16 {
    static constexpr bool PERM = true, AFTER_DRAIN = false; static_assert(ACT == 0 || ACT == 1, "EpiBf16: ACT is 0 (none) or 1 (gelu_pk)");
    bf16_t* O; int ldc; const float* bias; int split_cols; size_t split_stride; float scale0;
    __device__ __forceinline__ void operator()(const f32x4 (&acc)[2][2][4][2], const Unit& u, int wr, int wc, int fr, int fq) const {
        const int row0 = u.pm * BM + wr * 64 + fr; int colt = u.pn * BM; bf16_t* base = O;
        float sc = 1.f; if (split_cols) { const int t = colt / split_cols; base += (size_t)t * split_stride; colt -= t * split_cols; if (t == 0) sc = scale0; }
        const int col0 = colt + wc * 32 + 8 * fq, bcol0 = u.pn * BM + wc * 32 + 8 * fq;
        f32x4 bv[2][2];
#pragma unroll
        for (int bj = 0; bj < 2; ++bj)
#pragma unroll
            for (int n = 0; n < 2; ++n) bv[bj][n] = bias ? *(const f32x4*)(bias + bcol0 + bj * HALF + 4 * n) : (f32x4){0.f, 0.f, 0.f, 0.f};
#pragma unroll
        for (int ai = 0; ai < 2; ++ai)
#pragma unroll
            for (int m = 0; m < 4; ++m) { bf16_t* rowp = base + (size_t)(row0 + ai * HALF + m * 16) * ldc + col0;
#pragma unroll
                for (int bj = 0; bj < 2; ++bj) { f32x4 v0 = acc[ai][bj][m][0] + bv[bj][0], v1 = acc[ai][bj][m][1] + bv[bj][1];
                    if (ACT == 1) { f32x2 a = gelu_pk((f32x2){v0[0], v0[1]}), b = gelu_pk((f32x2){v0[2], v0[3]}), c = gelu_pk((f32x2){v1[0], v1[1]}), d = gelu_pk((f32x2){v1[2], v1[3]});
                        v0 = (f32x4){a.x, a.y, b.x, b.y}; v1 = (f32x4){c.x, c.y, d.x, d.y}; }
                    v0 = v0 * sc; v1 = v1 * sc; u32x4 w; w.x = cvt_pk_bf16(v0[0], v0[1]); w.y = cvt_pk_bf16(v0[2], v0[3]); w.z = cvt_pk_bf16(v1[0], v1[1]); w.w = cvt_pk_bf16(v1[2], v1[3]);
                    *(u32x4*)(rowp + bj * HALF) = w; } }
    }
};

template <class Epi, class Sched, bool ALIGN_EPI = false, bool SP2 = false>
__device__ __forceinline__ void gemm_phase(PG8_LAS unsigned char* lds, const Gemm g, const Sched& S, const Epi& E) {
    const int tid = threadIdx.x, wid = __builtin_amdgcn_readfirstlane(tid >> 6), lane = tid & 63, wr = wid >> 2, wc = wid & 3, fr = lane & 15, fq = lane >> 4;
    const int K = g.K, nt = K / BK;
    unsigned voffA[2], voffB[2];
#pragma unroll
    for (int i = 0; i < 2; ++i) { int R, C; stage_rc(tid * 16 + i * 8192, R, C); const int Rb = Epi::PERM ? ((R & ~31) + perm32(R & 31)) : R;
        voffA[i] = (unsigned)(R * g.lda + C) * 2u; voffB[i] = (unsigned)(Rb * g.ldb + C) * 2u; }
    const size_t kstep = (size_t)(BK * 2);
    const size_t hstepA = (size_t)HALF * g.lda * 2, hstepB = (size_t)HALF * g.ldb * 2;
    const size_t tstepA = 2 * hstepA, tstepB = 2 * hstepB;
    const unsigned ldsw = (unsigned)wid * 1024u;
    const int aoff = lds_byte(wr * 64 + fr, fq * 8), boff = lds_byte(wc * 32 + fr, fq * 8);
#define PG8_SA(b, h) (((b) * 2 + (h)) * HTB)
#define PG8_SB(b, h) ((4 + (b) * 2 + (h)) * HTB)
#define PG8_STAGE(bufoff, gbase, voff) do { _Pragma("unroll") for (int _i = 0; _i < 2; ++_i) \
        __builtin_amdgcn_global_load_lds((const unsigned*)((const char*)(gbase) + (voff)[_i]), (PG8_LAS unsigned*)(lds + (bufoff) + ldsw + _i * 8192), 16, 0, 0); } while (0)
#define PG8_LDA(dst, b, h) do { _Pragma("unroll") for (int m = 0; m < 4; ++m) _Pragma("unroll") for (int k = 0; k < 2; ++k) dst[m][k] = *(const PG8_LAS bf16x8*)(lds + PG8_SA(b, h) + aoff + m * 2048 + k * 1024); } while (0)
#define PG8_LDB(dst, b, h) do { _Pragma("unroll") for (int n = 0; n < 2; ++n) _Pragma("unroll") for (int k = 0; k < 2; ++k) dst[n][k] = *(const PG8_LAS bf16x8*)(lds + PG8_SB(b, h) + boff + n * 2048 + k * 1024); } while (0)
#define PG8_MMA(ai, bj, At, Bt) do { __builtin_amdgcn_s_setprio(1); _Pragma("unroll") for (int m = 0; m < 4; ++m) _Pragma("unroll") for (int n = 0; n < 2; ++n) _Pragma("unroll") for (int k = 0; k < 2; ++k) \
        acc[ai][bj][m][n] = __builtin_amdgcn_mfma_f32_16x16x32_bf16(Bt[n][k], At[m][k], acc[ai][bj][m][n], 0, 0, 0); __builtin_amdgcn_s_setprio(0); } while (0)
#define PG8_WAIT_V(n) asm volatile("s_waitcnt vmcnt(" #n ")" ::: "memory")
#define PG8_WAIT_L(n) asm volatile("s_waitcnt lgkmcnt(" #n ")" ::: "memory")
#define PG8_BAR __builtin_amdgcn_s_barrier()
#define PG8_SCHED __builtin_amdgcn_sched_barrier(0)
    Unit cur, nxt; int ui = 0;
    if (!S.next(0, cur)) return;
    f32x4 acc[2][2][4][2];
#pragma unroll
    for (int a = 0; a < 2; ++a)
#pragma unroll
        for (int b = 0; b < 2; ++b)
#pragma unroll
            for (int m = 0; m < 4; ++m)
#pragma unroll
                for (int n = 0; n < 2; ++n) acc[a][b][m][n] = (f32x4){0.f, 0.f, 0.f, 0.f};
    bf16x8 At[4][2], B0[2][2], B1[2][2];
    const char* cA = (const char*)g.A + (size_t)cur.pm * tstepA; const char* cB = (const char*)g.Bt + (size_t)cur.pn * tstepB;
    S.a_ready(cur);
    if constexpr (SP2) {
        PG8_STAGE(PG8_SB(0, 0), cB, voffB); PG8_STAGE(PG8_SB(0, 1), cB + hstepB, voffB); PG8_STAGE(PG8_SA(0, 0), cA, voffA); PG8_STAGE(PG8_SA(0, 1), cA + hstepA, voffA);
        if (wr == 1) PG8_BAR;
        PG8_WAIT_V(2); PG8_BAR;
        PG8_STAGE(PG8_SB(1, 0), cB + kstep, voffB); PG8_STAGE(PG8_SA(1, 0), cA + kstep, voffA); PG8_STAGE(PG8_SB(1, 1), cB + hstepB + kstep, voffB);
        PG8_WAIT_V(6); PG8_BAR;
    } else {
        PG8_STAGE(PG8_SB(0, 0), cB, voffB); PG8_STAGE(PG8_SA(0, 0), cA, voffA); PG8_STAGE(PG8_SB(0, 1), cB + hstepB, voffB); PG8_STAGE(PG8_SA(0, 1), cA + hstepA, voffA);
        if (wr == 1) PG8_BAR;
        PG8_WAIT_V(4); PG8_BAR;
        PG8_STAGE(PG8_SB(1, 0), cB + kstep, voffB); PG8_STAGE(PG8_SA(1, 0), cA + kstep, voffA); PG8_STAGE(PG8_SB(1, 1), cB + hstepB + kstep, voffB);
        PG8_WAIT_V(6); PG8_BAR;
    }
    for (;;) {
        const bool has_next = S.next(ui + 1, nxt);
        const char* nA = has_next ? (const char*)g.A + (size_t)nxt.pm * tstepA : cA; const char* nB = has_next ? (const char*)g.Bt + (size_t)nxt.pn * tstepB : cB;
        for (int t = 0; t < nt; t += 2) {
            const bool last = (t == nt - 2);
            const char* a1 = cA + (size_t)(t + 1) * kstep;
            const char* a2 = last ? nA : cA + (size_t)(t + 2) * kstep; const char* b2 = last ? nB : cB + (size_t)(t + 2) * kstep;
            const char* a3 = a2 + kstep; const char* b3 = b2 + kstep;
            if (last && has_next) S.a_ready(nxt);
            if constexpr (SP2) {
            PG8_LDB(B0, 0, 0); PG8_LDB(B1, 0, 1); PG8_SCHED; PG8_LDA(At, 0, 0); PG8_STAGE(PG8_SA(1, 1), a1 + hstepA, voffA);
            PG8_WAIT_V(8); PG8_WAIT_L(0); PG8_BAR; PG8_MMA(0, 0, At, B0); PG8_MMA(0, 1, At, B1); PG8_BAR; PG8_SCHED;
            PG8_LDA(At, 0, 1); PG8_STAGE(PG8_SB(0, 0), b2, voffB); PG8_STAGE(PG8_SB(0, 1), b2 + hstepB, voffB); PG8_STAGE(PG8_SA(0, 0), a2, voffA);
            PG8_WAIT_V(8); PG8_WAIT_L(0); PG8_BAR; PG8_MMA(1, 0, At, B0); PG8_MMA(1, 1, At, B1); PG8_BAR; PG8_SCHED;
            PG8_LDB(B0, 1, 0); PG8_LDB(B1, 1, 1); PG8_SCHED; PG8_LDA(At, 1, 0); PG8_STAGE(PG8_SA(0, 1), a2 + hstepA, voffA);
            PG8_WAIT_V(8); PG8_WAIT_L(0); PG8_BAR; PG8_MMA(0, 0, At, B0); PG8_MMA(0, 1, At, B1); PG8_BAR; PG8_SCHED;
            PG8_LDA(At, 1, 1); PG8_STAGE(PG8_SB(1, 0), b3, voffB); PG8_STAGE(PG8_SB(1, 1), b3 + hstepB, voffB); PG8_STAGE(PG8_SA(1, 0), a3, voffA);
            PG8_WAIT_V(8); PG8_WAIT_L(0); PG8_BAR; PG8_MMA(1, 0, At, B0); PG8_MMA(1, 1, At, B1); PG8_BAR; PG8_SCHED;
            } else {
            PG8_LDB(B0, 0, 0); PG8_SCHED; PG8_LDA(At, 0, 0); PG8_STAGE(PG8_SA(1, 1), a1 + hstepA, voffA);
            PG8_WAIT_L(8); PG8_BAR; PG8_WAIT_L(0); PG8_MMA(0, 0, At, B0); PG8_BAR; PG8_SCHED;
            PG8_LDB(B1, 0, 1); PG8_STAGE(PG8_SB(0, 0), b2, voffB);
            PG8_BAR; PG8_WAIT_L(0); PG8_MMA(0, 1, At, B1); PG8_BAR;
            PG8_LDA(At, 0, 1); PG8_STAGE(PG8_SA(0, 0), a2, voffA);
            PG8_BAR; PG8_WAIT_L(0); PG8_MMA(1, 0, At, B0); PG8_BAR; PG8_SCHED;
            PG8_STAGE(PG8_SB(0, 1), b2 + hstepB, voffB);
            PG8_WAIT_V(6); PG8_BAR; PG8_MMA(1, 1, At, B1); PG8_BAR;
            PG8_LDB(B0, 1, 0); PG8_SCHED; PG8_LDA(At, 1, 0); PG8_STAGE(PG8_SA(0, 1), a2 + hstepA, voffA);
            PG8_WAIT_L(8); PG8_BAR; PG8_WAIT_L(0); PG8_MMA(0, 0, At, B0); PG8_BAR; PG8_SCHED;
            PG8_LDB(B1, 1, 1); PG8_STAGE(PG8_SB(1, 0), b3, voffB);
            PG8_BAR; PG8_WAIT_L(0); PG8_MMA(0, 1, At, B1); PG8_BAR;
            PG8_LDA(At, 1, 1); PG8_STAGE(PG8_SA(1, 0), a3, voffA);
            PG8_BAR; PG8_WAIT_L(0); PG8_MMA(1, 0, At, B0); PG8_BAR; PG8_SCHED;
            PG8_STAGE(PG8_SB(1, 1), b3 + hstepB, voffB);
            PG8_WAIT_V(6); PG8_BAR; PG8_MMA(1, 1, At, B1); PG8_BAR;
            }
        }
        if constexpr (ALIGN_EPI) { if (wr == 0) PG8_BAR; }
        if constexpr (!Epi::AFTER_DRAIN) { E(acc, cur, wr, wc, fr, fq); S.done(cur); }
        if (!has_next) break;
#pragma unroll
        for (int a = 0; a < 2; ++a)
#pragma unroll
            for (int b = 0; b < 2; ++b)
#pragma unroll
                for (int m = 0; m < 4; ++m)
#pragma unroll
                    for (int n = 0; n < 2; ++n) acc[a][b][m][n] = (f32x4){0.f, 0.f, 0.f, 0.f};
        cur = nxt; cA = nA; cB = nB; ++ui;
        if constexpr (ALIGN_EPI) { if (wr == 1) PG8_BAR; }
    }
    PG8_WAIT_V(0);
    if constexpr (!ALIGN_EPI) { if (wr == 0) PG8_BAR; }
    PG8_BAR;
    if constexpr (Epi::AFTER_DRAIN) { E.fused(acc, cur, wr, wc, fr, fq, lds, wid, lane); S.done(cur); }
#undef PG8_SA
#undef PG8_SB
#undef PG8_STAGE
#undef PG8_LDA
#undef PG8_LDB
#undef PG8_MMA
#undef PG8_WAIT_V
#undef PG8_WAIT_L
#undef PG8_BAR
#undef PG8_SCHED
}
}

#ifndef MK_EXP_OLD
#define MK_EXP_OLD 0
#endif
#ifndef MK_ONE_LAUNCH
#define MK_ONE_LAUNCH 1
#endif
#define LAS __attribute__((address_space(3)))
typedef unsigned short bf16;
typedef unsigned v4u __attribute__((ext_vector_type(4)));
typedef unsigned v2u __attribute__((ext_vector_type(2)));
typedef float f32x4 __attribute__((ext_vector_type(4)));
typedef float f32x2 __attribute__((ext_vector_type(2)));
typedef short bf16x8 __attribute__((ext_vector_type(8)));
typedef float f32x16 __attribute__((ext_vector_type(16)));
#define MFMA32(a, b, c) __builtin_amdgcn_mfma_f32_32x32x16_bf16((a), (b), (c), 0, 0, 0)

constexpr int D = 1024, NB = 8, SEQ = 2048, LC = 256, ML = NB * SEQ  , MC = NB * LC  , MT = ML + MC  ;
constexpr int PROJ = 2576, NPROJ = 2560;
constexpr int NEXP = 16384, TOPK = 16, KK = 128;
constexpr float EPS = 1e-6f;
constexpr int NTHREADS = 512, NWAVES = 8;
constexpr int LDS_BYTES = 147456;
constexpr int NPHASES = 16;

constexpr size_t MiB = 1u << 20;
constexpr size_t WS_CTL = 0;
constexpr size_t CTL_ZERO_BYTES = 65536;
constexpr int CW_BAR = 0;
constexpr int CW_E1 = 4096, CW_E2 = 4096 + 8 * 64;
constexpr size_t WS_MOD = 1 * MiB;
constexpr size_t WS_LP = 1 * MiB + 512 * 1024;
constexpr size_t WS_WIN = 2 * MiB;
constexpr size_t WS_WOUT = 8 * MiB;
constexpr size_t WS_WGLU = 10 * MiB;
constexpr size_t WS_WQ = 11 * MiB;
constexpr size_t WS_GB = 15 * MiB;
constexpr size_t WS_BB = 17 * MiB;
constexpr size_t WS_PM = 41 * MiB;
constexpr size_t WS_OG = 17 * MiB;
constexpr size_t WS_HX2 = 17 * MiB;
constexpr size_t WS_U5 = 49 * MiB;
constexpr size_t WS_CAT = 49 * MiB;
constexpr size_t WS_IDX = 49 * MiB;
constexpr size_t WS_GATE = 57 * MiB;
constexpr size_t WS_ACT = 65 * MiB;
constexpr size_t WS_SSQP = 73 * MiB;
constexpr size_t WS_Z = 85 * MiB;
constexpr size_t WS_YRAW = 85 * MiB;
constexpr size_t WS_QP = 85 * MiB;
constexpr size_t WS_Y = 85 * MiB;
constexpr size_t WS_HX = 101 * MiB;
constexpr size_t WS_SS = 101 * MiB;
constexpr size_t WS_YG = 101 * MiB;
constexpr size_t WS_FRT = 125 * MiB;
constexpr size_t WS_QKVPRE = 137 * MiB;
constexpr size_t WS_FRA = 143 * MiB;
constexpr size_t WS_FRK = 161 * MiB;
constexpr size_t WS_FRTAB = 197 * MiB;
constexpr size_t WS_QKV = 202 * MiB;
constexpr size_t WS_U8 = 202 * MiB;
constexpr size_t WS_V8 = 218 * MiB;
constexpr size_t WS_USC = 234 * MiB;
constexpr size_t WS_VSC = 234 * MiB + 512 * 1024;
constexpr size_t WS_HQ8 = 150 * MiB;
constexpr size_t WS_HS = 183 * MiB;
constexpr size_t WS_PACT = 85 * MiB;
constexpr size_t WS_END = 256 * MiB;
static_assert(WS_BB + (size_t)32 * 512 * 768 * 2 <= WS_PM && WS_PM + (size_t)32 * 256 * 512 * 2 <= WS_U5 && WS_U5 + (size_t)32 * 768 * 768 * 2 <= WS_Z && WS_Z + (size_t)ML * 512 * 2 <= WS_HX, "ws map a");
static_assert(WS_HX + (size_t)MT * D * 2 <= WS_QKVPRE && WS_SS + (size_t)32 * 768 * 256 * 4 <= WS_FRT && WS_QKVPRE + (size_t)MT * 1536 * 2 <= WS_QKV && WS_QKV + (size_t)MT * 1536 * 2 <= WS_END, "ws map b");
static_assert(WS_FRT + (size_t)2304 * 8192 <= WS_FRA && WS_FRA + (size_t)2304 * 8192 <= WS_FRK && WS_FRK + (size_t)2304 * 16384 <= WS_FRTAB && WS_FRTAB + (size_t)2304 * 1024 <= WS_QKV, "ws map c");
static_assert(WS_OG + (size_t)2 * ML * 512 * 2 <= WS_CAT && WS_CAT + (size_t)ML * D * 2 <= WS_Z && WS_YRAW + (size_t)ML * D * 4 <= WS_U8 && WS_SSQP + (size_t)8 * ML * 4 <= WS_Z && WS_YG + (size_t)ML * 512 * 2 <= WS_FRT, "ws map d");

__device__ __forceinline__ unsigned f2bf(float f) { unsigned u = __builtin_bit_cast(unsigned, f); return (u + 0x7fffu + ((u >> 16) & 1u)) >> 16; }
typedef __bf16 bf16x2_t __attribute__((ext_vector_type(2)));
__device__ __forceinline__ unsigned pk2(float lo, float hi) { const f32x2 v = {lo, hi}; return __builtin_bit_cast(unsigned, __builtin_convertvector(v, bf16x2_t)); }
__device__ __forceinline__ float bflo(unsigned w) { return __builtin_bit_cast(float, w << 16); }
__device__ __forceinline__ float bfhi(unsigned w) { return __builtin_bit_cast(float, w & 0xffff0000u); }
__device__ __forceinline__ float bf1(bf16 h) { return __builtin_bit_cast(float, (unsigned)h << 16); }
__device__ __forceinline__ float wave_sum(float v) {
#pragma unroll
    for (int o = 1; o < 64; o <<= 1) v += __shfl_xor(v, o);
    return v;
}
__device__ __forceinline__ float wave_max(float v) {
#pragma unroll
    for (int o = 1; o < 64; o <<= 1) v = fmaxf(v, __shfl_xor(v, o));
    return v;
}
__device__ __forceinline__ float sigmoidf_(float x) { return __builtin_amdgcn_rcpf(1.f + __expf(-x)); }
__device__ __forceinline__ float siluf_(float x) { return x * __builtin_amdgcn_rcpf(1.f + __expf(-x)); }
__device__ __forceinline__ float gelu_erf(float x) { return 0.5f * x * (1.f + erff(x * 0.70710678118654752f)); }
__device__ __forceinline__ void sincos_d(double a, float& s, float& c) {
    const double k = rint(a * 0.63661977236758134308);
    const double r = fma(-k, 1.57079632679489661923, a) - k * 6.123233995736766e-17;
    const double r2 = r * r;
    double sp = -2.5052108385441720e-08; sp = sp * r2 + 2.7557319223985893e-06; sp = sp * r2 - 1.9841269841269841e-04; sp = sp * r2 + 8.3333333333333332e-03; sp = sp * r2 - 1.6666666666666666e-01;
    const double sn = r + r * r2 * sp;
    double cp = 2.0876756987868099e-09; cp = cp * r2 - 2.7557319223985888e-07; cp = cp * r2 + 2.4801587301587302e-05; cp = cp * r2 - 1.3888888888888889e-03; cp = cp * r2 + 4.1666666666666664e-02; cp = cp * r2 - 0.5;
    const double cs = 1.0 + r2 * cp;
    const int q = ((int)k) & 3;
    const double ss = (q == 0) ? sn : (q == 1) ? cs : (q == 2) ? -sn : -cs;
    const double cc = (q == 0) ? cs : (q == 1) ? -sn : (q == 2) ? -cs : sn;
    s = (float)ss; c = (float)cc;
}

struct Args { const float* in[29]; float* out; unsigned char* ws; int ph_lo, ph_hi; };
static_assert(sizeof(Args) == 29 * 8 + 8 + 8 + 8, "Args has no padding");
enum { I_X = 0, I_C, I_CTX, I_CCTX, I_WMOD, I_BMOD, I_GPREMIX, I_GPOSTMIX, I_GPREFFN, I_GPOSTFFN, I_WIN, I_WOUT, I_LAMRE, I_LAMIM, I_LOGDT, I_BRE, I_BIM, I_CRE, I_CIM, I_S5D, I_WGLU,
       I_CONV, I_ALOG, I_DTBIAS, I_GDNNORM, I_WQ, I_KEYS, I_PU, I_PV };

__device__ __forceinline__ const float* in_row(const Args& a, int row) { return row < ML ? a.in[I_X] + (size_t)row * D : a.in[I_CTX] + (size_t)(row - ML) * D; }
__device__ __forceinline__ int mod_row(int row) { return row < ML ? (row >> 11) : 8; }

template <int CTRL> __device__ __forceinline__ float dppf(float v) { return __builtin_bit_cast(float, __builtin_amdgcn_update_dpp(0, __builtin_bit_cast(int, v), CTRL, 0xf, 0xf, true)); }
__device__ __forceinline__ float row_sum16(float v) { v += dppf<0xB1>(v); v += dppf<0x4E>(v); v += dppf<0x141>(v); v += dppf<0x140>(v); return v; }
__device__ __forceinline__ float row_max16(float v) { v = fmaxf(v, dppf<0xB1>(v)); v = fmaxf(v, dppf<0x4E>(v)); v = fmaxf(v, dppf<0x141>(v)); v = fmaxf(v, dppf<0x140>(v)); return v; }
__device__ __forceinline__ float wsum(float v) { v = row_sum16(v); return
    __builtin_bit_cast(float, __builtin_amdgcn_readlane(__builtin_bit_cast(int, v), 0)) + __builtin_bit_cast(float, __builtin_amdgcn_readlane(__builtin_bit_cast(int, v), 16)) +
    __builtin_bit_cast(float, __builtin_amdgcn_readlane(__builtin_bit_cast(int, v), 32)) + __builtin_bit_cast(float, __builtin_amdgcn_readlane(__builtin_bit_cast(int, v), 48)); }
__device__ __forceinline__ float wmax(float v) { v = row_max16(v); return fmaxf(fmaxf(__builtin_bit_cast(float, __builtin_amdgcn_readlane(__builtin_bit_cast(int, v), 0)), __builtin_bit_cast(float, __builtin_amdgcn_readlane(__builtin_bit_cast(int, v), 16))),
    fmaxf(__builtin_bit_cast(float, __builtin_amdgcn_readlane(__builtin_bit_cast(int, v), 32)), __builtin_bit_cast(float, __builtin_amdgcn_readlane(__builtin_bit_cast(int, v), 48)))); }
__device__ __forceinline__ int lane_rank(unsigned long long m) { return __builtin_amdgcn_mbcnt_hi((unsigned)(m >> 32), __builtin_amdgcn_mbcnt_lo((unsigned)m, 0)); }
__device__ __forceinline__ unsigned fkey(float f) { const unsigned u = __builtin_bit_cast(unsigned, f); return u ^ ((unsigned)((int)u >> 31) | 0x80000000u); }
#define WAVE_LDS_SYNC() do { __builtin_amdgcn_fence(__ATOMIC_RELEASE, "wavefront"); __builtin_amdgcn_wave_barrier(); __builtin_amdgcn_fence(__ATOMIC_ACQUIRE, "wavefront"); } while (0)
template <int N> __device__ __forceinline__ unsigned kth_key(const unsigned (&k)[N], int K) {
    unsigned T = 0;
    for (int bit = 31; bit >= 0; --bit) { const unsigned cand = T | (1u << bit); int cnt = 0;
#pragma unroll
        for (int n = 0; n < N; ++n) cnt += __popcll(__ballot(k[n] >= cand));
        if (cnt >= K) T = cand;
        if (cnt == K) break; }
    return T;
}

namespace pg8 {
struct EpiInProj {
    static constexpr bool PERM = true, AFTER_DRAIN = false;
    bf16_t* U; bf16_t* QKV; bf16_t* Z;
    __device__ __forceinline__ void operator()(const f32x4 (&acc)[2][2][4][2], const Unit& u, int wr, int wc, int fr, int fq) const {
        bf16_t* base; int ld, colt; bool lat_only = false;
        const bool s5 = u.pn < 2;
        if (s5) { base = U; ld = 0; colt = u.pn * BM; }
        else if (u.pn < 8) { base = QKV; ld = 1536; colt = (u.pn - 2) * BM; }
        else { base = Z; ld = 512; colt = (u.pn - 8) * BM; lat_only = true; }
        const int row0 = u.pm * BM + wr * 64 + fr, col0 = colt + wc * 32 + 8 * fq;
#pragma unroll
        for (int ai = 0; ai < 2; ++ai)
#pragma unroll
            for (int m = 0; m < 4; ++m) { const int row = row0 + ai * HALF + m * 16; bf16_t* rowp = base + (size_t)row * ld + col0;
                if (lat_only && row >= 16384) continue;
                if (s5) { const int R = row < 16384 ? (row >> 5) : 512 + ((row - 16384) >> 5), ii = row & 31; rowp = base + (size_t)R * 768 + ii * 16 + (col0 & 15); }
#pragma unroll
                for (int bj = 0; bj < 2; ++bj) { const f32x4 v0 = acc[ai][bj][m][0], v1 = acc[ai][bj][m][1];
                    u32x4 w; w.x = cvt_pk_bf16(v0[0], v0[1]); w.y = cvt_pk_bf16(v0[2], v0[3]); w.z = cvt_pk_bf16(v1[0], v1[1]); w.w = cvt_pk_bf16(v1[2], v1[3]);
                    if (s5) *(u32x4*)(rowp + (size_t)((col0 + bj * HALF) >> 4) * (768 * 768)) = w; else *(u32x4*)(rowp + bj * HALF) = w; } }
    }
};
struct EpiGlu {
    static constexpr bool PERM = true, AFTER_DRAIN = false;
    const bf16_t* YG; bf16_t* CAT;
    __device__ __forceinline__ void operator()(const f32x4 (&acc)[2][2][4][2], const Unit& u, int wr, int wc, int fr, int fq) const {
        const int row0 = u.pm * BM + wr * 64 + fr, col0 = u.pn * BM + wc * 32 + 8 * fq;
#pragma unroll
        for (int ai = 0; ai < 2; ++ai)
#pragma unroll
            for (int m = 0; m < 4; ++m) { const int row = row0 + ai * HALF + m * 16;
#pragma unroll
                for (int bj = 0; bj < 2; ++bj) { const f32x4 v0 = acc[ai][bj][m][0], v1 = acc[ai][bj][m][1];
                    const u32x4 y = *(const u32x4*)(YG + (size_t)row * 512 + col0 + bj * HALF);
                    float o[8]; const float a[8] = {v0[0], v0[1], v0[2], v0[3], v1[0], v1[1], v1[2], v1[3]};
                    const unsigned yw[4] = {y.x, y.y, y.z, y.w};
#pragma unroll
                    for (int e = 0; e < 8; ++e) { const float yv = __builtin_bit_cast(float, (e & 1) ? (yw[e >> 1] & 0xffff0000u) : (yw[e >> 1] << 16)); o[e] = yv * __builtin_amdgcn_rcpf(1.f + __expf(-a[e])); }
                    u32x4 w; w.x = cvt_pk_bf16(o[0], o[1]); w.y = cvt_pk_bf16(o[2], o[3]); w.z = cvt_pk_bf16(o[4], o[5]); w.w = cvt_pk_bf16(o[6], o[7]);
                    *(u32x4*)(CAT + (size_t)row * 1024 + col0 + bj * HALF) = w; } }
    }
};
struct EpiF32 {
    static constexpr bool PERM = false, AFTER_DRAIN = false;
    float* C; int ldc;
    __device__ __forceinline__ void operator()(const f32x4 (&acc)[2][2][4][2], const Unit& u, int wr, int wc, int fr, int fq) const {
        const int row0 = u.pm * BM + wr * 64 + fr, col0 = u.pn * BM + wc * 32 + 4 * fq;
#pragma unroll
        for (int ai = 0; ai < 2; ++ai)
#pragma unroll
            for (int m = 0; m < 4; ++m) { float* rowp = C + (size_t)(row0 + ai * HALF + m * 16) * ldc + col0;
#pragma unroll
                for (int bj = 0; bj < 2; ++bj)
#pragma unroll
                    for (int n = 0; n < 2; ++n) *(f32x4*)(rowp + bj * HALF + n * 16) = acc[ai][bj][m][n]; }
    }
};
struct EpiSS {
    static constexpr bool PERM = false, AFTER_DRAIN = false;
    float* C;
    __device__ __forceinline__ void operator()(const f32x4 (&acc)[2][2][4][2], const Unit& u, int wr, int wc, int fr, int fq) const {
        const int row0 = u.pm * BM + wr * 64 + fr, col0 = wc * 32 + 4 * fq;
#pragma unroll
        for (int ai = 0; ai < 2; ++ai)
#pragma unroll
            for (int m = 0; m < 4; ++m) { float* rowp = C + (size_t)(row0 + ai * HALF + m * 16) * 256 + col0;
#pragma unroll
                for (int bj = 0; bj < 2; ++bj)
#pragma unroll
                    for (int n = 0; n < 2; ++n) *(f32x4*)(rowp + bj * HALF + n * 16) = acc[ai][bj][m][n]; }
    }
};
struct SchedSS { int G, c; __device__ bool next(int i, Unit& u) const { const int L = i * G + c; if (L >= 96) return false; u.pm = L; u.pn = L / 3; return true; }
    __device__ __forceinline__ void a_ready(const Unit&) const {} __device__ __forceinline__ void done(const Unit&) const {} };
struct EpiS5Y {
    static constexpr bool PERM = true, AFTER_DRAIN = false;
    bf16_t* YG;
    __device__ __forceinline__ void operator()(const f32x4 (&acc)[2][2][4][2], const Unit& u, int wr, int wc, int fr, int fq) const {
        const int g = u.pn >> 1, R0 = (u.pm - 3 * g) * BM + wr * 64 + fr, n0 = (u.pn & 1) * BM + wc * 32 + 8 * fq;
#pragma unroll
        for (int ai = 0; ai < 2; ++ai)
#pragma unroll
            for (int m = 0; m < 4; ++m) { const int R = R0 + ai * HALF + m * 16;
#pragma unroll
                for (int bj = 0; bj < 2; ++bj) { const int n = n0 + bj * HALF; const f32x4 v0 = acc[ai][bj][m][0], v1 = acc[ai][bj][m][1];
                    const f32x2 a = gelu_pk((f32x2){v0[0], v0[1]}), b = gelu_pk((f32x2){v0[2], v0[3]}), c2 = gelu_pk((f32x2){v1[0], v1[1]}), d = gelu_pk((f32x2){v1[2], v1[3]});
                    u32x4 w; w.x = cvt_pk_bf16(a.x, a.y); w.y = cvt_pk_bf16(b.x, b.y); w.z = cvt_pk_bf16(c2.x, c2.y); w.w = cvt_pk_bf16(d.x, d.y);
                    *(u32x4*)(YG + (size_t)(R * 32 + (n >> 4)) * 512 + g * 16 + (n & 15)) = w; } }
    }
};
struct SchedS5Y { int G, c; __device__ bool next(int i, Unit& u) const { const int L = i * G + c; if (L >= 128) return false; const int g = L >> 2; u.pm = 3 * g + ((L >> 1) & 1); u.pn = 2 * g + (L & 1); return true; }
    __device__ __forceinline__ void a_ready(const Unit&) const {} __device__ __forceinline__ void done(const Unit&) const {} };
}

struct Ctx { const Args* a; unsigned char* ws; unsigned char* lds; int tid, lane, wave, bid, G, gw, NGW, gwv; };

__device__ __forceinline__ void p0_transpose_item(const float* W, int ldw, int nblk, int K, bf16* WT, float* scr, int item, int lane) {
    const int kb = item / nblk, nb = item % nblk, k0 = 64 * kb, n0 = 32 * nb;
#pragma unroll 8
    for (int i = 0; i < 32; ++i) { const int kk = 2 * i + (lane >> 5); scr[kk * 33 + (lane & 31)] = W[(size_t)(k0 + kk) * ldw + n0 + (lane & 31)]; }
    __builtin_amdgcn_fence(__ATOMIC_RELEASE, "wavefront"); __builtin_amdgcn_wave_barrier(); __builtin_amdgcn_fence(__ATOMIC_ACQUIRE, "wavefront");
    const int c = lane & 7;
#pragma unroll
    for (int j = 0; j < 4; ++j) { const int n = (lane >> 3) + 8 * j; const float* s = scr + (8 * c) * 33 + n;
        v4u o; o.x = pk2(s[0 * 33], s[1 * 33]); o.y = pk2(s[2 * 33], s[3 * 33]); o.z = pk2(s[4 * 33], s[5 * 33]); o.w = pk2(s[6 * 33], s[7 * 33]);
        *(v4u*)(WT + (size_t)(n0 + n) * K + k0 + 8 * c) = o; }
    __builtin_amdgcn_fence(__ATOMIC_RELEASE, "wavefront"); __builtin_amdgcn_wave_barrier(); __builtin_amdgcn_fence(__ATOMIC_ACQUIRE, "wavefront");
}
__device__ __forceinline__ void phase_prep(const Ctx& c) {
    const Args& a = *c.a;
    float* scr = (float*)(c.lds + c.wave * 16384);
    constexpr int I_IN = 16 * 80, I_OUT = 16 * 32, I_GLU = 8 * 16, I_Q = 16 * 64;
    for (int it = c.gw; it < I_IN + I_OUT + I_GLU + I_Q; it += c.NGW) {
        int r = it;
        if (r < I_IN) { p0_transpose_item(a.in[I_WIN], PROJ, 80, 1024, (bf16*)(c.ws + WS_WIN), scr, r, c.lane); continue; } r -= I_IN;
        if (r < I_OUT) { p0_transpose_item(a.in[I_WOUT], 1024, 32, 1024, (bf16*)(c.ws + WS_WOUT), scr, r, c.lane); continue; } r -= I_OUT;
        if (r < I_GLU) { p0_transpose_item(a.in[I_WGLU], 512, 16, 512, (bf16*)(c.ws + WS_WGLU), scr, r, c.lane); continue; } r -= I_GLU;
        p0_transpose_item(a.in[I_WQ], 2048, 64, 1024, (bf16*)(c.ws + WS_WQ), scr, r, c.lane);
    }
    __syncthreads();
    float* sc = (float*)c.lds;
    float* red = (float*)(c.lds + 9 * 1024 * 4);
    float* MOD = (float*)(c.ws + WS_MOD);
    bool have = false;
    for (int item = c.bid; item < 96; item += c.G) {
        if (!have) { for (int i = c.tid; i < 9 * 1024; i += NTHREADS) { const int r = i >> 10, k = i & 1023; const float v = r < 8 ? a.in[I_C][r * 1024 + k] : a.in[I_CCTX][k]; sc[i] = siluf_(v); } have = true; __syncthreads(); }
        const int n0 = item * 64;
        float acc[9];
#pragma unroll
        for (int r = 0; r < 9; ++r) acc[r] = 0.f;
        const float* wp = a.in[I_WMOD] + (size_t)(c.wave * 128) * 6144 + n0 + c.lane;
#pragma unroll 16
        for (int k = 0; k < 128; ++k) { const float w = wp[(size_t)k * 6144];
#pragma unroll
            for (int r = 0; r < 9; ++r) acc[r] = fmaf(sc[r * 1024 + c.wave * 128 + k], w, acc[r]); }
#pragma unroll
        for (int r = 0; r < 9; ++r) red[(c.wave * 9 + r) * 64 + c.lane] = acc[r];
        __syncthreads();
        for (int i = c.tid; i < 576; i += NTHREADS) { const int r = i >> 6, l = i & 63; float s = a.in[I_BMOD][n0 + l];
#pragma unroll
            for (int w = 0; w < 8; ++w) s += red[(w * 9 + r) * 64 + l];
            MOD[r * 6144 + n0 + l] = s; }
        __syncthreads();
    }
}
__device__ __forceinline__ void s5_build_group(const Ctx& c, int g, int part);
__device__ __forceinline__ void phase_s5_build(const Ctx& c) { for (int it = c.G - 1 - c.bid; it < 128; it += c.G) if (it >= 0) s5_build_group(c, it >> 2, it & 3); }

__device__ __forceinline__ void phase_norm1(const Ctx& c) {
    const Args& a = *c.a;
    float* wabT = (float*)c.lds;
    { f32x4 wv[8];
#pragma unroll
      for (int q = 0; q < 8; ++q) { const int i = c.tid + NTHREADS * q, kk = i >> 2, qq = i & 3; wv[q] = *(const f32x4*)(a.in[I_WIN] + (size_t)kk * PROJ + NPROJ + 4 * qq); }
#pragma unroll
      for (int q = 0; q < 8; ++q) { const int i = c.tid + NTHREADS * q, kk = i >> 2, qq = i & 3; wabT[(4 * qq + 0) * 1028 + kk] = wv[q].x; wabT[(4 * qq + 1) * 1028 + kk] = wv[q].y; wabT[(4 * qq + 2) * 1028 + kk] = wv[q].z; wabT[(4 * qq + 3) * 1028 + kk] = wv[q].w; } }
    __syncthreads();
    const float* MOD = (const float*)(c.ws + WS_MOD);
    bf16* HX = (bf16*)(c.ws + WS_HX); float* GB = (float*)(c.ws + WS_GB);
    const float* gpre = a.in[I_GPREMIX];
    f32x4 nx[4];
    if (c.gw < MT) { const f32x4* xr = (const f32x4*)in_row(a, c.gw) + c.lane;
#pragma unroll
        for (int j = 0; j < 4; ++j) nx[j] = xr[64 * j]; }
    for (int row = c.gw; row < MT; row += c.NGW) {
        const float* mr = MOD + mod_row(row) * 6144;
        f32x4 v[4]; float ss = 0.f;
#pragma unroll
        for (int j = 0; j < 4; ++j) { v[j] = nx[j]; ss += (v[j].x * v[j].x + v[j].y * v[j].y) + (v[j].z * v[j].z + v[j].w * v[j].w); }
        if (row + c.NGW < MT) { const f32x4* xr = (const f32x4*)in_row(a, row + c.NGW) + c.lane;
#pragma unroll
            for (int j = 0; j < 4; ++j) nx[j] = xr[64 * j]; }
        const float r = rsqrtf(wsum(ss) * (1.f / D) + EPS);
#pragma unroll
        for (int j = 0; j < 4; ++j) { const int col = 4 * c.lane + 256 * j;
            const f32x4 g4 = *(const f32x4*)(gpre + col), sh = *(const f32x4*)(mr + col), scl = *(const f32x4*)(mr + 1024 + col);
            v[j] = (v[j] * r) * g4 * (scl + 1.f) + sh;
            v2u o; o.x = pk2(v[j].x, v[j].y); o.y = pk2(v[j].z, v[j].w);
            *(v2u*)(HX + (size_t)row * D + col) = o; }
        float pj[16];
#pragma unroll
        for (int j = 0; j < 16; ++j) { float s = 0.f;
#pragma unroll
            for (int jj = 0; jj < 4; ++jj) { const f32x4 w = *(const f32x4*)(wabT + j * 1028 + 4 * c.lane + 256 * jj); s += (v[jj].x * w.x + v[jj].y * w.y) + (v[jj].z * w.z + v[jj].w * w.w); }
            pj[j] = s; if ((j & 1) == 1) asm volatile("" ::: "memory"); }
        const bool b5 = c.lane & 32, b4 = c.lane & 16, b3 = c.lane & 8, b2 = c.lane & 4;
        float q8[8], q4[4], q2[2];
#pragma unroll
        for (int i = 0; i < 8; ++i) { const float keep = b5 ? pj[i + 8] : pj[i], send = b5 ? pj[i] : pj[i + 8]; q8[i] = keep + __shfl_xor(send, 32); }
#pragma unroll
        for (int i = 0; i < 4; ++i) { const float keep = b4 ? q8[i + 4] : q8[i], send = b4 ? q8[i] : q8[i + 4]; q4[i] = keep + __shfl_xor(send, 16); }
#pragma unroll
        for (int i = 0; i < 2; ++i) { const float keep = b3 ? q4[i + 2] : q4[i], send = b3 ? q4[i] : q4[i + 2]; q2[i] = keep + dppf<0x140>(send); }
        float mine; { const float keep = b2 ? q2[1] : q2[0], send = b2 ? q2[0] : q2[1]; mine = keep + dppf<0x141>(send); }
        mine += dppf<0xB1>(mine); mine += dppf<0x4E>(mine);
        const int jl = (b5 ? 8 : 0) + (b4 ? 4 : 0) + (b3 ? 2 : 0) + (b2 ? 1 : 0);
        if ((c.lane & 3) == 0) {
            if (jl < 8) { const float t = mine + a.in[I_DTBIAS][jl]; const float sp = t > 20.f ? t : log1pf(expf(t)); GB[(size_t)row * 16 + jl] = -expf(a.in[I_ALOG][jl]) * sp; }
            else GB[(size_t)row * 16 + jl] = 1.f / (1.f + expf(-mine)); }
    }
}

__device__ __forceinline__ void phase_conv(const Ctx& c) {
    const Args& a = *c.a;
    const bf16* PRE = (const bf16*)(c.ws + WS_QKVPRE); bf16* OUT = (bf16*)(c.ws + WS_QKV);
    const float* cw = a.in[I_CONV];
#pragma unroll 1
    for (int pass = 0; pass < 3; ++pass) { const int ch0 = pass * 512 + 8 * c.lane;
        f32x4 wt[9][2];
#pragma unroll
        for (int i = 0; i < 9; ++i) { wt[i][0] = *(const f32x4*)(cw + i * 1536 + ch0); wt[i][1] = *(const f32x4*)(cw + i * 1536 + ch0 + 4); }
#define CONV_LOAD(DST, ROW) do { const int row_ = (ROW); int nb_row[9]; bool ok[9]; \
            if (row_ < ML) { const int t = row_ & 2047, gr = t >> 6, gc = t & 63; \
                _Pragma("unroll") for (int dy = -1; dy <= 1; ++dy) _Pragma("unroll") for (int dx = -1; dx <= 1; ++dx) { const int i = (dy + 1) * 3 + dx + 1; ok[i] = (gr + dy >= 0) && (gr + dy < 32) && (gc + dx >= 0) && (gc + dx < 64); nb_row[i] = row_ + dy * 64 + dx; } } \
            else { const int t = (row_ - ML) & 255; _Pragma("unroll") for (int i = 0; i < 9; ++i) { ok[i] = false; nb_row[i] = row_; } \
                _Pragma("unroll") for (int dx = -1; dx <= 1; ++dx) { ok[4 + dx] = (t + dx >= 0) && (t + dx < 256); nb_row[4 + dx] = row_ + dx; } } \
            _Pragma("unroll") for (int i = 0; i < 9; ++i) DST[i] = ok[i] ? *(const v4u*)(PRE + (size_t)nb_row[i] * 1536 + ch0) : (v4u){0u, 0u, 0u, 0u}; } while (0)
        v4u nin[9];
        if (c.gw < MT) CONV_LOAD(nin, c.gw);
#pragma unroll 1
        for (int row = c.gw; row < MT; row += c.NGW) {
            v4u in[9];
#pragma unroll
            for (int i = 0; i < 9; ++i) in[i] = nin[i];
            if (row + c.NGW < MT) CONV_LOAD(nin, row + c.NGW);
            float o[8];
#pragma unroll
            for (int q = 0; q < 8; ++q) o[q] = 0.f;
#pragma unroll
            for (int i = 0; i < 9; ++i) { const unsigned w[4] = {in[i].x, in[i].y, in[i].z, in[i].w}; const float kk[8] = {wt[i][0].x, wt[i][0].y, wt[i][0].z, wt[i][0].w, wt[i][1].x, wt[i][1].y, wt[i][1].z, wt[i][1].w};
#pragma unroll
                for (int q = 0; q < 4; ++q) { o[2 * q] = fmaf(bflo(w[q]), kk[2 * q], o[2 * q]); o[2 * q + 1] = fmaf(bfhi(w[q]), kk[2 * q + 1], o[2 * q + 1]); } }
            float ssq = 0.f;
#pragma unroll
            for (int q = 0; q < 8; ++q) { o[q] = siluf_(o[q]); ssq = fmaf(o[q], o[q], ssq); }
            if (pass < 2) { const float sc = rsqrtf(row_sum16(ssq) + EPS) * (pass == 0 ? 0.08838834764831845f : 1.f);
#pragma unroll
                for (int q = 0; q < 8; ++q) o[q] *= sc; }
            v4u ov; ov.x = pk2(o[0], o[1]); ov.y = pk2(o[2], o[3]); ov.z = pk2(o[4], o[5]); ov.w = pk2(o[6], o[7]);
            *(v4u*)(OUT + (size_t)row * 1536 + ch0) = ov;
        }
#undef CONV_LOAD
    }
}

__device__ __forceinline__ int scan_row(int b, int dir, int step) {
    if (step < LC) { const int t = dir ? LC - 1 - step : step; return ML + b * LC + t; }
    const int t = step - LC; return b * SEQ + (dir ? SEQ - 1 - t : t);
}
__device__ __forceinline__ void phase_combine(const Ctx& c) {
    const Args& a = *c.a;
    const bf16* OG0 = (const bf16*)(c.ws + WS_OG); const bf16* OG1 = OG0 + (size_t)ML * 512; const bf16* Z = (const bf16*)(c.ws + WS_Z);
    bf16* CAT = (bf16*)(c.ws + WS_CAT);
    for (int row = c.gw; row < ML; row += c.NGW) {
#pragma unroll
        for (int h = 0; h < 4; ++h) { const int ch = h * 128 + 2 * c.lane;
            const unsigned w0 = *(const unsigned*)(OG0 + (size_t)row * 512 + ch), w1 = *(const unsigned*)(OG1 + (size_t)row * 512 + ch), zw = *(const unsigned*)(Z + (size_t)row * 512 + ch);
            const float o0 = bflo(w0) + bflo(w1), o1 = bfhi(w0) + bfhi(w1);
            const float r = rsqrtf(wave_sum(o0 * o0 + o1 * o1) * (1.f / 128.f) + EPS);
            const f32x2 ng = *(const f32x2*)(a.in[I_GDNNORM] + 2 * c.lane);
            *(unsigned*)(CAT + (size_t)row * 1024 + 512 + ch) = pk2(o0 * r * ng.x * siluf_(bflo(zw)), o1 * r * ng.y * siluf_(bfhi(zw))); }
    }
}

__device__ __forceinline__ void phase_rows2(const Ctx& c) {
    const Args& a = *c.a;
    const float* MOD = (const float*)(c.ws + WS_MOD); const bf16* YRAW = (const bf16*)(c.ws + WS_YRAW); bf16* HX2 = (bf16*)(c.ws + WS_HX2);
    v2u ny[4]; f32x4 nxx[4];
    if (c.gw < ML) {
#pragma unroll
        for (int j = 0; j < 4; ++j) { ny[j] = *((const v2u*)(YRAW + (size_t)c.gw * D) + c.lane + 64 * j); nxx[j] = *((const f32x4*)(a.in[I_X] + (size_t)c.gw * D) + c.lane + 64 * j); } }
    for (int row = c.gw; row < ML; row += c.NGW) {
        const float* mr = MOD + (row >> 11) * 6144;
        f32x4 y[4], x[4]; float ss = 0.f;
#pragma unroll
        for (int j = 0; j < 4; ++j) { y[j] = (f32x4){bflo(ny[j].x), bfhi(ny[j].x), bflo(ny[j].y), bfhi(ny[j].y)}; x[j] = nxx[j];
            ss += (y[j].x * y[j].x + y[j].y * y[j].y) + (y[j].z * y[j].z + y[j].w * y[j].w); }
        if (row + c.NGW < ML) { const size_t r2 = (size_t)(row + c.NGW);
#pragma unroll
            for (int j = 0; j < 4; ++j) { ny[j] = *((const v2u*)(YRAW + r2 * D) + c.lane + 64 * j); nxx[j] = *((const f32x4*)(a.in[I_X] + r2 * D) + c.lane + 64 * j); } }
        const float r = rsqrtf(wsum(ss) * (1.f / D) + EPS); float s2 = 0.f;
#pragma unroll
        for (int j = 0; j < 4; ++j) { const int col = 4 * c.lane + 256 * j;
            const f32x4 g4 = *(const f32x4*)(a.in[I_GPOSTMIX] + col), gt = *(const f32x4*)(mr + 2048 + col);
            x[j] = x[j] + gt * ((y[j] * r) * g4);
            *(f32x4*)(a.out + (size_t)row * D + col) = x[j];
            s2 += (x[j].x * x[j].x + x[j].y * x[j].y) + (x[j].z * x[j].z + x[j].w * x[j].w); }
        const float r2 = rsqrtf(wsum(s2) * (1.f / D) + EPS);
#pragma unroll
        for (int j = 0; j < 4; ++j) { const int col = 4 * c.lane + 256 * j;
            const f32x4 g4 = *(const f32x4*)(a.in[I_GPREFFN] + col), sh = *(const f32x4*)(mr + 3072 + col), scl = *(const f32x4*)(mr + 4096 + col);
            const f32x4 hv = (x[j] * r2) * g4 * (scl + 1.f) + sh;
            v2u o; o.x = pk2(hv.x, hv.y); o.y = pk2(hv.z, hv.w);
            *(v2u*)(HX2 + (size_t)row * D + col) = o;
            x[j] = (f32x4){bflo(o.x), bfhi(o.x), bflo(o.y), bfhi(o.y)}; }
        { float mx = 0.f;
#pragma unroll
          for (int j = 0; j < 4; ++j) mx = fmaxf(mx, fmaxf(fmaxf(fabsf(x[j].x), fabsf(x[j].y)), fmaxf(fabsf(x[j].z), fabsf(x[j].w))));
          mx = wmax(mx); const float hs = mx > 0.f ? 256.f / mx : 1.f;
          unsigned char* hq = c.ws + WS_HQ8 + (size_t)row * 2048;
#pragma unroll
          for (int j = 0; j < 4; ++j) { const float a0 = x[j].x * hs, a1 = x[j].y * hs, a2 = x[j].z * hs, a3 = x[j].w * hs;
              int w = __builtin_amdgcn_cvt_pk_fp8_f32(a0, a1, 0, false); w = __builtin_amdgcn_cvt_pk_fp8_f32(a2, a3, w, true);
              const f32x2 b01 = __builtin_amdgcn_cvt_pk_f32_fp8(w, false), b23 = __builtin_amdgcn_cvt_pk_f32_fp8(w, true);
              int w2 = __builtin_amdgcn_cvt_pk_fp8_f32((a0 - b01.x) * 16.f, (a1 - b01.y) * 16.f, 0, false); w2 = __builtin_amdgcn_cvt_pk_fp8_f32((a2 - b23.x) * 16.f, (a3 - b23.y) * 16.f, w2, true);
              *(unsigned*)(hq + 4 * c.lane + 256 * j) = (unsigned)w; *(unsigned*)(hq + 1024 + 4 * c.lane + 256 * j) = (unsigned)w2; }
          if (c.lane == 0) ((float*)(c.ws + WS_HS))[row] = 1.f / hs; }
    }
}


constexpr int KROW = 136;
__device__ __forceinline__ float unfkey(unsigned k) { const unsigned u = (k & 0x80000000u) ? (k ^ 0x80000000u) : ~k; return __builtin_bit_cast(float, u); }
__device__ __forceinline__ void ins16(unsigned (&L)[16], unsigned key) {
#pragma unroll
    for (int q = 0; q < 16; ++q) { const unsigned hi = L[q] > key ? L[q] : key, lo = L[q] > key ? key : L[q]; L[q] = hi; key = lo; }
}
__device__ __forceinline__ void sort16_desc(unsigned (&a)[16]) {
#pragma unroll
    for (int kk = 2; kk <= 16; kk <<= 1)
#pragma unroll
        for (int j = kk >> 1; j >= 1; j >>= 1)
#pragma unroll
            for (int i = 0; i < 16; ++i) { const int l = i ^ j; if (l > i) { const unsigned hi = a[i] > a[l] ? a[i] : a[l], lo = a[i] > a[l] ? a[l] : a[i]; if ((i & kk) == 0) { a[i] = hi; a[l] = lo; } else { a[i] = lo; a[l] = hi; } } }
}
__device__ __forceinline__ void top16_of_two(unsigned (&A)[16], const unsigned (&B)[16]) {
#pragma unroll
    for (int q = 0; q < 16; ++q) A[q] = A[q] > B[15 - q] ? A[q] : B[15 - q];
#pragma unroll
    for (int j = 8; j >= 1; j >>= 1)
#pragma unroll
        for (int q = 0; q < 16; ++q) if ((q & j) == 0) { const unsigned hi = A[q] > A[q + j] ? A[q] : A[q + j], lo = A[q] > A[q + j] ? A[q + j] : A[q]; A[q] = hi; A[q + j] = lo; }
}
__device__ __forceinline__ void merge16(unsigned (&L)[16]) {
    unsigned R[16];
#pragma unroll
    for (int q = 0; q < 16; ++q) R[q] = (unsigned)__shfl_xor((int)L[15 - q], 32);
#pragma unroll
    for (int q = 0; q < 16; ++q) L[q] = L[q] > R[q] ? L[q] : R[q];
#pragma unroll
    for (int j = 8; j >= 1; j >>= 1)
#pragma unroll
        for (int q = 0; q < 16; ++q) if ((q & j) == 0) { const unsigned hi = L[q] > L[q + j] ? L[q] : L[q + j], lo = L[q] > L[q + j] ? L[q + j] : L[q]; L[q] = hi; L[q + j] = lo; }
}
__device__ __forceinline__ void phase_topk(const Ctx& c) {
    const Args& a = *c.a;
    bf16* kl = (bf16*)c.lds;
    unsigned char* wtab = c.lds + 2 * 128 * KROW * 2 + c.wave * 1088;
    const bf16* QP = (const bf16*)(c.ws + WS_QP); int* IDX = (int*)(c.ws + WS_IDX); float* GATE = (float*)(c.ws + WS_GATE);
    const int r = c.lane & 31, hh = c.lane >> 5;
    { const unsigned char ptab[50] = {0, 1, 2, 3, 4, 5, 6, 7, 8, 9, 10, 11, 12, 13, 14, 15, 16, 17, 18, 19, 20, 21, 22, 23, 32, 33, 34, 35, 36, 48, 49, 50, 51, 64, 65, 66, 80, 81, 96, 97, 112, 113, 128, 144, 160, 176, 192, 208, 224, 240};
      if (c.lane < 50) wtab[1024 + c.lane] = ptab[c.lane < 50 ? c.lane : 0]; }
    for (int item = c.bid; item < 8 * 32; item += c.G) {
        const int h = item & 7, tr = item >> 3;
        __syncthreads();
        for (int i = c.tid; i < 2 * 128 * 64; i += NTHREADS) { const int k2 = i & 63, n = (i >> 6) & 127, p = i >> 13; const f32x2 kv = *(const f32x2*)(a.in[I_KEYS] + ((size_t)((h * 2 + p) * 128 + n)) * 128 + 2 * k2);
            *(unsigned*)(kl + (p * 128 + n) * KROW + 2 * k2) = pk2(kv.x, kv.y); }
        __syncthreads();
        for (int tile = c.wave; tile < 16; tile += NWAVES) {
            const int tok = tr * 512 + tile * 32 + r;
            unsigned LA[16], LB[16];
#pragma unroll
            for (int p = 0; p < 2; ++p) {
                bf16x8 qf[8];
#pragma unroll
                for (int kk = 0; kk < 8; ++kk) qf[kk] = *(const bf16x8*)(QP + (size_t)tok * 2048 + h * 256 + p * 128 + kk * 16 + hh * 8);
                f32x16 acc[4];
#pragma unroll
                for (int nt = 0; nt < 4; ++nt)
#pragma unroll
                    for (int i = 0; i < 16; ++i) acc[nt][i] = 0.f;
#pragma unroll
                for (int kk = 0; kk < 8; ++kk)
#pragma unroll
                    for (int nt = 0; nt < 4; ++nt) acc[nt] = MFMA32(*(const bf16x8*)(kl + (p * 128 + nt * 32 + r) * KROW + kk * 16 + hh * 8), qf[kk], acc[nt]);
                unsigned (&L)[16] = p ? LB : LA;
                unsigned G1[16], G2[16], G3[16];
#pragma unroll
                for (int i = 0; i < 16; ++i) { const int n0 = (i & 3) + 8 * (i >> 2) + 4 * hh;
                    L[i] = (fkey(acc[0][i]) & ~127u) | (unsigned)(127 - n0); G1[i] = (fkey(acc[1][i]) & ~127u) | (unsigned)(127 - (32 + n0));
                    G2[i] = (fkey(acc[2][i]) & ~127u) | (unsigned)(127 - (64 + n0)); G3[i] = (fkey(acc[3][i]) & ~127u) | (unsigned)(127 - (96 + n0)); }
                sort16_desc(L); sort16_desc(G1); sort16_desc(G2); sort16_desc(G3);
                top16_of_two(L, G1); top16_of_two(G2, G3); top16_of_two(L, G2);
                merge16(L);
            }
            unsigned char* tt = wtab + r * 32;
            if (hh == 0) {
#pragma unroll
                for (int q = 0; q < 16; ++q) tt[q] = (unsigned char)(127u - (LA[q] & 127u)); }
            else {
#pragma unroll
                for (int q = 0; q < 16; ++q) tt[16 + q] = (unsigned char)(127u - (LB[q] & 127u)); }
            float va[16], vb[16];
#pragma unroll
            for (int q = 0; q < 16; ++q) { va[q] = unfkey(LA[q] & ~127u); vb[q] = unfkey(LB[q] & ~127u); }
            unsigned LC[16];
#pragma unroll
            for (int q = 0; q < 16; ++q) LC[q] = 0u;
            { const float s0 = va[0] + vb[0], s1 = va[0] + vb[1]; ins16(LC, (fkey(hh ? s1 : s0) & ~63u) | (unsigned)(63 - (0 + hh))); }
            { const float s0 = va[0] + vb[2], s1 = va[0] + vb[3]; ins16(LC, (fkey(hh ? s1 : s0) & ~63u) | (unsigned)(63 - (2 + hh))); }
            { const float s0 = va[0] + vb[4], s1 = va[0] + vb[5]; ins16(LC, (fkey(hh ? s1 : s0) & ~63u) | (unsigned)(63 - (4 + hh))); }
            { const float s0 = va[0] + vb[6], s1 = va[0] + vb[7]; ins16(LC, (fkey(hh ? s1 : s0) & ~63u) | (unsigned)(63 - (6 + hh))); }
            { const float s0 = va[0] + vb[8], s1 = va[0] + vb[9]; ins16(LC, (fkey(hh ? s1 : s0) & ~63u) | (unsigned)(63 - (8 + hh))); }
            { const float s0 = va[0] + vb[10], s1 = va[0] + vb[11]; ins16(LC, (fkey(hh ? s1 : s0) & ~63u) | (unsigned)(63 - (10 + hh))); }
            { const float s0 = va[0] + vb[12], s1 = va[0] + vb[13]; ins16(LC, (fkey(hh ? s1 : s0) & ~63u) | (unsigned)(63 - (12 + hh))); }
            { const float s0 = va[0] + vb[14], s1 = va[0] + vb[15]; ins16(LC, (fkey(hh ? s1 : s0) & ~63u) | (unsigned)(63 - (14 + hh))); }
            { const float s0 = va[1] + vb[0], s1 = va[1] + vb[1]; ins16(LC, (fkey(hh ? s1 : s0) & ~63u) | (unsigned)(63 - (16 + hh))); }
            { const float s0 = va[1] + vb[2], s1 = va[1] + vb[3]; ins16(LC, (fkey(hh ? s1 : s0) & ~63u) | (unsigned)(63 - (18 + hh))); }
            { const float s0 = va[1] + vb[4], s1 = va[1] + vb[5]; ins16(LC, (fkey(hh ? s1 : s0) & ~63u) | (unsigned)(63 - (20 + hh))); }
            { const float s0 = va[1] + vb[6], s1 = va[1] + vb[7]; ins16(LC, (fkey(hh ? s1 : s0) & ~63u) | (unsigned)(63 - (22 + hh))); }
            { const float s0 = va[2] + vb[0], s1 = va[2] + vb[1]; ins16(LC, (fkey(hh ? s1 : s0) & ~63u) | (unsigned)(63 - (24 + hh))); }
            { const float s0 = va[2] + vb[2], s1 = va[2] + vb[3]; ins16(LC, (fkey(hh ? s1 : s0) & ~63u) | (unsigned)(63 - (26 + hh))); }
            { const float s0 = va[2] + vb[4], s1 = va[3] + vb[0]; ins16(LC, (fkey(hh ? s1 : s0) & ~63u) | (unsigned)(63 - (28 + hh))); }
            { const float s0 = va[3] + vb[1], s1 = va[3] + vb[2]; ins16(LC, (fkey(hh ? s1 : s0) & ~63u) | (unsigned)(63 - (30 + hh))); }
            { const float s0 = va[3] + vb[3], s1 = va[4] + vb[0]; ins16(LC, (fkey(hh ? s1 : s0) & ~63u) | (unsigned)(63 - (32 + hh))); }
            { const float s0 = va[4] + vb[1], s1 = va[4] + vb[2]; ins16(LC, (fkey(hh ? s1 : s0) & ~63u) | (unsigned)(63 - (34 + hh))); }
            { const float s0 = va[5] + vb[0], s1 = va[5] + vb[1]; ins16(LC, (fkey(hh ? s1 : s0) & ~63u) | (unsigned)(63 - (36 + hh))); }
            { const float s0 = va[6] + vb[0], s1 = va[6] + vb[1]; ins16(LC, (fkey(hh ? s1 : s0) & ~63u) | (unsigned)(63 - (38 + hh))); }
            { const float s0 = va[7] + vb[0], s1 = va[7] + vb[1]; ins16(LC, (fkey(hh ? s1 : s0) & ~63u) | (unsigned)(63 - (40 + hh))); }
            { const float s0 = va[8] + vb[0], s1 = va[9] + vb[0]; ins16(LC, (fkey(hh ? s1 : s0) & ~63u) | (unsigned)(63 - (42 + hh))); }
            { const float s0 = va[10] + vb[0], s1 = va[11] + vb[0]; ins16(LC, (fkey(hh ? s1 : s0) & ~63u) | (unsigned)(63 - (44 + hh))); }
            { const float s0 = va[12] + vb[0], s1 = va[13] + vb[0]; ins16(LC, (fkey(hh ? s1 : s0) & ~63u) | (unsigned)(63 - (46 + hh))); }
            { const float s0 = va[14] + vb[0], s1 = va[15] + vb[0]; ins16(LC, (fkey(hh ? s1 : s0) & ~63u) | (unsigned)(63 - (48 + hh))); }
            merge16(LC);
            WAVE_LDS_SYNC();
            float ev[16]; float den = 0.f; const float mx = unfkey(LC[0] & ~63u);
#pragma unroll
            for (int q = 0; q < 16; ++q) { ev[q] = __expf(unfkey(LC[q] & ~63u) - mx); den += ev[q]; }
            const float inv = 1.f / den;
            if (hh == 0) { int ex[16];
#pragma unroll
                for (int q = 0; q < 16; ++q) { const unsigned pc = wtab[1024 + (63u - (LC[q] & 63u))]; ex[q] = (int)tt[pc >> 4] * 128 + (int)tt[16 + (pc & 15u)]; }
#pragma unroll
                for (int q = 0; q < 4; ++q) *(v4u*)(IDX + (size_t)tok * 128 + h * 16 + 4 * q) = (v4u){(unsigned)ex[4 * q], (unsigned)ex[4 * q + 1], (unsigned)ex[4 * q + 2], (unsigned)ex[4 * q + 3]}; }
            else {
#pragma unroll
                for (int q = 0; q < 4; ++q) *(f32x4*)(GATE + (size_t)tok * 128 + h * 16 + 4 * q) = (f32x4){ev[4 * q] * inv, ev[4 * q + 1] * inv, ev[4 * q + 2] * inv, ev[4 * q + 3] * inv}; }
            WAVE_LDS_SYNC();
        }
    }
}

__device__ __forceinline__ void phase_fp8_tables(const Ctx& c) {
    const Args& a = *c.a;
    for (int r = c.gw; r < 2 * NEXP; r += c.NGW) {
        const bool isv = r >= NEXP; const int e = isv ? r - NEXP : r;
        const f32x4* src = (const f32x4*)((isv ? a.in[I_PV] : a.in[I_PU]) + (size_t)e * D) + c.lane;
        f32x4 v[4]; float m = 0.f;
#pragma unroll
        for (int j = 0; j < 4; ++j) { v[j] = src[64 * j]; m = fmaxf(m, fmaxf(fmaxf(fabsf(v[j].x), fabsf(v[j].y)), fmaxf(fabsf(v[j].z), fabsf(v[j].w)))); }
        m = wmax(m); const float inv = m > 0.f ? 256.f / m : 0.f;
        unsigned char* dst = c.ws + (isv ? WS_V8 : WS_U8) + (size_t)e * D + 4 * c.lane;
#pragma unroll
        for (int j = 0; j < 4; ++j) { int w = __builtin_amdgcn_cvt_pk_fp8_f32(v[j].x * inv, v[j].y * inv, 0, false); w = __builtin_amdgcn_cvt_pk_fp8_f32(v[j].z * inv, v[j].w * inv, w, true); *(unsigned*)(dst + 256 * j) = (unsigned)w; }
        if (c.lane == 0) ((float*)(c.ws + (isv ? WS_VSC : WS_USC)))[e] = m * (1.f / 256.f);
    }
}
__device__ __forceinline__ void fp8x16_to_f32(const v4u& r, float (&f)[16]) {
    const unsigned w[4] = {r.x, r.y, r.z, r.w};
#pragma unroll
    for (int j = 0; j < 4; ++j) { const f32x2 lo = __builtin_amdgcn_cvt_pk_f32_fp8((int)w[j], false), hi = __builtin_amdgcn_cvt_pk_f32_fp8((int)w[j], true); f[4 * j] = lo.x; f[4 * j + 1] = lo.y; f[4 * j + 2] = hi.x; f[4 * j + 3] = hi.y; }
}
__device__ __forceinline__ unsigned xcc_id() { return (unsigned)__builtin_amdgcn_s_getreg((3 << 11) | 20) & 7u; }

typedef long l64x2 __attribute__((ext_vector_type(2)));
struct E1Bat { l64x2 rw[16]; };
__device__ __forceinline__ void phase_exp1(const Ctx& c) {
    typedef float f32x4m __attribute__((ext_vector_type(4)));
    const int* IDX = (const int*)(c.ws + WS_IDX); const unsigned char* U8 = c.ws + WS_U8; float* PACT = (float*)(c.ws + WS_PACT);
    unsigned* cnt = (unsigned*)(c.ws + WS_CTL) + CW_E1;
    constexpr int CH = 8;
    constexpr int SROW = 144;
    unsigned char* wl = c.lds + c.wave * 11776; int* le = (int*)wl; unsigned char* himg = wl + 4096; float* res = (float*)(wl + 6144); unsigned char* stage = wl + 6656;
    const int xcc = (int)xcc_id(), r16 = c.lane & 15, g4 = c.lane >> 4, row8 = c.lane >> 3, pc8 = c.lane & 7; const bool bcol = r16 < 2;
    int bo = 0; unsigned tq = 0;
    if (c.lane == 0) tq = __hip_atomic_fetch_add(cnt + 64 * (xcc & 7), (unsigned)CH, __ATOMIC_RELAXED, __HIP_MEMORY_SCOPE_AGENT);
    for (;;) {
        const int x = (xcc + bo) & 7;
        const unsigned t0 = (unsigned)__builtin_amdgcn_readfirstlane((int)tq);
        if (t0 >= (unsigned)ML) { if (++bo >= 8) break; tq = 0; if (c.lane == 0) tq = __hip_atomic_fetch_add(cnt + 64 * ((xcc + bo) & 7), (unsigned)CH, __ATOMIC_RELAXED, __HIP_MEMORY_SCOPE_AGENT); continue; }
        tq = 0; if (c.lane == 0) tq = __hip_atomic_fetch_add(cnt + 64 * x, (unsigned)CH, __ATOMIC_RELAXED, __HIP_MEMORY_SCOPE_AGENT);
        { v4u ee[4], im[2];
#pragma unroll
          for (int q = 0; q < 4; ++q) ee[q] = *(const v4u*)(IDX + (size_t)t0 * 128 + 256 * q + 4 * c.lane);
#pragma unroll
          for (int q = 0; q < 2; ++q) { const int p = c.lane + 64 * q; im[q] = *(const v4u*)(c.ws + WS_HQ8 + ((size_t)t0 + (p >> 4)) * 2048 + ((p >> 3) & 1) * 1024 + 128 * x + 16 * (p & 7)); }
#pragma unroll
          for (int q = 0; q < 4; ++q) *(v4u*)(le + 256 * q + 4 * c.lane) = ee[q];
#pragma unroll
          for (int q = 0; q < 2; ++q) *(v4u*)(himg + 16 * (c.lane + 64 * q)) = im[q]; }
        WAVE_LDS_SYNC();
#define E1_LOAD(G, B) do { const int bb = (B) < CH ? (B) : 0; _Pragma("unroll") for (int i = 0; i < 16; ++i) G.rw[i] = *(const l64x2*)(U8 + (size_t)le[bb * 128 + 8 * i + row8] * D + 128 * x + 16 * pc8); } while (0)
#define E1_COMP(G, B) do { const unsigned char* hb = himg + ((B) * 2 + (r16 & 1)) * 128 + 32 * g4; long bq[4]; _Pragma("unroll") for (int m = 0; m < 4; ++m) { const long v = *(const long*)(hb + 8 * m); bq[m] = bcol ? v : 0l; } \
            _Pragma("unroll") for (int gi = 0; gi < 8; ++gi) { unsigned char* sb = stage + (gi & 1) * (16 * SROW); \
                *(l64x2*)(sb + row8 * SROW + 16 * pc8) = G.rw[2 * gi]; *(l64x2*)(sb + (8 + row8) * SROW + 16 * pc8) = G.rw[2 * gi + 1]; \
                WAVE_LDS_SYNC(); \
                const l64x2 a01 = *(const l64x2*)(sb + r16 * SROW + 32 * g4), a23 = *(const l64x2*)(sb + r16 * SROW + 32 * g4 + 16); \
                f32x4m acc = {0.f, 0.f, 0.f, 0.f}; \
                acc = __builtin_amdgcn_mfma_f32_16x16x32_fp8_fp8(a01.x, bq[0], acc, 0, 0, 0); acc = __builtin_amdgcn_mfma_f32_16x16x32_fp8_fp8(a01.y, bq[1], acc, 0, 0, 0); \
                acc = __builtin_amdgcn_mfma_f32_16x16x32_fp8_fp8(a23.x, bq[2], acc, 0, 0, 0); acc = __builtin_amdgcn_mfma_f32_16x16x32_fp8_fp8(a23.y, bq[3], acc, 0, 0, 0); \
                _Pragma("unroll") for (int q = 0; q < 4; ++q) { const float lo = dppf<0xB1>(acc[q]); if (r16 == 0) res[gi * 16 + 4 * g4 + q] = acc[q] + lo * 0.0625f; } } \
            WAVE_LDS_SYNC(); \
            { float* po = PACT + (size_t)x * ((size_t)ML * 128) + ((size_t)t0 + (B)) * 128; po[c.lane] = res[c.lane]; po[64 + c.lane] = res[64 + c.lane]; } \
            WAVE_LDS_SYNC(); } while (0)
        E1Bat ga, gb;
        E1_LOAD(ga, 0);
#pragma unroll 1
        for (int b2 = 0; b2 < CH; b2 += 2) {
            E1_LOAD(gb, b2 + 1);
            __builtin_amdgcn_sched_barrier(0);
            E1_COMP(ga, b2);
            __builtin_amdgcn_sched_barrier(0);
            E1_LOAD(ga, b2 + 2);
            __builtin_amdgcn_sched_barrier(0);
            E1_COMP(gb, b2 + 1);
            __builtin_amdgcn_sched_barrier(0);
        }
#undef E1_LOAD
#undef E1_COMP
    }
}
__device__ __forceinline__ void phase_exp1b(const Ctx& c) {
    const int* IDX = (const int*)(c.ws + WS_IDX); const float* GATE = (const float*)(c.ws + WS_GATE); const float* HS = (const float*)(c.ws + WS_HS); const float* PACT = (const float*)(c.ws + WS_PACT);
    const float* USC = (const float*)(c.ws + WS_USC); const float* VSC = (const float*)(c.ws + WS_VSC); float* ACT = (float*)(c.ws + WS_ACT);
    for (size_t i = (size_t)c.bid * NTHREADS + c.tid; i < (size_t)ML * 128; i += (size_t)c.G * NTHREADS) {
        float s = 0.f;
#pragma unroll
        for (int x = 0; x < 8; ++x) s += PACT[(size_t)x * ((size_t)ML * 128) + i];
        const int e = IDX[i];
        ACT[i] = gelu_erf(s * HS[i >> 7] * USC[e]) * GATE[i] * VSC[e];
    }
}
__device__ __forceinline__ void phase_exp2(const Ctx& c) {
    const int* IDX = (const int*)(c.ws + WS_IDX); const float* ACT = (const float*)(c.ws + WS_ACT); const unsigned char* V8 = c.ws + WS_V8;
    bf16* Y = (bf16*)(c.ws + WS_Y); float* SSQP = (float*)(c.ws + WS_SSQP);
    unsigned* cnt = (unsigned*)(c.ws + WS_CTL) + CW_E2;
    int* li = (int*)(c.lds + c.wave * 1024); float* la = (float*)(li + 128);
    const int xcc = (int)xcc_id(), sub = c.lane & 7, grp = c.lane >> 3;
    const bool b5 = c.lane & 32, b4 = c.lane & 16, b3 = c.lane & 8;
    constexpr int CH = 8;
    int bo = 0, t = 0, tend = 0;
    int iA = 0, iB = 0; float aA = 0.f, aB = 0.f;
    unsigned tq = 0; if (c.lane == 0) tq = __hip_atomic_fetch_add(cnt + 64 * (xcc & 7), (unsigned)CH, __ATOMIC_RELAXED, __HIP_MEMORY_SCOPE_AGENT);
    for (;;) {
        if (t >= tend) {
            const unsigned t0 = (unsigned)__builtin_amdgcn_readfirstlane((int)tq);
            if (t0 >= (unsigned)ML) { if (++bo >= 8) break; tq = 0; if (c.lane == 0) tq = __hip_atomic_fetch_add(cnt + 64 * ((xcc + bo) & 7), (unsigned)CH, __ATOMIC_RELAXED, __HIP_MEMORY_SCOPE_AGENT); continue; }
            tq = 0; if (c.lane == 0) tq = __hip_atomic_fetch_add(cnt + 64 * ((xcc + bo) & 7), (unsigned)CH, __ATOMIC_RELAXED, __HIP_MEMORY_SCOPE_AGENT);
            t = (int)t0; tend = t + CH;
            iA = IDX[(size_t)t * 128 + c.lane]; iB = IDX[(size_t)t * 128 + 64 + c.lane]; aA = ACT[(size_t)t * 128 + c.lane]; aB = ACT[(size_t)t * 128 + 64 + c.lane];
        }
        const int x = (xcc + bo) & 7;
        li[c.lane] = iA; li[64 + c.lane] = iB; la[c.lane] = aA; la[64 + c.lane] = aB;
        if (t + 1 < tend) { iA = IDX[(size_t)(t + 1) * 128 + c.lane]; iB = IDX[(size_t)(t + 1) * 128 + 64 + c.lane]; aA = ACT[(size_t)(t + 1) * 128 + c.lane]; aB = ACT[(size_t)(t + 1) * 128 + 64 + c.lane]; }
        WAVE_LDS_SYNC();
        float acc[16];
#pragma unroll
        for (int q = 0; q < 16; ++q) acc[q] = 0.f;
#pragma unroll
        for (int hf = 0; hf < 2; ++hf) { v4u rows[8]; float av[8];
#pragma unroll
            for (int i = 0; i < 8; ++i) { const int k = 8 * (8 * hf + i) + grp; rows[i] = *(const v4u*)(V8 + (size_t)li[k] * D + x * 128 + 16 * sub); av[i] = la[k]; }
#pragma unroll
            for (int i = 0; i < 8; ++i) { float f[16]; fp8x16_to_f32(rows[i], f);
#pragma unroll
                for (int q = 0; q < 16; ++q) acc[q] = fmaf(av[i], f[q], acc[q]); } }
        float q8[8], q4[4], q2[2];
#pragma unroll
        for (int i = 0; i < 8; ++i) { const float keep = b5 ? acc[i + 8] : acc[i], send = b5 ? acc[i] : acc[i + 8]; q8[i] = keep + __shfl_xor(send, 32); }
#pragma unroll
        for (int i = 0; i < 4; ++i) { const float keep = b4 ? q8[i + 4] : q8[i], send = b4 ? q8[i] : q8[i + 4]; q4[i] = keep + __shfl_xor(send, 16); }
#pragma unroll
        for (int i = 0; i < 2; ++i) { const float keep = b3 ? q4[i + 2] : q4[i], send = b3 ? q4[i] : q4[i + 2]; q2[i] = keep + __shfl_xor(send, 8); }
        const int col = x * 128 + 16 * sub + (b5 ? 8 : 0) + (b4 ? 4 : 0) + (b3 ? 2 : 0);
        *(unsigned*)(Y + (size_t)t * D + col) = pk2(q2[0], q2[1]);
        const float ss = wsum(q2[0] * q2[0] + q2[1] * q2[1]);
        SSQP[(size_t)x * ML + t] = ss;
        WAVE_LDS_SYNC();
        ++t;
    }
}
__device__ __forceinline__ void phase_exp3(const Ctx& c) {
    const Args& a = *c.a;
    const float* MOD = (const float*)(c.ws + WS_MOD); const bf16* Y = (const bf16*)(c.ws + WS_Y); const float* SSQP = (const float*)(c.ws + WS_SSQP);
    v2u ny[4]; f32x4 nx[4]; float nss = 0.f;
#define E3_LOAD(R) do { _Pragma("unroll") for (int j = 0; j < 4; ++j) { const int col = 4 * c.lane + 256 * j; ny[j] = *(const v2u*)(Y + (size_t)(R) * D + col); nx[j] = *(const f32x4*)(a.out + (size_t)(R) * D + col); } \
        nss = (c.lane < 8) ? SSQP[(size_t)c.lane * ML + (R)] : 0.f; } while (0)
    if (c.gw < ML) E3_LOAD(c.gw);
    for (int row = c.gw; row < ML; row += c.NGW) {
        f32x4 y[4], x1[4];
#pragma unroll
        for (int j = 0; j < 4; ++j) { y[j] = (f32x4){bflo(ny[j].x), bfhi(ny[j].x), bflo(ny[j].y), bfhi(ny[j].y)}; x1[j] = nx[j]; }
        const float ss = row_sum16(nss);
        const float tot = __builtin_bit_cast(float, __builtin_amdgcn_readlane(__builtin_bit_cast(int, ss), 0));
        if (row + c.NGW < ML) E3_LOAD(row + c.NGW);
        const float r = rsqrtf(tot * (1.f / D) + EPS); const float* mr = MOD + (row >> 11) * 6144 + 5120;
#pragma unroll
        for (int j = 0; j < 4; ++j) { const int col = 4 * c.lane + 256 * j;
            const f32x4 g4 = *(const f32x4*)(a.in[I_GPOSTFFN] + col), gt = *(const f32x4*)(mr + col);
            *(f32x4*)(a.out + (size_t)row * D + col) = x1[j] + gt * ((y[j] * r) * g4); }
    }
#undef E3_LOAD
}

constexpr int S5_LPOW = 0, S5_BBAR = 33792, S5_CC = 50176, S5_MM = 66560;
__device__ __forceinline__ void s5_build_group(const Ctx& c, int g, int part) {
    const Args& a = *c.a;
    f32x2* LPOW = (f32x2*)(c.lds + S5_LPOW);
    f32x2* BBAR = (f32x2*)(c.lds + S5_BBAR);
    f32x2* CC = (f32x2*)(c.lds + S5_CC);
    float* MM = (float*)(c.lds + S5_MM);
    __syncthreads();
    if (c.tid < 128) { const int dir = c.tid >> 6, p = c.tid & 63, dg = dir * 32 + g;
        const float dt = expf(a.in[I_LOGDT][dg]), lr = a.in[I_LAMRE][dg * 64 + p], li = a.in[I_LAMIM][dg * 64 + p];
        const double ang = (double)li * (double)dt; const float lrdt = lr * dt;
        for (int e = 0; e <= 32; ++e) { float sn, cs; sincos_d(ang * (double)e, sn, cs); const float mg = expf(lrdt * (float)e); LPOW[(dir * 33 + e) * 64 + p] = (f32x2){mg * cs, mg * sn}; }
        float sn, cs; sincos_d(ang, sn, cs); const float mag = expf(lrdt), lbr = mag * cs, lbi = mag * sn, den = lr * lr + li * li, nr = lbr - 1.f;
        const float cr = (nr * lr + lbi * li) / den, ci = (lbi * lr - nr * li) / den;
        for (int ch = 0; ch < 16; ++ch) { const float br = a.in[I_BRE][(size_t)(dg * 64 + p) * 16 + ch], bi = a.in[I_BIM][(size_t)(dg * 64 + p) * 16 + ch]; BBAR[(dir * 64 + p) * 16 + ch] = (f32x2){cr * br - ci * bi, cr * bi + ci * br}; } }
    for (int i = c.tid; i < 2048; i += NTHREADS) { const int dir = i >> 10, ch = (i >> 6) & 15, p = i & 63, dg = dir * 32 + g; CC[i] = (f32x2){a.in[I_CRE][(size_t)(dg * 16 + ch) * 64 + p], a.in[I_CIM][(size_t)(dg * 16 + ch) * 64 + p]}; }
    __syncthreads();
    for (int task = c.tid; task < 1024; task += NTHREADS) { const int cpb = task & 3, cb = (task >> 2) & 3, lag = (task >> 4) & 31, dir = task >> 9;
        float acc[4][4];
#pragma unroll
        for (int i = 0; i < 4; ++i)
#pragma unroll
            for (int j = 0; j < 4; ++j) acc[i][j] = 0.f;
        for (int p = 0; p < 64; ++p) { const f32x2 l = LPOW[(dir * 33 + lag) * 64 + p]; f32x2 G[4], Cw[4];
#pragma unroll
            for (int j = 0; j < 4; ++j) { const f32x2 bb = BBAR[(dir * 64 + p) * 16 + 4 * cpb + j]; G[j] = (f32x2){l.x * bb.x - l.y * bb.y, l.x * bb.y + l.y * bb.x}; }
#pragma unroll
            for (int i = 0; i < 4; ++i) Cw[i] = CC[(dir * 16 + 4 * cb + i) * 64 + p];
#pragma unroll
            for (int i = 0; i < 4; ++i)
#pragma unroll
                for (int j = 0; j < 4; ++j) acc[i][j] += Cw[i].x * G[j].x - Cw[i].y * G[j].y; }
#pragma unroll
        for (int i = 0; i < 4; ++i)
#pragma unroll
            for (int j = 0; j < 4; ++j) MM[((dir * 32 + lag) * 16 + 4 * cb + i) * 16 + 4 * cpb + j] = acc[i][j]; }
    __syncthreads();
    if (c.tid < 128 && part == 0) { const int dir = c.tid >> 6, p = c.tid & 63; ((f32x2*)(c.ws + WS_LP))[(dir * 32 + g) * 64 + p] = LPOW[(dir * 33 + 32) * 64 + p]; }
    bf16* PMg = (bf16*)(c.ws + WS_PM) + (size_t)g * 256 * 512; bf16* BBg = (bf16*)(c.ws + WS_BB) + (size_t)g * 512 * 768;
    for (int task = part * 64 * 32 + c.tid; task < (part + 1) * 64 * 32; task += NTHREADS) { const int ip = task & 31, n = task >> 5, dir = n >> 7, im = (n >> 6) & 1, p = n & 63, e = dir ? ip : 31 - ip;
        const f32x2 l = LPOW[(dir * 33 + e) * 64 + p]; float o[16];
#pragma unroll
        for (int ch = 0; ch < 16; ++ch) { const f32x2 bb = BBAR[(dir * 64 + p) * 16 + ch]; o[ch] = im ? (l.x * bb.y + l.y * bb.x) : (l.x * bb.x - l.y * bb.y); }
        v4u w0, w1; w0.x = pk2(o[0], o[1]); w0.y = pk2(o[2], o[3]); w0.z = pk2(o[4], o[5]); w0.w = pk2(o[6], o[7]); w1.x = pk2(o[8], o[9]); w1.y = pk2(o[10], o[11]); w1.z = pk2(o[12], o[13]); w1.w = pk2(o[14], o[15]);
        *(v4u*)(PMg + (size_t)n * 512 + ip * 16) = w0; *(v4u*)(PMg + (size_t)n * 512 + ip * 16 + 8) = w1; }
    for (int task = part * 128 * 32 + c.tid; task < (part + 1) * 128 * 32; task += NTHREADS) { const int ip = task & 31, n = task >> 5, i = n >> 4, ch = n & 15; float o[16];
#pragma unroll
        for (int q = 0; q < 16; ++q) o[q] = 0.f;
        if (ip <= i) { const float* m0 = MM + ((0 * 32 + (i - ip)) * 16 + ch) * 16;
#pragma unroll
            for (int q = 0; q < 16; ++q) o[q] += m0[q]; }
        if (ip >= i) { const float* m1 = MM + ((1 * 32 + (ip - i)) * 16 + ch) * 16;
#pragma unroll
            for (int q = 0; q < 16; ++q) o[q] += m1[q]; }
        if (ip == i) { const float dsk = a.in[I_S5D][g * 16 + ch];
#pragma unroll
            for (int q = 0; q < 16; ++q) o[q] += (q == ch) ? dsk : 0.f; }
        v4u w0, w1; w0.x = pk2(o[0], o[1]); w0.y = pk2(o[2], o[3]); w0.z = pk2(o[4], o[5]); w0.w = pk2(o[6], o[7]); w1.x = pk2(o[8], o[9]); w1.y = pk2(o[10], o[11]); w1.z = pk2(o[12], o[13]); w1.w = pk2(o[14], o[15]);
        *(v4u*)(BBg + (size_t)n * 768 + ip * 16) = w0; *(v4u*)(BBg + (size_t)n * 768 + ip * 16 + 8) = w1; }
    for (int task = part * 128 * 32 + c.tid; task < (part + 1) * 128 * 32; task += NTHREADS) { const int p8 = task & 7, part = (task >> 3) & 3, n = task >> 5, i = n >> 4, ch = n & 15, dir = part >> 1, im = part & 1, e = dir ? 32 - i : i + 1; float o[8];
#pragma unroll
        for (int q = 0; q < 8; ++q) { const int p = p8 * 8 + q; const f32x2 l = LPOW[(dir * 33 + e) * 64 + p], cc = CC[(dir * 16 + ch) * 64 + p]; o[q] = im ? -(cc.x * l.y + cc.y * l.x) : (cc.x * l.x - cc.y * l.y); }
        v4u w0; w0.x = pk2(o[0], o[1]); w0.y = pk2(o[2], o[3]); w0.z = pk2(o[4], o[5]); w0.w = pk2(o[6], o[7]);
        *(v4u*)(BBg + (size_t)n * 768 + 512 + part * 64 + p8 * 8) = w0; }
}
__device__ __forceinline__ void s5_state_scan(const Ctx& c, int task) {
    const int dir = task & 1, g = (task >> 1) & 31, b = task >> 6, p = c.lane;
    const f32x2 a = ((const f32x2*)(c.ws + WS_LP))[(dir * 32 + g) * 64 + p];
    const float* SS = (const float*)(c.ws + WS_SS) + (size_t)g * 768 * 256 + dir * 128 + p; bf16* U5 = (bf16*)(c.ws + WS_U5) + (size_t)g * 768 * 768 + 512 + dir * 128 + p;
    float er = 0.f, ei = 0.f;
#pragma unroll 1
    for (int s0 = 0; s0 < 72; s0 += 24) {
        float sr[24], si[24];
#pragma unroll
        for (int u = 0; u < 24; ++u) { const int step = s0 + u; const int R = (step < 8) ? 512 + b * 8 + (dir ? 7 - step : step) : b * 64 + (dir ? 71 - step : step - 8);
            sr[u] = SS[(size_t)R * 256]; si[u] = SS[(size_t)R * 256 + 64]; }
#pragma unroll
        for (int u = 0; u < 24; ++u) { const int step = s0 + u; const int R = (step < 8) ? 512 + b * 8 + (dir ? 7 - step : step) : b * 64 + (dir ? 71 - step : step - 8);
            if (step >= 8) { U5[(size_t)R * 768] = (bf16)f2bf(er); U5[(size_t)R * 768 + 64] = (bf16)f2bf(ei); }
            const float nr = sr[u] + a.x * er - a.y * ei, ni = si[u] + a.x * ei + a.y * er; er = nr; ei = ni; }
    }
}

constexpr int GDN_NCH = 36, GDN_ITEMS = NB * 4 * 2 * GDN_NCH;
constexpr size_t FR_T_BYTES = 8192, FR_ATT_BYTES = 8192, FR_KD_BYTES = 16384, FR_TAB_BYTES = 1024;
__device__ __forceinline__ int crow16(int i, int hh) { return (i & 3) + 8 * (i >> 2) + 4 * hh; }
__device__ __forceinline__ bf16x8 pack_step(const f32x16& x, int s) {
    v4u w; w.x = pk2(x[8 * s + 0], x[8 * s + 1]); w.y = pk2(x[8 * s + 2], x[8 * s + 3]); w.z = pk2(x[8 * s + 4], x[8 * s + 5]); w.w = pk2(x[8 * s + 6], x[8 * s + 7]);
    return __builtin_bit_cast(bf16x8, w);
}
__device__ __forceinline__ unsigned pk2v(float lo, float hi) { asm volatile("" : "+v"(lo), "+v"(hi)); return pk2(lo, hi); }
__device__ __forceinline__ bf16x8 pack_step_v(const f32x16& x, int s) {
    v4u w; w.x = pk2v(x[8 * s + 0], x[8 * s + 1]); w.y = pk2v(x[8 * s + 2], x[8 * s + 3]); w.z = pk2v(x[8 * s + 4], x[8 * s + 5]); w.w = pk2v(x[8 * s + 6], x[8 * s + 7]);
    return __builtin_bit_cast(bf16x8, w);
}
constexpr int GP_KR = 0, GP_QR = 17408, GP_KT = 34816, GP_TAB = 53248, GP_LP = 54272, GP_LPB = 8448 + 256;
__host__ __device__ constexpr int LOFF(int i) { return i < 1 ? 0 : 4 * (((i - 1) >> 2) + 1) * (2 * ((i - 1) >> 2) + ((i - 1) & 3)); }
static_assert(LOFF(1) == 0 && LOFF(2) == 4 && LOFF(5) == 16 && LOFF(6) == 24 && LOFF(64) == 2112, "packed lower-triangular row offsets");
struct GpPre { v4u q0, q1, k0, k1; float g, beta; };
__device__ __forceinline__ void gdn_prep_load(const Ctx& c, int item, GpPre& p) {
    const int n = item % GDN_NCH, bhd = item / GDN_NCH, dir = bhd & 1, h = (bhd >> 1) & 3, b = bhd >> 3;
    const bf16* QKV = (const bf16*)(c.ws + WS_QKV); const float* GB = (const float*)(c.ws + WS_GB);
    const int s = c.tid >> 3, seg = c.tid & 7; const bf16* rp = QKV + (size_t)scan_row(b, dir, n * 64 + s) * 1536 + h * 128 + seg * 16;
    p.q0 = *(const v4u*)rp; p.q1 = *(const v4u*)(rp + 8); p.k0 = *(const v4u*)(rp + 512); p.k1 = *(const v4u*)(rp + 520);
    const size_t rl = (size_t)scan_row(b, dir, n * 64 + c.lane) * 16 + dir * 4 + h; p.g = GB[rl]; p.beta = GB[rl + 8];
}
__device__ __forceinline__ void gdn_prep_stage(const Ctx& c, int item, int item_next, float* Lp, GpPre& p) {
    bf16* Kr = (bf16*)(c.lds + GP_KR); bf16* Qr = (bf16*)(c.lds + GP_QR); bf16* Kt = (bf16*)(c.lds + GP_KT); float* tab = (float*)(c.lds + GP_TAB);
    unsigned char* frA = c.ws + WS_FRA + (size_t)item * FR_ATT_BYTES; unsigned char* frK = c.ws + WS_FRK + (size_t)item * FR_KD_BYTES; float* frTab = (float*)(c.ws + WS_FRTAB + (size_t)item * FR_TAB_BYTES);
    const int r = c.lane & 31, hh = c.lane >> 5;
    if (c.wave == 0) { float g = p.g; const float beta = p.beta;
#pragma unroll
        for (int o = 1; o < 64; o <<= 1) { const float t = __shfl_up(g, o); if (c.lane >= o) g += t; }
        const float gl = __shfl(g, 63);
        tab[c.lane] = g; tab[64 + c.lane] = beta; tab[128 + c.lane] = __expf(g); tab[192 + c.lane] = __expf(gl - g); }
    { const int s = c.tid >> 3, seg = c.tid & 7;
      const v4u q0 = p.q0, q1 = p.q1, k0 = p.k0, k1 = p.k1;
      gdn_prep_load(c, item_next, p);
      *(v4u*)(Qr + s * 136 + seg * 16) = q0; *(v4u*)(Qr + s * 136 + seg * 16 + 8) = q1; *(v4u*)(Kr + s * 136 + seg * 16) = k0; *(v4u*)(Kr + s * 136 + seg * 16 + 8) = k1;
      const unsigned kw[8] = {k0.x, k0.y, k0.z, k0.w, k1.x, k1.y, k1.z, k1.w};
#pragma unroll
      for (int e = 0; e < 8; ++e) { Kt[(seg * 16 + 2 * e) * 72 + s] = (bf16)(kw[e] & 0xffffu); Kt[(seg * 16 + 2 * e + 1) * 72 + s] = (bf16)(kw[e] >> 16); } }
    __syncthreads();
    if (c.wave < 3) { const int ct = c.wave ? 1 : 0, st = c.wave == 2 ? 1 : 0;
        f32x16 acc;
#pragma unroll
        for (int i = 0; i < 16; ++i) acc[i] = 0.f;
#pragma unroll
        for (int kk = 0; kk < 8; ++kk) { const bf16x8 a = *(const bf16x8*)(Kr + (ct * 32 + r) * 136 + kk * 16 + hh * 8), bb = *(const bf16x8*)(Kr + (st * 32 + r) * 136 + kk * 16 + hh * 8); acc = MFMA32(a, bb, acc); }
        const int s = st * 32 + r; const float gcs = tab[s];
#pragma unroll
        for (int i = 0; i < 16; ++i) { const int cc = ct * 32 + crow16(i, hh); if (s < cc) Lp[LOFF(cc) + s] = tab[64 + cc] * acc[i] * __expf(tab[cc] - gcs); }
    } else if (c.wave < 6) { const int w = c.wave - 3, st = w == 2 ? 1 : 0, ct = w ? 1 : 0;
        f32x16 acc;
#pragma unroll
        for (int i = 0; i < 16; ++i) acc[i] = 0.f;
#pragma unroll
        for (int kk = 0; kk < 8; ++kk) { const bf16x8 a = *(const bf16x8*)(Kr + (st * 32 + r) * 136 + kk * 16 + hh * 8), bb = *(const bf16x8*)(Qr + (ct * 32 + r) * 136 + kk * 16 + hh * 8); acc = MFMA32(a, bb, acc); }
        const int cc = ct * 32 + r; const float gcc = tab[cc];
#pragma unroll
        for (int i = 0; i < 16; ++i) { const int s = st * 32 + crow16(i, hh); acc[i] = (s <= cc) ? acc[i] * __expf(gcc - tab[s]) : 0.f; }
        *(bf16x8*)(frA + ((size_t)((ct * 4 + 2 * st) * 64 + c.lane)) * 16) = pack_step(acc, 0);
        *(bf16x8*)(frA + ((size_t)((ct * 4 + 2 * st + 1) * 64 + c.lane)) * 16) = pack_step(acc, 1);
    } else { const int w = c.wave - 6;
#pragma unroll
        for (int f = 0; f < 8; ++f) { const int fi = w * 8 + f, dkt = fi >> 2, cb = fi & 3; const bf16* kp = Kt + (dkt * 32 + r) * 72 + 16 * cb + 4 * hh;
            const v2u lo = *(const v2u*)kp, hi = *(const v2u*)(kp + 8); const f32x4 e0 = *(const f32x4*)(tab + 192 + 16 * cb + 4 * hh), e1 = *(const f32x4*)(tab + 192 + 16 * cb + 8 + 4 * hh);
            v4u o; o.x = pk2(bflo(lo.x) * e0.x, bfhi(lo.x) * e0.y); o.y = pk2(bflo(lo.y) * e0.z, bfhi(lo.y) * e0.w); o.z = pk2(bflo(hi.x) * e1.x, bfhi(hi.x) * e1.y); o.w = pk2(bflo(hi.y) * e1.z, bfhi(hi.y) * e1.w);
            *(v4u*)(frK + ((size_t)(fi * 64 + c.lane)) * 16) = o; }
        if (w == 0) { const v4u z = (v4u){0u, 0u, 0u, 0u}; *(v4u*)(frA + ((size_t)((0 * 4 + 2) * 64 + c.lane)) * 16) = z; *(v4u*)(frA + ((size_t)((0 * 4 + 3) * 64 + c.lane)) * 16) = z; }
        else { *(f32x4*)(frTab + 4 * c.lane) = *(const f32x4*)(tab + 4 * c.lane); }
    }
    __syncthreads();
}
__device__ __forceinline__ int loff_rt(int i) { return i < 1 ? 0 : 4 * (((i - 1) >> 2) + 1) * (2 * ((i - 1) >> 2) + ((i - 1) & 3)); }
__device__ __forceinline__ void gdn_prep_solve(const Ctx& c, int item, float* Lp) {
    const int r = c.lane & 31, hh = c.lane >> 5;
    { float Tr[32];
#pragma unroll
      for (int i = 0; i < 32; ++i) { int je = r, bl = hh; asm volatile("" : "+v"(je), "+v"(bl)); float a0 = (je == i) ? 1.f : 0.f, a1 = 0.f;
          const int ro = bl ? LOFF(32 + i) + 32 : LOFF(i);
#pragma unroll
          for (int s4 = 0; s4 < (i + 3) / 4; ++s4) { const f32x4 l4 = *(const f32x4*)(Lp + ro + 4 * s4);
              if (4 * s4 + 0 < i) a0 = fmaf(-l4.x, Tr[4 * s4 + 0], a0); if (4 * s4 + 1 < i) a1 = fmaf(-l4.y, Tr[4 * s4 + 1], a1); if (4 * s4 + 2 < i) a0 = fmaf(-l4.z, Tr[4 * s4 + 2], a0); if (4 * s4 + 3 < i) a1 = fmaf(-l4.w, Tr[4 * s4 + 3], a1); }
          Tr[i] = a0 + a1; Lp[(je < i) ? ro + je : 2112 + 32 * bl + je] = Tr[i]; } }
    WAVE_LDS_SYNC();
    { const int offA = loff_rt(32 + r);
      f32x16 X;
#pragma unroll
      for (int i = 0; i < 16; ++i) X[i] = 0.f;
#pragma unroll
      for (int q = 0; q < 4; ++q) { const f32x4 a4 = *(const f32x4*)(Lp + offA + 16 * hh + 4 * q);
#pragma unroll
          for (int e = 0; e < 4; ++e) { const int kk = 4 * q + e; int hq = hh; asm volatile("" : "+v"(hq)); const int k = 16 * hq + kk;
              const float t = Lp[(hq ? LOFF(16 + kk) : LOFF(kk)) + r]; const float b = (r < k) ? t : (r == k ? 1.f : 0.f);
              X = __builtin_amdgcn_mfma_f32_32x32x2f32(a4[e], b, X, 0, 0, 0); } }
      f32x16 Y;
#pragma unroll
      for (int i = 0; i < 16; ++i) Y[i] = 0.f;
#pragma unroll
      for (int q = 0; q < 4; ++q) { const int k0 = 8 * q + 4 * hh; const f32x4 t4 = *(const f32x4*)(Lp + offA + 32 + k0);
#pragma unroll
          for (int e = 0; e < 4; ++e) { const int kq = k0 + e; const float av = (kq < r) ? t4[e] : (kq == r ? 1.f : 0.f);
              Y = __builtin_amdgcn_mfma_f32_32x32x2f32(av, X[4 * q + e], Y, 0, 0, 0); } }
#pragma unroll
      for (int i = 0; i < 16; ++i) { int hq = hh; asm volatile("" : "+v"(hq)); const int cb = (i & 3) + 8 * (i >> 2);
          Lp[(hq ? LOFF(32 + cb + 4) : LOFF(32 + cb)) + r] = -Y[i]; } }
    WAVE_LDS_SYNC();
    unsigned char* frT = c.ws + WS_FRT + (size_t)item * FR_T_BYTES;
#pragma unroll
    for (int f = 0; f < 8; ++f) { const int ct = f >> 2, sb = f & 3, cc = ct * 32 + r; float v[8];
#pragma unroll
        for (int q = 0; q < 2; ++q) { const int s0 = 16 * sb + 8 * q + 4 * hh;
            f32x4 t4 = (f32x4){0.f, 0.f, 0.f, 0.f}; if (s0 < cc) t4 = *(const f32x4*)(Lp + LOFF(cc) + s0);
            v[4 * q + 0] = (s0 + 0 < cc) ? t4.x : (s0 + 0 == cc ? 1.f : 0.f); v[4 * q + 1] = (s0 + 1 < cc) ? t4.y : (s0 + 1 == cc ? 1.f : 0.f);
            v[4 * q + 2] = (s0 + 2 < cc) ? t4.z : (s0 + 2 == cc ? 1.f : 0.f); v[4 * q + 3] = (s0 + 3 < cc) ? t4.w : (s0 + 3 == cc ? 1.f : 0.f); }
        *(v4u*)(frT + ((size_t)(f * 64 + c.lane)) * 16) = (v4u){pk2(v[0], v[1]), pk2(v[2], v[3]), pk2(v[4], v[5]), pk2(v[6], v[7])}; }
}
__device__ __forceinline__ void phase_gdn_prep(const Ctx& c) {
    const int nit = c.bid < GDN_ITEMS ? (GDN_ITEMS - 1 - c.bid) / c.G + 1 : 0;
    bool scanned = false;
    if (nit > 0) {
        GpPre p; gdn_prep_load(c, c.bid, p);
#pragma unroll 1
        for (int j = 0; j < nit; ++j) { const int item = c.bid + j * c.G, q = j & 7; int nx = item + c.G; nx = nx < GDN_ITEMS ? nx : item;
            gdn_prep_stage(c, item, nx, (float*)(c.lds + GP_LP + q * GP_LPB), p);
            if (q == 7 || j == nit - 1) { const int cnt = q + 1;
                if (c.wave < cnt) gdn_prep_solve(c, c.bid + ((j & ~7) + c.wave) * c.G, (float*)(c.lds + GP_LP + c.wave * GP_LPB));
                else if (j == nit - 1) { for (int t = c.bid + (c.wave - cnt) * c.G; t < 512; t += (8 - cnt) * c.G) s5_state_scan(c, t); }
                if (j == nit - 1 && cnt < 8) scanned = true;
                __syncthreads(); } }
    }
    if (!scanned) for (int t = c.bid + c.wave * c.G; t < 512; t += 8 * c.G) s5_state_scan(c, t);
}

constexpr int GR_K = 0, GR_Q = 16384, GR_T = 32768, GR_A = 40960, GR_KD = 49152, GR_TAB = 65536, GR_BUF = 66560;
__device__ __forceinline__ void gdn_rec_stage(const Ctx& c, int bhd, int n, int buf) {
    const int dir = bhd & 1, h = (bhd >> 1) & 3, b = bhd >> 3, lw = c.wave - 4; const int item = bhd * GDN_NCH + n;
    LAS unsigned char* base = (LAS unsigned char*)c.lds + buf * GR_BUF;
    const unsigned char* QKVb = c.ws + WS_QKV;
#pragma unroll
    for (int q = 0; q < 4; ++q) { const int qi = lw + 4 * q;
        const int s = 4 * qi + (c.lane >> 4), ps = c.lane & 15, p = ps ^ (s & 15); const size_t rowb = (size_t)scan_row(b, dir, n * 64 + s) * 3072 + (size_t)h * 256 + p * 16;
        __builtin_amdgcn_global_load_lds((const unsigned*)(QKVb + rowb + 1024), (LAS unsigned*)(base + GR_K + qi * 1024), 16, 0, 0);
        __builtin_amdgcn_global_load_lds((const unsigned*)(QKVb + rowb), (LAS unsigned*)(base + GR_Q + qi * 1024), 16, 0, 0); }
    const unsigned char* frT = c.ws + WS_FRT + (size_t)item * FR_T_BYTES; const unsigned char* frA = c.ws + WS_FRA + (size_t)item * FR_ATT_BYTES; const unsigned char* frK = c.ws + WS_FRK + (size_t)item * FR_KD_BYTES;
#pragma unroll
    for (int q = 0; q < 2; ++q) { const int qi = lw + 4 * q;
        __builtin_amdgcn_global_load_lds((const unsigned*)(frT + qi * 1024 + c.lane * 16), (LAS unsigned*)(base + GR_T + qi * 1024), 16, 0, 0);
        __builtin_amdgcn_global_load_lds((const unsigned*)(frA + qi * 1024 + c.lane * 16), (LAS unsigned*)(base + GR_A + qi * 1024), 16, 0, 0); }
#pragma unroll
    for (int q = 0; q < 4; ++q) { const int qi = lw + 4 * q;
        __builtin_amdgcn_global_load_lds((const unsigned*)(frK + qi * 1024 + c.lane * 16), (LAS unsigned*)(base + GR_KD + qi * 1024), 16, 0, 0); }
    if (lw == 0) __builtin_amdgcn_global_load_lds((const unsigned*)(c.ws + WS_FRTAB + (size_t)item * FR_TAB_BYTES + c.lane * 16), (LAS unsigned*)(base + GR_TAB), 16, 0, 0);
}
__device__ __forceinline__ bf16x8 gr_rowfrag(const unsigned char* rowp, const int (&po)[16], int kb) {
    const v2u lo = *(const v2u*)(rowp + po[2 * kb]), hi = *(const v2u*)(rowp + po[2 * kb + 1]);
    return __builtin_bit_cast(bf16x8, (v4u){lo.x, lo.y, hi.x, hi.y});
}
__device__ __forceinline__ void gdn_rec_block(const Ctx& c, int bhd, int dvhalf) {
    const int dir = bhd & 1, h = (bhd >> 1) & 3, b = bhd >> 3, r = c.lane & 31, hh = c.lane >> 5, dvt = 2 * dvhalf + (c.wave & 1);
    const bf16* QKV = (const bf16*)(c.ws + WS_QKV); bf16* OG = (bf16*)(c.ws + WS_OG) + (size_t)dir * ML * 512;
    f32x16 S[4];
#pragma unroll
    for (int t = 0; t < 4; ++t)
#pragma unroll
        for (int i = 0; i < 16; ++i) S[t][i] = 0.f;
    int po[16];
#pragma unroll
    for (int p = 0; p < 16; ++p) po[p] = r * 256 + ((p ^ (r & 15)) * 16) + 8 * hh;
    if (c.wave >= 4) gdn_rec_stage(c, bhd, 0, 0);
    asm volatile("s_waitcnt vmcnt(0)" ::: "memory"); __syncthreads();
    for (int n = 0; n < GDN_NCH; ++n) {
        const int buf = n & 1;
        if (c.wave >= 4) { if (n + 1 < GDN_NCH) gdn_rec_stage(c, bhd, n + 1, buf ^ 1); }
        else if (c.wave < 2) {
            const unsigned char* base = c.lds + buf * GR_BUF; const float* tab = (const float*)(base + GR_TAB);
            const int row0 = scan_row(b, dir, n * 64), sgn = dir ? -1 : 1;
            const bf16* vcol = QKV + (size_t)row0 * 1536 + 1024 + h * 128 + dvt * 32 + r + (ptrdiff_t)(sgn * 4 * hh) * 1536;
            bf16* ocol = OG + (size_t)row0 * 512 + h * 128 + dvt * 32 + r + (ptrdiff_t)(sgn * 4 * hh) * 512;
            const ptrdiff_t vst = (ptrdiff_t)sgn * 1536, ost = (ptrdiff_t)sgn * 512;
            bf16 vraw[2][16];
#pragma unroll
            for (int st = 0; st < 2; ++st)
#pragma unroll
                for (int i = 0; i < 16; ++i) vraw[st][i] = vcol[vst * (st * 32 + (i & 3) + 8 * (i >> 2))];
            bf16x8 Rf[2][2];
#pragma unroll
            for (int st = 0; st < 2; ++st) { f32x16 acc;
#pragma unroll
                for (int i = 0; i < 16; ++i) acc[i] = 0.f;
#pragma unroll
                for (int kb = 0; kb < 8; ++kb) acc = MFMA32(gr_rowfrag(base + GR_K + st * 8192, po, kb), pack_step_v(S[kb >> 1], kb & 1), acc);
#pragma unroll
                for (int i = 0; i < 16; ++i) { const int s = st * 32 + crow16(i, hh); acc[i] = tab[64 + s] * (bf1(vraw[st][i]) - tab[128 + s] * acc[i]); }
                Rf[st][0] = pack_step(acc, 0); Rf[st][1] = pack_step(acc, 1); asm volatile("" ::: "memory"); }
            bf16x8 Vf[2][2];
#pragma unroll
            for (int ct = 0; ct < 2; ++ct) { f32x16 acc;
#pragma unroll
                for (int i = 0; i < 16; ++i) acc[i] = 0.f;
#pragma unroll
                for (int sb = 0; sb < 4; ++sb) if (sb < 2 * ct + 2) acc = MFMA32(*(const bf16x8*)(base + GR_T + ((ct * 4 + sb) * 64 + c.lane) * 16), Rf[sb >> 1][sb & 1], acc);
                Vf[ct][0] = pack_step(acc, 0); Vf[ct][1] = pack_step(acc, 1); }
            asm volatile("" ::: "memory");
#pragma unroll
            for (int ct = 0; ct < 2; ++ct) { f32x16 acc;
#pragma unroll
                for (int i = 0; i < 16; ++i) acc[i] = 0.f;
#pragma unroll
                for (int kb = 0; kb < 8; ++kb) acc = MFMA32(gr_rowfrag(base + GR_Q + ct * 8192, po, kb), pack_step_v(S[kb >> 1], kb & 1), acc);
#pragma unroll
                for (int i = 0; i < 16; ++i) acc[i] *= tab[128 + ct * 32 + crow16(i, hh)];
#pragma unroll
                for (int cb = 0; cb < 4; ++cb) if (cb < 2 * ct + 2) acc = MFMA32(*(const bf16x8*)(base + GR_A + ((ct * 4 + cb) * 64 + c.lane) * 16), Vf[cb >> 1][cb & 1], acc);
                if (n >= 4) {
#pragma unroll
                    for (int i = 0; i < 16; ++i) ocol[ost * (ct * 32 + (i & 3) + 8 * (i >> 2))] = (bf16)f2bf(acc[i]); }
                asm volatile("" ::: "memory"); }
            const float gtot = tab[128 + 63];
#pragma unroll
            for (int t = 0; t < 4; ++t) {
#pragma unroll
                for (int i = 0; i < 16; ++i) S[t][i] *= gtot;
#pragma unroll
                for (int cb = 0; cb < 4; ++cb) S[t] = MFMA32(*(const bf16x8*)(base + GR_KD + ((t * 4 + cb) * 64 + c.lane) * 16), Vf[cb >> 1][cb & 1], S[t]); }
        }
        if (c.wave >= 4) asm volatile("s_waitcnt vmcnt(0)" ::: "memory"); else asm volatile("s_waitcnt lgkmcnt(0)" ::: "memory");
        __builtin_amdgcn_s_barrier(); asm volatile("" ::: "memory");
    }
    asm volatile("s_waitcnt vmcnt(0)" ::: "memory"); __syncthreads();
}
__device__ __forceinline__ void phase_gdn_rec(const Ctx& c) { if (c.bid < 128) gdn_rec_block(c, c.bid >> 1, c.bid & 1); }

#define XB_TMO      128
#define XB_XCNT(j)  (256  + 64 * (j))
#define XB_XSUB(j)  (1280 + 64 * (j))
#define XB_XGEN(j)  (2304 + 64 * (j))
#define XB_TOP      3328
#define XB_TOPGEN   3392
#define XCD_BAR_WORDS 3456
#define XB_SPIN_CAP (1u << 20)
__device__ __forceinline__ unsigned xb_ld(unsigned* p)              { return __hip_atomic_load(p, __ATOMIC_RELAXED, __HIP_MEMORY_SCOPE_AGENT); }
__device__ __forceinline__ unsigned xb_add(unsigned* p, unsigned v) { return __hip_atomic_fetch_add(p, v, __ATOMIC_RELAXED, __HIP_MEMORY_SCOPE_AGENT); }
__device__ __forceinline__ unsigned xb_xcc_id() { return (unsigned)__builtin_amdgcn_s_getreg((3 << 11) | 20) & 0xFu; }
#define XB_SPIN(cond, bar) do { unsigned _sp = 0; while (cond) { __builtin_amdgcn_s_sleep(1); \
    if ((++_sp & 255u) == 0u) { if (xb_ld(&(bar)[XB_TMO])) break; if (_sp > XB_SPIN_CAP) { atomicAdd(&(bar)[XB_TMO], 1u); break; } } } } while (0)
struct XcdBarrier { unsigned* bar; unsigned x; volatile LAS unsigned* st; };
__device__ __forceinline__ XcdBarrier xcd_barrier_post(unsigned* bar, volatile LAS unsigned* st) {
    XcdBarrier b; b.bar = bar; b.x = xb_xcc_id(); b.st = st;
    if (threadIdx.x == 0) (void)xb_add(&bar[XB_XCNT(b.x)], 1u);
    return b;
}
__device__ __forceinline__ void xcd_barrier_complete(unsigned* bar, unsigned x, unsigned& nloc, unsigned& nx) {
    const unsigned G = gridDim.x * gridDim.y * gridDim.z;
    unsigned sum, cnt, mine, sp = 0u;
    for (;;) {
        sum = 0u; cnt = 0u; mine = 0u;
#pragma unroll
        for (unsigned j = 0; j < 16; ++j) { const unsigned c = xb_ld(&bar[XB_XCNT(j)]); sum += c; cnt += (c > 0u) ? 1u : 0u; mine = (j == x) ? c : mine; }
        if (sum == G) break;
        __builtin_amdgcn_s_sleep(1);
        if ((++sp & 255u) == 0u) { if (xb_ld(&bar[XB_TMO])) break; if (sp > XB_SPIN_CAP) { atomicAdd(&bar[XB_TMO], 1u); break; } }
    }
    nloc = mine > 0u ? mine : 1u; nx = cnt > 0u ? cnt : 1u;
}
__device__ __forceinline__ void xcd_barrier(const XcdBarrier& b) {
    asm volatile("s_waitcnt vmcnt(0)" ::: "memory");
    __syncthreads();
    if (threadIdx.x == 0) {
        unsigned* bar = b.bar;
        __builtin_amdgcn_s_waitcnt(0);
        unsigned nloc = b.st[0], nx = b.st[1];
        if (nloc == 0u) { xcd_barrier_complete(bar, b.x, nloc, nx); b.st[0] = nloc; b.st[1] = nx; }
        const unsigned old = xb_add(&bar[XB_XSUB(b.x)], 1u);
        const unsigned gen = old / nloc;
        if (old + 1u == (gen + 1u) * nloc) {
            __builtin_amdgcn_fence(__ATOMIC_RELEASE, "agent");
            asm volatile("s_waitcnt vmcnt(0)" ::: "memory");
            const unsigned og = xb_add(&bar[XB_TOP], 1u);
            const unsigned tg = og / nx;
            if (og + 1u == (tg + 1u) * nx) xb_add(&bar[XB_TOPGEN], 1u);
            else XB_SPIN(xb_ld(&bar[XB_TOPGEN]) == tg, bar);
            __builtin_amdgcn_fence(__ATOMIC_ACQUIRE, "agent");
            xb_add(&bar[XB_XGEN(b.x)], 1u);
            asm volatile("s_waitcnt vmcnt(0)" ::: "memory");
        } else {
            XB_SPIN(xb_ld(&bar[XB_XGEN(b.x)]) == gen, bar);
            __builtin_amdgcn_fence(__ATOMIC_ACQUIRE, "agent");
            asm volatile("s_waitcnt vmcnt(0)" ::: "memory");
        }
    }
    __syncthreads();
}

constexpr int LDS_MISC = LDS_BYTES - 64;
__global__ void __launch_bounds__(NTHREADS, 2) mk_fwd(Args args) {
    extern __shared__ __attribute__((aligned(16))) unsigned char lds[];
    Ctx c; c.a = &args; c.ws = args.ws; c.lds = lds;
    c.tid = threadIdx.x; c.lane = c.tid & 63; c.wave = __builtin_amdgcn_readfirstlane(c.tid >> 6); c.bid = blockIdx.x; c.G = gridDim.x;
    c.gw = c.bid * NWAVES + c.wave; c.NGW = c.G * NWAVES; c.gwv = c.wave * c.G + c.bid;
    const int lo = args.ph_lo, hi = args.ph_hi;
    PG8_LAS unsigned char* ring = (PG8_LAS unsigned char*)lds;
#ifndef MK_PH_MASK
#define MK_PH_MASK 0xffff
#endif
#define IN(k) (((MK_PH_MASK >> (k)) & 1) && lo <= (k) && (k) < hi)
#if MK_ONE_LAUNCH
    cg::grid_group grid = cg::this_grid();
    if (lo < 0) grid.sync();
    volatile LAS unsigned* st = (volatile LAS unsigned*)((LAS unsigned char*)lds + LDS_MISC);
    if (c.tid < 2) st[c.tid] = 0u;
    __syncthreads();
    const XcdBarrier bar = xcd_barrier_post((unsigned*)(c.ws + WS_CTL) + CW_BAR, st);
#define SEAM(k) do { if (IN(k) && IN((k) + 1)) xcd_barrier(bar); } while (0)
#else
#define SEAM(k) do { } while (0)
#endif
    if (IN(0)) { phase_prep(c); phase_s5_build(c); } SEAM(0);
    if (IN(1)) { phase_norm1(c); } SEAM(1);
    if (IN(2)) { pg8::Gemm g{(const pg8::bf16_t*)(c.ws + WS_HX), (const pg8::bf16_t*)(c.ws + WS_WIN), 1024, 1024, 1024}; pg8::StaticOrder S; S.init(MT, NPROJ, c.G, c.bid);
        pg8::EpiInProj E{(pg8::bf16_t*)(c.ws + WS_U5), (pg8::bf16_t*)(c.ws + WS_QKVPRE), (pg8::bf16_t*)(c.ws + WS_Z)};
        pg8::gemm_phase<pg8::EpiInProj, pg8::StaticOrder, true, true>(ring, g, S, E); } SEAM(2);
    if (IN(3)) { { pg8::Gemm g{(const pg8::bf16_t*)(c.ws + WS_U5), (const pg8::bf16_t*)(c.ws + WS_PM), 768, 512, 512}; pg8::SchedSS S{c.G, c.bid}; pg8::EpiSS E{(float*)(c.ws + WS_SS)};
          pg8::gemm_phase<pg8::EpiSS, pg8::SchedSS, true, true>(ring, g, S, E); }
        __syncthreads(); phase_conv(c); } SEAM(3);
    if (IN(4)) { phase_gdn_prep(c); } SEAM(4);
    if (IN(5)) { pg8::Gemm g{(const pg8::bf16_t*)(c.ws + WS_U5), (const pg8::bf16_t*)(c.ws + WS_BB), 768, 768, 768}; pg8::SchedS5Y S{c.G, c.bid}; pg8::EpiS5Y E{(pg8::bf16_t*)(c.ws + WS_YG)};
        pg8::gemm_phase<pg8::EpiS5Y, pg8::SchedS5Y, true, true>(ring, g, S, E); } SEAM(5);
    if (IN(6)) { if (c.bid < 128) phase_gdn_rec(c);
        else { pg8::Gemm g{(const pg8::bf16_t*)(c.ws + WS_YG), (const pg8::bf16_t*)(c.ws + WS_WGLU), 512, 512, 512}; pg8::StaticOrder S; S.init(ML, 512, c.G - 128, c.bid - 128);
            pg8::EpiGlu E{(const pg8::bf16_t*)(c.ws + WS_YG), (pg8::bf16_t*)(c.ws + WS_CAT)};
            pg8::gemm_phase<pg8::EpiGlu, pg8::StaticOrder, true, true>(ring, g, S, E); } } SEAM(6);
    if (IN(7)) { phase_combine(c); } SEAM(7);
    if (IN(8)) { pg8::Gemm g{(const pg8::bf16_t*)(c.ws + WS_CAT), (const pg8::bf16_t*)(c.ws + WS_WOUT), 1024, 1024, 1024}; pg8::StaticOrder S; S.init(ML, 1024, c.G, c.bid);
        pg8::EpiBf16<0> E{(pg8::bf16_t*)(c.ws + WS_YRAW), 1024, nullptr, 0, 0, 1.f};
        pg8::gemm_phase<pg8::EpiBf16<0>, pg8::StaticOrder, true, true>(ring, g, S, E); } SEAM(8);
    if (IN(9)) { phase_rows2(c); phase_fp8_tables(c); } SEAM(9);
    if (IN(10)) { pg8::Gemm g{(const pg8::bf16_t*)(c.ws + WS_HX2), (const pg8::bf16_t*)(c.ws + WS_WQ), 1024, 1024, 1024}; pg8::StaticOrder S; S.init(ML, 2048, c.G, c.bid);
        pg8::EpiBf16<0> E{(pg8::bf16_t*)(c.ws + WS_QP), 2048, nullptr, 0, 0, 1.f};
        pg8::gemm_phase<pg8::EpiBf16<0>, pg8::StaticOrder, true, true>(ring, g, S, E); } SEAM(10);
    if (IN(11)) { phase_topk(c); } SEAM(11);
    if (IN(12)) { phase_exp1(c); } SEAM(12);
    if (IN(13)) { phase_exp1b(c); } SEAM(13);
    if (IN(14)) { phase_exp2(c); } SEAM(14);
    if (IN(15)) { phase_exp3(c); }
#undef IN
#undef SEAM
}

extern "C" void kernel_launch(void* const* d_in, const int* in_sizes, int n_in, void* d_out, int out_size, void* d_ws, size_t ws_size, hipStream_t stream) {
    static int grid = 0;
    if (grid == 0) {
        if (n_in != 29 || out_size != ML * D || ws_size < WS_END) { fprintf(stderr, "kernel_launch: unexpected shapes (n_in %d out %d ws %zu)\n", n_in, out_size, ws_size); grid = -1; return; }
        int dev = 0, cus = 0, per_cu = 0;
        (void)hipGetDevice(&dev); (void)hipDeviceGetAttribute(&cus, hipDeviceAttributeMultiprocessorCount, dev);
        if (hipFuncSetAttribute((const void*)mk_fwd, hipFuncAttributeMaxDynamicSharedMemorySize, LDS_BYTES) != hipSuccess) { fprintf(stderr, "kernel_launch: hipFuncSetAttribute failed\n"); grid = -1; return; }
        (void)hipOccupancyMaxActiveBlocksPerMultiprocessor(&per_cu, (const void*)mk_fwd, NTHREADS, LDS_BYTES);
        (void)hipGetLastError();
        grid = cus;
        fprintf(stderr, "kernel_launch: cus %d per_cu %d grid %d\n", cus, per_cu, grid);
    }
    if (grid < 0) return;
    Args a{};
    for (int i = 0; i < 29; ++i) a.in[i] = (const float*)d_in[i];
    a.out = (float*)d_out; a.ws = (unsigned char*)d_ws;
    (void)hipMemsetAsync((char*)d_ws + WS_CTL, 0, CTL_ZERO_BYTES, stream);
#if MK_ONE_LAUNCH
    a.ph_lo = 0; a.ph_hi = NPHASES;
    void* kargs[] = {&a};
    hipError_t e = hipLaunchCooperativeKernel((const void*)mk_fwd, dim3(grid), dim3(NTHREADS), kargs, LDS_BYTES, stream);
    if (e != hipSuccess) fprintf(stderr, "kernel_launch: cooperative launch failed: %s\n", hipGetErrorString(e));
#else
    for (int ph = 0; ph < NPHASES; ++ph) { a.ph_lo = ph; a.ph_hi = ph + 1; hipLaunchKernelGGL(mk_fwd, dim3(grid), dim3(NTHREADS), LDS_BYTES, stream, a); }
#endif
}
```

```cpp
#include <hip/hip_runtime.h>
#include <hip/hip_cooperative_groups.h>
#include <cstdio>
#include <cstdint>
namespace cg = cooperative_groups;
namespace pg8 {
#define PG8_LAS __attribute__((address_space(3)))
typedef unsigned short bf16_t;
typedef short bf16x8 __attribute__((ext_vector_type(8)));
typedef float f32x4 __attribute__((ext_vector_type(4)));
typedef unsigned u32x4 __attribute__((ext_vector_type(4)));
constexpr int BM = 256, BK = 64, HALF = 128, HTB = HALF * BK * 2  , STAGE_BYTES = 8 * HTB, NXCD = 8, WGM = 8;

__host__ __device__ __forceinline__ int lds_byte(int r, int c) { const int st = (r >> 4) * 2 + (c >> 5), rr = r & 15, cc = c & 31, ob = rr * 64 + cc * 2; return st * 1024 + (ob ^ (((ob >> 9) & 1) << 5)); }
__host__ __device__ __forceinline__ void stage_rc(int b, int& R, int& C) { const int st = b / 1024, sb = b % 1024, swz = sb ^ (((sb >> 9) & 1) << 5); R = (st >> 1) * 16 + swz / 64; C = (st & 1) * 32 + (swz % 64) / 2; }
__host__ __device__ __forceinline__ int perm32(int rho) { const int n = rho >> 4, i = rho & 15; return 8 * (i >> 2) + 4 * n + (i & 3); }

struct Unit { int pm, pn; };
struct Gemm { const bf16_t* A; const bf16_t* Bt; int lda, ldb, K; };

struct StaticOrder {
    int nM, nN, nwg, G, c;
    __host__ __device__ void init(int M, int N, int G_, int c_) { nM = M / BM; nN = N / BM; nwg = nM * nN; G = G_; c = c_; }
    __host__ __device__ bool next(int i, Unit& u) const {
        const long L = (long)i * G + c; if (L >= nwg) return false;
        int wgid = (int)L; { const int q = nwg / NXCD, r = nwg % NXCD, xcd = wgid % NXCD, off = wgid / NXCD; wgid = (xcd < r ? xcd * (q + 1) : r * (q + 1) + (xcd - r) * q) + off; }
        const int nig = WGM * nN, gid = wgid / nig, fm = gid * WGM, gsz = (nM - fm) < WGM ? (nM - fm) : WGM;
        u.pm = fm + ((wgid % nig) % gsz); u.pn = (wgid % nig) / gsz; return true;
    }
    __device__ __forceinline__ void a_ready(const Unit&) const {}
    __device__ __forceinline__ void done(const Unit&) const {}
};

__device__ __forceinline__ unsigned cvt_pk_bf16(float lo, float hi) { unsigned r; asm volatile("v_cvt_pk_bf16_f32 %0, %1, %2" : "=v"(r) : "v"(lo), "v"(hi)); return r; }
typedef float f32x2 __attribute__((ext_vector_type(2)));
__device__ __forceinline__ f32x2 gelu_pk(f32x2 v) {
    const f32x2 av = __builtin_elementwise_abs(v), d = av * 0.2316418882f + 1.0f;
    f32x2 t; t.x = __builtin_amdgcn_rcpf(d.x); t.y = __builtin_amdgcn_rcpf(d.y);
    f32x2 q = t * 0.5307027145f + (-0.7265760135f); q = q * t + 0.7107068705f; q = q * t + (-0.142248368f); q = q * t + 0.127414796f; q = q * t;
    const f32x2 s = (v * v) * (-0.72134752044f);
    f32x2 e; e.x = __builtin_amdgcn_exp2f(s.x); e.y = __builtin_amdgcn_exp2f(s.y);
    const f32x2 m = v * (q * e), r = v - m;
    f32x2 o; o.x = v.x < 0.f ? m.x : r.x; o.y = v.y < 0.f ? m.y : r.y; return o;
}

template <int ACT  > struct EpiBf16 {
    static constexpr bool PERM = true, AFTER_DRAIN = false; static_assert(ACT == 0 || ACT == 1, "EpiBf16: ACT is 0 (none) or 1 (gelu_pk)");
    bf16_t* O; int ldc; const float* bias; int split_cols; size_t split_stride; float scale0;
    __device__ __forceinline__ void operator()(const f32x4 (&acc)[2][2][4][2], const Unit& u, int wr, int wc, int fr, int fq) const {
        const int row0 = u.pm * BM + wr * 64 + fr; int colt = u.pn * BM; bf16_t* base = O;
        float sc = 1.f; if (split_cols) { const int t = colt / split_cols; base += (size_t)t * split_stride; colt -= t * split_cols; if (t == 0) sc = scale0; }
        const int col0 = colt + wc * 32 + 8 * fq, bcol0 = u.pn * BM + wc * 32 + 8 * fq;
        f32x4 bv[2][2];
#pragma unroll
        for (int bj = 0; bj < 2; ++bj)
#pragma unroll
            for (int n = 0; n < 2; ++n) bv[bj][n] = bias ? *(const f32x4*)(bias + bcol0 + bj * HALF + 4 * n) : (f32x4){0.f, 0.f, 0.f, 0.f};
#pragma unroll
        for (int ai = 0; ai < 2; ++ai)
#pragma unroll
            for (int m = 0; m < 4; ++m) { bf16_t* rowp = base + (size_t)(row0 + ai * HALF + m * 16) * ldc + col0;
#pragma unroll
                for (int bj = 0; bj < 2; ++bj) { f32x4 v0 = acc[ai][bj][m][0] + bv[bj][0], v1 = acc[ai][bj][m][1] + bv[bj][1];
                    if (ACT == 1) { f32x2 a = gelu_pk((f32x2){v0[0], v0[1]}), b = gelu_pk((f32x2){v0[2], v0[3]}), c = gelu_pk((f32x2){v1[0], v1[1]}), d = gelu_pk((f32x2){v1[2], v1[3]});
                        v0 = (f32x4){a.x, a.y, b.x, b.y}; v1 = (f32x4){c.x, c.y, d.x, d.y}; }
                    v0 = v0 * sc; v1 = v1 * sc; u32x4 w; w.x = cvt_pk_bf16(v0[0], v0[1]); w.y = cvt_pk_bf16(v0[2], v0[3]); w.z = cvt_pk_bf16(v1[0], v1[1]); w.w = cvt_pk_bf16(v1[2], v1[3]);
                    *(u32x4*)(rowp + bj * HALF) = w; } }
    }
};

template <class Epi, class Sched, bool ALIGN_EPI = false, bool SP2 = false>
__device__ __forceinline__ void gemm_phase(PG8_LAS unsigned char* lds, const Gemm g, const Sched& S, const Epi& E) {
    const int tid = threadIdx.x, wid = __builtin_amdgcn_readfirstlane(tid >> 6), lane = tid & 63, wr = wid >> 2, wc = wid & 3, fr = lane & 15, fq = lane >> 4;
    const int K = g.K, nt = K / BK;
    unsigned voffA[2], voffB[2];
#pragma unroll
    for (int i = 0; i < 2; ++i) { int R, C; stage_rc(tid * 16 + i * 8192, R, C); const int Rb = Epi::PERM ? ((R & ~31) + perm32(R & 31)) : R;
        voffA[i] = (unsigned)(R * g.lda + C) * 2u; voffB[i] = (unsigned)(Rb * g.ldb + C) * 2u; }
    const size_t kstep = (size_t)(BK * 2);
    const size_t hstepA = (size_t)HALF * g.lda * 2, hstepB = (size_t)HALF * g.ldb * 2;
    const size_t tstepA = 2 * hstepA, tstepB = 2 * hstepB;
    const unsigned ldsw = (unsigned)wid * 1024u;
    const int aoff = lds_byte(wr * 64 + fr, fq * 8), boff = lds_byte(wc * 32 + fr, fq * 8);
#define PG8_SA(b, h) (((b) * 2 + (h)) * HTB)
#define PG8_SB(b, h) ((4 + (b) * 2 + (h)) * HTB)
#define PG8_STAGE(bufoff, gbase, voff) do { _Pragma("unroll") for (int _i = 0; _i < 2; ++_i) \
        __builtin_amdgcn_global_load_lds((const unsigned*)((const char*)(gbase) + (voff)[_i]), (PG8_LAS unsigned*)(lds + (bufoff) + ldsw + _i * 8192), 16, 0, 0); } while (0)
#define PG8_LDA(dst, b, h) do { _Pragma("unroll") for (int m = 0; m < 4; ++m) _Pragma("unroll") for (int k = 0; k < 2; ++k) dst[m][k] = *(const PG8_LAS bf16x8*)(lds + PG8_SA(b, h) + aoff + m * 2048 + k * 1024); } while (0)
#define PG8_LDB(dst, b, h) do { _Pragma("unroll") for (int n = 0; n < 2; ++n) _Pragma("unroll") for (int k = 0; k < 2; ++k) dst[n][k] = *(const PG8_LAS bf16x8*)(lds + PG8_SB(b, h) + boff + n * 2048 + k * 1024); } while (0)
#define PG8_MMA(ai, bj, At, Bt) do { __builtin_amdgcn_s_setprio(1); _Pragma("unroll") for (int m = 0; m < 4; ++m) _Pragma("unroll") for (int n = 0; n < 2; ++n) _Pragma("unroll") for (int k = 0; k < 2; ++k) \
        acc[ai][bj][m][n] = __builtin_amdgcn_mfma_f32_16x16x32_bf16(Bt[n][k], At[m][k], acc[ai][bj][m][n], 0, 0, 0); __builtin_amdgcn_s_setprio(0); } while (0)
#define PG8_WAIT_V(n) asm volatile("s_waitcnt vmcnt(" #n ")" ::: "memory")
#define PG8_WAIT_L(n) asm volatile("s_waitcnt lgkmcnt(" #n ")" ::: "memory")
#define PG8_BAR __builtin_amdgcn_s_barrier()
#define PG8_SCHED __builtin_amdgcn_sched_barrier(0)
    Unit cur, nxt; int ui = 0;
    if (!S.next(0, cur)) return;
    f32x4 acc[2][2][4][2];
#pragma unroll
    for (int a = 0; a < 2; ++a)
#pragma unroll
        for (int b = 0; b < 2; ++b)
#pragma unroll
            for (int m = 0; m < 4; ++m)
#pragma unroll
                for (int n = 0; n < 2; ++n) acc[a][b][m][n] = (f32x4){0.f, 0.f, 0.f, 0.f};
    bf16x8 At[4][2], B0[2][2], B1[2][2];
    const char* cA = (const char*)g.A + (size_t)cur.pm * tstepA; const char* cB = (const char*)g.Bt + (size_t)cur.pn * tstepB;
    S.a_ready(cur);
    if constexpr (SP2) {
        PG8_STAGE(PG8_SB(0, 0), cB, voffB); PG8_STAGE(PG8_SB(0, 1), cB + hstepB, voffB); PG8_STAGE(PG8_SA(0, 0), cA, voffA); PG8_STAGE(PG8_SA(0, 1), cA + hstepA, voffA);
        if (wr == 1) PG8_BAR;
        PG8_WAIT_V(2); PG8_BAR;
        PG8_STAGE(PG8_SB(1, 0), cB + kstep, voffB); PG8_STAGE(PG8_SA(1, 0), cA + kstep, voffA); PG8_STAGE(PG8_SB(1, 1), cB + hstepB + kstep, voffB);
        PG8_WAIT_V(6); PG8_BAR;
    } else {
        PG8_STAGE(PG8_SB(0, 0), cB, voffB); PG8_STAGE(PG8_SA(0, 0), cA, voffA); PG8_STAGE(PG8_SB(0, 1), cB + hstepB, voffB); PG8_STAGE(PG8_SA(0, 1), cA + hstepA, voffA);
        if (wr == 1) PG8_BAR;
        PG8_WAIT_V(4); PG8_BAR;
        PG8_STAGE(PG8_SB(1, 0), cB + kstep, voffB); PG8_STAGE(PG8_SA(1, 0), cA + kstep, voffA); PG8_STAGE(PG8_SB(1, 1), cB + hstepB + kstep, voffB);
        PG8_WAIT_V(6); PG8_BAR;
    }
    for (;;) {
        const bool has_next = S.next(ui + 1, nxt);
        const char* nA = has_next ? (const char*)g.A + (size_t)nxt.pm * tstepA : cA; const char* nB = has_next ? (const char*)g.Bt + (size_t)nxt.pn * tstepB : cB;
        for (int t = 0; t < nt; t += 2) {
            const bool last = (t == nt - 2);
            const char* a1 = cA + (size_t)(t + 1) * kstep;
            const char* a2 = last ? nA : cA + (size_t)(t + 2) * kstep; const char* b2 = last ? nB : cB + (size_t)(t + 2) * kstep;
            const char* a3 = a2 + kstep; const char* b3 = b2 + kstep;
            if (last && has_next) S.a_ready(nxt);
            if constexpr (SP2) {
            PG8_LDB(B0, 0, 0); PG8_LDB(B1, 0, 1); PG8_SCHED; PG8_LDA(At, 0, 0); PG8_STAGE(PG8_SA(1, 1), a1 + hstepA, voffA);
            PG8_WAIT_V(8); PG8_WAIT_L(0); PG8_BAR; PG8_MMA(0, 0, At, B0); PG8_MMA(0, 1, At, B1); PG8_BAR; PG8_SCHED;
            PG8_LDA(At, 0, 1); PG8_STAGE(PG8_SB(0, 0), b2, voffB); PG8_STAGE(PG8_SB(0, 1), b2 + hstepB, voffB); PG8_STAGE(PG8_SA(0, 0), a2, voffA);
            PG8_WAIT_V(8); PG8_WAIT_L(0); PG8_BAR; PG8_MMA(1, 0, At, B0); PG8_MMA(1, 1, At, B1); PG8_BAR; PG8_SCHED;
            PG8_LDB(B0, 1, 0); PG8_LDB(B1, 1, 1); PG8_SCHED; PG8_LDA(At, 1, 0); PG8_STAGE(PG8_SA(0, 1), a2 + hstepA, voffA);
            PG8_WAIT_V(8); PG8_WAIT_L(0); PG8_BAR; PG8_MMA(0, 0, At, B0); PG8_MMA(0, 1, At, B1); PG8_BAR; PG8_SCHED;
            PG8_LDA(At, 1, 1); PG8_STAGE(PG8_SB(1, 0), b3, voffB); PG8_STAGE(PG8_SB(1, 1), b3 + hstepB, voffB); PG8_STAGE(PG8_SA(1, 0), a3, voffA);
            PG8_WAIT_V(8); PG8_WAIT_L(0); PG8_BAR; PG8_MMA(1, 0, At, B0); PG8_MMA(1, 1, At, B1); PG8_BAR; PG8_SCHED;
            } else {
            PG8_LDB(B0, 0, 0); PG8_SCHED; PG8_LDA(At, 0, 0); PG8_STAGE(PG8_SA(1, 1), a1 + hstepA, voffA);
            PG8_WAIT_L(8); PG8_BAR; PG8_WAIT_L(0); PG8_MMA(0, 0, At, B0); PG8_BAR; PG8_SCHED;
            PG8_LDB(B1, 0, 1); PG8_STAGE(PG8_SB(0, 0), b2, voffB);
            PG8_BAR; PG8_WAIT_L(0); PG8_MMA(0, 1, At, B1); PG8_BAR;
            PG8_LDA(At, 0, 1); PG8_STAGE(PG8_SA(0, 0), a2, voffA);
            PG8_BAR; PG8_WAIT_L(0); PG8_MMA(1, 0, At, B0); PG8_BAR; PG8_SCHED;
            PG8_STAGE(PG8_SB(0, 1), b2 + hstepB, voffB);
            PG8_WAIT_V(6); PG8_BAR; PG8_MMA(1, 1, At, B1); PG8_BAR;
            PG8_LDB(B0, 1, 0); PG8_SCHED; PG8_LDA(At, 1, 0); PG8_STAGE(PG8_SA(0, 1), a2 + hstepA, voffA);
            PG8_WAIT_L(8); PG8_BAR; PG8_WAIT_L(0); PG8_MMA(0, 0, At, B0); PG8_BAR; PG8_SCHED;
            PG8_LDB(B1, 1, 1); PG8_STAGE(PG8_SB(1, 0), b3, voffB);
            PG8_BAR; PG8_WAIT_L(0); PG8_MMA(0, 1, At, B1); PG8_BAR;
            PG8_LDA(At, 1, 1); PG8_STAGE(PG8_SA(1, 0), a3, voffA);
            PG8_BAR; PG8_WAIT_L(0); PG8_MMA(1, 0, At, B0); PG8_BAR; PG8_SCHED;
            PG8_STAGE(PG8_SB(1, 1), b3 + hstepB, voffB);
            PG8_WAIT_V(6); PG8_BAR; PG8_MMA(1, 1, At, B1); PG8_BAR;
            }
        }
        if constexpr (ALIGN_EPI) { if (wr == 0) PG8_BAR; }
        if constexpr (!Epi::AFTER_DRAIN) { E(acc, cur, wr, wc, fr, fq); S.done(cur); }
        if (!has_next) break;
#pragma unroll
        for (int a = 0; a < 2; ++a)
#pragma unroll
            for (int b = 0; b < 2; ++b)
#pragma unroll
                for (int m = 0; m < 4; ++m)
#pragma unroll
                    for (int n = 0; n < 2; ++n) acc[a][b][m][n] = (f32x4){0.f, 0.f, 0.f, 0.f};
        cur = nxt; cA = nA; cB = nB; ++ui;
        if constexpr (ALIGN_EPI) { if (wr == 1) PG8_BAR; }
    }
    PG8_WAIT_V(0);
    if constexpr (!ALIGN_EPI) { if (wr == 0) PG8_BAR; }
    PG8_BAR;
    if constexpr (Epi::AFTER_DRAIN) { E.fused(acc, cur, wr, wc, fr, fq, lds, wid, lane); S.done(cur); }
#undef PG8_SA
#undef PG8_SB
#undef PG8_STAGE
#undef PG8_LDA
#undef PG8_LDB
#undef PG8_MMA
#undef PG8_WAIT_V
#undef PG8_WAIT_L
#undef PG8_BAR
#undef PG8_SCHED
}
}

#ifndef MK_EXP_OLD
#define MK_EXP_OLD 0
#endif
#ifndef MK_ONE_LAUNCH
#define MK_ONE_LAUNCH 1
#endif
#define LAS __attribute__((address_space(3)))
typedef unsigned short bf16;
typedef unsigned v4u __attribute__((ext_vector_type(4)));
typedef unsigned v2u __attribute__((ext_vector_type(2)));
typedef float f32x4 __attribute__((ext_vector_type(4)));
typedef float f32x2 __attribute__((ext_vector_type(2)));
typedef short bf16x8 __attribute__((ext_vector_type(8)));
typedef float f32x16 __attribute__((ext_vector_type(16)));
#define MFMA32(a, b, c) __builtin_amdgcn_mfma_f32_32x32x16_bf16((a), (b), (c), 0, 0, 0)

constexpr int D = 1024, NB = 8, SEQ = 2048, LC = 256, ML = NB * SEQ  , MC = NB * LC  , MT = ML + MC  ;
constexpr int PROJ = 2576, NPROJ = 2560;
constexpr int NEXP = 16384, TOPK = 16, KK = 128;
constexpr float EPS = 1e-6f;
constexpr int NTHREADS = 512, NWAVES = 8;
constexpr int LDS_BYTES = 147456;
constexpr int NPHASES = 16;

constexpr size_t MiB = 1u << 20;
constexpr size_t WS_CTL = 0;
constexpr size_t CTL_ZERO_BYTES = 65536;
constexpr int CW_BAR = 0;
constexpr int CW_E1 = 4096, CW_E2 = 4096 + 8 * 64;
constexpr size_t WS_MOD = 1 * MiB;
constexpr size_t WS_LP = 1 * MiB + 512 * 1024;
constexpr size_t WS_WIN = 2 * MiB;
constexpr size_t WS_WOUT = 8 * MiB;
constexpr size_t WS_WGLU = 10 * MiB;
constexpr size_t WS_WQ = 11 * MiB;
constexpr size_t WS_GB = 15 * MiB;
constexpr size_t WS_BB = 17 * MiB;
constexpr size_t WS_PM = 41 * MiB;
constexpr size_t WS_OG = 17 * MiB;
constexpr size_t WS_HX2 = 17 * MiB;
constexpr size_t WS_U5 = 49 * MiB;
constexpr size_t WS_CAT = 49 * MiB;
constexpr size_t WS_IDX = 49 * MiB;
constexpr size_t WS_GATE = 57 * MiB;
constexpr size_t WS_ACT = 65 * MiB;
constexpr size_t WS_SSQP = 73 * MiB;
constexpr size_t WS_Z = 85 * MiB;
constexpr size_t WS_YRAW = 85 * MiB;
constexpr size_t WS_QP = 85 * MiB;
constexpr size_t WS_Y = 85 * MiB;
constexpr size_t WS_HX = 101 * MiB;
constexpr size_t WS_SS = 101 * MiB;
constexpr size_t WS_YG = 101 * MiB;
constexpr size_t WS_FRT = 125 * MiB;
constexpr size_t WS_QKVPRE = 137 * MiB;
constexpr size_t WS_FRA = 143 * MiB;
constexpr size_t WS_FRK = 161 * MiB;
constexpr size_t WS_FRTAB = 197 * MiB;
constexpr size_t WS_QKV = 202 * MiB;
constexpr size_t WS_U8 = 202 * MiB;
constexpr size_t WS_V8 = 218 * MiB;
constexpr size_t WS_USC = 234 * MiB;
constexpr size_t WS_VSC = 234 * MiB + 512 * 1024;
constexpr size_t WS_HQ8 = 150 * MiB;
constexpr size_t WS_HS = 183 * MiB;
constexpr size_t WS_PACT = 85 * MiB;
constexpr size_t WS_END = 256 * MiB;
static_assert(WS_BB + (size_t)32 * 512 * 768 * 2 <= WS_PM && WS_PM + (size_t)32 * 256 * 512 * 2 <= WS_U5 && WS_U5 + (size_t)32 * 768 * 768 * 2 <= WS_Z && WS_Z + (size_t)ML * 512 * 2 <= WS_HX, "ws map a");
static_assert(WS_HX + (size_t)MT * D * 2 <= WS_QKVPRE && WS_SS + (size_t)32 * 768 * 256 * 4 <= WS_FRT && WS_QKVPRE + (size_t)MT * 1536 * 2 <= WS_QKV && WS_QKV + (size_t)MT * 1536 * 2 <= WS_END, "ws map b");
static_assert(WS_FRT + (size_t)2304 * 8192 <= WS_FRA && WS_FRA + (size_t)2304 * 8192 <= WS_FRK && WS_FRK + (size_t)2304 * 16384 <= WS_FRTAB && WS_FRTAB + (size_t)2304 * 1024 <= WS_QKV, "ws map c");
static_assert(WS_OG + (size_t)2 * ML * 512 * 2 <= WS_CAT && WS_CAT + (size_t)ML * D * 2 <= WS_Z && WS_YRAW + (size_t)ML * D * 4 <= WS_U8 && WS_SSQP + (size_t)8 * ML * 4 <= WS_Z && WS_YG + (size_t)ML * 512 * 2 <= WS_FRT, "ws map d");

__device__ __forceinline__ unsigned f2bf(float f) { unsigned u = __builtin_bit_cast(unsigned, f); return (u + 0x7fffu + ((u >> 16) & 1u)) >> 16; }
typedef __bf16 bf16x2_t __attribute__((ext_vector_type(2)));
__device__ __forceinline__ unsigned pk2(float lo, float hi) { const f32x2 v = {lo, hi}; return __builtin_bit_cast(unsigned, __builtin_convertvector(v, bf16x2_t)); }
__device__ __forceinline__ float bflo(unsigned w) { return __builtin_bit_cast(float, w << 16); }
__device__ __forceinline__ float bfhi(unsigned w) { return __builtin_bit_cast(float, w & 0xffff0000u); }
__device__ __forceinline__ float bf1(bf16 h) { return __builtin_bit_cast(float, (unsigned)h << 16); }
__device__ __forceinline__ float wave_sum(float v) {
#pragma unroll
    for (int o = 1; o < 64; o <<= 1) v += __shfl_xor(v, o);
    return v;
}
__device__ __forceinline__ float wave_max(float v) {
#pragma unroll
    for (int o = 1; o < 64; o <<= 1) v = fmaxf(v, __shfl_xor(v, o));
    return v;
}
__device__ __forceinline__ float sigmoidf_(float x) { return __builtin_amdgcn_rcpf(1.f + __expf(-x)); }
__device__ __forceinline__ float siluf_(float x) { return x * __builtin_amdgcn_rcpf(1.f + __expf(-x)); }
__device__ __forceinline__ float gelu_erf(float x) { return 0.5f * x * (1.f + erff(x * 0.70710678118654752f)); }
__device__ __forceinline__ void sincos_d(double a, float& s, float& c) {
    const double k = rint(a * 0.63661977236758134308);
    const double r = fma(-k, 1.57079632679489661923, a) - k * 6.123233995736766e-17;
    const double r2 = r * r;
    double sp = -2.5052108385441720e-08; sp = sp * r2 + 2.7557319223985893e-06; sp = sp * r2 - 1.9841269841269841e-04; sp = sp * r2 + 8.3333333333333332e-03; sp = sp * r2 - 1.6666666666666666e-01;
    const double sn = r + r * r2 * sp;
    double cp = 2.0876756987868099e-09; cp = cp * r2 - 2.7557319223985888e-07; cp = cp * r2 + 2.4801587301587302e-05; cp = cp * r2 - 1.3888888888888889e-03; cp = cp * r2 + 4.1666666666666664e-02; cp = cp * r2 - 0.5;
    const double cs = 1.0 + r2 * cp;
    const int q = ((int)k) & 3;
    const double ss = (q == 0) ? sn : (q == 1) ? cs : (q == 2) ? -sn : -cs;
    const double cc = (q == 0) ? cs : (q == 1) ? -sn : (q == 2) ? -cs : sn;
    s = (float)ss; c = (float)cc;
}

struct Args { const float* in[29]; float* out; unsigned char* ws; int ph_lo, ph_hi; };
static_assert(sizeof(Args) == 29 * 8 + 8 + 8 + 8, "Args has no padding");
enum { I_X = 0, I_C, I_CTX, I_CCTX, I_WMOD, I_BMOD, I_GPREMIX, I_GPOSTMIX, I_GPREFFN, I_GPOSTFFN, I_WIN, I_WOUT, I_LAMRE, I_LAMIM, I_LOGDT, I_BRE, I_BIM, I_CRE, I_CIM, I_S5D, I_WGLU,
       I_CONV, I_ALOG, I_DTBIAS, I_GDNNORM, I_WQ, I_KEYS, I_PU, I_PV };

__device__ __forceinline__ const float* in_row(const Args& a, int row) { return row < ML ? a.in[I_X] + (size_t)row * D : a.in[I_CTX] + (size_t)(row - ML) * D; }
__device__ __forceinline__ int mod_row(int row) { return row < ML ? (row >> 11) : 8; }

template <int CTRL> __device__ __forceinline__ float dppf(float v) { return __builtin_bit_cast(float, __builtin_amdgcn_update_dpp(0, __builtin_bit_cast(int, v), CTRL, 0xf, 0xf, true)); }
__device__ __forceinline__ float row_sum16(float v) { v += dppf<0xB1>(v); v += dppf<0x4E>(v); v += dppf<0x141>(v); v += dppf<0x140>(v); return v; }
__device__ __forceinline__ float row_max16(float v) { v = fmaxf(v, dppf<0xB1>(v)); v = fmaxf(v, dppf<0x4E>(v)); v = fmaxf(v, dppf<0x141>(v)); v = fmaxf(v, dppf<0x140>(v)); return v; }
__device__ __forceinline__ float wsum(float v) { v = row_sum16(v); return
    __builtin_bit_cast(float, __builtin_amdgcn_readlane(__builtin_bit_cast(int, v), 0)) + __builtin_bit_cast(float, __builtin_amdgcn_readlane(__builtin_bit_cast(int, v), 16)) +
    __builtin_bit_cast(float, __builtin_amdgcn_readlane(__builtin_bit_cast(int, v), 32)) + __builtin_bit_cast(float, __builtin_amdgcn_readlane(__builtin_bit_cast(int, v), 48)); }
__device__ __forceinline__ float wmax(float v) { v = row_max16(v); return fmaxf(fmaxf(__builtin_bit_cast(float, __builtin_amdgcn_readlane(__builtin_bit_cast(int, v), 0)), __builtin_bit_cast(float, __builtin_amdgcn_readlane(__builtin_bit_cast(int, v), 16))),
    fmaxf(__builtin_bit_cast(float, __builtin_amdgcn_readlane(__builtin_bit_cast(int, v), 32)), __builtin_bit_cast(float, __builtin_amdgcn_readlane(__builtin_bit_cast(int, v), 48)))); }
__device__ __forceinline__ int lane_rank(unsigned long long m) { return __builtin_amdgcn_mbcnt_hi((unsigned)(m >> 32), __builtin_amdgcn_mbcnt_lo((unsigned)m, 0)); }
__device__ __forceinline__ unsigned fkey(float f) { const unsigned u = __builtin_bit_cast(unsigned, f); return u ^ ((unsigned)((int)u >> 31) | 0x80000000u); }
#define WAVE_LDS_SYNC() do { __builtin_amdgcn_fence(__ATOMIC_RELEASE, "wavefront"); __builtin_amdgcn_wave_barrier(); __builtin_amdgcn_fence(__ATOMIC_ACQUIRE, "wavefront"); } while (0)
template <int N> __device__ __forceinline__ unsigned kth_key(const unsigned (&k)[N], int K) {
    unsigned T = 0;
    for (int bit = 31; bit >= 0; --bit) { const unsigned cand = T | (1u << bit); int cnt = 0;
#pragma unroll
        for (int n = 0; n < N; ++n) cnt += __popcll(__ballot(k[n] >= cand));
        if (cnt >= K) T = cand;
        if (cnt == K) break; }
    return T;
}

namespace pg8 {
struct EpiInProj {
    static constexpr bool PERM = true, AFTER_DRAIN = false;
    bf16_t* U; bf16_t* QKV; bf16_t* Z;
    __device__ __forceinline__ void operator()(const f32x4 (&acc)[2][2][4][2], const Unit& u, int wr, int wc, int fr, int fq) const {
        bf16_t* base; int ld, colt; bool lat_only = false;
        const bool s5 = u.pn < 2;
        if (s5) { base = U; ld = 0; colt = u.pn * BM; }
        else if (u.pn < 8) { base = QKV; ld = 1536; colt = (u.pn - 2) * BM; }
        else { base = Z; ld = 512; colt = (u.pn - 8) * BM; lat_only = true; }
        const int row0 = u.pm * BM + wr * 64 + fr, col0 = colt + wc * 32 + 8 * fq;
#pragma unroll
        for (int ai = 0; ai < 2; ++ai)
#pragma unroll
            for (int m = 0; m < 4; ++m) { const int row = row0 + ai * HALF + m * 16; bf16_t* rowp = base + (size_t)row * ld + col0;
                if (lat_only && row >= 16384) continue;
                if (s5) { const int R = row < 16384 ? (row >> 5) : 512 + ((row - 16384) >> 5), ii = row & 31; rowp = base + (size_t)R * 768 + ii * 16 + (col0 & 15); }
#pragma unroll
                for (int bj = 0; bj < 2; ++bj) { const f32x4 v0 = acc[ai][bj][m][0], v1 = acc[ai][bj][m][1];
                    u32x4 w; w.x = cvt_pk_bf16(v0[0], v0[1]); w.y = cvt_pk_bf16(v0[2], v0[3]); w.z = cvt_pk_bf16(v1[0], v1[1]); w.w = cvt_pk_bf16(v1[2], v1[3]);
                    if (s5) *(u32x4*)(rowp + (size_t)((col0 + bj * HALF) >> 4) * (768 * 768)) = w; else *(u32x4*)(rowp + bj * HALF) = w; } }
    }
};
struct EpiGlu {
    static constexpr bool PERM = true, AFTER_DRAIN = false;
    const bf16_t* YG; bf16_t* CAT;
    __device__ __forceinline__ void operator()(const f32x4 (&acc)[2][2][4][2], const Unit& u, int wr, int wc, int fr, int fq) const {
        const int row0 = u.pm * BM + wr * 64 + fr, col0 = u.pn * BM + wc * 32 + 8 * fq;
#pragma unroll
        for (int ai = 0; ai < 2; ++ai)
#pragma unroll
            for (int m = 0; m < 4; ++m) { const int row = row0 + ai * HALF + m * 16;
#pragma unroll
                for (int bj = 0; bj < 2; ++bj) { const f32x4 v0 = acc[ai][bj][m][0], v1 = acc[ai][bj][m][1];
                    const u32x4 y = *(const u32x4*)(YG + (size_t)row * 512 + col0 + bj * HALF);
                    float o[8]; const float a[8] = {v0[0], v0[1], v0[2], v0[3], v1[0], v1[1], v1[2], v1[3]};
                    const unsigned yw[4] = {y.x, y.y, y.z, y.w};
#pragma unroll
                    for (int e = 0; e < 8; ++e) { const float yv = __builtin_bit_cast(float, (e & 1) ? (yw[e >> 1] & 0xffff0000u) : (yw[e >> 1] << 16)); o[e] = yv * __builtin_amdgcn_rcpf(1.f + __expf(-a[e])); }
                    u32x4 w; w.x = cvt_pk_bf16(o[0], o[1]); w.y = cvt_pk_bf16(o[2], o[3]); w.z = cvt_pk_bf16(o[4], o[5]); w.w = cvt_pk_bf16(o[6], o[7]);
                    *(u32x4*)(CAT + (size_t)row * 1024 + col0 + bj * HALF) = w; } }
    }
};
struct EpiF32 {
    static constexpr bool PERM = false, AFTER_DRAIN = false;
    float* C; int ldc;
    __device__ __forceinline__ void operator()(const f32x4 (&acc)[2][2][4][2], const Unit& u, int wr, int wc, int fr, int fq) const {
        const int row0 = u.pm * BM + wr * 64 + fr, col0 = u.pn * BM + wc * 32 + 4 * fq;
#pragma unroll
        for (int ai = 0; ai < 2; ++ai)
#pragma unroll
            for (int m = 0; m < 4; ++m) { float* rowp = C + (size_t)(row0 + ai * HALF + m * 16) * ldc + col0;
#pragma unroll
                for (int bj = 0; bj < 2; ++bj)
#pragma unroll
                    for (int n = 0; n < 2; ++n) *(f32x4*)(rowp + bj * HALF + n * 16) = acc[ai][bj][m][n]; }
    }
};
struct EpiSS {
    static constexpr bool PERM = false, AFTER_DRAIN = false;
    float* C;
    __device__ __forceinline__ void operator()(const f32x4 (&acc)[2][2][4][2], const Unit& u, int wr, int wc, int fr, int fq) const {
        const int row0 = u.pm * BM + wr * 64 + fr, col0 = wc * 32 + 4 * fq;
#pragma unroll
        for (int ai = 0; ai < 2; ++ai)
#pragma unroll
            for (int m = 0; m < 4; ++m) { float* rowp = C + (size_t)(row0 + ai * HALF + m * 16) * 256 + col0;
#pragma unroll
                for (int bj = 0; bj < 2; ++bj)
#pragma unroll
                    for (int n = 0; n < 2; ++n) *(f32x4*)(rowp + bj * HALF + n * 16) = acc[ai][bj][m][n]; }
    }
};
struct SchedSS { int G, c; __device__ bool next(int i, Unit& u) const { const int L = i * G + c; if (L >= 96) return false; u.pm = L; u.pn = L / 3; return true; }
    __device__ __forceinline__ void a_ready(const Unit&) const {} __device__ __forceinline__ void done(const Unit&) const {} };
struct EpiS5Y {
    static constexpr bool PERM = true, AFTER_DRAIN = false;
    bf16_t* YG;
    __device__ __forceinline__ void operator()(const f32x4 (&acc)[2][2][4][2], const Unit& u, int wr, int wc, int fr, int fq) const {
        const int g = u.pn >> 1, R0 = (u.pm - 3 * g) * BM + wr * 64 + fr, n0 = (u.pn & 1) * BM + wc * 32 + 8 * fq;
#pragma unroll
        for (int ai = 0; ai < 2; ++ai)
#pragma unroll
            for (int m = 0; m < 4; ++m) { const int R = R0 + ai * HALF + m * 16;
#pragma unroll
                for (int bj = 0; bj < 2; ++bj) { const int n = n0 + bj * HALF; const f32x4 v0 = acc[ai][bj][m][0], v1 = acc[ai][bj][m][1];
                    const f32x2 a = gelu_pk((f32x2){v0[0], v0[1]}), b = gelu_pk((f32x2){v0[2], v0[3]}), c2 = gelu_pk((f32x2){v1[0], v1[1]}), d = gelu_pk((f32x2){v1[2], v1[3]});
                    u32x4 w; w.x = cvt_pk_bf16(a.x, a.y); w.y = cvt_pk_bf16(b.x, b.y); w.z = cvt_pk_bf16(c2.x, c2.y); w.w = cvt_pk_bf16(d.x, d.y);
                    *(u32x4*)(YG + (size_t)(R * 32 + (n >> 4)) * 512 + g * 16 + (n & 15)) = w; } }
    }
};
struct SchedS5Y { int G, c; __device__ bool next(int i, Unit& u) const { const int L = i * G + c; if (L >= 128) return false; const int g = L >> 2; u.pm = 3 * g + ((L >> 1) & 1); u.pn = 2 * g + (L & 1); return true; }
    __device__ __forceinline__ void a_ready(const Unit&) const {} __device__ __forceinline__ void done(const Unit&) const {} };
}

struct Ctx { const Args* a; unsigned char* ws; unsigned char* lds; int tid, lane, wave, bid, G, gw, NGW, gwv; };

__device__ __forceinline__ void p0_transpose_item(const float* W, int ldw, int nblk, int K, bf16* WT, float* scr, int item, int lane) {
    const int kb = item / nblk, nb = item % nblk, k0 = 64 * kb, n0 = 32 * nb;
#pragma unroll 8
    for (int i = 0; i < 32; ++i) { const int kk = 2 * i + (lane >> 5); scr[kk * 33 + (lane & 31)] = W[(size_t)(k0 + kk) * ldw + n0 + (lane & 31)]; }
    __builtin_amdgcn_fence(__ATOMIC_RELEASE, "wavefront"); __builtin_amdgcn_wave_barrier(); __builtin_amdgcn_fence(__ATOMIC_ACQUIRE, "wavefront");
    const int c = lane & 7;
#pragma unroll
    for (int j = 0; j < 4; ++j) { const int n = (lane >> 3) + 8 * j; const float* s = scr + (8 * c) * 33 + n;
        v4u o; o.x = pk2(s[0 * 33], s[1 * 33]); o.y = pk2(s[2 * 33], s[3 * 33]); o.z = pk2(s[4 * 33], s[5 * 33]); o.w = pk2(s[6 * 33], s[7 * 33]);
        *(v4u*)(WT + (size_t)(n0 + n) * K + k0 + 8 * c) = o; }
    __builtin_amdgcn_fence(__ATOMIC_RELEASE, "wavefront"); __builtin_amdgcn_wave_barrier(); __builtin_amdgcn_fence(__ATOMIC_ACQUIRE, "wavefront");
}
__device__ __forceinline__ void phase_prep(const Ctx& c) {
    const Args& a = *c.a;
    float* scr = (float*)(c.lds + c.wave * 16384);
    constexpr int I_IN = 16 * 80, I_OUT = 16 * 32, I_GLU = 8 * 16, I_Q = 16 * 64;
    for (int it = c.gw; it < I_IN + I_OUT + I_GLU + I_Q; it += c.NGW) {
        int r = it;
        if (r < I_IN) { p0_transpose_item(a.in[I_WIN], PROJ, 80, 1024, (bf16*)(c.ws + WS_WIN), scr, r, c.lane); continue; } r -= I_IN;
        if (r < I_OUT) { p0_transpose_item(a.in[I_WOUT], 1024, 32, 1024, (bf16*)(c.ws + WS_WOUT), scr, r, c.lane); continue; } r -= I_OUT;
        if (r < I_GLU) { p0_transpose_item(a.in[I_WGLU], 512, 16, 512, (bf16*)(c.ws + WS_WGLU), scr, r, c.lane); continue; } r -= I_GLU;
        p0_transpose_item(a.in[I_WQ], 2048, 64, 1024, (bf16*)(c.ws + WS_WQ), scr, r, c.lane);
    }
    __syncthreads();
    float* sc = (float*)c.lds;
    float* red = (float*)(c.lds + 9 * 1024 * 4);
    float* MOD = (float*)(c.ws + WS_MOD);
    bool have = false;
    for (int item = c.bid; item < 96; item += c.G) {
        if (!have) { for (int i = c.tid; i < 9 * 1024; i += NTHREADS) { const int r = i >> 10, k = i & 1023; const float v = r < 8 ? a.in[I_C][r * 1024 + k] : a.in[I_CCTX][k]; sc[i] = siluf_(v); } have = true; __syncthreads(); }
        const int n0 = item * 64;
        float acc[9];
#pragma unroll
        for (int r = 0; r < 9; ++r) acc[r] = 0.f;
        const float* wp = a.in[I_WMOD] + (size_t)(c.wave * 128) * 6144 + n0 + c.lane;
#pragma unroll 16
        for (int k = 0; k < 128; ++k) { const float w = wp[(size_t)k * 6144];
#pragma unroll
            for (int r = 0; r < 9; ++r) acc[r] = fmaf(sc[r * 1024 + c.wave * 128 + k], w, acc[r]); }
#pragma unroll
        for (int r = 0; r < 9; ++r) red[(c.wave * 9 + r) * 64 + c.lane] = acc[r];
        __syncthreads();
        for (int i = c.tid; i < 576; i += NTHREADS) { const int r = i >> 6, l = i & 63; float s = a.in[I_BMOD][n0 + l];
#pragma unroll
            for (int w = 0; w < 8; ++w) s += red[(w * 9 + r) * 64 + l];
            MOD[r * 6144 + n0 + l] = s; }
        __syncthreads();
    }
}
__device__ __forceinline__ void s5_build_group(const Ctx& c, int g, int part);
__device__ __forceinline__ void phase_s5_build(const Ctx& c) { for (int it = c.G - 1 - c.bid; it < 128; it += c.G) if (it >= 0) s5_build_group(c, it >> 2, it & 3); }

__device__ __forceinline__ void phase_norm1(const Ctx& c) {
    const Args& a = *c.a;
    float* wabT = (float*)c.lds;
    { f32x4 wv[8];
#pragma unroll
      for (int q = 0; q < 8; ++q) { const int i = c.tid + NTHREADS * q, kk = i >> 2, qq = i & 3; wv[q] = *(const f32x4*)(a.in[I_WIN] + (size_t)kk * PROJ + NPROJ + 4 * qq); }
#pragma unroll
      for (int q = 0; q < 8; ++q) { const int i = c.tid + NTHREADS * q, kk = i >> 2, qq = i & 3; wabT[(4 * qq + 0) * 1028 + kk] = wv[q].x; wabT[(4 * qq + 1) * 1028 + kk] = wv[q].y; wabT[(4 * qq + 2) * 1028 + kk] = wv[q].z; wabT[(4 * qq + 3) * 1028 + kk] = wv[q].w; } }
    __syncthreads();
    const float* MOD = (const float*)(c.ws + WS_MOD);
    bf16* HX = (bf16*)(c.ws + WS_HX); float* GB = (float*)(c.ws + WS_GB);
    const float* gpre = a.in[I_GPREMIX];
    f32x4 nx[4], g4c[4];
#pragma unroll
    for (int j = 0; j < 4; ++j) g4c[j] = *(const f32x4*)(gpre + 4 * c.lane + 256 * j);
    if (c.gw < MT) { const f32x4* xr = (const f32x4*)in_row(a, c.gw) + c.lane;
#pragma unroll
        for (int j = 0; j < 4; ++j) nx[j] = xr[64 * j]; }
    for (int row = c.gw; row < MT; row += c.NGW) {
        const float* mr = MOD + mod_row(row) * 6144;
        f32x4 shv[4], sclv[4];
#pragma unroll
        for (int j = 0; j < 4; ++j) { shv[j] = *(const f32x4*)(mr + 4 * c.lane + 256 * j); sclv[j] = *(const f32x4*)(mr + 1024 + 4 * c.lane + 256 * j); }
        f32x4 v[4]; float ss = 0.f;
#pragma unroll
        for (int j = 0; j < 4; ++j) { v[j] = nx[j]; ss += (v[j].x * v[j].x + v[j].y * v[j].y) + (v[j].z * v[j].z + v[j].w * v[j].w); }
        if (row + c.NGW < MT) { const f32x4* xr = (const f32x4*)in_row(a, row + c.NGW) + c.lane;
#pragma unroll
            for (int j = 0; j < 4; ++j) nx[j] = xr[64 * j]; }
        const float r = rsqrtf(wsum(ss) * (1.f / D) + EPS);
#pragma unroll
        for (int j = 0; j < 4; ++j) { const int col = 4 * c.lane + 256 * j;
            v[j] = (v[j] * r) * g4c[j] * (sclv[j] + 1.f) + shv[j];
            v2u o; o.x = pk2(v[j].x, v[j].y); o.y = pk2(v[j].z, v[j].w);
            *(v2u*)(HX + (size_t)row * D + col) = o; }
        float pj[16];
#pragma unroll
        for (int j = 0; j < 16; ++j) { float s = 0.f;
#pragma unroll
            for (int jj = 0; jj < 4; ++jj) { const f32x4 w = *(const f32x4*)(wabT + j * 1028 + 4 * c.lane + 256 * jj); s += (v[jj].x * w.x + v[jj].y * w.y) + (v[jj].z * w.z + v[jj].w * w.w); }
            pj[j] = s; if ((j & 1) == 1) asm volatile("" ::: "memory"); }
        const bool b5 = c.lane & 32, b4 = c.lane & 16, b3 = c.lane & 8, b2 = c.lane & 4;
        float q8[8], q4[4], q2[2];
#pragma unroll
        for (int i = 0; i < 8; ++i) { const float keep = b5 ? pj[i + 8] : pj[i], send = b5 ? pj[i] : pj[i + 8]; q8[i] = keep + __shfl_xor(send, 32); }
#pragma unroll
        for (int i = 0; i < 4; ++i) { const float keep = b4 ? q8[i + 4] : q8[i], send = b4 ? q8[i] : q8[i + 4]; q4[i] = keep + __shfl_xor(send, 16); }
#pragma unroll
        for (int i = 0; i < 2; ++i) { const float keep = b3 ? q4[i + 2] : q4[i], send = b3 ? q4[i] : q4[i + 2]; q2[i] = keep + dppf<0x140>(send); }
        float mine; { const float keep = b2 ? q2[1] : q2[0], send = b2 ? q2[0] : q2[1]; mine = keep + dppf<0x141>(send); }
        mine += dppf<0xB1>(mine); mine += dppf<0x4E>(mine);
        const int jl = (b5 ? 8 : 0) + (b4 ? 4 : 0) + (b3 ? 2 : 0) + (b2 ? 1 : 0);
        if ((c.lane & 3) == 0) {
            if (jl < 8) { const float t = mine + a.in[I_DTBIAS][jl]; const float sp = t > 20.f ? t : log1pf(expf(t)); GB[(size_t)row * 16 + jl] = -expf(a.in[I_ALOG][jl]) * sp; }
            else GB[(size_t)row * 16 + jl] = 1.f / (1.f + expf(-mine)); }
    }
}

__device__ __forceinline__ void phase_conv(const Ctx& c) {
    const Args& a = *c.a;
    const bf16* PRE = (const bf16*)(c.ws + WS_QKVPRE); bf16* OUT = (bf16*)(c.ws + WS_QKV);
    const float* cw = a.in[I_CONV];
#pragma unroll 1
    for (int pass = 0; pass < 3; ++pass) { const int ch0 = pass * 512 + 8 * c.lane;
        f32x4 wt[9][2];
#pragma unroll
        for (int i = 0; i < 9; ++i) { wt[i][0] = *(const f32x4*)(cw + i * 1536 + ch0); wt[i][1] = *(const f32x4*)(cw + i * 1536 + ch0 + 4); }
#define CONV_LOAD(DST, ROW) do { const int row_ = (ROW); int nb_row[9]; bool ok[9]; \
            if (row_ < ML) { const int t = row_ & 2047, gr = t >> 6, gc = t & 63; \
                _Pragma("unroll") for (int dy = -1; dy <= 1; ++dy) _Pragma("unroll") for (int dx = -1; dx <= 1; ++dx) { const int i = (dy + 1) * 3 + dx + 1; ok[i] = (gr + dy >= 0) && (gr + dy < 32) && (gc + dx >= 0) && (gc + dx < 64); nb_row[i] = row_ + dy * 64 + dx; } } \
            else { const int t = (row_ - ML) & 255; _Pragma("unroll") for (int i = 0; i < 9; ++i) { ok[i] = false; nb_row[i] = row_; } \
                _Pragma("unroll") for (int dx = -1; dx <= 1; ++dx) { ok[4 + dx] = (t + dx >= 0) && (t + dx < 256); nb_row[4 + dx] = row_ + dx; } } \
            _Pragma("unroll") for (int i = 0; i < 9; ++i) DST[i] = ok[i] ? *(const v4u*)(PRE + (size_t)nb_row[i] * 1536 + ch0) : (v4u){0u, 0u, 0u, 0u}; } while (0)
        v4u nin[9];
        if (c.gw < MT) CONV_LOAD(nin, c.gw);
#pragma unroll 1
        for (int row = c.gw; row < MT; row += c.NGW) {
            v4u in[9];
#pragma unroll
            for (int i = 0; i < 9; ++i) in[i] = nin[i];
            if (row + c.NGW < MT) CONV_LOAD(nin, row + c.NGW);
            float o[8];
#pragma unroll
            for (int q = 0; q < 8; ++q) o[q] = 0.f;
#pragma unroll
            for (int i = 0; i < 9; ++i) { const unsigned w[4] = {in[i].x, in[i].y, in[i].z, in[i].w}; const float kk[8] = {wt[i][0].x, wt[i][0].y, wt[i][0].z, wt[i][0].w, wt[i][1].x, wt[i][1].y, wt[i][1].z, wt[i][1].w};
#pragma unroll
                for (int q = 0; q < 4; ++q) { o[2 * q] = fmaf(bflo(w[q]), kk[2 * q], o[2 * q]); o[2 * q + 1] = fmaf(bfhi(w[q]), kk[2 * q + 1], o[2 * q + 1]); } }
            float ssq = 0.f;
#pragma unroll
            for (int q = 0; q < 8; ++q) { o[q] = siluf_(o[q]); ssq = fmaf(o[q], o[q], ssq); }
            if (pass < 2) { const float sc = rsqrtf(row_sum16(ssq) + EPS) * (pass == 0 ? 0.08838834764831845f : 1.f);
#pragma unroll
                for (int q = 0; q < 8; ++q) o[q] *= sc; }
            v4u ov; ov.x = pk2(o[0], o[1]); ov.y = pk2(o[2], o[3]); ov.z = pk2(o[4], o[5]); ov.w = pk2(o[6], o[7]);
            *(v4u*)(OUT + (size_t)row * 1536 + ch0) = ov;
        }
#undef CONV_LOAD
    }
}

__device__ __forceinline__ int scan_row(int b, int dir, int step) {
    if (step < LC) { const int t = dir ? LC - 1 - step : step; return ML + b * LC + t; }
    const int t = step - LC; return b * SEQ + (dir ? SEQ - 1 - t : t);
}
__device__ __forceinline__ void phase_combine(const Ctx& c) {
    const Args& a = *c.a;
    const bf16* OG0 = (const bf16*)(c.ws + WS_OG); const bf16* OG1 = OG0 + (size_t)ML * 512; const bf16* Z = (const bf16*)(c.ws + WS_Z);
    bf16* CAT = (bf16*)(c.ws + WS_CAT);
    const f32x2 ng = *(const f32x2*)(a.in[I_GDNNORM] + 2 * c.lane);
    unsigned n0[4], n1[4], nz[4];
#define CB_LOAD(R) do { _Pragma("unroll") for (int h = 0; h < 4; ++h) { const size_t o_ = (size_t)(R) * 512 + h * 128 + 2 * c.lane; n0[h] = *(const unsigned*)(OG0 + o_); n1[h] = *(const unsigned*)(OG1 + o_); nz[h] = *(const unsigned*)(Z + o_); } } while (0)
    if (c.gw < ML) CB_LOAD(c.gw);
    for (int row = c.gw; row < ML; row += c.NGW) {
        unsigned w0[4], w1[4], zw[4];
#pragma unroll
        for (int h = 0; h < 4; ++h) { w0[h] = n0[h]; w1[h] = n1[h]; zw[h] = nz[h]; }
        { const int rn = row + c.NGW < ML ? row + c.NGW : row; CB_LOAD(rn); }
#pragma unroll
        for (int h = 0; h < 4; ++h) { const int ch = h * 128 + 2 * c.lane;
            const float o0 = bflo(w0[h]) + bflo(w1[h]), o1 = bfhi(w0[h]) + bfhi(w1[h]);
            const float r = rsqrtf(wave_sum(o0 * o0 + o1 * o1) * (1.f / 128.f) + EPS);
            *(unsigned*)(CAT + (size_t)row * 1024 + 512 + ch) = pk2(o0 * r * ng.x * siluf_(bflo(zw[h])), o1 * r * ng.y * siluf_(bfhi(zw[h]))); }
    }
#undef CB_LOAD
}

__device__ __forceinline__ void phase_rows2(const Ctx& c) {
    const Args& a = *c.a;
    const float* MOD = (const float*)(c.ws + WS_MOD); const bf16* YRAW = (const bf16*)(c.ws + WS_YRAW); bf16* HX2 = (bf16*)(c.ws + WS_HX2);
    v2u ny[4]; f32x4 nxx[4], gpo[4], gpf[4];
#pragma unroll
    for (int j = 0; j < 4; ++j) { gpo[j] = *(const f32x4*)(a.in[I_GPOSTMIX] + 4 * c.lane + 256 * j); gpf[j] = *(const f32x4*)(a.in[I_GPREFFN] + 4 * c.lane + 256 * j); }
    if (c.gw < ML) {
#pragma unroll
        for (int j = 0; j < 4; ++j) { ny[j] = *((const v2u*)(YRAW + (size_t)c.gw * D) + c.lane + 64 * j); nxx[j] = *((const f32x4*)(a.in[I_X] + (size_t)c.gw * D) + c.lane + 64 * j); } }
    for (int row = c.gw; row < ML; row += c.NGW) {
        const float* mr = MOD + (row >> 11) * 6144;
        f32x4 gtv[4], shv[4], sclv[4];
#pragma unroll
        for (int j = 0; j < 4; ++j) { const int col = 4 * c.lane + 256 * j; gtv[j] = *(const f32x4*)(mr + 2048 + col); shv[j] = *(const f32x4*)(mr + 3072 + col); sclv[j] = *(const f32x4*)(mr + 4096 + col); }
        f32x4 y[4], x[4]; float ss = 0.f;
#pragma unroll
        for (int j = 0; j < 4; ++j) { y[j] = (f32x4){bflo(ny[j].x), bfhi(ny[j].x), bflo(ny[j].y), bfhi(ny[j].y)}; x[j] = nxx[j];
            ss += (y[j].x * y[j].x + y[j].y * y[j].y) + (y[j].z * y[j].z + y[j].w * y[j].w); }
        if (row + c.NGW < ML) { const size_t r2 = (size_t)(row + c.NGW);
#pragma unroll
            for (int j = 0; j < 4; ++j) { ny[j] = *((const v2u*)(YRAW + r2 * D) + c.lane + 64 * j); nxx[j] = *((const f32x4*)(a.in[I_X] + r2 * D) + c.lane + 64 * j); } }
        const float r = rsqrtf(wsum(ss) * (1.f / D) + EPS); float s2 = 0.f;
#pragma unroll
        for (int j = 0; j < 4; ++j) { const int col = 4 * c.lane + 256 * j;
            x[j] = x[j] + gtv[j] * ((y[j] * r) * gpo[j]);
            *(f32x4*)(a.out + (size_t)row * D + col) = x[j];
            s2 += (x[j].x * x[j].x + x[j].y * x[j].y) + (x[j].z * x[j].z + x[j].w * x[j].w); }
        const float r2 = rsqrtf(wsum(s2) * (1.f / D) + EPS);
#pragma unroll
        for (int j = 0; j < 4; ++j) { const int col = 4 * c.lane + 256 * j;
            const f32x4 hv = (x[j] * r2) * gpf[j] * (sclv[j] + 1.f) + shv[j];
            v2u o; o.x = pk2(hv.x, hv.y); o.y = pk2(hv.z, hv.w);
            *(v2u*)(HX2 + (size_t)row * D + col) = o;
            x[j] = (f32x4){bflo(o.x), bfhi(o.x), bflo(o.y), bfhi(o.y)}; }
        { float mx = 0.f;
#pragma unroll
          for (int j = 0; j < 4; ++j) mx = fmaxf(mx, fmaxf(fmaxf(fabsf(x[j].x), fabsf(x[j].y)), fmaxf(fabsf(x[j].z), fabsf(x[j].w))));
          mx = wmax(mx); const float hs = mx > 0.f ? 256.f / mx : 1.f;
          unsigned char* hq = c.ws + WS_HQ8 + (size_t)row * 2048;
#pragma unroll
          for (int j = 0; j < 4; ++j) { const float a0 = x[j].x * hs, a1 = x[j].y * hs, a2 = x[j].z * hs, a3 = x[j].w * hs;
              int w = __builtin_amdgcn_cvt_pk_fp8_f32(a0, a1, 0, false); w = __builtin_amdgcn_cvt_pk_fp8_f32(a2, a3, w, true);
              const f32x2 b01 = __builtin_amdgcn_cvt_pk_f32_fp8(w, false), b23 = __builtin_amdgcn_cvt_pk_f32_fp8(w, true);
              int w2 = __builtin_amdgcn_cvt_pk_fp8_f32((a0 - b01.x) * 16.f, (a1 - b01.y) * 16.f, 0, false); w2 = __builtin_amdgcn_cvt_pk_fp8_f32((a2 - b23.x) * 16.f, (a3 - b23.y) * 16.f, w2, true);
              *(unsigned*)(hq + 4 * c.lane + 256 * j) = (unsigned)w; *(unsigned*)(hq + 1024 + 4 * c.lane + 256 * j) = (unsigned)w2; }
          if (c.lane == 0) ((float*)(c.ws + WS_HS))[row] = 1.f / hs; }
    }
}


constexpr int KROW = 136;
__device__ __forceinline__ float unfkey(unsigned k) { const unsigned u = (k & 0x80000000u) ? (k ^ 0x80000000u) : ~k; return __builtin_bit_cast(float, u); }
__device__ __forceinline__ void ins16(unsigned (&L)[16], unsigned key) {
#pragma unroll
    for (int q = 0; q < 16; ++q) { const unsigned hi = L[q] > key ? L[q] : key, lo = L[q] > key ? key : L[q]; L[q] = hi; key = lo; }
}
__device__ __forceinline__ void sort16_desc(unsigned (&a)[16]) {
#pragma unroll
    for (int kk = 2; kk <= 16; kk <<= 1)
#pragma unroll
        for (int j = kk >> 1; j >= 1; j >>= 1)
#pragma unroll
            for (int i = 0; i < 16; ++i) { const int l = i ^ j; if (l > i) { const unsigned hi = a[i] > a[l] ? a[i] : a[l], lo = a[i] > a[l] ? a[l] : a[i]; if ((i & kk) == 0) { a[i] = hi; a[l] = lo; } else { a[i] = lo; a[l] = hi; } } }
}
__device__ __forceinline__ void top16_of_two(unsigned (&A)[16], const unsigned (&B)[16]) {
#pragma unroll
    for (int q = 0; q < 16; ++q) A[q] = A[q] > B[15 - q] ? A[q] : B[15 - q];
#pragma unroll
    for (int j = 8; j >= 1; j >>= 1)
#pragma unroll
        for (int q = 0; q < 16; ++q) if ((q & j) == 0) { const unsigned hi = A[q] > A[q + j] ? A[q] : A[q + j], lo = A[q] > A[q + j] ? A[q + j] : A[q]; A[q] = hi; A[q + j] = lo; }
}
__device__ __forceinline__ void merge16(unsigned (&L)[16]) {
    unsigned R[16];
#pragma unroll
    for (int q = 0; q < 16; ++q) R[q] = (unsigned)__shfl_xor((int)L[15 - q], 32);
#pragma unroll
    for (int q = 0; q < 16; ++q) L[q] = L[q] > R[q] ? L[q] : R[q];
#pragma unroll
    for (int j = 8; j >= 1; j >>= 1)
#pragma unroll
        for (int q = 0; q < 16; ++q) if ((q & j) == 0) { const unsigned hi = L[q] > L[q + j] ? L[q] : L[q + j], lo = L[q] > L[q + j] ? L[q + j] : L[q]; L[q] = hi; L[q + j] = lo; }
}
__device__ __forceinline__ void phase_topk(const Ctx& c) {
    const Args& a = *c.a;
    bf16* kl = (bf16*)c.lds;
    unsigned char* wtab = c.lds + 2 * 128 * KROW * 2 + c.wave * 1088;
    const bf16* QP = (const bf16*)(c.ws + WS_QP); int* IDX = (int*)(c.ws + WS_IDX); float* GATE = (float*)(c.ws + WS_GATE);
    const int r = c.lane & 31, hh = c.lane >> 5;
    { const unsigned char ptab[50] = {0, 1, 2, 3, 4, 5, 6, 7, 8, 9, 10, 11, 12, 13, 14, 15, 16, 17, 18, 19, 20, 21, 22, 23, 32, 33, 34, 35, 36, 48, 49, 50, 51, 64, 65, 66, 80, 81, 96, 97, 112, 113, 128, 144, 160, 176, 192, 208, 224, 240};
      if (c.lane < 50) wtab[1024 + c.lane] = ptab[c.lane < 50 ? c.lane : 0]; }
    for (int item = c.bid; item < 8 * 32; item += c.G) {
        const int h = item & 7, tr = item >> 3;
        __syncthreads();
        for (int i = c.tid; i < 2 * 128 * 64; i += NTHREADS) { const int k2 = i & 63, n = (i >> 6) & 127, p = i >> 13; const f32x2 kv = *(const f32x2*)(a.in[I_KEYS] + ((size_t)((h * 2 + p) * 128 + n)) * 128 + 2 * k2);
            *(unsigned*)(kl + (p * 128 + n) * KROW + 2 * k2) = pk2(kv.x, kv.y); }
        __syncthreads();
        for (int tile = c.wave; tile < 16; tile += NWAVES) {
            const int tok = tr * 512 + tile * 32 + r;
            unsigned LA[16], LB[16];
#pragma unroll
            for (int p = 0; p < 2; ++p) {
                bf16x8 qf[8];
#pragma unroll
                for (int kk = 0; kk < 8; ++kk) qf[kk] = *(const bf16x8*)(QP + (size_t)tok * 2048 + h * 256 + p * 128 + kk * 16 + hh * 8);
                f32x16 acc[4];
#pragma unroll
                for (int nt = 0; nt < 4; ++nt)
#pragma unroll
                    for (int i = 0; i < 16; ++i) acc[nt][i] = 0.f;
#pragma unroll
                for (int kk = 0; kk < 8; ++kk)
#pragma unroll
                    for (int nt = 0; nt < 4; ++nt) acc[nt] = MFMA32(*(const bf16x8*)(kl + (p * 128 + nt * 32 + r) * KROW + kk * 16 + hh * 8), qf[kk], acc[nt]);
                unsigned (&L)[16] = p ? LB : LA;
                unsigned G1[16], G2[16], G3[16];
#pragma unroll
                for (int i = 0; i < 16; ++i) { const int n0 = (i & 3) + 8 * (i >> 2) + 4 * hh;
                    L[i] = (fkey(acc[0][i]) & ~127u) | (unsigned)(127 - n0); G1[i] = (fkey(acc[1][i]) & ~127u) | (unsigned)(127 - (32 + n0));
                    G2[i] = (fkey(acc[2][i]) & ~127u) | (unsigned)(127 - (64 + n0)); G3[i] = (fkey(acc[3][i]) & ~127u) | (unsigned)(127 - (96 + n0)); }
                sort16_desc(L); sort16_desc(G1); sort16_desc(G2); sort16_desc(G3);
                top16_of_two(L, G1); top16_of_two(G2, G3); top16_of_two(L, G2);
                merge16(L);
            }
            unsigned char* tt = wtab + r * 32;
            if (hh == 0) {
#pragma unroll
                for (int q = 0; q < 16; ++q) tt[q] = (unsigned char)(127u - (LA[q] & 127u)); }
            else {
#pragma unroll
                for (int q = 0; q < 16; ++q) tt[16 + q] = (unsigned char)(127u - (LB[q] & 127u)); }
            float va[16], vb[16];
#pragma unroll
            for (int q = 0; q < 16; ++q) { va[q] = unfkey(LA[q] & ~127u); vb[q] = unfkey(LB[q] & ~127u); }
            unsigned LC[16];
#pragma unroll
            for (int q = 0; q < 16; ++q) LC[q] = 0u;
            { const float s0 = va[0] + vb[0], s1 = va[0] + vb[1]; ins16(LC, (fkey(hh ? s1 : s0) & ~63u) | (unsigned)(63 - (0 + hh))); }
            { const float s0 = va[0] + vb[2], s1 = va[0] + vb[3]; ins16(LC, (fkey(hh ? s1 : s0) & ~63u) | (unsigned)(63 - (2 + hh))); }
            { const float s0 = va[0] + vb[4], s1 = va[0] + vb[5]; ins16(LC, (fkey(hh ? s1 : s0) & ~63u) | (unsigned)(63 - (4 + hh))); }
            { const float s0 = va[0] + vb[6], s1 = va[0] + vb[7]; ins16(LC, (fkey(hh ? s1 : s0) & ~63u) | (unsigned)(63 - (6 + hh))); }
            { const float s0 = va[0] + vb[8], s1 = va[0] + vb[9]; ins16(LC, (fkey(hh ? s1 : s0) & ~63u) | (unsigned)(63 - (8 + hh))); }
            { const float s0 = va[0] + vb[10], s1 = va[0] + vb[11]; ins16(LC, (fkey(hh ? s1 : s0) & ~63u) | (unsigned)(63 - (10 + hh))); }
            { const float s0 = va[0] + vb[12], s1 = va[0] + vb[13]; ins16(LC, (fkey(hh ? s1 : s0) & ~63u) | (unsigned)(63 - (12 + hh))); }
            { const float s0 = va[0] + vb[14], s1 = va[0] + vb[15]; ins16(LC, (fkey(hh ? s1 : s0) & ~63u) | (unsigned)(63 - (14 + hh))); }
            { const float s0 = va[1] + vb[0], s1 = va[1] + vb[1]; ins16(LC, (fkey(hh ? s1 : s0) & ~63u) | (unsigned)(63 - (16 + hh))); }
            { const float s0 = va[1] + vb[2], s1 = va[1] + vb[3]; ins16(LC, (fkey(hh ? s1 : s0) & ~63u) | (unsigned)(63 - (18 + hh))); }
            { const float s0 = va[1] + vb[4], s1 = va[1] + vb[5]; ins16(LC, (fkey(hh ? s1 : s0) & ~63u) | (unsigned)(63 - (20 + hh))); }
            { const float s0 = va[1] + vb[6], s1 = va[1] + vb[7]; ins16(LC, (fkey(hh ? s1 : s0) & ~63u) | (unsigned)(63 - (22 + hh))); }
            { const float s0 = va[2] + vb[0], s1 = va[2] + vb[1]; ins16(LC, (fkey(hh ? s1 : s0) & ~63u) | (unsigned)(63 - (24 + hh))); }
            { const float s0 = va[2] + vb[2], s1 = va[2] + vb[3]; ins16(LC, (fkey(hh ? s1 : s0) & ~63u) | (unsigned)(63 - (26 + hh))); }
            { const float s0 = va[2] + vb[4], s1 = va[3] + vb[0]; ins16(LC, (fkey(hh ? s1 : s0) & ~63u) | (unsigned)(63 - (28 + hh))); }
            { const float s0 = va[3] + vb[1], s1 = va[3] + vb[2]; ins16(LC, (fkey(hh ? s1 : s0) & ~63u) | (unsigned)(63 - (30 + hh))); }
            { const float s0 = va[3] + vb[3], s1 = va[4] + vb[0]; ins16(LC, (fkey(hh ? s1 : s0) & ~63u) | (unsigned)(63 - (32 + hh))); }
            { const float s0 = va[4] + vb[1], s1 = va[4] + vb[2]; ins16(LC, (fkey(hh ? s1 : s0) & ~63u) | (unsigned)(63 - (34 + hh))); }
            { const float s0 = va[5] + vb[0], s1 = va[5] + vb[1]; ins16(LC, (fkey(hh ? s1 : s0) & ~63u) | (unsigned)(63 - (36 + hh))); }
            { const float s0 = va[6] + vb[0], s1 = va[6] + vb[1]; ins16(LC, (fkey(hh ? s1 : s0) & ~63u) | (unsigned)(63 - (38 + hh))); }
            { const float s0 = va[7] + vb[0], s1 = va[7] + vb[1]; ins16(LC, (fkey(hh ? s1 : s0) & ~63u) | (unsigned)(63 - (40 + hh))); }
            { const float s0 = va[8] + vb[0], s1 = va[9] + vb[0]; ins16(LC, (fkey(hh ? s1 : s0) & ~63u) | (unsigned)(63 - (42 + hh))); }
            { const float s0 = va[10] + vb[0], s1 = va[11] + vb[0]; ins16(LC, (fkey(hh ? s1 : s0) & ~63u) | (unsigned)(63 - (44 + hh))); }
            { const float s0 = va[12] + vb[0], s1 = va[13] + vb[0]; ins16(LC, (fkey(hh ? s1 : s0) & ~63u) | (unsigned)(63 - (46 + hh))); }
            { const float s0 = va[14] + vb[0], s1 = va[15] + vb[0]; ins16(LC, (fkey(hh ? s1 : s0) & ~63u) | (unsigned)(63 - (48 + hh))); }
            merge16(LC);
            WAVE_LDS_SYNC();
            float ev[16]; float den = 0.f; const float mx = unfkey(LC[0] & ~63u);
#pragma unroll
            for (int q = 0; q < 16; ++q) { ev[q] = __expf(unfkey(LC[q] & ~63u) - mx); den += ev[q]; }
            const float inv = 1.f / den;
            if (hh == 0) { int ex[16];
#pragma unroll
                for (int q = 0; q < 16; ++q) { const unsigned pc = wtab[1024 + (63u - (LC[q] & 63u))]; ex[q] = (int)tt[pc >> 4] * 128 + (int)tt[16 + (pc & 15u)]; }
#pragma unroll
                for (int q = 0; q < 4; ++q) *(v4u*)(IDX + (size_t)tok * 128 + h * 16 + 4 * q) = (v4u){(unsigned)ex[4 * q], (unsigned)ex[4 * q + 1], (unsigned)ex[4 * q + 2], (unsigned)ex[4 * q + 3]}; }
            else {
#pragma unroll
                for (int q = 0; q < 4; ++q) *(f32x4*)(GATE + (size_t)tok * 128 + h * 16 + 4 * q) = (f32x4){ev[4 * q] * inv, ev[4 * q + 1] * inv, ev[4 * q + 2] * inv, ev[4 * q + 3] * inv}; }
            WAVE_LDS_SYNC();
        }
    }
}

__device__ __forceinline__ void phase_fp8_tables(const Ctx& c) {
    const Args& a = *c.a;
    for (int r = c.gw; r < 2 * NEXP; r += c.NGW) {
        const bool isv = r >= NEXP; const int e = isv ? r - NEXP : r;
        const f32x4* src = (const f32x4*)((isv ? a.in[I_PV] : a.in[I_PU]) + (size_t)e * D) + c.lane;
        f32x4 v[4]; float m = 0.f;
#pragma unroll
        for (int j = 0; j < 4; ++j) { v[j] = src[64 * j]; m = fmaxf(m, fmaxf(fmaxf(fabsf(v[j].x), fabsf(v[j].y)), fmaxf(fabsf(v[j].z), fabsf(v[j].w)))); }
        m = wmax(m); const float inv = m > 0.f ? 256.f / m : 0.f;
        unsigned char* dst = c.ws + (isv ? WS_V8 : WS_U8) + (size_t)e * D + 4 * c.lane;
#pragma unroll
        for (int j = 0; j < 4; ++j) { int w = __builtin_amdgcn_cvt_pk_fp8_f32(v[j].x * inv, v[j].y * inv, 0, false); w = __builtin_amdgcn_cvt_pk_fp8_f32(v[j].z * inv, v[j].w * inv, w, true); *(unsigned*)(dst + 256 * j) = (unsigned)w; }
        if (c.lane == 0) ((float*)(c.ws + (isv ? WS_VSC : WS_USC)))[e] = m * (1.f / 256.f);
    }
}
__device__ __forceinline__ void fp8x16_to_f32(const v4u& r, float (&f)[16]) {
    const unsigned w[4] = {r.x, r.y, r.z, r.w};
#pragma unroll
    for (int j = 0; j < 4; ++j) { const f32x2 lo = __builtin_amdgcn_cvt_pk_f32_fp8((int)w[j], false), hi = __builtin_amdgcn_cvt_pk_f32_fp8((int)w[j], true); f[4 * j] = lo.x; f[4 * j + 1] = lo.y; f[4 * j + 2] = hi.x; f[4 * j + 3] = hi.y; }
}
__device__ __forceinline__ unsigned xcc_id() { return (unsigned)__builtin_amdgcn_s_getreg((3 << 11) | 20) & 7u; }

typedef long l64x2 __attribute__((ext_vector_type(2)));
struct E1Bat { l64x2 rw[16]; };
__device__ __forceinline__ void phase_exp1(const Ctx& c) {
    typedef float f32x4m __attribute__((ext_vector_type(4)));
    const int* IDX = (const int*)(c.ws + WS_IDX); const unsigned char* U8 = c.ws + WS_U8; float* PACT = (float*)(c.ws + WS_PACT);
    unsigned* cnt = (unsigned*)(c.ws + WS_CTL) + CW_E1;
    constexpr int CH = 8;
    constexpr int SROW = 144;
    unsigned char* wl = c.lds + c.wave * 11776; int* le = (int*)wl; unsigned char* himg = wl + 4096; float* res = (float*)(wl + 6144); unsigned char* stage = wl + 6656;
    const int xcc = (int)xcc_id(), r16 = c.lane & 15, g4 = c.lane >> 4, row8 = c.lane >> 3, pc8 = c.lane & 7; const bool bcol = r16 < 2;
    int bo = 0; unsigned tq = 0;
    if (c.lane == 0) tq = __hip_atomic_fetch_add(cnt + 64 * (xcc & 7), (unsigned)CH, __ATOMIC_RELAXED, __HIP_MEMORY_SCOPE_AGENT);
    for (;;) {
        const int x = (xcc + bo) & 7;
        const unsigned t0 = (unsigned)__builtin_amdgcn_readfirstlane((int)tq);
        if (t0 >= (unsigned)ML) { if (++bo >= 8) break; tq = 0; if (c.lane == 0) tq = __hip_atomic_fetch_add(cnt + 64 * ((xcc + bo) & 7), (unsigned)CH, __ATOMIC_RELAXED, __HIP_MEMORY_SCOPE_AGENT); continue; }
        tq = 0; if (c.lane == 0) tq = __hip_atomic_fetch_add(cnt + 64 * x, (unsigned)CH, __ATOMIC_RELAXED, __HIP_MEMORY_SCOPE_AGENT);
        { v4u ee[4], im[2];
#pragma unroll
          for (int q = 0; q < 4; ++q) ee[q] = *(const v4u*)(IDX + (size_t)t0 * 128 + 256 * q + 4 * c.lane);
#pragma unroll
          for (int q = 0; q < 2; ++q) { const int p = c.lane + 64 * q; im[q] = *(const v4u*)(c.ws + WS_HQ8 + ((size_t)t0 + (p >> 4)) * 2048 + ((p >> 3) & 1) * 1024 + 128 * x + 16 * (p & 7)); }
#pragma unroll
          for (int q = 0; q < 4; ++q) *(v4u*)(le + 256 * q + 4 * c.lane) = ee[q];
#pragma unroll
          for (int q = 0; q < 2; ++q) *(v4u*)(himg + 16 * (c.lane + 64 * q)) = im[q]; }
        WAVE_LDS_SYNC();
#define E1_LOAD(G, B) do { const int bb = (B) < CH ? (B) : 0; _Pragma("unroll") for (int i = 0; i < 16; ++i) G.rw[i] = *(const l64x2*)(U8 + (size_t)le[bb * 128 + 8 * i + row8] * D + 128 * x + 16 * pc8); } while (0)
#define E1_COMP(G, B) do { const unsigned char* hb = himg + ((B) * 2 + (r16 & 1)) * 128 + 32 * g4; long bq[4]; _Pragma("unroll") for (int m = 0; m < 4; ++m) { const long v = *(const long*)(hb + 8 * m); bq[m] = bcol ? v : 0l; } \
            _Pragma("unroll") for (int gi = 0; gi < 8; ++gi) { unsigned char* sb = stage + (gi & 1) * (16 * SROW); \
                *(l64x2*)(sb + row8 * SROW + 16 * pc8) = G.rw[2 * gi]; *(l64x2*)(sb + (8 + row8) * SROW + 16 * pc8) = G.rw[2 * gi + 1]; \
                WAVE_LDS_SYNC(); \
                const l64x2 a01 = *(const l64x2*)(sb + r16 * SROW + 32 * g4), a23 = *(const l64x2*)(sb + r16 * SROW + 32 * g4 + 16); \
                f32x4m acc = {0.f, 0.f, 0.f, 0.f}; \
                acc = __builtin_amdgcn_mfma_f32_16x16x32_fp8_fp8(a01.x, bq[0], acc, 0, 0, 0); acc = __builtin_amdgcn_mfma_f32_16x16x32_fp8_fp8(a01.y, bq[1], acc, 0, 0, 0); \
                acc = __builtin_amdgcn_mfma_f32_16x16x32_fp8_fp8(a23.x, bq[2], acc, 0, 0, 0); acc = __builtin_amdgcn_mfma_f32_16x16x32_fp8_fp8(a23.y, bq[3], acc, 0, 0, 0); \
                _Pragma("unroll") for (int q = 0; q < 4; ++q) { const float lo = dppf<0xB1>(acc[q]); if (r16 == 0) res[gi * 16 + 4 * g4 + q] = acc[q] + lo * 0.0625f; } } \
            WAVE_LDS_SYNC(); \
            { float* po = PACT + (size_t)x * ((size_t)ML * 128) + ((size_t)t0 + (B)) * 128; po[c.lane] = res[c.lane]; po[64 + c.lane] = res[64 + c.lane]; } \
            WAVE_LDS_SYNC(); } while (0)
        E1Bat ga, gb;
        E1_LOAD(ga, 0);
#pragma unroll 1
        for (int b2 = 0; b2 < CH; b2 += 2) {
            E1_LOAD(gb, b2 + 1);
            __builtin_amdgcn_sched_barrier(0);
            E1_COMP(ga, b2);
            __builtin_amdgcn_sched_barrier(0);
            E1_LOAD(ga, b2 + 2);
            __builtin_amdgcn_sched_barrier(0);
            E1_COMP(gb, b2 + 1);
            __builtin_amdgcn_sched_barrier(0);
        }
#undef E1_LOAD
#undef E1_COMP
    }
}
__device__ __forceinline__ void phase_exp1b(const Ctx& c) {
    const int* IDX = (const int*)(c.ws + WS_IDX); const float* GATE = (const float*)(c.ws + WS_GATE); const float* HS = (const float*)(c.ws + WS_HS); const float* PACT = (const float*)(c.ws + WS_PACT);
    const float* USC = (const float*)(c.ws + WS_USC); const float* VSC = (const float*)(c.ws + WS_VSC); float* ACT = (float*)(c.ws + WS_ACT);
    const size_t N = (size_t)ML * 128, stride = (size_t)c.G * NTHREADS;
    for (size_t i0 = (size_t)c.bid * NTHREADS + c.tid; i0 < N; i0 += 4 * stride) {
        float pv[4][8], gt[4], hs[4], us[4], vs[4]; int e[4];
#pragma unroll
        for (int q = 0; q < 4; ++q) { size_t i = i0 + q * stride; i = i < N ? i : N - 1;
#pragma unroll
            for (int x = 0; x < 8; ++x) pv[q][x] = PACT[(size_t)x * N + i];
            e[q] = IDX[i]; gt[q] = GATE[i]; hs[q] = HS[i >> 7]; }
#pragma unroll
        for (int q = 0; q < 4; ++q) { us[q] = USC[e[q]]; vs[q] = VSC[e[q]]; }
#pragma unroll
        for (int q = 0; q < 4; ++q) { const size_t i = i0 + q * stride; float s = 0.f;
#pragma unroll
            for (int x = 0; x < 8; ++x) s += pv[q][x];
            if (i < N) ACT[i] = gelu_erf(s * hs[q] * us[q]) * gt[q] * vs[q]; }
    }
}
__device__ __forceinline__ void phase_exp2(const Ctx& c) {
    const int* IDX = (const int*)(c.ws + WS_IDX); const float* ACT = (const float*)(c.ws + WS_ACT); const unsigned char* V8 = c.ws + WS_V8;
    bf16* Y = (bf16*)(c.ws + WS_Y); float* SSQP = (float*)(c.ws + WS_SSQP);
    unsigned* cnt = (unsigned*)(c.ws + WS_CTL) + CW_E2;
    int* li = (int*)(c.lds + c.wave * 1024); float* la = (float*)(li + 128);
    const int xcc = (int)xcc_id(), sub = c.lane & 7, grp = c.lane >> 3;
    const bool b5 = c.lane & 32, b4 = c.lane & 16, b3 = c.lane & 8;
    constexpr int CH = 8;
    int bo = 0, t = 0, tend = 0;
    int iA = 0, iB = 0; float aA = 0.f, aB = 0.f;
    unsigned tq = 0; if (c.lane == 0) tq = __hip_atomic_fetch_add(cnt + 64 * (xcc & 7), (unsigned)CH, __ATOMIC_RELAXED, __HIP_MEMORY_SCOPE_AGENT);
    for (;;) {
        if (t >= tend) {
            const unsigned t0 = (unsigned)__builtin_amdgcn_readfirstlane((int)tq);
            if (t0 >= (unsigned)ML) { if (++bo >= 8) break; tq = 0; if (c.lane == 0) tq = __hip_atomic_fetch_add(cnt + 64 * ((xcc + bo) & 7), (unsigned)CH, __ATOMIC_RELAXED, __HIP_MEMORY_SCOPE_AGENT); continue; }
            tq = 0; if (c.lane == 0) tq = __hip_atomic_fetch_add(cnt + 64 * ((xcc + bo) & 7), (unsigned)CH, __ATOMIC_RELAXED, __HIP_MEMORY_SCOPE_AGENT);
            t = (int)t0; tend = t + CH;
            iA = IDX[(size_t)t * 128 + c.lane]; iB = IDX[(size_t)t * 128 + 64 + c.lane]; aA = ACT[(size_t)t * 128 + c.lane]; aB = ACT[(size_t)t * 128 + 64 + c.lane];
        }
        const int x = (xcc + bo) & 7;
        li[c.lane] = iA; li[64 + c.lane] = iB; la[c.lane] = aA; la[64 + c.lane] = aB;
        if (t + 1 < tend) { iA = IDX[(size_t)(t + 1) * 128 + c.lane]; iB = IDX[(size_t)(t + 1) * 128 + 64 + c.lane]; aA = ACT[(size_t)(t + 1) * 128 + c.lane]; aB = ACT[(size_t)(t + 1) * 128 + 64 + c.lane]; }
        WAVE_LDS_SYNC();
        float acc[16];
#pragma unroll
        for (int q = 0; q < 16; ++q) acc[q] = 0.f;
#pragma unroll
        for (int hf = 0; hf < 2; ++hf) { v4u rows[8]; float av[8];
#pragma unroll
            for (int i = 0; i < 8; ++i) { const int k = 8 * (8 * hf + i) + grp; rows[i] = *(const v4u*)(V8 + (size_t)li[k] * D + x * 128 + 16 * sub); av[i] = la[k]; }
#pragma unroll
            for (int i = 0; i < 8; ++i) { float f[16]; fp8x16_to_f32(rows[i], f);
#pragma unroll
                for (int q = 0; q < 16; ++q) acc[q] = fmaf(av[i], f[q], acc[q]); } }
        float q8[8], q4[4], q2[2];
#pragma unroll
        for (int i = 0; i < 8; ++i) { const float keep = b5 ? acc[i + 8] : acc[i], send = b5 ? acc[i] : acc[i + 8]; q8[i] = keep + __shfl_xor(send, 32); }
#pragma unroll
        for (int i = 0; i < 4; ++i) { const float keep = b4 ? q8[i + 4] : q8[i], send = b4 ? q8[i] : q8[i + 4]; q4[i] = keep + __shfl_xor(send, 16); }
#pragma unroll
        for (int i = 0; i < 2; ++i) { const float keep = b3 ? q4[i + 2] : q4[i], send = b3 ? q4[i] : q4[i + 2]; q2[i] = keep + __shfl_xor(send, 8); }
        const int col = x * 128 + 16 * sub + (b5 ? 8 : 0) + (b4 ? 4 : 0) + (b3 ? 2 : 0);
        *(unsigned*)(Y + (size_t)t * D + col) = pk2(q2[0], q2[1]);
        const float ss = wsum(q2[0] * q2[0] + q2[1] * q2[1]);
        SSQP[(size_t)x * ML + t] = ss;
        WAVE_LDS_SYNC();
        ++t;
    }
}
__device__ __forceinline__ void phase_exp3(const Ctx& c) {
    const Args& a = *c.a;
    const float* MOD = (const float*)(c.ws + WS_MOD); const bf16* Y = (const bf16*)(c.ws + WS_Y); const float* SSQP = (const float*)(c.ws + WS_SSQP);
    v2u ny[4]; f32x4 nx[4], ngt[4], g4c[4]; float nss = 0.f;
#pragma unroll
    for (int j = 0; j < 4; ++j) g4c[j] = *(const f32x4*)(a.in[I_GPOSTFFN] + 4 * c.lane + 256 * j);
#define E3_LOAD(R) do { _Pragma("unroll") for (int j = 0; j < 4; ++j) { const int col = 4 * c.lane + 256 * j; ny[j] = *(const v2u*)(Y + (size_t)(R) * D + col); nx[j] = *(const f32x4*)(a.out + (size_t)(R) * D + col); \
            ngt[j] = *(const f32x4*)(MOD + ((R) >> 11) * 6144 + 5120 + col); } \
        nss = (c.lane < 8) ? SSQP[(size_t)c.lane * ML + (R)] : 0.f; } while (0)
    if (c.gw < ML) E3_LOAD(c.gw);
    for (int row = c.gw; row < ML; row += c.NGW) {
        f32x4 y[4], x1[4], gt[4];
#pragma unroll
        for (int j = 0; j < 4; ++j) { y[j] = (f32x4){bflo(ny[j].x), bfhi(ny[j].x), bflo(ny[j].y), bfhi(ny[j].y)}; x1[j] = nx[j]; gt[j] = ngt[j]; }
        const float ss = row_sum16(nss);
        const float tot = __builtin_bit_cast(float, __builtin_amdgcn_readlane(__builtin_bit_cast(int, ss), 0));
        if (row + c.NGW < ML) E3_LOAD(row + c.NGW);
        const float r = rsqrtf(tot * (1.f / D) + EPS);
#pragma unroll
        for (int j = 0; j < 4; ++j) { const int col = 4 * c.lane + 256 * j;
            *(f32x4*)(a.out + (size_t)row * D + col) = x1[j] + gt[j] * ((y[j] * r) * g4c[j]); }
    }
#undef E3_LOAD
}

constexpr int S5_LPOW = 0, S5_BBAR = 33792, S5_CC = 50176, S5_MM = 66560;
__device__ __forceinline__ void s5_build_group(const Ctx& c, int g, int part) {
    const Args& a = *c.a;
    f32x2* LPOW = (f32x2*)(c.lds + S5_LPOW);
    f32x2* BBAR = (f32x2*)(c.lds + S5_BBAR);
    f32x2* CC = (f32x2*)(c.lds + S5_CC);
    float* MM = (float*)(c.lds + S5_MM);
    __syncthreads();
    if (c.tid < 128) { const int dir = c.tid >> 6, p = c.tid & 63, dg = dir * 32 + g;
        const float dt = expf(a.in[I_LOGDT][dg]), lr = a.in[I_LAMRE][dg * 64 + p], li = a.in[I_LAMIM][dg * 64 + p];
        const double ang = (double)li * (double)dt; const float lrdt = lr * dt;
        for (int e = 0; e <= 32; ++e) { float sn, cs; sincos_d(ang * (double)e, sn, cs); const float mg = expf(lrdt * (float)e); LPOW[(dir * 33 + e) * 64 + p] = (f32x2){mg * cs, mg * sn}; }
        float sn, cs; sincos_d(ang, sn, cs); const float mag = expf(lrdt), lbr = mag * cs, lbi = mag * sn, den = lr * lr + li * li, nr = lbr - 1.f;
        const float cr = (nr * lr + lbi * li) / den, ci = (lbi * lr - nr * li) / den;
        for (int ch = 0; ch < 16; ++ch) { const float br = a.in[I_BRE][(size_t)(dg * 64 + p) * 16 + ch], bi = a.in[I_BIM][(size_t)(dg * 64 + p) * 16 + ch]; BBAR[(dir * 64 + p) * 16 + ch] = (f32x2){cr * br - ci * bi, cr * bi + ci * br}; } }
    for (int i = c.tid; i < 2048; i += NTHREADS) { const int dir = i >> 10, ch = (i >> 6) & 15, p = i & 63, dg = dir * 32 + g; CC[i] = (f32x2){a.in[I_CRE][(size_t)(dg * 16 + ch) * 64 + p], a.in[I_CIM][(size_t)(dg * 16 + ch) * 64 + p]}; }
    __syncthreads();
    for (int task = c.tid; task < 1024; task += NTHREADS) { const int cpb = task & 3, cb = (task >> 2) & 3, lag = (task >> 4) & 31, dir = task >> 9;
        float acc[4][4];
#pragma unroll
        for (int i = 0; i < 4; ++i)
#pragma unroll
            for (int j = 0; j < 4; ++j) acc[i][j] = 0.f;
        for (int p = 0; p < 64; ++p) { const f32x2 l = LPOW[(dir * 33 + lag) * 64 + p]; f32x2 G[4], Cw[4];
#pragma unroll
            for (int j = 0; j < 4; ++j) { const f32x2 bb = BBAR[(dir * 64 + p) * 16 + 4 * cpb + j]; G[j] = (f32x2){l.x * bb.x - l.y * bb.y, l.x * bb.y + l.y * bb.x}; }
#pragma unroll
            for (int i = 0; i < 4; ++i) Cw[i] = CC[(dir * 16 + 4 * cb + i) * 64 + p];
#pragma unroll
            for (int i = 0; i < 4; ++i)
#pragma unroll
                for (int j = 0; j < 4; ++j) acc[i][j] += Cw[i].x * G[j].x - Cw[i].y * G[j].y; }
#pragma unroll
        for (int i = 0; i < 4; ++i)
#pragma unroll
            for (int j = 0; j < 4; ++j) MM[((dir * 32 + lag) * 16 + 4 * cb + i) * 16 + 4 * cpb + j] = acc[i][j]; }
    __syncthreads();
    if (c.tid < 128 && part == 0) { const int dir = c.tid >> 6, p = c.tid & 63; ((f32x2*)(c.ws + WS_LP))[(dir * 32 + g) * 64 + p] = LPOW[(dir * 33 + 32) * 64 + p]; }
    bf16* PMg = (bf16*)(c.ws + WS_PM) + (size_t)g * 256 * 512; bf16* BBg = (bf16*)(c.ws + WS_BB) + (size_t)g * 512 * 768;
    for (int task = part * 64 * 32 + c.tid; task < (part + 1) * 64 * 32; task += NTHREADS) { const int ip = task & 31, n = task >> 5, dir = n >> 7, im = (n >> 6) & 1, p = n & 63, e = dir ? ip : 31 - ip;
        const f32x2 l = LPOW[(dir * 33 + e) * 64 + p]; float o[16];
#pragma unroll
        for (int ch = 0; ch < 16; ++ch) { const f32x2 bb = BBAR[(dir * 64 + p) * 16 + ch]; o[ch] = im ? (l.x * bb.y + l.y * bb.x) : (l.x * bb.x - l.y * bb.y); }
        v4u w0, w1; w0.x = pk2(o[0], o[1]); w0.y = pk2(o[2], o[3]); w0.z = pk2(o[4], o[5]); w0.w = pk2(o[6], o[7]); w1.x = pk2(o[8], o[9]); w1.y = pk2(o[10], o[11]); w1.z = pk2(o[12], o[13]); w1.w = pk2(o[14], o[15]);
        *(v4u*)(PMg + (size_t)n * 512 + ip * 16) = w0; *(v4u*)(PMg + (size_t)n * 512 + ip * 16 + 8) = w1; }
    for (int task = part * 128 * 32 + c.tid; task < (part + 1) * 128 * 32; task += NTHREADS) { const int ip = task & 31, n = task >> 5, i = n >> 4, ch = n & 15; float o[16];
#pragma unroll
        for (int q = 0; q < 16; ++q) o[q] = 0.f;
        if (ip <= i) { const float* m0 = MM + ((0 * 32 + (i - ip)) * 16 + ch) * 16;
#pragma unroll
            for (int q = 0; q < 16; ++q) o[q] += m0[q]; }
        if (ip >= i) { const float* m1 = MM + ((1 * 32 + (ip - i)) * 16 + ch) * 16;
#pragma unroll
            for (int q = 0; q < 16; ++q) o[q] += m1[q]; }
        if (ip == i) { const float dsk = a.in[I_S5D][g * 16 + ch];
#pragma unroll
            for (int q = 0; q < 16; ++q) o[q] += (q == ch) ? dsk : 0.f; }
        v4u w0, w1; w0.x = pk2(o[0], o[1]); w0.y = pk2(o[2], o[3]); w0.z = pk2(o[4], o[5]); w0.w = pk2(o[6], o[7]); w1.x = pk2(o[8], o[9]); w1.y = pk2(o[10], o[11]); w1.z = pk2(o[12], o[13]); w1.w = pk2(o[14], o[15]);
        *(v4u*)(BBg + (size_t)n * 768 + ip * 16) = w0; *(v4u*)(BBg + (size_t)n * 768 + ip * 16 + 8) = w1; }
    for (int task = part * 128 * 32 + c.tid; task < (part + 1) * 128 * 32; task += NTHREADS) { const int p8 = task & 7, part = (task >> 3) & 3, n = task >> 5, i = n >> 4, ch = n & 15, dir = part >> 1, im = part & 1, e = dir ? 32 - i : i + 1; float o[8];
#pragma unroll
        for (int q = 0; q < 8; ++q) { const int p = p8 * 8 + q; const f32x2 l = LPOW[(dir * 33 + e) * 64 + p], cc = CC[(dir * 16 + ch) * 64 + p]; o[q] = im ? -(cc.x * l.y + cc.y * l.x) : (cc.x * l.x - cc.y * l.y); }
        v4u w0; w0.x = pk2(o[0], o[1]); w0.y = pk2(o[2], o[3]); w0.z = pk2(o[4], o[5]); w0.w = pk2(o[6], o[7]);
        *(v4u*)(BBg + (size_t)n * 768 + 512 + part * 64 + p8 * 8) = w0; }
}
__device__ __forceinline__ void s5_state_scan(const Ctx& c, int task) {
    const int dir = task & 1, g = (task >> 1) & 31, b = task >> 6, p = c.lane;
    const f32x2 a = ((const f32x2*)(c.ws + WS_LP))[(dir * 32 + g) * 64 + p];
    const float* SS = (const float*)(c.ws + WS_SS) + (size_t)g * 768 * 256 + dir * 128 + p; bf16* U5 = (bf16*)(c.ws + WS_U5) + (size_t)g * 768 * 768 + 512 + dir * 128 + p;
    float er = 0.f, ei = 0.f;
#pragma unroll 1
    for (int s0 = 0; s0 < 72; s0 += 24) {
        float sr[24], si[24];
#pragma unroll
        for (int u = 0; u < 24; ++u) { const int step = s0 + u; const int R = (step < 8) ? 512 + b * 8 + (dir ? 7 - step : step) : b * 64 + (dir ? 71 - step : step - 8);
            sr[u] = SS[(size_t)R * 256]; si[u] = SS[(size_t)R * 256 + 64]; }
#pragma unroll
        for (int u = 0; u < 24; ++u) { const int step = s0 + u; const int R = (step < 8) ? 512 + b * 8 + (dir ? 7 - step : step) : b * 64 + (dir ? 71 - step : step - 8);
            if (step >= 8) { U5[(size_t)R * 768] = (bf16)f2bf(er); U5[(size_t)R * 768 + 64] = (bf16)f2bf(ei); }
            const float nr = sr[u] + a.x * er - a.y * ei, ni = si[u] + a.x * ei + a.y * er; er = nr; ei = ni; }
    }
}

constexpr int GDN_NCH = 36, GDN_ITEMS = NB * 4 * 2 * GDN_NCH;
constexpr size_t FR_T_BYTES = 8192, FR_ATT_BYTES = 8192, FR_KD_BYTES = 16384, FR_TAB_BYTES = 1024;
__device__ __forceinline__ int crow16(int i, int hh) { return (i & 3) + 8 * (i >> 2) + 4 * hh; }
__device__ __forceinline__ bf16x8 pack_step(const f32x16& x, int s) {
    v4u w; w.x = pk2(x[8 * s + 0], x[8 * s + 1]); w.y = pk2(x[8 * s + 2], x[8 * s + 3]); w.z = pk2(x[8 * s + 4], x[8 * s + 5]); w.w = pk2(x[8 * s + 6], x[8 * s + 7]);
    return __builtin_bit_cast(bf16x8, w);
}
__device__ __forceinline__ unsigned pk2v(float lo, float hi) { asm volatile("" : "+v"(lo), "+v"(hi)); return pk2(lo, hi); }
__device__ __forceinline__ bf16x8 pack_step_v(const f32x16& x, int s) {
    v4u w; w.x = pk2v(x[8 * s + 0], x[8 * s + 1]); w.y = pk2v(x[8 * s + 2], x[8 * s + 3]); w.z = pk2v(x[8 * s + 4], x[8 * s + 5]); w.w = pk2v(x[8 * s + 6], x[8 * s + 7]);
    return __builtin_bit_cast(bf16x8, w);
}
constexpr int GP_KR = 0, GP_QR = 17408, GP_KT = 34816, GP_TAB = 53248, GP_LP = 54272, GP_LPB = 8448 + 256;
__host__ __device__ constexpr int LOFF(int i) { return i < 1 ? 0 : 4 * (((i - 1) >> 2) + 1) * (2 * ((i - 1) >> 2) + ((i - 1) & 3)); }
static_assert(LOFF(1) == 0 && LOFF(2) == 4 && LOFF(5) == 16 && LOFF(6) == 24 && LOFF(64) == 2112, "packed lower-triangular row offsets");
struct GpPre { v4u q0, q1, k0, k1; float g, beta; };
__device__ __forceinline__ void gdn_prep_load(const Ctx& c, int item, GpPre& p) {
    const int n = item % GDN_NCH, bhd = item / GDN_NCH, dir = bhd & 1, h = (bhd >> 1) & 3, b = bhd >> 3;
    const bf16* QKV = (const bf16*)(c.ws + WS_QKV); const float* GB = (const float*)(c.ws + WS_GB);
    const int s = c.tid >> 3, seg = c.tid & 7; const bf16* rp = QKV + (size_t)scan_row(b, dir, n * 64 + s) * 1536 + h * 128 + seg * 16;
    p.q0 = *(const v4u*)rp; p.q1 = *(const v4u*)(rp + 8); p.k0 = *(const v4u*)(rp + 512); p.k1 = *(const v4u*)(rp + 520);
    const size_t rl = (size_t)scan_row(b, dir, n * 64 + c.lane) * 16 + dir * 4 + h; p.g = GB[rl]; p.beta = GB[rl + 8];
}
__device__ __forceinline__ void gdn_prep_stage(const Ctx& c, int item, int item_next, float* Lp, GpPre& p) {
    bf16* Kr = (bf16*)(c.lds + GP_KR); bf16* Qr = (bf16*)(c.lds + GP_QR); bf16* Kt = (bf16*)(c.lds + GP_KT); float* tab = (float*)(c.lds + GP_TAB);
    unsigned char* frA = c.ws + WS_FRA + (size_t)item * FR_ATT_BYTES; unsigned char* frK = c.ws + WS_FRK + (size_t)item * FR_KD_BYTES; float* frTab = (float*)(c.ws + WS_FRTAB + (size_t)item * FR_TAB_BYTES);
    const int r = c.lane & 31, hh = c.lane >> 5;
    if (c.wave == 0) { float g = p.g; const float beta = p.beta;
#pragma unroll
        for (int o = 1; o < 64; o <<= 1) { const float t = __shfl_up(g, o); if (c.lane >= o) g += t; }
        const float gl = __shfl(g, 63);
        tab[c.lane] = g; tab[64 + c.lane] = beta; tab[128 + c.lane] = __expf(g); tab[192 + c.lane] = __expf(gl - g); }
    { const int s = c.tid >> 3, seg = c.tid & 7;
      const v4u q0 = p.q0, q1 = p.q1, k0 = p.k0, k1 = p.k1;
      gdn_prep_load(c, item_next, p);
      *(v4u*)(Qr + s * 136 + seg * 16) = q0; *(v4u*)(Qr + s * 136 + seg * 16 + 8) = q1; *(v4u*)(Kr + s * 136 + seg * 16) = k0; *(v4u*)(Kr + s * 136 + seg * 16 + 8) = k1;
      const unsigned kw[8] = {k0.x, k0.y, k0.z, k0.w, k1.x, k1.y, k1.z, k1.w};
#pragma unroll
      for (int e = 0; e < 8; ++e) { Kt[(seg * 16 + 2 * e) * 72 + s] = (bf16)(kw[e] & 0xffffu); Kt[(seg * 16 + 2 * e + 1) * 72 + s] = (bf16)(kw[e] >> 16); } }
    __syncthreads();
    if (c.wave < 3) { const int ct = c.wave ? 1 : 0, st = c.wave == 2 ? 1 : 0;
        f32x16 acc;
#pragma unroll
        for (int i = 0; i < 16; ++i) acc[i] = 0.f;
#pragma unroll
        for (int kk = 0; kk < 8; ++kk) { const bf16x8 a = *(const bf16x8*)(Kr + (ct * 32 + r) * 136 + kk * 16 + hh * 8), bb = *(const bf16x8*)(Kr + (st * 32 + r) * 136 + kk * 16 + hh * 8); acc = MFMA32(a, bb, acc); }
        const int s = st * 32 + r; const float gcs = tab[s];
#pragma unroll
        for (int i = 0; i < 16; ++i) { const int cc = ct * 32 + crow16(i, hh); if (s < cc) Lp[LOFF(cc) + s] = tab[64 + cc] * acc[i] * __expf(tab[cc] - gcs); }
    } else if (c.wave < 6) { const int w = c.wave - 3, st = w == 2 ? 1 : 0, ct = w ? 1 : 0;
        f32x16 acc;
#pragma unroll
        for (int i = 0; i < 16; ++i) acc[i] = 0.f;
#pragma unroll
        for (int kk = 0; kk < 8; ++kk) { const bf16x8 a = *(const bf16x8*)(Kr + (st * 32 + r) * 136 + kk * 16 + hh * 8), bb = *(const bf16x8*)(Qr + (ct * 32 + r) * 136 + kk * 16 + hh * 8); acc = MFMA32(a, bb, acc); }
        const int cc = ct * 32 + r; const float gcc = tab[cc];
#pragma unroll
        for (int i = 0; i < 16; ++i) { const int s = st * 32 + crow16(i, hh); acc[i] = (s <= cc) ? acc[i] * __expf(gcc - tab[s]) : 0.f; }
        *(bf16x8*)(frA + ((size_t)((ct * 4 + 2 * st) * 64 + c.lane)) * 16) = pack_step(acc, 0);
        *(bf16x8*)(frA + ((size_t)((ct * 4 + 2 * st + 1) * 64 + c.lane)) * 16) = pack_step(acc, 1);
    } else { const int w = c.wave - 6;
#pragma unroll
        for (int f = 0; f < 8; ++f) { const int fi = w * 8 + f, dkt = fi >> 2, cb = fi & 3; const bf16* kp = Kt + (dkt * 32 + r) * 72 + 16 * cb + 4 * hh;
            const v2u lo = *(const v2u*)kp, hi = *(const v2u*)(kp + 8); const f32x4 e0 = *(const f32x4*)(tab + 192 + 16 * cb + 4 * hh), e1 = *(const f32x4*)(tab + 192 + 16 * cb + 8 + 4 * hh);
            v4u o; o.x = pk2(bflo(lo.x) * e0.x, bfhi(lo.x) * e0.y); o.y = pk2(bflo(lo.y) * e0.z, bfhi(lo.y) * e0.w); o.z = pk2(bflo(hi.x) * e1.x, bfhi(hi.x) * e1.y); o.w = pk2(bflo(hi.y) * e1.z, bfhi(hi.y) * e1.w);
            *(v4u*)(frK + ((size_t)(fi * 64 + c.lane)) * 16) = o; }
        if (w == 0) { const v4u z = (v4u){0u, 0u, 0u, 0u}; *(v4u*)(frA + ((size_t)((0 * 4 + 2) * 64 + c.lane)) * 16) = z; *(v4u*)(frA + ((size_t)((0 * 4 + 3) * 64 + c.lane)) * 16) = z; }
        else { *(f32x4*)(frTab + 4 * c.lane) = *(const f32x4*)(tab + 4 * c.lane); }
    }
    __syncthreads();
}
__device__ __forceinline__ int loff_rt(int i) { return i < 1 ? 0 : 4 * (((i - 1) >> 2) + 1) * (2 * ((i - 1) >> 2) + ((i - 1) & 3)); }
__device__ __forceinline__ void gdn_prep_solve(const Ctx& c, int item, float* Lp) {
    const int r = c.lane & 31, hh = c.lane >> 5;
    { float Tr[32];
#pragma unroll
      for (int i = 0; i < 32; ++i) { int je = r, bl = hh; asm volatile("" : "+v"(je), "+v"(bl)); float a0 = (je == i) ? 1.f : 0.f, a1 = 0.f;
          const int ro = bl ? LOFF(32 + i) + 32 : LOFF(i);
#pragma unroll
          for (int s4 = 0; s4 < (i + 3) / 4; ++s4) { const f32x4 l4 = *(const f32x4*)(Lp + ro + 4 * s4);
              if (4 * s4 + 0 < i) a0 = fmaf(-l4.x, Tr[4 * s4 + 0], a0); if (4 * s4 + 1 < i) a1 = fmaf(-l4.y, Tr[4 * s4 + 1], a1); if (4 * s4 + 2 < i) a0 = fmaf(-l4.z, Tr[4 * s4 + 2], a0); if (4 * s4 + 3 < i) a1 = fmaf(-l4.w, Tr[4 * s4 + 3], a1); }
          Tr[i] = a0 + a1; Lp[(je < i) ? ro + je : 2112 + 32 * bl + je] = Tr[i]; } }
    WAVE_LDS_SYNC();
    { const int offA = loff_rt(32 + r);
      f32x16 X;
#pragma unroll
      for (int i = 0; i < 16; ++i) X[i] = 0.f;
#pragma unroll
      for (int q = 0; q < 4; ++q) { const f32x4 a4 = *(const f32x4*)(Lp + offA + 16 * hh + 4 * q);
#pragma unroll
          for (int e = 0; e < 4; ++e) { const int kk = 4 * q + e; int hq = hh; asm volatile("" : "+v"(hq)); const int k = 16 * hq + kk;
              const float t = Lp[(hq ? LOFF(16 + kk) : LOFF(kk)) + r]; const float b = (r < k) ? t : (r == k ? 1.f : 0.f);
              X = __builtin_amdgcn_mfma_f32_32x32x2f32(a4[e], b, X, 0, 0, 0); } }
      f32x16 Y;
#pragma unroll
      for (int i = 0; i < 16; ++i) Y[i] = 0.f;
#pragma unroll
      for (int q = 0; q < 4; ++q) { const int k0 = 8 * q + 4 * hh; const f32x4 t4 = *(const f32x4*)(Lp + offA + 32 + k0);
#pragma unroll
          for (int e = 0; e < 4; ++e) { const int kq = k0 + e; const float av = (kq < r) ? t4[e] : (kq == r ? 1.f : 0.f);
              Y = __builtin_amdgcn_mfma_f32_32x32x2f32(av, X[4 * q + e], Y, 0, 0, 0); } }
#pragma unroll
      for (int i = 0; i < 16; ++i) { int hq = hh; asm volatile("" : "+v"(hq)); const int cb = (i & 3) + 8 * (i >> 2);
          Lp[(hq ? LOFF(32 + cb + 4) : LOFF(32 + cb)) + r] = -Y[i]; } }
    WAVE_LDS_SYNC();
    unsigned char* frT = c.ws + WS_FRT + (size_t)item * FR_T_BYTES;
#pragma unroll
    for (int f = 0; f < 8; ++f) { const int ct = f >> 2, sb = f & 3, cc = ct * 32 + r; float v[8];
#pragma unroll
        for (int q = 0; q < 2; ++q) { const int s0 = 16 * sb + 8 * q + 4 * hh;
            f32x4 t4 = (f32x4){0.f, 0.f, 0.f, 0.f}; if (s0 < cc) t4 = *(const f32x4*)(Lp + LOFF(cc) + s0);
            v[4 * q + 0] = (s0 + 0 < cc) ? t4.x : (s0 + 0 == cc ? 1.f : 0.f); v[4 * q + 1] = (s0 + 1 < cc) ? t4.y : (s0 + 1 == cc ? 1.f : 0.f);
            v[4 * q + 2] = (s0 + 2 < cc) ? t4.z : (s0 + 2 == cc ? 1.f : 0.f); v[4 * q + 3] = (s0 + 3 < cc) ? t4.w : (s0 + 3 == cc ? 1.f : 0.f); }
        *(v4u*)(frT + ((size_t)(f * 64 + c.lane)) * 16) = (v4u){pk2(v[0], v[1]), pk2(v[2], v[3]), pk2(v[4], v[5]), pk2(v[6], v[7])}; }
}
__device__ __forceinline__ void phase_gdn_prep(const Ctx& c) {
    const int nit = c.bid < GDN_ITEMS ? (GDN_ITEMS - 1 - c.bid) / c.G + 1 : 0;
    bool scanned = false;
    if (nit > 0) {
        GpPre p; gdn_prep_load(c, c.bid, p);
#pragma unroll 1
        for (int j = 0; j < nit; ++j) { const int item = c.bid + j * c.G, q = j & 7; int nx = item + c.G; nx = nx < GDN_ITEMS ? nx : item;
            gdn_prep_stage(c, item, nx, (float*)(c.lds + GP_LP + q * GP_LPB), p);
            if (q == 7 || j == nit - 1) { const int cnt = q + 1;
                if (c.wave < cnt) gdn_prep_solve(c, c.bid + ((j & ~7) + c.wave) * c.G, (float*)(c.lds + GP_LP + c.wave * GP_LPB));
                else if (j == nit - 1) { for (int t = c.bid + (c.wave - cnt) * c.G; t < 512; t += (8 - cnt) * c.G) s5_state_scan(c, t); }
                if (j == nit - 1 && cnt < 8) scanned = true;
                __syncthreads(); } }
    }
    if (!scanned) for (int t = c.bid + c.wave * c.G; t < 512; t += 8 * c.G) s5_state_scan(c, t);
}

constexpr int GR_K = 0, GR_Q = 16384, GR_T = 32768, GR_A = 40960, GR_KD = 49152, GR_TAB = 65536, GR_BUF = 66560;
__device__ __forceinline__ void gdn_rec_stage(const Ctx& c, int bhd, int n, int buf) {
    const int dir = bhd & 1, h = (bhd >> 1) & 3, b = bhd >> 3, lw = c.wave - 4; const int item = bhd * GDN_NCH + n;
    LAS unsigned char* base = (LAS unsigned char*)c.lds + buf * GR_BUF;
    const unsigned char* QKVb = c.ws + WS_QKV;
#pragma unroll
    for (int q = 0; q < 4; ++q) { const int qi = lw + 4 * q;
        const int s = 4 * qi + (c.lane >> 4), ps = c.lane & 15, p = ps ^ (s & 15); const size_t rowb = (size_t)scan_row(b, dir, n * 64 + s) * 3072 + (size_t)h * 256 + p * 16;
        __builtin_amdgcn_global_load_lds((const unsigned*)(QKVb + rowb + 1024), (LAS unsigned*)(base + GR_K + qi * 1024), 16, 0, 0);
        __builtin_amdgcn_global_load_lds((const unsigned*)(QKVb + rowb), (LAS unsigned*)(base + GR_Q + qi * 1024), 16, 0, 0); }
    const unsigned char* frT = c.ws + WS_FRT + (size_t)item * FR_T_BYTES; const unsigned char* frA = c.ws + WS_FRA + (size_t)item * FR_ATT_BYTES; const unsigned char* frK = c.ws + WS_FRK + (size_t)item * FR_KD_BYTES;
#pragma unroll
    for (int q = 0; q < 2; ++q) { const int qi = lw + 4 * q;
        __builtin_amdgcn_global_load_lds((const unsigned*)(frT + qi * 1024 + c.lane * 16), (LAS unsigned*)(base + GR_T + qi * 1024), 16, 0, 0);
        __builtin_amdgcn_global_load_lds((const unsigned*)(frA + qi * 1024 + c.lane * 16), (LAS unsigned*)(base + GR_A + qi * 1024), 16, 0, 0); }
#pragma unroll
    for (int q = 0; q < 4; ++q) { const int qi = lw + 4 * q;
        __builtin_amdgcn_global_load_lds((const unsigned*)(frK + qi * 1024 + c.lane * 16), (LAS unsigned*)(base + GR_KD + qi * 1024), 16, 0, 0); }
    if (lw == 0) __builtin_amdgcn_global_load_lds((const unsigned*)(c.ws + WS_FRTAB + (size_t)item * FR_TAB_BYTES + c.lane * 16), (LAS unsigned*)(base + GR_TAB), 16, 0, 0);
}
__device__ __forceinline__ bf16x8 gr_rowfrag(const unsigned char* rowp, const int (&po)[16], int kb) {
    const v2u lo = *(const v2u*)(rowp + po[2 * kb]), hi = *(const v2u*)(rowp + po[2 * kb + 1]);
    return __builtin_bit_cast(bf16x8, (v4u){lo.x, lo.y, hi.x, hi.y});
}
__device__ __forceinline__ void gdn_rec_block(const Ctx& c, int bhd, int dvhalf) {
    const int dir = bhd & 1, h = (bhd >> 1) & 3, b = bhd >> 3, r = c.lane & 31, hh = c.lane >> 5, dvt = 2 * dvhalf + (c.wave & 1);
    const bf16* QKV = (const bf16*)(c.ws + WS_QKV); bf16* OG = (bf16*)(c.ws + WS_OG) + (size_t)dir * ML * 512;
    f32x16 S[4];
#pragma unroll
    for (int t = 0; t < 4; ++t)
#pragma unroll
        for (int i = 0; i < 16; ++i) S[t][i] = 0.f;
    int po[16];
#pragma unroll
    for (int p = 0; p < 16; ++p) po[p] = r * 256 + ((p ^ (r & 15)) * 16) + 8 * hh;
    if (c.wave >= 4) gdn_rec_stage(c, bhd, 0, 0);
    asm volatile("s_waitcnt vmcnt(0)" ::: "memory"); __syncthreads();
    for (int n = 0; n < GDN_NCH; ++n) {
        const int buf = n & 1;
        if (c.wave >= 4) { if (n + 1 < GDN_NCH) gdn_rec_stage(c, bhd, n + 1, buf ^ 1); }
        else if (c.wave < 2) {
            const unsigned char* base = c.lds + buf * GR_BUF; const float* tab = (const float*)(base + GR_TAB);
            const int row0 = scan_row(b, dir, n * 64), sgn = dir ? -1 : 1;
            const bf16* vcol = QKV + (size_t)row0 * 1536 + 1024 + h * 128 + dvt * 32 + r + (ptrdiff_t)(sgn * 4 * hh) * 1536;
            bf16* ocol = OG + (size_t)row0 * 512 + h * 128 + dvt * 32 + r + (ptrdiff_t)(sgn * 4 * hh) * 512;
            const ptrdiff_t vst = (ptrdiff_t)sgn * 1536, ost = (ptrdiff_t)sgn * 512;
            bf16 vraw[2][16];
#pragma unroll
            for (int st = 0; st < 2; ++st)
#pragma unroll
                for (int i = 0; i < 16; ++i) vraw[st][i] = vcol[vst * (st * 32 + (i & 3) + 8 * (i >> 2))];
            bf16x8 Rf[2][2];
#pragma unroll
            for (int st = 0; st < 2; ++st) { f32x16 acc;
#pragma unroll
                for (int i = 0; i < 16; ++i) acc[i] = 0.f;
#pragma unroll
                for (int kb = 0; kb < 8; ++kb) acc = MFMA32(gr_rowfrag(base + GR_K + st * 8192, po, kb), pack_step_v(S[kb >> 1], kb & 1), acc);
#pragma unroll
                for (int i = 0; i < 16; ++i) { const int s = st * 32 + crow16(i, hh); acc[i] = tab[64 + s] * (bf1(vraw[st][i]) - tab[128 + s] * acc[i]); }
                Rf[st][0] = pack_step(acc, 0); Rf[st][1] = pack_step(acc, 1); asm volatile("" ::: "memory"); }
            bf16x8 Vf[2][2];
#pragma unroll
            for (int ct = 0; ct < 2; ++ct) { f32x16 acc;
#pragma unroll
                for (int i = 0; i < 16; ++i) acc[i] = 0.f;
#pragma unroll
                for (int sb = 0; sb < 4; ++sb) if (sb < 2 * ct + 2) acc = MFMA32(*(const bf16x8*)(base + GR_T + ((ct * 4 + sb) * 64 + c.lane) * 16), Rf[sb >> 1][sb & 1], acc);
                Vf[ct][0] = pack_step(acc, 0); Vf[ct][1] = pack_step(acc, 1); }
            asm volatile("" ::: "memory");
#pragma unroll
            for (int ct = 0; ct < 2; ++ct) { f32x16 acc;
#pragma unroll
                for (int i = 0; i < 16; ++i) acc[i] = 0.f;
#pragma unroll
                for (int kb = 0; kb < 8; ++kb) acc = MFMA32(gr_rowfrag(base + GR_Q + ct * 8192, po, kb), pack_step_v(S[kb >> 1], kb & 1), acc);
#pragma unroll
                for (int i = 0; i < 16; ++i) acc[i] *= tab[128 + ct * 32 + crow16(i, hh)];
#pragma unroll
                for (int cb = 0; cb < 4; ++cb) if (cb < 2 * ct + 2) acc = MFMA32(*(const bf16x8*)(base + GR_A + ((ct * 4 + cb) * 64 + c.lane) * 16), Vf[cb >> 1][cb & 1], acc);
                if (n >= 4) {
#pragma unroll
                    for (int i = 0; i < 16; ++i) ocol[ost * (ct * 32 + (i & 3) + 8 * (i >> 2))] = (bf16)f2bf(acc[i]); }
                asm volatile("" ::: "memory"); }
            const float gtot = tab[128 + 63];
#pragma unroll
            for (int t = 0; t < 4; ++t) {
#pragma unroll
                for (int i = 0; i < 16; ++i) S[t][i] *= gtot;
#pragma unroll
                for (int cb = 0; cb < 4; ++cb) S[t] = MFMA32(*(const bf16x8*)(base + GR_KD + ((t * 4 + cb) * 64 + c.lane) * 16), Vf[cb >> 1][cb & 1], S[t]); }
        }
        if (c.wave >= 4) asm volatile("s_waitcnt vmcnt(0)" ::: "memory"); else asm volatile("s_waitcnt lgkmcnt(0)" ::: "memory");
        __builtin_amdgcn_s_barrier(); asm volatile("" ::: "memory");
    }
    asm volatile("s_waitcnt vmcnt(0)" ::: "memory"); __syncthreads();
}
__device__ __forceinline__ void phase_gdn_rec(const Ctx& c) { if (c.bid < 128) gdn_rec_block(c, c.bid >> 1, c.bid & 1); }

#define XB_TMO      128
#define XB_XCNT(j)  (256  + 64 * (j))
#define XB_XSUB(j)  (1280 + 64 * (j))
#define XB_XGEN(j)  (2304 + 64 * (j))
#define XB_TOP      3328
#define XB_TOPGEN   3392
#define XCD_BAR_WORDS 3456
#define XB_SPIN_CAP (1u << 20)
__device__ __forceinline__ unsigned xb_ld(unsigned* p)              { return __hip_atomic_load(p, __ATOMIC_RELAXED, __HIP_MEMORY_SCOPE_AGENT); }
__device__ __forceinline__ unsigned xb_add(unsigned* p, unsigned v) { return __hip_atomic_fetch_add(p, v, __ATOMIC_RELAXED, __HIP_MEMORY_SCOPE_AGENT); }
__device__ __forceinline__ unsigned xb_xcc_id() { return (unsigned)__builtin_amdgcn_s_getreg((3 << 11) | 20) & 0xFu; }
#define XB_SPIN(cond, bar) do { unsigned _sp = 0; while (cond) { __builtin_amdgcn_s_sleep(1); \
    if ((++_sp & 255u) == 0u) { if (xb_ld(&(bar)[XB_TMO])) break; if (_sp > XB_SPIN_CAP) { atomicAdd(&(bar)[XB_TMO], 1u); break; } } } } while (0)
struct XcdBarrier { unsigned* bar; unsigned x; volatile LAS unsigned* st; };
__device__ __forceinline__ XcdBarrier xcd_barrier_post(unsigned* bar, volatile LAS unsigned* st) {
    XcdBarrier b; b.bar = bar; b.x = xb_xcc_id(); b.st = st;
    if (threadIdx.x == 0) (void)xb_add(&bar[XB_XCNT(b.x)], 1u);
    return b;
}
__device__ __forceinline__ void xcd_barrier_complete(unsigned* bar, unsigned x, unsigned& nloc, unsigned& nx) {
    const unsigned G = gridDim.x * gridDim.y * gridDim.z;
    unsigned sum, cnt, mine, sp = 0u;
    for (;;) {
        sum = 0u; cnt = 0u; mine = 0u;
#pragma unroll
        for (unsigned j = 0; j < 16; ++j) { const unsigned c = xb_ld(&bar[XB_XCNT(j)]); sum += c; cnt += (c > 0u) ? 1u : 0u; mine = (j == x) ? c : mine; }
        if (sum == G) break;
        __builtin_amdgcn_s_sleep(1);
        if ((++sp & 255u) == 0u) { if (xb_ld(&bar[XB_TMO])) break; if (sp > XB_SPIN_CAP) { atomicAdd(&bar[XB_TMO], 1u); break; } }
    }
    nloc = mine > 0u ? mine : 1u; nx = cnt > 0u ? cnt : 1u;
}
__device__ __forceinline__ void xcd_barrier(const XcdBarrier& b) {
    asm volatile("s_waitcnt vmcnt(0)" ::: "memory");
    __syncthreads();
    if (threadIdx.x == 0) {
        unsigned* bar = b.bar;
        __builtin_amdgcn_s_waitcnt(0);
        unsigned nloc = b.st[0], nx = b.st[1];
        if (nloc == 0u) { xcd_barrier_complete(bar, b.x, nloc, nx); b.st[0] = nloc; b.st[1] = nx; }
        const unsigned old = xb_add(&bar[XB_XSUB(b.x)], 1u);
        const unsigned gen = old / nloc;
        if (old + 1u == (gen + 1u) * nloc) {
            __builtin_amdgcn_fence(__ATOMIC_RELEASE, "agent");
            asm volatile("s_waitcnt vmcnt(0)" ::: "memory");
            const unsigned og = xb_add(&bar[XB_TOP], 1u);
            const unsigned tg = og / nx;
            if (og + 1u == (tg + 1u) * nx) xb_add(&bar[XB_TOPGEN], 1u);
            else XB_SPIN(xb_ld(&bar[XB_TOPGEN]) == tg, bar);
            __builtin_amdgcn_fence(__ATOMIC_ACQUIRE, "agent");
            xb_add(&bar[XB_XGEN(b.x)], 1u);
            asm volatile("s_waitcnt vmcnt(0)" ::: "memory");
        } else {
            XB_SPIN(xb_ld(&bar[XB_XGEN(b.x)]) == gen, bar);
            __builtin_amdgcn_fence(__ATOMIC_ACQUIRE, "agent");
            asm volatile("s_waitcnt vmcnt(0)" ::: "memory");
        }
    }
    __syncthreads();
}

constexpr int LDS_MISC = LDS_BYTES - 64;
__global__ void __launch_bounds__(NTHREADS, 2) mk_fwd(Args args) {
    extern __shared__ __attribute__((aligned(16))) unsigned char lds[];
    Ctx c; c.a = &args; c.ws = args.ws; c.lds = lds;
    c.tid = threadIdx.x; c.lane = c.tid & 63; c.wave = __builtin_amdgcn_readfirstlane(c.tid >> 6); c.bid = blockIdx.x; c.G = gridDim.x;
    c.gw = c.bid * NWAVES + c.wave; c.NGW = c.G * NWAVES; c.gwv = c.wave * c.G + c.bid;
    const int lo = args.ph_lo, hi = args.ph_hi;
    PG8_LAS unsigned char* ring = (PG8_LAS unsigned char*)lds;
#ifndef MK_PH_MASK
#define MK_PH_MASK 0xffff
#endif
#define IN(k) (((MK_PH_MASK >> (k)) & 1) && lo <= (k) && (k) < hi)
#if MK_ONE_LAUNCH
    cg::grid_group grid = cg::this_grid();
    if (lo < 0) grid.sync();
    volatile LAS unsigned* st = (volatile LAS unsigned*)((LAS unsigned char*)lds + LDS_MISC);
    if (c.tid < 2) st[c.tid] = 0u;
    __syncthreads();
    const XcdBarrier bar = xcd_barrier_post((unsigned*)(c.ws + WS_CTL) + CW_BAR, st);
#define SEAM(k) do { if (IN(k) && IN((k) + 1)) xcd_barrier(bar); } while (0)
#else
#define SEAM(k) do { } while (0)
#endif
    if (IN(0)) { phase_prep(c); phase_s5_build(c); } SEAM(0);
    if (IN(1)) { phase_norm1(c); } SEAM(1);
    if (IN(2)) { pg8::Gemm g{(const pg8::bf16_t*)(c.ws + WS_HX), (const pg8::bf16_t*)(c.ws + WS_WIN), 1024, 1024, 1024}; pg8::StaticOrder S; S.init(MT, NPROJ, c.G, c.bid);
        pg8::EpiInProj E{(pg8::bf16_t*)(c.ws + WS_U5), (pg8::bf16_t*)(c.ws + WS_QKVPRE), (pg8::bf16_t*)(c.ws + WS_Z)};
        pg8::gemm_phase<pg8::EpiInProj, pg8::StaticOrder, true, true>(ring, g, S, E); } SEAM(2);
    if (IN(3)) { { pg8::Gemm g{(const pg8::bf16_t*)(c.ws + WS_U5), (const pg8::bf16_t*)(c.ws + WS_PM), 768, 512, 512}; pg8::SchedSS S{c.G, c.bid}; pg8::EpiSS E{(float*)(c.ws + WS_SS)};
          pg8::gemm_phase<pg8::EpiSS, pg8::SchedSS, true, true>(ring, g, S, E); }
        __syncthreads(); phase_conv(c); } SEAM(3);
    if (IN(4)) { phase_gdn_prep(c); } SEAM(4);
    if (IN(5)) { pg8::Gemm g{(const pg8::bf16_t*)(c.ws + WS_U5), (const pg8::bf16_t*)(c.ws + WS_BB), 768, 768, 768}; pg8::SchedS5Y S{c.G, c.bid}; pg8::EpiS5Y E{(pg8::bf16_t*)(c.ws + WS_YG)};
        pg8::gemm_phase<pg8::EpiS5Y, pg8::SchedS5Y, true, true>(ring, g, S, E); } SEAM(5);
    if (IN(6)) { if (c.bid < 128) phase_gdn_rec(c);
        else { pg8::Gemm g{(const pg8::bf16_t*)(c.ws + WS_YG), (const pg8::bf16_t*)(c.ws + WS_WGLU), 512, 512, 512}; pg8::StaticOrder S; S.init(ML, 512, c.G - 128, c.bid - 128);
            pg8::EpiGlu E{(const pg8::bf16_t*)(c.ws + WS_YG), (pg8::bf16_t*)(c.ws + WS_CAT)};
            pg8::gemm_phase<pg8::EpiGlu, pg8::StaticOrder, true, true>(ring, g, S, E); } } SEAM(6);
    if (IN(7)) { phase_combine(c); } SEAM(7);
    if (IN(8)) { pg8::Gemm g{(const pg8::bf16_t*)(c.ws + WS_CAT), (const pg8::bf16_t*)(c.ws + WS_WOUT), 1024, 1024, 1024}; pg8::StaticOrder S; S.init(ML, 1024, c.G, c.bid);
        pg8::EpiBf16<0> E{(pg8::bf16_t*)(c.ws + WS_YRAW), 1024, nullptr, 0, 0, 1.f};
        pg8::gemm_phase<pg8::EpiBf16<0>, pg8::StaticOrder, true, true>(ring, g, S, E); } SEAM(8);
    if (IN(9)) { phase_rows2(c); phase_fp8_tables(c); } SEAM(9);
    if (IN(10)) { pg8::Gemm g{(const pg8::bf16_t*)(c.ws + WS_HX2), (const pg8::bf16_t*)(c.ws + WS_WQ), 1024, 1024, 1024}; pg8::StaticOrder S; S.init(ML, 2048, c.G, c.bid);
        pg8::EpiBf16<0> E{(pg8::bf16_t*)(c.ws + WS_QP), 2048, nullptr, 0, 0, 1.f};
        pg8::gemm_phase<pg8::EpiBf16<0>, pg8::StaticOrder, true, true>(ring, g, S, E); } SEAM(10);
    if (IN(11)) { phase_topk(c); } SEAM(11);
    if (IN(12)) { phase_exp1(c); } SEAM(12);
    if (IN(13)) { phase_exp1b(c); } SEAM(13);
    if (IN(14)) { phase_exp2(c); } SEAM(14);
    if (IN(15)) { phase_exp3(c); }
#undef IN
#undef SEAM
}

extern "C" void kernel_launch(void* const* d_in, const int* in_sizes, int n_in, void* d_out, int out_size, void* d_ws, size_t ws_size, hipStream_t stream) {
    static int grid = 0;
    if (grid == 0) {
        if (n_in != 29 || out_size != ML * D || ws_size < WS_END) { fprintf(stderr, "kernel_launch: unexpected shapes (n_in %d out %d ws %zu)\n", n_in, out_size, ws_size); grid = -1; return; }
        int dev = 0, cus = 0, per_cu = 0;
        (void)hipGetDevice(&dev); (void)hipDeviceGetAttribute(&cus, hipDeviceAttributeMultiprocessorCount, dev);
        if (hipFuncSetAttribute((const void*)mk_fwd, hipFuncAttributeMaxDynamicSharedMemorySize, LDS_BYTES) != hipSuccess) { fprintf(stderr, "kernel_launch: hipFuncSetAttribute failed\n"); grid = -1; return; }
        (void)hipOccupancyMaxActiveBlocksPerMultiprocessor(&per_cu, (const void*)mk_fwd, NTHREADS, LDS_BYTES);
        (void)hipGetLastError();
        grid = cus;
        fprintf(stderr, "kernel_launch: cus %d per_cu %d grid %d\n", cus, per_cu, grid);
    }
    if (grid < 0) return;
    Args a{};
    for (int i = 0; i < 29; ++i) a.in[i] = (const float*)d_in[i];
    a.out = (float*)d_out; a.ws = (unsigned char*)d_ws;
    (void)hipMemsetAsync((char*)d_ws + WS_CTL, 0, CTL_ZERO_BYTES, stream);
#if MK_ONE_LAUNCH
    a.ph_lo = 0; a.ph_hi = NPHASES;
    void* kargs[] = {&a};
    hipError_t e = hipLaunchCooperativeKernel((const void*)mk_fwd, dim3(grid), dim3(NTHREADS), kargs, LDS_BYTES, stream);
    if (e != hipSuccess) fprintf(stderr, "kernel_launch: cooperative launch failed: %s\n", hipGetErrorString(e));
#else
    for (int ph = 0; ph < NPHASES; ++ph) { a.ph_lo = ph; a.ph_hi = ph + 1; hipLaunchKernelGGL(mk_fwd, dim3(grid), dim3(NTHREADS), LDS_BYTES, stream, a); }
#endif
}
```

```cpp
#include <hip/hip_runtime.h>
#include <hip/hip_cooperative_groups.h>
#include <cstdio>
#include <cstdint>
namespace cg = cooperative_groups;
namespace pg8 {
#define PG8_LAS __attribute__((address_space(3)))
typedef unsigned short bf16_t;
typedef short bf16x8 __attribute__((ext_vector_type(8)));
typedef float f32x4 __attribute__((ext_vector_type(4)));
typedef unsigned u32x4 __attribute__((ext_vector_type(4)));
constexpr int BM = 256, BK = 64, HALF = 128, HTB = HALF * BK * 2  , STAGE_BYTES = 8 * HTB, NXCD = 8, WGM = 8;

__host__ __device__ __forceinline__ int lds_byte(int r, int c) { const int st = (r >> 4) * 2 + (c >> 5), rr = r & 15, cc = c & 31, ob = rr * 64 + cc * 2; return st * 1024 + (ob ^ (((ob >> 9) & 1) << 5)); }
__host__ __device__ __forceinline__ void stage_rc(int b, int& R, int& C) { const int st = b / 1024, sb = b % 1024, swz = sb ^ (((sb >> 9) & 1) << 5); R = (st >> 1) * 16 + swz / 64; C = (st & 1) * 32 + (swz % 64) / 2; }
__host__ __device__ __forceinline__ int perm32(int rho) { const int n = rho >> 4, i = rho & 15; return 8 * (i >> 2) + 4 * n + (i & 3); }

struct Unit { int pm, pn; };
struct Gemm { const bf16_t* A; const bf16_t* Bt; int lda, ldb, K; };

struct StaticOrder {
    int nM, nN, nwg, G, c;
    __host__ __device__ void init(int M, int N, int G_, int c_) { nM = M / BM; nN = N / BM; nwg = nM * nN; G = G_; c = c_; }
    __host__ __device__ bool next(int i, Unit& u) const {
        const long L = (long)i * G + c; if (L >= nwg) return false;
        int wgid = (int)L; { const int q = nwg / NXCD, r = nwg % NXCD, xcd = wgid % NXCD, off = wgid / NXCD; wgid = (xcd < r ? xcd * (q + 1) : r * (q + 1) + (xcd - r) * q) + off; }
        const int nig = WGM * nN, gid = wgid / nig, fm = gid * WGM, gsz = (nM - fm) < WGM ? (nM - fm) : WGM;
        u.pm = fm + ((wgid % nig) % gsz); u.pn = (wgid % nig) / gsz; return true;
    }
    __device__ __forceinline__ void a_ready(const Unit&) const {}
    __device__ __forceinline__ void done(const Unit&) const {}
};

__device__ __forceinline__ unsigned cvt_pk_bf16(float lo, float hi) { unsigned r; asm volatile("v_cvt_pk_bf16_f32 %0, %1, %2" : "=v"(r) : "v"(lo), "v"(hi)); return r; }
typedef float f32x2 __attribute__((ext_vector_type(2)));
__device__ __forceinline__ f32x2 gelu_pk(f32x2 v) {
    const f32x2 av = __builtin_elementwise_abs(v), d = av * 0.2316418882f + 1.0f;
    f32x2 t; t.x = __builtin_amdgcn_rcpf(d.x); t.y = __builtin_amdgcn_rcpf(d.y);
    f32x2 q = t * 0.5307027145f + (-0.7265760135f); q = q * t + 0.7107068705f; q = q * t + (-0.142248368f); q = q * t + 0.127414796f; q = q * t;
    const f32x2 s = (v * v) * (-0.72134752044f);
    f32x2 e; e.x = __builtin_amdgcn_exp2f(s.x); e.y = __builtin_amdgcn_exp2f(s.y);
    const f32x2 m = v * (q * e), r = v - m;
    f32x2 o; o.x = v.x < 0.f ? m.x : r.x; o.y = v.y < 0.f ? m.y : r.y; return o;
}

template <int ACT  > struct EpiBf16 {
    static constexpr bool PERM = true, AFTER_DRAIN = false; static_assert(ACT == 0 || ACT == 1, "EpiBf16: ACT is 0 (none) or 1 (gelu_pk)");
    bf16_t* O; int ldc; const float* bias; int split_cols; size_t split_stride; float scale0;
    __device__ __forceinline__ void operator()(const f32x4 (&acc)[2][2][4][2], const Unit& u, int wr, int wc, int fr, int fq) const {
        const int row0 = u.pm * BM + wr * 64 + fr; int colt = u.pn * BM; bf16_t* base = O;
        float sc = 1.f; if (split_cols) { const int t = colt / split_cols; base += (size_t)t * split_stride; colt -= t * split_cols; if (t == 0) sc = scale0; }
        const int col0 = colt + wc * 32 + 8 * fq, bcol0 = u.pn * BM + wc * 32 + 8 * fq;
        f32x4 bv[2][2];
#pragma unroll
        for (int bj = 0; bj < 2; ++bj)
#pragma unroll
            for (int n = 0; n < 2; ++n) bv[bj][n] = bias ? *(const f32x4*)(bias + bcol0 + bj * HALF + 4 * n) : (f32x4){0.f, 0.f, 0.f, 0.f};
#pragma unroll
        for (int ai = 0; ai < 2; ++ai)
#pragma unroll
            for (int m = 0; m < 4; ++m) { bf16_t* rowp = base + (size_t)(row0 + ai * HALF + m * 16) * ldc + col0;
#pragma unroll
                for (int bj = 0; bj < 2; ++bj) { f32x4 v0 = acc[ai][bj][m][0] + bv[bj][0], v1 = acc[ai][bj][m][1] + bv[bj][1];
                    if (ACT == 1) { f32x2 a = gelu_pk((f32x2){v0[0], v0[1]}), b = gelu_pk((f32x2){v0[2], v0[3]}), c = gelu_pk((f32x2){v1[0], v1[1]}), d = gelu_pk((f32x2){v1[2], v1[3]});
                        v0 = (f32x4){a.x, a.y, b.x, b.y}; v1 = (f32x4){c.x, c.y, d.x, d.y}; }
                    v0 = v0 * sc; v1 = v1 * sc; u32x4 w; w.x = cvt_pk_bf16(v0[0], v0[1]); w.y = cvt_pk_bf16(v0[2], v0[3]); w.z = cvt_pk_bf16(v1[0], v1[1]); w.w = cvt_pk_bf16(v1[2], v1[3]);
                    *(u32x4*)(rowp + bj * HALF) = w; } }
    }
};

template <class Epi, class Sched, bool ALIGN_EPI = false, bool SP2 = false>
__device__ __forceinline__ void gemm_phase(PG8_LAS unsigned char* lds, const Gemm g, const Sched& S, const Epi& E) {
    const int tid = threadIdx.x, wid = __builtin_amdgcn_readfirstlane(tid >> 6), lane = tid & 63, wr = wid >> 2, wc = wid & 3, fr = lane & 15, fq = lane >> 4;
    const int K = g.K, nt = K / BK;
    unsigned voffA[2], voffB[2];
#pragma unroll
    for (int i = 0; i < 2; ++i) { int R, C; stage_rc(tid * 16 + i * 8192, R, C); const int Rb = Epi::PERM ? ((R & ~31) + perm32(R & 31)) : R;
        voffA[i] = (unsigned)(R * g.lda + C) * 2u; voffB[i] = (unsigned)(Rb * g.ldb + C) * 2u; }
    const size_t kstep = (size_t)(BK * 2);
    const size_t hstepA = (size_t)HALF * g.lda * 2, hstepB = (size_t)HALF * g.ldb * 2;
    const size_t tstepA = 2 * hstepA, tstepB = 2 * hstepB;
    const unsigned ldsw = (unsigned)wid * 1024u;
    const int aoff = lds_byte(wr * 64 + fr, fq * 8), boff = lds_byte(wc * 32 + fr, fq * 8);
#define PG8_SA(b, h) (((b) * 2 + (h)) * HTB)
#define PG8_SB(b, h) ((4 + (b) * 2 + (h)) * HTB)
#define PG8_STAGE(bufoff, gbase, voff) do { _Pragma("unroll") for (int _i = 0; _i < 2; ++_i) \
        __builtin_amdgcn_global_load_lds((const unsigned*)((const char*)(gbase) + (voff)[_i]), (PG8_LAS unsigned*)(lds + (bufoff) + ldsw + _i * 8192), 16, 0, 0); } while (0)
#define PG8_LDA(dst, b, h) do { _Pragma("unroll") for (int m = 0; m < 4; ++m) _Pragma("unroll") for (int k = 0; k < 2; ++k) dst[m][k] = *(const PG8_LAS bf16x8*)(lds + PG8_SA(b, h) + aoff + m * 2048 + k * 1024); } while (0)
#define PG8_LDB(dst, b, h) do { _Pragma("unroll") for (int n = 0; n < 2; ++n) _Pragma("unroll") for (int k = 0; k < 2; ++k) dst[n][k] = *(const PG8_LAS bf16x8*)(lds + PG8_SB(b, h) + boff + n * 2048 + k * 1024); } while (0)
#define PG8_MMA(ai, bj, At, Bt) do { __builtin_amdgcn_s_setprio(1); _Pragma("unroll") for (int m = 0; m < 4; ++m) _Pragma("unroll") for (int n = 0; n < 2; ++n) _Pragma("unroll") for (int k = 0; k < 2; ++k) \
        acc[ai][bj][m][n] = __builtin_amdgcn_mfma_f32_16x16x32_bf16(Bt[n][k], At[m][k], acc[ai][bj][m][n], 0, 0, 0); __builtin_amdgcn_s_setprio(0); } while (0)
#define PG8_WAIT_V(n) asm volatile("s_waitcnt vmcnt(" #n ")" ::: "memory")
#define PG8_WAIT_L(n) asm volatile("s_waitcnt lgkmcnt(" #n ")" ::: "memory")
#define PG8_BAR __builtin_amdgcn_s_barrier()
#define PG8_SCHED __builtin_amdgcn_sched_barrier(0)
    Unit cur, nxt; int ui = 0;
    if (!S.next(0, cur)) return;
    f32x4 acc[2][2][4][2];
#pragma unroll
    for (int a = 0; a < 2; ++a)
#pragma unroll
        for (int b = 0; b < 2; ++b)
#pragma unroll
            for (int m = 0; m < 4; ++m)
#pragma unroll
                for (int n = 0; n < 2; ++n) acc[a][b][m][n] = (f32x4){0.f, 0.f, 0.f, 0.f};
    bf16x8 At[4][2], B0[2][2], B1[2][2];
    const char* cA = (const char*)g.A + (size_t)cur.pm * tstepA; const char* cB = (const char*)g.Bt + (size_t)cur.pn * tstepB;
    S.a_ready(cur);
    if constexpr (SP2) {
        PG8_STAGE(PG8_SB(0, 0), cB, voffB); PG8_STAGE(PG8_SB(0, 1), cB + hstepB, voffB); PG8_STAGE(PG8_SA(0, 0), cA, voffA); PG8_STAGE(PG8_SA(0, 1), cA + hstepA, voffA);
        if (wr == 1) PG8_BAR;
        PG8_WAIT_V(2); PG8_BAR;
        PG8_STAGE(PG8_SB(1, 0), cB + kstep, voffB); PG8_STAGE(PG8_SA(1, 0), cA + kstep, voffA); PG8_STAGE(PG8_SB(1, 1), cB + hstepB + kstep, voffB);
        PG8_WAIT_V(6); PG8_BAR;
    } else {
        PG8_STAGE(PG8_SB(0, 0), cB, voffB); PG8_STAGE(PG8_SA(0, 0), cA, voffA); PG8_STAGE(PG8_SB(0, 1), cB + hstepB, voffB); PG8_STAGE(PG8_SA(0, 1), cA + hstepA, voffA);
        if (wr == 1) PG8_BAR;
        PG8_WAIT_V(4); PG8_BAR;
        PG8_STAGE(PG8_SB(1, 0), cB + kstep, voffB); PG8_STAGE(PG8_SA(1, 0), cA + kstep, voffA); PG8_STAGE(PG8_SB(1, 1), cB + hstepB + kstep, voffB);
        PG8_WAIT_V(6); PG8_BAR;
    }
    for (;;) {
        const bool has_next = S.next(ui + 1, nxt);
        const char* nA = has_next ? (const char*)g.A + (size_t)nxt.pm * tstepA : cA; const char* nB = has_next ? (const char*)g.Bt + (size_t)nxt.pn * tstepB : cB;
        for (int t = 0; t < nt; t += 2) {
            const bool last = (t == nt - 2);
            const char* a1 = cA + (size_t)(t + 1) * kstep;
            const char* a2 = last ? nA : cA + (size_t)(t + 2) * kstep; const char* b2 = last ? nB : cB + (size_t)(t + 2) * kstep;
            const char* a3 = a2 + kstep; const char* b3 = b2 + kstep;
            if (last && has_next) S.a_ready(nxt);
            if constexpr (SP2) {
            PG8_LDB(B0, 0, 0); PG8_LDB(B1, 0, 1); PG8_SCHED; PG8_LDA(At, 0, 0); PG8_STAGE(PG8_SA(1, 1), a1 + hstepA, voffA);
            PG8_WAIT_V(8); PG8_WAIT_L(0); PG8_BAR; PG8_MMA(0, 0, At, B0); PG8_MMA(0, 1, At, B1); PG8_BAR; PG8_SCHED;
            PG8_LDA(At, 0, 1); PG8_STAGE(PG8_SB(0, 0), b2, voffB); PG8_STAGE(PG8_SB(0, 1), b2 + hstepB, voffB); PG8_STAGE(PG8_SA(0, 0), a2, voffA);
            PG8_WAIT_V(8); PG8_WAIT_L(0); PG8_BAR; PG8_MMA(1, 0, At, B0); PG8_MMA(1, 1, At, B1); PG8_BAR; PG8_SCHED;
            PG8_LDB(B0, 1, 0); PG8_LDB(B1, 1, 1); PG8_SCHED; PG8_LDA(At, 1, 0); PG8_STAGE(PG8_SA(0, 1), a2 + hstepA, voffA);
            PG8_WAIT_V(8); PG8_WAIT_L(0); PG8_BAR; PG8_MMA(0, 0, At, B0); PG8_MMA(0, 1, At, B1); PG8_BAR; PG8_SCHED;
            PG8_LDA(At, 1, 1); PG8_STAGE(PG8_SB(1, 0), b3, voffB); PG8_STAGE(PG8_SB(1, 1), b3 + hstepB, voffB); PG8_STAGE(PG8_SA(1, 0), a3, voffA);
            PG8_WAIT_V(8); PG8_WAIT_L(0); PG8_BAR; PG8_MMA(1, 0, At, B0); PG8_MMA(1, 1, At, B1); PG8_BAR; PG8_SCHED;
            } else {
            PG8_LDB(B0, 0, 0); PG8_SCHED; PG8_LDA(At, 0, 0); PG8_STAGE(PG8_SA(1, 1), a1 + hstepA, voffA);
            PG8_WAIT_L(8); PG8_BAR; PG8_WAIT_L(0); PG8_MMA(0, 0, At, B0); PG8_BAR; PG8_SCHED;
            PG8_LDB(B1, 0, 1); PG8_STAGE(PG8_SB(0, 0), b2, voffB);
            PG8_BAR; PG8_WAIT_L(0); PG8_MMA(0, 1, At, B1); PG8_BAR;
            PG8_LDA(At, 0, 1); PG8_STAGE(PG8_SA(0, 0), a2, voffA);
            PG8_BAR; PG8_WAIT_L(0); PG8_MMA(1, 0, At, B0); PG8_BAR; PG8_SCHED;
            PG8_STAGE(PG8_SB(0, 1), b2 + hstepB, voffB);
            PG8_WAIT_V(6); PG8_BAR; PG8_MMA(1, 1, At, B1); PG8_BAR;
            PG8_LDB(B0, 1, 0); PG8_SCHED; PG8_LDA(At, 1, 0); PG8_STAGE(PG8_SA(0, 1), a2 + hstepA, voffA);
            PG8_WAIT_L(8); PG8_BAR; PG8_WAIT_L(0); PG8_MMA(0, 0, At, B0); PG8_BAR; PG8_SCHED;
            PG8_LDB(B1, 1, 1); PG8_STAGE(PG8_SB(1, 0), b3, voffB);
            PG8_BAR; PG8_WAIT_L(0); PG8_MMA(0, 1, At, B1); PG8_BAR;
            PG8_LDA(At, 1, 1); PG8_STAGE(PG8_SA(1, 0), a3, voffA);
            PG8_BAR; PG8_WAIT_L(0); PG8_MMA(1, 0, At, B0); PG8_BAR; PG8_SCHED;
            PG8_STAGE(PG8_SB(1, 1), b3 + hstepB, voffB);
            PG8_WAIT_V(6); PG8_BAR; PG8_MMA(1, 1, At, B1); PG8_BAR;
            }
        }
        if constexpr (ALIGN_EPI) { if (wr == 0) PG8_BAR; }
        if constexpr (!Epi::AFTER_DRAIN) { E(acc, cur, wr, wc, fr, fq); S.done(cur); }
        if (!has_next) break;
#pragma unroll
        for (int a = 0; a < 2; ++a)
#pragma unroll
            for (int b = 0; b < 2; ++b)
#pragma unroll
                for (int m = 0; m < 4; ++m)
#pragma unroll
                    for (int n = 0; n < 2; ++n) acc[a][b][m][n] = (f32x4){0.f, 0.f, 0.f, 0.f};
        cur = nxt; cA = nA; cB = nB; ++ui;
        if constexpr (ALIGN_EPI) { if (wr == 1) PG8_BAR; }
    }
    PG8_WAIT_V(0);
    if constexpr (!ALIGN_EPI) { if (wr == 0) PG8_BAR; }
    PG8_BAR;
    if constexpr (Epi::AFTER_DRAIN) { E.fused(acc, cur, wr, wc, fr, fq, lds, wid, lane); S.done(cur); }
#undef PG8_SA
#undef PG8_SB
#undef PG8_STAGE
#undef PG8_LDA
#undef PG8_LDB
#undef PG8_MMA
#undef PG8_WAIT_V
#undef PG8_WAIT_L
#undef PG8_BAR
#undef PG8_SCHED
}
}

#ifndef MK_EXP_OLD
#define MK_EXP_OLD 0
#endif
#ifndef MK_ONE_LAUNCH
#define MK_ONE_LAUNCH 1
#endif
#define LAS __attribute__((address_space(3)))
typedef unsigned short bf16;
typedef unsigned v4u __attribute__((ext_vector_type(4)));
typedef unsigned v2u __attribute__((ext_vector_type(2)));
typedef float f32x4 __attribute__((ext_vector_type(4)));
typedef float f32x2 __attribute__((ext_vector_type(2)));
typedef short bf16x8 __attribute__((ext_vector_type(8)));
typedef float f32x16 __attribute__((ext_vector_type(16)));
#define MFMA32(a, b, c) __builtin_amdgcn_mfma_f32_32x32x16_bf16((a), (b), (c), 0, 0, 0)

constexpr int D = 1024, NB = 8, SEQ = 2048, LC = 256, ML = NB * SEQ  , MC = NB * LC  , MT = ML + MC  ;
constexpr int PROJ = 2576, NPROJ = 2560;
constexpr int NEXP = 16384, TOPK = 16, KK = 128;
constexpr float EPS = 1e-6f;
constexpr int NTHREADS = 512, NWAVES = 8;
constexpr int LDS_BYTES = 151552;
constexpr int NPHASES = 16;

constexpr size_t MiB = 1u << 20;
constexpr size_t WS_CTL = 0;
constexpr size_t CTL_ZERO_BYTES = 65536;
constexpr int CW_BAR = 0;
constexpr int CW_E1 = 4096, CW_E2 = 4096 + 8 * 64;
constexpr size_t WS_MOD = 1 * MiB;
constexpr size_t WS_LP = 1 * MiB + 512 * 1024;
constexpr size_t WS_WIN = 2 * MiB;
constexpr size_t WS_WOUT = 8 * MiB;
constexpr size_t WS_WGLU = 10 * MiB;
constexpr size_t WS_WQ = 11 * MiB;
constexpr size_t WS_GB = 15 * MiB;
constexpr size_t WS_BB = 17 * MiB;
constexpr size_t WS_PM = 41 * MiB;
constexpr size_t WS_OG = 17 * MiB;
constexpr size_t WS_HX2 = 17 * MiB;
constexpr size_t WS_U5 = 49 * MiB;
constexpr size_t WS_CAT = 49 * MiB;
constexpr size_t WS_IDX = 49 * MiB;
constexpr size_t WS_GATE = 57 * MiB;
constexpr size_t WS_ACT = 65 * MiB;
constexpr size_t WS_SSQP = 73 * MiB;
constexpr size_t WS_Z = 85 * MiB;
constexpr size_t WS_YRAW = 85 * MiB;
constexpr size_t WS_QP = 85 * MiB;
constexpr size_t WS_Y = 85 * MiB;
constexpr size_t WS_HX = 101 * MiB;
constexpr size_t WS_SS = 101 * MiB;
constexpr size_t WS_YG = 101 * MiB;
constexpr size_t WS_FRT = 125 * MiB;
constexpr size_t WS_QKVPRE = 137 * MiB;
constexpr size_t WS_FRA = 143 * MiB;
constexpr size_t WS_FRK = 161 * MiB;
constexpr size_t WS_FRTAB = 197 * MiB;
constexpr size_t WS_QKV = 202 * MiB;
constexpr size_t WS_U8 = 202 * MiB;
constexpr size_t WS_V8 = 218 * MiB;
constexpr size_t WS_USC = 234 * MiB;
constexpr size_t WS_VSC = 234 * MiB + 512 * 1024;
constexpr size_t WS_HQ8 = 150 * MiB;
constexpr size_t WS_HS = 183 * MiB;
constexpr size_t WS_PACT = 85 * MiB;
constexpr size_t WS_END = 256 * MiB;
static_assert(WS_BB + (size_t)32 * 512 * 768 * 2 <= WS_PM && WS_PM + (size_t)32 * 256 * 512 * 2 <= WS_U5 && WS_U5 + (size_t)32 * 768 * 768 * 2 <= WS_Z && WS_Z + (size_t)ML * 512 * 2 <= WS_HX, "ws map a");
static_assert(WS_HX + (size_t)MT * D * 2 <= WS_QKVPRE && WS_SS + (size_t)32 * 768 * 256 * 4 <= WS_FRT && WS_QKVPRE + (size_t)MT * 1536 * 2 <= WS_QKV && WS_QKV + (size_t)MT * 1536 * 2 <= WS_END, "ws map b");
static_assert(WS_FRT + (size_t)2304 * 8192 <= WS_FRA && WS_FRA + (size_t)2304 * 8192 <= WS_FRK && WS_FRK + (size_t)2304 * 16384 <= WS_FRTAB && WS_FRTAB + (size_t)2304 * 1024 <= WS_QKV, "ws map c");
static_assert(WS_OG + (size_t)2 * ML * 512 * 2 <= WS_CAT && WS_CAT + (size_t)ML * D * 2 <= WS_Z && WS_YRAW + (size_t)ML * D * 4 <= WS_U8 && WS_SSQP + (size_t)8 * ML * 4 <= WS_Z && WS_YG + (size_t)ML * 512 * 2 <= WS_FRT, "ws map d");

__device__ __forceinline__ unsigned f2bf(float f) { unsigned u = __builtin_bit_cast(unsigned, f); return (u + 0x7fffu + ((u >> 16) & 1u)) >> 16; }
typedef __bf16 bf16x2_t __attribute__((ext_vector_type(2)));
__device__ __forceinline__ unsigned pk2(float lo, float hi) { const f32x2 v = {lo, hi}; return __builtin_bit_cast(unsigned, __builtin_convertvector(v, bf16x2_t)); }
__device__ __forceinline__ float bflo(unsigned w) { return __builtin_bit_cast(float, w << 16); }
__device__ __forceinline__ float bfhi(unsigned w) { return __builtin_bit_cast(float, w & 0xffff0000u); }
__device__ __forceinline__ float bf1(bf16 h) { return __builtin_bit_cast(float, (unsigned)h << 16); }
__device__ __forceinline__ float wave_sum(float v) {
#pragma unroll
    for (int o = 1; o < 64; o <<= 1) v += __shfl_xor(v, o);
    return v;
}
__device__ __forceinline__ float wave_max(float v) {
#pragma unroll
    for (int o = 1; o < 64; o <<= 1) v = fmaxf(v, __shfl_xor(v, o));
    return v;
}
__device__ __forceinline__ float sigmoidf_(float x) { return __builtin_amdgcn_rcpf(1.f + __expf(-x)); }
__device__ __forceinline__ float siluf_(float x) { return x * __builtin_amdgcn_rcpf(1.f + __expf(-x)); }
__device__ __forceinline__ float gelu_erf(float x) { return 0.5f * x * (1.f + erff(x * 0.70710678118654752f)); }
__device__ __forceinline__ void sincos_d(double a, float& s, float& c) {
    const double k = rint(a * 0.63661977236758134308);
    const double r = fma(-k, 1.57079632679489661923, a) - k * 6.123233995736766e-17;
    const double r2 = r * r;
    double sp = -2.5052108385441720e-08; sp = sp * r2 + 2.7557319223985893e-06; sp = sp * r2 - 1.9841269841269841e-04; sp = sp * r2 + 8.3333333333333332e-03; sp = sp * r2 - 1.6666666666666666e-01;
    const double sn = r + r * r2 * sp;
    double cp = 2.0876756987868099e-09; cp = cp * r2 - 2.7557319223985888e-07; cp = cp * r2 + 2.4801587301587302e-05; cp = cp * r2 - 1.3888888888888889e-03; cp = cp * r2 + 4.1666666666666664e-02; cp = cp * r2 - 0.5;
    const double cs = 1.0 + r2 * cp;
    const int q = ((int)k) & 3;
    const double ss = (q == 0) ? sn : (q == 1) ? cs : (q == 2) ? -sn : -cs;
    const double cc = (q == 0) ? cs : (q == 1) ? -sn : (q == 2) ? -cs : sn;
    s = (float)ss; c = (float)cc;
}

struct Args { const float* in[29]; float* out; unsigned char* ws; int ph_lo, ph_hi; };
static_assert(sizeof(Args) == 29 * 8 + 8 + 8 + 8, "Args has no padding");
enum { I_X = 0, I_C, I_CTX, I_CCTX, I_WMOD, I_BMOD, I_GPREMIX, I_GPOSTMIX, I_GPREFFN, I_GPOSTFFN, I_WIN, I_WOUT, I_LAMRE, I_LAMIM, I_LOGDT, I_BRE, I_BIM, I_CRE, I_CIM, I_S5D, I_WGLU,
       I_CONV, I_ALOG, I_DTBIAS, I_GDNNORM, I_WQ, I_KEYS, I_PU, I_PV };

__device__ __forceinline__ const float* in_row(const Args& a, int row) { return row < ML ? a.in[I_X] + (size_t)row * D : a.in[I_CTX] + (size_t)(row - ML) * D; }
__device__ __forceinline__ int mod_row(int row) { return row < ML ? (row >> 11) : 8; }

template <int CTRL> __device__ __forceinline__ float dppf(float v) { return __builtin_bit_cast(float, __builtin_amdgcn_update_dpp(0, __builtin_bit_cast(int, v), CTRL, 0xf, 0xf, true)); }
__device__ __forceinline__ float row_sum16(float v) { v += dppf<0xB1>(v); v += dppf<0x4E>(v); v += dppf<0x141>(v); v += dppf<0x140>(v); return v; }
__device__ __forceinline__ float row_max16(float v) { v = fmaxf(v, dppf<0xB1>(v)); v = fmaxf(v, dppf<0x4E>(v)); v = fmaxf(v, dppf<0x141>(v)); v = fmaxf(v, dppf<0x140>(v)); return v; }
__device__ __forceinline__ float wsum(float v) { v = row_sum16(v); return
    __builtin_bit_cast(float, __builtin_amdgcn_readlane(__builtin_bit_cast(int, v), 0)) + __builtin_bit_cast(float, __builtin_amdgcn_readlane(__builtin_bit_cast(int, v), 16)) +
    __builtin_bit_cast(float, __builtin_amdgcn_readlane(__builtin_bit_cast(int, v), 32)) + __builtin_bit_cast(float, __builtin_amdgcn_readlane(__builtin_bit_cast(int, v), 48)); }
__device__ __forceinline__ float wmax(float v) { v = row_max16(v); return fmaxf(fmaxf(__builtin_bit_cast(float, __builtin_amdgcn_readlane(__builtin_bit_cast(int, v), 0)), __builtin_bit_cast(float, __builtin_amdgcn_readlane(__builtin_bit_cast(int, v), 16))),
    fmaxf(__builtin_bit_cast(float, __builtin_amdgcn_readlane(__builtin_bit_cast(int, v), 32)), __builtin_bit_cast(float, __builtin_amdgcn_readlane(__builtin_bit_cast(int, v), 48)))); }
__device__ __forceinline__ int lane_rank(unsigned long long m) { return __builtin_amdgcn_mbcnt_hi((unsigned)(m >> 32), __builtin_amdgcn_mbcnt_lo((unsigned)m, 0)); }
__device__ __forceinline__ unsigned fkey(float f) { const unsigned u = __builtin_bit_cast(unsigned, f); return u ^ ((unsigned)((int)u >> 31) | 0x80000000u); }
#define WAVE_LDS_SYNC() do { __builtin_amdgcn_fence(__ATOMIC_RELEASE, "wavefront"); __builtin_amdgcn_wave_barrier(); __builtin_amdgcn_fence(__ATOMIC_ACQUIRE, "wavefront"); } while (0)
template <int N> __device__ __forceinline__ unsigned kth_key(const unsigned (&k)[N], int K) {
    unsigned T = 0;
    for (int bit = 31; bit >= 0; --bit) { const unsigned cand = T | (1u << bit); int cnt = 0;
#pragma unroll
        for (int n = 0; n < N; ++n) cnt += __popcll(__ballot(k[n] >= cand));
        if (cnt >= K) T = cand;
        if (cnt == K) break; }
    return T;
}

namespace pg8 {
struct EpiInProj {
    static constexpr bool PERM = true, AFTER_DRAIN = false;
    bf16_t* U; bf16_t* QKV; bf16_t* Z;
    __device__ __forceinline__ void operator()(const f32x4 (&acc)[2][2][4][2], const Unit& u, int wr, int wc, int fr, int fq) const {
        bf16_t* base; int ld, colt; bool lat_only = false;
        const bool s5 = u.pn < 2;
        if (s5) { base = U; ld = 0; colt = u.pn * BM; }
        else if (u.pn < 8) { base = QKV; ld = 1536; colt = (u.pn - 2) * BM; }
        else { base = Z; ld = 512; colt = (u.pn - 8) * BM; lat_only = true; }
        const int row0 = u.pm * BM + wr * 64 + fr, col0 = colt + wc * 32 + 8 * fq;
#pragma unroll
        for (int ai = 0; ai < 2; ++ai)
#pragma unroll
            for (int m = 0; m < 4; ++m) { const int row = row0 + ai * HALF + m * 16; bf16_t* rowp = base + (size_t)row * ld + col0;
                if (lat_only && row >= 16384) continue;
                if (s5) { const int R = row < 16384 ? (row >> 5) : 512 + ((row - 16384) >> 5), ii = row & 31; rowp = base + (size_t)R * 768 + ii * 16 + (col0 & 15); }
#pragma unroll
                for (int bj = 0; bj < 2; ++bj) { const f32x4 v0 = acc[ai][bj][m][0], v1 = acc[ai][bj][m][1];
                    u32x4 w; w.x = cvt_pk_bf16(v0[0], v0[1]); w.y = cvt_pk_bf16(v0[2], v0[3]); w.z = cvt_pk_bf16(v1[0], v1[1]); w.w = cvt_pk_bf16(v1[2], v1[3]);
                    if (s5) *(u32x4*)(rowp + (size_t)((col0 + bj * HALF) >> 4) * (768 * 768)) = w; else *(u32x4*)(rowp + bj * HALF) = w; } }
    }
};
struct EpiGlu {
    static constexpr bool PERM = true, AFTER_DRAIN = false;
    const bf16_t* YG; bf16_t* CAT;
    __device__ __forceinline__ void operator()(const f32x4 (&acc)[2][2][4][2], const Unit& u, int wr, int wc, int fr, int fq) const {
        const int row0 = u.pm * BM + wr * 64 + fr, col0 = u.pn * BM + wc * 32 + 8 * fq;
#pragma unroll
        for (int ai = 0; ai < 2; ++ai)
#pragma unroll
            for (int m = 0; m < 4; ++m) { const int row = row0 + ai * HALF + m * 16;
#pragma unroll
                for (int bj = 0; bj < 2; ++bj) { const f32x4 v0 = acc[ai][bj][m][0], v1 = acc[ai][bj][m][1];
                    const u32x4 y = *(const u32x4*)(YG + (size_t)row * 512 + col0 + bj * HALF);
                    float o[8]; const float a[8] = {v0[0], v0[1], v0[2], v0[3], v1[0], v1[1], v1[2], v1[3]};
                    const unsigned yw[4] = {y.x, y.y, y.z, y.w};
#pragma unroll
                    for (int e = 0; e < 8; ++e) { const float yv = __builtin_bit_cast(float, (e & 1) ? (yw[e >> 1] & 0xffff0000u) : (yw[e >> 1] << 16)); o[e] = yv * __builtin_amdgcn_rcpf(1.f + __expf(-a[e])); }
                    u32x4 w; w.x = cvt_pk_bf16(o[0], o[1]); w.y = cvt_pk_bf16(o[2], o[3]); w.z = cvt_pk_bf16(o[4], o[5]); w.w = cvt_pk_bf16(o[6], o[7]);
                    *(u32x4*)(CAT + (size_t)row * 1024 + col0 + bj * HALF) = w; } }
    }
};
struct EpiF32 {
    static constexpr bool PERM = false, AFTER_DRAIN = false;
    float* C; int ldc;
    __device__ __forceinline__ void operator()(const f32x4 (&acc)[2][2][4][2], const Unit& u, int wr, int wc, int fr, int fq) const {
        const int row0 = u.pm * BM + wr * 64 + fr, col0 = u.pn * BM + wc * 32 + 4 * fq;
#pragma unroll
        for (int ai = 0; ai < 2; ++ai)
#pragma unroll
            for (int m = 0; m < 4; ++m) { float* rowp = C + (size_t)(row0 + ai * HALF + m * 16) * ldc + col0;
#pragma unroll
                for (int bj = 0; bj < 2; ++bj)
#pragma unroll
                    for (int n = 0; n < 2; ++n) *(f32x4*)(rowp + bj * HALF + n * 16) = acc[ai][bj][m][n]; }
    }
};
struct EpiSS {
    static constexpr bool PERM = false, AFTER_DRAIN = false;
    float* C;
    __device__ __forceinline__ void operator()(const f32x4 (&acc)[2][2][4][2], const Unit& u, int wr, int wc, int fr, int fq) const {
        const int row0 = u.pm * BM + wr * 64 + fr, col0 = wc * 32 + 4 * fq;
#pragma unroll
        for (int ai = 0; ai < 2; ++ai)
#pragma unroll
            for (int m = 0; m < 4; ++m) { float* rowp = C + (size_t)(row0 + ai * HALF + m * 16) * 256 + col0;
#pragma unroll
                for (int bj = 0; bj < 2; ++bj)
#pragma unroll
                    for (int n = 0; n < 2; ++n) *(f32x4*)(rowp + bj * HALF + n * 16) = acc[ai][bj][m][n]; }
    }
};
struct SchedSS { int G, c; __device__ bool next(int i, Unit& u) const { const int L = i * G + c; if (L >= 96) return false; u.pm = L; u.pn = L / 3; return true; }
    __device__ __forceinline__ void a_ready(const Unit&) const {} __device__ __forceinline__ void done(const Unit&) const {} };
struct EpiS5Y {
    static constexpr bool PERM = true, AFTER_DRAIN = false;
    bf16_t* YG;
    __device__ __forceinline__ void operator()(const f32x4 (&acc)[2][2][4][2], const Unit& u, int wr, int wc, int fr, int fq) const {
        const int g = u.pn >> 1, R0 = (u.pm - 3 * g) * BM + wr * 64 + fr, n0 = (u.pn & 1) * BM + wc * 32 + 8 * fq;
#pragma unroll
        for (int ai = 0; ai < 2; ++ai)
#pragma unroll
            for (int m = 0; m < 4; ++m) { const int R = R0 + ai * HALF + m * 16;
#pragma unroll
                for (int bj = 0; bj < 2; ++bj) { const int n = n0 + bj * HALF; const f32x4 v0 = acc[ai][bj][m][0], v1 = acc[ai][bj][m][1];
                    const f32x2 a = gelu_pk((f32x2){v0[0], v0[1]}), b = gelu_pk((f32x2){v0[2], v0[3]}), c2 = gelu_pk((f32x2){v1[0], v1[1]}), d = gelu_pk((f32x2){v1[2], v1[3]});
                    u32x4 w; w.x = cvt_pk_bf16(a.x, a.y); w.y = cvt_pk_bf16(b.x, b.y); w.z = cvt_pk_bf16(c2.x, c2.y); w.w = cvt_pk_bf16(d.x, d.y);
                    *(u32x4*)(YG + (size_t)(R * 32 + (n >> 4)) * 512 + g * 16 + (n & 15)) = w; } }
    }
};
struct SchedS5Y { int G, c; __device__ bool next(int i, Unit& u) const { const int L = i * G + c; if (L >= 128) return false; const int g = L >> 2; u.pm = 3 * g + ((L >> 1) & 1); u.pn = 2 * g + (L & 1); return true; }
    __device__ __forceinline__ void a_ready(const Unit&) const {} __device__ __forceinline__ void done(const Unit&) const {} };
}

struct Ctx { const Args* a; unsigned char* ws; unsigned char* lds; int tid, lane, wave, bid, G, gw, NGW, gwv; };

__device__ __forceinline__ void p0_transpose_item(const float* W, int ldw, int nblk, int K, bf16* WT, float* scr, int item, int lane) {
    const int kb = item / nblk, nb = item % nblk, k0 = 64 * kb, n0 = 32 * nb;
    float wv[32];
#pragma unroll
    for (int i = 0; i < 32; ++i) { const int kk = 2 * i + (lane >> 5); wv[i] = W[(size_t)(k0 + kk) * ldw + n0 + (lane & 31)]; }
#pragma unroll
    for (int i = 0; i < 32; ++i) { const int kk = 2 * i + (lane >> 5); scr[kk * 33 + (lane & 31)] = wv[i]; }
    __builtin_amdgcn_fence(__ATOMIC_RELEASE, "wavefront"); __builtin_amdgcn_wave_barrier(); __builtin_amdgcn_fence(__ATOMIC_ACQUIRE, "wavefront");
    const int c = lane & 7;
#pragma unroll
    for (int j = 0; j < 4; ++j) { const int n = (lane >> 3) + 8 * j; const float* s = scr + (8 * c) * 33 + n;
        v4u o; o.x = pk2(s[0 * 33], s[1 * 33]); o.y = pk2(s[2 * 33], s[3 * 33]); o.z = pk2(s[4 * 33], s[5 * 33]); o.w = pk2(s[6 * 33], s[7 * 33]);
        *(v4u*)(WT + (size_t)(n0 + n) * K + k0 + 8 * c) = o; }
    __builtin_amdgcn_fence(__ATOMIC_RELEASE, "wavefront"); __builtin_amdgcn_wave_barrier(); __builtin_amdgcn_fence(__ATOMIC_ACQUIRE, "wavefront");
}
__device__ __forceinline__ void phase_prep(const Ctx& c) {
    const Args& a = *c.a;
    float* scr = (float*)(c.lds + c.wave * 16384);
    constexpr int I_IN = 16 * 80, I_OUT = 16 * 32, I_GLU = 8 * 16, I_Q = 16 * 64;
    for (int it = c.gw; it < I_IN + I_OUT + I_GLU + I_Q; it += c.NGW) {
        int r = it;
        if (r < I_IN) { p0_transpose_item(a.in[I_WIN], PROJ, 80, 1024, (bf16*)(c.ws + WS_WIN), scr, r, c.lane); continue; } r -= I_IN;
        if (r < I_OUT) { p0_transpose_item(a.in[I_WOUT], 1024, 32, 1024, (bf16*)(c.ws + WS_WOUT), scr, r, c.lane); continue; } r -= I_OUT;
        if (r < I_GLU) { p0_transpose_item(a.in[I_WGLU], 512, 16, 512, (bf16*)(c.ws + WS_WGLU), scr, r, c.lane); continue; } r -= I_GLU;
        p0_transpose_item(a.in[I_WQ], 2048, 64, 1024, (bf16*)(c.ws + WS_WQ), scr, r, c.lane);
    }
    __syncthreads();
    float* sc = (float*)c.lds;
    float* red = (float*)(c.lds + 9 * 1024 * 4);
    float* MOD = (float*)(c.ws + WS_MOD);
    bool have = false;
    for (int item = c.bid; item < 96; item += c.G) {
        if (!have) { for (int i = c.tid; i < 9 * 1024; i += NTHREADS) { const int r = i >> 10, k = i & 1023; const float v = r < 8 ? a.in[I_C][r * 1024 + k] : a.in[I_CCTX][k]; sc[i] = siluf_(v); } have = true; __syncthreads(); }
        const int n0 = item * 64;
        float acc[9];
#pragma unroll
        for (int r = 0; r < 9; ++r) acc[r] = 0.f;
        const float* wp = a.in[I_WMOD] + (size_t)(c.wave * 128) * 6144 + n0 + c.lane;
#pragma unroll 64
        for (int k = 0; k < 128; ++k) { const float w = wp[(size_t)k * 6144];
#pragma unroll
            for (int r = 0; r < 9; ++r) acc[r] = fmaf(sc[r * 1024 + c.wave * 128 + k], w, acc[r]); }
#pragma unroll
        for (int r = 0; r < 9; ++r) red[(c.wave * 9 + r) * 64 + c.lane] = acc[r];
        __syncthreads();
        for (int i = c.tid; i < 576; i += NTHREADS) { const int r = i >> 6, l = i & 63; float s = a.in[I_BMOD][n0 + l];
#pragma unroll
            for (int w = 0; w < 8; ++w) s += red[(w * 9 + r) * 64 + l];
            MOD[r * 6144 + n0 + l] = s; }
        __syncthreads();
    }
}
__device__ __forceinline__ void s5_build_group(const Ctx& c, int g, int part);
__device__ __forceinline__ void phase_s5_build(const Ctx& c) { for (int it = c.G - 1 - c.bid; it < 128; it += c.G) if (it >= 0) s5_build_group(c, it >> 2, it & 3); }

__device__ __forceinline__ void phase_norm1(const Ctx& c) {
    const Args& a = *c.a;
    float* wabT = (float*)c.lds;
    { f32x4 wv[8];
#pragma unroll
      for (int q = 0; q < 8; ++q) { const int i = c.tid + NTHREADS * q, kk = i >> 2, qq = i & 3; wv[q] = *(const f32x4*)(a.in[I_WIN] + (size_t)kk * PROJ + NPROJ + 4 * qq); }
#pragma unroll
      for (int q = 0; q < 8; ++q) { const int i = c.tid + NTHREADS * q, kk = i >> 2, qq = i & 3; wabT[(4 * qq + 0) * 1028 + kk] = wv[q].x; wabT[(4 * qq + 1) * 1028 + kk] = wv[q].y; wabT[(4 * qq + 2) * 1028 + kk] = wv[q].z; wabT[(4 * qq + 3) * 1028 + kk] = wv[q].w; } }
    __syncthreads();
    const float* MOD = (const float*)(c.ws + WS_MOD);
    bf16* HX = (bf16*)(c.ws + WS_HX); float* GB = (float*)(c.ws + WS_GB);
    const float* gpre = a.in[I_GPREMIX];
    f32x4 nx[4], g4c[4];
#pragma unroll
    for (int j = 0; j < 4; ++j) g4c[j] = *(const f32x4*)(gpre + 4 * c.lane + 256 * j);
    if (c.gw < MT) { const f32x4* xr = (const f32x4*)in_row(a, c.gw) + c.lane;
#pragma unroll
        for (int j = 0; j < 4; ++j) nx[j] = xr[64 * j]; }
    for (int row = c.gw; row < MT; row += c.NGW) {
        const float* mr = MOD + mod_row(row) * 6144;
        f32x4 shv[4], sclv[4];
#pragma unroll
        for (int j = 0; j < 4; ++j) { shv[j] = *(const f32x4*)(mr + 4 * c.lane + 256 * j); sclv[j] = *(const f32x4*)(mr + 1024 + 4 * c.lane + 256 * j); }
        f32x4 v[4]; float ss = 0.f;
#pragma unroll
        for (int j = 0; j < 4; ++j) { v[j] = nx[j]; ss += (v[j].x * v[j].x + v[j].y * v[j].y) + (v[j].z * v[j].z + v[j].w * v[j].w); }
        if (row + c.NGW < MT) { const f32x4* xr = (const f32x4*)in_row(a, row + c.NGW) + c.lane;
#pragma unroll
            for (int j = 0; j < 4; ++j) nx[j] = xr[64 * j]; }
        const float r = rsqrtf(wsum(ss) * (1.f / D) + EPS);
#pragma unroll
        for (int j = 0; j < 4; ++j) { const int col = 4 * c.lane + 256 * j;
            v[j] = (v[j] * r) * g4c[j] * (sclv[j] + 1.f) + shv[j];
            v2u o; o.x = pk2(v[j].x, v[j].y); o.y = pk2(v[j].z, v[j].w);
            *(v2u*)(HX + (size_t)row * D + col) = o; }
        float pj[16];
#pragma unroll
        for (int j = 0; j < 16; ++j) { float s = 0.f;
#pragma unroll
            for (int jj = 0; jj < 4; ++jj) { const f32x4 w = *(const f32x4*)(wabT + j * 1028 + 4 * c.lane + 256 * jj); s += (v[jj].x * w.x + v[jj].y * w.y) + (v[jj].z * w.z + v[jj].w * w.w); }
            pj[j] = s; if ((j & 1) == 1) asm volatile("" ::: "memory"); }
        const bool b5 = c.lane & 32, b4 = c.lane & 16, b3 = c.lane & 8, b2 = c.lane & 4;
        float q8[8], q4[4], q2[2];
#pragma unroll
        for (int i = 0; i < 8; ++i) { const float keep = b5 ? pj[i + 8] : pj[i], send = b5 ? pj[i] : pj[i + 8]; q8[i] = keep + __shfl_xor(send, 32); }
#pragma unroll
        for (int i = 0; i < 4; ++i) { const float keep = b4 ? q8[i + 4] : q8[i], send = b4 ? q8[i] : q8[i + 4]; q4[i] = keep + __shfl_xor(send, 16); }
#pragma unroll
        for (int i = 0; i < 2; ++i) { const float keep = b3 ? q4[i + 2] : q4[i], send = b3 ? q4[i] : q4[i + 2]; q2[i] = keep + dppf<0x140>(send); }
        float mine; { const float keep = b2 ? q2[1] : q2[0], send = b2 ? q2[0] : q2[1]; mine = keep + dppf<0x141>(send); }
        mine += dppf<0xB1>(mine); mine += dppf<0x4E>(mine);
        const int jl = (b5 ? 8 : 0) + (b4 ? 4 : 0) + (b3 ? 2 : 0) + (b2 ? 1 : 0);
        if ((c.lane & 3) == 0) {
            if (jl < 8) { const float t = mine + a.in[I_DTBIAS][jl]; const float sp = t > 20.f ? t : log1pf(expf(t)); GB[(size_t)row * 16 + jl] = -expf(a.in[I_ALOG][jl]) * sp; }
            else GB[(size_t)row * 16 + jl] = 1.f / (1.f + expf(-mine)); }
    }
}

__device__ __forceinline__ void phase_conv(const Ctx& c) {
    const Args& a = *c.a;
    const bf16* PRE = (const bf16*)(c.ws + WS_QKVPRE); bf16* OUT = (bf16*)(c.ws + WS_QKV);
    const float* cw = a.in[I_CONV];
#pragma unroll 1
    for (int pass = 0; pass < 3; ++pass) { const int ch0 = pass * 512 + 8 * c.lane;
        f32x4 wt[9][2];
#pragma unroll
        for (int i = 0; i < 9; ++i) { wt[i][0] = *(const f32x4*)(cw + i * 1536 + ch0); wt[i][1] = *(const f32x4*)(cw + i * 1536 + ch0 + 4); }
#define CONV_LOAD(DST, ROW) do { const int row_ = (ROW); int nb_row[9]; bool ok[9]; \
            if (row_ < ML) { const int t = row_ & 2047, gr = t >> 6, gc = t & 63; \
                _Pragma("unroll") for (int dy = -1; dy <= 1; ++dy) _Pragma("unroll") for (int dx = -1; dx <= 1; ++dx) { const int i = (dy + 1) * 3 + dx + 1; ok[i] = (gr + dy >= 0) && (gr + dy < 32) && (gc + dx >= 0) && (gc + dx < 64); nb_row[i] = row_ + dy * 64 + dx; } } \
            else { const int t = (row_ - ML) & 255; _Pragma("unroll") for (int i = 0; i < 9; ++i) { ok[i] = false; nb_row[i] = row_; } \
                _Pragma("unroll") for (int dx = -1; dx <= 1; ++dx) { ok[4 + dx] = (t + dx >= 0) && (t + dx < 256); nb_row[4 + dx] = row_ + dx; } } \
            _Pragma("unroll") for (int i = 0; i < 9; ++i) DST[i] = ok[i] ? *(const v4u*)(PRE + (size_t)nb_row[i] * 1536 + ch0) : (v4u){0u, 0u, 0u, 0u}; } while (0)
        v4u nin[9];
        if (c.gw < MT) CONV_LOAD(nin, c.gw);
#pragma unroll 1
        for (int row = c.gw; row < MT; row += c.NGW) {
            v4u in[9];
#pragma unroll
            for (int i = 0; i < 9; ++i) in[i] = nin[i];
            if (row + c.NGW < MT) CONV_LOAD(nin, row + c.NGW);
            float o[8];
#pragma unroll
            for (int q = 0; q < 8; ++q) o[q] = 0.f;
#pragma unroll
            for (int i = 0; i < 9; ++i) { const unsigned w[4] = {in[i].x, in[i].y, in[i].z, in[i].w}; const float kk[8] = {wt[i][0].x, wt[i][0].y, wt[i][0].z, wt[i][0].w, wt[i][1].x, wt[i][1].y, wt[i][1].z, wt[i][1].w};
#pragma unroll
                for (int q = 0; q < 4; ++q) { o[2 * q] = fmaf(bflo(w[q]), kk[2 * q], o[2 * q]); o[2 * q + 1] = fmaf(bfhi(w[q]), kk[2 * q + 1], o[2 * q + 1]); } }
            float ssq = 0.f;
#pragma unroll
            for (int q = 0; q < 8; ++q) { o[q] = siluf_(o[q]); ssq = fmaf(o[q], o[q], ssq); }
            if (pass < 2) { const float sc = rsqrtf(row_sum16(ssq) + EPS) * (pass == 0 ? 0.08838834764831845f : 1.f);
#pragma unroll
                for (int q = 0; q < 8; ++q) o[q] *= sc; }
            v4u ov; ov.x = pk2(o[0], o[1]); ov.y = pk2(o[2], o[3]); ov.z = pk2(o[4], o[5]); ov.w = pk2(o[6], o[7]);
            *(v4u*)(OUT + (size_t)row * 1536 + ch0) = ov;
        }
#undef CONV_LOAD
    }
}

__device__ __forceinline__ int scan_row(int b, int dir, int step) {
    if (step < LC) { const int t = dir ? LC - 1 - step : step; return ML + b * LC + t; }
    const int t = step - LC; return b * SEQ + (dir ? SEQ - 1 - t : t);
}
__device__ __forceinline__ void phase_combine(const Ctx& c) {
    const Args& a = *c.a;
    const bf16* OG0 = (const bf16*)(c.ws + WS_OG); const bf16* OG1 = OG0 + (size_t)ML * 512; const bf16* Z = (const bf16*)(c.ws + WS_Z);
    bf16* CAT = (bf16*)(c.ws + WS_CAT);
    const f32x2 ng = *(const f32x2*)(a.in[I_GDNNORM] + 2 * c.lane);
    unsigned n0[4], n1[4], nz[4];
#define CB_LOAD(R) do { _Pragma("unroll") for (int h = 0; h < 4; ++h) { const size_t o_ = (size_t)(R) * 512 + h * 128 + 2 * c.lane; n0[h] = *(const unsigned*)(OG0 + o_); n1[h] = *(const unsigned*)(OG1 + o_); nz[h] = *(const unsigned*)(Z + o_); } } while (0)
    if (c.gw < ML) CB_LOAD(c.gw);
    for (int row = c.gw; row < ML; row += c.NGW) {
        unsigned w0[4], w1[4], zw[4];
#pragma unroll
        for (int h = 0; h < 4; ++h) { w0[h] = n0[h]; w1[h] = n1[h]; zw[h] = nz[h]; }
        { const int rn = row + c.NGW < ML ? row + c.NGW : row; CB_LOAD(rn); }
#pragma unroll
        for (int h = 0; h < 4; ++h) { const int ch = h * 128 + 2 * c.lane;
            const float o0 = bflo(w0[h]) + bflo(w1[h]), o1 = bfhi(w0[h]) + bfhi(w1[h]);
            const float r = rsqrtf(wave_sum(o0 * o0 + o1 * o1) * (1.f / 128.f) + EPS);
            *(unsigned*)(CAT + (size_t)row * 1024 + 512 + ch) = pk2(o0 * r * ng.x * siluf_(bflo(zw[h])), o1 * r * ng.y * siluf_(bfhi(zw[h]))); }
    }
#undef CB_LOAD
}

__device__ __forceinline__ void phase_rows2(const Ctx& c) {
    const Args& a = *c.a;
    const float* MOD = (const float*)(c.ws + WS_MOD); const bf16* YRAW = (const bf16*)(c.ws + WS_YRAW); bf16* HX2 = (bf16*)(c.ws + WS_HX2);
    v2u ny[4]; f32x4 nxx[4], gpo[4], gpf[4];
#pragma unroll
    for (int j = 0; j < 4; ++j) { gpo[j] = *(const f32x4*)(a.in[I_GPOSTMIX] + 4 * c.lane + 256 * j); gpf[j] = *(const f32x4*)(a.in[I_GPREFFN] + 4 * c.lane + 256 * j); }
    if (c.gw < ML) {
#pragma unroll
        for (int j = 0; j < 4; ++j) { ny[j] = *((const v2u*)(YRAW + (size_t)c.gw * D) + c.lane + 64 * j); nxx[j] = *((const f32x4*)(a.in[I_X] + (size_t)c.gw * D) + c.lane + 64 * j); } }
    for (int row = c.gw; row < ML; row += c.NGW) {
        const float* mr = MOD + (row >> 11) * 6144;
        f32x4 gtv[4], shv[4], sclv[4];
#pragma unroll
        for (int j = 0; j < 4; ++j) { const int col = 4 * c.lane + 256 * j; gtv[j] = *(const f32x4*)(mr + 2048 + col); shv[j] = *(const f32x4*)(mr + 3072 + col); sclv[j] = *(const f32x4*)(mr + 4096 + col); }
        f32x4 y[4], x[4]; float ss = 0.f;
#pragma unroll
        for (int j = 0; j < 4; ++j) { y[j] = (f32x4){bflo(ny[j].x), bfhi(ny[j].x), bflo(ny[j].y), bfhi(ny[j].y)}; x[j] = nxx[j];
            ss += (y[j].x * y[j].x + y[j].y * y[j].y) + (y[j].z * y[j].z + y[j].w * y[j].w); }
        if (row + c.NGW < ML) { const size_t r2 = (size_t)(row + c.NGW);
#pragma unroll
            for (int j = 0; j < 4; ++j) { ny[j] = *((const v2u*)(YRAW + r2 * D) + c.lane + 64 * j); nxx[j] = *((const f32x4*)(a.in[I_X] + r2 * D) + c.lane + 64 * j); } }
        const float r = rsqrtf(wsum(ss) * (1.f / D) + EPS); float s2 = 0.f;
#pragma unroll
        for (int j = 0; j < 4; ++j) { const int col = 4 * c.lane + 256 * j;
            x[j] = x[j] + gtv[j] * ((y[j] * r) * gpo[j]);
            *(f32x4*)(a.out + (size_t)row * D + col) = x[j];
            s2 += (x[j].x * x[j].x + x[j].y * x[j].y) + (x[j].z * x[j].z + x[j].w * x[j].w); }
        const float r2 = rsqrtf(wsum(s2) * (1.f / D) + EPS);
#pragma unroll
        for (int j = 0; j < 4; ++j) { const int col = 4 * c.lane + 256 * j;
            const f32x4 hv = (x[j] * r2) * gpf[j] * (sclv[j] + 1.f) + shv[j];
            v2u o; o.x = pk2(hv.x, hv.y); o.y = pk2(hv.z, hv.w);
            *(v2u*)(HX2 + (size_t)row * D + col) = o;
            x[j] = (f32x4){bflo(o.x), bfhi(o.x), bflo(o.y), bfhi(o.y)}; }
        { float mx = 0.f;
#pragma unroll
          for (int j = 0; j < 4; ++j) mx = fmaxf(mx, fmaxf(fmaxf(fabsf(x[j].x), fabsf(x[j].y)), fmaxf(fabsf(x[j].z), fabsf(x[j].w))));
          mx = wmax(mx); const float hs = mx > 0.f ? 256.f / mx : 1.f;
          unsigned char* hq = c.ws + WS_HQ8 + (size_t)row * 2048;
#pragma unroll
          for (int j = 0; j < 4; ++j) { const float a0 = x[j].x * hs, a1 = x[j].y * hs, a2 = x[j].z * hs, a3 = x[j].w * hs;
              int w = __builtin_amdgcn_cvt_pk_fp8_f32(a0, a1, 0, false); w = __builtin_amdgcn_cvt_pk_fp8_f32(a2, a3, w, true);
              const f32x2 b01 = __builtin_amdgcn_cvt_pk_f32_fp8(w, false), b23 = __builtin_amdgcn_cvt_pk_f32_fp8(w, true);
              int w2 = __builtin_amdgcn_cvt_pk_fp8_f32((a0 - b01.x) * 16.f, (a1 - b01.y) * 16.f, 0, false); w2 = __builtin_amdgcn_cvt_pk_fp8_f32((a2 - b23.x) * 16.f, (a3 - b23.y) * 16.f, w2, true);
              *(unsigned*)(hq + 4 * c.lane + 256 * j) = (unsigned)w; *(unsigned*)(hq + 1024 + 4 * c.lane + 256 * j) = (unsigned)w2; }
          if (c.lane == 0) ((float*)(c.ws + WS_HS))[row] = 1.f / hs; }
    }
}


constexpr int KROW = 136;
__device__ __forceinline__ float unfkey(unsigned k) { const unsigned u = (k & 0x80000000u) ? (k ^ 0x80000000u) : ~k; return __builtin_bit_cast(float, u); }
__device__ __forceinline__ void ins16(unsigned (&L)[16], unsigned key) {
#pragma unroll
    for (int q = 0; q < 16; ++q) { const unsigned hi = L[q] > key ? L[q] : key, lo = L[q] > key ? key : L[q]; L[q] = hi; key = lo; }
}
__device__ __forceinline__ void sort16_desc(unsigned (&a)[16]) {
#pragma unroll
    for (int kk = 2; kk <= 16; kk <<= 1)
#pragma unroll
        for (int j = kk >> 1; j >= 1; j >>= 1)
#pragma unroll
            for (int i = 0; i < 16; ++i) { const int l = i ^ j; if (l > i) { const unsigned hi = a[i] > a[l] ? a[i] : a[l], lo = a[i] > a[l] ? a[l] : a[i]; if ((i & kk) == 0) { a[i] = hi; a[l] = lo; } else { a[i] = lo; a[l] = hi; } } }
}
__device__ __forceinline__ void top16_of_two(unsigned (&A)[16], const unsigned (&B)[16]) {
#pragma unroll
    for (int q = 0; q < 16; ++q) A[q] = A[q] > B[15 - q] ? A[q] : B[15 - q];
#pragma unroll
    for (int j = 8; j >= 1; j >>= 1)
#pragma unroll
        for (int q = 0; q < 16; ++q) if ((q & j) == 0) { const unsigned hi = A[q] > A[q + j] ? A[q] : A[q + j], lo = A[q] > A[q + j] ? A[q + j] : A[q]; A[q] = hi; A[q + j] = lo; }
}
__device__ __forceinline__ void merge16(unsigned (&L)[16]) {
    unsigned R[16];
#pragma unroll
    for (int q = 0; q < 16; ++q) R[q] = (unsigned)__shfl_xor((int)L[15 - q], 32);
#pragma unroll
    for (int q = 0; q < 16; ++q) L[q] = L[q] > R[q] ? L[q] : R[q];
#pragma unroll
    for (int j = 8; j >= 1; j >>= 1)
#pragma unroll
        for (int q = 0; q < 16; ++q) if ((q & j) == 0) { const unsigned hi = L[q] > L[q + j] ? L[q] : L[q + j], lo = L[q] > L[q + j] ? L[q + j] : L[q]; L[q] = hi; L[q + j] = lo; }
}
__device__ __forceinline__ void phase_topk(const Ctx& c, bool own) {
    const Args& a = *c.a;
    bf16* kl = (bf16*)c.lds;
    unsigned char* wtab = c.lds + 2 * 128 * KROW * 2 + c.wave * 1088;
    const bf16* QP = (const bf16*)(c.ws + WS_QP); int* IDX = (int*)(c.ws + WS_IDX); float* GATE = (float*)(c.ws + WS_GATE);
    const int r = c.lane & 31, hh = c.lane >> 5;
    { const unsigned char ptab[50] = {0, 1, 2, 3, 4, 5, 6, 7, 8, 9, 10, 11, 12, 13, 14, 15, 16, 17, 18, 19, 20, 21, 22, 23, 32, 33, 34, 35, 36, 48, 49, 50, 51, 64, 65, 66, 80, 81, 96, 97, 112, 113, 128, 144, 160, 176, 192, 208, 224, 240};
      if (c.lane < 50) wtab[1024 + c.lane] = ptab[c.lane < 50 ? c.lane : 0]; }
    pg8::StaticOrder SO; SO.init(ML, 2048, c.G, c.bid);
    for (int it = 0;; ++it) {
        int h, tokbase, ntile;
        if (own) { pg8::Unit u; if (!SO.next(it, u)) break; h = u.pn; tokbase = u.pm * 256; ntile = 8; }
        else { const int item = c.bid + it * c.G; if (item >= 8 * 32) break; h = item & 7; tokbase = (item >> 3) * 512; ntile = 16; }
        __syncthreads();
        { f32x4 kv[16];
#pragma unroll
          for (int q = 0; q < 16; ++q) { const int i = c.tid + NTHREADS * q, k4 = i & 31, n = (i >> 5) & 127, p = i >> 12; kv[q] = *(const f32x4*)(a.in[I_KEYS] + ((size_t)((h * 2 + p) * 128 + n)) * 128 + 4 * k4); }
#pragma unroll
          for (int q = 0; q < 16; ++q) { const int i = c.tid + NTHREADS * q, k4 = i & 31, n = (i >> 5) & 127, p = i >> 12; v2u o; o.x = pk2(kv[q].x, kv[q].y); o.y = pk2(kv[q].z, kv[q].w);
              *(v2u*)(kl + (p * 128 + n) * KROW + 4 * k4) = o; } }
        __syncthreads();
        for (int tile = c.wave; tile < ntile; tile += NWAVES) {
            const int tok = tokbase + tile * 32 + r;
            unsigned LA[16], LB[16];
#pragma unroll
            for (int p = 0; p < 2; ++p) {
                bf16x8 qf[8];
#pragma unroll
                for (int kk = 0; kk < 8; ++kk) qf[kk] = *(const bf16x8*)(QP + (size_t)tok * 2048 + h * 256 + p * 128 + kk * 16 + hh * 8);
                f32x16 acc[4];
#pragma unroll
                for (int nt = 0; nt < 4; ++nt)
#pragma unroll
                    for (int i = 0; i < 16; ++i) acc[nt][i] = 0.f;
#pragma unroll
                for (int kk = 0; kk < 8; ++kk)
#pragma unroll
                    for (int nt = 0; nt < 4; ++nt) acc[nt] = MFMA32(*(const bf16x8*)(kl + (p * 128 + nt * 32 + r) * KROW + kk * 16 + hh * 8), qf[kk], acc[nt]);
                unsigned (&L)[16] = p ? LB : LA;
                unsigned G1[16], G2[16], G3[16];
#pragma unroll
                for (int i = 0; i < 16; ++i) { const int n0 = (i & 3) + 8 * (i >> 2) + 4 * hh;
                    L[i] = (fkey(acc[0][i]) & ~127u) | (unsigned)(127 - n0); G1[i] = (fkey(acc[1][i]) & ~127u) | (unsigned)(127 - (32 + n0));
                    G2[i] = (fkey(acc[2][i]) & ~127u) | (unsigned)(127 - (64 + n0)); G3[i] = (fkey(acc[3][i]) & ~127u) | (unsigned)(127 - (96 + n0)); }
                sort16_desc(L); sort16_desc(G1); sort16_desc(G2); sort16_desc(G3);
                top16_of_two(L, G1); top16_of_two(G2, G3); top16_of_two(L, G2);
                merge16(L);
            }
            unsigned char* tt = wtab + r * 32;
            if (hh == 0) {
#pragma unroll
                for (int q = 0; q < 16; ++q) tt[q] = (unsigned char)(127u - (LA[q] & 127u)); }
            else {
#pragma unroll
                for (int q = 0; q < 16; ++q) tt[16 + q] = (unsigned char)(127u - (LB[q] & 127u)); }
            float va[16], vb[16];
#pragma unroll
            for (int q = 0; q < 16; ++q) { va[q] = unfkey(LA[q] & ~127u); vb[q] = unfkey(LB[q] & ~127u); }
            unsigned LC[16];
#pragma unroll
            for (int q = 0; q < 16; ++q) LC[q] = 0u;
            { const float s0 = va[0] + vb[0], s1 = va[0] + vb[1]; ins16(LC, (fkey(hh ? s1 : s0) & ~63u) | (unsigned)(63 - (0 + hh))); }
            { const float s0 = va[0] + vb[2], s1 = va[0] + vb[3]; ins16(LC, (fkey(hh ? s1 : s0) & ~63u) | (unsigned)(63 - (2 + hh))); }
            { const float s0 = va[0] + vb[4], s1 = va[0] + vb[5]; ins16(LC, (fkey(hh ? s1 : s0) & ~63u) | (unsigned)(63 - (4 + hh))); }
            { const float s0 = va[0] + vb[6], s1 = va[0] + vb[7]; ins16(LC, (fkey(hh ? s1 : s0) & ~63u) | (unsigned)(63 - (6 + hh))); }
            { const float s0 = va[0] + vb[8], s1 = va[0] + vb[9]; ins16(LC, (fkey(hh ? s1 : s0) & ~63u) | (unsigned)(63 - (8 + hh))); }
            { const float s0 = va[0] + vb[10], s1 = va[0] + vb[11]; ins16(LC, (fkey(hh ? s1 : s0) & ~63u) | (unsigned)(63 - (10 + hh))); }
            { const float s0 = va[0] + vb[12], s1 = va[0] + vb[13]; ins16(LC, (fkey(hh ? s1 : s0) & ~63u) | (unsigned)(63 - (12 + hh))); }
            { const float s0 = va[0] + vb[14], s1 = va[0] + vb[15]; ins16(LC, (fkey(hh ? s1 : s0) & ~63u) | (unsigned)(63 - (14 + hh))); }
            { const float s0 = va[1] + vb[0], s1 = va[1] + vb[1]; ins16(LC, (fkey(hh ? s1 : s0) & ~63u) | (unsigned)(63 - (16 + hh))); }
            { const float s0 = va[1] + vb[2], s1 = va[1] + vb[3]; ins16(LC, (fkey(hh ? s1 : s0) & ~63u) | (unsigned)(63 - (18 + hh))); }
            { const float s0 = va[1] + vb[4], s1 = va[1] + vb[5]; ins16(LC, (fkey(hh ? s1 : s0) & ~63u) | (unsigned)(63 - (20 + hh))); }
            { const float s0 = va[1] + vb[6], s1 = va[1] + vb[7]; ins16(LC, (fkey(hh ? s1 : s0) & ~63u) | (unsigned)(63 - (22 + hh))); }
            { const float s0 = va[2] + vb[0], s1 = va[2] + vb[1]; ins16(LC, (fkey(hh ? s1 : s0) & ~63u) | (unsigned)(63 - (24 + hh))); }
            { const float s0 = va[2] + vb[2], s1 = va[2] + vb[3]; ins16(LC, (fkey(hh ? s1 : s0) & ~63u) | (unsigned)(63 - (26 + hh))); }
            { const float s0 = va[2] + vb[4], s1 = va[3] + vb[0]; ins16(LC, (fkey(hh ? s1 : s0) & ~63u) | (unsigned)(63 - (28 + hh))); }
            { const float s0 = va[3] + vb[1], s1 = va[3] + vb[2]; ins16(LC, (fkey(hh ? s1 : s0) & ~63u) | (unsigned)(63 - (30 + hh))); }
            { const float s0 = va[3] + vb[3], s1 = va[4] + vb[0]; ins16(LC, (fkey(hh ? s1 : s0) & ~63u) | (unsigned)(63 - (32 + hh))); }
            { const float s0 = va[4] + vb[1], s1 = va[4] + vb[2]; ins16(LC, (fkey(hh ? s1 : s0) & ~63u) | (unsigned)(63 - (34 + hh))); }
            { const float s0 = va[5] + vb[0], s1 = va[5] + vb[1]; ins16(LC, (fkey(hh ? s1 : s0) & ~63u) | (unsigned)(63 - (36 + hh))); }
            { const float s0 = va[6] + vb[0], s1 = va[6] + vb[1]; ins16(LC, (fkey(hh ? s1 : s0) & ~63u) | (unsigned)(63 - (38 + hh))); }
            { const float s0 = va[7] + vb[0], s1 = va[7] + vb[1]; ins16(LC, (fkey(hh ? s1 : s0) & ~63u) | (unsigned)(63 - (40 + hh))); }
            { const float s0 = va[8] + vb[0], s1 = va[9] + vb[0]; ins16(LC, (fkey(hh ? s1 : s0) & ~63u) | (unsigned)(63 - (42 + hh))); }
            { const float s0 = va[10] + vb[0], s1 = va[11] + vb[0]; ins16(LC, (fkey(hh ? s1 : s0) & ~63u) | (unsigned)(63 - (44 + hh))); }
            { const float s0 = va[12] + vb[0], s1 = va[13] + vb[0]; ins16(LC, (fkey(hh ? s1 : s0) & ~63u) | (unsigned)(63 - (46 + hh))); }
            { const float s0 = va[14] + vb[0], s1 = va[15] + vb[0]; ins16(LC, (fkey(hh ? s1 : s0) & ~63u) | (unsigned)(63 - (48 + hh))); }
            merge16(LC);
            WAVE_LDS_SYNC();
            float ev[16]; float den = 0.f; const float mx = unfkey(LC[0] & ~63u);
#pragma unroll
            for (int q = 0; q < 16; ++q) { ev[q] = __expf(unfkey(LC[q] & ~63u) - mx); den += ev[q]; }
            const float inv = 1.f / den;
            if (hh == 0) { int ex[16];
#pragma unroll
                for (int q = 0; q < 16; ++q) { const unsigned pc = wtab[1024 + (63u - (LC[q] & 63u))]; ex[q] = (int)tt[pc >> 4] * 128 + (int)tt[16 + (pc & 15u)]; }
#pragma unroll
                for (int q = 0; q < 4; ++q) *(v4u*)(IDX + (size_t)tok * 128 + h * 16 + 4 * q) = (v4u){(unsigned)ex[4 * q], (unsigned)ex[4 * q + 1], (unsigned)ex[4 * q + 2], (unsigned)ex[4 * q + 3]}; }
            else {
#pragma unroll
                for (int q = 0; q < 4; ++q) *(f32x4*)(GATE + (size_t)tok * 128 + h * 16 + 4 * q) = (f32x4){ev[4 * q] * inv, ev[4 * q + 1] * inv, ev[4 * q + 2] * inv, ev[4 * q + 3] * inv}; }
            WAVE_LDS_SYNC();
        }
    }
}

__device__ __forceinline__ void phase_fp8_tables(const Ctx& c) {
    const Args& a = *c.a;
    f32x4 nv[2][4];
#define F8_LOAD(R0) do { _Pragma("unroll") for (int u = 0; u < 2; ++u) { int rr = (R0) + u * c.NGW; rr = rr < 2 * NEXP ? rr : 2 * NEXP - 1; const bool isv_ = rr >= NEXP; const int e_ = isv_ ? rr - NEXP : rr; \
        const f32x4* src = (const f32x4*)((isv_ ? a.in[I_PV] : a.in[I_PU]) + (size_t)e_ * D) + c.lane; _Pragma("unroll") for (int j = 0; j < 4; ++j) nv[u][j] = src[64 * j]; } } while (0)
    if (c.gw < 2 * NEXP) F8_LOAD(c.gw);
    for (int r0 = c.gw; r0 < 2 * NEXP; r0 += 2 * c.NGW) {
        f32x4 v[2][4];
#pragma unroll
        for (int u = 0; u < 2; ++u)
#pragma unroll
            for (int j = 0; j < 4; ++j) v[u][j] = nv[u][j];
        { const int rn = r0 + 2 * c.NGW < 2 * NEXP ? r0 + 2 * c.NGW : r0; F8_LOAD(rn); }
#pragma unroll
        for (int u = 0; u < 2; ++u) { const int r = r0 + u * c.NGW;
            if (r < 2 * NEXP) { const bool isv = r >= NEXP; const int e = isv ? r - NEXP : r; float m = 0.f;
#pragma unroll
                for (int j = 0; j < 4; ++j) m = fmaxf(m, fmaxf(fmaxf(fabsf(v[u][j].x), fabsf(v[u][j].y)), fmaxf(fabsf(v[u][j].z), fabsf(v[u][j].w))));
                m = wmax(m); const float inv = m > 0.f ? 256.f / m : 0.f;
                unsigned char* dst = c.ws + (isv ? WS_V8 : WS_U8) + (size_t)e * D + 4 * c.lane;
#pragma unroll
                for (int j = 0; j < 4; ++j) { int w = __builtin_amdgcn_cvt_pk_fp8_f32(v[u][j].x * inv, v[u][j].y * inv, 0, false); w = __builtin_amdgcn_cvt_pk_fp8_f32(v[u][j].z * inv, v[u][j].w * inv, w, true); *(unsigned*)(dst + 256 * j) = (unsigned)w; }
                if (c.lane == 0) ((float*)(c.ws + (isv ? WS_VSC : WS_USC)))[e] = m * (1.f / 256.f); } }
    }
#undef F8_LOAD
}
__device__ __forceinline__ void fp8x16_to_f32(const v4u& r, float (&f)[16]) {
    const unsigned w[4] = {r.x, r.y, r.z, r.w};
#pragma unroll
    for (int j = 0; j < 4; ++j) { const f32x2 lo = __builtin_amdgcn_cvt_pk_f32_fp8((int)w[j], false), hi = __builtin_amdgcn_cvt_pk_f32_fp8((int)w[j], true); f[4 * j] = lo.x; f[4 * j + 1] = lo.y; f[4 * j + 2] = hi.x; f[4 * j + 3] = hi.y; }
}
__device__ __forceinline__ unsigned xcc_id() { return (unsigned)__builtin_amdgcn_s_getreg((3 << 11) | 20) & 7u; }

typedef long l64x2 __attribute__((ext_vector_type(2)));
struct E1Bat { l64x2 rw[16]; };
__device__ __forceinline__ void phase_exp1(const Ctx& c) {
    typedef float f32x4m __attribute__((ext_vector_type(4)));
    const int* IDX = (const int*)(c.ws + WS_IDX); const unsigned char* U8 = c.ws + WS_U8; float* PACT = (float*)(c.ws + WS_PACT);
    unsigned* cnt = (unsigned*)(c.ws + WS_CTL) + CW_E1;
    constexpr int CH = 8;
    constexpr int SROW = 144;
    unsigned char* wl = c.lds + c.wave * 14080; int* le = (int*)wl; unsigned char* himg = wl + 4096; float* res = (float*)(wl + 6144); unsigned char* stage = wl + 6656;
    const int xcc = (int)xcc_id(), r16 = c.lane & 15, g4 = c.lane >> 4, row8 = c.lane >> 3, pc8 = c.lane & 7; const bool bcol = r16 < 2;
    int bo = 0; unsigned tq = 0;
    if (c.lane == 0) tq = __hip_atomic_fetch_add(cnt + 64 * (xcc & 7), (unsigned)CH, __ATOMIC_RELAXED, __HIP_MEMORY_SCOPE_AGENT);
    for (;;) {
        const int x = (xcc + bo) & 7;
        const unsigned t0 = (unsigned)__builtin_amdgcn_readfirstlane((int)tq);
        if (t0 >= (unsigned)ML) { if (++bo >= 8) break; tq = 0; if (c.lane == 0) tq = __hip_atomic_fetch_add(cnt + 64 * ((xcc + bo) & 7), (unsigned)CH, __ATOMIC_RELAXED, __HIP_MEMORY_SCOPE_AGENT); continue; }
        tq = 0; if (c.lane == 0) tq = __hip_atomic_fetch_add(cnt + 64 * x, (unsigned)CH, __ATOMIC_RELAXED, __HIP_MEMORY_SCOPE_AGENT);
        { v4u ee[4], im[2];
#pragma unroll
          for (int q = 0; q < 4; ++q) ee[q] = *(const v4u*)(IDX + (size_t)t0 * 128 + 256 * q + 4 * c.lane);
#pragma unroll
          for (int q = 0; q < 2; ++q) { const int p = c.lane + 64 * q; im[q] = *(const v4u*)(c.ws + WS_HQ8 + ((size_t)t0 + (p >> 4)) * 2048 + ((p >> 3) & 1) * 1024 + 128 * x + 16 * (p & 7)); }
#pragma unroll
          for (int q = 0; q < 4; ++q) *(v4u*)(le + 256 * q + 4 * c.lane) = ee[q];
#pragma unroll
          for (int q = 0; q < 2; ++q) *(v4u*)(himg + 16 * (c.lane + 64 * q)) = im[q]; }
        WAVE_LDS_SYNC();
#define E1_LOAD(G, B) do { const int bb = (B) < CH ? (B) : 0; _Pragma("unroll") for (int i = 0; i < 16; ++i) G.rw[i] = *(const l64x2*)(U8 + (size_t)le[bb * 128 + 8 * i + row8] * D + 128 * x + 16 * pc8); } while (0)
#define E1_W(G, GI) do { unsigned char* sb_ = stage + ((GI) % 3) * (16 * SROW); *(l64x2*)(sb_ + row8 * SROW + 16 * pc8) = G.rw[2 * (GI)]; *(l64x2*)(sb_ + (8 + row8) * SROW + 16 * pc8) = G.rw[2 * (GI) + 1]; } while (0)
#define E1_R(A01, A23, GI) do { const unsigned char* sb_ = stage + ((GI) % 3) * (16 * SROW); A01 = *(const l64x2*)(sb_ + r16 * SROW + 32 * g4); A23 = *(const l64x2*)(sb_ + r16 * SROW + 32 * g4 + 16); } while (0)
#define E1_COMP(G, B) do { const unsigned char* hb = himg + ((B) * 2 + (r16 & 1)) * 128 + 32 * g4; long bq[4]; _Pragma("unroll") for (int m = 0; m < 4; ++m) { const long v = *(const long*)(hb + 8 * m); bq[m] = bcol ? v : 0l; } \
            l64x2 a01, a23, n01, n23; \
            E1_W(G, 0); E1_W(G, 1); WAVE_LDS_SYNC(); E1_R(a01, a23, 0); \
            _Pragma("unroll") for (int gi = 0; gi < 8; ++gi) { \
                if (gi + 2 < 8) E1_W(G, gi + 2); \
                WAVE_LDS_SYNC(); \
                if (gi + 1 < 8) E1_R(n01, n23, gi + 1); \
                f32x4m acc = {0.f, 0.f, 0.f, 0.f}; \
                acc = __builtin_amdgcn_mfma_f32_16x16x32_fp8_fp8(a01.x, bq[0], acc, 0, 0, 0); acc = __builtin_amdgcn_mfma_f32_16x16x32_fp8_fp8(a01.y, bq[1], acc, 0, 0, 0); \
                acc = __builtin_amdgcn_mfma_f32_16x16x32_fp8_fp8(a23.x, bq[2], acc, 0, 0, 0); acc = __builtin_amdgcn_mfma_f32_16x16x32_fp8_fp8(a23.y, bq[3], acc, 0, 0, 0); \
                _Pragma("unroll") for (int q = 0; q < 4; ++q) { const float lo = dppf<0xB1>(acc[q]); if (r16 == 0) res[gi * 16 + 4 * g4 + q] = acc[q] + lo * 0.0625f; } \
                a01 = n01; a23 = n23; } \
            WAVE_LDS_SYNC(); \
            { float* po = PACT + (size_t)x * ((size_t)ML * 128) + ((size_t)t0 + (B)) * 128; po[c.lane] = res[c.lane]; po[64 + c.lane] = res[64 + c.lane]; } \
            WAVE_LDS_SYNC(); } while (0)
        E1Bat ga, gb;
        E1_LOAD(ga, 0);
#pragma unroll 1
        for (int b2 = 0; b2 < CH; b2 += 2) {
            E1_LOAD(gb, b2 + 1);
            __builtin_amdgcn_sched_barrier(0);
            E1_COMP(ga, b2);
            __builtin_amdgcn_sched_barrier(0);
            E1_LOAD(ga, b2 + 2);
            __builtin_amdgcn_sched_barrier(0);
            E1_COMP(gb, b2 + 1);
            __builtin_amdgcn_sched_barrier(0);
        }
#undef E1_LOAD
#undef E1_COMP
#undef E1_W
#undef E1_R
    }
}
__device__ __forceinline__ void phase_exp1b(const Ctx& c) {
    const int* IDX = (const int*)(c.ws + WS_IDX); const float* GATE = (const float*)(c.ws + WS_GATE); const float* HS = (const float*)(c.ws + WS_HS); const float* PACT = (const float*)(c.ws + WS_PACT);
    const float* USC = (const float*)(c.ws + WS_USC); const float* VSC = (const float*)(c.ws + WS_VSC); float* ACT = (float*)(c.ws + WS_ACT);
    const size_t N = (size_t)ML * 128, stride = (size_t)c.G * NTHREADS;
    for (size_t i0 = (size_t)c.bid * NTHREADS + c.tid; i0 < N; i0 += 4 * stride) {
        float pv[4][8], gt[4], hs[4], us[4], vs[4]; int e[4];
#pragma unroll
        for (int q = 0; q < 4; ++q) { size_t i = i0 + q * stride; i = i < N ? i : N - 1;
#pragma unroll
            for (int x = 0; x < 8; ++x) pv[q][x] = PACT[(size_t)x * N + i];
            e[q] = IDX[i]; gt[q] = GATE[i]; hs[q] = HS[i >> 7]; }
#pragma unroll
        for (int q = 0; q < 4; ++q) { us[q] = USC[e[q]]; vs[q] = VSC[e[q]]; }
#pragma unroll
        for (int q = 0; q < 4; ++q) { const size_t i = i0 + q * stride; float s = 0.f;
#pragma unroll
            for (int x = 0; x < 8; ++x) s += pv[q][x];
            if (i < N) ACT[i] = gelu_erf(s * hs[q] * us[q]) * gt[q] * vs[q]; }
    }
}
__device__ __forceinline__ void phase_exp2(const Ctx& c) {
    const int* IDX = (const int*)(c.ws + WS_IDX); const float* ACT = (const float*)(c.ws + WS_ACT); const unsigned char* V8 = c.ws + WS_V8;
    bf16* Y = (bf16*)(c.ws + WS_Y); float* SSQP = (float*)(c.ws + WS_SSQP);
    unsigned* cnt = (unsigned*)(c.ws + WS_CTL) + CW_E2;
    int* li = (int*)(c.lds + c.wave * 1024); float* la = (float*)(li + 128);
    const int xcc = (int)xcc_id(), sub = c.lane & 7, grp = c.lane >> 3;
    const bool b5 = c.lane & 32, b4 = c.lane & 16, b3 = c.lane & 8;
    constexpr int CH = 8;
    int bo = 0, t = 0, tend = 0;
    int iA = 0, iB = 0; float aA = 0.f, aB = 0.f;
    unsigned tq = 0; if (c.lane == 0) tq = __hip_atomic_fetch_add(cnt + 64 * (xcc & 7), (unsigned)CH, __ATOMIC_RELAXED, __HIP_MEMORY_SCOPE_AGENT);
    for (;;) {
        if (t >= tend) {
            const unsigned t0 = (unsigned)__builtin_amdgcn_readfirstlane((int)tq);
            if (t0 >= (unsigned)ML) { if (++bo >= 8) break; tq = 0; if (c.lane == 0) tq = __hip_atomic_fetch_add(cnt + 64 * ((xcc + bo) & 7), (unsigned)CH, __ATOMIC_RELAXED, __HIP_MEMORY_SCOPE_AGENT); continue; }
            tq = 0; if (c.lane == 0) tq = __hip_atomic_fetch_add(cnt + 64 * ((xcc + bo) & 7), (unsigned)CH, __ATOMIC_RELAXED, __HIP_MEMORY_SCOPE_AGENT);
            t = (int)t0; tend = t + CH;
            iA = IDX[(size_t)t * 128 + c.lane]; iB = IDX[(size_t)t * 128 + 64 + c.lane]; aA = ACT[(size_t)t * 128 + c.lane]; aB = ACT[(size_t)t * 128 + 64 + c.lane];
        }
        const int x = (xcc + bo) & 7;
        li[c.lane] = iA; li[64 + c.lane] = iB; la[c.lane] = aA; la[64 + c.lane] = aB;
        if (t + 1 < tend) { iA = IDX[(size_t)(t + 1) * 128 + c.lane]; iB = IDX[(size_t)(t + 1) * 128 + 64 + c.lane]; aA = ACT[(size_t)(t + 1) * 128 + c.lane]; aB = ACT[(size_t)(t + 1) * 128 + 64 + c.lane]; }
        WAVE_LDS_SYNC();
        float acc[16];
#pragma unroll
        for (int q = 0; q < 16; ++q) acc[q] = 0.f;
        { v4u rows[16]; float av[16];
#pragma unroll
          for (int i = 0; i < 16; ++i) { const int k = 8 * i + grp; rows[i] = *(const v4u*)(V8 + (size_t)li[k] * D + x * 128 + 16 * sub); av[i] = la[k]; }
          asm volatile("" ::: "memory");
#pragma unroll
          for (int i = 0; i < 16; ++i) { float f[16]; fp8x16_to_f32(rows[i], f);
#pragma unroll
              for (int q = 0; q < 16; ++q) acc[q] = fmaf(av[i], f[q], acc[q]); } }
        float q8[8], q4[4], q2[2];
#pragma unroll
        for (int i = 0; i < 8; ++i) { const float keep = b5 ? acc[i + 8] : acc[i], send = b5 ? acc[i] : acc[i + 8]; q8[i] = keep + __shfl_xor(send, 32); }
#pragma unroll
        for (int i = 0; i < 4; ++i) { const float keep = b4 ? q8[i + 4] : q8[i], send = b4 ? q8[i] : q8[i + 4]; q4[i] = keep + __shfl_xor(send, 16); }
#pragma unroll
        for (int i = 0; i < 2; ++i) { const float keep = b3 ? q4[i + 2] : q4[i], send = b3 ? q4[i] : q4[i + 2]; q2[i] = keep + __shfl_xor(send, 8); }
        const int col = x * 128 + 16 * sub + (b5 ? 8 : 0) + (b4 ? 4 : 0) + (b3 ? 2 : 0);
        *(unsigned*)(Y + (size_t)t * D + col) = pk2(q2[0], q2[1]);
        const float ss = wsum(q2[0] * q2[0] + q2[1] * q2[1]);
        SSQP[(size_t)x * ML + t] = ss;
        WAVE_LDS_SYNC();
        ++t;
    }
}
__device__ __forceinline__ void phase_exp3(const Ctx& c) {
    const Args& a = *c.a;
    const float* MOD = (const float*)(c.ws + WS_MOD); const bf16* Y = (const bf16*)(c.ws + WS_Y); const float* SSQP = (const float*)(c.ws + WS_SSQP);
    v2u ny[4]; f32x4 nx[4], ngt[4], g4c[4]; float nss = 0.f;
#pragma unroll
    for (int j = 0; j < 4; ++j) g4c[j] = *(const f32x4*)(a.in[I_GPOSTFFN] + 4 * c.lane + 256 * j);
#define E3_LOAD(R) do { _Pragma("unroll") for (int j = 0; j < 4; ++j) { const int col = 4 * c.lane + 256 * j; ny[j] = *(const v2u*)(Y + (size_t)(R) * D + col); nx[j] = *(const f32x4*)(a.out + (size_t)(R) * D + col); \
            ngt[j] = *(const f32x4*)(MOD + ((R) >> 11) * 6144 + 5120 + col); } \
        nss = (c.lane < 8) ? SSQP[(size_t)c.lane * ML + (R)] : 0.f; } while (0)
    if (c.gw < ML) E3_LOAD(c.gw);
    for (int row = c.gw; row < ML; row += c.NGW) {
        f32x4 y[4], x1[4], gt[4];
#pragma unroll
        for (int j = 0; j < 4; ++j) { y[j] = (f32x4){bflo(ny[j].x), bfhi(ny[j].x), bflo(ny[j].y), bfhi(ny[j].y)}; x1[j] = nx[j]; gt[j] = ngt[j]; }
        const float ss = row_sum16(nss);
        const float tot = __builtin_bit_cast(float, __builtin_amdgcn_readlane(__builtin_bit_cast(int, ss), 0));
        if (row + c.NGW < ML) E3_LOAD(row + c.NGW);
        const float r = rsqrtf(tot * (1.f / D) + EPS);
#pragma unroll
        for (int j = 0; j < 4; ++j) { const int col = 4 * c.lane + 256 * j;
            *(f32x4*)(a.out + (size_t)row * D + col) = x1[j] + gt[j] * ((y[j] * r) * g4c[j]); }
    }
#undef E3_LOAD
}

constexpr int S5_LPOW = 0, S5_BBAR = 33792, S5_CC = 50176, S5_MM = 66560;
__device__ __forceinline__ void s5_build_group(const Ctx& c, int g, int part) {
    const Args& a = *c.a;
    f32x2* LPOW = (f32x2*)(c.lds + S5_LPOW);
    f32x2* BBAR = (f32x2*)(c.lds + S5_BBAR);
    f32x2* CC = (f32x2*)(c.lds + S5_CC);
    float* MM = (float*)(c.lds + S5_MM);
    __syncthreads();
    { const int dir = (c.tid >> 6) & 1, p = c.tid & 63, eq = c.tid >> 7, dg = dir * 32 + g;
        const float dt = expf(a.in[I_LOGDT][dg]), lr = a.in[I_LAMRE][dg * 64 + p], li = a.in[I_LAMIM][dg * 64 + p];
        const f32x4 br4 = *(const f32x4*)(a.in[I_BRE] + (size_t)(dg * 64 + p) * 16 + 4 * eq), bi4 = *(const f32x4*)(a.in[I_BIM] + (size_t)(dg * 64 + p) * 16 + 4 * eq);
        const double ang = (double)li * (double)dt; const float lrdt = lr * dt;
        for (int e = eq; e <= 32; e += 4) { float sn, cs; sincos_d(ang * (double)e, sn, cs); const float mg = expf(lrdt * (float)e); LPOW[(dir * 33 + e) * 64 + p] = (f32x2){mg * cs, mg * sn}; }
        float sn, cs; sincos_d(ang, sn, cs); const float mag = expf(lrdt), lbr = mag * cs, lbi = mag * sn, den = lr * lr + li * li, nr = lbr - 1.f;
        const float cr = (nr * lr + lbi * li) / den, ci = (lbi * lr - nr * li) / den;
#pragma unroll
        for (int q = 0; q < 4; ++q) { const float br = br4[q], bi = bi4[q]; BBAR[(dir * 64 + p) * 16 + 4 * eq + q] = (f32x2){cr * br - ci * bi, cr * bi + ci * br}; } }
    for (int i = c.tid; i < 2048; i += NTHREADS) { const int dir = i >> 10, ch = (i >> 6) & 15, p = i & 63, dg = dir * 32 + g; CC[i] = (f32x2){a.in[I_CRE][(size_t)(dg * 16 + ch) * 64 + p], a.in[I_CIM][(size_t)(dg * 16 + ch) * 64 + p]}; }
    __syncthreads();
    for (int task = c.tid; task < 1024; task += NTHREADS) { const int cpb = task & 3, cb = (task >> 2) & 3, lag = (task >> 4) & 31, dir = task >> 9;
        float acc[4][4];
#pragma unroll
        for (int i = 0; i < 4; ++i)
#pragma unroll
            for (int j = 0; j < 4; ++j) acc[i][j] = 0.f;
        for (int p = 0; p < 64; ++p) { const f32x2 l = LPOW[(dir * 33 + lag) * 64 + p]; f32x2 G[4], Cw[4];
#pragma unroll
            for (int j = 0; j < 4; ++j) { const f32x2 bb = BBAR[(dir * 64 + p) * 16 + 4 * cpb + j]; G[j] = (f32x2){l.x * bb.x - l.y * bb.y, l.x * bb.y + l.y * bb.x}; }
#pragma unroll
            for (int i = 0; i < 4; ++i) Cw[i] = CC[(dir * 16 + 4 * cb + i) * 64 + p];
#pragma unroll
            for (int i = 0; i < 4; ++i)
#pragma unroll
                for (int j = 0; j < 4; ++j) acc[i][j] += Cw[i].x * G[j].x - Cw[i].y * G[j].y; }
#pragma unroll
        for (int i = 0; i < 4; ++i)
#pragma unroll
            for (int j = 0; j < 4; ++j) MM[((dir * 32 + lag) * 16 + 4 * cb + i) * 16 + 4 * cpb + j] = acc[i][j]; }
    __syncthreads();
    if (c.tid < 128 && part == 0) { const int dir = c.tid >> 6, p = c.tid & 63; ((f32x2*)(c.ws + WS_LP))[(dir * 32 + g) * 64 + p] = LPOW[(dir * 33 + 32) * 64 + p]; }
    bf16* PMg = (bf16*)(c.ws + WS_PM) + (size_t)g * 256 * 512; bf16* BBg = (bf16*)(c.ws + WS_BB) + (size_t)g * 512 * 768;
    for (int task = part * 64 * 32 + c.tid; task < (part + 1) * 64 * 32; task += NTHREADS) { const int ip = task & 31, n = task >> 5, dir = n >> 7, im = (n >> 6) & 1, p = n & 63, e = dir ? ip : 31 - ip;
        const f32x2 l = LPOW[(dir * 33 + e) * 64 + p]; float o[16];
#pragma unroll
        for (int ch = 0; ch < 16; ++ch) { const f32x2 bb = BBAR[(dir * 64 + p) * 16 + ch]; o[ch] = im ? (l.x * bb.y + l.y * bb.x) : (l.x * bb.x - l.y * bb.y); }
        v4u w0, w1; w0.x = pk2(o[0], o[1]); w0.y = pk2(o[2], o[3]); w0.z = pk2(o[4], o[5]); w0.w = pk2(o[6], o[7]); w1.x = pk2(o[8], o[9]); w1.y = pk2(o[10], o[11]); w1.z = pk2(o[12], o[13]); w1.w = pk2(o[14], o[15]);
        *(v4u*)(PMg + (size_t)n * 512 + ip * 16) = w0; *(v4u*)(PMg + (size_t)n * 512 + ip * 16 + 8) = w1; }
    const float dskv = a.in[I_S5D][g * 16 + ((c.tid >> 5) & 15)];
    for (int task = part * 128 * 32 + c.tid; task < (part + 1) * 128 * 32; task += NTHREADS) { const int ip = task & 31, n = task >> 5, i = n >> 4, ch = n & 15; float o[16];
#pragma unroll
        for (int q = 0; q < 16; ++q) o[q] = 0.f;
        if (ip <= i) { const float* m0 = MM + ((0 * 32 + (i - ip)) * 16 + ch) * 16;
#pragma unroll
            for (int q = 0; q < 16; ++q) o[q] += m0[q]; }
        if (ip >= i) { const float* m1 = MM + ((1 * 32 + (ip - i)) * 16 + ch) * 16;
#pragma unroll
            for (int q = 0; q < 16; ++q) o[q] += m1[q]; }
        if (ip == i) { const float dsk = dskv;
#pragma unroll
            for (int q = 0; q < 16; ++q) o[q] += (q == ch) ? dsk : 0.f; }
        v4u w0, w1; w0.x = pk2(o[0], o[1]); w0.y = pk2(o[2], o[3]); w0.z = pk2(o[4], o[5]); w0.w = pk2(o[6], o[7]); w1.x = pk2(o[8], o[9]); w1.y = pk2(o[10], o[11]); w1.z = pk2(o[12], o[13]); w1.w = pk2(o[14], o[15]);
        *(v4u*)(BBg + (size_t)n * 768 + ip * 16) = w0; *(v4u*)(BBg + (size_t)n * 768 + ip * 16 + 8) = w1; }
    for (int task = part * 128 * 32 + c.tid; task < (part + 1) * 128 * 32; task += NTHREADS) { const int p8 = task & 7, part = (task >> 3) & 3, n = task >> 5, i = n >> 4, ch = n & 15, dir = part >> 1, im = part & 1, e = dir ? 32 - i : i + 1; float o[8];
#pragma unroll
        for (int q = 0; q < 8; ++q) { const int p = p8 * 8 + q; const f32x2 l = LPOW[(dir * 33 + e) * 64 + p], cc = CC[(dir * 16 + ch) * 64 + p]; o[q] = im ? -(cc.x * l.y + cc.y * l.x) : (cc.x * l.x - cc.y * l.y); }
        v4u w0; w0.x = pk2(o[0], o[1]); w0.y = pk2(o[2], o[3]); w0.z = pk2(o[4], o[5]); w0.w = pk2(o[6], o[7]);
        *(v4u*)(BBg + (size_t)n * 768 + 512 + part * 64 + p8 * 8) = w0; }
}
__device__ __forceinline__ void s5_state_scan(const Ctx& c, int task) {
    const int dir = task & 1, g = (task >> 1) & 31, b = task >> 6, p = c.lane;
    const f32x2 a = ((const f32x2*)(c.ws + WS_LP))[(dir * 32 + g) * 64 + p];
    const float* SS = (const float*)(c.ws + WS_SS) + (size_t)g * 768 * 256 + dir * 128 + p; bf16* U5 = (bf16*)(c.ws + WS_U5) + (size_t)g * 768 * 768 + 512 + dir * 128 + p;
    float er = 0.f, ei = 0.f;
#pragma unroll 1
    for (int s0 = 0; s0 < 72; s0 += 24) {
        float sr[24], si[24];
#pragma unroll
        for (int u = 0; u < 24; ++u) { const int step = s0 + u; const int R = (step < 8) ? 512 + b * 8 + (dir ? 7 - step : step) : b * 64 + (dir ? 71 - step : step - 8);
            sr[u] = SS[(size_t)R * 256]; si[u] = SS[(size_t)R * 256 + 64]; }
#pragma unroll
        for (int u = 0; u < 24; ++u) { const int step = s0 + u; const int R = (step < 8) ? 512 + b * 8 + (dir ? 7 - step : step) : b * 64 + (dir ? 71 - step : step - 8);
            if (step >= 8) { U5[(size_t)R * 768] = (bf16)f2bf(er); U5[(size_t)R * 768 + 64] = (bf16)f2bf(ei); }
            const float nr = sr[u] + a.x * er - a.y * ei, ni = si[u] + a.x * ei + a.y * er; er = nr; ei = ni; }
    }
}

constexpr int GDN_NCH = 36, GDN_ITEMS = NB * 4 * 2 * GDN_NCH;
constexpr size_t FR_T_BYTES = 8192, FR_ATT_BYTES = 8192, FR_KD_BYTES = 16384, FR_TAB_BYTES = 1024;
__device__ __forceinline__ int crow16(int i, int hh) { return (i & 3) + 8 * (i >> 2) + 4 * hh; }
__device__ __forceinline__ bf16x8 pack_step(const f32x16& x, int s) {
    v4u w; w.x = pk2(x[8 * s + 0], x[8 * s + 1]); w.y = pk2(x[8 * s + 2], x[8 * s + 3]); w.z = pk2(x[8 * s + 4], x[8 * s + 5]); w.w = pk2(x[8 * s + 6], x[8 * s + 7]);
    return __builtin_bit_cast(bf16x8, w);
}
__device__ __forceinline__ unsigned pk2v(float lo, float hi) { asm volatile("" : "+v"(lo), "+v"(hi)); return pk2(lo, hi); }
__device__ __forceinline__ bf16x8 pack_step_v(const f32x16& x, int s) {
    v4u w; w.x = pk2v(x[8 * s + 0], x[8 * s + 1]); w.y = pk2v(x[8 * s + 2], x[8 * s + 3]); w.z = pk2v(x[8 * s + 4], x[8 * s + 5]); w.w = pk2v(x[8 * s + 6], x[8 * s + 7]);
    return __builtin_bit_cast(bf16x8, w);
}
constexpr int GP_KR = 0, GP_QR = 17408, GP_KT = 34816, GP_TAB = 53248, GP_LP = 54272, GP_LPB = 8448 + 256;
__host__ __device__ constexpr int LOFF(int i) { return i < 1 ? 0 : 4 * (((i - 1) >> 2) + 1) * (2 * ((i - 1) >> 2) + ((i - 1) & 3)); }
static_assert(LOFF(1) == 0 && LOFF(2) == 4 && LOFF(5) == 16 && LOFF(6) == 24 && LOFF(64) == 2112, "packed lower-triangular row offsets");
struct GpPre { v4u q0, q1, k0, k1; float g, beta; };
__device__ __forceinline__ void gdn_prep_load(const Ctx& c, int item, GpPre& p) {
    const int n = item % GDN_NCH, bhd = item / GDN_NCH, dir = bhd & 1, h = (bhd >> 1) & 3, b = bhd >> 3;
    const bf16* QKV = (const bf16*)(c.ws + WS_QKV); const float* GB = (const float*)(c.ws + WS_GB);
    const int s = c.tid >> 3, seg = c.tid & 7; const bf16* rp = QKV + (size_t)scan_row(b, dir, n * 64 + s) * 1536 + h * 128 + seg * 16;
    p.q0 = *(const v4u*)rp; p.q1 = *(const v4u*)(rp + 8); p.k0 = *(const v4u*)(rp + 512); p.k1 = *(const v4u*)(rp + 520);
    const size_t rl = (size_t)scan_row(b, dir, n * 64 + c.lane) * 16 + dir * 4 + h; p.g = GB[rl]; p.beta = GB[rl + 8];
}
__device__ __forceinline__ void gdn_prep_stage(const Ctx& c, int item, int item_next, float* Lp, GpPre& p) {
    bf16* Kr = (bf16*)(c.lds + GP_KR); bf16* Qr = (bf16*)(c.lds + GP_QR); bf16* Kt = (bf16*)(c.lds + GP_KT); float* tab = (float*)(c.lds + GP_TAB);
    unsigned char* frA = c.ws + WS_FRA + (size_t)item * FR_ATT_BYTES; unsigned char* frK = c.ws + WS_FRK + (size_t)item * FR_KD_BYTES; float* frTab = (float*)(c.ws + WS_FRTAB + (size_t)item * FR_TAB_BYTES);
    const int r = c.lane & 31, hh = c.lane >> 5;
    if (c.wave == 0) { float g = p.g; const float beta = p.beta;
#pragma unroll
        for (int o = 1; o < 64; o <<= 1) { const float t = __shfl_up(g, o); if (c.lane >= o) g += t; }
        const float gl = __shfl(g, 63);
        tab[c.lane] = g; tab[64 + c.lane] = beta; tab[128 + c.lane] = __expf(g); tab[192 + c.lane] = __expf(gl - g); }
    { const int s = c.tid >> 3, seg = c.tid & 7;
      const v4u q0 = p.q0, q1 = p.q1, k0 = p.k0, k1 = p.k1;
      gdn_prep_load(c, item_next, p);
      *(v4u*)(Qr + s * 136 + seg * 16) = q0; *(v4u*)(Qr + s * 136 + seg * 16 + 8) = q1; *(v4u*)(Kr + s * 136 + seg * 16) = k0; *(v4u*)(Kr + s * 136 + seg * 16 + 8) = k1;
      const unsigned kw[8] = {k0.x, k0.y, k0.z, k0.w, k1.x, k1.y, k1.z, k1.w};
#pragma unroll
      for (int e = 0; e < 8; ++e) { Kt[(seg * 16 + 2 * e) * 72 + s] = (bf16)(kw[e] & 0xffffu); Kt[(seg * 16 + 2 * e + 1) * 72 + s] = (bf16)(kw[e] >> 16); } }
    __syncthreads();
    if (c.wave < 3) { const int ct = c.wave ? 1 : 0, st = c.wave == 2 ? 1 : 0;
        f32x16 acc;
#pragma unroll
        for (int i = 0; i < 16; ++i) acc[i] = 0.f;
#pragma unroll
        for (int kk = 0; kk < 8; ++kk) { const bf16x8 a = *(const bf16x8*)(Kr + (ct * 32 + r) * 136 + kk * 16 + hh * 8), bb = *(const bf16x8*)(Kr + (st * 32 + r) * 136 + kk * 16 + hh * 8); acc = MFMA32(a, bb, acc); }
        const int s = st * 32 + r; const float gcs = tab[s];
#pragma unroll
        for (int i = 0; i < 16; ++i) { const int cc = ct * 32 + crow16(i, hh); if (s < cc) Lp[LOFF(cc) + s] = tab[64 + cc] * acc[i] * __expf(tab[cc] - gcs); }
    } else if (c.wave < 6) { const int w = c.wave - 3, st = w == 2 ? 1 : 0, ct = w ? 1 : 0;
        f32x16 acc;
#pragma unroll
        for (int i = 0; i < 16; ++i) acc[i] = 0.f;
#pragma unroll
        for (int kk = 0; kk < 8; ++kk) { const bf16x8 a = *(const bf16x8*)(Kr + (st * 32 + r) * 136 + kk * 16 + hh * 8), bb = *(const bf16x8*)(Qr + (ct * 32 + r) * 136 + kk * 16 + hh * 8); acc = MFMA32(a, bb, acc); }
        const int cc = ct * 32 + r; const float gcc = tab[cc];
#pragma unroll
        for (int i = 0; i < 16; ++i) { const int s = st * 32 + crow16(i, hh); acc[i] = (s <= cc) ? acc[i] * __expf(gcc - tab[s]) : 0.f; }
        *(bf16x8*)(frA + ((size_t)((ct * 4 + 2 * st) * 64 + c.lane)) * 16) = pack_step(acc, 0);
        *(bf16x8*)(frA + ((size_t)((ct * 4 + 2 * st + 1) * 64 + c.lane)) * 16) = pack_step(acc, 1);
    } else { const int w = c.wave - 6;
#pragma unroll
        for (int f = 0; f < 8; ++f) { const int fi = w * 8 + f, dkt = fi >> 2, cb = fi & 3; const bf16* kp = Kt + (dkt * 32 + r) * 72 + 16 * cb + 4 * hh;
            const v2u lo = *(const v2u*)kp, hi = *(const v2u*)(kp + 8); const f32x4 e0 = *(const f32x4*)(tab + 192 + 16 * cb + 4 * hh), e1 = *(const f32x4*)(tab + 192 + 16 * cb + 8 + 4 * hh);
            v4u o; o.x = pk2(bflo(lo.x) * e0.x, bfhi(lo.x) * e0.y); o.y = pk2(bflo(lo.y) * e0.z, bfhi(lo.y) * e0.w); o.z = pk2(bflo(hi.x) * e1.x, bfhi(hi.x) * e1.y); o.w = pk2(bflo(hi.y) * e1.z, bfhi(hi.y) * e1.w);
            *(v4u*)(frK + ((size_t)(fi * 64 + c.lane)) * 16) = o; }
        if (w == 0) { const v4u z = (v4u){0u, 0u, 0u, 0u}; *(v4u*)(frA + ((size_t)((0 * 4 + 2) * 64 + c.lane)) * 16) = z; *(v4u*)(frA + ((size_t)((0 * 4 + 3) * 64 + c.lane)) * 16) = z; }
        else { *(f32x4*)(frTab + 4 * c.lane) = *(const f32x4*)(tab + 4 * c.lane); }
    }
    __syncthreads();
}
__device__ __forceinline__ int loff_rt(int i) { return i < 1 ? 0 : 4 * (((i - 1) >> 2) + 1) * (2 * ((i - 1) >> 2) + ((i - 1) & 3)); }
__device__ __forceinline__ void gdn_prep_solve(const Ctx& c, int item, float* Lp) {
    const int r = c.lane & 31, hh = c.lane >> 5;
    { float Tr[32];
#pragma unroll
      for (int i = 0; i < 32; ++i) { int je = r, bl = hh; asm volatile("" : "+v"(je), "+v"(bl)); float a0 = (je == i) ? 1.f : 0.f, a1 = 0.f;
          const int ro = bl ? LOFF(32 + i) + 32 : LOFF(i);
#pragma unroll
          for (int s4 = 0; s4 < (i + 3) / 4; ++s4) { const f32x4 l4 = *(const f32x4*)(Lp + ro + 4 * s4);
              if (4 * s4 + 0 < i) a0 = fmaf(-l4.x, Tr[4 * s4 + 0], a0); if (4 * s4 + 1 < i) a1 = fmaf(-l4.y, Tr[4 * s4 + 1], a1); if (4 * s4 + 2 < i) a0 = fmaf(-l4.z, Tr[4 * s4 + 2], a0); if (4 * s4 + 3 < i) a1 = fmaf(-l4.w, Tr[4 * s4 + 3], a1); }
          Tr[i] = a0 + a1; Lp[(je < i) ? ro + je : 2112 + 32 * bl + je] = Tr[i]; } }
    WAVE_LDS_SYNC();
    { const int offA = loff_rt(32 + r);
      f32x16 X;
#pragma unroll
      for (int i = 0; i < 16; ++i) X[i] = 0.f;
#pragma unroll
      for (int q = 0; q < 4; ++q) { const f32x4 a4 = *(const f32x4*)(Lp + offA + 16 * hh + 4 * q);
#pragma unroll
          for (int e = 0; e < 4; ++e) { const int kk = 4 * q + e; int hq = hh; asm volatile("" : "+v"(hq)); const int k = 16 * hq + kk;
              const float t = Lp[(hq ? LOFF(16 + kk) : LOFF(kk)) + r]; const float b = (r < k) ? t : (r == k ? 1.f : 0.f);
              X = __builtin_amdgcn_mfma_f32_32x32x2f32(a4[e], b, X, 0, 0, 0); } }
      f32x16 Y;
#pragma unroll
      for (int i = 0; i < 16; ++i) Y[i] = 0.f;
#pragma unroll
      for (int q = 0; q < 4; ++q) { const int k0 = 8 * q + 4 * hh; const f32x4 t4 = *(const f32x4*)(Lp + offA + 32 + k0);
#pragma unroll
          for (int e = 0; e < 4; ++e) { const int kq = k0 + e; const float av = (kq < r) ? t4[e] : (kq == r ? 1.f : 0.f);
              Y = __builtin_amdgcn_mfma_f32_32x32x2f32(av, X[4 * q + e], Y, 0, 0, 0); } }
#pragma unroll
      for (int i = 0; i < 16; ++i) { int hq = hh; asm volatile("" : "+v"(hq)); const int cb = (i & 3) + 8 * (i >> 2);
          Lp[(hq ? LOFF(32 + cb + 4) : LOFF(32 + cb)) + r] = -Y[i]; } }
    WAVE_LDS_SYNC();
    unsigned char* frT = c.ws + WS_FRT + (size_t)item * FR_T_BYTES;
#pragma unroll
    for (int f = 0; f < 8; ++f) { const int ct = f >> 2, sb = f & 3, cc = ct * 32 + r; float v[8];
#pragma unroll
        for (int q = 0; q < 2; ++q) { const int s0 = 16 * sb + 8 * q + 4 * hh;
            f32x4 t4 = (f32x4){0.f, 0.f, 0.f, 0.f}; if (s0 < cc) t4 = *(const f32x4*)(Lp + LOFF(cc) + s0);
            v[4 * q + 0] = (s0 + 0 < cc) ? t4.x : (s0 + 0 == cc ? 1.f : 0.f); v[4 * q + 1] = (s0 + 1 < cc) ? t4.y : (s0 + 1 == cc ? 1.f : 0.f);
            v[4 * q + 2] = (s0 + 2 < cc) ? t4.z : (s0 + 2 == cc ? 1.f : 0.f); v[4 * q + 3] = (s0 + 3 < cc) ? t4.w : (s0 + 3 == cc ? 1.f : 0.f); }
        *(v4u*)(frT + ((size_t)(f * 64 + c.lane)) * 16) = (v4u){pk2(v[0], v[1]), pk2(v[2], v[3]), pk2(v[4], v[5]), pk2(v[6], v[7])}; }
}
__device__ __forceinline__ void phase_gdn_prep(const Ctx& c) {
    const int nit = c.bid < GDN_ITEMS ? (GDN_ITEMS - 1 - c.bid) / c.G + 1 : 0;
    bool scanned = false;
    if (nit > 0) {
        GpPre p; gdn_prep_load(c, c.bid, p);
#pragma unroll 1
        for (int j = 0; j < nit; ++j) { const int item = c.bid + j * c.G, q = j & 7; int nx = item + c.G; nx = nx < GDN_ITEMS ? nx : item;
            gdn_prep_stage(c, item, nx, (float*)(c.lds + GP_LP + q * GP_LPB), p);
            if (q == 7 || j == nit - 1) { const int cnt = q + 1;
                if (c.wave < cnt) gdn_prep_solve(c, c.bid + ((j & ~7) + c.wave) * c.G, (float*)(c.lds + GP_LP + c.wave * GP_LPB));
                else if (j == nit - 1) { for (int t = c.bid + (c.wave - cnt) * c.G; t < 512; t += (8 - cnt) * c.G) s5_state_scan(c, t); }
                if (j == nit - 1 && cnt < 8) scanned = true;
                __syncthreads(); } }
    }
    if (!scanned) for (int t = c.bid + c.wave * c.G; t < 512; t += 8 * c.G) s5_state_scan(c, t);
}

constexpr int GR_K = 0, GR_Q = 16384, GR_T = 32768, GR_A = 40960, GR_KD = 49152, GR_TAB = 65536, GR_V = 66560, GR_BUF = 74752;
static_assert(2 * GR_BUF + 64 <= LDS_BYTES, "recurrence buffers");
__device__ __forceinline__ void gdn_rec_fetch(const Ctx& c, int bhd, int dvhalf, int n, v4u (&st)[19]) {
    const int dir = bhd & 1, h = (bhd >> 1) & 3, b = bhd >> 3, lw = c.wave - 4; const int item = bhd * GDN_NCH + n;
    int ln = c.lane; asm volatile("" : "+v"(ln));
    const unsigned char* QKVb = c.ws + WS_QKV;
#pragma unroll
    for (int q = 0; q < 4; ++q) { const int qi = lw + 4 * q;
        const int s = 4 * qi + (ln >> 4), ps = ln & 15, p = ps ^ (s & 15); const size_t rowb = (size_t)scan_row(b, dir, n * 64 + s) * 3072 + (size_t)h * 256 + p * 16;
        st[2 * q] = *(const v4u*)(QKVb + rowb + 1024); st[2 * q + 1] = *(const v4u*)(QKVb + rowb); }
    const unsigned char* frT = c.ws + WS_FRT + (size_t)item * FR_T_BYTES; const unsigned char* frA = c.ws + WS_FRA + (size_t)item * FR_ATT_BYTES; const unsigned char* frK = c.ws + WS_FRK + (size_t)item * FR_KD_BYTES;
#pragma unroll
    for (int q = 0; q < 2; ++q) { const int qi = lw + 4 * q; st[8 + 2 * q] = *(const v4u*)(frT + qi * 1024 + ln * 16); st[9 + 2 * q] = *(const v4u*)(frA + qi * 1024 + ln * 16); }
#pragma unroll
    for (int q = 0; q < 4; ++q) { const int qi = lw + 4 * q; st[12 + q] = *(const v4u*)(frK + qi * 1024 + ln * 16); }
    st[16] = *(const v4u*)(c.ws + WS_FRTAB + (size_t)item * FR_TAB_BYTES + ln * 16);
#pragma unroll
    for (int q = 0; q < 2; ++q) { const int qi = lw + 4 * q, s = 8 * qi + (ln >> 3);
        st[17 + q] = *(const v4u*)(QKVb + (size_t)scan_row(b, dir, n * 64 + s) * 3072 + 2048 + (size_t)h * 256 + dvhalf * 128 + (ln & 7) * 16); }
}
__device__ __forceinline__ void gdn_rec_put(const Ctx& c, int buf, const v4u (&st)[19]) {
    const int lw = c.wave - 4; unsigned char* base = c.lds + buf * GR_BUF + c.lane * 16;
#pragma unroll
    for (int q = 0; q < 4; ++q) { const int qi = lw + 4 * q; *(v4u*)(base + GR_K + qi * 1024) = st[2 * q]; *(v4u*)(base + GR_Q + qi * 1024) = st[2 * q + 1]; }
#pragma unroll
    for (int q = 0; q < 2; ++q) { const int qi = lw + 4 * q; *(v4u*)(base + GR_T + qi * 1024) = st[8 + 2 * q]; *(v4u*)(base + GR_A + qi * 1024) = st[9 + 2 * q]; }
#pragma unroll
    for (int q = 0; q < 4; ++q) { const int qi = lw + 4 * q; *(v4u*)(base + GR_KD + qi * 1024) = st[12 + q]; }
    if (lw == 0) *(v4u*)(base + GR_TAB) = st[16];
#pragma unroll
    for (int q = 0; q < 2; ++q) { const int qi = lw + 4 * q; *(v4u*)(base + GR_V + qi * 1024) = st[17 + q]; }
}
__device__ __forceinline__ bf16x8 gr_rowfrag(const unsigned char* rowp, const int (&po)[16], int kb) {
    const v2u lo = *(const v2u*)(rowp + po[2 * kb]), hi = *(const v2u*)(rowp + po[2 * kb + 1]);
    return __builtin_bit_cast(bf16x8, (v4u){lo.x, lo.y, hi.x, hi.y});
}
__device__ __forceinline__ void gdn_rec_block(const Ctx& c, int bhd, int dvhalf) {
    const int dir = bhd & 1, h = (bhd >> 1) & 3, b = bhd >> 3, r = c.lane & 31, hh = c.lane >> 5, dvt = 2 * dvhalf + (c.wave & 1);
    const bf16* QKV = (const bf16*)(c.ws + WS_QKV); bf16* OG = (bf16*)(c.ws + WS_OG) + (size_t)dir * ML * 512;
    f32x16 S[4];
#pragma unroll
    for (int t = 0; t < 4; ++t)
#pragma unroll
        for (int i = 0; i < 16; ++i) S[t][i] = 0.f;
    int po[16];
#pragma unroll
    for (int p = 0; p < 16; ++p) po[p] = r * 256 + ((p ^ (r & 15)) * 16) + 8 * hh;
#define GR_STEP_BARRIER() do { asm volatile("s_waitcnt lgkmcnt(0)" ::: "memory"); __builtin_amdgcn_s_barrier(); asm volatile("" ::: "memory"); } while (0)
    if (c.wave >= 4) {
        v4u st[19];
        gdn_rec_fetch(c, bhd, dvhalf, 0, st); gdn_rec_put(c, 0, st); gdn_rec_fetch(c, bhd, dvhalf, 1, st);
        GR_STEP_BARRIER();
#pragma unroll 1
        for (int n = 0; n < GDN_NCH; ++n) {
            if (n + 1 < GDN_NCH) gdn_rec_put(c, (n + 1) & 1, st);
            { const int nn = n + 2 < GDN_NCH ? n + 2 : GDN_NCH - 1; gdn_rec_fetch(c, bhd, dvhalf, nn, st); }
            GR_STEP_BARRIER(); }
    } else if (c.wave >= 2) {
        GR_STEP_BARRIER();
#pragma unroll 1
        for (int n = 0; n < GDN_NCH; ++n) GR_STEP_BARRIER();
    } else {
    GR_STEP_BARRIER();
#define GR_FENCE() asm volatile("" ::: "memory")
#define GR_LOADROW(F, AREA, T8) do { _Pragma("unroll") for (int kb = 0; kb < 8; ++kb) F[kb] = gr_rowfrag(base + (AREA) + (T8) * 8192, po, kb); } while (0)
#define GR_FRAG(AREA, IDX) (*(const bf16x8*)(base + (AREA) + ((IDX) * 64 + c.lane) * 16))
#define GR_LOADV(DST, ST) do { _Pragma("unroll") for (int i = 0; i < 16; ++i) DST[i] = vl[((ST) * 32 + (i & 3) + 8 * (i >> 2)) * 64]; } while (0)
    for (int n = 0; n < GDN_NCH; ++n) {
        const int buf = n & 1;
        {
            const unsigned char* base = c.lds + buf * GR_BUF; const float* tab = (const float*)(base + GR_TAB);
            const int row0 = scan_row(b, dir, n * 64), sgn = dir ? -1 : 1;
            const bf16* vl = (const bf16*)(base + GR_V) + (4 * hh) * 64 + (c.wave & 1) * 32 + r;
            const unsigned ob = (unsigned)(((row0 + sgn * 4 * hh) * 512 + h * 128 + dvt * 32 + r) * 2); const int ostb = sgn * 1024;
            bf16x8 fr[3][4], tf[6]; bf16 vv[16];
            bf16x8 Rf[2][2], Vf[2][2];
            unsigned oK0 = GR_K, oK1 = GR_K + 8192, oQ0 = GR_Q, oQ1 = GR_Q + 8192; asm volatile("" : "+v"(oK0), "+v"(oK1), "+v"(oQ0), "+v"(oQ1));
#define GR_LD4(SLOT, KB) do { fr[SLOT][0] = gr_rowfrag(base + oK0, po, KB); fr[SLOT][1] = gr_rowfrag(base + oK1, po, KB); fr[SLOT][2] = gr_rowfrag(base + oQ0, po, KB); fr[SLOT][3] = gr_rowfrag(base + oQ1, po, KB); } while (0)
            GR_LD4(0, 0); GR_LD4(1, 1); GR_FENCE();
            f32x16 acc0, acc1, aq0, aq1;
#pragma unroll
            for (int i = 0; i < 16; ++i) { acc0[i] = 0.f; acc1[i] = 0.f; aq0[i] = 0.f; aq1[i] = 0.f; }
#pragma unroll
            for (int kb = 0; kb < 8; ++kb) {
                if (kb + 2 < 8) GR_LD4((kb + 2) % 3, kb + 2);
                else if (kb == 6) { tf[0] = GR_FRAG(GR_T, 0); tf[1] = GR_FRAG(GR_T, 1); tf[2] = GR_FRAG(GR_T, 4); tf[3] = GR_FRAG(GR_T, 5); tf[4] = GR_FRAG(GR_T, 6); tf[5] = GR_FRAG(GR_T, 7); }
                GR_FENCE();
                const bf16x8 sp = pack_step(S[kb >> 1], kb & 1);
                acc0 = MFMA32(fr[kb % 3][0], sp, acc0); acc1 = MFMA32(fr[kb % 3][1], sp, acc1); aq0 = MFMA32(fr[kb % 3][2], sp, aq0); aq1 = MFMA32(fr[kb % 3][3], sp, aq1); }
            GR_LOADV(vv, 0); GR_FENCE();
#pragma unroll
            for (int i = 0; i < 16; ++i) { const int s = crow16(i, hh); acc0[i] = tab[64 + s] * (bf1(vv[i]) - tab[128 + s] * acc0[i]); }
            Rf[0][0] = pack_step(acc0, 0); Rf[0][1] = pack_step(acc0, 1);
            GR_LOADV(vv, 1); GR_FENCE();
#pragma unroll
            for (int i = 0; i < 16; ++i) { const int s = 32 + crow16(i, hh); acc1[i] = tab[64 + s] * (bf1(vv[i]) - tab[128 + s] * acc1[i]); }
            Rf[1][0] = pack_step(acc1, 0); Rf[1][1] = pack_step(acc1, 1);
#pragma unroll
            for (int i = 0; i < 16; ++i) { acc0[i] = 0.f; acc1[i] = 0.f; }
            acc1 = MFMA32(tf[2], Rf[0][0], acc1); acc0 = MFMA32(tf[0], Rf[0][0], acc0); acc1 = MFMA32(tf[3], Rf[0][1], acc1); acc0 = MFMA32(tf[1], Rf[0][1], acc0);
            acc1 = MFMA32(tf[4], Rf[1][0], acc1); acc1 = MFMA32(tf[5], Rf[1][1], acc1);
            tf[0] = GR_FRAG(GR_A, 0); tf[1] = GR_FRAG(GR_A, 1); tf[2] = GR_FRAG(GR_A, 4); tf[3] = GR_FRAG(GR_A, 5); tf[4] = GR_FRAG(GR_A, 6); tf[5] = GR_FRAG(GR_A, 7); GR_FENCE();
#pragma unroll
            for (int i = 0; i < 16; ++i) { aq0[i] *= tab[128 + crow16(i, hh)]; aq1[i] *= tab[128 + 32 + crow16(i, hh)]; }
            Vf[0][0] = pack_step(acc0, 0); Vf[0][1] = pack_step(acc0, 1); Vf[1][0] = pack_step(acc1, 0); Vf[1][1] = pack_step(acc1, 1);
            aq1 = MFMA32(tf[2], Vf[0][0], aq1); aq0 = MFMA32(tf[0], Vf[0][0], aq0); aq1 = MFMA32(tf[3], Vf[0][1], aq1); aq0 = MFMA32(tf[1], Vf[0][1], aq0);
            aq1 = MFMA32(tf[4], Vf[1][0], aq1); aq1 = MFMA32(tf[5], Vf[1][1], aq1);
            if (n >= 4) {
#pragma unroll
                for (int i = 0; i < 16; i += 2) { const unsigned p0 = pk2(aq0[i], aq0[i + 1]), p1 = pk2(aq1[i], aq1[i + 1]); const int k0 = (i & 3) + 8 * (i >> 2);
                    unsigned char* ogb = (unsigned char*)OG;
                    *(bf16*)(ogb + (unsigned)(ob + (unsigned)(ostb * k0))) = (bf16)(p0 & 0xffffu); *(bf16*)(ogb + (unsigned)(ob + (unsigned)(ostb * (k0 + 1)))) = (bf16)(p0 >> 16);
                    *(bf16*)(ogb + (unsigned)(ob + (unsigned)(ostb * (32 + k0)))) = (bf16)(p1 & 0xffffu); *(bf16*)(ogb + (unsigned)(ob + (unsigned)(ostb * (33 + k0)))) = (bf16)(p1 >> 16); } }
            bf16x8 kd[16];
#pragma unroll
            for (int q = 0; q < 16; ++q) kd[q] = GR_FRAG(GR_KD, q);
            GR_FENCE();
            const float gtot = tab[128 + 63];
#pragma unroll
            for (int t = 0; t < 4; ++t) {
#pragma unroll
                for (int i = 0; i < 16; ++i) S[t][i] *= gtot; }
#pragma unroll
            for (int cb = 0; cb < 4; ++cb) {
#pragma unroll
                for (int t = 0; t < 4; ++t) S[t] = MFMA32(kd[t * 4 + cb], Vf[cb >> 1][cb & 1], S[t]); }
#undef GR_LD4
        }
        GR_STEP_BARRIER();
    }
    }
    asm volatile("s_waitcnt vmcnt(0)" ::: "memory"); __syncthreads();
#undef GR_STEP_BARRIER
#undef GR_FENCE
#undef GR_LOADROW
#undef GR_FRAG
#undef GR_LOADV
}
__device__ __forceinline__ void phase_gdn_rec(const Ctx& c) { if (c.bid < 128) gdn_rec_block(c, c.bid >> 1, c.bid & 1); }

#define XB_TMO      128
#define XB_XCNT(j)  (256  + 64 * (j))
#define XB_XSUB(j)  (1280 + 64 * (j))
#define XB_XGEN(j)  (2304 + 64 * (j))
#define XB_TOP      3328
#define XB_TOPGEN   3392
#define XCD_BAR_WORDS 3456
#define XB_SPIN_CAP (1u << 20)
__device__ __forceinline__ unsigned xb_ld(unsigned* p)              { return __hip_atomic_load(p, __ATOMIC_RELAXED, __HIP_MEMORY_SCOPE_AGENT); }
__device__ __forceinline__ unsigned xb_add(unsigned* p, unsigned v) { return __hip_atomic_fetch_add(p, v, __ATOMIC_RELAXED, __HIP_MEMORY_SCOPE_AGENT); }
__device__ __forceinline__ unsigned xb_xcc_id() { return (unsigned)__builtin_amdgcn_s_getreg((3 << 11) | 20) & 0xFu; }
#define XB_SPIN(cond, bar) do { unsigned _sp = 0; while (cond) { __builtin_amdgcn_s_sleep(1); \
    if ((++_sp & 255u) == 0u) { if (xb_ld(&(bar)[XB_TMO])) break; if (_sp > XB_SPIN_CAP) { atomicAdd(&(bar)[XB_TMO], 1u); break; } } } } while (0)
struct XcdBarrier { unsigned* bar; unsigned x; volatile LAS unsigned* st; };
__device__ __forceinline__ XcdBarrier xcd_barrier_post(unsigned* bar, volatile LAS unsigned* st) {
    XcdBarrier b; b.bar = bar; b.x = xb_xcc_id(); b.st = st;
    if (threadIdx.x == 0) (void)xb_add(&bar[XB_XCNT(b.x)], 1u);
    return b;
}
__device__ __forceinline__ void xcd_barrier_complete(unsigned* bar, unsigned x, unsigned& nloc, unsigned& nx) {
    const unsigned G = gridDim.x * gridDim.y * gridDim.z;
    unsigned sum, cnt, mine, sp = 0u;
    for (;;) {
        sum = 0u; cnt = 0u; mine = 0u;
#pragma unroll
        for (unsigned j = 0; j < 16; ++j) { const unsigned c = xb_ld(&bar[XB_XCNT(j)]); sum += c; cnt += (c > 0u) ? 1u : 0u; mine = (j == x) ? c : mine; }
        if (sum == G) break;
        __builtin_amdgcn_s_sleep(1);
        if ((++sp & 255u) == 0u) { if (xb_ld(&bar[XB_TMO])) break; if (sp > XB_SPIN_CAP) { atomicAdd(&bar[XB_TMO], 1u); break; } }
    }
    nloc = mine > 0u ? mine : 1u; nx = cnt > 0u ? cnt : 1u;
}
__device__ __forceinline__ void xcd_barrier(const XcdBarrier& b) {
    asm volatile("s_waitcnt vmcnt(0)" ::: "memory");
    __syncthreads();
    if (threadIdx.x == 0) {
        unsigned* bar = b.bar;
        __builtin_amdgcn_s_waitcnt(0);
        unsigned nloc = b.st[0], nx = b.st[1];
        if (nloc == 0u) { xcd_barrier_complete(bar, b.x, nloc, nx); b.st[0] = nloc; b.st[1] = nx; }
        const unsigned old = xb_add(&bar[XB_XSUB(b.x)], 1u);
        const unsigned gen = old / nloc;
        if (old + 1u == (gen + 1u) * nloc) {
            __builtin_amdgcn_fence(__ATOMIC_RELEASE, "agent");
            asm volatile("s_waitcnt vmcnt(0)" ::: "memory");
            const unsigned og = xb_add(&bar[XB_TOP], 1u);
            const unsigned tg = og / nx;
            if (og + 1u == (tg + 1u) * nx) xb_add(&bar[XB_TOPGEN], 1u);
            else XB_SPIN(xb_ld(&bar[XB_TOPGEN]) == tg, bar);
            __builtin_amdgcn_fence(__ATOMIC_ACQUIRE, "agent");
            xb_add(&bar[XB_XGEN(b.x)], 1u);
            asm volatile("s_waitcnt vmcnt(0)" ::: "memory");
        } else {
            XB_SPIN(xb_ld(&bar[XB_XGEN(b.x)]) == gen, bar);
            __builtin_amdgcn_fence(__ATOMIC_ACQUIRE, "agent");
            asm volatile("s_waitcnt vmcnt(0)" ::: "memory");
        }
    }
    __syncthreads();
}

constexpr int LDS_MISC = LDS_BYTES - 64;
__global__ void __launch_bounds__(NTHREADS, 2) mk_fwd(Args args) {
    extern __shared__ __attribute__((aligned(16))) unsigned char lds[];
    Ctx c; c.a = &args; c.ws = args.ws; c.lds = lds;
    c.tid = threadIdx.x; c.lane = c.tid & 63; c.wave = __builtin_amdgcn_readfirstlane(c.tid >> 6); c.bid = blockIdx.x; c.G = gridDim.x;
    c.gw = c.bid * NWAVES + c.wave; c.NGW = c.G * NWAVES; c.gwv = c.wave * c.G + c.bid;
    const int lo = args.ph_lo, hi = args.ph_hi;
    PG8_LAS unsigned char* ring = (PG8_LAS unsigned char*)lds;
#ifndef MK_PH_MASK
#define MK_PH_MASK 0xffff
#endif
#define IN(k) (((MK_PH_MASK >> (k)) & 1) && lo <= (k) && (k) < hi)
#if MK_ONE_LAUNCH
    cg::grid_group grid = cg::this_grid();
    if (lo < 0) grid.sync();
    volatile LAS unsigned* st = (volatile LAS unsigned*)((LAS unsigned char*)lds + LDS_MISC);
    if (c.tid < 2) st[c.tid] = 0u;
    __syncthreads();
    const XcdBarrier bar = xcd_barrier_post((unsigned*)(c.ws + WS_CTL) + CW_BAR, st);
#define SEAM(k) do { if (IN(k) && IN((k) + 1)) xcd_barrier(bar); } while (0)
#else
#define SEAM(k) do { } while (0)
#endif
    if (IN(0)) { phase_prep(c); phase_s5_build(c); } SEAM(0);
    if (IN(1)) { phase_norm1(c); } SEAM(1);
    if (IN(2)) { pg8::Gemm g{(const pg8::bf16_t*)(c.ws + WS_HX), (const pg8::bf16_t*)(c.ws + WS_WIN), 1024, 1024, 1024}; pg8::StaticOrder S; S.init(MT, NPROJ, c.G, c.bid);
        pg8::EpiInProj E{(pg8::bf16_t*)(c.ws + WS_U5), (pg8::bf16_t*)(c.ws + WS_QKVPRE), (pg8::bf16_t*)(c.ws + WS_Z)};
        pg8::gemm_phase<pg8::EpiInProj, pg8::StaticOrder, true, true>(ring, g, S, E); } SEAM(2);
    if (IN(3)) { { pg8::Gemm g{(const pg8::bf16_t*)(c.ws + WS_U5), (const pg8::bf16_t*)(c.ws + WS_PM), 768, 512, 512}; pg8::SchedSS S{c.G, c.bid}; pg8::EpiSS E{(float*)(c.ws + WS_SS)};
          pg8::gemm_phase<pg8::EpiSS, pg8::SchedSS, true, true>(ring, g, S, E); }
        __syncthreads(); phase_conv(c); } SEAM(3);
    if (IN(4)) { phase_gdn_prep(c); } SEAM(4);
    if (IN(5)) { pg8::Gemm g{(const pg8::bf16_t*)(c.ws + WS_U5), (const pg8::bf16_t*)(c.ws + WS_BB), 768, 768, 768}; pg8::SchedS5Y S{c.G, c.bid}; pg8::EpiS5Y E{(pg8::bf16_t*)(c.ws + WS_YG)};
        pg8::gemm_phase<pg8::EpiS5Y, pg8::SchedS5Y, true, true>(ring, g, S, E); } SEAM(5);
    if (IN(6)) { if (c.bid < 128) phase_gdn_rec(c);
        else { pg8::Gemm g{(const pg8::bf16_t*)(c.ws + WS_YG), (const pg8::bf16_t*)(c.ws + WS_WGLU), 512, 512, 512}; pg8::StaticOrder S; S.init(ML, 512, c.G - 128, c.bid - 128);
            pg8::EpiGlu E{(const pg8::bf16_t*)(c.ws + WS_YG), (pg8::bf16_t*)(c.ws + WS_CAT)};
            pg8::gemm_phase<pg8::EpiGlu, pg8::StaticOrder, true, true>(ring, g, S, E); } } SEAM(6);
    if (IN(7)) { phase_combine(c); } SEAM(7);
    if (IN(8)) { pg8::Gemm g{(const pg8::bf16_t*)(c.ws + WS_CAT), (const pg8::bf16_t*)(c.ws + WS_WOUT), 1024, 1024, 1024}; pg8::StaticOrder S; S.init(ML, 1024, c.G, c.bid);
        pg8::EpiBf16<0> E{(pg8::bf16_t*)(c.ws + WS_YRAW), 1024, nullptr, 0, 0, 1.f};
        pg8::gemm_phase<pg8::EpiBf16<0>, pg8::StaticOrder, true, true>(ring, g, S, E); } SEAM(8);
    if (IN(9)) { phase_rows2(c); phase_fp8_tables(c); } SEAM(9);
    if (IN(10)) { pg8::Gemm g{(const pg8::bf16_t*)(c.ws + WS_HX2), (const pg8::bf16_t*)(c.ws + WS_WQ), 1024, 1024, 1024}; pg8::StaticOrder S; S.init(ML, 2048, c.G, c.bid);
        pg8::EpiBf16<0> E{(pg8::bf16_t*)(c.ws + WS_QP), 2048, nullptr, 0, 0, 1.f};
        pg8::gemm_phase<pg8::EpiBf16<0>, pg8::StaticOrder, true, true>(ring, g, S, E); }
    if (IN(10) && IN(11)) { asm volatile("s_waitcnt vmcnt(0)" ::: "memory"); __syncthreads(); }
    if (IN(11)) { phase_topk(c, IN(10)); } SEAM(11);
    if (IN(12)) { phase_exp1(c); } SEAM(12);
    if (IN(13)) { phase_exp1b(c); } SEAM(13);
    if (IN(14)) { phase_exp2(c); } SEAM(14);
    if (IN(15)) { phase_exp3(c); }
#undef IN
#undef SEAM
}

extern "C" void kernel_launch(void* const* d_in, const int* in_sizes, int n_in, void* d_out, int out_size, void* d_ws, size_t ws_size, hipStream_t stream) {
    static int grid = 0;
    if (grid == 0) {
        if (n_in != 29 || out_size != ML * D || ws_size < WS_END) { fprintf(stderr, "kernel_launch: unexpected shapes (n_in %d out %d ws %zu)\n", n_in, out_size, ws_size); grid = -1; return; }
        int dev = 0, cus = 0, per_cu = 0;
        (void)hipGetDevice(&dev); (void)hipDeviceGetAttribute(&cus, hipDeviceAttributeMultiprocessorCount, dev);
        if (hipFuncSetAttribute((const void*)mk_fwd, hipFuncAttributeMaxDynamicSharedMemorySize, LDS_BYTES) != hipSuccess) { fprintf(stderr, "kernel_launch: hipFuncSetAttribute failed\n"); grid = -1; return; }
        (void)hipOccupancyMaxActiveBlocksPerMultiprocessor(&per_cu, (const void*)mk_fwd, NTHREADS, LDS_BYTES);
        (void)hipGetLastError();
        grid = cus;
        fprintf(stderr, "kernel_launch: cus %d per_cu %d grid %d\n", cus, per_cu, grid);
    }
    if (grid < 0) return;
    Args a{};
    for (int i = 0; i < 29; ++i) a.in[i] = (const float*)d_in[i];
    a.out = (float*)d_out; a.ws = (unsigned char*)d_ws;
    (void)hipMemsetAsync((char*)d_ws + WS_CTL, 0, CTL_ZERO_BYTES, stream);
#if MK_ONE_LAUNCH
    a.ph_lo = 0; a.ph_hi = NPHASES;
    void* kargs[] = {&a};
    hipError_t e = hipLaunchCooperativeKernel((const void*)mk_fwd, dim3(grid), dim3(NTHREADS), kargs, LDS_BYTES, stream);
    if (e != hipSuccess) fprintf(stderr, "kernel_launch: cooperative launch failed: %s\n", hipGetErrorString(e));
#else
    for (int ph = 0; ph < NPHASES; ++ph) { a.ph_lo = ph; a.ph_hi = ph + 1; hipLaunchKernelGGL(mk_fwd, dim3(grid), dim3(NTHREADS), LDS_BYTES, stream, a); }
#endif
}
```

```cpp
#include <hip/hip_runtime.h>
#include <hip/hip_cooperative_groups.h>
#include <cstdio>
#include <cstdint>
namespace cg = cooperative_groups;
namespace pg8 {
#define PG8_LAS __attribute__((address_space(3)))
typedef unsigned short bf16_t;
typedef short bf16x8 __attribute__((ext_vector_type(8)));
typedef float f32x4 __attribute__((ext_vector_type(4)));
typedef unsigned u32x4 __attribute__((ext_vector_type(4)));
constexpr int BM = 256, BK = 64, HALF = 128, HTB = HALF * BK * 2  , STAGE_BYTES = 8 * HTB, NXCD = 8, WGM = 8;

__host__ __device__ __forceinline__ int lds_byte(int r, int c) { const int st = (r >> 4) * 2 + (c >> 5), rr = r & 15, cc = c & 31, ob = rr * 64 + cc * 2; return st * 1024 + (ob ^ (((ob >> 9) & 1) << 5)); }
__host__ __device__ __forceinline__ void stage_rc(int b, int& R, int& C) { const int st = b / 1024, sb = b % 1024, swz = sb ^ (((sb >> 9) & 1) << 5); R = (st >> 1) * 16 + swz / 64; C = (st & 1) * 32 + (swz % 64) / 2; }
__host__ __device__ __forceinline__ int perm32(int rho) { const int n = rho >> 4, i = rho & 15; return 8 * (i >> 2) + 4 * n + (i & 3); }

struct Unit { int pm, pn; };
struct Gemm { const bf16_t* A; const bf16_t* Bt; int lda, ldb, K; };

struct StaticOrder {
    int nM, nN, nwg, G, c;
    __host__ __device__ void init(int M, int N, int G_, int c_) { nM = M / BM; nN = N / BM; nwg = nM * nN; G = G_; c = c_; }
    __host__ __device__ bool next(int i, Unit& u) const {
        const long L = (long)i * G + c; if (L >= nwg) return false;
        int wgid = (int)L; { const int q = nwg / NXCD, r = nwg % NXCD, xcd = wgid % NXCD, off = wgid / NXCD; wgid = (xcd < r ? xcd * (q + 1) : r * (q + 1) + (xcd - r) * q) + off; }
        const int nig = WGM * nN, gid = wgid / nig, fm = gid * WGM, gsz = (nM - fm) < WGM ? (nM - fm) : WGM;
        u.pm = fm + ((wgid % nig) % gsz); u.pn = (wgid % nig) / gsz; return true;
    }
    __device__ __forceinline__ void a_ready(const Unit&) const {}
    __device__ __forceinline__ void done(const Unit&) const {}
};

__device__ __forceinline__ unsigned cvt_pk_bf16(float lo, float hi) { unsigned r; asm volatile("v_cvt_pk_bf16_f32 %0, %1, %2" : "=v"(r) : "v"(lo), "v"(hi)); return r; }
typedef float f32x2 __attribute__((ext_vector_type(2)));
__device__ __forceinline__ f32x2 gelu_pk(f32x2 v) {
    const f32x2 av = __builtin_elementwise_abs(v), d = av * 0.2316418882f + 1.0f;
    f32x2 t; t.x = __builtin_amdgcn_rcpf(d.x); t.y = __builtin_amdgcn_rcpf(d.y);
    f32x2 q = t * 0.5307027145f + (-0.7265760135f); q = q * t + 0.7107068705f; q = q * t + (-0.142248368f); q = q * t + 0.127414796f; q = q * t;
    const f32x2 s = (v * v) * (-0.72134752044f);
    f32x2 e; e.x = __builtin_amdgcn_exp2f(s.x); e.y = __builtin_amdgcn_exp2f(s.y);
    const f32x2 m = v * (q * e), r = v - m;
    f32x2 o; o.x = v.x < 0.f ? m.x : r.x; o.y = v.y < 0.f ? m.y : r.y; return o;
}

template <int ACT  > struct EpiBf16 {
    static constexpr bool PERM = true, AFTER_DRAIN = false; static_assert(ACT == 0 || ACT == 1, "EpiBf16: ACT is 0 (none) or 1 (gelu_pk)");
    bf16_t* O; int ldc; const float* bias; int split_cols; size_t split_stride; float scale0;
    __device__ __forceinline__ void operator()(const f32x4 (&acc)[2][2][4][2], const Unit& u, int wr, int wc, int fr, int fq) const {
        const int row0 = u.pm * BM + wr * 64 + fr; int colt = u.pn * BM; bf16_t* base = O;
        float sc = 1.f; if (split_cols) { const int t = colt / split_cols; base += (size_t)t * split_stride; colt -= t * split_cols; if (t == 0) sc = scale0; }
        const int col0 = colt + wc * 32 + 8 * fq, bcol0 = u.pn * BM + wc * 32 + 8 * fq;
        f32x4 bv[2][2];
#pragma unroll
        for (int bj = 0; bj < 2; ++bj)
#pragma unroll
            for (int n = 0; n < 2; ++n) bv[bj][n] = bias ? *(const f32x4*)(bias + bcol0 + bj * HALF + 4 * n) : (f32x4){0.f, 0.f, 0.f, 0.f};
#pragma unroll
        for (int ai = 0; ai < 2; ++ai)
#pragma unroll
            for (int m = 0; m < 4; ++m) { bf16_t* rowp = base + (size_t)(row0 + ai * HALF + m * 16) * ldc + col0;
#pragma unroll
                for (int bj = 0; bj < 2; ++bj) { f32x4 v0 = acc[ai][bj][m][0] + bv[bj][0], v1 = acc[ai][bj][m][1] + bv[bj][1];
                    if (ACT == 1) { f32x2 a = gelu_pk((f32x2){v0[0], v0[1]}), b = gelu_pk((f32x2){v0[2], v0[3]}), c = gelu_pk((f32x2){v1[0], v1[1]}), d = gelu_pk((f32x2){v1[2], v1[3]});
                        v0 = (f32x4){a.x, a.y, b.x, b.y}; v1 = (f32x4){c.x, c.y, d.x, d.y}; }
                    v0 = v0 * sc; v1 = v1 * sc; u32x4 w; w.x = cvt_pk_bf16(v0[0], v0[1]); w.y = cvt_pk_bf16(v0[2], v0[3]); w.z = cvt_pk_bf16(v1[0], v1[1]); w.w = cvt_pk_bf16(v1[2], v1[3]);
                    *(u32x4*)(rowp + bj * HALF) = w; } }
    }
};

template <class Epi, class Sched, bool ALIGN_EPI = false, bool SP2 = false>
__device__ __forceinline__ void gemm_phase(PG8_LAS unsigned char* lds, const Gemm g, const Sched& S, const Epi& E) {
    const int tid = threadIdx.x, wid = __builtin_amdgcn_readfirstlane(tid >> 6), lane = tid & 63, wr = wid >> 2, wc = wid & 3, fr = lane & 15, fq = lane >> 4;
    const int K = g.K, nt = K / BK;
    unsigned voffA[2], voffB[2];
#pragma unroll
    for (int i = 0; i < 2; ++i) { int R, C; stage_rc(tid * 16 + i * 8192, R, C); const int Rb = Epi::PERM ? ((R & ~31) + perm32(R & 31)) : R;
        voffA[i] = (unsigned)(R * g.lda + C) * 2u; voffB[i] = (unsigned)(Rb * g.ldb + C) * 2u; }
    const size_t kstep = (size_t)(BK * 2);
    const size_t hstepA = (size_t)HALF * g.lda * 2, hstepB = (size_t)HALF * g.ldb * 2;
    const size_t tstepA = 2 * hstepA, tstepB = 2 * hstepB;
    const unsigned ldsw = (unsigned)wid * 1024u;
    const int aoff = lds_byte(wr * 64 + fr, fq * 8), boff = lds_byte(wc * 32 + fr, fq * 8);
#define PG8_SA(b, h) (((b) * 2 + (h)) * HTB)
#define PG8_SB(b, h) ((4 + (b) * 2 + (h)) * HTB)
#define PG8_STAGE(bufoff, gbase, voff) do { _Pragma("unroll") for (int _i = 0; _i < 2; ++_i) \
        __builtin_amdgcn_global_load_lds((const unsigned*)((const char*)(gbase) + (voff)[_i]), (PG8_LAS unsigned*)(lds + (bufoff) + ldsw + _i * 8192), 16, 0, 0); } while (0)
#define PG8_LDA(dst, b, h) do { _Pragma("unroll") for (int m = 0; m < 4; ++m) _Pragma("unroll") for (int k = 0; k < 2; ++k) dst[m][k] = *(const PG8_LAS bf16x8*)(lds + PG8_SA(b, h) + aoff + m * 2048 + k * 1024); } while (0)
#define PG8_LDB(dst, b, h) do { _Pragma("unroll") for (int n = 0; n < 2; ++n) _Pragma("unroll") for (int k = 0; k < 2; ++k) dst[n][k] = *(const PG8_LAS bf16x8*)(lds + PG8_SB(b, h) + boff + n * 2048 + k * 1024); } while (0)
#define PG8_MMA(ai, bj, At, Bt) do { __builtin_amdgcn_s_setprio(1); _Pragma("unroll") for (int m = 0; m < 4; ++m) _Pragma("unroll") for (int n = 0; n < 2; ++n) _Pragma("unroll") for (int k = 0; k < 2; ++k) \
        acc[ai][bj][m][n] = __builtin_amdgcn_mfma_f32_16x16x32_bf16(Bt[n][k], At[m][k], acc[ai][bj][m][n], 0, 0, 0); __builtin_amdgcn_s_setprio(0); } while (0)
#define PG8_WAIT_V(n) asm volatile("s_waitcnt vmcnt(" #n ")" ::: "memory")
#define PG8_WAIT_L(n) asm volatile("s_waitcnt lgkmcnt(" #n ")" ::: "memory")
#define PG8_BAR __builtin_amdgcn_s_barrier()
#define PG8_SCHED __builtin_amdgcn_sched_barrier(0)
    Unit cur, nxt; int ui = 0;
    if (!S.next(0, cur)) return;
    f32x4 acc[2][2][4][2];
#pragma unroll
    for (int a = 0; a < 2; ++a)
#pragma unroll
        for (int b = 0; b < 2; ++b)
#pragma unroll
            for (int m = 0; m < 4; ++m)
#pragma unroll
                for (int n = 0; n < 2; ++n) acc[a][b][m][n] = (f32x4){0.f, 0.f, 0.f, 0.f};
    bf16x8 At[4][2], B0[2][2], B1[2][2];
    const char* cA = (const char*)g.A + (size_t)cur.pm * tstepA; const char* cB = (const char*)g.Bt + (size_t)cur.pn * tstepB;
    S.a_ready(cur);
    if constexpr (SP2) {
        PG8_STAGE(PG8_SB(0, 0), cB, voffB); PG8_STAGE(PG8_SB(0, 1), cB + hstepB, voffB); PG8_STAGE(PG8_SA(0, 0), cA, voffA); PG8_STAGE(PG8_SA(0, 1), cA + hstepA, voffA);
        if (wr == 1) PG8_BAR;
        PG8_WAIT_V(2); PG8_BAR;
        PG8_STAGE(PG8_SB(1, 0), cB + kstep, voffB); PG8_STAGE(PG8_SA(1, 0), cA + kstep, voffA); PG8_STAGE(PG8_SB(1, 1), cB + hstepB + kstep, voffB);
        PG8_WAIT_V(6); PG8_BAR;
    } else {
        PG8_STAGE(PG8_SB(0, 0), cB, voffB); PG8_STAGE(PG8_SA(0, 0), cA, voffA); PG8_STAGE(PG8_SB(0, 1), cB + hstepB, voffB); PG8_STAGE(PG8_SA(0, 1), cA + hstepA, voffA);
        if (wr == 1) PG8_BAR;
        PG8_WAIT_V(4); PG8_BAR;
        PG8_STAGE(PG8_SB(1, 0), cB + kstep, voffB); PG8_STAGE(PG8_SA(1, 0), cA + kstep, voffA); PG8_STAGE(PG8_SB(1, 1), cB + hstepB + kstep, voffB);
        PG8_WAIT_V(6); PG8_BAR;
    }
    for (;;) {
        const bool has_next = S.next(ui + 1, nxt);
        const char* nA = has_next ? (const char*)g.A + (size_t)nxt.pm * tstepA : cA; const char* nB = has_next ? (const char*)g.Bt + (size_t)nxt.pn * tstepB : cB;
        for (int t = 0; t < nt; t += 2) {
            const bool last = (t == nt - 2);
            const char* a1 = cA + (size_t)(t + 1) * kstep;
            const char* a2 = last ? nA : cA + (size_t)(t + 2) * kstep; const char* b2 = last ? nB : cB + (size_t)(t + 2) * kstep;
            const char* a3 = a2 + kstep; const char* b3 = b2 + kstep;
            if (last && has_next) S.a_ready(nxt);
            if constexpr (SP2) {
            PG8_LDB(B0, 0, 0); PG8_LDB(B1, 0, 1); PG8_SCHED; PG8_LDA(At, 0, 0); PG8_STAGE(PG8_SA(1, 1), a1 + hstepA, voffA);
            PG8_WAIT_V(8); PG8_WAIT_L(0); PG8_BAR; PG8_MMA(0, 0, At, B0); PG8_MMA(0, 1, At, B1); PG8_BAR; PG8_SCHED;
            PG8_LDA(At, 0, 1); PG8_STAGE(PG8_SB(0, 0), b2, voffB); PG8_STAGE(PG8_SB(0, 1), b2 + hstepB, voffB); PG8_STAGE(PG8_SA(0, 0), a2, voffA);
            PG8_WAIT_V(8); PG8_WAIT_L(0); PG8_BAR; PG8_MMA(1, 0, At, B0); PG8_MMA(1, 1, At, B1); PG8_BAR; PG8_SCHED;
            PG8_LDB(B0, 1, 0); PG8_LDB(B1, 1, 1); PG8_SCHED; PG8_LDA(At, 1, 0); PG8_STAGE(PG8_SA(0, 1), a2 + hstepA, voffA);
            PG8_WAIT_V(8); PG8_WAIT_L(0); PG8_BAR; PG8_MMA(0, 0, At, B0); PG8_MMA(0, 1, At, B1); PG8_BAR; PG8_SCHED;
            PG8_LDA(At, 1, 1); PG8_STAGE(PG8_SB(1, 0), b3, voffB); PG8_STAGE(PG8_SB(1, 1), b3 + hstepB, voffB); PG8_STAGE(PG8_SA(1, 0), a3, voffA);
            PG8_WAIT_V(8); PG8_WAIT_L(0); PG8_BAR; PG8_MMA(1, 0, At, B0); PG8_MMA(1, 1, At, B1); PG8_BAR; PG8_SCHED;
            } else {
            PG8_LDB(B0, 0, 0); PG8_SCHED; PG8_LDA(At, 0, 0); PG8_STAGE(PG8_SA(1, 1), a1 + hstepA, voffA);
            PG8_WAIT_L(8); PG8_BAR; PG8_WAIT_L(0); PG8_MMA(0, 0, At, B0); PG8_BAR; PG8_SCHED;
            PG8_LDB(B1, 0, 1); PG8_STAGE(PG8_SB(0, 0), b2, voffB);
            PG8_BAR; PG8_WAIT_L(0); PG8_MMA(0, 1, At, B1); PG8_BAR;
            PG8_LDA(At, 0, 1); PG8_STAGE(PG8_SA(0, 0), a2, voffA);
            PG8_BAR; PG8_WAIT_L(0); PG8_MMA(1, 0, At, B0); PG8_BAR; PG8_SCHED;
            PG8_STAGE(PG8_SB(0, 1), b2 + hstepB, voffB);
            PG8_WAIT_V(6); PG8_BAR; PG8_MMA(1, 1, At, B1); PG8_BAR;
            PG8_LDB(B0, 1, 0); PG8_SCHED; PG8_LDA(At, 1, 0); PG8_STAGE(PG8_SA(0, 1), a2 + hstepA, voffA);
            PG8_WAIT_L(8); PG8_BAR; PG8_WAIT_L(0); PG8_MMA(0, 0, At, B0); PG8_BAR; PG8_SCHED;
            PG8_LDB(B1, 1, 1); PG8_STAGE(PG8_SB(1, 0), b3, voffB);
            PG8_BAR; PG8_WAIT_L(0); PG8_MMA(0, 1, At, B1); PG8_BAR;
            PG8_LDA(At, 1, 1); PG8_STAGE(PG8_SA(1, 0), a3, voffA);
            PG8_BAR; PG8_WAIT_L(0); PG8_MMA(1, 0, At, B0); PG8_BAR; PG8_SCHED;
            PG8_STAGE(PG8_SB(1, 1), b3 + hstepB, voffB);
            PG8_WAIT_V(6); PG8_BAR; PG8_MMA(1, 1, At, B1); PG8_BAR;
            }
        }
        if constexpr (ALIGN_EPI) { if (wr == 0) PG8_BAR; }
        if constexpr (!Epi::AFTER_DRAIN) { E(acc, cur, wr, wc, fr, fq); S.done(cur); }
        if (!has_next) break;
#pragma unroll
        for (int a = 0; a < 2; ++a)
#pragma unroll
            for (int b = 0; b < 2; ++b)
#pragma unroll
                for (int m = 0; m < 4; ++m)
#pragma unroll
                    for (int n = 0; n < 2; ++n) acc[a][b][m][n] = (f32x4){0.f, 0.f, 0.f, 0.f};
        cur = nxt; cA = nA; cB = nB; ++ui;
        if constexpr (ALIGN_EPI) { if (wr == 1) PG8_BAR; }
    }
    PG8_WAIT_V(0);
    if constexpr (!ALIGN_EPI) { if (wr == 0) PG8_BAR; }
    PG8_BAR;
    if constexpr (Epi::AFTER_DRAIN) { E.fused(acc, cur, wr, wc, fr, fq, lds, wid, lane); S.done(cur); }
#undef PG8_SA
#undef PG8_SB
#undef PG8_STAGE
#undef PG8_LDA
#undef PG8_LDB
#undef PG8_MMA
#undef PG8_WAIT_V
#undef PG8_WAIT_L
#undef PG8_BAR
#undef PG8_SCHED
}
}

#ifndef MK_EXP_OLD
#define MK_EXP_OLD 0
#endif
#ifndef MK_ONE_LAUNCH
#define MK_ONE_LAUNCH 1
#endif
#define LAS __attribute__((address_space(3)))
typedef unsigned short bf16;
typedef unsigned v4u __attribute__((ext_vector_type(4)));
typedef unsigned v2u __attribute__((ext_vector_type(2)));
typedef float f32x4 __attribute__((ext_vector_type(4)));
typedef float f32x2 __attribute__((ext_vector_type(2)));
typedef short bf16x8 __attribute__((ext_vector_type(8)));
typedef float f32x16 __attribute__((ext_vector_type(16)));
#define MFMA32(a, b, c) __builtin_amdgcn_mfma_f32_32x32x16_bf16((a), (b), (c), 0, 0, 0)

constexpr int D = 1024, NB = 8, SEQ = 2048, LC = 256, ML = NB * SEQ  , MC = NB * LC  , MT = ML + MC  ;
constexpr int PROJ = 2576, NPROJ = 2560;
constexpr int NEXP = 16384, TOPK = 16, KK = 128;
constexpr float EPS = 1e-6f;
constexpr int NTHREADS = 512, NWAVES = 8;
constexpr int LDS_BYTES = 151552;
constexpr int NPHASES = 16;

constexpr size_t MiB = 1u << 20;
constexpr size_t WS_CTL = 0;
constexpr size_t CTL_ZERO_BYTES = 65536;
constexpr int CW_BAR = 0;
constexpr int CW_E1 = 4096, CW_E2 = 4096 + 8 * 64;
constexpr size_t WS_MOD = 1 * MiB;
constexpr size_t WS_LP = 1 * MiB + 512 * 1024;
constexpr size_t WS_WIN = 2 * MiB;
constexpr size_t WS_WOUT = 8 * MiB;
constexpr size_t WS_WGLU = 10 * MiB;
constexpr size_t WS_WQ = 11 * MiB;
constexpr size_t WS_GB = 15 * MiB;
constexpr size_t WS_BB = 17 * MiB;
constexpr size_t WS_PM = 41 * MiB;
constexpr size_t WS_OG = 17 * MiB;
constexpr size_t WS_HX2 = 17 * MiB;
constexpr size_t WS_U5 = 49 * MiB;
constexpr size_t WS_CAT = 49 * MiB;
constexpr size_t WS_IDX = 49 * MiB;
constexpr size_t WS_GATE = 57 * MiB;
constexpr size_t WS_ACT = 65 * MiB;
constexpr size_t WS_SSQP = 73 * MiB;
constexpr size_t WS_Z = 85 * MiB;
constexpr size_t WS_YRAW = 85 * MiB;
constexpr size_t WS_QP = 85 * MiB;
constexpr size_t WS_Y = 85 * MiB;
constexpr size_t WS_HX = 101 * MiB;
constexpr size_t WS_SS = 101 * MiB;
constexpr size_t WS_YG = 101 * MiB;
constexpr size_t WS_FRT = 125 * MiB;
constexpr size_t WS_QKVPRE = 137 * MiB;
constexpr size_t WS_FRA = 143 * MiB;
constexpr size_t WS_FRK = 161 * MiB;
constexpr size_t WS_FRTAB = 197 * MiB;
constexpr size_t WS_QKV = 202 * MiB;
constexpr size_t WS_U8 = 202 * MiB;
constexpr size_t WS_V8 = 218 * MiB;
constexpr size_t WS_USC = 234 * MiB;
constexpr size_t WS_VSC = 234 * MiB + 512 * 1024;
constexpr size_t WS_HQ8 = 150 * MiB;
constexpr size_t WS_HS = 183 * MiB;
constexpr size_t WS_PACT = 85 * MiB;
constexpr size_t WS_X1A = 184 * MiB;
constexpr size_t WS_X1B = 236 * MiB;
constexpr size_t WS_END = 256 * MiB;
static_assert(WS_BB + (size_t)32 * 512 * 768 * 2 <= WS_PM && WS_PM + (size_t)32 * 256 * 512 * 2 <= WS_U5 && WS_U5 + (size_t)32 * 768 * 768 * 2 <= WS_Z && WS_Z + (size_t)ML * 512 * 2 <= WS_HX, "ws map a");
static_assert(WS_HX + (size_t)MT * D * 2 <= WS_QKVPRE && WS_SS + (size_t)32 * 768 * 256 * 4 <= WS_FRT && WS_QKVPRE + (size_t)MT * 1536 * 2 <= WS_QKV && WS_QKV + (size_t)MT * 1536 * 2 <= WS_END, "ws map b");
static_assert(WS_FRT + (size_t)2304 * 8192 <= WS_FRA && WS_FRA + (size_t)2304 * 8192 <= WS_FRK && WS_FRK + (size_t)2304 * 16384 <= WS_FRTAB && WS_FRTAB + (size_t)2304 * 1024 <= WS_QKV, "ws map c");
static_assert(WS_OG + (size_t)2 * ML * 512 * 2 <= WS_CAT && WS_CAT + (size_t)ML * D * 2 <= WS_Z && WS_YRAW + (size_t)ML * D * 4 <= WS_U8 && WS_SSQP + (size_t)8 * ML * 4 <= WS_Z && WS_YG + (size_t)ML * 512 * 2 <= WS_FRT, "ws map d");

__device__ __forceinline__ unsigned f2bf(float f) { unsigned u = __builtin_bit_cast(unsigned, f); return (u + 0x7fffu + ((u >> 16) & 1u)) >> 16; }
typedef __bf16 bf16x2_t __attribute__((ext_vector_type(2)));
__device__ __forceinline__ unsigned pk2(float lo, float hi) { const f32x2 v = {lo, hi}; return __builtin_bit_cast(unsigned, __builtin_convertvector(v, bf16x2_t)); }
__device__ __forceinline__ float bflo(unsigned w) { return __builtin_bit_cast(float, w << 16); }
__device__ __forceinline__ float bfhi(unsigned w) { return __builtin_bit_cast(float, w & 0xffff0000u); }
__device__ __forceinline__ float bf1(bf16 h) { return __builtin_bit_cast(float, (unsigned)h << 16); }
__device__ __forceinline__ float wave_sum(float v) {
#pragma unroll
    for (int o = 1; o < 64; o <<= 1) v += __shfl_xor(v, o);
    return v;
}
__device__ __forceinline__ float wave_max(float v) {
#pragma unroll
    for (int o = 1; o < 64; o <<= 1) v = fmaxf(v, __shfl_xor(v, o));
    return v;
}
__device__ __forceinline__ float sigmoidf_(float x) { return __builtin_amdgcn_rcpf(1.f + __expf(-x)); }
__device__ __forceinline__ float siluf_(float x) { return x * __builtin_amdgcn_rcpf(1.f + __expf(-x)); }
__device__ __forceinline__ float gelu_erf(float x) { return 0.5f * x * (1.f + erff(x * 0.70710678118654752f)); }
__device__ __forceinline__ void sincos_d(double a, float& s, float& c) {
    const double k = rint(a * 0.63661977236758134308);
    const double r = fma(-k, 1.57079632679489661923, a) - k * 6.123233995736766e-17;
    const double r2 = r * r;
    double sp = -2.5052108385441720e-08; sp = sp * r2 + 2.7557319223985893e-06; sp = sp * r2 - 1.9841269841269841e-04; sp = sp * r2 + 8.3333333333333332e-03; sp = sp * r2 - 1.6666666666666666e-01;
    const double sn = r + r * r2 * sp;
    double cp = 2.0876756987868099e-09; cp = cp * r2 - 2.7557319223985888e-07; cp = cp * r2 + 2.4801587301587302e-05; cp = cp * r2 - 1.3888888888888889e-03; cp = cp * r2 + 4.1666666666666664e-02; cp = cp * r2 - 0.5;
    const double cs = 1.0 + r2 * cp;
    const int q = ((int)k) & 3;
    const double ss = (q == 0) ? sn : (q == 1) ? cs : (q == 2) ? -sn : -cs;
    const double cc = (q == 0) ? cs : (q == 1) ? -sn : (q == 2) ? -cs : sn;
    s = (float)ss; c = (float)cc;
}

struct Args { const float* in[29]; float* out; unsigned char* ws; int ph_lo, ph_hi; };
static_assert(sizeof(Args) == 29 * 8 + 8 + 8 + 8, "Args has no padding");
enum { I_X = 0, I_C, I_CTX, I_CCTX, I_WMOD, I_BMOD, I_GPREMIX, I_GPOSTMIX, I_GPREFFN, I_GPOSTFFN, I_WIN, I_WOUT, I_LAMRE, I_LAMIM, I_LOGDT, I_BRE, I_BIM, I_CRE, I_CIM, I_S5D, I_WGLU,
       I_CONV, I_ALOG, I_DTBIAS, I_GDNNORM, I_WQ, I_KEYS, I_PU, I_PV };

__device__ __forceinline__ const float* in_row(const Args& a, int row) { return row < ML ? a.in[I_X] + (size_t)row * D : a.in[I_CTX] + (size_t)(row - ML) * D; }
__device__ __forceinline__ int mod_row(int row) { return row < ML ? (row >> 11) : 8; }

template <int CTRL> __device__ __forceinline__ float dppf(float v) { return __builtin_bit_cast(float, __builtin_amdgcn_update_dpp(0, __builtin_bit_cast(int, v), CTRL, 0xf, 0xf, true)); }
__device__ __forceinline__ float row_sum16(float v) { v += dppf<0xB1>(v); v += dppf<0x4E>(v); v += dppf<0x141>(v); v += dppf<0x140>(v); return v; }
__device__ __forceinline__ float row_max16(float v) { v = fmaxf(v, dppf<0xB1>(v)); v = fmaxf(v, dppf<0x4E>(v)); v = fmaxf(v, dppf<0x141>(v)); v = fmaxf(v, dppf<0x140>(v)); return v; }
__device__ __forceinline__ float wsum(float v) { v = row_sum16(v); return
    __builtin_bit_cast(float, __builtin_amdgcn_readlane(__builtin_bit_cast(int, v), 0)) + __builtin_bit_cast(float, __builtin_amdgcn_readlane(__builtin_bit_cast(int, v), 16)) +
    __builtin_bit_cast(float, __builtin_amdgcn_readlane(__builtin_bit_cast(int, v), 32)) + __builtin_bit_cast(float, __builtin_amdgcn_readlane(__builtin_bit_cast(int, v), 48)); }
__device__ __forceinline__ float wmax(float v) { v = row_max16(v); return fmaxf(fmaxf(__builtin_bit_cast(float, __builtin_amdgcn_readlane(__builtin_bit_cast(int, v), 0)), __builtin_bit_cast(float, __builtin_amdgcn_readlane(__builtin_bit_cast(int, v), 16))),
    fmaxf(__builtin_bit_cast(float, __builtin_amdgcn_readlane(__builtin_bit_cast(int, v), 32)), __builtin_bit_cast(float, __builtin_amdgcn_readlane(__builtin_bit_cast(int, v), 48)))); }
__device__ __forceinline__ int lane_rank(unsigned long long m) { return __builtin_amdgcn_mbcnt_hi((unsigned)(m >> 32), __builtin_amdgcn_mbcnt_lo((unsigned)m, 0)); }
__device__ __forceinline__ unsigned fkey(float f) { const unsigned u = __builtin_bit_cast(unsigned, f); return u ^ ((unsigned)((int)u >> 31) | 0x80000000u); }
#define WAVE_LDS_SYNC() do { __builtin_amdgcn_fence(__ATOMIC_RELEASE, "wavefront"); __builtin_amdgcn_wave_barrier(); __builtin_amdgcn_fence(__ATOMIC_ACQUIRE, "wavefront"); } while (0)
template <int N> __device__ __forceinline__ unsigned kth_key(const unsigned (&k)[N], int K) {
    unsigned T = 0;
    for (int bit = 31; bit >= 0; --bit) { const unsigned cand = T | (1u << bit); int cnt = 0;
#pragma unroll
        for (int n = 0; n < N; ++n) cnt += __popcll(__ballot(k[n] >= cand));
        if (cnt >= K) T = cand;
        if (cnt == K) break; }
    return T;
}

namespace pg8 {
struct EpiInProj {
    static constexpr bool PERM = true, AFTER_DRAIN = false;
    bf16_t* U; bf16_t* QKV; bf16_t* Z;
    __device__ __forceinline__ void operator()(const f32x4 (&acc)[2][2][4][2], const Unit& u, int wr, int wc, int fr, int fq) const {
        bf16_t* base; int ld, colt; bool lat_only = false;
        const bool s5 = u.pn < 2;
        if (s5) { base = U; ld = 0; colt = u.pn * BM; }
        else if (u.pn < 8) { base = QKV; ld = 1536; colt = (u.pn - 2) * BM; }
        else { base = Z; ld = 512; colt = (u.pn - 8) * BM; lat_only = true; }
        const int row0 = u.pm * BM + wr * 64 + fr, col0 = colt + wc * 32 + 8 * fq;
#pragma unroll
        for (int ai = 0; ai < 2; ++ai)
#pragma unroll
            for (int m = 0; m < 4; ++m) { const int row = row0 + ai * HALF + m * 16; bf16_t* rowp = base + (size_t)row * ld + col0;
                if (lat_only && row >= 16384) continue;
                if (s5) { const int R = row < 16384 ? (row >> 5) : 512 + ((row - 16384) >> 5), ii = row & 31; rowp = base + (size_t)R * 768 + ii * 16 + (col0 & 15); }
#pragma unroll
                for (int bj = 0; bj < 2; ++bj) { const f32x4 v0 = acc[ai][bj][m][0], v1 = acc[ai][bj][m][1];
                    u32x4 w; w.x = cvt_pk_bf16(v0[0], v0[1]); w.y = cvt_pk_bf16(v0[2], v0[3]); w.z = cvt_pk_bf16(v1[0], v1[1]); w.w = cvt_pk_bf16(v1[2], v1[3]);
                    if (s5) *(u32x4*)(rowp + (size_t)((col0 + bj * HALF) >> 4) * (768 * 768)) = w; else *(u32x4*)(rowp + bj * HALF) = w; } }
    }
};
struct EpiGlu {
    static constexpr bool PERM = true, AFTER_DRAIN = false;
    const bf16_t* YG; bf16_t* CAT;
    __device__ __forceinline__ void operator()(const f32x4 (&acc)[2][2][4][2], const Unit& u, int wr, int wc, int fr, int fq) const {
        const int row0 = u.pm * BM + wr * 64 + fr, col0 = u.pn * BM + wc * 32 + 8 * fq;
#pragma unroll
        for (int ai = 0; ai < 2; ++ai)
#pragma unroll
            for (int m = 0; m < 4; ++m) { const int row = row0 + ai * HALF + m * 16;
#pragma unroll
                for (int bj = 0; bj < 2; ++bj) { const f32x4 v0 = acc[ai][bj][m][0], v1 = acc[ai][bj][m][1];
                    const u32x4 y = *(const u32x4*)(YG + (size_t)row * 512 + col0 + bj * HALF);
                    float o[8]; const float a[8] = {v0[0], v0[1], v0[2], v0[3], v1[0], v1[1], v1[2], v1[3]};
                    const unsigned yw[4] = {y.x, y.y, y.z, y.w};
#pragma unroll
                    for (int e = 0; e < 8; ++e) { const float yv = __builtin_bit_cast(float, (e & 1) ? (yw[e >> 1] & 0xffff0000u) : (yw[e >> 1] << 16)); o[e] = yv * __builtin_amdgcn_rcpf(1.f + __expf(-a[e])); }
                    u32x4 w; w.x = cvt_pk_bf16(o[0], o[1]); w.y = cvt_pk_bf16(o[2], o[3]); w.z = cvt_pk_bf16(o[4], o[5]); w.w = cvt_pk_bf16(o[6], o[7]);
                    *(u32x4*)(CAT + (size_t)row * 1024 + col0 + bj * HALF) = w; } }
    }
};
struct EpiF32 {
    static constexpr bool PERM = false, AFTER_DRAIN = false;
    float* C; int ldc;
    __device__ __forceinline__ void operator()(const f32x4 (&acc)[2][2][4][2], const Unit& u, int wr, int wc, int fr, int fq) const {
        const int row0 = u.pm * BM + wr * 64 + fr, col0 = u.pn * BM + wc * 32 + 4 * fq;
#pragma unroll
        for (int ai = 0; ai < 2; ++ai)
#pragma unroll
            for (int m = 0; m < 4; ++m) { float* rowp = C + (size_t)(row0 + ai * HALF + m * 16) * ldc + col0;
#pragma unroll
                for (int bj = 0; bj < 2; ++bj)
#pragma unroll
                    for (int n = 0; n < 2; ++n) *(f32x4*)(rowp + bj * HALF + n * 16) = acc[ai][bj][m][n]; }
    }
};
struct EpiSS {
    static constexpr bool PERM = false, AFTER_DRAIN = false;
    float* C;
    __device__ __forceinline__ void operator()(const f32x4 (&acc)[2][2][4][2], const Unit& u, int wr, int wc, int fr, int fq) const {
        const int row0 = u.pm * BM + wr * 64 + fr, col0 = wc * 32 + 4 * fq;
#pragma unroll
        for (int ai = 0; ai < 2; ++ai)
#pragma unroll
            for (int m = 0; m < 4; ++m) { float* rowp = C + (size_t)(row0 + ai * HALF + m * 16) * 256 + col0;
#pragma unroll
                for (int bj = 0; bj < 2; ++bj)
#pragma unroll
                    for (int n = 0; n < 2; ++n) *(f32x4*)(rowp + bj * HALF + n * 16) = acc[ai][bj][m][n]; }
    }
};
struct SchedSS { int G, c; __device__ bool next(int i, Unit& u) const { const int L = i * G + c; if (L >= 96) return false; u.pm = L; u.pn = L / 3; return true; }
    __device__ __forceinline__ void a_ready(const Unit&) const {} __device__ __forceinline__ void done(const Unit&) const {} };
struct EpiS5Y {
    static constexpr bool PERM = true, AFTER_DRAIN = false;
    bf16_t* YG;
    __device__ __forceinline__ void operator()(const f32x4 (&acc)[2][2][4][2], const Unit& u, int wr, int wc, int fr, int fq) const {
        const int g = u.pn >> 1, R0 = (u.pm - 3 * g) * BM + wr * 64 + fr, n0 = (u.pn & 1) * BM + wc * 32 + 8 * fq;
#pragma unroll
        for (int ai = 0; ai < 2; ++ai)
#pragma unroll
            for (int m = 0; m < 4; ++m) { const int R = R0 + ai * HALF + m * 16;
#pragma unroll
                for (int bj = 0; bj < 2; ++bj) { const int n = n0 + bj * HALF; const f32x4 v0 = acc[ai][bj][m][0], v1 = acc[ai][bj][m][1];
                    const f32x2 a = gelu_pk((f32x2){v0[0], v0[1]}), b = gelu_pk((f32x2){v0[2], v0[3]}), c2 = gelu_pk((f32x2){v1[0], v1[1]}), d = gelu_pk((f32x2){v1[2], v1[3]});
                    u32x4 w; w.x = cvt_pk_bf16(a.x, a.y); w.y = cvt_pk_bf16(b.x, b.y); w.z = cvt_pk_bf16(c2.x, c2.y); w.w = cvt_pk_bf16(d.x, d.y);
                    *(u32x4*)(YG + (size_t)(R * 32 + (n >> 4)) * 512 + g * 16 + (n & 15)) = w; } }
    }
};
struct SchedS5Y { int G, c; __device__ bool next(int i, Unit& u) const { const int L = i * G + c; if (L >= 128) return false; const int g = L >> 2; u.pm = 3 * g + ((L >> 1) & 1); u.pn = 2 * g + (L & 1); return true; }
    __device__ __forceinline__ void a_ready(const Unit&) const {} __device__ __forceinline__ void done(const Unit&) const {} };
}

struct Ctx { const Args* a; unsigned char* ws; unsigned char* lds; int tid, lane, wave, bid, G, gw, NGW, gwv; };

__device__ __forceinline__ void p0_transpose_item(const float* W, int ldw, int nblk, int K, bf16* WT, float* scr, int item, int lane) {
    const int kb = item / nblk, nb = item % nblk, k0 = 64 * kb, n0 = 32 * nb;
    float wv[32];
#pragma unroll
    for (int i = 0; i < 32; ++i) { const int kk = 2 * i + (lane >> 5); wv[i] = W[(size_t)(k0 + kk) * ldw + n0 + (lane & 31)]; }
#pragma unroll
    for (int i = 0; i < 32; ++i) { const int kk = 2 * i + (lane >> 5); scr[kk * 33 + (lane & 31)] = wv[i]; }
    __builtin_amdgcn_fence(__ATOMIC_RELEASE, "wavefront"); __builtin_amdgcn_wave_barrier(); __builtin_amdgcn_fence(__ATOMIC_ACQUIRE, "wavefront");
    const int c = lane & 7;
#pragma unroll
    for (int j = 0; j < 4; ++j) { const int n = (lane >> 3) + 8 * j; const float* s = scr + (8 * c) * 33 + n;
        v4u o; o.x = pk2(s[0 * 33], s[1 * 33]); o.y = pk2(s[2 * 33], s[3 * 33]); o.z = pk2(s[4 * 33], s[5 * 33]); o.w = pk2(s[6 * 33], s[7 * 33]);
        *(v4u*)(WT + (size_t)(n0 + n) * K + k0 + 8 * c) = o; }
    __builtin_amdgcn_fence(__ATOMIC_RELEASE, "wavefront"); __builtin_amdgcn_wave_barrier(); __builtin_amdgcn_fence(__ATOMIC_ACQUIRE, "wavefront");
}
__device__ __forceinline__ void phase_prep(const Ctx& c) {
    const Args& a = *c.a;
    float* scr = (float*)(c.lds + c.wave * 16384);
    constexpr int I_IN = 16 * 80, I_OUT = 16 * 32, I_GLU = 8 * 16, I_Q = 16 * 64;
    for (int it = c.gw; it < I_IN + I_OUT + I_GLU + I_Q; it += c.NGW) {
        int r = it;
        if (r < I_IN) { p0_transpose_item(a.in[I_WIN], PROJ, 80, 1024, (bf16*)(c.ws + WS_WIN), scr, r, c.lane); continue; } r -= I_IN;
        if (r < I_OUT) { p0_transpose_item(a.in[I_WOUT], 1024, 32, 1024, (bf16*)(c.ws + WS_WOUT), scr, r, c.lane); continue; } r -= I_OUT;
        if (r < I_GLU) { p0_transpose_item(a.in[I_WGLU], 512, 16, 512, (bf16*)(c.ws + WS_WGLU), scr, r, c.lane); continue; } r -= I_GLU;
        p0_transpose_item(a.in[I_WQ], 2048, 64, 1024, (bf16*)(c.ws + WS_WQ), scr, r, c.lane);
    }
    __syncthreads();
    float* sc = (float*)c.lds;
    float* red = (float*)(c.lds + 9 * 1024 * 4);
    float* MOD = (float*)(c.ws + WS_MOD);
    bool have = false;
    for (int item = c.bid; item < 96; item += c.G) {
        if (!have) { for (int i = c.tid; i < 9 * 1024; i += NTHREADS) { const int r = i >> 10, k = i & 1023; const float v = r < 8 ? a.in[I_C][r * 1024 + k] : a.in[I_CCTX][k]; sc[i] = siluf_(v); } have = true; __syncthreads(); }
        const int n0 = item * 64;
        float acc[9];
#pragma unroll
        for (int r = 0; r < 9; ++r) acc[r] = 0.f;
        const float* wp = a.in[I_WMOD] + (size_t)(c.wave * 128) * 6144 + n0 + c.lane;
#pragma unroll 64
        for (int k = 0; k < 128; ++k) { const float w = wp[(size_t)k * 6144];
#pragma unroll
            for (int r = 0; r < 9; ++r) acc[r] = fmaf(sc[r * 1024 + c.wave * 128 + k], w, acc[r]); }
#pragma unroll
        for (int r = 0; r < 9; ++r) red[(c.wave * 9 + r) * 64 + c.lane] = acc[r];
        __syncthreads();
        for (int i = c.tid; i < 576; i += NTHREADS) { const int r = i >> 6, l = i & 63; float s = a.in[I_BMOD][n0 + l];
#pragma unroll
            for (int w = 0; w < 8; ++w) s += red[(w * 9 + r) * 64 + l];
            MOD[r * 6144 + n0 + l] = s; }
        __syncthreads();
    }
}
__device__ __forceinline__ void s5_build_group(const Ctx& c, int g, int part);
__device__ __forceinline__ void phase_s5_build(const Ctx& c) { for (int it = c.G - 1 - c.bid; it < 128; it += c.G) if (it >= 0) s5_build_group(c, it >> 2, it & 3); }

__device__ __forceinline__ void phase_norm1(const Ctx& c) {
    const Args& a = *c.a;
    float* wabT = (float*)c.lds;
    { f32x4 wv[8];
#pragma unroll
      for (int q = 0; q < 8; ++q) { const int i = c.tid + NTHREADS * q, kk = i >> 2, qq = i & 3; wv[q] = *(const f32x4*)(a.in[I_WIN] + (size_t)kk * PROJ + NPROJ + 4 * qq); }
#pragma unroll
      for (int q = 0; q < 8; ++q) { const int i = c.tid + NTHREADS * q, kk = i >> 2, qq = i & 3; wabT[(4 * qq + 0) * 1028 + kk] = wv[q].x; wabT[(4 * qq + 1) * 1028 + kk] = wv[q].y; wabT[(4 * qq + 2) * 1028 + kk] = wv[q].z; wabT[(4 * qq + 3) * 1028 + kk] = wv[q].w; } }
    __syncthreads();
    const float* MOD = (const float*)(c.ws + WS_MOD);
    bf16* HX = (bf16*)(c.ws + WS_HX); float* GB = (float*)(c.ws + WS_GB);
    const float* gpre = a.in[I_GPREMIX];
    f32x4 nx[4], g4c[4];
#pragma unroll
    for (int j = 0; j < 4; ++j) g4c[j] = *(const f32x4*)(gpre + 4 * c.lane + 256 * j);
    if (c.gw < MT) { const f32x4* xr = (const f32x4*)in_row(a, c.gw) + c.lane;
#pragma unroll
        for (int j = 0; j < 4; ++j) nx[j] = xr[64 * j]; }
    for (int row = c.gw; row < MT; row += c.NGW) {
        const float* mr = MOD + mod_row(row) * 6144;
        f32x4 shv[4], sclv[4];
#pragma unroll
        for (int j = 0; j < 4; ++j) { shv[j] = *(const f32x4*)(mr + 4 * c.lane + 256 * j); sclv[j] = *(const f32x4*)(mr + 1024 + 4 * c.lane + 256 * j); }
        f32x4 v[4]; float ss = 0.f;
#pragma unroll
        for (int j = 0; j < 4; ++j) { v[j] = nx[j]; ss += (v[j].x * v[j].x + v[j].y * v[j].y) + (v[j].z * v[j].z + v[j].w * v[j].w); }
        if (row + c.NGW < MT) { const f32x4* xr = (const f32x4*)in_row(a, row + c.NGW) + c.lane;
#pragma unroll
            for (int j = 0; j < 4; ++j) nx[j] = xr[64 * j]; }
        const float r = rsqrtf(wsum(ss) * (1.f / D) + EPS);
#pragma unroll
        for (int j = 0; j < 4; ++j) { const int col = 4 * c.lane + 256 * j;
            v[j] = (v[j] * r) * g4c[j] * (sclv[j] + 1.f) + shv[j];
            v2u o; o.x = pk2(v[j].x, v[j].y); o.y = pk2(v[j].z, v[j].w);
            *(v2u*)(HX + (size_t)row * D + col) = o; }
        float pj[16];
#pragma unroll
        for (int j = 0; j < 16; ++j) { float s = 0.f;
#pragma unroll
            for (int jj = 0; jj < 4; ++jj) { const f32x4 w = *(const f32x4*)(wabT + j * 1028 + 4 * c.lane + 256 * jj); s += (v[jj].x * w.x + v[jj].y * w.y) + (v[jj].z * w.z + v[jj].w * w.w); }
            pj[j] = s; if ((j & 1) == 1) asm volatile("" ::: "memory"); }
        const bool b5 = c.lane & 32, b4 = c.lane & 16, b3 = c.lane & 8, b2 = c.lane & 4;
        float q8[8], q4[4], q2[2];
#pragma unroll
        for (int i = 0; i < 8; ++i) { const float keep = b5 ? pj[i + 8] : pj[i], send = b5 ? pj[i] : pj[i + 8]; q8[i] = keep + __shfl_xor(send, 32); }
#pragma unroll
        for (int i = 0; i < 4; ++i) { const float keep = b4 ? q8[i + 4] : q8[i], send = b4 ? q8[i] : q8[i + 4]; q4[i] = keep + __shfl_xor(send, 16); }
#pragma unroll
        for (int i = 0; i < 2; ++i) { const float keep = b3 ? q4[i + 2] : q4[i], send = b3 ? q4[i] : q4[i + 2]; q2[i] = keep + dppf<0x140>(send); }
        float mine; { const float keep = b2 ? q2[1] : q2[0], send = b2 ? q2[0] : q2[1]; mine = keep + dppf<0x141>(send); }
        mine += dppf<0xB1>(mine); mine += dppf<0x4E>(mine);
        const int jl = (b5 ? 8 : 0) + (b4 ? 4 : 0) + (b3 ? 2 : 0) + (b2 ? 1 : 0);
        if ((c.lane & 3) == 0) {
            if (jl < 8) { const float t = mine + a.in[I_DTBIAS][jl]; const float sp = t > 20.f ? t : log1pf(expf(t)); GB[(size_t)row * 16 + jl] = -expf(a.in[I_ALOG][jl]) * sp; }
            else GB[(size_t)row * 16 + jl] = 1.f / (1.f + expf(-mine)); }
    }
}

__device__ __forceinline__ void phase_conv(const Ctx& c) {
    const Args& a = *c.a;
    const bf16* PRE = (const bf16*)(c.ws + WS_QKVPRE); bf16* OUT = (bf16*)(c.ws + WS_QKV);
    const float* cw = a.in[I_CONV];
#pragma unroll 1
    for (int pass = 0; pass < 3; ++pass) { const int ch0 = pass * 512 + 8 * c.lane;
        f32x4 wt[9][2];
#pragma unroll
        for (int i = 0; i < 9; ++i) { wt[i][0] = *(const f32x4*)(cw + i * 1536 + ch0); wt[i][1] = *(const f32x4*)(cw + i * 1536 + ch0 + 4); }
#define CONV_LOAD(DST, ROW) do { const int row_ = (ROW); int nb_row[9]; bool ok[9]; \
            if (row_ < ML) { const int t = row_ & 2047, gr = t >> 6, gc = t & 63; \
                _Pragma("unroll") for (int dy = -1; dy <= 1; ++dy) _Pragma("unroll") for (int dx = -1; dx <= 1; ++dx) { const int i = (dy + 1) * 3 + dx + 1; ok[i] = (gr + dy >= 0) && (gr + dy < 32) && (gc + dx >= 0) && (gc + dx < 64); nb_row[i] = row_ + dy * 64 + dx; } } \
            else { const int t = (row_ - ML) & 255; _Pragma("unroll") for (int i = 0; i < 9; ++i) { ok[i] = false; nb_row[i] = row_; } \
                _Pragma("unroll") for (int dx = -1; dx <= 1; ++dx) { ok[4 + dx] = (t + dx >= 0) && (t + dx < 256); nb_row[4 + dx] = row_ + dx; } } \
            _Pragma("unroll") for (int i = 0; i < 9; ++i) DST[i] = ok[i] ? *(const v4u*)(PRE + (size_t)nb_row[i] * 1536 + ch0) : (v4u){0u, 0u, 0u, 0u}; } while (0)
        v4u nin[9];
        if (c.gw < MT) CONV_LOAD(nin, c.gw);
#pragma unroll 1
        for (int row = c.gw; row < MT; row += c.NGW) {
            v4u in[9];
#pragma unroll
            for (int i = 0; i < 9; ++i) in[i] = nin[i];
            if (row + c.NGW < MT) CONV_LOAD(nin, row + c.NGW);
            float o[8];
#pragma unroll
            for (int q = 0; q < 8; ++q) o[q] = 0.f;
#pragma unroll
            for (int i = 0; i < 9; ++i) { const unsigned w[4] = {in[i].x, in[i].y, in[i].z, in[i].w}; const float kk[8] = {wt[i][0].x, wt[i][0].y, wt[i][0].z, wt[i][0].w, wt[i][1].x, wt[i][1].y, wt[i][1].z, wt[i][1].w};
#pragma unroll
                for (int q = 0; q < 4; ++q) { o[2 * q] = fmaf(bflo(w[q]), kk[2 * q], o[2 * q]); o[2 * q + 1] = fmaf(bfhi(w[q]), kk[2 * q + 1], o[2 * q + 1]); } }
            float ssq = 0.f;
#pragma unroll
            for (int q = 0; q < 8; ++q) { o[q] = siluf_(o[q]); ssq = fmaf(o[q], o[q], ssq); }
            if (pass < 2) { const float sc = rsqrtf(row_sum16(ssq) + EPS) * (pass == 0 ? 0.08838834764831845f : 1.f);
#pragma unroll
                for (int q = 0; q < 8; ++q) o[q] *= sc; }
            v4u ov; ov.x = pk2(o[0], o[1]); ov.y = pk2(o[2], o[3]); ov.z = pk2(o[4], o[5]); ov.w = pk2(o[6], o[7]);
            *(v4u*)(OUT + (size_t)row * 1536 + ch0) = ov;
        }
#undef CONV_LOAD
    }
}

__device__ __forceinline__ int scan_row(int b, int dir, int step) {
    if (step < LC) { const int t = dir ? LC - 1 - step : step; return ML + b * LC + t; }
    const int t = step - LC; return b * SEQ + (dir ? SEQ - 1 - t : t);
}
__device__ __forceinline__ void phase_combine(const Ctx& c) {
    const Args& a = *c.a;
    const bf16* OG0 = (const bf16*)(c.ws + WS_OG); const bf16* OG1 = OG0 + (size_t)ML * 512; const bf16* Z = (const bf16*)(c.ws + WS_Z);
    bf16* CAT = (bf16*)(c.ws + WS_CAT);
    const f32x2 ng = *(const f32x2*)(a.in[I_GDNNORM] + 2 * c.lane);
    unsigned n0[4], n1[4], nz[4];
#define CB_LOAD(R) do { _Pragma("unroll") for (int h = 0; h < 4; ++h) { const size_t o_ = (size_t)(R) * 512 + h * 128 + 2 * c.lane; n0[h] = *(const unsigned*)(OG0 + o_); n1[h] = *(const unsigned*)(OG1 + o_); nz[h] = *(const unsigned*)(Z + o_); } } while (0)
    if (c.gw < ML) CB_LOAD(c.gw);
    for (int row = c.gw; row < ML; row += c.NGW) {
        unsigned w0[4], w1[4], zw[4];
#pragma unroll
        for (int h = 0; h < 4; ++h) { w0[h] = n0[h]; w1[h] = n1[h]; zw[h] = nz[h]; }
        { const int rn = row + c.NGW < ML ? row + c.NGW : row; CB_LOAD(rn); }
#pragma unroll
        for (int h = 0; h < 4; ++h) { const int ch = h * 128 + 2 * c.lane;
            const float o0 = bflo(w0[h]) + bflo(w1[h]), o1 = bfhi(w0[h]) + bfhi(w1[h]);
            const float r = rsqrtf(wave_sum(o0 * o0 + o1 * o1) * (1.f / 128.f) + EPS);
            *(unsigned*)(CAT + (size_t)row * 1024 + 512 + ch) = pk2(o0 * r * ng.x * siluf_(bflo(zw[h])), o1 * r * ng.y * siluf_(bfhi(zw[h]))); }
    }
#undef CB_LOAD
}

__device__ __forceinline__ unsigned char* x1_row(unsigned char* ws, int row) { return ws + (row < 8192 ? WS_X1A + (size_t)row * 2048 : WS_X1B + (size_t)(row - 8192) * 2048); }
__device__ __forceinline__ void phase_rows2(const Ctx& c) {
    const Args& a = *c.a;
    const float* MOD = (const float*)(c.ws + WS_MOD); const bf16* YRAW = (const bf16*)(c.ws + WS_YRAW); bf16* HX2 = (bf16*)(c.ws + WS_HX2);
    v2u ny[4]; f32x4 nxx[4], gpo[4], gpf[4];
#pragma unroll
    for (int j = 0; j < 4; ++j) { gpo[j] = *(const f32x4*)(a.in[I_GPOSTMIX] + 4 * c.lane + 256 * j); gpf[j] = *(const f32x4*)(a.in[I_GPREFFN] + 4 * c.lane + 256 * j); }
    if (c.gw < ML) {
#pragma unroll
        for (int j = 0; j < 4; ++j) { ny[j] = *((const v2u*)(YRAW + (size_t)c.gw * D) + c.lane + 64 * j); nxx[j] = *((const f32x4*)(a.in[I_X] + (size_t)c.gw * D) + c.lane + 64 * j); } }
    for (int row = c.gw; row < ML; row += c.NGW) {
        const float* mr = MOD + (row >> 11) * 6144;
        f32x4 gtv[4], shv[4], sclv[4];
#pragma unroll
        for (int j = 0; j < 4; ++j) { const int col = 4 * c.lane + 256 * j; gtv[j] = *(const f32x4*)(mr + 2048 + col); shv[j] = *(const f32x4*)(mr + 3072 + col); sclv[j] = *(const f32x4*)(mr + 4096 + col); }
        f32x4 y[4], x[4]; float ss = 0.f;
#pragma unroll
        for (int j = 0; j < 4; ++j) { y[j] = (f32x4){bflo(ny[j].x), bfhi(ny[j].x), bflo(ny[j].y), bfhi(ny[j].y)}; x[j] = nxx[j];
            ss += (y[j].x * y[j].x + y[j].y * y[j].y) + (y[j].z * y[j].z + y[j].w * y[j].w); }
        if (row + c.NGW < ML) { const size_t r2 = (size_t)(row + c.NGW);
#pragma unroll
            for (int j = 0; j < 4; ++j) { ny[j] = *((const v2u*)(YRAW + r2 * D) + c.lane + 64 * j); nxx[j] = *((const f32x4*)(a.in[I_X] + r2 * D) + c.lane + 64 * j); } }
        const float r = rsqrtf(wsum(ss) * (1.f / D) + EPS); float s2 = 0.f;
#pragma unroll
        for (int j = 0; j < 4; ++j) { const int col = 4 * c.lane + 256 * j;
            x[j] = x[j] + gtv[j] * ((y[j] * r) * gpo[j]);
            { v2u xo; xo.x = pk2(x[j].x, x[j].y); xo.y = pk2(x[j].z, x[j].w); *(v2u*)(x1_row(c.ws, row) + 2 * col) = xo; }
            s2 += (x[j].x * x[j].x + x[j].y * x[j].y) + (x[j].z * x[j].z + x[j].w * x[j].w); }
        const float r2 = rsqrtf(wsum(s2) * (1.f / D) + EPS);
#pragma unroll
        for (int j = 0; j < 4; ++j) { const int col = 4 * c.lane + 256 * j;
            const f32x4 hv = (x[j] * r2) * gpf[j] * (sclv[j] + 1.f) + shv[j];
            v2u o; o.x = pk2(hv.x, hv.y); o.y = pk2(hv.z, hv.w);
            *(v2u*)(HX2 + (size_t)row * D + col) = o;
            x[j] = (f32x4){bflo(o.x), bfhi(o.x), bflo(o.y), bfhi(o.y)}; }
        { float mx = 0.f;
#pragma unroll
          for (int j = 0; j < 4; ++j) mx = fmaxf(mx, fmaxf(fmaxf(fabsf(x[j].x), fabsf(x[j].y)), fmaxf(fabsf(x[j].z), fabsf(x[j].w))));
          mx = wmax(mx); const float hs = mx > 0.f ? 256.f / mx : 1.f;
          unsigned char* hq = c.ws + WS_HQ8 + (size_t)row * 2048;
#pragma unroll
          for (int j = 0; j < 4; ++j) { const float a0 = x[j].x * hs, a1 = x[j].y * hs, a2 = x[j].z * hs, a3 = x[j].w * hs;
              int w = __builtin_amdgcn_cvt_pk_fp8_f32(a0, a1, 0, false); w = __builtin_amdgcn_cvt_pk_fp8_f32(a2, a3, w, true);
              const f32x2 b01 = __builtin_amdgcn_cvt_pk_f32_fp8(w, false), b23 = __builtin_amdgcn_cvt_pk_f32_fp8(w, true);
              int w2 = __builtin_amdgcn_cvt_pk_fp8_f32((a0 - b01.x) * 16.f, (a1 - b01.y) * 16.f, 0, false); w2 = __builtin_amdgcn_cvt_pk_fp8_f32((a2 - b23.x) * 16.f, (a3 - b23.y) * 16.f, w2, true);
              *(unsigned*)(hq + 4 * c.lane + 256 * j) = (unsigned)w; *(unsigned*)(hq + 1024 + 4 * c.lane + 256 * j) = (unsigned)w2; }
          if (c.lane == 0) ((float*)(c.ws + WS_HS))[row] = 1.f / hs; }
    }
}


constexpr int KROW = 136;
__device__ __forceinline__ float unfkey(unsigned k) { const unsigned u = (k & 0x80000000u) ? (k ^ 0x80000000u) : ~k; return __builtin_bit_cast(float, u); }
__device__ __forceinline__ void ins16(unsigned (&L)[16], unsigned key) {
#pragma unroll
    for (int q = 0; q < 16; ++q) { const unsigned hi = L[q] > key ? L[q] : key, lo = L[q] > key ? key : L[q]; L[q] = hi; key = lo; }
}
__device__ __forceinline__ void sort16_desc(unsigned (&a)[16]) {
#pragma unroll
    for (int kk = 2; kk <= 16; kk <<= 1)
#pragma unroll
        for (int j = kk >> 1; j >= 1; j >>= 1)
#pragma unroll
            for (int i = 0; i < 16; ++i) { const int l = i ^ j; if (l > i) { const unsigned hi = a[i] > a[l] ? a[i] : a[l], lo = a[i] > a[l] ? a[l] : a[i]; if ((i & kk) == 0) { a[i] = hi; a[l] = lo; } else { a[i] = lo; a[l] = hi; } } }
}
__device__ __forceinline__ void top16_of_two(unsigned (&A)[16], const unsigned (&B)[16]) {
#pragma unroll
    for (int q = 0; q < 16; ++q) A[q] = A[q] > B[15 - q] ? A[q] : B[15 - q];
#pragma unroll
    for (int j = 8; j >= 1; j >>= 1)
#pragma unroll
        for (int q = 0; q < 16; ++q) if ((q & j) == 0) { const unsigned hi = A[q] > A[q + j] ? A[q] : A[q + j], lo = A[q] > A[q + j] ? A[q + j] : A[q]; A[q] = hi; A[q + j] = lo; }
}
__device__ __forceinline__ void merge16(unsigned (&L)[16]) {
    unsigned R[16];
#pragma unroll
    for (int q = 0; q < 16; ++q) R[q] = (unsigned)__shfl_xor((int)L[15 - q], 32);
#pragma unroll
    for (int q = 0; q < 16; ++q) L[q] = L[q] > R[q] ? L[q] : R[q];
#pragma unroll
    for (int j = 8; j >= 1; j >>= 1)
#pragma unroll
        for (int q = 0; q < 16; ++q) if ((q & j) == 0) { const unsigned hi = L[q] > L[q + j] ? L[q] : L[q + j], lo = L[q] > L[q + j] ? L[q + j] : L[q]; L[q] = hi; L[q + j] = lo; }
}
__device__ __forceinline__ void phase_topk(const Ctx& c) {
    const Args& a = *c.a;
    bf16* kl = (bf16*)c.lds;
    unsigned char* wtab = c.lds + 2 * 128 * KROW * 2 + c.wave * 1088;
    const bf16* QP = (const bf16*)(c.ws + WS_QP); int* IDX = (int*)(c.ws + WS_IDX); float* GATE = (float*)(c.ws + WS_GATE);
    const int r = c.lane & 31, hh = c.lane >> 5;
    { const unsigned char ptab[50] = {0, 1, 2, 3, 4, 5, 6, 7, 8, 9, 10, 11, 12, 13, 14, 15, 16, 17, 18, 19, 20, 21, 22, 23, 32, 33, 34, 35, 36, 48, 49, 50, 51, 64, 65, 66, 80, 81, 96, 97, 112, 113, 128, 144, 160, 176, 192, 208, 224, 240};
      if (c.lane < 50) wtab[1024 + c.lane] = ptab[c.lane < 50 ? c.lane : 0]; }
    for (int item = c.bid; item < 8 * 32; item += c.G) {
        const int h = item & 7, tr = item >> 3;
        __syncthreads();
        { f32x4 kv[16];
#pragma unroll
          for (int q = 0; q < 16; ++q) { const int i = c.tid + NTHREADS * q, k4 = i & 31, n = (i >> 5) & 127, p = i >> 12; kv[q] = *(const f32x4*)(a.in[I_KEYS] + ((size_t)((h * 2 + p) * 128 + n)) * 128 + 4 * k4); }
#pragma unroll
          for (int q = 0; q < 16; ++q) { const int i = c.tid + NTHREADS * q, k4 = i & 31, n = (i >> 5) & 127, p = i >> 12; v2u o; o.x = pk2(kv[q].x, kv[q].y); o.y = pk2(kv[q].z, kv[q].w);
              *(v2u*)(kl + (p * 128 + n) * KROW + 4 * k4) = o; } }
        __syncthreads();
        for (int tile = c.wave; tile < 16; tile += NWAVES) {
            const int tok = tr * 512 + tile * 32 + r;
            unsigned LA[16], LB[16];
#pragma unroll
            for (int p = 0; p < 2; ++p) {
                bf16x8 qf[8];
#pragma unroll
                for (int kk = 0; kk < 8; ++kk) qf[kk] = *(const bf16x8*)(QP + (size_t)tok * 2048 + h * 256 + p * 128 + kk * 16 + hh * 8);
                f32x16 acc[4];
#pragma unroll
                for (int nt = 0; nt < 4; ++nt)
#pragma unroll
                    for (int i = 0; i < 16; ++i) acc[nt][i] = 0.f;
#pragma unroll
                for (int kk = 0; kk < 8; ++kk)
#pragma unroll
                    for (int nt = 0; nt < 4; ++nt) acc[nt] = MFMA32(*(const bf16x8*)(kl + (p * 128 + nt * 32 + r) * KROW + kk * 16 + hh * 8), qf[kk], acc[nt]);
                unsigned (&L)[16] = p ? LB : LA;
                unsigned G1[16], G2[16], G3[16];
#pragma unroll
                for (int i = 0; i < 16; ++i) { const int n0 = (i & 3) + 8 * (i >> 2) + 4 * hh;
                    L[i] = (fkey(acc[0][i]) & ~127u) | (unsigned)(127 - n0); G1[i] = (fkey(acc[1][i]) & ~127u) | (unsigned)(127 - (32 + n0));
                    G2[i] = (fkey(acc[2][i]) & ~127u) | (unsigned)(127 - (64 + n0)); G3[i] = (fkey(acc[3][i]) & ~127u) | (unsigned)(127 - (96 + n0)); }
                sort16_desc(L); sort16_desc(G1); sort16_desc(G2); sort16_desc(G3);
                top16_of_two(L, G1); top16_of_two(G2, G3); top16_of_two(L, G2);
                merge16(L);
            }
            unsigned char* tt = wtab + r * 32;
            if (hh == 0) {
#pragma unroll
                for (int q = 0; q < 16; ++q) tt[q] = (unsigned char)(127u - (LA[q] & 127u)); }
            else {
#pragma unroll
                for (int q = 0; q < 16; ++q) tt[16 + q] = (unsigned char)(127u - (LB[q] & 127u)); }
            float va[16], vb[16];
#pragma unroll
            for (int q = 0; q < 16; ++q) { va[q] = unfkey(LA[q] & ~127u); vb[q] = unfkey(LB[q] & ~127u); }
            unsigned LC[16];
#pragma unroll
            for (int q = 0; q < 16; ++q) LC[q] = 0u;
            { const float s0 = va[0] + vb[0], s1 = va[0] + vb[1]; ins16(LC, (fkey(hh ? s1 : s0) & ~63u) | (unsigned)(63 - (0 + hh))); }
            { const float s0 = va[0] + vb[2], s1 = va[0] + vb[3]; ins16(LC, (fkey(hh ? s1 : s0) & ~63u) | (unsigned)(63 - (2 + hh))); }
            { const float s0 = va[0] + vb[4], s1 = va[0] + vb[5]; ins16(LC, (fkey(hh ? s1 : s0) & ~63u) | (unsigned)(63 - (4 + hh))); }
            { const float s0 = va[0] + vb[6], s1 = va[0] + vb[7]; ins16(LC, (fkey(hh ? s1 : s0) & ~63u) | (unsigned)(63 - (6 + hh))); }
            { const float s0 = va[0] + vb[8], s1 = va[0] + vb[9]; ins16(LC, (fkey(hh ? s1 : s0) & ~63u) | (unsigned)(63 - (8 + hh))); }
            { const float s0 = va[0] + vb[10], s1 = va[0] + vb[11]; ins16(LC, (fkey(hh ? s1 : s0) & ~63u) | (unsigned)(63 - (10 + hh))); }
            { const float s0 = va[0] + vb[12], s1 = va[0] + vb[13]; ins16(LC, (fkey(hh ? s1 : s0) & ~63u) | (unsigned)(63 - (12 + hh))); }
            { const float s0 = va[0] + vb[14], s1 = va[0] + vb[15]; ins16(LC, (fkey(hh ? s1 : s0) & ~63u) | (unsigned)(63 - (14 + hh))); }
            { const float s0 = va[1] + vb[0], s1 = va[1] + vb[1]; ins16(LC, (fkey(hh ? s1 : s0) & ~63u) | (unsigned)(63 - (16 + hh))); }
            { const float s0 = va[1] + vb[2], s1 = va[1] + vb[3]; ins16(LC, (fkey(hh ? s1 : s0) & ~63u) | (unsigned)(63 - (18 + hh))); }
            { const float s0 = va[1] + vb[4], s1 = va[1] + vb[5]; ins16(LC, (fkey(hh ? s1 : s0) & ~63u) | (unsigned)(63 - (20 + hh))); }
            { const float s0 = va[1] + vb[6], s1 = va[1] + vb[7]; ins16(LC, (fkey(hh ? s1 : s0) & ~63u) | (unsigned)(63 - (22 + hh))); }
            { const float s0 = va[2] + vb[0], s1 = va[2] + vb[1]; ins16(LC, (fkey(hh ? s1 : s0) & ~63u) | (unsigned)(63 - (24 + hh))); }
            { const float s0 = va[2] + vb[2], s1 = va[2] + vb[3]; ins16(LC, (fkey(hh ? s1 : s0) & ~63u) | (unsigned)(63 - (26 + hh))); }
            { const float s0 = va[2] + vb[4], s1 = va[3] + vb[0]; ins16(LC, (fkey(hh ? s1 : s0) & ~63u) | (unsigned)(63 - (28 + hh))); }
            { const float s0 = va[3] + vb[1], s1 = va[3] + vb[2]; ins16(LC, (fkey(hh ? s1 : s0) & ~63u) | (unsigned)(63 - (30 + hh))); }
            { const float s0 = va[3] + vb[3], s1 = va[4] + vb[0]; ins16(LC, (fkey(hh ? s1 : s0) & ~63u) | (unsigned)(63 - (32 + hh))); }
            { const float s0 = va[4] + vb[1], s1 = va[4] + vb[2]; ins16(LC, (fkey(hh ? s1 : s0) & ~63u) | (unsigned)(63 - (34 + hh))); }
            { const float s0 = va[5] + vb[0], s1 = va[5] + vb[1]; ins16(LC, (fkey(hh ? s1 : s0) & ~63u) | (unsigned)(63 - (36 + hh))); }
            { const float s0 = va[6] + vb[0], s1 = va[6] + vb[1]; ins16(LC, (fkey(hh ? s1 : s0) & ~63u) | (unsigned)(63 - (38 + hh))); }
            { const float s0 = va[7] + vb[0], s1 = va[7] + vb[1]; ins16(LC, (fkey(hh ? s1 : s0) & ~63u) | (unsigned)(63 - (40 + hh))); }
            { const float s0 = va[8] + vb[0], s1 = va[9] + vb[0]; ins16(LC, (fkey(hh ? s1 : s0) & ~63u) | (unsigned)(63 - (42 + hh))); }
            { const float s0 = va[10] + vb[0], s1 = va[11] + vb[0]; ins16(LC, (fkey(hh ? s1 : s0) & ~63u) | (unsigned)(63 - (44 + hh))); }
            { const float s0 = va[12] + vb[0], s1 = va[13] + vb[0]; ins16(LC, (fkey(hh ? s1 : s0) & ~63u) | (unsigned)(63 - (46 + hh))); }
            { const float s0 = va[14] + vb[0], s1 = va[15] + vb[0]; ins16(LC, (fkey(hh ? s1 : s0) & ~63u) | (unsigned)(63 - (48 + hh))); }
            merge16(LC);
            WAVE_LDS_SYNC();
            float ev[16]; float den = 0.f; const float mx = unfkey(LC[0] & ~63u);
#pragma unroll
            for (int q = 0; q < 16; ++q) { ev[q] = __expf(unfkey(LC[q] & ~63u) - mx); den += ev[q]; }
            const float inv = 1.f / den;
            if (hh == 0) { int ex[16];
#pragma unroll
                for (int q = 0; q < 16; ++q) { const unsigned pc = wtab[1024 + (63u - (LC[q] & 63u))]; ex[q] = (int)tt[pc >> 4] * 128 + (int)tt[16 + (pc & 15u)]; }
#pragma unroll
                for (int q = 0; q < 4; ++q) *(v4u*)(IDX + (size_t)tok * 128 + h * 16 + 4 * q) = (v4u){(unsigned)ex[4 * q], (unsigned)ex[4 * q + 1], (unsigned)ex[4 * q + 2], (unsigned)ex[4 * q + 3]}; }
            else {
#pragma unroll
                for (int q = 0; q < 4; ++q) *(f32x4*)(GATE + (size_t)tok * 128 + h * 16 + 4 * q) = (f32x4){ev[4 * q] * inv, ev[4 * q + 1] * inv, ev[4 * q + 2] * inv, ev[4 * q + 3] * inv}; }
            WAVE_LDS_SYNC();
        }
    }
}

__device__ __forceinline__ void phase_fp8_tables(const Ctx& c) {
    const Args& a = *c.a;
    f32x4 nv[2][4];
#define F8_LOAD(R0) do { _Pragma("unroll") for (int u = 0; u < 2; ++u) { int rr = (R0) + u * c.NGW; rr = rr < 2 * NEXP ? rr : 2 * NEXP - 1; const bool isv_ = rr >= NEXP; const int e_ = isv_ ? rr - NEXP : rr; \
        const f32x4* src = (const f32x4*)((isv_ ? a.in[I_PV] : a.in[I_PU]) + (size_t)e_ * D) + c.lane; _Pragma("unroll") for (int j = 0; j < 4; ++j) nv[u][j] = src[64 * j]; } } while (0)
    if (c.gw < 2 * NEXP) F8_LOAD(c.gw);
    for (int r0 = c.gw; r0 < 2 * NEXP; r0 += 2 * c.NGW) {
        f32x4 v[2][4];
#pragma unroll
        for (int u = 0; u < 2; ++u)
#pragma unroll
            for (int j = 0; j < 4; ++j) v[u][j] = nv[u][j];
        { const int rn = r0 + 2 * c.NGW < 2 * NEXP ? r0 + 2 * c.NGW : r0; F8_LOAD(rn); }
#pragma unroll
        for (int u = 0; u < 2; ++u) { const int r = r0 + u * c.NGW;
            if (r < 2 * NEXP) { const bool isv = r >= NEXP; const int e = isv ? r - NEXP : r; float m = 0.f;
#pragma unroll
                for (int j = 0; j < 4; ++j) m = fmaxf(m, fmaxf(fmaxf(fabsf(v[u][j].x), fabsf(v[u][j].y)), fmaxf(fabsf(v[u][j].z), fabsf(v[u][j].w))));
                m = wmax(m); const float inv = m > 0.f ? 256.f / m : 0.f;
                unsigned char* dst = c.ws + (isv ? WS_V8 : WS_U8) + (size_t)e * D + 4 * c.lane;
#pragma unroll
                for (int j = 0; j < 4; ++j) { int w = __builtin_amdgcn_cvt_pk_fp8_f32(v[u][j].x * inv, v[u][j].y * inv, 0, false); w = __builtin_amdgcn_cvt_pk_fp8_f32(v[u][j].z * inv, v[u][j].w * inv, w, true); *(unsigned*)(dst + 256 * j) = (unsigned)w; }
                if (c.lane == 0) ((float*)(c.ws + (isv ? WS_VSC : WS_USC)))[e] = m * (1.f / 256.f); } }
    }
#undef F8_LOAD
}
__device__ __forceinline__ void fp8x16_to_f32(const v4u& r, float (&f)[16]) {
    const unsigned w[4] = {r.x, r.y, r.z, r.w};
#pragma unroll
    for (int j = 0; j < 4; ++j) { const f32x2 lo = __builtin_amdgcn_cvt_pk_f32_fp8((int)w[j], false), hi = __builtin_amdgcn_cvt_pk_f32_fp8((int)w[j], true); f[4 * j] = lo.x; f[4 * j + 1] = lo.y; f[4 * j + 2] = hi.x; f[4 * j + 3] = hi.y; }
}
__device__ __forceinline__ unsigned xcc_id() { return (unsigned)__builtin_amdgcn_s_getreg((3 << 11) | 20) & 7u; }

typedef long l64x2 __attribute__((ext_vector_type(2)));
struct E1Bat { l64x2 rw[16]; };
__device__ __forceinline__ void phase_exp1(const Ctx& c) {
    typedef float f32x4m __attribute__((ext_vector_type(4)));
    const int* IDX = (const int*)(c.ws + WS_IDX); const unsigned char* U8 = c.ws + WS_U8; float* PACT = (float*)(c.ws + WS_PACT);
    unsigned* cnt = (unsigned*)(c.ws + WS_CTL) + CW_E1;
    constexpr int CH = 8;
    constexpr int SROW = 144;
    unsigned char* wl = c.lds + c.wave * 14080; int* le = (int*)wl; unsigned char* himg = wl + 4096; float* res = (float*)(wl + 6144); unsigned char* stage = wl + 6656;
    const int xcc = (int)xcc_id(), r16 = c.lane & 15, g4 = c.lane >> 4, row8 = c.lane >> 3, pc8 = c.lane & 7; const bool bcol = r16 < 2;
    int bo = 0; unsigned tq = 0;
    if (c.lane == 0) tq = __hip_atomic_fetch_add(cnt + 64 * (xcc & 7), (unsigned)CH, __ATOMIC_RELAXED, __HIP_MEMORY_SCOPE_AGENT);
    for (;;) {
        const int x = (xcc + bo) & 7;
        const unsigned t0 = (unsigned)__builtin_amdgcn_readfirstlane((int)tq);
        if (t0 >= (unsigned)ML) { if (++bo >= 8) break; tq = 0; if (c.lane == 0) tq = __hip_atomic_fetch_add(cnt + 64 * ((xcc + bo) & 7), (unsigned)CH, __ATOMIC_RELAXED, __HIP_MEMORY_SCOPE_AGENT); continue; }
        tq = 0; if (c.lane == 0) tq = __hip_atomic_fetch_add(cnt + 64 * x, (unsigned)CH, __ATOMIC_RELAXED, __HIP_MEMORY_SCOPE_AGENT);
        { v4u ee[4], im[2];
#pragma unroll
          for (int q = 0; q < 4; ++q) ee[q] = *(const v4u*)(IDX + (size_t)t0 * 128 + 256 * q + 4 * c.lane);
#pragma unroll
          for (int q = 0; q < 2; ++q) { const int p = c.lane + 64 * q; im[q] = *(const v4u*)(c.ws + WS_HQ8 + ((size_t)t0 + (p >> 4)) * 2048 + ((p >> 3) & 1) * 1024 + 128 * x + 16 * (p & 7)); }
#pragma unroll
          for (int q = 0; q < 4; ++q) *(v4u*)(le + 256 * q + 4 * c.lane) = ee[q];
#pragma unroll
          for (int q = 0; q < 2; ++q) *(v4u*)(himg + 16 * (c.lane + 64 * q)) = im[q]; }
        WAVE_LDS_SYNC();
#define E1_LOAD(G, B) do { const int bb = (B) < CH ? (B) : 0; _Pragma("unroll") for (int i = 0; i < 16; ++i) G.rw[i] = *(const l64x2*)(U8 + (size_t)le[bb * 128 + 8 * i + row8] * D + 128 * x + 16 * pc8); } while (0)
#define E1_W(G, GI) do { unsigned char* sb_ = stage + ((GI) % 3) * (16 * SROW); *(l64x2*)(sb_ + row8 * SROW + 16 * pc8) = G.rw[2 * (GI)]; *(l64x2*)(sb_ + (8 + row8) * SROW + 16 * pc8) = G.rw[2 * (GI) + 1]; } while (0)
#define E1_R(A01, A23, GI) do { const unsigned char* sb_ = stage + ((GI) % 3) * (16 * SROW); A01 = *(const l64x2*)(sb_ + r16 * SROW + 32 * g4); A23 = *(const l64x2*)(sb_ + r16 * SROW + 32 * g4 + 16); } while (0)
#define E1_COMP(G, B) do { const unsigned char* hb = himg + ((B) * 2 + (r16 & 1)) * 128 + 32 * g4; long bq[4]; _Pragma("unroll") for (int m = 0; m < 4; ++m) { const long v = *(const long*)(hb + 8 * m); bq[m] = bcol ? v : 0l; } \
            l64x2 a01, a23, n01, n23; \
            E1_W(G, 0); E1_W(G, 1); WAVE_LDS_SYNC(); E1_R(a01, a23, 0); \
            _Pragma("unroll") for (int gi = 0; gi < 8; ++gi) { \
                if (gi + 2 < 8) E1_W(G, gi + 2); \
                WAVE_LDS_SYNC(); \
                if (gi + 1 < 8) E1_R(n01, n23, gi + 1); \
                f32x4m acc = {0.f, 0.f, 0.f, 0.f}; \
                acc = __builtin_amdgcn_mfma_f32_16x16x32_fp8_fp8(a01.x, bq[0], acc, 0, 0, 0); acc = __builtin_amdgcn_mfma_f32_16x16x32_fp8_fp8(a01.y, bq[1], acc, 0, 0, 0); \
                acc = __builtin_amdgcn_mfma_f32_16x16x32_fp8_fp8(a23.x, bq[2], acc, 0, 0, 0); acc = __builtin_amdgcn_mfma_f32_16x16x32_fp8_fp8(a23.y, bq[3], acc, 0, 0, 0); \
                _Pragma("unroll") for (int q = 0; q < 4; ++q) { const float lo = dppf<0xB1>(acc[q]); if (r16 == 0) res[gi * 16 + 4 * g4 + q] = acc[q] + lo * 0.0625f; } \
                a01 = n01; a23 = n23; } \
            WAVE_LDS_SYNC(); \
            { float* po = PACT + (size_t)x * ((size_t)ML * 128) + ((size_t)t0 + (B)) * 128; po[c.lane] = res[c.lane]; po[64 + c.lane] = res[64 + c.lane]; } \
            WAVE_LDS_SYNC(); } while (0)
        E1Bat ga, gb;
        E1_LOAD(ga, 0);
#pragma unroll 1
        for (int b2 = 0; b2 < CH; b2 += 2) {
            E1_LOAD(gb, b2 + 1);
            __builtin_amdgcn_sched_barrier(0);
            E1_COMP(ga, b2);
            __builtin_amdgcn_sched_barrier(0);
            E1_LOAD(ga, b2 + 2);
            __builtin_amdgcn_sched_barrier(0);
            E1_COMP(gb, b2 + 1);
            __builtin_amdgcn_sched_barrier(0);
        }
#undef E1_LOAD
#undef E1_COMP
#undef E1_W
#undef E1_R
    }
}
__device__ __forceinline__ void phase_exp1b(const Ctx& c) {
    const int* IDX = (const int*)(c.ws + WS_IDX); const float* GATE = (const float*)(c.ws + WS_GATE); const float* HS = (const float*)(c.ws + WS_HS); const float* PACT = (const float*)(c.ws + WS_PACT);
    const float* USC = (const float*)(c.ws + WS_USC); const float* VSC = (const float*)(c.ws + WS_VSC); float* ACT = (float*)(c.ws + WS_ACT);
    const size_t N = (size_t)ML * 128, stride = (size_t)c.G * NTHREADS;
    for (size_t i0 = (size_t)c.bid * NTHREADS + c.tid; i0 < N; i0 += 4 * stride) {
        float pv[4][8], gt[4], hs[4], us[4], vs[4]; int e[4];
#pragma unroll
        for (int q = 0; q < 4; ++q) { size_t i = i0 + q * stride; i = i < N ? i : N - 1;
#pragma unroll
            for (int x = 0; x < 8; ++x) pv[q][x] = PACT[(size_t)x * N + i];
            e[q] = IDX[i]; gt[q] = GATE[i]; hs[q] = HS[i >> 7]; }
#pragma unroll
        for (int q = 0; q < 4; ++q) { us[q] = USC[e[q]]; vs[q] = VSC[e[q]]; }
#pragma unroll
        for (int q = 0; q < 4; ++q) { const size_t i = i0 + q * stride; float s = 0.f;
#pragma unroll
            for (int x = 0; x < 8; ++x) s += pv[q][x];
            if (i < N) ACT[i] = gelu_erf(s * hs[q] * us[q]) * gt[q] * vs[q]; }
    }
}
__device__ __forceinline__ void phase_exp2(const Ctx& c) {
    const int* IDX = (const int*)(c.ws + WS_IDX); const float* ACT = (const float*)(c.ws + WS_ACT); const unsigned char* V8 = c.ws + WS_V8;
    bf16* Y = (bf16*)(c.ws + WS_Y); float* SSQP = (float*)(c.ws + WS_SSQP);
    unsigned* cnt = (unsigned*)(c.ws + WS_CTL) + CW_E2;
    int* li = (int*)(c.lds + c.wave * 1024); float* la = (float*)(li + 128);
    const int xcc = (int)xcc_id(), sub = c.lane & 7, grp = c.lane >> 3;
    const bool b5 = c.lane & 32, b4 = c.lane & 16, b3 = c.lane & 8;
    constexpr int CH = 8;
    int bo = 0, t = 0, tend = 0;
    int iA = 0, iB = 0; float aA = 0.f, aB = 0.f;
    unsigned tq = 0; if (c.lane == 0) tq = __hip_atomic_fetch_add(cnt + 64 * (xcc & 7), (unsigned)CH, __ATOMIC_RELAXED, __HIP_MEMORY_SCOPE_AGENT);
    for (;;) {
        if (t >= tend) {
            const unsigned t0 = (unsigned)__builtin_amdgcn_readfirstlane((int)tq);
            if (t0 >= (unsigned)ML) { if (++bo >= 8) break; tq = 0; if (c.lane == 0) tq = __hip_atomic_fetch_add(cnt + 64 * ((xcc + bo) & 7), (unsigned)CH, __ATOMIC_RELAXED, __HIP_MEMORY_SCOPE_AGENT); continue; }
            tq = 0; if (c.lane == 0) tq = __hip_atomic_fetch_add(cnt + 64 * ((xcc + bo) & 7), (unsigned)CH, __ATOMIC_RELAXED, __HIP_MEMORY_SCOPE_AGENT);
            t = (int)t0; tend = t + CH;
            iA = IDX[(size_t)t * 128 + c.lane]; iB = IDX[(size_t)t * 128 + 64 + c.lane]; aA = ACT[(size_t)t * 128 + c.lane]; aB = ACT[(size_t)t * 128 + 64 + c.lane];
        }
        const int x = (xcc + bo) & 7;
        li[c.lane] = iA; li[64 + c.lane] = iB; la[c.lane] = aA; la[64 + c.lane] = aB;
        if (t + 1 < tend) { iA = IDX[(size_t)(t + 1) * 128 + c.lane]; iB = IDX[(size_t)(t + 1) * 128 + 64 + c.lane]; aA = ACT[(size_t)(t + 1) * 128 + c.lane]; aB = ACT[(size_t)(t + 1) * 128 + 64 + c.lane]; }
        WAVE_LDS_SYNC();
        float acc[16];
#pragma unroll
        for (int q = 0; q < 16; ++q) acc[q] = 0.f;
        { v4u rows[16]; float av[16];
#pragma unroll
          for (int i = 0; i < 16; ++i) { const int k = 8 * i + grp; rows[i] = *(const v4u*)(V8 + (size_t)li[k] * D + x * 128 + 16 * sub); av[i] = la[k]; }
          asm volatile("" ::: "memory");
#pragma unroll
          for (int i = 0; i < 16; ++i) { float f[16]; fp8x16_to_f32(rows[i], f);
#pragma unroll
              for (int q = 0; q < 16; ++q) acc[q] = fmaf(av[i], f[q], acc[q]); } }
        float q8[8], q4[4], q2[2];
#pragma unroll
        for (int i = 0; i < 8; ++i) { const float keep = b5 ? acc[i + 8] : acc[i], send = b5 ? acc[i] : acc[i + 8]; q8[i] = keep + __shfl_xor(send, 32); }
#pragma unroll
        for (int i = 0; i < 4; ++i) { const float keep = b4 ? q8[i + 4] : q8[i], send = b4 ? q8[i] : q8[i + 4]; q4[i] = keep + __shfl_xor(send, 16); }
#pragma unroll
        for (int i = 0; i < 2; ++i) { const float keep = b3 ? q4[i + 2] : q4[i], send = b3 ? q4[i] : q4[i + 2]; q2[i] = keep + __shfl_xor(send, 8); }
        const int col = x * 128 + 16 * sub + (b5 ? 8 : 0) + (b4 ? 4 : 0) + (b3 ? 2 : 0);
        *(unsigned*)(Y + (size_t)t * D + col) = pk2(q2[0], q2[1]);
        const float ss = wsum(q2[0] * q2[0] + q2[1] * q2[1]);
        SSQP[(size_t)x * ML + t] = ss;
        WAVE_LDS_SYNC();
        ++t;
    }
}
__device__ __forceinline__ void phase_exp3(const Ctx& c) {
    const Args& a = *c.a;
    const float* MOD = (const float*)(c.ws + WS_MOD); const bf16* Y = (const bf16*)(c.ws + WS_Y); const float* SSQP = (const float*)(c.ws + WS_SSQP);
    v2u ny[4], nx[4]; f32x4 ngt[4], g4c[4]; float nss = 0.f;
#pragma unroll
    for (int j = 0; j < 4; ++j) g4c[j] = *(const f32x4*)(a.in[I_GPOSTFFN] + 4 * c.lane + 256 * j);
#define E3_LOAD(R) do { _Pragma("unroll") for (int j = 0; j < 4; ++j) { const int col = 4 * c.lane + 256 * j; ny[j] = *(const v2u*)(Y + (size_t)(R) * D + col); nx[j] = *(const v2u*)(x1_row(c.ws, (R)) + 2 * col); \
            ngt[j] = *(const f32x4*)(MOD + ((R) >> 11) * 6144 + 5120 + col); } \
        nss = (c.lane < 8) ? SSQP[(size_t)c.lane * ML + (R)] : 0.f; } while (0)
    if (c.gw < ML) E3_LOAD(c.gw);
    for (int row = c.gw; row < ML; row += c.NGW) {
        f32x4 y[4], x1[4], gt[4];
#pragma unroll
        for (int j = 0; j < 4; ++j) { y[j] = (f32x4){bflo(ny[j].x), bfhi(ny[j].x), bflo(ny[j].y), bfhi(ny[j].y)}; x1[j] = (f32x4){bflo(nx[j].x), bfhi(nx[j].x), bflo(nx[j].y), bfhi(nx[j].y)}; gt[j] = ngt[j]; }
        const float ss = row_sum16(nss);
        const float tot = __builtin_bit_cast(float, __builtin_amdgcn_readlane(__builtin_bit_cast(int, ss), 0));
        if (row + c.NGW < ML) E3_LOAD(row + c.NGW);
        const float r = rsqrtf(tot * (1.f / D) + EPS);
#pragma unroll
        for (int j = 0; j < 4; ++j) { const int col = 4 * c.lane + 256 * j;
            *(f32x4*)(a.out + (size_t)row * D + col) = x1[j] + gt[j] * ((y[j] * r) * g4c[j]); }
    }
#undef E3_LOAD
}

constexpr int S5_LPOW = 0, S5_BBAR = 33792, S5_CC = 50176, S5_MM = 66560;
__device__ __forceinline__ void s5_build_group(const Ctx& c, int g, int part) {
    const Args& a = *c.a;
    f32x2* LPOW = (f32x2*)(c.lds + S5_LPOW);
    f32x2* BBAR = (f32x2*)(c.lds + S5_BBAR);
    f32x2* CC = (f32x2*)(c.lds + S5_CC);
    float* MM = (float*)(c.lds + S5_MM);
    __syncthreads();
    { const int dir = (c.tid >> 6) & 1, p = c.tid & 63, eq = c.tid >> 7, dg = dir * 32 + g;
        const float dt = expf(a.in[I_LOGDT][dg]), lr = a.in[I_LAMRE][dg * 64 + p], li = a.in[I_LAMIM][dg * 64 + p];
        const f32x4 br4 = *(const f32x4*)(a.in[I_BRE] + (size_t)(dg * 64 + p) * 16 + 4 * eq), bi4 = *(const f32x4*)(a.in[I_BIM] + (size_t)(dg * 64 + p) * 16 + 4 * eq);
        const double ang = (double)li * (double)dt; const float lrdt = lr * dt;
        for (int e = eq; e <= 32; e += 4) { float sn, cs; sincos_d(ang * (double)e, sn, cs); const float mg = expf(lrdt * (float)e); LPOW[(dir * 33 + e) * 64 + p] = (f32x2){mg * cs, mg * sn}; }
        float sn, cs; sincos_d(ang, sn, cs); const float mag = expf(lrdt), lbr = mag * cs, lbi = mag * sn, den = lr * lr + li * li, nr = lbr - 1.f;
        const float cr = (nr * lr + lbi * li) / den, ci = (lbi * lr - nr * li) / den;
#pragma unroll
        for (int q = 0; q < 4; ++q) { const float br = br4[q], bi = bi4[q]; BBAR[(dir * 64 + p) * 16 + 4 * eq + q] = (f32x2){cr * br - ci * bi, cr * bi + ci * br}; } }
    for (int i = c.tid; i < 2048; i += NTHREADS) { const int dir = i >> 10, ch = (i >> 6) & 15, p = i & 63, dg = dir * 32 + g; CC[i] = (f32x2){a.in[I_CRE][(size_t)(dg * 16 + ch) * 64 + p], a.in[I_CIM][(size_t)(dg * 16 + ch) * 64 + p]}; }
    __syncthreads();
    for (int task = c.tid; task < 1024; task += NTHREADS) { const int cpb = task & 3, cb = (task >> 2) & 3, lag = (task >> 4) & 31, dir = task >> 9;
        float acc[4][4];
#pragma unroll
        for (int i = 0; i < 4; ++i)
#pragma unroll
            for (int j = 0; j < 4; ++j) acc[i][j] = 0.f;
        for (int p = 0; p < 64; ++p) { const f32x2 l = LPOW[(dir * 33 + lag) * 64 + p]; f32x2 G[4], Cw[4];
#pragma unroll
            for (int j = 0; j < 4; ++j) { const f32x2 bb = BBAR[(dir * 64 + p) * 16 + 4 * cpb + j]; G[j] = (f32x2){l.x * bb.x - l.y * bb.y, l.x * bb.y + l.y * bb.x}; }
#pragma unroll
            for (int i = 0; i < 4; ++i) Cw[i] = CC[(dir * 16 + 4 * cb + i) * 64 + p];
#pragma unroll
            for (int i = 0; i < 4; ++i)
#pragma unroll
                for (int j = 0; j < 4; ++j) acc[i][j] += Cw[i].x * G[j].x - Cw[i].y * G[j].y; }
#pragma unroll
        for (int i = 0; i < 4; ++i)
#pragma unroll
            for (int j = 0; j < 4; ++j) MM[((dir * 32 + lag) * 16 + 4 * cb + i) * 16 + 4 * cpb + j] = acc[i][j]; }
    __syncthreads();
    if (c.tid < 128 && part == 0) { const int dir = c.tid >> 6, p = c.tid & 63; ((f32x2*)(c.ws + WS_LP))[(dir * 32 + g) * 64 + p] = LPOW[(dir * 33 + 32) * 64 + p]; }
    bf16* PMg = (bf16*)(c.ws + WS_PM) + (size_t)g * 256 * 512; bf16* BBg = (bf16*)(c.ws + WS_BB) + (size_t)g * 512 * 768;
    for (int task = part * 64 * 32 + c.tid; task < (part + 1) * 64 * 32; task += NTHREADS) { const int ip = task & 31, n = task >> 5, dir = n >> 7, im = (n >> 6) & 1, p = n & 63, e = dir ? ip : 31 - ip;
        const f32x2 l = LPOW[(dir * 33 + e) * 64 + p]; float o[16];
#pragma unroll
        for (int ch = 0; ch < 16; ++ch) { const f32x2 bb = BBAR[(dir * 64 + p) * 16 + ch]; o[ch] = im ? (l.x * bb.y + l.y * bb.x) : (l.x * bb.x - l.y * bb.y); }
        v4u w0, w1; w0.x = pk2(o[0], o[1]); w0.y = pk2(o[2], o[3]); w0.z = pk2(o[4], o[5]); w0.w = pk2(o[6], o[7]); w1.x = pk2(o[8], o[9]); w1.y = pk2(o[10], o[11]); w1.z = pk2(o[12], o[13]); w1.w = pk2(o[14], o[15]);
        *(v4u*)(PMg + (size_t)n * 512 + ip * 16) = w0; *(v4u*)(PMg + (size_t)n * 512 + ip * 16 + 8) = w1; }
    const float dskv = a.in[I_S5D][g * 16 + ((c.tid >> 5) & 15)];
    for (int task = part * 128 * 32 + c.tid; task < (part + 1) * 128 * 32; task += NTHREADS) { const int ip = task & 31, n = task >> 5, i = n >> 4, ch = n & 15; float o[16];
#pragma unroll
        for (int q = 0; q < 16; ++q) o[q] = 0.f;
        if (ip <= i) { const float* m0 = MM + ((0 * 32 + (i - ip)) * 16 + ch) * 16;
#pragma unroll
            for (int q = 0; q < 16; ++q) o[q] += m0[q]; }
        if (ip >= i) { const float* m1 = MM + ((1 * 32 + (ip - i)) * 16 + ch) * 16;
#pragma unroll
            for (int q = 0; q < 16; ++q) o[q] += m1[q]; }
        if (ip == i) { const float dsk = dskv;
#pragma unroll
            for (int q = 0; q < 16; ++q) o[q] += (q == ch) ? dsk : 0.f; }
        v4u w0, w1; w0.x = pk2(o[0], o[1]); w0.y = pk2(o[2], o[3]); w0.z = pk2(o[4], o[5]); w0.w = pk2(o[6], o[7]); w1.x = pk2(o[8], o[9]); w1.y = pk2(o[10], o[11]); w1.z = pk2(o[12], o[13]); w1.w = pk2(o[14], o[15]);
        *(v4u*)(BBg + (size_t)n * 768 + ip * 16) = w0; *(v4u*)(BBg + (size_t)n * 768 + ip * 16 + 8) = w1; }
    for (int task = part * 128 * 32 + c.tid; task < (part + 1) * 128 * 32; task += NTHREADS) { const int p8 = task & 7, part = (task >> 3) & 3, n = task >> 5, i = n >> 4, ch = n & 15, dir = part >> 1, im = part & 1, e = dir ? 32 - i : i + 1; float o[8];
#pragma unroll
        for (int q = 0; q < 8; ++q) { const int p = p8 * 8 + q; const f32x2 l = LPOW[(dir * 33 + e) * 64 + p], cc = CC[(dir * 16 + ch) * 64 + p]; o[q] = im ? -(cc.x * l.y + cc.y * l.x) : (cc.x * l.x - cc.y * l.y); }
        v4u w0; w0.x = pk2(o[0], o[1]); w0.y = pk2(o[2], o[3]); w0.z = pk2(o[4], o[5]); w0.w = pk2(o[6], o[7]);
        *(v4u*)(BBg + (size_t)n * 768 + 512 + part * 64 + p8 * 8) = w0; }
}
__device__ __forceinline__ void s5_state_scan(const Ctx& c, int task) {
    const int dir = task & 1, g = (task >> 1) & 31, b = task >> 6, p = c.lane;
    const f32x2 a = ((const f32x2*)(c.ws + WS_LP))[(dir * 32 + g) * 64 + p];
    const float* SS = (const float*)(c.ws + WS_SS) + (size_t)g * 768 * 256 + dir * 128 + p; bf16* U5 = (bf16*)(c.ws + WS_U5) + (size_t)g * 768 * 768 + 512 + dir * 128 + p;
    float er = 0.f, ei = 0.f;
#pragma unroll 1
    for (int s0 = 0; s0 < 72; s0 += 24) {
        float sr[24], si[24];
#pragma unroll
        for (int u = 0; u < 24; ++u) { const int step = s0 + u; const int R = (step < 8) ? 512 + b * 8 + (dir ? 7 - step : step) : b * 64 + (dir ? 71 - step : step - 8);
            sr[u] = SS[(size_t)R * 256]; si[u] = SS[(size_t)R * 256 + 64]; }
#pragma unroll
        for (int u = 0; u < 24; ++u) { const int step = s0 + u; const int R = (step < 8) ? 512 + b * 8 + (dir ? 7 - step : step) : b * 64 + (dir ? 71 - step : step - 8);
            if (step >= 8) { U5[(size_t)R * 768] = (bf16)f2bf(er); U5[(size_t)R * 768 + 64] = (bf16)f2bf(ei); }
            const float nr = sr[u] + a.x * er - a.y * ei, ni = si[u] + a.x * ei + a.y * er; er = nr; ei = ni; }
    }
}

constexpr int GDN_NCH = 36, GDN_ITEMS = NB * 4 * 2 * GDN_NCH;
constexpr size_t FR_T_BYTES = 8192, FR_ATT_BYTES = 8192, FR_KD_BYTES = 16384, FR_TAB_BYTES = 1024;
__device__ __forceinline__ int crow16(int i, int hh) { return (i & 3) + 8 * (i >> 2) + 4 * hh; }
__device__ __forceinline__ bf16x8 pack_step(const f32x16& x, int s) {
    v4u w; w.x = pk2(x[8 * s + 0], x[8 * s + 1]); w.y = pk2(x[8 * s + 2], x[8 * s + 3]); w.z = pk2(x[8 * s + 4], x[8 * s + 5]); w.w = pk2(x[8 * s + 6], x[8 * s + 7]);
    return __builtin_bit_cast(bf16x8, w);
}
__device__ __forceinline__ unsigned pk2v(float lo, float hi) { asm volatile("" : "+v"(lo), "+v"(hi)); return pk2(lo, hi); }
__device__ __forceinline__ bf16x8 pack_step_v(const f32x16& x, int s) {
    v4u w; w.x = pk2v(x[8 * s + 0], x[8 * s + 1]); w.y = pk2v(x[8 * s + 2], x[8 * s + 3]); w.z = pk2v(x[8 * s + 4], x[8 * s + 5]); w.w = pk2v(x[8 * s + 6], x[8 * s + 7]);
    return __builtin_bit_cast(bf16x8, w);
}
constexpr int GP_KR = 0, GP_QR = 17408, GP_KT = 34816, GP_TAB = 53248, GP_LP = 54272, GP_LPB = 8448 + 256;
__host__ __device__ constexpr int LOFF(int i) { return i < 1 ? 0 : 4 * (((i - 1) >> 2) + 1) * (2 * ((i - 1) >> 2) + ((i - 1) & 3)); }
static_assert(LOFF(1) == 0 && LOFF(2) == 4 && LOFF(5) == 16 && LOFF(6) == 24 && LOFF(64) == 2112, "packed lower-triangular row offsets");
struct GpPre { v4u q0, q1, k0, k1; float g, beta; };
__device__ __forceinline__ void gdn_prep_load(const Ctx& c, int item, GpPre& p) {
    const int n = item % GDN_NCH, bhd = item / GDN_NCH, dir = bhd & 1, h = (bhd >> 1) & 3, b = bhd >> 3;
    const bf16* QKV = (const bf16*)(c.ws + WS_QKV); const float* GB = (const float*)(c.ws + WS_GB);
    const int s = c.tid >> 3, seg = c.tid & 7; const bf16* rp = QKV + (size_t)scan_row(b, dir, n * 64 + s) * 1536 + h * 128 + seg * 16;
    p.q0 = *(const v4u*)rp; p.q1 = *(const v4u*)(rp + 8); p.k0 = *(const v4u*)(rp + 512); p.k1 = *(const v4u*)(rp + 520);
    const size_t rl = (size_t)scan_row(b, dir, n * 64 + c.lane) * 16 + dir * 4 + h; p.g = GB[rl]; p.beta = GB[rl + 8];
}
__device__ __forceinline__ void gdn_prep_stage(const Ctx& c, int item, int item_next, float* Lp, GpPre& p) {
    bf16* Kr = (bf16*)(c.lds + GP_KR); bf16* Qr = (bf16*)(c.lds + GP_QR); bf16* Kt = (bf16*)(c.lds + GP_KT); float* tab = (float*)(c.lds + GP_TAB);
    unsigned char* frA = c.ws + WS_FRA + (size_t)item * FR_ATT_BYTES; unsigned char* frK = c.ws + WS_FRK + (size_t)item * FR_KD_BYTES; float* frTab = (float*)(c.ws + WS_FRTAB + (size_t)item * FR_TAB_BYTES);
    const int r = c.lane & 31, hh = c.lane >> 5;
    if (c.wave == 0) { float g = p.g; const float beta = p.beta;
#pragma unroll
        for (int o = 1; o < 64; o <<= 1) { const float t = __shfl_up(g, o); if (c.lane >= o) g += t; }
        const float gl = __shfl(g, 63);
        tab[c.lane] = g; tab[64 + c.lane] = beta; tab[128 + c.lane] = __expf(g); tab[192 + c.lane] = __expf(gl - g); }
    { const int s = c.tid >> 3, seg = c.tid & 7;
      const v4u q0 = p.q0, q1 = p.q1, k0 = p.k0, k1 = p.k1;
      gdn_prep_load(c, item_next, p);
      *(v4u*)(Qr + s * 136 + seg * 16) = q0; *(v4u*)(Qr + s * 136 + seg * 16 + 8) = q1; *(v4u*)(Kr + s * 136 + seg * 16) = k0; *(v4u*)(Kr + s * 136 + seg * 16 + 8) = k1;
      const unsigned kw[8] = {k0.x, k0.y, k0.z, k0.w, k1.x, k1.y, k1.z, k1.w};
#pragma unroll
      for (int e = 0; e < 8; ++e) { Kt[(seg * 16 + 2 * e) * 72 + s] = (bf16)(kw[e] & 0xffffu); Kt[(seg * 16 + 2 * e + 1) * 72 + s] = (bf16)(kw[e] >> 16); } }
    __syncthreads();
    if (c.wave < 3) { const int ct = c.wave ? 1 : 0, st = c.wave == 2 ? 1 : 0;
        f32x16 acc;
#pragma unroll
        for (int i = 0; i < 16; ++i) acc[i] = 0.f;
#pragma unroll
        for (int kk = 0; kk < 8; ++kk) { const bf16x8 a = *(const bf16x8*)(Kr + (ct * 32 + r) * 136 + kk * 16 + hh * 8), bb = *(const bf16x8*)(Kr + (st * 32 + r) * 136 + kk * 16 + hh * 8); acc = MFMA32(a, bb, acc); }
        const int s = st * 32 + r; const float gcs = tab[s];
#pragma unroll
        for (int i = 0; i < 16; ++i) { const int cc = ct * 32 + crow16(i, hh); if (s < cc) Lp[LOFF(cc) + s] = tab[64 + cc] * acc[i] * __expf(tab[cc] - gcs); }
    } else if (c.wave < 6) { const int w = c.wave - 3, st = w == 2 ? 1 : 0, ct = w ? 1 : 0;
        f32x16 acc;
#pragma unroll
        for (int i = 0; i < 16; ++i) acc[i] = 0.f;
#pragma unroll
        for (int kk = 0; kk < 8; ++kk) { const bf16x8 a = *(const bf16x8*)(Kr + (st * 32 + r) * 136 + kk * 16 + hh * 8), bb = *(const bf16x8*)(Qr + (ct * 32 + r) * 136 + kk * 16 + hh * 8); acc = MFMA32(a, bb, acc); }
        const int cc = ct * 32 + r; const float gcc = tab[cc];
#pragma unroll
        for (int i = 0; i < 16; ++i) { const int s = st * 32 + crow16(i, hh); acc[i] = (s <= cc) ? acc[i] * __expf(gcc - tab[s]) : 0.f; }
        *(bf16x8*)(frA + ((size_t)((ct * 4 + 2 * st) * 64 + c.lane)) * 16) = pack_step(acc, 0);
        *(bf16x8*)(frA + ((size_t)((ct * 4 + 2 * st + 1) * 64 + c.lane)) * 16) = pack_step(acc, 1);
    } else { const int w = c.wave - 6;
#pragma unroll
        for (int f = 0; f < 8; ++f) { const int fi = w * 8 + f, dkt = fi >> 2, cb = fi & 3; const bf16* kp = Kt + (dkt * 32 + r) * 72 + 16 * cb + 4 * hh;
            const v2u lo = *(const v2u*)kp, hi = *(const v2u*)(kp + 8); const f32x4 e0 = *(const f32x4*)(tab + 192 + 16 * cb + 4 * hh), e1 = *(const f32x4*)(tab + 192 + 16 * cb + 8 + 4 * hh);
            v4u o; o.x = pk2(bflo(lo.x) * e0.x, bfhi(lo.x) * e0.y); o.y = pk2(bflo(lo.y) * e0.z, bfhi(lo.y) * e0.w); o.z = pk2(bflo(hi.x) * e1.x, bfhi(hi.x) * e1.y); o.w = pk2(bflo(hi.y) * e1.z, bfhi(hi.y) * e1.w);
            *(v4u*)(frK + ((size_t)(fi * 64 + c.lane)) * 16) = o; }
        if (w == 0) { const v4u z = (v4u){0u, 0u, 0u, 0u}; *(v4u*)(frA + ((size_t)((0 * 4 + 2) * 64 + c.lane)) * 16) = z; *(v4u*)(frA + ((size_t)((0 * 4 + 3) * 64 + c.lane)) * 16) = z; }
        else { *(f32x4*)(frTab + 4 * c.lane) = *(const f32x4*)(tab + 4 * c.lane); }
    }
    __syncthreads();
}
__device__ __forceinline__ int loff_rt(int i) { return i < 1 ? 0 : 4 * (((i - 1) >> 2) + 1) * (2 * ((i - 1) >> 2) + ((i - 1) & 3)); }
__device__ __forceinline__ void gdn_prep_solve(const Ctx& c, int item, float* Lp) {
    const int r = c.lane & 31, hh = c.lane >> 5;
    { float Tr[32];
#pragma unroll
      for (int i = 0; i < 32; ++i) { int je = r, bl = hh; asm volatile("" : "+v"(je), "+v"(bl)); float a0 = (je == i) ? 1.f : 0.f, a1 = 0.f;
          const int ro = bl ? LOFF(32 + i) + 32 : LOFF(i);
#pragma unroll
          for (int s4 = 0; s4 < (i + 3) / 4; ++s4) { const f32x4 l4 = *(const f32x4*)(Lp + ro + 4 * s4);
              if (4 * s4 + 0 < i) a0 = fmaf(-l4.x, Tr[4 * s4 + 0], a0); if (4 * s4 + 1 < i) a1 = fmaf(-l4.y, Tr[4 * s4 + 1], a1); if (4 * s4 + 2 < i) a0 = fmaf(-l4.z, Tr[4 * s4 + 2], a0); if (4 * s4 + 3 < i) a1 = fmaf(-l4.w, Tr[4 * s4 + 3], a1); }
          Tr[i] = a0 + a1; Lp[(je < i) ? ro + je : 2112 + 32 * bl + je] = Tr[i]; } }
    WAVE_LDS_SYNC();
    { const int offA = loff_rt(32 + r);
      f32x16 X;
#pragma unroll
      for (int i = 0; i < 16; ++i) X[i] = 0.f;
#pragma unroll
      for (int q = 0; q < 4; ++q) { const f32x4 a4 = *(const f32x4*)(Lp + offA + 16 * hh + 4 * q);
#pragma unroll
          for (int e = 0; e < 4; ++e) { const int kk = 4 * q + e; int hq = hh; asm volatile("" : "+v"(hq)); const int k = 16 * hq + kk;
              const float t = Lp[(hq ? LOFF(16 + kk) : LOFF(kk)) + r]; const float b = (r < k) ? t : (r == k ? 1.f : 0.f);
              X = __builtin_amdgcn_mfma_f32_32x32x2f32(a4[e], b, X, 0, 0, 0); } }
      f32x16 Y;
#pragma unroll
      for (int i = 0; i < 16; ++i) Y[i] = 0.f;
#pragma unroll
      for (int q = 0; q < 4; ++q) { const int k0 = 8 * q + 4 * hh; const f32x4 t4 = *(const f32x4*)(Lp + offA + 32 + k0);
#pragma unroll
          for (int e = 0; e < 4; ++e) { const int kq = k0 + e; const float av = (kq < r) ? t4[e] : (kq == r ? 1.f : 0.f);
              Y = __builtin_amdgcn_mfma_f32_32x32x2f32(av, X[4 * q + e], Y, 0, 0, 0); } }
#pragma unroll
      for (int i = 0; i < 16; ++i) { int hq = hh; asm volatile("" : "+v"(hq)); const int cb = (i & 3) + 8 * (i >> 2);
          Lp[(hq ? LOFF(32 + cb + 4) : LOFF(32 + cb)) + r] = -Y[i]; } }
    WAVE_LDS_SYNC();
    unsigned char* frT = c.ws + WS_FRT + (size_t)item * FR_T_BYTES;
#pragma unroll
    for (int f = 0; f < 8; ++f) { const int ct = f >> 2, sb = f & 3, cc = ct * 32 + r; float v[8];
#pragma unroll
        for (int q = 0; q < 2; ++q) { const int s0 = 16 * sb + 8 * q + 4 * hh;
            f32x4 t4 = (f32x4){0.f, 0.f, 0.f, 0.f}; if (s0 < cc) t4 = *(const f32x4*)(Lp + LOFF(cc) + s0);
            v[4 * q + 0] = (s0 + 0 < cc) ? t4.x : (s0 + 0 == cc ? 1.f : 0.f); v[4 * q + 1] = (s0 + 1 < cc) ? t4.y : (s0 + 1 == cc ? 1.f : 0.f);
            v[4 * q + 2] = (s0 + 2 < cc) ? t4.z : (s0 + 2 == cc ? 1.f : 0.f); v[4 * q + 3] = (s0 + 3 < cc) ? t4.w : (s0 + 3 == cc ? 1.f : 0.f); }
        *(v4u*)(frT + ((size_t)(f * 64 + c.lane)) * 16) = (v4u){pk2(v[0], v[1]), pk2(v[2], v[3]), pk2(v[4], v[5]), pk2(v[6], v[7])}; }
}
__device__ __forceinline__ void phase_gdn_prep(const Ctx& c) {
    const int nit = c.bid < GDN_ITEMS ? (GDN_ITEMS - 1 - c.bid) / c.G + 1 : 0;
    bool scanned = false;
    if (nit > 0) {
        GpPre p; gdn_prep_load(c, c.bid, p);
#pragma unroll 1
        for (int j = 0; j < nit; ++j) { const int item = c.bid + j * c.G, q = j & 7; int nx = item + c.G; nx = nx < GDN_ITEMS ? nx : item;
            gdn_prep_stage(c, item, nx, (float*)(c.lds + GP_LP + q * GP_LPB), p);
            if (q == 7 || j == nit - 1) { const int cnt = q + 1;
                if (c.wave < cnt) gdn_prep_solve(c, c.bid + ((j & ~7) + c.wave) * c.G, (float*)(c.lds + GP_LP + c.wave * GP_LPB));
                else if (j == nit - 1) { for (int t = c.bid + (c.wave - cnt) * c.G; t < 512; t += (8 - cnt) * c.G) s5_state_scan(c, t); }
                if (j == nit - 1 && cnt < 8) scanned = true;
                __syncthreads(); } }
    }
    if (!scanned) for (int t = c.bid + c.wave * c.G; t < 512; t += 8 * c.G) s5_state_scan(c, t);
}

constexpr int GR_K = 0, GR_Q = 16384, GR_T = 32768, GR_A = 40960, GR_KD = 49152, GR_TAB = 65536, GR_V = 66560, GR_BUF = 74752;
static_assert(2 * GR_BUF + 64 <= LDS_BYTES, "recurrence buffers");
__device__ __forceinline__ void gdn_rec_fetch(const Ctx& c, int bhd, int dvhalf, int n, v4u (&st)[19]) {
    const int dir = bhd & 1, h = (bhd >> 1) & 3, b = bhd >> 3, lw = c.wave - 4; const int item = bhd * GDN_NCH + n;
    int ln = c.lane; asm volatile("" : "+v"(ln));
    const unsigned char* QKVb = c.ws + WS_QKV;
#pragma unroll
    for (int q = 0; q < 4; ++q) { const int qi = lw + 4 * q;
        const int s = 4 * qi + (ln >> 4), ps = ln & 15, p = ps ^ (s & 15); const size_t rowb = (size_t)scan_row(b, dir, n * 64 + s) * 3072 + (size_t)h * 256 + p * 16;
        st[2 * q] = *(const v4u*)(QKVb + rowb + 1024); st[2 * q + 1] = *(const v4u*)(QKVb + rowb); }
    const unsigned char* frT = c.ws + WS_FRT + (size_t)item * FR_T_BYTES; const unsigned char* frA = c.ws + WS_FRA + (size_t)item * FR_ATT_BYTES; const unsigned char* frK = c.ws + WS_FRK + (size_t)item * FR_KD_BYTES;
#pragma unroll
    for (int q = 0; q < 2; ++q) { const int qi = lw + 4 * q; st[8 + 2 * q] = *(const v4u*)(frT + qi * 1024 + ln * 16); st[9 + 2 * q] = *(const v4u*)(frA + qi * 1024 + ln * 16); }
#pragma unroll
    for (int q = 0; q < 4; ++q) { const int qi = lw + 4 * q; st[12 + q] = *(const v4u*)(frK + qi * 1024 + ln * 16); }
    st[16] = *(const v4u*)(c.ws + WS_FRTAB + (size_t)item * FR_TAB_BYTES + ln * 16);
#pragma unroll
    for (int q = 0; q < 2; ++q) { const int qi = lw + 4 * q, s = 8 * qi + (ln >> 3);
        st[17 + q] = *(const v4u*)(QKVb + (size_t)scan_row(b, dir, n * 64 + s) * 3072 + 2048 + (size_t)h * 256 + dvhalf * 128 + (ln & 7) * 16); }
}
__device__ __forceinline__ void gdn_rec_put(const Ctx& c, int buf, const v4u (&st)[19]) {
    const int lw = c.wave - 4; unsigned char* base = c.lds + buf * GR_BUF + c.lane * 16;
#pragma unroll
    for (int q = 0; q < 4; ++q) { const int qi = lw + 4 * q; *(v4u*)(base + GR_K + qi * 1024) = st[2 * q]; *(v4u*)(base + GR_Q + qi * 1024) = st[2 * q + 1]; }
#pragma unroll
    for (int q = 0; q < 2; ++q) { const int qi = lw + 4 * q; *(v4u*)(base + GR_T + qi * 1024) = st[8 + 2 * q]; *(v4u*)(base + GR_A + qi * 1024) = st[9 + 2 * q]; }
#pragma unroll
    for (int q = 0; q < 4; ++q) { const int qi = lw + 4 * q; *(v4u*)(base + GR_KD + qi * 1024) = st[12 + q]; }
    if (lw == 0) *(v4u*)(base + GR_TAB) = st[16];
#pragma unroll
    for (int q = 0; q < 2; ++q) { const int qi = lw + 4 * q; *(v4u*)(base + GR_V + qi * 1024) = st[17 + q]; }
}
__device__ __forceinline__ bf16x8 gr_rowfrag(const unsigned char* rowp, const int (&po)[16], int kb) {
    const v2u lo = *(const v2u*)(rowp + po[2 * kb]), hi = *(const v2u*)(rowp + po[2 * kb + 1]);
    return __builtin_bit_cast(bf16x8, (v4u){lo.x, lo.y, hi.x, hi.y});
}
__device__ __forceinline__ void gdn_rec_block(const Ctx& c, int bhd, int dvhalf) {
    const int dir = bhd & 1, h = (bhd >> 1) & 3, b = bhd >> 3, r = c.lane & 31, hh = c.lane >> 5, dvt = 2 * dvhalf + (c.wave & 1);
    const bf16* QKV = (const bf16*)(c.ws + WS_QKV); bf16* OG = (bf16*)(c.ws + WS_OG) + (size_t)dir * ML * 512;
    f32x16 S[4];
#pragma unroll
    for (int t = 0; t < 4; ++t)
#pragma unroll
        for (int i = 0; i < 16; ++i) S[t][i] = 0.f;
    int po[16];
#pragma unroll
    for (int p = 0; p < 16; ++p) po[p] = r * 256 + ((p ^ (r & 15)) * 16) + 8 * hh;
#define GR_STEP_BARRIER() do { asm volatile("s_waitcnt lgkmcnt(0)" ::: "memory"); __builtin_amdgcn_s_barrier(); asm volatile("" ::: "memory"); } while (0)
    if (c.wave >= 4) {
        v4u st[19];
        gdn_rec_fetch(c, bhd, dvhalf, 0, st); gdn_rec_put(c, 0, st); gdn_rec_fetch(c, bhd, dvhalf, 1, st);
        GR_STEP_BARRIER();
#pragma unroll 1
        for (int n = 0; n < GDN_NCH; ++n) {
            if (n + 1 < GDN_NCH) gdn_rec_put(c, (n + 1) & 1, st);
            { const int nn = n + 2 < GDN_NCH ? n + 2 : GDN_NCH - 1; gdn_rec_fetch(c, bhd, dvhalf, nn, st); }
            GR_STEP_BARRIER(); }
    } else if (c.wave >= 2) {
        GR_STEP_BARRIER();
#pragma unroll 1
        for (int n = 0; n < GDN_NCH; ++n) GR_STEP_BARRIER();
    } else {
    GR_STEP_BARRIER();
#define GR_FENCE() asm volatile("" ::: "memory")
#define GR_LOADROW(F, AREA, T8) do { _Pragma("unroll") for (int kb = 0; kb < 8; ++kb) F[kb] = gr_rowfrag(base + (AREA) + (T8) * 8192, po, kb); } while (0)
#define GR_FRAG(AREA, IDX) (*(const bf16x8*)(base + (AREA) + ((IDX) * 64 + c.lane) * 16))
#define GR_LOADV(DST, ST) do { _Pragma("unroll") for (int i = 0; i < 16; ++i) DST[i] = vl[((ST) * 32 + (i & 3) + 8 * (i >> 2)) * 64]; } while (0)
    for (int n = 0; n < GDN_NCH; ++n) {
        const int buf = n & 1;
        {
            const unsigned char* base = c.lds + buf * GR_BUF; const float* tab = (const float*)(base + GR_TAB);
            const int row0 = scan_row(b, dir, n * 64), sgn = dir ? -1 : 1;
            const bf16* vl = (const bf16*)(base + GR_V) + (4 * hh) * 64 + (c.wave & 1) * 32 + r;
            const unsigned ob = (unsigned)(((row0 + sgn * 4 * hh) * 512 + h * 128 + dvt * 32 + r) * 2); const int ostb = sgn * 1024;
            bf16x8 fr[3][4], tf[6]; bf16 vv[16];
            bf16x8 Rf[2][2], Vf[2][2];
            unsigned oK0 = GR_K, oK1 = GR_K + 8192, oQ0 = GR_Q, oQ1 = GR_Q + 8192; asm volatile("" : "+v"(oK0), "+v"(oK1), "+v"(oQ0), "+v"(oQ1));
#define GR_LD4(SLOT, KB) do { fr[SLOT][0] = gr_rowfrag(base + oK0, po, KB); fr[SLOT][1] = gr_rowfrag(base + oK1, po, KB); fr[SLOT][2] = gr_rowfrag(base + oQ0, po, KB); fr[SLOT][3] = gr_rowfrag(base + oQ1, po, KB); } while (0)
            GR_LD4(0, 0); GR_LD4(1, 1); GR_FENCE();
            f32x16 acc0, acc1, aq0, aq1;
#pragma unroll
            for (int i = 0; i < 16; ++i) { acc0[i] = 0.f; acc1[i] = 0.f; aq0[i] = 0.f; aq1[i] = 0.f; }
#pragma unroll
            for (int kb = 0; kb < 8; ++kb) {
                if (kb + 2 < 8) GR_LD4((kb + 2) % 3, kb + 2);
                else if (kb == 6) { tf[0] = GR_FRAG(GR_T, 0); tf[1] = GR_FRAG(GR_T, 1); tf[2] = GR_FRAG(GR_T, 4); tf[3] = GR_FRAG(GR_T, 5); tf[4] = GR_FRAG(GR_T, 6); tf[5] = GR_FRAG(GR_T, 7); }
                GR_FENCE();
                const bf16x8 sp = pack_step(S[kb >> 1], kb & 1);
                acc0 = MFMA32(fr[kb % 3][0], sp, acc0); acc1 = MFMA32(fr[kb % 3][1], sp, acc1); aq0 = MFMA32(fr[kb % 3][2], sp, aq0); aq1 = MFMA32(fr[kb % 3][3], sp, aq1); }
            GR_LOADV(vv, 0); GR_FENCE();
#pragma unroll
            for (int i = 0; i < 16; ++i) { const int s = crow16(i, hh); acc0[i] = tab[64 + s] * (bf1(vv[i]) - tab[128 + s] * acc0[i]); }
            Rf[0][0] = pack_step(acc0, 0); Rf[0][1] = pack_step(acc0, 1);
            GR_LOADV(vv, 1); GR_FENCE();
#pragma unroll
            for (int i = 0; i < 16; ++i) { const int s = 32 + crow16(i, hh); acc1[i] = tab[64 + s] * (bf1(vv[i]) - tab[128 + s] * acc1[i]); }
            Rf[1][0] = pack_step(acc1, 0); Rf[1][1] = pack_step(acc1, 1);
#pragma unroll
            for (int i = 0; i < 16; ++i) { acc0[i] = 0.f; acc1[i] = 0.f; }
            acc1 = MFMA32(tf[2], Rf[0][0], acc1); acc0 = MFMA32(tf[0], Rf[0][0], acc0); acc1 = MFMA32(tf[3], Rf[0][1], acc1); acc0 = MFMA32(tf[1], Rf[0][1], acc0);
            acc1 = MFMA32(tf[4], Rf[1][0], acc1); acc1 = MFMA32(tf[5], Rf[1][1], acc1);
            tf[0] = GR_FRAG(GR_A, 0); tf[1] = GR_FRAG(GR_A, 1); tf[2] = GR_FRAG(GR_A, 4); tf[3] = GR_FRAG(GR_A, 5); tf[4] = GR_FRAG(GR_A, 6); tf[5] = GR_FRAG(GR_A, 7); GR_FENCE();
#pragma unroll
            for (int i = 0; i < 16; ++i) { aq0[i] *= tab[128 + crow16(i, hh)]; aq1[i] *= tab[128 + 32 + crow16(i, hh)]; }
            Vf[0][0] = pack_step(acc0, 0); Vf[0][1] = pack_step(acc0, 1); Vf[1][0] = pack_step(acc1, 0); Vf[1][1] = pack_step(acc1, 1);
            aq1 = MFMA32(tf[2], Vf[0][0], aq1); aq0 = MFMA32(tf[0], Vf[0][0], aq0); aq1 = MFMA32(tf[3], Vf[0][1], aq1); aq0 = MFMA32(tf[1], Vf[0][1], aq0);
            aq1 = MFMA32(tf[4], Vf[1][0], aq1); aq1 = MFMA32(tf[5], Vf[1][1], aq1);
            if (n >= 4) {
#pragma unroll
                for (int i = 0; i < 16; i += 2) { const unsigned p0 = pk2(aq0[i], aq0[i + 1]), p1 = pk2(aq1[i], aq1[i + 1]); const int k0 = (i & 3) + 8 * (i >> 2);
                    unsigned char* ogb = (unsigned char*)OG;
                    *(bf16*)(ogb + (unsigned)(ob + (unsigned)(ostb * k0))) = (bf16)(p0 & 0xffffu); *(bf16*)(ogb + (unsigned)(ob + (unsigned)(ostb * (k0 + 1)))) = (bf16)(p0 >> 16);
                    *(bf16*)(ogb + (unsigned)(ob + (unsigned)(ostb * (32 + k0)))) = (bf16)(p1 & 0xffffu); *(bf16*)(ogb + (unsigned)(ob + (unsigned)(ostb * (33 + k0)))) = (bf16)(p1 >> 16); } }
            bf16x8 kd[16];
#pragma unroll
            for (int q = 0; q < 16; ++q) kd[q] = GR_FRAG(GR_KD, q);
            GR_FENCE();
            const float gtot = tab[128 + 63];
#pragma unroll
            for (int t = 0; t < 4; ++t) {
#pragma unroll
                for (int i = 0; i < 16; ++i) S[t][i] *= gtot; }
#pragma unroll
            for (int cb = 0; cb < 4; ++cb) {
#pragma unroll
                for (int t = 0; t < 4; ++t) S[t] = MFMA32(kd[t * 4 + cb], Vf[cb >> 1][cb & 1], S[t]); }
#undef GR_LD4
        }
        GR_STEP_BARRIER();
    }
    }
    asm volatile("s_waitcnt vmcnt(0)" ::: "memory"); __syncthreads();
#undef GR_STEP_BARRIER
#undef GR_FENCE
#undef GR_LOADROW
#undef GR_FRAG
#undef GR_LOADV
}
__device__ __forceinline__ void phase_gdn_rec(const Ctx& c) { if (c.bid < 128) gdn_rec_block(c, c.bid >> 1, c.bid & 1); }

#define XB_TMO      128
#define XB_XCNT(j)  (256  + 64 * (j))
#define XB_XSUB(j)  (1280 + 64 * (j))
#define XB_XGEN(j)  (2304 + 64 * (j))
#define XB_TOP      3328
#define XB_TOPGEN   3392
#define XCD_BAR_WORDS 3456
#define XB_SPIN_CAP (1u << 20)
__device__ __forceinline__ unsigned xb_ld(unsigned* p)              { return __hip_atomic_load(p, __ATOMIC_RELAXED, __HIP_MEMORY_SCOPE_AGENT); }
__device__ __forceinline__ unsigned xb_add(unsigned* p, unsigned v) { return __hip_atomic_fetch_add(p, v, __ATOMIC_RELAXED, __HIP_MEMORY_SCOPE_AGENT); }
__device__ __forceinline__ unsigned xb_xcc_id() { return (unsigned)__builtin_amdgcn_s_getreg((3 << 11) | 20) & 0xFu; }
#define XB_SPIN(cond, bar) do { unsigned _sp = 0; while (cond) { __builtin_amdgcn_s_sleep(1); \
    if ((++_sp & 255u) == 0u) { if (xb_ld(&(bar)[XB_TMO])) break; if (_sp > XB_SPIN_CAP) { atomicAdd(&(bar)[XB_TMO], 1u); break; } } } } while (0)
struct XcdBarrier { unsigned* bar; unsigned x; volatile LAS unsigned* st; };
__device__ __forceinline__ XcdBarrier xcd_barrier_post(unsigned* bar, volatile LAS unsigned* st) {
    XcdBarrier b; b.bar = bar; b.x = xb_xcc_id(); b.st = st;
    if (threadIdx.x == 0) (void)xb_add(&bar[XB_XCNT(b.x)], 1u);
    return b;
}
__device__ __forceinline__ void xcd_barrier_complete(unsigned* bar, unsigned x, unsigned& nloc, unsigned& nx) {
    const unsigned G = gridDim.x * gridDim.y * gridDim.z;
    unsigned sum, cnt, mine, sp = 0u;
    for (;;) {
        sum = 0u; cnt = 0u; mine = 0u;
#pragma unroll
        for (unsigned j = 0; j < 16; ++j) { const unsigned c = xb_ld(&bar[XB_XCNT(j)]); sum += c; cnt += (c > 0u) ? 1u : 0u; mine = (j == x) ? c : mine; }
        if (sum == G) break;
        __builtin_amdgcn_s_sleep(1);
        if ((++sp & 255u) == 0u) { if (xb_ld(&bar[XB_TMO])) break; if (sp > XB_SPIN_CAP) { atomicAdd(&bar[XB_TMO], 1u); break; } }
    }
    nloc = mine > 0u ? mine : 1u; nx = cnt > 0u ? cnt : 1u;
}
__device__ __forceinline__ void xcd_barrier(const XcdBarrier& b) {
    asm volatile("s_waitcnt vmcnt(0)" ::: "memory");
    __syncthreads();
    if (threadIdx.x == 0) {
        unsigned* bar = b.bar;
        __builtin_amdgcn_s_waitcnt(0);
        unsigned nloc = b.st[0], nx = b.st[1];
        if (nloc == 0u) { xcd_barrier_complete(bar, b.x, nloc, nx); b.st[0] = nloc; b.st[1] = nx; }
        const unsigned old = xb_add(&bar[XB_XSUB(b.x)], 1u);
        const unsigned gen = old / nloc;
        if (old + 1u == (gen + 1u) * nloc) {
            __builtin_amdgcn_fence(__ATOMIC_RELEASE, "agent");
            asm volatile("s_waitcnt vmcnt(0)" ::: "memory");
            const unsigned og = xb_add(&bar[XB_TOP], 1u);
            const unsigned tg = og / nx;
            if (og + 1u == (tg + 1u) * nx) xb_add(&bar[XB_TOPGEN], 1u);
            else XB_SPIN(xb_ld(&bar[XB_TOPGEN]) == tg, bar);
            __builtin_amdgcn_fence(__ATOMIC_ACQUIRE, "agent");
            xb_add(&bar[XB_XGEN(b.x)], 1u);
            asm volatile("s_waitcnt vmcnt(0)" ::: "memory");
        } else {
            XB_SPIN(xb_ld(&bar[XB_XGEN(b.x)]) == gen, bar);
            __builtin_amdgcn_fence(__ATOMIC_ACQUIRE, "agent");
            asm volatile("s_waitcnt vmcnt(0)" ::: "memory");
        }
    }
    __syncthreads();
}

constexpr int LDS_MISC = LDS_BYTES - 64;
__global__ void __launch_bounds__(NTHREADS, 2) mk_fwd(Args args) {
    extern __shared__ __attribute__((aligned(16))) unsigned char lds[];
    Ctx c; c.a = &args; c.ws = args.ws; c.lds = lds;
    c.tid = threadIdx.x; c.lane = c.tid & 63; c.wave = __builtin_amdgcn_readfirstlane(c.tid >> 6); c.bid = blockIdx.x; c.G = gridDim.x;
    c.gw = c.bid * NWAVES + c.wave; c.NGW = c.G * NWAVES; c.gwv = c.wave * c.G + c.bid;
    const int lo = args.ph_lo, hi = args.ph_hi;
    PG8_LAS unsigned char* ring = (PG8_LAS unsigned char*)lds;
#ifndef MK_PH_MASK
#define MK_PH_MASK 0xffff
#endif
#define IN(k) (((MK_PH_MASK >> (k)) & 1) && lo <= (k) && (k) < hi)
#if MK_ONE_LAUNCH
    cg::grid_group grid = cg::this_grid();
    if (lo < 0) grid.sync();
    volatile LAS unsigned* st = (volatile LAS unsigned*)((LAS unsigned char*)lds + LDS_MISC);
    if (c.tid < 2) st[c.tid] = 0u;
    __syncthreads();
    const XcdBarrier bar = xcd_barrier_post((unsigned*)(c.ws + WS_CTL) + CW_BAR, st);
#define SEAM(k) do { if (IN(k) && IN((k) + 1)) xcd_barrier(bar); } while (0)
#else
#define SEAM(k) do { } while (0)
#endif
    if (IN(0)) { phase_prep(c); phase_s5_build(c); } SEAM(0);
    if (IN(1)) { phase_norm1(c); } SEAM(1);
    if (IN(2)) { pg8::Gemm g{(const pg8::bf16_t*)(c.ws + WS_HX), (const pg8::bf16_t*)(c.ws + WS_WIN), 1024, 1024, 1024}; pg8::StaticOrder S; S.init(MT, NPROJ, c.G, c.bid);
        pg8::EpiInProj E{(pg8::bf16_t*)(c.ws + WS_U5), (pg8::bf16_t*)(c.ws + WS_QKVPRE), (pg8::bf16_t*)(c.ws + WS_Z)};
        pg8::gemm_phase<pg8::EpiInProj, pg8::StaticOrder, true, true>(ring, g, S, E); } SEAM(2);
    if (IN(3)) { { pg8::Gemm g{(const pg8::bf16_t*)(c.ws + WS_U5), (const pg8::bf16_t*)(c.ws + WS_PM), 768, 512, 512}; pg8::SchedSS S{c.G, c.bid}; pg8::EpiSS E{(float*)(c.ws + WS_SS)};
          pg8::gemm_phase<pg8::EpiSS, pg8::SchedSS, true, true>(ring, g, S, E); }
        __syncthreads(); phase_conv(c); } SEAM(3);
    if (IN(4)) { phase_gdn_prep(c); } SEAM(4);
    if (IN(5)) { pg8::Gemm g{(const pg8::bf16_t*)(c.ws + WS_U5), (const pg8::bf16_t*)(c.ws + WS_BB), 768, 768, 768}; pg8::SchedS5Y S{c.G, c.bid}; pg8::EpiS5Y E{(pg8::bf16_t*)(c.ws + WS_YG)};
        pg8::gemm_phase<pg8::EpiS5Y, pg8::SchedS5Y, true, true>(ring, g, S, E); } SEAM(5);
    if (IN(6)) { if (c.bid < 128) phase_gdn_rec(c);
        else { pg8::Gemm g{(const pg8::bf16_t*)(c.ws + WS_YG), (const pg8::bf16_t*)(c.ws + WS_WGLU), 512, 512, 512}; pg8::StaticOrder S; S.init(ML, 512, c.G - 128, c.bid - 128);
            pg8::EpiGlu E{(const pg8::bf16_t*)(c.ws + WS_YG), (pg8::bf16_t*)(c.ws + WS_CAT)};
            pg8::gemm_phase<pg8::EpiGlu, pg8::StaticOrder, true, true>(ring, g, S, E); } } SEAM(6);
    if (IN(7)) { phase_combine(c); } SEAM(7);
    if (IN(8)) { pg8::Gemm g{(const pg8::bf16_t*)(c.ws + WS_CAT), (const pg8::bf16_t*)(c.ws + WS_WOUT), 1024, 1024, 1024}; pg8::StaticOrder S; S.init(ML, 1024, c.G, c.bid);
        pg8::EpiBf16<0> E{(pg8::bf16_t*)(c.ws + WS_YRAW), 1024, nullptr, 0, 0, 1.f};
        pg8::gemm_phase<pg8::EpiBf16<0>, pg8::StaticOrder, true, true>(ring, g, S, E); } SEAM(8);
    if (IN(9)) { phase_rows2(c); phase_fp8_tables(c); } SEAM(9);
    if (IN(10)) { pg8::Gemm g{(const pg8::bf16_t*)(c.ws + WS_HX2), (const pg8::bf16_t*)(c.ws + WS_WQ), 1024, 1024, 1024}; pg8::StaticOrder S; S.init(ML, 2048, c.G, c.bid);
        pg8::EpiBf16<0> E{(pg8::bf16_t*)(c.ws + WS_QP), 2048, nullptr, 0, 0, 1.f};
        pg8::gemm_phase<pg8::EpiBf16<0>, pg8::StaticOrder, true, true>(ring, g, S, E); } SEAM(10);
    if (IN(11)) { phase_topk(c); } SEAM(11);
    if (IN(12)) { phase_exp1(c); } SEAM(12);
    if (IN(13)) { phase_exp1b(c); } SEAM(13);
    if (IN(14)) { phase_exp2(c); } SEAM(14);
    if (IN(15)) { phase_exp3(c); }
#undef IN
#undef SEAM
}

extern "C" void kernel_launch(void* const* d_in, const int* in_sizes, int n_in, void* d_out, int out_size, void* d_ws, size_t ws_size, hipStream_t stream) {
    static int grid = 0;
    if (grid == 0) {
        if (n_in != 29 || out_size != ML * D || ws_size < WS_END) { fprintf(stderr, "kernel_launch: unexpected shapes (n_in %d out %d ws %zu)\n", n_in, out_size, ws_size); grid = -1; return; }
        int dev = 0, cus = 0, per_cu = 0;
        (void)hipGetDevice(&dev); (void)hipDeviceGetAttribute(&cus, hipDeviceAttributeMultiprocessorCount, dev);
        if (hipFuncSetAttribute((const void*)mk_fwd, hipFuncAttributeMaxDynamicSharedMemorySize, LDS_BYTES) != hipSuccess) { fprintf(stderr, "kernel_launch: hipFuncSetAttribute failed\n"); grid = -1; return; }
        (void)hipOccupancyMaxActiveBlocksPerMultiprocessor(&per_cu, (const void*)mk_fwd, NTHREADS, LDS_BYTES);
        (void)hipGetLastError();
        grid = cus;
        fprintf(stderr, "kernel_launch: cus %d per_cu %d grid %d\n", cus, per_cu, grid);
    }
    if (grid < 0) return;
    Args a{};
    for (int i = 0; i < 29; ++i) a.in[i] = (const float*)d_in[i];
    a.out = (float*)d_out; a.ws = (unsigned char*)d_ws;
    (void)hipMemsetAsync((char*)d_ws + WS_CTL, 0, CTL_ZERO_BYTES, stream);
#if MK_ONE_LAUNCH
    a.ph_lo = 0; a.ph_hi = NPHASES;
    void* kargs[] = {&a};
    hipError_t e = hipLaunchCooperativeKernel((const void*)mk_fwd, dim3(grid), dim3(NTHREADS), kargs, LDS_BYTES, stream);
    if (e != hipSuccess) fprintf(stderr, "kernel_launch: cooperative launch failed: %s\n", hipGetErrorString(e));
#else
    for (int ph = 0; ph < NPHASES; ++ph) { a.ph_lo = ph; a.ph_hi = ph + 1; hipLaunchKernelGGL(mk_fwd, dim3(grid), dim3(NTHREADS), LDS_BYTES, stream, a); }
#endif
}
```

```cpp
#include <hip/hip_runtime.h>
#include <hip/hip_cooperative_groups.h>
#include <cstdio>
#include <cstdint>
namespace cg = cooperative_groups;
namespace pg8 {
#define PG8_LAS __attribute__((address_space(3)))
typedef unsigned short bf16_t;
typedef short bf16x8 __attribute__((ext_vector_type(8)));
typedef float f32x4 __attribute__((ext_vector_type(4)));
typedef unsigned u32x4 __attribute__((ext_vector_type(4)));
constexpr int BM = 256, BK = 64, HALF = 128, HTB = HALF * BK * 2  , STAGE_BYTES = 8 * HTB, NXCD = 8, WGM = 8;

__host__ __device__ __forceinline__ int lds_byte(int r, int c) { const int st = (r >> 4) * 2 + (c >> 5), rr = r & 15, cc = c & 31, ob = rr * 64 + cc * 2; return st * 1024 + (ob ^ (((ob >> 9) & 1) << 5)); }
__host__ __device__ __forceinline__ void stage_rc(int b, int& R, int& C) { const int st = b / 1024, sb = b % 1024, swz = sb ^ (((sb >> 9) & 1) << 5); R = (st >> 1) * 16 + swz / 64; C = (st & 1) * 32 + (swz % 64) / 2; }
__host__ __device__ __forceinline__ int perm32(int rho) { const int n = rho >> 4, i = rho & 15; return 8 * (i >> 2) + 4 * n + (i & 3); }

struct Unit { int pm, pn; };
struct Gemm { const bf16_t* A; const bf16_t* Bt; int lda, ldb, K; };

struct StaticOrder {
    int nM, nN, nwg, G, c;
    __host__ __device__ void init(int M, int N, int G_, int c_) { nM = M / BM; nN = N / BM; nwg = nM * nN; G = G_; c = c_; }
    __host__ __device__ bool next(int i, Unit& u) const {
        const long L = (long)i * G + c; if (L >= nwg) return false;
        int wgid = (int)L; { const int q = nwg / NXCD, r = nwg % NXCD, xcd = wgid % NXCD, off = wgid / NXCD; wgid = (xcd < r ? xcd * (q + 1) : r * (q + 1) + (xcd - r) * q) + off; }
        const int nig = WGM * nN, gid = wgid / nig, fm = gid * WGM, gsz = (nM - fm) < WGM ? (nM - fm) : WGM;
        u.pm = fm + ((wgid % nig) % gsz); u.pn = (wgid % nig) / gsz; return true;
    }
    __device__ __forceinline__ void a_ready(const Unit&) const {}
    __device__ __forceinline__ void done(const Unit&) const {}
};

__device__ __forceinline__ unsigned cvt_pk_bf16(float lo, float hi) { unsigned r; asm volatile("v_cvt_pk_bf16_f32 %0, %1, %2" : "=v"(r) : "v"(lo), "v"(hi)); return r; }
typedef float f32x2 __attribute__((ext_vector_type(2)));
__device__ __forceinline__ f32x2 gelu_pk(f32x2 v) {
    const f32x2 av = __builtin_elementwise_abs(v), d = av * 0.2316418882f + 1.0f;
    f32x2 t; t.x = __builtin_amdgcn_rcpf(d.x); t.y = __builtin_amdgcn_rcpf(d.y);
    f32x2 q = t * 0.5307027145f + (-0.7265760135f); q = q * t + 0.7107068705f; q = q * t + (-0.142248368f); q = q * t + 0.127414796f; q = q * t;
    const f32x2 s = (v * v) * (-0.72134752044f);
    f32x2 e; e.x = __builtin_amdgcn_exp2f(s.x); e.y = __builtin_amdgcn_exp2f(s.y);
    const f32x2 m = v * (q * e), r = v - m;
    f32x2 o; o.x = v.x < 0.f ? m.x : r.x; o.y = v.y < 0.f ? m.y : r.y; return o;
}

template <int ACT  > struct EpiBf16 {
    static constexpr bool PERM = true, AFTER_DRAIN = false; static_assert(ACT == 0 || ACT == 1, "EpiBf16: ACT is 0 (none) or 1 (gelu_pk)");
    bf16_t* O; int ldc; const float* bias; int split_cols; size_t split_stride; float scale0;
    __device__ __forceinline__ void operator()(const f32x4 (&acc)[2][2][4][2], const Unit& u, int wr, int wc, int fr, int fq) const {
        const int row0 = u.pm * BM + wr * 64 + fr; int colt = u.pn * BM; bf16_t* base = O;
        float sc = 1.f; if (split_cols) { const int t = colt / split_cols; base += (size_t)t * split_stride; colt -= t * split_cols; if (t == 0) sc = scale0; }
        const int col0 = colt + wc * 32 + 8 * fq, bcol0 = u.pn * BM + wc * 32 + 8 * fq;
        f32x4 bv[2][2];
#pragma unroll
        for (int bj = 0; bj < 2; ++bj)
#pragma unroll
            for (int n = 0; n < 2; ++n) bv[bj][n] = bias ? *(const f32x4*)(bias + bcol0 + bj * HALF + 4 * n) : (f32x4){0.f, 0.f, 0.f, 0.f};
#pragma unroll
        for (int ai = 0; ai < 2; ++ai)
#pragma unroll
            for (int m = 0; m < 4; ++m) { bf16_t* rowp = base + (size_t)(row0 + ai * HALF + m * 16) * ldc + col0;
#pragma unroll
                for (int bj = 0; bj < 2; ++bj) { f32x4 v0 = acc[ai][bj][m][0] + bv[bj][0], v1 = acc[ai][bj][m][1] + bv[bj][1];
                    if (ACT == 1) { f32x2 a = gelu_pk((f32x2){v0[0], v0[1]}), b = gelu_pk((f32x2){v0[2], v0[3]}), c = gelu_pk((f32x2){v1[0], v1[1]}), d = gelu_pk((f32x2){v1[2], v1[3]});
                        v0 = (f32x4){a.x, a.y, b.x, b.y}; v1 = (f32x4){c.x, c.y, d.x, d.y}; }
                    v0 = v0 * sc; v1 = v1 * sc; u32x4 w; w.x = cvt_pk_bf16(v0[0], v0[1]); w.y = cvt_pk_bf16(v0[2], v0[3]); w.z = cvt_pk_bf16(v1[0], v1[1]); w.w = cvt_pk_bf16(v1[2], v1[3]);
                    *(u32x4*)(rowp + bj * HALF) = w; } }
    }
};

template <class Epi, class Sched, bool ALIGN_EPI = false, bool SP2 = false>
__device__ __forceinline__ void gemm_phase(PG8_LAS unsigned char* lds, const Gemm g, const Sched& S, const Epi& E) {
    const int tid = threadIdx.x, wid = __builtin_amdgcn_readfirstlane(tid >> 6), lane = tid & 63, wr = wid >> 2, wc = wid & 3, fr = lane & 15, fq = lane >> 4;
    const int K = g.K, nt = K / BK;
    unsigned voffA[2], voffB[2];
#pragma unroll
    for (int i = 0; i < 2; ++i) { int R, C; stage_rc(tid * 16 + i * 8192, R, C); const int Rb = Epi::PERM ? ((R & ~31) + perm32(R & 31)) : R;
        voffA[i] = (unsigned)(R * g.lda + C) * 2u; voffB[i] = (unsigned)(Rb * g.ldb + C) * 2u; }
    const size_t kstep = (size_t)(BK * 2);
    const size_t hstepA = (size_t)HALF * g.lda * 2, hstepB = (size_t)HALF * g.ldb * 2;
    const size_t tstepA = 2 * hstepA, tstepB = 2 * hstepB;
    const unsigned ldsw = (unsigned)wid * 1024u;
    const int aoff = lds_byte(wr * 64 + fr, fq * 8), boff = lds_byte(wc * 32 + fr, fq * 8);
#define PG8_SA(b, h) (((b) * 2 + (h)) * HTB)
#define PG8_SB(b, h) ((4 + (b) * 2 + (h)) * HTB)
#define PG8_STAGE(bufoff, gbase, voff) do { _Pragma("unroll") for (int _i = 0; _i < 2; ++_i) \
        __builtin_amdgcn_global_load_lds((const unsigned*)((const char*)(gbase) + (voff)[_i]), (PG8_LAS unsigned*)(lds + (bufoff) + ldsw + _i * 8192), 16, 0, 0); } while (0)
#define PG8_LDA(dst, b, h) do { _Pragma("unroll") for (int m = 0; m < 4; ++m) _Pragma("unroll") for (int k = 0; k < 2; ++k) dst[m][k] = *(const PG8_LAS bf16x8*)(lds + PG8_SA(b, h) + aoff + m * 2048 + k * 1024); } while (0)
#define PG8_LDB(dst, b, h) do { _Pragma("unroll") for (int n = 0; n < 2; ++n) _Pragma("unroll") for (int k = 0; k < 2; ++k) dst[n][k] = *(const PG8_LAS bf16x8*)(lds + PG8_SB(b, h) + boff + n * 2048 + k * 1024); } while (0)
#define PG8_MMA(ai, bj, At, Bt) do { __builtin_amdgcn_s_setprio(1); _Pragma("unroll") for (int m = 0; m < 4; ++m) _Pragma("unroll") for (int n = 0; n < 2; ++n) _Pragma("unroll") for (int k = 0; k < 2; ++k) \
        acc[ai][bj][m][n] = __builtin_amdgcn_mfma_f32_16x16x32_bf16(Bt[n][k], At[m][k], acc[ai][bj][m][n], 0, 0, 0); __builtin_amdgcn_s_setprio(0); } while (0)
#define PG8_WAIT_V(n) asm volatile("s_waitcnt vmcnt(" #n ")" ::: "memory")
#define PG8_WAIT_L(n) asm volatile("s_waitcnt lgkmcnt(" #n ")" ::: "memory")
#define PG8_BAR __builtin_amdgcn_s_barrier()
#define PG8_SCHED __builtin_amdgcn_sched_barrier(0)
    Unit cur, nxt; int ui = 0;
    if (!S.next(0, cur)) return;
    f32x4 acc[2][2][4][2];
#pragma unroll
    for (int a = 0; a < 2; ++a)
#pragma unroll
        for (int b = 0; b < 2; ++b)
#pragma unroll
            for (int m = 0; m < 4; ++m)
#pragma unroll
                for (int n = 0; n < 2; ++n) acc[a][b][m][n] = (f32x4){0.f, 0.f, 0.f, 0.f};
    bf16x8 At[4][2], B0[2][2], B1[2][2];
    const char* cA = (const char*)g.A + (size_t)cur.pm * tstepA; const char* cB = (const char*)g.Bt + (size_t)cur.pn * tstepB;
    S.a_ready(cur);
    if constexpr (SP2) {
        PG8_STAGE(PG8_SB(0, 0), cB, voffB); PG8_STAGE(PG8_SB(0, 1), cB + hstepB, voffB); PG8_STAGE(PG8_SA(0, 0), cA, voffA); PG8_STAGE(PG8_SA(0, 1), cA + hstepA, voffA);
        if (wr == 1) PG8_BAR;
        PG8_WAIT_V(2); PG8_BAR;
        PG8_STAGE(PG8_SB(1, 0), cB + kstep, voffB); PG8_STAGE(PG8_SA(1, 0), cA + kstep, voffA); PG8_STAGE(PG8_SB(1, 1), cB + hstepB + kstep, voffB);
        PG8_WAIT_V(6); PG8_BAR;
    } else {
        PG8_STAGE(PG8_SB(0, 0), cB, voffB); PG8_STAGE(PG8_SA(0, 0), cA, voffA); PG8_STAGE(PG8_SB(0, 1), cB + hstepB, voffB); PG8_STAGE(PG8_SA(0, 1), cA + hstepA, voffA);
        if (wr == 1) PG8_BAR;
        PG8_WAIT_V(4); PG8_BAR;
        PG8_STAGE(PG8_SB(1, 0), cB + kstep, voffB); PG8_STAGE(PG8_SA(1, 0), cA + kstep, voffA); PG8_STAGE(PG8_SB(1, 1), cB + hstepB + kstep, voffB);
        PG8_WAIT_V(6); PG8_BAR;
    }
    for (;;) {
        const bool has_next = S.next(ui + 1, nxt);
        const char* nA = has_next ? (const char*)g.A + (size_t)nxt.pm * tstepA : cA; const char* nB = has_next ? (const char*)g.Bt + (size_t)nxt.pn * tstepB : cB;
        for (int t = 0; t < nt; t += 2) {
            const bool last = (t == nt - 2);
            const char* a1 = cA + (size_t)(t + 1) * kstep;
            const char* a2 = last ? nA : cA + (size_t)(t + 2) * kstep; const char* b2 = last ? nB : cB + (size_t)(t + 2) * kstep;
            const char* a3 = a2 + kstep; const char* b3 = b2 + kstep;
            if (last && has_next) S.a_ready(nxt);
            if constexpr (SP2) {
            PG8_LDB(B0, 0, 0); PG8_LDB(B1, 0, 1); PG8_SCHED; PG8_LDA(At, 0, 0); PG8_STAGE(PG8_SA(1, 1), a1 + hstepA, voffA);
            PG8_WAIT_V(8); PG8_WAIT_L(0); PG8_BAR; PG8_MMA(0, 0, At, B0); PG8_MMA(0, 1, At, B1); PG8_BAR; PG8_SCHED;
            PG8_LDA(At, 0, 1); PG8_STAGE(PG8_SB(0, 0), b2, voffB); PG8_STAGE(PG8_SB(0, 1), b2 + hstepB, voffB); PG8_STAGE(PG8_SA(0, 0), a2, voffA);
            PG8_WAIT_V(8); PG8_WAIT_L(0); PG8_BAR; PG8_MMA(1, 0, At, B0); PG8_MMA(1, 1, At, B1); PG8_BAR; PG8_SCHED;
            PG8_LDB(B0, 1, 0); PG8_LDB(B1, 1, 1); PG8_SCHED; PG8_LDA(At, 1, 0); PG8_STAGE(PG8_SA(0, 1), a2 + hstepA, voffA);
            PG8_WAIT_V(8); PG8_WAIT_L(0); PG8_BAR; PG8_MMA(0, 0, At, B0); PG8_MMA(0, 1, At, B1); PG8_BAR; PG8_SCHED;
            PG8_LDA(At, 1, 1); PG8_STAGE(PG8_SB(1, 0), b3, voffB); PG8_STAGE(PG8_SB(1, 1), b3 + hstepB, voffB); PG8_STAGE(PG8_SA(1, 0), a3, voffA);
            PG8_WAIT_V(8); PG8_WAIT_L(0); PG8_BAR; PG8_MMA(1, 0, At, B0); PG8_MMA(1, 1, At, B1); PG8_BAR; PG8_SCHED;
            } else {
            PG8_LDB(B0, 0, 0); PG8_SCHED; PG8_LDA(At, 0, 0); PG8_STAGE(PG8_SA(1, 1), a1 + hstepA, voffA);
            PG8_WAIT_L(8); PG8_BAR; PG8_WAIT_L(0); PG8_MMA(0, 0, At, B0); PG8_BAR; PG8_SCHED;
            PG8_LDB(B1, 0, 1); PG8_STAGE(PG8_SB(0, 0), b2, voffB);
            PG8_BAR; PG8_WAIT_L(0); PG8_MMA(0, 1, At, B1); PG8_BAR;
            PG8_LDA(At, 0, 1); PG8_STAGE(PG8_SA(0, 0), a2, voffA);
            PG8_BAR; PG8_WAIT_L(0); PG8_MMA(1, 0, At, B0); PG8_BAR; PG8_SCHED;
            PG8_STAGE(PG8_SB(0, 1), b2 + hstepB, voffB);
            PG8_WAIT_V(6); PG8_BAR; PG8_MMA(1, 1, At, B1); PG8_BAR;
            PG8_LDB(B0, 1, 0); PG8_SCHED; PG8_LDA(At, 1, 0); PG8_STAGE(PG8_SA(0, 1), a2 + hstepA, voffA);
            PG8_WAIT_L(8); PG8_BAR; PG8_WAIT_L(0); PG8_MMA(0, 0, At, B0); PG8_BAR; PG8_SCHED;
            PG8_LDB(B1, 1, 1); PG8_STAGE(PG8_SB(1, 0), b3, voffB);
            PG8_BAR; PG8_WAIT_L(0); PG8_MMA(0, 1, At, B1); PG8_BAR;
            PG8_LDA(At, 1, 1); PG8_STAGE(PG8_SA(1, 0), a3, voffA);
            PG8_BAR; PG8_WAIT_L(0); PG8_MMA(1, 0, At, B0); PG8_BAR; PG8_SCHED;
            PG8_STAGE(PG8_SB(1, 1), b3 + hstepB, voffB);
            PG8_WAIT_V(6); PG8_BAR; PG8_MMA(1, 1, At, B1); PG8_BAR;
            }
        }
        if constexpr (ALIGN_EPI) { if (wr == 0) PG8_BAR; }
        if constexpr (!Epi::AFTER_DRAIN) { E(acc, cur, wr, wc, fr, fq); S.done(cur); }
        if (!has_next) break;
#pragma unroll
        for (int a = 0; a < 2; ++a)
#pragma unroll
            for (int b = 0; b < 2; ++b)
#pragma unroll
                for (int m = 0; m < 4; ++m)
#pragma unroll
                    for (int n = 0; n < 2; ++n) acc[a][b][m][n] = (f32x4){0.f, 0.f, 0.f, 0.f};
        cur = nxt; cA = nA; cB = nB; ++ui;
        if constexpr (ALIGN_EPI) { if (wr == 1) PG8_BAR; }
    }
    PG8_WAIT_V(0);
    if constexpr (!ALIGN_EPI) { if (wr == 0) PG8_BAR; }
    PG8_BAR;
    if constexpr (Epi::AFTER_DRAIN) { E.fused(acc, cur, wr, wc, fr, fq, lds, wid, lane); S.done(cur); }
#undef PG8_SA
#undef PG8_SB
#undef PG8_STAGE
#undef PG8_LDA
#undef PG8_LDB
#undef PG8_MMA
#undef PG8_WAIT_V
#undef PG8_WAIT_L
#undef PG8_BAR
#undef PG8_SCHED
}
}

#ifndef MK_EXP_OLD
#define MK_EXP_OLD 0
#endif
#ifndef MK_ONE_LAUNCH
#define MK_ONE_LAUNCH 1
#endif
#define LAS __attribute__((address_space(3)))
typedef unsigned short bf16;
typedef unsigned v4u __attribute__((ext_vector_type(4)));
typedef unsigned v2u __attribute__((ext_vector_type(2)));
typedef float f32x4 __attribute__((ext_vector_type(4)));
typedef float f32x2 __attribute__((ext_vector_type(2)));
typedef short bf16x8 __attribute__((ext_vector_type(8)));
typedef float f32x16 __attribute__((ext_vector_type(16)));
#define MFMA32(a, b, c) __builtin_amdgcn_mfma_f32_32x32x16_bf16((a), (b), (c), 0, 0, 0)

constexpr int D = 1024, NB = 8, SEQ = 2048, LC = 256, ML = NB * SEQ  , MC = NB * LC  , MT = ML + MC  ;
constexpr int PROJ = 2576, NPROJ = 2560;
constexpr int NEXP = 16384, TOPK = 16, KK = 128;
constexpr float EPS = 1e-6f;
constexpr int NTHREADS = 512, NWAVES = 8;
constexpr int LDS_BYTES = 151552;
constexpr int NPHASES = 16;

constexpr size_t MiB = 1u << 20;
constexpr size_t WS_CTL = 0;
constexpr size_t CTL_ZERO_BYTES = 65536;
constexpr int CW_BAR = 0;
constexpr int CW_E1 = 4096, CW_E2 = 4096 + 8 * 64;
constexpr size_t WS_MOD = 1 * MiB;
constexpr size_t WS_LP = 1 * MiB + 512 * 1024;
constexpr size_t WS_WIN = 2 * MiB;
constexpr size_t WS_WOUT = 8 * MiB;
constexpr size_t WS_WGLU = 10 * MiB;
constexpr size_t WS_WQ = 11 * MiB;
constexpr size_t WS_GB = 15 * MiB;
constexpr size_t WS_BB = 17 * MiB;
constexpr size_t WS_PM = 41 * MiB;
constexpr size_t WS_OG = 17 * MiB;
constexpr size_t WS_HX2 = 17 * MiB;
constexpr size_t WS_U5 = 49 * MiB;
constexpr size_t WS_CAT = 49 * MiB;
constexpr size_t WS_IDX = 49 * MiB;
constexpr size_t WS_GATE = 57 * MiB;
constexpr size_t WS_ACT = 65 * MiB;
constexpr size_t WS_SSQP = 73 * MiB;
constexpr size_t WS_Z = 85 * MiB;
constexpr size_t WS_YRAW = 85 * MiB;
constexpr size_t WS_QP = 85 * MiB;
constexpr size_t WS_Y = 85 * MiB;
constexpr size_t WS_HX = 101 * MiB;
constexpr size_t WS_SS = 101 * MiB;
constexpr size_t WS_YG = 101 * MiB;
constexpr size_t WS_FRT = 125 * MiB;
constexpr size_t WS_QKVPRE = 137 * MiB;
constexpr size_t WS_FRA = 143 * MiB;
constexpr size_t WS_FRK = 161 * MiB;
constexpr size_t WS_FRTAB = 197 * MiB;
constexpr size_t WS_QKV = 202 * MiB;
constexpr size_t WS_U8 = 202 * MiB;
constexpr size_t WS_V8 = 218 * MiB;
constexpr size_t WS_USC = 234 * MiB;
constexpr size_t WS_VSC = 234 * MiB + 512 * 1024;
constexpr size_t WS_HQ8 = 150 * MiB;
constexpr size_t WS_HS = 183 * MiB;
constexpr size_t WS_PACT = 85 * MiB;
constexpr size_t WS_X1A = 184 * MiB;
constexpr size_t WS_X1B = 236 * MiB;
constexpr size_t WS_END = 256 * MiB;
static_assert(WS_BB + (size_t)32 * 512 * 768 * 2 <= WS_PM && WS_PM + (size_t)32 * 256 * 512 * 2 <= WS_U5 && WS_U5 + (size_t)32 * 768 * 768 * 2 <= WS_Z && WS_Z + (size_t)ML * 512 * 2 <= WS_HX, "ws map a");
static_assert(WS_HX + (size_t)MT * D * 2 <= WS_QKVPRE && WS_SS + (size_t)32 * 768 * 256 * 4 <= WS_FRT && WS_QKVPRE + (size_t)MT * 1536 * 2 <= WS_QKV && WS_QKV + (size_t)MT * 1536 * 2 <= WS_END, "ws map b");
static_assert(WS_FRT + (size_t)2304 * 8192 <= WS_FRA && WS_FRA + (size_t)2304 * 8192 <= WS_FRK && WS_FRK + (size_t)2304 * 16384 <= WS_FRTAB && WS_FRTAB + (size_t)2304 * 1024 <= WS_QKV, "ws map c");
static_assert(WS_OG + (size_t)2 * ML * 512 * 2 <= WS_CAT && WS_CAT + (size_t)ML * D * 2 <= WS_Z && WS_YRAW + (size_t)ML * D * 4 <= WS_U8 && WS_SSQP + (size_t)8 * ML * 4 <= WS_Z && WS_YG + (size_t)ML * 512 * 2 <= WS_FRT, "ws map d");

__device__ __forceinline__ unsigned f2bf(float f) { unsigned u = __builtin_bit_cast(unsigned, f); return (u + 0x7fffu + ((u >> 16) & 1u)) >> 16; }
typedef __bf16 bf16x2_t __attribute__((ext_vector_type(2)));
__device__ __forceinline__ unsigned pk2(float lo, float hi) { const f32x2 v = {lo, hi}; return __builtin_bit_cast(unsigned, __builtin_convertvector(v, bf16x2_t)); }
__device__ __forceinline__ float bflo(unsigned w) { return __builtin_bit_cast(float, w << 16); }
__device__ __forceinline__ float bfhi(unsigned w) { return __builtin_bit_cast(float, w & 0xffff0000u); }
__device__ __forceinline__ float bf1(bf16 h) { return __builtin_bit_cast(float, (unsigned)h << 16); }
__device__ __forceinline__ float wave_sum(float v) {
#pragma unroll
    for (int o = 1; o < 64; o <<= 1) v += __shfl_xor(v, o);
    return v;
}
__device__ __forceinline__ float wave_max(float v) {
#pragma unroll
    for (int o = 1; o < 64; o <<= 1) v = fmaxf(v, __shfl_xor(v, o));
    return v;
}
__device__ __forceinline__ float sigmoidf_(float x) { return __builtin_amdgcn_rcpf(1.f + __expf(-x)); }
__device__ __forceinline__ float siluf_(float x) { return x * __builtin_amdgcn_rcpf(1.f + __expf(-x)); }
__device__ __forceinline__ float gelu_erf(float x) { return 0.5f * x * (1.f + erff(x * 0.70710678118654752f)); }
__device__ __forceinline__ void sincos_d(double a, float& s, float& c) {
    const double k = rint(a * 0.63661977236758134308);
    const double r = fma(-k, 1.57079632679489661923, a) - k * 6.123233995736766e-17;
    const double r2 = r * r;
    double sp = -2.5052108385441720e-08; sp = sp * r2 + 2.7557319223985893e-06; sp = sp * r2 - 1.9841269841269841e-04; sp = sp * r2 + 8.3333333333333332e-03; sp = sp * r2 - 1.6666666666666666e-01;
    const double sn = r + r * r2 * sp;
    double cp = 2.0876756987868099e-09; cp = cp * r2 - 2.7557319223985888e-07; cp = cp * r2 + 2.4801587301587302e-05; cp = cp * r2 - 1.3888888888888889e-03; cp = cp * r2 + 4.1666666666666664e-02; cp = cp * r2 - 0.5;
    const double cs = 1.0 + r2 * cp;
    const int q = ((int)k) & 3;
    const double ss = (q == 0) ? sn : (q == 1) ? cs : (q == 2) ? -sn : -cs;
    const double cc = (q == 0) ? cs : (q == 1) ? -sn : (q == 2) ? -cs : sn;
    s = (float)ss; c = (float)cc;
}

struct Args { const float* in[29]; float* out; unsigned char* ws; int ph_lo, ph_hi; };
static_assert(sizeof(Args) == 29 * 8 + 8 + 8 + 8, "Args has no padding");
enum { I_X = 0, I_C, I_CTX, I_CCTX, I_WMOD, I_BMOD, I_GPREMIX, I_GPOSTMIX, I_GPREFFN, I_GPOSTFFN, I_WIN, I_WOUT, I_LAMRE, I_LAMIM, I_LOGDT, I_BRE, I_BIM, I_CRE, I_CIM, I_S5D, I_WGLU,
       I_CONV, I_ALOG, I_DTBIAS, I_GDNNORM, I_WQ, I_KEYS, I_PU, I_PV };

__device__ __forceinline__ const float* in_row(const Args& a, int row) { return row < ML ? a.in[I_X] + (size_t)row * D : a.in[I_CTX] + (size_t)(row - ML) * D; }
__device__ __forceinline__ int mod_row(int row) { return row < ML ? (row >> 11) : 8; }

template <int CTRL> __device__ __forceinline__ float dppf(float v) { return __builtin_bit_cast(float, __builtin_amdgcn_update_dpp(0, __builtin_bit_cast(int, v), CTRL, 0xf, 0xf, true)); }
__device__ __forceinline__ float row_sum16(float v) { v += dppf<0xB1>(v); v += dppf<0x4E>(v); v += dppf<0x141>(v); v += dppf<0x140>(v); return v; }
__device__ __forceinline__ float row_max16(float v) { v = fmaxf(v, dppf<0xB1>(v)); v = fmaxf(v, dppf<0x4E>(v)); v = fmaxf(v, dppf<0x141>(v)); v = fmaxf(v, dppf<0x140>(v)); return v; }
__device__ __forceinline__ float wsum(float v) { v = row_sum16(v); return
    __builtin_bit_cast(float, __builtin_amdgcn_readlane(__builtin_bit_cast(int, v), 0)) + __builtin_bit_cast(float, __builtin_amdgcn_readlane(__builtin_bit_cast(int, v), 16)) +
    __builtin_bit_cast(float, __builtin_amdgcn_readlane(__builtin_bit_cast(int, v), 32)) + __builtin_bit_cast(float, __builtin_amdgcn_readlane(__builtin_bit_cast(int, v), 48)); }
__device__ __forceinline__ float wmax(float v) { v = row_max16(v); return fmaxf(fmaxf(__builtin_bit_cast(float, __builtin_amdgcn_readlane(__builtin_bit_cast(int, v), 0)), __builtin_bit_cast(float, __builtin_amdgcn_readlane(__builtin_bit_cast(int, v), 16))),
    fmaxf(__builtin_bit_cast(float, __builtin_amdgcn_readlane(__builtin_bit_cast(int, v), 32)), __builtin_bit_cast(float, __builtin_amdgcn_readlane(__builtin_bit_cast(int, v), 48)))); }
__device__ __forceinline__ int lane_rank(unsigned long long m) { return __builtin_amdgcn_mbcnt_hi((unsigned)(m >> 32), __builtin_amdgcn_mbcnt_lo((unsigned)m, 0)); }
__device__ __forceinline__ unsigned fkey(float f) { const unsigned u = __builtin_bit_cast(unsigned, f); return u ^ ((unsigned)((int)u >> 31) | 0x80000000u); }
#define WAVE_LDS_SYNC() do { __builtin_amdgcn_fence(__ATOMIC_RELEASE, "wavefront"); __builtin_amdgcn_wave_barrier(); __builtin_amdgcn_fence(__ATOMIC_ACQUIRE, "wavefront"); } while (0)
template <int N> __device__ __forceinline__ unsigned kth_key(const unsigned (&k)[N], int K) {
    unsigned T = 0;
    for (int bit = 31; bit >= 0; --bit) { const unsigned cand = T | (1u << bit); int cnt = 0;
#pragma unroll
        for (int n = 0; n < N; ++n) cnt += __popcll(__ballot(k[n] >= cand));
        if (cnt >= K) T = cand;
        if (cnt == K) break; }
    return T;
}

namespace pg8 {
struct EpiInProj {
    static constexpr bool PERM = true, AFTER_DRAIN = false;
    bf16_t* U; bf16_t* QKV; bf16_t* Z;
    __device__ __forceinline__ void operator()(const f32x4 (&acc)[2][2][4][2], const Unit& u, int wr, int wc, int fr, int fq) const {
        bf16_t* base; int ld, colt; bool lat_only = false;
        const bool s5 = u.pn < 2;
        if (s5) { base = U; ld = 0; colt = u.pn * BM; }
        else if (u.pn < 8) { base = QKV; ld = 1536; colt = (u.pn - 2) * BM; }
        else { base = Z; ld = 512; colt = (u.pn - 8) * BM; lat_only = true; }
        const int row0 = u.pm * BM + wr * 64 + fr, col0 = colt + wc * 32 + 8 * fq;
#pragma unroll
        for (int ai = 0; ai < 2; ++ai)
#pragma unroll
            for (int m = 0; m < 4; ++m) { const int row = row0 + ai * HALF + m * 16; bf16_t* rowp = base + (size_t)row * ld + col0;
                if (lat_only && row >= 16384) continue;
                if (s5) { const int R = row < 16384 ? (row >> 5) : 512 + ((row - 16384) >> 5), ii = row & 31; rowp = base + (size_t)R * 768 + ii * 16 + (col0 & 15); }
#pragma unroll
                for (int bj = 0; bj < 2; ++bj) { const f32x4 v0 = acc[ai][bj][m][0], v1 = acc[ai][bj][m][1];
                    u32x4 w; w.x = cvt_pk_bf16(v0[0], v0[1]); w.y = cvt_pk_bf16(v0[2], v0[3]); w.z = cvt_pk_bf16(v1[0], v1[1]); w.w = cvt_pk_bf16(v1[2], v1[3]);
                    if (s5) *(u32x4*)(rowp + (size_t)((col0 + bj * HALF) >> 4) * (768 * 768)) = w; else *(u32x4*)(rowp + bj * HALF) = w; } }
    }
};
struct EpiGlu {
    static constexpr bool PERM = true, AFTER_DRAIN = false;
    const bf16_t* YG; bf16_t* CAT;
    __device__ __forceinline__ void operator()(const f32x4 (&acc)[2][2][4][2], const Unit& u, int wr, int wc, int fr, int fq) const {
        const int row0 = u.pm * BM + wr * 64 + fr, col0 = u.pn * BM + wc * 32 + 8 * fq;
#pragma unroll
        for (int ai = 0; ai < 2; ++ai)
#pragma unroll
            for (int m = 0; m < 4; ++m) { const int row = row0 + ai * HALF + m * 16;
#pragma unroll
                for (int bj = 0; bj < 2; ++bj) { const f32x4 v0 = acc[ai][bj][m][0], v1 = acc[ai][bj][m][1];
                    const u32x4 y = *(const u32x4*)(YG + (size_t)row * 512 + col0 + bj * HALF);
                    float o[8]; const float a[8] = {v0[0], v0[1], v0[2], v0[3], v1[0], v1[1], v1[2], v1[3]};
                    const unsigned yw[4] = {y.x, y.y, y.z, y.w};
#pragma unroll
                    for (int e = 0; e < 8; ++e) { const float yv = __builtin_bit_cast(float, (e & 1) ? (yw[e >> 1] & 0xffff0000u) : (yw[e >> 1] << 16)); o[e] = yv * __builtin_amdgcn_rcpf(1.f + __expf(-a[e])); }
                    u32x4 w; w.x = cvt_pk_bf16(o[0], o[1]); w.y = cvt_pk_bf16(o[2], o[3]); w.z = cvt_pk_bf16(o[4], o[5]); w.w = cvt_pk_bf16(o[6], o[7]);
                    *(u32x4*)(CAT + (size_t)row * 1024 + col0 + bj * HALF) = w; } }
    }
};
struct EpiF32 {
    static constexpr bool PERM = false, AFTER_DRAIN = false;
    float* C; int ldc;
    __device__ __forceinline__ void operator()(const f32x4 (&acc)[2][2][4][2], const Unit& u, int wr, int wc, int fr, int fq) const {
        const int row0 = u.pm * BM + wr * 64 + fr, col0 = u.pn * BM + wc * 32 + 4 * fq;
#pragma unroll
        for (int ai = 0; ai < 2; ++ai)
#pragma unroll
            for (int m = 0; m < 4; ++m) { float* rowp = C + (size_t)(row0 + ai * HALF + m * 16) * ldc + col0;
#pragma unroll
                for (int bj = 0; bj < 2; ++bj)
#pragma unroll
                    for (int n = 0; n < 2; ++n) *(f32x4*)(rowp + bj * HALF + n * 16) = acc[ai][bj][m][n]; }
    }
};
struct EpiSS {
    static constexpr bool PERM = false, AFTER_DRAIN = false;
    float* C;
    __device__ __forceinline__ void operator()(const f32x4 (&acc)[2][2][4][2], const Unit& u, int wr, int wc, int fr, int fq) const {
        const int row0 = u.pm * BM + wr * 64 + fr, col0 = wc * 32 + 4 * fq;
#pragma unroll
        for (int ai = 0; ai < 2; ++ai)
#pragma unroll
            for (int m = 0; m < 4; ++m) { float* rowp = C + (size_t)(row0 + ai * HALF + m * 16) * 256 + col0;
#pragma unroll
                for (int bj = 0; bj < 2; ++bj)
#pragma unroll
                    for (int n = 0; n < 2; ++n) *(f32x4*)(rowp + bj * HALF + n * 16) = acc[ai][bj][m][n]; }
    }
};
struct SchedSS { int G, c; __device__ bool next(int i, Unit& u) const { const int L = i * G + c; if (L >= 96) return false; u.pm = L; u.pn = L / 3; return true; }
    __device__ __forceinline__ void a_ready(const Unit&) const {} __device__ __forceinline__ void done(const Unit&) const {} };
struct EpiS5Y {
    static constexpr bool PERM = true, AFTER_DRAIN = false;
    bf16_t* YG;
    __device__ __forceinline__ void operator()(const f32x4 (&acc)[2][2][4][2], const Unit& u, int wr, int wc, int fr, int fq) const {
        const int g = u.pn >> 1, R0 = (u.pm - 3 * g) * BM + wr * 64 + fr, n0 = (u.pn & 1) * BM + wc * 32 + 8 * fq;
#pragma unroll
        for (int ai = 0; ai < 2; ++ai)
#pragma unroll
            for (int m = 0; m < 4; ++m) { const int R = R0 + ai * HALF + m * 16;
#pragma unroll
                for (int bj = 0; bj < 2; ++bj) { const int n = n0 + bj * HALF; const f32x4 v0 = acc[ai][bj][m][0], v1 = acc[ai][bj][m][1];
                    const f32x2 a = gelu_pk((f32x2){v0[0], v0[1]}), b = gelu_pk((f32x2){v0[2], v0[3]}), c2 = gelu_pk((f32x2){v1[0], v1[1]}), d = gelu_pk((f32x2){v1[2], v1[3]});
                    u32x4 w; w.x = cvt_pk_bf16(a.x, a.y); w.y = cvt_pk_bf16(b.x, b.y); w.z = cvt_pk_bf16(c2.x, c2.y); w.w = cvt_pk_bf16(d.x, d.y);
                    *(u32x4*)(YG + (size_t)(R * 32 + (n >> 4)) * 512 + g * 16 + (n & 15)) = w; } }
    }
};
struct SchedS5Y { int G, c; __device__ bool next(int i, Unit& u) const { const int L = i * G + c; if (L >= 128) return false; const int g = L >> 2; u.pm = 3 * g + ((L >> 1) & 1); u.pn = 2 * g + (L & 1); return true; }
    __device__ __forceinline__ void a_ready(const Unit&) const {} __device__ __forceinline__ void done(const Unit&) const {} };
}

struct Ctx { const Args* a; unsigned char* ws; unsigned char* lds; int tid, lane, wave, bid, G, gw, NGW, gwv; };

__device__ __forceinline__ void p0_transpose_item(const float* W, int ldw, int nblk, int K, bf16* WT, float* scr, int item, int lane) {
    const int kb = item / nblk, nb = item % nblk, k0 = 64 * kb, n0 = 32 * nb;
    float wv[32];
#pragma unroll
    for (int i = 0; i < 32; ++i) { const int kk = 2 * i + (lane >> 5); wv[i] = W[(size_t)(k0 + kk) * ldw + n0 + (lane & 31)]; }
#pragma unroll
    for (int i = 0; i < 32; ++i) { const int kk = 2 * i + (lane >> 5); scr[kk * 33 + (lane & 31)] = wv[i]; }
    __builtin_amdgcn_fence(__ATOMIC_RELEASE, "wavefront"); __builtin_amdgcn_wave_barrier(); __builtin_amdgcn_fence(__ATOMIC_ACQUIRE, "wavefront");
    const int c = lane & 7;
#pragma unroll
    for (int j = 0; j < 4; ++j) { const int n = (lane >> 3) + 8 * j; const float* s = scr + (8 * c) * 33 + n;
        v4u o; o.x = pk2(s[0 * 33], s[1 * 33]); o.y = pk2(s[2 * 33], s[3 * 33]); o.z = pk2(s[4 * 33], s[5 * 33]); o.w = pk2(s[6 * 33], s[7 * 33]);
        *(v4u*)(WT + (size_t)(n0 + n) * K + k0 + 8 * c) = o; }
    __builtin_amdgcn_fence(__ATOMIC_RELEASE, "wavefront"); __builtin_amdgcn_wave_barrier(); __builtin_amdgcn_fence(__ATOMIC_ACQUIRE, "wavefront");
}
__device__ __forceinline__ void phase_prep(const Ctx& c) {
    const Args& a = *c.a;
    float* scr = (float*)(c.lds + c.wave * 16384);
    constexpr int I_IN = 16 * 80, I_OUT = 16 * 32, I_GLU = 8 * 16, I_Q = 16 * 64;
    for (int it = c.gw; it < I_IN + I_OUT + I_GLU + I_Q; it += c.NGW) {
        int r = it;
        if (r < I_IN) { p0_transpose_item(a.in[I_WIN], PROJ, 80, 1024, (bf16*)(c.ws + WS_WIN), scr, r, c.lane); continue; } r -= I_IN;
        if (r < I_OUT) { p0_transpose_item(a.in[I_WOUT], 1024, 32, 1024, (bf16*)(c.ws + WS_WOUT), scr, r, c.lane); continue; } r -= I_OUT;
        if (r < I_GLU) { p0_transpose_item(a.in[I_WGLU], 512, 16, 512, (bf16*)(c.ws + WS_WGLU), scr, r, c.lane); continue; } r -= I_GLU;
        p0_transpose_item(a.in[I_WQ], 2048, 64, 1024, (bf16*)(c.ws + WS_WQ), scr, r, c.lane);
    }
    __syncthreads();
    float* sc = (float*)c.lds;
    float* red = (float*)(c.lds + 9 * 1024 * 4);
    float* MOD = (float*)(c.ws + WS_MOD);
    bool have = false;
    for (int item = c.bid; item < 96; item += c.G) {
        if (!have) { for (int i = c.tid; i < 9 * 1024; i += NTHREADS) { const int r = i >> 10, k = i & 1023; const float v = r < 8 ? a.in[I_C][r * 1024 + k] : a.in[I_CCTX][k]; sc[i] = siluf_(v); } have = true; __syncthreads(); }
        const int n0 = item * 64;
        float acc[9];
#pragma unroll
        for (int r = 0; r < 9; ++r) acc[r] = 0.f;
        const float* wp = a.in[I_WMOD] + (size_t)(c.wave * 128) * 6144 + n0 + c.lane;
#pragma unroll 64
        for (int k = 0; k < 128; ++k) { const float w = wp[(size_t)k * 6144];
#pragma unroll
            for (int r = 0; r < 9; ++r) acc[r] = fmaf(sc[r * 1024 + c.wave * 128 + k], w, acc[r]); }
#pragma unroll
        for (int r = 0; r < 9; ++r) red[(c.wave * 9 + r) * 64 + c.lane] = acc[r];
        __syncthreads();
        for (int i = c.tid; i < 576; i += NTHREADS) { const int r = i >> 6, l = i & 63; float s = a.in[I_BMOD][n0 + l];
#pragma unroll
            for (int w = 0; w < 8; ++w) s += red[(w * 9 + r) * 64 + l];
            MOD[r * 6144 + n0 + l] = s; }
        __syncthreads();
    }
}
__device__ __forceinline__ void s5_build_group(const Ctx& c, int g, int part);
__device__ __forceinline__ void phase_s5_build(const Ctx& c) { for (int it = c.G - 1 - c.bid; it < 128; it += c.G) if (it >= 0) s5_build_group(c, it >> 2, it & 3); }

__device__ __forceinline__ void phase_norm1(const Ctx& c) {
    const Args& a = *c.a;
    float* wabT = (float*)c.lds;
    { f32x4 wv[8];
#pragma unroll
      for (int q = 0; q < 8; ++q) { const int i = c.tid + NTHREADS * q, kk = i >> 2, qq = i & 3; wv[q] = *(const f32x4*)(a.in[I_WIN] + (size_t)kk * PROJ + NPROJ + 4 * qq); }
#pragma unroll
      for (int q = 0; q < 8; ++q) { const int i = c.tid + NTHREADS * q, kk = i >> 2, qq = i & 3; wabT[(4 * qq + 0) * 1028 + kk] = wv[q].x; wabT[(4 * qq + 1) * 1028 + kk] = wv[q].y; wabT[(4 * qq + 2) * 1028 + kk] = wv[q].z; wabT[(4 * qq + 3) * 1028 + kk] = wv[q].w; } }
    __syncthreads();
    const float* MOD = (const float*)(c.ws + WS_MOD);
    bf16* HX = (bf16*)(c.ws + WS_HX); float* GB = (float*)(c.ws + WS_GB);
    const float* gpre = a.in[I_GPREMIX];
    f32x4 nx[4], g4c[4];
#pragma unroll
    for (int j = 0; j < 4; ++j) g4c[j] = *(const f32x4*)(gpre + 4 * c.lane + 256 * j);
    if (c.gw < MT) { const f32x4* xr = (const f32x4*)in_row(a, c.gw) + c.lane;
#pragma unroll
        for (int j = 0; j < 4; ++j) nx[j] = xr[64 * j]; }
    for (int row = c.gw; row < MT; row += c.NGW) {
        const float* mr = MOD + mod_row(row) * 6144;
        f32x4 shv[4], sclv[4];
#pragma unroll
        for (int j = 0; j < 4; ++j) { shv[j] = *(const f32x4*)(mr + 4 * c.lane + 256 * j); sclv[j] = *(const f32x4*)(mr + 1024 + 4 * c.lane + 256 * j); }
        f32x4 v[4]; float ss = 0.f;
#pragma unroll
        for (int j = 0; j < 4; ++j) { v[j] = nx[j]; ss += (v[j].x * v[j].x + v[j].y * v[j].y) + (v[j].z * v[j].z + v[j].w * v[j].w); }
        if (row + c.NGW < MT) { const f32x4* xr = (const f32x4*)in_row(a, row + c.NGW) + c.lane;
#pragma unroll
            for (int j = 0; j < 4; ++j) nx[j] = xr[64 * j]; }
        const float r = rsqrtf(wsum(ss) * (1.f / D) + EPS);
#pragma unroll
        for (int j = 0; j < 4; ++j) { const int col = 4 * c.lane + 256 * j;
            v[j] = (v[j] * r) * g4c[j] * (sclv[j] + 1.f) + shv[j];
            v2u o; o.x = pk2(v[j].x, v[j].y); o.y = pk2(v[j].z, v[j].w);
            *(v2u*)(HX + (size_t)row * D + col) = o; }
        float pj[16];
#pragma unroll
        for (int j = 0; j < 16; ++j) { float s = 0.f;
#pragma unroll
            for (int jj = 0; jj < 4; ++jj) { const f32x4 w = *(const f32x4*)(wabT + j * 1028 + 4 * c.lane + 256 * jj); s += (v[jj].x * w.x + v[jj].y * w.y) + (v[jj].z * w.z + v[jj].w * w.w); }
            pj[j] = s; if ((j & 1) == 1) asm volatile("" ::: "memory"); }
        const bool b5 = c.lane & 32, b4 = c.lane & 16, b3 = c.lane & 8, b2 = c.lane & 4;
        float q8[8], q4[4], q2[2];
#pragma unroll
        for (int i = 0; i < 8; ++i) { const float keep = b5 ? pj[i + 8] : pj[i], send = b5 ? pj[i] : pj[i + 8]; q8[i] = keep + __shfl_xor(send, 32); }
#pragma unroll
        for (int i = 0; i < 4; ++i) { const float keep = b4 ? q8[i + 4] : q8[i], send = b4 ? q8[i] : q8[i + 4]; q4[i] = keep + __shfl_xor(send, 16); }
#pragma unroll
        for (int i = 0; i < 2; ++i) { const float keep = b3 ? q4[i + 2] : q4[i], send = b3 ? q4[i] : q4[i + 2]; q2[i] = keep + dppf<0x140>(send); }
        float mine; { const float keep = b2 ? q2[1] : q2[0], send = b2 ? q2[0] : q2[1]; mine = keep + dppf<0x141>(send); }
        mine += dppf<0xB1>(mine); mine += dppf<0x4E>(mine);
        const int jl = (b5 ? 8 : 0) + (b4 ? 4 : 0) + (b3 ? 2 : 0) + (b2 ? 1 : 0);
        if ((c.lane & 3) == 0) {
            if (jl < 8) { const float t = mine + a.in[I_DTBIAS][jl]; const float sp = t > 20.f ? t : log1pf(expf(t)); GB[(size_t)row * 16 + jl] = -expf(a.in[I_ALOG][jl]) * sp; }
            else GB[(size_t)row * 16 + jl] = 1.f / (1.f + expf(-mine)); }
    }
}

__device__ __forceinline__ void phase_conv(const Ctx& c) {
    const Args& a = *c.a;
    const bf16* PRE = (const bf16*)(c.ws + WS_QKVPRE); bf16* OUT = (bf16*)(c.ws + WS_QKV);
    const float* cw = a.in[I_CONV];
#pragma unroll 1
    for (int pass = 0; pass < 3; ++pass) { const int ch0 = pass * 512 + 8 * c.lane;
        f32x4 wt[9][2];
#pragma unroll
        for (int i = 0; i < 9; ++i) { wt[i][0] = *(const f32x4*)(cw + i * 1536 + ch0); wt[i][1] = *(const f32x4*)(cw + i * 1536 + ch0 + 4); }
#define CONV_LOAD(DST, ROW) do { const int row_ = (ROW); int nb_row[9]; bool ok[9]; \
            if (row_ < ML) { const int t = row_ & 2047, gr = t >> 6, gc = t & 63; \
                _Pragma("unroll") for (int dy = -1; dy <= 1; ++dy) _Pragma("unroll") for (int dx = -1; dx <= 1; ++dx) { const int i = (dy + 1) * 3 + dx + 1; ok[i] = (gr + dy >= 0) && (gr + dy < 32) && (gc + dx >= 0) && (gc + dx < 64); nb_row[i] = row_ + dy * 64 + dx; } } \
            else { const int t = (row_ - ML) & 255; _Pragma("unroll") for (int i = 0; i < 9; ++i) { ok[i] = false; nb_row[i] = row_; } \
                _Pragma("unroll") for (int dx = -1; dx <= 1; ++dx) { ok[4 + dx] = (t + dx >= 0) && (t + dx < 256); nb_row[4 + dx] = row_ + dx; } } \
            _Pragma("unroll") for (int i = 0; i < 9; ++i) DST[i] = ok[i] ? *(const v4u*)(PRE + (size_t)nb_row[i] * 1536 + ch0) : (v4u){0u, 0u, 0u, 0u}; } while (0)
        v4u nin[9];
        if (c.gw < MT) CONV_LOAD(nin, c.gw);
#pragma unroll 1
        for (int row = c.gw; row < MT; row += c.NGW) {
            v4u in[9];
#pragma unroll
            for (int i = 0; i < 9; ++i) in[i] = nin[i];
            if (row + c.NGW < MT) CONV_LOAD(nin, row + c.NGW);
            float o[8];
#pragma unroll
            for (int q = 0; q < 8; ++q) o[q] = 0.f;
#pragma unroll
            for (int i = 0; i < 9; ++i) { const unsigned w[4] = {in[i].x, in[i].y, in[i].z, in[i].w}; const float kk[8] = {wt[i][0].x, wt[i][0].y, wt[i][0].z, wt[i][0].w, wt[i][1].x, wt[i][1].y, wt[i][1].z, wt[i][1].w};
#pragma unroll
                for (int q = 0; q < 4; ++q) { o[2 * q] = fmaf(bflo(w[q]), kk[2 * q], o[2 * q]); o[2 * q + 1] = fmaf(bfhi(w[q]), kk[2 * q + 1], o[2 * q + 1]); } }
            float ssq = 0.f;
#pragma unroll
            for (int q = 0; q < 8; ++q) { o[q] = siluf_(o[q]); ssq = fmaf(o[q], o[q], ssq); }
            if (pass < 2) { const float sc = rsqrtf(row_sum16(ssq) + EPS) * (pass == 0 ? 0.08838834764831845f : 1.f);
#pragma unroll
                for (int q = 0; q < 8; ++q) o[q] *= sc; }
            v4u ov; ov.x = pk2(o[0], o[1]); ov.y = pk2(o[2], o[3]); ov.z = pk2(o[4], o[5]); ov.w = pk2(o[6], o[7]);
            *(v4u*)(OUT + (size_t)row * 1536 + ch0) = ov;
        }
#undef CONV_LOAD
    }
}

__device__ __forceinline__ int scan_row(int b, int dir, int step) {
    if (step < LC) { const int t = dir ? LC - 1 - step : step; return ML + b * LC + t; }
    const int t = step - LC; return b * SEQ + (dir ? SEQ - 1 - t : t);
}
__device__ __forceinline__ void phase_combine(const Ctx& c) {
    const Args& a = *c.a;
    const bf16* OG0 = (const bf16*)(c.ws + WS_OG); const bf16* OG1 = OG0 + (size_t)ML * 512; const bf16* Z = (const bf16*)(c.ws + WS_Z);
    bf16* CAT = (bf16*)(c.ws + WS_CAT);
    const f32x2 ng = *(const f32x2*)(a.in[I_GDNNORM] + 2 * c.lane);
    unsigned n0[4], n1[4], nz[4];
#define CB_LOAD(R) do { _Pragma("unroll") for (int h = 0; h < 4; ++h) { const size_t o_ = (size_t)(R) * 512 + h * 128 + 2 * c.lane; n0[h] = *(const unsigned*)(OG0 + o_); n1[h] = *(const unsigned*)(OG1 + o_); nz[h] = *(const unsigned*)(Z + o_); } } while (0)
    if (c.gw < ML) CB_LOAD(c.gw);
    for (int row = c.gw; row < ML; row += c.NGW) {
        unsigned w0[4], w1[4], zw[4];
#pragma unroll
        for (int h = 0; h < 4; ++h) { w0[h] = n0[h]; w1[h] = n1[h]; zw[h] = nz[h]; }
        { const int rn = row + c.NGW < ML ? row + c.NGW : row; CB_LOAD(rn); }
#pragma unroll
        for (int h = 0; h < 4; ++h) { const int ch = h * 128 + 2 * c.lane;
            const float o0 = bflo(w0[h]) + bflo(w1[h]), o1 = bfhi(w0[h]) + bfhi(w1[h]);
            const float r = rsqrtf(wave_sum(o0 * o0 + o1 * o1) * (1.f / 128.f) + EPS);
            *(unsigned*)(CAT + (size_t)row * 1024 + 512 + ch) = pk2(o0 * r * ng.x * siluf_(bflo(zw[h])), o1 * r * ng.y * siluf_(bfhi(zw[h]))); }
    }
#undef CB_LOAD
}

__device__ __forceinline__ unsigned char* x1_row(unsigned char* ws, int row) { return ws + (row < 8192 ? WS_X1A + (size_t)row * 2048 : WS_X1B + (size_t)(row - 8192) * 2048); }
__device__ __forceinline__ void phase_rows2(const Ctx& c) {
    const Args& a = *c.a;
    const float* MOD = (const float*)(c.ws + WS_MOD); const bf16* YRAW = (const bf16*)(c.ws + WS_YRAW); bf16* HX2 = (bf16*)(c.ws + WS_HX2);
    v2u ny[4]; f32x4 nxx[4], gpo[4], gpf[4];
#pragma unroll
    for (int j = 0; j < 4; ++j) { gpo[j] = *(const f32x4*)(a.in[I_GPOSTMIX] + 4 * c.lane + 256 * j); gpf[j] = *(const f32x4*)(a.in[I_GPREFFN] + 4 * c.lane + 256 * j); }
    if (c.gw < ML) {
#pragma unroll
        for (int j = 0; j < 4; ++j) { ny[j] = *((const v2u*)(YRAW + (size_t)c.gw * D) + c.lane + 64 * j); nxx[j] = *((const f32x4*)(a.in[I_X] + (size_t)c.gw * D) + c.lane + 64 * j); } }
    for (int row = c.gw; row < ML; row += c.NGW) {
        const float* mr = MOD + (row >> 11) * 6144;
        f32x4 gtv[4], shv[4], sclv[4];
#pragma unroll
        for (int j = 0; j < 4; ++j) { const int col = 4 * c.lane + 256 * j; gtv[j] = *(const f32x4*)(mr + 2048 + col); shv[j] = *(const f32x4*)(mr + 3072 + col); sclv[j] = *(const f32x4*)(mr + 4096 + col); }
        f32x4 y[4], x[4]; float ss = 0.f;
#pragma unroll
        for (int j = 0; j < 4; ++j) { y[j] = (f32x4){bflo(ny[j].x), bfhi(ny[j].x), bflo(ny[j].y), bfhi(ny[j].y)}; x[j] = nxx[j];
            ss += (y[j].x * y[j].x + y[j].y * y[j].y) + (y[j].z * y[j].z + y[j].w * y[j].w); }
        if (row + c.NGW < ML) { const size_t r2 = (size_t)(row + c.NGW);
#pragma unroll
            for (int j = 0; j < 4; ++j) { ny[j] = *((const v2u*)(YRAW + r2 * D) + c.lane + 64 * j); nxx[j] = *((const f32x4*)(a.in[I_X] + r2 * D) + c.lane + 64 * j); } }
        const float r = rsqrtf(wsum(ss) * (1.f / D) + EPS); float s2 = 0.f;
#pragma unroll
        for (int j = 0; j < 4; ++j) { const int col = 4 * c.lane + 256 * j;
            x[j] = x[j] + gtv[j] * ((y[j] * r) * gpo[j]);
            { v2u xo; xo.x = pk2(x[j].x, x[j].y); xo.y = pk2(x[j].z, x[j].w); *(v2u*)(x1_row(c.ws, row) + 2 * col) = xo; }
            s2 += (x[j].x * x[j].x + x[j].y * x[j].y) + (x[j].z * x[j].z + x[j].w * x[j].w); }
        const float r2 = rsqrtf(wsum(s2) * (1.f / D) + EPS);
#pragma unroll
        for (int j = 0; j < 4; ++j) { const int col = 4 * c.lane + 256 * j;
            const f32x4 hv = (x[j] * r2) * gpf[j] * (sclv[j] + 1.f) + shv[j];
            v2u o; o.x = pk2(hv.x, hv.y); o.y = pk2(hv.z, hv.w);
            *(v2u*)(HX2 + (size_t)row * D + col) = o;
            x[j] = (f32x4){bflo(o.x), bfhi(o.x), bflo(o.y), bfhi(o.y)}; }
        { float mx = 0.f;
#pragma unroll
          for (int j = 0; j < 4; ++j) mx = fmaxf(mx, fmaxf(fmaxf(fabsf(x[j].x), fabsf(x[j].y)), fmaxf(fabsf(x[j].z), fabsf(x[j].w))));
          mx = wmax(mx); const float hs = mx > 0.f ? 256.f / mx : 1.f;
          unsigned char* hq = c.ws + WS_HQ8 + (size_t)row * 2048;
#pragma unroll
          for (int j = 0; j < 4; ++j) { const float a0 = x[j].x * hs, a1 = x[j].y * hs, a2 = x[j].z * hs, a3 = x[j].w * hs;
              int w = __builtin_amdgcn_cvt_pk_fp8_f32(a0, a1, 0, false); w = __builtin_amdgcn_cvt_pk_fp8_f32(a2, a3, w, true);
              const f32x2 b01 = __builtin_amdgcn_cvt_pk_f32_fp8(w, false), b23 = __builtin_amdgcn_cvt_pk_f32_fp8(w, true);
              int w2 = __builtin_amdgcn_cvt_pk_fp8_f32((a0 - b01.x) * 16.f, (a1 - b01.y) * 16.f, 0, false); w2 = __builtin_amdgcn_cvt_pk_fp8_f32((a2 - b23.x) * 16.f, (a3 - b23.y) * 16.f, w2, true);
              *(unsigned*)(hq + 4 * c.lane + 256 * j) = (unsigned)w; *(unsigned*)(hq + 1024 + 4 * c.lane + 256 * j) = (unsigned)w2; }
          if (c.lane == 0) ((float*)(c.ws + WS_HS))[row] = 1.f / hs; }
    }
}


constexpr int KROW = 136;
__device__ __forceinline__ float unfkey(unsigned k) { const unsigned u = (k & 0x80000000u) ? (k ^ 0x80000000u) : ~k; return __builtin_bit_cast(float, u); }
__device__ __forceinline__ void ins16(unsigned (&L)[16], unsigned key) {
#pragma unroll
    for (int q = 0; q < 16; ++q) { const unsigned hi = L[q] > key ? L[q] : key, lo = L[q] > key ? key : L[q]; L[q] = hi; key = lo; }
}
__device__ __forceinline__ void sort16_desc(unsigned (&a)[16]) {
#pragma unroll
    for (int kk = 2; kk <= 16; kk <<= 1)
#pragma unroll
        for (int j = kk >> 1; j >= 1; j >>= 1)
#pragma unroll
            for (int i = 0; i < 16; ++i) { const int l = i ^ j; if (l > i) { const unsigned hi = a[i] > a[l] ? a[i] : a[l], lo = a[i] > a[l] ? a[l] : a[i]; if ((i & kk) == 0) { a[i] = hi; a[l] = lo; } else { a[i] = lo; a[l] = hi; } } }
}
__device__ __forceinline__ void top16_of_two(unsigned (&A)[16], const unsigned (&B)[16]) {
#pragma unroll
    for (int q = 0; q < 16; ++q) A[q] = A[q] > B[15 - q] ? A[q] : B[15 - q];
#pragma unroll
    for (int j = 8; j >= 1; j >>= 1)
#pragma unroll
        for (int q = 0; q < 16; ++q) if ((q & j) == 0) { const unsigned hi = A[q] > A[q + j] ? A[q] : A[q + j], lo = A[q] > A[q + j] ? A[q + j] : A[q]; A[q] = hi; A[q + j] = lo; }
}
__device__ __forceinline__ void merge16(unsigned (&L)[16]) {
    unsigned R[16];
#pragma unroll
    for (int q = 0; q < 16; ++q) R[q] = (unsigned)__shfl_xor((int)L[15 - q], 32);
#pragma unroll
    for (int q = 0; q < 16; ++q) L[q] = L[q] > R[q] ? L[q] : R[q];
#pragma unroll
    for (int j = 8; j >= 1; j >>= 1)
#pragma unroll
        for (int q = 0; q < 16; ++q) if ((q & j) == 0) { const unsigned hi = L[q] > L[q + j] ? L[q] : L[q + j], lo = L[q] > L[q + j] ? L[q + j] : L[q]; L[q] = hi; L[q + j] = lo; }
}
__device__ __forceinline__ void phase_topk(const Ctx& c) {
    const Args& a = *c.a;
    bf16* kl = (bf16*)c.lds;
    unsigned char* wtab = c.lds + 2 * 128 * KROW * 2 + c.wave * 1088;
    const bf16* QP = (const bf16*)(c.ws + WS_QP); int* IDX = (int*)(c.ws + WS_IDX); float* GATE = (float*)(c.ws + WS_GATE);
    const int r = c.lane & 31, hh = c.lane >> 5;
    { const unsigned char ptab[50] = {0, 1, 2, 3, 4, 5, 6, 7, 8, 9, 10, 11, 12, 13, 14, 15, 16, 17, 18, 19, 20, 21, 22, 23, 32, 33, 34, 35, 36, 48, 49, 50, 51, 64, 65, 66, 80, 81, 96, 97, 112, 113, 128, 144, 160, 176, 192, 208, 224, 240};
      if (c.lane < 50) wtab[1024 + c.lane] = ptab[c.lane < 50 ? c.lane : 0]; }
    for (int item = c.bid; item < 8 * 32; item += c.G) {
        const int h = item & 7, tr = item >> 3;
        __syncthreads();
        { f32x4 kv[16];
#pragma unroll
          for (int q = 0; q < 16; ++q) { const int i = c.tid + NTHREADS * q, k4 = i & 31, n = (i >> 5) & 127, p = i >> 12; kv[q] = *(const f32x4*)(a.in[I_KEYS] + ((size_t)((h * 2 + p) * 128 + n)) * 128 + 4 * k4); }
#pragma unroll
          for (int q = 0; q < 16; ++q) { const int i = c.tid + NTHREADS * q, k4 = i & 31, n = (i >> 5) & 127, p = i >> 12; v2u o; o.x = pk2(kv[q].x, kv[q].y); o.y = pk2(kv[q].z, kv[q].w);
              *(v2u*)(kl + (p * 128 + n) * KROW + 4 * k4) = o; } }
        __syncthreads();
        for (int tile = c.wave; tile < 16; tile += NWAVES) {
            const int tok = tr * 512 + tile * 32 + r;
            unsigned LA[16], LB[16];
#pragma unroll
            for (int p = 0; p < 2; ++p) {
                bf16x8 qf[8];
#pragma unroll
                for (int kk = 0; kk < 8; ++kk) qf[kk] = *(const bf16x8*)(QP + (size_t)tok * 2048 + h * 256 + p * 128 + kk * 16 + hh * 8);
                f32x16 acc[4];
#pragma unroll
                for (int nt = 0; nt < 4; ++nt)
#pragma unroll
                    for (int i = 0; i < 16; ++i) acc[nt][i] = 0.f;
#pragma unroll
                for (int kk = 0; kk < 8; ++kk)
#pragma unroll
                    for (int nt = 0; nt < 4; ++nt) acc[nt] = MFMA32(*(const bf16x8*)(kl + (p * 128 + nt * 32 + r) * KROW + kk * 16 + hh * 8), qf[kk], acc[nt]);
                unsigned (&L)[16] = p ? LB : LA;
                unsigned G1[16], G2[16], G3[16];
#pragma unroll
                for (int i = 0; i < 16; ++i) { const int n0 = (i & 3) + 8 * (i >> 2) + 4 * hh;
                    L[i] = (fkey(acc[0][i]) & ~127u) | (unsigned)(127 - n0); G1[i] = (fkey(acc[1][i]) & ~127u) | (unsigned)(127 - (32 + n0));
                    G2[i] = (fkey(acc[2][i]) & ~127u) | (unsigned)(127 - (64 + n0)); G3[i] = (fkey(acc[3][i]) & ~127u) | (unsigned)(127 - (96 + n0)); }
                sort16_desc(L); sort16_desc(G1); sort16_desc(G2); sort16_desc(G3);
                top16_of_two(L, G1); top16_of_two(G2, G3); top16_of_two(L, G2);
                merge16(L);
            }
            unsigned char* tt = wtab + r * 32;
            if (hh == 0) {
#pragma unroll
                for (int q = 0; q < 16; ++q) tt[q] = (unsigned char)(127u - (LA[q] & 127u)); }
            else {
#pragma unroll
                for (int q = 0; q < 16; ++q) tt[16 + q] = (unsigned char)(127u - (LB[q] & 127u)); }
            float va[16], vb[16];
#pragma unroll
            for (int q = 0; q < 16; ++q) { va[q] = unfkey(LA[q] & ~127u); vb[q] = unfkey(LB[q] & ~127u); }
            unsigned LC[16];
#pragma unroll
            for (int q = 0; q < 16; ++q) LC[q] = 0u;
            { const float s0 = va[0] + vb[0], s1 = va[0] + vb[1]; ins16(LC, (fkey(hh ? s1 : s0) & ~63u) | (unsigned)(63 - (0 + hh))); }
            { const float s0 = va[0] + vb[2], s1 = va[0] + vb[3]; ins16(LC, (fkey(hh ? s1 : s0) & ~63u) | (unsigned)(63 - (2 + hh))); }
            { const float s0 = va[0] + vb[4], s1 = va[0] + vb[5]; ins16(LC, (fkey(hh ? s1 : s0) & ~63u) | (unsigned)(63 - (4 + hh))); }
            { const float s0 = va[0] + vb[6], s1 = va[0] + vb[7]; ins16(LC, (fkey(hh ? s1 : s0) & ~63u) | (unsigned)(63 - (6 + hh))); }
            { const float s0 = va[0] + vb[8], s1 = va[0] + vb[9]; ins16(LC, (fkey(hh ? s1 : s0) & ~63u) | (unsigned)(63 - (8 + hh))); }
            { const float s0 = va[0] + vb[10], s1 = va[0] + vb[11]; ins16(LC, (fkey(hh ? s1 : s0) & ~63u) | (unsigned)(63 - (10 + hh))); }
            { const float s0 = va[0] + vb[12], s1 = va[0] + vb[13]; ins16(LC, (fkey(hh ? s1 : s0) & ~63u) | (unsigned)(63 - (12 + hh))); }
            { const float s0 = va[0] + vb[14], s1 = va[0] + vb[15]; ins16(LC, (fkey(hh ? s1 : s0) & ~63u) | (unsigned)(63 - (14 + hh))); }
            { const float s0 = va[1] + vb[0], s1 = va[1] + vb[1]; ins16(LC, (fkey(hh ? s1 : s0) & ~63u) | (unsigned)(63 - (16 + hh))); }
            { const float s0 = va[1] + vb[2], s1 = va[1] + vb[3]; ins16(LC, (fkey(hh ? s1 : s0) & ~63u) | (unsigned)(63 - (18 + hh))); }
            { const float s0 = va[1] + vb[4], s1 = va[1] + vb[5]; ins16(LC, (fkey(hh ? s1 : s0) & ~63u) | (unsigned)(63 - (20 + hh))); }
            { const float s0 = va[1] + vb[6], s1 = va[1] + vb[7]; ins16(LC, (fkey(hh ? s1 : s0) & ~63u) | (unsigned)(63 - (22 + hh))); }
            { const float s0 = va[2] + vb[0], s1 = va[2] + vb[1]; ins16(LC, (fkey(hh ? s1 : s0) & ~63u) | (unsigned)(63 - (24 + hh))); }
            { const float s0 = va[2] + vb[2], s1 = va[2] + vb[3]; ins16(LC, (fkey(hh ? s1 : s0) & ~63u) | (unsigned)(63 - (26 + hh))); }
            { const float s0 = va[2] + vb[4], s1 = va[3] + vb[0]; ins16(LC, (fkey(hh ? s1 : s0) & ~63u) | (unsigned)(63 - (28 + hh))); }
            { const float s0 = va[3] + vb[1], s1 = va[3] + vb[2]; ins16(LC, (fkey(hh ? s1 : s0) & ~63u) | (unsigned)(63 - (30 + hh))); }
            { const float s0 = va[3] + vb[3], s1 = va[4] + vb[0]; ins16(LC, (fkey(hh ? s1 : s0) & ~63u) | (unsigned)(63 - (32 + hh))); }
            { const float s0 = va[4] + vb[1], s1 = va[4] + vb[2]; ins16(LC, (fkey(hh ? s1 : s0) & ~63u) | (unsigned)(63 - (34 + hh))); }
            { const float s0 = va[5] + vb[0], s1 = va[5] + vb[1]; ins16(LC, (fkey(hh ? s1 : s0) & ~63u) | (unsigned)(63 - (36 + hh))); }
            { const float s0 = va[6] + vb[0], s1 = va[6] + vb[1]; ins16(LC, (fkey(hh ? s1 : s0) & ~63u) | (unsigned)(63 - (38 + hh))); }
            { const float s0 = va[7] + vb[0], s1 = va[7] + vb[1]; ins16(LC, (fkey(hh ? s1 : s0) & ~63u) | (unsigned)(63 - (40 + hh))); }
            { const float s0 = va[8] + vb[0], s1 = va[9] + vb[0]; ins16(LC, (fkey(hh ? s1 : s0) & ~63u) | (unsigned)(63 - (42 + hh))); }
            { const float s0 = va[10] + vb[0], s1 = va[11] + vb[0]; ins16(LC, (fkey(hh ? s1 : s0) & ~63u) | (unsigned)(63 - (44 + hh))); }
            { const float s0 = va[12] + vb[0], s1 = va[13] + vb[0]; ins16(LC, (fkey(hh ? s1 : s0) & ~63u) | (unsigned)(63 - (46 + hh))); }
            { const float s0 = va[14] + vb[0], s1 = va[15] + vb[0]; ins16(LC, (fkey(hh ? s1 : s0) & ~63u) | (unsigned)(63 - (48 + hh))); }
            merge16(LC);
            WAVE_LDS_SYNC();
            float ev[16]; float den = 0.f; const float mx = unfkey(LC[0] & ~63u);
#pragma unroll
            for (int q = 0; q < 16; ++q) { ev[q] = __expf(unfkey(LC[q] & ~63u) - mx); den += ev[q]; }
            const float inv = 1.f / den;
            if (hh == 0) { int ex[16];
#pragma unroll
                for (int q = 0; q < 16; ++q) { const unsigned pc = wtab[1024 + (63u - (LC[q] & 63u))]; ex[q] = (int)tt[pc >> 4] * 128 + (int)tt[16 + (pc & 15u)]; }
#pragma unroll
                for (int q = 0; q < 4; ++q) *(v4u*)(IDX + (size_t)tok * 128 + h * 16 + 4 * q) = (v4u){(unsigned)ex[4 * q], (unsigned)ex[4 * q + 1], (unsigned)ex[4 * q + 2], (unsigned)ex[4 * q + 3]}; }
            else {
#pragma unroll
                for (int q = 0; q < 4; ++q) *(f32x4*)(GATE + (size_t)tok * 128 + h * 16 + 4 * q) = (f32x4){ev[4 * q] * inv, ev[4 * q + 1] * inv, ev[4 * q + 2] * inv, ev[4 * q + 3] * inv}; }
            WAVE_LDS_SYNC();
        }
    }
}

__device__ __forceinline__ void phase_fp8_tables(const Ctx& c) {
    const Args& a = *c.a;
    f32x4 nv[2][4];
#define F8_LOAD(R0) do { _Pragma("unroll") for (int u = 0; u < 2; ++u) { int rr = (R0) + u * c.NGW; rr = rr < 2 * NEXP ? rr : 2 * NEXP - 1; const bool isv_ = rr >= NEXP; const int e_ = isv_ ? rr - NEXP : rr; \
        const f32x4* src = (const f32x4*)((isv_ ? a.in[I_PV] : a.in[I_PU]) + (size_t)e_ * D) + c.lane; _Pragma("unroll") for (int j = 0; j < 4; ++j) nv[u][j] = src[64 * j]; } } while (0)
    if (c.gw < 2 * NEXP) F8_LOAD(c.gw);
    for (int r0 = c.gw; r0 < 2 * NEXP; r0 += 2 * c.NGW) {
        f32x4 v[2][4];
#pragma unroll
        for (int u = 0; u < 2; ++u)
#pragma unroll
            for (int j = 0; j < 4; ++j) v[u][j] = nv[u][j];
        { const int rn = r0 + 2 * c.NGW < 2 * NEXP ? r0 + 2 * c.NGW : r0; F8_LOAD(rn); }
#pragma unroll
        for (int u = 0; u < 2; ++u) { const int r = r0 + u * c.NGW;
            if (r < 2 * NEXP) { const bool isv = r >= NEXP; const int e = isv ? r - NEXP : r; float m = 0.f;
#pragma unroll
                for (int j = 0; j < 4; ++j) m = fmaxf(m, fmaxf(fmaxf(fabsf(v[u][j].x), fabsf(v[u][j].y)), fmaxf(fabsf(v[u][j].z), fabsf(v[u][j].w))));
                m = wmax(m); const float inv = m > 0.f ? 256.f / m : 0.f;
                unsigned char* dst = c.ws + (isv ? WS_V8 : WS_U8) + (size_t)e * D + 4 * c.lane;
#pragma unroll
                for (int j = 0; j < 4; ++j) { int w = __builtin_amdgcn_cvt_pk_fp8_f32(v[u][j].x * inv, v[u][j].y * inv, 0, false); w = __builtin_amdgcn_cvt_pk_fp8_f32(v[u][j].z * inv, v[u][j].w * inv, w, true); *(unsigned*)(dst + 256 * j) = (unsigned)w; }
                if (c.lane == 0) ((float*)(c.ws + (isv ? WS_VSC : WS_USC)))[e] = m * (1.f / 256.f); } }
    }
#undef F8_LOAD
}
__device__ __forceinline__ void fp8x16_to_f32(const v4u& r, float (&f)[16]) {
    const unsigned w[4] = {r.x, r.y, r.z, r.w};
#pragma unroll
    for (int j = 0; j < 4; ++j) { const f32x2 lo = __builtin_amdgcn_cvt_pk_f32_fp8((int)w[j], false), hi = __builtin_amdgcn_cvt_pk_f32_fp8((int)w[j], true); f[4 * j] = lo.x; f[4 * j + 1] = lo.y; f[4 * j + 2] = hi.x; f[4 * j + 3] = hi.y; }
}
__device__ __forceinline__ unsigned xcc_id() { return (unsigned)__builtin_amdgcn_s_getreg((3 << 11) | 20) & 7u; }

typedef long l64x2 __attribute__((ext_vector_type(2)));
struct E1Bat { l64x2 rw[16]; };
__device__ __forceinline__ void phase_exp1(const Ctx& c) {
    typedef float f32x4m __attribute__((ext_vector_type(4)));
    const int* IDX = (const int*)(c.ws + WS_IDX); const unsigned char* U8 = c.ws + WS_U8; float* PACT = (float*)(c.ws + WS_PACT);
    unsigned* cnt = (unsigned*)(c.ws + WS_CTL) + CW_E1;
    constexpr int CH = 8;
    constexpr int SROW = 144;
    unsigned char* wl = c.lds + c.wave * 14080; int* le = (int*)wl; unsigned char* himg = wl + 4096; float* res = (float*)(wl + 6144); unsigned char* stage = wl + 6656;
    const int xcc = (int)xcc_id(), r16 = c.lane & 15, g4 = c.lane >> 4, row8 = c.lane >> 3, pc8 = c.lane & 7; const bool bcol = r16 < 2;
    int bo = 0; unsigned tq = 0;
    if (c.lane == 0) tq = __hip_atomic_fetch_add(cnt + 64 * (xcc & 7), (unsigned)CH, __ATOMIC_RELAXED, __HIP_MEMORY_SCOPE_AGENT);
    for (;;) {
        const int x = (xcc + bo) & 7;
        const unsigned t0 = (unsigned)__builtin_amdgcn_readfirstlane((int)tq);
        if (t0 >= (unsigned)ML) { if (++bo >= 8) break; tq = 0; if (c.lane == 0) tq = __hip_atomic_fetch_add(cnt + 64 * ((xcc + bo) & 7), (unsigned)CH, __ATOMIC_RELAXED, __HIP_MEMORY_SCOPE_AGENT); continue; }
        tq = 0; if (c.lane == 0) tq = __hip_atomic_fetch_add(cnt + 64 * x, (unsigned)CH, __ATOMIC_RELAXED, __HIP_MEMORY_SCOPE_AGENT);
        { v4u ee[4], im[2];
#pragma unroll
          for (int q = 0; q < 4; ++q) ee[q] = *(const v4u*)(IDX + (size_t)t0 * 128 + 256 * q + 4 * c.lane);
#pragma unroll
          for (int q = 0; q < 2; ++q) { const int p = c.lane + 64 * q; im[q] = *(const v4u*)(c.ws + WS_HQ8 + ((size_t)t0 + (p >> 4)) * 2048 + ((p >> 3) & 1) * 1024 + 128 * x + 16 * (p & 7)); }
#pragma unroll
          for (int q = 0; q < 4; ++q) *(v4u*)(le + 256 * q + 4 * c.lane) = ee[q];
#pragma unroll
          for (int q = 0; q < 2; ++q) *(v4u*)(himg + 16 * (c.lane + 64 * q)) = im[q]; }
        WAVE_LDS_SYNC();
#define E1_LOAD(G, B) do { const int bb = (B) < CH ? (B) : 0; _Pragma("unroll") for (int i = 0; i < 16; ++i) G.rw[i] = *(const l64x2*)(U8 + (size_t)le[bb * 128 + 8 * i + row8] * D + 128 * x + 16 * pc8); } while (0)
#define E1_W(G, GI) do { unsigned char* sb_ = stage + ((GI) % 3) * (16 * SROW); *(l64x2*)(sb_ + row8 * SROW + 16 * pc8) = G.rw[2 * (GI)]; *(l64x2*)(sb_ + (8 + row8) * SROW + 16 * pc8) = G.rw[2 * (GI) + 1]; } while (0)
#define E1_R(A01, A23, GI) do { const unsigned char* sb_ = stage + ((GI) % 3) * (16 * SROW); A01 = *(const l64x2*)(sb_ + r16 * SROW + 32 * g4); A23 = *(const l64x2*)(sb_ + r16 * SROW + 32 * g4 + 16); } while (0)
#define E1_COMP(G, B) do { const unsigned char* hb = himg + ((B) * 2 + (r16 & 1)) * 128 + 32 * g4; long bq[4]; _Pragma("unroll") for (int m = 0; m < 4; ++m) { const long v = *(const long*)(hb + 8 * m); bq[m] = bcol ? v : 0l; } \
            l64x2 a01, a23, n01, n23; \
            E1_W(G, 0); E1_W(G, 1); WAVE_LDS_SYNC(); E1_R(a01, a23, 0); \
            _Pragma("unroll") for (int gi = 0; gi < 8; ++gi) { \
                if (gi + 2 < 8) E1_W(G, gi + 2); \
                WAVE_LDS_SYNC(); \
                if (gi + 1 < 8) E1_R(n01, n23, gi + 1); \
                f32x4m acc = {0.f, 0.f, 0.f, 0.f}; \
                acc = __builtin_amdgcn_mfma_f32_16x16x32_fp8_fp8(a01.x, bq[0], acc, 0, 0, 0); acc = __builtin_amdgcn_mfma_f32_16x16x32_fp8_fp8(a01.y, bq[1], acc, 0, 0, 0); \
                acc = __builtin_amdgcn_mfma_f32_16x16x32_fp8_fp8(a23.x, bq[2], acc, 0, 0, 0); acc = __builtin_amdgcn_mfma_f32_16x16x32_fp8_fp8(a23.y, bq[3], acc, 0, 0, 0); \
                _Pragma("unroll") for (int q = 0; q < 4; ++q) { const float lo = dppf<0xB1>(acc[q]); if (r16 == 0) res[gi * 16 + 4 * g4 + q] = acc[q] + lo * 0.0625f; } \
                a01 = n01; a23 = n23; } \
            WAVE_LDS_SYNC(); \
            { unsigned* po = (unsigned*)PACT + (size_t)x * ((size_t)ML * 64) + ((size_t)t0 + (B)) * 64; const f32x2 rr = *(const f32x2*)(res + 2 * c.lane); po[c.lane] = pk2(rr.x, rr.y); }     \
            WAVE_LDS_SYNC(); } while (0)
        E1Bat ga, gb;
        E1_LOAD(ga, 0);
#pragma unroll 1
        for (int b2 = 0; b2 < CH; b2 += 2) {
            E1_LOAD(gb, b2 + 1);
            __builtin_amdgcn_sched_barrier(0);
            E1_COMP(ga, b2);
            __builtin_amdgcn_sched_barrier(0);
            E1_LOAD(ga, b2 + 2);
            __builtin_amdgcn_sched_barrier(0);
            E1_COMP(gb, b2 + 1);
            __builtin_amdgcn_sched_barrier(0);
        }
#undef E1_LOAD
#undef E1_COMP
#undef E1_W
#undef E1_R
    }
}
__device__ __forceinline__ void phase_exp1b(const Ctx& c) {
    const int* IDX = (const int*)(c.ws + WS_IDX); const float* GATE = (const float*)(c.ws + WS_GATE); const float* HS = (const float*)(c.ws + WS_HS); const unsigned* PACT = (const unsigned*)(c.ws + WS_PACT);
    const float* USC = (const float*)(c.ws + WS_USC); const float* VSC = (const float*)(c.ws + WS_VSC); float* ACT = (float*)(c.ws + WS_ACT);
    const size_t NP = (size_t)ML * 64, stride = (size_t)c.G * NTHREADS;
    for (size_t p0 = (size_t)c.bid * NTHREADS + c.tid; p0 < NP; p0 += 4 * stride) {
        unsigned pv[4][8]; f32x2 gt[4]; float hs[4], us[4][2], vs[4][2]; v2u e[4];
#pragma unroll
        for (int q = 0; q < 4; ++q) { size_t p = p0 + q * stride; p = p < NP ? p : NP - 1;
#pragma unroll
            for (int x = 0; x < 8; ++x) pv[q][x] = PACT[(size_t)x * NP + p];
            e[q] = *(const v2u*)(IDX + 2 * p); gt[q] = *(const f32x2*)(GATE + 2 * p); hs[q] = HS[p >> 6]; }
#pragma unroll
        for (int q = 0; q < 4; ++q) { us[q][0] = USC[e[q].x]; us[q][1] = USC[e[q].y]; vs[q][0] = VSC[e[q].x]; vs[q][1] = VSC[e[q].y]; }
#pragma unroll
        for (int q = 0; q < 4; ++q) { const size_t p = p0 + q * stride; float s0 = 0.f, s1 = 0.f;
#pragma unroll
            for (int x = 0; x < 8; ++x) { s0 += bflo(pv[q][x]); s1 += bfhi(pv[q][x]); }
            if (p < NP) *(f32x2*)(ACT + 2 * p) = (f32x2){gelu_erf(s0 * hs[q] * us[q][0]) * gt[q].x * vs[q][0], gelu_erf(s1 * hs[q] * us[q][1]) * gt[q].y * vs[q][1]}; }
    }
}
__device__ __forceinline__ void phase_exp2(const Ctx& c) {
    const int* IDX = (const int*)(c.ws + WS_IDX); const float* ACT = (const float*)(c.ws + WS_ACT); const unsigned char* V8 = c.ws + WS_V8;
    bf16* Y = (bf16*)(c.ws + WS_Y); float* SSQP = (float*)(c.ws + WS_SSQP);
    unsigned* cnt = (unsigned*)(c.ws + WS_CTL) + CW_E2;
    int* li = (int*)(c.lds + c.wave * 1024); float* la = (float*)(li + 128);
    const int xcc = (int)xcc_id(), sub = c.lane & 7, grp = c.lane >> 3;
    const bool b5 = c.lane & 32, b4 = c.lane & 16, b3 = c.lane & 8;
    constexpr int CH = 8;
    int bo = 0, t = 0, tend = 0;
    int iA = 0, iB = 0; float aA = 0.f, aB = 0.f;
    unsigned tq = 0; if (c.lane == 0) tq = __hip_atomic_fetch_add(cnt + 64 * (xcc & 7), (unsigned)CH, __ATOMIC_RELAXED, __HIP_MEMORY_SCOPE_AGENT);
    for (;;) {
        if (t >= tend) {
            const unsigned t0 = (unsigned)__builtin_amdgcn_readfirstlane((int)tq);
            if (t0 >= (unsigned)ML) { if (++bo >= 8) break; tq = 0; if (c.lane == 0) tq = __hip_atomic_fetch_add(cnt + 64 * ((xcc + bo) & 7), (unsigned)CH, __ATOMIC_RELAXED, __HIP_MEMORY_SCOPE_AGENT); continue; }
            tq = 0; if (c.lane == 0) tq = __hip_atomic_fetch_add(cnt + 64 * ((xcc + bo) & 7), (unsigned)CH, __ATOMIC_RELAXED, __HIP_MEMORY_SCOPE_AGENT);
            t = (int)t0; tend = t + CH;
            iA = IDX[(size_t)t * 128 + c.lane]; iB = IDX[(size_t)t * 128 + 64 + c.lane]; aA = ACT[(size_t)t * 128 + c.lane]; aB = ACT[(size_t)t * 128 + 64 + c.lane];
        }
        const int x = (xcc + bo) & 7;
        li[c.lane] = iA; li[64 + c.lane] = iB; la[c.lane] = aA; la[64 + c.lane] = aB;
        if (t + 1 < tend) { iA = IDX[(size_t)(t + 1) * 128 + c.lane]; iB = IDX[(size_t)(t + 1) * 128 + 64 + c.lane]; aA = ACT[(size_t)(t + 1) * 128 + c.lane]; aB = ACT[(size_t)(t + 1) * 128 + 64 + c.lane]; }
        WAVE_LDS_SYNC();
        float acc[16];
#pragma unroll
        for (int q = 0; q < 16; ++q) acc[q] = 0.f;
        { v4u rows[16]; float av[16];
#pragma unroll
          for (int i = 0; i < 16; ++i) { const int k = 8 * i + grp; rows[i] = *(const v4u*)(V8 + (size_t)li[k] * D + x * 128 + 16 * sub); av[i] = la[k]; }
          asm volatile("" ::: "memory");
#pragma unroll
          for (int i = 0; i < 16; ++i) { float f[16]; fp8x16_to_f32(rows[i], f);
#pragma unroll
              for (int q = 0; q < 16; ++q) acc[q] = fmaf(av[i], f[q], acc[q]); } }
        float q8[8], q4[4], q2[2];
#pragma unroll
        for (int i = 0; i < 8; ++i) { const float keep = b5 ? acc[i + 8] : acc[i], send = b5 ? acc[i] : acc[i + 8]; q8[i] = keep + __shfl_xor(send, 32); }
#pragma unroll
        for (int i = 0; i < 4; ++i) { const float keep = b4 ? q8[i + 4] : q8[i], send = b4 ? q8[i] : q8[i + 4]; q4[i] = keep + __shfl_xor(send, 16); }
#pragma unroll
        for (int i = 0; i < 2; ++i) { const float keep = b3 ? q4[i + 2] : q4[i], send = b3 ? q4[i] : q4[i + 2]; q2[i] = keep + __shfl_xor(send, 8); }
        const int col = x * 128 + 16 * sub + (b5 ? 8 : 0) + (b4 ? 4 : 0) + (b3 ? 2 : 0);
        *(unsigned*)(Y + (size_t)t * D + col) = pk2(q2[0], q2[1]);
        const float ss = wsum(q2[0] * q2[0] + q2[1] * q2[1]);
        SSQP[(size_t)x * ML + t] = ss;
        WAVE_LDS_SYNC();
        ++t;
    }
}
__device__ __forceinline__ void phase_exp3(const Ctx& c) {
    const Args& a = *c.a;
    const float* MOD = (const float*)(c.ws + WS_MOD); const bf16* Y = (const bf16*)(c.ws + WS_Y); const float* SSQP = (const float*)(c.ws + WS_SSQP);
    v2u ny[4], nx[4]; f32x4 ngt[4], g4c[4]; float nss = 0.f;
#pragma unroll
    for (int j = 0; j < 4; ++j) g4c[j] = *(const f32x4*)(a.in[I_GPOSTFFN] + 4 * c.lane + 256 * j);
#define E3_LOAD(R) do { _Pragma("unroll") for (int j = 0; j < 4; ++j) { const int col = 4 * c.lane + 256 * j; ny[j] = *(const v2u*)(Y + (size_t)(R) * D + col); nx[j] = *(const v2u*)(x1_row(c.ws, (R)) + 2 * col); \
            ngt[j] = *(const f32x4*)(MOD + ((R) >> 11) * 6144 + 5120 + col); } \
        nss = (c.lane < 8) ? SSQP[(size_t)c.lane * ML + (R)] : 0.f; } while (0)
    if (c.gw < ML) E3_LOAD(c.gw);
    for (int row = c.gw; row < ML; row += c.NGW) {
        f32x4 y[4], x1[4], gt[4];
#pragma unroll
        for (int j = 0; j < 4; ++j) { y[j] = (f32x4){bflo(ny[j].x), bfhi(ny[j].x), bflo(ny[j].y), bfhi(ny[j].y)}; x1[j] = (f32x4){bflo(nx[j].x), bfhi(nx[j].x), bflo(nx[j].y), bfhi(nx[j].y)}; gt[j] = ngt[j]; }
        const float ss = row_sum16(nss);
        const float tot = __builtin_bit_cast(float, __builtin_amdgcn_readlane(__builtin_bit_cast(int, ss), 0));
        if (row + c.NGW < ML) E3_LOAD(row + c.NGW);
        const float r = rsqrtf(tot * (1.f / D) + EPS);
#pragma unroll
        for (int j = 0; j < 4; ++j) { const int col = 4 * c.lane + 256 * j;
            *(f32x4*)(a.out + (size_t)row * D + col) = x1[j] + gt[j] * ((y[j] * r) * g4c[j]); }
    }
#undef E3_LOAD
}

constexpr int S5_LPOW = 0, S5_BBAR = 33792, S5_CC = 50176, S5_MM = 66560;
__device__ __forceinline__ void s5_build_group(const Ctx& c, int g, int part) {
    const Args& a = *c.a;
    f32x2* LPOW = (f32x2*)(c.lds + S5_LPOW);
    f32x2* BBAR = (f32x2*)(c.lds + S5_BBAR);
    f32x2* CC = (f32x2*)(c.lds + S5_CC);
    float* MM = (float*)(c.lds + S5_MM);
    __syncthreads();
    { const int dir = (c.tid >> 6) & 1, p = c.tid & 63, eq = c.tid >> 7, dg = dir * 32 + g;
        const float dt = expf(a.in[I_LOGDT][dg]), lr = a.in[I_LAMRE][dg * 64 + p], li = a.in[I_LAMIM][dg * 64 + p];
        const f32x4 br4 = *(const f32x4*)(a.in[I_BRE] + (size_t)(dg * 64 + p) * 16 + 4 * eq), bi4 = *(const f32x4*)(a.in[I_BIM] + (size_t)(dg * 64 + p) * 16 + 4 * eq);
        const double ang = (double)li * (double)dt; const float lrdt = lr * dt;
        for (int e = eq; e <= 32; e += 4) { float sn, cs; sincos_d(ang * (double)e, sn, cs); const float mg = expf(lrdt * (float)e); LPOW[(dir * 33 + e) * 64 + p] = (f32x2){mg * cs, mg * sn}; }
        float sn, cs; sincos_d(ang, sn, cs); const float mag = expf(lrdt), lbr = mag * cs, lbi = mag * sn, den = lr * lr + li * li, nr = lbr - 1.f;
        const float cr = (nr * lr + lbi * li) / den, ci = (lbi * lr - nr * li) / den;
#pragma unroll
        for (int q = 0; q < 4; ++q) { const float br = br4[q], bi = bi4[q]; BBAR[(dir * 64 + p) * 16 + 4 * eq + q] = (f32x2){cr * br - ci * bi, cr * bi + ci * br}; } }
    for (int i = c.tid; i < 2048; i += NTHREADS) { const int dir = i >> 10, ch = (i >> 6) & 15, p = i & 63, dg = dir * 32 + g; CC[i] = (f32x2){a.in[I_CRE][(size_t)(dg * 16 + ch) * 64 + p], a.in[I_CIM][(size_t)(dg * 16 + ch) * 64 + p]}; }
    __syncthreads();
    for (int task = c.tid; task < 1024; task += NTHREADS) { const int cpb = task & 3, cb = (task >> 2) & 3, lag = (task >> 4) & 31, dir = task >> 9;
        float acc[4][4];
#pragma unroll
        for (int i = 0; i < 4; ++i)
#pragma unroll
            for (int j = 0; j < 4; ++j) acc[i][j] = 0.f;
        for (int p = 0; p < 64; ++p) { const f32x2 l = LPOW[(dir * 33 + lag) * 64 + p]; f32x2 G[4], Cw[4];
#pragma unroll
            for (int j = 0; j < 4; ++j) { const f32x2 bb = BBAR[(dir * 64 + p) * 16 + 4 * cpb + j]; G[j] = (f32x2){l.x * bb.x - l.y * bb.y, l.x * bb.y + l.y * bb.x}; }
#pragma unroll
            for (int i = 0; i < 4; ++i) Cw[i] = CC[(dir * 16 + 4 * cb + i) * 64 + p];
#pragma unroll
            for (int i = 0; i < 4; ++i)
#pragma unroll
                for (int j = 0; j < 4; ++j) acc[i][j] += Cw[i].x * G[j].x - Cw[i].y * G[j].y; }
#pragma unroll
        for (int i = 0; i < 4; ++i)
#pragma unroll
            for (int j = 0; j < 4; ++j) MM[((dir * 32 + lag) * 16 + 4 * cb + i) * 16 + 4 * cpb + j] = acc[i][j]; }
    __syncthreads();
    if (c.tid < 128 && part == 0) { const int dir = c.tid >> 6, p = c.tid & 63; ((f32x2*)(c.ws + WS_LP))[(dir * 32 + g) * 64 + p] = LPOW[(dir * 33 + 32) * 64 + p]; }
    bf16* PMg = (bf16*)(c.ws + WS_PM) + (size_t)g * 256 * 512; bf16* BBg = (bf16*)(c.ws + WS_BB) + (size_t)g * 512 * 768;
    for (int task = part * 64 * 32 + c.tid; task < (part + 1) * 64 * 32; task += NTHREADS) { const int ip = task & 31, n = task >> 5, dir = n >> 7, im = (n >> 6) & 1, p = n & 63, e = dir ? ip : 31 - ip;
        const f32x2 l = LPOW[(dir * 33 + e) * 64 + p]; float o[16];
#pragma unroll
        for (int ch = 0; ch < 16; ++ch) { const f32x2 bb = BBAR[(dir * 64 + p) * 16 + ch]; o[ch] = im ? (l.x * bb.y + l.y * bb.x) : (l.x * bb.x - l.y * bb.y); }
        v4u w0, w1; w0.x = pk2(o[0], o[1]); w0.y = pk2(o[2], o[3]); w0.z = pk2(o[4], o[5]); w0.w = pk2(o[6], o[7]); w1.x = pk2(o[8], o[9]); w1.y = pk2(o[10], o[11]); w1.z = pk2(o[12], o[13]); w1.w = pk2(o[14], o[15]);
        *(v4u*)(PMg + (size_t)n * 512 + ip * 16) = w0; *(v4u*)(PMg + (size_t)n * 512 + ip * 16 + 8) = w1; }
    const float dskv = a.in[I_S5D][g * 16 + ((c.tid >> 5) & 15)];
    for (int task = part * 128 * 32 + c.tid; task < (part + 1) * 128 * 32; task += NTHREADS) { const int ip = task & 31, n = task >> 5, i = n >> 4, ch = n & 15; float o[16];
#pragma unroll
        for (int q = 0; q < 16; ++q) o[q] = 0.f;
        if (ip <= i) { const float* m0 = MM + ((0 * 32 + (i - ip)) * 16 + ch) * 16;
#pragma unroll
            for (int q = 0; q < 16; ++q) o[q] += m0[q]; }
        if (ip >= i) { const float* m1 = MM + ((1 * 32 + (ip - i)) * 16 + ch) * 16;
#pragma unroll
            for (int q = 0; q < 16; ++q) o[q] += m1[q]; }
        if (ip == i) { const float dsk = dskv;
#pragma unroll
            for (int q = 0; q < 16; ++q) o[q] += (q == ch) ? dsk : 0.f; }
        v4u w0, w1; w0.x = pk2(o[0], o[1]); w0.y = pk2(o[2], o[3]); w0.z = pk2(o[4], o[5]); w0.w = pk2(o[6], o[7]); w1.x = pk2(o[8], o[9]); w1.y = pk2(o[10], o[11]); w1.z = pk2(o[12], o[13]); w1.w = pk2(o[14], o[15]);
        *(v4u*)(BBg + (size_t)n * 768 + ip * 16) = w0; *(v4u*)(BBg + (size_t)n * 768 + ip * 16 + 8) = w1; }
    for (int task = part * 128 * 32 + c.tid; task < (part + 1) * 128 * 32; task += NTHREADS) { const int p8 = task & 7, part = (task >> 3) & 3, n = task >> 5, i = n >> 4, ch = n & 15, dir = part >> 1, im = part & 1, e = dir ? 32 - i : i + 1; float o[8];
#pragma unroll
        for (int q = 0; q < 8; ++q) { const int p = p8 * 8 + q; const f32x2 l = LPOW[(dir * 33 + e) * 64 + p], cc = CC[(dir * 16 + ch) * 64 + p]; o[q] = im ? -(cc.x * l.y + cc.y * l.x) : (cc.x * l.x - cc.y * l.y); }
        v4u w0; w0.x = pk2(o[0], o[1]); w0.y = pk2(o[2], o[3]); w0.z = pk2(o[4], o[5]); w0.w = pk2(o[6], o[7]);
        *(v4u*)(BBg + (size_t)n * 768 + 512 + part * 64 + p8 * 8) = w0; }
}
__device__ __forceinline__ void s5_state_scan(const Ctx& c, int task) {
    const int dir = task & 1, g = (task >> 1) & 31, b = task >> 6, p = c.lane;
    const f32x2 a = ((const f32x2*)(c.ws + WS_LP))[(dir * 32 + g) * 64 + p];
    const float* SS = (const float*)(c.ws + WS_SS) + (size_t)g * 768 * 256 + dir * 128 + p; bf16* U5 = (bf16*)(c.ws + WS_U5) + (size_t)g * 768 * 768 + 512 + dir * 128 + p;
    float er = 0.f, ei = 0.f;
#pragma unroll 1
    for (int s0 = 0; s0 < 72; s0 += 24) {
        float sr[24], si[24];
#pragma unroll
        for (int u = 0; u < 24; ++u) { const int step = s0 + u; const int R = (step < 8) ? 512 + b * 8 + (dir ? 7 - step : step) : b * 64 + (dir ? 71 - step : step - 8);
            sr[u] = SS[(size_t)R * 256]; si[u] = SS[(size_t)R * 256 + 64]; }
#pragma unroll
        for (int u = 0; u < 24; ++u) { const int step = s0 + u; const int R = (step < 8) ? 512 + b * 8 + (dir ? 7 - step : step) : b * 64 + (dir ? 71 - step : step - 8);
            if (step >= 8) { U5[(size_t)R * 768] = (bf16)f2bf(er); U5[(size_t)R * 768 + 64] = (bf16)f2bf(ei); }
            const float nr = sr[u] + a.x * er - a.y * ei, ni = si[u] + a.x * ei + a.y * er; er = nr; ei = ni; }
    }
}

constexpr int GDN_NCH = 36, GDN_ITEMS = NB * 4 * 2 * GDN_NCH;
constexpr size_t FR_T_BYTES = 8192, FR_ATT_BYTES = 8192, FR_KD_BYTES = 16384, FR_TAB_BYTES = 1024;
__device__ __forceinline__ int crow16(int i, int hh) { return (i & 3) + 8 * (i >> 2) + 4 * hh; }
__device__ __forceinline__ bf16x8 pack_step(const f32x16& x, int s) {
    v4u w; w.x = pk2(x[8 * s + 0], x[8 * s + 1]); w.y = pk2(x[8 * s + 2], x[8 * s + 3]); w.z = pk2(x[8 * s + 4], x[8 * s + 5]); w.w = pk2(x[8 * s + 6], x[8 * s + 7]);
    return __builtin_bit_cast(bf16x8, w);
}
__device__ __forceinline__ unsigned pk2v(float lo, float hi) { asm volatile("" : "+v"(lo), "+v"(hi)); return pk2(lo, hi); }
__device__ __forceinline__ bf16x8 pack_step_v(const f32x16& x, int s) {
    v4u w; w.x = pk2v(x[8 * s + 0], x[8 * s + 1]); w.y = pk2v(x[8 * s + 2], x[8 * s + 3]); w.z = pk2v(x[8 * s + 4], x[8 * s + 5]); w.w = pk2v(x[8 * s + 6], x[8 * s + 7]);
    return __builtin_bit_cast(bf16x8, w);
}
constexpr int GP_KR = 0, GP_QR = 17408, GP_KT = 34816, GP_TAB = 53248, GP_LP = 54272, GP_LPB = 8448 + 256;
__host__ __device__ constexpr int LOFF(int i) { return i < 1 ? 0 : 4 * (((i - 1) >> 2) + 1) * (2 * ((i - 1) >> 2) + ((i - 1) & 3)); }
static_assert(LOFF(1) == 0 && LOFF(2) == 4 && LOFF(5) == 16 && LOFF(6) == 24 && LOFF(64) == 2112, "packed lower-triangular row offsets");
struct GpPre { v4u q0, q1, k0, k1; float g, beta; };
__device__ __forceinline__ void gdn_prep_load(const Ctx& c, int item, GpPre& p) {
    const int n = item % GDN_NCH, bhd = item / GDN_NCH, dir = bhd & 1, h = (bhd >> 1) & 3, b = bhd >> 3;
    const bf16* QKV = (const bf16*)(c.ws + WS_QKV); const float* GB = (const float*)(c.ws + WS_GB);
    const int s = c.tid >> 3, seg = c.tid & 7; const bf16* rp = QKV + (size_t)scan_row(b, dir, n * 64 + s) * 1536 + h * 128 + seg * 16;
    p.q0 = *(const v4u*)rp; p.q1 = *(const v4u*)(rp + 8); p.k0 = *(const v4u*)(rp + 512); p.k1 = *(const v4u*)(rp + 520);
    const size_t rl = (size_t)scan_row(b, dir, n * 64 + c.lane) * 16 + dir * 4 + h; p.g = GB[rl]; p.beta = GB[rl + 8];
}
__device__ __forceinline__ void gdn_prep_stage(const Ctx& c, int item, int item_next, float* Lp, GpPre& p) {
    bf16* Kr = (bf16*)(c.lds + GP_KR); bf16* Qr = (bf16*)(c.lds + GP_QR); bf16* Kt = (bf16*)(c.lds + GP_KT); float* tab = (float*)(c.lds + GP_TAB);
    unsigned char* frA = c.ws + WS_FRA + (size_t)item * FR_ATT_BYTES; unsigned char* frK = c.ws + WS_FRK + (size_t)item * FR_KD_BYTES; float* frTab = (float*)(c.ws + WS_FRTAB + (size_t)item * FR_TAB_BYTES);
    const int r = c.lane & 31, hh = c.lane >> 5;
    if (c.wave == 0) { float g = p.g; const float beta = p.beta;
#pragma unroll
        for (int o = 1; o < 64; o <<= 1) { const float t = __shfl_up(g, o); if (c.lane >= o) g += t; }
        const float gl = __shfl(g, 63);
        tab[c.lane] = g; tab[64 + c.lane] = beta; tab[128 + c.lane] = __expf(g); tab[192 + c.lane] = __expf(gl - g); }
    { const int s = c.tid >> 3, seg = c.tid & 7;
      const v4u q0 = p.q0, q1 = p.q1, k0 = p.k0, k1 = p.k1;
      gdn_prep_load(c, item_next, p);
      *(v4u*)(Qr + s * 136 + seg * 16) = q0; *(v4u*)(Qr + s * 136 + seg * 16 + 8) = q1; *(v4u*)(Kr + s * 136 + seg * 16) = k0; *(v4u*)(Kr + s * 136 + seg * 16 + 8) = k1;
      const unsigned kw[8] = {k0.x, k0.y, k0.z, k0.w, k1.x, k1.y, k1.z, k1.w};
#pragma unroll
      for (int e = 0; e < 8; ++e) { Kt[(seg * 16 + 2 * e) * 72 + s] = (bf16)(kw[e] & 0xffffu); Kt[(seg * 16 + 2 * e + 1) * 72 + s] = (bf16)(kw[e] >> 16); } }
    __syncthreads();
    if (c.wave < 3) { const int ct = c.wave ? 1 : 0, st = c.wave == 2 ? 1 : 0;
        f32x16 acc;
#pragma unroll
        for (int i = 0; i < 16; ++i) acc[i] = 0.f;
#pragma unroll
        for (int kk = 0; kk < 8; ++kk) { const bf16x8 a = *(const bf16x8*)(Kr + (ct * 32 + r) * 136 + kk * 16 + hh * 8), bb = *(const bf16x8*)(Kr + (st * 32 + r) * 136 + kk * 16 + hh * 8); acc = MFMA32(a, bb, acc); }
        const int s = st * 32 + r; const float gcs = tab[s];
#pragma unroll
        for (int i = 0; i < 16; ++i) { const int cc = ct * 32 + crow16(i, hh); if (s < cc) Lp[LOFF(cc) + s] = tab[64 + cc] * acc[i] * __expf(tab[cc] - gcs); }
    } else if (c.wave < 6) { const int w = c.wave - 3, st = w == 2 ? 1 : 0, ct = w ? 1 : 0;
        f32x16 acc;
#pragma unroll
        for (int i = 0; i < 16; ++i) acc[i] = 0.f;
#pragma unroll
        for (int kk = 0; kk < 8; ++kk) { const bf16x8 a = *(const bf16x8*)(Kr + (st * 32 + r) * 136 + kk * 16 + hh * 8), bb = *(const bf16x8*)(Qr + (ct * 32 + r) * 136 + kk * 16 + hh * 8); acc = MFMA32(a, bb, acc); }
        const int cc = ct * 32 + r; const float gcc = tab[cc];
#pragma unroll
        for (int i = 0; i < 16; ++i) { const int s = st * 32 + crow16(i, hh); acc[i] = (s <= cc) ? acc[i] * __expf(gcc - tab[s]) : 0.f; }
        *(bf16x8*)(frA + ((size_t)((ct * 4 + 2 * st) * 64 + c.lane)) * 16) = pack_step(acc, 0);
        *(bf16x8*)(frA + ((size_t)((ct * 4 + 2 * st + 1) * 64 + c.lane)) * 16) = pack_step(acc, 1);
    } else { const int w = c.wave - 6;
#pragma unroll
        for (int f = 0; f < 8; ++f) { const int fi = w * 8 + f, dkt = fi >> 2, cb = fi & 3; const bf16* kp = Kt + (dkt * 32 + r) * 72 + 16 * cb + 4 * hh;
            const v2u lo = *(const v2u*)kp, hi = *(const v2u*)(kp + 8); const f32x4 e0 = *(const f32x4*)(tab + 192 + 16 * cb + 4 * hh), e1 = *(const f32x4*)(tab + 192 + 16 * cb + 8 + 4 * hh);
            v4u o; o.x = pk2(bflo(lo.x) * e0.x, bfhi(lo.x) * e0.y); o.y = pk2(bflo(lo.y) * e0.z, bfhi(lo.y) * e0.w); o.z = pk2(bflo(hi.x) * e1.x, bfhi(hi.x) * e1.y); o.w = pk2(bflo(hi.y) * e1.z, bfhi(hi.y) * e1.w);
            *(v4u*)(frK + ((size_t)(fi * 64 + c.lane)) * 16) = o; }
        if (w == 0) { const v4u z = (v4u){0u, 0u, 0u, 0u}; *(v4u*)(frA + ((size_t)((0 * 4 + 2) * 64 + c.lane)) * 16) = z; *(v4u*)(frA + ((size_t)((0 * 4 + 3) * 64 + c.lane)) * 16) = z; }
        else { *(f32x4*)(frTab + 4 * c.lane) = *(const f32x4*)(tab + 4 * c.lane); }
    }
    __syncthreads();
}
__device__ __forceinline__ int loff_rt(int i) { return i < 1 ? 0 : 4 * (((i - 1) >> 2) + 1) * (2 * ((i - 1) >> 2) + ((i - 1) & 3)); }
__device__ __forceinline__ void gdn_prep_solve(const Ctx& c, int item, float* Lp) {
    const int r = c.lane & 31, hh = c.lane >> 5;
    { float Tr[32];
#pragma unroll
      for (int i = 0; i < 32; ++i) { int je = r, bl = hh; asm volatile("" : "+v"(je), "+v"(bl)); float a0 = (je == i) ? 1.f : 0.f, a1 = 0.f;
          const int ro = bl ? LOFF(32 + i) + 32 : LOFF(i);
#pragma unroll
          for (int s4 = 0; s4 < (i + 3) / 4; ++s4) { const f32x4 l4 = *(const f32x4*)(Lp + ro + 4 * s4);
              if (4 * s4 + 0 < i) a0 = fmaf(-l4.x, Tr[4 * s4 + 0], a0); if (4 * s4 + 1 < i) a1 = fmaf(-l4.y, Tr[4 * s4 + 1], a1); if (4 * s4 + 2 < i) a0 = fmaf(-l4.z, Tr[4 * s4 + 2], a0); if (4 * s4 + 3 < i) a1 = fmaf(-l4.w, Tr[4 * s4 + 3], a1); }
          Tr[i] = a0 + a1; Lp[(je < i) ? ro + je : 2112 + 32 * bl + je] = Tr[i]; } }
    WAVE_LDS_SYNC();
    { const int offA = loff_rt(32 + r);
      f32x16 X;
#pragma unroll
      for (int i = 0; i < 16; ++i) X[i] = 0.f;
#pragma unroll
      for (int q = 0; q < 4; ++q) { const f32x4 a4 = *(const f32x4*)(Lp + offA + 16 * hh + 4 * q);
#pragma unroll
          for (int e = 0; e < 4; ++e) { const int kk = 4 * q + e; int hq = hh; asm volatile("" : "+v"(hq)); const int k = 16 * hq + kk;
              const float t = Lp[(hq ? LOFF(16 + kk) : LOFF(kk)) + r]; const float b = (r < k) ? t : (r == k ? 1.f : 0.f);
              X = __builtin_amdgcn_mfma_f32_32x32x2f32(a4[e], b, X, 0, 0, 0); } }
      f32x16 Y;
#pragma unroll
      for (int i = 0; i < 16; ++i) Y[i] = 0.f;
#pragma unroll
      for (int q = 0; q < 4; ++q) { const int k0 = 8 * q + 4 * hh; const f32x4 t4 = *(const f32x4*)(Lp + offA + 32 + k0);
#pragma unroll
          for (int e = 0; e < 4; ++e) { const int kq = k0 + e; const float av = (kq < r) ? t4[e] : (kq == r ? 1.f : 0.f);
              Y = __builtin_amdgcn_mfma_f32_32x32x2f32(av, X[4 * q + e], Y, 0, 0, 0); } }
#pragma unroll
      for (int i = 0; i < 16; ++i) { int hq = hh; asm volatile("" : "+v"(hq)); const int cb = (i & 3) + 8 * (i >> 2);
          Lp[(hq ? LOFF(32 + cb + 4) : LOFF(32 + cb)) + r] = -Y[i]; } }
    WAVE_LDS_SYNC();
    unsigned char* frT = c.ws + WS_FRT + (size_t)item * FR_T_BYTES;
#pragma unroll
    for (int f = 0; f < 8; ++f) { const int ct = f >> 2, sb = f & 3, cc = ct * 32 + r; float v[8];
#pragma unroll
        for (int q = 0; q < 2; ++q) { const int s0 = 16 * sb + 8 * q + 4 * hh;
            f32x4 t4 = (f32x4){0.f, 0.f, 0.f, 0.f}; if (s0 < cc) t4 = *(const f32x4*)(Lp + LOFF(cc) + s0);
            v[4 * q + 0] = (s0 + 0 < cc) ? t4.x : (s0 + 0 == cc ? 1.f : 0.f); v[4 * q + 1] = (s0 + 1 < cc) ? t4.y : (s0 + 1 == cc ? 1.f : 0.f);
            v[4 * q + 2] = (s0 + 2 < cc) ? t4.z : (s0 + 2 == cc ? 1.f : 0.f); v[4 * q + 3] = (s0 + 3 < cc) ? t4.w : (s0 + 3 == cc ? 1.f : 0.f); }
        *(v4u*)(frT + ((size_t)(f * 64 + c.lane)) * 16) = (v4u){pk2(v[0], v[1]), pk2(v[2], v[3]), pk2(v[4], v[5]), pk2(v[6], v[7])}; }
}
__device__ __forceinline__ void phase_gdn_prep(const Ctx& c) {
    const int nit = c.bid < GDN_ITEMS ? (GDN_ITEMS - 1 - c.bid) / c.G + 1 : 0;
    bool scanned = false;
    if (nit > 0) {
        GpPre p; gdn_prep_load(c, c.bid, p);
#pragma unroll 1
        for (int j = 0; j < nit; ++j) { const int item = c.bid + j * c.G, q = j & 7; int nx = item + c.G; nx = nx < GDN_ITEMS ? nx : item;
            gdn_prep_stage(c, item, nx, (float*)(c.lds + GP_LP + q * GP_LPB), p);
            if (q == 7 || j == nit - 1) { const int cnt = q + 1;
                if (c.wave < cnt) gdn_prep_solve(c, c.bid + ((j & ~7) + c.wave) * c.G, (float*)(c.lds + GP_LP + c.wave * GP_LPB));
                else if (j == nit - 1) { for (int t = c.bid + (c.wave - cnt) * c.G; t < 512; t += (8 - cnt) * c.G) s5_state_scan(c, t); }
                if (j == nit - 1 && cnt < 8) scanned = true;
                __syncthreads(); } }
    }
    if (!scanned) for (int t = c.bid + c.wave * c.G; t < 512; t += 8 * c.G) s5_state_scan(c, t);
}

constexpr int GR_K = 0, GR_Q = 16384, GR_T = 32768, GR_A = 40960, GR_KD = 49152, GR_TAB = 65536, GR_V = 66560, GR_BUF = 74752;
static_assert(2 * GR_BUF + 64 <= LDS_BYTES, "recurrence buffers");
__device__ __forceinline__ void gdn_rec_fetch(const Ctx& c, int bhd, int dvhalf, int n, v4u (&st)[19]) {
    const int dir = bhd & 1, h = (bhd >> 1) & 3, b = bhd >> 3, lw = c.wave - 4; const int item = bhd * GDN_NCH + n;
    int ln = c.lane; asm volatile("" : "+v"(ln));
    const unsigned char* QKVb = c.ws + WS_QKV;
#pragma unroll
    for (int q = 0; q < 4; ++q) { const int qi = lw + 4 * q;
        const int s = 4 * qi + (ln >> 4), ps = ln & 15, p = ps ^ (s & 15); const size_t rowb = (size_t)scan_row(b, dir, n * 64 + s) * 3072 + (size_t)h * 256 + p * 16;
        st[2 * q] = *(const v4u*)(QKVb + rowb + 1024); st[2 * q + 1] = *(const v4u*)(QKVb + rowb); }
    const unsigned char* frT = c.ws + WS_FRT + (size_t)item * FR_T_BYTES; const unsigned char* frA = c.ws + WS_FRA + (size_t)item * FR_ATT_BYTES; const unsigned char* frK = c.ws + WS_FRK + (size_t)item * FR_KD_BYTES;
#pragma unroll
    for (int q = 0; q < 2; ++q) { const int qi = lw + 4 * q; st[8 + 2 * q] = *(const v4u*)(frT + qi * 1024 + ln * 16); st[9 + 2 * q] = *(const v4u*)(frA + qi * 1024 + ln * 16); }
#pragma unroll
    for (int q = 0; q < 4; ++q) { const int qi = lw + 4 * q; st[12 + q] = *(const v4u*)(frK + qi * 1024 + ln * 16); }
    st[16] = *(const v4u*)(c.ws + WS_FRTAB + (size_t)item * FR_TAB_BYTES + ln * 16);
#pragma unroll
    for (int q = 0; q < 2; ++q) { const int qi = lw + 4 * q, s = 8 * qi + (ln >> 3);
        st[17 + q] = *(const v4u*)(QKVb + (size_t)scan_row(b, dir, n * 64 + s) * 3072 + 2048 + (size_t)h * 256 + dvhalf * 128 + (ln & 7) * 16); }
}
__device__ __forceinline__ void gdn_rec_put(const Ctx& c, int buf, const v4u (&st)[19]) {
    const int lw = c.wave - 4; unsigned char* base = c.lds + buf * GR_BUF + c.lane * 16;
#pragma unroll
    for (int q = 0; q < 4; ++q) { const int qi = lw + 4 * q; *(v4u*)(base + GR_K + qi * 1024) = st[2 * q]; *(v4u*)(base + GR_Q + qi * 1024) = st[2 * q + 1]; }
#pragma unroll
    for (int q = 0; q < 2; ++q) { const int qi = lw + 4 * q; *(v4u*)(base + GR_T + qi * 1024) = st[8 + 2 * q]; *(v4u*)(base + GR_A + qi * 1024) = st[9 + 2 * q]; }
#pragma unroll
    for (int q = 0; q < 4; ++q) { const int qi = lw + 4 * q; *(v4u*)(base + GR_KD + qi * 1024) = st[12 + q]; }
    if (lw == 0) *(v4u*)(base + GR_TAB) = st[16];
#pragma unroll
    for (int q = 0; q < 2; ++q) { const int qi = lw + 4 * q; *(v4u*)(base + GR_V + qi * 1024) = st[17 + q]; }
}
__device__ __forceinline__ bf16x8 gr_rowfrag(const unsigned char* rowp, const int (&po)[16], int kb) {
    const v2u lo = *(const v2u*)(rowp + po[2 * kb]), hi = *(const v2u*)(rowp + po[2 * kb + 1]);
    return __builtin_bit_cast(bf16x8, (v4u){lo.x, lo.y, hi.x, hi.y});
}
__device__ __forceinline__ void gdn_rec_block(const Ctx& c, int bhd, int dvhalf) {
    const int dir = bhd & 1, h = (bhd >> 1) & 3, b = bhd >> 3, r = c.lane & 31, hh = c.lane >> 5, dvt = 2 * dvhalf + (c.wave & 1);
    const bf16* QKV = (const bf16*)(c.ws + WS_QKV); bf16* OG = (bf16*)(c.ws + WS_OG) + (size_t)dir * ML * 512;
    f32x16 S[4];
#pragma unroll
    for (int t = 0; t < 4; ++t)
#pragma unroll
        for (int i = 0; i < 16; ++i) S[t][i] = 0.f;
    int po[16];
#pragma unroll
    for (int p = 0; p < 16; ++p) po[p] = r * 256 + ((p ^ (r & 15)) * 16) + 8 * hh;
#define GR_STEP_BARRIER() do { asm volatile("s_waitcnt lgkmcnt(0)" ::: "memory"); __builtin_amdgcn_s_barrier(); asm volatile("" ::: "memory"); } while (0)
    if (c.wave >= 4) {
        v4u st[19];
        gdn_rec_fetch(c, bhd, dvhalf, 0, st); gdn_rec_put(c, 0, st); gdn_rec_fetch(c, bhd, dvhalf, 1, st);
        GR_STEP_BARRIER();
#pragma unroll 1
        for (int n = 0; n < GDN_NCH; ++n) {
            if (n + 1 < GDN_NCH) gdn_rec_put(c, (n + 1) & 1, st);
            { const int nn = n + 2 < GDN_NCH ? n + 2 : GDN_NCH - 1; gdn_rec_fetch(c, bhd, dvhalf, nn, st); }
            GR_STEP_BARRIER(); }
    } else if (c.wave >= 2) {
        GR_STEP_BARRIER();
#pragma unroll 1
        for (int n = 0; n < GDN_NCH; ++n) GR_STEP_BARRIER();
    } else {
    GR_STEP_BARRIER();
#define GR_FENCE() asm volatile("" ::: "memory")
#define GR_LOADROW(F, AREA, T8) do { _Pragma("unroll") for (int kb = 0; kb < 8; ++kb) F[kb] = gr_rowfrag(base + (AREA) + (T8) * 8192, po, kb); } while (0)
#define GR_FRAG(AREA, IDX) (*(const bf16x8*)(base + (AREA) + ((IDX) * 64 + c.lane) * 16))
#define GR_LOADV(DST, ST) do { _Pragma("unroll") for (int i = 0; i < 16; ++i) DST[i] = vl[((ST) * 32 + (i & 3) + 8 * (i >> 2)) * 64]; } while (0)
    for (int n = 0; n < GDN_NCH; ++n) {
        const int buf = n & 1;
        {
            const unsigned char* base = c.lds + buf * GR_BUF; const float* tab = (const float*)(base + GR_TAB);
            const int row0 = scan_row(b, dir, n * 64), sgn = dir ? -1 : 1;
            const bf16* vl = (const bf16*)(base + GR_V) + (4 * hh) * 64 + (c.wave & 1) * 32 + r;
            const unsigned ob = (unsigned)(((row0 + sgn * 4 * hh) * 512 + h * 128 + dvt * 32 + r) * 2); const int ostb = sgn * 1024;
            bf16x8 fr[3][4], tf[6]; bf16 vv[16];
            bf16x8 Rf[2][2], Vf[2][2];
            unsigned oK0 = GR_K, oK1 = GR_K + 8192, oQ0 = GR_Q, oQ1 = GR_Q + 8192; asm volatile("" : "+v"(oK0), "+v"(oK1), "+v"(oQ0), "+v"(oQ1));
#define GR_LD4(SLOT, KB) do { fr[SLOT][0] = gr_rowfrag(base + oK0, po, KB); fr[SLOT][1] = gr_rowfrag(base + oK1, po, KB); fr[SLOT][2] = gr_rowfrag(base + oQ0, po, KB); fr[SLOT][3] = gr_rowfrag(base + oQ1, po, KB); } while (0)
            GR_LD4(0, 0); GR_LD4(1, 1); GR_FENCE();
            f32x16 acc0, acc1, aq0, aq1;
#pragma unroll
            for (int i = 0; i < 16; ++i) { acc0[i] = 0.f; acc1[i] = 0.f; aq0[i] = 0.f; aq1[i] = 0.f; }
#pragma unroll
            for (int kb = 0; kb < 8; ++kb) {
                if (kb + 2 < 8) GR_LD4((kb + 2) % 3, kb + 2);
                else if (kb == 6) { tf[0] = GR_FRAG(GR_T, 0); tf[1] = GR_FRAG(GR_T, 1); tf[2] = GR_FRAG(GR_T, 4); tf[3] = GR_FRAG(GR_T, 5); tf[4] = GR_FRAG(GR_T, 6); tf[5] = GR_FRAG(GR_T, 7); }
                GR_FENCE();
                const bf16x8 sp = pack_step(S[kb >> 1], kb & 1);
                acc0 = MFMA32(fr[kb % 3][0], sp, acc0); acc1 = MFMA32(fr[kb % 3][1], sp, acc1); aq0 = MFMA32(fr[kb % 3][2], sp, aq0); aq1 = MFMA32(fr[kb % 3][3], sp, aq1); }
            GR_LOADV(vv, 0); GR_FENCE();
#pragma unroll
            for (int i = 0; i < 16; ++i) { const int s = crow16(i, hh); acc0[i] = tab[64 + s] * (bf1(vv[i]) - tab[128 + s] * acc0[i]); }
            Rf[0][0] = pack_step(acc0, 0); Rf[0][1] = pack_step(acc0, 1);
            GR_LOADV(vv, 1); GR_FENCE();
#pragma unroll
            for (int i = 0; i < 16; ++i) { const int s = 32 + crow16(i, hh); acc1[i] = tab[64 + s] * (bf1(vv[i]) - tab[128 + s] * acc1[i]); }
            Rf[1][0] = pack_step(acc1, 0); Rf[1][1] = pack_step(acc1, 1);
#pragma unroll
            for (int i = 0; i < 16; ++i) { acc0[i] = 0.f; acc1[i] = 0.f; }
            acc1 = MFMA32(tf[2], Rf[0][0], acc1); acc0 = MFMA32(tf[0], Rf[0][0], acc0); acc1 = MFMA32(tf[3], Rf[0][1], acc1); acc0 = MFMA32(tf[1], Rf[0][1], acc0);
            acc1 = MFMA32(tf[4], Rf[1][0], acc1); acc1 = MFMA32(tf[5], Rf[1][1], acc1);
            tf[0] = GR_FRAG(GR_A, 0); tf[1] = GR_FRAG(GR_A, 1); tf[2] = GR_FRAG(GR_A, 4); tf[3] = GR_FRAG(GR_A, 5); tf[4] = GR_FRAG(GR_A, 6); tf[5] = GR_FRAG(GR_A, 7); GR_FENCE();
#pragma unroll
            for (int i = 0; i < 16; ++i) { aq0[i] *= tab[128 + crow16(i, hh)]; aq1[i] *= tab[128 + 32 + crow16(i, hh)]; }
            Vf[0][0] = pack_step(acc0, 0); Vf[0][1] = pack_step(acc0, 1); Vf[1][0] = pack_step(acc1, 0); Vf[1][1] = pack_step(acc1, 1);
            aq1 = MFMA32(tf[2], Vf[0][0], aq1); aq0 = MFMA32(tf[0], Vf[0][0], aq0); aq1 = MFMA32(tf[3], Vf[0][1], aq1); aq0 = MFMA32(tf[1], Vf[0][1], aq0);
            aq1 = MFMA32(tf[4], Vf[1][0], aq1); aq1 = MFMA32(tf[5], Vf[1][1], aq1);
            if (n >= 4) {
#pragma unroll
                for (int i = 0; i < 16; i += 2) { const unsigned p0 = pk2(aq0[i], aq0[i + 1]), p1 = pk2(aq1[i], aq1[i + 1]); const int k0 = (i & 3) + 8 * (i >> 2);
                    unsigned char* ogb = (unsigned char*)OG;
                    *(bf16*)(ogb + (unsigned)(ob + (unsigned)(ostb * k0))) = (bf16)(p0 & 0xffffu); *(bf16*)(ogb + (unsigned)(ob + (unsigned)(ostb * (k0 + 1)))) = (bf16)(p0 >> 16);
                    *(bf16*)(ogb + (unsigned)(ob + (unsigned)(ostb * (32 + k0)))) = (bf16)(p1 & 0xffffu); *(bf16*)(ogb + (unsigned)(ob + (unsigned)(ostb * (33 + k0)))) = (bf16)(p1 >> 16); } }
            bf16x8 kd[16];
#pragma unroll
            for (int q = 0; q < 16; ++q) kd[q] = GR_FRAG(GR_KD, q);
            GR_FENCE();
            const float gtot = tab[128 + 63];
#pragma unroll
            for (int t = 0; t < 4; ++t) {
#pragma unroll
                for (int i = 0; i < 16; ++i) S[t][i] *= gtot; }
#pragma unroll
            for (int cb = 0; cb < 4; ++cb) {
#pragma unroll
                for (int t = 0; t < 4; ++t) S[t] = MFMA32(kd[t * 4 + cb], Vf[cb >> 1][cb & 1], S[t]); }
#undef GR_LD4
        }
        GR_STEP_BARRIER();
    }
    }
    asm volatile("s_waitcnt vmcnt(0)" ::: "memory"); __syncthreads();
#undef GR_STEP_BARRIER
#undef GR_FENCE
#undef GR_LOADROW
#undef GR_FRAG
#undef GR_LOADV
}
__device__ __forceinline__ void phase_gdn_rec(const Ctx& c) { if (c.bid < 128) gdn_rec_block(c, c.bid >> 1, c.bid & 1); }

#define XB_TMO      128
#define XB_XCNT(j)  (256  + 64 * (j))
#define XB_XSUB(j)  (1280 + 64 * (j))
#define XB_XGEN(j)  (2304 + 64 * (j))
#define XB_TOP      3328
#define XB_TOPGEN   3392
#define XCD_BAR_WORDS 3456
#define XB_SPIN_CAP (1u << 20)
__device__ __forceinline__ unsigned xb_ld(unsigned* p)              { return __hip_atomic_load(p, __ATOMIC_RELAXED, __HIP_MEMORY_SCOPE_AGENT); }
__device__ __forceinline__ unsigned xb_add(unsigned* p, unsigned v) { return __hip_atomic_fetch_add(p, v, __ATOMIC_RELAXED, __HIP_MEMORY_SCOPE_AGENT); }
__device__ __forceinline__ unsigned xb_xcc_id() { return (unsigned)__builtin_amdgcn_s_getreg((3 << 11) | 20) & 0xFu; }
#define XB_SPIN(cond, bar) do { unsigned _sp = 0; while (cond) { __builtin_amdgcn_s_sleep(1); \
    if ((++_sp & 255u) == 0u) { if (xb_ld(&(bar)[XB_TMO])) break; if (_sp > XB_SPIN_CAP) { atomicAdd(&(bar)[XB_TMO], 1u); break; } } } } while (0)
struct XcdBarrier { unsigned* bar; unsigned x; volatile LAS unsigned* st; };
__device__ __forceinline__ XcdBarrier xcd_barrier_post(unsigned* bar, volatile LAS unsigned* st) {
    XcdBarrier b; b.bar = bar; b.x = xb_xcc_id(); b.st = st;
    if (threadIdx.x == 0) (void)xb_add(&bar[XB_XCNT(b.x)], 1u);
    return b;
}
__device__ __forceinline__ void xcd_barrier_complete(unsigned* bar, unsigned x, unsigned& nloc, unsigned& nx) {
    const unsigned G = gridDim.x * gridDim.y * gridDim.z;
    unsigned sum, cnt, mine, sp = 0u;
    for (;;) {
        sum = 0u; cnt = 0u; mine = 0u;
#pragma unroll
        for (unsigned j = 0; j < 16; ++j) { const unsigned c = xb_ld(&bar[XB_XCNT(j)]); sum += c; cnt += (c > 0u) ? 1u : 0u; mine = (j == x) ? c : mine; }
        if (sum == G) break;
        __builtin_amdgcn_s_sleep(1);
        if ((++sp & 255u) == 0u) { if (xb_ld(&bar[XB_TMO])) break; if (sp > XB_SPIN_CAP) { atomicAdd(&bar[XB_TMO], 1u); break; } }
    }
    nloc = mine > 0u ? mine : 1u; nx = cnt > 0u ? cnt : 1u;
}
__device__ __forceinline__ void xcd_barrier(const XcdBarrier& b) {
    asm volatile("s_waitcnt vmcnt(0)" ::: "memory");
    __syncthreads();
    if (threadIdx.x == 0) {
        unsigned* bar = b.bar;
        __builtin_amdgcn_s_waitcnt(0);
        unsigned nloc = b.st[0], nx = b.st[1];
        if (nloc == 0u) { xcd_barrier_complete(bar, b.x, nloc, nx); b.st[0] = nloc; b.st[1] = nx; }
        const unsigned old = xb_add(&bar[XB_XSUB(b.x)], 1u);
        const unsigned gen = old / nloc;
        if (old + 1u == (gen + 1u) * nloc) {
            __builtin_amdgcn_fence(__ATOMIC_RELEASE, "agent");
            asm volatile("s_waitcnt vmcnt(0)" ::: "memory");
            const unsigned og = xb_add(&bar[XB_TOP], 1u);
            const unsigned tg = og / nx;
            if (og + 1u == (tg + 1u) * nx) xb_add(&bar[XB_TOPGEN], 1u);
            else XB_SPIN(xb_ld(&bar[XB_TOPGEN]) == tg, bar);
            __builtin_amdgcn_fence(__ATOMIC_ACQUIRE, "agent");
            xb_add(&bar[XB_XGEN(b.x)], 1u);
            asm volatile("s_waitcnt vmcnt(0)" ::: "memory");
        } else {
            XB_SPIN(xb_ld(&bar[XB_XGEN(b.x)]) == gen, bar);
            __builtin_amdgcn_fence(__ATOMIC_ACQUIRE, "agent");
            asm volatile("s_waitcnt vmcnt(0)" ::: "memory");
        }
    }
    __syncthreads();
}

constexpr int LDS_MISC = LDS_BYTES - 64;
__global__ void __launch_bounds__(NTHREADS, 2) mk_fwd(Args args) {
    extern __shared__ __attribute__((aligned(16))) unsigned char lds[];
    Ctx c; c.a = &args; c.ws = args.ws; c.lds = lds;
    c.tid = threadIdx.x; c.lane = c.tid & 63; c.wave = __builtin_amdgcn_readfirstlane(c.tid >> 6); c.bid = blockIdx.x; c.G = gridDim.x;
    c.gw = c.bid * NWAVES + c.wave; c.NGW = c.G * NWAVES; c.gwv = c.wave * c.G + c.bid;
    const int lo = args.ph_lo, hi = args.ph_hi;
    PG8_LAS unsigned char* ring = (PG8_LAS unsigned char*)lds;
#ifndef MK_PH_MASK
#define MK_PH_MASK 0xffff
#endif
#define IN(k) (((MK_PH_MASK >> (k)) & 1) && lo <= (k) && (k) < hi)
#if MK_ONE_LAUNCH
    cg::grid_group grid = cg::this_grid();
    if (lo < 0) grid.sync();
    volatile LAS unsigned* st = (volatile LAS unsigned*)((LAS unsigned char*)lds + LDS_MISC);
    if (c.tid < 2) st[c.tid] = 0u;
    __syncthreads();
    const XcdBarrier bar = xcd_barrier_post((unsigned*)(c.ws + WS_CTL) + CW_BAR, st);
#define SEAM(k) do { if (IN(k) && IN((k) + 1)) xcd_barrier(bar); } while (0)
#else
#define SEAM(k) do { } while (0)
#endif
    if (IN(0)) { phase_prep(c); phase_s5_build(c); } SEAM(0);
    if (IN(1)) { phase_norm1(c); } SEAM(1);
    if (IN(2)) { pg8::Gemm g{(const pg8::bf16_t*)(c.ws + WS_HX), (const pg8::bf16_t*)(c.ws + WS_WIN), 1024, 1024, 1024}; pg8::StaticOrder S; S.init(MT, NPROJ, c.G, c.bid);
        pg8::EpiInProj E{(pg8::bf16_t*)(c.ws + WS_U5), (pg8::bf16_t*)(c.ws + WS_QKVPRE), (pg8::bf16_t*)(c.ws + WS_Z)};
        pg8::gemm_phase<pg8::EpiInProj, pg8::StaticOrder, true, true>(ring, g, S, E); } SEAM(2);
    if (IN(3)) { { pg8::Gemm g{(const pg8::bf16_t*)(c.ws + WS_U5), (const pg8::bf16_t*)(c.ws + WS_PM), 768, 512, 512}; pg8::SchedSS S{c.G, c.bid}; pg8::EpiSS E{(float*)(c.ws + WS_SS)};
          pg8::gemm_phase<pg8::EpiSS, pg8::SchedSS, true, true>(ring, g, S, E); }
        __syncthreads(); phase_conv(c); } SEAM(3);
    if (IN(4)) { phase_gdn_prep(c); } SEAM(4);
    if (IN(5)) { pg8::Gemm g{(const pg8::bf16_t*)(c.ws + WS_U5), (const pg8::bf16_t*)(c.ws + WS_BB), 768, 768, 768}; pg8::SchedS5Y S{c.G, c.bid}; pg8::EpiS5Y E{(pg8::bf16_t*)(c.ws + WS_YG)};
        pg8::gemm_phase<pg8::EpiS5Y, pg8::SchedS5Y, true, true>(ring, g, S, E); } SEAM(5);
    if (IN(6)) { if (c.bid < 128) phase_gdn_rec(c);
        else { pg8::Gemm g{(const pg8::bf16_t*)(c.ws + WS_YG), (const pg8::bf16_t*)(c.ws + WS_WGLU), 512, 512, 512}; pg8::StaticOrder S; S.init(ML, 512, c.G - 128, c.bid - 128);
            pg8::EpiGlu E{(const pg8::bf16_t*)(c.ws + WS_YG), (pg8::bf16_t*)(c.ws + WS_CAT)};
            pg8::gemm_phase<pg8::EpiGlu, pg8::StaticOrder, true, true>(ring, g, S, E); } } SEAM(6);
    if (IN(7)) { phase_combine(c); } SEAM(7);
    if (IN(8)) { pg8::Gemm g{(const pg8::bf16_t*)(c.ws + WS_CAT), (const pg8::bf16_t*)(c.ws + WS_WOUT), 1024, 1024, 1024}; pg8::StaticOrder S; S.init(ML, 1024, c.G, c.bid);
        pg8::EpiBf16<0> E{(pg8::bf16_t*)(c.ws + WS_YRAW), 1024, nullptr, 0, 0, 1.f};
        pg8::gemm_phase<pg8::EpiBf16<0>, pg8::StaticOrder, true, true>(ring, g, S, E); } SEAM(8);
    if (IN(9)) { phase_rows2(c); phase_fp8_tables(c); } SEAM(9);
    if (IN(10)) { pg8::Gemm g{(const pg8::bf16_t*)(c.ws + WS_HX2), (const pg8::bf16_t*)(c.ws + WS_WQ), 1024, 1024, 1024}; pg8::StaticOrder S; S.init(ML, 2048, c.G, c.bid);
        pg8::EpiBf16<0> E{(pg8::bf16_t*)(c.ws + WS_QP), 2048, nullptr, 0, 0, 1.f};
        pg8::gemm_phase<pg8::EpiBf16<0>, pg8::StaticOrder, true, true>(ring, g, S, E); } SEAM(10);
    if (IN(11)) { phase_topk(c); } SEAM(11);
    if (IN(12)) { phase_exp1(c); } SEAM(12);
    if (IN(13)) { phase_exp1b(c); } SEAM(13);
    if (IN(14)) { phase_exp2(c); } SEAM(14);
    if (IN(15)) { phase_exp3(c); }
#undef IN
#undef SEAM
}

extern "C" void kernel_launch(void* const* d_in, const int* in_sizes, int n_in, void* d_out, int out_size, void* d_ws, size_t ws_size, hipStream_t stream) {
    static int grid = 0;
    if (grid == 0) {
        if (n_in != 29 || out_size != ML * D || ws_size < WS_END) { fprintf(stderr, "kernel_launch: unexpected shapes (n_in %d out %d ws %zu)\n", n_in, out_size, ws_size); grid = -1; return; }
        int dev = 0, cus = 0, per_cu = 0;
        (void)hipGetDevice(&dev); (void)hipDeviceGetAttribute(&cus, hipDeviceAttributeMultiprocessorCount, dev);
        if (hipFuncSetAttribute((const void*)mk_fwd, hipFuncAttributeMaxDynamicSharedMemorySize, LDS_BYTES) != hipSuccess) { fprintf(stderr, "kernel_launch: hipFuncSetAttribute failed\n"); grid = -1; return; }
        (void)hipOccupancyMaxActiveBlocksPerMultiprocessor(&per_cu, (const void*)mk_fwd, NTHREADS, LDS_BYTES);
        (void)hipGetLastError();
        grid = cus;
        fprintf(stderr, "kernel_launch: cus %d per_cu %d grid %d\n", cus, per_cu, grid);
    }
    if (grid < 0) return;
    Args a{};
    for (int i = 0; i < 29; ++i) a.in[i] = (const float*)d_in[i];
    a.out = (float*)d_out; a.ws = (unsigned char*)d_ws;
    (void)hipMemsetAsync((char*)d_ws + WS_CTL, 0, CTL_ZERO_BYTES, stream);
#if MK_ONE_LAUNCH
    a.ph_lo = 0; a.ph_hi = NPHASES;
    void* kargs[] = {&a};
    hipError_t e = hipLaunchCooperativeKernel((const void*)mk_fwd, dim3(grid), dim3(NTHREADS), kargs, LDS_BYTES, stream);
    if (e != hipSuccess) fprintf(stderr, "kernel_launch: cooperative launch failed: %s\n", hipGetErrorString(e));
#else
    for (int ph = 0; ph < NPHASES; ++ph) { a.ph_lo = ph; a.ph_hi = ph + 1; hipLaunchKernelGGL(mk_fwd, dim3(grid), dim3(NTHREADS), LDS_BYTES, stream, a); }
#endif
}
```

```cpp
#include <hip/hip_runtime.h>
#include <hip/hip_cooperative_groups.h>
#include <cstdio>
#include <cstdint>
namespace cg = cooperative_groups;
namespace pg8 {
#define PG8_LAS __attribute__((address_space(3)))
typedef unsigned short bf16_t;
typedef short bf16x8 __attribute__((ext_vector_type(8)));
typedef float f32x4 __attribute__((ext_vector_type(4)));
typedef unsigned u32x4 __attribute__((ext_vector_type(4)));
constexpr int BM = 256, BK = 64, HALF = 128, HTB = HALF * BK * 2  , STAGE_BYTES = 8 * HTB, NXCD = 8, WGM = 8;

__host__ __device__ __forceinline__ int lds_byte(int r, int c) { const int st = (r >> 4) * 2 + (c >> 5), rr = r & 15, cc = c & 31, ob = rr * 64 + cc * 2; return st * 1024 + (ob ^ (((ob >> 9) & 1) << 5)); }
__host__ __device__ __forceinline__ void stage_rc(int b, int& R, int& C) { const int st = b / 1024, sb = b % 1024, swz = sb ^ (((sb >> 9) & 1) << 5); R = (st >> 1) * 16 + swz / 64; C = (st & 1) * 32 + (swz % 64) / 2; }
__host__ __device__ __forceinline__ int perm32(int rho) { const int n = rho >> 4, i = rho & 15; return 8 * (i >> 2) + 4 * n + (i & 3); }

struct Unit { int pm, pn; };
struct Gemm { const bf16_t* A; const bf16_t* Bt; int lda, ldb, K; };

struct StaticOrder {
    int nM, nN, nwg, G, c;
    __host__ __device__ void init(int M, int N, int G_, int c_) { nM = M / BM; nN = N / BM; nwg = nM * nN; G = G_; c = c_; }
    __host__ __device__ bool next(int i, Unit& u) const {
        const long L = (long)i * G + c; if (L >= nwg) return false;
        int wgid = (int)L; { const int q = nwg / NXCD, r = nwg % NXCD, xcd = wgid % NXCD, off = wgid / NXCD; wgid = (xcd < r ? xcd * (q + 1) : r * (q + 1) + (xcd - r) * q) + off; }
        const int nig = WGM * nN, gid = wgid / nig, fm = gid * WGM, gsz = (nM - fm) < WGM ? (nM - fm) : WGM;
        u.pm = fm + ((wgid % nig) % gsz); u.pn = (wgid % nig) / gsz; return true;
    }
    __device__ __forceinline__ void a_ready(const Unit&) const {}
    __device__ __forceinline__ void done(const Unit&) const {}
};

__device__ __forceinline__ unsigned cvt_pk_bf16(float lo, float hi) { unsigned r; asm volatile("v_cvt_pk_bf16_f32 %0, %1, %2" : "=v"(r) : "v"(lo), "v"(hi)); return r; }
typedef float f32x2 __attribute__((ext_vector_type(2)));
__device__ __forceinline__ f32x2 gelu_pk(f32x2 v) {
    const f32x2 av = __builtin_elementwise_abs(v), d = av * 0.2316418882f + 1.0f;
    f32x2 t; t.x = __builtin_amdgcn_rcpf(d.x); t.y = __builtin_amdgcn_rcpf(d.y);
    f32x2 q = t * 0.5307027145f + (-0.7265760135f); q = q * t + 0.7107068705f; q = q * t + (-0.142248368f); q = q * t + 0.127414796f; q = q * t;
    const f32x2 s = (v * v) * (-0.72134752044f);
    f32x2 e; e.x = __builtin_amdgcn_exp2f(s.x); e.y = __builtin_amdgcn_exp2f(s.y);
    const f32x2 m = v * (q * e), r = v - m;
    f32x2 o; o.x = v.x < 0.f ? m.x : r.x; o.y = v.y < 0.f ? m.y : r.y; return o;
}

template <int ACT  > struct EpiBf16 {
    static constexpr bool PERM = true, AFTER_DRAIN = false; static_assert(ACT == 0 || ACT == 1, "EpiBf16: ACT is 0 (none) or 1 (gelu_pk)");
    bf16_t* O; int ldc; const float* bias; int split_cols; size_t split_stride; float scale0;
    __device__ __forceinline__ void operator()(const f32x4 (&acc)[2][2][4][2], const Unit& u, int wr, int wc, int fr, int fq) const {
        const int row0 = u.pm * BM + wr * 64 + fr; int colt = u.pn * BM; bf16_t* base = O;
        float sc = 1.f; if (split_cols) { const int t = colt / split_cols; base += (size_t)t * split_stride; colt -= t * split_cols; if (t == 0) sc = scale0; }
        const int col0 = colt + wc * 32 + 8 * fq, bcol0 = u.pn * BM + wc * 32 + 8 * fq;
        f32x4 bv[2][2];
#pragma unroll
        for (int bj = 0; bj < 2; ++bj)
#pragma unroll
            for (int n = 0; n < 2; ++n) bv[bj][n] = bias ? *(const f32x4*)(bias + bcol0 + bj * HALF + 4 * n) : (f32x4){0.f, 0.f, 0.f, 0.f};
#pragma unroll
        for (int ai = 0; ai < 2; ++ai)
#pragma unroll
            for (int m = 0; m < 4; ++m) { bf16_t* rowp = base + (size_t)(row0 + ai * HALF + m * 16) * ldc + col0;
#pragma unroll
                for (int bj = 0; bj < 2; ++bj) { f32x4 v0 = acc[ai][bj][m][0] + bv[bj][0], v1 = acc[ai][bj][m][1] + bv[bj][1];
                    if (ACT == 1) { f32x2 a = gelu_pk((f32x2){v0[0], v0[1]}), b = gelu_pk((f32x2){v0[2], v0[3]}), c = gelu_pk((f32x2){v1[0], v1[1]}), d = gelu_pk((f32x2){v1[2], v1[3]});
                        v0 = (f32x4){a.x, a.y, b.x, b.y}; v1 = (f32x4){c.x, c.y, d.x, d.y}; }
                    v0 = v0 * sc; v1 = v1 * sc; u32x4 w; w.x = cvt_pk_bf16(v0[0], v0[1]); w.y = cvt_pk_bf16(v0[2], v0[3]); w.z = cvt_pk_bf16(v1[0], v1[1]); w.w = cvt_pk_bf16(v1[2], v1[3]);
                    *(u32x4*)(rowp + bj * HALF) = w; } }
    }
};

template <class Epi, class Sched, bool ALIGN_EPI = false, bool SP2 = false>
__device__ __forceinline__ void gemm_phase(PG8_LAS unsigned char* lds, const Gemm g, const Sched& S, const Epi& E) {
    const int tid = threadIdx.x, wid = __builtin_amdgcn_readfirstlane(tid >> 6), lane = tid & 63, wr = wid >> 2, wc = wid & 3, fr = lane & 15, fq = lane >> 4;
    const int K = g.K, nt = K / BK;
    unsigned voffA[2], voffB[2];
#pragma unroll
    for (int i = 0; i < 2; ++i) { int R, C; stage_rc(tid * 16 + i * 8192, R, C); const int Rb = Epi::PERM ? ((R & ~31) + perm32(R & 31)) : R;
        voffA[i] = (unsigned)(R * g.lda + C) * 2u; voffB[i] = (unsigned)(Rb * g.ldb + C) * 2u; }
    const size_t kstep = (size_t)(BK * 2);
    const size_t hstepA = (size_t)HALF * g.lda * 2, hstepB = (size_t)HALF * g.ldb * 2;
    const size_t tstepA = 2 * hstepA, tstepB = 2 * hstepB;
    const unsigned ldsw = (unsigned)wid * 1024u;
    const int aoff = lds_byte(wr * 64 + fr, fq * 8), boff = lds_byte(wc * 32 + fr, fq * 8);
#define PG8_SA(b, h) (((b) * 2 + (h)) * HTB)
#define PG8_SB(b, h) ((4 + (b) * 2 + (h)) * HTB)
#define PG8_STAGE(bufoff, gbase, voff) do { _Pragma("unroll") for (int _i = 0; _i < 2; ++_i) \
        __builtin_amdgcn_global_load_lds((const unsigned*)((const char*)(gbase) + (voff)[_i]), (PG8_LAS unsigned*)(lds + (bufoff) + ldsw + _i * 8192), 16, 0, 0); } while (0)
#define PG8_LDA(dst, b, h) do { _Pragma("unroll") for (int m = 0; m < 4; ++m) _Pragma("unroll") for (int k = 0; k < 2; ++k) dst[m][k] = *(const PG8_LAS bf16x8*)(lds + PG8_SA(b, h) + aoff + m * 2048 + k * 1024); } while (0)
#define PG8_LDB(dst, b, h) do { _Pragma("unroll") for (int n = 0; n < 2; ++n) _Pragma("unroll") for (int k = 0; k < 2; ++k) dst[n][k] = *(const PG8_LAS bf16x8*)(lds + PG8_SB(b, h) + boff + n * 2048 + k * 1024); } while (0)
#define PG8_MMA(ai, bj, At, Bt) do { __builtin_amdgcn_s_setprio(1); _Pragma("unroll") for (int m = 0; m < 4; ++m) _Pragma("unroll") for (int n = 0; n < 2; ++n) _Pragma("unroll") for (int k = 0; k < 2; ++k) \
        acc[ai][bj][m][n] = __builtin_amdgcn_mfma_f32_16x16x32_bf16(Bt[n][k], At[m][k], acc[ai][bj][m][n], 0, 0, 0); __builtin_amdgcn_s_setprio(0); } while (0)
#define PG8_WAIT_V(n) asm volatile("s_waitcnt vmcnt(" #n ")" ::: "memory")
#define PG8_WAIT_L(n) asm volatile("s_waitcnt lgkmcnt(" #n ")" ::: "memory")
#define PG8_BAR __builtin_amdgcn_s_barrier()
#define PG8_SCHED __builtin_amdgcn_sched_barrier(0)
    Unit cur, nxt; int ui = 0;
    if (!S.next(0, cur)) return;
    f32x4 acc[2][2][4][2];
#pragma unroll
    for (int a = 0; a < 2; ++a)
#pragma unroll
        for (int b = 0; b < 2; ++b)
#pragma unroll
            for (int m = 0; m < 4; ++m)
#pragma unroll
                for (int n = 0; n < 2; ++n) acc[a][b][m][n] = (f32x4){0.f, 0.f, 0.f, 0.f};
    bf16x8 At[4][2], B0[2][2], B1[2][2];
    const char* cA = (const char*)g.A + (size_t)cur.pm * tstepA; const char* cB = (const char*)g.Bt + (size_t)cur.pn * tstepB;
    S.a_ready(cur);
    if constexpr (SP2) {
        PG8_STAGE(PG8_SB(0, 0), cB, voffB); PG8_STAGE(PG8_SB(0, 1), cB + hstepB, voffB); PG8_STAGE(PG8_SA(0, 0), cA, voffA); PG8_STAGE(PG8_SA(0, 1), cA + hstepA, voffA);
        if (wr == 1) PG8_BAR;
        PG8_WAIT_V(2); PG8_BAR;
        PG8_STAGE(PG8_SB(1, 0), cB + kstep, voffB); PG8_STAGE(PG8_SA(1, 0), cA + kstep, voffA); PG8_STAGE(PG8_SB(1, 1), cB + hstepB + kstep, voffB);
        PG8_WAIT_V(6); PG8_BAR;
    } else {
        PG8_STAGE(PG8_SB(0, 0), cB, voffB); PG8_STAGE(PG8_SA(0, 0), cA, voffA); PG8_STAGE(PG8_SB(0, 1), cB + hstepB, voffB); PG8_STAGE(PG8_SA(0, 1), cA + hstepA, voffA);
        if (wr == 1) PG8_BAR;
        PG8_WAIT_V(4); PG8_BAR;
        PG8_STAGE(PG8_SB(1, 0), cB + kstep, voffB); PG8_STAGE(PG8_SA(1, 0), cA + kstep, voffA); PG8_STAGE(PG8_SB(1, 1), cB + hstepB + kstep, voffB);
        PG8_WAIT_V(6); PG8_BAR;
    }
    for (;;) {
        const bool has_next = S.next(ui + 1, nxt);
        const char* nA = has_next ? (const char*)g.A + (size_t)nxt.pm * tstepA : cA; const char* nB = has_next ? (const char*)g.Bt + (size_t)nxt.pn * tstepB : cB;
        for (int t = 0; t < nt; t += 2) {
            const bool last = (t == nt - 2);
            const char* a1 = cA + (size_t)(t + 1) * kstep;
            const char* a2 = last ? nA : cA + (size_t)(t + 2) * kstep; const char* b2 = last ? nB : cB + (size_t)(t + 2) * kstep;
            const char* a3 = a2 + kstep; const char* b3 = b2 + kstep;
            if (last && has_next) S.a_ready(nxt);
            if constexpr (SP2) {
            PG8_LDB(B0, 0, 0); PG8_LDB(B1, 0, 1); PG8_SCHED; PG8_LDA(At, 0, 0); PG8_STAGE(PG8_SA(1, 1), a1 + hstepA, voffA);
            PG8_WAIT_V(8); PG8_WAIT_L(0); PG8_BAR; PG8_MMA(0, 0, At, B0); PG8_MMA(0, 1, At, B1); PG8_BAR; PG8_SCHED;
            PG8_LDA(At, 0, 1); PG8_STAGE(PG8_SB(0, 0), b2, voffB); PG8_STAGE(PG8_SB(0, 1), b2 + hstepB, voffB); PG8_STAGE(PG8_SA(0, 0), a2, voffA);
            PG8_WAIT_V(8); PG8_WAIT_L(0); PG8_BAR; PG8_MMA(1, 0, At, B0); PG8_MMA(1, 1, At, B1); PG8_BAR; PG8_SCHED;
            PG8_LDB(B0, 1, 0); PG8_LDB(B1, 1, 1); PG8_SCHED; PG8_LDA(At, 1, 0); PG8_STAGE(PG8_SA(0, 1), a2 + hstepA, voffA);
            PG8_WAIT_V(8); PG8_WAIT_L(0); PG8_BAR; PG8_MMA(0, 0, At, B0); PG8_MMA(0, 1, At, B1); PG8_BAR; PG8_SCHED;
            PG8_LDA(At, 1, 1); PG8_STAGE(PG8_SB(1, 0), b3, voffB); PG8_STAGE(PG8_SB(1, 1), b3 + hstepB, voffB); PG8_STAGE(PG8_SA(1, 0), a3, voffA);
            PG8_WAIT_V(8); PG8_WAIT_L(0); PG8_BAR; PG8_MMA(1, 0, At, B0); PG8_MMA(1, 1, At, B1); PG8_BAR; PG8_SCHED;
            } else {
            PG8_LDB(B0, 0, 0); PG8_SCHED; PG8_LDA(At, 0, 0); PG8_STAGE(PG8_SA(1, 1), a1 + hstepA, voffA);
            PG8_WAIT_L(8); PG8_BAR; PG8_WAIT_L(0); PG8_MMA(0, 0, At, B0); PG8_BAR; PG8_SCHED;
            PG8_LDB(B1, 0, 1); PG8_STAGE(PG8_SB(0, 0), b2, voffB);
            PG8_BAR; PG8_WAIT_L(0); PG8_MMA(0, 1, At, B1); PG8_BAR;
            PG8_LDA(At, 0, 1); PG8_STAGE(PG8_SA(0, 0), a2, voffA);
            PG8_BAR; PG8_WAIT_L(0); PG8_MMA(1, 0, At, B0); PG8_BAR; PG8_SCHED;
            PG8_STAGE(PG8_SB(0, 1), b2 + hstepB, voffB);
            PG8_WAIT_V(6); PG8_BAR; PG8_MMA(1, 1, At, B1); PG8_BAR;
            PG8_LDB(B0, 1, 0); PG8_SCHED; PG8_LDA(At, 1, 0); PG8_STAGE(PG8_SA(0, 1), a2 + hstepA, voffA);
            PG8_WAIT_L(8); PG8_BAR; PG8_WAIT_L(0); PG8_MMA(0, 0, At, B0); PG8_BAR; PG8_SCHED;
            PG8_LDB(B1, 1, 1); PG8_STAGE(PG8_SB(1, 0), b3, voffB);
            PG8_BAR; PG8_WAIT_L(0); PG8_MMA(0, 1, At, B1); PG8_BAR;
            PG8_LDA(At, 1, 1); PG8_STAGE(PG8_SA(1, 0), a3, voffA);
            PG8_BAR; PG8_WAIT_L(0); PG8_MMA(1, 0, At, B0); PG8_BAR; PG8_SCHED;
            PG8_STAGE(PG8_SB(1, 1), b3 + hstepB, voffB);
            PG8_WAIT_V(6); PG8_BAR; PG8_MMA(1, 1, At, B1); PG8_BAR;
            }
        }
        if constexpr (ALIGN_EPI) { if (wr == 0) PG8_BAR; }
        if constexpr (!Epi::AFTER_DRAIN) { E(acc, cur, wr, wc, fr, fq); S.done(cur); }
        if (!has_next) break;
#pragma unroll
        for (int a = 0; a < 2; ++a)
#pragma unroll
            for (int b = 0; b < 2; ++b)
#pragma unroll
                for (int m = 0; m < 4; ++m)
#pragma unroll
                    for (int n = 0; n < 2; ++n) acc[a][b][m][n] = (f32x4){0.f, 0.f, 0.f, 0.f};
        cur = nxt; cA = nA; cB = nB; ++ui;
        if constexpr (ALIGN_EPI) { if (wr == 1) PG8_BAR; }
    }
    PG8_WAIT_V(0);
    if constexpr (!ALIGN_EPI) { if (wr == 0) PG8_BAR; }
    PG8_BAR;
    if constexpr (Epi::AFTER_DRAIN) { E.fused(acc, cur, wr, wc, fr, fq, lds, wid, lane); S.done(cur); }
#undef PG8_SA
#undef PG8_SB
#undef PG8_STAGE
#undef PG8_LDA
#undef PG8_LDB
#undef PG8_MMA
#undef PG8_WAIT_V
#undef PG8_WAIT_L
#undef PG8_BAR
#undef PG8_SCHED
}
}

#ifndef MK_EXP_OLD
#define MK_EXP_OLD 0
#endif
#ifndef MK_ONE_LAUNCH
#define MK_ONE_LAUNCH 1
#endif
#define LAS __attribute__((address_space(3)))
typedef unsigned short bf16;
typedef unsigned v4u __attribute__((ext_vector_type(4)));
typedef unsigned v2u __attribute__((ext_vector_type(2)));
typedef float f32x4 __attribute__((ext_vector_type(4)));
typedef float f32x2 __attribute__((ext_vector_type(2)));
typedef short bf16x8 __attribute__((ext_vector_type(8)));
typedef float f32x16 __attribute__((ext_vector_type(16)));
#define MFMA32(a, b, c) __builtin_amdgcn_mfma_f32_32x32x16_bf16((a), (b), (c), 0, 0, 0)

constexpr int D = 1024, NB = 8, SEQ = 2048, LC = 256, ML = NB * SEQ  , MC = NB * LC  , MT = ML + MC  ;
constexpr int PROJ = 2576, NPROJ = 2560;
constexpr int NEXP = 16384, TOPK = 16, KK = 128;
constexpr float EPS = 1e-6f;
constexpr int NTHREADS = 512, NWAVES = 8;
constexpr int LDS_BYTES = 151552;
constexpr int NPHASES = 16;

constexpr size_t MiB = 1u << 20;
constexpr size_t WS_CTL = 0;
constexpr size_t CTL_ZERO_BYTES = 65536;
constexpr int CW_BAR = 0;
constexpr int CW_E1 = 4096, CW_E2 = 4096 + 8 * 64;
constexpr int CW_EXIT = 4096 + 16 * 64, CW_WORDS = CW_EXIT + 64;
static __device__ unsigned g_ctl[CW_WORDS];
constexpr size_t WS_MOD = 1 * MiB;
constexpr size_t WS_LP = 1 * MiB + 512 * 1024;
constexpr size_t WS_WIN = 2 * MiB;
constexpr size_t WS_WOUT = 8 * MiB;
constexpr size_t WS_WGLU = 10 * MiB;
constexpr size_t WS_WQ = 11 * MiB;
constexpr size_t WS_GB = 15 * MiB;
constexpr size_t WS_BB = 17 * MiB;
constexpr size_t WS_PM = 41 * MiB;
constexpr size_t WS_OG = 17 * MiB;
constexpr size_t WS_HX2 = 17 * MiB;
constexpr size_t WS_U5 = 49 * MiB;
constexpr size_t WS_CAT = 49 * MiB;
constexpr size_t WS_IDX = 49 * MiB;
constexpr size_t WS_GATE = 57 * MiB;
constexpr size_t WS_ACT = 65 * MiB;
constexpr size_t WS_SSQP = 73 * MiB;
constexpr size_t WS_Z = 85 * MiB;
constexpr size_t WS_YRAW = 85 * MiB;
constexpr size_t WS_QP = 85 * MiB;
constexpr size_t WS_Y = 85 * MiB;
constexpr size_t WS_HX = 101 * MiB;
constexpr size_t WS_SS = 101 * MiB;
constexpr size_t WS_YG = 101 * MiB;
constexpr size_t WS_FRT = 125 * MiB;
constexpr size_t WS_QKVPRE = 137 * MiB;
constexpr size_t WS_FRA = 143 * MiB;
constexpr size_t WS_FRK = 161 * MiB;
constexpr size_t WS_FRTAB = 197 * MiB;
constexpr size_t WS_QKV = 202 * MiB;
constexpr size_t WS_U8 = 202 * MiB;
constexpr size_t WS_V8 = 218 * MiB;
constexpr size_t WS_USC = 234 * MiB;
constexpr size_t WS_VSC = 234 * MiB + 512 * 1024;
constexpr size_t WS_HQ8 = 150 * MiB;
constexpr size_t WS_HS = 183 * MiB;
constexpr size_t WS_PACT = 85 * MiB;
constexpr size_t WS_KEYB = 6 * MiB;
constexpr size_t WS_X1A = 184 * MiB;
constexpr size_t WS_X1B = 236 * MiB;
constexpr size_t WS_END = 256 * MiB;
static_assert(WS_BB + (size_t)32 * 512 * 768 * 2 <= WS_PM && WS_PM + (size_t)32 * 256 * 512 * 2 <= WS_U5 && WS_U5 + (size_t)32 * 768 * 768 * 2 <= WS_Z && WS_Z + (size_t)ML * 512 * 2 <= WS_HX, "ws map a");
static_assert(WS_HX + (size_t)MT * D * 2 <= WS_QKVPRE && WS_SS + (size_t)32 * 768 * 256 * 4 <= WS_FRT && WS_QKVPRE + (size_t)MT * 1536 * 2 <= WS_QKV && WS_QKV + (size_t)MT * 1536 * 2 <= WS_END, "ws map b");
static_assert(WS_FRT + (size_t)2304 * 8192 <= WS_FRA && WS_FRA + (size_t)2304 * 8192 <= WS_FRK && WS_FRK + (size_t)2304 * 16384 <= WS_FRTAB && WS_FRTAB + (size_t)2304 * 1024 <= WS_QKV, "ws map c");
static_assert(WS_OG + (size_t)2 * ML * 512 * 2 <= WS_CAT && WS_CAT + (size_t)ML * D * 2 <= WS_Z && WS_YRAW + (size_t)ML * D * 4 <= WS_U8 && WS_SSQP + (size_t)8 * ML * 4 <= WS_Z && WS_YG + (size_t)ML * 512 * 2 <= WS_FRT, "ws map d");

__device__ __forceinline__ unsigned f2bf(float f) { unsigned u = __builtin_bit_cast(unsigned, f); return (u + 0x7fffu + ((u >> 16) & 1u)) >> 16; }
typedef __bf16 bf16x2_t __attribute__((ext_vector_type(2)));
__device__ __forceinline__ unsigned pk2(float lo, float hi) { const f32x2 v = {lo, hi}; return __builtin_bit_cast(unsigned, __builtin_convertvector(v, bf16x2_t)); }
__device__ __forceinline__ float bflo(unsigned w) { return __builtin_bit_cast(float, w << 16); }
__device__ __forceinline__ float bfhi(unsigned w) { return __builtin_bit_cast(float, w & 0xffff0000u); }
__device__ __forceinline__ float bf1(bf16 h) { return __builtin_bit_cast(float, (unsigned)h << 16); }
__device__ __forceinline__ float wave_sum(float v) {
#pragma unroll
    for (int o = 1; o < 64; o <<= 1) v += __shfl_xor(v, o);
    return v;
}
__device__ __forceinline__ float wave_max(float v) {
#pragma unroll
    for (int o = 1; o < 64; o <<= 1) v = fmaxf(v, __shfl_xor(v, o));
    return v;
}
__device__ __forceinline__ float sigmoidf_(float x) { return __builtin_amdgcn_rcpf(1.f + __expf(-x)); }
__device__ __forceinline__ float siluf_(float x) { return x * __builtin_amdgcn_rcpf(1.f + __expf(-x)); }
__device__ __forceinline__ float gelu_erf(float x) { return 0.5f * x * (1.f + erff(x * 0.70710678118654752f)); }
__device__ __forceinline__ void sincos_d(double a, float& s, float& c) {
    const double k = rint(a * 0.63661977236758134308);
    const double r = fma(-k, 1.57079632679489661923, a) - k * 6.123233995736766e-17;
    const double r2 = r * r;
    double sp = -2.5052108385441720e-08; sp = sp * r2 + 2.7557319223985893e-06; sp = sp * r2 - 1.9841269841269841e-04; sp = sp * r2 + 8.3333333333333332e-03; sp = sp * r2 - 1.6666666666666666e-01;
    const double sn = r + r * r2 * sp;
    double cp = 2.0876756987868099e-09; cp = cp * r2 - 2.7557319223985888e-07; cp = cp * r2 + 2.4801587301587302e-05; cp = cp * r2 - 1.3888888888888889e-03; cp = cp * r2 + 4.1666666666666664e-02; cp = cp * r2 - 0.5;
    const double cs = 1.0 + r2 * cp;
    const int q = ((int)k) & 3;
    const double ss = (q == 0) ? sn : (q == 1) ? cs : (q == 2) ? -sn : -cs;
    const double cc = (q == 0) ? cs : (q == 1) ? -sn : (q == 2) ? -cs : sn;
    s = (float)ss; c = (float)cc;
}

struct Args { const float* in[29]; float* out; unsigned char* ws; int ph_lo, ph_hi; };
static_assert(sizeof(Args) == 29 * 8 + 8 + 8 + 8, "Args has no padding");
enum { I_X = 0, I_C, I_CTX, I_CCTX, I_WMOD, I_BMOD, I_GPREMIX, I_GPOSTMIX, I_GPREFFN, I_GPOSTFFN, I_WIN, I_WOUT, I_LAMRE, I_LAMIM, I_LOGDT, I_BRE, I_BIM, I_CRE, I_CIM, I_S5D, I_WGLU,
       I_CONV, I_ALOG, I_DTBIAS, I_GDNNORM, I_WQ, I_KEYS, I_PU, I_PV };

__device__ __forceinline__ const float* in_row(const Args& a, int row) { return row < ML ? a.in[I_X] + (size_t)row * D : a.in[I_CTX] + (size_t)(row - ML) * D; }
__device__ __forceinline__ int mod_row(int row) { return row < ML ? (row >> 11) : 8; }

template <int CTRL> __device__ __forceinline__ float dppf(float v) { return __builtin_bit_cast(float, __builtin_amdgcn_update_dpp(0, __builtin_bit_cast(int, v), CTRL, 0xf, 0xf, true)); }
__device__ __forceinline__ float row_sum16(float v) { v += dppf<0xB1>(v); v += dppf<0x4E>(v); v += dppf<0x141>(v); v += dppf<0x140>(v); return v; }
__device__ __forceinline__ float row_max16(float v) { v = fmaxf(v, dppf<0xB1>(v)); v = fmaxf(v, dppf<0x4E>(v)); v = fmaxf(v, dppf<0x141>(v)); v = fmaxf(v, dppf<0x140>(v)); return v; }
__device__ __forceinline__ float wsum(float v) { v = row_sum16(v); return
    __builtin_bit_cast(float, __builtin_amdgcn_readlane(__builtin_bit_cast(int, v), 0)) + __builtin_bit_cast(float, __builtin_amdgcn_readlane(__builtin_bit_cast(int, v), 16)) +
    __builtin_bit_cast(float, __builtin_amdgcn_readlane(__builtin_bit_cast(int, v), 32)) + __builtin_bit_cast(float, __builtin_amdgcn_readlane(__builtin_bit_cast(int, v), 48)); }
__device__ __forceinline__ float wmax(float v) { v = row_max16(v); return fmaxf(fmaxf(__builtin_bit_cast(float, __builtin_amdgcn_readlane(__builtin_bit_cast(int, v), 0)), __builtin_bit_cast(float, __builtin_amdgcn_readlane(__builtin_bit_cast(int, v), 16))),
    fmaxf(__builtin_bit_cast(float, __builtin_amdgcn_readlane(__builtin_bit_cast(int, v), 32)), __builtin_bit_cast(float, __builtin_amdgcn_readlane(__builtin_bit_cast(int, v), 48)))); }
__device__ __forceinline__ int lane_rank(unsigned long long m) { return __builtin_amdgcn_mbcnt_hi((unsigned)(m >> 32), __builtin_amdgcn_mbcnt_lo((unsigned)m, 0)); }
__device__ __forceinline__ unsigned fkey(float f) { const unsigned u = __builtin_bit_cast(unsigned, f); return u ^ ((unsigned)((int)u >> 31) | 0x80000000u); }
#define WAVE_LDS_SYNC() do { __builtin_amdgcn_fence(__ATOMIC_RELEASE, "wavefront"); __builtin_amdgcn_wave_barrier(); __builtin_amdgcn_fence(__ATOMIC_ACQUIRE, "wavefront"); } while (0)
template <int N> __device__ __forceinline__ unsigned kth_key(const unsigned (&k)[N], int K) {
    unsigned T = 0;
    for (int bit = 31; bit >= 0; --bit) { const unsigned cand = T | (1u << bit); int cnt = 0;
#pragma unroll
        for (int n = 0; n < N; ++n) cnt += __popcll(__ballot(k[n] >= cand));
        if (cnt >= K) T = cand;
        if (cnt == K) break; }
    return T;
}

namespace pg8 {
struct EpiInProj {
    static constexpr bool PERM = true, AFTER_DRAIN = false;
    bf16_t* U; bf16_t* QKV; bf16_t* Z;
    __device__ __forceinline__ void operator()(const f32x4 (&acc)[2][2][4][2], const Unit& u, int wr, int wc, int fr, int fq) const {
        bf16_t* base; int ld, colt; bool lat_only = false;
        const bool s5 = u.pn < 2;
        if (s5) { base = U; ld = 0; colt = u.pn * BM; }
        else if (u.pn < 8) { base = QKV; ld = 1536; colt = (u.pn - 2) * BM; }
        else { base = Z; ld = 512; colt = (u.pn - 8) * BM; lat_only = true; }
        const int row0 = u.pm * BM + wr * 64 + fr, col0 = colt + wc * 32 + 8 * fq;
#pragma unroll
        for (int ai = 0; ai < 2; ++ai)
#pragma unroll
            for (int m = 0; m < 4; ++m) { const int row = row0 + ai * HALF + m * 16; bf16_t* rowp = base + (size_t)row * ld + col0;
                if (lat_only && row >= 16384) continue;
                if (s5) { const int R = row < 16384 ? (row >> 5) : 512 + ((row - 16384) >> 5), ii = row & 31; rowp = base + (size_t)R * 768 + ii * 16 + (col0 & 15); }
#pragma unroll
                for (int bj = 0; bj < 2; ++bj) { const f32x4 v0 = acc[ai][bj][m][0], v1 = acc[ai][bj][m][1];
                    u32x4 w; w.x = cvt_pk_bf16(v0[0], v0[1]); w.y = cvt_pk_bf16(v0[2], v0[3]); w.z = cvt_pk_bf16(v1[0], v1[1]); w.w = cvt_pk_bf16(v1[2], v1[3]);
                    if (s5) *(u32x4*)(rowp + (size_t)((col0 + bj * HALF) >> 4) * (768 * 768)) = w; else *(u32x4*)(rowp + bj * HALF) = w; } }
    }
};
struct EpiGlu {
    static constexpr bool PERM = true, AFTER_DRAIN = false;
    const bf16_t* YG; bf16_t* CAT;
    __device__ __forceinline__ void operator()(const f32x4 (&acc)[2][2][4][2], const Unit& u, int wr, int wc, int fr, int fq) const {
        const int row0 = u.pm * BM + wr * 64 + fr, col0 = u.pn * BM + wc * 32 + 8 * fq;
#pragma unroll
        for (int ai = 0; ai < 2; ++ai)
#pragma unroll
            for (int m = 0; m < 4; ++m) { const int row = row0 + ai * HALF + m * 16;
#pragma unroll
                for (int bj = 0; bj < 2; ++bj) { const f32x4 v0 = acc[ai][bj][m][0], v1 = acc[ai][bj][m][1];
                    const u32x4 y = *(const u32x4*)(YG + (size_t)row * 512 + col0 + bj * HALF);
                    float o[8]; const float a[8] = {v0[0], v0[1], v0[2], v0[3], v1[0], v1[1], v1[2], v1[3]};
                    const unsigned yw[4] = {y.x, y.y, y.z, y.w};
#pragma unroll
                    for (int e = 0; e < 8; ++e) { const float yv = __builtin_bit_cast(float, (e & 1) ? (yw[e >> 1] & 0xffff0000u) : (yw[e >> 1] << 16)); o[e] = yv * __builtin_amdgcn_rcpf(1.f + __expf(-a[e])); }
                    u32x4 w; w.x = cvt_pk_bf16(o[0], o[1]); w.y = cvt_pk_bf16(o[2], o[3]); w.z = cvt_pk_bf16(o[4], o[5]); w.w = cvt_pk_bf16(o[6], o[7]);
                    *(u32x4*)(CAT + (size_t)row * 1024 + col0 + bj * HALF) = w; } }
    }
};
struct EpiF32 {
    static constexpr bool PERM = false, AFTER_DRAIN = false;
    float* C; int ldc;
    __device__ __forceinline__ void operator()(const f32x4 (&acc)[2][2][4][2], const Unit& u, int wr, int wc, int fr, int fq) const {
        const int row0 = u.pm * BM + wr * 64 + fr, col0 = u.pn * BM + wc * 32 + 4 * fq;
#pragma unroll
        for (int ai = 0; ai < 2; ++ai)
#pragma unroll
            for (int m = 0; m < 4; ++m) { float* rowp = C + (size_t)(row0 + ai * HALF + m * 16) * ldc + col0;
#pragma unroll
                for (int bj = 0; bj < 2; ++bj)
#pragma unroll
                    for (int n = 0; n < 2; ++n) *(f32x4*)(rowp + bj * HALF + n * 16) = acc[ai][bj][m][n]; }
    }
};
struct EpiSS {
    static constexpr bool PERM = false, AFTER_DRAIN = false;
    float* C;
    __device__ __forceinline__ void operator()(const f32x4 (&acc)[2][2][4][2], const Unit& u, int wr, int wc, int fr, int fq) const {
        const int row0 = u.pm * BM + wr * 64 + fr, col0 = wc * 32 + 4 * fq;
#pragma unroll
        for (int ai = 0; ai < 2; ++ai)
#pragma unroll
            for (int m = 0; m < 4; ++m) { float* rowp = C + (size_t)(row0 + ai * HALF + m * 16) * 256 + col0;
#pragma unroll
                for (int bj = 0; bj < 2; ++bj)
#pragma unroll
                    for (int n = 0; n < 2; ++n) *(f32x4*)(rowp + bj * HALF + n * 16) = acc[ai][bj][m][n]; }
    }
};
struct SchedSS { int G, c; __device__ bool next(int i, Unit& u) const { const int L = i * G + c; if (L >= 96) return false; u.pm = L; u.pn = L / 3; return true; }
    __device__ __forceinline__ void a_ready(const Unit&) const {} __device__ __forceinline__ void done(const Unit&) const {} };
struct EpiS5Y {
    static constexpr bool PERM = true, AFTER_DRAIN = false;
    bf16_t* YG;
    __device__ __forceinline__ void operator()(const f32x4 (&acc)[2][2][4][2], const Unit& u, int wr, int wc, int fr, int fq) const {
        const int g = u.pn >> 1, R0 = (u.pm - 3 * g) * BM + wr * 64 + fr, n0 = (u.pn & 1) * BM + wc * 32 + 8 * fq;
#pragma unroll
        for (int ai = 0; ai < 2; ++ai)
#pragma unroll
            for (int m = 0; m < 4; ++m) { const int R = R0 + ai * HALF + m * 16;
#pragma unroll
                for (int bj = 0; bj < 2; ++bj) { const int n = n0 + bj * HALF; const f32x4 v0 = acc[ai][bj][m][0], v1 = acc[ai][bj][m][1];
                    const f32x2 a = gelu_pk((f32x2){v0[0], v0[1]}), b = gelu_pk((f32x2){v0[2], v0[3]}), c2 = gelu_pk((f32x2){v1[0], v1[1]}), d = gelu_pk((f32x2){v1[2], v1[3]});
                    u32x4 w; w.x = cvt_pk_bf16(a.x, a.y); w.y = cvt_pk_bf16(b.x, b.y); w.z = cvt_pk_bf16(c2.x, c2.y); w.w = cvt_pk_bf16(d.x, d.y);
                    *(u32x4*)(YG + (size_t)(R * 32 + (n >> 4)) * 512 + g * 16 + (n & 15)) = w; } }
    }
};
struct SchedS5Y { int G, c; __device__ bool next(int i, Unit& u) const { const int L = i * G + c; if (L >= 128) return false; const int g = L >> 2; u.pm = 3 * g + ((L >> 1) & 1); u.pn = 2 * g + (L & 1); return true; }
    __device__ __forceinline__ void a_ready(const Unit&) const {} __device__ __forceinline__ void done(const Unit&) const {} };
}

struct Ctx { const Args* a; unsigned char* ws; unsigned char* lds; int tid, lane, wave, bid, G, gw, NGW, gwv; };

__device__ __forceinline__ void p0_transpose_item(const float* W, int ldw, int nblk, int K, bf16* WT, float* scr, int item, int lane) {
    const int kb = item / nblk, nb = item % nblk, k0 = 64 * kb, n0 = 32 * nb;
    float wv[32];
#pragma unroll
    for (int i = 0; i < 32; ++i) { const int kk = 2 * i + (lane >> 5); wv[i] = W[(size_t)(k0 + kk) * ldw + n0 + (lane & 31)]; }
#pragma unroll
    for (int i = 0; i < 32; ++i) { const int kk = 2 * i + (lane >> 5); scr[kk * 33 + (lane & 31)] = wv[i]; }
    __builtin_amdgcn_fence(__ATOMIC_RELEASE, "wavefront"); __builtin_amdgcn_wave_barrier(); __builtin_amdgcn_fence(__ATOMIC_ACQUIRE, "wavefront");
    const int c = lane & 7;
#pragma unroll
    for (int j = 0; j < 4; ++j) { const int n = (lane >> 3) + 8 * j; const float* s = scr + (8 * c) * 33 + n;
        v4u o; o.x = pk2(s[0 * 33], s[1 * 33]); o.y = pk2(s[2 * 33], s[3 * 33]); o.z = pk2(s[4 * 33], s[5 * 33]); o.w = pk2(s[6 * 33], s[7 * 33]);
        *(v4u*)(WT + (size_t)(n0 + n) * K + k0 + 8 * c) = o; }
    __builtin_amdgcn_fence(__ATOMIC_RELEASE, "wavefront"); __builtin_amdgcn_wave_barrier(); __builtin_amdgcn_fence(__ATOMIC_ACQUIRE, "wavefront");
}
__device__ __forceinline__ void phase_prep(const Ctx& c) {
    const Args& a = *c.a;
    float* scr = (float*)(c.lds + c.wave * 16384);
    constexpr int I_IN = 16 * 80, I_GLU = 8 * 16;
    for (int it = c.gw; it < I_IN + I_GLU; it += c.NGW) {
        int r = it;
        if (r < I_IN) { p0_transpose_item(a.in[I_WIN], PROJ, 80, 1024, (bf16*)(c.ws + WS_WIN), scr, r, c.lane); continue; } r -= I_IN;
        p0_transpose_item(a.in[I_WGLU], 512, 16, 512, (bf16*)(c.ws + WS_WGLU), scr, r, c.lane);
    }
    __syncthreads();
    float* sc = (float*)c.lds;
    float* red = (float*)(c.lds + 9 * 1024 * 4);
    float* MOD = (float*)(c.ws + WS_MOD);
    bool have = false;
    for (int item = c.bid; item < 96; item += c.G) {
        if (!have) { for (int i = c.tid; i < 9 * 1024; i += NTHREADS) { const int r = i >> 10, k = i & 1023; const float v = r < 8 ? a.in[I_C][r * 1024 + k] : a.in[I_CCTX][k]; sc[i] = siluf_(v); } have = true; __syncthreads(); }
        const int n0 = item * 64;
        float acc[9];
#pragma unroll
        for (int r = 0; r < 9; ++r) acc[r] = 0.f;
        const float* wp = a.in[I_WMOD] + (size_t)(c.wave * 128) * 6144 + n0 + c.lane;
#pragma unroll 64
        for (int k = 0; k < 128; ++k) { const float w = wp[(size_t)k * 6144];
#pragma unroll
            for (int r = 0; r < 9; ++r) acc[r] = fmaf(sc[r * 1024 + c.wave * 128 + k], w, acc[r]); }
#pragma unroll
        for (int r = 0; r < 9; ++r) red[(c.wave * 9 + r) * 64 + c.lane] = acc[r];
        __syncthreads();
        for (int i = c.tid; i < 576; i += NTHREADS) { const int r = i >> 6, l = i & 63; float s = a.in[I_BMOD][n0 + l];
#pragma unroll
            for (int w = 0; w < 8; ++w) s += red[(w * 9 + r) * 64 + l];
            MOD[r * 6144 + n0 + l] = s; }
        __syncthreads();
    }
}
__device__ __forceinline__ void phase_late_copies(const Ctx& c, int w0, int nw) {
    const Args& a = *c.a;
    float* scr = (float*)(c.lds + c.wave * 16384);
    constexpr int I_OUT = 16 * 32, I_Q = 16 * 64;
    for (int it = c.gw - w0; it < I_OUT + I_Q; it += nw) {
        if (it < I_OUT) p0_transpose_item(a.in[I_WOUT], 1024, 32, 1024, (bf16*)(c.ws + WS_WOUT), scr, it, c.lane);
        else p0_transpose_item(a.in[I_WQ], 2048, 64, 1024, (bf16*)(c.ws + WS_WQ), scr, it - I_OUT, c.lane);
    }
    { const int nth = nw * 64, t0 = (c.gw - w0) * 64 + c.lane;
      for (int i = t0; i < 8 * 2 * 128 * 128 / 4; i += nth) { const f32x4 kv = *(const f32x4*)(a.in[I_KEYS] + 4 * (size_t)i); v2u o; o.x = pk2(kv.x, kv.y); o.y = pk2(kv.z, kv.w); *(v2u*)(c.ws + WS_KEYB + 8 * (size_t)i) = o; } }
}
template <int MODE> __device__ __forceinline__ void s5_build_group(const Ctx& c, int g, int part);
__device__ __forceinline__ void phase_s5_build(const Ctx& c) { for (int it = c.G - 1 - c.bid; it < 128; it += c.G) if (it >= 0) s5_build_group<0>(c, it >> 2, it & 3); }

__device__ __forceinline__ void phase_norm1(const Ctx& c) {
    const Args& a = *c.a;
    bf16* wabT = (bf16*)c.lds;
    { f32x4 wv[8];
#pragma unroll
      for (int q = 0; q < 8; ++q) { const int i = c.tid + NTHREADS * q, kk = i >> 2, qq = i & 3; wv[q] = *(const f32x4*)(a.in[I_WIN] + (size_t)kk * PROJ + NPROJ + 4 * qq); }
#pragma unroll
      for (int q = 0; q < 8; ++q) { const int i = c.tid + NTHREADS * q, kk = i >> 2, qq = i & 3; wabT[(4 * qq + 0) * 1032 + kk] = (bf16)f2bf(wv[q].x); wabT[(4 * qq + 1) * 1032 + kk] = (bf16)f2bf(wv[q].y); wabT[(4 * qq + 2) * 1032 + kk] = (bf16)f2bf(wv[q].z); wabT[(4 * qq + 3) * 1032 + kk] = (bf16)f2bf(wv[q].w); } }
    __syncthreads();
    const float* MOD = (const float*)(c.ws + WS_MOD);
    bf16* HX = (bf16*)(c.ws + WS_HX); float* GB = (float*)(c.ws + WS_GB);
    const float* gpre = a.in[I_GPREMIX];
    f32x4 nx[4], g4c[4];
#pragma unroll
    for (int j = 0; j < 4; ++j) g4c[j] = *(const f32x4*)(gpre + 4 * c.lane + 256 * j);
    if (c.gw < MT) { const f32x4* xr = (const f32x4*)in_row(a, c.gw) + c.lane;
#pragma unroll
        for (int j = 0; j < 4; ++j) nx[j] = xr[64 * j]; }
    for (int row = c.gw; row < MT; row += c.NGW) {
        const float* mr = MOD + mod_row(row) * 6144;
        f32x4 shv[4], sclv[4];
#pragma unroll
        for (int j = 0; j < 4; ++j) { shv[j] = *(const f32x4*)(mr + 4 * c.lane + 256 * j); sclv[j] = *(const f32x4*)(mr + 1024 + 4 * c.lane + 256 * j); }
        f32x4 v[4]; bf16x2_t hp[8]; float ss = 0.f;
#pragma unroll
        for (int j = 0; j < 4; ++j) { v[j] = nx[j]; ss += (v[j].x * v[j].x + v[j].y * v[j].y) + (v[j].z * v[j].z + v[j].w * v[j].w); }
        if (row + c.NGW < MT) { const f32x4* xr = (const f32x4*)in_row(a, row + c.NGW) + c.lane;
#pragma unroll
            for (int j = 0; j < 4; ++j) nx[j] = xr[64 * j]; }
        const float r = rsqrtf(wsum(ss) * (1.f / D) + EPS);
#pragma unroll
        for (int j = 0; j < 4; ++j) { const int col = 4 * c.lane + 256 * j;
            v[j] = (v[j] * r) * g4c[j] * (sclv[j] + 1.f) + shv[j];
            hp[2 * j] = __builtin_convertvector((f32x2){v[j].x, v[j].y}, bf16x2_t); hp[2 * j + 1] = __builtin_convertvector((f32x2){v[j].z, v[j].w}, bf16x2_t);
            v2u o; o.x = __builtin_bit_cast(unsigned, hp[2 * j]); o.y = __builtin_bit_cast(unsigned, hp[2 * j + 1]);
            *(v2u*)(HX + (size_t)row * D + col) = o; }
        float pj[16];
#pragma unroll
        for (int j = 0; j < 16; ++j) { float s = 0.f;
#pragma unroll
            for (int jj = 0; jj < 4; ++jj) { const bf16x2_t* wp = (const bf16x2_t*)(wabT + j * 1032 + 4 * c.lane + 256 * jj);
                s = __builtin_amdgcn_fdot2_f32_bf16(hp[2 * jj], wp[0], s, false); s = __builtin_amdgcn_fdot2_f32_bf16(hp[2 * jj + 1], wp[1], s, false); }
            pj[j] = s; if ((j & 1) == 1) asm volatile("" ::: "memory"); }
        const bool b5 = c.lane & 32, b4 = c.lane & 16, b3 = c.lane & 8, b2 = c.lane & 4;
        float q8[8], q4[4], q2[2];
#pragma unroll
        for (int i = 0; i < 8; ++i) { const float keep = b5 ? pj[i + 8] : pj[i], send = b5 ? pj[i] : pj[i + 8]; q8[i] = keep + __shfl_xor(send, 32); }
#pragma unroll
        for (int i = 0; i < 4; ++i) { const float keep = b4 ? q8[i + 4] : q8[i], send = b4 ? q8[i] : q8[i + 4]; q4[i] = keep + __shfl_xor(send, 16); }
#pragma unroll
        for (int i = 0; i < 2; ++i) { const float keep = b3 ? q4[i + 2] : q4[i], send = b3 ? q4[i] : q4[i + 2]; q2[i] = keep + dppf<0x140>(send); }
        float mine; { const float keep = b2 ? q2[1] : q2[0], send = b2 ? q2[0] : q2[1]; mine = keep + dppf<0x141>(send); }
        mine += dppf<0xB1>(mine); mine += dppf<0x4E>(mine);
        const int jl = (b5 ? 8 : 0) + (b4 ? 4 : 0) + (b3 ? 2 : 0) + (b2 ? 1 : 0);
        if ((c.lane & 3) == 0) {
            if (jl < 8) { const float t = mine + a.in[I_DTBIAS][jl]; const float sp = t > 20.f ? t : log1pf(expf(t)); GB[(size_t)row * 16 + jl] = -expf(a.in[I_ALOG][jl]) * sp; }
            else GB[(size_t)row * 16 + jl] = 1.f / (1.f + expf(-mine)); }
    }
}

__device__ __forceinline__ void phase_conv(const Ctx& c) {
    const Args& a = *c.a;
    const bf16* PRE = (const bf16*)(c.ws + WS_QKVPRE); bf16* OUT = (bf16*)(c.ws + WS_QKV);
    const float* cw = a.in[I_CONV];
    int rbase = c.gw, rstride = c.NGW, rcnt = (MT - c.gw + c.NGW - 1) / c.NGW;
    if (c.G == 256) { if (c.bid < 96) { rbase = c.gw; rstride = 768; rcnt = 10; } else if (c.bid < 128) { rbase = 7680 + (c.gw - 768); rstride = 256; rcnt = 14; } else { rbase = 11264 + (c.gw - 1024); rstride = 1024; rcnt = 7; } }
    static_assert(MT == 768 * 10 + 256 * 14 + 1024 * 7, "weighted conv split");
#pragma unroll 1
    for (int pass = 0; pass < 3; ++pass) { const int ch0 = pass * 512 + 8 * c.lane;
        f32x4 wt[9][2];
#pragma unroll
        for (int i = 0; i < 9; ++i) { wt[i][0] = *(const f32x4*)(cw + i * 1536 + ch0); wt[i][1] = *(const f32x4*)(cw + i * 1536 + ch0 + 4); }
#define CONV_LOAD(DST, ROW) do { const int row_ = (ROW); int nb_row[9]; bool ok[9]; \
            if (row_ < ML) { const int t = row_ & 2047, gr = t >> 6, gc = t & 63; \
                _Pragma("unroll") for (int dy = -1; dy <= 1; ++dy) _Pragma("unroll") for (int dx = -1; dx <= 1; ++dx) { const int i = (dy + 1) * 3 + dx + 1; ok[i] = (gr + dy >= 0) && (gr + dy < 32) && (gc + dx >= 0) && (gc + dx < 64); nb_row[i] = row_ + dy * 64 + dx; } } \
            else { const int t = (row_ - ML) & 255; _Pragma("unroll") for (int i = 0; i < 9; ++i) { ok[i] = false; nb_row[i] = row_; } \
                _Pragma("unroll") for (int dx = -1; dx <= 1; ++dx) { ok[4 + dx] = (t + dx >= 0) && (t + dx < 256); nb_row[4 + dx] = row_ + dx; } } \
            _Pragma("unroll") for (int i = 0; i < 9; ++i) DST[i] = ok[i] ? *(const v4u*)(PRE + (size_t)nb_row[i] * 1536 + ch0) : (v4u){0u, 0u, 0u, 0u}; } while (0)
        v4u nin[9];
        if (rcnt > 0) CONV_LOAD(nin, rbase);
#pragma unroll 1
        for (int ri = 0; ri < rcnt; ++ri) { const int row = rbase + ri * rstride;
            v4u in[9];
#pragma unroll
            for (int i = 0; i < 9; ++i) in[i] = nin[i];
            if (ri + 1 < rcnt) CONV_LOAD(nin, row + rstride);
            float o[8];
#pragma unroll
            for (int q = 0; q < 8; ++q) o[q] = 0.f;
#pragma unroll
            for (int i = 0; i < 9; ++i) { const unsigned w[4] = {in[i].x, in[i].y, in[i].z, in[i].w}; const float kk[8] = {wt[i][0].x, wt[i][0].y, wt[i][0].z, wt[i][0].w, wt[i][1].x, wt[i][1].y, wt[i][1].z, wt[i][1].w};
#pragma unroll
                for (int q = 0; q < 4; ++q) { o[2 * q] = fmaf(bflo(w[q]), kk[2 * q], o[2 * q]); o[2 * q + 1] = fmaf(bfhi(w[q]), kk[2 * q + 1], o[2 * q + 1]); } }
            float ssq = 0.f;
#pragma unroll
            for (int q = 0; q < 8; ++q) { o[q] = siluf_(o[q]); ssq = fmaf(o[q], o[q], ssq); }
            if (pass < 2) { const float sc = rsqrtf(row_sum16(ssq) + EPS) * (pass == 0 ? 0.08838834764831845f : 1.f);
#pragma unroll
                for (int q = 0; q < 8; ++q) o[q] *= sc; }
            v4u ov; ov.x = pk2(o[0], o[1]); ov.y = pk2(o[2], o[3]); ov.z = pk2(o[4], o[5]); ov.w = pk2(o[6], o[7]);
            *(v4u*)(OUT + (size_t)row * 1536 + ch0) = ov;
        }
#undef CONV_LOAD
    }
}

__device__ __forceinline__ int scan_row(int b, int dir, int step) {
    if (step < LC) { const int t = dir ? LC - 1 - step : step; return ML + b * LC + t; }
    const int t = step - LC; return b * SEQ + (dir ? SEQ - 1 - t : t);
}
__device__ __forceinline__ void phase_combine(const Ctx& c) {
    const Args& a = *c.a;
    const bf16* OG0 = (const bf16*)(c.ws + WS_OG); const bf16* OG1 = OG0 + (size_t)ML * 512; const bf16* Z = (const bf16*)(c.ws + WS_Z);
    bf16* CAT = (bf16*)(c.ws + WS_CAT);
    const f32x4 ng0 = *(const f32x4*)(a.in[I_GDNNORM] + 8 * (c.lane & 15)), ng1 = *(const f32x4*)(a.in[I_GDNNORM] + 8 * (c.lane & 15) + 4);
    const float ngv[8] = {ng0.x, ng0.y, ng0.z, ng0.w, ng1.x, ng1.y, ng1.z, ng1.w};
    v4u n0, n1, nz;
#define CB_LOAD(R) do { const size_t o_ = (size_t)(R) * 512 + 8 * c.lane; n0 = *(const v4u*)(OG0 + o_); n1 = *(const v4u*)(OG1 + o_); nz = *(const v4u*)(Z + o_); } while (0)
    if (c.gw < ML) CB_LOAD(c.gw);
    for (int row = c.gw; row < ML; row += c.NGW) {
        const v4u w0 = n0, w1 = n1, zw = nz;
        { const int rn = row + c.NGW < ML ? row + c.NGW : row; CB_LOAD(rn); }
        const unsigned a0[4] = {w0.x, w0.y, w0.z, w0.w}, a1[4] = {w1.x, w1.y, w1.z, w1.w}, zz[4] = {zw.x, zw.y, zw.z, zw.w};
        float o[8]; float ss = 0.f;
#pragma unroll
        for (int q = 0; q < 4; ++q) { o[2 * q] = bflo(a0[q]) + bflo(a1[q]); o[2 * q + 1] = bfhi(a0[q]) + bfhi(a1[q]); ss += o[2 * q] * o[2 * q] + o[2 * q + 1] * o[2 * q + 1]; }
        const float r = rsqrtf(row_sum16(ss) * (1.f / 128.f) + EPS);
        v4u ov; unsigned* op = (unsigned*)&ov;
#pragma unroll
        for (int q = 0; q < 4; ++q) op[q] = pk2(o[2 * q] * r * ngv[2 * q] * siluf_(bflo(zz[q])), o[2 * q + 1] * r * ngv[2 * q + 1] * siluf_(bfhi(zz[q])));
        *(v4u*)(CAT + (size_t)row * 1024 + 512 + 8 * c.lane) = ov;
    }
#undef CB_LOAD
}

__device__ __forceinline__ unsigned char* x1_row(unsigned char* ws, int row) { return ws + (row < 8192 ? WS_X1A + (size_t)row * 2048 : WS_X1B + (size_t)(row - 8192) * 2048); }
__device__ __forceinline__ void phase_rows2(const Ctx& c) {
    const Args& a = *c.a;
    const float* MOD = (const float*)(c.ws + WS_MOD); const bf16* YRAW = (const bf16*)(c.ws + WS_YRAW); bf16* HX2 = (bf16*)(c.ws + WS_HX2);
    v2u ny[4]; f32x4 nxx[4], gpo[4], gpf[4];
#pragma unroll
    for (int j = 0; j < 4; ++j) { gpo[j] = *(const f32x4*)(a.in[I_GPOSTMIX] + 4 * c.lane + 256 * j); gpf[j] = *(const f32x4*)(a.in[I_GPREFFN] + 4 * c.lane + 256 * j); }
    if (c.gw < ML) {
#pragma unroll
        for (int j = 0; j < 4; ++j) { ny[j] = *((const v2u*)(YRAW + (size_t)c.gw * D) + c.lane + 64 * j); nxx[j] = *((const f32x4*)(a.in[I_X] + (size_t)c.gw * D) + c.lane + 64 * j); } }
    for (int row = c.gw; row < ML; row += c.NGW) {
        const float* mr = MOD + (row >> 11) * 6144;
        f32x4 gtv[4], shv[4], sclv[4];
#pragma unroll
        for (int j = 0; j < 4; ++j) { const int col = 4 * c.lane + 256 * j; gtv[j] = *(const f32x4*)(mr + 2048 + col); shv[j] = *(const f32x4*)(mr + 3072 + col); sclv[j] = *(const f32x4*)(mr + 4096 + col); }
        f32x4 y[4], x[4]; float ss = 0.f;
#pragma unroll
        for (int j = 0; j < 4; ++j) { y[j] = (f32x4){bflo(ny[j].x), bfhi(ny[j].x), bflo(ny[j].y), bfhi(ny[j].y)}; x[j] = nxx[j];
            ss += (y[j].x * y[j].x + y[j].y * y[j].y) + (y[j].z * y[j].z + y[j].w * y[j].w); }
        if (row + c.NGW < ML) { const size_t r2 = (size_t)(row + c.NGW);
#pragma unroll
            for (int j = 0; j < 4; ++j) { ny[j] = *((const v2u*)(YRAW + r2 * D) + c.lane + 64 * j); nxx[j] = *((const f32x4*)(a.in[I_X] + r2 * D) + c.lane + 64 * j); } }
        const float r = rsqrtf(wsum(ss) * (1.f / D) + EPS); float s2 = 0.f;
#pragma unroll
        for (int j = 0; j < 4; ++j) { const int col = 4 * c.lane + 256 * j;
            x[j] = x[j] + gtv[j] * ((y[j] * r) * gpo[j]);
            { v2u xo; xo.x = pk2(x[j].x, x[j].y); xo.y = pk2(x[j].z, x[j].w); *(v2u*)(x1_row(c.ws, row) + 2 * col) = xo; }
            s2 += (x[j].x * x[j].x + x[j].y * x[j].y) + (x[j].z * x[j].z + x[j].w * x[j].w); }
        const float r2 = rsqrtf(wsum(s2) * (1.f / D) + EPS);
#pragma unroll
        for (int j = 0; j < 4; ++j) { const int col = 4 * c.lane + 256 * j;
            const f32x4 hv = (x[j] * r2) * gpf[j] * (sclv[j] + 1.f) + shv[j];
            v2u o; o.x = pk2(hv.x, hv.y); o.y = pk2(hv.z, hv.w);
            *(v2u*)(HX2 + (size_t)row * D + col) = o;
            x[j] = (f32x4){bflo(o.x), bfhi(o.x), bflo(o.y), bfhi(o.y)}; }
        { float mx = 0.f;
#pragma unroll
          for (int j = 0; j < 4; ++j) mx = fmaxf(mx, fmaxf(fmaxf(fabsf(x[j].x), fabsf(x[j].y)), fmaxf(fabsf(x[j].z), fabsf(x[j].w))));
          mx = wmax(mx); const float hs = mx > 0.f ? 256.f / mx : 1.f;
          if (c.lane == 0) ((float*)(c.ws + WS_HS))[row] = 1.f / hs; }
    }
}


constexpr int KROW = 136;
__device__ __forceinline__ float unfkey(unsigned k) { const unsigned u = (k & 0x80000000u) ? (k ^ 0x80000000u) : ~k; return __builtin_bit_cast(float, u); }
__device__ __forceinline__ void ins16(unsigned (&L)[16], unsigned key) {
#pragma unroll
    for (int q = 0; q < 16; ++q) { const unsigned hi = L[q] > key ? L[q] : key, lo = L[q] > key ? key : L[q]; L[q] = hi; key = lo; }
}
__device__ __forceinline__ void sort16_desc(unsigned (&a)[16]) {
#pragma unroll
    for (int kk = 2; kk <= 16; kk <<= 1)
#pragma unroll
        for (int j = kk >> 1; j >= 1; j >>= 1)
#pragma unroll
            for (int i = 0; i < 16; ++i) { const int l = i ^ j; if (l > i) { const unsigned hi = a[i] > a[l] ? a[i] : a[l], lo = a[i] > a[l] ? a[l] : a[i]; if ((i & kk) == 0) { a[i] = hi; a[l] = lo; } else { a[i] = lo; a[l] = hi; } } }
}
__device__ __forceinline__ void top16_of_two(unsigned (&A)[16], const unsigned (&B)[16]) {
#pragma unroll
    for (int q = 0; q < 16; ++q) A[q] = A[q] > B[15 - q] ? A[q] : B[15 - q];
#pragma unroll
    for (int j = 8; j >= 1; j >>= 1)
#pragma unroll
        for (int q = 0; q < 16; ++q) if ((q & j) == 0) { const unsigned hi = A[q] > A[q + j] ? A[q] : A[q + j], lo = A[q] > A[q + j] ? A[q + j] : A[q]; A[q] = hi; A[q + j] = lo; }
}
__device__ __forceinline__ void merge16(unsigned (&L)[16]) {
    unsigned R[16];
#pragma unroll
    for (int q = 0; q < 16; ++q) R[q] = (unsigned)__shfl_xor((int)L[15 - q], 32);
#pragma unroll
    for (int q = 0; q < 16; ++q) L[q] = L[q] > R[q] ? L[q] : R[q];
#pragma unroll
    for (int j = 8; j >= 1; j >>= 1)
#pragma unroll
        for (int q = 0; q < 16; ++q) if ((q & j) == 0) { const unsigned hi = L[q] > L[q + j] ? L[q] : L[q + j], lo = L[q] > L[q + j] ? L[q + j] : L[q]; L[q] = hi; L[q + j] = lo; }
}
__device__ __forceinline__ void phase_topk(const Ctx& c) {
    const Args& a = *c.a;
    bf16* kl = (bf16*)c.lds;
    unsigned char* wtab = c.lds + 2 * 128 * KROW * 2 + c.wave * 1088;
    const bf16* QP = (const bf16*)(c.ws + WS_QP); int* IDX = (int*)(c.ws + WS_IDX); float* GATE = (float*)(c.ws + WS_GATE);
    const int r = c.lane & 31, hh = c.lane >> 5;
    { const unsigned char ptab[50] = {0, 1, 2, 3, 4, 5, 6, 7, 8, 9, 10, 11, 12, 13, 14, 15, 16, 17, 18, 19, 20, 21, 22, 23, 32, 33, 34, 35, 36, 48, 49, 50, 51, 64, 65, 66, 80, 81, 96, 97, 112, 113, 128, 144, 160, 176, 192, 208, 224, 240};
      if (c.lane < 50) wtab[1024 + c.lane] = ptab[c.lane < 50 ? c.lane : 0]; }
    for (int item = c.bid; item < 8 * 32; item += c.G) {
        const int h = item & 7, tr = item >> 3;
        __syncthreads();
        { v4u kv[8];
          const bf16* kb = (const bf16*)(c.ws + WS_KEYB) + (size_t)h * 2 * 128 * 128;
#pragma unroll
          for (int q = 0; q < 8; ++q) { const int i = c.tid + NTHREADS * q; kv[q] = *(const v4u*)(kb + 8 * (size_t)i); }
#pragma unroll
          for (int q = 0; q < 8; ++q) { const int i = c.tid + NTHREADS * q, k8 = i & 15, pn = i >> 4; *(v4u*)(kl + pn * KROW + 8 * k8) = kv[q]; } }
        __syncthreads();
        for (int tile = c.wave; tile < 16; tile += NWAVES) {
            const int tok = tr * 512 + tile * 32 + r;
            unsigned LA[16], LB[16];
#pragma unroll
            for (int p = 0; p < 2; ++p) {
                bf16x8 qf[8];
#pragma unroll
                for (int kk = 0; kk < 8; ++kk) qf[kk] = *(const bf16x8*)(QP + (size_t)tok * 2048 + h * 256 + p * 128 + kk * 16 + hh * 8);
                f32x16 acc[4];
#pragma unroll
                for (int nt = 0; nt < 4; ++nt)
#pragma unroll
                    for (int i = 0; i < 16; ++i) acc[nt][i] = 0.f;
#pragma unroll
                for (int kk = 0; kk < 8; ++kk)
#pragma unroll
                    for (int nt = 0; nt < 4; ++nt) acc[nt] = MFMA32(*(const bf16x8*)(kl + (p * 128 + nt * 32 + r) * KROW + kk * 16 + hh * 8), qf[kk], acc[nt]);
                unsigned (&L)[16] = p ? LB : LA;
                unsigned G1[16], G2[16], G3[16];
#pragma unroll
                for (int i = 0; i < 16; ++i) { const int n0 = (i & 3) + 8 * (i >> 2) + 4 * hh;
                    L[i] = (fkey(acc[0][i]) & ~127u) | (unsigned)(127 - n0); G1[i] = (fkey(acc[1][i]) & ~127u) | (unsigned)(127 - (32 + n0));
                    G2[i] = (fkey(acc[2][i]) & ~127u) | (unsigned)(127 - (64 + n0)); G3[i] = (fkey(acc[3][i]) & ~127u) | (unsigned)(127 - (96 + n0)); }
                sort16_desc(L); sort16_desc(G1); sort16_desc(G2); sort16_desc(G3);
                top16_of_two(L, G1); top16_of_two(G2, G3); top16_of_two(L, G2);
                merge16(L);
            }
            unsigned char* tt = wtab + r * 32;
            if (hh == 0) {
#pragma unroll
                for (int q = 0; q < 16; ++q) tt[q] = (unsigned char)(127u - (LA[q] & 127u)); }
            else {
#pragma unroll
                for (int q = 0; q < 16; ++q) tt[16 + q] = (unsigned char)(127u - (LB[q] & 127u)); }
            float va[16], vb[16];
#pragma unroll
            for (int q = 0; q < 16; ++q) { va[q] = unfkey(LA[q] & ~127u); vb[q] = unfkey(LB[q] & ~127u); }
            unsigned LC[16];
#pragma unroll
            for (int q = 0; q < 16; ++q) LC[q] = 0u;
            { const float s0 = va[0] + vb[0], s1 = va[0] + vb[1]; ins16(LC, (fkey(hh ? s1 : s0) & ~63u) | (unsigned)(63 - (0 + hh))); }
            { const float s0 = va[0] + vb[2], s1 = va[0] + vb[3]; ins16(LC, (fkey(hh ? s1 : s0) & ~63u) | (unsigned)(63 - (2 + hh))); }
            { const float s0 = va[0] + vb[4], s1 = va[0] + vb[5]; ins16(LC, (fkey(hh ? s1 : s0) & ~63u) | (unsigned)(63 - (4 + hh))); }
            { const float s0 = va[0] + vb[6], s1 = va[0] + vb[7]; ins16(LC, (fkey(hh ? s1 : s0) & ~63u) | (unsigned)(63 - (6 + hh))); }
            { const float s0 = va[0] + vb[8], s1 = va[0] + vb[9]; ins16(LC, (fkey(hh ? s1 : s0) & ~63u) | (unsigned)(63 - (8 + hh))); }
            { const float s0 = va[0] + vb[10], s1 = va[0] + vb[11]; ins16(LC, (fkey(hh ? s1 : s0) & ~63u) | (unsigned)(63 - (10 + hh))); }
            { const float s0 = va[0] + vb[12], s1 = va[0] + vb[13]; ins16(LC, (fkey(hh ? s1 : s0) & ~63u) | (unsigned)(63 - (12 + hh))); }
            { const float s0 = va[0] + vb[14], s1 = va[0] + vb[15]; ins16(LC, (fkey(hh ? s1 : s0) & ~63u) | (unsigned)(63 - (14 + hh))); }
            { const float s0 = va[1] + vb[0], s1 = va[1] + vb[1]; ins16(LC, (fkey(hh ? s1 : s0) & ~63u) | (unsigned)(63 - (16 + hh))); }
            { const float s0 = va[1] + vb[2], s1 = va[1] + vb[3]; ins16(LC, (fkey(hh ? s1 : s0) & ~63u) | (unsigned)(63 - (18 + hh))); }
            { const float s0 = va[1] + vb[4], s1 = va[1] + vb[5]; ins16(LC, (fkey(hh ? s1 : s0) & ~63u) | (unsigned)(63 - (20 + hh))); }
            { const float s0 = va[1] + vb[6], s1 = va[1] + vb[7]; ins16(LC, (fkey(hh ? s1 : s0) & ~63u) | (unsigned)(63 - (22 + hh))); }
            { const float s0 = va[2] + vb[0], s1 = va[2] + vb[1]; ins16(LC, (fkey(hh ? s1 : s0) & ~63u) | (unsigned)(63 - (24 + hh))); }
            { const float s0 = va[2] + vb[2], s1 = va[2] + vb[3]; ins16(LC, (fkey(hh ? s1 : s0) & ~63u) | (unsigned)(63 - (26 + hh))); }
            { const float s0 = va[2] + vb[4], s1 = va[3] + vb[0]; ins16(LC, (fkey(hh ? s1 : s0) & ~63u) | (unsigned)(63 - (28 + hh))); }
            { const float s0 = va[3] + vb[1], s1 = va[3] + vb[2]; ins16(LC, (fkey(hh ? s1 : s0) & ~63u) | (unsigned)(63 - (30 + hh))); }
            { const float s0 = va[3] + vb[3], s1 = va[4] + vb[0]; ins16(LC, (fkey(hh ? s1 : s0) & ~63u) | (unsigned)(63 - (32 + hh))); }
            { const float s0 = va[4] + vb[1], s1 = va[4] + vb[2]; ins16(LC, (fkey(hh ? s1 : s0) & ~63u) | (unsigned)(63 - (34 + hh))); }
            { const float s0 = va[5] + vb[0], s1 = va[5] + vb[1]; ins16(LC, (fkey(hh ? s1 : s0) & ~63u) | (unsigned)(63 - (36 + hh))); }
            { const float s0 = va[6] + vb[0], s1 = va[6] + vb[1]; ins16(LC, (fkey(hh ? s1 : s0) & ~63u) | (unsigned)(63 - (38 + hh))); }
            { const float s0 = va[7] + vb[0], s1 = va[7] + vb[1]; ins16(LC, (fkey(hh ? s1 : s0) & ~63u) | (unsigned)(63 - (40 + hh))); }
            { const float s0 = va[8] + vb[0], s1 = va[9] + vb[0]; ins16(LC, (fkey(hh ? s1 : s0) & ~63u) | (unsigned)(63 - (42 + hh))); }
            { const float s0 = va[10] + vb[0], s1 = va[11] + vb[0]; ins16(LC, (fkey(hh ? s1 : s0) & ~63u) | (unsigned)(63 - (44 + hh))); }
            { const float s0 = va[12] + vb[0], s1 = va[13] + vb[0]; ins16(LC, (fkey(hh ? s1 : s0) & ~63u) | (unsigned)(63 - (46 + hh))); }
            { const float s0 = va[14] + vb[0], s1 = va[15] + vb[0]; ins16(LC, (fkey(hh ? s1 : s0) & ~63u) | (unsigned)(63 - (48 + hh))); }
            merge16(LC);
            WAVE_LDS_SYNC();
            float ev[16]; float den = 0.f; const float mx = unfkey(LC[0] & ~63u);
#pragma unroll
            for (int q = 0; q < 16; ++q) { ev[q] = __expf(unfkey(LC[q] & ~63u) - mx); den += ev[q]; }
            const float inv = 1.f / den;
            if (hh == 0) { int ex[16];
#pragma unroll
                for (int q = 0; q < 16; ++q) { const unsigned pc = wtab[1024 + (63u - (LC[q] & 63u))]; ex[q] = (int)tt[pc >> 4] * 128 + (int)tt[16 + (pc & 15u)]; }
#pragma unroll
                for (int q = 0; q < 4; ++q) *(v4u*)(IDX + (size_t)tok * 128 + h * 16 + 4 * q) = (v4u){(unsigned)ex[4 * q], (unsigned)ex[4 * q + 1], (unsigned)ex[4 * q + 2], (unsigned)ex[4 * q + 3]}; }
            else {
#pragma unroll
                for (int q = 0; q < 4; ++q) *(f32x4*)(GATE + (size_t)tok * 128 + h * 16 + 4 * q) = (f32x4){ev[4 * q] * inv, ev[4 * q + 1] * inv, ev[4 * q + 2] * inv, ev[4 * q + 3] * inv}; }
            WAVE_LDS_SYNC();
        }
    }
}

__device__ __forceinline__ void phase_fp8_tables(const Ctx& c) {
    const Args& a = *c.a;
    f32x4 nv[2][4];
#define F8_LOAD(R0) do { _Pragma("unroll") for (int u = 0; u < 2; ++u) { int rr = (R0) + u * c.NGW; rr = rr < 2 * NEXP ? rr : 2 * NEXP - 1; const bool isv_ = rr >= NEXP; const int e_ = isv_ ? rr - NEXP : rr; \
        const f32x4* src = (const f32x4*)((isv_ ? a.in[I_PV] : a.in[I_PU]) + (size_t)e_ * D) + c.lane; _Pragma("unroll") for (int j = 0; j < 4; ++j) nv[u][j] = src[64 * j]; } } while (0)
    if (c.gw < 2 * NEXP) F8_LOAD(c.gw);
    for (int r0 = c.gw; r0 < 2 * NEXP; r0 += 2 * c.NGW) {
        f32x4 v[2][4];
#pragma unroll
        for (int u = 0; u < 2; ++u)
#pragma unroll
            for (int j = 0; j < 4; ++j) v[u][j] = nv[u][j];
        { const int rn = r0 + 2 * c.NGW < 2 * NEXP ? r0 + 2 * c.NGW : r0; F8_LOAD(rn); }
#pragma unroll
        for (int u = 0; u < 2; ++u) { const int r = r0 + u * c.NGW;
            if (r < 2 * NEXP) { const bool isv = r >= NEXP; const int e = isv ? r - NEXP : r; float m = 0.f;
#pragma unroll
                for (int j = 0; j < 4; ++j) m = fmaxf(m, fmaxf(fmaxf(fabsf(v[u][j].x), fabsf(v[u][j].y)), fmaxf(fabsf(v[u][j].z), fabsf(v[u][j].w))));
                m = wmax(m); const float inv = m > 0.f ? 256.f / m : 0.f;
                unsigned char* dst = c.ws + (isv ? WS_V8 : WS_U8) + (size_t)e * D + 4 * c.lane;
#pragma unroll
                for (int j = 0; j < 4; ++j) { int w = __builtin_amdgcn_cvt_pk_fp8_f32(v[u][j].x * inv, v[u][j].y * inv, 0, false); w = __builtin_amdgcn_cvt_pk_fp8_f32(v[u][j].z * inv, v[u][j].w * inv, w, true); *(unsigned*)(dst + 256 * j) = (unsigned)w; }
                if (c.lane == 0) ((float*)(c.ws + (isv ? WS_VSC : WS_USC)))[e] = m * (1.f / 256.f); } }
    }
#undef F8_LOAD
}
__device__ __forceinline__ void fp8x16_to_f32(const v4u& r, float (&f)[16]) {
    const unsigned w[4] = {r.x, r.y, r.z, r.w};
#pragma unroll
    for (int j = 0; j < 4; ++j) { const f32x2 lo = __builtin_amdgcn_cvt_pk_f32_fp8((int)w[j], false), hi = __builtin_amdgcn_cvt_pk_f32_fp8((int)w[j], true); f[4 * j] = lo.x; f[4 * j + 1] = lo.y; f[4 * j + 2] = hi.x; f[4 * j + 3] = hi.y; }
}
__device__ __forceinline__ unsigned xcc_id() { return (unsigned)__builtin_amdgcn_s_getreg((3 << 11) | 20) & 7u; }

typedef long l64x2 __attribute__((ext_vector_type(2)));
struct E1Bat { l64x2 rw[16]; };
__device__ __forceinline__ void phase_exp1(const Ctx& c) {
    typedef float f32x4m __attribute__((ext_vector_type(4)));
    const int* IDX = (const int*)(c.ws + WS_IDX); const unsigned char* U8 = c.ws + WS_U8; float* PACT = (float*)(c.ws + WS_PACT);
    unsigned* cnt = g_ctl + CW_E1;
    constexpr int CH = 8;
    constexpr int SROW = 144;
    unsigned char* wl = c.lds + c.wave * 14080; int* le = (int*)wl; unsigned char* himg = wl + 4096; float* res = (float*)(wl + 6144); unsigned char* stage = wl + 6656;
    const int xcc = (int)xcc_id(), r16 = c.lane & 15, g4 = c.lane >> 4, row8 = c.lane >> 3, pc8 = c.lane & 7; const bool bcol = r16 < 2;
    unsigned char* rsel = (r16 == 0) ? (unsigned char*)res + 16 * g4 : wl + 13568 + 16 * (c.lane & 3);
    int bo = 0; unsigned tq = 0;
    if (c.lane == 0) tq = __hip_atomic_fetch_add(cnt + 64 * (xcc & 7), (unsigned)CH, __ATOMIC_RELAXED, __HIP_MEMORY_SCOPE_AGENT);
    for (;;) {
        const int x = (xcc + bo) & 7;
        const unsigned t0 = (unsigned)__builtin_amdgcn_readfirstlane((int)tq);
        if (t0 >= (unsigned)ML) { if (++bo >= 8) break; tq = 0; if (c.lane == 0) tq = __hip_atomic_fetch_add(cnt + 64 * ((xcc + bo) & 7), (unsigned)CH, __ATOMIC_RELAXED, __HIP_MEMORY_SCOPE_AGENT); continue; }
        tq = 0; if (c.lane == 0) tq = __hip_atomic_fetch_add(cnt + 64 * x, (unsigned)CH, __ATOMIC_RELAXED, __HIP_MEMORY_SCOPE_AGENT);
        { v4u ee[4], im[2]; float hsc[2];
#pragma unroll
          for (int q = 0; q < 4; ++q) ee[q] = *(const v4u*)(IDX + (size_t)t0 * 128 + 256 * q + 4 * c.lane);
#pragma unroll
          for (int q = 0; q < 2; ++q) { const int p = c.lane + 64 * q; im[q] = *(const v4u*)(c.ws + WS_HX2 + ((size_t)t0 + (p >> 4)) * 2048 + 256 * x + 16 * (p & 15)); hsc[q] = ((const float*)(c.ws + WS_HS))[t0 + (p >> 4)]; }
#pragma unroll
          for (int q = 0; q < 4; ++q) *(v4u*)(le + 256 * q + 4 * c.lane) = ee[q];
#pragma unroll
          for (int q = 0; q < 2; ++q) { const int p = c.lane + 64 * q; const float hs_ = __builtin_amdgcn_rcpf(hsc[q]); const unsigned w4[4] = {im[q].x, im[q].y, im[q].z, im[q].w};
              int f0 = __builtin_amdgcn_cvt_pk_fp8_f32(bflo(w4[0]) * hs_, bfhi(w4[0]) * hs_, 0, false); f0 = __builtin_amdgcn_cvt_pk_fp8_f32(bflo(w4[1]) * hs_, bfhi(w4[1]) * hs_, f0, true);
              int f1 = __builtin_amdgcn_cvt_pk_fp8_f32(bflo(w4[2]) * hs_, bfhi(w4[2]) * hs_, 0, false); f1 = __builtin_amdgcn_cvt_pk_fp8_f32(bflo(w4[3]) * hs_, bfhi(w4[3]) * hs_, f1, true);
              *(v2u*)(himg + (p >> 4) * 128 + 8 * (p & 15)) = (v2u){(unsigned)f0, (unsigned)f1}; } }
        WAVE_LDS_SYNC();
#define E1_LOAD(G, B) do { const int bb = (B) < CH ? (B) : 0; _Pragma("unroll") for (int i = 0; i < 16; ++i) G.rw[i] = *(const l64x2*)(U8 + 128 * x + (((unsigned)le[bb * 128 + 8 * i + row8] << 10) + (unsigned)(16 * pc8))); } while (0)
#define E1_W(G, GI) do { unsigned char* sb_ = stage + ((GI) % 3) * (16 * SROW); *(l64x2*)(sb_ + row8 * SROW + 16 * pc8) = G.rw[2 * (GI)]; *(l64x2*)(sb_ + (8 + row8) * SROW + 16 * pc8) = G.rw[2 * (GI) + 1]; } while (0)
#define E1_R(A01, A23, GI) do { const unsigned char* sb_ = stage + ((GI) % 3) * (16 * SROW); A01 = *(const l64x2*)(sb_ + r16 * SROW + 32 * g4); A23 = *(const l64x2*)(sb_ + r16 * SROW + 32 * g4 + 16); } while (0)
#define E1_COMP(G, B) do { const unsigned char* hb = himg + (B) * 128 + 32 * g4; long bq[4]; _Pragma("unroll") for (int m = 0; m < 4; ++m) { const long v = *(const long*)(hb + 8 * m); bq[m] = r16 == 0 ? v : 0l; } \
            l64x2 a01, a23, n01, n23; \
            E1_W(G, 0); E1_W(G, 1); WAVE_LDS_SYNC(); E1_R(a01, a23, 0); \
            _Pragma("unroll") for (int gi = 0; gi < 8; ++gi) { \
                if (gi + 2 < 8) E1_W(G, gi + 2); \
                WAVE_LDS_SYNC(); \
                if (gi + 1 < 8) E1_R(n01, n23, gi + 1); \
                f32x4m acc = {0.f, 0.f, 0.f, 0.f}; \
                acc = __builtin_amdgcn_mfma_f32_16x16x32_fp8_fp8(a01.x, bq[0], acc, 0, 0, 0); acc = __builtin_amdgcn_mfma_f32_16x16x32_fp8_fp8(a01.y, bq[1], acc, 0, 0, 0); \
                acc = __builtin_amdgcn_mfma_f32_16x16x32_fp8_fp8(a23.x, bq[2], acc, 0, 0, 0); acc = __builtin_amdgcn_mfma_f32_16x16x32_fp8_fp8(a23.y, bq[3], acc, 0, 0, 0); \
                *(f32x4m*)(rsel + gi * 64) = acc;     \
                a01 = n01; a23 = n23; } \
            WAVE_LDS_SYNC(); \
            { unsigned* po = (unsigned*)PACT + (size_t)x * ((size_t)ML * 64) + ((size_t)t0 + (B)) * 64; const f32x2 rr = *(const f32x2*)(res + 2 * c.lane); po[c.lane] = pk2(rr.x, rr.y); }     \
            WAVE_LDS_SYNC(); } while (0)
        E1Bat ga, gb;
        E1_LOAD(ga, 0);
#pragma unroll 1
        for (int b2 = 0; b2 < CH; b2 += 2) {
            E1_LOAD(gb, b2 + 1);
            __builtin_amdgcn_sched_barrier(0);
            E1_COMP(ga, b2);
            __builtin_amdgcn_sched_barrier(0);
            E1_LOAD(ga, b2 + 2);
            __builtin_amdgcn_sched_barrier(0);
            E1_COMP(gb, b2 + 1);
            __builtin_amdgcn_sched_barrier(0);
        }
#undef E1_LOAD
#undef E1_COMP
#undef E1_W
#undef E1_R
    }
}
__device__ __forceinline__ void phase_exp1b(const Ctx& c) {
    const int* IDX = (const int*)(c.ws + WS_IDX); const float* GATE = (const float*)(c.ws + WS_GATE); const float* HS = (const float*)(c.ws + WS_HS); const unsigned* PACT = (const unsigned*)(c.ws + WS_PACT);
    const float* USC = (const float*)(c.ws + WS_USC); const float* VSC = (const float*)(c.ws + WS_VSC); unsigned* ACT = (unsigned*)(c.ws + WS_ACT);
    const size_t NQ = (size_t)ML * 32, stride = (size_t)c.G * NTHREADS;
    for (size_t q0 = (size_t)c.bid * NTHREADS + c.tid; q0 < NQ; q0 += 2 * stride) {
        v2u pv[2][8]; f32x4 gt[2]; float hs[2], us[2][4], vs[2][4]; v4u e[2];
#pragma unroll
        for (int u = 0; u < 2; ++u) { size_t q = q0 + u * stride; q = q < NQ ? q : NQ - 1;
#pragma unroll
            for (int x = 0; x < 8; ++x) pv[u][x] = *(const v2u*)(PACT + (size_t)x * (NQ * 2) + 2 * q);
            e[u] = *(const v4u*)(IDX + 4 * q); gt[u] = *(const f32x4*)(GATE + 4 * q); hs[u] = HS[q >> 5]; }
#pragma unroll
        for (int u = 0; u < 2; ++u) { const unsigned ee[4] = {e[u].x, e[u].y, e[u].z, e[u].w};
#pragma unroll
            for (int j = 0; j < 4; ++j) { us[u][j] = USC[ee[j]]; vs[u][j] = VSC[ee[j]]; } }
#pragma unroll
        for (int u = 0; u < 2; ++u) { const size_t q = q0 + u * stride; float s[4] = {0.f, 0.f, 0.f, 0.f};
#pragma unroll
            for (int x = 0; x < 8; ++x) { s[0] += bflo(pv[u][x].x); s[1] += bfhi(pv[u][x].x); s[2] += bflo(pv[u][x].y); s[3] += bfhi(pv[u][x].y); }
            const float g4[4] = {gt[u].x, gt[u].y, gt[u].z, gt[u].w};
            if (q < NQ) *(v4u*)(ACT + 4 * q) = (v4u){pk2(0.f, gelu_erf(s[0] * hs[u] * us[u][0]) * g4[0] * vs[u][0]) | e[u].x, pk2(0.f, gelu_erf(s[1] * hs[u] * us[u][1]) * g4[1] * vs[u][1]) | e[u].y,
                                                     pk2(0.f, gelu_erf(s[2] * hs[u] * us[u][2]) * g4[2] * vs[u][2]) | e[u].z, pk2(0.f, gelu_erf(s[3] * hs[u] * us[u][3]) * g4[3] * vs[u][3]) | e[u].w}; }
    }
}
__device__ __forceinline__ void phase_exp2(const Ctx& c) {
    const unsigned* ACT = (const unsigned*)(c.ws + WS_ACT); const unsigned char* V8 = c.ws + WS_V8;
    bf16* Y = (bf16*)(c.ws + WS_Y);
    unsigned* cnt = g_ctl + CW_E2;
    unsigned* lp = (unsigned*)(c.lds + c.wave * 1024);
    const int xcc = (int)xcc_id(), sub = c.lane & 7, grp = c.lane >> 3;
    const bool b5 = c.lane & 32, b4 = c.lane & 16, b3 = c.lane & 8;
    constexpr int CH = 8;
    int bo = 0, t = 0, tend = 0;
    unsigned pA = 0, pB = 0;
    unsigned tq = 0; if (c.lane == 0) tq = __hip_atomic_fetch_add(cnt + 64 * (xcc & 7), (unsigned)CH, __ATOMIC_RELAXED, __HIP_MEMORY_SCOPE_AGENT);
    for (;;) {
        if (t >= tend) {
            const unsigned t0 = (unsigned)__builtin_amdgcn_readfirstlane((int)tq);
            if (t0 >= (unsigned)ML) { if (++bo >= 8) break; tq = 0; if (c.lane == 0) tq = __hip_atomic_fetch_add(cnt + 64 * ((xcc + bo) & 7), (unsigned)CH, __ATOMIC_RELAXED, __HIP_MEMORY_SCOPE_AGENT); continue; }
            tq = 0; if (c.lane == 0) tq = __hip_atomic_fetch_add(cnt + 64 * ((xcc + bo) & 7), (unsigned)CH, __ATOMIC_RELAXED, __HIP_MEMORY_SCOPE_AGENT);
            t = (int)t0; tend = t + CH;
            pA = ACT[(size_t)t * 128 + c.lane]; pB = ACT[(size_t)t * 128 + 64 + c.lane];
        }
        const int x = (xcc + bo) & 7;
        lp[c.lane] = pA; lp[64 + c.lane] = pB;
        if (t + 1 < tend) { pA = ACT[(size_t)(t + 1) * 128 + c.lane]; pB = ACT[(size_t)(t + 1) * 128 + 64 + c.lane]; }
        WAVE_LDS_SYNC();
        float acc[16];
#pragma unroll
        for (int q = 0; q < 16; ++q) acc[q] = 0.f;
        { v4u rows[16]; float av[16];
#pragma unroll
          for (int i = 0; i < 16; ++i) { const unsigned p = lp[8 * i + grp]; rows[i] = *(const v4u*)(V8 + x * 128 + (((p & 0xffffu) << 10) + (unsigned)(16 * sub))); av[i] = __uint_as_float(p & 0xffff0000u); }
          asm volatile("" ::: "memory");
#pragma unroll
          for (int i = 0; i < 16; ++i) { float f[16]; fp8x16_to_f32(rows[i], f);
#pragma unroll
              for (int q = 0; q < 16; ++q) acc[q] = fmaf(av[i], f[q], acc[q]); } }
        float q8[8], q4[4], q2[2];
#pragma unroll
        for (int i = 0; i < 8; ++i) { const float keep = b5 ? acc[i + 8] : acc[i], send = b5 ? acc[i] : acc[i + 8]; q8[i] = keep + __shfl_xor(send, 32); }
#pragma unroll
        for (int i = 0; i < 4; ++i) { const float keep = b4 ? q8[i + 4] : q8[i], send = b4 ? q8[i] : q8[i + 4]; q4[i] = keep + __shfl_xor(send, 16); }
#pragma unroll
        for (int i = 0; i < 2; ++i) { const float keep = b3 ? q4[i + 2] : q4[i], send = b3 ? q4[i] : q4[i + 2]; q2[i] = keep + __shfl_xor(send, 8); }
        const int col = x * 128 + 16 * sub + (b5 ? 8 : 0) + (b4 ? 4 : 0) + (b3 ? 2 : 0);
        *(unsigned*)(Y + (size_t)t * D + col) = pk2(q2[0], q2[1]);
        WAVE_LDS_SYNC();
        ++t;
    }
}
__device__ __forceinline__ void phase_exp3(const Ctx& c) {
    const Args& a = *c.a;
    const float* MOD = (const float*)(c.ws + WS_MOD); const bf16* Y = (const bf16*)(c.ws + WS_Y);
    v2u ny[4], nx[4]; f32x4 ngt[4], g4c[4];
#pragma unroll
    for (int j = 0; j < 4; ++j) g4c[j] = *(const f32x4*)(a.in[I_GPOSTFFN] + 4 * c.lane + 256 * j);
#define E3_LOAD(R) do { _Pragma("unroll") for (int j = 0; j < 4; ++j) { const int col = 4 * c.lane + 256 * j; ny[j] = *(const v2u*)(Y + (size_t)(R) * D + col); nx[j] = *(const v2u*)(x1_row(c.ws, (R)) + 2 * col); \
            ngt[j] = *(const f32x4*)(MOD + ((R) >> 11) * 6144 + 5120 + col); } } while (0)
    if (c.gw < ML) E3_LOAD(c.gw);
    for (int row = c.gw; row < ML; row += c.NGW) {
        f32x4 y[4], x1[4], gt[4];
#pragma unroll
        for (int j = 0; j < 4; ++j) { y[j] = (f32x4){bflo(ny[j].x), bfhi(ny[j].x), bflo(ny[j].y), bfhi(ny[j].y)}; x1[j] = (f32x4){bflo(nx[j].x), bfhi(nx[j].x), bflo(nx[j].y), bfhi(nx[j].y)}; gt[j] = ngt[j]; }
        float sq = 0.f;
#pragma unroll
        for (int j = 0; j < 4; ++j) sq += (y[j].x * y[j].x + y[j].y * y[j].y) + (y[j].z * y[j].z + y[j].w * y[j].w);
        const float tot = wsum(sq);
        if (row + c.NGW < ML) E3_LOAD(row + c.NGW);
        const float r = rsqrtf(tot * (1.f / D) + EPS);
#pragma unroll
        for (int j = 0; j < 4; ++j) { const int col = 4 * c.lane + 256 * j;
            *(f32x4*)(a.out + (size_t)row * D + col) = x1[j] + gt[j] * ((y[j] * r) * g4c[j]); }
    }
#undef E3_LOAD
}

constexpr int S5_LPOW = 0, S5_BBAR = 33792, S5_CC = 50176, S5_MM = 66560;
template <int MODE> __device__ __forceinline__ void s5_build_group(const Ctx& c, int g, int part) {
    const Args& a = *c.a;
    f32x2* LPOW = (f32x2*)(c.lds + S5_LPOW);
    f32x2* BBAR = (f32x2*)(c.lds + S5_BBAR);
    f32x2* CC = (f32x2*)(c.lds + S5_CC);
    float* MM = (float*)(c.lds + S5_MM);
    __syncthreads();
    { const int dir = (c.tid >> 6) & 1, p = c.tid & 63, eq = c.tid >> 7, dg = dir * 32 + g;
        const float dt = expf(a.in[I_LOGDT][dg]), lr = a.in[I_LAMRE][dg * 64 + p], li = a.in[I_LAMIM][dg * 64 + p];
        const f32x4 br4 = *(const f32x4*)(a.in[I_BRE] + (size_t)(dg * 64 + p) * 16 + 4 * eq), bi4 = *(const f32x4*)(a.in[I_BIM] + (size_t)(dg * 64 + p) * 16 + 4 * eq);
        const double ang = (double)li * (double)dt; const float lrdt = lr * dt;
        for (int e = eq; e <= 32; e += 4) { float sn, cs; sincos_d(ang * (double)e, sn, cs); const float mg = expf(lrdt * (float)e); LPOW[(dir * 33 + e) * 64 + p] = (f32x2){mg * cs, mg * sn}; }
        float sn, cs; sincos_d(ang, sn, cs); const float mag = expf(lrdt), lbr = mag * cs, lbi = mag * sn, den = lr * lr + li * li, nr = lbr - 1.f;
        const float cr = (nr * lr + lbi * li) / den, ci = (lbi * lr - nr * li) / den;
#pragma unroll
        for (int q = 0; q < 4; ++q) { const float br = br4[q], bi = bi4[q]; BBAR[(dir * 64 + p) * 16 + 4 * eq + q] = (f32x2){cr * br - ci * bi, cr * bi + ci * br}; } }
    if (MODE == 1) { float cre[4], cim[4];
#pragma unroll
        for (int q = 0; q < 4; ++q) { const int i = c.tid + NTHREADS * q, dir = i >> 10, ch = (i >> 6) & 15, p = i & 63, dg = dir * 32 + g; cre[q] = a.in[I_CRE][(size_t)(dg * 16 + ch) * 64 + p]; cim[q] = a.in[I_CIM][(size_t)(dg * 16 + ch) * 64 + p]; }
#pragma unroll
        for (int q = 0; q < 4; ++q) CC[c.tid + NTHREADS * q] = (f32x2){cre[q], cim[q]}; }
    __syncthreads();
    if (MODE == 1) { typedef float f32x4m __attribute__((ext_vector_type(4)));
      const int mn = c.lane & 15, kq = c.lane >> 4, n0 = 8 * part + 8;
      float are[16], aim[16]; f32x2 bb[16]; int curdir = -1;
#pragma unroll 1
      for (int j = 0; j < 5; ++j) { const int q = c.wave + 8 * j, dir = q >= n0 ? 1 : 0, lag = dir ? q - n0 : q;
          if (dir != curdir) { curdir = dir;
#pragma unroll
              for (int t = 0; t < 16; ++t) { const f32x2 cv = CC[(dir * 16 + mn) * 64 + 4 * t + kq]; are[t] = cv.x; aim[t] = -cv.y; bb[t] = BBAR[(dir * 64 + 4 * t + kq) * 16 + mn]; } }
          f32x4m acc = {0.f, 0.f, 0.f, 0.f}, acc2 = {0.f, 0.f, 0.f, 0.f};
          f32x2 l[16];
#pragma unroll
          for (int t = 0; t < 16; ++t) l[t] = LPOW[(dir * 33 + lag) * 64 + 4 * t + kq];
#pragma unroll
          for (int t = 0; t < 16; ++t) { acc = __builtin_amdgcn_mfma_f32_16x16x4f32(are[t], l[t].x * bb[t].x - l[t].y * bb[t].y, acc, 0, 0, 0);
              acc2 = __builtin_amdgcn_mfma_f32_16x16x4f32(aim[t], l[t].x * bb[t].y + l[t].y * bb[t].x, acc2, 0, 0, 0); }
#pragma unroll
          for (int qq = 0; qq < 4; ++qq) MM[((dir * 32 + lag) * 16 + 4 * kq + qq) * 16 + mn] = acc[qq] + acc2[qq]; } }
    __syncthreads();
    if (MODE == 0 && c.tid < 128 && part == 0) { const int dir = c.tid >> 6, p = c.tid & 63; ((f32x2*)(c.ws + WS_LP))[(dir * 32 + g) * 64 + p] = LPOW[(dir * 33 + 32) * 64 + p]; }
    bf16* PMg = (bf16*)(c.ws + WS_PM) + (size_t)g * 256 * 512; bf16* BBg = (bf16*)(c.ws + WS_BB) + (size_t)g * 512 * 768;
    if (MODE == 0) for (int task = part * 64 * 32 + c.tid; task < (part + 1) * 64 * 32; task += NTHREADS) { const int ip = task & 31, n = task >> 5, dir = n >> 7, im = (n >> 6) & 1, p = n & 63, e = dir ? ip : 31 - ip;
        const f32x2 l = LPOW[(dir * 33 + e) * 64 + p]; float o[16];
#pragma unroll
        for (int ch = 0; ch < 16; ++ch) { const f32x2 bb = BBAR[(dir * 64 + p) * 16 + ch]; o[ch] = im ? (l.x * bb.y + l.y * bb.x) : (l.x * bb.x - l.y * bb.y); }
        v4u w0, w1; w0.x = pk2(o[0], o[1]); w0.y = pk2(o[2], o[3]); w0.z = pk2(o[4], o[5]); w0.w = pk2(o[6], o[7]); w1.x = pk2(o[8], o[9]); w1.y = pk2(o[10], o[11]); w1.z = pk2(o[12], o[13]); w1.w = pk2(o[14], o[15]);
        *(v4u*)(PMg + (size_t)n * 512 + ip * 16) = w0; *(v4u*)(PMg + (size_t)n * 512 + ip * 16 + 8) = w1; }
    if (MODE == 0) return;
    const float dskv = a.in[I_S5D][g * 16 + ((c.tid >> 5) & 15)];
    for (int task = part * 128 * 32 + c.tid; task < (part + 1) * 128 * 32; task += NTHREADS) { const int ip = task & 31, n = task >> 5, i = n >> 4, ch = n & 15; float o[16];
#pragma unroll
        for (int q = 0; q < 16; ++q) o[q] = 0.f;
        if (ip <= i) { const float* m0 = MM + ((0 * 32 + (i - ip)) * 16 + ch) * 16;
#pragma unroll
            for (int q = 0; q < 16; ++q) o[q] += m0[q]; }
        if (ip >= i) { const float* m1 = MM + ((1 * 32 + (ip - i)) * 16 + ch) * 16;
#pragma unroll
            for (int q = 0; q < 16; ++q) o[q] += m1[q]; }
        if (ip == i) { const float dsk = dskv;
#pragma unroll
            for (int q = 0; q < 16; ++q) o[q] += (q == ch) ? dsk : 0.f; }
        v4u w0, w1; w0.x = pk2(o[0], o[1]); w0.y = pk2(o[2], o[3]); w0.z = pk2(o[4], o[5]); w0.w = pk2(o[6], o[7]); w1.x = pk2(o[8], o[9]); w1.y = pk2(o[10], o[11]); w1.z = pk2(o[12], o[13]); w1.w = pk2(o[14], o[15]);
        *(v4u*)(BBg + (size_t)n * 768 + ip * 16) = w0; *(v4u*)(BBg + (size_t)n * 768 + ip * 16 + 8) = w1; }
    for (int task = part * 128 * 32 + c.tid; task < (part + 1) * 128 * 32; task += NTHREADS) { const int p8 = task & 7, part = (task >> 3) & 3, n = task >> 5, i = n >> 4, ch = n & 15, dir = part >> 1, im = part & 1, e = dir ? 32 - i : i + 1; float o[8];
#pragma unroll
        for (int q = 0; q < 8; ++q) { const int p = p8 * 8 + q; const f32x2 l = LPOW[(dir * 33 + e) * 64 + p], cc = CC[(dir * 16 + ch) * 64 + p]; o[q] = im ? -(cc.x * l.y + cc.y * l.x) : (cc.x * l.x - cc.y * l.y); }
        v4u w0; w0.x = pk2(o[0], o[1]); w0.y = pk2(o[2], o[3]); w0.z = pk2(o[4], o[5]); w0.w = pk2(o[6], o[7]);
        *(v4u*)(BBg + (size_t)n * 768 + 512 + part * 64 + p8 * 8) = w0; }
}
__device__ __forceinline__ void s5_state_scan(const Ctx& c, int task) {
    const int dir = task & 1, g = (task >> 1) & 31, b = task >> 6, p = c.lane;
    const f32x2 a = ((const f32x2*)(c.ws + WS_LP))[(dir * 32 + g) * 64 + p];
    const float* SS = (const float*)(c.ws + WS_SS) + (size_t)g * 768 * 256 + dir * 128 + p; bf16* U5 = (bf16*)(c.ws + WS_U5) + (size_t)g * 768 * 768 + 512 + dir * 128 + p;
    float er = 0.f, ei = 0.f;
#pragma unroll 1
    for (int s0 = 0; s0 < 72; s0 += 24) {
        float sr[24], si[24];
#pragma unroll
        for (int u = 0; u < 24; ++u) { const int step = s0 + u; const int R = (step < 8) ? 512 + b * 8 + (dir ? 7 - step : step) : b * 64 + (dir ? 71 - step : step - 8);
            sr[u] = SS[(size_t)R * 256]; si[u] = SS[(size_t)R * 256 + 64]; }
#pragma unroll
        for (int u = 0; u < 24; ++u) { const int step = s0 + u; const int R = (step < 8) ? 512 + b * 8 + (dir ? 7 - step : step) : b * 64 + (dir ? 71 - step : step - 8);
            if (step >= 8) { U5[(size_t)R * 768] = (bf16)f2bf(er); U5[(size_t)R * 768 + 64] = (bf16)f2bf(ei); }
            const float nr = sr[u] + a.x * er - a.y * ei, ni = si[u] + a.x * ei + a.y * er; er = nr; ei = ni; }
    }
}

constexpr int GDN_NCH = 36, GDN_ITEMS = NB * 4 * 2 * GDN_NCH;
constexpr size_t FR_T_BYTES = 8192, FR_ATT_BYTES = 8192, FR_KD_BYTES = 16384, FR_TAB_BYTES = 1024;
__device__ __forceinline__ int crow16(int i, int hh) { return (i & 3) + 8 * (i >> 2) + 4 * hh; }
__device__ __forceinline__ bf16x8 pack_step(const f32x16& x, int s) {
    v4u w; w.x = pk2(x[8 * s + 0], x[8 * s + 1]); w.y = pk2(x[8 * s + 2], x[8 * s + 3]); w.z = pk2(x[8 * s + 4], x[8 * s + 5]); w.w = pk2(x[8 * s + 6], x[8 * s + 7]);
    return __builtin_bit_cast(bf16x8, w);
}
__device__ __forceinline__ unsigned pk2v(float lo, float hi) { asm volatile("" : "+v"(lo), "+v"(hi)); return pk2(lo, hi); }
__device__ __forceinline__ bf16x8 pack_step_v(const f32x16& x, int s) {
    v4u w; w.x = pk2v(x[8 * s + 0], x[8 * s + 1]); w.y = pk2v(x[8 * s + 2], x[8 * s + 3]); w.z = pk2v(x[8 * s + 4], x[8 * s + 5]); w.w = pk2v(x[8 * s + 6], x[8 * s + 7]);
    return __builtin_bit_cast(bf16x8, w);
}
constexpr int GP_KR = 0, GP_QR = 17408, GP_KT = 34816, GP_TAB = 53248, GP_LP = 54272, GP_LPB = 8448 + 256;
__host__ __device__ constexpr int LOFF(int i) { return i < 1 ? 0 : 4 * (((i - 1) >> 2) + 1) * (2 * ((i - 1) >> 2) + ((i - 1) & 3)); }
static_assert(LOFF(1) == 0 && LOFF(2) == 4 && LOFF(5) == 16 && LOFF(6) == 24 && LOFF(64) == 2112, "packed lower-triangular row offsets");
struct GpPre { v4u q0, q1, k0, k1; float g, beta; };
__device__ __forceinline__ void gdn_prep_load(const Ctx& c, int item, GpPre& p) {
    const int n = item % GDN_NCH, bhd = item / GDN_NCH, dir = bhd & 1, h = (bhd >> 1) & 3, b = bhd >> 3;
    const bf16* QKV = (const bf16*)(c.ws + WS_QKV); const float* GB = (const float*)(c.ws + WS_GB);
    const int s = c.tid >> 3, seg = c.tid & 7; const bf16* rp = QKV + (size_t)scan_row(b, dir, n * 64 + s) * 1536 + h * 128 + seg * 16;
    p.q0 = *(const v4u*)rp; p.q1 = *(const v4u*)(rp + 8); p.k0 = *(const v4u*)(rp + 512); p.k1 = *(const v4u*)(rp + 520);
    const size_t rl = (size_t)scan_row(b, dir, n * 64 + c.lane) * 16 + dir * 4 + h; p.g = GB[rl]; p.beta = GB[rl + 8];
}
__device__ __forceinline__ void gdn_prep_stage(const Ctx& c, int item, int item_next, float* Lp, GpPre& p) {
    bf16* Kr = (bf16*)(c.lds + GP_KR); bf16* Qr = (bf16*)(c.lds + GP_QR); bf16* Kt = (bf16*)(c.lds + GP_KT); float* tab = (float*)(c.lds + GP_TAB);
    unsigned char* frA = c.ws + WS_FRA + (size_t)item * FR_ATT_BYTES; unsigned char* frK = c.ws + WS_FRK + (size_t)item * FR_KD_BYTES; float* frTab = (float*)(c.ws + WS_FRTAB + (size_t)item * FR_TAB_BYTES);
    const int r = c.lane & 31, hh = c.lane >> 5;
    if (c.wave == 0) { float g = p.g; const float beta = p.beta;
#pragma unroll
        for (int o = 1; o < 64; o <<= 1) { const float t = __shfl_up(g, o); if (c.lane >= o) g += t; }
        const float gl = __shfl(g, 63);
        tab[c.lane] = g; tab[64 + c.lane] = beta; tab[128 + c.lane] = __expf(g); tab[192 + c.lane] = __expf(gl - g); }
    { const int s = c.tid >> 3, seg = c.tid & 7;
      const v4u q0 = p.q0, q1 = p.q1, k0 = p.k0, k1 = p.k1;
      gdn_prep_load(c, item_next, p);
      *(v4u*)(Qr + s * 136 + seg * 16) = q0; *(v4u*)(Qr + s * 136 + seg * 16 + 8) = q1; *(v4u*)(Kr + s * 136 + seg * 16) = k0; *(v4u*)(Kr + s * 136 + seg * 16 + 8) = k1;
      const unsigned kw[8] = {k0.x, k0.y, k0.z, k0.w, k1.x, k1.y, k1.z, k1.w};
#pragma unroll
      for (int e = 0; e < 8; ++e) { Kt[(seg * 16 + 2 * e) * 72 + s] = (bf16)(kw[e] & 0xffffu); Kt[(seg * 16 + 2 * e + 1) * 72 + s] = (bf16)(kw[e] >> 16); } }
    __syncthreads();
    if (c.wave < 3) { const int ct = c.wave ? 1 : 0, st = c.wave == 2 ? 1 : 0;
        f32x16 acc;
#pragma unroll
        for (int i = 0; i < 16; ++i) acc[i] = 0.f;
#pragma unroll
        for (int kk = 0; kk < 8; ++kk) { const bf16x8 a = *(const bf16x8*)(Kr + (ct * 32 + r) * 136 + kk * 16 + hh * 8), bb = *(const bf16x8*)(Kr + (st * 32 + r) * 136 + kk * 16 + hh * 8); acc = MFMA32(a, bb, acc); }
        const int s = st * 32 + r; const float gcs = tab[s];
#pragma unroll
        for (int i = 0; i < 16; ++i) { const int cc = ct * 32 + crow16(i, hh); if (s < cc) Lp[LOFF(cc) + s] = tab[64 + cc] * acc[i] * __expf(tab[cc] - gcs); }
    } else if (c.wave < 6) { const int w = c.wave - 3, st = w == 2 ? 1 : 0, ct = w ? 1 : 0;
        f32x16 acc;
#pragma unroll
        for (int i = 0; i < 16; ++i) acc[i] = 0.f;
#pragma unroll
        for (int kk = 0; kk < 8; ++kk) { const bf16x8 a = *(const bf16x8*)(Kr + (st * 32 + r) * 136 + kk * 16 + hh * 8), bb = *(const bf16x8*)(Qr + (ct * 32 + r) * 136 + kk * 16 + hh * 8); acc = MFMA32(a, bb, acc); }
        const int cc = ct * 32 + r; const float gcc = tab[cc];
#pragma unroll
        for (int i = 0; i < 16; ++i) { const int s = st * 32 + crow16(i, hh); acc[i] = (s <= cc) ? acc[i] * __expf(gcc - tab[s]) : 0.f; }
        *(bf16x8*)(frA + ((size_t)((ct * 4 + 2 * st) * 64 + c.lane)) * 16) = pack_step(acc, 0);
        *(bf16x8*)(frA + ((size_t)((ct * 4 + 2 * st + 1) * 64 + c.lane)) * 16) = pack_step(acc, 1);
    } else { const int w = c.wave - 6;
#pragma unroll
        for (int f = 0; f < 8; ++f) { const int fi = w * 8 + f, dkt = fi >> 2, cb = fi & 3; const bf16* kp = Kt + (dkt * 32 + r) * 72 + 16 * cb + 4 * hh;
            const v2u lo = *(const v2u*)kp, hi = *(const v2u*)(kp + 8); const f32x4 e0 = *(const f32x4*)(tab + 192 + 16 * cb + 4 * hh), e1 = *(const f32x4*)(tab + 192 + 16 * cb + 8 + 4 * hh);
            v4u o; o.x = pk2(bflo(lo.x) * e0.x, bfhi(lo.x) * e0.y); o.y = pk2(bflo(lo.y) * e0.z, bfhi(lo.y) * e0.w); o.z = pk2(bflo(hi.x) * e1.x, bfhi(hi.x) * e1.y); o.w = pk2(bflo(hi.y) * e1.z, bfhi(hi.y) * e1.w);
            *(v4u*)(frK + ((size_t)(fi * 64 + c.lane)) * 16) = o; }
        if (w == 0) { const v4u z = (v4u){0u, 0u, 0u, 0u}; *(v4u*)(frA + ((size_t)((0 * 4 + 2) * 64 + c.lane)) * 16) = z; *(v4u*)(frA + ((size_t)((0 * 4 + 3) * 64 + c.lane)) * 16) = z; }
        else { *(f32x4*)(frTab + 4 * c.lane) = *(const f32x4*)(tab + 4 * c.lane); }
    }
    __syncthreads();
}
__device__ __forceinline__ int loff_rt(int i) { return i < 1 ? 0 : 4 * (((i - 1) >> 2) + 1) * (2 * ((i - 1) >> 2) + ((i - 1) & 3)); }
__device__ __forceinline__ void gdn_prep_solve(const Ctx& c, int item, float* Lp) {
    const int r = c.lane & 31, hh = c.lane >> 5;
    { float Tr[32];
#pragma unroll
      for (int i = 0; i < 32; ++i) { int je = r, bl = hh; asm volatile("" : "+v"(je), "+v"(bl)); float a0 = (je == i) ? 1.f : 0.f, a1 = 0.f;
          const int ro = bl ? LOFF(32 + i) + 32 : LOFF(i);
#pragma unroll
          for (int s4 = 0; s4 < (i + 3) / 4; ++s4) { const f32x4 l4 = *(const f32x4*)(Lp + ro + 4 * s4);
              if (4 * s4 + 0 < i) a0 = fmaf(-l4.x, Tr[4 * s4 + 0], a0); if (4 * s4 + 1 < i) a1 = fmaf(-l4.y, Tr[4 * s4 + 1], a1); if (4 * s4 + 2 < i) a0 = fmaf(-l4.z, Tr[4 * s4 + 2], a0); if (4 * s4 + 3 < i) a1 = fmaf(-l4.w, Tr[4 * s4 + 3], a1); }
          Tr[i] = a0 + a1; Lp[(je < i) ? ro + je : 2112 + 32 * bl + je] = Tr[i]; } }
    WAVE_LDS_SYNC();
    { const int offA = loff_rt(32 + r);
      f32x16 X;
#pragma unroll
      for (int i = 0; i < 16; ++i) X[i] = 0.f;
#pragma unroll
      for (int q = 0; q < 4; ++q) { const f32x4 a4 = *(const f32x4*)(Lp + offA + 16 * hh + 4 * q);
#pragma unroll
          for (int e = 0; e < 4; ++e) { const int kk = 4 * q + e; int hq = hh; asm volatile("" : "+v"(hq)); const int k = 16 * hq + kk;
              const float t = Lp[(hq ? LOFF(16 + kk) : LOFF(kk)) + r]; const float b = (r < k) ? t : (r == k ? 1.f : 0.f);
              X = __builtin_amdgcn_mfma_f32_32x32x2f32(a4[e], b, X, 0, 0, 0); } }
      f32x16 Y;
#pragma unroll
      for (int i = 0; i < 16; ++i) Y[i] = 0.f;
#pragma unroll
      for (int q = 0; q < 4; ++q) { const int k0 = 8 * q + 4 * hh; const f32x4 t4 = *(const f32x4*)(Lp + offA + 32 + k0);
#pragma unroll
          for (int e = 0; e < 4; ++e) { const int kq = k0 + e; const float av = (kq < r) ? t4[e] : (kq == r ? 1.f : 0.f);
              Y = __builtin_amdgcn_mfma_f32_32x32x2f32(av, X[4 * q + e], Y, 0, 0, 0); } }
#pragma unroll
      for (int i = 0; i < 16; ++i) { int hq = hh; asm volatile("" : "+v"(hq)); const int cb = (i & 3) + 8 * (i >> 2);
          Lp[(hq ? LOFF(32 + cb + 4) : LOFF(32 + cb)) + r] = -Y[i]; } }
    WAVE_LDS_SYNC();
    unsigned char* frT = c.ws + WS_FRT + (size_t)item * FR_T_BYTES;
#pragma unroll
    for (int f = 0; f < 8; ++f) { const int ct = f >> 2, sb = f & 3, cc = ct * 32 + r; float v[8];
#pragma unroll
        for (int q = 0; q < 2; ++q) { const int s0 = 16 * sb + 8 * q + 4 * hh;
            f32x4 t4 = (f32x4){0.f, 0.f, 0.f, 0.f}; if (s0 < cc) t4 = *(const f32x4*)(Lp + LOFF(cc) + s0);
            v[4 * q + 0] = (s0 + 0 < cc) ? t4.x : (s0 + 0 == cc ? 1.f : 0.f); v[4 * q + 1] = (s0 + 1 < cc) ? t4.y : (s0 + 1 == cc ? 1.f : 0.f);
            v[4 * q + 2] = (s0 + 2 < cc) ? t4.z : (s0 + 2 == cc ? 1.f : 0.f); v[4 * q + 3] = (s0 + 3 < cc) ? t4.w : (s0 + 3 == cc ? 1.f : 0.f); }
        *(v4u*)(frT + ((size_t)(f * 64 + c.lane)) * 16) = (v4u){pk2(v[0], v[1]), pk2(v[2], v[3]), pk2(v[4], v[5]), pk2(v[6], v[7])}; }
}
__device__ __forceinline__ void phase_gdn_prep(const Ctx& c) {
    const int nit = c.bid < GDN_ITEMS ? (GDN_ITEMS - 1 - c.bid) / c.G + 1 : 0;
    bool scanned = false;
    if (nit > 0) {
        GpPre p; gdn_prep_load(c, c.bid, p);
#pragma unroll 1
        for (int j = 0; j < nit; ++j) { const int item = c.bid + j * c.G, q = j & 7; int nx = item + c.G; nx = nx < GDN_ITEMS ? nx : item;
            gdn_prep_stage(c, item, nx, (float*)(c.lds + GP_LP + q * GP_LPB), p);
            if (q == 7 || j == nit - 1) { const int cnt = q + 1;
                if (c.wave < cnt) gdn_prep_solve(c, c.bid + ((j & ~7) + c.wave) * c.G, (float*)(c.lds + GP_LP + c.wave * GP_LPB));
                else if (j == nit - 1) { for (int t = c.bid + (c.wave - cnt) * c.G; t < 512; t += (8 - cnt) * c.G) s5_state_scan(c, t); }
                if (j == nit - 1 && cnt < 8) scanned = true;
                __syncthreads(); } }
    }
    if (!scanned) for (int t = c.bid + c.wave * c.G; t < 512; t += 8 * c.G) s5_state_scan(c, t);
}

constexpr int GR_K = 0, GR_Q = 16384, GR_T = 32768, GR_A = 40960, GR_KD = 49152, GR_TAB = 65536, GR_V = 66560, GR_BUF = 74752;
static_assert(2 * GR_BUF + 64 <= LDS_BYTES, "recurrence buffers");
__device__ __forceinline__ void gdn_rec_fetch(const Ctx& c, int bhd, int dvhalf, int n, v4u (&st)[19]) {
    const int dir = bhd & 1, h = (bhd >> 1) & 3, b = bhd >> 3, lw = c.wave - 4; const int item = bhd * GDN_NCH + n;
    int ln = c.lane; asm volatile("" : "+v"(ln));
    const unsigned char* QKVb = c.ws + WS_QKV;
#pragma unroll
    for (int q = 0; q < 4; ++q) { const int qi = lw + 4 * q;
        const int s = 4 * qi + (ln >> 4), ps = ln & 15, p = ps ^ (s & 15); const size_t rowb = (size_t)scan_row(b, dir, n * 64 + s) * 3072 + (size_t)h * 256 + p * 16;
        st[2 * q] = *(const v4u*)(QKVb + rowb + 1024); st[2 * q + 1] = *(const v4u*)(QKVb + rowb); }
    const unsigned char* frT = c.ws + WS_FRT + (size_t)item * FR_T_BYTES; const unsigned char* frA = c.ws + WS_FRA + (size_t)item * FR_ATT_BYTES; const unsigned char* frK = c.ws + WS_FRK + (size_t)item * FR_KD_BYTES;
#pragma unroll
    for (int q = 0; q < 2; ++q) { const int qi = lw + 4 * q; st[8 + 2 * q] = *(const v4u*)(frT + qi * 1024 + ln * 16); st[9 + 2 * q] = *(const v4u*)(frA + qi * 1024 + ln * 16); }
#pragma unroll
    for (int q = 0; q < 4; ++q) { const int qi = lw + 4 * q; st[12 + q] = *(const v4u*)(frK + qi * 1024 + ln * 16); }
    st[16] = *(const v4u*)(c.ws + WS_FRTAB + (size_t)item * FR_TAB_BYTES + ln * 16);
#pragma unroll
    for (int q = 0; q < 2; ++q) { const int qi = lw + 4 * q, s = 8 * qi + (ln >> 3);
        st[17 + q] = *(const v4u*)(QKVb + (size_t)scan_row(b, dir, n * 64 + s) * 3072 + 2048 + (size_t)h * 256 + dvhalf * 128 + (ln & 7) * 16); }
}
__device__ __forceinline__ void gdn_rec_put(const Ctx& c, int buf, const v4u (&st)[19]) {
    const int lw = c.wave - 4; unsigned char* base = c.lds + buf * GR_BUF + c.lane * 16;
#pragma unroll
    for (int q = 0; q < 4; ++q) { const int qi = lw + 4 * q; *(v4u*)(base + GR_K + qi * 1024) = st[2 * q]; *(v4u*)(base + GR_Q + qi * 1024) = st[2 * q + 1]; }
#pragma unroll
    for (int q = 0; q < 2; ++q) { const int qi = lw + 4 * q; *(v4u*)(base + GR_T + qi * 1024) = st[8 + 2 * q]; *(v4u*)(base + GR_A + qi * 1024) = st[9 + 2 * q]; }
#pragma unroll
    for (int q = 0; q < 4; ++q) { const int qi = lw + 4 * q; *(v4u*)(base + GR_KD + qi * 1024) = st[12 + q]; }
    if (lw == 0) *(v4u*)(base + GR_TAB) = st[16];
#pragma unroll
    for (int q = 0; q < 2; ++q) { const int qi = lw + 4 * q; *(v4u*)(base + GR_V + qi * 1024) = st[17 + q]; }
}
__device__ __forceinline__ bf16x8 gr_rowfrag(const unsigned char* rowp, const int (&po)[16], int kb) {
    const v2u lo = *(const v2u*)(rowp + po[2 * kb]), hi = *(const v2u*)(rowp + po[2 * kb + 1]);
    return __builtin_bit_cast(bf16x8, (v4u){lo.x, lo.y, hi.x, hi.y});
}
__device__ __forceinline__ void gdn_rec_block(const Ctx& c, int bhd, int dvhalf) {
    const int dir = bhd & 1, h = (bhd >> 1) & 3, b = bhd >> 3, r = c.lane & 31, hh = c.lane >> 5, dvt = 2 * dvhalf + (c.wave & 1);
    const bf16* QKV = (const bf16*)(c.ws + WS_QKV); bf16* OG = (bf16*)(c.ws + WS_OG) + (size_t)dir * ML * 512;
    f32x16 S[4];
#pragma unroll
    for (int t = 0; t < 4; ++t)
#pragma unroll
        for (int i = 0; i < 16; ++i) S[t][i] = 0.f;
    int po[16];
#pragma unroll
    for (int p = 0; p < 16; ++p) po[p] = r * 256 + ((p ^ (r & 15)) * 16) + 8 * hh;
#define GR_STEP_BARRIER() do { asm volatile("s_waitcnt lgkmcnt(0)" ::: "memory"); __builtin_amdgcn_s_barrier(); asm volatile("" ::: "memory"); } while (0)
    if (c.wave >= 4) {
        v4u st[19];
        gdn_rec_fetch(c, bhd, dvhalf, 0, st); gdn_rec_put(c, 0, st); gdn_rec_fetch(c, bhd, dvhalf, 1, st);
        GR_STEP_BARRIER();
#pragma unroll 1
        for (int n = 0; n < GDN_NCH; ++n) {
            if (n + 1 < GDN_NCH) gdn_rec_put(c, (n + 1) & 1, st);
            { const int nn = n + 2 < GDN_NCH ? n + 2 : GDN_NCH - 1; gdn_rec_fetch(c, bhd, dvhalf, nn, st); }
            GR_STEP_BARRIER(); }
    } else if (c.wave >= 2) {
        GR_STEP_BARRIER();
#pragma unroll 1
        for (int n = 0; n < GDN_NCH; ++n) GR_STEP_BARRIER();
    } else {
    GR_STEP_BARRIER();
#define GR_FENCE() asm volatile("" ::: "memory")
#define GR_LOADROW(F, AREA, T8) do { _Pragma("unroll") for (int kb = 0; kb < 8; ++kb) F[kb] = gr_rowfrag(base + (AREA) + (T8) * 8192, po, kb); } while (0)
#define GR_FRAG(AREA, IDX) (*(const bf16x8*)(base + (AREA) + ((IDX) * 64 + c.lane) * 16))
#define GR_LOADV(DST, ST) do { _Pragma("unroll") for (int i = 0; i < 16; ++i) DST[i] = vl[((ST) * 32 + (i & 3) + 8 * (i >> 2)) * 64]; } while (0)
    for (int n = 0; n < GDN_NCH; ++n) {
        const int buf = n & 1;
        {
            const unsigned char* base = c.lds + buf * GR_BUF; const float* tab = (const float*)(base + GR_TAB);
            const int row0 = scan_row(b, dir, n * 64), sgn = dir ? -1 : 1;
            const bf16* vl = (const bf16*)(base + GR_V) + (4 * hh) * 64 + (c.wave & 1) * 32 + r;
            const unsigned ob = (unsigned)(((row0 + sgn * 4 * hh) * 512 + h * 128 + dvt * 32 + r) * 2); const int ostb = sgn * 1024;
            bf16x8 fr[3][4], tf[6]; bf16 vv[16];
            bf16x8 Rf[2][2], Vf[2][2];
            unsigned oK0 = GR_K, oK1 = GR_K + 8192, oQ0 = GR_Q, oQ1 = GR_Q + 8192; asm volatile("" : "+v"(oK0), "+v"(oK1), "+v"(oQ0), "+v"(oQ1));
#define GR_LD4(SLOT, KB) do { fr[SLOT][0] = gr_rowfrag(base + oK0, po, KB); fr[SLOT][1] = gr_rowfrag(base + oK1, po, KB); fr[SLOT][2] = gr_rowfrag(base + oQ0, po, KB); fr[SLOT][3] = gr_rowfrag(base + oQ1, po, KB); } while (0)
            GR_LD4(0, 0); GR_LD4(1, 1); GR_FENCE();
            f32x16 acc0, acc1, aq0, aq1;
#pragma unroll
            for (int i = 0; i < 16; ++i) { acc0[i] = 0.f; acc1[i] = 0.f; aq0[i] = 0.f; aq1[i] = 0.f; }
#pragma unroll
            for (int kb = 0; kb < 8; ++kb) {
                if (kb + 2 < 8) GR_LD4((kb + 2) % 3, kb + 2);
                else if (kb == 6) { tf[0] = GR_FRAG(GR_T, 0); tf[1] = GR_FRAG(GR_T, 1); tf[2] = GR_FRAG(GR_T, 4); tf[3] = GR_FRAG(GR_T, 5); tf[4] = GR_FRAG(GR_T, 6); tf[5] = GR_FRAG(GR_T, 7); }
                GR_FENCE();
                const bf16x8 sp = pack_step(S[kb >> 1], kb & 1);
                acc0 = MFMA32(fr[kb % 3][0], sp, acc0); acc1 = MFMA32(fr[kb % 3][1], sp, acc1); aq0 = MFMA32(fr[kb % 3][2], sp, aq0); aq1 = MFMA32(fr[kb % 3][3], sp, aq1); }
            GR_LOADV(vv, 0); GR_FENCE();
#pragma unroll
            for (int i = 0; i < 16; ++i) { const int s = crow16(i, hh); acc0[i] = tab[64 + s] * (bf1(vv[i]) - tab[128 + s] * acc0[i]); }
            Rf[0][0] = pack_step(acc0, 0); Rf[0][1] = pack_step(acc0, 1);
            GR_LOADV(vv, 1); GR_FENCE();
#pragma unroll
            for (int i = 0; i < 16; ++i) { const int s = 32 + crow16(i, hh); acc1[i] = tab[64 + s] * (bf1(vv[i]) - tab[128 + s] * acc1[i]); }
            Rf[1][0] = pack_step(acc1, 0); Rf[1][1] = pack_step(acc1, 1);
#pragma unroll
            for (int i = 0; i < 16; ++i) { acc0[i] = 0.f; acc1[i] = 0.f; }
            acc1 = MFMA32(tf[2], Rf[0][0], acc1); acc0 = MFMA32(tf[0], Rf[0][0], acc0); acc1 = MFMA32(tf[3], Rf[0][1], acc1); acc0 = MFMA32(tf[1], Rf[0][1], acc0);
            acc1 = MFMA32(tf[4], Rf[1][0], acc1); acc1 = MFMA32(tf[5], Rf[1][1], acc1);
            tf[0] = GR_FRAG(GR_A, 0); tf[1] = GR_FRAG(GR_A, 1); tf[2] = GR_FRAG(GR_A, 4); tf[3] = GR_FRAG(GR_A, 5); tf[4] = GR_FRAG(GR_A, 6); tf[5] = GR_FRAG(GR_A, 7); GR_FENCE();
#pragma unroll
            for (int i = 0; i < 16; ++i) { aq0[i] *= tab[128 + crow16(i, hh)]; aq1[i] *= tab[128 + 32 + crow16(i, hh)]; }
            Vf[0][0] = pack_step(acc0, 0); Vf[0][1] = pack_step(acc0, 1); Vf[1][0] = pack_step(acc1, 0); Vf[1][1] = pack_step(acc1, 1);
            aq1 = MFMA32(tf[2], Vf[0][0], aq1); aq0 = MFMA32(tf[0], Vf[0][0], aq0); aq1 = MFMA32(tf[3], Vf[0][1], aq1); aq0 = MFMA32(tf[1], Vf[0][1], aq0);
            aq1 = MFMA32(tf[4], Vf[1][0], aq1); aq1 = MFMA32(tf[5], Vf[1][1], aq1);
            if (n >= 4) {
#pragma unroll
                for (int i = 0; i < 16; i += 2) { const unsigned p0 = pk2(aq0[i], aq0[i + 1]), p1 = pk2(aq1[i], aq1[i + 1]); const int k0 = (i & 3) + 8 * (i >> 2);
                    unsigned char* ogb = (unsigned char*)OG;
                    *(bf16*)(ogb + (unsigned)(ob + (unsigned)(ostb * k0))) = (bf16)(p0 & 0xffffu); *(bf16*)(ogb + (unsigned)(ob + (unsigned)(ostb * (k0 + 1)))) = (bf16)(p0 >> 16);
                    *(bf16*)(ogb + (unsigned)(ob + (unsigned)(ostb * (32 + k0)))) = (bf16)(p1 & 0xffffu); *(bf16*)(ogb + (unsigned)(ob + (unsigned)(ostb * (33 + k0)))) = (bf16)(p1 >> 16); } }
            bf16x8 kd[16];
#pragma unroll
            for (int q = 0; q < 16; ++q) kd[q] = GR_FRAG(GR_KD, q);
            GR_FENCE();
            const float gtot = tab[128 + 63];
#pragma unroll
            for (int t = 0; t < 4; ++t) {
#pragma unroll
                for (int i = 0; i < 16; ++i) S[t][i] *= gtot; }
#pragma unroll
            for (int cb = 0; cb < 4; ++cb) {
#pragma unroll
                for (int t = 0; t < 4; ++t) S[t] = MFMA32(kd[t * 4 + cb], Vf[cb >> 1][cb & 1], S[t]); }
#undef GR_LD4
        }
        GR_STEP_BARRIER();
    }
    }
    asm volatile("s_waitcnt vmcnt(0)" ::: "memory"); __syncthreads();
#undef GR_STEP_BARRIER
#undef GR_FENCE
#undef GR_LOADROW
#undef GR_FRAG
#undef GR_LOADV
}
__device__ __forceinline__ void phase_gdn_rec(const Ctx& c) { if (c.bid < 128) gdn_rec_block(c, c.bid >> 1, c.bid & 1); }

#define XB_TMO      128
#define XB_XCNT(j)  (256  + 64 * (j))
#define XB_XSUB(j)  (1280 + 64 * (j))
#define XB_XGEN(j)  (2304 + 64 * (j))
#define XB_TOP      3328
#define XB_TOPGEN   3392
#define XCD_BAR_WORDS 3456
#define XB_SPIN_CAP (1u << 20)
__device__ __forceinline__ unsigned xb_ld(unsigned* p)              { return __hip_atomic_load(p, __ATOMIC_RELAXED, __HIP_MEMORY_SCOPE_AGENT); }
__device__ __forceinline__ unsigned xb_add(unsigned* p, unsigned v) { return __hip_atomic_fetch_add(p, v, __ATOMIC_RELAXED, __HIP_MEMORY_SCOPE_AGENT); }
__device__ __forceinline__ unsigned xb_xcc_id() { return (unsigned)__builtin_amdgcn_s_getreg((3 << 11) | 20) & 0xFu; }
#define XB_SPIN(cond, bar) do { unsigned _sp = 0; while (cond) { __builtin_amdgcn_s_sleep(1); \
    if ((++_sp & 255u) == 0u) { if (xb_ld(&(bar)[XB_TMO])) break; if (_sp > XB_SPIN_CAP) { atomicAdd(&(bar)[XB_TMO], 1u); break; } } } } while (0)
struct XcdBarrier { unsigned* bar; unsigned x; volatile LAS unsigned* st; };
__device__ __forceinline__ XcdBarrier xcd_barrier_post(unsigned* bar, volatile LAS unsigned* st) {
    XcdBarrier b; b.bar = bar; b.x = xb_xcc_id(); b.st = st;
    if (threadIdx.x == 0) (void)xb_add(&bar[XB_XCNT(b.x)], 1u);
    return b;
}
__device__ __forceinline__ void xcd_barrier_complete(unsigned* bar, unsigned x, unsigned& nloc, unsigned& nx) {
    const unsigned G = gridDim.x * gridDim.y * gridDim.z;
    unsigned sum, cnt, mine, sp = 0u;
    for (;;) {
        sum = 0u; cnt = 0u; mine = 0u;
#pragma unroll
        for (unsigned j = 0; j < 16; ++j) { const unsigned c = xb_ld(&bar[XB_XCNT(j)]); sum += c; cnt += (c > 0u) ? 1u : 0u; mine = (j == x) ? c : mine; }
        if (sum == G) break;
        __builtin_amdgcn_s_sleep(1);
        if ((++sp & 255u) == 0u) { if (xb_ld(&bar[XB_TMO])) break; if (sp > XB_SPIN_CAP) { atomicAdd(&bar[XB_TMO], 1u); break; } }
    }
    nloc = mine > 0u ? mine : 1u; nx = cnt > 0u ? cnt : 1u;
}
__device__ __forceinline__ void xcd_barrier(const XcdBarrier& b) {
    asm volatile("s_waitcnt vmcnt(0)" ::: "memory");
    __syncthreads();
    if (threadIdx.x == 0) {
        unsigned* bar = b.bar;
        __builtin_amdgcn_s_waitcnt(0);
        unsigned nloc = b.st[0], nx = b.st[1];
        if (nloc == 0u) { xcd_barrier_complete(bar, b.x, nloc, nx); b.st[0] = nloc; b.st[1] = nx; }
        const unsigned old = xb_add(&bar[XB_XSUB(b.x)], 1u);
        const unsigned gen = old / nloc;
        if (old + 1u == (gen + 1u) * nloc) {
            __builtin_amdgcn_fence(__ATOMIC_RELEASE, "agent");
            asm volatile("s_waitcnt vmcnt(0)" ::: "memory");
            const unsigned og = xb_add(&bar[XB_TOP], 1u);
            const unsigned tg = og / nx;
            if (og + 1u == (tg + 1u) * nx) xb_add(&bar[XB_TOPGEN], 1u);
            else XB_SPIN(xb_ld(&bar[XB_TOPGEN]) == tg, bar);
            __builtin_amdgcn_fence(__ATOMIC_ACQUIRE, "agent");
            asm volatile("s_waitcnt vmcnt(0)" ::: "memory");
        } else {
            XB_SPIN(xb_ld(&bar[XB_TOPGEN]) == gen, bar);
            __builtin_amdgcn_fence(__ATOMIC_ACQUIRE, "agent");
            asm volatile("s_waitcnt vmcnt(0)" ::: "memory");
        }
    }
    __syncthreads();
}

constexpr int LDS_MISC = LDS_BYTES - 64;
__global__ void __launch_bounds__(NTHREADS, 2) mk_fwd(Args args) {
    extern __shared__ __attribute__((aligned(16))) unsigned char lds[];
    Ctx c; c.a = &args; c.ws = args.ws; c.lds = lds;
    c.tid = threadIdx.x; c.lane = c.tid & 63; c.wave = __builtin_amdgcn_readfirstlane(c.tid >> 6); c.bid = blockIdx.x; c.G = gridDim.x;
    c.gw = c.bid * NWAVES + c.wave; c.NGW = c.G * NWAVES; c.gwv = c.wave * c.G + c.bid;
    const int lo = args.ph_lo, hi = args.ph_hi;
    PG8_LAS unsigned char* ring = (PG8_LAS unsigned char*)lds;
#ifndef MK_PH_MASK
#define MK_PH_MASK 0xffff
#endif
#define IN(k) (((MK_PH_MASK >> (k)) & 1) && lo <= (k) && (k) < hi)
#if MK_ONE_LAUNCH
    cg::grid_group grid = cg::this_grid();
    if (lo < 0) grid.sync();
    volatile LAS unsigned* st = (volatile LAS unsigned*)((LAS unsigned char*)lds + LDS_MISC);
    if (c.tid < 2) st[c.tid] = 0u;
    __syncthreads();
    const XcdBarrier bar = xcd_barrier_post(g_ctl + CW_BAR, st);
#define SEAM(k) do { if (IN(k) && IN((k) + 1)) xcd_barrier(bar); } while (0)
#else
#define SEAM(k) do { } while (0)
#endif
    if (IN(0)) { phase_prep(c); phase_s5_build(c); } SEAM(0);
    if (IN(1)) { phase_norm1(c); } SEAM(1);
    if (IN(2)) { pg8::Gemm g{(const pg8::bf16_t*)(c.ws + WS_HX), (const pg8::bf16_t*)(c.ws + WS_WIN), 1024, 1024, 1024}; pg8::StaticOrder S; S.init(MT, NPROJ, c.G, c.bid);
        pg8::EpiInProj E{(pg8::bf16_t*)(c.ws + WS_U5), (pg8::bf16_t*)(c.ws + WS_QKVPRE), (pg8::bf16_t*)(c.ws + WS_Z)};
        pg8::gemm_phase<pg8::EpiInProj, pg8::StaticOrder, true, true>(ring, g, S, E); } SEAM(2);
    if (IN(3)) { { pg8::Gemm g{(const pg8::bf16_t*)(c.ws + WS_U5), (const pg8::bf16_t*)(c.ws + WS_PM), 768, 512, 512}; pg8::SchedSS S{c.G, c.bid}; pg8::EpiSS E{(float*)(c.ws + WS_SS)};
          pg8::gemm_phase<pg8::EpiSS, pg8::SchedSS, true, true>(ring, g, S, E); }
        __syncthreads(); for (int it = c.G - 1 - c.bid; it < 128; it += c.G) if (it >= 0) s5_build_group<1>(c, it >> 2, it & 3);
        __syncthreads(); phase_conv(c); } SEAM(3);
    if (IN(4)) { phase_gdn_prep(c); } SEAM(4);
    if (IN(5)) { pg8::Gemm g{(const pg8::bf16_t*)(c.ws + WS_U5), (const pg8::bf16_t*)(c.ws + WS_BB), 768, 768, 768}; pg8::SchedS5Y S{c.G, c.bid}; pg8::EpiS5Y E{(pg8::bf16_t*)(c.ws + WS_YG)};
        pg8::gemm_phase<pg8::EpiS5Y, pg8::SchedS5Y, true, true>(ring, g, S, E); } SEAM(5);
    if (IN(6)) { if (c.bid < 128) phase_gdn_rec(c);
        else { pg8::Gemm g{(const pg8::bf16_t*)(c.ws + WS_YG), (const pg8::bf16_t*)(c.ws + WS_WGLU), 512, 512, 512}; pg8::StaticOrder S; S.init(ML, 512, c.G - 128, c.bid - 128);
            pg8::EpiGlu E{(const pg8::bf16_t*)(c.ws + WS_YG), (pg8::bf16_t*)(c.ws + WS_CAT)};
            pg8::gemm_phase<pg8::EpiGlu, pg8::StaticOrder, true, true>(ring, g, S, E);
            __syncthreads(); phase_late_copies(c, 128 * NWAVES, (c.G - 128) * NWAVES); } } SEAM(6);
    if (IN(7)) { phase_combine(c); } SEAM(7);
    if (IN(8)) { pg8::Gemm g{(const pg8::bf16_t*)(c.ws + WS_CAT), (const pg8::bf16_t*)(c.ws + WS_WOUT), 1024, 1024, 1024}; pg8::StaticOrder S; S.init(ML, 1024, c.G, c.bid);
        pg8::EpiBf16<0> E{(pg8::bf16_t*)(c.ws + WS_YRAW), 1024, nullptr, 0, 0, 1.f};
        pg8::gemm_phase<pg8::EpiBf16<0>, pg8::StaticOrder, true, true>(ring, g, S, E); } SEAM(8);
    if (IN(9)) { phase_rows2(c); phase_fp8_tables(c); } SEAM(9);
    if (IN(10)) { pg8::Gemm g{(const pg8::bf16_t*)(c.ws + WS_HX2), (const pg8::bf16_t*)(c.ws + WS_WQ), 1024, 1024, 1024}; pg8::StaticOrder S; S.init(ML, 2048, c.G, c.bid);
        pg8::EpiBf16<0> E{(pg8::bf16_t*)(c.ws + WS_QP), 2048, nullptr, 0, 0, 1.f};
        pg8::gemm_phase<pg8::EpiBf16<0>, pg8::StaticOrder, true, true>(ring, g, S, E); } SEAM(10);
    if (IN(11)) { phase_topk(c); } SEAM(11);
    if (IN(12)) { phase_exp1(c); } SEAM(12);
    if (IN(13)) { phase_exp1b(c); } SEAM(13);
    if (IN(14)) { phase_exp2(c); } SEAM(14);
    if (IN(15)) { phase_exp3(c); }
    if (c.tid == 0) {
        unsigned* ctl = g_ctl;
        const unsigned old = xb_add(&ctl[CW_EXIT], 1u);
        if (old + 1u == (unsigned)c.G) {
#pragma unroll 1
            for (int j = 0; j < 16; ++j) { __hip_atomic_store(&ctl[CW_BAR + XB_XCNT(j)], 0u, __ATOMIC_RELAXED, __HIP_MEMORY_SCOPE_AGENT); __hip_atomic_store(&ctl[CW_BAR + XB_XSUB(j)], 0u, __ATOMIC_RELAXED, __HIP_MEMORY_SCOPE_AGENT);
                __hip_atomic_store(&ctl[CW_BAR + XB_XGEN(j)], 0u, __ATOMIC_RELAXED, __HIP_MEMORY_SCOPE_AGENT); __hip_atomic_store(&ctl[CW_E1 + 64 * j], 0u, __ATOMIC_RELAXED, __HIP_MEMORY_SCOPE_AGENT); }
            __hip_atomic_store(&ctl[CW_BAR + XB_TOP], 0u, __ATOMIC_RELAXED, __HIP_MEMORY_SCOPE_AGENT); __hip_atomic_store(&ctl[CW_BAR + XB_TOPGEN], 0u, __ATOMIC_RELAXED, __HIP_MEMORY_SCOPE_AGENT);
            __hip_atomic_store(&ctl[CW_BAR + XB_TMO], 0u, __ATOMIC_RELAXED, __HIP_MEMORY_SCOPE_AGENT); __hip_atomic_store(&ctl[CW_EXIT], 0u, __ATOMIC_RELAXED, __HIP_MEMORY_SCOPE_AGENT);
        }
    }
#undef IN
#undef SEAM
}

extern "C" void kernel_launch(void* const* d_in, const int* in_sizes, int n_in, void* d_out, int out_size, void* d_ws, size_t ws_size, hipStream_t stream) {
    static int grid = 0;
    if (grid == 0) {
        if (n_in != 29 || out_size != ML * D || ws_size < WS_END) { fprintf(stderr, "kernel_launch: unexpected shapes (n_in %d out %d ws %zu)\n", n_in, out_size, ws_size); grid = -1; return; }
        int dev = 0, cus = 0, per_cu = 0;
        (void)hipGetDevice(&dev); (void)hipDeviceGetAttribute(&cus, hipDeviceAttributeMultiprocessorCount, dev);
        if (hipFuncSetAttribute((const void*)mk_fwd, hipFuncAttributeMaxDynamicSharedMemorySize, LDS_BYTES) != hipSuccess) { fprintf(stderr, "kernel_launch: hipFuncSetAttribute failed\n"); grid = -1; return; }
        (void)hipOccupancyMaxActiveBlocksPerMultiprocessor(&per_cu, (const void*)mk_fwd, NTHREADS, LDS_BYTES);
        (void)hipGetLastError();
        grid = cus;
        fprintf(stderr, "kernel_launch: cus %d per_cu %d grid %d\n", cus, per_cu, grid);
    }
    if (grid < 0) return;
    Args a{};
    for (int i = 0; i < 29; ++i) a.in[i] = (const float*)d_in[i];
    a.out = (float*)d_out; a.ws = (unsigned char*)d_ws;
#if MK_ONE_LAUNCH
    a.ph_lo = 0; a.ph_hi = NPHASES;
    void* kargs[] = {&a};
    hipError_t e = hipLaunchCooperativeKernel((const void*)mk_fwd, dim3(grid), dim3(NTHREADS), kargs, LDS_BYTES, stream);
    if (e != hipSuccess) fprintf(stderr, "kernel_launch: cooperative launch failed: %s\n", hipGetErrorString(e));
#else
    for (int ph = 0; ph < NPHASES; ++ph) { a.ph_lo = ph; a.ph_hi = ph + 1; hipLaunchKernelGGL(mk_fwd, dim3(grid), dim3(NTHREADS), LDS_BYTES, stream, a); }
#endif
}
```
